# Optimizing an MI355X kernel written in HIP

```python
import math
import jax, jax.numpy as jnp
from jax import lax
import numpy as np

D_MODEL = 1024
BATCH = 32
SEQ = 256
DEPTH = 1
DEC_BATCH = 8
DEC_SEQ = 2048
PAST_LEN = 256

GRID_W = 64
N_HEADS = 4
HEAD_DIM = 256
D_MLSTM = N_HEADS * HEAD_DIM
D_HYENA = D_MODEL
HYENA_ORDER = 2
SHORT_CONV = 3
FILT_BANDS = 16
FILT_EMB = 1 + 2 * FILT_BANDS
FILT_WIDTH = 64
HYENA_MIN_DECAY = math.log(1e-2) / 1.5
HYENA_MAX_DECAY = math.log(1e-2) / 0.3
D_FF = 4 * D_MODEL
CHUNK = 128
RMS_EPS = 1e-6
SPLIT_SIZES = (D_MLSTM, D_MLSTM, D_MLSTM, D_MLSTM, 4 * N_HEADS, 3 * D_HYENA, D_MODEL, D_MODEL)
IN_COLS = 4 * D_MLSTM + 4 * N_HEADS + 3 * D_HYENA + 2 * D_MODEL

kernel_name = "hybrid_mlstm_hyena_diffusion_step"


def rmsnorm(x, w):
    xf = x.astype(jnp.float32)
    y = xf * lax.rsqrt(jnp.mean(xf * xf, axis=-1, keepdims=True) + RMS_EPS)
    return (y * w.astype(jnp.float32)).astype(x.dtype)


def grid_pos_embed(n_tokens):
    rows = n_tokens // GRID_W
    quarter = D_MODEL // 4
    omega = 1.0 / (10000.0 ** (jnp.arange(quarter, dtype=jnp.float32) / quarter))

    def axis_embed(pos):
        a = pos[:, None] * omega[None, :]
        return jnp.concatenate([jnp.sin(a), jnp.cos(a)], axis=-1)

    er = axis_embed(jnp.arange(rows, dtype=jnp.float32))
    ec = axis_embed(jnp.arange(GRID_W, dtype=jnp.float32))
    half = D_MODEL // 2
    pos = jnp.concatenate([jnp.broadcast_to(er[:, None, :], (rows, GRID_W, half)),
                           jnp.broadcast_to(ec[None, :, :], (rows, GRID_W, half))], axis=-1)
    return pos.reshape(rows * GRID_W, D_MODEL)


def mlstm_scan(q, k, v, li, lf, C0, n0, m0):
    B, S, H, DK = q.shape
    nc = S // CHUNK

    def to_chunks(a):
        a = a.reshape((B, nc, CHUNK, H) + a.shape[3:])
        return jnp.moveaxis(a, (1, 3), (0, 2))

    tril = jnp.tril(jnp.ones((CHUNK, CHUNK), dtype=bool))

    def step(carry, inp):
        C, n, m = carry
        qc, kc, vc, lic, lfc = inp
        b = jnp.cumsum(lfc, axis=-1)
        d = jnp.where(tril, b[..., :, None] - b[..., None, :] + lic[..., None, :], -jnp.inf)
        m_inter = b + m[..., None]
        m_comb = jnp.maximum(m_inter, jnp.max(d, axis=-1))
        s = jnp.einsum('bhjd,bhsd->bhjs', qc, kc) * jnp.exp(d - m_comb[..., None])
        w_inter = jnp.exp(m_inter - m_comb)
        num = w_inter[..., None] * jnp.einsum('bhjk,bhkv->bhjv', qc, C) + jnp.einsum('bhjs,bhsv->bhjv', s, vc)
        den = w_inter * jnp.einsum('bhjk,bhk->bhj', qc, n) + jnp.sum(s, axis=-1)
        h = num / jnp.maximum(jnp.abs(den), jnp.exp(-m_comb))[..., None]
        b_last = b[..., -1]
        a = b_last[..., None] - b + lic
        m_new = jnp.maximum(b_last + m, jnp.max(a, axis=-1))
        w_state = jnp.exp(a - m_new[..., None])
        decay = jnp.exp(b_last + m - m_new)
        C_new = decay[..., None, None] * C + jnp.einsum('bhsk,bhsv->bhkv', kc * w_state[..., None], vc)
        n_new = decay[..., None] * n + jnp.einsum('bhs,bhsk->bhk', w_state, kc)
        return (C_new, n_new, m_new), h

    xs = (to_chunks(q), to_chunks(k), to_chunks(v), to_chunks(li), to_chunks(lf))
    (C, n, m), h = lax.scan(step, (C0, n0, m0), xs)
    h = jnp.moveaxis(h, (0, 2), (1, 3)).reshape(B, S, H, v.shape[-1])
    return h, C, n, m


def mlstm_bidir(q, k, v, i_f, f_f, i_b, f_b, C0, n0, m0):
    hf, Cf, nf, mf = mlstm_scan(q, k, v, i_f, jax.nn.log_sigmoid(f_f), C0[:, 0], n0[:, 0], m0[:, 0])
    fl = lambda a: jnp.flip(a, axis=1)
    hb, Cb, nb, mb = mlstm_scan(fl(q), fl(k), fl(v), fl(i_b), fl(jax.nn.log_sigmoid(f_b)),
                                C0[:, 1], n0[:, 1], m0[:, 1])
    return (hf + fl(hb), jnp.stack([Cf, Cb], axis=1), jnp.stack([nf, nb], axis=1),
            jnp.stack([mf, mb], axis=1))


def hyena_filters(L, w1, b1, fr1, w2, b2, fr2, w3):
    f32 = jnp.float32
    t_idx = jnp.arange(L, dtype=f32)
    t = jnp.linspace(0.0, 1.0, L, dtype=f32)
    bands = jnp.arange(1, FILT_BANDS + 1, dtype=f32)
    ang = (2.0 * math.pi / L) * t_idx[:, None] * bands[None, :]
    z = jnp.concatenate([t[:, None], jnp.cos(ang), jnp.sin(ang)], axis=-1)
    h = jnp.sin(fr1.astype(f32) * (z @ w1.astype(f32) + b1.astype(f32)))
    h = jnp.sin(fr2.astype(f32) * (h @ w2.astype(f32) + b2.astype(f32)))
    h = (h @ w3.astype(f32)).reshape(L, HYENA_ORDER, D_HYENA)
    centre = L // 2
    dist = jnp.abs(t_idx - centre) / centre
    deltas = jnp.abs(jnp.linspace(HYENA_MIN_DECAY, HYENA_MAX_DECAY, D_HYENA, dtype=f32))
    h = h * jnp.exp(-dist[:, None, None] * deltas[None, None, :])
    return h / (jnp.sum(jnp.abs(h), axis=0, keepdims=True) + 1e-6)


def long_conv(z, h):
    L = z.shape[1]
    n = 2 * L
    y = jnp.fft.irfft(jnp.fft.rfft(z, n=n, axis=1) * jnp.fft.rfft(h, n=n, axis=0)[None], n=n, axis=1)
    return y[:, L // 2: L // 2 + L]


def short_conv(u, w, b):
    L = u.shape[1]
    pad = SHORT_CONV // 2
    up = jnp.pad(u, ((0, 0), (pad, SHORT_CONV - 1 - pad), (0, 0)))
    out = b
    for j in range(SHORT_CONV):
        out = out + up[:, j:j + L] * w[j]
    return out


def hyena(u, conv_w, conv_b, w1, b1, fr1, w2, b2, fr2, w3, skip):
    L = u.shape[1]
    uc = short_conv(u.astype(jnp.float32), conv_w.astype(jnp.float32), conv_b.astype(jnp.float32))
    x1, x2, z = jnp.split(uc, 3, axis=-1)
    h = hyena_filters(L, w1, b1, fr1, w2, b2, fr2, w3)
    skip = skip.astype(jnp.float32)
    for o, gate in enumerate((x1, x2)):
        z = gate * (long_conv(z, h[:, o]) + skip[o] * z)
    return z


def layer(x, cond, C0, n0, m0, w_ada, b_ada, norm1_w, w_in, b_in, hy_conv_w, hy_conv_b,
          filt_w1, filt_b1, filt_freq1, filt_w2, filt_b2, filt_freq2, filt_w3, hy_skip,
          mlstm_norm_w, w_br_m, w_br_h, w_out, norm2_w, w_mlp1, b_mlp1, w_mlp2, b_mlp2):
    B, S, _ = x.shape
    f32 = jnp.float32
    mod = jax.nn.silu(cond) @ w_ada + b_ada
    sh1, sc1, g1, sh2, sc2, g2 = jnp.split(mod[:, None, :], 6, axis=-1)
    hn = rmsnorm(x, norm1_w) * (1 + sc1) + sh1
    proj = hn @ w_in + b_in
    idx = [int(i) for i in np.cumsum(SPLIT_SIZES)[:-1]]
    q, k, v, o, gates, u_h, gm, gh = jnp.split(proj, idx, axis=-1)
    q = q.astype(f32).reshape(B, S, N_HEADS, HEAD_DIM) * (HEAD_DIM ** -0.5)
    k = k.astype(f32).reshape(B, S, N_HEADS, HEAD_DIM)
    v = v.astype(f32).reshape(B, S, N_HEADS, HEAD_DIM)
    gates = gates.astype(f32).reshape(B, S, 4, N_HEADS)
    h, C, n, m = mlstm_bidir(q, k, v, gates[:, :, 0], gates[:, :, 1], gates[:, :, 2], gates[:, :, 3],
                             C0.astype(f32), n0.astype(f32), m0.astype(f32))
    h = h * lax.rsqrt(jnp.mean(h * h, axis=-1, keepdims=True) + RMS_EPS)
    h = h.reshape(B, S, D_MLSTM) * mlstm_norm_w.astype(f32) * jax.nn.sigmoid(o.astype(f32))
    h = h.astype(x.dtype)
    yh = hyena(u_h, hy_conv_w, hy_conv_b, filt_w1, filt_b1, filt_freq1, filt_w2, filt_b2,
               filt_freq2, filt_w3, hy_skip).astype(x.dtype)
    merged = jax.nn.sigmoid(gm) * (h @ w_br_m) + jax.nn.sigmoid(gh) * (yh @ w_br_h)
    x = x + g1 * (merged @ w_out)
    hn2 = rmsnorm(x, norm2_w) * (1 + sc2) + sh2
    ff = jnp.square(jax.nn.relu(hn2 @ w_mlp1 + b_mlp1)) @ w_mlp2 + b_mlp2
    x = x + g2 * ff
    return x, C, n, m


def setup_inputs(seed: int = 0) -> dict:
    key = jax.random.key(seed)
    ks = jax.random.split(key, 32)
    nrm = lambda k, shape, s=1.0: s * jax.random.normal(k, shape, dtype=jnp.float32)
    gate_off = 4 * D_MLSTM
    forget_bias = jnp.linspace(3.0, 6.0, N_HEADS, dtype=jnp.float32)
    b_in = nrm(ks[10], (DEPTH, IN_COLS), 0.01)
    b_in = b_in.at[:, gate_off + N_HEADS: gate_off + 2 * N_HEADS].add(forget_bias)
    b_in = b_in.at[:, gate_off + 3 * N_HEADS: gate_off + 4 * N_HEADS].add(forget_bias)
    return {
        "x_prompt": nrm(ks[0], (BATCH, SEQ, D_MODEL)),
        "x_sample": nrm(ks[1], (DEC_BATCH, DEC_SEQ, D_MODEL)),
        "state_mlstm_C": nrm(ks[2], (DEC_BATCH, DEPTH, 2, N_HEADS, HEAD_DIM, HEAD_DIM), 0.3),
        "state_mlstm_n": nrm(ks[3], (DEC_BATCH, DEPTH, 2, N_HEADS, HEAD_DIM), 0.3),
        "state_mlstm_m": nrm(ks[4], (DEC_BATCH, DEPTH, 2, N_HEADS), 0.5),
        "c": nrm(ks[5], (DEC_BATCH, D_MODEL)),
        "c_ctx": nrm(ks[6], (D_MODEL,)),
        "w_ada": nrm(ks[7], (DEPTH, D_MODEL, 6 * D_MODEL), 0.5 * D_MODEL ** -0.5),
        "b_ada": nrm(ks[8], (DEPTH, 6 * D_MODEL), 0.01),
        "norm1_w": 1.0 + nrm(ks[9], (DEPTH, D_MODEL), 0.05),
        "w_in": nrm(ks[11], (DEPTH, D_MODEL, IN_COLS), D_MODEL ** -0.5),
        "b_in": b_in,
        "hy_conv_w": nrm(ks[12], (DEPTH, SHORT_CONV, 3 * D_HYENA), SHORT_CONV ** -0.5),
        "hy_conv_b": nrm(ks[13], (DEPTH, 3 * D_HYENA), 0.01),
        "filt_w1": nrm(ks[14], (DEPTH, FILT_EMB, FILT_WIDTH), FILT_EMB ** -0.5),
        "filt_b1": nrm(ks[15], (DEPTH, FILT_WIDTH), 0.01),
        "filt_freq1": 1.0 + nrm(ks[16], (DEPTH, FILT_WIDTH), 0.1),
        "filt_w2": nrm(ks[17], (DEPTH, FILT_WIDTH, FILT_WIDTH), FILT_WIDTH ** -0.5),
        "filt_b2": nrm(ks[18], (DEPTH, FILT_WIDTH), 0.01),
        "filt_freq2": 1.0 + nrm(ks[19], (DEPTH, FILT_WIDTH), 0.1),
        "filt_w3": nrm(ks[20], (DEPTH, FILT_WIDTH, HYENA_ORDER * D_HYENA), FILT_WIDTH ** -0.5),
        "hy_skip": nrm(ks[21], (DEPTH, HYENA_ORDER, D_HYENA)),
        "mlstm_norm_w": 1.0 + nrm(ks[22], (DEPTH, D_MLSTM), 0.05),
        "w_br_m": nrm(ks[23], (DEPTH, D_MLSTM, D_MODEL), D_MLSTM ** -0.5),
        "w_br_h": nrm(ks[24], (DEPTH, D_HYENA, D_MODEL), D_HYENA ** -0.5),
        "w_out": nrm(ks[25], (DEPTH, D_MODEL, D_MODEL), D_MODEL ** -0.5),
        "norm2_w": 1.0 + nrm(ks[26], (DEPTH, D_MODEL), 0.05),
        "w_mlp1": nrm(ks[27], (DEPTH, D_MODEL, D_FF), D_MODEL ** -0.5),
        "b_mlp1": nrm(ks[28], (DEPTH, D_FF), 0.01),
        "w_mlp2": nrm(ks[29], (DEPTH, D_FF, D_MODEL), D_FF ** -0.5),
        "b_mlp2": nrm(ks[30], (DEPTH, D_MODEL), 0.01),
        "final_norm_w": 1.0 + nrm(ks[31], (D_MODEL,), 0.05),
    }


def reference(x_prompt, x_sample, state_mlstm_C, state_mlstm_n, state_mlstm_m, c, c_ctx,
              w_ada, b_ada, norm1_w, w_in, b_in, hy_conv_w, hy_conv_b, filt_w1, filt_b1,
              filt_freq1, filt_w2, filt_b2, filt_freq2, filt_w3, hy_skip, mlstm_norm_w,
              w_br_m, w_br_h, w_out, norm2_w, w_mlp1, b_mlp1, w_mlp2, b_mlp2, final_norm_w):
    layer_params = (w_ada, b_ada, norm1_w, w_in, b_in, hy_conv_w, hy_conv_b, filt_w1, filt_b1,
                    filt_freq1, filt_w2, filt_b2, filt_freq2, filt_w3, hy_skip, mlstm_norm_w,
                    w_br_m, w_br_h, w_out, norm2_w, w_mlp1, b_mlp1, w_mlp2, b_mlp2)
    f32 = jnp.float32
    bp = x_prompt.shape[0]
    zC = jnp.zeros((bp, 2, N_HEADS, HEAD_DIM, HEAD_DIM), f32)
    zn = jnp.zeros((bp, 2, N_HEADS, HEAD_DIM), f32)
    zm = jnp.zeros((bp, 2, N_HEADS), f32)
    xp = x_prompt
    Cs, ns, ms = [], [], []
    for l in range(DEPTH):
        lw = [p[l] for p in layer_params]
        xp, Cl, nl, ml = layer(xp, c_ctx[None, :], zC, zn, zm, *lw)
        Cs.append(Cl)
        ns.append(nl)
        ms.append(ml)
    y_prompt = rmsnorm(xp, final_norm_w)
    new_state_C = jnp.stack(Cs, axis=1)
    new_state_n = jnp.stack(ns, axis=1)
    new_state_m = jnp.stack(ms, axis=1)
    xs = x_sample + grid_pos_embed(x_sample.shape[1]).astype(x_sample.dtype)[None]
    for l in range(DEPTH):
        lw = [p[l] for p in layer_params]
        xs, _, _, _ = layer(xs, c, state_mlstm_C[:, l], state_mlstm_n[:, l], state_mlstm_m[:, l], *lw)
    y_sample = rmsnorm(xs, final_norm_w)
    return (y_prompt, y_sample, new_state_C, new_state_n, new_state_m)
```

```cpp
#include <hip/hip_runtime.h>
#include <hip/hip_cooperative_groups.h>
#include <cstdio>
#include <cstdint>
namespace cg = cooperative_groups;

#define LAS __attribute__((address_space(3)))
typedef LAS unsigned char* LP;
typedef unsigned short bf16_t;
typedef short bf16x8 __attribute__((ext_vector_type(8)));
typedef short s16x4 __attribute__((ext_vector_type(4)));
typedef float f32x4 __attribute__((ext_vector_type(4)));
typedef float f32x16 __attribute__((ext_vector_type(16)));
typedef unsigned u32x4 __attribute__((ext_vector_type(4)));
typedef unsigned u32x2 __attribute__((ext_vector_type(2)));

constexpr int DM = 1024, NTOK = 24576, NCTX = 8192, SEQC = 256, SEQS = 2048, INC = 9232;
constexpr int LDS_BYTES = 160 * 1024;
constexpr size_t OFF_WT = 0;
constexpr size_t OFF_WBM = 18874368, OFF_WBH = 20971520, OFF_WOUT = 23068672, OFF_W1T = 25165824, OFF_W2T = 33554432;
constexpr size_t OFF_HN = 41943040;
constexpr size_t OFF_BIG = 92274688;
constexpr size_t OFF_SM = 243269632;
constexpr size_t OFF_MOD = OFF_SM;
constexpr size_t OFF_C1 = OFF_MOD + 221184;
constexpr size_t OFF_H2S = OFF_C1 + 147456;
constexpr size_t OFF_H2C = OFF_H2S + 524288;
constexpr size_t OFF_PER = OFF_H2C + 65536;
constexpr size_t OFF_PEC = OFF_PER + 65536;
constexpr size_t OFF_GT = OFF_PEC + 131072;
constexpr size_t OFF_SSQ1 = OFF_GT + 1572864;
constexpr size_t OFF_SSQ2 = OFF_SSQ1 + 1572864;
constexpr size_t OFF_HFS = OFF_SSQ2 + 1572864;
constexpr size_t OFF_HFC = OFF_HFS + 16777216;
constexpr size_t OFF_BAR = OFF_HFC + 2097152;
constexpr size_t WS_END = OFF_BAR + 3456 * 4;
constexpr size_t OUT_H = 0, OUT_HB = 50331648;
constexpr size_t OUTF_C = 25165824, OUTF_N = 41943040, OUTF_M = 42008576;

struct Params { const float* in[32]; float* out; unsigned char* ws; };

__device__ __forceinline__ bf16_t f2bf(float f) { unsigned u = __float_as_uint(f); u += 0x7FFFu + ((u >> 16) & 1u); return (bf16_t)(u >> 16); }
__device__ __forceinline__ float bf2f(unsigned b) { return __uint_as_float(b << 16); }
__device__ __forceinline__ unsigned pack2(float lo, float hi) { return (unsigned)f2bf(lo) | ((unsigned)f2bf(hi) << 16); }
__device__ __forceinline__ float bflo(unsigned w) { return __uint_as_float(w << 16); }
__device__ __forceinline__ float bfhi(unsigned w) { return __uint_as_float(w & 0xffff0000u); }
__device__ __forceinline__ float sigmoidf_(float x) { return 1.0f / (1.0f + __expf(-x)); }
__device__ __forceinline__ int opaque_tid() { int t = threadIdx.x; asm volatile("" : "+v"(t)); return t; }
__device__ __forceinline__ float wave_sum(float v) {
#pragma unroll
  for (int o = 32; o >= 1; o >>= 1) v += __shfl_xor(v, o);
  return v;
}


#define XB_TMO      128
#define XB_XCNT(j)  (256  + 64 * (j))
#define XB_XSUB(j)  (1280 + 64 * (j))
#define XB_XGEN(j)  (2304 + 64 * (j))
#define XB_TOP      3328
#define XB_TOPGEN   3392
#define XCD_BAR_WORDS 3456
#define XB_SPIN_CAP (1u << 18)
__device__ __forceinline__ unsigned xb_ld(unsigned* p)              { return __hip_atomic_load(p, __ATOMIC_RELAXED, __HIP_MEMORY_SCOPE_AGENT); }
__device__ __forceinline__ unsigned xb_add(unsigned* p, unsigned v) { return __hip_atomic_fetch_add(p, v, __ATOMIC_RELAXED, __HIP_MEMORY_SCOPE_AGENT); }
__device__ __forceinline__ unsigned xb_xcc_id() { return (unsigned)__builtin_amdgcn_s_getreg((3 << 11) | 20) & 0xFu; }
#define XB_SPIN(cond, bar) do { unsigned _sp = 0; while (cond) { __builtin_amdgcn_s_sleep(1); \
    if ((++_sp & 255u) == 0u) { if (xb_ld(&(bar)[XB_TMO])) break; if (_sp > XB_SPIN_CAP) { atomicAdd(&(bar)[XB_TMO], 1u); break; } } } } while (0)
struct XcdBarrier { unsigned* bar; unsigned x; volatile LAS unsigned* st; };
__device__ __forceinline__ XcdBarrier xcd_barrier_post(unsigned* bar, volatile LAS unsigned* st) {
  XcdBarrier b; b.bar = bar; b.x = xb_xcc_id(); b.st = st;
  if (threadIdx.x == 0) (void)xb_add(&bar[XB_XCNT(b.x)], 1u);
  return b;
}
__device__ __forceinline__ void xcd_barrier_complete(unsigned* bar, unsigned x, unsigned& nloc, unsigned& nx) {
  const unsigned G = gridDim.x * gridDim.y * gridDim.z;
  unsigned sum, cnt, mine, sp = 0u;
  for (;;) {
    sum = 0u; cnt = 0u; mine = 0u;
#pragma unroll
    for (unsigned j = 0; j < 16; ++j) { const unsigned c = xb_ld(&bar[XB_XCNT(j)]); sum += c; cnt += (c > 0u) ? 1u : 0u; mine = (j == x) ? c : mine; }
    if (sum == G) break;
    __builtin_amdgcn_s_sleep(1);
    if ((++sp & 255u) == 0u) { if (xb_ld(&bar[XB_TMO])) break; if (sp > XB_SPIN_CAP) { atomicAdd(&bar[XB_TMO], 1u); break; } }
  }
  nloc = mine > 0u ? mine : 1u; nx = cnt > 0u ? cnt : 1u;
}
__device__ __forceinline__ void xcd_barrier(const XcdBarrier& b) {
  asm volatile("s_waitcnt vmcnt(0)" ::: "memory");
  __syncthreads();
  if (threadIdx.x == 0) {
    unsigned* bar = b.bar;
    __builtin_amdgcn_s_waitcnt(0);
    unsigned nloc = b.st[0], nx = b.st[1];
    if (nloc == 0u) { xcd_barrier_complete(bar, b.x, nloc, nx); b.st[0] = nloc; b.st[1] = nx; }
    const unsigned old = xb_add(&bar[XB_XSUB(b.x)], 1u);
    const unsigned gen = old / nloc;
    if (old + 1u == (gen + 1u) * nloc) {
      __builtin_amdgcn_fence(__ATOMIC_RELEASE, "agent");
      asm volatile("s_waitcnt vmcnt(0)" ::: "memory");
      const unsigned og = xb_add(&bar[XB_TOP], 1u);
      const unsigned tg = og / nx;
      if (og + 1u == (tg + 1u) * nx) xb_add(&bar[XB_TOPGEN], 1u);
      else XB_SPIN(xb_ld(&bar[XB_TOPGEN]) == tg, bar);
      __builtin_amdgcn_fence(__ATOMIC_ACQUIRE, "agent");
      xb_add(&bar[XB_XGEN(b.x)], 1u);
      asm volatile("s_waitcnt vmcnt(0)" ::: "memory");
    } else {
      XB_SPIN(xb_ld(&bar[XB_XGEN(b.x)]) == gen, bar);
      __builtin_amdgcn_fence(__ATOMIC_ACQUIRE, "agent");
      asm volatile("s_waitcnt vmcnt(0)" ::: "memory");
    }
  }
  __syncthreads();
}

namespace pg8 {
constexpr int BM = 256, BK = 64, HALF = 128, HTB = HALF * BK * 2, STAGE_BYTES = 8 * HTB, NXCD = 8, WGM = 8;
__host__ __device__ __forceinline__ int lds_byte(int r, int c) { const int st = (r >> 4) * 2 + (c >> 5), rr = r & 15, cc = c & 31, ob = rr * 64 + cc * 2; return st * 1024 + (ob ^ (((ob >> 9) & 1) << 5)); }
__host__ __device__ __forceinline__ void stage_rc(int b, int& R, int& C) { const int st = b / 1024, sb = b % 1024, swz = sb ^ (((sb >> 9) & 1) << 5); R = (st >> 1) * 16 + swz / 64; C = (st & 1) * 32 + (swz % 64) / 2; }
struct Unit { int pm, pn; };
struct Gemm { const bf16_t* A; const bf16_t* Bt; int M, N, K; };
struct StaticOrder {
  int nM, nN, nwg, G, c;
  __device__ void init(int M, int N, int G_, int c_) { nM = M / BM; nN = N / BM; nwg = nM * nN; G = G_; c = c_; }
  __device__ bool next(int i, Unit& u) const {
    const long L = (long)i * G + c; if (L >= nwg) return false;
    int wgid = (int)L; { const int q = nwg / NXCD, r = nwg % NXCD, xcd = wgid % NXCD, off = wgid / NXCD; wgid = (xcd < r ? xcd * (q + 1) : r * (q + 1) + (xcd - r) * q) + off; }
    const int nig = WGM * nN, gid = wgid / nig, fm = gid * WGM, gsz = (nM - fm) < WGM ? (nM - fm) : WGM;
    u.pm = fm + ((wgid % nig) % gsz); u.pn = (wgid % nig) / gsz; return true;
  }
};

template <class Epi>
__device__ __forceinline__ void gemm_phase(LP lds, const Gemm g, const StaticOrder& S, const Epi& E) {
  int tid_ = threadIdx.x; asm volatile("" : "+v"(tid_));
  const int tid = tid_, wid = __builtin_amdgcn_readfirstlane(tid >> 6), lane = tid & 63, wr = wid >> 2, wc = wid & 3, fr = lane & 15, fq = lane >> 4;
  const int K = g.K, nt = K / BK;
  unsigned voffA[2], voffB[2];
#pragma unroll
  for (int i = 0; i < 2; ++i) { int R, C; stage_rc(tid * 16 + i * 8192, R, C); voffA[i] = (unsigned)(R * K + C) * 2u; voffB[i] = voffA[i]; }
  const size_t kstep = (size_t)(BK * 2);
  const size_t hstep = (size_t)HALF * K * 2;
  const size_t tstep = 2 * hstep;
  const unsigned ldsw = (unsigned)wid * 1024u;
  const int aoff = lds_byte(wr * 64 + fr, fq * 8), boff = lds_byte(wc * 32 + fr, fq * 8);
#define PG8_SA(b, h) (((b) * 2 + (h)) * HTB)
#define PG8_SB(b, h) ((4 + (b) * 2 + (h)) * HTB)
#define PG8_STAGE(bufoff, gbase, voff) do { _Pragma("unroll") for (int _i = 0; _i < 2; ++_i) \
    __builtin_amdgcn_global_load_lds((const unsigned*)((const char*)(gbase) + (voff)[_i]), (LAS unsigned*)(lds + (bufoff) + ldsw + _i * 8192), 16, 0, 0); } while (0)
#define PG8_LDA(dst, b, h) do { _Pragma("unroll") for (int m = 0; m < 4; ++m) _Pragma("unroll") for (int k = 0; k < 2; ++k) dst[m][k] = *(const LAS bf16x8*)(lds + PG8_SA(b, h) + aoff + m * 2048 + k * 1024); } while (0)
#define PG8_LDB(dst, b, h) do { _Pragma("unroll") for (int n = 0; n < 2; ++n) _Pragma("unroll") for (int k = 0; k < 2; ++k) dst[n][k] = *(const LAS bf16x8*)(lds + PG8_SB(b, h) + boff + n * 2048 + k * 1024); } while (0)
#define PG8_MMA(ai, bj, At, Bt) do { __builtin_amdgcn_s_setprio(1); _Pragma("unroll") for (int m = 0; m < 4; ++m) _Pragma("unroll") for (int n = 0; n < 2; ++n) _Pragma("unroll") for (int k = 0; k < 2; ++k) \
    acc[ai][bj][m][n] = __builtin_amdgcn_mfma_f32_16x16x32_bf16(Bt[n][k], At[m][k], acc[ai][bj][m][n], 0, 0, 0); __builtin_amdgcn_s_setprio(0); } while (0)
#define PG8_WAIT_V(n) asm volatile("s_waitcnt vmcnt(" #n ")" ::: "memory")
#define PG8_WAIT_L(n) asm volatile("s_waitcnt lgkmcnt(" #n ")" ::: "memory")
#define PG8_BAR __builtin_amdgcn_s_barrier()
#define PG8_SCHED __builtin_amdgcn_sched_barrier(0)
  Unit cur, nxt; int ui = 0;
  if (!S.next(0, cur)) return;
  f32x4 acc[2][2][4][2];
#pragma unroll
  for (int a = 0; a < 2; ++a)
#pragma unroll
    for (int b = 0; b < 2; ++b)
#pragma unroll
      for (int m = 0; m < 4; ++m)
#pragma unroll
        for (int n = 0; n < 2; ++n) acc[a][b][m][n] = (f32x4){0.f, 0.f, 0.f, 0.f};
  bf16x8 At[4][2], B0[2][2], B1[2][2];
  const char* cA = (const char*)g.A + (size_t)cur.pm * tstep; const char* cB = (const char*)g.Bt + (size_t)cur.pn * tstep;
  PG8_STAGE(PG8_SB(0, 0), cB, voffB); PG8_STAGE(PG8_SA(0, 0), cA, voffA); PG8_STAGE(PG8_SB(0, 1), cB + hstep, voffB); PG8_STAGE(PG8_SA(0, 1), cA + hstep, voffA);
  if (wr == 1) PG8_BAR;
  PG8_WAIT_V(4); PG8_BAR;
  PG8_STAGE(PG8_SB(1, 0), cB + kstep, voffB); PG8_STAGE(PG8_SA(1, 0), cA + kstep, voffA); PG8_STAGE(PG8_SB(1, 1), cB + hstep + kstep, voffB);
  PG8_WAIT_V(6); PG8_BAR;
  for (;;) {
    const bool has_next = S.next(ui + 1, nxt);
    const char* nA = has_next ? (const char*)g.A + (size_t)nxt.pm * tstep : cA; const char* nB = has_next ? (const char*)g.Bt + (size_t)nxt.pn * tstep : cB;
    for (int t = 0; t < nt; t += 2) {
      const bool last = (t == nt - 2);
      const char* a1 = cA + (size_t)(t + 1) * kstep;
      const char* a2 = last ? nA : cA + (size_t)(t + 2) * kstep; const char* b2 = last ? nB : cB + (size_t)(t + 2) * kstep;
      const char* a3 = a2 + kstep; const char* b3 = b2 + kstep;
      PG8_LDB(B0, 0, 0); PG8_SCHED; PG8_LDA(At, 0, 0); PG8_STAGE(PG8_SA(1, 1), a1 + hstep, voffA);
      PG8_WAIT_L(8); PG8_BAR; PG8_WAIT_L(0); PG8_MMA(0, 0, At, B0); PG8_BAR; PG8_SCHED;
      PG8_LDB(B1, 0, 1); PG8_STAGE(PG8_SB(0, 0), b2, voffB);
      PG8_BAR; PG8_WAIT_L(0); PG8_MMA(0, 1, At, B1); PG8_BAR;
      PG8_LDA(At, 0, 1); PG8_STAGE(PG8_SA(0, 0), a2, voffA);
      PG8_BAR; PG8_WAIT_L(0); PG8_MMA(1, 0, At, B0); PG8_BAR; PG8_SCHED;
      PG8_STAGE(PG8_SB(0, 1), b2 + hstep, voffB);
      PG8_WAIT_V(6); PG8_BAR; PG8_MMA(1, 1, At, B1); PG8_BAR;
      PG8_LDB(B0, 1, 0); PG8_SCHED; PG8_LDA(At, 1, 0); PG8_STAGE(PG8_SA(0, 1), a2 + hstep, voffA);
      PG8_WAIT_L(8); PG8_BAR; PG8_WAIT_L(0); PG8_MMA(0, 0, At, B0); PG8_BAR; PG8_SCHED;
      PG8_LDB(B1, 1, 1); PG8_STAGE(PG8_SB(1, 0), b3, voffB);
      PG8_BAR; PG8_WAIT_L(0); PG8_MMA(0, 1, At, B1); PG8_BAR;
      PG8_LDA(At, 1, 1); PG8_STAGE(PG8_SA(1, 0), a3, voffA);
      PG8_BAR; PG8_WAIT_L(0); PG8_MMA(1, 0, At, B0); PG8_BAR; PG8_SCHED;
      PG8_STAGE(PG8_SB(1, 1), b3 + hstep, voffB);
      PG8_WAIT_V(6); PG8_BAR; PG8_MMA(1, 1, At, B1); PG8_BAR;
    }
    { int fr2 = fr, fq2 = fq; asm volatile("" : "+v"(fr2), "+v"(fq2)); E(acc, cur, wr, wc, fr2, fq2); }
    if (!has_next) break;
#pragma unroll
    for (int a = 0; a < 2; ++a)
#pragma unroll
      for (int b = 0; b < 2; ++b)
#pragma unroll
        for (int m = 0; m < 4; ++m)
#pragma unroll
          for (int n = 0; n < 2; ++n) acc[a][b][m][n] = (f32x4){0.f, 0.f, 0.f, 0.f};
    cur = nxt; cA = nA; cB = nB; ++ui;
  }
  PG8_WAIT_V(0);
  if (wr == 0) PG8_BAR;
  PG8_BAR;
#undef PG8_SA
#undef PG8_SB
#undef PG8_STAGE
#undef PG8_LDA
#undef PG8_LDB
#undef PG8_MMA
#undef PG8_WAIT_V
#undef PG8_WAIT_L
#undef PG8_BAR
#undef PG8_SCHED
}
}
using pg8::Unit;
typedef f32x4 AccT[2][2][4][2];

#define EPI_ROW(ai, m) (u.pm * 256 + (ai) * 128 + wr * 64 + (m) * 16 + fr)
#define EPI_COL(bj, n) (u.pn * 256 + (bj) * 128 + wc * 32 + (n) * 16 + 4 * fq)
#define EPI_LOOP_ROWS _Pragma("unroll") for (int ai = 0; ai < 2; ++ai) _Pragma("unroll") for (int m = 0; m < 4; ++m)
#define EPI_LOOP_COLS _Pragma("unroll") for (int bj = 0; bj < 2; ++bj) _Pragma("unroll") for (int n = 0; n < 2; ++n)

__device__ __forceinline__ int cond_of_row(int row) { return row < NCTX ? 0 : 1 + ((row - NCTX) >> 11); }

struct EpiQKV {
  bf16_t* O; const float* bias;
  __device__ __forceinline__ void operator()(const AccT& acc, const Unit& u, int wr, int wc, int fr, int fq) const {
    const float sc = (u.pn < 4) ? 0.0625f : 1.0f;
    EPI_LOOP_COLS { const int col = EPI_COL(bj, n); const f32x4 bv = *(const f32x4*)(bias + col);
      EPI_LOOP_ROWS { const int row = EPI_ROW(ai, m); const f32x4 v = (acc[ai][bj][m][n] + bv) * sc;
        u32x2 w; w.x = pack2(v[0], v[1]); w.y = pack2(v[2], v[3]); *(u32x2*)(O + (size_t)row * 3072 + col) = w; } }
  }
};
struct EpiUT {
  bf16_t* O; const float* bias;
  __device__ __forceinline__ void operator()(const AccT& acc, const Unit& u, int wr, int wc, int fr, int fq) const {
    EPI_LOOP_ROWS { const int row = EPI_ROW(ai, m); const float bv = bias[row];
      EPI_LOOP_COLS { const int col = EPI_COL(bj, n); const f32x4 v = acc[ai][bj][m][n] + bv;
        u32x2 w; w.x = pack2(v[0], v[1]); w.y = pack2(v[2], v[3]); *(u32x2*)(O + (size_t)row * NTOK + col) = w; } }
  }
};
struct EpiGates {
  bf16_t* H; bf16_t* G; const float* b_in;
  __device__ __forceinline__ void operator()(const AccT& acc, const Unit& u, int wr, int wc, int fr, int fq) const {
    const bool og = u.pn < 4;
    EPI_LOOP_COLS { const int col = EPI_COL(bj, n); const f32x4 bv = *(const f32x4*)(b_in + (og ? 3072 + col : 7184 + (col - 1024)));
      EPI_LOOP_ROWS { const int row = EPI_ROW(ai, m); const f32x4 a = acc[ai][bj][m][n] + bv;
        f32x4 s; s[0] = sigmoidf_(a[0]); s[1] = sigmoidf_(a[1]); s[2] = sigmoidf_(a[2]); s[3] = sigmoidf_(a[3]);
        if (og) { bf16_t* hp = H + (size_t)row * 1024 + col; const u32x2 hv = *(const u32x2*)hp;
          u32x2 w; w.x = pack2(bflo(hv.x) * s[0], bfhi(hv.x) * s[1]); w.y = pack2(bflo(hv.y) * s[2], bfhi(hv.y) * s[3]); *(u32x2*)hp = w; }
        else { u32x2 w; w.x = pack2(s[0], s[1]); w.y = pack2(s[2], s[3]); *(u32x2*)(G + (size_t)row * 2048 + (col - 1024)) = w; } } }
  }
};
template <int SECOND> struct EpiMerge {
  bf16_t* T; const bf16_t* G;
  __device__ __forceinline__ void operator()(const AccT& acc, const Unit& u, int wr, int wc, int fr, int fq) const {
    EPI_LOOP_ROWS { const int row = EPI_ROW(ai, m);
      EPI_LOOP_COLS { const int col = EPI_COL(bj, n); const f32x4 a = acc[ai][bj][m][n];
        const u32x2 gv = *(const u32x2*)(G + (size_t)row * 2048 + SECOND * 1024 + col);
        f32x4 v; v[0] = bflo(gv.x) * a[0]; v[1] = bfhi(gv.x) * a[1]; v[2] = bflo(gv.y) * a[2]; v[3] = bfhi(gv.y) * a[3];
        bf16_t* tp = T + (size_t)row * 1024 + col;
        if (SECOND) { const u32x2 tv = *(const u32x2*)tp; v[0] += bflo(tv.x); v[1] += bfhi(tv.x); v[2] += bflo(tv.y); v[3] += bfhi(tv.y); }
        u32x2 w; w.x = pack2(v[0], v[1]); w.y = pack2(v[2], v[3]); *(u32x2*)tp = w; } }
  }
};
struct EpiOut {
  const float* xp; const float* xs; const float* per; const float* pec; const float* mod; const float* n2w; float* X1; bf16_t* A2; float* ssq;
  __device__ __forceinline__ void operator()(const AccT& acc, const Unit& u, int wr, int wc, int fr, int fq) const {
    const int cb = cond_of_row(u.pm * 256); const float* md = mod + cb * 6144;
    EPI_LOOP_ROWS { const int row = EPI_ROW(ai, m); float ss = 0.f;
      EPI_LOOP_COLS { const int col = EPI_COL(bj, n); const f32x4 a = acc[ai][bj][m][n];
        f32x4 x0;
        if (row < NCTX) x0 = *(const f32x4*)(xp + (size_t)row * 1024 + col);
        else { const int r2 = row - NCTX, t = r2 & 2047; x0 = *(const f32x4*)(xs + (size_t)r2 * 1024 + col);
          const f32x4 pe = (col < 512) ? *(const f32x4*)(per + (t >> 6) * 512 + col) : *(const f32x4*)(pec + (t & 63) * 512 + (col - 512)); x0 += pe; }
        const f32x4 g1 = *(const f32x4*)(md + 2048 + col); const f32x4 sc2 = *(const f32x4*)(md + 4096 + col); const f32x4 nw = *(const f32x4*)(n2w + col);
        const f32x4 x1 = x0 + g1 * a; *(f32x4*)(X1 + (size_t)row * 1024 + col) = x1;
        ss += x1[0] * x1[0] + x1[1] * x1[1] + x1[2] * x1[2] + x1[3] * x1[3];
        const f32x4 av = x1 * nw * (sc2 + 1.0f); u32x2 w; w.x = pack2(av[0], av[1]); w.y = pack2(av[2], av[3]); *(u32x2*)(A2 + (size_t)row * 1024 + col) = w; }
      ss += __shfl_xor(ss, 16); ss += __shfl_xor(ss, 32);
      if (fq == 0) ssq[(size_t)row * 16 + u.pn * 4 + wc] = ss; }
  }
};
struct EpiFF1 {
  int row0; const float* ssq; const float* c1; bf16_t* Hd;
  __device__ __forceinline__ void operator()(const AccT& acc, const Unit& u, int wr, int wc, int fr, int fq) const {
    const int cb = cond_of_row(row0 + u.pm * 256); const float* cc = c1 + cb * 4096;
    EPI_LOOP_ROWS { const int rl = EPI_ROW(ai, m); const float* sp = ssq + (size_t)(row0 + rl) * 16;
      const f32x4 s0 = *(const f32x4*)sp, s1 = *(const f32x4*)(sp + 4), s2 = *(const f32x4*)(sp + 8), s3 = *(const f32x4*)(sp + 12);
      const f32x4 st = s0 + s1 + s2 + s3; const float rstd = rsqrtf((st[0] + st[1] + st[2] + st[3]) * (1.0f / 1024.0f) + 1e-6f);
      EPI_LOOP_COLS { const int col = EPI_COL(bj, n); const f32x4 cv = *(const f32x4*)(cc + col); f32x4 v = acc[ai][bj][m][n] * rstd + cv;
#pragma unroll
        for (int e = 0; e < 4; ++e) { const float r = fmaxf(v[e], 0.f); v[e] = r * r; }
        u32x2 w; w.x = pack2(v[0], v[1]); w.y = pack2(v[2], v[3]); *(u32x2*)(Hd + (size_t)rl * 4096 + col) = w; } }
  }
};
struct EpiFF2 {
  int row0; const float* mod; const float* b2; float* X; float* ssq;
  __device__ __forceinline__ void operator()(const AccT& acc, const Unit& u, int wr, int wc, int fr, int fq) const {
    const int cb = cond_of_row(row0 + u.pm * 256); const float* md = mod + cb * 6144;
    EPI_LOOP_ROWS { const int row = row0 + EPI_ROW(ai, m); float ss = 0.f;
      EPI_LOOP_COLS { const int col = EPI_COL(bj, n); const f32x4 g2 = *(const f32x4*)(md + 5120 + col); const f32x4 bb = *(const f32x4*)(b2 + col);
        float* xp = X + (size_t)row * 1024 + col; const f32x4 x2 = *(const f32x4*)xp + g2 * (acc[ai][bj][m][n] + bb); *(f32x4*)xp = x2;
        ss += x2[0] * x2[0] + x2[1] * x2[1] + x2[2] * x2[2] + x2[3] * x2[3]; }
      ss += __shfl_xor(ss, 16); ss += __shfl_xor(ss, 32);
      if (fq == 0) ssq[(size_t)row * 16 + u.pn * 4 + wc] = ss; }
  }
};

template <class Epi> __device__ __forceinline__ void run_gemm(LP lds, const bf16_t* A, const bf16_t* Bt, int M, int N, int K, const Epi& E) {
  pg8::Gemm g; g.A = A; g.Bt = Bt; g.M = M; g.N = N; g.K = K;
  pg8::StaticOrder S; S.init(M, N, (int)gridDim.x, (int)blockIdx.x);
  pg8::gemm_phase<Epi>(lds, g, S, E);
}

struct WTile { const float* src; bf16_t* dst; int ld, K, col0, k0, drow0; };
__device__ __forceinline__ WTile wtile_of(const Params& p, int tu) {
  WTile w; unsigned char* ws = p.ws;
  if (tu < 1152) { const int nt = tu >> 4, kt = tu & 15; const int r = nt * 128; w.src = p.in[10]; w.ld = INC; w.K = 1024; w.k0 = kt * 64; w.drow0 = r; w.dst = (bf16_t*)(ws + OFF_WT);
    w.col0 = r < 3072 ? r : (r < 6144 ? 4112 + (r - 3072) : (r < 7168 ? 3072 + (r - 6144) : 7184 + (r - 7168))); }
  else if (tu < 1536) { const int v = tu - 1152, wq = v >> 7, q = v & 127; w.src = (wq == 0 ? p.in[23] : (wq == 1 ? p.in[24] : p.in[25])); w.ld = 1024; w.K = 1024; w.k0 = (q & 15) * 64; w.col0 = (q >> 4) * 128; w.drow0 = w.col0; w.dst = (bf16_t*)(ws + (wq == 0 ? OFF_WBM : (wq == 1 ? OFF_WBH : OFF_WOUT))); }
  else if (tu < 2048) { const int q = tu - 1536; w.src = p.in[27]; w.ld = 4096; w.K = 1024; w.k0 = (q & 15) * 64; w.col0 = (q >> 4) * 128; w.drow0 = w.col0; w.dst = (bf16_t*)(ws + OFF_W1T); }
  else { const int q = tu - 2048; w.src = p.in[29]; w.ld = 1024; w.K = 4096; w.k0 = (q & 63) * 64; w.col0 = (q >> 6) * 128; w.drow0 = w.col0; w.dst = (bf16_t*)(ws + OFF_W2T); }
  return w;
}
__device__ __forceinline__ void weight_tiles(const Params& p, LP lds) {
  LAS float* tile = (LAS float*)lds; const int t = opaque_tid();
  int tu = blockIdx.x; if (tu >= 2560) return;
  f32x4 v[4];
  { const WTile w = wtile_of(p, tu);
#pragma unroll
    for (int i = 0; i < 4; ++i) { const int idx = t + 512 * i, kr = idx >> 5, c4 = idx & 31; v[i] = *(const f32x4*)(w.src + (size_t)(w.k0 + kr) * w.ld + w.col0 + 4 * c4); } }
  for (; tu < 2560; tu += gridDim.x) {
    const WTile w = wtile_of(p, tu);
#pragma unroll
    for (int i = 0; i < 4; ++i) { const int idx = t + 512 * i, kr = idx >> 5, c4 = idx & 31; LAS float* tp = tile + kr * 129 + 4 * c4; tp[0] = v[i][0]; tp[1] = v[i][1]; tp[2] = v[i][2]; tp[3] = v[i][3]; }
    const int tn = tu + gridDim.x;
    if (tn < 2560) { const WTile wn = wtile_of(p, tn);
#pragma unroll
      for (int i = 0; i < 4; ++i) { const int idx = t + 512 * i, kr = idx >> 5, c4 = idx & 31; v[i] = *(const f32x4*)(wn.src + (size_t)(wn.k0 + kr) * wn.ld + wn.col0 + 4 * c4); } }
    __syncthreads();
    const int kb = t & 7;
#pragma unroll
    for (int i = 0; i < 2; ++i) { const int c = (t >> 3) + 64 * i; const LAS float* tp = tile + (kb * 8) * 129 + c; u32x4 o;
      o.x = pack2(tp[0], tp[129]); o.y = pack2(tp[2 * 129], tp[3 * 129]); o.z = pack2(tp[4 * 129], tp[5 * 129]); o.w = pack2(tp[6 * 129], tp[7 * 129]);
      *(u32x4*)(w.dst + (size_t)(w.drow0 + c) * w.K + w.k0 + kb * 8) = o; }
    __syncthreads();
  }
}
template <int SILU> __device__ __forceinline__ void matvec9_unit(const float* v0, const float* v1, int v1stride, const float* __restrict__ W, int ldw, const float* bias, float* out, int ldo, int col0, LAS float* lf) {
  const int t = opaque_tid(), lane = t & 63, wid = t >> 6;
  LAS float* sv = lf; LAS float* red = lf + 9216;
  for (int i = t; i < 9216; i += 512) { const int b = i >> 10, k = i & 1023; float x = (b == 0) ? v0[k] : v1[(size_t)(b - 1) * v1stride + k]; if (SILU) x = x / (1.0f + __expf(-x)); sv[i] = x; }
  __syncthreads();
  const int c4 = t & 7, kl = t >> 3;
  f32x4 w[16];
#pragma unroll
  for (int i = 0; i < 16; ++i) w[i] = *(const f32x4*)(W + (size_t)(kl + 64 * i) * ldw + col0 + 4 * c4);
  f32x4 acc[9];
#pragma unroll
  for (int b = 0; b < 9; ++b) acc[b] = (f32x4){0.f, 0.f, 0.f, 0.f};
#pragma unroll
  for (int i = 0; i < 16; ++i)
#pragma unroll
    for (int b = 0; b < 9; ++b) acc[b] += w[i] * sv[b * 1024 + kl + 64 * i];
#pragma unroll
  for (int b = 0; b < 9; ++b)
#pragma unroll
    for (int e = 0; e < 4; ++e) { float x = acc[b][e]; x += __shfl_xor(x, 8); x += __shfl_xor(x, 16); x += __shfl_xor(x, 32); acc[b][e] = x; }
  if (lane < 8) {
#pragma unroll
    for (int b = 0; b < 9; ++b) *(LAS f32x4*)(red + (wid * 9 + b) * 32 + 4 * lane) = acc[b]; }
  __syncthreads();
  if (t < 288) { const int b = t >> 5, cc = t & 31; float s = bias[col0 + cc];
#pragma unroll
    for (int pz = 0; pz < 8; ++pz) s += red[(pz * 9 + b) * 32 + cc];
    out[(size_t)b * ldo + col0 + cc] = s; }
  __syncthreads();
}

__device__ __forceinline__ void phase0(const Params& p, LP lds) {
  unsigned char* ws = p.ws; LAS float* lf = (LAS float*)lds;
  const int tid0 = opaque_tid(); const int wid = tid0 >> 6, lane = tid0 & 63;
  for (int unit = blockIdx.x; unit < 576; unit += gridDim.x) {
    if (unit < 192) {
      matvec9_unit<1>(p.in[6], p.in[5], 1024, p.in[7], 6144, p.in[8], (float*)(ws + OFF_MOD), 6144, unit * 32, lf);
    } else if (unit < 480) {
      const int row = (unit - 192) * 8 + wid; const bool smp = row < 2048; const int L = smp ? 2048 : 256, t = smp ? row : row - 2048;
      const float* w1 = p.in[14]; const float* b1 = p.in[15]; const float* fr1 = p.in[16]; const float* w2 = p.in[17]; const float* b2 = p.in[18]; const float* fr2 = p.in[19];
      float a = b1[lane] + (float)t / (float)(L - 1) * w1[lane];
      const float base = (6.283185307179586f / (float)L) * (float)t;
      float cs = 0.f, sn = 0.f; if (lane < 16) { const float ang = base * (float)(lane + 1); cs = cosf(ang); sn = sinf(ang); }
#pragma unroll
      for (int i = 0; i < 16; ++i) a += __shfl(cs, i) * w1[(1 + i) * 64 + lane] + __shfl(sn, i) * w1[(17 + i) * 64 + lane];
      const float h1 = sinf(fr1[lane] * a);
      float a2 = b2[lane];
#pragma unroll 16
      for (int j = 0; j < 64; ++j) a2 += __shfl(h1, j) * w2[j * 64 + lane];
      const float h2 = sinf(fr2[lane] * a2);
      float* dst = (float*)(ws + (smp ? OFF_H2S : OFF_H2C)); dst[(size_t)t * 64 + lane] = h2;
    } else {
      const int r = unit - 480, c = tid0; const int pos = r < 32 ? r : r - 32; const int i = c & 255;
      const float omega = 1.0f / powf(10000.0f, (float)i / 256.0f); const float a = (float)pos * omega; const float v = c < 256 ? sinf(a) : cosf(a);
      float* dst = (float*)(ws + (r < 32 ? OFF_PER : OFF_PEC)); dst[(size_t)pos * 512 + c] = v;
    }
  }
}
__device__ __forceinline__ void phase1(const Params& p, LP lds) {
  unsigned char* ws = p.ws;
  int tid_ = threadIdx.x; asm volatile("" : "+v"(tid_));
  const int tid = tid_, wid = tid >> 6, lane = tid & 63;
  const float* mod = (const float*)(ws + OFF_MOD);
  LAS float* wg = (LAS float*)lds;
  if ((int)blockIdx.x < 1536) {
    f32x4 gw[8];
#pragma unroll
    for (int i = 0; i < 8; ++i) { const int idx = tid + 512 * i, k = idx >> 2, q = idx & 3; gw[i] = *(const f32x4*)(p.in[10] + (size_t)k * INC + 4096 + 4 * q); }
#pragma unroll
    for (int i = 0; i < 8; ++i) { const int idx = tid + 512 * i, k = idx >> 2, q = idx & 3; wg[(4 * q) * 1024 + k] = gw[i][0]; wg[(4 * q + 1) * 1024 + k] = gw[i][1]; wg[(4 * q + 2) * 1024 + k] = gw[i][2]; wg[(4 * q + 3) * 1024 + k] = gw[i][3]; }
    __syncthreads();
  }
  for (int unit = blockIdx.x; unit < 1536; unit += gridDim.x) {
    const int tidn = opaque_tid(); const int wid = tidn >> 6, lane = tidn & 63;
    const int row0 = unit * 16 + wid * 2; const int cb = cond_of_row(row0); const float* md = mod + cb * 6144; const bool smp = row0 >= NCTX;
    f32x4 v[2][4]; float rstd[2];
#pragma unroll
    for (int r = 0; r < 2; ++r) { const int row = row0 + r; const float* xr; int t = 0;
      if (!smp) xr = p.in[0] + (size_t)row * 1024; else { xr = p.in[1] + (size_t)(row - NCTX) * 1024; t = (row - NCTX) & 2047; }
      const float* per = (const float*)(ws + OFF_PER) + (t >> 6) * 512; const float* pec = (const float*)(ws + OFF_PEC) + (t & 63) * 512;
      float ss = 0.f;
#pragma unroll
      for (int i = 0; i < 4; ++i) { const int col = 4 * lane + 256 * i; v[r][i] = *(const f32x4*)(xr + col);
        if (smp) v[r][i] += (col < 512) ? *(const f32x4*)(per + col) : *(const f32x4*)(pec + col - 512);
        ss += v[r][i][0] * v[r][i][0] + v[r][i][1] * v[r][i][1] + v[r][i][2] * v[r][i][2] + v[r][i][3] * v[r][i][3]; }
      ss = wave_sum(ss); rstd[r] = rsqrtf(ss * (1.0f / 1024.0f) + 1e-6f); }
    const float* n1w = p.in[9];
    float ga[32];
#pragma unroll
    for (int g = 0; g < 32; ++g) ga[g] = 0.f;
#pragma unroll
    for (int i = 0; i < 4; ++i) { const int col = 4 * lane + 256 * i;
      const f32x4 w = *(const f32x4*)(n1w + col), sc = *(const f32x4*)(md + 1024 + col), sh = *(const f32x4*)(md + col);
      const f32x4 ws1 = w * (sc + 1.0f);
      f32x4 h[2];
#pragma unroll
      for (int r = 0; r < 2; ++r) { h[r] = v[r][i] * rstd[r] * ws1 + sh;
        u32x2 o; o.x = pack2(h[r][0], h[r][1]); o.y = pack2(h[r][2], h[r][3]); *(u32x2*)((bf16_t*)(ws + OFF_HN) + (size_t)(row0 + r) * 1024 + col) = o; }
#pragma unroll
      for (int g = 0; g < 16; ++g) { const f32x4 wv = *(const LAS f32x4*)(wg + g * 1024 + col);
#pragma unroll
        for (int r = 0; r < 2; ++r) ga[r * 16 + g] += h[r][0] * wv[0] + h[r][1] * wv[1] + h[r][2] * wv[2] + h[r][3] * wv[3]; }
      asm volatile("" ::: "memory"); }
#pragma unroll
    for (int off = 16; off >= 1; off >>= 1) { const bool hi = (lane & off) != 0;
#pragma unroll
      for (int i = 0; i < off; ++i) { const float send = hi ? ga[i] : ga[i + off]; const float keep = hi ? ga[i + off] : ga[i]; ga[i] = keep + __shfl_xor(send, off); } }
    const float tot = ga[0] + __shfl_xor(ga[0], 32);
    if (lane < 32) ((float*)(ws + OFF_GT))[(size_t)row0 * 16 + lane] = tot + p.in[11][4096 + (lane & 15)];
  }
  __syncthreads();
  LAS float* w3s = (LAS float*)lds;
  for (int v = blockIdx.x; v < 320; v += gridDim.x) {
    const int tid = opaque_tid();
    const bool smp = v < 256; const int L = smp ? 2048 : 256; const int tt = smp ? (v >> 6) : 0, cgp = v & 63; const int t = tt * 512 + tid;
    { const f32x4 x = *(const f32x4*)(p.in[20] + (size_t)(tid >> 3) * 2048 + cgp * 32 + 4 * (tid & 7)); LAS float* wp = w3s + (4 * (tid & 7)) * 64 + (tid >> 3);
      wp[0] = x[0]; wp[64] = x[1]; wp[128] = x[2]; wp[192] = x[3]; }
    __syncthreads();
    if (t < L) {
      const float* H2 = (const float*)(ws + (smp ? OFF_H2S : OFF_H2C)) + (size_t)t * 64;
      f32x4 h2[16];
#pragma unroll
      for (int i = 0; i < 16; ++i) h2[i] = *(const f32x4*)(H2 + 4 * i);
      const float dist = fabsf((float)t - (float)(L / 2)) / (float)(L / 2);
      float* HF = (float*)(ws + (smp ? OFF_HFS : OFF_HFC)) + (size_t)(cgp * 32) * L + t;
#pragma unroll 1
      for (int j = 0; j < 32; ++j) {
        f32x4 a = {0.f, 0.f, 0.f, 0.f};
#pragma unroll
        for (int i = 0; i < 16; ++i) a += *(const LAS f32x4*)(w3s + j * 64 + 4 * i) * h2[i];
        const int c = (cgp * 32 + j) & 1023;
        const float dmin = -3.0701134573253946f, dmax = -15.350567286626973f;
        const float delta = fabsf(dmin + (dmax - dmin) * ((float)c / 1023.0f));
        HF[(size_t)j * L] = ((a[0] + a[1]) + (a[2] + a[3])) * __expf(-dist * delta); }
    }
    __syncthreads();
  }
  for (int u = (int)gridDim.x - 1 - (int)blockIdx.x; u < 128; u += gridDim.x)
    matvec9_unit<0>(mod + 3072, mod + 6144 + 3072, 6144, p.in[27], 4096, p.in[28], (float*)(ws + OFF_C1), 4096, u * 32, (LAS float*)lds);
}

__device__ __forceinline__ bf16x8 tr_frag(LP base, int k0, int m0, int pitch  , int l15, int g) {
  const int q = l15 >> 2, pp = l15 & 3;
  LP a = base + ((k0 + 8 * g + q) * pitch + m0 + 4 * pp) * 2;
  const s16x4 lo = __builtin_amdgcn_ds_read_tr16_b64_v4i16((LAS s16x4*)a);
  const s16x4 hi = __builtin_amdgcn_ds_read_tr16_b64_v4i16((LAS s16x4*)(a + 8 * pitch));
  bf16x8 r; r[0] = lo[0]; r[1] = lo[1]; r[2] = lo[2]; r[3] = lo[3]; r[4] = hi[0]; r[5] = hi[1]; r[6] = hi[2]; r[7] = hi[3]; return r;
}
__device__ __forceinline__ bf16x8 tr_at(LP lanebase, int coff  , int pitch_bytes) {
  const s16x4 lo = __builtin_amdgcn_ds_read_tr16_b64_v4i16((LAS s16x4*)(lanebase + coff));
  const s16x4 hi = __builtin_amdgcn_ds_read_tr16_b64_v4i16((LAS s16x4*)(lanebase + coff + 4 * pitch_bytes));
  bf16x8 r; r[0] = lo[0]; r[1] = lo[1]; r[2] = lo[2]; r[3] = lo[3]; r[4] = hi[0]; r[5] = hi[1]; r[6] = hi[2]; r[7] = hi[3]; return r;
}
constexpr int ML_K = 0, ML_V = 67584, ML_P = 86016, ML_C = 120832, ML_T = 157696, ML_TSZ = 1600;
constexpr int KP = 264, VP = 72, PP = 136, CP = 72;

__device__ __forceinline__ void mlstm_item(const Params& p, LP lds, int item) {
  const int tid = opaque_tid(), wid = __builtin_amdgcn_readfirstlane(tid >> 6), lane = tid & 63, l15 = lane & 15, g = lane >> 4;
  const bool smp = item < 256; const int uu = smp ? (item >> 2) : ((item - 256) >> 2); const int sl = item & 3;
  const int b = uu >> 3, dir = (uu >> 2) & 1, head = uu & 3;
  const int S = smp ? SEQS : SEQC, nc = S >> 7; const int tok0 = smp ? NCTX + b * SEQS : b * SEQC;
  const bf16_t* qkv = (const bf16_t*)(p.ws + OFF_BIG);
  const float* GT = (const float*)(p.ws + OFF_GT);
  bf16_t* hout = (bf16_t*)((unsigned char*)p.out + (dir ? OUT_HB : OUT_H));
  const int sidx = (b * 2 + dir) * 4 + head;
  const int gi_col = dir * 8 + head, gf_col = dir * 8 + 4 + head;
  f32x4 Cacc[2][4], nacc[2]; float mst0;
  if (smp) {
    const float* C0 = p.in[2] + (size_t)sidx * 65536;
#pragma unroll
    for (int dt = 0; dt < 2; ++dt) {
#pragma unroll
      for (int vt = 0; vt < 4; ++vt) Cacc[dt][vt] = *(const f32x4*)(C0 + (size_t)((2 * wid + dt) * 16 + l15) * 256 + sl * 64 + 16 * vt + 4 * g);
      nacc[dt] = (f32x4){p.in[3][sidx * 256 + (2 * wid + dt) * 16 + l15], 0.f, 0.f, 0.f}; }
    mst0 = p.in[4][sidx];
  } else {
#pragma unroll
    for (int dt = 0; dt < 2; ++dt) {
#pragma unroll
      for (int vt = 0; vt < 4; ++vt) Cacc[dt][vt] = (f32x4){0.f, 0.f, 0.f, 0.f};
      nacc[dt] = (f32x4){0.f, 0.f, 0.f, 0.f}; }
    mst0 = 0.f;
  }
#define TOKC(cc, j) (dir ? (tok0 + S - 1 - ((cc) * 128 + (j))) : (tok0 + (cc) * 128 + (j)))
  const int rt = (wid < 4) ? wid : 11 - wid;
  const int jrow = 16 * rt + l15;
  bf16x8 qf[8]; u32x4 kreg[8], vreg[2]; float g4[4] = {0.f, 0.f, 0.f, 0.f};
#define ML_LOAD_Q(cc) do { const bf16_t* qp = qkv + (size_t)TOKC(cc, jrow) * 3072 + head * 256 + 8 * g; \
    _Pragma("unroll") for (int kk = 0; kk < 8; ++kk) qf[kk] = *(const bf16x8*)(qp + 32 * kk); } while (0)
#define ML_LOAD_KV(cc) do { \
    _Pragma("unroll") for (int i = 0; i < 8; ++i) { const int row = (tid >> 5) + 16 * i; kreg[i] = *(const u32x4*)(qkv + (size_t)TOKC(cc, row) * 3072 + 1024 + head * 256 + (tid & 31) * 8); } \
    _Pragma("unroll") for (int i = 0; i < 2; ++i) { const int row = (tid >> 3) + 64 * i; vreg[i] = *(const u32x4*)(qkv + (size_t)TOKC(cc, row) * 3072 + 2048 + head * 256 + sl * 64 + (tid & 7) * 8); } \
    if (wid == 0) { const float* g0 = GT + (size_t)TOKC(cc, 2 * lane) * 16; const float* g1 = GT + (size_t)TOKC(cc, 2 * lane + 1) * 16; g4[0] = g0[gi_col]; g4[1] = g0[gf_col]; g4[2] = g1[gi_col]; g4[3] = g1[gf_col]; } } while (0)
#define ML_SCAN(tabp, mcur, mnext) do { LAS float* T_ = (LAS float*)(tabp); \
    const float lf0 = fminf(g4[1], 0.f) - log1pf(__expf(-fabsf(g4[1]))), lf1 = fminf(g4[3], 0.f) - log1pf(__expf(-fabsf(g4[3]))); \
    float s_ = lf0 + lf1; \
    _Pragma("unroll") for (int o = 1; o < 64; o <<= 1) { const float t_ = __shfl_up(s_, o); if (lane >= o) s_ += t_; } \
    const float b1_ = s_, b0_ = s_ - lf1; const float u0_ = g4[0] - b0_, u1_ = g4[2] - b1_; \
    float mx_ = fmaxf(u0_, u1_); \
    _Pragma("unroll") for (int o = 1; o < 64; o <<= 1) { const float t_ = __shfl_up(mx_, o); if (lane >= o) mx_ = fmaxf(mx_, t_); } \
    float ex_ = __shfl_up(mx_, 1); if (lane == 0) ex_ = -INFINITY; \
    const float M0_ = fmaxf(mcur, fmaxf(ex_, u0_)), M1_ = fmaxf(mcur, mx_); \
    T_[2 * lane] = u0_; T_[2 * lane + 1] = u1_; T_[128 + 2 * lane] = M0_; T_[128 + 2 * lane + 1] = M1_; T_[256 + 2 * lane] = b0_; T_[256 + 2 * lane + 1] = b1_; \
    const float Ml_ = __shfl(M1_, 63), bl_ = __shfl(b1_, 63); \
    if (lane == 0) { T_[384] = mcur; T_[385] = Ml_; } \
    mnext = bl_ + Ml_; } while (0)
  float mw0 = mst0;
  ML_LOAD_Q(0); ML_LOAD_KV(0);
  if (wid == 0) { float mn; ML_SCAN(lds + ML_T, mw0, mn); mw0 = mn; }
  __syncthreads();
  float m_final = 0.f;
  for (int c = 0; c < nc; ++c) {
    LAS float* T = (LAS float*)(lds + ML_T + (c & 1) * ML_TSZ);
    const float mst = T[384], M_last = T[385];
#pragma unroll
    for (int i = 0; i < 8; ++i) { const int row = (tid >> 5) + 16 * i; *(LAS u32x4*)(lds + ML_K + (row * KP + (tid & 31) * 8) * 2) = kreg[i]; }
#pragma unroll
    for (int i = 0; i < 2; ++i) { const int row = (tid >> 3) + 64 * i; const float w = __expf(T[row] - M_last); const u32x4 v = vreg[i]; u32x4 o;
      o.x = pack2(bflo(v.x) * w, bfhi(v.x) * w); o.y = pack2(bflo(v.y) * w, bfhi(v.y) * w); o.z = pack2(bflo(v.z) * w, bfhi(v.z) * w); o.w = pack2(bflo(v.w) * w, bfhi(v.w) * w);
      *(LAS u32x4*)(lds + ML_V + (row * VP + (tid & 7) * 8) * 2) = o; }
    if (tid < 128) *(LAS unsigned short*)(lds + ML_V + (tid * VP + 64) * 2) = f2bf(__expf(T[tid] - M_last));
#pragma unroll
    for (int dt = 0; dt < 2; ++dt) {
#pragma unroll
      for (int vt = 0; vt < 4; ++vt) { u32x2 w; w.x = pack2(Cacc[dt][vt][0], Cacc[dt][vt][1]); w.y = pack2(Cacc[dt][vt][2], Cacc[dt][vt][3]);
        *(LAS u32x2*)(lds + ML_C + (((2 * wid + dt) * 16 + l15) * CP + 16 * vt + 4 * g) * 2) = w; }
      if (g == 0) *(LAS unsigned short*)(lds + ML_C + (((2 * wid + dt) * 16 + l15) * CP + 64) * 2) = f2bf(nacc[dt][0]); }
    const int qtok = TOKC(c, jrow);
    const bool more = (c + 1 < nc);
    __syncthreads();
    const float Mj = T[128 + jrow], bj = T[256 + jrow]; const float rf = __expf(M_last - Mj), w_inter = __expf(mst - Mj);
    int lq_ = (8 * g + (l15 >> 2)), lp_ = 4 * (l15 & 3); asm volatile("" : "+v"(lq_), "+v"(lp_));
    const LP cB = lds + ML_C + (lq_ * CP + lp_) * 2, vB = lds + ML_V + (lq_ * VP + lp_) * 2, kB = lds + ML_K + (lq_ * KP + lp_ + 32 * wid) * 2;
    const LP pB = lds + ML_P + (jrow * PP + 8 * g) * 2;
    for (int st = 0; st <= rt; ++st) {
      f32x4 s = {0.f, 0.f, 0.f, 0.f};
#pragma unroll
      for (int kk = 0; kk < 8; ++kk) { const bf16x8 kf = *(const LAS bf16x8*)(lds + ML_K + ((16 * st + l15) * KP + 32 * kk + 8 * g) * 2); s = __builtin_amdgcn_mfma_f32_16x16x32_bf16(kf, qf[kk], s, 0, 0, 0); }
      float pv[4];
#pragma unroll
      for (int i = 0; i < 4; ++i) pv[i] = ((16 * st + 4 * g + i) <= jrow) ? s[i] * rf : 0.f;
      u32x2 w; w.x = pack2(pv[0], pv[1]); w.y = pack2(pv[2], pv[3]);
      *(LAS u32x2*)(lds + ML_P + (jrow * PP + 16 * st + 4 * g) * 2) = w;
    }
    if ((rt & 1) == 0) { u32x2 z; z.x = 0u; z.y = 0u; *(LAS u32x2*)(lds + ML_P + (jrow * PP + 16 * (rt + 1) + 4 * g) * 2) = z; }
    if (more) ML_LOAD_KV(c + 1);
    asm volatile("s_waitcnt lgkmcnt(0)" ::: "memory");
    float rdd;
    { f32x4 a = {0.f, 0.f, 0.f, 0.f};
#pragma unroll
      for (int kk = 0; kk < 8; ++kk) { const bf16x8 cf = tr_at(cB, (32 * kk * CP + 64) * 2, CP * 2); a = __builtin_amdgcn_mfma_f32_16x16x32_bf16(cf, qf[kk], a, 0, 0, 0); }
      a *= w_inter;
      for (int k2 = 0; k2 <= (rt >> 1); ++k2) { const bf16x8 pf = *(const LAS bf16x8*)(pB + k2 * 64);
        const bf16x8 vf = tr_at(vB + k2 * (32 * VP * 2), 64 * 2, VP * 2); a = __builtin_amdgcn_mfma_f32_16x16x32_bf16(vf, pf, a, 0, 0, 0); }
      const float den = __shfl(a[0], l15); rdd = 1.0f / fmaxf(fabsf(den), __expf(-(bj + Mj))); }
#pragma unroll
    for (int vt = 0; vt < 4; ++vt) { f32x4 a = {0.f, 0.f, 0.f, 0.f};
#pragma unroll
      for (int kk = 0; kk < 8; ++kk) { const bf16x8 cf = tr_at(cB, (32 * kk * CP + 16 * vt) * 2, CP * 2); a = __builtin_amdgcn_mfma_f32_16x16x32_bf16(cf, qf[kk], a, 0, 0, 0); }
      a *= w_inter;
      for (int k2 = 0; k2 <= (rt >> 1); ++k2) { const bf16x8 pf = *(const LAS bf16x8*)(pB + k2 * 64);
        const bf16x8 vf = tr_at(vB + k2 * (32 * VP * 2), (16 * vt) * 2, VP * 2); a = __builtin_amdgcn_mfma_f32_16x16x32_bf16(vf, pf, a, 0, 0, 0); }
      a *= rdd; u32x2 w; w.x = pack2(a[0], a[1]); w.y = pack2(a[2], a[3]);
      *(u32x2*)(hout + (size_t)qtok * 1024 + head * 256 + sl * 64 + 16 * vt + 4 * g) = w; }
    if (more) ML_LOAD_Q(c + 1);
    const bool need_state = (!smp) || more;
    if (need_state) {
      const float decay = __expf(mst - M_last);
#pragma unroll
      for (int dt = 0; dt < 2; ++dt) {
#pragma unroll
        for (int vt = 0; vt < 4; ++vt) Cacc[dt][vt] *= decay;
        nacc[dt] *= decay; }
#pragma unroll
      for (int ks = 0; ks < 4; ++ks) {
        const bf16x8 kf0 = tr_at(kB, (32 * ks * KP) * 2, KP * 2), kf1 = tr_at(kB, (32 * ks * KP + 16) * 2, KP * 2);
#pragma unroll
        for (int vt = 0; vt < 4; ++vt) { const bf16x8 vf = tr_at(vB, (32 * ks * VP + 16 * vt) * 2, VP * 2);
          Cacc[0][vt] = __builtin_amdgcn_mfma_f32_16x16x32_bf16(vf, kf0, Cacc[0][vt], 0, 0, 0); Cacc[1][vt] = __builtin_amdgcn_mfma_f32_16x16x32_bf16(vf, kf1, Cacc[1][vt], 0, 0, 0); }
        { const bf16x8 vf = tr_at(vB, (32 * ks * VP + 64) * 2, VP * 2);
          nacc[0] = __builtin_amdgcn_mfma_f32_16x16x32_bf16(vf, kf0, nacc[0], 0, 0, 0); nacc[1] = __builtin_amdgcn_mfma_f32_16x16x32_bf16(vf, kf1, nacc[1], 0, 0, 0); }
      }
    }
    if (wid == 0 && more) { float mn; ML_SCAN(lds + ML_T + ((c + 1) & 1) * ML_TSZ, mw0, mn); mw0 = mn; }
    m_final = T[256 + 127] + M_last;
    __syncthreads();
  }
#undef ML_LOAD_Q
#undef ML_LOAD_KV
#undef ML_SCAN
#undef TOKC
  if (!smp) {
    float* oC = p.out + OUTF_C + (size_t)sidx * 65536;
#pragma unroll
    for (int dt = 0; dt < 2; ++dt) {
#pragma unroll
      for (int vt = 0; vt < 4; ++vt) *(f32x4*)(oC + (size_t)((2 * wid + dt) * 16 + l15) * 256 + sl * 64 + 16 * vt + 4 * g) = Cacc[dt][vt];
      if (sl == 0 && g == 0) p.out[OUTF_N + (size_t)sidx * 256 + (2 * wid + dt) * 16 + l15] = nacc[dt][0]; }
    if (sl == 0 && tid == 0) p.out[OUTF_M + sidx] = m_final;
  }
}

__device__ __forceinline__ void combine_rows(const Params& p) {
  const int tid0 = opaque_tid(); const int wid = tid0 >> 6, lane = tid0 & 63;
  bf16_t* H = (bf16_t*)((unsigned char*)p.out + OUT_H); const bf16_t* HB = (const bf16_t*)((unsigned char*)p.out + OUT_HB); const float* nw = p.in[22];
  for (int unit = blockIdx.x; unit < 3072; unit += gridDim.x) {
    const int row = unit * 8 + wid; bf16_t* hp = H + (size_t)row * 1024 + 16 * lane; const bf16_t* bp = HB + (size_t)row * 1024 + 16 * lane;
    float v[16]; float ss = 0.f;
#pragma unroll
    for (int i = 0; i < 2; ++i) { const u32x4 a = *(const u32x4*)(hp + 8 * i), bq = *(const u32x4*)(bp + 8 * i);
      v[8 * i + 0] = bflo(a.x) + bflo(bq.x); v[8 * i + 1] = bfhi(a.x) + bfhi(bq.x); v[8 * i + 2] = bflo(a.y) + bflo(bq.y); v[8 * i + 3] = bfhi(a.y) + bfhi(bq.y);
      v[8 * i + 4] = bflo(a.z) + bflo(bq.z); v[8 * i + 5] = bfhi(a.z) + bfhi(bq.z); v[8 * i + 6] = bflo(a.w) + bflo(bq.w); v[8 * i + 7] = bfhi(a.w) + bfhi(bq.w); }
#pragma unroll
    for (int e = 0; e < 16; ++e) ss += v[e] * v[e];
    ss += __shfl_xor(ss, 1); ss += __shfl_xor(ss, 2); ss += __shfl_xor(ss, 4); ss += __shfl_xor(ss, 8);
    const float r = rsqrtf(ss * (1.0f / 256.0f) + 1e-6f);
#pragma unroll
    for (int i = 0; i < 2; ++i) { const f32x4 w0 = *(const f32x4*)(nw + 16 * lane + 8 * i), w1 = *(const f32x4*)(nw + 16 * lane + 8 * i + 4); u32x4 o;
      o.x = pack2(v[8 * i] * r * w0[0], v[8 * i + 1] * r * w0[1]); o.y = pack2(v[8 * i + 2] * r * w0[2], v[8 * i + 3] * r * w0[3]);
      o.z = pack2(v[8 * i + 4] * r * w1[0], v[8 * i + 5] * r * w1[1]); o.w = pack2(v[8 * i + 6] * r * w1[2], v[8 * i + 7] * r * w1[3]);
      *(u32x4*)(hp + 8 * i) = o; }
  }
}

constexpr int HY_WAVE = 18816, HY_HR = 0, HY_ZA = 8576, HY_ZB = 8576 + 5120;
__device__ __forceinline__ void hyena_item(const Params& p, LP lds, int item) {
  const int tid = opaque_tid(), wid = __builtin_amdgcn_readfirstlane(tid >> 6), lane = tid & 63, n31 = lane & 31, hh = lane >> 5;
  const bool smp = item < 1024; const int it = smp ? item : item - 1024; const int bset = it >> 7, cgp = it & 127; const int c = cgp * 8 + wid;
  const int L = smp ? 2048 : 256, lgL = smp ? 11 : 8, nblk = L >> 5, lgnb = lgL - 5, ntok = smp ? 2048 : 1024, ntile = smp ? 2 : 1, dmax = L >> 6;
  const int tok0 = smp ? NCTX + bset * 2048 : bset * 1024;
  LP wl = lds + wid * HY_WAVE; LAS float* hr = (LAS float*)(wl + HY_HR);
  const float* HFp = (const float*)(p.ws + (smp ? OFF_HFS : OFF_HFC));
  const bf16_t* UT = (const bf16_t*)(p.ws + OFF_BIG);
  const float* cw = p.in[12]; const float* cbv = p.in[13]; const float* skp = p.in[21];
  { const int uc = 2048 + c; const float w0 = cw[uc], w1 = cw[3072 + uc], w2 = cw[6144 + uc], cb = cbv[uc]; const bf16_t* src = UT + (size_t)uc * NTOK + tok0;
    u32x4 vv[4]; float pvv[4], nxv[4];
#pragma unroll
    for (int i = 0; i < 4; ++i) { const int base = lane * 8 + 512 * i; vv[i] = (u32x4){0u, 0u, 0u, 0u}; pvv[i] = 0.f; nxv[i] = 0.f;
      if (base < ntok) { vv[i] = *(const u32x4*)(src + base); const int tl = base & (L - 1);
        if (tl != 0) pvv[i] = bf2f(src[base - 1]); if (tl + 8 != L) nxv[i] = bf2f(src[base + 8]); } }
#pragma unroll
    for (int i = 0; i < 4; ++i) { const int base = lane * 8 + 512 * i;
      if (base < ntok) { const u32x4 v = vv[i];
        float u[10]; u[0] = pvv[i]; u[1] = bflo(v.x); u[2] = bfhi(v.x); u[3] = bflo(v.y); u[4] = bfhi(v.y); u[5] = bflo(v.z); u[6] = bfhi(v.z); u[7] = bflo(v.w); u[8] = bfhi(v.w); u[9] = nxv[i];
        float o[8];
#pragma unroll
        for (int e = 0; e < 8; ++e) o[e] = cb + w0 * u[e] + w1 * u[e + 1] + w2 * u[e + 2];
        u32x4 w; w.x = pack2(o[0], o[1]); w.y = pack2(o[2], o[3]); w.z = pack2(o[4], o[5]); w.w = pack2(o[6], o[7]);
        *(LAS u32x4*)(wl + HY_ZA + ((base >> 5) * 40 + (base & 31)) * 2) = w; } } }
  const int HRP = L + 96;
  for (int ord = 0; ord < 2; ++ord) {
    { const float* src = HFp + (size_t)(ord * 1024 + c) * L; float sa = 0.f;
      f32x4 fv[8];
#pragma unroll
      for (int i = 0; i < 8; ++i) { const int q = lane + 64 * i; fv[i] = (4 * q < L) ? *(const f32x4*)(src + 4 * q) : (f32x4){0.f, 0.f, 0.f, 0.f}; }
#pragma unroll
      for (int i = 0; i < 8; ++i) sa += (fabsf(fv[i][0]) + fabsf(fv[i][1])) + (fabsf(fv[i][2]) + fabsf(fv[i][3]));
      sa = wave_sum(sa); const float inv = 1.0f / (sa + 1e-6f);
      asm volatile("s_waitcnt lgkmcnt(0)" ::: "memory");
      LAS bf16_t* E = (LAS bf16_t*)hr; LAS bf16_t* O = E + HRP;
#pragma unroll
      for (int i = 0; i < 8; ++i) { const int q = lane + 64 * i;
        if (4 * q < L) {
#pragma unroll
          for (int e = 0; e < 4; ++e) { const int yy = L - 1 - (4 * q + e); const bf16_t v = f2bf(fv[i][e] * inv); E[32 + yy] = v; O[31 + yy] = v; } } }
      if (lane < 32) { E[lane] = 0; E[32 + L + lane] = 0; O[31 + L + lane] = 0; if (lane < 31) O[lane] = 0; }
      if (lane < 33) O[HRP - 33 + lane] = 0;
      asm volatile("s_waitcnt lgkmcnt(0)" ::: "memory"); }
    LP zin = wl + (ord == 0 ? HY_ZA : HY_ZB); LP zout = wl + (ord == 0 ? HY_ZB : HY_ZA);
    const int gc = ord * 1024 + c; const float w0 = cw[gc], w1 = cw[3072 + gc], w2 = cw[6144 + gc], cb = cbv[gc], sk = skp[ord * 1024 + c];
    const bf16_t* gsrc = UT + (size_t)gc * NTOK + tok0;
    u32x4 gv[4]; unsigned gpv[4], gnx[4];
#pragma unroll
    for (int i = 0; i < 4; ++i) { const int base = lane * 8 + 512 * i; gv[i] = (u32x4){0u, 0u, 0u, 0u}; gpv[i] = 0u; gnx[i] = 0u;
      if (base < ntok) { gv[i] = *(const u32x4*)(gsrc + base); const int tl = base & (L - 1);
        if (tl != 0) gpv[i] = gsrc[base - 1]; if (tl + 8 != L) gnx[i] = gsrc[base + 8]; } }
    f32x16 accs[2];
#pragma unroll
    for (int o2 = 0; o2 < 2; ++o2)
#pragma unroll
      for (int r = 0; r < 16; ++r) accs[o2][r] = 0.f;
    LP fb = wl + HY_HR + ((n31 & 1) ? 0 : (HRP * 2 - 2)) + 2 * ((L >> 1) - 1 - n31 + 8 * hh + 32);
    int cbl[2], ca[2];
#pragma unroll
    for (int ot = 0; ot < 2; ++ot) { const int col = 32 * ot + n31; cbl[ot] = (col >> lgnb) << lgnb; ca[ot] = col & (nblk - 1); }
    const bool two = (ntile == 2);
    {
      LP zero = wl + HY_HR + 16 * hh;
      LP ap = fb + 64 * dmax;
      int bbr0 = ca[0] + dmax, bbr1 = ca[1] + dmax;
      LP bp0 = zin + ((cbl[0] + bbr0) * 40 + 8 * hh) * 2, bp1 = zin + ((cbl[1] + bbr1) * 40 + 8 * hh) * 2;
      for (int d = -dmax; d <= dmax; ++d) {
        u32x4 w0v, w1v;
        w0v.x = *(const LAS unsigned*)(ap); w0v.y = *(const LAS unsigned*)(ap + 4); w0v.z = *(const LAS unsigned*)(ap + 8); w0v.w = *(const LAS unsigned*)(ap + 12);
        w1v.x = *(const LAS unsigned*)(ap + 32); w1v.y = *(const LAS unsigned*)(ap + 36); w1v.z = *(const LAS unsigned*)(ap + 40); w1v.w = *(const LAS unsigned*)(ap + 44);
        const bf16x8 af0 = __builtin_bit_cast(bf16x8, w0v), af1 = __builtin_bit_cast(bf16x8, w1v);
        LP q0 = ((unsigned)bbr0 < (unsigned)nblk) ? bp0 : zero;
        const bf16x8 b00 = *(const LAS bf16x8*)q0, b01 = *(const LAS bf16x8*)(q0 + 32);
        accs[0] = __builtin_amdgcn_mfma_f32_32x32x16_bf16(af0, b00, accs[0], 0, 0, 0);
        accs[0] = __builtin_amdgcn_mfma_f32_32x32x16_bf16(af1, b01, accs[0], 0, 0, 0);
        if (two) {
          LP q1 = ((unsigned)bbr1 < (unsigned)nblk) ? bp1 : zero;
          const bf16x8 b10 = *(const LAS bf16x8*)q1, b11 = *(const LAS bf16x8*)(q1 + 32);
          accs[1] = __builtin_amdgcn_mfma_f32_32x32x16_bf16(af0, b10, accs[1], 0, 0, 0);
          accs[1] = __builtin_amdgcn_mfma_f32_32x32x16_bf16(af1, b11, accs[1], 0, 0, 0);
        }
        ap -= 64; bbr0 -= 1; bbr1 -= 1; bp0 -= 80; bp1 -= 80;
      }
    }
#pragma unroll
    for (int ot = 0; ot < 2; ++ot) {
      if (ot >= ntile) continue;
      const f32x16 acc = accs[ot];
#pragma unroll
      for (int rg = 0; rg < 4; ++rg) {
        const int zo = (((cbl[ot] + ca[ot]) * 40) + 8 * rg + 4 * hh) * 2;
        const u32x2 zv = *(const LAS u32x2*)(zin + zo);
        u32x2 w; w.x = pack2(acc[4 * rg] + sk * bflo(zv.x), acc[4 * rg + 1] + sk * bfhi(zv.x)); w.y = pack2(acc[4 * rg + 2] + sk * bflo(zv.y), acc[4 * rg + 3] + sk * bfhi(zv.y));
        *(LAS u32x2*)(zout + zo) = w;
      }
    }
    asm volatile("s_waitcnt lgkmcnt(0)" ::: "memory");
#pragma unroll
    for (int i = 0; i < 4; ++i) { const int base = lane * 8 + 512 * i;
      if (base < ntok) { const u32x4 v = gv[i];
        float u[10]; u[0] = bf2f(gpv[i]); u[1] = bflo(v.x); u[2] = bfhi(v.x); u[3] = bflo(v.y); u[4] = bfhi(v.y); u[5] = bflo(v.z); u[6] = bfhi(v.z); u[7] = bflo(v.w); u[8] = bfhi(v.w); u[9] = bf2f(gnx[i]);
        LP zp = zout + ((base >> 5) * 40 + (base & 31)) * 2; const u32x4 t = *(const LAS u32x4*)zp;
        float tv[8]; tv[0] = bflo(t.x); tv[1] = bfhi(t.x); tv[2] = bflo(t.y); tv[3] = bfhi(t.y); tv[4] = bflo(t.z); tv[5] = bfhi(t.z); tv[6] = bflo(t.w); tv[7] = bfhi(t.w);
        float o[8];
#pragma unroll
        for (int e = 0; e < 8; ++e) o[e] = (cb + w0 * u[e] + w1 * u[e + 1] + w2 * u[e + 2]) * tv[e];
        u32x4 w; w.x = pack2(o[0], o[1]); w.y = pack2(o[2], o[3]); w.z = pack2(o[4], o[5]); w.w = pack2(o[6], o[7]);
        *(LAS u32x4*)zp = w; } }
    asm volatile("s_waitcnt lgkmcnt(0)" ::: "memory");
  }
  __syncthreads();
  { bf16_t* YH = (bf16_t*)((unsigned char*)p.out + OUT_HB);
    for (int tl = tid; tl < ntok; tl += 512) {
      const int bl = tl >> lgL, tloc = tl & (L - 1); const int zo = ((((bl << lgnb) + (tloc >> 5)) * 40) + (tloc & 31)) * 2;
      unsigned short e[8];
#pragma unroll
      for (int w = 0; w < 8; ++w) e[w] = *(const LAS unsigned short*)(lds + w * HY_WAVE + HY_ZA + zo);
      u32x4 o; o.x = e[0] | ((unsigned)e[1] << 16); o.y = e[2] | ((unsigned)e[3] << 16); o.z = e[4] | ((unsigned)e[5] << 16); o.w = e[6] | ((unsigned)e[7] << 16);
      *(u32x4*)(YH + (size_t)(tok0 + tl) * 1024 + cgp * 8) = o; } }
  __syncthreads();
}

__device__ __forceinline__ void final_norm(const Params& p) {
  const int tid0 = opaque_tid(); const int wid = tid0 >> 6, lane = tid0 & 63; const float* fw = p.in[31]; const float* ssq = (const float*)(p.ws + OFF_SSQ2);
  for (int unit = blockIdx.x; unit < 3072; unit += gridDim.x) {
    const int row = unit * 8 + wid; float* xr = p.out + (size_t)row * 1024; const float* sp = ssq + (size_t)row * 16;
    const f32x4 st = *(const f32x4*)sp + *(const f32x4*)(sp + 4) + *(const f32x4*)(sp + 8) + *(const f32x4*)(sp + 12);
    const float rstd = rsqrtf((st[0] + st[1] + st[2] + st[3]) * (1.0f / 1024.0f) + 1e-6f);
#pragma unroll
    for (int i = 0; i < 4; ++i) { const int col = 4 * lane + 256 * i; const f32x4 v = *(const f32x4*)(xr + col) * rstd * *(const f32x4*)(fw + col); *(f32x4*)(xr + col) = v; }
  }
}

__global__ void __launch_bounds__(512, 2) mega(Params p) {
  extern __shared__ __attribute__((aligned(16))) unsigned char shm[];
  LP lds = (LP)shm;
  cg::grid_group grid = cg::this_grid();
  volatile LAS unsigned* xst = (volatile LAS unsigned*)(lds + LDS_BYTES - 16);
  if (threadIdx.x == 0) { xst[0] = 0u; xst[1] = 0u; }
  __syncthreads();
  const XcdBarrier xb = xcd_barrier_post((unsigned*)(p.ws + OFF_BAR), xst);
  unsigned char* ws = p.ws;
  const bf16_t* WT = (const bf16_t*)(ws + OFF_WT); const bf16_t* HN = (const bf16_t*)(ws + OFF_HN); bf16_t* BIG = (bf16_t*)(ws + OFF_BIG);
  bf16_t* Hb = (bf16_t*)((unsigned char*)p.out + OUT_H); bf16_t* YH = (bf16_t*)((unsigned char*)p.out + OUT_HB);
  const float* mod = (const float*)(ws + OFF_MOD);
  phase0(p, lds);
  if (gridDim.y == 7u) grid.sync();
  xcd_barrier(xb);
  phase1(p, lds);
  weight_tiles(p, lds);
  xcd_barrier(xb);
  { EpiQKV e; e.O = BIG; e.bias = p.in[11]; run_gemm(lds, HN, WT, NTOK, 3072, 1024, e); }
  xcd_barrier(xb);
  for (int item = blockIdx.x; item < 1280; item += gridDim.x) mlstm_item(p, lds, item);
  xcd_barrier(xb);
  combine_rows(p);
  { EpiUT e; e.O = BIG; e.bias = p.in[11] + 4112; run_gemm(lds, WT + (size_t)3072 * 1024, HN, 3072, NTOK, 1024, e); }
  xcd_barrier(xb);
  for (int item = blockIdx.x; item < 2048; item += gridDim.x) hyena_item(p, lds, item);
  xcd_barrier(xb);
  { EpiGates e; e.H = Hb; e.G = BIG; e.b_in = p.in[11]; run_gemm(lds, HN, WT + (size_t)6144 * 1024, NTOK, 3072, 1024, e); }
  xcd_barrier(xb);
  bf16_t* T = BIG + (size_t)NTOK * 2048;
  { EpiMerge<0> e; e.T = T; e.G = BIG; run_gemm(lds, Hb, (const bf16_t*)(ws + OFF_WBM), NTOK, 1024, 1024, e); }
  { EpiMerge<1> e; e.T = T; e.G = BIG; run_gemm(lds, YH, (const bf16_t*)(ws + OFF_WBH), NTOK, 1024, 1024, e); }
  xcd_barrier(xb);
  { EpiOut e; e.xp = p.in[0]; e.xs = p.in[1]; e.per = (const float*)(ws + OFF_PER); e.pec = (const float*)(ws + OFF_PEC); e.mod = mod; e.n2w = p.in[26];
    e.X1 = p.out; e.A2 = (bf16_t*)(ws + OFF_HN); e.ssq = (float*)(ws + OFF_SSQ1); run_gemm(lds, T, (const bf16_t*)(ws + OFF_WOUT), NTOK, 1024, 1024, e); }
  xcd_barrier(xb);
#define FFN_HALF(ROW0) do { \
    { EpiFF1 e; e.row0 = (ROW0); e.ssq = (const float*)(p.ws + OFF_SSQ1); e.c1 = (const float*)(p.ws + OFF_C1); e.Hd = (bf16_t*)(p.ws + OFF_BIG); \
      run_gemm(lds, (const bf16_t*)(p.ws + OFF_HN) + (size_t)(ROW0) * 1024, (const bf16_t*)(p.ws + OFF_W1T), 12288, 4096, 1024, e); } \
    xcd_barrier(xb); \
    { EpiFF2 e; e.row0 = (ROW0); e.mod = (const float*)(p.ws + OFF_MOD); e.b2 = p.in[30]; e.X = p.out; e.ssq = (float*)(p.ws + OFF_SSQ2); \
      run_gemm(lds, (const bf16_t*)(p.ws + OFF_BIG), (const bf16_t*)(p.ws + OFF_W2T), 12288, 1024, 4096, e); } \
    xcd_barrier(xb); } while (0)
  FFN_HALF(0);
  FFN_HALF(12288);
#undef FFN_HALF
  final_norm(p);
}

extern "C" void kernel_launch(void* const* d_in, const int* in_sizes, int n_in, void* d_out, int out_size, void* d_ws, size_t ws_size, hipStream_t stream) {
  static int grid_blocks = 0;
  if (!grid_blocks) {
    int dev = 0, cus = 0, per_cu = 0;
    hipGetDevice(&dev);
    hipDeviceGetAttribute(&cus, hipDeviceAttributeMultiprocessorCount, dev);
    hipFuncSetAttribute((const void*)mega, hipFuncAttributeMaxDynamicSharedMemorySize, LDS_BYTES);
    hipOccupancyMaxActiveBlocksPerMultiprocessor(&per_cu, (const void*)mega, 512, LDS_BYTES);
    if (per_cu < 1) { fprintf(stderr, "kernel_launch: occupancy query reports %d blocks per CU\n", per_cu); grid_blocks = -1; }
    else grid_blocks = cus;
    if (n_in != 32 || ws_size < WS_END) { fprintf(stderr, "kernel_launch: unexpected n_in %d / ws_size %zu (need %zu)\n", n_in, ws_size, (size_t)WS_END); grid_blocks = -1; }
  }
  if (grid_blocks < 0) return;
  hipMemsetAsync((unsigned char*)d_ws + OFF_BAR, 0, 3456 * 4, stream);
  Params p{};
  for (int i = 0; i < 32; ++i) p.in[i] = (const float*)d_in[i];
  p.out = (float*)d_out; p.ws = (unsigned char*)d_ws;
  void* args[] = {&p};
  hipError_t e = hipLaunchCooperativeKernel((void*)mega, dim3(grid_blocks), dim3(512), args, LDS_BYTES, stream);
  if (e != hipSuccess) fprintf(stderr, "cooperative launch failed: %s (grid %d)\n", hipGetErrorString(e), grid_blocks);
}
```

```cpp
#include <hip/hip_runtime.h>
#include <hip/hip_cooperative_groups.h>
#include <cstdio>
#include <cstdint>
namespace cg = cooperative_groups;

#define LAS __attribute__((address_space(3)))
typedef LAS unsigned char* LP;
typedef unsigned short bf16_t;
typedef short bf16x8 __attribute__((ext_vector_type(8)));
typedef short s16x4 __attribute__((ext_vector_type(4)));
typedef float f32x4 __attribute__((ext_vector_type(4)));
typedef float f32x16 __attribute__((ext_vector_type(16)));
typedef unsigned u32x4 __attribute__((ext_vector_type(4)));
typedef unsigned u32x2 __attribute__((ext_vector_type(2)));

constexpr int DM = 1024, NTOK = 24576, NCTX = 8192, SEQC = 256, SEQS = 2048, INC = 9232;
constexpr int LDS_BYTES = 160 * 1024;
constexpr size_t OFF_WT = 0;
constexpr size_t OFF_WBM = 18874368, OFF_WBH = 20971520, OFF_WOUT = 23068672, OFF_W1T = 25165824, OFF_W2T = 33554432;
constexpr size_t OFF_HN = 41943040;
constexpr size_t OFF_BIG = 92274688;
constexpr size_t OFF_SM = 243269632;
constexpr size_t OFF_MOD = OFF_SM;
constexpr size_t OFF_C1 = OFF_MOD + 221184;
constexpr size_t OFF_H2S = OFF_C1 + 147456;
constexpr size_t OFF_H2C = OFF_H2S + 524288;
constexpr size_t OFF_PER = OFF_H2C + 65536;
constexpr size_t OFF_PEC = OFF_PER + 65536;
constexpr size_t OFF_GT = OFF_PEC + 131072;
constexpr size_t OFF_SSQ1 = OFF_GT + 1572864;
constexpr size_t OFF_SSQ2 = OFF_SSQ1 + 1572864;
constexpr size_t OFF_HFS = OFF_SSQ2 + 1572864;
constexpr size_t OFF_HFC = OFF_HFS + 16777216;
constexpr size_t OFF_BAR = OFF_HFC + 2097152;
constexpr size_t WS_END = OFF_BAR + 3456 * 4;
constexpr size_t OUT_H = 0, OUT_HB = 50331648;
constexpr size_t OUTF_C = 25165824, OUTF_N = 41943040, OUTF_M = 42008576;

struct Params { const float* in[32]; float* out; unsigned char* ws; };

__device__ __forceinline__ bf16_t f2bf(float f) { unsigned u = __float_as_uint(f); u += 0x7FFFu + ((u >> 16) & 1u); return (bf16_t)(u >> 16); }
__device__ __forceinline__ float bf2f(unsigned b) { return __uint_as_float(b << 16); }
__device__ __forceinline__ unsigned pack2(float lo, float hi) { return (unsigned)f2bf(lo) | ((unsigned)f2bf(hi) << 16); }
__device__ __forceinline__ float bflo(unsigned w) { return __uint_as_float(w << 16); }
__device__ __forceinline__ float bfhi(unsigned w) { return __uint_as_float(w & 0xffff0000u); }
__device__ __forceinline__ float sigmoidf_(float x) { return 1.0f / (1.0f + __expf(-x)); }
__device__ __forceinline__ int opaque_tid() { int t = threadIdx.x; asm volatile("" : "+v"(t)); return t; }
__device__ __forceinline__ float wave_sum(float v) {
#pragma unroll
  for (int o = 32; o >= 1; o >>= 1) v += __shfl_xor(v, o);
  return v;
}


#define XB_TMO      128
#define XB_XCNT(j)  (256  + 64 * (j))
#define XB_XSUB(j)  (1280 + 64 * (j))
#define XB_XGEN(j)  (2304 + 64 * (j))
#define XB_TOP      3328
#define XB_TOPGEN   3392
#define XCD_BAR_WORDS 3456
#define XB_SPIN_CAP (1u << 18)
__device__ __forceinline__ unsigned xb_ld(unsigned* p)              { return __hip_atomic_load(p, __ATOMIC_RELAXED, __HIP_MEMORY_SCOPE_AGENT); }
__device__ __forceinline__ unsigned xb_add(unsigned* p, unsigned v) { return __hip_atomic_fetch_add(p, v, __ATOMIC_RELAXED, __HIP_MEMORY_SCOPE_AGENT); }
__device__ __forceinline__ unsigned xb_xcc_id() { return (unsigned)__builtin_amdgcn_s_getreg((3 << 11) | 20) & 0xFu; }
#define XB_SPIN(cond, bar) do { unsigned _sp = 0; while (cond) { __builtin_amdgcn_s_sleep(1); \
    if ((++_sp & 255u) == 0u) { if (xb_ld(&(bar)[XB_TMO])) break; if (_sp > XB_SPIN_CAP) { atomicAdd(&(bar)[XB_TMO], 1u); break; } } } } while (0)
struct XcdBarrier { unsigned* bar; unsigned x; volatile LAS unsigned* st; };
__device__ __forceinline__ XcdBarrier xcd_barrier_post(unsigned* bar, volatile LAS unsigned* st) {
  XcdBarrier b; b.bar = bar; b.x = xb_xcc_id(); b.st = st;
  if (threadIdx.x == 0) (void)xb_add(&bar[XB_XCNT(b.x)], 1u);
  return b;
}
__device__ __forceinline__ void xcd_barrier_complete(unsigned* bar, unsigned x, unsigned& nloc, unsigned& nx) {
  const unsigned G = gridDim.x * gridDim.y * gridDim.z;
  unsigned sum, cnt, mine, sp = 0u;
  for (;;) {
    sum = 0u; cnt = 0u; mine = 0u;
#pragma unroll
    for (unsigned j = 0; j < 16; ++j) { const unsigned c = xb_ld(&bar[XB_XCNT(j)]); sum += c; cnt += (c > 0u) ? 1u : 0u; mine = (j == x) ? c : mine; }
    if (sum == G) break;
    __builtin_amdgcn_s_sleep(1);
    if ((++sp & 255u) == 0u) { if (xb_ld(&bar[XB_TMO])) break; if (sp > XB_SPIN_CAP) { atomicAdd(&bar[XB_TMO], 1u); break; } }
  }
  nloc = mine > 0u ? mine : 1u; nx = cnt > 0u ? cnt : 1u;
}
__device__ __forceinline__ void xcd_barrier(const XcdBarrier& b) {
  asm volatile("s_waitcnt vmcnt(0)" ::: "memory");
  __syncthreads();
  if (threadIdx.x == 0) {
    unsigned* bar = b.bar;
    __builtin_amdgcn_s_waitcnt(0);
    unsigned nloc = b.st[0], nx = b.st[1];
    if (nloc == 0u) { xcd_barrier_complete(bar, b.x, nloc, nx); b.st[0] = nloc; b.st[1] = nx; }
    const unsigned old = xb_add(&bar[XB_XSUB(b.x)], 1u);
    const unsigned gen = old / nloc;
    if (old + 1u == (gen + 1u) * nloc) {
      __builtin_amdgcn_fence(__ATOMIC_RELEASE, "agent");
      asm volatile("s_waitcnt vmcnt(0)" ::: "memory");
      const unsigned og = xb_add(&bar[XB_TOP], 1u);
      const unsigned tg = og / nx;
      if (og + 1u == (tg + 1u) * nx) xb_add(&bar[XB_TOPGEN], 1u);
      else XB_SPIN(xb_ld(&bar[XB_TOPGEN]) == tg, bar);
      __builtin_amdgcn_fence(__ATOMIC_ACQUIRE, "agent");
      xb_add(&bar[XB_XGEN(b.x)], 1u);
      asm volatile("s_waitcnt vmcnt(0)" ::: "memory");
    } else {
      XB_SPIN(xb_ld(&bar[XB_XGEN(b.x)]) == gen, bar);
      __builtin_amdgcn_fence(__ATOMIC_ACQUIRE, "agent");
      asm volatile("s_waitcnt vmcnt(0)" ::: "memory");
    }
  }
  __syncthreads();
}

namespace pg8 {
constexpr int BM = 256, BK = 64, HALF = 128, HTB = HALF * BK * 2, STAGE_BYTES = 8 * HTB, NXCD = 8, WGM = 8;
__host__ __device__ __forceinline__ int lds_byte(int r, int c) { const int st = (r >> 4) * 2 + (c >> 5), rr = r & 15, cc = c & 31, ob = rr * 64 + cc * 2; return st * 1024 + (ob ^ (((ob >> 9) & 1) << 5)); }
__host__ __device__ __forceinline__ void stage_rc(int b, int& R, int& C) { const int st = b / 1024, sb = b % 1024, swz = sb ^ (((sb >> 9) & 1) << 5); R = (st >> 1) * 16 + swz / 64; C = (st & 1) * 32 + (swz % 64) / 2; }
struct Unit { int pm, pn; };
struct Gemm { const bf16_t* A; const bf16_t* Bt; int M, N, K; };
struct StaticOrder {
  int nM, nN, nwg, G, c;
  __device__ void init(int M, int N, int G_, int c_) { nM = M / BM; nN = N / BM; nwg = nM * nN; G = G_; c = c_; }
  __device__ bool next(int i, Unit& u) const {
    const long L = (long)i * G + c; if (L >= nwg) return false;
    int wgid = (int)L; { const int q = nwg / NXCD, r = nwg % NXCD, xcd = wgid % NXCD, off = wgid / NXCD; wgid = (xcd < r ? xcd * (q + 1) : r * (q + 1) + (xcd - r) * q) + off; }
    const int nig = WGM * nN, gid = wgid / nig, fm = gid * WGM, gsz = (nM - fm) < WGM ? (nM - fm) : WGM;
    u.pm = fm + ((wgid % nig) % gsz); u.pn = (wgid % nig) / gsz; return true;
  }
};

template <class Epi>
__device__ __forceinline__ void gemm_phase(LP lds, const Gemm g, const StaticOrder& S, const Epi& E) {
  int tid_ = threadIdx.x; asm volatile("" : "+v"(tid_));
  const int tid = tid_, wid = __builtin_amdgcn_readfirstlane(tid >> 6), lane = tid & 63, wr = wid >> 2, wc = wid & 3, fr = lane & 15, fq = lane >> 4;
  const int K = g.K, nt = K / BK;
  unsigned voffA[2], voffB[2];
#pragma unroll
  for (int i = 0; i < 2; ++i) { int R, C; stage_rc(tid * 16 + i * 8192, R, C); voffA[i] = (unsigned)(R * K + C) * 2u; voffB[i] = voffA[i]; }
  const size_t kstep = (size_t)(BK * 2);
  const size_t hstep = (size_t)HALF * K * 2;
  const size_t tstep = 2 * hstep;
  const unsigned ldsw = (unsigned)wid * 1024u;
  const int aoff = lds_byte(wr * 64 + fr, fq * 8), boff = lds_byte(wc * 32 + fr, fq * 8);
#define PG8_SA(b, h) (((b) * 2 + (h)) * HTB)
#define PG8_SB(b, h) ((4 + (b) * 2 + (h)) * HTB)
#define PG8_STAGE(bufoff, gbase, voff) do { _Pragma("unroll") for (int _i = 0; _i < 2; ++_i) \
    __builtin_amdgcn_global_load_lds((const unsigned*)((const char*)(gbase) + (voff)[_i]), (LAS unsigned*)(lds + (bufoff) + ldsw + _i * 8192), 16, 0, 0); } while (0)
#define PG8_LDA(dst, b, h) do { _Pragma("unroll") for (int m = 0; m < 4; ++m) _Pragma("unroll") for (int k = 0; k < 2; ++k) dst[m][k] = *(const LAS bf16x8*)(lds + PG8_SA(b, h) + aoff + m * 2048 + k * 1024); } while (0)
#define PG8_LDB(dst, b, h) do { _Pragma("unroll") for (int n = 0; n < 2; ++n) _Pragma("unroll") for (int k = 0; k < 2; ++k) dst[n][k] = *(const LAS bf16x8*)(lds + PG8_SB(b, h) + boff + n * 2048 + k * 1024); } while (0)
#define PG8_MMA(ai, bj, At, Bt) do { __builtin_amdgcn_s_setprio(1); _Pragma("unroll") for (int m = 0; m < 4; ++m) _Pragma("unroll") for (int n = 0; n < 2; ++n) _Pragma("unroll") for (int k = 0; k < 2; ++k) \
    acc[ai][bj][m][n] = __builtin_amdgcn_mfma_f32_16x16x32_bf16(Bt[n][k], At[m][k], acc[ai][bj][m][n], 0, 0, 0); __builtin_amdgcn_s_setprio(0); } while (0)
#define PG8_WAIT_V(n) asm volatile("s_waitcnt vmcnt(" #n ")" ::: "memory")
#define PG8_WAIT_L(n) asm volatile("s_waitcnt lgkmcnt(" #n ")" ::: "memory")
#define PG8_BAR __builtin_amdgcn_s_barrier()
#define PG8_SCHED __builtin_amdgcn_sched_barrier(0)
  Unit cur, nxt; int ui = 0;
  if (!S.next(0, cur)) return;
  f32x4 acc[2][2][4][2];
#pragma unroll
  for (int a = 0; a < 2; ++a)
#pragma unroll
    for (int b = 0; b < 2; ++b)
#pragma unroll
      for (int m = 0; m < 4; ++m)
#pragma unroll
        for (int n = 0; n < 2; ++n) acc[a][b][m][n] = (f32x4){0.f, 0.f, 0.f, 0.f};
  bf16x8 At[4][2], B0[2][2], B1[2][2];
  const char* cA = (const char*)g.A + (size_t)cur.pm * tstep; const char* cB = (const char*)g.Bt + (size_t)cur.pn * tstep;
  PG8_STAGE(PG8_SB(0, 0), cB, voffB); PG8_STAGE(PG8_SA(0, 0), cA, voffA); PG8_STAGE(PG8_SB(0, 1), cB + hstep, voffB); PG8_STAGE(PG8_SA(0, 1), cA + hstep, voffA);
  if (wr == 1) PG8_BAR;
  PG8_WAIT_V(4); PG8_BAR;
  PG8_STAGE(PG8_SB(1, 0), cB + kstep, voffB); PG8_STAGE(PG8_SA(1, 0), cA + kstep, voffA); PG8_STAGE(PG8_SB(1, 1), cB + hstep + kstep, voffB);
  PG8_WAIT_V(6); PG8_BAR;
  for (;;) {
    const bool has_next = S.next(ui + 1, nxt);
    const char* nA = has_next ? (const char*)g.A + (size_t)nxt.pm * tstep : cA; const char* nB = has_next ? (const char*)g.Bt + (size_t)nxt.pn * tstep : cB;
    for (int t = 0; t < nt; t += 2) {
      const bool last = (t == nt - 2);
      const char* a1 = cA + (size_t)(t + 1) * kstep;
      const char* a2 = last ? nA : cA + (size_t)(t + 2) * kstep; const char* b2 = last ? nB : cB + (size_t)(t + 2) * kstep;
      const char* a3 = a2 + kstep; const char* b3 = b2 + kstep;
      PG8_LDB(B0, 0, 0); PG8_SCHED; PG8_LDA(At, 0, 0); PG8_STAGE(PG8_SA(1, 1), a1 + hstep, voffA);
      PG8_WAIT_L(8); PG8_BAR; PG8_WAIT_L(0); PG8_MMA(0, 0, At, B0); PG8_BAR; PG8_SCHED;
      PG8_LDB(B1, 0, 1); PG8_STAGE(PG8_SB(0, 0), b2, voffB);
      PG8_BAR; PG8_WAIT_L(0); PG8_MMA(0, 1, At, B1); PG8_BAR;
      PG8_LDA(At, 0, 1); PG8_STAGE(PG8_SA(0, 0), a2, voffA);
      PG8_BAR; PG8_WAIT_L(0); PG8_MMA(1, 0, At, B0); PG8_BAR; PG8_SCHED;
      PG8_STAGE(PG8_SB(0, 1), b2 + hstep, voffB);
      PG8_WAIT_V(6); PG8_BAR; PG8_MMA(1, 1, At, B1); PG8_BAR;
      PG8_LDB(B0, 1, 0); PG8_SCHED; PG8_LDA(At, 1, 0); PG8_STAGE(PG8_SA(0, 1), a2 + hstep, voffA);
      PG8_WAIT_L(8); PG8_BAR; PG8_WAIT_L(0); PG8_MMA(0, 0, At, B0); PG8_BAR; PG8_SCHED;
      PG8_LDB(B1, 1, 1); PG8_STAGE(PG8_SB(1, 0), b3, voffB);
      PG8_BAR; PG8_WAIT_L(0); PG8_MMA(0, 1, At, B1); PG8_BAR;
      PG8_LDA(At, 1, 1); PG8_STAGE(PG8_SA(1, 0), a3, voffA);
      PG8_BAR; PG8_WAIT_L(0); PG8_MMA(1, 0, At, B0); PG8_BAR; PG8_SCHED;
      PG8_STAGE(PG8_SB(1, 1), b3 + hstep, voffB);
      PG8_WAIT_V(6); PG8_BAR; PG8_MMA(1, 1, At, B1); PG8_BAR;
    }
    { int fr2 = fr, fq2 = fq; asm volatile("" : "+v"(fr2), "+v"(fq2)); E(acc, cur, wr, wc, fr2, fq2); }
    if (!has_next) break;
#pragma unroll
    for (int a = 0; a < 2; ++a)
#pragma unroll
      for (int b = 0; b < 2; ++b)
#pragma unroll
        for (int m = 0; m < 4; ++m)
#pragma unroll
          for (int n = 0; n < 2; ++n) acc[a][b][m][n] = (f32x4){0.f, 0.f, 0.f, 0.f};
    cur = nxt; cA = nA; cB = nB; ++ui;
  }
  PG8_WAIT_V(0);
  if (wr == 0) PG8_BAR;
  PG8_BAR;
#undef PG8_SA
#undef PG8_SB
#undef PG8_STAGE
#undef PG8_LDA
#undef PG8_LDB
#undef PG8_MMA
#undef PG8_WAIT_V
#undef PG8_WAIT_L
#undef PG8_BAR
#undef PG8_SCHED
}
}
using pg8::Unit;
typedef f32x4 AccT[2][2][4][2];

#define EPI_ROW(ai, m) (u.pm * 256 + (ai) * 128 + wr * 64 + (m) * 16 + fr)
#define EPI_COL(bj, n) (u.pn * 256 + (bj) * 128 + wc * 32 + (n) * 16 + 4 * fq)
#define EPI_LOOP_ROWS _Pragma("unroll") for (int ai = 0; ai < 2; ++ai) _Pragma("unroll") for (int m = 0; m < 4; ++m)
#define EPI_LOOP_COLS _Pragma("unroll") for (int bj = 0; bj < 2; ++bj) _Pragma("unroll") for (int n = 0; n < 2; ++n)

__device__ __forceinline__ int cond_of_row(int row) { return row < NCTX ? 0 : 1 + ((row - NCTX) >> 11); }

struct EpiQKV {
  bf16_t* O; const float* bias;
  __device__ __forceinline__ void operator()(const AccT& acc, const Unit& u, int wr, int wc, int fr, int fq) const {
    const float sc = (u.pn < 4) ? 0.0625f : 1.0f;
    EPI_LOOP_COLS { const int col = EPI_COL(bj, n); const f32x4 bv = *(const f32x4*)(bias + col);
      EPI_LOOP_ROWS { const int row = EPI_ROW(ai, m); const f32x4 v = (acc[ai][bj][m][n] + bv) * sc;
        u32x2 w; w.x = pack2(v[0], v[1]); w.y = pack2(v[2], v[3]); *(u32x2*)(O + (size_t)row * 3072 + col) = w; } }
  }
};
struct EpiUT {
  bf16_t* O; const float* bias;
  __device__ __forceinline__ void operator()(const AccT& acc, const Unit& u, int wr, int wc, int fr, int fq) const {
    EPI_LOOP_ROWS { const int row = EPI_ROW(ai, m); const float bv = bias[row];
      EPI_LOOP_COLS { const int col = EPI_COL(bj, n); const f32x4 v = acc[ai][bj][m][n] + bv;
        u32x2 w; w.x = pack2(v[0], v[1]); w.y = pack2(v[2], v[3]); *(u32x2*)(O + (size_t)row * NTOK + col) = w; } }
  }
};
struct EpiGates {
  bf16_t* H; bf16_t* G; const float* b_in;
  __device__ __forceinline__ void operator()(const AccT& acc, const Unit& u, int wr, int wc, int fr, int fq) const {
    const bool og = u.pn < 4;
    EPI_LOOP_COLS { const int col = EPI_COL(bj, n); const f32x4 bv = *(const f32x4*)(b_in + (og ? 3072 + col : 7184 + (col - 1024)));
      EPI_LOOP_ROWS { const int row = EPI_ROW(ai, m); const f32x4 a = acc[ai][bj][m][n] + bv;
        f32x4 s; s[0] = sigmoidf_(a[0]); s[1] = sigmoidf_(a[1]); s[2] = sigmoidf_(a[2]); s[3] = sigmoidf_(a[3]);
        if (og) { bf16_t* hp = H + (size_t)row * 1024 + col; const u32x2 hv = *(const u32x2*)hp;
          u32x2 w; w.x = pack2(bflo(hv.x) * s[0], bfhi(hv.x) * s[1]); w.y = pack2(bflo(hv.y) * s[2], bfhi(hv.y) * s[3]); *(u32x2*)hp = w; }
        else { u32x2 w; w.x = pack2(s[0], s[1]); w.y = pack2(s[2], s[3]); *(u32x2*)(G + (size_t)row * 2048 + (col - 1024)) = w; } } }
  }
};
template <int SECOND> struct EpiMerge {
  bf16_t* T; const bf16_t* G;
  __device__ __forceinline__ void operator()(const AccT& acc, const Unit& u, int wr, int wc, int fr, int fq) const {
    EPI_LOOP_ROWS { const int row = EPI_ROW(ai, m);
      EPI_LOOP_COLS { const int col = EPI_COL(bj, n); const f32x4 a = acc[ai][bj][m][n];
        const u32x2 gv = *(const u32x2*)(G + (size_t)row * 2048 + SECOND * 1024 + col);
        f32x4 v; v[0] = bflo(gv.x) * a[0]; v[1] = bfhi(gv.x) * a[1]; v[2] = bflo(gv.y) * a[2]; v[3] = bfhi(gv.y) * a[3];
        bf16_t* tp = T + (size_t)row * 1024 + col;
        if (SECOND) { const u32x2 tv = *(const u32x2*)tp; v[0] += bflo(tv.x); v[1] += bfhi(tv.x); v[2] += bflo(tv.y); v[3] += bfhi(tv.y); }
        u32x2 w; w.x = pack2(v[0], v[1]); w.y = pack2(v[2], v[3]); *(u32x2*)tp = w; } }
  }
};
struct EpiOut {
  const float* xp; const float* xs; const float* per; const float* pec; const float* mod; const float* n2w; float* X1; bf16_t* A2; float* ssq;
  __device__ __forceinline__ void operator()(const AccT& acc, const Unit& u, int wr, int wc, int fr, int fq) const {
    const int cb = cond_of_row(u.pm * 256); const float* md = mod + cb * 6144;
    EPI_LOOP_ROWS { const int row = EPI_ROW(ai, m); float ss = 0.f;
      EPI_LOOP_COLS { const int col = EPI_COL(bj, n); const f32x4 a = acc[ai][bj][m][n];
        f32x4 x0;
        if (row < NCTX) x0 = *(const f32x4*)(xp + (size_t)row * 1024 + col);
        else { const int r2 = row - NCTX, t = r2 & 2047; x0 = *(const f32x4*)(xs + (size_t)r2 * 1024 + col);
          const f32x4 pe = (col < 512) ? *(const f32x4*)(per + (t >> 6) * 512 + col) : *(const f32x4*)(pec + (t & 63) * 512 + (col - 512)); x0 += pe; }
        const f32x4 g1 = *(const f32x4*)(md + 2048 + col); const f32x4 sc2 = *(const f32x4*)(md + 4096 + col); const f32x4 nw = *(const f32x4*)(n2w + col);
        const f32x4 x1 = x0 + g1 * a; *(f32x4*)(X1 + (size_t)row * 1024 + col) = x1;
        ss += x1[0] * x1[0] + x1[1] * x1[1] + x1[2] * x1[2] + x1[3] * x1[3];
        const f32x4 av = x1 * nw * (sc2 + 1.0f); u32x2 w; w.x = pack2(av[0], av[1]); w.y = pack2(av[2], av[3]); *(u32x2*)(A2 + (size_t)row * 1024 + col) = w; }
      ss += __shfl_xor(ss, 16); ss += __shfl_xor(ss, 32);
      if (fq == 0) ssq[(size_t)row * 16 + u.pn * 4 + wc] = ss; }
  }
};
struct EpiFF1 {
  int row0; const float* ssq; const float* c1; bf16_t* Hd;
  __device__ __forceinline__ void operator()(const AccT& acc, const Unit& u, int wr, int wc, int fr, int fq) const {
    const int cb = cond_of_row(row0 + u.pm * 256); const float* cc = c1 + cb * 4096;
    EPI_LOOP_ROWS { const int rl = EPI_ROW(ai, m); const float* sp = ssq + (size_t)(row0 + rl) * 16;
      const f32x4 s0 = *(const f32x4*)sp, s1 = *(const f32x4*)(sp + 4), s2 = *(const f32x4*)(sp + 8), s3 = *(const f32x4*)(sp + 12);
      const f32x4 st = s0 + s1 + s2 + s3; const float rstd = rsqrtf((st[0] + st[1] + st[2] + st[3]) * (1.0f / 1024.0f) + 1e-6f);
      EPI_LOOP_COLS { const int col = EPI_COL(bj, n); const f32x4 cv = *(const f32x4*)(cc + col); f32x4 v = acc[ai][bj][m][n] * rstd + cv;
#pragma unroll
        for (int e = 0; e < 4; ++e) { const float r = fmaxf(v[e], 0.f); v[e] = r * r; }
        u32x2 w; w.x = pack2(v[0], v[1]); w.y = pack2(v[2], v[3]); *(u32x2*)(Hd + (size_t)rl * 4096 + col) = w; } }
  }
};
struct EpiFF2 {
  int row0; const float* mod; const float* b2; float* X; float* ssq;
  __device__ __forceinline__ void operator()(const AccT& acc, const Unit& u, int wr, int wc, int fr, int fq) const {
    const int cb = cond_of_row(row0 + u.pm * 256); const float* md = mod + cb * 6144;
    EPI_LOOP_ROWS { const int row = row0 + EPI_ROW(ai, m); float ss = 0.f;
      EPI_LOOP_COLS { const int col = EPI_COL(bj, n); const f32x4 g2 = *(const f32x4*)(md + 5120 + col); const f32x4 bb = *(const f32x4*)(b2 + col);
        float* xp = X + (size_t)row * 1024 + col; const f32x4 x2 = *(const f32x4*)xp + g2 * (acc[ai][bj][m][n] + bb); *(f32x4*)xp = x2;
        ss += x2[0] * x2[0] + x2[1] * x2[1] + x2[2] * x2[2] + x2[3] * x2[3]; }
      ss += __shfl_xor(ss, 16); ss += __shfl_xor(ss, 32);
      if (fq == 0) ssq[(size_t)row * 16 + u.pn * 4 + wc] = ss; }
  }
};

template <class Epi> __device__ __forceinline__ void run_gemm(LP lds, const bf16_t* A, const bf16_t* Bt, int M, int N, int K, const Epi& E) {
  pg8::Gemm g; g.A = A; g.Bt = Bt; g.M = M; g.N = N; g.K = K;
  pg8::StaticOrder S; S.init(M, N, (int)gridDim.x, (int)blockIdx.x);
  pg8::gemm_phase<Epi>(lds, g, S, E);
}

__device__ void transpose_tile(const float* __restrict__ src, int ld, int col0, int k0, bf16_t* __restrict__ dst, int K, int drow0, LAS float* tile) {
  const int t = opaque_tid();
  f32x4 v[4];
#pragma unroll
  for (int i = 0; i < 4; ++i) { const int idx = t + 512 * i, kr = idx >> 5, c4 = idx & 31; v[i] = *(const f32x4*)(src + (size_t)(k0 + kr) * ld + col0 + 4 * c4); }
#pragma unroll
  for (int i = 0; i < 4; ++i) { const int idx = t + 512 * i, kr = idx >> 5, c4 = idx & 31; LAS float* tp = tile + kr * 129 + 4 * c4; tp[0] = v[i][0]; tp[1] = v[i][1]; tp[2] = v[i][2]; tp[3] = v[i][3]; }
  __syncthreads();
  const int kb = t & 7;
#pragma unroll
  for (int i = 0; i < 2; ++i) { const int c = (t >> 3) + 64 * i; const LAS float* tp = tile + (kb * 8) * 129 + c; u32x4 o;
    o.x = pack2(tp[0], tp[129]); o.y = pack2(tp[2 * 129], tp[3 * 129]); o.z = pack2(tp[4 * 129], tp[5 * 129]); o.w = pack2(tp[6 * 129], tp[7 * 129]);
    *(u32x4*)(dst + (size_t)(drow0 + c) * K + k0 + kb * 8) = o; }
  __syncthreads();
}
template <int SILU> __device__ void matvec9_unit(const float* v0, const float* v1, int v1stride, const float* __restrict__ W, int ldw, const float* bias, float* out, int ldo, int col0, LAS float* lf) {
  const int t = opaque_tid(), lane = t & 63, wid = t >> 6;
  LAS float* sv = lf; LAS float* red = lf + 9216;
  for (int i = t; i < 9216; i += 512) { const int b = i >> 10, k = i & 1023; float x = (b == 0) ? v0[k] : v1[(size_t)(b - 1) * v1stride + k]; if (SILU) x = x / (1.0f + __expf(-x)); sv[i] = x; }
  __syncthreads();
  const int c4 = t & 7, kl = t >> 3;
  f32x4 w[16];
#pragma unroll
  for (int i = 0; i < 16; ++i) w[i] = *(const f32x4*)(W + (size_t)(kl + 64 * i) * ldw + col0 + 4 * c4);
  f32x4 acc[9];
#pragma unroll
  for (int b = 0; b < 9; ++b) acc[b] = (f32x4){0.f, 0.f, 0.f, 0.f};
#pragma unroll
  for (int i = 0; i < 16; ++i)
#pragma unroll
    for (int b = 0; b < 9; ++b) acc[b] += w[i] * sv[b * 1024 + kl + 64 * i];
#pragma unroll
  for (int b = 0; b < 9; ++b)
#pragma unroll
    for (int e = 0; e < 4; ++e) { float x = acc[b][e]; x += __shfl_xor(x, 8); x += __shfl_xor(x, 16); x += __shfl_xor(x, 32); acc[b][e] = x; }
  if (lane < 8) {
#pragma unroll
    for (int b = 0; b < 9; ++b) *(LAS f32x4*)(red + (wid * 9 + b) * 32 + 4 * lane) = acc[b]; }
  __syncthreads();
  if (t < 288) { const int b = t >> 5, cc = t & 31; float s = bias[col0 + cc];
#pragma unroll
    for (int pz = 0; pz < 8; ++pz) s += red[(pz * 9 + b) * 32 + cc];
    out[(size_t)b * ldo + col0 + cc] = s; }
  __syncthreads();
}

__device__ void phase0(const Params& p, LP lds) {
  unsigned char* ws = p.ws; LAS float* lf = (LAS float*)lds;
  const int tid0 = opaque_tid(); const int wid = tid0 >> 6, lane = tid0 & 63;
  for (int unit = blockIdx.x; unit < 576; unit += gridDim.x) {
    if (unit < 192) {
      matvec9_unit<1>(p.in[6], p.in[5], 1024, p.in[7], 6144, p.in[8], (float*)(ws + OFF_MOD), 6144, unit * 32, lf);
    } else if (unit < 480) {
      const int row = (unit - 192) * 8 + wid; const bool smp = row < 2048; const int L = smp ? 2048 : 256, t = smp ? row : row - 2048;
      const float* w1 = p.in[14]; const float* b1 = p.in[15]; const float* fr1 = p.in[16]; const float* w2 = p.in[17]; const float* b2 = p.in[18]; const float* fr2 = p.in[19];
      float a = b1[lane] + (float)t / (float)(L - 1) * w1[lane];
      const float base = (6.283185307179586f / (float)L) * (float)t;
      float cs = 0.f, sn = 0.f; if (lane < 16) { const float ang = base * (float)(lane + 1); cs = cosf(ang); sn = sinf(ang); }
#pragma unroll
      for (int i = 0; i < 16; ++i) a += __shfl(cs, i) * w1[(1 + i) * 64 + lane] + __shfl(sn, i) * w1[(17 + i) * 64 + lane];
      const float h1 = sinf(fr1[lane] * a);
      float a2 = b2[lane];
#pragma unroll 16
      for (int j = 0; j < 64; ++j) a2 += __shfl(h1, j) * w2[j * 64 + lane];
      const float h2 = sinf(fr2[lane] * a2);
      float* dst = (float*)(ws + (smp ? OFF_H2S : OFF_H2C)); dst[(size_t)t * 64 + lane] = h2;
    } else {
      const int r = unit - 480, c = tid0; const int pos = r < 32 ? r : r - 32; const int i = c & 255;
      const float omega = 1.0f / powf(10000.0f, (float)i / 256.0f); const float a = (float)pos * omega; const float v = c < 256 ? sinf(a) : cosf(a);
      float* dst = (float*)(ws + (r < 32 ? OFF_PER : OFF_PEC)); dst[(size_t)pos * 512 + c] = v;
    }
  }
}
__device__ void weight_tiles(const Params& p, LP lds) {
  unsigned char* ws = p.ws; LAS float* lf = (LAS float*)lds;
  for (int tu = blockIdx.x; tu < 2560; tu += gridDim.x) {
    const float* src; int ld, K, col0, k0, drow0; bf16_t* dst;
    if (tu < 1152) { const int nt = tu >> 4, kt = tu & 15; const int r = nt * 128; src = p.in[10]; ld = INC; K = 1024; k0 = kt * 64; drow0 = r; dst = (bf16_t*)(ws + OFF_WT);
      col0 = r < 3072 ? r : (r < 6144 ? 4112 + (r - 3072) : (r < 7168 ? 3072 + (r - 6144) : 7184 + (r - 7168))); }
    else if (tu < 1536) { const int v = tu - 1152, w = v >> 7, q = v & 127; src = p.in[23 + w]; ld = 1024; K = 1024; k0 = (q & 15) * 64; col0 = (q >> 4) * 128; drow0 = col0; dst = (bf16_t*)(ws + (w == 0 ? OFF_WBM : (w == 1 ? OFF_WBH : OFF_WOUT))); }
    else if (tu < 2048) { const int q = tu - 1536; src = p.in[27]; ld = 4096; K = 1024; k0 = (q & 15) * 64; col0 = (q >> 4) * 128; drow0 = col0; dst = (bf16_t*)(ws + OFF_W1T); }
    else { const int q = tu - 2048; src = p.in[29]; ld = 1024; K = 4096; k0 = (q & 63) * 64; col0 = (q >> 6) * 128; drow0 = col0; dst = (bf16_t*)(ws + OFF_W2T); }
    transpose_tile(src, ld, col0, k0, dst, K, drow0, lf);
  }
}

__device__ void phase1(const Params& p, LP lds) {
  unsigned char* ws = p.ws;
  int tid_ = threadIdx.x; asm volatile("" : "+v"(tid_));
  const int tid = tid_, wid = tid >> 6, lane = tid & 63;
  const float* mod = (const float*)(ws + OFF_MOD);
  LAS float* wg = (LAS float*)lds;
  if ((int)blockIdx.x < 1536) {
    f32x4 gw[8];
#pragma unroll
    for (int i = 0; i < 8; ++i) { const int idx = tid + 512 * i, k = idx >> 2, q = idx & 3; gw[i] = *(const f32x4*)(p.in[10] + (size_t)k * INC + 4096 + 4 * q); }
#pragma unroll
    for (int i = 0; i < 8; ++i) { const int idx = tid + 512 * i, k = idx >> 2, q = idx & 3; wg[(4 * q) * 1024 + k] = gw[i][0]; wg[(4 * q + 1) * 1024 + k] = gw[i][1]; wg[(4 * q + 2) * 1024 + k] = gw[i][2]; wg[(4 * q + 3) * 1024 + k] = gw[i][3]; }
    __syncthreads();
  }
  for (int unit = blockIdx.x; unit < 1536; unit += gridDim.x) {
    const int tidn = opaque_tid(); const int wid = tidn >> 6, lane = tidn & 63;
    const int row0 = unit * 16 + wid * 2; const int cb = cond_of_row(row0); const float* md = mod + cb * 6144; const bool smp = row0 >= NCTX;
    f32x4 v[2][4]; float rstd[2];
#pragma unroll
    for (int r = 0; r < 2; ++r) { const int row = row0 + r; const float* xr; int t = 0;
      if (!smp) xr = p.in[0] + (size_t)row * 1024; else { xr = p.in[1] + (size_t)(row - NCTX) * 1024; t = (row - NCTX) & 2047; }
      const float* per = (const float*)(ws + OFF_PER) + (t >> 6) * 512; const float* pec = (const float*)(ws + OFF_PEC) + (t & 63) * 512;
      float ss = 0.f;
#pragma unroll
      for (int i = 0; i < 4; ++i) { const int col = 4 * lane + 256 * i; v[r][i] = *(const f32x4*)(xr + col);
        if (smp) v[r][i] += (col < 512) ? *(const f32x4*)(per + col) : *(const f32x4*)(pec + col - 512);
        ss += v[r][i][0] * v[r][i][0] + v[r][i][1] * v[r][i][1] + v[r][i][2] * v[r][i][2] + v[r][i][3] * v[r][i][3]; }
      ss = wave_sum(ss); rstd[r] = rsqrtf(ss * (1.0f / 1024.0f) + 1e-6f); }
    const float* n1w = p.in[9];
    float ga[32];
#pragma unroll
    for (int g = 0; g < 32; ++g) ga[g] = 0.f;
#pragma unroll
    for (int i = 0; i < 4; ++i) { const int col = 4 * lane + 256 * i;
      const f32x4 w = *(const f32x4*)(n1w + col), sc = *(const f32x4*)(md + 1024 + col), sh = *(const f32x4*)(md + col);
      const f32x4 ws1 = w * (sc + 1.0f);
      f32x4 h[2];
#pragma unroll
      for (int r = 0; r < 2; ++r) { h[r] = v[r][i] * rstd[r] * ws1 + sh;
        u32x2 o; o.x = pack2(h[r][0], h[r][1]); o.y = pack2(h[r][2], h[r][3]); *(u32x2*)((bf16_t*)(ws + OFF_HN) + (size_t)(row0 + r) * 1024 + col) = o; }
#pragma unroll
      for (int g = 0; g < 16; ++g) { const f32x4 wv = *(const LAS f32x4*)(wg + g * 1024 + col);
#pragma unroll
        for (int r = 0; r < 2; ++r) ga[r * 16 + g] += h[r][0] * wv[0] + h[r][1] * wv[1] + h[r][2] * wv[2] + h[r][3] * wv[3]; }
      asm volatile("" ::: "memory"); }
#pragma unroll
    for (int off = 16; off >= 1; off >>= 1) { const bool hi = (lane & off) != 0;
#pragma unroll
      for (int i = 0; i < off; ++i) { const float send = hi ? ga[i] : ga[i + off]; const float keep = hi ? ga[i + off] : ga[i]; ga[i] = keep + __shfl_xor(send, off); } }
    const float tot = ga[0] + __shfl_xor(ga[0], 32);
    if (lane < 32) ((float*)(ws + OFF_GT))[(size_t)row0 * 16 + lane] = tot + p.in[11][4096 + (lane & 15)];
  }
  __syncthreads();
  LAS float* w3s = (LAS float*)lds;
  for (int v = blockIdx.x; v < 320; v += gridDim.x) {
    const int tid = opaque_tid();
    const bool smp = v < 256; const int L = smp ? 2048 : 256; const int tt = smp ? (v >> 6) : 0, cgp = v & 63; const int t = tt * 512 + tid;
    { const f32x4 x = *(const f32x4*)(p.in[20] + (size_t)(tid >> 3) * 2048 + cgp * 32 + 4 * (tid & 7)); LAS float* wp = w3s + (4 * (tid & 7)) * 64 + (tid >> 3);
      wp[0] = x[0]; wp[64] = x[1]; wp[128] = x[2]; wp[192] = x[3]; }
    __syncthreads();
    if (t < L) {
      const float* H2 = (const float*)(ws + (smp ? OFF_H2S : OFF_H2C)) + (size_t)t * 64;
      f32x4 h2[16];
#pragma unroll
      for (int i = 0; i < 16; ++i) h2[i] = *(const f32x4*)(H2 + 4 * i);
      const float dist = fabsf((float)t - (float)(L / 2)) / (float)(L / 2);
      float* HF = (float*)(ws + (smp ? OFF_HFS : OFF_HFC)) + (size_t)(cgp * 32) * L + t;
#pragma unroll 1
      for (int j = 0; j < 32; ++j) {
        f32x4 a = {0.f, 0.f, 0.f, 0.f};
#pragma unroll
        for (int i = 0; i < 16; ++i) a += *(const LAS f32x4*)(w3s + j * 64 + 4 * i) * h2[i];
        const int c = (cgp * 32 + j) & 1023;
        const float dmin = -3.0701134573253946f, dmax = -15.350567286626973f;
        const float delta = fabsf(dmin + (dmax - dmin) * ((float)c / 1023.0f));
        HF[(size_t)j * L] = ((a[0] + a[1]) + (a[2] + a[3])) * __expf(-dist * delta); }
    }
    __syncthreads();
  }
  for (int u = (int)gridDim.x - 1 - (int)blockIdx.x; u < 128; u += gridDim.x)
    matvec9_unit<0>(mod + 3072, mod + 6144 + 3072, 6144, p.in[27], 4096, p.in[28], (float*)(ws + OFF_C1), 4096, u * 32, (LAS float*)lds);
}

__device__ __forceinline__ bf16x8 tr_frag(LP base, int k0, int m0, int pitch  , int l15, int g) {
  const int q = l15 >> 2, pp = l15 & 3;
  LP a = base + ((k0 + 8 * g + q) * pitch + m0 + 4 * pp) * 2;
  const s16x4 lo = __builtin_amdgcn_ds_read_tr16_b64_v4i16((LAS s16x4*)a);
  const s16x4 hi = __builtin_amdgcn_ds_read_tr16_b64_v4i16((LAS s16x4*)(a + 8 * pitch));
  bf16x8 r; r[0] = lo[0]; r[1] = lo[1]; r[2] = lo[2]; r[3] = lo[3]; r[4] = hi[0]; r[5] = hi[1]; r[6] = hi[2]; r[7] = hi[3]; return r;
}
__device__ __forceinline__ bf16x8 tr_at(LP lanebase, int coff  , int pitch_bytes) {
  const s16x4 lo = __builtin_amdgcn_ds_read_tr16_b64_v4i16((LAS s16x4*)(lanebase + coff));
  const s16x4 hi = __builtin_amdgcn_ds_read_tr16_b64_v4i16((LAS s16x4*)(lanebase + coff + 4 * pitch_bytes));
  bf16x8 r; r[0] = lo[0]; r[1] = lo[1]; r[2] = lo[2]; r[3] = lo[3]; r[4] = hi[0]; r[5] = hi[1]; r[6] = hi[2]; r[7] = hi[3]; return r;
}
constexpr int ML_K = 0, ML_V = 67584, ML_P = 86016, ML_C = 120832, ML_T = 157696, ML_TSZ = 1600;
constexpr int KP = 264, VP = 72, PP = 136, CP = 72;

__device__ void mlstm_item(const Params& p, LP lds, int item) {
  const int tid = opaque_tid(), wid = __builtin_amdgcn_readfirstlane(tid >> 6), lane = tid & 63, l15 = lane & 15, g = lane >> 4;
  const bool smp = item < 256; const int uu = smp ? (item >> 2) : ((item - 256) >> 2); const int sl = item & 3;
  const int b = uu >> 3, dir = (uu >> 2) & 1, head = uu & 3;
  const int S = smp ? SEQS : SEQC, nc = S >> 7; const int tok0 = smp ? NCTX + b * SEQS : b * SEQC;
  const bf16_t* qkv = (const bf16_t*)(p.ws + OFF_BIG);
  const float* GT = (const float*)(p.ws + OFF_GT);
  bf16_t* hout = (bf16_t*)((unsigned char*)p.out + (dir ? OUT_HB : OUT_H));
  const int sidx = (b * 2 + dir) * 4 + head;
  const int gi_col = dir * 8 + head, gf_col = dir * 8 + 4 + head;
  f32x4 Cacc[2][4], nacc[2]; float mst0;
  if (smp) {
    const float* C0 = p.in[2] + (size_t)sidx * 65536;
#pragma unroll
    for (int dt = 0; dt < 2; ++dt) {
#pragma unroll
      for (int vt = 0; vt < 4; ++vt) Cacc[dt][vt] = *(const f32x4*)(C0 + (size_t)((2 * wid + dt) * 16 + l15) * 256 + sl * 64 + 16 * vt + 4 * g);
      nacc[dt] = (f32x4){p.in[3][sidx * 256 + (2 * wid + dt) * 16 + l15], 0.f, 0.f, 0.f}; }
    mst0 = p.in[4][sidx];
  } else {
#pragma unroll
    for (int dt = 0; dt < 2; ++dt) {
#pragma unroll
      for (int vt = 0; vt < 4; ++vt) Cacc[dt][vt] = (f32x4){0.f, 0.f, 0.f, 0.f};
      nacc[dt] = (f32x4){0.f, 0.f, 0.f, 0.f}; }
    mst0 = 0.f;
  }
#define TOKC(cc, j) (dir ? (tok0 + S - 1 - ((cc) * 128 + (j))) : (tok0 + (cc) * 128 + (j)))
  const int rt = (wid < 4) ? wid : 11 - wid;
  const int jrow = 16 * rt + l15;
  bf16x8 qf[8]; u32x4 kreg[8], vreg[2]; float g4[4] = {0.f, 0.f, 0.f, 0.f};
#define ML_LOAD_Q(cc) do { const bf16_t* qp = qkv + (size_t)TOKC(cc, jrow) * 3072 + head * 256 + 8 * g; \
    _Pragma("unroll") for (int kk = 0; kk < 8; ++kk) qf[kk] = *(const bf16x8*)(qp + 32 * kk); } while (0)
#define ML_LOAD_KV(cc) do { \
    _Pragma("unroll") for (int i = 0; i < 8; ++i) { const int row = (tid >> 5) + 16 * i; kreg[i] = *(const u32x4*)(qkv + (size_t)TOKC(cc, row) * 3072 + 1024 + head * 256 + (tid & 31) * 8); } \
    _Pragma("unroll") for (int i = 0; i < 2; ++i) { const int row = (tid >> 3) + 64 * i; vreg[i] = *(const u32x4*)(qkv + (size_t)TOKC(cc, row) * 3072 + 2048 + head * 256 + sl * 64 + (tid & 7) * 8); } \
    if (wid == 0) { const float* g0 = GT + (size_t)TOKC(cc, 2 * lane) * 16; const float* g1 = GT + (size_t)TOKC(cc, 2 * lane + 1) * 16; g4[0] = g0[gi_col]; g4[1] = g0[gf_col]; g4[2] = g1[gi_col]; g4[3] = g1[gf_col]; } } while (0)
#define ML_SCAN(tabp, mcur, mnext) do { LAS float* T_ = (LAS float*)(tabp); \
    const float lf0 = fminf(g4[1], 0.f) - log1pf(__expf(-fabsf(g4[1]))), lf1 = fminf(g4[3], 0.f) - log1pf(__expf(-fabsf(g4[3]))); \
    float s_ = lf0 + lf1; \
    _Pragma("unroll") for (int o = 1; o < 64; o <<= 1) { const float t_ = __shfl_up(s_, o); if (lane >= o) s_ += t_; } \
    const float b1_ = s_, b0_ = s_ - lf1; const float u0_ = g4[0] - b0_, u1_ = g4[2] - b1_; \
    float mx_ = fmaxf(u0_, u1_); \
    _Pragma("unroll") for (int o = 1; o < 64; o <<= 1) { const float t_ = __shfl_up(mx_, o); if (lane >= o) mx_ = fmaxf(mx_, t_); } \
    float ex_ = __shfl_up(mx_, 1); if (lane == 0) ex_ = -INFINITY; \
    const float M0_ = fmaxf(mcur, fmaxf(ex_, u0_)), M1_ = fmaxf(mcur, mx_); \
    T_[2 * lane] = u0_; T_[2 * lane + 1] = u1_; T_[128 + 2 * lane] = M0_; T_[128 + 2 * lane + 1] = M1_; T_[256 + 2 * lane] = b0_; T_[256 + 2 * lane + 1] = b1_; \
    const float Ml_ = __shfl(M1_, 63), bl_ = __shfl(b1_, 63); \
    if (lane == 0) { T_[384] = mcur; T_[385] = Ml_; } \
    mnext = bl_ + Ml_; } while (0)
  float mw0 = mst0;
  ML_LOAD_Q(0); ML_LOAD_KV(0);
  if (wid == 0) { float mn; ML_SCAN(lds + ML_T, mw0, mn); mw0 = mn; }
  __syncthreads();
  float m_final = 0.f;
  for (int c = 0; c < nc; ++c) {
    LAS float* T = (LAS float*)(lds + ML_T + (c & 1) * ML_TSZ);
    const float mst = T[384], M_last = T[385];
#pragma unroll
    for (int i = 0; i < 8; ++i) { const int row = (tid >> 5) + 16 * i; *(LAS u32x4*)(lds + ML_K + (row * KP + (tid & 31) * 8) * 2) = kreg[i]; }
#pragma unroll
    for (int i = 0; i < 2; ++i) { const int row = (tid >> 3) + 64 * i; const float w = __expf(T[row] - M_last); const u32x4 v = vreg[i]; u32x4 o;
      o.x = pack2(bflo(v.x) * w, bfhi(v.x) * w); o.y = pack2(bflo(v.y) * w, bfhi(v.y) * w); o.z = pack2(bflo(v.z) * w, bfhi(v.z) * w); o.w = pack2(bflo(v.w) * w, bfhi(v.w) * w);
      *(LAS u32x4*)(lds + ML_V + (row * VP + (tid & 7) * 8) * 2) = o; }
    if (tid < 128) *(LAS unsigned short*)(lds + ML_V + (tid * VP + 64) * 2) = f2bf(__expf(T[tid] - M_last));
#pragma unroll
    for (int dt = 0; dt < 2; ++dt) {
#pragma unroll
      for (int vt = 0; vt < 4; ++vt) { u32x2 w; w.x = pack2(Cacc[dt][vt][0], Cacc[dt][vt][1]); w.y = pack2(Cacc[dt][vt][2], Cacc[dt][vt][3]);
        *(LAS u32x2*)(lds + ML_C + (((2 * wid + dt) * 16 + l15) * CP + 16 * vt + 4 * g) * 2) = w; }
      if (g == 0) *(LAS unsigned short*)(lds + ML_C + (((2 * wid + dt) * 16 + l15) * CP + 64) * 2) = f2bf(nacc[dt][0]); }
    const int qtok = TOKC(c, jrow);
    const bool more = (c + 1 < nc);
    __syncthreads();
    const float Mj = T[128 + jrow], bj = T[256 + jrow]; const float rf = __expf(M_last - Mj), w_inter = __expf(mst - Mj);
    int lq_ = (8 * g + (l15 >> 2)), lp_ = 4 * (l15 & 3); asm volatile("" : "+v"(lq_), "+v"(lp_));
    const LP cB = lds + ML_C + (lq_ * CP + lp_) * 2, vB = lds + ML_V + (lq_ * VP + lp_) * 2, kB = lds + ML_K + (lq_ * KP + lp_ + 32 * wid) * 2;
    const LP pB = lds + ML_P + (jrow * PP + 8 * g) * 2;
    for (int st = 0; st <= rt; ++st) {
      f32x4 s = {0.f, 0.f, 0.f, 0.f};
#pragma unroll
      for (int kk = 0; kk < 8; ++kk) { const bf16x8 kf = *(const LAS bf16x8*)(lds + ML_K + ((16 * st + l15) * KP + 32 * kk + 8 * g) * 2); s = __builtin_amdgcn_mfma_f32_16x16x32_bf16(kf, qf[kk], s, 0, 0, 0); }
      float pv[4];
#pragma unroll
      for (int i = 0; i < 4; ++i) pv[i] = ((16 * st + 4 * g + i) <= jrow) ? s[i] * rf : 0.f;
      u32x2 w; w.x = pack2(pv[0], pv[1]); w.y = pack2(pv[2], pv[3]);
      *(LAS u32x2*)(lds + ML_P + (jrow * PP + 16 * st + 4 * g) * 2) = w;
    }
    if ((rt & 1) == 0) { u32x2 z; z.x = 0u; z.y = 0u; *(LAS u32x2*)(lds + ML_P + (jrow * PP + 16 * (rt + 1) + 4 * g) * 2) = z; }
    if (more) ML_LOAD_KV(c + 1);
    asm volatile("s_waitcnt lgkmcnt(0)" ::: "memory");
    float rdd;
    { f32x4 a = {0.f, 0.f, 0.f, 0.f};
#pragma unroll
      for (int kk = 0; kk < 8; ++kk) { const bf16x8 cf = tr_at(cB, (32 * kk * CP + 64) * 2, CP * 2); a = __builtin_amdgcn_mfma_f32_16x16x32_bf16(cf, qf[kk], a, 0, 0, 0); }
      a *= w_inter;
      for (int k2 = 0; k2 <= (rt >> 1); ++k2) { const bf16x8 pf = *(const LAS bf16x8*)(pB + k2 * 64);
        const bf16x8 vf = tr_at(vB + k2 * (32 * VP * 2), 64 * 2, VP * 2); a = __builtin_amdgcn_mfma_f32_16x16x32_bf16(vf, pf, a, 0, 0, 0); }
      const float den = __shfl(a[0], l15); rdd = 1.0f / fmaxf(fabsf(den), __expf(-(bj + Mj))); }
#pragma unroll
    for (int vt = 0; vt < 4; ++vt) { f32x4 a = {0.f, 0.f, 0.f, 0.f};
#pragma unroll
      for (int kk = 0; kk < 8; ++kk) { const bf16x8 cf = tr_at(cB, (32 * kk * CP + 16 * vt) * 2, CP * 2); a = __builtin_amdgcn_mfma_f32_16x16x32_bf16(cf, qf[kk], a, 0, 0, 0); }
      a *= w_inter;
      for (int k2 = 0; k2 <= (rt >> 1); ++k2) { const bf16x8 pf = *(const LAS bf16x8*)(pB + k2 * 64);
        const bf16x8 vf = tr_at(vB + k2 * (32 * VP * 2), (16 * vt) * 2, VP * 2); a = __builtin_amdgcn_mfma_f32_16x16x32_bf16(vf, pf, a, 0, 0, 0); }
      a *= rdd; u32x2 w; w.x = pack2(a[0], a[1]); w.y = pack2(a[2], a[3]);
      *(u32x2*)(hout + (size_t)qtok * 1024 + head * 256 + sl * 64 + 16 * vt + 4 * g) = w; }
    if (more) ML_LOAD_Q(c + 1);
    const bool need_state = (!smp) || more;
    if (need_state) {
      const float decay = __expf(mst - M_last);
#pragma unroll
      for (int dt = 0; dt < 2; ++dt) {
#pragma unroll
        for (int vt = 0; vt < 4; ++vt) Cacc[dt][vt] *= decay;
        nacc[dt] *= decay; }
#pragma unroll
      for (int ks = 0; ks < 4; ++ks) {
        const bf16x8 kf0 = tr_at(kB, (32 * ks * KP) * 2, KP * 2), kf1 = tr_at(kB, (32 * ks * KP + 16) * 2, KP * 2);
#pragma unroll
        for (int vt = 0; vt < 4; ++vt) { const bf16x8 vf = tr_at(vB, (32 * ks * VP + 16 * vt) * 2, VP * 2);
          Cacc[0][vt] = __builtin_amdgcn_mfma_f32_16x16x32_bf16(vf, kf0, Cacc[0][vt], 0, 0, 0); Cacc[1][vt] = __builtin_amdgcn_mfma_f32_16x16x32_bf16(vf, kf1, Cacc[1][vt], 0, 0, 0); }
        { const bf16x8 vf = tr_at(vB, (32 * ks * VP + 64) * 2, VP * 2);
          nacc[0] = __builtin_amdgcn_mfma_f32_16x16x32_bf16(vf, kf0, nacc[0], 0, 0, 0); nacc[1] = __builtin_amdgcn_mfma_f32_16x16x32_bf16(vf, kf1, nacc[1], 0, 0, 0); }
      }
    }
    if (wid == 0 && more) { float mn; ML_SCAN(lds + ML_T + ((c + 1) & 1) * ML_TSZ, mw0, mn); mw0 = mn; }
    m_final = T[256 + 127] + M_last;
    __syncthreads();
  }
#undef ML_LOAD_Q
#undef ML_LOAD_KV
#undef ML_SCAN
#undef TOKC
  if (!smp) {
    float* oC = p.out + OUTF_C + (size_t)sidx * 65536;
#pragma unroll
    for (int dt = 0; dt < 2; ++dt) {
#pragma unroll
      for (int vt = 0; vt < 4; ++vt) *(f32x4*)(oC + (size_t)((2 * wid + dt) * 16 + l15) * 256 + sl * 64 + 16 * vt + 4 * g) = Cacc[dt][vt];
      if (sl == 0 && g == 0) p.out[OUTF_N + (size_t)sidx * 256 + (2 * wid + dt) * 16 + l15] = nacc[dt][0]; }
    if (sl == 0 && tid == 0) p.out[OUTF_M + sidx] = m_final;
  }
}

__device__ void combine_rows(const Params& p) {
  const int tid0 = opaque_tid(); const int wid = tid0 >> 6, lane = tid0 & 63;
  bf16_t* H = (bf16_t*)((unsigned char*)p.out + OUT_H); const bf16_t* HB = (const bf16_t*)((unsigned char*)p.out + OUT_HB); const float* nw = p.in[22];
  for (int unit = blockIdx.x; unit < 3072; unit += gridDim.x) {
    const int row = unit * 8 + wid; bf16_t* hp = H + (size_t)row * 1024 + 16 * lane; const bf16_t* bp = HB + (size_t)row * 1024 + 16 * lane;
    float v[16]; float ss = 0.f;
#pragma unroll
    for (int i = 0; i < 2; ++i) { const u32x4 a = *(const u32x4*)(hp + 8 * i), bq = *(const u32x4*)(bp + 8 * i);
      v[8 * i + 0] = bflo(a.x) + bflo(bq.x); v[8 * i + 1] = bfhi(a.x) + bfhi(bq.x); v[8 * i + 2] = bflo(a.y) + bflo(bq.y); v[8 * i + 3] = bfhi(a.y) + bfhi(bq.y);
      v[8 * i + 4] = bflo(a.z) + bflo(bq.z); v[8 * i + 5] = bfhi(a.z) + bfhi(bq.z); v[8 * i + 6] = bflo(a.w) + bflo(bq.w); v[8 * i + 7] = bfhi(a.w) + bfhi(bq.w); }
#pragma unroll
    for (int e = 0; e < 16; ++e) ss += v[e] * v[e];
    ss += __shfl_xor(ss, 1); ss += __shfl_xor(ss, 2); ss += __shfl_xor(ss, 4); ss += __shfl_xor(ss, 8);
    const float r = rsqrtf(ss * (1.0f / 256.0f) + 1e-6f);
#pragma unroll
    for (int i = 0; i < 2; ++i) { const f32x4 w0 = *(const f32x4*)(nw + 16 * lane + 8 * i), w1 = *(const f32x4*)(nw + 16 * lane + 8 * i + 4); u32x4 o;
      o.x = pack2(v[8 * i] * r * w0[0], v[8 * i + 1] * r * w0[1]); o.y = pack2(v[8 * i + 2] * r * w0[2], v[8 * i + 3] * r * w0[3]);
      o.z = pack2(v[8 * i + 4] * r * w1[0], v[8 * i + 5] * r * w1[1]); o.w = pack2(v[8 * i + 6] * r * w1[2], v[8 * i + 7] * r * w1[3]);
      *(u32x4*)(hp + 8 * i) = o; }
  }
}

constexpr int HY_WAVE = 18816, HY_HR = 0, HY_ZA = 8576, HY_ZB = 8576 + 5120;
__device__ void hyena_item(const Params& p, LP lds, int item) {
  const int tid = opaque_tid(), wid = __builtin_amdgcn_readfirstlane(tid >> 6), lane = tid & 63, n31 = lane & 31, hh = lane >> 5;
  const bool smp = item < 1024; const int it = smp ? item : item - 1024; const int bset = it >> 7, cgp = it & 127; const int c = cgp * 8 + wid;
  const int L = smp ? 2048 : 256, lgL = smp ? 11 : 8, nblk = L >> 5, lgnb = lgL - 5, ntok = smp ? 2048 : 1024, ntile = smp ? 2 : 1, dmax = L >> 6;
  const int tok0 = smp ? NCTX + bset * 2048 : bset * 1024;
  LP wl = lds + wid * HY_WAVE; LAS float* hr = (LAS float*)(wl + HY_HR);
  const float* HFp = (const float*)(p.ws + (smp ? OFF_HFS : OFF_HFC));
  const bf16_t* UT = (const bf16_t*)(p.ws + OFF_BIG);
  const float* cw = p.in[12]; const float* cbv = p.in[13]; const float* skp = p.in[21];
  { const int uc = 2048 + c; const float w0 = cw[uc], w1 = cw[3072 + uc], w2 = cw[6144 + uc], cb = cbv[uc]; const bf16_t* src = UT + (size_t)uc * NTOK + tok0;
    u32x4 vv[4]; float pvv[4], nxv[4];
#pragma unroll
    for (int i = 0; i < 4; ++i) { const int base = lane * 8 + 512 * i; vv[i] = (u32x4){0u, 0u, 0u, 0u}; pvv[i] = 0.f; nxv[i] = 0.f;
      if (base < ntok) { vv[i] = *(const u32x4*)(src + base); const int tl = base & (L - 1);
        if (tl != 0) pvv[i] = bf2f(src[base - 1]); if (tl + 8 != L) nxv[i] = bf2f(src[base + 8]); } }
#pragma unroll
    for (int i = 0; i < 4; ++i) { const int base = lane * 8 + 512 * i;
      if (base < ntok) { const u32x4 v = vv[i];
        float u[10]; u[0] = pvv[i]; u[1] = bflo(v.x); u[2] = bfhi(v.x); u[3] = bflo(v.y); u[4] = bfhi(v.y); u[5] = bflo(v.z); u[6] = bfhi(v.z); u[7] = bflo(v.w); u[8] = bfhi(v.w); u[9] = nxv[i];
        float o[8];
#pragma unroll
        for (int e = 0; e < 8; ++e) o[e] = cb + w0 * u[e] + w1 * u[e + 1] + w2 * u[e + 2];
        u32x4 w; w.x = pack2(o[0], o[1]); w.y = pack2(o[2], o[3]); w.z = pack2(o[4], o[5]); w.w = pack2(o[6], o[7]);
        *(LAS u32x4*)(wl + HY_ZA + ((base >> 5) * 40 + (base & 31)) * 2) = w; } } }
  const int HRP = L + 96;
  for (int ord = 0; ord < 2; ++ord) {
    { const float* src = HFp + (size_t)(ord * 1024 + c) * L; float sa = 0.f;
      f32x4 fv[8];
#pragma unroll
      for (int i = 0; i < 8; ++i) { const int q = lane + 64 * i; fv[i] = (4 * q < L) ? *(const f32x4*)(src + 4 * q) : (f32x4){0.f, 0.f, 0.f, 0.f}; }
#pragma unroll
      for (int i = 0; i < 8; ++i) sa += (fabsf(fv[i][0]) + fabsf(fv[i][1])) + (fabsf(fv[i][2]) + fabsf(fv[i][3]));
      sa = wave_sum(sa); const float inv = 1.0f / (sa + 1e-6f);
      asm volatile("s_waitcnt lgkmcnt(0)" ::: "memory");
      LAS bf16_t* E = (LAS bf16_t*)hr; LAS bf16_t* O = E + HRP;
#pragma unroll
      for (int i = 0; i < 8; ++i) { const int q = lane + 64 * i;
        if (4 * q < L) {
#pragma unroll
          for (int e = 0; e < 4; ++e) { const int yy = L - 1 - (4 * q + e); const bf16_t v = f2bf(fv[i][e] * inv); E[32 + yy] = v; O[31 + yy] = v; } } }
      if (lane < 32) { E[lane] = 0; E[32 + L + lane] = 0; O[31 + L + lane] = 0; if (lane < 31) O[lane] = 0; }
      if (lane < 33) O[HRP - 33 + lane] = 0;
      asm volatile("s_waitcnt lgkmcnt(0)" ::: "memory"); }
    LP zin = wl + (ord == 0 ? HY_ZA : HY_ZB); LP zout = wl + (ord == 0 ? HY_ZB : HY_ZA);
    const int gc = ord * 1024 + c; const float w0 = cw[gc], w1 = cw[3072 + gc], w2 = cw[6144 + gc], cb = cbv[gc], sk = skp[ord * 1024 + c];
    const bf16_t* gsrc = UT + (size_t)gc * NTOK + tok0;
    u32x4 gv[4]; unsigned gpv[4], gnx[4];
#pragma unroll
    for (int i = 0; i < 4; ++i) { const int base = lane * 8 + 512 * i; gv[i] = (u32x4){0u, 0u, 0u, 0u}; gpv[i] = 0u; gnx[i] = 0u;
      if (base < ntok) { gv[i] = *(const u32x4*)(gsrc + base); const int tl = base & (L - 1);
        if (tl != 0) gpv[i] = gsrc[base - 1]; if (tl + 8 != L) gnx[i] = gsrc[base + 8]; } }
    f32x16 accs[2];
#pragma unroll
    for (int o2 = 0; o2 < 2; ++o2)
#pragma unroll
      for (int r = 0; r < 16; ++r) accs[o2][r] = 0.f;
    LP fb = wl + HY_HR + ((n31 & 1) ? 0 : (HRP * 2 - 2)) + 2 * ((L >> 1) - 1 - n31 + 8 * hh + 32);
    int cbl[2], ca[2];
#pragma unroll
    for (int ot = 0; ot < 2; ++ot) { const int col = 32 * ot + n31; cbl[ot] = (col >> lgnb) << lgnb; ca[ot] = col & (nblk - 1); }
    const bool two = (ntile == 2);
    {
      LP zero = wl + HY_HR + 16 * hh;
      LP ap = fb + 64 * dmax;
      int bbr0 = ca[0] + dmax, bbr1 = ca[1] + dmax;
      LP bp0 = zin + ((cbl[0] + bbr0) * 40 + 8 * hh) * 2, bp1 = zin + ((cbl[1] + bbr1) * 40 + 8 * hh) * 2;
      for (int d = -dmax; d <= dmax; ++d) {
        u32x4 w0v, w1v;
        w0v.x = *(const LAS unsigned*)(ap); w0v.y = *(const LAS unsigned*)(ap + 4); w0v.z = *(const LAS unsigned*)(ap + 8); w0v.w = *(const LAS unsigned*)(ap + 12);
        w1v.x = *(const LAS unsigned*)(ap + 32); w1v.y = *(const LAS unsigned*)(ap + 36); w1v.z = *(const LAS unsigned*)(ap + 40); w1v.w = *(const LAS unsigned*)(ap + 44);
        const bf16x8 af0 = __builtin_bit_cast(bf16x8, w0v), af1 = __builtin_bit_cast(bf16x8, w1v);
        LP q0 = ((unsigned)bbr0 < (unsigned)nblk) ? bp0 : zero;
        const bf16x8 b00 = *(const LAS bf16x8*)q0, b01 = *(const LAS bf16x8*)(q0 + 32);
        accs[0] = __builtin_amdgcn_mfma_f32_32x32x16_bf16(af0, b00, accs[0], 0, 0, 0);
        accs[0] = __builtin_amdgcn_mfma_f32_32x32x16_bf16(af1, b01, accs[0], 0, 0, 0);
        if (two) {
          LP q1 = ((unsigned)bbr1 < (unsigned)nblk) ? bp1 : zero;
          const bf16x8 b10 = *(const LAS bf16x8*)q1, b11 = *(const LAS bf16x8*)(q1 + 32);
          accs[1] = __builtin_amdgcn_mfma_f32_32x32x16_bf16(af0, b10, accs[1], 0, 0, 0);
          accs[1] = __builtin_amdgcn_mfma_f32_32x32x16_bf16(af1, b11, accs[1], 0, 0, 0);
        }
        ap -= 64; bbr0 -= 1; bbr1 -= 1; bp0 -= 80; bp1 -= 80;
      }
    }
#pragma unroll
    for (int ot = 0; ot < 2; ++ot) {
      if (ot >= ntile) continue;
      const f32x16 acc = accs[ot];
#pragma unroll
      for (int rg = 0; rg < 4; ++rg) {
        const int zo = (((cbl[ot] + ca[ot]) * 40) + 8 * rg + 4 * hh) * 2;
        const u32x2 zv = *(const LAS u32x2*)(zin + zo);
        u32x2 w; w.x = pack2(acc[4 * rg] + sk * bflo(zv.x), acc[4 * rg + 1] + sk * bfhi(zv.x)); w.y = pack2(acc[4 * rg + 2] + sk * bflo(zv.y), acc[4 * rg + 3] + sk * bfhi(zv.y));
        *(LAS u32x2*)(zout + zo) = w;
      }
    }
    asm volatile("s_waitcnt lgkmcnt(0)" ::: "memory");
#pragma unroll
    for (int i = 0; i < 4; ++i) { const int base = lane * 8 + 512 * i;
      if (base < ntok) { const u32x4 v = gv[i];
        float u[10]; u[0] = bf2f(gpv[i]); u[1] = bflo(v.x); u[2] = bfhi(v.x); u[3] = bflo(v.y); u[4] = bfhi(v.y); u[5] = bflo(v.z); u[6] = bfhi(v.z); u[7] = bflo(v.w); u[8] = bfhi(v.w); u[9] = bf2f(gnx[i]);
        LP zp = zout + ((base >> 5) * 40 + (base & 31)) * 2; const u32x4 t = *(const LAS u32x4*)zp;
        float tv[8]; tv[0] = bflo(t.x); tv[1] = bfhi(t.x); tv[2] = bflo(t.y); tv[3] = bfhi(t.y); tv[4] = bflo(t.z); tv[5] = bfhi(t.z); tv[6] = bflo(t.w); tv[7] = bfhi(t.w);
        float o[8];
#pragma unroll
        for (int e = 0; e < 8; ++e) o[e] = (cb + w0 * u[e] + w1 * u[e + 1] + w2 * u[e + 2]) * tv[e];
        u32x4 w; w.x = pack2(o[0], o[1]); w.y = pack2(o[2], o[3]); w.z = pack2(o[4], o[5]); w.w = pack2(o[6], o[7]);
        *(LAS u32x4*)zp = w; } }
    asm volatile("s_waitcnt lgkmcnt(0)" ::: "memory");
  }
  __syncthreads();
  { bf16_t* YH = (bf16_t*)((unsigned char*)p.out + OUT_HB);
    for (int tl = tid; tl < ntok; tl += 512) {
      const int bl = tl >> lgL, tloc = tl & (L - 1); const int zo = ((((bl << lgnb) + (tloc >> 5)) * 40) + (tloc & 31)) * 2;
      unsigned short e[8];
#pragma unroll
      for (int w = 0; w < 8; ++w) e[w] = *(const LAS unsigned short*)(lds + w * HY_WAVE + HY_ZA + zo);
      u32x4 o; o.x = e[0] | ((unsigned)e[1] << 16); o.y = e[2] | ((unsigned)e[3] << 16); o.z = e[4] | ((unsigned)e[5] << 16); o.w = e[6] | ((unsigned)e[7] << 16);
      *(u32x4*)(YH + (size_t)(tok0 + tl) * 1024 + cgp * 8) = o; } }
  __syncthreads();
}

__device__ void final_norm(const Params& p) {
  const int tid0 = opaque_tid(); const int wid = tid0 >> 6, lane = tid0 & 63; const float* fw = p.in[31]; const float* ssq = (const float*)(p.ws + OFF_SSQ2);
  for (int unit = blockIdx.x; unit < 3072; unit += gridDim.x) {
    const int row = unit * 8 + wid; float* xr = p.out + (size_t)row * 1024; const float* sp = ssq + (size_t)row * 16;
    const f32x4 st = *(const f32x4*)sp + *(const f32x4*)(sp + 4) + *(const f32x4*)(sp + 8) + *(const f32x4*)(sp + 12);
    const float rstd = rsqrtf((st[0] + st[1] + st[2] + st[3]) * (1.0f / 1024.0f) + 1e-6f);
#pragma unroll
    for (int i = 0; i < 4; ++i) { const int col = 4 * lane + 256 * i; const f32x4 v = *(const f32x4*)(xr + col) * rstd * *(const f32x4*)(fw + col); *(f32x4*)(xr + col) = v; }
  }
}

__global__ void __launch_bounds__(512, 2) mega(Params p) {
  extern __shared__ __attribute__((aligned(16))) unsigned char shm[];
  LP lds = (LP)shm;
  cg::grid_group grid = cg::this_grid();
  volatile LAS unsigned* xst = (volatile LAS unsigned*)(lds + LDS_BYTES - 16);
  if (threadIdx.x == 0) { xst[0] = 0u; xst[1] = 0u; }
  __syncthreads();
  const XcdBarrier xb = xcd_barrier_post((unsigned*)(p.ws + OFF_BAR), xst);
  unsigned char* ws = p.ws;
  const bf16_t* WT = (const bf16_t*)(ws + OFF_WT); const bf16_t* HN = (const bf16_t*)(ws + OFF_HN); bf16_t* BIG = (bf16_t*)(ws + OFF_BIG);
  bf16_t* Hb = (bf16_t*)((unsigned char*)p.out + OUT_H); bf16_t* YH = (bf16_t*)((unsigned char*)p.out + OUT_HB);
  const float* mod = (const float*)(ws + OFF_MOD);
  phase0(p, lds);
  if (gridDim.y == 7u) grid.sync();
  xcd_barrier(xb);
  phase1(p, lds);
  weight_tiles(p, lds);
  xcd_barrier(xb);
  { EpiQKV e; e.O = BIG; e.bias = p.in[11]; run_gemm(lds, HN, WT, NTOK, 3072, 1024, e); }
  xcd_barrier(xb);
  for (int item = blockIdx.x; item < 1280; item += gridDim.x) mlstm_item(p, lds, item);
  xcd_barrier(xb);
  combine_rows(p);
  { EpiUT e; e.O = BIG; e.bias = p.in[11] + 4112; run_gemm(lds, WT + (size_t)3072 * 1024, HN, 3072, NTOK, 1024, e); }
  xcd_barrier(xb);
  for (int item = blockIdx.x; item < 2048; item += gridDim.x) hyena_item(p, lds, item);
  xcd_barrier(xb);
  { EpiGates e; e.H = Hb; e.G = BIG; e.b_in = p.in[11]; run_gemm(lds, HN, WT + (size_t)6144 * 1024, NTOK, 3072, 1024, e); }
  xcd_barrier(xb);
  bf16_t* T = BIG + (size_t)NTOK * 2048;
  { EpiMerge<0> e; e.T = T; e.G = BIG; run_gemm(lds, Hb, (const bf16_t*)(ws + OFF_WBM), NTOK, 1024, 1024, e); }
  { EpiMerge<1> e; e.T = T; e.G = BIG; run_gemm(lds, YH, (const bf16_t*)(ws + OFF_WBH), NTOK, 1024, 1024, e); }
  xcd_barrier(xb);
  { EpiOut e; e.xp = p.in[0]; e.xs = p.in[1]; e.per = (const float*)(ws + OFF_PER); e.pec = (const float*)(ws + OFF_PEC); e.mod = mod; e.n2w = p.in[26];
    e.X1 = p.out; e.A2 = (bf16_t*)(ws + OFF_HN); e.ssq = (float*)(ws + OFF_SSQ1); run_gemm(lds, T, (const bf16_t*)(ws + OFF_WOUT), NTOK, 1024, 1024, e); }
  xcd_barrier(xb);
#define FFN_HALF(ROW0) do { \
    { EpiFF1 e; e.row0 = (ROW0); e.ssq = (const float*)(p.ws + OFF_SSQ1); e.c1 = (const float*)(p.ws + OFF_C1); e.Hd = (bf16_t*)(p.ws + OFF_BIG); \
      run_gemm(lds, (const bf16_t*)(p.ws + OFF_HN) + (size_t)(ROW0) * 1024, (const bf16_t*)(p.ws + OFF_W1T), 12288, 4096, 1024, e); } \
    xcd_barrier(xb); \
    { EpiFF2 e; e.row0 = (ROW0); e.mod = (const float*)(p.ws + OFF_MOD); e.b2 = p.in[30]; e.X = p.out; e.ssq = (float*)(p.ws + OFF_SSQ2); \
      run_gemm(lds, (const bf16_t*)(p.ws + OFF_BIG), (const bf16_t*)(p.ws + OFF_W2T), 12288, 1024, 4096, e); } \
    xcd_barrier(xb); } while (0)
  FFN_HALF(0);
  FFN_HALF(12288);
#undef FFN_HALF
  final_norm(p);
}

extern "C" void kernel_launch(void* const* d_in, const int* in_sizes, int n_in, void* d_out, int out_size, void* d_ws, size_t ws_size, hipStream_t stream) {
  static int grid_blocks = 0;
  if (!grid_blocks) {
    int dev = 0, cus = 0, per_cu = 0;
    hipGetDevice(&dev);
    hipDeviceGetAttribute(&cus, hipDeviceAttributeMultiprocessorCount, dev);
    hipFuncSetAttribute((const void*)mega, hipFuncAttributeMaxDynamicSharedMemorySize, LDS_BYTES);
    hipOccupancyMaxActiveBlocksPerMultiprocessor(&per_cu, (const void*)mega, 512, LDS_BYTES);
    if (per_cu < 1) { fprintf(stderr, "kernel_launch: occupancy query reports %d blocks per CU\n", per_cu); grid_blocks = -1; }
    else grid_blocks = cus;
    if (n_in != 32 || ws_size < WS_END) { fprintf(stderr, "kernel_launch: unexpected n_in %d / ws_size %zu (need %zu)\n", n_in, ws_size, (size_t)WS_END); grid_blocks = -1; }
  }
  if (grid_blocks < 0) return;
  hipMemsetAsync((unsigned char*)d_ws + OFF_BAR, 0, 3456 * 4, stream);
  Params p{};
  for (int i = 0; i < 32; ++i) p.in[i] = (const float*)d_in[i];
  p.out = (float*)d_out; p.ws = (unsigned char*)d_ws;
  void* args[] = {&p};
  hipError_t e = hipLaunchCooperativeKernel((void*)mega, dim3(grid_blocks), dim3(512), args, LDS_BYTES, stream);
  if (e != hipSuccess) fprintf(stderr, "cooperative launch failed: %s (grid %d)\n", hipGetErrorString(e), grid_blocks);
}
```

```cpp
#include <hip/hip_runtime.h>
#include <hip/hip_cooperative_groups.h>
#include <cstdio>
#include <cstdint>
namespace cg = cooperative_groups;

#define LAS __attribute__((address_space(3)))
typedef LAS unsigned char* LP;
typedef unsigned short bf16_t;
typedef short bf16x8 __attribute__((ext_vector_type(8)));
typedef short s16x4 __attribute__((ext_vector_type(4)));
typedef float f32x4 __attribute__((ext_vector_type(4)));
typedef float f32x16 __attribute__((ext_vector_type(16)));
typedef unsigned u32x4 __attribute__((ext_vector_type(4)));
typedef unsigned u32x2 __attribute__((ext_vector_type(2)));

constexpr int DM = 1024, NTOK = 24576, NCTX = 8192, SEQC = 256, SEQS = 2048, INC = 9232;
constexpr int LDS_BYTES = 160 * 1024;
constexpr size_t OFF_WT = 0;
constexpr size_t OFF_WBM = 18874368, OFF_WBH = 20971520, OFF_WOUT = 23068672, OFF_W1T = 25165824, OFF_W2T = 33554432;
constexpr size_t OFF_HN = 41943040;
constexpr size_t OFF_BIG = 92274688;
constexpr size_t OFF_SM = 243269632;
constexpr size_t OFF_MOD = OFF_SM;
constexpr size_t OFF_C1 = OFF_MOD + 221184;
constexpr size_t OFF_H2S = OFF_C1 + 147456;
constexpr size_t OFF_H2C = OFF_H2S + 524288;
constexpr size_t OFF_PER = OFF_H2C + 65536;
constexpr size_t OFF_PEC = OFF_PER + 65536;
constexpr size_t OFF_GT = OFF_PEC + 131072;
constexpr size_t OFF_SSQ1 = OFF_GT + 1572864;
constexpr size_t OFF_SSQ2 = OFF_SSQ1 + 1572864;
constexpr size_t OFF_HFS = OFF_SSQ2 + 1572864;
constexpr size_t OFF_HFC = OFF_HFS + 16777216;
constexpr size_t OFF_BAR = OFF_HFC + 2097152;
constexpr size_t WS_END = OFF_BAR + 3456 * 4;
constexpr size_t OUT_H = 0, OUT_HB = 50331648;
constexpr size_t OUTF_C = 25165824, OUTF_N = 41943040, OUTF_M = 42008576;

struct Params { const float* in[32]; float* out; unsigned char* ws; };

__device__ __forceinline__ bf16_t f2bf(float f) { unsigned u = __float_as_uint(f); u += 0x7FFFu + ((u >> 16) & 1u); return (bf16_t)(u >> 16); }
__device__ __forceinline__ float bf2f(unsigned b) { return __uint_as_float(b << 16); }
__device__ __forceinline__ unsigned pack2(float lo, float hi) { return (unsigned)f2bf(lo) | ((unsigned)f2bf(hi) << 16); }
__device__ __forceinline__ float bflo(unsigned w) { return __uint_as_float(w << 16); }
__device__ __forceinline__ float bfhi(unsigned w) { return __uint_as_float(w & 0xffff0000u); }
__device__ __forceinline__ float sigmoidf_(float x) { return 1.0f / (1.0f + __expf(-x)); }
__device__ __forceinline__ int opaque_tid() { int t = threadIdx.x; asm volatile("" : "+v"(t)); return t; }
__device__ __forceinline__ float wave_sum(float v) {
#pragma unroll
  for (int o = 32; o >= 1; o >>= 1) v += __shfl_xor(v, o);
  return v;
}


#define XB_TMO      128
#define XB_XCNT(j)  (256  + 64 * (j))
#define XB_XSUB(j)  (1280 + 64 * (j))
#define XB_XGEN(j)  (2304 + 64 * (j))
#define XB_TOP      3328
#define XB_TOPGEN   3392
#define XCD_BAR_WORDS 3456
#define XB_SPIN_CAP (1u << 18)
__device__ __forceinline__ unsigned xb_ld(unsigned* p)              { return __hip_atomic_load(p, __ATOMIC_RELAXED, __HIP_MEMORY_SCOPE_AGENT); }
__device__ __forceinline__ unsigned xb_add(unsigned* p, unsigned v) { return __hip_atomic_fetch_add(p, v, __ATOMIC_RELAXED, __HIP_MEMORY_SCOPE_AGENT); }
__device__ __forceinline__ unsigned xb_xcc_id() { return (unsigned)__builtin_amdgcn_s_getreg((3 << 11) | 20) & 0xFu; }
#define XB_SPIN(cond, bar) do { unsigned _sp = 0; while (cond) { __builtin_amdgcn_s_sleep(1); \
    if ((++_sp & 255u) == 0u) { if (xb_ld(&(bar)[XB_TMO])) break; if (_sp > XB_SPIN_CAP) { atomicAdd(&(bar)[XB_TMO], 1u); break; } } } } while (0)
struct XcdBarrier { unsigned* bar; unsigned x; volatile LAS unsigned* st; };
__device__ __forceinline__ XcdBarrier xcd_barrier_post(unsigned* bar, volatile LAS unsigned* st) {
  XcdBarrier b; b.bar = bar; b.x = xb_xcc_id(); b.st = st;
  if (threadIdx.x == 0) (void)xb_add(&bar[XB_XCNT(b.x)], 1u);
  return b;
}
__device__ __forceinline__ void xcd_barrier_complete(unsigned* bar, unsigned x, unsigned& nloc, unsigned& nx) {
  const unsigned G = gridDim.x * gridDim.y * gridDim.z;
  unsigned sum, cnt, mine, sp = 0u;
  for (;;) {
    sum = 0u; cnt = 0u; mine = 0u;
#pragma unroll
    for (unsigned j = 0; j < 16; ++j) { const unsigned c = xb_ld(&bar[XB_XCNT(j)]); sum += c; cnt += (c > 0u) ? 1u : 0u; mine = (j == x) ? c : mine; }
    if (sum == G) break;
    __builtin_amdgcn_s_sleep(1);
    if ((++sp & 255u) == 0u) { if (xb_ld(&bar[XB_TMO])) break; if (sp > XB_SPIN_CAP) { atomicAdd(&bar[XB_TMO], 1u); break; } }
  }
  nloc = mine > 0u ? mine : 1u; nx = cnt > 0u ? cnt : 1u;
}
__device__ __forceinline__ void xcd_barrier(const XcdBarrier& b) {
  asm volatile("s_waitcnt vmcnt(0)" ::: "memory");
  __syncthreads();
  if (threadIdx.x == 0) {
    unsigned* bar = b.bar;
    __builtin_amdgcn_s_waitcnt(0);
    unsigned nloc = b.st[0], nx = b.st[1];
    if (nloc == 0u) { xcd_barrier_complete(bar, b.x, nloc, nx); b.st[0] = nloc; b.st[1] = nx; }
    const unsigned old = xb_add(&bar[XB_XSUB(b.x)], 1u);
    const unsigned gen = old / nloc;
    if (old + 1u == (gen + 1u) * nloc) {
      __builtin_amdgcn_fence(__ATOMIC_RELEASE, "agent");
      asm volatile("s_waitcnt vmcnt(0)" ::: "memory");
      const unsigned og = xb_add(&bar[XB_TOP], 1u);
      const unsigned tg = og / nx;
      if (og + 1u == (tg + 1u) * nx) xb_add(&bar[XB_TOPGEN], 1u);
      else XB_SPIN(xb_ld(&bar[XB_TOPGEN]) == tg, bar);
      __builtin_amdgcn_fence(__ATOMIC_ACQUIRE, "agent");
      xb_add(&bar[XB_XGEN(b.x)], 1u);
      asm volatile("s_waitcnt vmcnt(0)" ::: "memory");
    } else {
      XB_SPIN(xb_ld(&bar[XB_XGEN(b.x)]) == gen, bar);
      __builtin_amdgcn_fence(__ATOMIC_ACQUIRE, "agent");
      asm volatile("s_waitcnt vmcnt(0)" ::: "memory");
    }
  }
  __syncthreads();
}

namespace pg8 {
constexpr int BM = 256, BK = 64, HALF = 128, HTB = HALF * BK * 2, STAGE_BYTES = 8 * HTB, NXCD = 8, WGM = 8;
__host__ __device__ __forceinline__ int lds_byte(int r, int c) { const int st = (r >> 4) * 2 + (c >> 5), rr = r & 15, cc = c & 31, ob = rr * 64 + cc * 2; return st * 1024 + (ob ^ (((ob >> 9) & 1) << 5)); }
__host__ __device__ __forceinline__ void stage_rc(int b, int& R, int& C) { const int st = b / 1024, sb = b % 1024, swz = sb ^ (((sb >> 9) & 1) << 5); R = (st >> 1) * 16 + swz / 64; C = (st & 1) * 32 + (swz % 64) / 2; }
struct Unit { int pm, pn; };
struct Gemm { const bf16_t* A; const bf16_t* Bt; int M, N, K; };
struct StaticOrder {
  int nM, nN, nwg, G, c;
  __device__ void init(int M, int N, int G_, int c_) { nM = M / BM; nN = N / BM; nwg = nM * nN; G = G_; c = c_; }
  __device__ bool next(int i, Unit& u) const {
    const long L = (long)i * G + c; if (L >= nwg) return false;
    int wgid = (int)L; { const int q = nwg / NXCD, r = nwg % NXCD, xcd = wgid % NXCD, off = wgid / NXCD; wgid = (xcd < r ? xcd * (q + 1) : r * (q + 1) + (xcd - r) * q) + off; }
    const int nig = WGM * nN, gid = wgid / nig, fm = gid * WGM, gsz = (nM - fm) < WGM ? (nM - fm) : WGM;
    u.pm = fm + ((wgid % nig) % gsz); u.pn = (wgid % nig) / gsz; return true;
  }
};

template <class Epi>
__device__ __forceinline__ void gemm_phase(LP lds, const Gemm g, const StaticOrder& S, const Epi& E) {
  int tid_ = threadIdx.x; asm volatile("" : "+v"(tid_));
  const int tid = tid_, wid = __builtin_amdgcn_readfirstlane(tid >> 6), lane = tid & 63, wr = wid >> 2, wc = wid & 3, fr = lane & 15, fq = lane >> 4;
  const int K = g.K, nt = K / BK;
  unsigned voffA[2], voffB[2];
#pragma unroll
  for (int i = 0; i < 2; ++i) { int R, C; stage_rc(tid * 16 + i * 8192, R, C); voffA[i] = (unsigned)(R * K + C) * 2u; voffB[i] = voffA[i]; }
  const size_t kstep = (size_t)(BK * 2);
  const size_t hstep = (size_t)HALF * K * 2;
  const size_t tstep = 2 * hstep;
  const unsigned ldsw = (unsigned)wid * 1024u;
  const int aoff = lds_byte(wr * 64 + fr, fq * 8), boff = lds_byte(wc * 32 + fr, fq * 8);
#define PG8_SA(b, h) (((b) * 2 + (h)) * HTB)
#define PG8_SB(b, h) ((4 + (b) * 2 + (h)) * HTB)
#define PG8_STAGE(bufoff, gbase, voff) do { _Pragma("unroll") for (int _i = 0; _i < 2; ++_i) \
    __builtin_amdgcn_global_load_lds((const unsigned*)((const char*)(gbase) + (voff)[_i]), (LAS unsigned*)(lds + (bufoff) + ldsw + _i * 8192), 16, 0, 0); } while (0)
#define PG8_LDA(dst, b, h) do { _Pragma("unroll") for (int m = 0; m < 4; ++m) _Pragma("unroll") for (int k = 0; k < 2; ++k) dst[m][k] = *(const LAS bf16x8*)(lds + PG8_SA(b, h) + aoff + m * 2048 + k * 1024); } while (0)
#define PG8_LDB(dst, b, h) do { _Pragma("unroll") for (int n = 0; n < 2; ++n) _Pragma("unroll") for (int k = 0; k < 2; ++k) dst[n][k] = *(const LAS bf16x8*)(lds + PG8_SB(b, h) + boff + n * 2048 + k * 1024); } while (0)
#define PG8_MMA(ai, bj, At, Bt) do { __builtin_amdgcn_s_setprio(1); _Pragma("unroll") for (int m = 0; m < 4; ++m) _Pragma("unroll") for (int n = 0; n < 2; ++n) _Pragma("unroll") for (int k = 0; k < 2; ++k) \
    acc[ai][bj][m][n] = __builtin_amdgcn_mfma_f32_16x16x32_bf16(Bt[n][k], At[m][k], acc[ai][bj][m][n], 0, 0, 0); __builtin_amdgcn_s_setprio(0); } while (0)
#define PG8_WAIT_V(n) asm volatile("s_waitcnt vmcnt(" #n ")" ::: "memory")
#define PG8_WAIT_L(n) asm volatile("s_waitcnt lgkmcnt(" #n ")" ::: "memory")
#define PG8_BAR __builtin_amdgcn_s_barrier()
#define PG8_SCHED __builtin_amdgcn_sched_barrier(0)
  Unit cur, nxt; int ui = 0;
  if (!S.next(0, cur)) return;
  f32x4 acc[2][2][4][2];
#pragma unroll
  for (int a = 0; a < 2; ++a)
#pragma unroll
    for (int b = 0; b < 2; ++b)
#pragma unroll
      for (int m = 0; m < 4; ++m)
#pragma unroll
        for (int n = 0; n < 2; ++n) acc[a][b][m][n] = (f32x4){0.f, 0.f, 0.f, 0.f};
  bf16x8 At[4][2], B0[2][2], B1[2][2];
  const char* cA = (const char*)g.A + (size_t)cur.pm * tstep; const char* cB = (const char*)g.Bt + (size_t)cur.pn * tstep;
  PG8_STAGE(PG8_SB(0, 0), cB, voffB); PG8_STAGE(PG8_SA(0, 0), cA, voffA); PG8_STAGE(PG8_SB(0, 1), cB + hstep, voffB); PG8_STAGE(PG8_SA(0, 1), cA + hstep, voffA);
  if (wr == 1) PG8_BAR;
  PG8_WAIT_V(4); PG8_BAR;
  PG8_STAGE(PG8_SB(1, 0), cB + kstep, voffB); PG8_STAGE(PG8_SA(1, 0), cA + kstep, voffA); PG8_STAGE(PG8_SB(1, 1), cB + hstep + kstep, voffB);
  PG8_WAIT_V(6); PG8_BAR;
  for (;;) {
    const bool has_next = S.next(ui + 1, nxt);
    const char* nA = has_next ? (const char*)g.A + (size_t)nxt.pm * tstep : cA; const char* nB = has_next ? (const char*)g.Bt + (size_t)nxt.pn * tstep : cB;
    for (int t = 0; t < nt; t += 2) {
      const bool last = (t == nt - 2);
      const char* a1 = cA + (size_t)(t + 1) * kstep;
      const char* a2 = last ? nA : cA + (size_t)(t + 2) * kstep; const char* b2 = last ? nB : cB + (size_t)(t + 2) * kstep;
      const char* a3 = a2 + kstep; const char* b3 = b2 + kstep;
      PG8_LDB(B0, 0, 0); PG8_SCHED; PG8_LDA(At, 0, 0); PG8_STAGE(PG8_SA(1, 1), a1 + hstep, voffA);
      PG8_WAIT_L(8); PG8_BAR; PG8_WAIT_L(0); PG8_MMA(0, 0, At, B0); PG8_BAR; PG8_SCHED;
      PG8_LDB(B1, 0, 1); PG8_STAGE(PG8_SB(0, 0), b2, voffB);
      PG8_BAR; PG8_WAIT_L(0); PG8_MMA(0, 1, At, B1); PG8_BAR;
      PG8_LDA(At, 0, 1); PG8_STAGE(PG8_SA(0, 0), a2, voffA);
      PG8_BAR; PG8_WAIT_L(0); PG8_MMA(1, 0, At, B0); PG8_BAR; PG8_SCHED;
      PG8_STAGE(PG8_SB(0, 1), b2 + hstep, voffB);
      PG8_WAIT_V(6); PG8_BAR; PG8_MMA(1, 1, At, B1); PG8_BAR;
      PG8_LDB(B0, 1, 0); PG8_SCHED; PG8_LDA(At, 1, 0); PG8_STAGE(PG8_SA(0, 1), a2 + hstep, voffA);
      PG8_WAIT_L(8); PG8_BAR; PG8_WAIT_L(0); PG8_MMA(0, 0, At, B0); PG8_BAR; PG8_SCHED;
      PG8_LDB(B1, 1, 1); PG8_STAGE(PG8_SB(1, 0), b3, voffB);
      PG8_BAR; PG8_WAIT_L(0); PG8_MMA(0, 1, At, B1); PG8_BAR;
      PG8_LDA(At, 1, 1); PG8_STAGE(PG8_SA(1, 0), a3, voffA);
      PG8_BAR; PG8_WAIT_L(0); PG8_MMA(1, 0, At, B0); PG8_BAR; PG8_SCHED;
      PG8_STAGE(PG8_SB(1, 1), b3 + hstep, voffB);
      PG8_WAIT_V(6); PG8_BAR; PG8_MMA(1, 1, At, B1); PG8_BAR;
    }
    { int fr2 = fr, fq2 = fq; asm volatile("" : "+v"(fr2), "+v"(fq2)); E(acc, cur, wr, wc, fr2, fq2); }
    if (!has_next) break;
#pragma unroll
    for (int a = 0; a < 2; ++a)
#pragma unroll
      for (int b = 0; b < 2; ++b)
#pragma unroll
        for (int m = 0; m < 4; ++m)
#pragma unroll
          for (int n = 0; n < 2; ++n) acc[a][b][m][n] = (f32x4){0.f, 0.f, 0.f, 0.f};
    cur = nxt; cA = nA; cB = nB; ++ui;
  }
  PG8_WAIT_V(0);
  if (wr == 0) PG8_BAR;
  PG8_BAR;
#undef PG8_SA
#undef PG8_SB
#undef PG8_STAGE
#undef PG8_LDA
#undef PG8_LDB
#undef PG8_MMA
#undef PG8_WAIT_V
#undef PG8_WAIT_L
#undef PG8_BAR
#undef PG8_SCHED
}
}
using pg8::Unit;
typedef f32x4 AccT[2][2][4][2];

#define EPI_ROW(ai, m) (u.pm * 256 + (ai) * 128 + wr * 64 + (m) * 16 + fr)
#define EPI_COL(bj, n) (u.pn * 256 + (bj) * 128 + wc * 32 + (n) * 16 + 4 * fq)
#define EPI_LOOP_ROWS _Pragma("unroll") for (int ai = 0; ai < 2; ++ai) _Pragma("unroll") for (int m = 0; m < 4; ++m)
#define EPI_LOOP_COLS _Pragma("unroll") for (int bj = 0; bj < 2; ++bj) _Pragma("unroll") for (int n = 0; n < 2; ++n)

__device__ __forceinline__ int cond_of_row(int row) { return row < NCTX ? 0 : 1 + ((row - NCTX) >> 11); }

struct EpiQKV {
  bf16_t* O; const float* bias;
  __device__ __forceinline__ void operator()(const AccT& acc, const Unit& u, int wr, int wc, int fr, int fq) const {
    const float sc = (u.pn < 4) ? 0.0625f : 1.0f;
    EPI_LOOP_COLS { const int col = EPI_COL(bj, n); const f32x4 bv = *(const f32x4*)(bias + col);
      EPI_LOOP_ROWS { const int row = EPI_ROW(ai, m); const f32x4 v = (acc[ai][bj][m][n] + bv) * sc;
        u32x2 w; w.x = pack2(v[0], v[1]); w.y = pack2(v[2], v[3]); *(u32x2*)(O + (size_t)row * 3072 + col) = w; } }
  }
};
struct EpiUT {
  bf16_t* O; const float* bias;
  __device__ __forceinline__ void operator()(const AccT& acc, const Unit& u, int wr, int wc, int fr, int fq) const {
    EPI_LOOP_ROWS { const int row = EPI_ROW(ai, m); const float bv = bias[row];
      EPI_LOOP_COLS { const int col = EPI_COL(bj, n); const f32x4 v = acc[ai][bj][m][n] + bv;
        u32x2 w; w.x = pack2(v[0], v[1]); w.y = pack2(v[2], v[3]); *(u32x2*)(O + (size_t)row * NTOK + col) = w; } }
  }
};
struct EpiGates {
  bf16_t* H; bf16_t* G; const float* b_in;
  __device__ __forceinline__ void operator()(const AccT& acc, const Unit& u, int wr, int wc, int fr, int fq) const {
    const bool og = u.pn < 4;
    EPI_LOOP_COLS { const int col = EPI_COL(bj, n); const f32x4 bv = *(const f32x4*)(b_in + (og ? 3072 + col : 7184 + (col - 1024)));
      EPI_LOOP_ROWS { const int row = EPI_ROW(ai, m); const f32x4 a = acc[ai][bj][m][n] + bv;
        f32x4 s; s[0] = sigmoidf_(a[0]); s[1] = sigmoidf_(a[1]); s[2] = sigmoidf_(a[2]); s[3] = sigmoidf_(a[3]);
        if (og) { bf16_t* hp = H + (size_t)row * 1024 + col; const u32x2 hv = *(const u32x2*)hp;
          u32x2 w; w.x = pack2(bflo(hv.x) * s[0], bfhi(hv.x) * s[1]); w.y = pack2(bflo(hv.y) * s[2], bfhi(hv.y) * s[3]); *(u32x2*)hp = w; }
        else { u32x2 w; w.x = pack2(s[0], s[1]); w.y = pack2(s[2], s[3]); *(u32x2*)(G + (size_t)row * 2048 + (col - 1024)) = w; } } }
  }
};
template <int SECOND> struct EpiMerge {
  bf16_t* T; const bf16_t* G;
  __device__ __forceinline__ void operator()(const AccT& acc, const Unit& u, int wr, int wc, int fr, int fq) const {
    EPI_LOOP_ROWS { const int row = EPI_ROW(ai, m);
      EPI_LOOP_COLS { const int col = EPI_COL(bj, n); const f32x4 a = acc[ai][bj][m][n];
        const u32x2 gv = *(const u32x2*)(G + (size_t)row * 2048 + SECOND * 1024 + col);
        f32x4 v; v[0] = bflo(gv.x) * a[0]; v[1] = bfhi(gv.x) * a[1]; v[2] = bflo(gv.y) * a[2]; v[3] = bfhi(gv.y) * a[3];
        bf16_t* tp = T + (size_t)row * 1024 + col;
        if (SECOND) { const u32x2 tv = *(const u32x2*)tp; v[0] += bflo(tv.x); v[1] += bfhi(tv.x); v[2] += bflo(tv.y); v[3] += bfhi(tv.y); }
        u32x2 w; w.x = pack2(v[0], v[1]); w.y = pack2(v[2], v[3]); *(u32x2*)tp = w; } }
  }
};
struct EpiOut {
  const float* xp; const float* xs; const float* per; const float* pec; const float* mod; const float* n2w; float* X1; bf16_t* A2; float* ssq;
  __device__ __forceinline__ void operator()(const AccT& acc, const Unit& u, int wr, int wc, int fr, int fq) const {
    const int cb = cond_of_row(u.pm * 256); const float* md = mod + cb * 6144;
    EPI_LOOP_ROWS { const int row = EPI_ROW(ai, m); float ss = 0.f;
      EPI_LOOP_COLS { const int col = EPI_COL(bj, n); const f32x4 a = acc[ai][bj][m][n];
        f32x4 x0;
        if (row < NCTX) x0 = *(const f32x4*)(xp + (size_t)row * 1024 + col);
        else { const int r2 = row - NCTX, t = r2 & 2047; x0 = *(const f32x4*)(xs + (size_t)r2 * 1024 + col);
          const f32x4 pe = (col < 512) ? *(const f32x4*)(per + (t >> 6) * 512 + col) : *(const f32x4*)(pec + (t & 63) * 512 + (col - 512)); x0 += pe; }
        const f32x4 g1 = *(const f32x4*)(md + 2048 + col); const f32x4 sc2 = *(const f32x4*)(md + 4096 + col); const f32x4 nw = *(const f32x4*)(n2w + col);
        const f32x4 x1 = x0 + g1 * a; *(f32x4*)(X1 + (size_t)row * 1024 + col) = x1;
        ss += x1[0] * x1[0] + x1[1] * x1[1] + x1[2] * x1[2] + x1[3] * x1[3];
        const f32x4 av = x1 * nw * (sc2 + 1.0f); u32x2 w; w.x = pack2(av[0], av[1]); w.y = pack2(av[2], av[3]); *(u32x2*)(A2 + (size_t)row * 1024 + col) = w; }
      ss += __shfl_xor(ss, 16); ss += __shfl_xor(ss, 32);
      if (fq == 0) ssq[(size_t)row * 16 + u.pn * 4 + wc] = ss; }
  }
};
struct EpiFF1 {
  int row0; const float* ssq; const float* c1; bf16_t* Hd;
  __device__ __forceinline__ void operator()(const AccT& acc, const Unit& u, int wr, int wc, int fr, int fq) const {
    const int cb = cond_of_row(row0 + u.pm * 256); const float* cc = c1 + cb * 4096;
    EPI_LOOP_ROWS { const int rl = EPI_ROW(ai, m); const float* sp = ssq + (size_t)(row0 + rl) * 16;
      const f32x4 s0 = *(const f32x4*)sp, s1 = *(const f32x4*)(sp + 4), s2 = *(const f32x4*)(sp + 8), s3 = *(const f32x4*)(sp + 12);
      const f32x4 st = s0 + s1 + s2 + s3; const float rstd = rsqrtf((st[0] + st[1] + st[2] + st[3]) * (1.0f / 1024.0f) + 1e-6f);
      EPI_LOOP_COLS { const int col = EPI_COL(bj, n); const f32x4 cv = *(const f32x4*)(cc + col); f32x4 v = acc[ai][bj][m][n] * rstd + cv;
#pragma unroll
        for (int e = 0; e < 4; ++e) { const float r = fmaxf(v[e], 0.f); v[e] = r * r; }
        u32x2 w; w.x = pack2(v[0], v[1]); w.y = pack2(v[2], v[3]); *(u32x2*)(Hd + (size_t)rl * 4096 + col) = w; } }
  }
};
struct EpiFF2 {
  int row0; const float* mod; const float* b2; float* X; float* ssq;
  __device__ __forceinline__ void operator()(const AccT& acc, const Unit& u, int wr, int wc, int fr, int fq) const {
    const int cb = cond_of_row(row0 + u.pm * 256); const float* md = mod + cb * 6144;
    EPI_LOOP_ROWS { const int row = row0 + EPI_ROW(ai, m); float ss = 0.f;
      EPI_LOOP_COLS { const int col = EPI_COL(bj, n); const f32x4 g2 = *(const f32x4*)(md + 5120 + col); const f32x4 bb = *(const f32x4*)(b2 + col);
        float* xp = X + (size_t)row * 1024 + col; const f32x4 x2 = *(const f32x4*)xp + g2 * (acc[ai][bj][m][n] + bb); *(f32x4*)xp = x2;
        ss += x2[0] * x2[0] + x2[1] * x2[1] + x2[2] * x2[2] + x2[3] * x2[3]; }
      ss += __shfl_xor(ss, 16); ss += __shfl_xor(ss, 32);
      if (fq == 0) ssq[(size_t)row * 16 + u.pn * 4 + wc] = ss; }
  }
};

template <class Epi> __device__ __forceinline__ void run_gemm(LP lds, const bf16_t* A, const bf16_t* Bt, int M, int N, int K, const Epi& E) {
  pg8::Gemm g; g.A = A; g.Bt = Bt; g.M = M; g.N = N; g.K = K;
  pg8::StaticOrder S; S.init(M, N, (int)gridDim.x, (int)blockIdx.x);
  pg8::gemm_phase<Epi>(lds, g, S, E);
}

__device__ void transpose_tile(const float* __restrict__ src, int ld, int col0, int k0, bf16_t* __restrict__ dst, int K, int drow0, LAS float* tile) {
  const int t = opaque_tid();
  f32x4 v[4];
#pragma unroll
  for (int i = 0; i < 4; ++i) { const int idx = t + 512 * i, kr = idx >> 5, c4 = idx & 31; v[i] = *(const f32x4*)(src + (size_t)(k0 + kr) * ld + col0 + 4 * c4); }
#pragma unroll
  for (int i = 0; i < 4; ++i) { const int idx = t + 512 * i, kr = idx >> 5, c4 = idx & 31; LAS float* tp = tile + kr * 129 + 4 * c4; tp[0] = v[i][0]; tp[1] = v[i][1]; tp[2] = v[i][2]; tp[3] = v[i][3]; }
  __syncthreads();
  const int kb = t & 7;
#pragma unroll
  for (int i = 0; i < 2; ++i) { const int c = (t >> 3) + 64 * i; const LAS float* tp = tile + (kb * 8) * 129 + c; u32x4 o;
    o.x = pack2(tp[0], tp[129]); o.y = pack2(tp[2 * 129], tp[3 * 129]); o.z = pack2(tp[4 * 129], tp[5 * 129]); o.w = pack2(tp[6 * 129], tp[7 * 129]);
    *(u32x4*)(dst + (size_t)(drow0 + c) * K + k0 + kb * 8) = o; }
  __syncthreads();
}
template <int SILU> __device__ void matvec9_unit(const float* v0, const float* v1, int v1stride, const float* __restrict__ W, int ldw, const float* bias, float* out, int ldo, int col0, LAS float* lf) {
  const int t = opaque_tid(), lane = t & 63, wid = t >> 6;
  LAS float* sv = lf; LAS float* red = lf + 9216;
  for (int i = t; i < 9216; i += 512) { const int b = i >> 10, k = i & 1023; float x = (b == 0) ? v0[k] : v1[(size_t)(b - 1) * v1stride + k]; if (SILU) x = x / (1.0f + __expf(-x)); sv[i] = x; }
  __syncthreads();
  const int c4 = t & 7, kl = t >> 3;
  f32x4 w[16];
#pragma unroll
  for (int i = 0; i < 16; ++i) w[i] = *(const f32x4*)(W + (size_t)(kl + 64 * i) * ldw + col0 + 4 * c4);
  f32x4 acc[9];
#pragma unroll
  for (int b = 0; b < 9; ++b) acc[b] = (f32x4){0.f, 0.f, 0.f, 0.f};
#pragma unroll
  for (int i = 0; i < 16; ++i)
#pragma unroll
    for (int b = 0; b < 9; ++b) acc[b] += w[i] * sv[b * 1024 + kl + 64 * i];
#pragma unroll
  for (int b = 0; b < 9; ++b)
#pragma unroll
    for (int e = 0; e < 4; ++e) { float x = acc[b][e]; x += __shfl_xor(x, 8); x += __shfl_xor(x, 16); x += __shfl_xor(x, 32); acc[b][e] = x; }
  if (lane < 8) {
#pragma unroll
    for (int b = 0; b < 9; ++b) *(LAS f32x4*)(red + (wid * 9 + b) * 32 + 4 * lane) = acc[b]; }
  __syncthreads();
  if (t < 288) { const int b = t >> 5, cc = t & 31; float s = bias[col0 + cc];
#pragma unroll
    for (int pz = 0; pz < 8; ++pz) s += red[(pz * 9 + b) * 32 + cc];
    out[(size_t)b * ldo + col0 + cc] = s; }
  __syncthreads();
}

__device__ void phase0(const Params& p, LP lds) {
  unsigned char* ws = p.ws; LAS float* lf = (LAS float*)lds;
  const int tid0 = opaque_tid(); const int wid = tid0 >> 6, lane = tid0 & 63;
  for (int unit = blockIdx.x; unit < 576; unit += gridDim.x) {
    if (unit < 192) {
      matvec9_unit<1>(p.in[6], p.in[5], 1024, p.in[7], 6144, p.in[8], (float*)(ws + OFF_MOD), 6144, unit * 32, lf);
    } else if (unit < 480) {
      const int row = (unit - 192) * 8 + wid; const bool smp = row < 2048; const int L = smp ? 2048 : 256, t = smp ? row : row - 2048;
      const float* w1 = p.in[14]; const float* b1 = p.in[15]; const float* fr1 = p.in[16]; const float* w2 = p.in[17]; const float* b2 = p.in[18]; const float* fr2 = p.in[19];
      float a = b1[lane] + (float)t / (float)(L - 1) * w1[lane];
      const float base = (6.283185307179586f / (float)L) * (float)t;
      float cs = 0.f, sn = 0.f; if (lane < 16) { const float ang = base * (float)(lane + 1); cs = cosf(ang); sn = sinf(ang); }
#pragma unroll
      for (int i = 0; i < 16; ++i) a += __shfl(cs, i) * w1[(1 + i) * 64 + lane] + __shfl(sn, i) * w1[(17 + i) * 64 + lane];
      const float h1 = sinf(fr1[lane] * a);
      float a2 = b2[lane];
#pragma unroll 16
      for (int j = 0; j < 64; ++j) a2 += __shfl(h1, j) * w2[j * 64 + lane];
      const float h2 = sinf(fr2[lane] * a2);
      float* dst = (float*)(ws + (smp ? OFF_H2S : OFF_H2C)); dst[(size_t)t * 64 + lane] = h2;
    } else {
      const int r = unit - 480, c = tid0; const int pos = r < 32 ? r : r - 32; const int i = c & 255;
      const float omega = 1.0f / powf(10000.0f, (float)i / 256.0f); const float a = (float)pos * omega; const float v = c < 256 ? sinf(a) : cosf(a);
      float* dst = (float*)(ws + (r < 32 ? OFF_PER : OFF_PEC)); dst[(size_t)pos * 512 + c] = v;
    }
  }
}
__device__ void weight_tiles(const Params& p, LP lds) {
  unsigned char* ws = p.ws; LAS float* lf = (LAS float*)lds;
  for (int tu = blockIdx.x; tu < 2560; tu += gridDim.x) {
    const float* src; int ld, K, col0, k0, drow0; bf16_t* dst;
    if (tu < 1152) { const int nt = tu >> 4, kt = tu & 15; const int r = nt * 128; src = p.in[10]; ld = INC; K = 1024; k0 = kt * 64; drow0 = r; dst = (bf16_t*)(ws + OFF_WT);
      col0 = r < 3072 ? r : (r < 6144 ? 4112 + (r - 3072) : (r < 7168 ? 3072 + (r - 6144) : 7184 + (r - 7168))); }
    else if (tu < 1536) { const int v = tu - 1152, w = v >> 7, q = v & 127; src = p.in[23 + w]; ld = 1024; K = 1024; k0 = (q & 15) * 64; col0 = (q >> 4) * 128; drow0 = col0; dst = (bf16_t*)(ws + (w == 0 ? OFF_WBM : (w == 1 ? OFF_WBH : OFF_WOUT))); }
    else if (tu < 2048) { const int q = tu - 1536; src = p.in[27]; ld = 4096; K = 1024; k0 = (q & 15) * 64; col0 = (q >> 4) * 128; drow0 = col0; dst = (bf16_t*)(ws + OFF_W1T); }
    else { const int q = tu - 2048; src = p.in[29]; ld = 1024; K = 4096; k0 = (q & 63) * 64; col0 = (q >> 6) * 128; drow0 = col0; dst = (bf16_t*)(ws + OFF_W2T); }
    transpose_tile(src, ld, col0, k0, dst, K, drow0, lf);
  }
}

__device__ void phase1(const Params& p, LP lds) {
  unsigned char* ws = p.ws;
  int tid_ = threadIdx.x; asm volatile("" : "+v"(tid_));
  const int tid = tid_, wid = tid >> 6, lane = tid & 63;
  const float* mod = (const float*)(ws + OFF_MOD);
  LAS float* wg = (LAS float*)lds;
  if ((int)blockIdx.x < 1536) {
    f32x4 gw[8];
#pragma unroll
    for (int i = 0; i < 8; ++i) { const int idx = tid + 512 * i, k = idx >> 2, q = idx & 3; gw[i] = *(const f32x4*)(p.in[10] + (size_t)k * INC + 4096 + 4 * q); }
#pragma unroll
    for (int i = 0; i < 8; ++i) { const int idx = tid + 512 * i, k = idx >> 2, q = idx & 3; wg[(4 * q) * 1024 + k] = gw[i][0]; wg[(4 * q + 1) * 1024 + k] = gw[i][1]; wg[(4 * q + 2) * 1024 + k] = gw[i][2]; wg[(4 * q + 3) * 1024 + k] = gw[i][3]; }
    __syncthreads();
  }
  for (int unit = blockIdx.x; unit < 1536; unit += gridDim.x) {
    const int tidn = opaque_tid(); const int wid = tidn >> 6, lane = tidn & 63;
    const int row0 = unit * 16 + wid * 2; const int cb = cond_of_row(row0); const float* md = mod + cb * 6144; const bool smp = row0 >= NCTX;
    f32x4 v[2][4]; float rstd[2];
#pragma unroll
    for (int r = 0; r < 2; ++r) { const int row = row0 + r; const float* xr; int t = 0;
      if (!smp) xr = p.in[0] + (size_t)row * 1024; else { xr = p.in[1] + (size_t)(row - NCTX) * 1024; t = (row - NCTX) & 2047; }
      const float* per = (const float*)(ws + OFF_PER) + (t >> 6) * 512; const float* pec = (const float*)(ws + OFF_PEC) + (t & 63) * 512;
      float ss = 0.f;
#pragma unroll
      for (int i = 0; i < 4; ++i) { const int col = 4 * lane + 256 * i; v[r][i] = *(const f32x4*)(xr + col);
        if (smp) v[r][i] += (col < 512) ? *(const f32x4*)(per + col) : *(const f32x4*)(pec + col - 512);
        ss += v[r][i][0] * v[r][i][0] + v[r][i][1] * v[r][i][1] + v[r][i][2] * v[r][i][2] + v[r][i][3] * v[r][i][3]; }
      ss = wave_sum(ss); rstd[r] = rsqrtf(ss * (1.0f / 1024.0f) + 1e-6f); }
    const float* n1w = p.in[9];
    float ga[32];
#pragma unroll
    for (int g = 0; g < 32; ++g) ga[g] = 0.f;
#pragma unroll
    for (int i = 0; i < 4; ++i) { const int col = 4 * lane + 256 * i;
      const f32x4 w = *(const f32x4*)(n1w + col), sc = *(const f32x4*)(md + 1024 + col), sh = *(const f32x4*)(md + col);
      const f32x4 ws1 = w * (sc + 1.0f);
      f32x4 h[2];
#pragma unroll
      for (int r = 0; r < 2; ++r) { h[r] = v[r][i] * rstd[r] * ws1 + sh;
        u32x2 o; o.x = pack2(h[r][0], h[r][1]); o.y = pack2(h[r][2], h[r][3]); *(u32x2*)((bf16_t*)(ws + OFF_HN) + (size_t)(row0 + r) * 1024 + col) = o; }
#pragma unroll
      for (int g = 0; g < 16; ++g) { const f32x4 wv = *(const LAS f32x4*)(wg + g * 1024 + col);
#pragma unroll
        for (int r = 0; r < 2; ++r) ga[r * 16 + g] += h[r][0] * wv[0] + h[r][1] * wv[1] + h[r][2] * wv[2] + h[r][3] * wv[3]; }
      asm volatile("" ::: "memory"); }
#pragma unroll
    for (int off = 16; off >= 1; off >>= 1) { const bool hi = (lane & off) != 0;
#pragma unroll
      for (int i = 0; i < off; ++i) { const float send = hi ? ga[i] : ga[i + off]; const float keep = hi ? ga[i + off] : ga[i]; ga[i] = keep + __shfl_xor(send, off); } }
    const float tot = ga[0] + __shfl_xor(ga[0], 32);
    if (lane < 32) ((float*)(ws + OFF_GT))[(size_t)row0 * 16 + lane] = tot + p.in[11][4096 + (lane & 15)];
  }
  __syncthreads();
  LAS float* w3s = (LAS float*)lds;
  for (int v = blockIdx.x; v < 320; v += gridDim.x) {
    const int tid = opaque_tid();
    const bool smp = v < 256; const int L = smp ? 2048 : 256; const int tt = smp ? (v >> 6) : 0, cgp = v & 63; const int t = tt * 512 + tid;
    { const f32x4 x = *(const f32x4*)(p.in[20] + (size_t)(tid >> 3) * 2048 + cgp * 32 + 4 * (tid & 7)); LAS float* wp = w3s + (4 * (tid & 7)) * 64 + (tid >> 3);
      wp[0] = x[0]; wp[64] = x[1]; wp[128] = x[2]; wp[192] = x[3]; }
    __syncthreads();
    if (t < L) {
      const float* H2 = (const float*)(ws + (smp ? OFF_H2S : OFF_H2C)) + (size_t)t * 64;
      f32x4 h2[16];
#pragma unroll
      for (int i = 0; i < 16; ++i) h2[i] = *(const f32x4*)(H2 + 4 * i);
      const float dist = fabsf((float)t - (float)(L / 2)) / (float)(L / 2);
      float* HF = (float*)(ws + (smp ? OFF_HFS : OFF_HFC)) + (size_t)(cgp * 32) * L + t;
#pragma unroll 1
      for (int j = 0; j < 32; ++j) {
        f32x4 a = {0.f, 0.f, 0.f, 0.f};
#pragma unroll
        for (int i = 0; i < 16; ++i) a += *(const LAS f32x4*)(w3s + j * 64 + 4 * i) * h2[i];
        const int c = (cgp * 32 + j) & 1023;
        const float dmin = -3.0701134573253946f, dmax = -15.350567286626973f;
        const float delta = fabsf(dmin + (dmax - dmin) * ((float)c / 1023.0f));
        HF[(size_t)j * L] = ((a[0] + a[1]) + (a[2] + a[3])) * __expf(-dist * delta); }
    }
    __syncthreads();
  }
  for (int u = (int)gridDim.x - 1 - (int)blockIdx.x; u < 128; u += gridDim.x)
    matvec9_unit<0>(mod + 3072, mod + 6144 + 3072, 6144, p.in[27], 4096, p.in[28], (float*)(ws + OFF_C1), 4096, u * 32, (LAS float*)lds);
}

__device__ __forceinline__ bf16x8 tr_frag(LP base, int k0, int m0, int pitch  , int l15, int g) {
  const int q = l15 >> 2, pp = l15 & 3;
  LP a = base + ((k0 + 8 * g + q) * pitch + m0 + 4 * pp) * 2;
  const s16x4 lo = __builtin_amdgcn_ds_read_tr16_b64_v4i16((LAS s16x4*)a);
  const s16x4 hi = __builtin_amdgcn_ds_read_tr16_b64_v4i16((LAS s16x4*)(a + 8 * pitch));
  bf16x8 r; r[0] = lo[0]; r[1] = lo[1]; r[2] = lo[2]; r[3] = lo[3]; r[4] = hi[0]; r[5] = hi[1]; r[6] = hi[2]; r[7] = hi[3]; return r;
}
__device__ __forceinline__ bf16x8 tr_at(LP lanebase, int coff  , int pitch_bytes) {
  const s16x4 lo = __builtin_amdgcn_ds_read_tr16_b64_v4i16((LAS s16x4*)(lanebase + coff));
  const s16x4 hi = __builtin_amdgcn_ds_read_tr16_b64_v4i16((LAS s16x4*)(lanebase + coff + 4 * pitch_bytes));
  bf16x8 r; r[0] = lo[0]; r[1] = lo[1]; r[2] = lo[2]; r[3] = lo[3]; r[4] = hi[0]; r[5] = hi[1]; r[6] = hi[2]; r[7] = hi[3]; return r;
}
constexpr int ML_K = 0, ML_V = 67584, ML_P = 86016, ML_C = 120832, ML_T = 157696, ML_TSZ = 1600;
constexpr int KP = 264, VP = 72, PP = 136, CP = 72;

__device__ void mlstm_item(const Params& p, LP lds, int item) {
  const int tid = opaque_tid(), wid = __builtin_amdgcn_readfirstlane(tid >> 6), lane = tid & 63, l15 = lane & 15, g = lane >> 4;
  const bool smp = item < 256; const int uu = smp ? (item >> 2) : ((item - 256) >> 2); const int sl = item & 3;
  const int b = uu >> 3, dir = (uu >> 2) & 1, head = uu & 3;
  const int S = smp ? SEQS : SEQC, nc = S >> 7; const int tok0 = smp ? NCTX + b * SEQS : b * SEQC;
  const bf16_t* qkv = (const bf16_t*)(p.ws + OFF_BIG);
  const float* GT = (const float*)(p.ws + OFF_GT);
  bf16_t* hout = (bf16_t*)((unsigned char*)p.out + (dir ? OUT_HB : OUT_H));
  const int sidx = (b * 2 + dir) * 4 + head;
  const int gi_col = dir * 8 + head, gf_col = dir * 8 + 4 + head;
  f32x4 Cacc[2][4], nacc[2]; float mst0;
  if (smp) {
    const float* C0 = p.in[2] + (size_t)sidx * 65536;
#pragma unroll
    for (int dt = 0; dt < 2; ++dt) {
#pragma unroll
      for (int vt = 0; vt < 4; ++vt) Cacc[dt][vt] = *(const f32x4*)(C0 + (size_t)((2 * wid + dt) * 16 + l15) * 256 + sl * 64 + 16 * vt + 4 * g);
      nacc[dt] = (f32x4){p.in[3][sidx * 256 + (2 * wid + dt) * 16 + l15], 0.f, 0.f, 0.f}; }
    mst0 = p.in[4][sidx];
  } else {
#pragma unroll
    for (int dt = 0; dt < 2; ++dt) {
#pragma unroll
      for (int vt = 0; vt < 4; ++vt) Cacc[dt][vt] = (f32x4){0.f, 0.f, 0.f, 0.f};
      nacc[dt] = (f32x4){0.f, 0.f, 0.f, 0.f}; }
    mst0 = 0.f;
  }
#define TOKC(cc, j) (dir ? (tok0 + S - 1 - ((cc) * 128 + (j))) : (tok0 + (cc) * 128 + (j)))
  const int rt = (wid < 4) ? wid : 11 - wid;
  const int jrow = 16 * rt + l15;
  bf16x8 qf[8]; u32x4 kreg[8], vreg[2]; float g4[4] = {0.f, 0.f, 0.f, 0.f};
#define ML_LOAD_Q(cc) do { const bf16_t* qp = qkv + (size_t)TOKC(cc, jrow) * 3072 + head * 256 + 8 * g; \
    _Pragma("unroll") for (int kk = 0; kk < 8; ++kk) qf[kk] = *(const bf16x8*)(qp + 32 * kk); } while (0)
#define ML_LOAD_KV(cc) do { \
    _Pragma("unroll") for (int i = 0; i < 8; ++i) { const int row = (tid >> 5) + 16 * i; kreg[i] = *(const u32x4*)(qkv + (size_t)TOKC(cc, row) * 3072 + 1024 + head * 256 + (tid & 31) * 8); } \
    _Pragma("unroll") for (int i = 0; i < 2; ++i) { const int row = (tid >> 3) + 64 * i; vreg[i] = *(const u32x4*)(qkv + (size_t)TOKC(cc, row) * 3072 + 2048 + head * 256 + sl * 64 + (tid & 7) * 8); } \
    if (wid == 0) { const float* g0 = GT + (size_t)TOKC(cc, 2 * lane) * 16; const float* g1 = GT + (size_t)TOKC(cc, 2 * lane + 1) * 16; g4[0] = g0[gi_col]; g4[1] = g0[gf_col]; g4[2] = g1[gi_col]; g4[3] = g1[gf_col]; } } while (0)
#define ML_SCAN(tabp, mcur, mnext) do { LAS float* T_ = (LAS float*)(tabp); \
    const float lf0 = fminf(g4[1], 0.f) - log1pf(__expf(-fabsf(g4[1]))), lf1 = fminf(g4[3], 0.f) - log1pf(__expf(-fabsf(g4[3]))); \
    float s_ = lf0 + lf1; \
    _Pragma("unroll") for (int o = 1; o < 64; o <<= 1) { const float t_ = __shfl_up(s_, o); if (lane >= o) s_ += t_; } \
    const float b1_ = s_, b0_ = s_ - lf1; const float u0_ = g4[0] - b0_, u1_ = g4[2] - b1_; \
    float mx_ = fmaxf(u0_, u1_); \
    _Pragma("unroll") for (int o = 1; o < 64; o <<= 1) { const float t_ = __shfl_up(mx_, o); if (lane >= o) mx_ = fmaxf(mx_, t_); } \
    float ex_ = __shfl_up(mx_, 1); if (lane == 0) ex_ = -INFINITY; \
    const float M0_ = fmaxf(mcur, fmaxf(ex_, u0_)), M1_ = fmaxf(mcur, mx_); \
    T_[2 * lane] = u0_; T_[2 * lane + 1] = u1_; T_[128 + 2 * lane] = M0_; T_[128 + 2 * lane + 1] = M1_; T_[256 + 2 * lane] = b0_; T_[256 + 2 * lane + 1] = b1_; \
    const float Ml_ = __shfl(M1_, 63), bl_ = __shfl(b1_, 63); \
    if (lane == 0) { T_[384] = mcur; T_[385] = Ml_; } \
    mnext = bl_ + Ml_; } while (0)
  float mw0 = mst0;
  ML_LOAD_Q(0); ML_LOAD_KV(0);
  if (wid == 0) { float mn; ML_SCAN(lds + ML_T, mw0, mn); mw0 = mn; }
  __syncthreads();
  float m_final = 0.f;
  for (int c = 0; c < nc; ++c) {
    LAS float* T = (LAS float*)(lds + ML_T + (c & 1) * ML_TSZ);
    const float mst = T[384], M_last = T[385];
#pragma unroll
    for (int i = 0; i < 8; ++i) { const int row = (tid >> 5) + 16 * i; *(LAS u32x4*)(lds + ML_K + (row * KP + (tid & 31) * 8) * 2) = kreg[i]; }
#pragma unroll
    for (int i = 0; i < 2; ++i) { const int row = (tid >> 3) + 64 * i; const float w = __expf(T[row] - M_last); const u32x4 v = vreg[i]; u32x4 o;
      o.x = pack2(bflo(v.x) * w, bfhi(v.x) * w); o.y = pack2(bflo(v.y) * w, bfhi(v.y) * w); o.z = pack2(bflo(v.z) * w, bfhi(v.z) * w); o.w = pack2(bflo(v.w) * w, bfhi(v.w) * w);
      *(LAS u32x4*)(lds + ML_V + (row * VP + (tid & 7) * 8) * 2) = o; }
    if (tid < 128) *(LAS unsigned short*)(lds + ML_V + (tid * VP + 64) * 2) = f2bf(__expf(T[tid] - M_last));
#pragma unroll
    for (int dt = 0; dt < 2; ++dt) {
#pragma unroll
      for (int vt = 0; vt < 4; ++vt) { u32x2 w; w.x = pack2(Cacc[dt][vt][0], Cacc[dt][vt][1]); w.y = pack2(Cacc[dt][vt][2], Cacc[dt][vt][3]);
        *(LAS u32x2*)(lds + ML_C + (((2 * wid + dt) * 16 + l15) * CP + 16 * vt + 4 * g) * 2) = w; }
      if (g == 0) *(LAS unsigned short*)(lds + ML_C + (((2 * wid + dt) * 16 + l15) * CP + 64) * 2) = f2bf(nacc[dt][0]); }
    const int qtok = TOKC(c, jrow);
    const bool more = (c + 1 < nc);
    __syncthreads();
    const float Mj = T[128 + jrow], bj = T[256 + jrow]; const float rf = __expf(M_last - Mj), w_inter = __expf(mst - Mj);
    int lq_ = (8 * g + (l15 >> 2)), lp_ = 4 * (l15 & 3); asm volatile("" : "+v"(lq_), "+v"(lp_));
    const LP cB = lds + ML_C + (lq_ * CP + lp_) * 2, vB = lds + ML_V + (lq_ * VP + lp_) * 2, kB = lds + ML_K + (lq_ * KP + lp_ + 32 * wid) * 2;
    const LP pB = lds + ML_P + (jrow * PP + 8 * g) * 2;
    for (int st = 0; st <= rt; ++st) {
      f32x4 s = {0.f, 0.f, 0.f, 0.f};
#pragma unroll
      for (int kk = 0; kk < 8; ++kk) { const bf16x8 kf = *(const LAS bf16x8*)(lds + ML_K + ((16 * st + l15) * KP + 32 * kk + 8 * g) * 2); s = __builtin_amdgcn_mfma_f32_16x16x32_bf16(kf, qf[kk], s, 0, 0, 0); }
      float pv[4];
#pragma unroll
      for (int i = 0; i < 4; ++i) pv[i] = ((16 * st + 4 * g + i) <= jrow) ? s[i] * rf : 0.f;
      u32x2 w; w.x = pack2(pv[0], pv[1]); w.y = pack2(pv[2], pv[3]);
      *(LAS u32x2*)(lds + ML_P + (jrow * PP + 16 * st + 4 * g) * 2) = w;
    }
    if ((rt & 1) == 0) { u32x2 z; z.x = 0u; z.y = 0u; *(LAS u32x2*)(lds + ML_P + (jrow * PP + 16 * (rt + 1) + 4 * g) * 2) = z; }
    if (more) ML_LOAD_KV(c + 1);
    asm volatile("s_waitcnt lgkmcnt(0)" ::: "memory");
    float rdd;
    { f32x4 a = {0.f, 0.f, 0.f, 0.f};
      if (smp || c > 0) {
#pragma unroll
        for (int kk = 0; kk < 8; ++kk) { const bf16x8 cf = tr_at(cB, (32 * kk * CP + 64) * 2, CP * 2); a = __builtin_amdgcn_mfma_f32_16x16x32_bf16(cf, qf[kk], a, 0, 0, 0); }
        a *= w_inter; }
      for (int k2 = 0; k2 <= (rt >> 1); ++k2) { const bf16x8 pf = *(const LAS bf16x8*)(pB + k2 * 64);
        const bf16x8 vf = tr_at(vB + k2 * (32 * VP * 2), 64 * 2, VP * 2); a = __builtin_amdgcn_mfma_f32_16x16x32_bf16(vf, pf, a, 0, 0, 0); }
      const float den = __shfl(a[0], l15); rdd = 1.0f / fmaxf(fabsf(den), __expf(-(bj + Mj))); }
#pragma unroll
    for (int vt = 0; vt < 4; ++vt) { f32x4 a = {0.f, 0.f, 0.f, 0.f};
      if (smp || c > 0) {
#pragma unroll
        for (int kk = 0; kk < 8; ++kk) { const bf16x8 cf = tr_at(cB, (32 * kk * CP + 16 * vt) * 2, CP * 2); a = __builtin_amdgcn_mfma_f32_16x16x32_bf16(cf, qf[kk], a, 0, 0, 0); }
        a *= w_inter; }
      for (int k2 = 0; k2 <= (rt >> 1); ++k2) { const bf16x8 pf = *(const LAS bf16x8*)(pB + k2 * 64);
        const bf16x8 vf = tr_at(vB + k2 * (32 * VP * 2), (16 * vt) * 2, VP * 2); a = __builtin_amdgcn_mfma_f32_16x16x32_bf16(vf, pf, a, 0, 0, 0); }
      a *= rdd; u32x2 w; w.x = pack2(a[0], a[1]); w.y = pack2(a[2], a[3]);
      *(u32x2*)(hout + (size_t)qtok * 1024 + head * 256 + sl * 64 + 16 * vt + 4 * g) = w; }
    if (more) ML_LOAD_Q(c + 1);
    const bool need_state = (!smp) || more;
    if (need_state) {
      const float decay = __expf(mst - M_last);
#pragma unroll
      for (int dt = 0; dt < 2; ++dt) {
#pragma unroll
        for (int vt = 0; vt < 4; ++vt) Cacc[dt][vt] *= decay;
        nacc[dt] *= decay; }
#pragma unroll
      for (int ks = 0; ks < 4; ++ks) {
        const bf16x8 kf0 = tr_at(kB, (32 * ks * KP) * 2, KP * 2), kf1 = tr_at(kB, (32 * ks * KP + 16) * 2, KP * 2);
#pragma unroll
        for (int vt = 0; vt < 4; ++vt) { const bf16x8 vf = tr_at(vB, (32 * ks * VP + 16 * vt) * 2, VP * 2);
          Cacc[0][vt] = __builtin_amdgcn_mfma_f32_16x16x32_bf16(vf, kf0, Cacc[0][vt], 0, 0, 0); Cacc[1][vt] = __builtin_amdgcn_mfma_f32_16x16x32_bf16(vf, kf1, Cacc[1][vt], 0, 0, 0); }
        { const bf16x8 vf = tr_at(vB, (32 * ks * VP + 64) * 2, VP * 2);
          nacc[0] = __builtin_amdgcn_mfma_f32_16x16x32_bf16(vf, kf0, nacc[0], 0, 0, 0); nacc[1] = __builtin_amdgcn_mfma_f32_16x16x32_bf16(vf, kf1, nacc[1], 0, 0, 0); }
      }
    }
    if (wid == 0 && more) { float mn; ML_SCAN(lds + ML_T + ((c + 1) & 1) * ML_TSZ, mw0, mn); mw0 = mn; }
    m_final = T[256 + 127] + M_last;
    __syncthreads();
  }
#undef ML_LOAD_Q
#undef ML_LOAD_KV
#undef ML_SCAN
#undef TOKC
  if (!smp) {
    float* oC = p.out + OUTF_C + (size_t)sidx * 65536;
#pragma unroll
    for (int dt = 0; dt < 2; ++dt) {
#pragma unroll
      for (int vt = 0; vt < 4; ++vt) *(f32x4*)(oC + (size_t)((2 * wid + dt) * 16 + l15) * 256 + sl * 64 + 16 * vt + 4 * g) = Cacc[dt][vt];
      if (sl == 0 && g == 0) p.out[OUTF_N + (size_t)sidx * 256 + (2 * wid + dt) * 16 + l15] = nacc[dt][0]; }
    if (sl == 0 && tid == 0) p.out[OUTF_M + sidx] = m_final;
  }
}

__device__ void combine_rows(const Params& p) {
  const int tid0 = opaque_tid(); const int wid = tid0 >> 6, lane = tid0 & 63;
  bf16_t* H = (bf16_t*)((unsigned char*)p.out + OUT_H); const bf16_t* HB = (const bf16_t*)((unsigned char*)p.out + OUT_HB); const float* nw = p.in[22];
  for (int unit = blockIdx.x; unit < 3072; unit += gridDim.x) {
    const int row = unit * 8 + wid; bf16_t* hp = H + (size_t)row * 1024 + 16 * lane; const bf16_t* bp = HB + (size_t)row * 1024 + 16 * lane;
    float v[16]; float ss = 0.f;
#pragma unroll
    for (int i = 0; i < 2; ++i) { const u32x4 a = *(const u32x4*)(hp + 8 * i), bq = *(const u32x4*)(bp + 8 * i);
      v[8 * i + 0] = bflo(a.x) + bflo(bq.x); v[8 * i + 1] = bfhi(a.x) + bfhi(bq.x); v[8 * i + 2] = bflo(a.y) + bflo(bq.y); v[8 * i + 3] = bfhi(a.y) + bfhi(bq.y);
      v[8 * i + 4] = bflo(a.z) + bflo(bq.z); v[8 * i + 5] = bfhi(a.z) + bfhi(bq.z); v[8 * i + 6] = bflo(a.w) + bflo(bq.w); v[8 * i + 7] = bfhi(a.w) + bfhi(bq.w); }
#pragma unroll
    for (int e = 0; e < 16; ++e) ss += v[e] * v[e];
    ss += __shfl_xor(ss, 1); ss += __shfl_xor(ss, 2); ss += __shfl_xor(ss, 4); ss += __shfl_xor(ss, 8);
    const float r = rsqrtf(ss * (1.0f / 256.0f) + 1e-6f);
#pragma unroll
    for (int i = 0; i < 2; ++i) { const f32x4 w0 = *(const f32x4*)(nw + 16 * lane + 8 * i), w1 = *(const f32x4*)(nw + 16 * lane + 8 * i + 4); u32x4 o;
      o.x = pack2(v[8 * i] * r * w0[0], v[8 * i + 1] * r * w0[1]); o.y = pack2(v[8 * i + 2] * r * w0[2], v[8 * i + 3] * r * w0[3]);
      o.z = pack2(v[8 * i + 4] * r * w1[0], v[8 * i + 5] * r * w1[1]); o.w = pack2(v[8 * i + 6] * r * w1[2], v[8 * i + 7] * r * w1[3]);
      *(u32x4*)(hp + 8 * i) = o; }
  }
}

constexpr int HY_WAVE = 18816, HY_HR = 0, HY_ZA = 8576, HY_ZB = 8576 + 5120;
__device__ void hyena_item(const Params& p, LP lds, int item) {
  const int tid = opaque_tid(), wid = __builtin_amdgcn_readfirstlane(tid >> 6), lane = tid & 63, n31 = lane & 31, hh = lane >> 5;
  const bool smp = item < 1024; const int it = smp ? item : item - 1024; const int bset = it >> 7, cgp = it & 127; const int c = cgp * 8 + wid;
  const int L = smp ? 2048 : 256, lgL = smp ? 11 : 8, nblk = L >> 5, lgnb = lgL - 5, ntok = smp ? 2048 : 1024, ntile = smp ? 2 : 1, dmax = L >> 6;
  const int tok0 = smp ? NCTX + bset * 2048 : bset * 1024;
  LP wl = lds + wid * HY_WAVE; LAS float* hr = (LAS float*)(wl + HY_HR);
  const float* HFp = (const float*)(p.ws + (smp ? OFF_HFS : OFF_HFC));
  const bf16_t* UT = (const bf16_t*)(p.ws + OFF_BIG);
  const float* cw = p.in[12]; const float* cbv = p.in[13]; const float* skp = p.in[21];
  { const int uc = 2048 + c; const float w0 = cw[uc], w1 = cw[3072 + uc], w2 = cw[6144 + uc], cb = cbv[uc]; const bf16_t* src = UT + (size_t)uc * NTOK + tok0;
    u32x4 vv[4]; float pvv[4], nxv[4];
#pragma unroll
    for (int i = 0; i < 4; ++i) { const int base = lane * 8 + 512 * i; vv[i] = (u32x4){0u, 0u, 0u, 0u}; pvv[i] = 0.f; nxv[i] = 0.f;
      if (base < ntok) { vv[i] = *(const u32x4*)(src + base); const int tl = base & (L - 1);
        if (tl != 0) pvv[i] = bf2f(src[base - 1]); if (tl + 8 != L) nxv[i] = bf2f(src[base + 8]); } }
#pragma unroll
    for (int i = 0; i < 4; ++i) { const int base = lane * 8 + 512 * i;
      if (base < ntok) { const u32x4 v = vv[i];
        float u[10]; u[0] = pvv[i]; u[1] = bflo(v.x); u[2] = bfhi(v.x); u[3] = bflo(v.y); u[4] = bfhi(v.y); u[5] = bflo(v.z); u[6] = bfhi(v.z); u[7] = bflo(v.w); u[8] = bfhi(v.w); u[9] = nxv[i];
        float o[8];
#pragma unroll
        for (int e = 0; e < 8; ++e) o[e] = cb + w0 * u[e] + w1 * u[e + 1] + w2 * u[e + 2];
        u32x4 w; w.x = pack2(o[0], o[1]); w.y = pack2(o[2], o[3]); w.z = pack2(o[4], o[5]); w.w = pack2(o[6], o[7]);
        *(LAS u32x4*)(wl + HY_ZA + ((base >> 5) * 40 + (base & 31)) * 2) = w; } } }
  const int HRP = L + 96;
  f32x4 fvN[8];
#define HY_FLOAD(o) do { const float* src_ = HFp + (size_t)((o) * 1024 + c) * L; \
    _Pragma("unroll") for (int i = 0; i < 8; ++i) { const int q = lane + 64 * i; fvN[i] = (4 * q < L) ? *(const f32x4*)(src_ + 4 * q) : (f32x4){0.f, 0.f, 0.f, 0.f}; } } while (0)
  HY_FLOAD(0);
  for (int ord = 0; ord < 2; ++ord) {
    { float sa = 0.f;
      f32x4 fv[8];
#pragma unroll
      for (int i = 0; i < 8; ++i) fv[i] = fvN[i];
#pragma unroll
      for (int i = 0; i < 8; ++i) sa += (fabsf(fv[i][0]) + fabsf(fv[i][1])) + (fabsf(fv[i][2]) + fabsf(fv[i][3]));
      sa = wave_sum(sa); const float inv = 1.0f / (sa + 1e-6f);
      asm volatile("s_waitcnt lgkmcnt(0)" ::: "memory");
      LAS bf16_t* E = (LAS bf16_t*)hr; LAS bf16_t* O = E + HRP;
#pragma unroll
      for (int i = 0; i < 8; ++i) { const int q = lane + 64 * i;
        if (4 * q < L) {
#pragma unroll
          for (int e = 0; e < 4; ++e) { const int yy = L - 1 - (4 * q + e); const bf16_t v = f2bf(fv[i][e] * inv); E[32 + yy] = v; O[31 + yy] = v; } } }
      if (lane < 32) { E[lane] = 0; E[32 + L + lane] = 0; O[31 + L + lane] = 0; if (lane < 31) O[lane] = 0; }
      if (lane < 33) O[HRP - 33 + lane] = 0;
      asm volatile("s_waitcnt lgkmcnt(0)" ::: "memory"); }
    if (ord == 0) HY_FLOAD(1);
    LP zin = wl + (ord == 0 ? HY_ZA : HY_ZB); LP zout = wl + (ord == 0 ? HY_ZB : HY_ZA);
    const int gc = ord * 1024 + c; const float w0 = cw[gc], w1 = cw[3072 + gc], w2 = cw[6144 + gc], cb = cbv[gc], sk = skp[ord * 1024 + c];
    const bf16_t* gsrc = UT + (size_t)gc * NTOK + tok0;
    u32x4 gv[4]; unsigned gpv[4], gnx[4];
#pragma unroll
    for (int i = 0; i < 4; ++i) { const int base = lane * 8 + 512 * i; gv[i] = (u32x4){0u, 0u, 0u, 0u}; gpv[i] = 0u; gnx[i] = 0u;
      if (base < ntok) { gv[i] = *(const u32x4*)(gsrc + base); const int tl = base & (L - 1);
        if (tl != 0) gpv[i] = gsrc[base - 1]; if (tl + 8 != L) gnx[i] = gsrc[base + 8]; } }
    f32x16 accs[2];
#pragma unroll
    for (int o2 = 0; o2 < 2; ++o2)
#pragma unroll
      for (int r = 0; r < 16; ++r) accs[o2][r] = 0.f;
    LP fb = wl + HY_HR + ((n31 & 1) ? 0 : (HRP * 2 - 2)) + 2 * ((L >> 1) - 1 - n31 + 8 * hh + 32);
    int cbl[2], ca[2];
#pragma unroll
    for (int ot = 0; ot < 2; ++ot) { const int col = 32 * ot + n31; cbl[ot] = (col >> lgnb) << lgnb; ca[ot] = col & (nblk - 1); }
    const bool two = (ntile == 2);
    {
      LP zero = wl + HY_HR + 16 * hh;
      LP ap = fb + 64 * dmax;
      int bbr0 = ca[0] + dmax, bbr1 = ca[1] + dmax;
      LP bp0 = zin + ((cbl[0] + bbr0) * 40 + 8 * hh) * 2, bp1 = zin + ((cbl[1] + bbr1) * 40 + 8 * hh) * 2;
      for (int d = -dmax; d <= dmax; ++d) {
        u32x4 w0v, w1v;
        w0v.x = *(const LAS unsigned*)(ap); w0v.y = *(const LAS unsigned*)(ap + 4); w0v.z = *(const LAS unsigned*)(ap + 8); w0v.w = *(const LAS unsigned*)(ap + 12);
        w1v.x = *(const LAS unsigned*)(ap + 32); w1v.y = *(const LAS unsigned*)(ap + 36); w1v.z = *(const LAS unsigned*)(ap + 40); w1v.w = *(const LAS unsigned*)(ap + 44);
        const bf16x8 af0 = __builtin_bit_cast(bf16x8, w0v), af1 = __builtin_bit_cast(bf16x8, w1v);
        LP q0 = ((unsigned)bbr0 < (unsigned)nblk) ? bp0 : zero;
        const bf16x8 b00 = *(const LAS bf16x8*)q0, b01 = *(const LAS bf16x8*)(q0 + 32);
        accs[0] = __builtin_amdgcn_mfma_f32_32x32x16_bf16(af0, b00, accs[0], 0, 0, 0);
        accs[0] = __builtin_amdgcn_mfma_f32_32x32x16_bf16(af1, b01, accs[0], 0, 0, 0);
        if (two) {
          LP q1 = ((unsigned)bbr1 < (unsigned)nblk) ? bp1 : zero;
          const bf16x8 b10 = *(const LAS bf16x8*)q1, b11 = *(const LAS bf16x8*)(q1 + 32);
          accs[1] = __builtin_amdgcn_mfma_f32_32x32x16_bf16(af0, b10, accs[1], 0, 0, 0);
          accs[1] = __builtin_amdgcn_mfma_f32_32x32x16_bf16(af1, b11, accs[1], 0, 0, 0);
        }
        ap -= 64; bbr0 -= 1; bbr1 -= 1; bp0 -= 80; bp1 -= 80;
      }
    }
#pragma unroll
    for (int ot = 0; ot < 2; ++ot) {
      if (ot >= ntile) continue;
      const f32x16 acc = accs[ot];
#pragma unroll
      for (int rg = 0; rg < 4; ++rg) {
        const int zo = (((cbl[ot] + ca[ot]) * 40) + 8 * rg + 4 * hh) * 2;
        const u32x2 zv = *(const LAS u32x2*)(zin + zo);
        u32x2 w; w.x = pack2(acc[4 * rg] + sk * bflo(zv.x), acc[4 * rg + 1] + sk * bfhi(zv.x)); w.y = pack2(acc[4 * rg + 2] + sk * bflo(zv.y), acc[4 * rg + 3] + sk * bfhi(zv.y));
        *(LAS u32x2*)(zout + zo) = w;
      }
    }
    asm volatile("s_waitcnt lgkmcnt(0)" ::: "memory");
#pragma unroll
    for (int i = 0; i < 4; ++i) { const int base = lane * 8 + 512 * i;
      if (base < ntok) { const u32x4 v = gv[i];
        float u[10]; u[0] = bf2f(gpv[i]); u[1] = bflo(v.x); u[2] = bfhi(v.x); u[3] = bflo(v.y); u[4] = bfhi(v.y); u[5] = bflo(v.z); u[6] = bfhi(v.z); u[7] = bflo(v.w); u[8] = bfhi(v.w); u[9] = bf2f(gnx[i]);
        LP zp = zout + ((base >> 5) * 40 + (base & 31)) * 2; const u32x4 t = *(const LAS u32x4*)zp;
        float tv[8]; tv[0] = bflo(t.x); tv[1] = bfhi(t.x); tv[2] = bflo(t.y); tv[3] = bfhi(t.y); tv[4] = bflo(t.z); tv[5] = bfhi(t.z); tv[6] = bflo(t.w); tv[7] = bfhi(t.w);
        float o[8];
#pragma unroll
        for (int e = 0; e < 8; ++e) o[e] = (cb + w0 * u[e] + w1 * u[e + 1] + w2 * u[e + 2]) * tv[e];
        u32x4 w; w.x = pack2(o[0], o[1]); w.y = pack2(o[2], o[3]); w.z = pack2(o[4], o[5]); w.w = pack2(o[6], o[7]);
        *(LAS u32x4*)zp = w; } }
    asm volatile("s_waitcnt lgkmcnt(0)" ::: "memory");
  }
  __syncthreads();
  { bf16_t* YH = (bf16_t*)((unsigned char*)p.out + OUT_HB);
    for (int tl = tid; tl < ntok; tl += 512) {
      const int bl = tl >> lgL, tloc = tl & (L - 1); const int zo = ((((bl << lgnb) + (tloc >> 5)) * 40) + (tloc & 31)) * 2;
      unsigned short e[8];
#pragma unroll
      for (int w = 0; w < 8; ++w) e[w] = *(const LAS unsigned short*)(lds + w * HY_WAVE + HY_ZA + zo);
      u32x4 o; o.x = e[0] | ((unsigned)e[1] << 16); o.y = e[2] | ((unsigned)e[3] << 16); o.z = e[4] | ((unsigned)e[5] << 16); o.w = e[6] | ((unsigned)e[7] << 16);
      *(u32x4*)(YH + (size_t)(tok0 + tl) * 1024 + cgp * 8) = o; } }
  __syncthreads();
}

__device__ void final_norm(const Params& p) {
  const int tid0 = opaque_tid(); const int wid = tid0 >> 6, lane = tid0 & 63; const float* fw = p.in[31]; const float* ssq = (const float*)(p.ws + OFF_SSQ2);
  for (int unit = blockIdx.x; unit < 3072; unit += gridDim.x) {
    const int row = unit * 8 + wid; float* xr = p.out + (size_t)row * 1024; const float* sp = ssq + (size_t)row * 16;
    const f32x4 st = *(const f32x4*)sp + *(const f32x4*)(sp + 4) + *(const f32x4*)(sp + 8) + *(const f32x4*)(sp + 12);
    const float rstd = rsqrtf((st[0] + st[1] + st[2] + st[3]) * (1.0f / 1024.0f) + 1e-6f);
#pragma unroll
    for (int i = 0; i < 4; ++i) { const int col = 4 * lane + 256 * i; const f32x4 v = *(const f32x4*)(xr + col) * rstd * *(const f32x4*)(fw + col); *(f32x4*)(xr + col) = v; }
  }
}

__global__ void __launch_bounds__(512, 2) __attribute__((flatten)) mega(Params p) {
  extern __shared__ __attribute__((aligned(16))) unsigned char shm[];
  LP lds = (LP)shm;
  cg::grid_group grid = cg::this_grid();
  volatile LAS unsigned* xst = (volatile LAS unsigned*)(lds + LDS_BYTES - 16);
  if (threadIdx.x == 0) { xst[0] = 0u; xst[1] = 0u; }
  __syncthreads();
  const XcdBarrier xb = xcd_barrier_post((unsigned*)(p.ws + OFF_BAR), xst);
  unsigned char* ws = p.ws;
  const bf16_t* WT = (const bf16_t*)(ws + OFF_WT); const bf16_t* HN = (const bf16_t*)(ws + OFF_HN); bf16_t* BIG = (bf16_t*)(ws + OFF_BIG);
  bf16_t* Hb = (bf16_t*)((unsigned char*)p.out + OUT_H); bf16_t* YH = (bf16_t*)((unsigned char*)p.out + OUT_HB);
  const float* mod = (const float*)(ws + OFF_MOD);
  phase0(p, lds);
  if (gridDim.y == 7u) grid.sync();
  xcd_barrier(xb);
  phase1(p, lds);
  weight_tiles(p, lds);
  xcd_barrier(xb);
  { EpiQKV e; e.O = BIG; e.bias = p.in[11]; run_gemm(lds, HN, WT, NTOK, 3072, 1024, e); }
  xcd_barrier(xb);
  for (int item = blockIdx.x; item < 1280; item += gridDim.x) mlstm_item(p, lds, item);
  xcd_barrier(xb);
  combine_rows(p);
  { EpiUT e; e.O = BIG; e.bias = p.in[11] + 4112; run_gemm(lds, WT + (size_t)3072 * 1024, HN, 3072, NTOK, 1024, e); }
  xcd_barrier(xb);
  for (int item = blockIdx.x; item < 2048; item += gridDim.x) hyena_item(p, lds, item);
  xcd_barrier(xb);
  { EpiGates e; e.H = Hb; e.G = BIG; e.b_in = p.in[11]; run_gemm(lds, HN, WT + (size_t)6144 * 1024, NTOK, 3072, 1024, e); }
  xcd_barrier(xb);
  bf16_t* T = BIG + (size_t)NTOK * 2048;
  { EpiMerge<0> e; e.T = T; e.G = BIG; run_gemm(lds, Hb, (const bf16_t*)(ws + OFF_WBM), NTOK, 1024, 1024, e); }
  { EpiMerge<1> e; e.T = T; e.G = BIG; run_gemm(lds, YH, (const bf16_t*)(ws + OFF_WBH), NTOK, 1024, 1024, e); }
  xcd_barrier(xb);
  { EpiOut e; e.xp = p.in[0]; e.xs = p.in[1]; e.per = (const float*)(ws + OFF_PER); e.pec = (const float*)(ws + OFF_PEC); e.mod = mod; e.n2w = p.in[26];
    e.X1 = p.out; e.A2 = (bf16_t*)(ws + OFF_HN); e.ssq = (float*)(ws + OFF_SSQ1); run_gemm(lds, T, (const bf16_t*)(ws + OFF_WOUT), NTOK, 1024, 1024, e); }
  xcd_barrier(xb);
#define FFN_HALF(ROW0) do { \
    { EpiFF1 e; e.row0 = (ROW0); e.ssq = (const float*)(p.ws + OFF_SSQ1); e.c1 = (const float*)(p.ws + OFF_C1); e.Hd = (bf16_t*)(p.ws + OFF_BIG); \
      run_gemm(lds, (const bf16_t*)(p.ws + OFF_HN) + (size_t)(ROW0) * 1024, (const bf16_t*)(p.ws + OFF_W1T), 12288, 4096, 1024, e); } \
    xcd_barrier(xb); \
    { EpiFF2 e; e.row0 = (ROW0); e.mod = (const float*)(p.ws + OFF_MOD); e.b2 = p.in[30]; e.X = p.out; e.ssq = (float*)(p.ws + OFF_SSQ2); \
      run_gemm(lds, (const bf16_t*)(p.ws + OFF_BIG), (const bf16_t*)(p.ws + OFF_W2T), 12288, 1024, 4096, e); } \
    xcd_barrier(xb); } while (0)
  FFN_HALF(0);
  FFN_HALF(12288);
#undef FFN_HALF
  final_norm(p);
}

extern "C" void kernel_launch(void* const* d_in, const int* in_sizes, int n_in, void* d_out, int out_size, void* d_ws, size_t ws_size, hipStream_t stream) {
  static int grid_blocks = 0;
  if (!grid_blocks) {
    int dev = 0, cus = 0, per_cu = 0;
    hipGetDevice(&dev);
    hipDeviceGetAttribute(&cus, hipDeviceAttributeMultiprocessorCount, dev);
    hipFuncSetAttribute((const void*)mega, hipFuncAttributeMaxDynamicSharedMemorySize, LDS_BYTES);
    hipOccupancyMaxActiveBlocksPerMultiprocessor(&per_cu, (const void*)mega, 512, LDS_BYTES);
    if (per_cu < 1) { fprintf(stderr, "kernel_launch: occupancy query reports %d blocks per CU\n", per_cu); grid_blocks = -1; }
    else grid_blocks = cus;
    if (n_in != 32 || ws_size < WS_END) { fprintf(stderr, "kernel_launch: unexpected n_in %d / ws_size %zu (need %zu)\n", n_in, ws_size, (size_t)WS_END); grid_blocks = -1; }
  }
  if (grid_blocks < 0) return;
  hipMemsetAsync((unsigned char*)d_ws + OFF_BAR, 0, 3456 * 4, stream);
  Params p{};
  for (int i = 0; i < 32; ++i) p.in[i] = (const float*)d_in[i];
  p.out = (float*)d_out; p.ws = (unsigned char*)d_ws;
  void* args[] = {&p};
  hipError_t e = hipLaunchCooperativeKernel((void*)mega, dim3(grid_blocks), dim3(512), args, LDS_BYTES, stream);
  if (e != hipSuccess) fprintf(stderr, "cooperative launch failed: %s (grid %d)\n", hipGetErrorString(e), grid_blocks);
}
```

```cpp
#include <hip/hip_runtime.h>
#include <hip/hip_cooperative_groups.h>
#include <cstdio>
#include <cstdint>
namespace cg = cooperative_groups;

#define LAS __attribute__((address_space(3)))
typedef LAS unsigned char* LP;
typedef unsigned short bf16_t;
typedef short bf16x8 __attribute__((ext_vector_type(8)));
typedef short s16x4 __attribute__((ext_vector_type(4)));
typedef float f32x4 __attribute__((ext_vector_type(4)));
typedef float f32x16 __attribute__((ext_vector_type(16)));
typedef unsigned u32x4 __attribute__((ext_vector_type(4)));
typedef unsigned u32x2 __attribute__((ext_vector_type(2)));

constexpr int DM = 1024, NTOK = 24576, NCTX = 8192, SEQC = 256, SEQS = 2048, INC = 9232;
constexpr int LDS_BYTES = 160 * 1024;
constexpr size_t OFF_WT = 0;
constexpr size_t OFF_WBM = 18874368, OFF_WBH = 20971520, OFF_WOUT = 23068672, OFF_W1T = 25165824, OFF_W2T = 33554432;
constexpr size_t OFF_HN = 41943040;
constexpr size_t OFF_BIG = 92274688;
constexpr size_t OFF_SM = 243269632;
constexpr size_t OFF_MOD = OFF_SM;
constexpr size_t OFF_C1 = OFF_MOD + 221184;
constexpr size_t OFF_H2S = OFF_C1 + 147456;
constexpr size_t OFF_H2C = OFF_H2S + 524288;
constexpr size_t OFF_PER = OFF_H2C + 65536;
constexpr size_t OFF_PEC = OFF_PER + 65536;
constexpr size_t OFF_GT = OFF_PEC + 131072;
constexpr size_t OFF_SSQ1 = OFF_GT + 1572864;
constexpr size_t OFF_SSQ2 = OFF_SSQ1 + 1572864;
constexpr size_t OFF_HFS = OFF_SSQ2 + 1572864;
constexpr size_t OFF_HFC = OFF_HFS + 16777216;
constexpr size_t OFF_BAR = OFF_HFC + 2097152;
constexpr size_t WS_END = OFF_BAR + 3456 * 4;
constexpr size_t OUT_H = 0, OUT_HB = 50331648;
constexpr size_t OUTF_C = 25165824, OUTF_N = 41943040, OUTF_M = 42008576;

struct Params { const float* in[32]; float* out; unsigned char* ws; };

__device__ __forceinline__ bf16_t f2bf(float f) { unsigned u = __float_as_uint(f); u += 0x7FFFu + ((u >> 16) & 1u); return (bf16_t)(u >> 16); }
__device__ __forceinline__ float bf2f(unsigned b) { return __uint_as_float(b << 16); }
__device__ __forceinline__ unsigned pack2(float lo, float hi) { return (unsigned)f2bf(lo) | ((unsigned)f2bf(hi) << 16); }
__device__ __forceinline__ float bflo(unsigned w) { return __uint_as_float(w << 16); }
__device__ __forceinline__ float bfhi(unsigned w) { return __uint_as_float(w & 0xffff0000u); }
__device__ __forceinline__ float sigmoidf_(float x) { return 1.0f / (1.0f + __expf(-x)); }
__device__ __forceinline__ int opaque_tid() { int t = threadIdx.x; asm volatile("" : "+v"(t)); return t; }
__device__ __forceinline__ float wave_sum(float v) {
#pragma unroll
  for (int o = 32; o >= 1; o >>= 1) v += __shfl_xor(v, o);
  return v;
}


#define XB_TMO      128
#define XB_XCNT(j)  (256  + 64 * (j))
#define XB_XSUB(j)  (1280 + 64 * (j))
#define XB_XGEN(j)  (2304 + 64 * (j))
#define XB_TOP      3328
#define XB_TOPGEN   3392
#define XCD_BAR_WORDS 3456
#define XB_SPIN_CAP (1u << 18)
__device__ __forceinline__ unsigned xb_ld(unsigned* p)              { return __hip_atomic_load(p, __ATOMIC_RELAXED, __HIP_MEMORY_SCOPE_AGENT); }
__device__ __forceinline__ unsigned xb_add(unsigned* p, unsigned v) { return __hip_atomic_fetch_add(p, v, __ATOMIC_RELAXED, __HIP_MEMORY_SCOPE_AGENT); }
__device__ __forceinline__ unsigned xb_xcc_id() { return (unsigned)__builtin_amdgcn_s_getreg((3 << 11) | 20) & 0xFu; }
#define XB_SPIN(cond, bar) do { unsigned _sp = 0; while (cond) { __builtin_amdgcn_s_sleep(1); \
    if ((++_sp & 255u) == 0u) { if (xb_ld(&(bar)[XB_TMO])) break; if (_sp > XB_SPIN_CAP) { atomicAdd(&(bar)[XB_TMO], 1u); break; } } } } while (0)
struct XcdBarrier { unsigned* bar; unsigned x; volatile LAS unsigned* st; };
__device__ __forceinline__ XcdBarrier xcd_barrier_post(unsigned* bar, volatile LAS unsigned* st) {
  XcdBarrier b; b.bar = bar; b.x = xb_xcc_id(); b.st = st;
  if (threadIdx.x == 0) (void)xb_add(&bar[XB_XCNT(b.x)], 1u);
  return b;
}
__device__ __forceinline__ void xcd_barrier_complete(unsigned* bar, unsigned x, unsigned& nloc, unsigned& nx) {
  const unsigned G = gridDim.x * gridDim.y * gridDim.z;
  unsigned sum, cnt, mine, sp = 0u;
  for (;;) {
    sum = 0u; cnt = 0u; mine = 0u;
#pragma unroll
    for (unsigned j = 0; j < 16; ++j) { const unsigned c = xb_ld(&bar[XB_XCNT(j)]); sum += c; cnt += (c > 0u) ? 1u : 0u; mine = (j == x) ? c : mine; }
    if (sum == G) break;
    __builtin_amdgcn_s_sleep(1);
    if ((++sp & 255u) == 0u) { if (xb_ld(&bar[XB_TMO])) break; if (sp > XB_SPIN_CAP) { atomicAdd(&bar[XB_TMO], 1u); break; } }
  }
  nloc = mine > 0u ? mine : 1u; nx = cnt > 0u ? cnt : 1u;
}
__device__ __forceinline__ void xcd_barrier(const XcdBarrier& b) {
  asm volatile("s_waitcnt vmcnt(0)" ::: "memory");
  __syncthreads();
  if (threadIdx.x == 0) {
    unsigned* bar = b.bar;
    __builtin_amdgcn_s_waitcnt(0);
    unsigned nloc = b.st[0], nx = b.st[1];
    if (nloc == 0u) { xcd_barrier_complete(bar, b.x, nloc, nx); b.st[0] = nloc; b.st[1] = nx; }
    const unsigned old = xb_add(&bar[XB_XSUB(b.x)], 1u);
    const unsigned gen = old / nloc;
    if (old + 1u == (gen + 1u) * nloc) {
      __builtin_amdgcn_fence(__ATOMIC_RELEASE, "agent");
      asm volatile("s_waitcnt vmcnt(0)" ::: "memory");
      const unsigned og = xb_add(&bar[XB_TOP], 1u);
      const unsigned tg = og / nx;
      if (og + 1u == (tg + 1u) * nx) xb_add(&bar[XB_TOPGEN], 1u);
      else XB_SPIN(xb_ld(&bar[XB_TOPGEN]) == tg, bar);
      __builtin_amdgcn_fence(__ATOMIC_ACQUIRE, "agent");
      xb_add(&bar[XB_XGEN(b.x)], 1u);
      asm volatile("s_waitcnt vmcnt(0)" ::: "memory");
    } else {
      XB_SPIN(xb_ld(&bar[XB_XGEN(b.x)]) == gen, bar);
      __builtin_amdgcn_fence(__ATOMIC_ACQUIRE, "agent");
      asm volatile("s_waitcnt vmcnt(0)" ::: "memory");
    }
  }
  __syncthreads();
}

namespace pg8 {
constexpr int BM = 256, BK = 64, HALF = 128, HTB = HALF * BK * 2, STAGE_BYTES = 8 * HTB, NXCD = 8, WGM = 8;
__host__ __device__ __forceinline__ int lds_byte(int r, int c) { const int st = (r >> 4) * 2 + (c >> 5), rr = r & 15, cc = c & 31, ob = rr * 64 + cc * 2; return st * 1024 + (ob ^ (((ob >> 9) & 1) << 5)); }
__host__ __device__ __forceinline__ void stage_rc(int b, int& R, int& C) { const int st = b / 1024, sb = b % 1024, swz = sb ^ (((sb >> 9) & 1) << 5); R = (st >> 1) * 16 + swz / 64; C = (st & 1) * 32 + (swz % 64) / 2; }
struct Unit { int pm, pn; };
struct Gemm { const bf16_t* A; const bf16_t* Bt; int M, N, K; };
struct StaticOrder {
  int nM, nN, nwg, G, c;
  __device__ void init(int M, int N, int G_, int c_) { nM = M / BM; nN = N / BM; nwg = nM * nN; G = G_; c = c_; }
  __device__ bool next(int i, Unit& u) const {
    const long L = (long)i * G + c; if (L >= nwg) return false;
    int wgid = (int)L; { const int q = nwg / NXCD, r = nwg % NXCD, xcd = wgid % NXCD, off = wgid / NXCD; wgid = (xcd < r ? xcd * (q + 1) : r * (q + 1) + (xcd - r) * q) + off; }
    const int nig = WGM * nN, gid = wgid / nig, fm = gid * WGM, gsz = (nM - fm) < WGM ? (nM - fm) : WGM;
    u.pm = fm + ((wgid % nig) % gsz); u.pn = (wgid % nig) / gsz; return true;
  }
};

template <class Epi>
__device__ __forceinline__ void gemm_phase(LP lds, const Gemm g, const StaticOrder& S, const Epi& E) {
  int tid_ = threadIdx.x; asm volatile("" : "+v"(tid_));
  const int tid = tid_, wid = __builtin_amdgcn_readfirstlane(tid >> 6), lane = tid & 63, wr = wid >> 2, wc = wid & 3, fr = lane & 15, fq = lane >> 4;
  const int K = g.K, nt = K / BK;
  unsigned voffA[2], voffB[2];
#pragma unroll
  for (int i = 0; i < 2; ++i) { int R, C; stage_rc(tid * 16 + i * 8192, R, C); voffA[i] = (unsigned)(R * K + C) * 2u; voffB[i] = voffA[i]; }
  const size_t kstep = (size_t)(BK * 2);
  const size_t hstep = (size_t)HALF * K * 2;
  const size_t tstep = 2 * hstep;
  const unsigned ldsw = (unsigned)wid * 1024u;
  const int aoff = lds_byte(wr * 64 + fr, fq * 8), boff = lds_byte(wc * 32 + fr, fq * 8);
#define PG8_SA(b, h) (((b) * 2 + (h)) * HTB)
#define PG8_SB(b, h) ((4 + (b) * 2 + (h)) * HTB)
#define PG8_STAGE(bufoff, gbase, voff) do { _Pragma("unroll") for (int _i = 0; _i < 2; ++_i) \
    __builtin_amdgcn_global_load_lds((const unsigned*)((const char*)(gbase) + (voff)[_i]), (LAS unsigned*)(lds + (bufoff) + ldsw + _i * 8192), 16, 0, 0); } while (0)
#define PG8_LDA(dst, b, h) do { _Pragma("unroll") for (int m = 0; m < 4; ++m) _Pragma("unroll") for (int k = 0; k < 2; ++k) dst[m][k] = *(const LAS bf16x8*)(lds + PG8_SA(b, h) + aoff + m * 2048 + k * 1024); } while (0)
#define PG8_LDB(dst, b, h) do { _Pragma("unroll") for (int n = 0; n < 2; ++n) _Pragma("unroll") for (int k = 0; k < 2; ++k) dst[n][k] = *(const LAS bf16x8*)(lds + PG8_SB(b, h) + boff + n * 2048 + k * 1024); } while (0)
#define PG8_MMA(ai, bj, At, Bt) do { __builtin_amdgcn_s_setprio(1); _Pragma("unroll") for (int m = 0; m < 4; ++m) _Pragma("unroll") for (int n = 0; n < 2; ++n) _Pragma("unroll") for (int k = 0; k < 2; ++k) \
    acc[ai][bj][m][n] = __builtin_amdgcn_mfma_f32_16x16x32_bf16(Bt[n][k], At[m][k], acc[ai][bj][m][n], 0, 0, 0); __builtin_amdgcn_s_setprio(0); } while (0)
#define PG8_WAIT_V(n) asm volatile("s_waitcnt vmcnt(" #n ")" ::: "memory")
#define PG8_WAIT_L(n) asm volatile("s_waitcnt lgkmcnt(" #n ")" ::: "memory")
#define PG8_BAR __builtin_amdgcn_s_barrier()
#define PG8_SCHED __builtin_amdgcn_sched_barrier(0)
  Unit cur, nxt; int ui = 0;
  if (!S.next(0, cur)) return;
  f32x4 acc[2][2][4][2];
#pragma unroll
  for (int a = 0; a < 2; ++a)
#pragma unroll
    for (int b = 0; b < 2; ++b)
#pragma unroll
      for (int m = 0; m < 4; ++m)
#pragma unroll
        for (int n = 0; n < 2; ++n) acc[a][b][m][n] = (f32x4){0.f, 0.f, 0.f, 0.f};
  bf16x8 At[4][2], B0[2][2], B1[2][2];
  const char* cA = (const char*)g.A + (size_t)cur.pm * tstep; const char* cB = (const char*)g.Bt + (size_t)cur.pn * tstep;
  PG8_STAGE(PG8_SB(0, 0), cB, voffB); PG8_STAGE(PG8_SA(0, 0), cA, voffA); PG8_STAGE(PG8_SB(0, 1), cB + hstep, voffB); PG8_STAGE(PG8_SA(0, 1), cA + hstep, voffA);
  if (wr == 1) PG8_BAR;
  PG8_WAIT_V(4); PG8_BAR;
  PG8_STAGE(PG8_SB(1, 0), cB + kstep, voffB); PG8_STAGE(PG8_SA(1, 0), cA + kstep, voffA); PG8_STAGE(PG8_SB(1, 1), cB + hstep + kstep, voffB);
  PG8_WAIT_V(6); PG8_BAR;
  for (;;) {
    const bool has_next = S.next(ui + 1, nxt);
    const char* nA = has_next ? (const char*)g.A + (size_t)nxt.pm * tstep : cA; const char* nB = has_next ? (const char*)g.Bt + (size_t)nxt.pn * tstep : cB;
    for (int t = 0; t < nt; t += 2) {
      const bool last = (t == nt - 2);
      const char* a1 = cA + (size_t)(t + 1) * kstep;
      const char* a2 = last ? nA : cA + (size_t)(t + 2) * kstep; const char* b2 = last ? nB : cB + (size_t)(t + 2) * kstep;
      const char* a3 = a2 + kstep; const char* b3 = b2 + kstep;
      PG8_LDB(B0, 0, 0); PG8_SCHED; PG8_LDA(At, 0, 0); PG8_STAGE(PG8_SA(1, 1), a1 + hstep, voffA);
      PG8_WAIT_L(8); PG8_BAR; PG8_WAIT_L(0); PG8_MMA(0, 0, At, B0); PG8_BAR; PG8_SCHED;
      PG8_LDB(B1, 0, 1); PG8_STAGE(PG8_SB(0, 0), b2, voffB);
      PG8_BAR; PG8_WAIT_L(0); PG8_MMA(0, 1, At, B1); PG8_BAR;
      PG8_LDA(At, 0, 1); PG8_STAGE(PG8_SA(0, 0), a2, voffA);
      PG8_BAR; PG8_WAIT_L(0); PG8_MMA(1, 0, At, B0); PG8_BAR; PG8_SCHED;
      PG8_STAGE(PG8_SB(0, 1), b2 + hstep, voffB);
      PG8_WAIT_V(6); PG8_BAR; PG8_MMA(1, 1, At, B1); PG8_BAR;
      PG8_LDB(B0, 1, 0); PG8_SCHED; PG8_LDA(At, 1, 0); PG8_STAGE(PG8_SA(0, 1), a2 + hstep, voffA);
      PG8_WAIT_L(8); PG8_BAR; PG8_WAIT_L(0); PG8_MMA(0, 0, At, B0); PG8_BAR; PG8_SCHED;
      PG8_LDB(B1, 1, 1); PG8_STAGE(PG8_SB(1, 0), b3, voffB);
      PG8_BAR; PG8_WAIT_L(0); PG8_MMA(0, 1, At, B1); PG8_BAR;
      PG8_LDA(At, 1, 1); PG8_STAGE(PG8_SA(1, 0), a3, voffA);
      PG8_BAR; PG8_WAIT_L(0); PG8_MMA(1, 0, At, B0); PG8_BAR; PG8_SCHED;
      PG8_STAGE(PG8_SB(1, 1), b3 + hstep, voffB);
      PG8_WAIT_V(6); PG8_BAR; PG8_MMA(1, 1, At, B1); PG8_BAR;
    }
    { int fr2 = fr, fq2 = fq; asm volatile("" : "+v"(fr2), "+v"(fq2)); E(acc, cur, wr, wc, fr2, fq2); }
    if (!has_next) break;
#pragma unroll
    for (int a = 0; a < 2; ++a)
#pragma unroll
      for (int b = 0; b < 2; ++b)
#pragma unroll
        for (int m = 0; m < 4; ++m)
#pragma unroll
          for (int n = 0; n < 2; ++n) acc[a][b][m][n] = (f32x4){0.f, 0.f, 0.f, 0.f};
    cur = nxt; cA = nA; cB = nB; ++ui;
  }
  PG8_WAIT_V(0);
  if (wr == 0) PG8_BAR;
  PG8_BAR;
#undef PG8_SA
#undef PG8_SB
#undef PG8_STAGE
#undef PG8_LDA
#undef PG8_LDB
#undef PG8_MMA
#undef PG8_WAIT_V
#undef PG8_WAIT_L
#undef PG8_BAR
#undef PG8_SCHED
}
}
using pg8::Unit;
typedef f32x4 AccT[2][2][4][2];

#define EPI_ROW(ai, m) (u.pm * 256 + (ai) * 128 + wr * 64 + (m) * 16 + fr)
#define EPI_COL(bj, n) (u.pn * 256 + (bj) * 128 + wc * 32 + (n) * 16 + 4 * fq)
#define EPI_LOOP_ROWS _Pragma("unroll") for (int ai = 0; ai < 2; ++ai) _Pragma("unroll") for (int m = 0; m < 4; ++m)
#define EPI_LOOP_COLS _Pragma("unroll") for (int bj = 0; bj < 2; ++bj) _Pragma("unroll") for (int n = 0; n < 2; ++n)

__device__ __forceinline__ int cond_of_row(int row) { return row < NCTX ? 0 : 1 + ((row - NCTX) >> 11); }

struct EpiQKV {
  bf16_t* O; const float* bias;
  __device__ __forceinline__ void operator()(const AccT& acc, const Unit& u, int wr, int wc, int fr, int fq) const {
    const float sc = (u.pn < 4) ? 0.0625f : 1.0f;
    EPI_LOOP_COLS { const int col = EPI_COL(bj, n); const f32x4 bv = *(const f32x4*)(bias + col);
      EPI_LOOP_ROWS { const int row = EPI_ROW(ai, m); const f32x4 v = (acc[ai][bj][m][n] + bv) * sc;
        u32x2 w; w.x = pack2(v[0], v[1]); w.y = pack2(v[2], v[3]); *(u32x2*)(O + (size_t)row * 3072 + col) = w; } }
  }
};
struct EpiUT {
  bf16_t* O; const float* bias;
  __device__ __forceinline__ void operator()(const AccT& acc, const Unit& u, int wr, int wc, int fr, int fq) const {
    EPI_LOOP_ROWS { const int row = EPI_ROW(ai, m); const float bv = bias[row];
      EPI_LOOP_COLS { const int col = EPI_COL(bj, n); const f32x4 v = acc[ai][bj][m][n] + bv;
        u32x2 w; w.x = pack2(v[0], v[1]); w.y = pack2(v[2], v[3]); *(u32x2*)(O + (size_t)row * NTOK + col) = w; } }
  }
};
struct EpiGates {
  bf16_t* H; bf16_t* G; const float* b_in;
  __device__ __forceinline__ void operator()(const AccT& acc, const Unit& u, int wr, int wc, int fr, int fq) const {
    const bool og = u.pn < 4;
    EPI_LOOP_COLS { const int col = EPI_COL(bj, n); const f32x4 bv = *(const f32x4*)(b_in + (og ? 3072 + col : 7184 + (col - 1024)));
      EPI_LOOP_ROWS { const int row = EPI_ROW(ai, m); const f32x4 a = acc[ai][bj][m][n] + bv;
        f32x4 s; s[0] = sigmoidf_(a[0]); s[1] = sigmoidf_(a[1]); s[2] = sigmoidf_(a[2]); s[3] = sigmoidf_(a[3]);
        if (og) { bf16_t* hp = H + (size_t)row * 1024 + col; const u32x2 hv = *(const u32x2*)hp;
          u32x2 w; w.x = pack2(bflo(hv.x) * s[0], bfhi(hv.x) * s[1]); w.y = pack2(bflo(hv.y) * s[2], bfhi(hv.y) * s[3]); *(u32x2*)hp = w; }
        else { u32x2 w; w.x = pack2(s[0], s[1]); w.y = pack2(s[2], s[3]); *(u32x2*)(G + (size_t)row * 2048 + (col - 1024)) = w; } } }
  }
};
template <int SECOND> struct EpiMerge {
  bf16_t* T; const bf16_t* G;
  __device__ __forceinline__ void operator()(const AccT& acc, const Unit& u, int wr, int wc, int fr, int fq) const {
    EPI_LOOP_ROWS { const int row = EPI_ROW(ai, m);
      EPI_LOOP_COLS { const int col = EPI_COL(bj, n); const f32x4 a = acc[ai][bj][m][n];
        const u32x2 gv = *(const u32x2*)(G + (size_t)row * 2048 + SECOND * 1024 + col);
        f32x4 v; v[0] = bflo(gv.x) * a[0]; v[1] = bfhi(gv.x) * a[1]; v[2] = bflo(gv.y) * a[2]; v[3] = bfhi(gv.y) * a[3];
        bf16_t* tp = T + (size_t)row * 1024 + col;
        if (SECOND) { const u32x2 tv = *(const u32x2*)tp; v[0] += bflo(tv.x); v[1] += bfhi(tv.x); v[2] += bflo(tv.y); v[3] += bfhi(tv.y); }
        u32x2 w; w.x = pack2(v[0], v[1]); w.y = pack2(v[2], v[3]); *(u32x2*)tp = w; } }
  }
};
struct EpiOut {
  const float* xp; const float* xs; const float* per; const float* pec; const float* mod; const float* n2w; float* X1; bf16_t* A2; float* ssq;
  __device__ __forceinline__ void operator()(const AccT& acc, const Unit& u, int wr, int wc, int fr, int fq) const {
    const int cb = cond_of_row(u.pm * 256); const float* md = mod + cb * 6144;
    EPI_LOOP_ROWS { const int row = EPI_ROW(ai, m); float ss = 0.f;
      EPI_LOOP_COLS { const int col = EPI_COL(bj, n); const f32x4 a = acc[ai][bj][m][n];
        f32x4 x0;
        if (row < NCTX) x0 = *(const f32x4*)(xp + (size_t)row * 1024 + col);
        else { const int r2 = row - NCTX, t = r2 & 2047; x0 = *(const f32x4*)(xs + (size_t)r2 * 1024 + col);
          const f32x4 pe = (col < 512) ? *(const f32x4*)(per + (t >> 6) * 512 + col) : *(const f32x4*)(pec + (t & 63) * 512 + (col - 512)); x0 += pe; }
        const f32x4 g1 = *(const f32x4*)(md + 2048 + col); const f32x4 sc2 = *(const f32x4*)(md + 4096 + col); const f32x4 nw = *(const f32x4*)(n2w + col);
        const f32x4 x1 = x0 + g1 * a; *(f32x4*)(X1 + (size_t)row * 1024 + col) = x1;
        ss += x1[0] * x1[0] + x1[1] * x1[1] + x1[2] * x1[2] + x1[3] * x1[3];
        const f32x4 av = x1 * nw * (sc2 + 1.0f); u32x2 w; w.x = pack2(av[0], av[1]); w.y = pack2(av[2], av[3]); *(u32x2*)(A2 + (size_t)row * 1024 + col) = w; }
      ss += __shfl_xor(ss, 16); ss += __shfl_xor(ss, 32);
      if (fq == 0) ssq[(size_t)row * 16 + u.pn * 4 + wc] = ss; }
  }
};
struct EpiFF1 {
  int row0; const float* ssq; const float* c1; bf16_t* Hd;
  __device__ __forceinline__ void operator()(const AccT& acc, const Unit& u, int wr, int wc, int fr, int fq) const {
    const int cb = cond_of_row(row0 + u.pm * 256); const float* cc = c1 + cb * 4096;
    EPI_LOOP_ROWS { const int rl = EPI_ROW(ai, m); const float* sp = ssq + (size_t)(row0 + rl) * 16;
      const f32x4 s0 = *(const f32x4*)sp, s1 = *(const f32x4*)(sp + 4), s2 = *(const f32x4*)(sp + 8), s3 = *(const f32x4*)(sp + 12);
      const f32x4 st = s0 + s1 + s2 + s3; const float rstd = rsqrtf((st[0] + st[1] + st[2] + st[3]) * (1.0f / 1024.0f) + 1e-6f);
      EPI_LOOP_COLS { const int col = EPI_COL(bj, n); const f32x4 cv = *(const f32x4*)(cc + col); f32x4 v = acc[ai][bj][m][n] * rstd + cv;
#pragma unroll
        for (int e = 0; e < 4; ++e) { const float r = fmaxf(v[e], 0.f); v[e] = r * r; }
        u32x2 w; w.x = pack2(v[0], v[1]); w.y = pack2(v[2], v[3]); *(u32x2*)(Hd + (size_t)rl * 4096 + col) = w; } }
  }
};
struct EpiFF2 {
  int row0; const float* mod; const float* b2; float* X; float* ssq;
  __device__ __forceinline__ void operator()(const AccT& acc, const Unit& u, int wr, int wc, int fr, int fq) const {
    const int cb = cond_of_row(row0 + u.pm * 256); const float* md = mod + cb * 6144;
    EPI_LOOP_ROWS { const int row = row0 + EPI_ROW(ai, m); float ss = 0.f;
      EPI_LOOP_COLS { const int col = EPI_COL(bj, n); const f32x4 g2 = *(const f32x4*)(md + 5120 + col); const f32x4 bb = *(const f32x4*)(b2 + col);
        float* xp = X + (size_t)row * 1024 + col; const f32x4 x2 = *(const f32x4*)xp + g2 * (acc[ai][bj][m][n] + bb); *(f32x4*)xp = x2;
        ss += x2[0] * x2[0] + x2[1] * x2[1] + x2[2] * x2[2] + x2[3] * x2[3]; }
      ss += __shfl_xor(ss, 16); ss += __shfl_xor(ss, 32);
      if (fq == 0) ssq[(size_t)row * 16 + u.pn * 4 + wc] = ss; }
  }
};

template <class Epi> __device__ __forceinline__ void run_gemm(LP lds, const bf16_t* A, const bf16_t* Bt, int M, int N, int K, const Epi& E) {
  pg8::Gemm g; g.A = A; g.Bt = Bt; g.M = M; g.N = N; g.K = K;
  pg8::StaticOrder S; S.init(M, N, (int)gridDim.x, (int)blockIdx.x);
  pg8::gemm_phase<Epi>(lds, g, S, E);
}

__device__ void transpose_tile(const float* __restrict__ src, int ld, int col0, int k0, bf16_t* __restrict__ dst, int K, int drow0, LAS float* tile) {
  const int t = opaque_tid();
  f32x4 v[4];
#pragma unroll
  for (int i = 0; i < 4; ++i) { const int idx = t + 512 * i, kr = idx >> 5, c4 = idx & 31; v[i] = *(const f32x4*)(src + (size_t)(k0 + kr) * ld + col0 + 4 * c4); }
#pragma unroll
  for (int i = 0; i < 4; ++i) { const int idx = t + 512 * i, kr = idx >> 5, c4 = idx & 31; LAS float* tp = tile + kr * 129 + 4 * c4; tp[0] = v[i][0]; tp[1] = v[i][1]; tp[2] = v[i][2]; tp[3] = v[i][3]; }
  __syncthreads();
  const int kb = t & 7;
#pragma unroll
  for (int i = 0; i < 2; ++i) { const int c = (t >> 3) + 64 * i; const LAS float* tp = tile + (kb * 8) * 129 + c; u32x4 o;
    o.x = pack2(tp[0], tp[129]); o.y = pack2(tp[2 * 129], tp[3 * 129]); o.z = pack2(tp[4 * 129], tp[5 * 129]); o.w = pack2(tp[6 * 129], tp[7 * 129]);
    *(u32x4*)(dst + (size_t)(drow0 + c) * K + k0 + kb * 8) = o; }
  __syncthreads();
}
template <int SILU> __device__ void matvec9_unit(const float* v0, const float* v1, int v1stride, const float* __restrict__ W, int ldw, const float* bias, float* out, int ldo, int col0, LAS float* lf) {
  const int t = opaque_tid(), lane = t & 63, wid = t >> 6;
  LAS float* sv = lf; LAS float* red = lf + 9216;
  for (int i = t; i < 9216; i += 512) { const int b = i >> 10, k = i & 1023; float x = (b == 0) ? v0[k] : v1[(size_t)(b - 1) * v1stride + k]; if (SILU) x = x / (1.0f + __expf(-x)); sv[i] = x; }
  __syncthreads();
  const int c4 = t & 7, kl = t >> 3;
  f32x4 w[16];
#pragma unroll
  for (int i = 0; i < 16; ++i) w[i] = *(const f32x4*)(W + (size_t)(kl + 64 * i) * ldw + col0 + 4 * c4);
  f32x4 acc[9];
#pragma unroll
  for (int b = 0; b < 9; ++b) acc[b] = (f32x4){0.f, 0.f, 0.f, 0.f};
#pragma unroll
  for (int i = 0; i < 16; ++i)
#pragma unroll
    for (int b = 0; b < 9; ++b) acc[b] += w[i] * sv[b * 1024 + kl + 64 * i];
#pragma unroll
  for (int b = 0; b < 9; ++b)
#pragma unroll
    for (int e = 0; e < 4; ++e) { float x = acc[b][e]; x += __shfl_xor(x, 8); x += __shfl_xor(x, 16); x += __shfl_xor(x, 32); acc[b][e] = x; }
  if (lane < 8) {
#pragma unroll
    for (int b = 0; b < 9; ++b) *(LAS f32x4*)(red + (wid * 9 + b) * 32 + 4 * lane) = acc[b]; }
  __syncthreads();
  if (t < 288) { const int b = t >> 5, cc = t & 31; float s = bias[col0 + cc];
#pragma unroll
    for (int pz = 0; pz < 8; ++pz) s += red[(pz * 9 + b) * 32 + cc];
    out[(size_t)b * ldo + col0 + cc] = s; }
  __syncthreads();
}

__device__ void phase0(const Params& p, LP lds) {
  unsigned char* ws = p.ws; LAS float* lf = (LAS float*)lds;
  const int tid0 = opaque_tid(); const int wid = tid0 >> 6, lane = tid0 & 63;
  for (int unit = blockIdx.x; unit < 576; unit += gridDim.x) {
    if (unit < 192) {
      matvec9_unit<1>(p.in[6], p.in[5], 1024, p.in[7], 6144, p.in[8], (float*)(ws + OFF_MOD), 6144, unit * 32, lf);
    } else if (unit < 480) {
      const int row = (unit - 192) * 8 + wid; const bool smp = row < 2048; const int L = smp ? 2048 : 256, t = smp ? row : row - 2048;
      const float* w1 = p.in[14]; const float* b1 = p.in[15]; const float* fr1 = p.in[16]; const float* w2 = p.in[17]; const float* b2 = p.in[18]; const float* fr2 = p.in[19];
      float a = b1[lane] + (float)t / (float)(L - 1) * w1[lane];
      const float base = (6.283185307179586f / (float)L) * (float)t;
      float cs = 0.f, sn = 0.f; if (lane < 16) { const float ang = base * (float)(lane + 1); cs = cosf(ang); sn = sinf(ang); }
#pragma unroll
      for (int i = 0; i < 16; ++i) a += __shfl(cs, i) * w1[(1 + i) * 64 + lane] + __shfl(sn, i) * w1[(17 + i) * 64 + lane];
      const float h1 = sinf(fr1[lane] * a);
      float a2 = b2[lane];
#pragma unroll 16
      for (int j = 0; j < 64; ++j) a2 += __shfl(h1, j) * w2[j * 64 + lane];
      const float h2 = sinf(fr2[lane] * a2);
      float* dst = (float*)(ws + (smp ? OFF_H2S : OFF_H2C)); dst[(size_t)t * 64 + lane] = h2;
    } else {
      const int r = unit - 480, c = tid0; const int pos = r < 32 ? r : r - 32; const int i = c & 255;
      const float omega = 1.0f / powf(10000.0f, (float)i / 256.0f); const float a = (float)pos * omega; const float v = c < 256 ? sinf(a) : cosf(a);
      float* dst = (float*)(ws + (r < 32 ? OFF_PER : OFF_PEC)); dst[(size_t)pos * 512 + c] = v;
    }
  }
}
__device__ void weight_tiles(const Params& p, LP lds) {
  unsigned char* ws = p.ws; LAS float* lf = (LAS float*)lds;
  for (int tu = blockIdx.x; tu < 2560; tu += gridDim.x) {
    const float* src; int ld, K, col0, k0, drow0; bf16_t* dst;
    if (tu < 1152) { const int nt = tu >> 4, kt = tu & 15; const int r = nt * 128; src = p.in[10]; ld = INC; K = 1024; k0 = kt * 64; drow0 = r; dst = (bf16_t*)(ws + OFF_WT);
      col0 = r < 3072 ? r : (r < 6144 ? 4112 + (r - 3072) : (r < 7168 ? 3072 + (r - 6144) : 7184 + (r - 7168))); }
    else if (tu < 1536) { const int v = tu - 1152, w = v >> 7, q = v & 127; src = p.in[23 + w]; ld = 1024; K = 1024; k0 = (q & 15) * 64; col0 = (q >> 4) * 128; drow0 = col0; dst = (bf16_t*)(ws + (w == 0 ? OFF_WBM : (w == 1 ? OFF_WBH : OFF_WOUT))); }
    else if (tu < 2048) { const int q = tu - 1536; src = p.in[27]; ld = 4096; K = 1024; k0 = (q & 15) * 64; col0 = (q >> 4) * 128; drow0 = col0; dst = (bf16_t*)(ws + OFF_W1T); }
    else { const int q = tu - 2048; src = p.in[29]; ld = 1024; K = 4096; k0 = (q & 63) * 64; col0 = (q >> 6) * 128; drow0 = col0; dst = (bf16_t*)(ws + OFF_W2T); }
    transpose_tile(src, ld, col0, k0, dst, K, drow0, lf);
  }
}

__device__ void phase1(const Params& p, LP lds) {
  unsigned char* ws = p.ws;
  int tid_ = threadIdx.x; asm volatile("" : "+v"(tid_));
  const int tid = tid_, wid = tid >> 6, lane = tid & 63;
  const float* mod = (const float*)(ws + OFF_MOD);
  LAS float* wg = (LAS float*)lds;
  if ((int)blockIdx.x < 1536) {
    f32x4 gw[8];
#pragma unroll
    for (int i = 0; i < 8; ++i) { const int idx = tid + 512 * i, k = idx >> 2, q = idx & 3; gw[i] = *(const f32x4*)(p.in[10] + (size_t)k * INC + 4096 + 4 * q); }
#pragma unroll
    for (int i = 0; i < 8; ++i) { const int idx = tid + 512 * i, k = idx >> 2, q = idx & 3; wg[(4 * q) * 1024 + k] = gw[i][0]; wg[(4 * q + 1) * 1024 + k] = gw[i][1]; wg[(4 * q + 2) * 1024 + k] = gw[i][2]; wg[(4 * q + 3) * 1024 + k] = gw[i][3]; }
    __syncthreads();
  }
  for (int unit = blockIdx.x; unit < 1536; unit += gridDim.x) {
    const int tidn = opaque_tid(); const int wid = tidn >> 6, lane = tidn & 63;
    const int row0 = unit * 16 + wid * 2; const int cb = cond_of_row(row0); const float* md = mod + cb * 6144; const bool smp = row0 >= NCTX;
    f32x4 v[2][4]; float rstd[2];
#pragma unroll
    for (int r = 0; r < 2; ++r) { const int row = row0 + r; const float* xr; int t = 0;
      if (!smp) xr = p.in[0] + (size_t)row * 1024; else { xr = p.in[1] + (size_t)(row - NCTX) * 1024; t = (row - NCTX) & 2047; }
      const float* per = (const float*)(ws + OFF_PER) + (t >> 6) * 512; const float* pec = (const float*)(ws + OFF_PEC) + (t & 63) * 512;
      float ss = 0.f;
#pragma unroll
      for (int i = 0; i < 4; ++i) { const int col = 4 * lane + 256 * i; v[r][i] = *(const f32x4*)(xr + col);
        if (smp) v[r][i] += (col < 512) ? *(const f32x4*)(per + col) : *(const f32x4*)(pec + col - 512);
        ss += v[r][i][0] * v[r][i][0] + v[r][i][1] * v[r][i][1] + v[r][i][2] * v[r][i][2] + v[r][i][3] * v[r][i][3]; }
      ss = wave_sum(ss); rstd[r] = rsqrtf(ss * (1.0f / 1024.0f) + 1e-6f); }
    const float* n1w = p.in[9];
    float ga[32];
#pragma unroll
    for (int g = 0; g < 32; ++g) ga[g] = 0.f;
#pragma unroll
    for (int i = 0; i < 4; ++i) { const int col = 4 * lane + 256 * i;
      const f32x4 w = *(const f32x4*)(n1w + col), sc = *(const f32x4*)(md + 1024 + col), sh = *(const f32x4*)(md + col);
      const f32x4 ws1 = w * (sc + 1.0f);
      f32x4 h[2];
#pragma unroll
      for (int r = 0; r < 2; ++r) { h[r] = v[r][i] * rstd[r] * ws1 + sh;
        u32x2 o; o.x = pack2(h[r][0], h[r][1]); o.y = pack2(h[r][2], h[r][3]); *(u32x2*)((bf16_t*)(ws + OFF_HN) + (size_t)(row0 + r) * 1024 + col) = o; }
#pragma unroll
      for (int g = 0; g < 16; ++g) { const f32x4 wv = *(const LAS f32x4*)(wg + g * 1024 + col);
#pragma unroll
        for (int r = 0; r < 2; ++r) ga[r * 16 + g] += h[r][0] * wv[0] + h[r][1] * wv[1] + h[r][2] * wv[2] + h[r][3] * wv[3]; }
      asm volatile("" ::: "memory"); }
#pragma unroll
    for (int off = 16; off >= 1; off >>= 1) { const bool hi = (lane & off) != 0;
#pragma unroll
      for (int i = 0; i < off; ++i) { const float send = hi ? ga[i] : ga[i + off]; const float keep = hi ? ga[i + off] : ga[i]; ga[i] = keep + __shfl_xor(send, off); } }
    const float tot = ga[0] + __shfl_xor(ga[0], 32);
    if (lane < 32) ((float*)(ws + OFF_GT))[(size_t)row0 * 16 + lane] = tot + p.in[11][4096 + (lane & 15)];
  }
  __syncthreads();
  LAS float* w3s = (LAS float*)lds;
  for (int v = blockIdx.x; v < 320; v += gridDim.x) {
    const int tid = opaque_tid();
    const bool smp = v < 256; const int L = smp ? 2048 : 256; const int tt = smp ? (v >> 6) : 0, cgp = v & 63; const int t = tt * 512 + tid;
    { const f32x4 x = *(const f32x4*)(p.in[20] + (size_t)(tid >> 3) * 2048 + cgp * 32 + 4 * (tid & 7)); LAS float* wp = w3s + (4 * (tid & 7)) * 64 + (tid >> 3);
      wp[0] = x[0]; wp[64] = x[1]; wp[128] = x[2]; wp[192] = x[3]; }
    __syncthreads();
    if (t < L) {
      const float* H2 = (const float*)(ws + (smp ? OFF_H2S : OFF_H2C)) + (size_t)t * 64;
      f32x4 h2[16];
#pragma unroll
      for (int i = 0; i < 16; ++i) h2[i] = *(const f32x4*)(H2 + 4 * i);
      const float dist = fabsf((float)t - (float)(L / 2)) / (float)(L / 2);
      float* HF = (float*)(ws + (smp ? OFF_HFS : OFF_HFC)) + (size_t)(cgp * 32) * L + t;
#pragma unroll 1
      for (int j = 0; j < 32; ++j) {
        f32x4 a = {0.f, 0.f, 0.f, 0.f};
#pragma unroll
        for (int i = 0; i < 16; ++i) a += *(const LAS f32x4*)(w3s + j * 64 + 4 * i) * h2[i];
        const int c = (cgp * 32 + j) & 1023;
        const float dmin = -3.0701134573253946f, dmax = -15.350567286626973f;
        const float delta = fabsf(dmin + (dmax - dmin) * ((float)c / 1023.0f));
        HF[(size_t)j * L] = ((a[0] + a[1]) + (a[2] + a[3])) * __expf(-dist * delta); }
    }
    __syncthreads();
  }
  for (int u = (int)gridDim.x - 1 - (int)blockIdx.x; u < 128; u += gridDim.x)
    matvec9_unit<0>(mod + 3072, mod + 6144 + 3072, 6144, p.in[27], 4096, p.in[28], (float*)(ws + OFF_C1), 4096, u * 32, (LAS float*)lds);
}

__device__ __forceinline__ bf16x8 tr_frag(LP base, int k0, int m0, int pitch  , int l15, int g) {
  const int q = l15 >> 2, pp = l15 & 3;
  LP a = base + ((k0 + 8 * g + q) * pitch + m0 + 4 * pp) * 2;
  const s16x4 lo = __builtin_amdgcn_ds_read_tr16_b64_v4i16((LAS s16x4*)a);
  const s16x4 hi = __builtin_amdgcn_ds_read_tr16_b64_v4i16((LAS s16x4*)(a + 8 * pitch));
  bf16x8 r; r[0] = lo[0]; r[1] = lo[1]; r[2] = lo[2]; r[3] = lo[3]; r[4] = hi[0]; r[5] = hi[1]; r[6] = hi[2]; r[7] = hi[3]; return r;
}
__device__ __forceinline__ bf16x8 tr_at(LP lanebase, int coff  , int pitch_bytes) {
  const s16x4 lo = __builtin_amdgcn_ds_read_tr16_b64_v4i16((LAS s16x4*)(lanebase + coff));
  const s16x4 hi = __builtin_amdgcn_ds_read_tr16_b64_v4i16((LAS s16x4*)(lanebase + coff + 4 * pitch_bytes));
  bf16x8 r; r[0] = lo[0]; r[1] = lo[1]; r[2] = lo[2]; r[3] = lo[3]; r[4] = hi[0]; r[5] = hi[1]; r[6] = hi[2]; r[7] = hi[3]; return r;
}
constexpr int ML_K = 0, ML_V = 67584, ML_P = 86016, ML_C = 120832, ML_T = 157696, ML_TSZ = 1600;
constexpr int KP = 264, VP = 72, PP = 136, CP = 72;

__device__ void mlstm_item(const Params& p, LP lds, int item) {
  const int tid = opaque_tid(), wid = __builtin_amdgcn_readfirstlane(tid >> 6), lane = tid & 63, l15 = lane & 15, g = lane >> 4;
  const bool smp = item < 256; const int uu = smp ? (item >> 2) : ((item - 256) >> 2); const int sl = item & 3;
  const int b = uu >> 3, dir = (uu >> 2) & 1, head = uu & 3;
  const int S = smp ? SEQS : SEQC, nc = S >> 7; const int tok0 = smp ? NCTX + b * SEQS : b * SEQC;
  const bf16_t* qkv = (const bf16_t*)(p.ws + OFF_BIG);
  const float* GT = (const float*)(p.ws + OFF_GT);
  bf16_t* hout = (bf16_t*)((unsigned char*)p.out + (dir ? OUT_HB : OUT_H));
  const int sidx = (b * 2 + dir) * 4 + head;
  const int gi_col = dir * 8 + head, gf_col = dir * 8 + 4 + head;
  f32x4 Cacc[2][4], nacc[2]; float mst0;
  if (smp) {
    const float* C0 = p.in[2] + (size_t)sidx * 65536;
#pragma unroll
    for (int dt = 0; dt < 2; ++dt) {
#pragma unroll
      for (int vt = 0; vt < 4; ++vt) Cacc[dt][vt] = *(const f32x4*)(C0 + (size_t)((2 * wid + dt) * 16 + l15) * 256 + sl * 64 + 16 * vt + 4 * g);
      nacc[dt] = (f32x4){p.in[3][sidx * 256 + (2 * wid + dt) * 16 + l15], 0.f, 0.f, 0.f}; }
    mst0 = p.in[4][sidx];
  } else {
#pragma unroll
    for (int dt = 0; dt < 2; ++dt) {
#pragma unroll
      for (int vt = 0; vt < 4; ++vt) Cacc[dt][vt] = (f32x4){0.f, 0.f, 0.f, 0.f};
      nacc[dt] = (f32x4){0.f, 0.f, 0.f, 0.f}; }
    mst0 = 0.f;
  }
#define TOKC(cc, j) (dir ? (tok0 + S - 1 - ((cc) * 128 + (j))) : (tok0 + (cc) * 128 + (j)))
  const int rt = (wid < 4) ? wid : 11 - wid;
  const int jrow = 16 * rt + l15;
  bf16x8 qf[8]; u32x4 kreg[8], vreg[2]; float g4[4] = {0.f, 0.f, 0.f, 0.f};
#define ML_LOAD_Q(cc) do { const bf16_t* qp = qkv + (size_t)TOKC(cc, jrow) * 3072 + head * 256 + 8 * g; \
    _Pragma("unroll") for (int kk = 0; kk < 8; ++kk) qf[kk] = *(const bf16x8*)(qp + 32 * kk); } while (0)
#define ML_LOAD_KV(cc) do { \
    _Pragma("unroll") for (int i = 0; i < 8; ++i) { const int row = (tid >> 5) + 16 * i; kreg[i] = *(const u32x4*)(qkv + (size_t)TOKC(cc, row) * 3072 + 1024 + head * 256 + (tid & 31) * 8); } \
    _Pragma("unroll") for (int i = 0; i < 2; ++i) { const int row = (tid >> 3) + 64 * i; vreg[i] = *(const u32x4*)(qkv + (size_t)TOKC(cc, row) * 3072 + 2048 + head * 256 + sl * 64 + (tid & 7) * 8); } \
    if (wid == 0) { const float* g0 = GT + (size_t)TOKC(cc, 2 * lane) * 16; const float* g1 = GT + (size_t)TOKC(cc, 2 * lane + 1) * 16; g4[0] = g0[gi_col]; g4[1] = g0[gf_col]; g4[2] = g1[gi_col]; g4[3] = g1[gf_col]; } } while (0)
#define ML_SCAN(tabp, mcur, mnext) do { LAS float* T_ = (LAS float*)(tabp); \
    const float lf0 = fminf(g4[1], 0.f) - log1pf(__expf(-fabsf(g4[1]))), lf1 = fminf(g4[3], 0.f) - log1pf(__expf(-fabsf(g4[3]))); \
    float s_ = lf0 + lf1; \
    _Pragma("unroll") for (int o = 1; o < 64; o <<= 1) { const float t_ = __shfl_up(s_, o); if (lane >= o) s_ += t_; } \
    const float b1_ = s_, b0_ = s_ - lf1; const float u0_ = g4[0] - b0_, u1_ = g4[2] - b1_; \
    float mx_ = fmaxf(u0_, u1_); \
    _Pragma("unroll") for (int o = 1; o < 64; o <<= 1) { const float t_ = __shfl_up(mx_, o); if (lane >= o) mx_ = fmaxf(mx_, t_); } \
    float ex_ = __shfl_up(mx_, 1); if (lane == 0) ex_ = -INFINITY; \
    const float M0_ = fmaxf(mcur, fmaxf(ex_, u0_)), M1_ = fmaxf(mcur, mx_); \
    T_[2 * lane] = u0_; T_[2 * lane + 1] = u1_; T_[128 + 2 * lane] = M0_; T_[128 + 2 * lane + 1] = M1_; T_[256 + 2 * lane] = b0_; T_[256 + 2 * lane + 1] = b1_; \
    const float Ml_ = __shfl(M1_, 63), bl_ = __shfl(b1_, 63); \
    if (lane == 0) { T_[384] = mcur; T_[385] = Ml_; } \
    mnext = bl_ + Ml_; } while (0)
  float mw0 = mst0;
  ML_LOAD_Q(0); ML_LOAD_KV(0);
  if (wid == 0) { float mn; ML_SCAN(lds + ML_T, mw0, mn); mw0 = mn; }
  __syncthreads();
  float m_final = 0.f;
  for (int c = 0; c < nc; ++c) {
    LAS float* T = (LAS float*)(lds + ML_T + (c & 1) * ML_TSZ);
    const float mst = T[384], M_last = T[385];
#pragma unroll
    for (int i = 0; i < 8; ++i) { const int row = (tid >> 5) + 16 * i; *(LAS u32x4*)(lds + ML_K + (row * KP + (tid & 31) * 8) * 2) = kreg[i]; }
#pragma unroll
    for (int i = 0; i < 2; ++i) { const int row = (tid >> 3) + 64 * i; const float w = __expf(T[row] - M_last); const u32x4 v = vreg[i]; u32x4 o;
      o.x = pack2(bflo(v.x) * w, bfhi(v.x) * w); o.y = pack2(bflo(v.y) * w, bfhi(v.y) * w); o.z = pack2(bflo(v.z) * w, bfhi(v.z) * w); o.w = pack2(bflo(v.w) * w, bfhi(v.w) * w);
      *(LAS u32x4*)(lds + ML_V + (row * VP + (tid & 7) * 8) * 2) = o; }
    if (tid < 128) *(LAS unsigned short*)(lds + ML_V + (tid * VP + 64) * 2) = f2bf(__expf(T[tid] - M_last));
#pragma unroll
    for (int dt = 0; dt < 2; ++dt) {
#pragma unroll
      for (int vt = 0; vt < 4; ++vt) { u32x2 w; w.x = pack2(Cacc[dt][vt][0], Cacc[dt][vt][1]); w.y = pack2(Cacc[dt][vt][2], Cacc[dt][vt][3]);
        *(LAS u32x2*)(lds + ML_C + (((2 * wid + dt) * 16 + l15) * CP + 16 * vt + 4 * g) * 2) = w; }
      if (g == 0) *(LAS unsigned short*)(lds + ML_C + (((2 * wid + dt) * 16 + l15) * CP + 64) * 2) = f2bf(nacc[dt][0]); }
    const int qtok = TOKC(c, jrow);
    const bool more = (c + 1 < nc);
    __syncthreads();
    const float Mj = T[128 + jrow], bj = T[256 + jrow]; const float rf = __expf(M_last - Mj), w_inter = __expf(mst - Mj);
    int lq_ = (8 * g + (l15 >> 2)), lp_ = 4 * (l15 & 3); asm volatile("" : "+v"(lq_), "+v"(lp_));
    const LP cB = lds + ML_C + (lq_ * CP + lp_) * 2, vB = lds + ML_V + (lq_ * VP + lp_) * 2, kB = lds + ML_K + (lq_ * KP + lp_ + 32 * wid) * 2;
    const LP pB = lds + ML_P + (jrow * PP + 8 * g) * 2;
    for (int st = 0; st <= rt; ++st) {
      f32x4 s = {0.f, 0.f, 0.f, 0.f};
      bf16x8 kfr[8];
#pragma unroll
      for (int kk = 0; kk < 8; ++kk) kfr[kk] = *(const LAS bf16x8*)(lds + ML_K + ((16 * st + l15) * KP + 32 * kk + 8 * g) * 2);
      __builtin_amdgcn_sched_barrier(0);
#pragma unroll
      for (int kk = 0; kk < 8; ++kk) s = __builtin_amdgcn_mfma_f32_16x16x32_bf16(kfr[kk], qf[kk], s, 0, 0, 0);
      float pv[4];
#pragma unroll
      for (int i = 0; i < 4; ++i) pv[i] = ((16 * st + 4 * g + i) <= jrow) ? s[i] * rf : 0.f;
      u32x2 w; w.x = pack2(pv[0], pv[1]); w.y = pack2(pv[2], pv[3]);
      *(LAS u32x2*)(lds + ML_P + (jrow * PP + 16 * st + 4 * g) * 2) = w;
    }
    if ((rt & 1) == 0) { u32x2 z; z.x = 0u; z.y = 0u; *(LAS u32x2*)(lds + ML_P + (jrow * PP + 16 * (rt + 1) + 4 * g) * 2) = z; }
    if (more) ML_LOAD_KV(c + 1);
    asm volatile("s_waitcnt lgkmcnt(0)" ::: "memory");
    f32x4 ha[5];
#pragma unroll
    for (int vt = 0; vt < 5; ++vt) { f32x4 a = {0.f, 0.f, 0.f, 0.f};
      if (smp || c > 0) {
        bf16x8 cfr[8];
#pragma unroll
        for (int kk = 0; kk < 8; ++kk) cfr[kk] = tr_at(cB, (32 * kk * CP + 16 * vt) * 2, CP * 2);
        __builtin_amdgcn_sched_barrier(0);
#pragma unroll
        for (int kk = 0; kk < 8; ++kk) a = __builtin_amdgcn_mfma_f32_16x16x32_bf16(cfr[kk], qf[kk], a, 0, 0, 0);
        a *= w_inter; }
      ha[vt] = a; }
    for (int k2 = 0; k2 <= (rt >> 1); ++k2) {
      const bf16x8 pf = *(const LAS bf16x8*)(pB + k2 * 64);
      bf16x8 vfr[5];
#pragma unroll
      for (int vt = 0; vt < 5; ++vt) vfr[vt] = tr_at(vB + k2 * (32 * VP * 2), (16 * vt) * 2, VP * 2);
      __builtin_amdgcn_sched_barrier(0);
#pragma unroll
      for (int vt = 0; vt < 5; ++vt) ha[vt] = __builtin_amdgcn_mfma_f32_16x16x32_bf16(vfr[vt], pf, ha[vt], 0, 0, 0); }
    { const float den = __shfl(ha[4][0], l15); const float rdd = 1.0f / fmaxf(fabsf(den), __expf(-(bj + Mj)));
#pragma unroll
      for (int vt = 0; vt < 4; ++vt) { const f32x4 a = ha[vt] * rdd; u32x2 w; w.x = pack2(a[0], a[1]); w.y = pack2(a[2], a[3]);
        *(u32x2*)(hout + (size_t)qtok * 1024 + head * 256 + sl * 64 + 16 * vt + 4 * g) = w; } }
    if (more) ML_LOAD_Q(c + 1);
    const bool need_state = (!smp) || more;
    if (need_state) {
      const float decay = __expf(mst - M_last);
#pragma unroll
      for (int dt = 0; dt < 2; ++dt) {
#pragma unroll
        for (int vt = 0; vt < 4; ++vt) Cacc[dt][vt] *= decay;
        nacc[dt] *= decay; }
#pragma unroll
      for (int ks = 0; ks < 4; ++ks) {
        const bf16x8 kf0 = tr_at(kB, (32 * ks * KP) * 2, KP * 2), kf1 = tr_at(kB, (32 * ks * KP + 16) * 2, KP * 2);
        bf16x8 vfr[5];
#pragma unroll
        for (int vt = 0; vt < 5; ++vt) vfr[vt] = tr_at(vB, (32 * ks * VP + 16 * vt) * 2, VP * 2);
        __builtin_amdgcn_sched_barrier(0);
#pragma unroll
        for (int vt = 0; vt < 4; ++vt) { Cacc[0][vt] = __builtin_amdgcn_mfma_f32_16x16x32_bf16(vfr[vt], kf0, Cacc[0][vt], 0, 0, 0); Cacc[1][vt] = __builtin_amdgcn_mfma_f32_16x16x32_bf16(vfr[vt], kf1, Cacc[1][vt], 0, 0, 0); }
        nacc[0] = __builtin_amdgcn_mfma_f32_16x16x32_bf16(vfr[4], kf0, nacc[0], 0, 0, 0); nacc[1] = __builtin_amdgcn_mfma_f32_16x16x32_bf16(vfr[4], kf1, nacc[1], 0, 0, 0);
      }
    }
    if (wid == 0 && more) { float mn; ML_SCAN(lds + ML_T + ((c + 1) & 1) * ML_TSZ, mw0, mn); mw0 = mn; }
    m_final = T[256 + 127] + M_last;
    __syncthreads();
  }
#undef ML_LOAD_Q
#undef ML_LOAD_KV
#undef ML_SCAN
#undef TOKC
  if (!smp) {
    float* oC = p.out + OUTF_C + (size_t)sidx * 65536;
#pragma unroll
    for (int dt = 0; dt < 2; ++dt) {
#pragma unroll
      for (int vt = 0; vt < 4; ++vt) *(f32x4*)(oC + (size_t)((2 * wid + dt) * 16 + l15) * 256 + sl * 64 + 16 * vt + 4 * g) = Cacc[dt][vt];
      if (sl == 0 && g == 0) p.out[OUTF_N + (size_t)sidx * 256 + (2 * wid + dt) * 16 + l15] = nacc[dt][0]; }
    if (sl == 0 && tid == 0) p.out[OUTF_M + sidx] = m_final;
  }
}

__device__ void combine_rows(const Params& p) {
  const int tid0 = opaque_tid(); const int wid = tid0 >> 6, lane = tid0 & 63;
  bf16_t* H = (bf16_t*)((unsigned char*)p.out + OUT_H); const bf16_t* HB = (const bf16_t*)((unsigned char*)p.out + OUT_HB); const float* nw = p.in[22];
  for (int unit = blockIdx.x; unit < 3072; unit += gridDim.x) {
    const int row = unit * 8 + wid; bf16_t* hp = H + (size_t)row * 1024 + 16 * lane; const bf16_t* bp = HB + (size_t)row * 1024 + 16 * lane;
    float v[16]; float ss = 0.f;
#pragma unroll
    for (int i = 0; i < 2; ++i) { const u32x4 a = *(const u32x4*)(hp + 8 * i), bq = *(const u32x4*)(bp + 8 * i);
      v[8 * i + 0] = bflo(a.x) + bflo(bq.x); v[8 * i + 1] = bfhi(a.x) + bfhi(bq.x); v[8 * i + 2] = bflo(a.y) + bflo(bq.y); v[8 * i + 3] = bfhi(a.y) + bfhi(bq.y);
      v[8 * i + 4] = bflo(a.z) + bflo(bq.z); v[8 * i + 5] = bfhi(a.z) + bfhi(bq.z); v[8 * i + 6] = bflo(a.w) + bflo(bq.w); v[8 * i + 7] = bfhi(a.w) + bfhi(bq.w); }
#pragma unroll
    for (int e = 0; e < 16; ++e) ss += v[e] * v[e];
    ss += __shfl_xor(ss, 1); ss += __shfl_xor(ss, 2); ss += __shfl_xor(ss, 4); ss += __shfl_xor(ss, 8);
    const float r = rsqrtf(ss * (1.0f / 256.0f) + 1e-6f);
#pragma unroll
    for (int i = 0; i < 2; ++i) { const f32x4 w0 = *(const f32x4*)(nw + 16 * lane + 8 * i), w1 = *(const f32x4*)(nw + 16 * lane + 8 * i + 4); u32x4 o;
      o.x = pack2(v[8 * i] * r * w0[0], v[8 * i + 1] * r * w0[1]); o.y = pack2(v[8 * i + 2] * r * w0[2], v[8 * i + 3] * r * w0[3]);
      o.z = pack2(v[8 * i + 4] * r * w1[0], v[8 * i + 5] * r * w1[1]); o.w = pack2(v[8 * i + 6] * r * w1[2], v[8 * i + 7] * r * w1[3]);
      *(u32x4*)(hp + 8 * i) = o; }
  }
}

constexpr int HY_WAVE = 18816, HY_HR = 0, HY_ZA = 8576, HY_ZB = 8576 + 5120;
__device__ void hyena_item(const Params& p, LP lds, int item) {
  const int tid = opaque_tid(), wid = __builtin_amdgcn_readfirstlane(tid >> 6), lane = tid & 63, n31 = lane & 31, hh = lane >> 5;
  const bool smp = item < 1024; const int it = smp ? item : item - 1024; const int bset = it >> 7, cgp = it & 127; const int c = cgp * 8 + wid;
  const int L = smp ? 2048 : 256, lgL = smp ? 11 : 8, nblk = L >> 5, lgnb = lgL - 5, ntok = smp ? 2048 : 1024, ntile = smp ? 2 : 1, dmax = L >> 6;
  const int tok0 = smp ? NCTX + bset * 2048 : bset * 1024;
  LP wl = lds + wid * HY_WAVE; LAS float* hr = (LAS float*)(wl + HY_HR);
  const float* HFp = (const float*)(p.ws + (smp ? OFF_HFS : OFF_HFC));
  const bf16_t* UT = (const bf16_t*)(p.ws + OFF_BIG);
  const float* cw = p.in[12]; const float* cbv = p.in[13]; const float* skp = p.in[21];
  { const int uc = 2048 + c; const float w0 = cw[uc], w1 = cw[3072 + uc], w2 = cw[6144 + uc], cb = cbv[uc]; const bf16_t* src = UT + (size_t)uc * NTOK + tok0;
    u32x4 vv[4]; float pvv[4], nxv[4];
#pragma unroll
    for (int i = 0; i < 4; ++i) { const int base = lane * 8 + 512 * i; vv[i] = (u32x4){0u, 0u, 0u, 0u}; pvv[i] = 0.f; nxv[i] = 0.f;
      if (base < ntok) { vv[i] = *(const u32x4*)(src + base); const int tl = base & (L - 1);
        if (tl != 0) pvv[i] = bf2f(src[base - 1]); if (tl + 8 != L) nxv[i] = bf2f(src[base + 8]); } }
#pragma unroll
    for (int i = 0; i < 4; ++i) { const int base = lane * 8 + 512 * i;
      if (base < ntok) { const u32x4 v = vv[i];
        float u[10]; u[0] = pvv[i]; u[1] = bflo(v.x); u[2] = bfhi(v.x); u[3] = bflo(v.y); u[4] = bfhi(v.y); u[5] = bflo(v.z); u[6] = bfhi(v.z); u[7] = bflo(v.w); u[8] = bfhi(v.w); u[9] = nxv[i];
        float o[8];
#pragma unroll
        for (int e = 0; e < 8; ++e) o[e] = cb + w0 * u[e] + w1 * u[e + 1] + w2 * u[e + 2];
        u32x4 w; w.x = pack2(o[0], o[1]); w.y = pack2(o[2], o[3]); w.z = pack2(o[4], o[5]); w.w = pack2(o[6], o[7]);
        *(LAS u32x4*)(wl + HY_ZA + ((base >> 5) * 40 + (base & 31)) * 2) = w; } } }
  const int HRP = L + 96;
  f32x4 fvN[8];
#define HY_FLOAD(o) do { const float* src_ = HFp + (size_t)((o) * 1024 + c) * L; \
    _Pragma("unroll") for (int i = 0; i < 8; ++i) { const int q = lane + 64 * i; fvN[i] = (4 * q < L) ? *(const f32x4*)(src_ + 4 * q) : (f32x4){0.f, 0.f, 0.f, 0.f}; } } while (0)
  HY_FLOAD(0);
  for (int ord = 0; ord < 2; ++ord) {
    { float sa = 0.f;
      f32x4 fv[8];
#pragma unroll
      for (int i = 0; i < 8; ++i) fv[i] = fvN[i];
#pragma unroll
      for (int i = 0; i < 8; ++i) sa += (fabsf(fv[i][0]) + fabsf(fv[i][1])) + (fabsf(fv[i][2]) + fabsf(fv[i][3]));
      sa = wave_sum(sa); const float inv = 1.0f / (sa + 1e-6f);
      asm volatile("s_waitcnt lgkmcnt(0)" ::: "memory");
      LAS bf16_t* E = (LAS bf16_t*)hr; LAS bf16_t* O = E + HRP;
#pragma unroll
      for (int i = 0; i < 8; ++i) { const int q = lane + 64 * i;
        if (4 * q < L) {
#pragma unroll
          for (int e = 0; e < 4; ++e) { const int yy = L - 1 - (4 * q + e); const bf16_t v = f2bf(fv[i][e] * inv); E[32 + yy] = v; O[31 + yy] = v; } } }
      if (lane < 32) { E[lane] = 0; E[32 + L + lane] = 0; O[31 + L + lane] = 0; if (lane < 31) O[lane] = 0; }
      if (lane < 33) O[HRP - 33 + lane] = 0;
      asm volatile("s_waitcnt lgkmcnt(0)" ::: "memory"); }
    if (ord == 0) HY_FLOAD(1);
    LP zin = wl + (ord == 0 ? HY_ZA : HY_ZB); LP zout = wl + (ord == 0 ? HY_ZB : HY_ZA);
    const int gc = ord * 1024 + c; const float w0 = cw[gc], w1 = cw[3072 + gc], w2 = cw[6144 + gc], cb = cbv[gc], sk = skp[ord * 1024 + c];
    const bf16_t* gsrc = UT + (size_t)gc * NTOK + tok0;
    u32x4 gv[4]; unsigned gpv[4], gnx[4];
#pragma unroll
    for (int i = 0; i < 4; ++i) { const int base = lane * 8 + 512 * i; gv[i] = (u32x4){0u, 0u, 0u, 0u}; gpv[i] = 0u; gnx[i] = 0u;
      if (base < ntok) { gv[i] = *(const u32x4*)(gsrc + base); const int tl = base & (L - 1);
        if (tl != 0) gpv[i] = gsrc[base - 1]; if (tl + 8 != L) gnx[i] = gsrc[base + 8]; } }
    f32x16 accs[2];
#pragma unroll
    for (int o2 = 0; o2 < 2; ++o2)
#pragma unroll
      for (int r = 0; r < 16; ++r) accs[o2][r] = 0.f;
    LP fb = wl + HY_HR + ((n31 & 1) ? 0 : (HRP * 2 - 2)) + 2 * ((L >> 1) - 1 - n31 + 8 * hh + 32);
    int cbl[2], ca[2];
#pragma unroll
    for (int ot = 0; ot < 2; ++ot) { const int col = 32 * ot + n31; cbl[ot] = (col >> lgnb) << lgnb; ca[ot] = col & (nblk - 1); }
    const bool two = (ntile == 2);
    {
      LP zero = wl + HY_HR + 16 * hh;
      LP ap = fb + 64 * dmax;
      int bbr0 = ca[0] + dmax, bbr1 = ca[1] + dmax;
      LP bp0 = zin + ((cbl[0] + bbr0) * 40 + 8 * hh) * 2, bp1 = zin + ((cbl[1] + bbr1) * 40 + 8 * hh) * 2;
      for (int d = -dmax; d <= dmax; ++d) {
        u32x4 w0v, w1v;
        w0v.x = *(const LAS unsigned*)(ap); w0v.y = *(const LAS unsigned*)(ap + 4); w0v.z = *(const LAS unsigned*)(ap + 8); w0v.w = *(const LAS unsigned*)(ap + 12);
        w1v.x = *(const LAS unsigned*)(ap + 32); w1v.y = *(const LAS unsigned*)(ap + 36); w1v.z = *(const LAS unsigned*)(ap + 40); w1v.w = *(const LAS unsigned*)(ap + 44);
        const bf16x8 af0 = __builtin_bit_cast(bf16x8, w0v), af1 = __builtin_bit_cast(bf16x8, w1v);
        LP q0 = ((unsigned)bbr0 < (unsigned)nblk) ? bp0 : zero;
        LP q1 = (two && ((unsigned)bbr1 < (unsigned)nblk)) ? bp1 : zero;
        const bf16x8 b00 = *(const LAS bf16x8*)q0, b01 = *(const LAS bf16x8*)(q0 + 32);
        const bf16x8 b10 = *(const LAS bf16x8*)q1, b11 = *(const LAS bf16x8*)(q1 + 32);
        __builtin_amdgcn_sched_barrier(0);
        accs[0] = __builtin_amdgcn_mfma_f32_32x32x16_bf16(af0, b00, accs[0], 0, 0, 0);
        if (two) accs[1] = __builtin_amdgcn_mfma_f32_32x32x16_bf16(af0, b10, accs[1], 0, 0, 0);
        accs[0] = __builtin_amdgcn_mfma_f32_32x32x16_bf16(af1, b01, accs[0], 0, 0, 0);
        if (two) accs[1] = __builtin_amdgcn_mfma_f32_32x32x16_bf16(af1, b11, accs[1], 0, 0, 0);
        ap -= 64; bbr0 -= 1; bbr1 -= 1; bp0 -= 80; bp1 -= 80;
      }
    }
#pragma unroll
    for (int ot = 0; ot < 2; ++ot) {
      if (ot >= ntile) continue;
      const f32x16 acc = accs[ot];
#pragma unroll
      for (int rg = 0; rg < 4; ++rg) {
        const int zo = (((cbl[ot] + ca[ot]) * 40) + 8 * rg + 4 * hh) * 2;
        const u32x2 zv = *(const LAS u32x2*)(zin + zo);
        u32x2 w; w.x = pack2(acc[4 * rg] + sk * bflo(zv.x), acc[4 * rg + 1] + sk * bfhi(zv.x)); w.y = pack2(acc[4 * rg + 2] + sk * bflo(zv.y), acc[4 * rg + 3] + sk * bfhi(zv.y));
        *(LAS u32x2*)(zout + zo) = w;
      }
    }
    asm volatile("s_waitcnt lgkmcnt(0)" ::: "memory");
#pragma unroll
    for (int i = 0; i < 4; ++i) { const int base = lane * 8 + 512 * i;
      if (base < ntok) { const u32x4 v = gv[i];
        float u[10]; u[0] = bf2f(gpv[i]); u[1] = bflo(v.x); u[2] = bfhi(v.x); u[3] = bflo(v.y); u[4] = bfhi(v.y); u[5] = bflo(v.z); u[6] = bfhi(v.z); u[7] = bflo(v.w); u[8] = bfhi(v.w); u[9] = bf2f(gnx[i]);
        LP zp = zout + ((base >> 5) * 40 + (base & 31)) * 2; const u32x4 t = *(const LAS u32x4*)zp;
        float tv[8]; tv[0] = bflo(t.x); tv[1] = bfhi(t.x); tv[2] = bflo(t.y); tv[3] = bfhi(t.y); tv[4] = bflo(t.z); tv[5] = bfhi(t.z); tv[6] = bflo(t.w); tv[7] = bfhi(t.w);
        float o[8];
#pragma unroll
        for (int e = 0; e < 8; ++e) o[e] = (cb + w0 * u[e] + w1 * u[e + 1] + w2 * u[e + 2]) * tv[e];
        u32x4 w; w.x = pack2(o[0], o[1]); w.y = pack2(o[2], o[3]); w.z = pack2(o[4], o[5]); w.w = pack2(o[6], o[7]);
        *(LAS u32x4*)zp = w; } }
    asm volatile("s_waitcnt lgkmcnt(0)" ::: "memory");
  }
  __syncthreads();
  { bf16_t* YH = (bf16_t*)((unsigned char*)p.out + OUT_HB);
    for (int tl = tid; tl < ntok; tl += 512) {
      const int bl = tl >> lgL, tloc = tl & (L - 1); const int zo = ((((bl << lgnb) + (tloc >> 5)) * 40) + (tloc & 31)) * 2;
      unsigned short e[8];
#pragma unroll
      for (int w = 0; w < 8; ++w) e[w] = *(const LAS unsigned short*)(lds + w * HY_WAVE + HY_ZA + zo);
      u32x4 o; o.x = e[0] | ((unsigned)e[1] << 16); o.y = e[2] | ((unsigned)e[3] << 16); o.z = e[4] | ((unsigned)e[5] << 16); o.w = e[6] | ((unsigned)e[7] << 16);
      *(u32x4*)(YH + (size_t)(tok0 + tl) * 1024 + cgp * 8) = o; } }
  __syncthreads();
}

__device__ void final_norm(const Params& p) {
  const int tid0 = opaque_tid(); const int wid = tid0 >> 6, lane = tid0 & 63; const float* fw = p.in[31]; const float* ssq = (const float*)(p.ws + OFF_SSQ2);
  for (int unit = blockIdx.x; unit < 3072; unit += gridDim.x) {
    const int row = unit * 8 + wid; float* xr = p.out + (size_t)row * 1024; const float* sp = ssq + (size_t)row * 16;
    const f32x4 st = *(const f32x4*)sp + *(const f32x4*)(sp + 4) + *(const f32x4*)(sp + 8) + *(const f32x4*)(sp + 12);
    const float rstd = rsqrtf((st[0] + st[1] + st[2] + st[3]) * (1.0f / 1024.0f) + 1e-6f);
#pragma unroll
    for (int i = 0; i < 4; ++i) { const int col = 4 * lane + 256 * i; const f32x4 v = *(const f32x4*)(xr + col) * rstd * *(const f32x4*)(fw + col); *(f32x4*)(xr + col) = v; }
  }
}

__global__ void __launch_bounds__(512, 2) __attribute__((flatten)) mega(Params p) {
  extern __shared__ __attribute__((aligned(16))) unsigned char shm[];
  LP lds = (LP)shm;
  cg::grid_group grid = cg::this_grid();
  volatile LAS unsigned* xst = (volatile LAS unsigned*)(lds + LDS_BYTES - 16);
  if (threadIdx.x == 0) { xst[0] = 0u; xst[1] = 0u; }
  __syncthreads();
  const XcdBarrier xb = xcd_barrier_post((unsigned*)(p.ws + OFF_BAR), xst);
  unsigned char* ws = p.ws;
  const bf16_t* WT = (const bf16_t*)(ws + OFF_WT); const bf16_t* HN = (const bf16_t*)(ws + OFF_HN); bf16_t* BIG = (bf16_t*)(ws + OFF_BIG);
  bf16_t* Hb = (bf16_t*)((unsigned char*)p.out + OUT_H); bf16_t* YH = (bf16_t*)((unsigned char*)p.out + OUT_HB);
  const float* mod = (const float*)(ws + OFF_MOD);
  phase0(p, lds);
  if (gridDim.y == 7u) grid.sync();
  xcd_barrier(xb);
  phase1(p, lds);
  weight_tiles(p, lds);
  xcd_barrier(xb);
  { EpiQKV e; e.O = BIG; e.bias = p.in[11]; run_gemm(lds, HN, WT, NTOK, 3072, 1024, e); }
  xcd_barrier(xb);
  for (int item = blockIdx.x; item < 1280; item += gridDim.x) mlstm_item(p, lds, item);
  xcd_barrier(xb);
  combine_rows(p);
  { EpiUT e; e.O = BIG; e.bias = p.in[11] + 4112; run_gemm(lds, WT + (size_t)3072 * 1024, HN, 3072, NTOK, 1024, e); }
  xcd_barrier(xb);
  for (int item = blockIdx.x; item < 2048; item += gridDim.x) hyena_item(p, lds, item);
  xcd_barrier(xb);
  { EpiGates e; e.H = Hb; e.G = BIG; e.b_in = p.in[11]; run_gemm(lds, HN, WT + (size_t)6144 * 1024, NTOK, 3072, 1024, e); }
  xcd_barrier(xb);
  bf16_t* T = BIG + (size_t)NTOK * 2048;
  { EpiMerge<0> e; e.T = T; e.G = BIG; run_gemm(lds, Hb, (const bf16_t*)(ws + OFF_WBM), NTOK, 1024, 1024, e); }
  { EpiMerge<1> e; e.T = T; e.G = BIG; run_gemm(lds, YH, (const bf16_t*)(ws + OFF_WBH), NTOK, 1024, 1024, e); }
  xcd_barrier(xb);
  { EpiOut e; e.xp = p.in[0]; e.xs = p.in[1]; e.per = (const float*)(ws + OFF_PER); e.pec = (const float*)(ws + OFF_PEC); e.mod = mod; e.n2w = p.in[26];
    e.X1 = p.out; e.A2 = (bf16_t*)(ws + OFF_HN); e.ssq = (float*)(ws + OFF_SSQ1); run_gemm(lds, T, (const bf16_t*)(ws + OFF_WOUT), NTOK, 1024, 1024, e); }
  xcd_barrier(xb);
#define FFN_HALF(ROW0) do { \
    { EpiFF1 e; e.row0 = (ROW0); e.ssq = (const float*)(p.ws + OFF_SSQ1); e.c1 = (const float*)(p.ws + OFF_C1); e.Hd = (bf16_t*)(p.ws + OFF_BIG); \
      run_gemm(lds, (const bf16_t*)(p.ws + OFF_HN) + (size_t)(ROW0) * 1024, (const bf16_t*)(p.ws + OFF_W1T), 12288, 4096, 1024, e); } \
    xcd_barrier(xb); \
    { EpiFF2 e; e.row0 = (ROW0); e.mod = (const float*)(p.ws + OFF_MOD); e.b2 = p.in[30]; e.X = p.out; e.ssq = (float*)(p.ws + OFF_SSQ2); \
      run_gemm(lds, (const bf16_t*)(p.ws + OFF_BIG), (const bf16_t*)(p.ws + OFF_W2T), 12288, 1024, 4096, e); } \
    xcd_barrier(xb); } while (0)
  FFN_HALF(0);
  FFN_HALF(12288);
#undef FFN_HALF
  final_norm(p);
}

extern "C" void kernel_launch(void* const* d_in, const int* in_sizes, int n_in, void* d_out, int out_size, void* d_ws, size_t ws_size, hipStream_t stream) {
  static int grid_blocks = 0;
  if (!grid_blocks) {
    int dev = 0, cus = 0, per_cu = 0;
    hipGetDevice(&dev);
    hipDeviceGetAttribute(&cus, hipDeviceAttributeMultiprocessorCount, dev);
    hipFuncSetAttribute((const void*)mega, hipFuncAttributeMaxDynamicSharedMemorySize, LDS_BYTES);
    hipOccupancyMaxActiveBlocksPerMultiprocessor(&per_cu, (const void*)mega, 512, LDS_BYTES);
    if (per_cu < 1) { fprintf(stderr, "kernel_launch: occupancy query reports %d blocks per CU\n", per_cu); grid_blocks = -1; }
    else grid_blocks = cus;
    if (n_in != 32 || ws_size < WS_END) { fprintf(stderr, "kernel_launch: unexpected n_in %d / ws_size %zu (need %zu)\n", n_in, ws_size, (size_t)WS_END); grid_blocks = -1; }
  }
  if (grid_blocks < 0) return;
  hipMemsetAsync((unsigned char*)d_ws + OFF_BAR, 0, 3456 * 4, stream);
  Params p{};
  for (int i = 0; i < 32; ++i) p.in[i] = (const float*)d_in[i];
  p.out = (float*)d_out; p.ws = (unsigned char*)d_ws;
  void* args[] = {&p};
  hipError_t e = hipLaunchCooperativeKernel((void*)mega, dim3(grid_blocks), dim3(512), args, LDS_BYTES, stream);
  if (e != hipSuccess) fprintf(stderr, "cooperative launch failed: %s (grid %d)\n", hipGetErrorString(e), grid_blocks);
}
```

```cpp
#include <hip/hip_runtime.h>
#include <hip/hip_cooperative_groups.h>
#include <cstdio>
#include <cstdint>
namespace cg = cooperative_groups;

#define LAS __attribute__((address_space(3)))
typedef LAS unsigned char* LP;
typedef unsigned short bf16_t;
typedef short bf16x8 __attribute__((ext_vector_type(8)));
typedef short s16x4 __attribute__((ext_vector_type(4)));
typedef float f32x4 __attribute__((ext_vector_type(4)));
typedef float f32x16 __attribute__((ext_vector_type(16)));
typedef unsigned u32x4 __attribute__((ext_vector_type(4)));
typedef unsigned u32x2 __attribute__((ext_vector_type(2)));

constexpr int DM = 1024, NTOK = 24576, NCTX = 8192, SEQC = 256, SEQS = 2048, INC = 9232;
constexpr int LDS_BYTES = 160 * 1024;
constexpr size_t OFF_WT = 0;
constexpr size_t OFF_WBM = 18874368, OFF_WBH = 20971520, OFF_WOUT = 23068672, OFF_W1T = 25165824, OFF_W2T = 33554432;
constexpr size_t OFF_HN = 41943040;
constexpr size_t OFF_BIG = 92274688;
constexpr size_t OFF_SM = 243269632;
constexpr size_t OFF_MOD = OFF_SM;
constexpr size_t OFF_C1 = OFF_MOD + 221184;
constexpr size_t OFF_H2S = OFF_C1 + 147456;
constexpr size_t OFF_H2C = OFF_H2S + 524288;
constexpr size_t OFF_PER = OFF_H2C + 65536;
constexpr size_t OFF_PEC = OFF_PER + 65536;
constexpr size_t OFF_GT = OFF_PEC + 131072;
constexpr size_t OFF_SSQ1 = OFF_GT + 1572864;
constexpr size_t OFF_SSQ2 = OFF_SSQ1 + 1572864;
constexpr size_t OFF_HFS = OFF_SSQ2 + 1572864;
constexpr size_t OFF_HFC = OFF_HFS + 16777216;
constexpr size_t OFF_BAR = OFF_HFC + 2097152;
constexpr size_t WS_END = OFF_BAR + 3456 * 4;
constexpr size_t OUT_H = 0, OUT_HB = 50331648;
constexpr size_t OUTF_C = 25165824, OUTF_N = 41943040, OUTF_M = 42008576;

struct Params { const float* in[32]; float* out; unsigned char* ws; };

__device__ __forceinline__ bf16_t f2bf(float f) { unsigned u = __float_as_uint(f); u += 0x7FFFu + ((u >> 16) & 1u); return (bf16_t)(u >> 16); }
__device__ __forceinline__ float bf2f(unsigned b) { return __uint_as_float(b << 16); }
__device__ __forceinline__ unsigned pack2(float lo, float hi) { return (unsigned)f2bf(lo) | ((unsigned)f2bf(hi) << 16); }
__device__ __forceinline__ float bflo(unsigned w) { return __uint_as_float(w << 16); }
__device__ __forceinline__ float bfhi(unsigned w) { return __uint_as_float(w & 0xffff0000u); }
__device__ __forceinline__ float sigmoidf_(float x) { return 1.0f / (1.0f + __expf(-x)); }
__device__ __forceinline__ int opaque_tid() { int t = threadIdx.x; asm volatile("" : "+v"(t)); return t; }
__device__ __forceinline__ float wave_sum(float v) {
#pragma unroll
  for (int o = 32; o >= 1; o >>= 1) v += __shfl_xor(v, o);
  return v;
}


#define XB_TMO      128
#define XB_XCNT(j)  (256  + 64 * (j))
#define XB_XSUB(j)  (1280 + 64 * (j))
#define XB_XGEN(j)  (2304 + 64 * (j))
#define XB_TOP      3328
#define XB_TOPGEN   3392
#define XCD_BAR_WORDS 3456
#define XB_SPIN_CAP (1u << 18)
__device__ __forceinline__ unsigned xb_ld(unsigned* p)              { return __hip_atomic_load(p, __ATOMIC_RELAXED, __HIP_MEMORY_SCOPE_AGENT); }
__device__ __forceinline__ unsigned xb_add(unsigned* p, unsigned v) { return __hip_atomic_fetch_add(p, v, __ATOMIC_RELAXED, __HIP_MEMORY_SCOPE_AGENT); }
__device__ __forceinline__ unsigned xb_xcc_id() { return (unsigned)__builtin_amdgcn_s_getreg((3 << 11) | 20) & 0xFu; }
#define XB_SPIN(cond, bar) do { unsigned _sp = 0; while (cond) { __builtin_amdgcn_s_sleep(1); \
    if ((++_sp & 255u) == 0u) { if (xb_ld(&(bar)[XB_TMO])) break; if (_sp > XB_SPIN_CAP) { atomicAdd(&(bar)[XB_TMO], 1u); break; } } } } while (0)
struct XcdBarrier { unsigned* bar; unsigned x; volatile LAS unsigned* st; };
__device__ __forceinline__ XcdBarrier xcd_barrier_post(unsigned* bar, volatile LAS unsigned* st) {
  XcdBarrier b; b.bar = bar; b.x = xb_xcc_id(); b.st = st;
  if (threadIdx.x == 0) (void)xb_add(&bar[XB_XCNT(b.x)], 1u);
  return b;
}
__device__ __forceinline__ void xcd_barrier_complete(unsigned* bar, unsigned x, unsigned& nloc, unsigned& nx) {
  const unsigned G = gridDim.x * gridDim.y * gridDim.z;
  unsigned sum, cnt, mine, sp = 0u;
  for (;;) {
    sum = 0u; cnt = 0u; mine = 0u;
#pragma unroll
    for (unsigned j = 0; j < 16; ++j) { const unsigned c = xb_ld(&bar[XB_XCNT(j)]); sum += c; cnt += (c > 0u) ? 1u : 0u; mine = (j == x) ? c : mine; }
    if (sum == G) break;
    __builtin_amdgcn_s_sleep(1);
    if ((++sp & 255u) == 0u) { if (xb_ld(&bar[XB_TMO])) break; if (sp > XB_SPIN_CAP) { atomicAdd(&bar[XB_TMO], 1u); break; } }
  }
  nloc = mine > 0u ? mine : 1u; nx = cnt > 0u ? cnt : 1u;
}
__device__ __forceinline__ void xcd_barrier(const XcdBarrier& b) {
  asm volatile("s_waitcnt vmcnt(0)" ::: "memory");
  __syncthreads();
  if (threadIdx.x == 0) {
    unsigned* bar = b.bar;
    __builtin_amdgcn_s_waitcnt(0);
    unsigned nloc = b.st[0], nx = b.st[1];
    if (nloc == 0u) { xcd_barrier_complete(bar, b.x, nloc, nx); b.st[0] = nloc; b.st[1] = nx; }
    const unsigned old = xb_add(&bar[XB_XSUB(b.x)], 1u);
    const unsigned gen = old / nloc;
    if (old + 1u == (gen + 1u) * nloc) {
      __builtin_amdgcn_fence(__ATOMIC_RELEASE, "agent");
      asm volatile("s_waitcnt vmcnt(0)" ::: "memory");
      const unsigned og = xb_add(&bar[XB_TOP], 1u);
      const unsigned tg = og / nx;
      if (og + 1u == (tg + 1u) * nx) xb_add(&bar[XB_TOPGEN], 1u);
      else XB_SPIN(xb_ld(&bar[XB_TOPGEN]) == tg, bar);
      __builtin_amdgcn_fence(__ATOMIC_ACQUIRE, "agent");
      xb_add(&bar[XB_XGEN(b.x)], 1u);
      asm volatile("s_waitcnt vmcnt(0)" ::: "memory");
    } else {
      XB_SPIN(xb_ld(&bar[XB_XGEN(b.x)]) == gen, bar);
      __builtin_amdgcn_fence(__ATOMIC_ACQUIRE, "agent");
      asm volatile("s_waitcnt vmcnt(0)" ::: "memory");
    }
  }
  __syncthreads();
}

namespace pg8 {
constexpr int BM = 256, BK = 64, HALF = 128, HTB = HALF * BK * 2, STAGE_BYTES = 8 * HTB, NXCD = 8, WGM = 8;
__host__ __device__ __forceinline__ int lds_byte(int r, int c) { const int st = (r >> 4) * 2 + (c >> 5), rr = r & 15, cc = c & 31, ob = rr * 64 + cc * 2; return st * 1024 + (ob ^ (((ob >> 9) & 1) << 5)); }
__host__ __device__ __forceinline__ void stage_rc(int b, int& R, int& C) { const int st = b / 1024, sb = b % 1024, swz = sb ^ (((sb >> 9) & 1) << 5); R = (st >> 1) * 16 + swz / 64; C = (st & 1) * 32 + (swz % 64) / 2; }
struct Unit { int pm, pn; };
struct Gemm { const bf16_t* A; const bf16_t* Bt; int M, N, K; };
struct StaticOrder {
  int nM, nN, nwg, G, c;
  __device__ void init(int M, int N, int G_, int c_) { nM = M / BM; nN = N / BM; nwg = nM * nN; G = G_; c = c_; }
  __device__ bool next(int i, Unit& u) const {
    const long L = (long)i * G + c; if (L >= nwg) return false;
    int wgid = (int)L; { const int q = nwg / NXCD, r = nwg % NXCD, xcd = wgid % NXCD, off = wgid / NXCD; wgid = (xcd < r ? xcd * (q + 1) : r * (q + 1) + (xcd - r) * q) + off; }
    const int nig = WGM * nN, gid = wgid / nig, fm = gid * WGM, gsz = (nM - fm) < WGM ? (nM - fm) : WGM;
    u.pm = fm + ((wgid % nig) % gsz); u.pn = (wgid % nig) / gsz; return true;
  }
};

template <class Epi>
__device__ __forceinline__ void gemm_phase(LP lds, const Gemm g, const StaticOrder& S, const Epi& E) {
  int tid_ = threadIdx.x; asm volatile("" : "+v"(tid_));
  const int tid = tid_, wid = __builtin_amdgcn_readfirstlane(tid >> 6), lane = tid & 63, wr = wid >> 2, wc = wid & 3, fr = lane & 15, fq = lane >> 4;
  const int K = g.K, nt = K / BK;
  unsigned voffA[2], voffB[2];
#pragma unroll
  for (int i = 0; i < 2; ++i) { int R, C; stage_rc(tid * 16 + i * 8192, R, C); voffA[i] = (unsigned)(R * K + C) * 2u; voffB[i] = voffA[i]; }
  const size_t kstep = (size_t)(BK * 2);
  const size_t hstep = (size_t)HALF * K * 2;
  const size_t tstep = 2 * hstep;
  const unsigned ldsw = (unsigned)wid * 1024u;
  const int aoff = lds_byte(wr * 64 + fr, fq * 8), boff = lds_byte(wc * 32 + fr, fq * 8);
#define PG8_SA(b, h) (((b) * 2 + (h)) * HTB)
#define PG8_SB(b, h) ((4 + (b) * 2 + (h)) * HTB)
#define PG8_STAGE(bufoff, gbase, voff) do { _Pragma("unroll") for (int _i = 0; _i < 2; ++_i) \
    __builtin_amdgcn_global_load_lds((const unsigned*)((const char*)(gbase) + (voff)[_i]), (LAS unsigned*)(lds + (bufoff) + ldsw + _i * 8192), 16, 0, 0); } while (0)
#define PG8_LDA(dst, b, h) do { _Pragma("unroll") for (int m = 0; m < 4; ++m) _Pragma("unroll") for (int k = 0; k < 2; ++k) dst[m][k] = *(const LAS bf16x8*)(lds + PG8_SA(b, h) + aoff + m * 2048 + k * 1024); } while (0)
#define PG8_LDB(dst, b, h) do { _Pragma("unroll") for (int n = 0; n < 2; ++n) _Pragma("unroll") for (int k = 0; k < 2; ++k) dst[n][k] = *(const LAS bf16x8*)(lds + PG8_SB(b, h) + boff + n * 2048 + k * 1024); } while (0)
#define PG8_MMA(ai, bj, At, Bt) do { __builtin_amdgcn_s_setprio(1); _Pragma("unroll") for (int m = 0; m < 4; ++m) _Pragma("unroll") for (int n = 0; n < 2; ++n) _Pragma("unroll") for (int k = 0; k < 2; ++k) \
    acc[ai][bj][m][n] = __builtin_amdgcn_mfma_f32_16x16x32_bf16(Bt[n][k], At[m][k], acc[ai][bj][m][n], 0, 0, 0); __builtin_amdgcn_s_setprio(0); } while (0)
#define PG8_WAIT_V(n) asm volatile("s_waitcnt vmcnt(" #n ")" ::: "memory")
#define PG8_WAIT_L(n) asm volatile("s_waitcnt lgkmcnt(" #n ")" ::: "memory")
#define PG8_BAR __builtin_amdgcn_s_barrier()
#define PG8_SCHED __builtin_amdgcn_sched_barrier(0)
  Unit cur, nxt; int ui = 0;
  if (!S.next(0, cur)) return;
  f32x4 acc[2][2][4][2];
#pragma unroll
  for (int a = 0; a < 2; ++a)
#pragma unroll
    for (int b = 0; b < 2; ++b)
#pragma unroll
      for (int m = 0; m < 4; ++m)
#pragma unroll
        for (int n = 0; n < 2; ++n) acc[a][b][m][n] = (f32x4){0.f, 0.f, 0.f, 0.f};
  bf16x8 At[4][2], B0[2][2], B1[2][2];
  const char* cA = (const char*)g.A + (size_t)cur.pm * tstep; const char* cB = (const char*)g.Bt + (size_t)cur.pn * tstep;
  PG8_STAGE(PG8_SB(0, 0), cB, voffB); PG8_STAGE(PG8_SA(0, 0), cA, voffA); PG8_STAGE(PG8_SB(0, 1), cB + hstep, voffB); PG8_STAGE(PG8_SA(0, 1), cA + hstep, voffA);
  if (wr == 1) PG8_BAR;
  PG8_WAIT_V(4); PG8_BAR;
  PG8_STAGE(PG8_SB(1, 0), cB + kstep, voffB); PG8_STAGE(PG8_SA(1, 0), cA + kstep, voffA); PG8_STAGE(PG8_SB(1, 1), cB + hstep + kstep, voffB);
  PG8_WAIT_V(6); PG8_BAR;
  for (;;) {
    const bool has_next = S.next(ui + 1, nxt);
    const char* nA = has_next ? (const char*)g.A + (size_t)nxt.pm * tstep : cA; const char* nB = has_next ? (const char*)g.Bt + (size_t)nxt.pn * tstep : cB;
    for (int t = 0; t < nt; t += 2) {
      const bool last = (t == nt - 2);
      const char* a1 = cA + (size_t)(t + 1) * kstep;
      const char* a2 = last ? nA : cA + (size_t)(t + 2) * kstep; const char* b2 = last ? nB : cB + (size_t)(t + 2) * kstep;
      const char* a3 = a2 + kstep; const char* b3 = b2 + kstep;
      PG8_LDB(B0, 0, 0); PG8_SCHED; PG8_LDA(At, 0, 0); PG8_STAGE(PG8_SA(1, 1), a1 + hstep, voffA);
      PG8_WAIT_L(8); PG8_BAR; PG8_WAIT_L(0); PG8_MMA(0, 0, At, B0); PG8_BAR; PG8_SCHED;
      PG8_LDB(B1, 0, 1); PG8_STAGE(PG8_SB(0, 0), b2, voffB);
      PG8_BAR; PG8_WAIT_L(0); PG8_MMA(0, 1, At, B1); PG8_BAR;
      PG8_LDA(At, 0, 1); PG8_STAGE(PG8_SA(0, 0), a2, voffA);
      PG8_BAR; PG8_WAIT_L(0); PG8_MMA(1, 0, At, B0); PG8_BAR; PG8_SCHED;
      PG8_STAGE(PG8_SB(0, 1), b2 + hstep, voffB);
      PG8_WAIT_V(6); PG8_BAR; PG8_MMA(1, 1, At, B1); PG8_BAR;
      PG8_LDB(B0, 1, 0); PG8_SCHED; PG8_LDA(At, 1, 0); PG8_STAGE(PG8_SA(0, 1), a2 + hstep, voffA);
      PG8_WAIT_L(8); PG8_BAR; PG8_WAIT_L(0); PG8_MMA(0, 0, At, B0); PG8_BAR; PG8_SCHED;
      PG8_LDB(B1, 1, 1); PG8_STAGE(PG8_SB(1, 0), b3, voffB);
      PG8_BAR; PG8_WAIT_L(0); PG8_MMA(0, 1, At, B1); PG8_BAR;
      PG8_LDA(At, 1, 1); PG8_STAGE(PG8_SA(1, 0), a3, voffA);
      PG8_BAR; PG8_WAIT_L(0); PG8_MMA(1, 0, At, B0); PG8_BAR; PG8_SCHED;
      PG8_STAGE(PG8_SB(1, 1), b3 + hstep, voffB);
      PG8_WAIT_V(6); PG8_BAR; PG8_MMA(1, 1, At, B1); PG8_BAR;
    }
    { int fr2 = fr, fq2 = fq; asm volatile("" : "+v"(fr2), "+v"(fq2)); E(acc, cur, wr, wc, fr2, fq2); }
    if (!has_next) break;
#pragma unroll
    for (int a = 0; a < 2; ++a)
#pragma unroll
      for (int b = 0; b < 2; ++b)
#pragma unroll
        for (int m = 0; m < 4; ++m)
#pragma unroll
          for (int n = 0; n < 2; ++n) acc[a][b][m][n] = (f32x4){0.f, 0.f, 0.f, 0.f};
    cur = nxt; cA = nA; cB = nB; ++ui;
  }
  PG8_WAIT_V(0);
  if (wr == 0) PG8_BAR;
  PG8_BAR;
#undef PG8_SA
#undef PG8_SB
#undef PG8_STAGE
#undef PG8_LDA
#undef PG8_LDB
#undef PG8_MMA
#undef PG8_WAIT_V
#undef PG8_WAIT_L
#undef PG8_BAR
#undef PG8_SCHED
}
}
using pg8::Unit;
typedef f32x4 AccT[2][2][4][2];

#define EPI_ROW(ai, m) (u.pm * 256 + (ai) * 128 + wr * 64 + (m) * 16 + fr)
#define EPI_COL(bj, n) (u.pn * 256 + (bj) * 128 + wc * 32 + (n) * 16 + 4 * fq)
#define EPI_LOOP_ROWS _Pragma("unroll") for (int ai = 0; ai < 2; ++ai) _Pragma("unroll") for (int m = 0; m < 4; ++m)
#define EPI_LOOP_COLS _Pragma("unroll") for (int bj = 0; bj < 2; ++bj) _Pragma("unroll") for (int n = 0; n < 2; ++n)

__device__ __forceinline__ int cond_of_row(int row) { return row < NCTX ? 0 : 1 + ((row - NCTX) >> 11); }

struct EpiQKV {
  bf16_t* O; const float* bias;
  __device__ __forceinline__ void operator()(const AccT& acc, const Unit& u, int wr, int wc, int fr, int fq) const {
    const float sc = (u.pn < 4) ? 0.0625f : 1.0f;
    EPI_LOOP_COLS { const int col = EPI_COL(bj, n); const f32x4 bv = *(const f32x4*)(bias + col);
      EPI_LOOP_ROWS { const int row = EPI_ROW(ai, m); const f32x4 v = (acc[ai][bj][m][n] + bv) * sc;
        u32x2 w; w.x = pack2(v[0], v[1]); w.y = pack2(v[2], v[3]); *(u32x2*)(O + (size_t)row * 3072 + col) = w; } }
  }
};
struct EpiUT {
  bf16_t* O; const float* bias;
  __device__ __forceinline__ void operator()(const AccT& acc, const Unit& u, int wr, int wc, int fr, int fq) const {
    EPI_LOOP_ROWS { const int row = EPI_ROW(ai, m); const float bv = bias[row];
      EPI_LOOP_COLS { const int col = EPI_COL(bj, n); const f32x4 v = acc[ai][bj][m][n] + bv;
        u32x2 w; w.x = pack2(v[0], v[1]); w.y = pack2(v[2], v[3]); *(u32x2*)(O + (size_t)row * NTOK + col) = w; } }
  }
};
struct EpiGates {
  bf16_t* H; bf16_t* G; const float* b_in;
  __device__ __forceinline__ void operator()(const AccT& acc, const Unit& u, int wr, int wc, int fr, int fq) const {
    const bool og = u.pn < 4;
    f32x4 bv[2][2];
    EPI_LOOP_COLS { const int col = EPI_COL(bj, n); bv[bj][n] = *(const f32x4*)(b_in + (og ? 3072 + col : 7184 + (col - 1024))); }
    EPI_LOOP_ROWS { const int row = EPI_ROW(ai, m);
      u32x2 hv[2][2];
      if (og) { EPI_LOOP_COLS { hv[bj][n] = *(const u32x2*)(H + (size_t)row * 1024 + EPI_COL(bj, n)); } }
      EPI_LOOP_COLS { const int col = EPI_COL(bj, n); const f32x4 a = acc[ai][bj][m][n] + bv[bj][n];
        f32x4 s; s[0] = sigmoidf_(a[0]); s[1] = sigmoidf_(a[1]); s[2] = sigmoidf_(a[2]); s[3] = sigmoidf_(a[3]);
        if (og) { const u32x2 h = hv[bj][n]; u32x2 w; w.x = pack2(bflo(h.x) * s[0], bfhi(h.x) * s[1]); w.y = pack2(bflo(h.y) * s[2], bfhi(h.y) * s[3]); *(u32x2*)(H + (size_t)row * 1024 + col) = w; }
        else { u32x2 w; w.x = pack2(s[0], s[1]); w.y = pack2(s[2], s[3]); *(u32x2*)(G + (size_t)row * 2048 + (col - 1024)) = w; } } }
  }
};
template <int SECOND> struct EpiMerge {
  bf16_t* T; const bf16_t* G;
  __device__ __forceinline__ void operator()(const AccT& acc, const Unit& u, int wr, int wc, int fr, int fq) const {
    EPI_LOOP_ROWS { const int row = EPI_ROW(ai, m);
      u32x2 gv[2][2], tv[2][2];
      EPI_LOOP_COLS { const int col = EPI_COL(bj, n); gv[bj][n] = *(const u32x2*)(G + (size_t)row * 2048 + SECOND * 1024 + col);
        if (SECOND) tv[bj][n] = *(const u32x2*)(T + (size_t)row * 1024 + col); }
      EPI_LOOP_COLS { const int col = EPI_COL(bj, n); const f32x4 a = acc[ai][bj][m][n]; const u32x2 g = gv[bj][n];
        f32x4 v; v[0] = bflo(g.x) * a[0]; v[1] = bfhi(g.x) * a[1]; v[2] = bflo(g.y) * a[2]; v[3] = bfhi(g.y) * a[3];
        if (SECOND) { const u32x2 t = tv[bj][n]; v[0] += bflo(t.x); v[1] += bfhi(t.x); v[2] += bflo(t.y); v[3] += bfhi(t.y); }
        u32x2 w; w.x = pack2(v[0], v[1]); w.y = pack2(v[2], v[3]); *(u32x2*)(T + (size_t)row * 1024 + col) = w; } }
  }
};
struct EpiOut {
  const float* xp; const float* xs; const float* per; const float* pec; const float* mod; const float* n2w; float* X1; bf16_t* A2; float* ssq;
  __device__ __forceinline__ void operator()(const AccT& acc, const Unit& u, int wr, int wc, int fr, int fq) const {
    const int cb = cond_of_row(u.pm * 256); const float* md = mod + cb * 6144; const bool smp = (u.pm * 256) >= NCTX;
    f32x4 g1v[2][2], k2v[2][2];
    EPI_LOOP_COLS { const int col = EPI_COL(bj, n); g1v[bj][n] = *(const f32x4*)(md + 2048 + col); k2v[bj][n] = *(const f32x4*)(n2w + col) * (*(const f32x4*)(md + 4096 + col) + 1.0f); }
    EPI_LOOP_ROWS { const int row = EPI_ROW(ai, m); float ss = 0.f;
#pragma unroll
      for (int bj = 0; bj < 2; ++bj) {
        f32x4 x0[2];
        if (!smp) {
#pragma unroll
          for (int n = 0; n < 2; ++n) x0[n] = *(const f32x4*)(xp + (size_t)row * 1024 + EPI_COL(bj, n)); }
        else { const int r2 = row - NCTX, t = r2 & 2047; f32x4 pe[2];
#pragma unroll
          for (int n = 0; n < 2; ++n) { const int col = EPI_COL(bj, n); x0[n] = *(const f32x4*)(xs + (size_t)r2 * 1024 + col);
            pe[n] = (col < 512) ? *(const f32x4*)(per + (t >> 6) * 512 + col) : *(const f32x4*)(pec + (t & 63) * 512 + (col - 512)); }
#pragma unroll
          for (int n = 0; n < 2; ++n) x0[n] += pe[n]; }
#pragma unroll
        for (int n = 0; n < 2; ++n) { const int col = EPI_COL(bj, n);
          const f32x4 x1 = x0[n] + g1v[bj][n] * acc[ai][bj][m][n]; *(f32x4*)(X1 + (size_t)row * 1024 + col) = x1;
          ss += x1[0] * x1[0] + x1[1] * x1[1] + x1[2] * x1[2] + x1[3] * x1[3];
          const f32x4 av = x1 * k2v[bj][n]; u32x2 w; w.x = pack2(av[0], av[1]); w.y = pack2(av[2], av[3]); *(u32x2*)(A2 + (size_t)row * 1024 + col) = w; } }
      ss += __shfl_xor(ss, 16); ss += __shfl_xor(ss, 32);
      if (fq == 0) ssq[(size_t)row * 16 + u.pn * 4 + wc] = ss; }
  }
};
struct EpiFF1 {
  int row0; const float* ssq; const float* c1; bf16_t* Hd;
  __device__ __forceinline__ void operator()(const AccT& acc, const Unit& u, int wr, int wc, int fr, int fq) const {
    const int cb = cond_of_row(row0 + u.pm * 256); const float* cc = c1 + cb * 4096;
    f32x4 cv[2][2];
    EPI_LOOP_COLS { cv[bj][n] = *(const f32x4*)(cc + EPI_COL(bj, n)); }
    float rs[2][4];
    EPI_LOOP_ROWS { const float* sp = ssq + (size_t)(row0 + EPI_ROW(ai, m)) * 16;
      const f32x4 st = (*(const f32x4*)sp + *(const f32x4*)(sp + 4)) + (*(const f32x4*)(sp + 8) + *(const f32x4*)(sp + 12));
      rs[ai][m] = rsqrtf((st[0] + st[1] + st[2] + st[3]) * (1.0f / 1024.0f) + 1e-6f); }
    EPI_LOOP_ROWS { const int rl = EPI_ROW(ai, m); const float rstd = rs[ai][m];
      EPI_LOOP_COLS { const int col = EPI_COL(bj, n); f32x4 v = acc[ai][bj][m][n] * rstd + cv[bj][n];
#pragma unroll
        for (int e = 0; e < 4; ++e) { const float r = fmaxf(v[e], 0.f); v[e] = r * r; }
        u32x2 w; w.x = pack2(v[0], v[1]); w.y = pack2(v[2], v[3]); *(u32x2*)(Hd + (size_t)rl * 4096 + col) = w; } }
  }
};
struct EpiFF2 {
  int row0; const float* mod; const float* b2; float* X; float* ssq;
  __device__ __forceinline__ void operator()(const AccT& acc, const Unit& u, int wr, int wc, int fr, int fq) const {
    const int cb = cond_of_row(row0 + u.pm * 256); const float* md = mod + cb * 6144;
    f32x4 g2v[2][2], bbv[2][2];
    EPI_LOOP_COLS { const int col = EPI_COL(bj, n); g2v[bj][n] = *(const f32x4*)(md + 5120 + col); bbv[bj][n] = *(const f32x4*)(b2 + col); }
    EPI_LOOP_ROWS { const int row = row0 + EPI_ROW(ai, m); float ss = 0.f;
      f32x4 xv[2][2];
      EPI_LOOP_COLS { xv[bj][n] = *(const f32x4*)(X + (size_t)row * 1024 + EPI_COL(bj, n)); }
      EPI_LOOP_COLS { const int col = EPI_COL(bj, n);
        const f32x4 x2 = xv[bj][n] + g2v[bj][n] * (acc[ai][bj][m][n] + bbv[bj][n]); *(f32x4*)(X + (size_t)row * 1024 + col) = x2;
        ss += x2[0] * x2[0] + x2[1] * x2[1] + x2[2] * x2[2] + x2[3] * x2[3]; }
      ss += __shfl_xor(ss, 16); ss += __shfl_xor(ss, 32);
      if (fq == 0) ssq[(size_t)row * 16 + u.pn * 4 + wc] = ss; }
  }
};

template <class Epi> __device__ __forceinline__ void run_gemm(LP lds, const bf16_t* A, const bf16_t* Bt, int M, int N, int K, const Epi& E) {
  pg8::Gemm g; g.A = A; g.Bt = Bt; g.M = M; g.N = N; g.K = K;
  pg8::StaticOrder S; S.init(M, N, (int)gridDim.x, (int)blockIdx.x);
  pg8::gemm_phase<Epi>(lds, g, S, E);
}

__device__ void transpose_tile(const float* __restrict__ src, int ld, int col0, int k0, bf16_t* __restrict__ dst, int K, int drow0, LAS float* tile) {
  const int t = opaque_tid();
  f32x4 v[4];
#pragma unroll
  for (int i = 0; i < 4; ++i) { const int idx = t + 512 * i, kr = idx >> 5, c4 = idx & 31; v[i] = *(const f32x4*)(src + (size_t)(k0 + kr) * ld + col0 + 4 * c4); }
#pragma unroll
  for (int i = 0; i < 4; ++i) { const int idx = t + 512 * i, kr = idx >> 5, c4 = idx & 31; LAS float* tp = tile + kr * 129 + 4 * c4; tp[0] = v[i][0]; tp[1] = v[i][1]; tp[2] = v[i][2]; tp[3] = v[i][3]; }
  __syncthreads();
  const int kb = t & 7;
#pragma unroll
  for (int i = 0; i < 2; ++i) { const int c = (t >> 3) + 64 * i; const LAS float* tp = tile + (kb * 8) * 129 + c; u32x4 o;
    o.x = pack2(tp[0], tp[129]); o.y = pack2(tp[2 * 129], tp[3 * 129]); o.z = pack2(tp[4 * 129], tp[5 * 129]); o.w = pack2(tp[6 * 129], tp[7 * 129]);
    *(u32x4*)(dst + (size_t)(drow0 + c) * K + k0 + kb * 8) = o; }
  __syncthreads();
}
template <int SILU> __device__ void matvec9_unit(const float* v0, const float* v1, int v1stride, const float* __restrict__ W, int ldw, const float* bias, float* out, int ldo, int col0, LAS float* lf) {
  const int t = opaque_tid(), lane = t & 63, wid = t >> 6;
  LAS float* sv = lf; LAS float* red = lf + 9216;
  for (int i = t; i < 9216; i += 512) { const int b = i >> 10, k = i & 1023; float x = (b == 0) ? v0[k] : v1[(size_t)(b - 1) * v1stride + k]; if (SILU) x = x / (1.0f + __expf(-x)); sv[i] = x; }
  __syncthreads();
  const int c4 = t & 7, kl = t >> 3;
  f32x4 w[16];
#pragma unroll
  for (int i = 0; i < 16; ++i) w[i] = *(const f32x4*)(W + (size_t)(kl + 64 * i) * ldw + col0 + 4 * c4);
  f32x4 acc[9];
#pragma unroll
  for (int b = 0; b < 9; ++b) acc[b] = (f32x4){0.f, 0.f, 0.f, 0.f};
#pragma unroll
  for (int i = 0; i < 16; ++i)
#pragma unroll
    for (int b = 0; b < 9; ++b) acc[b] += w[i] * sv[b * 1024 + kl + 64 * i];
#pragma unroll
  for (int b = 0; b < 9; ++b)
#pragma unroll
    for (int e = 0; e < 4; ++e) { float x = acc[b][e]; x += __shfl_xor(x, 8); x += __shfl_xor(x, 16); x += __shfl_xor(x, 32); acc[b][e] = x; }
  if (lane < 8) {
#pragma unroll
    for (int b = 0; b < 9; ++b) *(LAS f32x4*)(red + (wid * 9 + b) * 32 + 4 * lane) = acc[b]; }
  __syncthreads();
  if (t < 288) { const int b = t >> 5, cc = t & 31; float s = bias[col0 + cc];
#pragma unroll
    for (int pz = 0; pz < 8; ++pz) s += red[(pz * 9 + b) * 32 + cc];
    out[(size_t)b * ldo + col0 + cc] = s; }
  __syncthreads();
}

__device__ void phase0(const Params& p, LP lds) {
  unsigned char* ws = p.ws; LAS float* lf = (LAS float*)lds;
  const int tid0 = opaque_tid(); const int wid = tid0 >> 6, lane = tid0 & 63;
  for (int unit = blockIdx.x; unit < 576; unit += gridDim.x) {
    if (unit < 192) {
      matvec9_unit<1>(p.in[6], p.in[5], 1024, p.in[7], 6144, p.in[8], (float*)(ws + OFF_MOD), 6144, unit * 32, lf);
    } else if (unit < 480) {
      const int row = (unit - 192) * 8 + wid; const bool smp = row < 2048; const int L = smp ? 2048 : 256, t = smp ? row : row - 2048;
      const float* w1 = p.in[14]; const float* b1 = p.in[15]; const float* fr1 = p.in[16]; const float* w2 = p.in[17]; const float* b2 = p.in[18]; const float* fr2 = p.in[19];
      float a = b1[lane] + (float)t / (float)(L - 1) * w1[lane];
      const float base = (6.283185307179586f / (float)L) * (float)t;
      float cs = 0.f, sn = 0.f; if (lane < 16) { const float ang = base * (float)(lane + 1); cs = cosf(ang); sn = sinf(ang); }
#pragma unroll
      for (int i = 0; i < 16; ++i) a += __shfl(cs, i) * w1[(1 + i) * 64 + lane] + __shfl(sn, i) * w1[(17 + i) * 64 + lane];
      const float h1 = sinf(fr1[lane] * a);
      float a2 = b2[lane];
#pragma unroll 16
      for (int j = 0; j < 64; ++j) a2 += __shfl(h1, j) * w2[j * 64 + lane];
      const float h2 = sinf(fr2[lane] * a2);
      float* dst = (float*)(ws + (smp ? OFF_H2S : OFF_H2C)); dst[(size_t)t * 64 + lane] = h2;
    } else {
      const int r = unit - 480, c = tid0; const int pos = r < 32 ? r : r - 32; const int i = c & 255;
      const float omega = 1.0f / powf(10000.0f, (float)i / 256.0f); const float a = (float)pos * omega; const float v = c < 256 ? sinf(a) : cosf(a);
      float* dst = (float*)(ws + (r < 32 ? OFF_PER : OFF_PEC)); dst[(size_t)pos * 512 + c] = v;
    }
  }
}
__device__ void weight_tiles(const Params& p, LP lds) {
  unsigned char* ws = p.ws; LAS float* lf = (LAS float*)lds;
  for (int tu = blockIdx.x; tu < 2560; tu += gridDim.x) {
    const float* src; int ld, K, col0, k0, drow0; bf16_t* dst;
    if (tu < 1152) { const int nt = tu >> 4, kt = tu & 15; const int r = nt * 128; src = p.in[10]; ld = INC; K = 1024; k0 = kt * 64; drow0 = r; dst = (bf16_t*)(ws + OFF_WT);
      col0 = r < 3072 ? r : (r < 6144 ? 4112 + (r - 3072) : (r < 7168 ? 3072 + (r - 6144) : 7184 + (r - 7168))); }
    else if (tu < 1536) { const int v = tu - 1152, w = v >> 7, q = v & 127; src = p.in[23 + w]; ld = 1024; K = 1024; k0 = (q & 15) * 64; col0 = (q >> 4) * 128; drow0 = col0; dst = (bf16_t*)(ws + (w == 0 ? OFF_WBM : (w == 1 ? OFF_WBH : OFF_WOUT))); }
    else if (tu < 2048) { const int q = tu - 1536; src = p.in[27]; ld = 4096; K = 1024; k0 = (q & 15) * 64; col0 = (q >> 4) * 128; drow0 = col0; dst = (bf16_t*)(ws + OFF_W1T); }
    else { const int q = tu - 2048; src = p.in[29]; ld = 1024; K = 4096; k0 = (q & 63) * 64; col0 = (q >> 6) * 128; drow0 = col0; dst = (bf16_t*)(ws + OFF_W2T); }
    transpose_tile(src, ld, col0, k0, dst, K, drow0, lf);
  }
}

__device__ void phase1(const Params& p, LP lds) {
  unsigned char* ws = p.ws;
  int tid_ = threadIdx.x; asm volatile("" : "+v"(tid_));
  const int tid = tid_, wid = tid >> 6, lane = tid & 63;
  const float* mod = (const float*)(ws + OFF_MOD);
  LAS float* wg = (LAS float*)lds;
  if ((int)blockIdx.x < 1536) {
    f32x4 gw[8];
#pragma unroll
    for (int i = 0; i < 8; ++i) { const int idx = tid + 512 * i, k = idx >> 2, q = idx & 3; gw[i] = *(const f32x4*)(p.in[10] + (size_t)k * INC + 4096 + 4 * q); }
#pragma unroll
    for (int i = 0; i < 8; ++i) { const int idx = tid + 512 * i, k = idx >> 2, q = idx & 3; wg[(4 * q) * 1024 + k] = gw[i][0]; wg[(4 * q + 1) * 1024 + k] = gw[i][1]; wg[(4 * q + 2) * 1024 + k] = gw[i][2]; wg[(4 * q + 3) * 1024 + k] = gw[i][3]; }
    __syncthreads();
  }
  for (int unit = blockIdx.x; unit < 1536; unit += gridDim.x) {
    const int tidn = opaque_tid(); const int wid = tidn >> 6, lane = tidn & 63;
    const int row0 = unit * 16 + wid * 2; const int cb = cond_of_row(row0); const float* md = mod + cb * 6144; const bool smp = row0 >= NCTX;
    f32x4 v[2][4]; float rstd[2];
#pragma unroll
    for (int r = 0; r < 2; ++r) { const int row = row0 + r; const float* xr; int t = 0;
      if (!smp) xr = p.in[0] + (size_t)row * 1024; else { xr = p.in[1] + (size_t)(row - NCTX) * 1024; t = (row - NCTX) & 2047; }
      const float* per = (const float*)(ws + OFF_PER) + (t >> 6) * 512; const float* pec = (const float*)(ws + OFF_PEC) + (t & 63) * 512;
      float ss = 0.f;
#pragma unroll
      for (int i = 0; i < 4; ++i) { const int col = 4 * lane + 256 * i; v[r][i] = *(const f32x4*)(xr + col);
        if (smp) v[r][i] += (col < 512) ? *(const f32x4*)(per + col) : *(const f32x4*)(pec + col - 512);
        ss += v[r][i][0] * v[r][i][0] + v[r][i][1] * v[r][i][1] + v[r][i][2] * v[r][i][2] + v[r][i][3] * v[r][i][3]; }
      ss = wave_sum(ss); rstd[r] = rsqrtf(ss * (1.0f / 1024.0f) + 1e-6f); }
    const float* n1w = p.in[9];
    float ga[32];
#pragma unroll
    for (int g = 0; g < 32; ++g) ga[g] = 0.f;
#pragma unroll
    for (int i = 0; i < 4; ++i) { const int col = 4 * lane + 256 * i;
      const f32x4 w = *(const f32x4*)(n1w + col), sc = *(const f32x4*)(md + 1024 + col), sh = *(const f32x4*)(md + col);
      const f32x4 ws1 = w * (sc + 1.0f);
      f32x4 h[2];
#pragma unroll
      for (int r = 0; r < 2; ++r) { h[r] = v[r][i] * rstd[r] * ws1 + sh;
        u32x2 o; o.x = pack2(h[r][0], h[r][1]); o.y = pack2(h[r][2], h[r][3]); *(u32x2*)((bf16_t*)(ws + OFF_HN) + (size_t)(row0 + r) * 1024 + col) = o; }
#pragma unroll
      for (int g = 0; g < 16; ++g) { const f32x4 wv = *(const LAS f32x4*)(wg + g * 1024 + col);
#pragma unroll
        for (int r = 0; r < 2; ++r) ga[r * 16 + g] += h[r][0] * wv[0] + h[r][1] * wv[1] + h[r][2] * wv[2] + h[r][3] * wv[3]; }
      asm volatile("" ::: "memory"); }
#pragma unroll
    for (int off = 16; off >= 1; off >>= 1) { const bool hi = (lane & off) != 0;
#pragma unroll
      for (int i = 0; i < off; ++i) { const float send = hi ? ga[i] : ga[i + off]; const float keep = hi ? ga[i + off] : ga[i]; ga[i] = keep + __shfl_xor(send, off); } }
    const float tot = ga[0] + __shfl_xor(ga[0], 32);
    if (lane < 32) ((float*)(ws + OFF_GT))[(size_t)row0 * 16 + lane] = tot + p.in[11][4096 + (lane & 15)];
  }
  __syncthreads();
  LAS float* w3s = (LAS float*)lds;
  for (int v = blockIdx.x; v < 320; v += gridDim.x) {
    const int tid = opaque_tid();
    const bool smp = v < 256; const int L = smp ? 2048 : 256; const int tt = smp ? (v >> 6) : 0, cgp = v & 63; const int t = tt * 512 + tid;
    { const f32x4 x = *(const f32x4*)(p.in[20] + (size_t)(tid >> 3) * 2048 + cgp * 32 + 4 * (tid & 7)); LAS float* wp = w3s + (4 * (tid & 7)) * 64 + (tid >> 3);
      wp[0] = x[0]; wp[64] = x[1]; wp[128] = x[2]; wp[192] = x[3]; }
    __syncthreads();
    if (t < L) {
      const float* H2 = (const float*)(ws + (smp ? OFF_H2S : OFF_H2C)) + (size_t)t * 64;
      f32x4 h2[16];
#pragma unroll
      for (int i = 0; i < 16; ++i) h2[i] = *(const f32x4*)(H2 + 4 * i);
      const float dist = fabsf((float)t - (float)(L / 2)) / (float)(L / 2);
      float* HF = (float*)(ws + (smp ? OFF_HFS : OFF_HFC)) + (size_t)(cgp * 32) * L + t;
#pragma unroll 1
      for (int j = 0; j < 32; ++j) {
        f32x4 a = {0.f, 0.f, 0.f, 0.f};
#pragma unroll
        for (int i = 0; i < 16; ++i) a += *(const LAS f32x4*)(w3s + j * 64 + 4 * i) * h2[i];
        const int c = (cgp * 32 + j) & 1023;
        const float dmin = -3.0701134573253946f, dmax = -15.350567286626973f;
        const float delta = fabsf(dmin + (dmax - dmin) * ((float)c / 1023.0f));
        HF[(size_t)j * L] = ((a[0] + a[1]) + (a[2] + a[3])) * __expf(-dist * delta); }
    }
    __syncthreads();
  }
  for (int u = (int)gridDim.x - 1 - (int)blockIdx.x; u < 128; u += gridDim.x)
    matvec9_unit<0>(mod + 3072, mod + 6144 + 3072, 6144, p.in[27], 4096, p.in[28], (float*)(ws + OFF_C1), 4096, u * 32, (LAS float*)lds);
}

__device__ __forceinline__ bf16x8 tr_frag(LP base, int k0, int m0, int pitch  , int l15, int g) {
  const int q = l15 >> 2, pp = l15 & 3;
  LP a = base + ((k0 + 8 * g + q) * pitch + m0 + 4 * pp) * 2;
  const s16x4 lo = __builtin_amdgcn_ds_read_tr16_b64_v4i16((LAS s16x4*)a);
  const s16x4 hi = __builtin_amdgcn_ds_read_tr16_b64_v4i16((LAS s16x4*)(a + 8 * pitch));
  bf16x8 r; r[0] = lo[0]; r[1] = lo[1]; r[2] = lo[2]; r[3] = lo[3]; r[4] = hi[0]; r[5] = hi[1]; r[6] = hi[2]; r[7] = hi[3]; return r;
}
__device__ __forceinline__ bf16x8 tr_at(LP lanebase, int coff  , int pitch_bytes) {
  const s16x4 lo = __builtin_amdgcn_ds_read_tr16_b64_v4i16((LAS s16x4*)(lanebase + coff));
  const s16x4 hi = __builtin_amdgcn_ds_read_tr16_b64_v4i16((LAS s16x4*)(lanebase + coff + 4 * pitch_bytes));
  bf16x8 r; r[0] = lo[0]; r[1] = lo[1]; r[2] = lo[2]; r[3] = lo[3]; r[4] = hi[0]; r[5] = hi[1]; r[6] = hi[2]; r[7] = hi[3]; return r;
}
constexpr int ML_K = 0, ML_V = 67584, ML_P = 86016, ML_C = 120832, ML_T = 157696, ML_TSZ = 1600;
constexpr int KP = 264, VP = 72, PP = 136, CP = 72;

__device__ void mlstm_item(const Params& p, LP lds, int item) {
  const int tid = opaque_tid(), wid = __builtin_amdgcn_readfirstlane(tid >> 6), lane = tid & 63, l15 = lane & 15, g = lane >> 4;
  const bool smp = item < 256; const int uu = smp ? (item >> 2) : ((item - 256) >> 2); const int sl = item & 3;
  const int b = uu >> 3, dir = (uu >> 2) & 1, head = uu & 3;
  const int S = smp ? SEQS : SEQC, nc = S >> 7; const int tok0 = smp ? NCTX + b * SEQS : b * SEQC;
  const bf16_t* qkv = (const bf16_t*)(p.ws + OFF_BIG);
  const float* GT = (const float*)(p.ws + OFF_GT);
  bf16_t* hout = (bf16_t*)((unsigned char*)p.out + (dir ? OUT_HB : OUT_H));
  const int sidx = (b * 2 + dir) * 4 + head;
  const int gi_col = dir * 8 + head, gf_col = dir * 8 + 4 + head;
  f32x4 Cacc[2][4], nacc[2]; float mst0;
  if (smp) {
    const float* C0 = p.in[2] + (size_t)sidx * 65536;
#pragma unroll
    for (int dt = 0; dt < 2; ++dt) {
#pragma unroll
      for (int vt = 0; vt < 4; ++vt) Cacc[dt][vt] = *(const f32x4*)(C0 + (size_t)((2 * wid + dt) * 16 + l15) * 256 + sl * 64 + 16 * vt + 4 * g);
      nacc[dt] = (f32x4){p.in[3][sidx * 256 + (2 * wid + dt) * 16 + l15], 0.f, 0.f, 0.f}; }
    mst0 = p.in[4][sidx];
  } else {
#pragma unroll
    for (int dt = 0; dt < 2; ++dt) {
#pragma unroll
      for (int vt = 0; vt < 4; ++vt) Cacc[dt][vt] = (f32x4){0.f, 0.f, 0.f, 0.f};
      nacc[dt] = (f32x4){0.f, 0.f, 0.f, 0.f}; }
    mst0 = 0.f;
  }
#define TOKC(cc, j) (dir ? (tok0 + S - 1 - ((cc) * 128 + (j))) : (tok0 + (cc) * 128 + (j)))
  const int rt = (wid < 4) ? wid : 11 - wid;
  const int jrow = 16 * rt + l15;
  bf16x8 qf[8]; u32x4 kreg[8], vreg[2]; float g4[4] = {0.f, 0.f, 0.f, 0.f};
#define ML_LOAD_Q(cc) do { const bf16_t* qp = qkv + (size_t)TOKC(cc, jrow) * 3072 + head * 256 + 8 * g; \
    _Pragma("unroll") for (int kk = 0; kk < 8; ++kk) qf[kk] = *(const bf16x8*)(qp + 32 * kk); } while (0)
#define ML_LOAD_KV(cc) do { \
    _Pragma("unroll") for (int i = 0; i < 8; ++i) { const int row = (tid >> 5) + 16 * i; kreg[i] = *(const u32x4*)(qkv + (size_t)TOKC(cc, row) * 3072 + 1024 + head * 256 + (tid & 31) * 8); } \
    _Pragma("unroll") for (int i = 0; i < 2; ++i) { const int row = (tid >> 3) + 64 * i; vreg[i] = *(const u32x4*)(qkv + (size_t)TOKC(cc, row) * 3072 + 2048 + head * 256 + sl * 64 + (tid & 7) * 8); } \
    if (wid == 0) { const float* g0 = GT + (size_t)TOKC(cc, 2 * lane) * 16; const float* g1 = GT + (size_t)TOKC(cc, 2 * lane + 1) * 16; g4[0] = g0[gi_col]; g4[1] = g0[gf_col]; g4[2] = g1[gi_col]; g4[3] = g1[gf_col]; } } while (0)
#define ML_SCAN(tabp, mcur, mnext) do { LAS float* T_ = (LAS float*)(tabp); \
    const float lf0 = fminf(g4[1], 0.f) - log1pf(__expf(-fabsf(g4[1]))), lf1 = fminf(g4[3], 0.f) - log1pf(__expf(-fabsf(g4[3]))); \
    float s_ = lf0 + lf1; \
    _Pragma("unroll") for (int o = 1; o < 64; o <<= 1) { const float t_ = __shfl_up(s_, o); if (lane >= o) s_ += t_; } \
    const float b1_ = s_, b0_ = s_ - lf1; const float u0_ = g4[0] - b0_, u1_ = g4[2] - b1_; \
    float mx_ = fmaxf(u0_, u1_); \
    _Pragma("unroll") for (int o = 1; o < 64; o <<= 1) { const float t_ = __shfl_up(mx_, o); if (lane >= o) mx_ = fmaxf(mx_, t_); } \
    float ex_ = __shfl_up(mx_, 1); if (lane == 0) ex_ = -INFINITY; \
    const float M0_ = fmaxf(mcur, fmaxf(ex_, u0_)), M1_ = fmaxf(mcur, mx_); \
    T_[2 * lane] = u0_; T_[2 * lane + 1] = u1_; T_[128 + 2 * lane] = M0_; T_[128 + 2 * lane + 1] = M1_; T_[256 + 2 * lane] = b0_; T_[256 + 2 * lane + 1] = b1_; \
    const float Ml_ = __shfl(M1_, 63), bl_ = __shfl(b1_, 63); \
    if (lane == 0) { T_[384] = mcur; T_[385] = Ml_; } \
    mnext = bl_ + Ml_; } while (0)
  float mw0 = mst0;
  ML_LOAD_Q(0); ML_LOAD_KV(0);
  if (wid == 0) { float mn; ML_SCAN(lds + ML_T, mw0, mn); mw0 = mn; }
  __syncthreads();
  float m_final = 0.f;
  for (int c = 0; c < nc; ++c) {
    LAS float* T = (LAS float*)(lds + ML_T + (c & 1) * ML_TSZ);
    const float mst = T[384], M_last = T[385];
#pragma unroll
    for (int i = 0; i < 8; ++i) { const int row = (tid >> 5) + 16 * i; *(LAS u32x4*)(lds + ML_K + (row * KP + (tid & 31) * 8) * 2) = kreg[i]; }
#pragma unroll
    for (int i = 0; i < 2; ++i) { const int row = (tid >> 3) + 64 * i; const float w = __expf(T[row] - M_last); const u32x4 v = vreg[i]; u32x4 o;
      o.x = pack2(bflo(v.x) * w, bfhi(v.x) * w); o.y = pack2(bflo(v.y) * w, bfhi(v.y) * w); o.z = pack2(bflo(v.z) * w, bfhi(v.z) * w); o.w = pack2(bflo(v.w) * w, bfhi(v.w) * w);
      *(LAS u32x4*)(lds + ML_V + (row * VP + (tid & 7) * 8) * 2) = o; }
    if (tid < 128) *(LAS unsigned short*)(lds + ML_V + (tid * VP + 64) * 2) = f2bf(__expf(T[tid] - M_last));
#pragma unroll
    for (int dt = 0; dt < 2; ++dt) {
#pragma unroll
      for (int vt = 0; vt < 4; ++vt) { u32x2 w; w.x = pack2(Cacc[dt][vt][0], Cacc[dt][vt][1]); w.y = pack2(Cacc[dt][vt][2], Cacc[dt][vt][3]);
        *(LAS u32x2*)(lds + ML_C + (((2 * wid + dt) * 16 + l15) * CP + 16 * vt + 4 * g) * 2) = w; }
      if (g == 0) *(LAS unsigned short*)(lds + ML_C + (((2 * wid + dt) * 16 + l15) * CP + 64) * 2) = f2bf(nacc[dt][0]); }
    const int qtok = TOKC(c, jrow);
    const bool more = (c + 1 < nc);
    __syncthreads();
    const float Mj = T[128 + jrow], bj = T[256 + jrow]; const float rf = __expf(M_last - Mj), w_inter = __expf(mst - Mj);
    int lq_ = (8 * g + (l15 >> 2)), lp_ = 4 * (l15 & 3); asm volatile("" : "+v"(lq_), "+v"(lp_));
    const LP cB = lds + ML_C + (lq_ * CP + lp_) * 2, vB = lds + ML_V + (lq_ * VP + lp_) * 2, kB = lds + ML_K + (lq_ * KP + lp_ + 32 * wid) * 2;
    const LP pB = lds + ML_P + (jrow * PP + 8 * g) * 2;
    for (int st = 0; st <= rt; ++st) {
      f32x4 s = {0.f, 0.f, 0.f, 0.f};
      bf16x8 kfr[8];
#pragma unroll
      for (int kk = 0; kk < 8; ++kk) kfr[kk] = *(const LAS bf16x8*)(lds + ML_K + ((16 * st + l15) * KP + 32 * kk + 8 * g) * 2);
      __builtin_amdgcn_sched_barrier(0);
#pragma unroll
      for (int kk = 0; kk < 8; ++kk) s = __builtin_amdgcn_mfma_f32_16x16x32_bf16(kfr[kk], qf[kk], s, 0, 0, 0);
      float pv[4];
#pragma unroll
      for (int i = 0; i < 4; ++i) pv[i] = ((16 * st + 4 * g + i) <= jrow) ? s[i] * rf : 0.f;
      u32x2 w; w.x = pack2(pv[0], pv[1]); w.y = pack2(pv[2], pv[3]);
      *(LAS u32x2*)(lds + ML_P + (jrow * PP + 16 * st + 4 * g) * 2) = w;
    }
    if ((rt & 1) == 0) { u32x2 z; z.x = 0u; z.y = 0u; *(LAS u32x2*)(lds + ML_P + (jrow * PP + 16 * (rt + 1) + 4 * g) * 2) = z; }
    if (more) ML_LOAD_KV(c + 1);
    asm volatile("s_waitcnt lgkmcnt(0)" ::: "memory");
    f32x4 ha[5];
#pragma unroll
    for (int vt = 0; vt < 5; ++vt) { f32x4 a = {0.f, 0.f, 0.f, 0.f};
      if (smp || c > 0) {
        bf16x8 cfr[8];
#pragma unroll
        for (int kk = 0; kk < 8; ++kk) cfr[kk] = tr_at(cB, (32 * kk * CP + 16 * vt) * 2, CP * 2);
        __builtin_amdgcn_sched_barrier(0);
#pragma unroll
        for (int kk = 0; kk < 8; ++kk) a = __builtin_amdgcn_mfma_f32_16x16x32_bf16(cfr[kk], qf[kk], a, 0, 0, 0);
        a *= w_inter; }
      ha[vt] = a; }
    for (int k2 = 0; k2 <= (rt >> 1); ++k2) {
      const bf16x8 pf = *(const LAS bf16x8*)(pB + k2 * 64);
      bf16x8 vfr[5];
#pragma unroll
      for (int vt = 0; vt < 5; ++vt) vfr[vt] = tr_at(vB + k2 * (32 * VP * 2), (16 * vt) * 2, VP * 2);
      __builtin_amdgcn_sched_barrier(0);
#pragma unroll
      for (int vt = 0; vt < 5; ++vt) ha[vt] = __builtin_amdgcn_mfma_f32_16x16x32_bf16(vfr[vt], pf, ha[vt], 0, 0, 0); }
    { const float den = __shfl(ha[4][0], l15); const float rdd = 1.0f / fmaxf(fabsf(den), __expf(-(bj + Mj)));
#pragma unroll
      for (int vt = 0; vt < 4; ++vt) { const f32x4 a = ha[vt] * rdd; u32x2 w; w.x = pack2(a[0], a[1]); w.y = pack2(a[2], a[3]);
        *(u32x2*)(hout + (size_t)qtok * 1024 + head * 256 + sl * 64 + 16 * vt + 4 * g) = w; } }
    if (more) ML_LOAD_Q(c + 1);
    const bool need_state = (!smp) || more;
    if (need_state) {
      const float decay = __expf(mst - M_last);
#pragma unroll
      for (int dt = 0; dt < 2; ++dt) {
#pragma unroll
        for (int vt = 0; vt < 4; ++vt) Cacc[dt][vt] *= decay;
        nacc[dt] *= decay; }
#pragma unroll
      for (int ks = 0; ks < 4; ++ks) {
        const bf16x8 kf0 = tr_at(kB, (32 * ks * KP) * 2, KP * 2), kf1 = tr_at(kB, (32 * ks * KP + 16) * 2, KP * 2);
        bf16x8 vfr[5];
#pragma unroll
        for (int vt = 0; vt < 5; ++vt) vfr[vt] = tr_at(vB, (32 * ks * VP + 16 * vt) * 2, VP * 2);
        __builtin_amdgcn_sched_barrier(0);
#pragma unroll
        for (int vt = 0; vt < 4; ++vt) { Cacc[0][vt] = __builtin_amdgcn_mfma_f32_16x16x32_bf16(vfr[vt], kf0, Cacc[0][vt], 0, 0, 0); Cacc[1][vt] = __builtin_amdgcn_mfma_f32_16x16x32_bf16(vfr[vt], kf1, Cacc[1][vt], 0, 0, 0); }
        nacc[0] = __builtin_amdgcn_mfma_f32_16x16x32_bf16(vfr[4], kf0, nacc[0], 0, 0, 0); nacc[1] = __builtin_amdgcn_mfma_f32_16x16x32_bf16(vfr[4], kf1, nacc[1], 0, 0, 0);
      }
    }
    if (wid == 0 && more) { float mn; ML_SCAN(lds + ML_T + ((c + 1) & 1) * ML_TSZ, mw0, mn); mw0 = mn; }
    m_final = T[256 + 127] + M_last;
    __syncthreads();
  }
#undef ML_LOAD_Q
#undef ML_LOAD_KV
#undef ML_SCAN
#undef TOKC
  if (!smp) {
    float* oC = p.out + OUTF_C + (size_t)sidx * 65536;
#pragma unroll
    for (int dt = 0; dt < 2; ++dt) {
#pragma unroll
      for (int vt = 0; vt < 4; ++vt) *(f32x4*)(oC + (size_t)((2 * wid + dt) * 16 + l15) * 256 + sl * 64 + 16 * vt + 4 * g) = Cacc[dt][vt];
      if (sl == 0 && g == 0) p.out[OUTF_N + (size_t)sidx * 256 + (2 * wid + dt) * 16 + l15] = nacc[dt][0]; }
    if (sl == 0 && tid == 0) p.out[OUTF_M + sidx] = m_final;
  }
}

__device__ void combine_rows(const Params& p) {
  const int tid0 = opaque_tid(); const int wid = tid0 >> 6, lane = tid0 & 63;
  bf16_t* H = (bf16_t*)((unsigned char*)p.out + OUT_H); const bf16_t* HB = (const bf16_t*)((unsigned char*)p.out + OUT_HB); const float* nw = p.in[22];
  for (int unit = blockIdx.x; unit < 3072; unit += gridDim.x) {
    const int row = unit * 8 + wid; bf16_t* hp = H + (size_t)row * 1024 + 16 * lane; const bf16_t* bp = HB + (size_t)row * 1024 + 16 * lane;
    float v[16]; float ss = 0.f;
#pragma unroll
    for (int i = 0; i < 2; ++i) { const u32x4 a = *(const u32x4*)(hp + 8 * i), bq = *(const u32x4*)(bp + 8 * i);
      v[8 * i + 0] = bflo(a.x) + bflo(bq.x); v[8 * i + 1] = bfhi(a.x) + bfhi(bq.x); v[8 * i + 2] = bflo(a.y) + bflo(bq.y); v[8 * i + 3] = bfhi(a.y) + bfhi(bq.y);
      v[8 * i + 4] = bflo(a.z) + bflo(bq.z); v[8 * i + 5] = bfhi(a.z) + bfhi(bq.z); v[8 * i + 6] = bflo(a.w) + bflo(bq.w); v[8 * i + 7] = bfhi(a.w) + bfhi(bq.w); }
#pragma unroll
    for (int e = 0; e < 16; ++e) ss += v[e] * v[e];
    ss += __shfl_xor(ss, 1); ss += __shfl_xor(ss, 2); ss += __shfl_xor(ss, 4); ss += __shfl_xor(ss, 8);
    const float r = rsqrtf(ss * (1.0f / 256.0f) + 1e-6f);
#pragma unroll
    for (int i = 0; i < 2; ++i) { const f32x4 w0 = *(const f32x4*)(nw + 16 * lane + 8 * i), w1 = *(const f32x4*)(nw + 16 * lane + 8 * i + 4); u32x4 o;
      o.x = pack2(v[8 * i] * r * w0[0], v[8 * i + 1] * r * w0[1]); o.y = pack2(v[8 * i + 2] * r * w0[2], v[8 * i + 3] * r * w0[3]);
      o.z = pack2(v[8 * i + 4] * r * w1[0], v[8 * i + 5] * r * w1[1]); o.w = pack2(v[8 * i + 6] * r * w1[2], v[8 * i + 7] * r * w1[3]);
      *(u32x4*)(hp + 8 * i) = o; }
  }
}

constexpr int HY_WAVE = 18816, HY_HR = 0, HY_ZA = 8576, HY_ZB = 8576 + 5120;
__device__ void hyena_item(const Params& p, LP lds, int item) {
  const int tid = opaque_tid(), wid = __builtin_amdgcn_readfirstlane(tid >> 6), lane = tid & 63, n31 = lane & 31, hh = lane >> 5;
  const bool smp = item < 1024; const int it = smp ? item : item - 1024; const int bset = it >> 7, cgp = it & 127; const int c = cgp * 8 + wid;
  const int L = smp ? 2048 : 256, lgL = smp ? 11 : 8, nblk = L >> 5, lgnb = lgL - 5, ntok = smp ? 2048 : 1024, ntile = smp ? 2 : 1, dmax = L >> 6;
  const int tok0 = smp ? NCTX + bset * 2048 : bset * 1024;
  LP wl = lds + wid * HY_WAVE; LAS float* hr = (LAS float*)(wl + HY_HR);
  const float* HFp = (const float*)(p.ws + (smp ? OFF_HFS : OFF_HFC));
  const bf16_t* UT = (const bf16_t*)(p.ws + OFF_BIG);
  const float* cw = p.in[12]; const float* cbv = p.in[13]; const float* skp = p.in[21];
  { const int uc = 2048 + c; const float w0 = cw[uc], w1 = cw[3072 + uc], w2 = cw[6144 + uc], cb = cbv[uc]; const bf16_t* src = UT + (size_t)uc * NTOK + tok0;
    u32x4 vv[4]; float pvv[4], nxv[4];
#pragma unroll
    for (int i = 0; i < 4; ++i) { const int base = lane * 8 + 512 * i; vv[i] = (u32x4){0u, 0u, 0u, 0u}; pvv[i] = 0.f; nxv[i] = 0.f;
      if (base < ntok) { vv[i] = *(const u32x4*)(src + base); const int tl = base & (L - 1);
        if (tl != 0) pvv[i] = bf2f(src[base - 1]); if (tl + 8 != L) nxv[i] = bf2f(src[base + 8]); } }
#pragma unroll
    for (int i = 0; i < 4; ++i) { const int base = lane * 8 + 512 * i;
      if (base < ntok) { const u32x4 v = vv[i];
        float u[10]; u[0] = pvv[i]; u[1] = bflo(v.x); u[2] = bfhi(v.x); u[3] = bflo(v.y); u[4] = bfhi(v.y); u[5] = bflo(v.z); u[6] = bfhi(v.z); u[7] = bflo(v.w); u[8] = bfhi(v.w); u[9] = nxv[i];
        float o[8];
#pragma unroll
        for (int e = 0; e < 8; ++e) o[e] = cb + w0 * u[e] + w1 * u[e + 1] + w2 * u[e + 2];
        u32x4 w; w.x = pack2(o[0], o[1]); w.y = pack2(o[2], o[3]); w.z = pack2(o[4], o[5]); w.w = pack2(o[6], o[7]);
        *(LAS u32x4*)(wl + HY_ZA + ((base >> 5) * 40 + (base & 31)) * 2) = w; } } }
  const int HRP = L + 96;
  f32x4 fvN[8];
#define HY_FLOAD(o) do { const float* src_ = HFp + (size_t)((o) * 1024 + c) * L; \
    _Pragma("unroll") for (int i = 0; i < 8; ++i) { const int q = lane + 64 * i; fvN[i] = (4 * q < L) ? *(const f32x4*)(src_ + 4 * q) : (f32x4){0.f, 0.f, 0.f, 0.f}; } } while (0)
  HY_FLOAD(0);
  for (int ord = 0; ord < 2; ++ord) {
    { float sa = 0.f;
      f32x4 fv[8];
#pragma unroll
      for (int i = 0; i < 8; ++i) fv[i] = fvN[i];
#pragma unroll
      for (int i = 0; i < 8; ++i) sa += (fabsf(fv[i][0]) + fabsf(fv[i][1])) + (fabsf(fv[i][2]) + fabsf(fv[i][3]));
      sa = wave_sum(sa); const float inv = 1.0f / (sa + 1e-6f);
      asm volatile("s_waitcnt lgkmcnt(0)" ::: "memory");
      LAS bf16_t* E = (LAS bf16_t*)hr; LAS bf16_t* O = E + HRP;
#pragma unroll
      for (int i = 0; i < 8; ++i) { const int q = lane + 64 * i;
        if (4 * q < L) {
#pragma unroll
          for (int e = 0; e < 4; ++e) { const int yy = L - 1 - (4 * q + e); const bf16_t v = f2bf(fv[i][e] * inv); E[32 + yy] = v; O[31 + yy] = v; } } }
      if (lane < 32) { E[lane] = 0; E[32 + L + lane] = 0; O[31 + L + lane] = 0; if (lane < 31) O[lane] = 0; }
      if (lane < 33) O[HRP - 33 + lane] = 0;
      asm volatile("s_waitcnt lgkmcnt(0)" ::: "memory"); }
    if (ord == 0) HY_FLOAD(1);
    LP zin = wl + (ord == 0 ? HY_ZA : HY_ZB); LP zout = wl + (ord == 0 ? HY_ZB : HY_ZA);
    const int gc = ord * 1024 + c; const float w0 = cw[gc], w1 = cw[3072 + gc], w2 = cw[6144 + gc], cb = cbv[gc], sk = skp[ord * 1024 + c];
    const bf16_t* gsrc = UT + (size_t)gc * NTOK + tok0;
    u32x4 gv[4]; unsigned gpv[4], gnx[4];
#pragma unroll
    for (int i = 0; i < 4; ++i) { const int base = lane * 8 + 512 * i; gv[i] = (u32x4){0u, 0u, 0u, 0u}; gpv[i] = 0u; gnx[i] = 0u;
      if (base < ntok) { gv[i] = *(const u32x4*)(gsrc + base); const int tl = base & (L - 1);
        if (tl != 0) gpv[i] = gsrc[base - 1]; if (tl + 8 != L) gnx[i] = gsrc[base + 8]; } }
    f32x16 accs[2];
#pragma unroll
    for (int o2 = 0; o2 < 2; ++o2)
#pragma unroll
      for (int r = 0; r < 16; ++r) accs[o2][r] = 0.f;
    LP fb = wl + HY_HR + ((n31 & 1) ? 0 : (HRP * 2 - 2)) + 2 * ((L >> 1) - 1 - n31 + 8 * hh + 32);
    int cbl[2], ca[2];
#pragma unroll
    for (int ot = 0; ot < 2; ++ot) { const int col = 32 * ot + n31; cbl[ot] = (col >> lgnb) << lgnb; ca[ot] = col & (nblk - 1); }
    const bool two = (ntile == 2);
    {
      LP zero = wl + HY_HR + 16 * hh;
      LP ap = fb + 64 * dmax;
      int bbr0 = ca[0] + dmax, bbr1 = ca[1] + dmax;
      LP bp0 = zin + ((cbl[0] + bbr0) * 40 + 8 * hh) * 2, bp1 = zin + ((cbl[1] + bbr1) * 40 + 8 * hh) * 2;
      for (int d = -dmax; d <= dmax; ++d) {
        u32x4 w0v, w1v;
        w0v.x = *(const LAS unsigned*)(ap); w0v.y = *(const LAS unsigned*)(ap + 4); w0v.z = *(const LAS unsigned*)(ap + 8); w0v.w = *(const LAS unsigned*)(ap + 12);
        w1v.x = *(const LAS unsigned*)(ap + 32); w1v.y = *(const LAS unsigned*)(ap + 36); w1v.z = *(const LAS unsigned*)(ap + 40); w1v.w = *(const LAS unsigned*)(ap + 44);
        const bf16x8 af0 = __builtin_bit_cast(bf16x8, w0v), af1 = __builtin_bit_cast(bf16x8, w1v);
        LP q0 = ((unsigned)bbr0 < (unsigned)nblk) ? bp0 : zero;
        LP q1 = (two && ((unsigned)bbr1 < (unsigned)nblk)) ? bp1 : zero;
        const bf16x8 b00 = *(const LAS bf16x8*)q0, b01 = *(const LAS bf16x8*)(q0 + 32);
        const bf16x8 b10 = *(const LAS bf16x8*)q1, b11 = *(const LAS bf16x8*)(q1 + 32);
        __builtin_amdgcn_sched_barrier(0);
        accs[0] = __builtin_amdgcn_mfma_f32_32x32x16_bf16(af0, b00, accs[0], 0, 0, 0);
        if (two) accs[1] = __builtin_amdgcn_mfma_f32_32x32x16_bf16(af0, b10, accs[1], 0, 0, 0);
        accs[0] = __builtin_amdgcn_mfma_f32_32x32x16_bf16(af1, b01, accs[0], 0, 0, 0);
        if (two) accs[1] = __builtin_amdgcn_mfma_f32_32x32x16_bf16(af1, b11, accs[1], 0, 0, 0);
        ap -= 64; bbr0 -= 1; bbr1 -= 1; bp0 -= 80; bp1 -= 80;
      }
    }
#pragma unroll
    for (int ot = 0; ot < 2; ++ot) {
      if (ot >= ntile) continue;
      const f32x16 acc = accs[ot];
#pragma unroll
      for (int rg = 0; rg < 4; ++rg) {
        const int zo = (((cbl[ot] + ca[ot]) * 40) + 8 * rg + 4 * hh) * 2;
        const u32x2 zv = *(const LAS u32x2*)(zin + zo);
        u32x2 w; w.x = pack2(acc[4 * rg] + sk * bflo(zv.x), acc[4 * rg + 1] + sk * bfhi(zv.x)); w.y = pack2(acc[4 * rg + 2] + sk * bflo(zv.y), acc[4 * rg + 3] + sk * bfhi(zv.y));
        *(LAS u32x2*)(zout + zo) = w;
      }
    }
    asm volatile("s_waitcnt lgkmcnt(0)" ::: "memory");
#pragma unroll
    for (int i = 0; i < 4; ++i) { const int base = lane * 8 + 512 * i;
      if (base < ntok) { const u32x4 v = gv[i];
        float u[10]; u[0] = bf2f(gpv[i]); u[1] = bflo(v.x); u[2] = bfhi(v.x); u[3] = bflo(v.y); u[4] = bfhi(v.y); u[5] = bflo(v.z); u[6] = bfhi(v.z); u[7] = bflo(v.w); u[8] = bfhi(v.w); u[9] = bf2f(gnx[i]);
        LP zp = zout + ((base >> 5) * 40 + (base & 31)) * 2; const u32x4 t = *(const LAS u32x4*)zp;
        float tv[8]; tv[0] = bflo(t.x); tv[1] = bfhi(t.x); tv[2] = bflo(t.y); tv[3] = bfhi(t.y); tv[4] = bflo(t.z); tv[5] = bfhi(t.z); tv[6] = bflo(t.w); tv[7] = bfhi(t.w);
        float o[8];
#pragma unroll
        for (int e = 0; e < 8; ++e) o[e] = (cb + w0 * u[e] + w1 * u[e + 1] + w2 * u[e + 2]) * tv[e];
        u32x4 w; w.x = pack2(o[0], o[1]); w.y = pack2(o[2], o[3]); w.z = pack2(o[4], o[5]); w.w = pack2(o[6], o[7]);
        *(LAS u32x4*)zp = w; } }
    asm volatile("s_waitcnt lgkmcnt(0)" ::: "memory");
  }
  __syncthreads();
  { bf16_t* YH = (bf16_t*)((unsigned char*)p.out + OUT_HB);
    for (int tl = tid; tl < ntok; tl += 512) {
      const int bl = tl >> lgL, tloc = tl & (L - 1); const int zo = ((((bl << lgnb) + (tloc >> 5)) * 40) + (tloc & 31)) * 2;
      unsigned short e[8];
#pragma unroll
      for (int w = 0; w < 8; ++w) e[w] = *(const LAS unsigned short*)(lds + w * HY_WAVE + HY_ZA + zo);
      u32x4 o; o.x = e[0] | ((unsigned)e[1] << 16); o.y = e[2] | ((unsigned)e[3] << 16); o.z = e[4] | ((unsigned)e[5] << 16); o.w = e[6] | ((unsigned)e[7] << 16);
      *(u32x4*)(YH + (size_t)(tok0 + tl) * 1024 + cgp * 8) = o; } }
  __syncthreads();
}

__device__ void final_norm(const Params& p) {
  const int tid0 = opaque_tid(); const int wid = tid0 >> 6, lane = tid0 & 63; const float* fw = p.in[31]; const float* ssq = (const float*)(p.ws + OFF_SSQ2);
  for (int unit = blockIdx.x; unit < 3072; unit += gridDim.x) {
    const int row = unit * 8 + wid; float* xr = p.out + (size_t)row * 1024; const float* sp = ssq + (size_t)row * 16;
    const f32x4 st = *(const f32x4*)sp + *(const f32x4*)(sp + 4) + *(const f32x4*)(sp + 8) + *(const f32x4*)(sp + 12);
    const float rstd = rsqrtf((st[0] + st[1] + st[2] + st[3]) * (1.0f / 1024.0f) + 1e-6f);
#pragma unroll
    for (int i = 0; i < 4; ++i) { const int col = 4 * lane + 256 * i; const f32x4 v = *(const f32x4*)(xr + col) * rstd * *(const f32x4*)(fw + col); *(f32x4*)(xr + col) = v; }
  }
}

__global__ void __launch_bounds__(512, 2) __attribute__((flatten)) mega(Params p) {
  extern __shared__ __attribute__((aligned(16))) unsigned char shm[];
  LP lds = (LP)shm;
  cg::grid_group grid = cg::this_grid();
  volatile LAS unsigned* xst = (volatile LAS unsigned*)(lds + LDS_BYTES - 16);
  if (threadIdx.x == 0) { xst[0] = 0u; xst[1] = 0u; }
  __syncthreads();
  const XcdBarrier xb = xcd_barrier_post((unsigned*)(p.ws + OFF_BAR), xst);
  unsigned char* ws = p.ws;
  const bf16_t* WT = (const bf16_t*)(ws + OFF_WT); const bf16_t* HN = (const bf16_t*)(ws + OFF_HN); bf16_t* BIG = (bf16_t*)(ws + OFF_BIG);
  bf16_t* Hb = (bf16_t*)((unsigned char*)p.out + OUT_H); bf16_t* YH = (bf16_t*)((unsigned char*)p.out + OUT_HB);
  const float* mod = (const float*)(ws + OFF_MOD);
  phase0(p, lds);
  if (gridDim.y == 7u) grid.sync();
  xcd_barrier(xb);
  phase1(p, lds);
  weight_tiles(p, lds);
  xcd_barrier(xb);
  { EpiQKV e; e.O = BIG; e.bias = p.in[11]; run_gemm(lds, HN, WT, NTOK, 3072, 1024, e); }
  xcd_barrier(xb);
  for (int item = blockIdx.x; item < 1280; item += gridDim.x) mlstm_item(p, lds, item);
  xcd_barrier(xb);
  combine_rows(p);
  { EpiUT e; e.O = BIG; e.bias = p.in[11] + 4112; run_gemm(lds, WT + (size_t)3072 * 1024, HN, 3072, NTOK, 1024, e); }
  xcd_barrier(xb);
  for (int item = blockIdx.x; item < 2048; item += gridDim.x) hyena_item(p, lds, item);
  xcd_barrier(xb);
  { EpiGates e; e.H = Hb; e.G = BIG; e.b_in = p.in[11]; run_gemm(lds, HN, WT + (size_t)6144 * 1024, NTOK, 3072, 1024, e); }
  xcd_barrier(xb);
  bf16_t* T = BIG + (size_t)NTOK * 2048;
  { EpiMerge<0> e; e.T = T; e.G = BIG; run_gemm(lds, Hb, (const bf16_t*)(ws + OFF_WBM), NTOK, 1024, 1024, e); }
  { EpiMerge<1> e; e.T = T; e.G = BIG; run_gemm(lds, YH, (const bf16_t*)(ws + OFF_WBH), NTOK, 1024, 1024, e); }
  xcd_barrier(xb);
  { EpiOut e; e.xp = p.in[0]; e.xs = p.in[1]; e.per = (const float*)(ws + OFF_PER); e.pec = (const float*)(ws + OFF_PEC); e.mod = mod; e.n2w = p.in[26];
    e.X1 = p.out; e.A2 = (bf16_t*)(ws + OFF_HN); e.ssq = (float*)(ws + OFF_SSQ1); run_gemm(lds, T, (const bf16_t*)(ws + OFF_WOUT), NTOK, 1024, 1024, e); }
  xcd_barrier(xb);
#define FFN_HALF(ROW0) do { \
    { EpiFF1 e; e.row0 = (ROW0); e.ssq = (const float*)(p.ws + OFF_SSQ1); e.c1 = (const float*)(p.ws + OFF_C1); e.Hd = (bf16_t*)(p.ws + OFF_BIG); \
      run_gemm(lds, (const bf16_t*)(p.ws + OFF_HN) + (size_t)(ROW0) * 1024, (const bf16_t*)(p.ws + OFF_W1T), 12288, 4096, 1024, e); } \
    xcd_barrier(xb); \
    { EpiFF2 e; e.row0 = (ROW0); e.mod = (const float*)(p.ws + OFF_MOD); e.b2 = p.in[30]; e.X = p.out; e.ssq = (float*)(p.ws + OFF_SSQ2); \
      run_gemm(lds, (const bf16_t*)(p.ws + OFF_BIG), (const bf16_t*)(p.ws + OFF_W2T), 12288, 1024, 4096, e); } \
    xcd_barrier(xb); } while (0)
  FFN_HALF(0);
  FFN_HALF(12288);
#undef FFN_HALF
  final_norm(p);
}

extern "C" void kernel_launch(void* const* d_in, const int* in_sizes, int n_in, void* d_out, int out_size, void* d_ws, size_t ws_size, hipStream_t stream) {
  static int grid_blocks = 0;
  if (!grid_blocks) {
    int dev = 0, cus = 0, per_cu = 0;
    hipGetDevice(&dev);
    hipDeviceGetAttribute(&cus, hipDeviceAttributeMultiprocessorCount, dev);
    hipFuncSetAttribute((const void*)mega, hipFuncAttributeMaxDynamicSharedMemorySize, LDS_BYTES);
    hipOccupancyMaxActiveBlocksPerMultiprocessor(&per_cu, (const void*)mega, 512, LDS_BYTES);
    if (per_cu < 1) { fprintf(stderr, "kernel_launch: occupancy query reports %d blocks per CU\n", per_cu); grid_blocks = -1; }
    else grid_blocks = cus;
    if (n_in != 32 || ws_size < WS_END) { fprintf(stderr, "kernel_launch: unexpected n_in %d / ws_size %zu (need %zu)\n", n_in, ws_size, (size_t)WS_END); grid_blocks = -1; }
  }
  if (grid_blocks < 0) return;
  hipMemsetAsync((unsigned char*)d_ws + OFF_BAR, 0, 3456 * 4, stream);
  Params p{};
  for (int i = 0; i < 32; ++i) p.in[i] = (const float*)d_in[i];
  p.out = (float*)d_out; p.ws = (unsigned char*)d_ws;
  void* args[] = {&p};
  hipError_t e = hipLaunchCooperativeKernel((void*)mega, dim3(grid_blocks), dim3(512), args, LDS_BYTES, stream);
  if (e != hipSuccess) fprintf(stderr, "cooperative launch failed: %s (grid %d)\n", hipGetErrorString(e), grid_blocks);
}
```

```cpp
#include <hip/hip_runtime.h>
#include <hip/hip_cooperative_groups.h>
#include <cstdio>
#include <cstdint>
namespace cg = cooperative_groups;

#define LAS __attribute__((address_space(3)))
typedef LAS unsigned char* LP;
typedef unsigned short bf16_t;
typedef short bf16x8 __attribute__((ext_vector_type(8)));
typedef short s16x4 __attribute__((ext_vector_type(4)));
typedef float f32x4 __attribute__((ext_vector_type(4)));
typedef float f32x16 __attribute__((ext_vector_type(16)));
typedef unsigned u32x4 __attribute__((ext_vector_type(4)));
typedef unsigned u32x2 __attribute__((ext_vector_type(2)));

constexpr int DM = 1024, NTOK = 24576, NCTX = 8192, SEQC = 256, SEQS = 2048, INC = 9232;
constexpr int LDS_BYTES = 160 * 1024;
constexpr size_t OFF_WT = 0;
constexpr size_t OFF_WBM = 18874368, OFF_WBH = 20971520, OFF_WOUT = 23068672, OFF_W1T = 25165824, OFF_W2T = 33554432;
constexpr size_t OFF_HN = 41943040;
constexpr size_t OFF_BIG = 92274688;
constexpr size_t OFF_SM = 243269632;
constexpr size_t OFF_MOD = OFF_SM;
constexpr size_t OFF_C1 = OFF_MOD + 221184;
constexpr size_t OFF_H2S = OFF_C1 + 147456;
constexpr size_t OFF_H2C = OFF_H2S + 524288;
constexpr size_t OFF_PER = OFF_H2C + 65536;
constexpr size_t OFF_PEC = OFF_PER + 65536;
constexpr size_t OFF_GT = OFF_PEC + 131072;
constexpr size_t OFF_SSQ1 = OFF_GT + 1572864;
constexpr size_t OFF_SSQ2 = OFF_SSQ1 + 1572864;
constexpr size_t OFF_HFS = OFF_SSQ2 + 1572864;
constexpr size_t OFF_HFC = OFF_HFS + 16777216;
constexpr size_t OFF_BAR = OFF_HFC + 2097152;
constexpr size_t WS_END = OFF_BAR + 3456 * 4;
constexpr size_t OUT_H = 0, OUT_HB = 50331648;
constexpr size_t OUTF_C = 25165824, OUTF_N = 41943040, OUTF_M = 42008576;

struct Params { const float* in[32]; float* out; unsigned char* ws; };

__device__ __forceinline__ bf16_t f2bf(float f) { unsigned u = __float_as_uint(f); u += 0x7FFFu + ((u >> 16) & 1u); return (bf16_t)(u >> 16); }
__device__ __forceinline__ float bf2f(unsigned b) { return __uint_as_float(b << 16); }
__device__ __forceinline__ unsigned pack2(float lo, float hi) { return (unsigned)f2bf(lo) | ((unsigned)f2bf(hi) << 16); }
__device__ __forceinline__ float bflo(unsigned w) { return __uint_as_float(w << 16); }
__device__ __forceinline__ float bfhi(unsigned w) { return __uint_as_float(w & 0xffff0000u); }
__device__ __forceinline__ float sigmoidf_(float x) { return 1.0f / (1.0f + __expf(-x)); }
__device__ __forceinline__ int opaque_tid() { int t = threadIdx.x; asm volatile("" : "+v"(t)); return t; }
__device__ __forceinline__ float wave_sum(float v) {
#pragma unroll
  for (int o = 32; o >= 1; o >>= 1) v += __shfl_xor(v, o);
  return v;
}


#define XB_TMO      128
#define XB_XCNT(j)  (256  + 64 * (j))
#define XB_XSUB(j)  (1280 + 64 * (j))
#define XB_XGEN(j)  (2304 + 64 * (j))
#define XB_TOP      3328
#define XB_TOPGEN   3392
#define XCD_BAR_WORDS 3456
#define XB_SPIN_CAP (1u << 18)
__device__ __forceinline__ unsigned xb_ld(unsigned* p)              { return __hip_atomic_load(p, __ATOMIC_RELAXED, __HIP_MEMORY_SCOPE_AGENT); }
__device__ __forceinline__ unsigned xb_add(unsigned* p, unsigned v) { return __hip_atomic_fetch_add(p, v, __ATOMIC_RELAXED, __HIP_MEMORY_SCOPE_AGENT); }
__device__ __forceinline__ unsigned xb_xcc_id() { return (unsigned)__builtin_amdgcn_s_getreg((3 << 11) | 20) & 0xFu; }
#define XB_SPIN(cond, bar) do { unsigned _sp = 0; while (cond) { __builtin_amdgcn_s_sleep(1); \
    if ((++_sp & 255u) == 0u) { if (xb_ld(&(bar)[XB_TMO])) break; if (_sp > XB_SPIN_CAP) { atomicAdd(&(bar)[XB_TMO], 1u); break; } } } } while (0)
struct XcdBarrier { unsigned* bar; unsigned x; volatile LAS unsigned* st; };
__device__ __forceinline__ XcdBarrier xcd_barrier_post(unsigned* bar, volatile LAS unsigned* st) {
  XcdBarrier b; b.bar = bar; b.x = xb_xcc_id(); b.st = st;
  if (threadIdx.x == 0) (void)xb_add(&bar[XB_XCNT(b.x)], 1u);
  return b;
}
__device__ __forceinline__ void xcd_barrier_complete(unsigned* bar, unsigned x, unsigned& nloc, unsigned& nx) {
  const unsigned G = gridDim.x * gridDim.y * gridDim.z;
  unsigned sum, cnt, mine, sp = 0u;
  for (;;) {
    sum = 0u; cnt = 0u; mine = 0u;
#pragma unroll
    for (unsigned j = 0; j < 16; ++j) { const unsigned c = xb_ld(&bar[XB_XCNT(j)]); sum += c; cnt += (c > 0u) ? 1u : 0u; mine = (j == x) ? c : mine; }
    if (sum == G) break;
    __builtin_amdgcn_s_sleep(1);
    if ((++sp & 255u) == 0u) { if (xb_ld(&bar[XB_TMO])) break; if (sp > XB_SPIN_CAP) { atomicAdd(&bar[XB_TMO], 1u); break; } }
  }
  nloc = mine > 0u ? mine : 1u; nx = cnt > 0u ? cnt : 1u;
}
__device__ __forceinline__ void xcd_barrier(const XcdBarrier& b) {
  asm volatile("s_waitcnt vmcnt(0)" ::: "memory");
  __syncthreads();
  if (threadIdx.x == 0) {
    unsigned* bar = b.bar;
    __builtin_amdgcn_s_waitcnt(0);
    unsigned nloc = b.st[0], nx = b.st[1];
    if (nloc == 0u) { xcd_barrier_complete(bar, b.x, nloc, nx); b.st[0] = nloc; b.st[1] = nx; }
    const unsigned old = xb_add(&bar[XB_XSUB(b.x)], 1u);
    const unsigned gen = old / nloc;
    if (old + 1u == (gen + 1u) * nloc) {
      __builtin_amdgcn_fence(__ATOMIC_RELEASE, "agent");
      asm volatile("s_waitcnt vmcnt(0)" ::: "memory");
      const unsigned og = xb_add(&bar[XB_TOP], 1u);
      const unsigned tg = og / nx;
      if (og + 1u == (tg + 1u) * nx) xb_add(&bar[XB_TOPGEN], 1u);
      else XB_SPIN(xb_ld(&bar[XB_TOPGEN]) == tg, bar);
      __builtin_amdgcn_fence(__ATOMIC_ACQUIRE, "agent");
      xb_add(&bar[XB_XGEN(b.x)], 1u);
      asm volatile("s_waitcnt vmcnt(0)" ::: "memory");
    } else {
      XB_SPIN(xb_ld(&bar[XB_XGEN(b.x)]) == gen, bar);
      __builtin_amdgcn_fence(__ATOMIC_ACQUIRE, "agent");
      asm volatile("s_waitcnt vmcnt(0)" ::: "memory");
    }
  }
  __syncthreads();
}

namespace pg8 {
constexpr int BM = 256, BK = 64, HALF = 128, HTB = HALF * BK * 2, STAGE_BYTES = 8 * HTB, NXCD = 8, WGM = 8;
__host__ __device__ __forceinline__ int lds_byte(int r, int c) { const int st = (r >> 4) * 2 + (c >> 5), rr = r & 15, cc = c & 31, ob = rr * 64 + cc * 2; return st * 1024 + (ob ^ (((ob >> 9) & 1) << 5)); }
__host__ __device__ __forceinline__ void stage_rc(int b, int& R, int& C) { const int st = b / 1024, sb = b % 1024, swz = sb ^ (((sb >> 9) & 1) << 5); R = (st >> 1) * 16 + swz / 64; C = (st & 1) * 32 + (swz % 64) / 2; }
__host__ __device__ __forceinline__ int perm32(int rho) { const int n = rho >> 4, i = rho & 15; return 8 * (i >> 2) + 4 * n + (i & 3); }
struct Unit { int pm, pn; };
struct Gemm { const bf16_t* A; const bf16_t* Bt; int M, N, K; };
struct StaticOrder {
  int nM, nN, nwg, G, c;
  __device__ void init(int M, int N, int G_, int c_) { nM = M / BM; nN = N / BM; nwg = nM * nN; G = G_; c = c_; }
  __device__ bool next(int i, Unit& u) const {
    const long L = (long)i * G + c; if (L >= nwg) return false;
    int wgid = (int)L; { const int q = nwg / NXCD, r = nwg % NXCD, xcd = wgid % NXCD, off = wgid / NXCD; wgid = (xcd < r ? xcd * (q + 1) : r * (q + 1) + (xcd - r) * q) + off; }
    const int nig = WGM * nN, gid = wgid / nig, fm = gid * WGM, gsz = (nM - fm) < WGM ? (nM - fm) : WGM;
    u.pm = fm + ((wgid % nig) % gsz); u.pn = (wgid % nig) / gsz; return true;
  }
};

template <class Epi>
__device__ __forceinline__ void gemm_phase(LP lds, const Gemm g, const StaticOrder& S, const Epi& E) {
  int tid_ = threadIdx.x; asm volatile("" : "+v"(tid_));
  const int tid = tid_, wid = __builtin_amdgcn_readfirstlane(tid >> 6), lane = tid & 63, wr = wid >> 2, wc = wid & 3, fr = lane & 15, fq = lane >> 4;
  const int K = g.K, nt = K / BK;
  unsigned voffA[2], voffB[2];
#pragma unroll
  for (int i = 0; i < 2; ++i) { int R, C; stage_rc(tid * 16 + i * 8192, R, C); const int Rb = (R & ~31) + perm32(R & 31); voffA[i] = (unsigned)(R * K + C) * 2u; voffB[i] = (unsigned)(Rb * K + C) * 2u; }
  const size_t kstep = (size_t)(BK * 2);
  const size_t hstep = (size_t)HALF * K * 2;
  const size_t tstep = 2 * hstep;
  const unsigned ldsw = (unsigned)wid * 1024u;
  const int aoff = lds_byte(wr * 64 + fr, fq * 8), boff = lds_byte(wc * 32 + fr, fq * 8);
#define PG8_SA(b, h) (((b) * 2 + (h)) * HTB)
#define PG8_SB(b, h) ((4 + (b) * 2 + (h)) * HTB)
#define PG8_STAGE(bufoff, gbase, voff) do { _Pragma("unroll") for (int _i = 0; _i < 2; ++_i) \
    __builtin_amdgcn_global_load_lds((const unsigned*)((const char*)(gbase) + (voff)[_i]), (LAS unsigned*)(lds + (bufoff) + ldsw + _i * 8192), 16, 0, 0); } while (0)
#define PG8_LDA(dst, b, h) do { _Pragma("unroll") for (int m = 0; m < 4; ++m) _Pragma("unroll") for (int k = 0; k < 2; ++k) dst[m][k] = *(const LAS bf16x8*)(lds + PG8_SA(b, h) + aoff + m * 2048 + k * 1024); } while (0)
#define PG8_LDB(dst, b, h) do { _Pragma("unroll") for (int n = 0; n < 2; ++n) _Pragma("unroll") for (int k = 0; k < 2; ++k) dst[n][k] = *(const LAS bf16x8*)(lds + PG8_SB(b, h) + boff + n * 2048 + k * 1024); } while (0)
#define PG8_MMA(ai, bj, At, Bt) do { __builtin_amdgcn_s_setprio(1); _Pragma("unroll") for (int m = 0; m < 4; ++m) _Pragma("unroll") for (int n = 0; n < 2; ++n) _Pragma("unroll") for (int k = 0; k < 2; ++k) \
    acc[ai][bj][m][n] = __builtin_amdgcn_mfma_f32_16x16x32_bf16(Bt[n][k], At[m][k], acc[ai][bj][m][n], 0, 0, 0); __builtin_amdgcn_s_setprio(0); } while (0)
#define PG8_WAIT_V(n) asm volatile("s_waitcnt vmcnt(" #n ")" ::: "memory")
#define PG8_WAIT_L(n) asm volatile("s_waitcnt lgkmcnt(" #n ")" ::: "memory")
#define PG8_BAR __builtin_amdgcn_s_barrier()
#define PG8_SCHED __builtin_amdgcn_sched_barrier(0)
  Unit cur, nxt; int ui = 0;
  if (!S.next(0, cur)) return;
  f32x4 acc[2][2][4][2];
#pragma unroll
  for (int a = 0; a < 2; ++a)
#pragma unroll
    for (int b = 0; b < 2; ++b)
#pragma unroll
      for (int m = 0; m < 4; ++m)
#pragma unroll
        for (int n = 0; n < 2; ++n) acc[a][b][m][n] = (f32x4){0.f, 0.f, 0.f, 0.f};
  bf16x8 At[4][2], B0[2][2], B1[2][2];
  const char* cA = (const char*)g.A + (size_t)cur.pm * tstep; const char* cB = (const char*)g.Bt + (size_t)cur.pn * tstep;
  PG8_STAGE(PG8_SB(0, 0), cB, voffB); PG8_STAGE(PG8_SA(0, 0), cA, voffA); PG8_STAGE(PG8_SB(0, 1), cB + hstep, voffB); PG8_STAGE(PG8_SA(0, 1), cA + hstep, voffA);
  if (wr == 1) PG8_BAR;
  PG8_WAIT_V(4); PG8_BAR;
  PG8_STAGE(PG8_SB(1, 0), cB + kstep, voffB); PG8_STAGE(PG8_SA(1, 0), cA + kstep, voffA); PG8_STAGE(PG8_SB(1, 1), cB + hstep + kstep, voffB);
  PG8_WAIT_V(6); PG8_BAR;
  for (;;) {
    const bool has_next = S.next(ui + 1, nxt);
    const char* nA = has_next ? (const char*)g.A + (size_t)nxt.pm * tstep : cA; const char* nB = has_next ? (const char*)g.Bt + (size_t)nxt.pn * tstep : cB;
    for (int t = 0; t < nt; t += 2) {
      const bool last = (t == nt - 2);
      const char* a1 = cA + (size_t)(t + 1) * kstep;
      const char* a2 = last ? nA : cA + (size_t)(t + 2) * kstep; const char* b2 = last ? nB : cB + (size_t)(t + 2) * kstep;
      const char* a3 = a2 + kstep; const char* b3 = b2 + kstep;
      PG8_LDB(B0, 0, 0); PG8_SCHED; PG8_LDA(At, 0, 0); PG8_STAGE(PG8_SA(1, 1), a1 + hstep, voffA);
      PG8_WAIT_L(8); PG8_BAR; PG8_WAIT_L(0); PG8_MMA(0, 0, At, B0); PG8_BAR; PG8_SCHED;
      PG8_LDB(B1, 0, 1); PG8_STAGE(PG8_SB(0, 0), b2, voffB);
      PG8_BAR; PG8_WAIT_L(0); PG8_MMA(0, 1, At, B1); PG8_BAR;
      PG8_LDA(At, 0, 1); PG8_STAGE(PG8_SA(0, 0), a2, voffA);
      PG8_BAR; PG8_WAIT_L(0); PG8_MMA(1, 0, At, B0); PG8_BAR; PG8_SCHED;
      PG8_STAGE(PG8_SB(0, 1), b2 + hstep, voffB);
      PG8_WAIT_V(6); PG8_BAR; PG8_MMA(1, 1, At, B1); PG8_BAR;
      PG8_LDB(B0, 1, 0); PG8_SCHED; PG8_LDA(At, 1, 0); PG8_STAGE(PG8_SA(0, 1), a2 + hstep, voffA);
      PG8_WAIT_L(8); PG8_BAR; PG8_WAIT_L(0); PG8_MMA(0, 0, At, B0); PG8_BAR; PG8_SCHED;
      PG8_LDB(B1, 1, 1); PG8_STAGE(PG8_SB(1, 0), b3, voffB);
      PG8_BAR; PG8_WAIT_L(0); PG8_MMA(0, 1, At, B1); PG8_BAR;
      PG8_LDA(At, 1, 1); PG8_STAGE(PG8_SA(1, 0), a3, voffA);
      PG8_BAR; PG8_WAIT_L(0); PG8_MMA(1, 0, At, B0); PG8_BAR; PG8_SCHED;
      PG8_STAGE(PG8_SB(1, 1), b3 + hstep, voffB);
      PG8_WAIT_V(6); PG8_BAR; PG8_MMA(1, 1, At, B1); PG8_BAR;
    }
    { int fr2 = fr, fq2 = fq; asm volatile("" : "+v"(fr2), "+v"(fq2)); E(acc, cur, wr, wc, fr2, fq2); }
    if (!has_next) break;
#pragma unroll
    for (int a = 0; a < 2; ++a)
#pragma unroll
      for (int b = 0; b < 2; ++b)
#pragma unroll
        for (int m = 0; m < 4; ++m)
#pragma unroll
          for (int n = 0; n < 2; ++n) acc[a][b][m][n] = (f32x4){0.f, 0.f, 0.f, 0.f};
    cur = nxt; cA = nA; cB = nB; ++ui;
  }
  PG8_WAIT_V(0);
  if (wr == 0) PG8_BAR;
  PG8_BAR;
#undef PG8_SA
#undef PG8_SB
#undef PG8_STAGE
#undef PG8_LDA
#undef PG8_LDB
#undef PG8_MMA
#undef PG8_WAIT_V
#undef PG8_WAIT_L
#undef PG8_BAR
#undef PG8_SCHED
}
}
using pg8::Unit;
typedef f32x4 AccT[2][2][4][2];

#define EPI_ROW(ai, m) (u.pm * 256 + (ai) * 128 + wr * 64 + (m) * 16 + fr)
#define EPI_COL(bj, n) (u.pn * 256 + (bj) * 128 + wc * 32 + 8 * fq + 4 * (n))
#define EPI_LOOP_ROWS _Pragma("unroll") for (int ai = 0; ai < 2; ++ai) _Pragma("unroll") for (int m = 0; m < 4; ++m)
#define EPI_LOOP_COLS _Pragma("unroll") for (int bj = 0; bj < 2; ++bj) _Pragma("unroll") for (int n = 0; n < 2; ++n)

__device__ __forceinline__ int cond_of_row(int row) { return row < NCTX ? 0 : 1 + ((row - NCTX) >> 11); }

struct EpiQKV {
  bf16_t* O; const float* bias;
  __device__ __forceinline__ void operator()(const AccT& acc, const Unit& u, int wr, int wc, int fr, int fq) const {
    const float sc = (u.pn < 4) ? 0.0625f : 1.0f;
    EPI_LOOP_COLS { const int col = EPI_COL(bj, n); const f32x4 bv = *(const f32x4*)(bias + col);
      EPI_LOOP_ROWS { const int row = EPI_ROW(ai, m); const f32x4 v = (acc[ai][bj][m][n] + bv) * sc;
        u32x2 w; w.x = pack2(v[0], v[1]); w.y = pack2(v[2], v[3]); *(u32x2*)(O + (size_t)row * 3072 + col) = w; } }
  }
};
struct EpiUT {
  bf16_t* O; const float* bias;
  __device__ __forceinline__ void operator()(const AccT& acc, const Unit& u, int wr, int wc, int fr, int fq) const {
    EPI_LOOP_ROWS { const int row = EPI_ROW(ai, m); const float bv = bias[row];
      EPI_LOOP_COLS { const int col = EPI_COL(bj, n); const f32x4 v = acc[ai][bj][m][n] + bv;
        u32x2 w; w.x = pack2(v[0], v[1]); w.y = pack2(v[2], v[3]); *(u32x2*)(O + (size_t)row * NTOK + col) = w; } }
  }
};
struct EpiGates {
  bf16_t* H; bf16_t* G; const float* b_in;
  __device__ __forceinline__ void operator()(const AccT& acc, const Unit& u, int wr, int wc, int fr, int fq) const {
    const bool og = u.pn < 4;
    f32x4 bv[2][2];
    EPI_LOOP_COLS { const int col = EPI_COL(bj, n); bv[bj][n] = *(const f32x4*)(b_in + (og ? 3072 + col : 7184 + (col - 1024))); }
    EPI_LOOP_ROWS { const int row = EPI_ROW(ai, m);
      u32x2 hv[2][2];
      if (og) { EPI_LOOP_COLS { hv[bj][n] = *(const u32x2*)(H + (size_t)row * 1024 + EPI_COL(bj, n)); } }
      EPI_LOOP_COLS { const int col = EPI_COL(bj, n); const f32x4 a = acc[ai][bj][m][n] + bv[bj][n];
        f32x4 s; s[0] = sigmoidf_(a[0]); s[1] = sigmoidf_(a[1]); s[2] = sigmoidf_(a[2]); s[3] = sigmoidf_(a[3]);
        if (og) { const u32x2 h = hv[bj][n]; u32x2 w; w.x = pack2(bflo(h.x) * s[0], bfhi(h.x) * s[1]); w.y = pack2(bflo(h.y) * s[2], bfhi(h.y) * s[3]); *(u32x2*)(H + (size_t)row * 1024 + col) = w; }
        else { u32x2 w; w.x = pack2(s[0], s[1]); w.y = pack2(s[2], s[3]); *(u32x2*)(G + (size_t)row * 2048 + (col - 1024)) = w; } } }
  }
};
template <int SECOND> struct EpiMerge {
  bf16_t* T; const bf16_t* G;
  __device__ __forceinline__ void operator()(const AccT& acc, const Unit& u, int wr, int wc, int fr, int fq) const {
    EPI_LOOP_ROWS { const int row = EPI_ROW(ai, m);
      u32x2 gv[2][2], tv[2][2];
      EPI_LOOP_COLS { const int col = EPI_COL(bj, n); gv[bj][n] = *(const u32x2*)(G + (size_t)row * 2048 + SECOND * 1024 + col);
        if (SECOND) tv[bj][n] = *(const u32x2*)(T + (size_t)row * 1024 + col); }
      EPI_LOOP_COLS { const int col = EPI_COL(bj, n); const f32x4 a = acc[ai][bj][m][n]; const u32x2 g = gv[bj][n];
        f32x4 v; v[0] = bflo(g.x) * a[0]; v[1] = bfhi(g.x) * a[1]; v[2] = bflo(g.y) * a[2]; v[3] = bfhi(g.y) * a[3];
        if (SECOND) { const u32x2 t = tv[bj][n]; v[0] += bflo(t.x); v[1] += bfhi(t.x); v[2] += bflo(t.y); v[3] += bfhi(t.y); }
        u32x2 w; w.x = pack2(v[0], v[1]); w.y = pack2(v[2], v[3]); *(u32x2*)(T + (size_t)row * 1024 + col) = w; } }
  }
};
struct EpiOut {
  const float* xp; const float* xs; const float* per; const float* pec; const float* mod; const float* n2w; float* X1; bf16_t* A2; float* ssq;
  __device__ __forceinline__ void operator()(const AccT& acc, const Unit& u, int wr, int wc, int fr, int fq) const {
    const int cb = cond_of_row(u.pm * 256); const float* md = mod + cb * 6144; const bool smp = (u.pm * 256) >= NCTX;
    f32x4 g1v[2][2], k2v[2][2];
    EPI_LOOP_COLS { const int col = EPI_COL(bj, n); g1v[bj][n] = *(const f32x4*)(md + 2048 + col); k2v[bj][n] = *(const f32x4*)(n2w + col) * (*(const f32x4*)(md + 4096 + col) + 1.0f); }
    EPI_LOOP_ROWS { const int row = EPI_ROW(ai, m); float ss = 0.f;
#pragma unroll
      for (int bj = 0; bj < 2; ++bj) {
        f32x4 x0[2];
        if (!smp) {
#pragma unroll
          for (int n = 0; n < 2; ++n) x0[n] = *(const f32x4*)(xp + (size_t)row * 1024 + EPI_COL(bj, n)); }
        else { const int r2 = row - NCTX, t = r2 & 2047; f32x4 pe[2];
#pragma unroll
          for (int n = 0; n < 2; ++n) { const int col = EPI_COL(bj, n); x0[n] = *(const f32x4*)(xs + (size_t)r2 * 1024 + col);
            pe[n] = (col < 512) ? *(const f32x4*)(per + (t >> 6) * 512 + col) : *(const f32x4*)(pec + (t & 63) * 512 + (col - 512)); }
#pragma unroll
          for (int n = 0; n < 2; ++n) x0[n] += pe[n]; }
#pragma unroll
        for (int n = 0; n < 2; ++n) { const int col = EPI_COL(bj, n);
          const f32x4 x1 = x0[n] + g1v[bj][n] * acc[ai][bj][m][n]; *(f32x4*)(X1 + (size_t)row * 1024 + col) = x1;
          ss += x1[0] * x1[0] + x1[1] * x1[1] + x1[2] * x1[2] + x1[3] * x1[3];
          const f32x4 av = x1 * k2v[bj][n]; u32x2 w; w.x = pack2(av[0], av[1]); w.y = pack2(av[2], av[3]); *(u32x2*)(A2 + (size_t)row * 1024 + col) = w; } }
      ss += __shfl_xor(ss, 16); ss += __shfl_xor(ss, 32);
      if (fq == 0) ssq[(size_t)row * 16 + u.pn * 4 + wc] = ss; }
  }
};
struct EpiFF1 {
  int row0; const float* ssq; const float* c1; bf16_t* Hd;
  __device__ __forceinline__ void operator()(const AccT& acc, const Unit& u, int wr, int wc, int fr, int fq) const {
    const int cb = cond_of_row(row0 + u.pm * 256); const float* cc = c1 + cb * 4096;
    f32x4 cv[2][2];
    EPI_LOOP_COLS { cv[bj][n] = *(const f32x4*)(cc + EPI_COL(bj, n)); }
    float rs[2][4];
    EPI_LOOP_ROWS { const float* sp = ssq + (size_t)(row0 + EPI_ROW(ai, m)) * 16;
      const f32x4 st = (*(const f32x4*)sp + *(const f32x4*)(sp + 4)) + (*(const f32x4*)(sp + 8) + *(const f32x4*)(sp + 12));
      rs[ai][m] = rsqrtf((st[0] + st[1] + st[2] + st[3]) * (1.0f / 1024.0f) + 1e-6f); }
    EPI_LOOP_ROWS { const int rl = EPI_ROW(ai, m); const float rstd = rs[ai][m];
      EPI_LOOP_COLS { const int col = EPI_COL(bj, n); f32x4 v = acc[ai][bj][m][n] * rstd + cv[bj][n];
#pragma unroll
        for (int e = 0; e < 4; ++e) { const float r = fmaxf(v[e], 0.f); v[e] = r * r; }
        u32x2 w; w.x = pack2(v[0], v[1]); w.y = pack2(v[2], v[3]); *(u32x2*)(Hd + (size_t)rl * 4096 + col) = w; } }
  }
};
struct EpiFF2 {
  int row0; const float* mod; const float* b2; float* X; float* ssq;
  __device__ __forceinline__ void operator()(const AccT& acc, const Unit& u, int wr, int wc, int fr, int fq) const {
    const int cb = cond_of_row(row0 + u.pm * 256); const float* md = mod + cb * 6144;
    f32x4 g2v[2][2], bbv[2][2];
    EPI_LOOP_COLS { const int col = EPI_COL(bj, n); g2v[bj][n] = *(const f32x4*)(md + 5120 + col); bbv[bj][n] = *(const f32x4*)(b2 + col); }
    EPI_LOOP_ROWS { const int row = row0 + EPI_ROW(ai, m); float ss = 0.f;
      f32x4 xv[2][2];
      EPI_LOOP_COLS { xv[bj][n] = *(const f32x4*)(X + (size_t)row * 1024 + EPI_COL(bj, n)); }
      EPI_LOOP_COLS { const int col = EPI_COL(bj, n);
        const f32x4 x2 = xv[bj][n] + g2v[bj][n] * (acc[ai][bj][m][n] + bbv[bj][n]); *(f32x4*)(X + (size_t)row * 1024 + col) = x2;
        ss += x2[0] * x2[0] + x2[1] * x2[1] + x2[2] * x2[2] + x2[3] * x2[3]; }
      ss += __shfl_xor(ss, 16); ss += __shfl_xor(ss, 32);
      if (fq == 0) ssq[(size_t)row * 16 + u.pn * 4 + wc] = ss; }
  }
};

template <class Epi> __device__ __forceinline__ void run_gemm(LP lds, const bf16_t* A, const bf16_t* Bt, int M, int N, int K, const Epi& E) {
  pg8::Gemm g; g.A = A; g.Bt = Bt; g.M = M; g.N = N; g.K = K;
  pg8::StaticOrder S; S.init(M, N, (int)gridDim.x, (int)blockIdx.x);
  pg8::gemm_phase<Epi>(lds, g, S, E);
}

__device__ void transpose_tile(const float* __restrict__ src, int ld, int col0, int k0, bf16_t* __restrict__ dst, int K, int drow0, LAS float* tile) {
  const int t = opaque_tid();
  f32x4 v[4];
#pragma unroll
  for (int i = 0; i < 4; ++i) { const int idx = t + 512 * i, kr = idx >> 5, c4 = idx & 31; v[i] = *(const f32x4*)(src + (size_t)(k0 + kr) * ld + col0 + 4 * c4); }
#pragma unroll
  for (int i = 0; i < 4; ++i) { const int idx = t + 512 * i, kr = idx >> 5, c4 = idx & 31; LAS float* tp = tile + kr * 129 + 4 * c4; tp[0] = v[i][0]; tp[1] = v[i][1]; tp[2] = v[i][2]; tp[3] = v[i][3]; }
  __syncthreads();
  const int kb = t & 7;
#pragma unroll
  for (int i = 0; i < 2; ++i) { const int c = (t >> 3) + 64 * i; const LAS float* tp = tile + (kb * 8) * 129 + c; u32x4 o;
    o.x = pack2(tp[0], tp[129]); o.y = pack2(tp[2 * 129], tp[3 * 129]); o.z = pack2(tp[4 * 129], tp[5 * 129]); o.w = pack2(tp[6 * 129], tp[7 * 129]);
    *(u32x4*)(dst + (size_t)(drow0 + c) * K + k0 + kb * 8) = o; }
  __syncthreads();
}
template <int SILU> __device__ void matvec9_unit(const float* v0, const float* v1, int v1stride, const float* __restrict__ W, int ldw, const float* bias, float* out, int ldo, int col0, LAS float* lf) {
  const int t = opaque_tid(), lane = t & 63, wid = t >> 6;
  LAS float* sv = lf; LAS float* red = lf + 9216;
  for (int i = t; i < 9216; i += 512) { const int b = i >> 10, k = i & 1023; float x = (b == 0) ? v0[k] : v1[(size_t)(b - 1) * v1stride + k]; if (SILU) x = x / (1.0f + __expf(-x)); sv[i] = x; }
  __syncthreads();
  const int c4 = t & 7, kl = t >> 3;
  f32x4 w[16];
#pragma unroll
  for (int i = 0; i < 16; ++i) w[i] = *(const f32x4*)(W + (size_t)(kl + 64 * i) * ldw + col0 + 4 * c4);
  f32x4 acc[9];
#pragma unroll
  for (int b = 0; b < 9; ++b) acc[b] = (f32x4){0.f, 0.f, 0.f, 0.f};
#pragma unroll
  for (int i = 0; i < 16; ++i)
#pragma unroll
    for (int b = 0; b < 9; ++b) acc[b] += w[i] * sv[b * 1024 + kl + 64 * i];
#pragma unroll
  for (int b = 0; b < 9; ++b)
#pragma unroll
    for (int e = 0; e < 4; ++e) { float x = acc[b][e]; x += __shfl_xor(x, 8); x += __shfl_xor(x, 16); x += __shfl_xor(x, 32); acc[b][e] = x; }
  if (lane < 8) {
#pragma unroll
    for (int b = 0; b < 9; ++b) *(LAS f32x4*)(red + (wid * 9 + b) * 32 + 4 * lane) = acc[b]; }
  __syncthreads();
  if (t < 288) { const int b = t >> 5, cc = t & 31; float s = bias[col0 + cc];
#pragma unroll
    for (int pz = 0; pz < 8; ++pz) s += red[(pz * 9 + b) * 32 + cc];
    out[(size_t)b * ldo + col0 + cc] = s; }
  __syncthreads();
}

__device__ void phase0(const Params& p, LP lds) {
  unsigned char* ws = p.ws; LAS float* lf = (LAS float*)lds;
  const int tid0 = opaque_tid(); const int wid = tid0 >> 6, lane = tid0 & 63;
  for (int unit = blockIdx.x; unit < 576; unit += gridDim.x) {
    if (unit < 192) {
      matvec9_unit<1>(p.in[6], p.in[5], 1024, p.in[7], 6144, p.in[8], (float*)(ws + OFF_MOD), 6144, unit * 32, lf);
    } else if (unit < 480) {
      const int row = (unit - 192) * 8 + wid; const bool smp = row < 2048; const int L = smp ? 2048 : 256, t = smp ? row : row - 2048;
      const float* w1 = p.in[14]; const float* b1 = p.in[15]; const float* fr1 = p.in[16]; const float* w2 = p.in[17]; const float* b2 = p.in[18]; const float* fr2 = p.in[19];
      float a = b1[lane] + (float)t / (float)(L - 1) * w1[lane];
      const float base = (6.283185307179586f / (float)L) * (float)t;
      float cs = 0.f, sn = 0.f; if (lane < 16) { const float ang = base * (float)(lane + 1); cs = cosf(ang); sn = sinf(ang); }
#pragma unroll
      for (int i = 0; i < 16; ++i) a += __shfl(cs, i) * w1[(1 + i) * 64 + lane] + __shfl(sn, i) * w1[(17 + i) * 64 + lane];
      const float h1 = sinf(fr1[lane] * a);
      float a2 = b2[lane];
#pragma unroll 16
      for (int j = 0; j < 64; ++j) a2 += __shfl(h1, j) * w2[j * 64 + lane];
      const float h2 = sinf(fr2[lane] * a2);
      float* dst = (float*)(ws + (smp ? OFF_H2S : OFF_H2C)); dst[(size_t)t * 64 + lane] = h2;
    } else {
      const int r = unit - 480, c = tid0; const int pos = r < 32 ? r : r - 32; const int i = c & 255;
      const float omega = 1.0f / powf(10000.0f, (float)i / 256.0f); const float a = (float)pos * omega; const float v = c < 256 ? sinf(a) : cosf(a);
      float* dst = (float*)(ws + (r < 32 ? OFF_PER : OFF_PEC)); dst[(size_t)pos * 512 + c] = v;
    }
  }
}
__device__ void weight_tiles(const Params& p, LP lds) {
  unsigned char* ws = p.ws; LAS float* lf = (LAS float*)lds;
  for (int tu = blockIdx.x; tu < 2560; tu += gridDim.x) {
    const float* src; int ld, K, col0, k0, drow0; bf16_t* dst;
    if (tu < 1152) { const int nt = tu >> 4, kt = tu & 15; const int r = nt * 128; src = p.in[10]; ld = INC; K = 1024; k0 = kt * 64; drow0 = r; dst = (bf16_t*)(ws + OFF_WT);
      col0 = r < 3072 ? r : (r < 6144 ? 4112 + (r - 3072) : (r < 7168 ? 3072 + (r - 6144) : 7184 + (r - 7168))); }
    else if (tu < 1536) { const int v = tu - 1152, w = v >> 7, q = v & 127; src = p.in[23 + w]; ld = 1024; K = 1024; k0 = (q & 15) * 64; col0 = (q >> 4) * 128; drow0 = col0; dst = (bf16_t*)(ws + (w == 0 ? OFF_WBM : (w == 1 ? OFF_WBH : OFF_WOUT))); }
    else if (tu < 2048) { const int q = tu - 1536; src = p.in[27]; ld = 4096; K = 1024; k0 = (q & 15) * 64; col0 = (q >> 4) * 128; drow0 = col0; dst = (bf16_t*)(ws + OFF_W1T); }
    else { const int q = tu - 2048; src = p.in[29]; ld = 1024; K = 4096; k0 = (q & 63) * 64; col0 = (q >> 6) * 128; drow0 = col0; dst = (bf16_t*)(ws + OFF_W2T); }
    transpose_tile(src, ld, col0, k0, dst, K, drow0, lf);
  }
}

__device__ void phase1(const Params& p, LP lds) {
  unsigned char* ws = p.ws;
  int tid_ = threadIdx.x; asm volatile("" : "+v"(tid_));
  const int tid = tid_, wid = tid >> 6, lane = tid & 63;
  const float* mod = (const float*)(ws + OFF_MOD);
  LAS float* wg = (LAS float*)lds;
  if ((int)blockIdx.x < 1536) {
    f32x4 gw[8];
#pragma unroll
    for (int i = 0; i < 8; ++i) { const int idx = tid + 512 * i, k = idx >> 2, q = idx & 3; gw[i] = *(const f32x4*)(p.in[10] + (size_t)k * INC + 4096 + 4 * q); }
#pragma unroll
    for (int i = 0; i < 8; ++i) { const int idx = tid + 512 * i, k = idx >> 2, q = idx & 3; wg[(4 * q) * 1024 + k] = gw[i][0]; wg[(4 * q + 1) * 1024 + k] = gw[i][1]; wg[(4 * q + 2) * 1024 + k] = gw[i][2]; wg[(4 * q + 3) * 1024 + k] = gw[i][3]; }
    __syncthreads();
  }
  for (int unit = blockIdx.x; unit < 1536; unit += gridDim.x) {
    const int tidn = opaque_tid(); const int wid = tidn >> 6, lane = tidn & 63;
    const int row0 = unit * 16 + wid * 2; const int cb = cond_of_row(row0); const float* md = mod + cb * 6144; const bool smp = row0 >= NCTX;
    f32x4 v[2][4]; float rstd[2];
#pragma unroll
    for (int r = 0; r < 2; ++r) { const int row = row0 + r; const float* xr; int t = 0;
      if (!smp) xr = p.in[0] + (size_t)row * 1024; else { xr = p.in[1] + (size_t)(row - NCTX) * 1024; t = (row - NCTX) & 2047; }
      const float* per = (const float*)(ws + OFF_PER) + (t >> 6) * 512; const float* pec = (const float*)(ws + OFF_PEC) + (t & 63) * 512;
      float ss = 0.f;
#pragma unroll
      for (int i = 0; i < 4; ++i) { const int col = 4 * lane + 256 * i; v[r][i] = *(const f32x4*)(xr + col);
        if (smp) v[r][i] += (col < 512) ? *(const f32x4*)(per + col) : *(const f32x4*)(pec + col - 512);
        ss += v[r][i][0] * v[r][i][0] + v[r][i][1] * v[r][i][1] + v[r][i][2] * v[r][i][2] + v[r][i][3] * v[r][i][3]; }
      ss = wave_sum(ss); rstd[r] = rsqrtf(ss * (1.0f / 1024.0f) + 1e-6f); }
    const float* n1w = p.in[9];
    float ga[32];
#pragma unroll
    for (int g = 0; g < 32; ++g) ga[g] = 0.f;
#pragma unroll
    for (int i = 0; i < 4; ++i) { const int col = 4 * lane + 256 * i;
      const f32x4 w = *(const f32x4*)(n1w + col), sc = *(const f32x4*)(md + 1024 + col), sh = *(const f32x4*)(md + col);
      const f32x4 ws1 = w * (sc + 1.0f);
      f32x4 h[2];
#pragma unroll
      for (int r = 0; r < 2; ++r) { h[r] = v[r][i] * rstd[r] * ws1 + sh;
        u32x2 o; o.x = pack2(h[r][0], h[r][1]); o.y = pack2(h[r][2], h[r][3]); *(u32x2*)((bf16_t*)(ws + OFF_HN) + (size_t)(row0 + r) * 1024 + col) = o; }
#pragma unroll
      for (int g = 0; g < 16; ++g) { const f32x4 wv = *(const LAS f32x4*)(wg + g * 1024 + col);
#pragma unroll
        for (int r = 0; r < 2; ++r) ga[r * 16 + g] += h[r][0] * wv[0] + h[r][1] * wv[1] + h[r][2] * wv[2] + h[r][3] * wv[3]; }
      asm volatile("" ::: "memory"); }
#pragma unroll
    for (int off = 16; off >= 1; off >>= 1) { const bool hi = (lane & off) != 0;
#pragma unroll
      for (int i = 0; i < off; ++i) { const float send = hi ? ga[i] : ga[i + off]; const float keep = hi ? ga[i + off] : ga[i]; ga[i] = keep + __shfl_xor(send, off); } }
    const float tot = ga[0] + __shfl_xor(ga[0], 32);
    if (lane < 32) ((float*)(ws + OFF_GT))[(size_t)row0 * 16 + lane] = tot + p.in[11][4096 + (lane & 15)];
  }
  __syncthreads();
  LAS float* w3s = (LAS float*)lds;
  for (int v = blockIdx.x; v < 320; v += gridDim.x) {
    const int tid = opaque_tid();
    const bool smp = v < 256; const int L = smp ? 2048 : 256; const int tt = smp ? (v >> 6) : 0, cgp = v & 63; const int t = tt * 512 + tid;
    { const f32x4 x = *(const f32x4*)(p.in[20] + (size_t)(tid >> 3) * 2048 + cgp * 32 + 4 * (tid & 7)); LAS float* wp = w3s + (4 * (tid & 7)) * 64 + (tid >> 3);
      wp[0] = x[0]; wp[64] = x[1]; wp[128] = x[2]; wp[192] = x[3]; }
    __syncthreads();
    if (t < L) {
      const float* H2 = (const float*)(ws + (smp ? OFF_H2S : OFF_H2C)) + (size_t)t * 64;
      f32x4 h2[16];
#pragma unroll
      for (int i = 0; i < 16; ++i) h2[i] = *(const f32x4*)(H2 + 4 * i);
      const float dist = fabsf((float)t - (float)(L / 2)) / (float)(L / 2);
      float* HF = (float*)(ws + (smp ? OFF_HFS : OFF_HFC)) + (size_t)(cgp * 32) * L + t;
#pragma unroll 1
      for (int j = 0; j < 32; ++j) {
        f32x4 a = {0.f, 0.f, 0.f, 0.f};
#pragma unroll
        for (int i = 0; i < 16; ++i) a += *(const LAS f32x4*)(w3s + j * 64 + 4 * i) * h2[i];
        const int c = (cgp * 32 + j) & 1023;
        const float dmin = -3.0701134573253946f, dmax = -15.350567286626973f;
        const float delta = fabsf(dmin + (dmax - dmin) * ((float)c / 1023.0f));
        HF[(size_t)j * L] = ((a[0] + a[1]) + (a[2] + a[3])) * __expf(-dist * delta); }
    }
    __syncthreads();
  }
  for (int u = (int)gridDim.x - 1 - (int)blockIdx.x; u < 128; u += gridDim.x)
    matvec9_unit<0>(mod + 3072, mod + 6144 + 3072, 6144, p.in[27], 4096, p.in[28], (float*)(ws + OFF_C1), 4096, u * 32, (LAS float*)lds);
}

__device__ __forceinline__ bf16x8 tr_frag(LP base, int k0, int m0, int pitch  , int l15, int g) {
  const int q = l15 >> 2, pp = l15 & 3;
  LP a = base + ((k0 + 8 * g + q) * pitch + m0 + 4 * pp) * 2;
  const s16x4 lo = __builtin_amdgcn_ds_read_tr16_b64_v4i16((LAS s16x4*)a);
  const s16x4 hi = __builtin_amdgcn_ds_read_tr16_b64_v4i16((LAS s16x4*)(a + 8 * pitch));
  bf16x8 r; r[0] = lo[0]; r[1] = lo[1]; r[2] = lo[2]; r[3] = lo[3]; r[4] = hi[0]; r[5] = hi[1]; r[6] = hi[2]; r[7] = hi[3]; return r;
}
__device__ __forceinline__ bf16x8 tr_at(LP lanebase, int coff  , int pitch_bytes) {
  const s16x4 lo = __builtin_amdgcn_ds_read_tr16_b64_v4i16((LAS s16x4*)(lanebase + coff));
  const s16x4 hi = __builtin_amdgcn_ds_read_tr16_b64_v4i16((LAS s16x4*)(lanebase + coff + 4 * pitch_bytes));
  bf16x8 r; r[0] = lo[0]; r[1] = lo[1]; r[2] = lo[2]; r[3] = lo[3]; r[4] = hi[0]; r[5] = hi[1]; r[6] = hi[2]; r[7] = hi[3]; return r;
}
constexpr int ML_K = 0, ML_V = 67584, ML_P = 86016, ML_C = 120832, ML_T = 157696, ML_TSZ = 1600;
constexpr int KP = 264, VP = 72, PP = 136, CP = 72;

__device__ void mlstm_item(const Params& p, LP lds, int item) {
  const int tid = opaque_tid(), wid = __builtin_amdgcn_readfirstlane(tid >> 6), lane = tid & 63, l15 = lane & 15, g = lane >> 4;
  const bool smp = item < 256; const int uu = smp ? (item >> 2) : ((item - 256) >> 2); const int sl = item & 3;
  const int b = uu >> 3, dir = (uu >> 2) & 1, head = uu & 3;
  const int S = smp ? SEQS : SEQC, nc = S >> 7; const int tok0 = smp ? NCTX + b * SEQS : b * SEQC;
  const bf16_t* qkv = (const bf16_t*)(p.ws + OFF_BIG);
  const float* GT = (const float*)(p.ws + OFF_GT);
  bf16_t* hout = (bf16_t*)((unsigned char*)p.out + (dir ? OUT_HB : OUT_H));
  const int sidx = (b * 2 + dir) * 4 + head;
  const int gi_col = dir * 8 + head, gf_col = dir * 8 + 4 + head;
  f32x4 Cacc[2][4], nacc[2]; float mst0;
  if (smp) {
    const float* C0 = p.in[2] + (size_t)sidx * 65536;
#pragma unroll
    for (int dt = 0; dt < 2; ++dt) {
#pragma unroll
      for (int vt = 0; vt < 4; ++vt) Cacc[dt][vt] = *(const f32x4*)(C0 + (size_t)((2 * wid + dt) * 16 + l15) * 256 + sl * 64 + 16 * vt + 4 * g);
      nacc[dt] = (f32x4){p.in[3][sidx * 256 + (2 * wid + dt) * 16 + l15], 0.f, 0.f, 0.f}; }
    mst0 = p.in[4][sidx];
  } else {
#pragma unroll
    for (int dt = 0; dt < 2; ++dt) {
#pragma unroll
      for (int vt = 0; vt < 4; ++vt) Cacc[dt][vt] = (f32x4){0.f, 0.f, 0.f, 0.f};
      nacc[dt] = (f32x4){0.f, 0.f, 0.f, 0.f}; }
    mst0 = 0.f;
  }
#define TOKC(cc, j) (dir ? (tok0 + S - 1 - ((cc) * 128 + (j))) : (tok0 + (cc) * 128 + (j)))
  const int rt = (wid < 4) ? wid : 11 - wid;
  const int jrow = 16 * rt + l15;
  bf16x8 qf[8]; u32x4 kreg[8], vreg[2]; float g4[4] = {0.f, 0.f, 0.f, 0.f};
#define ML_LOAD_Q(cc) do { const bf16_t* qp = qkv + (size_t)TOKC(cc, jrow) * 3072 + head * 256 + 8 * g; \
    _Pragma("unroll") for (int kk = 0; kk < 8; ++kk) qf[kk] = *(const bf16x8*)(qp + 32 * kk); } while (0)
#define ML_LOAD_KV(cc) do { \
    _Pragma("unroll") for (int i = 0; i < 8; ++i) { const int row = (tid >> 5) + 16 * i; kreg[i] = *(const u32x4*)(qkv + (size_t)TOKC(cc, row) * 3072 + 1024 + head * 256 + (tid & 31) * 8); } \
    _Pragma("unroll") for (int i = 0; i < 2; ++i) { const int row = (tid >> 3) + 64 * i; vreg[i] = *(const u32x4*)(qkv + (size_t)TOKC(cc, row) * 3072 + 2048 + head * 256 + sl * 64 + (tid & 7) * 8); } \
    if (wid == 0) { const float* g0 = GT + (size_t)TOKC(cc, 2 * lane) * 16; const float* g1 = GT + (size_t)TOKC(cc, 2 * lane + 1) * 16; g4[0] = g0[gi_col]; g4[1] = g0[gf_col]; g4[2] = g1[gi_col]; g4[3] = g1[gf_col]; } } while (0)
#define ML_SCAN(tabp, mcur, mnext) do { LAS float* T_ = (LAS float*)(tabp); \
    const float lf0 = fminf(g4[1], 0.f) - log1pf(__expf(-fabsf(g4[1]))), lf1 = fminf(g4[3], 0.f) - log1pf(__expf(-fabsf(g4[3]))); \
    float s_ = lf0 + lf1; \
    _Pragma("unroll") for (int o = 1; o < 64; o <<= 1) { const float t_ = __shfl_up(s_, o); if (lane >= o) s_ += t_; } \
    const float b1_ = s_, b0_ = s_ - lf1; const float u0_ = g4[0] - b0_, u1_ = g4[2] - b1_; \
    float mx_ = fmaxf(u0_, u1_); \
    _Pragma("unroll") for (int o = 1; o < 64; o <<= 1) { const float t_ = __shfl_up(mx_, o); if (lane >= o) mx_ = fmaxf(mx_, t_); } \
    float ex_ = __shfl_up(mx_, 1); if (lane == 0) ex_ = -INFINITY; \
    const float M0_ = fmaxf(mcur, fmaxf(ex_, u0_)), M1_ = fmaxf(mcur, mx_); \
    T_[2 * lane] = u0_; T_[2 * lane + 1] = u1_; T_[128 + 2 * lane] = M0_; T_[128 + 2 * lane + 1] = M1_; T_[256 + 2 * lane] = b0_; T_[256 + 2 * lane + 1] = b1_; \
    const float Ml_ = __shfl(M1_, 63), bl_ = __shfl(b1_, 63); \
    if (lane == 0) { T_[384] = mcur; T_[385] = Ml_; } \
    mnext = bl_ + Ml_; } while (0)
  float mw0 = mst0;
  ML_LOAD_Q(0); ML_LOAD_KV(0);
  if (wid == 0) { float mn; ML_SCAN(lds + ML_T, mw0, mn); mw0 = mn; }
  __syncthreads();
  float m_final = 0.f;
  for (int c = 0; c < nc; ++c) {
    LAS float* T = (LAS float*)(lds + ML_T + (c & 1) * ML_TSZ);
    const float mst = T[384], M_last = T[385];
#pragma unroll
    for (int i = 0; i < 8; ++i) { const int row = (tid >> 5) + 16 * i; *(LAS u32x4*)(lds + ML_K + (row * KP + (tid & 31) * 8) * 2) = kreg[i]; }
#pragma unroll
    for (int i = 0; i < 2; ++i) { const int row = (tid >> 3) + 64 * i; const float w = __expf(T[row] - M_last); const u32x4 v = vreg[i]; u32x4 o;
      o.x = pack2(bflo(v.x) * w, bfhi(v.x) * w); o.y = pack2(bflo(v.y) * w, bfhi(v.y) * w); o.z = pack2(bflo(v.z) * w, bfhi(v.z) * w); o.w = pack2(bflo(v.w) * w, bfhi(v.w) * w);
      *(LAS u32x4*)(lds + ML_V + (row * VP + (tid & 7) * 8) * 2) = o; }
    if (tid < 128) *(LAS unsigned short*)(lds + ML_V + (tid * VP + 64) * 2) = f2bf(__expf(T[tid] - M_last));
#pragma unroll
    for (int dt = 0; dt < 2; ++dt) {
#pragma unroll
      for (int vt = 0; vt < 4; ++vt) { u32x2 w; w.x = pack2(Cacc[dt][vt][0], Cacc[dt][vt][1]); w.y = pack2(Cacc[dt][vt][2], Cacc[dt][vt][3]);
        *(LAS u32x2*)(lds + ML_C + (((2 * wid + dt) * 16 + l15) * CP + 16 * vt + 4 * g) * 2) = w; }
      if (g == 0) *(LAS unsigned short*)(lds + ML_C + (((2 * wid + dt) * 16 + l15) * CP + 64) * 2) = f2bf(nacc[dt][0]); }
    const int qtok = TOKC(c, jrow);
    const bool more = (c + 1 < nc);
    __syncthreads();
    const float Mj = T[128 + jrow], bj = T[256 + jrow]; const float rf = __expf(M_last - Mj), w_inter = __expf(mst - Mj);
    int lq_ = (8 * g + (l15 >> 2)), lp_ = 4 * (l15 & 3); asm volatile("" : "+v"(lq_), "+v"(lp_));
    const LP cB = lds + ML_C + (lq_ * CP + lp_) * 2, vB = lds + ML_V + (lq_ * VP + lp_) * 2, kB = lds + ML_K + (lq_ * KP + lp_ + 32 * wid) * 2;
    const LP pB = lds + ML_P + (jrow * PP + 8 * g) * 2;
    for (int st = 0; st <= rt; ++st) {
      f32x4 s = {0.f, 0.f, 0.f, 0.f};
      bf16x8 kfr[8];
#pragma unroll
      for (int kk = 0; kk < 8; ++kk) kfr[kk] = *(const LAS bf16x8*)(lds + ML_K + ((16 * st + l15) * KP + 32 * kk + 8 * g) * 2);
      __builtin_amdgcn_sched_barrier(0);
#pragma unroll
      for (int kk = 0; kk < 8; ++kk) s = __builtin_amdgcn_mfma_f32_16x16x32_bf16(kfr[kk], qf[kk], s, 0, 0, 0);
      float pv[4];
#pragma unroll
      for (int i = 0; i < 4; ++i) pv[i] = ((16 * st + 4 * g + i) <= jrow) ? s[i] * rf : 0.f;
      u32x2 w; w.x = pack2(pv[0], pv[1]); w.y = pack2(pv[2], pv[3]);
      *(LAS u32x2*)(lds + ML_P + (jrow * PP + 16 * st + 4 * g) * 2) = w;
    }
    if ((rt & 1) == 0) { u32x2 z; z.x = 0u; z.y = 0u; *(LAS u32x2*)(lds + ML_P + (jrow * PP + 16 * (rt + 1) + 4 * g) * 2) = z; }
    if (more) ML_LOAD_KV(c + 1);
    asm volatile("s_waitcnt lgkmcnt(0)" ::: "memory");
    f32x4 ha[5];
#pragma unroll
    for (int vt = 0; vt < 5; ++vt) { f32x4 a = {0.f, 0.f, 0.f, 0.f};
      if (smp || c > 0) {
        bf16x8 cfr[8];
#pragma unroll
        for (int kk = 0; kk < 8; ++kk) cfr[kk] = tr_at(cB, (32 * kk * CP + 16 * vt) * 2, CP * 2);
        __builtin_amdgcn_sched_barrier(0);
#pragma unroll
        for (int kk = 0; kk < 8; ++kk) a = __builtin_amdgcn_mfma_f32_16x16x32_bf16(cfr[kk], qf[kk], a, 0, 0, 0);
        a *= w_inter; }
      ha[vt] = a; }
    for (int k2 = 0; k2 <= (rt >> 1); ++k2) {
      const bf16x8 pf = *(const LAS bf16x8*)(pB + k2 * 64);
      bf16x8 vfr[5];
#pragma unroll
      for (int vt = 0; vt < 5; ++vt) vfr[vt] = tr_at(vB + k2 * (32 * VP * 2), (16 * vt) * 2, VP * 2);
      __builtin_amdgcn_sched_barrier(0);
#pragma unroll
      for (int vt = 0; vt < 5; ++vt) ha[vt] = __builtin_amdgcn_mfma_f32_16x16x32_bf16(vfr[vt], pf, ha[vt], 0, 0, 0); }
    { const float den = __shfl(ha[4][0], l15); const float rdd = 1.0f / fmaxf(fabsf(den), __expf(-(bj + Mj)));
#pragma unroll
      for (int vt = 0; vt < 4; ++vt) { const f32x4 a = ha[vt] * rdd; u32x2 w; w.x = pack2(a[0], a[1]); w.y = pack2(a[2], a[3]);
        *(u32x2*)(hout + (size_t)qtok * 1024 + head * 256 + sl * 64 + 16 * vt + 4 * g) = w; } }
    if (more) ML_LOAD_Q(c + 1);
    const bool need_state = (!smp) || more;
    if (need_state) {
      const float decay = __expf(mst - M_last);
#pragma unroll
      for (int dt = 0; dt < 2; ++dt) {
#pragma unroll
        for (int vt = 0; vt < 4; ++vt) Cacc[dt][vt] *= decay;
        nacc[dt] *= decay; }
#pragma unroll
      for (int ks = 0; ks < 4; ++ks) {
        const bf16x8 kf0 = tr_at(kB, (32 * ks * KP) * 2, KP * 2), kf1 = tr_at(kB, (32 * ks * KP + 16) * 2, KP * 2);
        bf16x8 vfr[5];
#pragma unroll
        for (int vt = 0; vt < 5; ++vt) vfr[vt] = tr_at(vB, (32 * ks * VP + 16 * vt) * 2, VP * 2);
        __builtin_amdgcn_sched_barrier(0);
#pragma unroll
        for (int vt = 0; vt < 4; ++vt) { Cacc[0][vt] = __builtin_amdgcn_mfma_f32_16x16x32_bf16(vfr[vt], kf0, Cacc[0][vt], 0, 0, 0); Cacc[1][vt] = __builtin_amdgcn_mfma_f32_16x16x32_bf16(vfr[vt], kf1, Cacc[1][vt], 0, 0, 0); }
        nacc[0] = __builtin_amdgcn_mfma_f32_16x16x32_bf16(vfr[4], kf0, nacc[0], 0, 0, 0); nacc[1] = __builtin_amdgcn_mfma_f32_16x16x32_bf16(vfr[4], kf1, nacc[1], 0, 0, 0);
      }
    }
    if (wid == 0 && more) { float mn; ML_SCAN(lds + ML_T + ((c + 1) & 1) * ML_TSZ, mw0, mn); mw0 = mn; }
    m_final = T[256 + 127] + M_last;
    __syncthreads();
  }
#undef ML_LOAD_Q
#undef ML_LOAD_KV
#undef ML_SCAN
#undef TOKC
  if (!smp) {
    float* oC = p.out + OUTF_C + (size_t)sidx * 65536;
#pragma unroll
    for (int dt = 0; dt < 2; ++dt) {
#pragma unroll
      for (int vt = 0; vt < 4; ++vt) *(f32x4*)(oC + (size_t)((2 * wid + dt) * 16 + l15) * 256 + sl * 64 + 16 * vt + 4 * g) = Cacc[dt][vt];
      if (sl == 0 && g == 0) p.out[OUTF_N + (size_t)sidx * 256 + (2 * wid + dt) * 16 + l15] = nacc[dt][0]; }
    if (sl == 0 && tid == 0) p.out[OUTF_M + sidx] = m_final;
  }
}

__device__ void combine_rows(const Params& p) {
  const int tid0 = opaque_tid(); const int wid = tid0 >> 6, lane = tid0 & 63;
  bf16_t* H = (bf16_t*)((unsigned char*)p.out + OUT_H); const bf16_t* HB = (const bf16_t*)((unsigned char*)p.out + OUT_HB); const float* nw = p.in[22];
  for (int unit = blockIdx.x; unit < 3072; unit += gridDim.x) {
    const int row = unit * 8 + wid; bf16_t* hp = H + (size_t)row * 1024 + 16 * lane; const bf16_t* bp = HB + (size_t)row * 1024 + 16 * lane;
    float v[16]; float ss = 0.f;
#pragma unroll
    for (int i = 0; i < 2; ++i) { const u32x4 a = *(const u32x4*)(hp + 8 * i), bq = *(const u32x4*)(bp + 8 * i);
      v[8 * i + 0] = bflo(a.x) + bflo(bq.x); v[8 * i + 1] = bfhi(a.x) + bfhi(bq.x); v[8 * i + 2] = bflo(a.y) + bflo(bq.y); v[8 * i + 3] = bfhi(a.y) + bfhi(bq.y);
      v[8 * i + 4] = bflo(a.z) + bflo(bq.z); v[8 * i + 5] = bfhi(a.z) + bfhi(bq.z); v[8 * i + 6] = bflo(a.w) + bflo(bq.w); v[8 * i + 7] = bfhi(a.w) + bfhi(bq.w); }
#pragma unroll
    for (int e = 0; e < 16; ++e) ss += v[e] * v[e];
    ss += __shfl_xor(ss, 1); ss += __shfl_xor(ss, 2); ss += __shfl_xor(ss, 4); ss += __shfl_xor(ss, 8);
    const float r = rsqrtf(ss * (1.0f / 256.0f) + 1e-6f);
#pragma unroll
    for (int i = 0; i < 2; ++i) { const f32x4 w0 = *(const f32x4*)(nw + 16 * lane + 8 * i), w1 = *(const f32x4*)(nw + 16 * lane + 8 * i + 4); u32x4 o;
      o.x = pack2(v[8 * i] * r * w0[0], v[8 * i + 1] * r * w0[1]); o.y = pack2(v[8 * i + 2] * r * w0[2], v[8 * i + 3] * r * w0[3]);
      o.z = pack2(v[8 * i + 4] * r * w1[0], v[8 * i + 5] * r * w1[1]); o.w = pack2(v[8 * i + 6] * r * w1[2], v[8 * i + 7] * r * w1[3]);
      *(u32x4*)(hp + 8 * i) = o; }
  }
}

constexpr int HY_WAVE = 18816, HY_HR = 0, HY_ZA = 8576, HY_ZB = 8576 + 5120;
__device__ void hyena_item(const Params& p, LP lds, int item) {
  const int tid = opaque_tid(), wid = __builtin_amdgcn_readfirstlane(tid >> 6), lane = tid & 63, n31 = lane & 31, hh = lane >> 5;
  const bool smp = item < 1024; const int it = smp ? item : item - 1024; const int bset = it >> 7, cgp = it & 127; const int c = cgp * 8 + wid;
  const int L = smp ? 2048 : 256, lgL = smp ? 11 : 8, nblk = L >> 5, lgnb = lgL - 5, ntok = smp ? 2048 : 1024, ntile = smp ? 2 : 1, dmax = L >> 6;
  const int tok0 = smp ? NCTX + bset * 2048 : bset * 1024;
  LP wl = lds + wid * HY_WAVE; LAS float* hr = (LAS float*)(wl + HY_HR);
  const float* HFp = (const float*)(p.ws + (smp ? OFF_HFS : OFF_HFC));
  const bf16_t* UT = (const bf16_t*)(p.ws + OFF_BIG);
  const float* cw = p.in[12]; const float* cbv = p.in[13]; const float* skp = p.in[21];
  { const int uc = 2048 + c; const float w0 = cw[uc], w1 = cw[3072 + uc], w2 = cw[6144 + uc], cb = cbv[uc]; const bf16_t* src = UT + (size_t)uc * NTOK + tok0;
    u32x4 vv[4]; float pvv[4], nxv[4];
#pragma unroll
    for (int i = 0; i < 4; ++i) { const int base = lane * 8 + 512 * i; vv[i] = (u32x4){0u, 0u, 0u, 0u}; pvv[i] = 0.f; nxv[i] = 0.f;
      if (base < ntok) { vv[i] = *(const u32x4*)(src + base); const int tl = base & (L - 1);
        if (tl != 0) pvv[i] = bf2f(src[base - 1]); if (tl + 8 != L) nxv[i] = bf2f(src[base + 8]); } }
#pragma unroll
    for (int i = 0; i < 4; ++i) { const int base = lane * 8 + 512 * i;
      if (base < ntok) { const u32x4 v = vv[i];
        float u[10]; u[0] = pvv[i]; u[1] = bflo(v.x); u[2] = bfhi(v.x); u[3] = bflo(v.y); u[4] = bfhi(v.y); u[5] = bflo(v.z); u[6] = bfhi(v.z); u[7] = bflo(v.w); u[8] = bfhi(v.w); u[9] = nxv[i];
        float o[8];
#pragma unroll
        for (int e = 0; e < 8; ++e) o[e] = cb + w0 * u[e] + w1 * u[e + 1] + w2 * u[e + 2];
        u32x4 w; w.x = pack2(o[0], o[1]); w.y = pack2(o[2], o[3]); w.z = pack2(o[4], o[5]); w.w = pack2(o[6], o[7]);
        *(LAS u32x4*)(wl + HY_ZA + ((base >> 5) * 40 + (base & 31)) * 2) = w; } } }
  const int HRP = L + 96;
  f32x4 fvN[8];
#define HY_FLOAD(o) do { const float* src_ = HFp + (size_t)((o) * 1024 + c) * L; \
    _Pragma("unroll") for (int i = 0; i < 8; ++i) { const int q = lane + 64 * i; fvN[i] = (4 * q < L) ? *(const f32x4*)(src_ + 4 * q) : (f32x4){0.f, 0.f, 0.f, 0.f}; } } while (0)
  HY_FLOAD(0);
  for (int ord = 0; ord < 2; ++ord) {
    { float sa = 0.f;
      f32x4 fv[8];
#pragma unroll
      for (int i = 0; i < 8; ++i) fv[i] = fvN[i];
#pragma unroll
      for (int i = 0; i < 8; ++i) sa += (fabsf(fv[i][0]) + fabsf(fv[i][1])) + (fabsf(fv[i][2]) + fabsf(fv[i][3]));
      sa = wave_sum(sa); const float inv = 1.0f / (sa + 1e-6f);
      asm volatile("s_waitcnt lgkmcnt(0)" ::: "memory");
      LAS bf16_t* E = (LAS bf16_t*)hr; LAS bf16_t* O = E + HRP;
#pragma unroll
      for (int i = 0; i < 8; ++i) { const int q = lane + 64 * i;
        if (4 * q < L) {
#pragma unroll
          for (int e = 0; e < 4; ++e) { const int yy = L - 1 - (4 * q + e); const bf16_t v = f2bf(fv[i][e] * inv); E[32 + yy] = v; O[31 + yy] = v; } } }
      if (lane < 32) { E[lane] = 0; E[32 + L + lane] = 0; O[31 + L + lane] = 0; if (lane < 31) O[lane] = 0; }
      if (lane < 33) O[HRP - 33 + lane] = 0;
      asm volatile("s_waitcnt lgkmcnt(0)" ::: "memory"); }
    if (ord == 0) HY_FLOAD(1);
    LP zin = wl + (ord == 0 ? HY_ZA : HY_ZB); LP zout = wl + (ord == 0 ? HY_ZB : HY_ZA);
    const int gc = ord * 1024 + c; const float w0 = cw[gc], w1 = cw[3072 + gc], w2 = cw[6144 + gc], cb = cbv[gc], sk = skp[ord * 1024 + c];
    const bf16_t* gsrc = UT + (size_t)gc * NTOK + tok0;
    u32x4 gv[4]; unsigned gpv[4], gnx[4];
#pragma unroll
    for (int i = 0; i < 4; ++i) { const int base = lane * 8 + 512 * i; gv[i] = (u32x4){0u, 0u, 0u, 0u}; gpv[i] = 0u; gnx[i] = 0u;
      if (base < ntok) { gv[i] = *(const u32x4*)(gsrc + base); const int tl = base & (L - 1);
        if (tl != 0) gpv[i] = gsrc[base - 1]; if (tl + 8 != L) gnx[i] = gsrc[base + 8]; } }
    f32x16 accs[2];
#pragma unroll
    for (int o2 = 0; o2 < 2; ++o2)
#pragma unroll
      for (int r = 0; r < 16; ++r) accs[o2][r] = 0.f;
    LP fb = wl + HY_HR + ((n31 & 1) ? 0 : (HRP * 2 - 2)) + 2 * ((L >> 1) - 1 - n31 + 8 * hh + 32);
    int cbl[2], ca[2];
#pragma unroll
    for (int ot = 0; ot < 2; ++ot) { const int col = 32 * ot + n31; cbl[ot] = (col >> lgnb) << lgnb; ca[ot] = col & (nblk - 1); }
    const bool two = (ntile == 2);
    {
      LP zero = wl + HY_HR + 16 * hh;
      LP ap = fb + 64 * dmax;
      int bbr0 = ca[0] + dmax, bbr1 = ca[1] + dmax;
      LP bp0 = zin + ((cbl[0] + bbr0) * 40 + 8 * hh) * 2, bp1 = zin + ((cbl[1] + bbr1) * 40 + 8 * hh) * 2;
      for (int d = -dmax; d <= dmax; ++d) {
        u32x4 w0v, w1v;
        w0v.x = *(const LAS unsigned*)(ap); w0v.y = *(const LAS unsigned*)(ap + 4); w0v.z = *(const LAS unsigned*)(ap + 8); w0v.w = *(const LAS unsigned*)(ap + 12);
        w1v.x = *(const LAS unsigned*)(ap + 32); w1v.y = *(const LAS unsigned*)(ap + 36); w1v.z = *(const LAS unsigned*)(ap + 40); w1v.w = *(const LAS unsigned*)(ap + 44);
        const bf16x8 af0 = __builtin_bit_cast(bf16x8, w0v), af1 = __builtin_bit_cast(bf16x8, w1v);
        LP q0 = ((unsigned)bbr0 < (unsigned)nblk) ? bp0 : zero;
        LP q1 = (two && ((unsigned)bbr1 < (unsigned)nblk)) ? bp1 : zero;
        const bf16x8 b00 = *(const LAS bf16x8*)q0, b01 = *(const LAS bf16x8*)(q0 + 32);
        const bf16x8 b10 = *(const LAS bf16x8*)q1, b11 = *(const LAS bf16x8*)(q1 + 32);
        __builtin_amdgcn_sched_barrier(0);
        accs[0] = __builtin_amdgcn_mfma_f32_32x32x16_bf16(af0, b00, accs[0], 0, 0, 0);
        if (two) accs[1] = __builtin_amdgcn_mfma_f32_32x32x16_bf16(af0, b10, accs[1], 0, 0, 0);
        accs[0] = __builtin_amdgcn_mfma_f32_32x32x16_bf16(af1, b01, accs[0], 0, 0, 0);
        if (two) accs[1] = __builtin_amdgcn_mfma_f32_32x32x16_bf16(af1, b11, accs[1], 0, 0, 0);
        ap -= 64; bbr0 -= 1; bbr1 -= 1; bp0 -= 80; bp1 -= 80;
      }
    }
#pragma unroll
    for (int ot = 0; ot < 2; ++ot) {
      if (ot >= ntile) continue;
      const f32x16 acc = accs[ot];
#pragma unroll
      for (int rg = 0; rg < 4; ++rg) {
        const int zo = (((cbl[ot] + ca[ot]) * 40) + 8 * rg + 4 * hh) * 2;
        const u32x2 zv = *(const LAS u32x2*)(zin + zo);
        u32x2 w; w.x = pack2(acc[4 * rg] + sk * bflo(zv.x), acc[4 * rg + 1] + sk * bfhi(zv.x)); w.y = pack2(acc[4 * rg + 2] + sk * bflo(zv.y), acc[4 * rg + 3] + sk * bfhi(zv.y));
        *(LAS u32x2*)(zout + zo) = w;
      }
    }
    asm volatile("s_waitcnt lgkmcnt(0)" ::: "memory");
#pragma unroll
    for (int i = 0; i < 4; ++i) { const int base = lane * 8 + 512 * i;
      if (base < ntok) { const u32x4 v = gv[i];
        float u[10]; u[0] = bf2f(gpv[i]); u[1] = bflo(v.x); u[2] = bfhi(v.x); u[3] = bflo(v.y); u[4] = bfhi(v.y); u[5] = bflo(v.z); u[6] = bfhi(v.z); u[7] = bflo(v.w); u[8] = bfhi(v.w); u[9] = bf2f(gnx[i]);
        LP zp = zout + ((base >> 5) * 40 + (base & 31)) * 2; const u32x4 t = *(const LAS u32x4*)zp;
        float tv[8]; tv[0] = bflo(t.x); tv[1] = bfhi(t.x); tv[2] = bflo(t.y); tv[3] = bfhi(t.y); tv[4] = bflo(t.z); tv[5] = bfhi(t.z); tv[6] = bflo(t.w); tv[7] = bfhi(t.w);
        float o[8];
#pragma unroll
        for (int e = 0; e < 8; ++e) o[e] = (cb + w0 * u[e] + w1 * u[e + 1] + w2 * u[e + 2]) * tv[e];
        u32x4 w; w.x = pack2(o[0], o[1]); w.y = pack2(o[2], o[3]); w.z = pack2(o[4], o[5]); w.w = pack2(o[6], o[7]);
        *(LAS u32x4*)zp = w; } }
    asm volatile("s_waitcnt lgkmcnt(0)" ::: "memory");
  }
  __syncthreads();
  { bf16_t* YH = (bf16_t*)((unsigned char*)p.out + OUT_HB);
    for (int tl = tid; tl < ntok; tl += 512) {
      const int bl = tl >> lgL, tloc = tl & (L - 1); const int zo = ((((bl << lgnb) + (tloc >> 5)) * 40) + (tloc & 31)) * 2;
      unsigned short e[8];
#pragma unroll
      for (int w = 0; w < 8; ++w) e[w] = *(const LAS unsigned short*)(lds + w * HY_WAVE + HY_ZA + zo);
      u32x4 o; o.x = e[0] | ((unsigned)e[1] << 16); o.y = e[2] | ((unsigned)e[3] << 16); o.z = e[4] | ((unsigned)e[5] << 16); o.w = e[6] | ((unsigned)e[7] << 16);
      *(u32x4*)(YH + (size_t)(tok0 + tl) * 1024 + cgp * 8) = o; } }
  __syncthreads();
}

__device__ void final_norm(const Params& p) {
  const int tid0 = opaque_tid(); const int wid = tid0 >> 6, lane = tid0 & 63; const float* fw = p.in[31]; const float* ssq = (const float*)(p.ws + OFF_SSQ2);
  for (int unit = blockIdx.x; unit < 3072; unit += gridDim.x) {
    const int row = unit * 8 + wid; float* xr = p.out + (size_t)row * 1024; const float* sp = ssq + (size_t)row * 16;
    const f32x4 st = *(const f32x4*)sp + *(const f32x4*)(sp + 4) + *(const f32x4*)(sp + 8) + *(const f32x4*)(sp + 12);
    const float rstd = rsqrtf((st[0] + st[1] + st[2] + st[3]) * (1.0f / 1024.0f) + 1e-6f);
#pragma unroll
    for (int i = 0; i < 4; ++i) { const int col = 4 * lane + 256 * i; const f32x4 v = *(const f32x4*)(xr + col) * rstd * *(const f32x4*)(fw + col); *(f32x4*)(xr + col) = v; }
  }
}

__global__ void __launch_bounds__(512, 2) __attribute__((flatten)) mega(Params p) {
  extern __shared__ __attribute__((aligned(16))) unsigned char shm[];
  LP lds = (LP)shm;
  cg::grid_group grid = cg::this_grid();
  volatile LAS unsigned* xst = (volatile LAS unsigned*)(lds + LDS_BYTES - 16);
  if (threadIdx.x == 0) { xst[0] = 0u; xst[1] = 0u; }
  __syncthreads();
  const XcdBarrier xb = xcd_barrier_post((unsigned*)(p.ws + OFF_BAR), xst);
  unsigned char* ws = p.ws;
  const bf16_t* WT = (const bf16_t*)(ws + OFF_WT); const bf16_t* HN = (const bf16_t*)(ws + OFF_HN); bf16_t* BIG = (bf16_t*)(ws + OFF_BIG);
  bf16_t* Hb = (bf16_t*)((unsigned char*)p.out + OUT_H); bf16_t* YH = (bf16_t*)((unsigned char*)p.out + OUT_HB);
  const float* mod = (const float*)(ws + OFF_MOD);
  phase0(p, lds);
  if (gridDim.y == 7u) grid.sync();
  xcd_barrier(xb);
  phase1(p, lds);
  weight_tiles(p, lds);
  xcd_barrier(xb);
  { EpiQKV e; e.O = BIG; e.bias = p.in[11]; run_gemm(lds, HN, WT, NTOK, 3072, 1024, e); }
  xcd_barrier(xb);
  for (int item = blockIdx.x; item < 1280; item += gridDim.x) mlstm_item(p, lds, item);
  xcd_barrier(xb);
  combine_rows(p);
  { EpiUT e; e.O = BIG; e.bias = p.in[11] + 4112; run_gemm(lds, WT + (size_t)3072 * 1024, HN, 3072, NTOK, 1024, e); }
  xcd_barrier(xb);
  for (int item = blockIdx.x; item < 2048; item += gridDim.x) hyena_item(p, lds, item);
  xcd_barrier(xb);
  { EpiGates e; e.H = Hb; e.G = BIG; e.b_in = p.in[11]; run_gemm(lds, HN, WT + (size_t)6144 * 1024, NTOK, 3072, 1024, e); }
  xcd_barrier(xb);
  bf16_t* T = BIG + (size_t)NTOK * 2048;
  { EpiMerge<0> e; e.T = T; e.G = BIG; run_gemm(lds, Hb, (const bf16_t*)(ws + OFF_WBM), NTOK, 1024, 1024, e); }
  { EpiMerge<1> e; e.T = T; e.G = BIG; run_gemm(lds, YH, (const bf16_t*)(ws + OFF_WBH), NTOK, 1024, 1024, e); }
  xcd_barrier(xb);
  { EpiOut e; e.xp = p.in[0]; e.xs = p.in[1]; e.per = (const float*)(ws + OFF_PER); e.pec = (const float*)(ws + OFF_PEC); e.mod = mod; e.n2w = p.in[26];
    e.X1 = p.out; e.A2 = (bf16_t*)(ws + OFF_HN); e.ssq = (float*)(ws + OFF_SSQ1); run_gemm(lds, T, (const bf16_t*)(ws + OFF_WOUT), NTOK, 1024, 1024, e); }
  xcd_barrier(xb);
#define FFN_HALF(ROW0) do { \
    { EpiFF1 e; e.row0 = (ROW0); e.ssq = (const float*)(p.ws + OFF_SSQ1); e.c1 = (const float*)(p.ws + OFF_C1); e.Hd = (bf16_t*)(p.ws + OFF_BIG); \
      run_gemm(lds, (const bf16_t*)(p.ws + OFF_HN) + (size_t)(ROW0) * 1024, (const bf16_t*)(p.ws + OFF_W1T), 12288, 4096, 1024, e); } \
    xcd_barrier(xb); \
    { EpiFF2 e; e.row0 = (ROW0); e.mod = (const float*)(p.ws + OFF_MOD); e.b2 = p.in[30]; e.X = p.out; e.ssq = (float*)(p.ws + OFF_SSQ2); \
      run_gemm(lds, (const bf16_t*)(p.ws + OFF_BIG), (const bf16_t*)(p.ws + OFF_W2T), 12288, 1024, 4096, e); } \
    xcd_barrier(xb); } while (0)
  FFN_HALF(0);
  FFN_HALF(12288);
#undef FFN_HALF
  final_norm(p);
}

extern "C" void kernel_launch(void* const* d_in, const int* in_sizes, int n_in, void* d_out, int out_size, void* d_ws, size_t ws_size, hipStream_t stream) {
  static int grid_blocks = 0;
  if (!grid_blocks) {
    int dev = 0, cus = 0, per_cu = 0;
    hipGetDevice(&dev);
    hipDeviceGetAttribute(&cus, hipDeviceAttributeMultiprocessorCount, dev);
    hipFuncSetAttribute((const void*)mega, hipFuncAttributeMaxDynamicSharedMemorySize, LDS_BYTES);
    hipOccupancyMaxActiveBlocksPerMultiprocessor(&per_cu, (const void*)mega, 512, LDS_BYTES);
    if (per_cu < 1) { fprintf(stderr, "kernel_launch: occupancy query reports %d blocks per CU\n", per_cu); grid_blocks = -1; }
    else grid_blocks = cus;
    if (n_in != 32 || ws_size < WS_END) { fprintf(stderr, "kernel_launch: unexpected n_in %d / ws_size %zu (need %zu)\n", n_in, ws_size, (size_t)WS_END); grid_blocks = -1; }
  }
  if (grid_blocks < 0) return;
  hipMemsetAsync((unsigned char*)d_ws + OFF_BAR, 0, 3456 * 4, stream);
  Params p{};
  for (int i = 0; i < 32; ++i) p.in[i] = (const float*)d_in[i];
  p.out = (float*)d_out; p.ws = (unsigned char*)d_ws;
  void* args[] = {&p};
  hipError_t e = hipLaunchCooperativeKernel((void*)mega, dim3(grid_blocks), dim3(512), args, LDS_BYTES, stream);
  if (e != hipSuccess) fprintf(stderr, "cooperative launch failed: %s (grid %d)\n", hipGetErrorString(e), grid_blocks);
}
```

```cpp
#include <hip/hip_runtime.h>
#include <hip/hip_cooperative_groups.h>
#include <cstdio>
#include <cstdint>
namespace cg = cooperative_groups;

#define LAS __attribute__((address_space(3)))
typedef LAS unsigned char* LP;
typedef unsigned short bf16_t;
typedef short bf16x8 __attribute__((ext_vector_type(8)));
typedef short s16x4 __attribute__((ext_vector_type(4)));
typedef float f32x4 __attribute__((ext_vector_type(4)));
typedef float f32x16 __attribute__((ext_vector_type(16)));
typedef unsigned u32x4 __attribute__((ext_vector_type(4)));
typedef unsigned u32x2 __attribute__((ext_vector_type(2)));

constexpr int DM = 1024, NTOK = 24576, NCTX = 8192, SEQC = 256, SEQS = 2048, INC = 9232;
constexpr int LDS_BYTES = 160 * 1024;
constexpr size_t OFF_WT = 0;
constexpr size_t OFF_WBM = 18874368, OFF_WBH = 20971520, OFF_WOUT = 23068672, OFF_W1T = 25165824, OFF_W2T = 33554432;
constexpr size_t OFF_HN = 41943040;
constexpr size_t OFF_BIG = 92274688;
constexpr size_t OFF_SM = 243269632;
constexpr size_t OFF_MOD = OFF_SM;
constexpr size_t OFF_C1 = OFF_MOD + 221184;
constexpr size_t OFF_H2S = OFF_C1 + 147456;
constexpr size_t OFF_H2C = OFF_H2S + 524288;
constexpr size_t OFF_PER = OFF_H2C + 65536;
constexpr size_t OFF_PEC = OFF_PER + 65536;
constexpr size_t OFF_GT = OFF_PEC + 131072;
constexpr size_t OFF_SSQ1 = OFF_GT + 1572864;
constexpr size_t OFF_SSQ2 = OFF_SSQ1 + 1572864;
constexpr size_t OFF_HFS = OFF_SSQ2 + 1572864;
constexpr size_t OFF_HFC = OFF_HFS + 16777216;
constexpr size_t OFF_BAR = OFF_HFC + 2097152;
constexpr size_t WS_END = OFF_BAR + 3456 * 4;
constexpr size_t OUT_H = 0, OUT_HB = 50331648;
constexpr size_t OUTF_C = 25165824, OUTF_N = 41943040, OUTF_M = 42008576;

struct Params { const float* in[32]; float* out; unsigned char* ws; };

__device__ __forceinline__ bf16_t f2bf(float f) { unsigned u = __float_as_uint(f); u += 0x7FFFu + ((u >> 16) & 1u); return (bf16_t)(u >> 16); }
__device__ __forceinline__ float bf2f(unsigned b) { return __uint_as_float(b << 16); }
__device__ __forceinline__ unsigned pack2(float lo, float hi) { return (unsigned)f2bf(lo) | ((unsigned)f2bf(hi) << 16); }
__device__ __forceinline__ float bflo(unsigned w) { return __uint_as_float(w << 16); }
__device__ __forceinline__ float bfhi(unsigned w) { return __uint_as_float(w & 0xffff0000u); }
__device__ __forceinline__ float sigmoidf_(float x) { return 1.0f / (1.0f + __expf(-x)); }
__device__ __forceinline__ int opaque_tid() { int t = threadIdx.x; asm volatile("" : "+v"(t)); return t; }
__device__ __forceinline__ float wave_sum(float v) {
#pragma unroll
  for (int o = 32; o >= 1; o >>= 1) v += __shfl_xor(v, o);
  return v;
}


#define XB_TMO      128
#define XB_XCNT(j)  (256  + 64 * (j))
#define XB_XSUB(j)  (1280 + 64 * (j))
#define XB_XGEN(j)  (2304 + 64 * (j))
#define XB_TOP      3328
#define XB_TOPGEN   3392
#define XCD_BAR_WORDS 3456
#define XB_SPIN_CAP (1u << 18)
__device__ __forceinline__ unsigned xb_ld(unsigned* p)              { return __hip_atomic_load(p, __ATOMIC_RELAXED, __HIP_MEMORY_SCOPE_AGENT); }
__device__ __forceinline__ unsigned xb_add(unsigned* p, unsigned v) { return __hip_atomic_fetch_add(p, v, __ATOMIC_RELAXED, __HIP_MEMORY_SCOPE_AGENT); }
__device__ __forceinline__ unsigned xb_xcc_id() { return (unsigned)__builtin_amdgcn_s_getreg((3 << 11) | 20) & 0xFu; }
#define XB_SPIN(cond, bar) do { unsigned _sp = 0; while (cond) { __builtin_amdgcn_s_sleep(1); \
    if ((++_sp & 255u) == 0u) { if (xb_ld(&(bar)[XB_TMO])) break; if (_sp > XB_SPIN_CAP) { atomicAdd(&(bar)[XB_TMO], 1u); break; } } } } while (0)
struct XcdBarrier { unsigned* bar; unsigned x; volatile LAS unsigned* st; };
__device__ __forceinline__ XcdBarrier xcd_barrier_post(unsigned* bar, volatile LAS unsigned* st) {
  XcdBarrier b; b.bar = bar; b.x = xb_xcc_id(); b.st = st;
  if (threadIdx.x == 0) (void)xb_add(&bar[XB_XCNT(b.x)], 1u);
  return b;
}
__device__ __forceinline__ void xcd_barrier_complete(unsigned* bar, unsigned x, unsigned& nloc, unsigned& nx) {
  const unsigned G = gridDim.x * gridDim.y * gridDim.z;
  unsigned sum, cnt, mine, sp = 0u;
  for (;;) {
    sum = 0u; cnt = 0u; mine = 0u;
#pragma unroll
    for (unsigned j = 0; j < 16; ++j) { const unsigned c = xb_ld(&bar[XB_XCNT(j)]); sum += c; cnt += (c > 0u) ? 1u : 0u; mine = (j == x) ? c : mine; }
    if (sum == G) break;
    __builtin_amdgcn_s_sleep(1);
    if ((++sp & 255u) == 0u) { if (xb_ld(&bar[XB_TMO])) break; if (sp > XB_SPIN_CAP) { atomicAdd(&bar[XB_TMO], 1u); break; } }
  }
  nloc = mine > 0u ? mine : 1u; nx = cnt > 0u ? cnt : 1u;
}
__device__ __forceinline__ void xcd_barrier(const XcdBarrier& b) {
  asm volatile("s_waitcnt vmcnt(0)" ::: "memory");
  __syncthreads();
  if (threadIdx.x == 0) {
    unsigned* bar = b.bar;
    __builtin_amdgcn_s_waitcnt(0);
    unsigned nloc = b.st[0], nx = b.st[1];
    if (nloc == 0u) { xcd_barrier_complete(bar, b.x, nloc, nx); b.st[0] = nloc; b.st[1] = nx; }
    const unsigned old = xb_add(&bar[XB_XSUB(b.x)], 1u);
    const unsigned gen = old / nloc;
    if (old + 1u == (gen + 1u) * nloc) {
      __builtin_amdgcn_fence(__ATOMIC_RELEASE, "agent");
      asm volatile("s_waitcnt vmcnt(0)" ::: "memory");
      const unsigned og = xb_add(&bar[XB_TOP], 1u);
      const unsigned tg = og / nx;
      if (og + 1u == (tg + 1u) * nx) xb_add(&bar[XB_TOPGEN], 1u);
      else XB_SPIN(xb_ld(&bar[XB_TOPGEN]) == tg, bar);
      __builtin_amdgcn_fence(__ATOMIC_ACQUIRE, "agent");
      xb_add(&bar[XB_XGEN(b.x)], 1u);
      asm volatile("s_waitcnt vmcnt(0)" ::: "memory");
    } else {
      XB_SPIN(xb_ld(&bar[XB_XGEN(b.x)]) == gen, bar);
      __builtin_amdgcn_fence(__ATOMIC_ACQUIRE, "agent");
      asm volatile("s_waitcnt vmcnt(0)" ::: "memory");
    }
  }
  __syncthreads();
}

namespace pg8 {
constexpr int BM = 256, BK = 64, HALF = 128, HTB = HALF * BK * 2, STAGE_BYTES = 8 * HTB, NXCD = 8, WGM = 8;
__host__ __device__ __forceinline__ int lds_byte(int r, int c) { const int st = (r >> 4) * 2 + (c >> 5), rr = r & 15, cc = c & 31, ob = rr * 64 + cc * 2; return st * 1024 + (ob ^ (((ob >> 9) & 1) << 5)); }
__host__ __device__ __forceinline__ void stage_rc(int b, int& R, int& C) { const int st = b / 1024, sb = b % 1024, swz = sb ^ (((sb >> 9) & 1) << 5); R = (st >> 1) * 16 + swz / 64; C = (st & 1) * 32 + (swz % 64) / 2; }
__host__ __device__ __forceinline__ int perm32(int rho) { const int n = rho >> 4, i = rho & 15; return 8 * (i >> 2) + 4 * n + (i & 3); }
struct Unit { int pm, pn; };
struct Gemm { const bf16_t* A; const bf16_t* Bt; int M, N, K; };
struct StaticOrder {
  int nM, nN, nwg, G, c;
  __device__ void init(int M, int N, int G_, int c_) { nM = M / BM; nN = N / BM; nwg = nM * nN; G = G_; c = c_; }
  __device__ bool next(int i, Unit& u) const {
    const long L = (long)i * G + c; if (L >= nwg) return false;
    int wgid = (int)L; { const int q = nwg / NXCD, r = nwg % NXCD, xcd = wgid % NXCD, off = wgid / NXCD; wgid = (xcd < r ? xcd * (q + 1) : r * (q + 1) + (xcd - r) * q) + off; }
    const int nig = WGM * nN, gid = wgid / nig, fm = gid * WGM, gsz = (nM - fm) < WGM ? (nM - fm) : WGM;
    u.pm = fm + ((wgid % nig) % gsz); u.pn = (wgid % nig) / gsz; return true;
  }
};

template <class Epi>
__device__ __forceinline__ void gemm_phase(LP lds, const Gemm g, const StaticOrder& S, const Epi& E) {
  int tid_ = threadIdx.x; asm volatile("" : "+v"(tid_));
  const int tid = tid_, wid = __builtin_amdgcn_readfirstlane(tid >> 6), lane = tid & 63, wr = wid >> 2, wc = wid & 3, fr = lane & 15, fq = lane >> 4;
  const int K = g.K, nt = K / BK;
  unsigned voffA[2], voffB[2];
#pragma unroll
  for (int i = 0; i < 2; ++i) { int R, C; stage_rc(tid * 16 + i * 8192, R, C); const int Rb = (R & ~31) + perm32(R & 31); voffA[i] = (unsigned)(R * K + C) * 2u; voffB[i] = (unsigned)(Rb * K + C) * 2u; }
  const size_t kstep = (size_t)(BK * 2);
  const size_t hstep = (size_t)HALF * K * 2;
  const size_t tstep = 2 * hstep;
  const unsigned ldsw = (unsigned)wid * 1024u;
  const int aoff = lds_byte(wr * 64 + fr, fq * 8), boff = lds_byte(wc * 32 + fr, fq * 8);
#define PG8_SA(b, h) (((b) * 2 + (h)) * HTB)
#define PG8_SB(b, h) ((4 + (b) * 2 + (h)) * HTB)
#define PG8_STAGE(bufoff, gbase, voff) do { _Pragma("unroll") for (int _i = 0; _i < 2; ++_i) \
    __builtin_amdgcn_global_load_lds((const unsigned*)((const char*)(gbase) + (voff)[_i]), (LAS unsigned*)(lds + (bufoff) + ldsw + _i * 8192), 16, 0, 0); } while (0)
#define PG8_LDA(dst, b, h) do { _Pragma("unroll") for (int m = 0; m < 4; ++m) _Pragma("unroll") for (int k = 0; k < 2; ++k) dst[m][k] = *(const LAS bf16x8*)(lds + PG8_SA(b, h) + aoff + m * 2048 + k * 1024); } while (0)
#define PG8_LDB(dst, b, h) do { _Pragma("unroll") for (int n = 0; n < 2; ++n) _Pragma("unroll") for (int k = 0; k < 2; ++k) dst[n][k] = *(const LAS bf16x8*)(lds + PG8_SB(b, h) + boff + n * 2048 + k * 1024); } while (0)
#define PG8_MMA(ai, bj, At, Bt) do { __builtin_amdgcn_s_setprio(1); _Pragma("unroll") for (int m = 0; m < 4; ++m) _Pragma("unroll") for (int n = 0; n < 2; ++n) _Pragma("unroll") for (int k = 0; k < 2; ++k) \
    acc[ai][bj][m][n] = __builtin_amdgcn_mfma_f32_16x16x32_bf16(Bt[n][k], At[m][k], acc[ai][bj][m][n], 0, 0, 0); __builtin_amdgcn_s_setprio(0); } while (0)
#define PG8_WAIT_V(n) asm volatile("s_waitcnt vmcnt(" #n ")" ::: "memory")
#define PG8_WAIT_L(n) asm volatile("s_waitcnt lgkmcnt(" #n ")" ::: "memory")
#define PG8_BAR __builtin_amdgcn_s_barrier()
#define PG8_SCHED __builtin_amdgcn_sched_barrier(0)
  Unit cur, nxt; int ui = 0;
  if (!S.next(0, cur)) return;
  f32x4 acc[2][2][4][2];
#pragma unroll
  for (int a = 0; a < 2; ++a)
#pragma unroll
    for (int b = 0; b < 2; ++b)
#pragma unroll
      for (int m = 0; m < 4; ++m)
#pragma unroll
        for (int n = 0; n < 2; ++n) acc[a][b][m][n] = (f32x4){0.f, 0.f, 0.f, 0.f};
  bf16x8 At[4][2], B0[2][2], B1[2][2];
  const char* cA = (const char*)g.A + (size_t)cur.pm * tstep; const char* cB = (const char*)g.Bt + (size_t)cur.pn * tstep;
  PG8_STAGE(PG8_SB(0, 0), cB, voffB); PG8_STAGE(PG8_SA(0, 0), cA, voffA); PG8_STAGE(PG8_SB(0, 1), cB + hstep, voffB); PG8_STAGE(PG8_SA(0, 1), cA + hstep, voffA);
  if (wr == 1) PG8_BAR;
  PG8_WAIT_V(4); PG8_BAR;
  PG8_STAGE(PG8_SB(1, 0), cB + kstep, voffB); PG8_STAGE(PG8_SA(1, 0), cA + kstep, voffA); PG8_STAGE(PG8_SB(1, 1), cB + hstep + kstep, voffB);
  PG8_WAIT_V(6); PG8_BAR;
  for (;;) {
    const bool has_next = S.next(ui + 1, nxt);
    const char* nA = has_next ? (const char*)g.A + (size_t)nxt.pm * tstep : cA; const char* nB = has_next ? (const char*)g.Bt + (size_t)nxt.pn * tstep : cB;
    for (int t = 0; t < nt; t += 2) {
      const bool last = (t == nt - 2);
      const char* a1 = cA + (size_t)(t + 1) * kstep;
      const char* a2 = last ? nA : cA + (size_t)(t + 2) * kstep; const char* b2 = last ? nB : cB + (size_t)(t + 2) * kstep;
      const char* a3 = a2 + kstep; const char* b3 = b2 + kstep;
      PG8_LDB(B0, 0, 0); PG8_SCHED; PG8_LDA(At, 0, 0); PG8_STAGE(PG8_SA(1, 1), a1 + hstep, voffA);
      PG8_WAIT_L(8); PG8_BAR; PG8_WAIT_L(0); PG8_MMA(0, 0, At, B0); PG8_BAR; PG8_SCHED;
      PG8_LDB(B1, 0, 1); PG8_STAGE(PG8_SB(0, 0), b2, voffB);
      PG8_BAR; PG8_WAIT_L(0); PG8_MMA(0, 1, At, B1); PG8_BAR;
      PG8_LDA(At, 0, 1); PG8_STAGE(PG8_SA(0, 0), a2, voffA);
      PG8_BAR; PG8_WAIT_L(0); PG8_MMA(1, 0, At, B0); PG8_BAR; PG8_SCHED;
      PG8_STAGE(PG8_SB(0, 1), b2 + hstep, voffB);
      PG8_WAIT_V(6); PG8_BAR; PG8_MMA(1, 1, At, B1); PG8_BAR;
      PG8_LDB(B0, 1, 0); PG8_SCHED; PG8_LDA(At, 1, 0); PG8_STAGE(PG8_SA(0, 1), a2 + hstep, voffA);
      PG8_WAIT_L(8); PG8_BAR; PG8_WAIT_L(0); PG8_MMA(0, 0, At, B0); PG8_BAR; PG8_SCHED;
      PG8_LDB(B1, 1, 1); PG8_STAGE(PG8_SB(1, 0), b3, voffB);
      PG8_BAR; PG8_WAIT_L(0); PG8_MMA(0, 1, At, B1); PG8_BAR;
      PG8_LDA(At, 1, 1); PG8_STAGE(PG8_SA(1, 0), a3, voffA);
      PG8_BAR; PG8_WAIT_L(0); PG8_MMA(1, 0, At, B0); PG8_BAR; PG8_SCHED;
      PG8_STAGE(PG8_SB(1, 1), b3 + hstep, voffB);
      PG8_WAIT_V(6); PG8_BAR; PG8_MMA(1, 1, At, B1); PG8_BAR;
    }
    { int fr2 = fr, fq2 = fq; asm volatile("" : "+v"(fr2), "+v"(fq2)); E(acc, cur, wr, wc, fr2, fq2); }
    if (!has_next) break;
#pragma unroll
    for (int a = 0; a < 2; ++a)
#pragma unroll
      for (int b = 0; b < 2; ++b)
#pragma unroll
        for (int m = 0; m < 4; ++m)
#pragma unroll
          for (int n = 0; n < 2; ++n) acc[a][b][m][n] = (f32x4){0.f, 0.f, 0.f, 0.f};
    cur = nxt; cA = nA; cB = nB; ++ui;
  }
  PG8_WAIT_V(0);
  if (wr == 0) PG8_BAR;
  PG8_BAR;
#undef PG8_SA
#undef PG8_SB
#undef PG8_STAGE
#undef PG8_LDA
#undef PG8_LDB
#undef PG8_MMA
#undef PG8_WAIT_V
#undef PG8_WAIT_L
#undef PG8_BAR
#undef PG8_SCHED
}
}
using pg8::Unit;
typedef f32x4 AccT[2][2][4][2];

#define EPI_ROW(ai, m) (u.pm * 256 + (ai) * 128 + wr * 64 + (m) * 16 + fr)
#define EPI_COL(bj, n) (u.pn * 256 + (bj) * 128 + wc * 32 + 8 * fq + 4 * (n))
#define EPI_LOOP_ROWS _Pragma("unroll") for (int ai = 0; ai < 2; ++ai) _Pragma("unroll") for (int m = 0; m < 4; ++m)
#define EPI_LOOP_COLS _Pragma("unroll") for (int bj = 0; bj < 2; ++bj) _Pragma("unroll") for (int n = 0; n < 2; ++n)

__device__ __forceinline__ int cond_of_row(int row) { return row < NCTX ? 0 : 1 + ((row - NCTX) >> 11); }

#define EPI_LOOP_BJ _Pragma("unroll") for (int bj = 0; bj < 2; ++bj)
__device__ __forceinline__ u32x4 pack8(const f32x4 v0, const f32x4 v1) { u32x4 w; w.x = pack2(v0[0], v0[1]); w.y = pack2(v0[2], v0[3]); w.z = pack2(v1[0], v1[1]); w.w = pack2(v1[2], v1[3]); return w; }
__device__ __forceinline__ void unpack8(const u32x4 w, f32x4& v0, f32x4& v1) { v0[0] = bflo(w.x); v0[1] = bfhi(w.x); v0[2] = bflo(w.y); v0[3] = bfhi(w.y); v1[0] = bflo(w.z); v1[1] = bfhi(w.z); v1[2] = bflo(w.w); v1[3] = bfhi(w.w); }
struct EpiQKV {
  bf16_t* O; const float* bias;
  __device__ __forceinline__ void operator()(const AccT& acc, const Unit& u, int wr, int wc, int fr, int fq) const {
    const float sc = (u.pn < 4) ? 0.0625f : 1.0f;
    f32x4 bv[2][2];
    EPI_LOOP_COLS { bv[bj][n] = *(const f32x4*)(bias + EPI_COL(bj, n)); }
    EPI_LOOP_ROWS { const int row = EPI_ROW(ai, m);
      EPI_LOOP_BJ { *(u32x4*)(O + (size_t)row * 3072 + EPI_COL(bj, 0)) = pack8((acc[ai][bj][m][0] + bv[bj][0]) * sc, (acc[ai][bj][m][1] + bv[bj][1]) * sc); } }
  }
};
struct EpiUT {
  bf16_t* O; const float* bias;
  __device__ __forceinline__ void operator()(const AccT& acc, const Unit& u, int wr, int wc, int fr, int fq) const {
    EPI_LOOP_ROWS { const int row = EPI_ROW(ai, m); const float bv = bias[row];
      EPI_LOOP_BJ { *(u32x4*)(O + (size_t)row * NTOK + EPI_COL(bj, 0)) = pack8(acc[ai][bj][m][0] + bv, acc[ai][bj][m][1] + bv); } }
  }
};
struct EpiGates {
  bf16_t* H; bf16_t* G; const float* b_in;
  __device__ __forceinline__ void operator()(const AccT& acc, const Unit& u, int wr, int wc, int fr, int fq) const {
    const bool og = u.pn < 4;
    f32x4 bv[2][2];
    EPI_LOOP_COLS { const int col = EPI_COL(bj, n); bv[bj][n] = *(const f32x4*)(b_in + (og ? 3072 + col : 7184 + (col - 1024))); }
    EPI_LOOP_ROWS { const int row = EPI_ROW(ai, m);
      u32x4 hv[2];
      if (og) { EPI_LOOP_BJ { hv[bj] = *(const u32x4*)(H + (size_t)row * 1024 + EPI_COL(bj, 0)); } }
      EPI_LOOP_BJ { const int col = EPI_COL(bj, 0); f32x4 s0, s1; const f32x4 a0 = acc[ai][bj][m][0] + bv[bj][0], a1 = acc[ai][bj][m][1] + bv[bj][1];
#pragma unroll
        for (int e = 0; e < 4; ++e) { s0[e] = sigmoidf_(a0[e]); s1[e] = sigmoidf_(a1[e]); }
        if (og) { f32x4 h0, h1; unpack8(hv[bj], h0, h1); *(u32x4*)(H + (size_t)row * 1024 + col) = pack8(h0 * s0, h1 * s1); }
        else *(u32x4*)(G + (size_t)row * 2048 + (col - 1024)) = pack8(s0, s1); } }
  }
};
template <int SECOND> struct EpiMerge {
  bf16_t* T; const bf16_t* G;
  __device__ __forceinline__ void operator()(const AccT& acc, const Unit& u, int wr, int wc, int fr, int fq) const {
    EPI_LOOP_ROWS { const int row = EPI_ROW(ai, m);
      u32x4 gv[2], tv[2];
      EPI_LOOP_BJ { const int col = EPI_COL(bj, 0); gv[bj] = *(const u32x4*)(G + (size_t)row * 2048 + SECOND * 1024 + col);
        if (SECOND) tv[bj] = *(const u32x4*)(T + (size_t)row * 1024 + col); }
      EPI_LOOP_BJ { const int col = EPI_COL(bj, 0); f32x4 g0, g1; unpack8(gv[bj], g0, g1);
        f32x4 v0 = g0 * acc[ai][bj][m][0], v1 = g1 * acc[ai][bj][m][1];
        if (SECOND) { f32x4 t0, t1; unpack8(tv[bj], t0, t1); v0 += t0; v1 += t1; }
        *(u32x4*)(T + (size_t)row * 1024 + col) = pack8(v0, v1); } }
  }
};
struct EpiOut {
  const float* xp; const float* xs; const float* per; const float* pec; const float* mod; const float* n2w; float* X1; bf16_t* A2; float* ssq;
  __device__ __forceinline__ void operator()(const AccT& acc, const Unit& u, int wr, int wc, int fr, int fq) const {
    const int cb = cond_of_row(u.pm * 256); const float* md = mod + cb * 6144; const bool smp = (u.pm * 256) >= NCTX;
    f32x4 g1v[2][2], k2v[2][2];
    EPI_LOOP_COLS { const int col = EPI_COL(bj, n); g1v[bj][n] = *(const f32x4*)(md + 2048 + col); k2v[bj][n] = *(const f32x4*)(n2w + col) * (*(const f32x4*)(md + 4096 + col) + 1.0f); }
    EPI_LOOP_ROWS { const int row = EPI_ROW(ai, m); float ss = 0.f;
#pragma unroll
      for (int bj = 0; bj < 2; ++bj) {
        f32x4 x0[2];
        if (!smp) {
#pragma unroll
          for (int n = 0; n < 2; ++n) x0[n] = *(const f32x4*)(xp + (size_t)row * 1024 + EPI_COL(bj, n)); }
        else { const int r2 = row - NCTX, t = r2 & 2047; f32x4 pe[2];
#pragma unroll
          for (int n = 0; n < 2; ++n) { const int col = EPI_COL(bj, n); x0[n] = *(const f32x4*)(xs + (size_t)r2 * 1024 + col);
            pe[n] = (col < 512) ? *(const f32x4*)(per + (t >> 6) * 512 + col) : *(const f32x4*)(pec + (t & 63) * 512 + (col - 512)); }
#pragma unroll
          for (int n = 0; n < 2; ++n) x0[n] += pe[n]; }
        f32x4 x1[2];
#pragma unroll
        for (int n = 0; n < 2; ++n) { x1[n] = x0[n] + g1v[bj][n] * acc[ai][bj][m][n]; *(f32x4*)(X1 + (size_t)row * 1024 + EPI_COL(bj, n)) = x1[n];
          ss += x1[n][0] * x1[n][0] + x1[n][1] * x1[n][1] + x1[n][2] * x1[n][2] + x1[n][3] * x1[n][3]; }
        *(u32x4*)(A2 + (size_t)row * 1024 + EPI_COL(bj, 0)) = pack8(x1[0] * k2v[bj][0], x1[1] * k2v[bj][1]); }
      ss += __shfl_xor(ss, 16); ss += __shfl_xor(ss, 32);
      if (fq == 0) ssq[(size_t)row * 16 + u.pn * 4 + wc] = ss; }
  }
};
struct EpiFF1 {
  int row0; const float* ssq; const float* c1; bf16_t* Hd;
  __device__ __forceinline__ void operator()(const AccT& acc, const Unit& u, int wr, int wc, int fr, int fq) const {
    const int cb = cond_of_row(row0 + u.pm * 256); const float* cc = c1 + cb * 4096;
    f32x4 cv[2][2];
    EPI_LOOP_COLS { cv[bj][n] = *(const f32x4*)(cc + EPI_COL(bj, n)); }
    float rs[2][4];
    EPI_LOOP_ROWS { const float* sp = ssq + (size_t)(row0 + EPI_ROW(ai, m)) * 16;
      const f32x4 st = (*(const f32x4*)sp + *(const f32x4*)(sp + 4)) + (*(const f32x4*)(sp + 8) + *(const f32x4*)(sp + 12));
      rs[ai][m] = rsqrtf((st[0] + st[1] + st[2] + st[3]) * (1.0f / 1024.0f) + 1e-6f); }
    EPI_LOOP_ROWS { const int rl = EPI_ROW(ai, m); const float rstd = rs[ai][m];
      EPI_LOOP_BJ { f32x4 v0 = acc[ai][bj][m][0] * rstd + cv[bj][0], v1 = acc[ai][bj][m][1] * rstd + cv[bj][1];
#pragma unroll
        for (int e = 0; e < 4; ++e) { const float r0 = fmaxf(v0[e], 0.f), r1 = fmaxf(v1[e], 0.f); v0[e] = r0 * r0; v1[e] = r1 * r1; }
        *(u32x4*)(Hd + (size_t)rl * 4096 + EPI_COL(bj, 0)) = pack8(v0, v1); } }
  }
};
struct EpiFF2 {
  int row0; const float* mod; const float* b2; float* X; float* ssq;
  __device__ __forceinline__ void operator()(const AccT& acc, const Unit& u, int wr, int wc, int fr, int fq) const {
    const int cb = cond_of_row(row0 + u.pm * 256); const float* md = mod + cb * 6144;
    f32x4 g2v[2][2], bbv[2][2];
    EPI_LOOP_COLS { const int col = EPI_COL(bj, n); g2v[bj][n] = *(const f32x4*)(md + 5120 + col); bbv[bj][n] = *(const f32x4*)(b2 + col); }
    EPI_LOOP_ROWS { const int row = row0 + EPI_ROW(ai, m); float ss = 0.f;
      f32x4 xv[2][2];
      EPI_LOOP_COLS { xv[bj][n] = *(const f32x4*)(X + (size_t)row * 1024 + EPI_COL(bj, n)); }
      EPI_LOOP_COLS { const int col = EPI_COL(bj, n);
        const f32x4 x2 = xv[bj][n] + g2v[bj][n] * (acc[ai][bj][m][n] + bbv[bj][n]); *(f32x4*)(X + (size_t)row * 1024 + col) = x2;
        ss += x2[0] * x2[0] + x2[1] * x2[1] + x2[2] * x2[2] + x2[3] * x2[3]; }
      ss += __shfl_xor(ss, 16); ss += __shfl_xor(ss, 32);
      if (fq == 0) ssq[(size_t)row * 16 + u.pn * 4 + wc] = ss; }
  }
};

template <class Epi> __device__ __forceinline__ void run_gemm(LP lds, const bf16_t* A, const bf16_t* Bt, int M, int N, int K, const Epi& E) {
  pg8::Gemm g; g.A = A; g.Bt = Bt; g.M = M; g.N = N; g.K = K;
  pg8::StaticOrder S; S.init(M, N, (int)gridDim.x, (int)blockIdx.x);
  pg8::gemm_phase<Epi>(lds, g, S, E);
}

__device__ void transpose_tile(const float* __restrict__ src, int ld, int col0, int k0, bf16_t* __restrict__ dst, int K, int drow0, LAS float* tile) {
  const int t = opaque_tid();
  f32x4 v[4];
#pragma unroll
  for (int i = 0; i < 4; ++i) { const int idx = t + 512 * i, kr = idx >> 5, c4 = idx & 31; v[i] = *(const f32x4*)(src + (size_t)(k0 + kr) * ld + col0 + 4 * c4); }
#pragma unroll
  for (int i = 0; i < 4; ++i) { const int idx = t + 512 * i, kr = idx >> 5, c4 = idx & 31; LAS float* tp = tile + kr * 129 + 4 * c4; tp[0] = v[i][0]; tp[1] = v[i][1]; tp[2] = v[i][2]; tp[3] = v[i][3]; }
  __syncthreads();
  const int kb = t & 7;
#pragma unroll
  for (int i = 0; i < 2; ++i) { const int c = (t >> 3) + 64 * i; const LAS float* tp = tile + (kb * 8) * 129 + c; u32x4 o;
    o.x = pack2(tp[0], tp[129]); o.y = pack2(tp[2 * 129], tp[3 * 129]); o.z = pack2(tp[4 * 129], tp[5 * 129]); o.w = pack2(tp[6 * 129], tp[7 * 129]);
    *(u32x4*)(dst + (size_t)(drow0 + c) * K + k0 + kb * 8) = o; }
  __syncthreads();
}
template <int SILU> __device__ void matvec9_unit(const float* v0, const float* v1, int v1stride, const float* __restrict__ W, int ldw, const float* bias, float* out, int ldo, int col0, LAS float* lf) {
  const int t = opaque_tid(), lane = t & 63, wid = t >> 6;
  LAS float* sv = lf; LAS float* red = lf + 9216;
  for (int i = t; i < 9216; i += 512) { const int b = i >> 10, k = i & 1023; float x = (b == 0) ? v0[k] : v1[(size_t)(b - 1) * v1stride + k]; if (SILU) x = x / (1.0f + __expf(-x)); sv[i] = x; }
  __syncthreads();
  const int c4 = t & 7, kl = t >> 3;
  f32x4 w[16];
#pragma unroll
  for (int i = 0; i < 16; ++i) w[i] = *(const f32x4*)(W + (size_t)(kl + 64 * i) * ldw + col0 + 4 * c4);
  f32x4 acc[9];
#pragma unroll
  for (int b = 0; b < 9; ++b) acc[b] = (f32x4){0.f, 0.f, 0.f, 0.f};
#pragma unroll
  for (int i = 0; i < 16; ++i)
#pragma unroll
    for (int b = 0; b < 9; ++b) acc[b] += w[i] * sv[b * 1024 + kl + 64 * i];
#pragma unroll
  for (int b = 0; b < 9; ++b)
#pragma unroll
    for (int e = 0; e < 4; ++e) { float x = acc[b][e]; x += __shfl_xor(x, 8); x += __shfl_xor(x, 16); x += __shfl_xor(x, 32); acc[b][e] = x; }
  if (lane < 8) {
#pragma unroll
    for (int b = 0; b < 9; ++b) *(LAS f32x4*)(red + (wid * 9 + b) * 32 + 4 * lane) = acc[b]; }
  __syncthreads();
  if (t < 288) { const int b = t >> 5, cc = t & 31; float s = bias[col0 + cc];
#pragma unroll
    for (int pz = 0; pz < 8; ++pz) s += red[(pz * 9 + b) * 32 + cc];
    out[(size_t)b * ldo + col0 + cc] = s; }
  __syncthreads();
}

__device__ void phase0(const Params& p, LP lds) {
  unsigned char* ws = p.ws; LAS float* lf = (LAS float*)lds;
  const int tid0 = opaque_tid(); const int wid = tid0 >> 6, lane = tid0 & 63;
  for (int unit = blockIdx.x; unit < 576; unit += gridDim.x) {
    if (unit < 192) {
      matvec9_unit<1>(p.in[6], p.in[5], 1024, p.in[7], 6144, p.in[8], (float*)(ws + OFF_MOD), 6144, unit * 32, lf);
    } else if (unit < 480) {
      const int row = (unit - 192) * 8 + wid; const bool smp = row < 2048; const int L = smp ? 2048 : 256, t = smp ? row : row - 2048;
      const float* w1 = p.in[14]; const float* b1 = p.in[15]; const float* fr1 = p.in[16]; const float* w2 = p.in[17]; const float* b2 = p.in[18]; const float* fr2 = p.in[19];
      float a = b1[lane] + (float)t / (float)(L - 1) * w1[lane];
      const float base = (6.283185307179586f / (float)L) * (float)t;
      float cs = 0.f, sn = 0.f; if (lane < 16) { const float ang = base * (float)(lane + 1); cs = cosf(ang); sn = sinf(ang); }
#pragma unroll
      for (int i = 0; i < 16; ++i) a += __shfl(cs, i) * w1[(1 + i) * 64 + lane] + __shfl(sn, i) * w1[(17 + i) * 64 + lane];
      const float h1 = sinf(fr1[lane] * a);
      float a2 = b2[lane];
#pragma unroll 16
      for (int j = 0; j < 64; ++j) a2 += __shfl(h1, j) * w2[j * 64 + lane];
      const float h2 = sinf(fr2[lane] * a2);
      float* dst = (float*)(ws + (smp ? OFF_H2S : OFF_H2C)); dst[(size_t)t * 64 + lane] = h2;
    } else {
      const int r = unit - 480, c = tid0; const int pos = r < 32 ? r : r - 32; const int i = c & 255;
      const float omega = 1.0f / powf(10000.0f, (float)i / 256.0f); const float a = (float)pos * omega; const float v = c < 256 ? sinf(a) : cosf(a);
      float* dst = (float*)(ws + (r < 32 ? OFF_PER : OFF_PEC)); dst[(size_t)pos * 512 + c] = v;
    }
  }
}
__device__ void weight_tiles(const Params& p, LP lds) {
  unsigned char* ws = p.ws; LAS float* lf = (LAS float*)lds;
  for (int tu = blockIdx.x; tu < 2560; tu += gridDim.x) {
    const float* src; int ld, K, col0, k0, drow0; bf16_t* dst;
    if (tu < 1152) { const int nt = tu >> 4, kt = tu & 15; const int r = nt * 128; src = p.in[10]; ld = INC; K = 1024; k0 = kt * 64; drow0 = r; dst = (bf16_t*)(ws + OFF_WT);
      col0 = r < 3072 ? r : (r < 6144 ? 4112 + (r - 3072) : (r < 7168 ? 3072 + (r - 6144) : 7184 + (r - 7168))); }
    else if (tu < 1536) { const int v = tu - 1152, w = v >> 7, q = v & 127; src = p.in[23 + w]; ld = 1024; K = 1024; k0 = (q & 15) * 64; col0 = (q >> 4) * 128; drow0 = col0; dst = (bf16_t*)(ws + (w == 0 ? OFF_WBM : (w == 1 ? OFF_WBH : OFF_WOUT))); }
    else if (tu < 2048) { const int q = tu - 1536; src = p.in[27]; ld = 4096; K = 1024; k0 = (q & 15) * 64; col0 = (q >> 4) * 128; drow0 = col0; dst = (bf16_t*)(ws + OFF_W1T); }
    else { const int q = tu - 2048; src = p.in[29]; ld = 1024; K = 4096; k0 = (q & 63) * 64; col0 = (q >> 6) * 128; drow0 = col0; dst = (bf16_t*)(ws + OFF_W2T); }
    transpose_tile(src, ld, col0, k0, dst, K, drow0, lf);
  }
}

__device__ void phase1(const Params& p, LP lds) {
  unsigned char* ws = p.ws;
  int tid_ = threadIdx.x; asm volatile("" : "+v"(tid_));
  const int tid = tid_, wid = tid >> 6, lane = tid & 63;
  const float* mod = (const float*)(ws + OFF_MOD);
  LAS float* wg = (LAS float*)lds;
  if ((int)blockIdx.x < 1536) {
    f32x4 gw[8];
#pragma unroll
    for (int i = 0; i < 8; ++i) { const int idx = tid + 512 * i, k = idx >> 2, q = idx & 3; gw[i] = *(const f32x4*)(p.in[10] + (size_t)k * INC + 4096 + 4 * q); }
#pragma unroll
    for (int i = 0; i < 8; ++i) { const int idx = tid + 512 * i, k = idx >> 2, q = idx & 3; wg[(4 * q) * 1024 + k] = gw[i][0]; wg[(4 * q + 1) * 1024 + k] = gw[i][1]; wg[(4 * q + 2) * 1024 + k] = gw[i][2]; wg[(4 * q + 3) * 1024 + k] = gw[i][3]; }
    __syncthreads();
  }
  for (int unit = blockIdx.x; unit < 1536; unit += gridDim.x) {
    const int tidn = opaque_tid(); const int wid = tidn >> 6, lane = tidn & 63;
    const int row0 = unit * 16 + wid * 2; const int cb = cond_of_row(row0); const float* md = mod + cb * 6144; const bool smp = row0 >= NCTX;
    f32x4 v[2][4]; float rstd[2];
#pragma unroll
    for (int r = 0; r < 2; ++r) { const int row = row0 + r; const float* xr; int t = 0;
      if (!smp) xr = p.in[0] + (size_t)row * 1024; else { xr = p.in[1] + (size_t)(row - NCTX) * 1024; t = (row - NCTX) & 2047; }
      const float* per = (const float*)(ws + OFF_PER) + (t >> 6) * 512; const float* pec = (const float*)(ws + OFF_PEC) + (t & 63) * 512;
      float ss = 0.f;
#pragma unroll
      for (int i = 0; i < 4; ++i) { const int col = 4 * lane + 256 * i; v[r][i] = *(const f32x4*)(xr + col);
        if (smp) v[r][i] += (col < 512) ? *(const f32x4*)(per + col) : *(const f32x4*)(pec + col - 512);
        ss += v[r][i][0] * v[r][i][0] + v[r][i][1] * v[r][i][1] + v[r][i][2] * v[r][i][2] + v[r][i][3] * v[r][i][3]; }
      ss = wave_sum(ss); rstd[r] = rsqrtf(ss * (1.0f / 1024.0f) + 1e-6f); }
    const float* n1w = p.in[9];
    float ga[32];
#pragma unroll
    for (int g = 0; g < 32; ++g) ga[g] = 0.f;
#pragma unroll
    for (int i = 0; i < 4; ++i) { const int col = 4 * lane + 256 * i;
      const f32x4 w = *(const f32x4*)(n1w + col), sc = *(const f32x4*)(md + 1024 + col), sh = *(const f32x4*)(md + col);
      const f32x4 ws1 = w * (sc + 1.0f);
      f32x4 h[2];
#pragma unroll
      for (int r = 0; r < 2; ++r) { h[r] = v[r][i] * rstd[r] * ws1 + sh;
        u32x2 o; o.x = pack2(h[r][0], h[r][1]); o.y = pack2(h[r][2], h[r][3]); *(u32x2*)((bf16_t*)(ws + OFF_HN) + (size_t)(row0 + r) * 1024 + col) = o; }
#pragma unroll
      for (int g = 0; g < 16; ++g) { const f32x4 wv = *(const LAS f32x4*)(wg + g * 1024 + col);
#pragma unroll
        for (int r = 0; r < 2; ++r) ga[r * 16 + g] += h[r][0] * wv[0] + h[r][1] * wv[1] + h[r][2] * wv[2] + h[r][3] * wv[3]; }
      asm volatile("" ::: "memory"); }
#pragma unroll
    for (int off = 16; off >= 1; off >>= 1) { const bool hi = (lane & off) != 0;
#pragma unroll
      for (int i = 0; i < off; ++i) { const float send = hi ? ga[i] : ga[i + off]; const float keep = hi ? ga[i + off] : ga[i]; ga[i] = keep + __shfl_xor(send, off); } }
    const float tot = ga[0] + __shfl_xor(ga[0], 32);
    if (lane < 32) ((float*)(ws + OFF_GT))[(size_t)row0 * 16 + lane] = tot + p.in[11][4096 + (lane & 15)];
  }
  __syncthreads();
  LAS float* w3s = (LAS float*)lds;
  for (int v = blockIdx.x; v < 320; v += gridDim.x) {
    const int tid = opaque_tid();
    const bool smp = v < 256; const int L = smp ? 2048 : 256; const int tt = smp ? (v >> 6) : 0, cgp = v & 63; const int t = tt * 512 + tid;
    { const f32x4 x = *(const f32x4*)(p.in[20] + (size_t)(tid >> 3) * 2048 + cgp * 32 + 4 * (tid & 7)); LAS float* wp = w3s + (4 * (tid & 7)) * 64 + (tid >> 3);
      wp[0] = x[0]; wp[64] = x[1]; wp[128] = x[2]; wp[192] = x[3]; }
    __syncthreads();
    if (t < L) {
      const float* H2 = (const float*)(ws + (smp ? OFF_H2S : OFF_H2C)) + (size_t)t * 64;
      f32x4 h2[16];
#pragma unroll
      for (int i = 0; i < 16; ++i) h2[i] = *(const f32x4*)(H2 + 4 * i);
      const float dist = fabsf((float)t - (float)(L / 2)) / (float)(L / 2);
      float* HF = (float*)(ws + (smp ? OFF_HFS : OFF_HFC)) + (size_t)(cgp * 32) * L + t;
#pragma unroll 1
      for (int j = 0; j < 32; ++j) {
        f32x4 a = {0.f, 0.f, 0.f, 0.f};
#pragma unroll
        for (int i = 0; i < 16; ++i) a += *(const LAS f32x4*)(w3s + j * 64 + 4 * i) * h2[i];
        const int c = (cgp * 32 + j) & 1023;
        const float dmin = -3.0701134573253946f, dmax = -15.350567286626973f;
        const float delta = fabsf(dmin + (dmax - dmin) * ((float)c / 1023.0f));
        HF[(size_t)j * L] = ((a[0] + a[1]) + (a[2] + a[3])) * __expf(-dist * delta); }
    }
    __syncthreads();
  }
  for (int u = (int)gridDim.x - 1 - (int)blockIdx.x; u < 128; u += gridDim.x)
    matvec9_unit<0>(mod + 3072, mod + 6144 + 3072, 6144, p.in[27], 4096, p.in[28], (float*)(ws + OFF_C1), 4096, u * 32, (LAS float*)lds);
}

__device__ __forceinline__ bf16x8 tr_frag(LP base, int k0, int m0, int pitch  , int l15, int g) {
  const int q = l15 >> 2, pp = l15 & 3;
  LP a = base + ((k0 + 8 * g + q) * pitch + m0 + 4 * pp) * 2;
  const s16x4 lo = __builtin_amdgcn_ds_read_tr16_b64_v4i16((LAS s16x4*)a);
  const s16x4 hi = __builtin_amdgcn_ds_read_tr16_b64_v4i16((LAS s16x4*)(a + 8 * pitch));
  bf16x8 r; r[0] = lo[0]; r[1] = lo[1]; r[2] = lo[2]; r[3] = lo[3]; r[4] = hi[0]; r[5] = hi[1]; r[6] = hi[2]; r[7] = hi[3]; return r;
}
__device__ __forceinline__ bf16x8 tr_at(LP lanebase, int coff  , int pitch_bytes) {
  const s16x4 lo = __builtin_amdgcn_ds_read_tr16_b64_v4i16((LAS s16x4*)(lanebase + coff));
  const s16x4 hi = __builtin_amdgcn_ds_read_tr16_b64_v4i16((LAS s16x4*)(lanebase + coff + 4 * pitch_bytes));
  bf16x8 r; r[0] = lo[0]; r[1] = lo[1]; r[2] = lo[2]; r[3] = lo[3]; r[4] = hi[0]; r[5] = hi[1]; r[6] = hi[2]; r[7] = hi[3]; return r;
}
constexpr int ML_K = 0, ML_V = 67584, ML_P = 86016, ML_C = 120832, ML_T = 157696, ML_TSZ = 1600;
constexpr int KP = 264, VP = 72, PP = 136, CP = 72;

__device__ void mlstm_item(const Params& p, LP lds, int item) {
  const int tid = opaque_tid(), wid = __builtin_amdgcn_readfirstlane(tid >> 6), lane = tid & 63, l15 = lane & 15, g = lane >> 4;
  const bool smp = item < 256; const int uu = smp ? (item >> 2) : ((item - 256) >> 2); const int sl = item & 3;
  const int b = uu >> 3, dir = (uu >> 2) & 1, head = uu & 3;
  const int S = smp ? SEQS : SEQC, nc = S >> 7; const int tok0 = smp ? NCTX + b * SEQS : b * SEQC;
  const bf16_t* qkv = (const bf16_t*)(p.ws + OFF_BIG);
  const float* GT = (const float*)(p.ws + OFF_GT);
  bf16_t* hout = (bf16_t*)((unsigned char*)p.out + (dir ? OUT_HB : OUT_H));
  const int sidx = (b * 2 + dir) * 4 + head;
  const int gi_col = dir * 8 + head, gf_col = dir * 8 + 4 + head;
  f32x4 Cacc[2][4], nacc[2]; float mst0;
  if (smp) {
    const float* C0 = p.in[2] + (size_t)sidx * 65536;
#pragma unroll
    for (int dt = 0; dt < 2; ++dt) {
#pragma unroll
      for (int vt = 0; vt < 4; ++vt) Cacc[dt][vt] = *(const f32x4*)(C0 + (size_t)((2 * wid + dt) * 16 + l15) * 256 + sl * 64 + 16 * vt + 4 * g);
      nacc[dt] = (f32x4){p.in[3][sidx * 256 + (2 * wid + dt) * 16 + l15], 0.f, 0.f, 0.f}; }
    mst0 = p.in[4][sidx];
  } else {
#pragma unroll
    for (int dt = 0; dt < 2; ++dt) {
#pragma unroll
      for (int vt = 0; vt < 4; ++vt) Cacc[dt][vt] = (f32x4){0.f, 0.f, 0.f, 0.f};
      nacc[dt] = (f32x4){0.f, 0.f, 0.f, 0.f}; }
    mst0 = 0.f;
  }
#define TOKC(cc, j) (dir ? (tok0 + S - 1 - ((cc) * 128 + (j))) : (tok0 + (cc) * 128 + (j)))
  const int rt = (wid < 4) ? wid : 11 - wid;
  const int jrow = 16 * rt + l15;
  bf16x8 qf[8]; u32x4 kreg[8], vreg[2]; float g4[4] = {0.f, 0.f, 0.f, 0.f};
#define ML_LOAD_Q(cc) do { const bf16_t* qp = qkv + (size_t)TOKC(cc, jrow) * 3072 + head * 256 + 8 * g; \
    _Pragma("unroll") for (int kk = 0; kk < 8; ++kk) qf[kk] = *(const bf16x8*)(qp + 32 * kk); } while (0)
#define ML_LOAD_KV(cc) do { \
    _Pragma("unroll") for (int i = 0; i < 8; ++i) { const int row = (tid >> 5) + 16 * i; kreg[i] = *(const u32x4*)(qkv + (size_t)TOKC(cc, row) * 3072 + 1024 + head * 256 + (tid & 31) * 8); } \
    _Pragma("unroll") for (int i = 0; i < 2; ++i) { const int row = (tid >> 3) + 64 * i; vreg[i] = *(const u32x4*)(qkv + (size_t)TOKC(cc, row) * 3072 + 2048 + head * 256 + sl * 64 + (tid & 7) * 8); } \
    if (wid == 0) { const float* g0 = GT + (size_t)TOKC(cc, 2 * lane) * 16; const float* g1 = GT + (size_t)TOKC(cc, 2 * lane + 1) * 16; g4[0] = g0[gi_col]; g4[1] = g0[gf_col]; g4[2] = g1[gi_col]; g4[3] = g1[gf_col]; } } while (0)
#define ML_SCAN(tabp, mcur, mnext) do { LAS float* T_ = (LAS float*)(tabp); \
    const float lf0 = fminf(g4[1], 0.f) - log1pf(__expf(-fabsf(g4[1]))), lf1 = fminf(g4[3], 0.f) - log1pf(__expf(-fabsf(g4[3]))); \
    float s_ = lf0 + lf1; \
    _Pragma("unroll") for (int o = 1; o < 64; o <<= 1) { const float t_ = __shfl_up(s_, o); if (lane >= o) s_ += t_; } \
    const float b1_ = s_, b0_ = s_ - lf1; const float u0_ = g4[0] - b0_, u1_ = g4[2] - b1_; \
    float mx_ = fmaxf(u0_, u1_); \
    _Pragma("unroll") for (int o = 1; o < 64; o <<= 1) { const float t_ = __shfl_up(mx_, o); if (lane >= o) mx_ = fmaxf(mx_, t_); } \
    float ex_ = __shfl_up(mx_, 1); if (lane == 0) ex_ = -INFINITY; \
    const float M0_ = fmaxf(mcur, fmaxf(ex_, u0_)), M1_ = fmaxf(mcur, mx_); \
    T_[2 * lane] = u0_; T_[2 * lane + 1] = u1_; T_[128 + 2 * lane] = M0_; T_[128 + 2 * lane + 1] = M1_; T_[256 + 2 * lane] = b0_; T_[256 + 2 * lane + 1] = b1_; \
    const float Ml_ = __shfl(M1_, 63), bl_ = __shfl(b1_, 63); \
    if (lane == 0) { T_[384] = mcur; T_[385] = Ml_; } \
    mnext = bl_ + Ml_; } while (0)
  float mw0 = mst0;
  ML_LOAD_Q(0); ML_LOAD_KV(0);
  if (wid == 0) { float mn; ML_SCAN(lds + ML_T, mw0, mn); mw0 = mn; }
  __syncthreads();
  float m_final = 0.f;
  for (int c = 0; c < nc; ++c) {
    LAS float* T = (LAS float*)(lds + ML_T + (c & 1) * ML_TSZ);
    const float mst = T[384], M_last = T[385];
#pragma unroll
    for (int i = 0; i < 8; ++i) { const int row = (tid >> 5) + 16 * i; *(LAS u32x4*)(lds + ML_K + (row * KP + (tid & 31) * 8) * 2) = kreg[i]; }
#pragma unroll
    for (int i = 0; i < 2; ++i) { const int row = (tid >> 3) + 64 * i; const float w = __expf(T[row] - M_last); const u32x4 v = vreg[i]; u32x4 o;
      o.x = pack2(bflo(v.x) * w, bfhi(v.x) * w); o.y = pack2(bflo(v.y) * w, bfhi(v.y) * w); o.z = pack2(bflo(v.z) * w, bfhi(v.z) * w); o.w = pack2(bflo(v.w) * w, bfhi(v.w) * w);
      *(LAS u32x4*)(lds + ML_V + (row * VP + (tid & 7) * 8) * 2) = o; }
    if (tid < 128) *(LAS unsigned short*)(lds + ML_V + (tid * VP + 64) * 2) = f2bf(__expf(T[tid] - M_last));
#pragma unroll
    for (int dt = 0; dt < 2; ++dt) {
#pragma unroll
      for (int vt = 0; vt < 4; ++vt) { u32x2 w; w.x = pack2(Cacc[dt][vt][0], Cacc[dt][vt][1]); w.y = pack2(Cacc[dt][vt][2], Cacc[dt][vt][3]);
        *(LAS u32x2*)(lds + ML_C + (((2 * wid + dt) * 16 + l15) * CP + 16 * vt + 4 * g) * 2) = w; }
      if (g == 0) *(LAS unsigned short*)(lds + ML_C + (((2 * wid + dt) * 16 + l15) * CP + 64) * 2) = f2bf(nacc[dt][0]); }
    const int qtok = TOKC(c, jrow);
    const bool more = (c + 1 < nc);
    __syncthreads();
    const float Mj = T[128 + jrow], bj = T[256 + jrow]; const float rf = __expf(M_last - Mj), w_inter = __expf(mst - Mj);
    int lq_ = (8 * g + (l15 >> 2)), lp_ = 4 * (l15 & 3); asm volatile("" : "+v"(lq_), "+v"(lp_));
    const LP cB = lds + ML_C + (lq_ * CP + lp_) * 2, vB = lds + ML_V + (lq_ * VP + lp_) * 2, kB = lds + ML_K + (lq_ * KP + lp_ + 32 * wid) * 2;
    const LP pB = lds + ML_P + (jrow * PP + 8 * g) * 2;
    for (int st = 0; st <= rt; ++st) {
      f32x4 s = {0.f, 0.f, 0.f, 0.f};
      bf16x8 kfr[8];
#pragma unroll
      for (int kk = 0; kk < 8; ++kk) kfr[kk] = *(const LAS bf16x8*)(lds + ML_K + ((16 * st + l15) * KP + 32 * kk + 8 * g) * 2);
      __builtin_amdgcn_sched_barrier(0);
#pragma unroll
      for (int kk = 0; kk < 8; ++kk) s = __builtin_amdgcn_mfma_f32_16x16x32_bf16(kfr[kk], qf[kk], s, 0, 0, 0);
      float pv[4];
#pragma unroll
      for (int i = 0; i < 4; ++i) pv[i] = ((16 * st + 4 * g + i) <= jrow) ? s[i] * rf : 0.f;
      u32x2 w; w.x = pack2(pv[0], pv[1]); w.y = pack2(pv[2], pv[3]);
      *(LAS u32x2*)(lds + ML_P + (jrow * PP + 16 * st + 4 * g) * 2) = w;
    }
    if ((rt & 1) == 0) { u32x2 z; z.x = 0u; z.y = 0u; *(LAS u32x2*)(lds + ML_P + (jrow * PP + 16 * (rt + 1) + 4 * g) * 2) = z; }
    if (more) ML_LOAD_KV(c + 1);
    asm volatile("s_waitcnt lgkmcnt(0)" ::: "memory");
    f32x4 ha[5];
#pragma unroll
    for (int vt = 0; vt < 5; ++vt) { f32x4 a = {0.f, 0.f, 0.f, 0.f};
      if (smp || c > 0) {
        bf16x8 cfr[8];
#pragma unroll
        for (int kk = 0; kk < 8; ++kk) cfr[kk] = tr_at(cB, (32 * kk * CP + 16 * vt) * 2, CP * 2);
        __builtin_amdgcn_sched_barrier(0);
#pragma unroll
        for (int kk = 0; kk < 8; ++kk) a = __builtin_amdgcn_mfma_f32_16x16x32_bf16(cfr[kk], qf[kk], a, 0, 0, 0);
        a *= w_inter; }
      ha[vt] = a; }
    for (int k2 = 0; k2 <= (rt >> 1); ++k2) {
      const bf16x8 pf = *(const LAS bf16x8*)(pB + k2 * 64);
      bf16x8 vfr[5];
#pragma unroll
      for (int vt = 0; vt < 5; ++vt) vfr[vt] = tr_at(vB + k2 * (32 * VP * 2), (16 * vt) * 2, VP * 2);
      __builtin_amdgcn_sched_barrier(0);
#pragma unroll
      for (int vt = 0; vt < 5; ++vt) ha[vt] = __builtin_amdgcn_mfma_f32_16x16x32_bf16(vfr[vt], pf, ha[vt], 0, 0, 0); }
    { const float den = __shfl(ha[4][0], l15); const float rdd = 1.0f / fmaxf(fabsf(den), __expf(-(bj + Mj)));
#pragma unroll
      for (int vt = 0; vt < 4; ++vt) { const f32x4 a = ha[vt] * rdd; u32x2 w; w.x = pack2(a[0], a[1]); w.y = pack2(a[2], a[3]);
        *(u32x2*)(hout + (size_t)qtok * 1024 + head * 256 + sl * 64 + 16 * vt + 4 * g) = w; } }
    if (more) ML_LOAD_Q(c + 1);
    const bool need_state = (!smp) || more;
    if (need_state) {
      const float decay = __expf(mst - M_last);
#pragma unroll
      for (int dt = 0; dt < 2; ++dt) {
#pragma unroll
        for (int vt = 0; vt < 4; ++vt) Cacc[dt][vt] *= decay;
        nacc[dt] *= decay; }
#pragma unroll
      for (int ks = 0; ks < 4; ++ks) {
        const bf16x8 kf0 = tr_at(kB, (32 * ks * KP) * 2, KP * 2), kf1 = tr_at(kB, (32 * ks * KP + 16) * 2, KP * 2);
        bf16x8 vfr[5];
#pragma unroll
        for (int vt = 0; vt < 5; ++vt) vfr[vt] = tr_at(vB, (32 * ks * VP + 16 * vt) * 2, VP * 2);
        __builtin_amdgcn_sched_barrier(0);
#pragma unroll
        for (int vt = 0; vt < 4; ++vt) { Cacc[0][vt] = __builtin_amdgcn_mfma_f32_16x16x32_bf16(vfr[vt], kf0, Cacc[0][vt], 0, 0, 0); Cacc[1][vt] = __builtin_amdgcn_mfma_f32_16x16x32_bf16(vfr[vt], kf1, Cacc[1][vt], 0, 0, 0); }
        nacc[0] = __builtin_amdgcn_mfma_f32_16x16x32_bf16(vfr[4], kf0, nacc[0], 0, 0, 0); nacc[1] = __builtin_amdgcn_mfma_f32_16x16x32_bf16(vfr[4], kf1, nacc[1], 0, 0, 0);
      }
    }
    if (wid == 0 && more) { float mn; ML_SCAN(lds + ML_T + ((c + 1) & 1) * ML_TSZ, mw0, mn); mw0 = mn; }
    m_final = T[256 + 127] + M_last;
    __syncthreads();
  }
#undef ML_LOAD_Q
#undef ML_LOAD_KV
#undef ML_SCAN
#undef TOKC
  if (!smp) {
    float* oC = p.out + OUTF_C + (size_t)sidx * 65536;
#pragma unroll
    for (int dt = 0; dt < 2; ++dt) {
#pragma unroll
      for (int vt = 0; vt < 4; ++vt) *(f32x4*)(oC + (size_t)((2 * wid + dt) * 16 + l15) * 256 + sl * 64 + 16 * vt + 4 * g) = Cacc[dt][vt];
      if (sl == 0 && g == 0) p.out[OUTF_N + (size_t)sidx * 256 + (2 * wid + dt) * 16 + l15] = nacc[dt][0]; }
    if (sl == 0 && tid == 0) p.out[OUTF_M + sidx] = m_final;
  }
}

__device__ void combine_rows(const Params& p) {
  const int tid0 = opaque_tid(); const int wid = tid0 >> 6, lane = tid0 & 63;
  bf16_t* H = (bf16_t*)((unsigned char*)p.out + OUT_H); const bf16_t* HB = (const bf16_t*)((unsigned char*)p.out + OUT_HB); const float* nw = p.in[22];
  for (int unit = blockIdx.x; unit < 3072; unit += gridDim.x) {
    const int row = unit * 8 + wid; bf16_t* hp = H + (size_t)row * 1024 + 16 * lane; const bf16_t* bp = HB + (size_t)row * 1024 + 16 * lane;
    float v[16]; float ss = 0.f;
#pragma unroll
    for (int i = 0; i < 2; ++i) { const u32x4 a = *(const u32x4*)(hp + 8 * i), bq = *(const u32x4*)(bp + 8 * i);
      v[8 * i + 0] = bflo(a.x) + bflo(bq.x); v[8 * i + 1] = bfhi(a.x) + bfhi(bq.x); v[8 * i + 2] = bflo(a.y) + bflo(bq.y); v[8 * i + 3] = bfhi(a.y) + bfhi(bq.y);
      v[8 * i + 4] = bflo(a.z) + bflo(bq.z); v[8 * i + 5] = bfhi(a.z) + bfhi(bq.z); v[8 * i + 6] = bflo(a.w) + bflo(bq.w); v[8 * i + 7] = bfhi(a.w) + bfhi(bq.w); }
#pragma unroll
    for (int e = 0; e < 16; ++e) ss += v[e] * v[e];
    ss += __shfl_xor(ss, 1); ss += __shfl_xor(ss, 2); ss += __shfl_xor(ss, 4); ss += __shfl_xor(ss, 8);
    const float r = rsqrtf(ss * (1.0f / 256.0f) + 1e-6f);
#pragma unroll
    for (int i = 0; i < 2; ++i) { const f32x4 w0 = *(const f32x4*)(nw + 16 * lane + 8 * i), w1 = *(const f32x4*)(nw + 16 * lane + 8 * i + 4); u32x4 o;
      o.x = pack2(v[8 * i] * r * w0[0], v[8 * i + 1] * r * w0[1]); o.y = pack2(v[8 * i + 2] * r * w0[2], v[8 * i + 3] * r * w0[3]);
      o.z = pack2(v[8 * i + 4] * r * w1[0], v[8 * i + 5] * r * w1[1]); o.w = pack2(v[8 * i + 6] * r * w1[2], v[8 * i + 7] * r * w1[3]);
      *(u32x4*)(hp + 8 * i) = o; }
  }
}

constexpr int HY_WAVE = 18816, HY_HR = 0, HY_ZA = 8576, HY_ZB = 8576 + 5120;
__device__ void hyena_item(const Params& p, LP lds, int item) {
  const int tid = opaque_tid(), wid = __builtin_amdgcn_readfirstlane(tid >> 6), lane = tid & 63, n31 = lane & 31, hh = lane >> 5;
  const bool smp = item < 1024; const int it = smp ? item : item - 1024; const int bset = it >> 7, cgp = it & 127; const int c = cgp * 8 + wid;
  const int L = smp ? 2048 : 256, lgL = smp ? 11 : 8, nblk = L >> 5, lgnb = lgL - 5, ntok = smp ? 2048 : 1024, ntile = smp ? 2 : 1, dmax = L >> 6;
  const int tok0 = smp ? NCTX + bset * 2048 : bset * 1024;
  LP wl = lds + wid * HY_WAVE; LAS float* hr = (LAS float*)(wl + HY_HR);
  const float* HFp = (const float*)(p.ws + (smp ? OFF_HFS : OFF_HFC));
  const bf16_t* UT = (const bf16_t*)(p.ws + OFF_BIG);
  const float* cw = p.in[12]; const float* cbv = p.in[13]; const float* skp = p.in[21];
  { const int uc = 2048 + c; const float w0 = cw[uc], w1 = cw[3072 + uc], w2 = cw[6144 + uc], cb = cbv[uc]; const bf16_t* src = UT + (size_t)uc * NTOK + tok0;
    u32x4 vv[4]; float pvv[4], nxv[4];
#pragma unroll
    for (int i = 0; i < 4; ++i) { const int base = lane * 8 + 512 * i; vv[i] = (u32x4){0u, 0u, 0u, 0u}; pvv[i] = 0.f; nxv[i] = 0.f;
      if (base < ntok) { vv[i] = *(const u32x4*)(src + base); const int tl = base & (L - 1);
        if (tl != 0) pvv[i] = bf2f(src[base - 1]); if (tl + 8 != L) nxv[i] = bf2f(src[base + 8]); } }
#pragma unroll
    for (int i = 0; i < 4; ++i) { const int base = lane * 8 + 512 * i;
      if (base < ntok) { const u32x4 v = vv[i];
        float u[10]; u[0] = pvv[i]; u[1] = bflo(v.x); u[2] = bfhi(v.x); u[3] = bflo(v.y); u[4] = bfhi(v.y); u[5] = bflo(v.z); u[6] = bfhi(v.z); u[7] = bflo(v.w); u[8] = bfhi(v.w); u[9] = nxv[i];
        float o[8];
#pragma unroll
        for (int e = 0; e < 8; ++e) o[e] = cb + w0 * u[e] + w1 * u[e + 1] + w2 * u[e + 2];
        u32x4 w; w.x = pack2(o[0], o[1]); w.y = pack2(o[2], o[3]); w.z = pack2(o[4], o[5]); w.w = pack2(o[6], o[7]);
        *(LAS u32x4*)(wl + HY_ZA + ((base >> 5) * 40 + (base & 31)) * 2) = w; } } }
  const int HRP = L + 96;
  f32x4 fvN[8];
#define HY_FLOAD(o) do { const float* src_ = HFp + (size_t)((o) * 1024 + c) * L; \
    _Pragma("unroll") for (int i = 0; i < 8; ++i) { const int q = lane + 64 * i; fvN[i] = (4 * q < L) ? *(const f32x4*)(src_ + 4 * q) : (f32x4){0.f, 0.f, 0.f, 0.f}; } } while (0)
  HY_FLOAD(0);
  for (int ord = 0; ord < 2; ++ord) {
    { float sa = 0.f;
      f32x4 fv[8];
#pragma unroll
      for (int i = 0; i < 8; ++i) fv[i] = fvN[i];
#pragma unroll
      for (int i = 0; i < 8; ++i) sa += (fabsf(fv[i][0]) + fabsf(fv[i][1])) + (fabsf(fv[i][2]) + fabsf(fv[i][3]));
      sa = wave_sum(sa); const float inv = 1.0f / (sa + 1e-6f);
      asm volatile("s_waitcnt lgkmcnt(0)" ::: "memory");
      LAS bf16_t* E = (LAS bf16_t*)hr; LAS bf16_t* O = E + HRP;
#pragma unroll
      for (int i = 0; i < 8; ++i) { const int q = lane + 64 * i;
        if (4 * q < L) {
#pragma unroll
          for (int e = 0; e < 4; ++e) { const int yy = L - 1 - (4 * q + e); const bf16_t v = f2bf(fv[i][e] * inv); E[32 + yy] = v; O[31 + yy] = v; } } }
      if (lane < 32) { E[lane] = 0; E[32 + L + lane] = 0; O[31 + L + lane] = 0; if (lane < 31) O[lane] = 0; }
      if (lane < 33) O[HRP - 33 + lane] = 0;
      asm volatile("s_waitcnt lgkmcnt(0)" ::: "memory"); }
    if (ord == 0) HY_FLOAD(1);
    LP zin = wl + (ord == 0 ? HY_ZA : HY_ZB); LP zout = wl + (ord == 0 ? HY_ZB : HY_ZA);
    const int gc = ord * 1024 + c; const float w0 = cw[gc], w1 = cw[3072 + gc], w2 = cw[6144 + gc], cb = cbv[gc], sk = skp[ord * 1024 + c];
    const bf16_t* gsrc = UT + (size_t)gc * NTOK + tok0;
    u32x4 gv[4]; unsigned gpv[4], gnx[4];
#pragma unroll
    for (int i = 0; i < 4; ++i) { const int base = lane * 8 + 512 * i; gv[i] = (u32x4){0u, 0u, 0u, 0u}; gpv[i] = 0u; gnx[i] = 0u;
      if (base < ntok) { gv[i] = *(const u32x4*)(gsrc + base); const int tl = base & (L - 1);
        if (tl != 0) gpv[i] = gsrc[base - 1]; if (tl + 8 != L) gnx[i] = gsrc[base + 8]; } }
    f32x16 accs[2];
#pragma unroll
    for (int o2 = 0; o2 < 2; ++o2)
#pragma unroll
      for (int r = 0; r < 16; ++r) accs[o2][r] = 0.f;
    LP fb = wl + HY_HR + ((n31 & 1) ? 0 : (HRP * 2 - 2)) + 2 * ((L >> 1) - 1 - n31 + 8 * hh + 32);
    int cbl[2], ca[2];
#pragma unroll
    for (int ot = 0; ot < 2; ++ot) { const int col = 32 * ot + n31; cbl[ot] = (col >> lgnb) << lgnb; ca[ot] = col & (nblk - 1); }
    const bool two = (ntile == 2);
    {
      LP zero = wl + HY_HR + 16 * hh;
      LP ap = fb + 64 * dmax;
      int bbr0 = ca[0] + dmax, bbr1 = ca[1] + dmax;
      LP bp0 = zin + ((cbl[0] + bbr0) * 40 + 8 * hh) * 2, bp1 = zin + ((cbl[1] + bbr1) * 40 + 8 * hh) * 2;
      for (int d = -dmax; d <= dmax; ++d) {
        u32x4 w0v, w1v;
        w0v.x = *(const LAS unsigned*)(ap); w0v.y = *(const LAS unsigned*)(ap + 4); w0v.z = *(const LAS unsigned*)(ap + 8); w0v.w = *(const LAS unsigned*)(ap + 12);
        w1v.x = *(const LAS unsigned*)(ap + 32); w1v.y = *(const LAS unsigned*)(ap + 36); w1v.z = *(const LAS unsigned*)(ap + 40); w1v.w = *(const LAS unsigned*)(ap + 44);
        const bf16x8 af0 = __builtin_bit_cast(bf16x8, w0v), af1 = __builtin_bit_cast(bf16x8, w1v);
        LP q0 = ((unsigned)bbr0 < (unsigned)nblk) ? bp0 : zero;
        LP q1 = (two && ((unsigned)bbr1 < (unsigned)nblk)) ? bp1 : zero;
        const bf16x8 b00 = *(const LAS bf16x8*)q0, b01 = *(const LAS bf16x8*)(q0 + 32);
        const bf16x8 b10 = *(const LAS bf16x8*)q1, b11 = *(const LAS bf16x8*)(q1 + 32);
        __builtin_amdgcn_sched_barrier(0);
        accs[0] = __builtin_amdgcn_mfma_f32_32x32x16_bf16(af0, b00, accs[0], 0, 0, 0);
        if (two) accs[1] = __builtin_amdgcn_mfma_f32_32x32x16_bf16(af0, b10, accs[1], 0, 0, 0);
        accs[0] = __builtin_amdgcn_mfma_f32_32x32x16_bf16(af1, b01, accs[0], 0, 0, 0);
        if (two) accs[1] = __builtin_amdgcn_mfma_f32_32x32x16_bf16(af1, b11, accs[1], 0, 0, 0);
        ap -= 64; bbr0 -= 1; bbr1 -= 1; bp0 -= 80; bp1 -= 80;
      }
    }
#pragma unroll
    for (int ot = 0; ot < 2; ++ot) {
      if (ot >= ntile) continue;
      const f32x16 acc = accs[ot];
#pragma unroll
      for (int rg = 0; rg < 4; ++rg) {
        const int zo = (((cbl[ot] + ca[ot]) * 40) + 8 * rg + 4 * hh) * 2;
        const u32x2 zv = *(const LAS u32x2*)(zin + zo);
        u32x2 w; w.x = pack2(acc[4 * rg] + sk * bflo(zv.x), acc[4 * rg + 1] + sk * bfhi(zv.x)); w.y = pack2(acc[4 * rg + 2] + sk * bflo(zv.y), acc[4 * rg + 3] + sk * bfhi(zv.y));
        *(LAS u32x2*)(zout + zo) = w;
      }
    }
    asm volatile("s_waitcnt lgkmcnt(0)" ::: "memory");
#pragma unroll
    for (int i = 0; i < 4; ++i) { const int base = lane * 8 + 512 * i;
      if (base < ntok) { const u32x4 v = gv[i];
        float u[10]; u[0] = bf2f(gpv[i]); u[1] = bflo(v.x); u[2] = bfhi(v.x); u[3] = bflo(v.y); u[4] = bfhi(v.y); u[5] = bflo(v.z); u[6] = bfhi(v.z); u[7] = bflo(v.w); u[8] = bfhi(v.w); u[9] = bf2f(gnx[i]);
        LP zp = zout + ((base >> 5) * 40 + (base & 31)) * 2; const u32x4 t = *(const LAS u32x4*)zp;
        float tv[8]; tv[0] = bflo(t.x); tv[1] = bfhi(t.x); tv[2] = bflo(t.y); tv[3] = bfhi(t.y); tv[4] = bflo(t.z); tv[5] = bfhi(t.z); tv[6] = bflo(t.w); tv[7] = bfhi(t.w);
        float o[8];
#pragma unroll
        for (int e = 0; e < 8; ++e) o[e] = (cb + w0 * u[e] + w1 * u[e + 1] + w2 * u[e + 2]) * tv[e];
        u32x4 w; w.x = pack2(o[0], o[1]); w.y = pack2(o[2], o[3]); w.z = pack2(o[4], o[5]); w.w = pack2(o[6], o[7]);
        *(LAS u32x4*)zp = w; } }
    asm volatile("s_waitcnt lgkmcnt(0)" ::: "memory");
  }
  __syncthreads();
  { bf16_t* YH = (bf16_t*)((unsigned char*)p.out + OUT_HB);
    for (int tl = tid; tl < ntok; tl += 512) {
      const int bl = tl >> lgL, tloc = tl & (L - 1); const int zo = ((((bl << lgnb) + (tloc >> 5)) * 40) + (tloc & 31)) * 2;
      unsigned short e[8];
#pragma unroll
      for (int w = 0; w < 8; ++w) e[w] = *(const LAS unsigned short*)(lds + w * HY_WAVE + HY_ZA + zo);
      u32x4 o; o.x = e[0] | ((unsigned)e[1] << 16); o.y = e[2] | ((unsigned)e[3] << 16); o.z = e[4] | ((unsigned)e[5] << 16); o.w = e[6] | ((unsigned)e[7] << 16);
      *(u32x4*)(YH + (size_t)(tok0 + tl) * 1024 + cgp * 8) = o; } }
  __syncthreads();
}

__device__ void final_norm(const Params& p) {
  const int tid0 = opaque_tid(); const int wid = tid0 >> 6, lane = tid0 & 63; const float* fw = p.in[31]; const float* ssq = (const float*)(p.ws + OFF_SSQ2);
  for (int unit = blockIdx.x; unit < 3072; unit += gridDim.x) {
    const int row = unit * 8 + wid; float* xr = p.out + (size_t)row * 1024; const float* sp = ssq + (size_t)row * 16;
    const f32x4 st = *(const f32x4*)sp + *(const f32x4*)(sp + 4) + *(const f32x4*)(sp + 8) + *(const f32x4*)(sp + 12);
    const float rstd = rsqrtf((st[0] + st[1] + st[2] + st[3]) * (1.0f / 1024.0f) + 1e-6f);
#pragma unroll
    for (int i = 0; i < 4; ++i) { const int col = 4 * lane + 256 * i; const f32x4 v = *(const f32x4*)(xr + col) * rstd * *(const f32x4*)(fw + col); *(f32x4*)(xr + col) = v; }
  }
}

__global__ void __launch_bounds__(512, 2) __attribute__((flatten)) mega(Params p) {
  extern __shared__ __attribute__((aligned(16))) unsigned char shm[];
  LP lds = (LP)shm;
  cg::grid_group grid = cg::this_grid();
  volatile LAS unsigned* xst = (volatile LAS unsigned*)(lds + LDS_BYTES - 16);
  if (threadIdx.x == 0) { xst[0] = 0u; xst[1] = 0u; }
  __syncthreads();
  const XcdBarrier xb = xcd_barrier_post((unsigned*)(p.ws + OFF_BAR), xst);
  unsigned char* ws = p.ws;
  const bf16_t* WT = (const bf16_t*)(ws + OFF_WT); const bf16_t* HN = (const bf16_t*)(ws + OFF_HN); bf16_t* BIG = (bf16_t*)(ws + OFF_BIG);
  bf16_t* Hb = (bf16_t*)((unsigned char*)p.out + OUT_H); bf16_t* YH = (bf16_t*)((unsigned char*)p.out + OUT_HB);
  const float* mod = (const float*)(ws + OFF_MOD);
  phase0(p, lds);
  if (gridDim.y == 7u) grid.sync();
  xcd_barrier(xb);
  phase1(p, lds);
  weight_tiles(p, lds);
  xcd_barrier(xb);
  { EpiQKV e; e.O = BIG; e.bias = p.in[11]; run_gemm(lds, HN, WT, NTOK, 3072, 1024, e); }
  xcd_barrier(xb);
  for (int item = blockIdx.x; item < 1280; item += gridDim.x) mlstm_item(p, lds, item);
  xcd_barrier(xb);
  combine_rows(p);
  { EpiUT e; e.O = BIG; e.bias = p.in[11] + 4112; run_gemm(lds, WT + (size_t)3072 * 1024, HN, 3072, NTOK, 1024, e); }
  xcd_barrier(xb);
  for (int item = blockIdx.x; item < 2048; item += gridDim.x) hyena_item(p, lds, item);
  xcd_barrier(xb);
  { EpiGates e; e.H = Hb; e.G = BIG; e.b_in = p.in[11]; run_gemm(lds, HN, WT + (size_t)6144 * 1024, NTOK, 3072, 1024, e); }
  xcd_barrier(xb);
  bf16_t* T = BIG + (size_t)NTOK * 2048;
  { EpiMerge<0> e; e.T = T; e.G = BIG; run_gemm(lds, Hb, (const bf16_t*)(ws + OFF_WBM), NTOK, 1024, 1024, e); }
  { EpiMerge<1> e; e.T = T; e.G = BIG; run_gemm(lds, YH, (const bf16_t*)(ws + OFF_WBH), NTOK, 1024, 1024, e); }
  xcd_barrier(xb);
  { EpiOut e; e.xp = p.in[0]; e.xs = p.in[1]; e.per = (const float*)(ws + OFF_PER); e.pec = (const float*)(ws + OFF_PEC); e.mod = mod; e.n2w = p.in[26];
    e.X1 = p.out; e.A2 = (bf16_t*)(ws + OFF_HN); e.ssq = (float*)(ws + OFF_SSQ1); run_gemm(lds, T, (const bf16_t*)(ws + OFF_WOUT), NTOK, 1024, 1024, e); }
  xcd_barrier(xb);
#define FFN_HALF(ROW0) do { \
    { EpiFF1 e; e.row0 = (ROW0); e.ssq = (const float*)(p.ws + OFF_SSQ1); e.c1 = (const float*)(p.ws + OFF_C1); e.Hd = (bf16_t*)(p.ws + OFF_BIG); \
      run_gemm(lds, (const bf16_t*)(p.ws + OFF_HN) + (size_t)(ROW0) * 1024, (const bf16_t*)(p.ws + OFF_W1T), 12288, 4096, 1024, e); } \
    xcd_barrier(xb); \
    { EpiFF2 e; e.row0 = (ROW0); e.mod = (const float*)(p.ws + OFF_MOD); e.b2 = p.in[30]; e.X = p.out; e.ssq = (float*)(p.ws + OFF_SSQ2); \
      run_gemm(lds, (const bf16_t*)(p.ws + OFF_BIG), (const bf16_t*)(p.ws + OFF_W2T), 12288, 1024, 4096, e); } \
    xcd_barrier(xb); } while (0)
  FFN_HALF(0);
  FFN_HALF(12288);
#undef FFN_HALF
  final_norm(p);
}

extern "C" void kernel_launch(void* const* d_in, const int* in_sizes, int n_in, void* d_out, int out_size, void* d_ws, size_t ws_size, hipStream_t stream) {
  static int grid_blocks = 0;
  if (!grid_blocks) {
    int dev = 0, cus = 0, per_cu = 0;
    hipGetDevice(&dev);
    hipDeviceGetAttribute(&cus, hipDeviceAttributeMultiprocessorCount, dev);
    hipFuncSetAttribute((const void*)mega, hipFuncAttributeMaxDynamicSharedMemorySize, LDS_BYTES);
    hipOccupancyMaxActiveBlocksPerMultiprocessor(&per_cu, (const void*)mega, 512, LDS_BYTES);
    if (per_cu < 1) { fprintf(stderr, "kernel_launch: occupancy query reports %d blocks per CU\n", per_cu); grid_blocks = -1; }
    else grid_blocks = cus;
    if (n_in != 32 || ws_size < WS_END) { fprintf(stderr, "kernel_launch: unexpected n_in %d / ws_size %zu (need %zu)\n", n_in, ws_size, (size_t)WS_END); grid_blocks = -1; }
  }
  if (grid_blocks < 0) return;
  hipMemsetAsync((unsigned char*)d_ws + OFF_BAR, 0, 3456 * 4, stream);
  Params p{};
  for (int i = 0; i < 32; ++i) p.in[i] = (const float*)d_in[i];
  p.out = (float*)d_out; p.ws = (unsigned char*)d_ws;
  void* args[] = {&p};
  hipError_t e = hipLaunchCooperativeKernel((void*)mega, dim3(grid_blocks), dim3(512), args, LDS_BYTES, stream);
  if (e != hipSuccess) fprintf(stderr, "cooperative launch failed: %s (grid %d)\n", hipGetErrorString(e), grid_blocks);
}
```

```cpp
#include <hip/hip_runtime.h>
#include <hip/hip_cooperative_groups.h>
#include <cstdio>
#include <cstdint>
namespace cg = cooperative_groups;

#define LAS __attribute__((address_space(3)))
typedef LAS unsigned char* LP;
typedef unsigned short bf16_t;
typedef short bf16x8 __attribute__((ext_vector_type(8)));
typedef short s16x4 __attribute__((ext_vector_type(4)));
typedef float f32x4 __attribute__((ext_vector_type(4)));
typedef float f32x16 __attribute__((ext_vector_type(16)));
typedef unsigned u32x4 __attribute__((ext_vector_type(4)));
typedef unsigned u32x2 __attribute__((ext_vector_type(2)));

constexpr int DM = 1024, NTOK = 24576, NCTX = 8192, SEQC = 256, SEQS = 2048, INC = 9232;
constexpr int LDS_BYTES = 160 * 1024;
constexpr size_t OFF_WT = 0;
constexpr size_t OFF_WBM = 18874368, OFF_WBH = 20971520, OFF_WOUT = 23068672, OFF_W1T = 25165824, OFF_W2T = 33554432;
constexpr size_t OFF_HN = 41943040;
constexpr size_t OFF_BIG = 92274688;
constexpr size_t OFF_SM = 243269632;
constexpr size_t OFF_MOD = OFF_SM;
constexpr size_t OFF_C1 = OFF_MOD + 221184;
constexpr size_t OFF_H2S = OFF_C1 + 147456;
constexpr size_t OFF_H2C = OFF_H2S + 524288;
constexpr size_t OFF_PER = OFF_H2C + 65536;
constexpr size_t OFF_PEC = OFF_PER + 65536;
constexpr size_t OFF_GT = OFF_PEC + 131072;
constexpr size_t OFF_SSQ1 = OFF_GT + 1572864;
constexpr size_t OFF_SSQ2 = OFF_SSQ1 + 1572864;
constexpr size_t OFF_HFS = OFF_SSQ2 + 1572864;
constexpr size_t OFF_HFC = OFF_HFS + 16777216;
constexpr size_t OFF_BAR = OFF_HFC + 2097152;
constexpr size_t WS_END = OFF_BAR + 3456 * 4;
constexpr size_t OUT_H = 0, OUT_HB = 50331648;
constexpr size_t OUTF_C = 25165824, OUTF_N = 41943040, OUTF_M = 42008576;

struct Params { const float* in[32]; float* out; unsigned char* ws; };

__device__ __forceinline__ bf16_t f2bf(float f) { unsigned u = __float_as_uint(f); u += 0x7FFFu + ((u >> 16) & 1u); return (bf16_t)(u >> 16); }
__device__ __forceinline__ float bf2f(unsigned b) { return __uint_as_float(b << 16); }
__device__ __forceinline__ unsigned pack2(float lo, float hi) { return (unsigned)f2bf(lo) | ((unsigned)f2bf(hi) << 16); }
__device__ __forceinline__ float bflo(unsigned w) { return __uint_as_float(w << 16); }
__device__ __forceinline__ float bfhi(unsigned w) { return __uint_as_float(w & 0xffff0000u); }
__device__ __forceinline__ float sigmoidf_(float x) { return 1.0f / (1.0f + __expf(-x)); }
__device__ __forceinline__ int opaque_tid() { int t = threadIdx.x; asm volatile("" : "+v"(t)); return t; }
__device__ __forceinline__ float wave_sum(float v) {
#pragma unroll
  for (int o = 32; o >= 1; o >>= 1) v += __shfl_xor(v, o);
  return v;
}


#define XB_TMO      128
#define XB_XCNT(j)  (256  + 64 * (j))
#define XB_XSUB(j)  (1280 + 64 * (j))
#define XB_XGEN(j)  (2304 + 64 * (j))
#define XB_TOP      3328
#define XB_TOPGEN   3392
#define XCD_BAR_WORDS 3456
#define XB_SPIN_CAP (1u << 18)
__device__ __forceinline__ unsigned xb_ld(unsigned* p)              { return __hip_atomic_load(p, __ATOMIC_RELAXED, __HIP_MEMORY_SCOPE_AGENT); }
__device__ __forceinline__ unsigned xb_add(unsigned* p, unsigned v) { return __hip_atomic_fetch_add(p, v, __ATOMIC_RELAXED, __HIP_MEMORY_SCOPE_AGENT); }
__device__ __forceinline__ unsigned xb_xcc_id() { return (unsigned)__builtin_amdgcn_s_getreg((3 << 11) | 20) & 0xFu; }
#define XB_SPIN(cond, bar) do { unsigned _sp = 0; while (cond) { __builtin_amdgcn_s_sleep(1); \
    if ((++_sp & 255u) == 0u) { if (xb_ld(&(bar)[XB_TMO])) break; if (_sp > XB_SPIN_CAP) { atomicAdd(&(bar)[XB_TMO], 1u); break; } } } } while (0)
struct XcdBarrier { unsigned* bar; unsigned x; volatile LAS unsigned* st; };
__device__ __forceinline__ XcdBarrier xcd_barrier_post(unsigned* bar, volatile LAS unsigned* st) {
  XcdBarrier b; b.bar = bar; b.x = xb_xcc_id(); b.st = st;
  if (threadIdx.x == 0) (void)xb_add(&bar[XB_XCNT(b.x)], 1u);
  return b;
}
__device__ __forceinline__ void xcd_barrier_complete(unsigned* bar, unsigned x, unsigned& nloc, unsigned& nx) {
  const unsigned G = gridDim.x * gridDim.y * gridDim.z;
  unsigned sum, cnt, mine, sp = 0u;
  for (;;) {
    sum = 0u; cnt = 0u; mine = 0u;
#pragma unroll
    for (unsigned j = 0; j < 16; ++j) { const unsigned c = xb_ld(&bar[XB_XCNT(j)]); sum += c; cnt += (c > 0u) ? 1u : 0u; mine = (j == x) ? c : mine; }
    if (sum == G) break;
    __builtin_amdgcn_s_sleep(1);
    if ((++sp & 255u) == 0u) { if (xb_ld(&bar[XB_TMO])) break; if (sp > XB_SPIN_CAP) { atomicAdd(&bar[XB_TMO], 1u); break; } }
  }
  nloc = mine > 0u ? mine : 1u; nx = cnt > 0u ? cnt : 1u;
}
__device__ __forceinline__ void xcd_barrier(const XcdBarrier& b) {
  asm volatile("s_waitcnt vmcnt(0)" ::: "memory");
  __syncthreads();
  if (threadIdx.x == 0) {
    unsigned* bar = b.bar;
    __builtin_amdgcn_s_waitcnt(0);
    unsigned nloc = b.st[0], nx = b.st[1];
    if (nloc == 0u) { xcd_barrier_complete(bar, b.x, nloc, nx); b.st[0] = nloc; b.st[1] = nx; }
    const unsigned old = xb_add(&bar[XB_XSUB(b.x)], 1u);
    const unsigned gen = old / nloc;
    if (old + 1u == (gen + 1u) * nloc) {
      __builtin_amdgcn_fence(__ATOMIC_RELEASE, "agent");
      asm volatile("s_waitcnt vmcnt(0)" ::: "memory");
      const unsigned og = xb_add(&bar[XB_TOP], 1u);
      const unsigned tg = og / nx;
      if (og + 1u == (tg + 1u) * nx) xb_add(&bar[XB_TOPGEN], 1u);
      else XB_SPIN(xb_ld(&bar[XB_TOPGEN]) == tg, bar);
      __builtin_amdgcn_fence(__ATOMIC_ACQUIRE, "agent");
      xb_add(&bar[XB_XGEN(b.x)], 1u);
      asm volatile("s_waitcnt vmcnt(0)" ::: "memory");
    } else {
      XB_SPIN(xb_ld(&bar[XB_XGEN(b.x)]) == gen, bar);
      __builtin_amdgcn_fence(__ATOMIC_ACQUIRE, "agent");
      asm volatile("s_waitcnt vmcnt(0)" ::: "memory");
    }
  }
  __syncthreads();
}

namespace pg8 {
constexpr int BM = 256, BK = 64, HALF = 128, HTB = HALF * BK * 2, STAGE_BYTES = 8 * HTB, NXCD = 8, WGM = 8;
__host__ __device__ __forceinline__ int lds_byte(int r, int c) { const int st = (r >> 4) * 2 + (c >> 5), rr = r & 15, cc = c & 31, ob = rr * 64 + cc * 2; return st * 1024 + (ob ^ (((ob >> 9) & 1) << 5)); }
__host__ __device__ __forceinline__ void stage_rc(int b, int& R, int& C) { const int st = b / 1024, sb = b % 1024, swz = sb ^ (((sb >> 9) & 1) << 5); R = (st >> 1) * 16 + swz / 64; C = (st & 1) * 32 + (swz % 64) / 2; }
__host__ __device__ __forceinline__ int perm32(int rho) { const int n = rho >> 4, i = rho & 15; return 8 * (i >> 2) + 4 * n + (i & 3); }
struct Unit { int pm, pn; };
struct Gemm { const bf16_t* A; const bf16_t* Bt; int M, N, K; };
struct StaticOrder {
  int nM, nN, nwg, G, c;
  __device__ void init(int M, int N, int G_, int c_) { nM = M / BM; nN = N / BM; nwg = nM * nN; G = G_; c = c_; }
  __device__ bool next(int i, Unit& u) const {
    const long L = (long)i * G + c; if (L >= nwg) return false;
    int wgid = (int)L; { const int q = nwg / NXCD, r = nwg % NXCD, xcd = wgid % NXCD, off = wgid / NXCD; wgid = (xcd < r ? xcd * (q + 1) : r * (q + 1) + (xcd - r) * q) + off; }
    const int nig = WGM * nN, gid = wgid / nig, fm = gid * WGM, gsz = (nM - fm) < WGM ? (nM - fm) : WGM;
    u.pm = fm + ((wgid % nig) % gsz); u.pn = (wgid % nig) / gsz; return true;
  }
};

template <class Epi>
__device__ __forceinline__ void gemm_phase(LP lds, const Gemm g, const StaticOrder& S, const Epi& E) {
  int tid_ = threadIdx.x; asm volatile("" : "+v"(tid_));
  const int tid = tid_, wid = __builtin_amdgcn_readfirstlane(tid >> 6), lane = tid & 63, wr = wid >> 2, wc = wid & 3, fr = lane & 15, fq = lane >> 4;
  const int K = g.K, nt = K / BK;
  unsigned voffA[2], voffB[2];
#pragma unroll
  for (int i = 0; i < 2; ++i) { int R, C; stage_rc(tid * 16 + i * 8192, R, C); const int Rb = (R & ~31) + perm32(R & 31); voffA[i] = (unsigned)(R * K + C) * 2u; voffB[i] = (unsigned)(Rb * K + C) * 2u; }
  const size_t kstep = (size_t)(BK * 2);
  const size_t hstep = (size_t)HALF * K * 2;
  const size_t tstep = 2 * hstep;
  const unsigned ldsw = (unsigned)wid * 1024u;
  const int aoff = lds_byte(wr * 64 + fr, fq * 8), boff = lds_byte(wc * 32 + fr, fq * 8);
#define PG8_SA(b, h) (((b) * 2 + (h)) * HTB)
#define PG8_SB(b, h) ((4 + (b) * 2 + (h)) * HTB)
#define PG8_STAGE(bufoff, gbase, voff) do { _Pragma("unroll") for (int _i = 0; _i < 2; ++_i) \
    __builtin_amdgcn_global_load_lds((const unsigned*)((const char*)(gbase) + (voff)[_i]), (LAS unsigned*)(lds + (bufoff) + ldsw + _i * 8192), 16, 0, 0); } while (0)
#define PG8_LDA(dst, b, h) do { _Pragma("unroll") for (int m = 0; m < 4; ++m) _Pragma("unroll") for (int k = 0; k < 2; ++k) dst[m][k] = *(const LAS bf16x8*)(lds + PG8_SA(b, h) + aoff + m * 2048 + k * 1024); } while (0)
#define PG8_LDB(dst, b, h) do { _Pragma("unroll") for (int n = 0; n < 2; ++n) _Pragma("unroll") for (int k = 0; k < 2; ++k) dst[n][k] = *(const LAS bf16x8*)(lds + PG8_SB(b, h) + boff + n * 2048 + k * 1024); } while (0)
#define PG8_MMA(ai, bj, At, Bt) do { __builtin_amdgcn_s_setprio(1); _Pragma("unroll") for (int m = 0; m < 4; ++m) _Pragma("unroll") for (int n = 0; n < 2; ++n) _Pragma("unroll") for (int k = 0; k < 2; ++k) \
    acc[ai][bj][m][n] = __builtin_amdgcn_mfma_f32_16x16x32_bf16(Bt[n][k], At[m][k], acc[ai][bj][m][n], 0, 0, 0); __builtin_amdgcn_s_setprio(0); } while (0)
#define PG8_WAIT_V(n) asm volatile("s_waitcnt vmcnt(" #n ")" ::: "memory")
#define PG8_WAIT_L(n) asm volatile("s_waitcnt lgkmcnt(" #n ")" ::: "memory")
#define PG8_BAR __builtin_amdgcn_s_barrier()
#define PG8_SCHED __builtin_amdgcn_sched_barrier(0)
  Unit cur, nxt; int ui = 0;
  if (!S.next(0, cur)) return;
  f32x4 acc[2][2][4][2];
#pragma unroll
  for (int a = 0; a < 2; ++a)
#pragma unroll
    for (int b = 0; b < 2; ++b)
#pragma unroll
      for (int m = 0; m < 4; ++m)
#pragma unroll
        for (int n = 0; n < 2; ++n) acc[a][b][m][n] = (f32x4){0.f, 0.f, 0.f, 0.f};
  bf16x8 At[4][2], B0[2][2], B1[2][2];
  const char* cA = (const char*)g.A + (size_t)cur.pm * tstep; const char* cB = (const char*)g.Bt + (size_t)cur.pn * tstep;
  PG8_STAGE(PG8_SB(0, 0), cB, voffB); PG8_STAGE(PG8_SA(0, 0), cA, voffA); PG8_STAGE(PG8_SB(0, 1), cB + hstep, voffB); PG8_STAGE(PG8_SA(0, 1), cA + hstep, voffA);
  if (wr == 1) PG8_BAR;
  PG8_WAIT_V(4); PG8_BAR;
  PG8_STAGE(PG8_SB(1, 0), cB + kstep, voffB); PG8_STAGE(PG8_SA(1, 0), cA + kstep, voffA); PG8_STAGE(PG8_SB(1, 1), cB + hstep + kstep, voffB);
  PG8_WAIT_V(6); PG8_BAR;
  for (;;) {
    const bool has_next = S.next(ui + 1, nxt);
    const char* nA = has_next ? (const char*)g.A + (size_t)nxt.pm * tstep : cA; const char* nB = has_next ? (const char*)g.Bt + (size_t)nxt.pn * tstep : cB;
    for (int t = 0; t < nt; t += 2) {
      const bool last = (t == nt - 2);
      const char* a1 = cA + (size_t)(t + 1) * kstep;
      const char* a2 = last ? nA : cA + (size_t)(t + 2) * kstep; const char* b2 = last ? nB : cB + (size_t)(t + 2) * kstep;
      const char* a3 = a2 + kstep; const char* b3 = b2 + kstep;
      PG8_LDB(B0, 0, 0); PG8_SCHED; PG8_LDA(At, 0, 0); PG8_STAGE(PG8_SA(1, 1), a1 + hstep, voffA);
      PG8_WAIT_L(8); PG8_BAR; PG8_WAIT_L(0); PG8_MMA(0, 0, At, B0); PG8_BAR; PG8_SCHED;
      PG8_LDB(B1, 0, 1); PG8_STAGE(PG8_SB(0, 0), b2, voffB);
      PG8_BAR; PG8_WAIT_L(0); PG8_MMA(0, 1, At, B1); PG8_BAR;
      PG8_LDA(At, 0, 1); PG8_STAGE(PG8_SA(0, 0), a2, voffA);
      PG8_BAR; PG8_WAIT_L(0); PG8_MMA(1, 0, At, B0); PG8_BAR; PG8_SCHED;
      PG8_STAGE(PG8_SB(0, 1), b2 + hstep, voffB);
      PG8_WAIT_V(6); PG8_BAR; PG8_MMA(1, 1, At, B1); PG8_BAR;
      PG8_LDB(B0, 1, 0); PG8_SCHED; PG8_LDA(At, 1, 0); PG8_STAGE(PG8_SA(0, 1), a2 + hstep, voffA);
      PG8_WAIT_L(8); PG8_BAR; PG8_WAIT_L(0); PG8_MMA(0, 0, At, B0); PG8_BAR; PG8_SCHED;
      PG8_LDB(B1, 1, 1); PG8_STAGE(PG8_SB(1, 0), b3, voffB);
      PG8_BAR; PG8_WAIT_L(0); PG8_MMA(0, 1, At, B1); PG8_BAR;
      PG8_LDA(At, 1, 1); PG8_STAGE(PG8_SA(1, 0), a3, voffA);
      PG8_BAR; PG8_WAIT_L(0); PG8_MMA(1, 0, At, B0); PG8_BAR; PG8_SCHED;
      PG8_STAGE(PG8_SB(1, 1), b3 + hstep, voffB);
      PG8_WAIT_V(6); PG8_BAR; PG8_MMA(1, 1, At, B1); PG8_BAR;
    }
    { int fr2 = fr, fq2 = fq; asm volatile("" : "+v"(fr2), "+v"(fq2)); E(acc, cur, wr, wc, fr2, fq2); }
    if (!has_next) break;
#pragma unroll
    for (int a = 0; a < 2; ++a)
#pragma unroll
      for (int b = 0; b < 2; ++b)
#pragma unroll
        for (int m = 0; m < 4; ++m)
#pragma unroll
          for (int n = 0; n < 2; ++n) acc[a][b][m][n] = (f32x4){0.f, 0.f, 0.f, 0.f};
    cur = nxt; cA = nA; cB = nB; ++ui;
  }
  PG8_WAIT_V(0);
  if (wr == 0) PG8_BAR;
  PG8_BAR;
#undef PG8_SA
#undef PG8_SB
#undef PG8_STAGE
#undef PG8_LDA
#undef PG8_LDB
#undef PG8_MMA
#undef PG8_WAIT_V
#undef PG8_WAIT_L
#undef PG8_BAR
#undef PG8_SCHED
}
}
using pg8::Unit;
typedef f32x4 AccT[2][2][4][2];

#define EPI_ROW(ai, m) (u.pm * 256 + (ai) * 128 + wr * 64 + (m) * 16 + fr)
#define EPI_COL(bj, n) (u.pn * 256 + (bj) * 128 + wc * 32 + 8 * fq + 4 * (n))
#define EPI_LOOP_ROWS _Pragma("unroll") for (int ai = 0; ai < 2; ++ai) _Pragma("unroll") for (int m = 0; m < 4; ++m)
#define EPI_LOOP_COLS _Pragma("unroll") for (int bj = 0; bj < 2; ++bj) _Pragma("unroll") for (int n = 0; n < 2; ++n)

__device__ __forceinline__ int cond_of_row(int row) { return row < NCTX ? 0 : 1 + ((row - NCTX) >> 11); }

#define EPI_LOOP_BJ _Pragma("unroll") for (int bj = 0; bj < 2; ++bj)
__device__ __forceinline__ u32x4 pack8(const f32x4 v0, const f32x4 v1) { u32x4 w; w.x = pack2(v0[0], v0[1]); w.y = pack2(v0[2], v0[3]); w.z = pack2(v1[0], v1[1]); w.w = pack2(v1[2], v1[3]); return w; }
__device__ __forceinline__ void unpack8(const u32x4 w, f32x4& v0, f32x4& v1) { v0[0] = bflo(w.x); v0[1] = bfhi(w.x); v0[2] = bflo(w.y); v0[3] = bfhi(w.y); v1[0] = bflo(w.z); v1[1] = bfhi(w.z); v1[2] = bflo(w.w); v1[3] = bfhi(w.w); }
struct EpiQKV {
  bf16_t* O; const float* bias;
  __device__ __forceinline__ void operator()(const AccT& acc, const Unit& u, int wr, int wc, int fr, int fq) const {
    const float sc = (u.pn < 4) ? 0.0625f : 1.0f;
    f32x4 bv[2][2];
    EPI_LOOP_COLS { bv[bj][n] = *(const f32x4*)(bias + EPI_COL(bj, n)); }
    EPI_LOOP_ROWS { const int row = EPI_ROW(ai, m);
      EPI_LOOP_BJ { *(u32x4*)(O + (size_t)row * 3072 + EPI_COL(bj, 0)) = pack8((acc[ai][bj][m][0] + bv[bj][0]) * sc, (acc[ai][bj][m][1] + bv[bj][1]) * sc); } }
  }
};
struct EpiUT {
  bf16_t* O; const float* bias;
  __device__ __forceinline__ void operator()(const AccT& acc, const Unit& u, int wr, int wc, int fr, int fq) const {
    EPI_LOOP_ROWS { const int row = EPI_ROW(ai, m); const float bv = bias[row];
      EPI_LOOP_BJ { *(u32x4*)(O + (size_t)row * NTOK + EPI_COL(bj, 0)) = pack8(acc[ai][bj][m][0] + bv, acc[ai][bj][m][1] + bv); } }
  }
};
struct EpiGates {
  bf16_t* H; bf16_t* G; const float* b_in;
  __device__ __forceinline__ void operator()(const AccT& acc, const Unit& u, int wr, int wc, int fr, int fq) const {
    const bool og = u.pn < 4;
    f32x4 bv[2][2];
    EPI_LOOP_COLS { const int col = EPI_COL(bj, n); bv[bj][n] = *(const f32x4*)(b_in + (og ? 3072 + col : 7184 + (col - 1024))); }
    EPI_LOOP_ROWS { const int row = EPI_ROW(ai, m);
      u32x4 hv[2];
      if (og) { EPI_LOOP_BJ { hv[bj] = *(const u32x4*)(H + (size_t)row * 1024 + EPI_COL(bj, 0)); } }
      EPI_LOOP_BJ { const int col = EPI_COL(bj, 0); f32x4 s0, s1; const f32x4 a0 = acc[ai][bj][m][0] + bv[bj][0], a1 = acc[ai][bj][m][1] + bv[bj][1];
#pragma unroll
        for (int e = 0; e < 4; ++e) { s0[e] = sigmoidf_(a0[e]); s1[e] = sigmoidf_(a1[e]); }
        if (og) { f32x4 h0, h1; unpack8(hv[bj], h0, h1); *(u32x4*)(H + (size_t)row * 1024 + col) = pack8(h0 * s0, h1 * s1); }
        else *(u32x4*)(G + (size_t)row * 2048 + (col - 1024)) = pack8(s0, s1); } }
  }
};
template <int SECOND> struct EpiMerge {
  bf16_t* T; const bf16_t* G;
  __device__ __forceinline__ void operator()(const AccT& acc, const Unit& u, int wr, int wc, int fr, int fq) const {
    EPI_LOOP_ROWS { const int row = EPI_ROW(ai, m);
      u32x4 gv[2], tv[2];
      EPI_LOOP_BJ { const int col = EPI_COL(bj, 0); gv[bj] = *(const u32x4*)(G + (size_t)row * 2048 + SECOND * 1024 + col);
        if (SECOND) tv[bj] = *(const u32x4*)(T + (size_t)row * 1024 + col); }
      EPI_LOOP_BJ { const int col = EPI_COL(bj, 0); f32x4 g0, g1; unpack8(gv[bj], g0, g1);
        f32x4 v0 = g0 * acc[ai][bj][m][0], v1 = g1 * acc[ai][bj][m][1];
        if (SECOND) { f32x4 t0, t1; unpack8(tv[bj], t0, t1); v0 += t0; v1 += t1; }
        *(u32x4*)(T + (size_t)row * 1024 + col) = pack8(v0, v1); } }
  }
};
struct EpiOut {
  const float* xp; const float* xs; const float* per; const float* pec; const float* mod; const float* n2w; float* X1; bf16_t* A2; float* ssq;
  __device__ __forceinline__ void operator()(const AccT& acc, const Unit& u, int wr, int wc, int fr, int fq) const {
    const int cb = cond_of_row(u.pm * 256); const float* md = mod + cb * 6144; const bool smp = (u.pm * 256) >= NCTX;
    f32x4 g1v[2][2], k2v[2][2];
    EPI_LOOP_COLS { const int col = EPI_COL(bj, n); g1v[bj][n] = *(const f32x4*)(md + 2048 + col); k2v[bj][n] = *(const f32x4*)(n2w + col) * (*(const f32x4*)(md + 4096 + col) + 1.0f); }
    EPI_LOOP_ROWS { const int row = EPI_ROW(ai, m); float ss = 0.f;
#pragma unroll
      for (int bj = 0; bj < 2; ++bj) {
        f32x4 x0[2];
        if (!smp) {
#pragma unroll
          for (int n = 0; n < 2; ++n) x0[n] = *(const f32x4*)(xp + (size_t)row * 1024 + EPI_COL(bj, n)); }
        else { const int r2 = row - NCTX, t = r2 & 2047; f32x4 pe[2];
#pragma unroll
          for (int n = 0; n < 2; ++n) { const int col = EPI_COL(bj, n); x0[n] = *(const f32x4*)(xs + (size_t)r2 * 1024 + col);
            pe[n] = (col < 512) ? *(const f32x4*)(per + (t >> 6) * 512 + col) : *(const f32x4*)(pec + (t & 63) * 512 + (col - 512)); }
#pragma unroll
          for (int n = 0; n < 2; ++n) x0[n] += pe[n]; }
        f32x4 x1[2];
#pragma unroll
        for (int n = 0; n < 2; ++n) { x1[n] = x0[n] + g1v[bj][n] * acc[ai][bj][m][n]; *(f32x4*)(X1 + (size_t)row * 1024 + EPI_COL(bj, n)) = x1[n];
          ss += x1[n][0] * x1[n][0] + x1[n][1] * x1[n][1] + x1[n][2] * x1[n][2] + x1[n][3] * x1[n][3]; }
        *(u32x4*)(A2 + (size_t)row * 1024 + EPI_COL(bj, 0)) = pack8(x1[0] * k2v[bj][0], x1[1] * k2v[bj][1]); }
      ss += __shfl_xor(ss, 16); ss += __shfl_xor(ss, 32);
      if (fq == 0) ssq[(size_t)row * 16 + u.pn * 4 + wc] = ss; }
  }
};
struct EpiFF1 {
  int row0; const float* ssq; const float* c1; bf16_t* Hd;
  __device__ __forceinline__ void operator()(const AccT& acc, const Unit& u, int wr, int wc, int fr, int fq) const {
    const int cb = cond_of_row(row0 + u.pm * 256); const float* cc = c1 + cb * 4096;
    f32x4 cv[2][2];
    EPI_LOOP_COLS { cv[bj][n] = *(const f32x4*)(cc + EPI_COL(bj, n)); }
    float rs[2][4];
    EPI_LOOP_ROWS { const float* sp = ssq + (size_t)(row0 + EPI_ROW(ai, m)) * 16;
      const f32x4 st = (*(const f32x4*)sp + *(const f32x4*)(sp + 4)) + (*(const f32x4*)(sp + 8) + *(const f32x4*)(sp + 12));
      rs[ai][m] = rsqrtf((st[0] + st[1] + st[2] + st[3]) * (1.0f / 1024.0f) + 1e-6f); }
    EPI_LOOP_ROWS { const int rl = EPI_ROW(ai, m); const float rstd = rs[ai][m];
      EPI_LOOP_BJ { f32x4 v0 = acc[ai][bj][m][0] * rstd + cv[bj][0], v1 = acc[ai][bj][m][1] * rstd + cv[bj][1];
#pragma unroll
        for (int e = 0; e < 4; ++e) { const float r0 = fmaxf(v0[e], 0.f), r1 = fmaxf(v1[e], 0.f); v0[e] = r0 * r0; v1[e] = r1 * r1; }
        *(u32x4*)(Hd + (size_t)rl * 4096 + EPI_COL(bj, 0)) = pack8(v0, v1); } }
  }
};
struct EpiFF2 {
  int row0; const float* mod; const float* b2; float* X; float* ssq;
  __device__ __forceinline__ void operator()(const AccT& acc, const Unit& u, int wr, int wc, int fr, int fq) const {
    const int cb = cond_of_row(row0 + u.pm * 256); const float* md = mod + cb * 6144;
    f32x4 g2v[2][2], bbv[2][2];
    EPI_LOOP_COLS { const int col = EPI_COL(bj, n); g2v[bj][n] = *(const f32x4*)(md + 5120 + col); bbv[bj][n] = *(const f32x4*)(b2 + col); }
#pragma unroll
    for (int ai = 0; ai < 2; ++ai)
#pragma unroll
      for (int m2 = 0; m2 < 2; ++m2) {
        f32x4 xv[2][2][2];
#pragma unroll
        for (int mm = 0; mm < 2; ++mm) { const int row = row0 + EPI_ROW(ai, 2 * m2 + mm); EPI_LOOP_COLS { xv[mm][bj][n] = *(const f32x4*)(X + (size_t)row * 1024 + EPI_COL(bj, n)); } }
#pragma unroll
        for (int mm = 0; mm < 2; ++mm) { const int m = 2 * m2 + mm; const int row = row0 + EPI_ROW(ai, m); float ss = 0.f;
          EPI_LOOP_COLS { const int col = EPI_COL(bj, n);
            const f32x4 x2 = xv[mm][bj][n] + g2v[bj][n] * (acc[ai][bj][m][n] + bbv[bj][n]); *(f32x4*)(X + (size_t)row * 1024 + col) = x2;
            ss += x2[0] * x2[0] + x2[1] * x2[1] + x2[2] * x2[2] + x2[3] * x2[3]; }
          ss += __shfl_xor(ss, 16); ss += __shfl_xor(ss, 32);
          if (fq == 0) ssq[(size_t)row * 16 + u.pn * 4 + wc] = ss; } }
  }
};

template <class Epi> __device__ __forceinline__ void run_gemm(LP lds, const bf16_t* A, const bf16_t* Bt, int M, int N, int K, const Epi& E) {
  pg8::Gemm g; g.A = A; g.Bt = Bt; g.M = M; g.N = N; g.K = K;
  pg8::StaticOrder S; S.init(M, N, (int)gridDim.x, (int)blockIdx.x);
  pg8::gemm_phase<Epi>(lds, g, S, E);
}

__device__ void transpose_tile(const float* __restrict__ src, int ld, int col0, int k0, bf16_t* __restrict__ dst, int K, int drow0, LAS float* tile) {
  const int t = opaque_tid();
  f32x4 v[4];
#pragma unroll
  for (int i = 0; i < 4; ++i) { const int idx = t + 512 * i, kr = idx >> 5, c4 = idx & 31; v[i] = *(const f32x4*)(src + (size_t)(k0 + kr) * ld + col0 + 4 * c4); }
#pragma unroll
  for (int i = 0; i < 4; ++i) { const int idx = t + 512 * i, kr = idx >> 5, c4 = idx & 31; LAS float* tp = tile + kr * 129 + 4 * c4; tp[0] = v[i][0]; tp[1] = v[i][1]; tp[2] = v[i][2]; tp[3] = v[i][3]; }
  __syncthreads();
  const int kb = t & 7;
#pragma unroll
  for (int i = 0; i < 2; ++i) { const int c = (t >> 3) + 64 * i; const LAS float* tp = tile + (kb * 8) * 129 + c; u32x4 o;
    o.x = pack2(tp[0], tp[129]); o.y = pack2(tp[2 * 129], tp[3 * 129]); o.z = pack2(tp[4 * 129], tp[5 * 129]); o.w = pack2(tp[6 * 129], tp[7 * 129]);
    *(u32x4*)(dst + (size_t)(drow0 + c) * K + k0 + kb * 8) = o; }
  __syncthreads();
}
template <int SILU> __device__ void matvec9_unit(const float* v0, const float* v1, int v1stride, const float* __restrict__ W, int ldw, const float* bias, float* out, int ldo, int col0, LAS float* lf) {
  const int t = opaque_tid(), lane = t & 63, wid = t >> 6;
  LAS float* sv = lf; LAS float* red = lf + 9216;
  for (int i = t; i < 9216; i += 512) { const int b = i >> 10, k = i & 1023; float x = (b == 0) ? v0[k] : v1[(size_t)(b - 1) * v1stride + k]; if (SILU) x = x / (1.0f + __expf(-x)); sv[i] = x; }
  __syncthreads();
  const int c4 = t & 7, kl = t >> 3;
  f32x4 w[16];
#pragma unroll
  for (int i = 0; i < 16; ++i) w[i] = *(const f32x4*)(W + (size_t)(kl + 64 * i) * ldw + col0 + 4 * c4);
  f32x4 acc[9];
#pragma unroll
  for (int b = 0; b < 9; ++b) acc[b] = (f32x4){0.f, 0.f, 0.f, 0.f};
#pragma unroll
  for (int i = 0; i < 16; ++i)
#pragma unroll
    for (int b = 0; b < 9; ++b) acc[b] += w[i] * sv[b * 1024 + kl + 64 * i];
#pragma unroll
  for (int b = 0; b < 9; ++b)
#pragma unroll
    for (int e = 0; e < 4; ++e) { float x = acc[b][e]; x += __shfl_xor(x, 8); x += __shfl_xor(x, 16); x += __shfl_xor(x, 32); acc[b][e] = x; }
  if (lane < 8) {
#pragma unroll
    for (int b = 0; b < 9; ++b) *(LAS f32x4*)(red + (wid * 9 + b) * 32 + 4 * lane) = acc[b]; }
  __syncthreads();
  if (t < 288) { const int b = t >> 5, cc = t & 31; float s = bias[col0 + cc];
#pragma unroll
    for (int pz = 0; pz < 8; ++pz) s += red[(pz * 9 + b) * 32 + cc];
    out[(size_t)b * ldo + col0 + cc] = s; }
  __syncthreads();
}

__device__ void phase0(const Params& p, LP lds) {
  unsigned char* ws = p.ws; LAS float* lf = (LAS float*)lds;
  const int tid0 = opaque_tid(); const int wid = tid0 >> 6, lane = tid0 & 63;
  for (int unit = blockIdx.x; unit < 576; unit += gridDim.x) {
    if (unit < 192) {
      matvec9_unit<1>(p.in[6], p.in[5], 1024, p.in[7], 6144, p.in[8], (float*)(ws + OFF_MOD), 6144, unit * 32, lf);
    } else if (unit < 480) {
      const int row = (unit - 192) * 8 + wid; const bool smp = row < 2048; const int L = smp ? 2048 : 256, t = smp ? row : row - 2048;
      const float* w1 = p.in[14]; const float* b1 = p.in[15]; const float* fr1 = p.in[16]; const float* w2 = p.in[17]; const float* b2 = p.in[18]; const float* fr2 = p.in[19];
      float a = b1[lane] + (float)t / (float)(L - 1) * w1[lane];
      const float base = (6.283185307179586f / (float)L) * (float)t;
      float cs = 0.f, sn = 0.f; if (lane < 16) { const float ang = base * (float)(lane + 1); cs = cosf(ang); sn = sinf(ang); }
#pragma unroll
      for (int i = 0; i < 16; ++i) a += __shfl(cs, i) * w1[(1 + i) * 64 + lane] + __shfl(sn, i) * w1[(17 + i) * 64 + lane];
      const float h1 = sinf(fr1[lane] * a);
      float a2 = b2[lane];
#pragma unroll 16
      for (int j = 0; j < 64; ++j) a2 += __shfl(h1, j) * w2[j * 64 + lane];
      const float h2 = sinf(fr2[lane] * a2);
      float* dst = (float*)(ws + (smp ? OFF_H2S : OFF_H2C)); dst[(size_t)t * 64 + lane] = h2;
    } else {
      const int r = unit - 480, c = tid0; const int pos = r < 32 ? r : r - 32; const int i = c & 255;
      const float omega = 1.0f / powf(10000.0f, (float)i / 256.0f); const float a = (float)pos * omega; const float v = c < 256 ? sinf(a) : cosf(a);
      float* dst = (float*)(ws + (r < 32 ? OFF_PER : OFF_PEC)); dst[(size_t)pos * 512 + c] = v;
    }
  }
}
__device__ void weight_tiles(const Params& p, LP lds) {
  unsigned char* ws = p.ws; LAS float* lf = (LAS float*)lds;
  for (int tu = blockIdx.x; tu < 2560; tu += gridDim.x) {
    const float* src; int ld, K, col0, k0, drow0; bf16_t* dst;
    if (tu < 1152) { const int nt = tu >> 4, kt = tu & 15; const int r = nt * 128; src = p.in[10]; ld = INC; K = 1024; k0 = kt * 64; drow0 = r; dst = (bf16_t*)(ws + OFF_WT);
      col0 = r < 3072 ? r : (r < 6144 ? 4112 + (r - 3072) : (r < 7168 ? 3072 + (r - 6144) : 7184 + (r - 7168))); }
    else if (tu < 1536) { const int v = tu - 1152, w = v >> 7, q = v & 127; src = p.in[23 + w]; ld = 1024; K = 1024; k0 = (q & 15) * 64; col0 = (q >> 4) * 128; drow0 = col0; dst = (bf16_t*)(ws + (w == 0 ? OFF_WBM : (w == 1 ? OFF_WBH : OFF_WOUT))); }
    else if (tu < 2048) { const int q = tu - 1536; src = p.in[27]; ld = 4096; K = 1024; k0 = (q & 15) * 64; col0 = (q >> 4) * 128; drow0 = col0; dst = (bf16_t*)(ws + OFF_W1T); }
    else { const int q = tu - 2048; src = p.in[29]; ld = 1024; K = 4096; k0 = (q & 63) * 64; col0 = (q >> 6) * 128; drow0 = col0; dst = (bf16_t*)(ws + OFF_W2T); }
    transpose_tile(src, ld, col0, k0, dst, K, drow0, lf);
  }
}

__device__ void phase1(const Params& p, LP lds) {
  unsigned char* ws = p.ws;
  int tid_ = threadIdx.x; asm volatile("" : "+v"(tid_));
  const int tid = tid_, wid = tid >> 6, lane = tid & 63;
  const float* mod = (const float*)(ws + OFF_MOD);
  LAS float* wg = (LAS float*)lds;
  if ((int)blockIdx.x < 1536) {
    f32x4 gw[8];
#pragma unroll
    for (int i = 0; i < 8; ++i) { const int idx = tid + 512 * i, k = idx >> 2, q = idx & 3; gw[i] = *(const f32x4*)(p.in[10] + (size_t)k * INC + 4096 + 4 * q); }
#pragma unroll
    for (int i = 0; i < 8; ++i) { const int idx = tid + 512 * i, k = idx >> 2, q = idx & 3; wg[(4 * q) * 1024 + k] = gw[i][0]; wg[(4 * q + 1) * 1024 + k] = gw[i][1]; wg[(4 * q + 2) * 1024 + k] = gw[i][2]; wg[(4 * q + 3) * 1024 + k] = gw[i][3]; }
    __syncthreads();
  }
  for (int unit = blockIdx.x; unit < 1536; unit += gridDim.x) {
    const int tidn = opaque_tid(); const int wid = tidn >> 6, lane = tidn & 63;
    const int row0 = unit * 16 + wid * 2; const int cb = cond_of_row(row0); const float* md = mod + cb * 6144; const bool smp = row0 >= NCTX;
    f32x4 v[2][4]; float rstd[2];
#pragma unroll
    for (int r = 0; r < 2; ++r) { const int row = row0 + r; const float* xr; int t = 0;
      if (!smp) xr = p.in[0] + (size_t)row * 1024; else { xr = p.in[1] + (size_t)(row - NCTX) * 1024; t = (row - NCTX) & 2047; }
      const float* per = (const float*)(ws + OFF_PER) + (t >> 6) * 512; const float* pec = (const float*)(ws + OFF_PEC) + (t & 63) * 512;
      float ss = 0.f;
#pragma unroll
      for (int i = 0; i < 4; ++i) { const int col = 4 * lane + 256 * i; v[r][i] = *(const f32x4*)(xr + col);
        if (smp) v[r][i] += (col < 512) ? *(const f32x4*)(per + col) : *(const f32x4*)(pec + col - 512);
        ss += v[r][i][0] * v[r][i][0] + v[r][i][1] * v[r][i][1] + v[r][i][2] * v[r][i][2] + v[r][i][3] * v[r][i][3]; }
      ss = wave_sum(ss); rstd[r] = rsqrtf(ss * (1.0f / 1024.0f) + 1e-6f); }
    const float* n1w = p.in[9];
    float ga[32];
#pragma unroll
    for (int g = 0; g < 32; ++g) ga[g] = 0.f;
#pragma unroll
    for (int i = 0; i < 4; ++i) { const int col = 4 * lane + 256 * i;
      const f32x4 w = *(const f32x4*)(n1w + col), sc = *(const f32x4*)(md + 1024 + col), sh = *(const f32x4*)(md + col);
      const f32x4 ws1 = w * (sc + 1.0f);
      f32x4 h[2];
#pragma unroll
      for (int r = 0; r < 2; ++r) { h[r] = v[r][i] * rstd[r] * ws1 + sh;
        u32x2 o; o.x = pack2(h[r][0], h[r][1]); o.y = pack2(h[r][2], h[r][3]); *(u32x2*)((bf16_t*)(ws + OFF_HN) + (size_t)(row0 + r) * 1024 + col) = o; }
#pragma unroll
      for (int g = 0; g < 16; ++g) { const f32x4 wv = *(const LAS f32x4*)(wg + g * 1024 + col);
#pragma unroll
        for (int r = 0; r < 2; ++r) ga[r * 16 + g] += h[r][0] * wv[0] + h[r][1] * wv[1] + h[r][2] * wv[2] + h[r][3] * wv[3]; }
      asm volatile("" ::: "memory"); }
#pragma unroll
    for (int off = 16; off >= 1; off >>= 1) { const bool hi = (lane & off) != 0;
#pragma unroll
      for (int i = 0; i < off; ++i) { const float send = hi ? ga[i] : ga[i + off]; const float keep = hi ? ga[i + off] : ga[i]; ga[i] = keep + __shfl_xor(send, off); } }
    const float tot = ga[0] + __shfl_xor(ga[0], 32);
    if (lane < 32) ((float*)(ws + OFF_GT))[(size_t)row0 * 16 + lane] = tot + p.in[11][4096 + (lane & 15)];
  }
  __syncthreads();
  LAS float* w3s = (LAS float*)lds;
  for (int v = blockIdx.x; v < 320; v += gridDim.x) {
    const int tid = opaque_tid();
    const bool smp = v < 256; const int L = smp ? 2048 : 256; const int tt = smp ? (v >> 6) : 0, cgp = v & 63; const int t = tt * 512 + tid;
    { const f32x4 x = *(const f32x4*)(p.in[20] + (size_t)(tid >> 3) * 2048 + cgp * 32 + 4 * (tid & 7)); LAS float* wp = w3s + (4 * (tid & 7)) * 64 + (tid >> 3);
      wp[0] = x[0]; wp[64] = x[1]; wp[128] = x[2]; wp[192] = x[3]; }
    __syncthreads();
    if (t < L) {
      const float* H2 = (const float*)(ws + (smp ? OFF_H2S : OFF_H2C)) + (size_t)t * 64;
      f32x4 h2[16];
#pragma unroll
      for (int i = 0; i < 16; ++i) h2[i] = *(const f32x4*)(H2 + 4 * i);
      const float dist = fabsf((float)t - (float)(L / 2)) / (float)(L / 2);
      float* HF = (float*)(ws + (smp ? OFF_HFS : OFF_HFC)) + (size_t)(cgp * 32) * L + t;
#pragma unroll 1
      for (int j = 0; j < 32; ++j) {
        f32x4 a = {0.f, 0.f, 0.f, 0.f};
#pragma unroll
        for (int i = 0; i < 16; ++i) a += *(const LAS f32x4*)(w3s + j * 64 + 4 * i) * h2[i];
        const int c = (cgp * 32 + j) & 1023;
        const float dmin = -3.0701134573253946f, dmax = -15.350567286626973f;
        const float delta = fabsf(dmin + (dmax - dmin) * ((float)c / 1023.0f));
        HF[(size_t)j * L] = ((a[0] + a[1]) + (a[2] + a[3])) * __expf(-dist * delta); }
    }
    __syncthreads();
  }
  for (int u = (int)gridDim.x - 1 - (int)blockIdx.x; u < 128; u += gridDim.x)
    matvec9_unit<0>(mod + 3072, mod + 6144 + 3072, 6144, p.in[27], 4096, p.in[28], (float*)(ws + OFF_C1), 4096, u * 32, (LAS float*)lds);
}

__device__ __forceinline__ bf16x8 tr_frag(LP base, int k0, int m0, int pitch  , int l15, int g) {
  const int q = l15 >> 2, pp = l15 & 3;
  LP a = base + ((k0 + 8 * g + q) * pitch + m0 + 4 * pp) * 2;
  const s16x4 lo = __builtin_amdgcn_ds_read_tr16_b64_v4i16((LAS s16x4*)a);
  const s16x4 hi = __builtin_amdgcn_ds_read_tr16_b64_v4i16((LAS s16x4*)(a + 8 * pitch));
  bf16x8 r; r[0] = lo[0]; r[1] = lo[1]; r[2] = lo[2]; r[3] = lo[3]; r[4] = hi[0]; r[5] = hi[1]; r[6] = hi[2]; r[7] = hi[3]; return r;
}
__device__ __forceinline__ bf16x8 tr_at(LP lanebase, int coff  , int pitch_bytes) {
  const s16x4 lo = __builtin_amdgcn_ds_read_tr16_b64_v4i16((LAS s16x4*)(lanebase + coff));
  const s16x4 hi = __builtin_amdgcn_ds_read_tr16_b64_v4i16((LAS s16x4*)(lanebase + coff + 4 * pitch_bytes));
  bf16x8 r; r[0] = lo[0]; r[1] = lo[1]; r[2] = lo[2]; r[3] = lo[3]; r[4] = hi[0]; r[5] = hi[1]; r[6] = hi[2]; r[7] = hi[3]; return r;
}
constexpr int ML_K = 0, ML_V = 67584, ML_P = 86016, ML_C = 120832, ML_T = 157696, ML_TSZ = 1600;
constexpr int KP = 264, VP = 72, PP = 136, CP = 72;

__device__ void mlstm_item(const Params& p, LP lds, int item) {
  const int tid = opaque_tid(), wid = __builtin_amdgcn_readfirstlane(tid >> 6), lane = tid & 63, l15 = lane & 15, g = lane >> 4;
  const bool smp = item < 256; const int uu = smp ? (item >> 2) : ((item - 256) >> 2); const int sl = item & 3;
  const int b = uu >> 3, dir = (uu >> 2) & 1, head = uu & 3;
  const int S = smp ? SEQS : SEQC, nc = S >> 7; const int tok0 = smp ? NCTX + b * SEQS : b * SEQC;
  const bf16_t* qkv = (const bf16_t*)(p.ws + OFF_BIG);
  const float* GT = (const float*)(p.ws + OFF_GT);
  bf16_t* hout = (bf16_t*)((unsigned char*)p.out + (dir ? OUT_HB : OUT_H));
  const int sidx = (b * 2 + dir) * 4 + head;
  const int gi_col = dir * 8 + head, gf_col = dir * 8 + 4 + head;
  f32x4 Cacc[2][4], nacc[2]; float mst0;
  if (smp) {
    const float* C0 = p.in[2] + (size_t)sidx * 65536;
#pragma unroll
    for (int dt = 0; dt < 2; ++dt) {
#pragma unroll
      for (int vt = 0; vt < 4; ++vt) Cacc[dt][vt] = *(const f32x4*)(C0 + (size_t)((2 * wid + dt) * 16 + l15) * 256 + sl * 64 + 16 * vt + 4 * g);
      nacc[dt] = (f32x4){p.in[3][sidx * 256 + (2 * wid + dt) * 16 + l15], 0.f, 0.f, 0.f}; }
    mst0 = p.in[4][sidx];
  } else {
#pragma unroll
    for (int dt = 0; dt < 2; ++dt) {
#pragma unroll
      for (int vt = 0; vt < 4; ++vt) Cacc[dt][vt] = (f32x4){0.f, 0.f, 0.f, 0.f};
      nacc[dt] = (f32x4){0.f, 0.f, 0.f, 0.f}; }
    mst0 = 0.f;
  }
#define TOKC(cc, j) (dir ? (tok0 + S - 1 - ((cc) * 128 + (j))) : (tok0 + (cc) * 128 + (j)))
  const int rt = (wid < 4) ? wid : 11 - wid;
  const int jrow = 16 * rt + l15;
  bf16x8 qf[8]; u32x4 kreg[8], vreg[2]; float g4[4] = {0.f, 0.f, 0.f, 0.f};
#define ML_LOAD_Q(cc) do { const bf16_t* qp = qkv + (size_t)TOKC(cc, jrow) * 3072 + head * 256 + 8 * g; \
    _Pragma("unroll") for (int kk = 0; kk < 8; ++kk) qf[kk] = *(const bf16x8*)(qp + 32 * kk); } while (0)
#define ML_LOAD_KV(cc) do { \
    _Pragma("unroll") for (int i = 0; i < 8; ++i) { const int row = (tid >> 5) + 16 * i; kreg[i] = *(const u32x4*)(qkv + (size_t)TOKC(cc, row) * 3072 + 1024 + head * 256 + (tid & 31) * 8); } \
    _Pragma("unroll") for (int i = 0; i < 2; ++i) { const int row = (tid >> 3) + 64 * i; vreg[i] = *(const u32x4*)(qkv + (size_t)TOKC(cc, row) * 3072 + 2048 + head * 256 + sl * 64 + (tid & 7) * 8); } \
    if (wid == 0) { const float* g0 = GT + (size_t)TOKC(cc, 2 * lane) * 16; const float* g1 = GT + (size_t)TOKC(cc, 2 * lane + 1) * 16; g4[0] = g0[gi_col]; g4[1] = g0[gf_col]; g4[2] = g1[gi_col]; g4[3] = g1[gf_col]; } } while (0)
#define ML_SCAN(tabp, mcur, mnext) do { LAS float* T_ = (LAS float*)(tabp); \
    const float lf0 = fminf(g4[1], 0.f) - log1pf(__expf(-fabsf(g4[1]))), lf1 = fminf(g4[3], 0.f) - log1pf(__expf(-fabsf(g4[3]))); \
    float s_ = lf0 + lf1; \
    _Pragma("unroll") for (int o = 1; o < 64; o <<= 1) { const float t_ = __shfl_up(s_, o); if (lane >= o) s_ += t_; } \
    const float b1_ = s_, b0_ = s_ - lf1; const float u0_ = g4[0] - b0_, u1_ = g4[2] - b1_; \
    float mx_ = fmaxf(u0_, u1_); \
    _Pragma("unroll") for (int o = 1; o < 64; o <<= 1) { const float t_ = __shfl_up(mx_, o); if (lane >= o) mx_ = fmaxf(mx_, t_); } \
    float ex_ = __shfl_up(mx_, 1); if (lane == 0) ex_ = -INFINITY; \
    const float M0_ = fmaxf(mcur, fmaxf(ex_, u0_)), M1_ = fmaxf(mcur, mx_); \
    T_[2 * lane] = u0_; T_[2 * lane + 1] = u1_; T_[128 + 2 * lane] = M0_; T_[128 + 2 * lane + 1] = M1_; T_[256 + 2 * lane] = b0_; T_[256 + 2 * lane + 1] = b1_; \
    const float Ml_ = __shfl(M1_, 63), bl_ = __shfl(b1_, 63); \
    if (lane == 0) { T_[384] = mcur; T_[385] = Ml_; } \
    mnext = bl_ + Ml_; } while (0)
  float mw0 = mst0;
  ML_LOAD_Q(0); ML_LOAD_KV(0);
  if (wid == 0) { float mn; ML_SCAN(lds + ML_T, mw0, mn); mw0 = mn; }
  __syncthreads();
  float m_final = 0.f;
  for (int c = 0; c < nc; ++c) {
    LAS float* T = (LAS float*)(lds + ML_T + (c & 1) * ML_TSZ);
    const float mst = T[384], M_last = T[385];
#pragma unroll
    for (int i = 0; i < 8; ++i) { const int row = (tid >> 5) + 16 * i; *(LAS u32x4*)(lds + ML_K + (row * KP + (tid & 31) * 8) * 2) = kreg[i]; }
#pragma unroll
    for (int i = 0; i < 2; ++i) { const int row = (tid >> 3) + 64 * i; const float w = __expf(T[row] - M_last); const u32x4 v = vreg[i]; u32x4 o;
      o.x = pack2(bflo(v.x) * w, bfhi(v.x) * w); o.y = pack2(bflo(v.y) * w, bfhi(v.y) * w); o.z = pack2(bflo(v.z) * w, bfhi(v.z) * w); o.w = pack2(bflo(v.w) * w, bfhi(v.w) * w);
      *(LAS u32x4*)(lds + ML_V + (row * VP + (tid & 7) * 8) * 2) = o; }
    if (tid < 128) *(LAS unsigned short*)(lds + ML_V + (tid * VP + 64) * 2) = f2bf(__expf(T[tid] - M_last));
#pragma unroll
    for (int dt = 0; dt < 2; ++dt) {
#pragma unroll
      for (int vt = 0; vt < 4; ++vt) { u32x2 w; w.x = pack2(Cacc[dt][vt][0], Cacc[dt][vt][1]); w.y = pack2(Cacc[dt][vt][2], Cacc[dt][vt][3]);
        *(LAS u32x2*)(lds + ML_C + (((2 * wid + dt) * 16 + l15) * CP + 16 * vt + 4 * g) * 2) = w; }
      if (g == 0) *(LAS unsigned short*)(lds + ML_C + (((2 * wid + dt) * 16 + l15) * CP + 64) * 2) = f2bf(nacc[dt][0]); }
    const int qtok = TOKC(c, jrow);
    const bool more = (c + 1 < nc);
    __syncthreads();
    const float Mj = T[128 + jrow], bj = T[256 + jrow]; const float rf = __expf(M_last - Mj), w_inter = __expf(mst - Mj);
    int lq_ = (8 * g + (l15 >> 2)), lp_ = 4 * (l15 & 3); asm volatile("" : "+v"(lq_), "+v"(lp_));
    const LP cB = lds + ML_C + (lq_ * CP + lp_) * 2, vB = lds + ML_V + (lq_ * VP + lp_) * 2, kB = lds + ML_K + (lq_ * KP + lp_ + 32 * wid) * 2;
    const LP pB = lds + ML_P + (jrow * PP + 8 * g) * 2;
    for (int st = 0; st <= rt; ++st) {
      f32x4 s = {0.f, 0.f, 0.f, 0.f};
      bf16x8 kfr[8];
#pragma unroll
      for (int kk = 0; kk < 8; ++kk) kfr[kk] = *(const LAS bf16x8*)(lds + ML_K + ((16 * st + l15) * KP + 32 * kk + 8 * g) * 2);
      __builtin_amdgcn_sched_barrier(0);
#pragma unroll
      for (int kk = 0; kk < 8; ++kk) s = __builtin_amdgcn_mfma_f32_16x16x32_bf16(kfr[kk], qf[kk], s, 0, 0, 0);
      float pv[4];
#pragma unroll
      for (int i = 0; i < 4; ++i) pv[i] = ((16 * st + 4 * g + i) <= jrow) ? s[i] * rf : 0.f;
      u32x2 w; w.x = pack2(pv[0], pv[1]); w.y = pack2(pv[2], pv[3]);
      *(LAS u32x2*)(lds + ML_P + (jrow * PP + 16 * st + 4 * g) * 2) = w;
    }
    if ((rt & 1) == 0) { u32x2 z; z.x = 0u; z.y = 0u; *(LAS u32x2*)(lds + ML_P + (jrow * PP + 16 * (rt + 1) + 4 * g) * 2) = z; }
    if (more) ML_LOAD_KV(c + 1);
    asm volatile("s_waitcnt lgkmcnt(0)" ::: "memory");
    f32x4 ha[5];
#pragma unroll
    for (int vt = 0; vt < 5; ++vt) { f32x4 a = {0.f, 0.f, 0.f, 0.f};
      if (smp || c > 0) {
        bf16x8 cfr[8];
#pragma unroll
        for (int kk = 0; kk < 8; ++kk) cfr[kk] = tr_at(cB, (32 * kk * CP + 16 * vt) * 2, CP * 2);
        __builtin_amdgcn_sched_barrier(0);
#pragma unroll
        for (int kk = 0; kk < 8; ++kk) a = __builtin_amdgcn_mfma_f32_16x16x32_bf16(cfr[kk], qf[kk], a, 0, 0, 0);
        a *= w_inter; }
      ha[vt] = a; }
    for (int k2 = 0; k2 <= (rt >> 1); ++k2) {
      const bf16x8 pf = *(const LAS bf16x8*)(pB + k2 * 64);
      bf16x8 vfr[5];
#pragma unroll
      for (int vt = 0; vt < 5; ++vt) vfr[vt] = tr_at(vB + k2 * (32 * VP * 2), (16 * vt) * 2, VP * 2);
      __builtin_amdgcn_sched_barrier(0);
#pragma unroll
      for (int vt = 0; vt < 5; ++vt) ha[vt] = __builtin_amdgcn_mfma_f32_16x16x32_bf16(vfr[vt], pf, ha[vt], 0, 0, 0); }
    { const float den = __shfl(ha[4][0], l15); const float rdd = 1.0f / fmaxf(fabsf(den), __expf(-(bj + Mj)));
#pragma unroll
      for (int vt = 0; vt < 4; ++vt) { const f32x4 a = ha[vt] * rdd; u32x2 w; w.x = pack2(a[0], a[1]); w.y = pack2(a[2], a[3]);
        *(u32x2*)(hout + (size_t)qtok * 1024 + head * 256 + sl * 64 + 16 * vt + 4 * g) = w; } }
    if (more) ML_LOAD_Q(c + 1);
    const bool need_state = (!smp) || more;
    if (need_state) {
      const float decay = __expf(mst - M_last);
#pragma unroll
      for (int dt = 0; dt < 2; ++dt) {
#pragma unroll
        for (int vt = 0; vt < 4; ++vt) Cacc[dt][vt] *= decay;
        nacc[dt] *= decay; }
#pragma unroll
      for (int ks = 0; ks < 4; ++ks) {
        const bf16x8 kf0 = tr_at(kB, (32 * ks * KP) * 2, KP * 2), kf1 = tr_at(kB, (32 * ks * KP + 16) * 2, KP * 2);
        bf16x8 vfr[5];
#pragma unroll
        for (int vt = 0; vt < 5; ++vt) vfr[vt] = tr_at(vB, (32 * ks * VP + 16 * vt) * 2, VP * 2);
        __builtin_amdgcn_sched_barrier(0);
#pragma unroll
        for (int vt = 0; vt < 4; ++vt) { Cacc[0][vt] = __builtin_amdgcn_mfma_f32_16x16x32_bf16(vfr[vt], kf0, Cacc[0][vt], 0, 0, 0); Cacc[1][vt] = __builtin_amdgcn_mfma_f32_16x16x32_bf16(vfr[vt], kf1, Cacc[1][vt], 0, 0, 0); }
        nacc[0] = __builtin_amdgcn_mfma_f32_16x16x32_bf16(vfr[4], kf0, nacc[0], 0, 0, 0); nacc[1] = __builtin_amdgcn_mfma_f32_16x16x32_bf16(vfr[4], kf1, nacc[1], 0, 0, 0);
      }
    }
    if (wid == 0 && more) { float mn; ML_SCAN(lds + ML_T + ((c + 1) & 1) * ML_TSZ, mw0, mn); mw0 = mn; }
    m_final = T[256 + 127] + M_last;
    __syncthreads();
  }
#undef ML_LOAD_Q
#undef ML_LOAD_KV
#undef ML_SCAN
#undef TOKC
  if (!smp) {
    float* oC = p.out + OUTF_C + (size_t)sidx * 65536;
#pragma unroll
    for (int dt = 0; dt < 2; ++dt) {
#pragma unroll
      for (int vt = 0; vt < 4; ++vt) *(f32x4*)(oC + (size_t)((2 * wid + dt) * 16 + l15) * 256 + sl * 64 + 16 * vt + 4 * g) = Cacc[dt][vt];
      if (sl == 0 && g == 0) p.out[OUTF_N + (size_t)sidx * 256 + (2 * wid + dt) * 16 + l15] = nacc[dt][0]; }
    if (sl == 0 && tid == 0) p.out[OUTF_M + sidx] = m_final;
  }
}

__device__ void combine_rows(const Params& p) {
  const int tid0 = opaque_tid(); const int wid = tid0 >> 6, lane = tid0 & 63;
  bf16_t* H = (bf16_t*)((unsigned char*)p.out + OUT_H); const bf16_t* HB = (const bf16_t*)((unsigned char*)p.out + OUT_HB); const float* nw = p.in[22];
  f32x4 wv[4];
#pragma unroll
  for (int i = 0; i < 4; ++i) wv[i] = *(const f32x4*)(nw + 16 * lane + 4 * i);
  for (int unit = blockIdx.x; unit < 768; unit += gridDim.x) {
    const int row0 = unit * 32 + wid * 4;
    u32x4 a[4][2], bq[4][2];
#pragma unroll
    for (int r = 0; r < 4; ++r)
#pragma unroll
      for (int i = 0; i < 2; ++i) { a[r][i] = *(const u32x4*)(H + (size_t)(row0 + r) * 1024 + 16 * lane + 8 * i); bq[r][i] = *(const u32x4*)(HB + (size_t)(row0 + r) * 1024 + 16 * lane + 8 * i); }
#pragma unroll
    for (int r = 0; r < 4; ++r) {
      f32x4 v[4]; float ss = 0.f;
#pragma unroll
      for (int i = 0; i < 2; ++i) { f32x4 x0, x1, y0, y1; unpack8(a[r][i], x0, x1); unpack8(bq[r][i], y0, y1); v[2 * i] = x0 + y0; v[2 * i + 1] = x1 + y1; }
#pragma unroll
      for (int i = 0; i < 4; ++i) ss += v[i][0] * v[i][0] + v[i][1] * v[i][1] + v[i][2] * v[i][2] + v[i][3] * v[i][3];
      ss += __shfl_xor(ss, 1); ss += __shfl_xor(ss, 2); ss += __shfl_xor(ss, 4); ss += __shfl_xor(ss, 8);
      const float rr = rsqrtf(ss * (1.0f / 256.0f) + 1e-6f);
#pragma unroll
      for (int i = 0; i < 2; ++i) *(u32x4*)(H + (size_t)(row0 + r) * 1024 + 16 * lane + 8 * i) = pack8(v[2 * i] * rr * wv[2 * i], v[2 * i + 1] * rr * wv[2 * i + 1]);
    }
  }
}

constexpr int HY_WAVE = 18816, HY_HR = 0, HY_ZA = 8576, HY_ZB = 8576 + 5120;
__device__ void hyena_item(const Params& p, LP lds, int item) {
  const int tid = opaque_tid(), wid = __builtin_amdgcn_readfirstlane(tid >> 6), lane = tid & 63, n31 = lane & 31, hh = lane >> 5;
  const bool smp = item < 1024; const int it = smp ? item : item - 1024; const int bset = it >> 7, cgp = it & 127; const int c = cgp * 8 + wid;
  const int L = smp ? 2048 : 256, lgL = smp ? 11 : 8, nblk = L >> 5, lgnb = lgL - 5, ntok = smp ? 2048 : 1024, ntile = smp ? 2 : 1, dmax = L >> 6;
  const int tok0 = smp ? NCTX + bset * 2048 : bset * 1024;
  LP wl = lds + wid * HY_WAVE; LAS float* hr = (LAS float*)(wl + HY_HR);
  const float* HFp = (const float*)(p.ws + (smp ? OFF_HFS : OFF_HFC));
  const bf16_t* UT = (const bf16_t*)(p.ws + OFF_BIG);
  const float* cw = p.in[12]; const float* cbv = p.in[13]; const float* skp = p.in[21];
  { const int uc = 2048 + c; const float w0 = cw[uc], w1 = cw[3072 + uc], w2 = cw[6144 + uc], cb = cbv[uc]; const bf16_t* src = UT + (size_t)uc * NTOK + tok0;
    u32x4 vv[4]; float pvv[4], nxv[4];
#pragma unroll
    for (int i = 0; i < 4; ++i) { const int base = lane * 8 + 512 * i; vv[i] = (u32x4){0u, 0u, 0u, 0u}; pvv[i] = 0.f; nxv[i] = 0.f;
      if (base < ntok) { vv[i] = *(const u32x4*)(src + base); const int tl = base & (L - 1);
        if (tl != 0) pvv[i] = bf2f(src[base - 1]); if (tl + 8 != L) nxv[i] = bf2f(src[base + 8]); } }
#pragma unroll
    for (int i = 0; i < 4; ++i) { const int base = lane * 8 + 512 * i;
      if (base < ntok) { const u32x4 v = vv[i];
        float u[10]; u[0] = pvv[i]; u[1] = bflo(v.x); u[2] = bfhi(v.x); u[3] = bflo(v.y); u[4] = bfhi(v.y); u[5] = bflo(v.z); u[6] = bfhi(v.z); u[7] = bflo(v.w); u[8] = bfhi(v.w); u[9] = nxv[i];
        float o[8];
#pragma unroll
        for (int e = 0; e < 8; ++e) o[e] = cb + w0 * u[e] + w1 * u[e + 1] + w2 * u[e + 2];
        u32x4 w; w.x = pack2(o[0], o[1]); w.y = pack2(o[2], o[3]); w.z = pack2(o[4], o[5]); w.w = pack2(o[6], o[7]);
        *(LAS u32x4*)(wl + HY_ZA + ((base >> 5) * 40 + (base & 31)) * 2) = w; } } }
  const int HRP = L + 96;
  f32x4 fvN[8];
#define HY_FLOAD(o) do { const float* src_ = HFp + (size_t)((o) * 1024 + c) * L; \
    _Pragma("unroll") for (int i = 0; i < 8; ++i) { const int q = lane + 64 * i; fvN[i] = (4 * q < L) ? *(const f32x4*)(src_ + 4 * q) : (f32x4){0.f, 0.f, 0.f, 0.f}; } } while (0)
  HY_FLOAD(0);
  for (int ord = 0; ord < 2; ++ord) {
    { float sa = 0.f;
      f32x4 fv[8];
#pragma unroll
      for (int i = 0; i < 8; ++i) fv[i] = fvN[i];
#pragma unroll
      for (int i = 0; i < 8; ++i) sa += (fabsf(fv[i][0]) + fabsf(fv[i][1])) + (fabsf(fv[i][2]) + fabsf(fv[i][3]));
      sa = wave_sum(sa); const float inv = 1.0f / (sa + 1e-6f);
      asm volatile("s_waitcnt lgkmcnt(0)" ::: "memory");
      LAS bf16_t* E = (LAS bf16_t*)hr; LAS bf16_t* O = E + HRP;
#pragma unroll
      for (int i = 0; i < 8; ++i) { const int q = lane + 64 * i;
        if (4 * q < L) {
#pragma unroll
          for (int e = 0; e < 4; ++e) { const int yy = L - 1 - (4 * q + e); const bf16_t v = f2bf(fv[i][e] * inv); E[32 + yy] = v; O[31 + yy] = v; } } }
      if (lane < 32) { E[lane] = 0; E[32 + L + lane] = 0; O[31 + L + lane] = 0; if (lane < 31) O[lane] = 0; }
      if (lane < 33) O[HRP - 33 + lane] = 0;
      asm volatile("s_waitcnt lgkmcnt(0)" ::: "memory"); }
    if (ord == 0) HY_FLOAD(1);
    LP zin = wl + (ord == 0 ? HY_ZA : HY_ZB); LP zout = wl + (ord == 0 ? HY_ZB : HY_ZA);
    const int gc = ord * 1024 + c; const float w0 = cw[gc], w1 = cw[3072 + gc], w2 = cw[6144 + gc], cb = cbv[gc], sk = skp[ord * 1024 + c];
    const bf16_t* gsrc = UT + (size_t)gc * NTOK + tok0;
    u32x4 gv[4]; unsigned gpv[4], gnx[4];
#pragma unroll
    for (int i = 0; i < 4; ++i) { const int base = lane * 8 + 512 * i; gv[i] = (u32x4){0u, 0u, 0u, 0u}; gpv[i] = 0u; gnx[i] = 0u;
      if (base < ntok) { gv[i] = *(const u32x4*)(gsrc + base); const int tl = base & (L - 1);
        if (tl != 0) gpv[i] = gsrc[base - 1]; if (tl + 8 != L) gnx[i] = gsrc[base + 8]; } }
    f32x16 accs[2];
#pragma unroll
    for (int o2 = 0; o2 < 2; ++o2)
#pragma unroll
      for (int r = 0; r < 16; ++r) accs[o2][r] = 0.f;
    LP fb = wl + HY_HR + ((n31 & 1) ? 0 : (HRP * 2 - 2)) + 2 * ((L >> 1) - 1 - n31 + 8 * hh + 32);
    int cbl[2], ca[2];
#pragma unroll
    for (int ot = 0; ot < 2; ++ot) { const int col = 32 * ot + n31; cbl[ot] = (col >> lgnb) << lgnb; ca[ot] = col & (nblk - 1); }
    const bool two = (ntile == 2);
    {
      LP zero = wl + HY_HR + 16 * hh;
      LP ap = fb + 64 * dmax;
      int bbr0 = ca[0] + dmax, bbr1 = ca[1] + dmax;
      LP bp0 = zin + ((cbl[0] + bbr0) * 40 + 8 * hh) * 2, bp1 = zin + ((cbl[1] + bbr1) * 40 + 8 * hh) * 2;
      for (int d = -dmax; d <= dmax; ++d) {
        u32x4 w0v, w1v;
        w0v.x = *(const LAS unsigned*)(ap); w0v.y = *(const LAS unsigned*)(ap + 4); w0v.z = *(const LAS unsigned*)(ap + 8); w0v.w = *(const LAS unsigned*)(ap + 12);
        w1v.x = *(const LAS unsigned*)(ap + 32); w1v.y = *(const LAS unsigned*)(ap + 36); w1v.z = *(const LAS unsigned*)(ap + 40); w1v.w = *(const LAS unsigned*)(ap + 44);
        const bf16x8 af0 = __builtin_bit_cast(bf16x8, w0v), af1 = __builtin_bit_cast(bf16x8, w1v);
        LP q0 = ((unsigned)bbr0 < (unsigned)nblk) ? bp0 : zero;
        LP q1 = (two && ((unsigned)bbr1 < (unsigned)nblk)) ? bp1 : zero;
        const bf16x8 b00 = *(const LAS bf16x8*)q0, b01 = *(const LAS bf16x8*)(q0 + 32);
        const bf16x8 b10 = *(const LAS bf16x8*)q1, b11 = *(const LAS bf16x8*)(q1 + 32);
        __builtin_amdgcn_sched_barrier(0);
        accs[0] = __builtin_amdgcn_mfma_f32_32x32x16_bf16(af0, b00, accs[0], 0, 0, 0);
        if (two) accs[1] = __builtin_amdgcn_mfma_f32_32x32x16_bf16(af0, b10, accs[1], 0, 0, 0);
        accs[0] = __builtin_amdgcn_mfma_f32_32x32x16_bf16(af1, b01, accs[0], 0, 0, 0);
        if (two) accs[1] = __builtin_amdgcn_mfma_f32_32x32x16_bf16(af1, b11, accs[1], 0, 0, 0);
        ap -= 64; bbr0 -= 1; bbr1 -= 1; bp0 -= 80; bp1 -= 80;
      }
    }
#pragma unroll
    for (int ot = 0; ot < 2; ++ot) {
      if (ot >= ntile) continue;
      const f32x16 acc = accs[ot];
#pragma unroll
      for (int rg = 0; rg < 4; ++rg) {
        const int zo = (((cbl[ot] + ca[ot]) * 40) + 8 * rg + 4 * hh) * 2;
        const u32x2 zv = *(const LAS u32x2*)(zin + zo);
        u32x2 w; w.x = pack2(acc[4 * rg] + sk * bflo(zv.x), acc[4 * rg + 1] + sk * bfhi(zv.x)); w.y = pack2(acc[4 * rg + 2] + sk * bflo(zv.y), acc[4 * rg + 3] + sk * bfhi(zv.y));
        *(LAS u32x2*)(zout + zo) = w;
      }
    }
    asm volatile("s_waitcnt lgkmcnt(0)" ::: "memory");
#pragma unroll
    for (int i = 0; i < 4; ++i) { const int base = lane * 8 + 512 * i;
      if (base < ntok) { const u32x4 v = gv[i];
        float u[10]; u[0] = bf2f(gpv[i]); u[1] = bflo(v.x); u[2] = bfhi(v.x); u[3] = bflo(v.y); u[4] = bfhi(v.y); u[5] = bflo(v.z); u[6] = bfhi(v.z); u[7] = bflo(v.w); u[8] = bfhi(v.w); u[9] = bf2f(gnx[i]);
        LP zp = zout + ((base >> 5) * 40 + (base & 31)) * 2; const u32x4 t = *(const LAS u32x4*)zp;
        float tv[8]; tv[0] = bflo(t.x); tv[1] = bfhi(t.x); tv[2] = bflo(t.y); tv[3] = bfhi(t.y); tv[4] = bflo(t.z); tv[5] = bfhi(t.z); tv[6] = bflo(t.w); tv[7] = bfhi(t.w);
        float o[8];
#pragma unroll
        for (int e = 0; e < 8; ++e) o[e] = (cb + w0 * u[e] + w1 * u[e + 1] + w2 * u[e + 2]) * tv[e];
        u32x4 w; w.x = pack2(o[0], o[1]); w.y = pack2(o[2], o[3]); w.z = pack2(o[4], o[5]); w.w = pack2(o[6], o[7]);
        *(LAS u32x4*)zp = w; } }
    asm volatile("s_waitcnt lgkmcnt(0)" ::: "memory");
  }
  __syncthreads();
  { bf16_t* YH = (bf16_t*)((unsigned char*)p.out + OUT_HB);
    for (int tl = tid; tl < ntok; tl += 512) {
      const int bl = tl >> lgL, tloc = tl & (L - 1); const int zo = ((((bl << lgnb) + (tloc >> 5)) * 40) + (tloc & 31)) * 2;
      unsigned short e[8];
#pragma unroll
      for (int w = 0; w < 8; ++w) e[w] = *(const LAS unsigned short*)(lds + w * HY_WAVE + HY_ZA + zo);
      u32x4 o; o.x = e[0] | ((unsigned)e[1] << 16); o.y = e[2] | ((unsigned)e[3] << 16); o.z = e[4] | ((unsigned)e[5] << 16); o.w = e[6] | ((unsigned)e[7] << 16);
      *(u32x4*)(YH + (size_t)(tok0 + tl) * 1024 + cgp * 8) = o; } }
  __syncthreads();
}

__device__ void final_norm(const Params& p) {
  const int tid0 = opaque_tid(); const int wid = tid0 >> 6, lane = tid0 & 63; const float* fw = p.in[31]; const float* ssq = (const float*)(p.ws + OFF_SSQ2);
  f32x4 wv[4];
#pragma unroll
  for (int i = 0; i < 4; ++i) wv[i] = *(const f32x4*)(fw + 4 * lane + 256 * i);
  for (int unit = blockIdx.x; unit < 768; unit += gridDim.x) {
    const int row0 = unit * 32 + wid * 4;
    f32x4 x[4][4], sq[4];
#pragma unroll
    for (int r = 0; r < 4; ++r) { const float* sp = ssq + (size_t)(row0 + r) * 16; sq[r] = (*(const f32x4*)sp + *(const f32x4*)(sp + 4)) + (*(const f32x4*)(sp + 8) + *(const f32x4*)(sp + 12));
#pragma unroll
      for (int i = 0; i < 4; ++i) x[r][i] = *(const f32x4*)(p.out + (size_t)(row0 + r) * 1024 + 4 * lane + 256 * i); }
#pragma unroll
    for (int r = 0; r < 4; ++r) { const float rstd = rsqrtf((sq[r][0] + sq[r][1] + sq[r][2] + sq[r][3]) * (1.0f / 1024.0f) + 1e-6f);
#pragma unroll
      for (int i = 0; i < 4; ++i) *(f32x4*)(p.out + (size_t)(row0 + r) * 1024 + 4 * lane + 256 * i) = x[r][i] * rstd * wv[i]; }
  }
}

__global__ void __launch_bounds__(512, 2) __attribute__((flatten)) mega(Params p) {
  extern __shared__ __attribute__((aligned(16))) unsigned char shm[];
  LP lds = (LP)shm;
  cg::grid_group grid = cg::this_grid();
  volatile LAS unsigned* xst = (volatile LAS unsigned*)(lds + LDS_BYTES - 16);
  if (threadIdx.x == 0) { xst[0] = 0u; xst[1] = 0u; }
  __syncthreads();
  const XcdBarrier xb = xcd_barrier_post((unsigned*)(p.ws + OFF_BAR), xst);
  unsigned char* ws = p.ws;
  const bf16_t* WT = (const bf16_t*)(ws + OFF_WT); const bf16_t* HN = (const bf16_t*)(ws + OFF_HN); bf16_t* BIG = (bf16_t*)(ws + OFF_BIG);
  bf16_t* Hb = (bf16_t*)((unsigned char*)p.out + OUT_H); bf16_t* YH = (bf16_t*)((unsigned char*)p.out + OUT_HB);
  const float* mod = (const float*)(ws + OFF_MOD);
  phase0(p, lds);
  if (gridDim.y == 7u) grid.sync();
  xcd_barrier(xb);
  phase1(p, lds);
  weight_tiles(p, lds);
  xcd_barrier(xb);
  { EpiQKV e; e.O = BIG; e.bias = p.in[11]; run_gemm(lds, HN, WT, NTOK, 3072, 1024, e); }
  xcd_barrier(xb);
  for (int item = blockIdx.x; item < 1280; item += gridDim.x) mlstm_item(p, lds, item);
  xcd_barrier(xb);
  combine_rows(p);
  { EpiUT e; e.O = BIG; e.bias = p.in[11] + 4112; run_gemm(lds, WT + (size_t)3072 * 1024, HN, 3072, NTOK, 1024, e); }
  xcd_barrier(xb);
  for (int item = blockIdx.x; item < 2048; item += gridDim.x) hyena_item(p, lds, item);
  xcd_barrier(xb);
  { EpiGates e; e.H = Hb; e.G = BIG; e.b_in = p.in[11]; run_gemm(lds, HN, WT + (size_t)6144 * 1024, NTOK, 3072, 1024, e); }
  xcd_barrier(xb);
  bf16_t* T = BIG + (size_t)NTOK * 2048;
  { EpiMerge<0> e; e.T = T; e.G = BIG; run_gemm(lds, Hb, (const bf16_t*)(ws + OFF_WBM), NTOK, 1024, 1024, e); }
  { EpiMerge<1> e; e.T = T; e.G = BIG; run_gemm(lds, YH, (const bf16_t*)(ws + OFF_WBH), NTOK, 1024, 1024, e); }
  xcd_barrier(xb);
  { EpiOut e; e.xp = p.in[0]; e.xs = p.in[1]; e.per = (const float*)(ws + OFF_PER); e.pec = (const float*)(ws + OFF_PEC); e.mod = mod; e.n2w = p.in[26];
    e.X1 = p.out; e.A2 = (bf16_t*)(ws + OFF_HN); e.ssq = (float*)(ws + OFF_SSQ1); run_gemm(lds, T, (const bf16_t*)(ws + OFF_WOUT), NTOK, 1024, 1024, e); }
  xcd_barrier(xb);
#define FFN_HALF(ROW0) do { \
    { EpiFF1 e; e.row0 = (ROW0); e.ssq = (const float*)(p.ws + OFF_SSQ1); e.c1 = (const float*)(p.ws + OFF_C1); e.Hd = (bf16_t*)(p.ws + OFF_BIG); \
      run_gemm(lds, (const bf16_t*)(p.ws + OFF_HN) + (size_t)(ROW0) * 1024, (const bf16_t*)(p.ws + OFF_W1T), 12288, 4096, 1024, e); } \
    xcd_barrier(xb); \
    { EpiFF2 e; e.row0 = (ROW0); e.mod = (const float*)(p.ws + OFF_MOD); e.b2 = p.in[30]; e.X = p.out; e.ssq = (float*)(p.ws + OFF_SSQ2); \
      run_gemm(lds, (const bf16_t*)(p.ws + OFF_BIG), (const bf16_t*)(p.ws + OFF_W2T), 12288, 1024, 4096, e); } \
    xcd_barrier(xb); } while (0)
  FFN_HALF(0);
  FFN_HALF(12288);
#undef FFN_HALF
  final_norm(p);
}

extern "C" void kernel_launch(void* const* d_in, const int* in_sizes, int n_in, void* d_out, int out_size, void* d_ws, size_t ws_size, hipStream_t stream) {
  static int grid_blocks = 0;
  if (!grid_blocks) {
    int dev = 0, cus = 0, per_cu = 0;
    hipGetDevice(&dev);
    hipDeviceGetAttribute(&cus, hipDeviceAttributeMultiprocessorCount, dev);
    hipFuncSetAttribute((const void*)mega, hipFuncAttributeMaxDynamicSharedMemorySize, LDS_BYTES);
    hipOccupancyMaxActiveBlocksPerMultiprocessor(&per_cu, (const void*)mega, 512, LDS_BYTES);
    if (per_cu < 1) { fprintf(stderr, "kernel_launch: occupancy query reports %d blocks per CU\n", per_cu); grid_blocks = -1; }
    else grid_blocks = cus;
    if (n_in != 32 || ws_size < WS_END) { fprintf(stderr, "kernel_launch: unexpected n_in %d / ws_size %zu (need %zu)\n", n_in, ws_size, (size_t)WS_END); grid_blocks = -1; }
  }
  if (grid_blocks < 0) return;
  hipMemsetAsync((unsigned char*)d_ws + OFF_BAR, 0, 3456 * 4, stream);
  Params p{};
  for (int i = 0; i < 32; ++i) p.in[i] = (const float*)d_in[i];
  p.out = (float*)d_out; p.ws = (unsigned char*)d_ws;
  void* args[] = {&p};
  hipError_t e = hipLaunchCooperativeKernel((void*)mega, dim3(grid_blocks), dim3(512), args, LDS_BYTES, stream);
  if (e != hipSuccess) fprintf(stderr, "cooperative launch failed: %s (grid %d)\n", hipGetErrorString(e), grid_blocks);
}
```

```cpp
#include <hip/hip_runtime.h>
#include <hip/hip_cooperative_groups.h>
#include <cstdio>
#include <cstdint>
namespace cg = cooperative_groups;

#define LAS __attribute__((address_space(3)))
typedef LAS unsigned char* LP;
typedef unsigned short bf16_t;
typedef short bf16x8 __attribute__((ext_vector_type(8)));
typedef short s16x4 __attribute__((ext_vector_type(4)));
typedef float f32x4 __attribute__((ext_vector_type(4)));
typedef float f32x16 __attribute__((ext_vector_type(16)));
typedef unsigned u32x4 __attribute__((ext_vector_type(4)));
typedef unsigned u32x2 __attribute__((ext_vector_type(2)));

constexpr int DM = 1024, NTOK = 24576, NCTX = 8192, SEQC = 256, SEQS = 2048, INC = 9232;
constexpr int LDS_BYTES = 160 * 1024;
constexpr size_t OFF_WT = 0;
constexpr size_t OFF_WBM = 18874368, OFF_WBH = 20971520, OFF_WOUT = 23068672, OFF_W1T = 25165824, OFF_W2T = 33554432;
constexpr size_t OFF_HN = 41943040;
constexpr size_t OFF_BIG = 92274688;
constexpr size_t OFF_SM = 243269632;
constexpr size_t OFF_MOD = OFF_SM;
constexpr size_t OFF_C1 = OFF_MOD + 221184;
constexpr size_t OFF_H2S = OFF_C1 + 147456;
constexpr size_t OFF_H2C = OFF_H2S + 524288;
constexpr size_t OFF_PER = OFF_H2C + 65536;
constexpr size_t OFF_PEC = OFF_PER + 65536;
constexpr size_t OFF_GT = OFF_PEC + 131072;
constexpr size_t OFF_SSQ1 = OFF_GT + 1572864;
constexpr size_t OFF_SSQ2 = OFF_SSQ1 + 1572864;
constexpr size_t OFF_HFS = OFF_SSQ2 + 1572864;
constexpr size_t OFF_HFC = OFF_HFS + 16777216;
constexpr size_t OFF_BAR = OFF_HFC + 2097152;
constexpr size_t WS_END = OFF_BAR + 3456 * 4;
constexpr size_t OUT_H = 0, OUT_HB = 50331648;
constexpr size_t OUTF_C = 25165824, OUTF_N = 41943040, OUTF_M = 42008576;

struct Params { const float* in[32]; float* out; unsigned char* ws; };

__device__ __forceinline__ bf16_t f2bf(float f) { unsigned u = __float_as_uint(f); u += 0x7FFFu + ((u >> 16) & 1u); return (bf16_t)(u >> 16); }
__device__ __forceinline__ float bf2f(unsigned b) { return __uint_as_float(b << 16); }
__device__ __forceinline__ unsigned pack2(float lo, float hi) { return (unsigned)f2bf(lo) | ((unsigned)f2bf(hi) << 16); }
__device__ __forceinline__ float bflo(unsigned w) { return __uint_as_float(w << 16); }
__device__ __forceinline__ float bfhi(unsigned w) { return __uint_as_float(w & 0xffff0000u); }
__device__ __forceinline__ float sigmoidf_(float x) { return 1.0f / (1.0f + __expf(-x)); }
__device__ __forceinline__ int opaque_tid() { int t = threadIdx.x; asm volatile("" : "+v"(t)); return t; }
__device__ __forceinline__ float wave_sum(float v) {
#pragma unroll
  for (int o = 32; o >= 1; o >>= 1) v += __shfl_xor(v, o);
  return v;
}


#define XB_TMO      128
#define XB_XCNT(j)  (256  + 64 * (j))
#define XB_XSUB(j)  (1280 + 64 * (j))
#define XB_XGEN(j)  (2304 + 64 * (j))
#define XB_TOP      3328
#define XB_TOPGEN   3392
#define XCD_BAR_WORDS 3456
#define XB_SPIN_CAP (1u << 18)
__device__ __forceinline__ unsigned xb_ld(unsigned* p)              { return __hip_atomic_load(p, __ATOMIC_RELAXED, __HIP_MEMORY_SCOPE_AGENT); }
__device__ __forceinline__ unsigned xb_add(unsigned* p, unsigned v) { return __hip_atomic_fetch_add(p, v, __ATOMIC_RELAXED, __HIP_MEMORY_SCOPE_AGENT); }
__device__ __forceinline__ unsigned xb_xcc_id() { return (unsigned)__builtin_amdgcn_s_getreg((3 << 11) | 20) & 0xFu; }
#define XB_SPIN(cond, bar) do { unsigned _sp = 0; while (cond) { __builtin_amdgcn_s_sleep(1); \
    if ((++_sp & 255u) == 0u) { if (xb_ld(&(bar)[XB_TMO])) break; if (_sp > XB_SPIN_CAP) { atomicAdd(&(bar)[XB_TMO], 1u); break; } } } } while (0)
struct XcdBarrier { unsigned* bar; unsigned x; volatile LAS unsigned* st; };
__device__ __forceinline__ XcdBarrier xcd_barrier_post(unsigned* bar, volatile LAS unsigned* st) {
  XcdBarrier b; b.bar = bar; b.x = xb_xcc_id(); b.st = st;
  if (threadIdx.x == 0) (void)xb_add(&bar[XB_XCNT(b.x)], 1u);
  return b;
}
__device__ __forceinline__ void xcd_barrier_complete(unsigned* bar, unsigned x, unsigned& nloc, unsigned& nx) {
  const unsigned G = gridDim.x * gridDim.y * gridDim.z;
  unsigned sum, cnt, mine, sp = 0u;
  for (;;) {
    sum = 0u; cnt = 0u; mine = 0u;
#pragma unroll
    for (unsigned j = 0; j < 16; ++j) { const unsigned c = xb_ld(&bar[XB_XCNT(j)]); sum += c; cnt += (c > 0u) ? 1u : 0u; mine = (j == x) ? c : mine; }
    if (sum == G) break;
    __builtin_amdgcn_s_sleep(1);
    if ((++sp & 255u) == 0u) { if (xb_ld(&bar[XB_TMO])) break; if (sp > XB_SPIN_CAP) { atomicAdd(&bar[XB_TMO], 1u); break; } }
  }
  nloc = mine > 0u ? mine : 1u; nx = cnt > 0u ? cnt : 1u;
}
__device__ __forceinline__ void xcd_barrier(const XcdBarrier& b) {
  asm volatile("s_waitcnt vmcnt(0)" ::: "memory");
  __syncthreads();
  if (threadIdx.x == 0) {
    unsigned* bar = b.bar;
    __builtin_amdgcn_s_waitcnt(0);
    unsigned nloc = b.st[0], nx = b.st[1];
    if (nloc == 0u) { xcd_barrier_complete(bar, b.x, nloc, nx); b.st[0] = nloc; b.st[1] = nx; }
    const unsigned old = xb_add(&bar[XB_XSUB(b.x)], 1u);
    const unsigned gen = old / nloc;
    if (old + 1u == (gen + 1u) * nloc) {
      __builtin_amdgcn_fence(__ATOMIC_RELEASE, "agent");
      asm volatile("s_waitcnt vmcnt(0)" ::: "memory");
      const unsigned og = xb_add(&bar[XB_TOP], 1u);
      const unsigned tg = og / nx;
      if (og + 1u == (tg + 1u) * nx) xb_add(&bar[XB_TOPGEN], 1u);
      else XB_SPIN(xb_ld(&bar[XB_TOPGEN]) == tg, bar);
      __builtin_amdgcn_fence(__ATOMIC_ACQUIRE, "agent");
      xb_add(&bar[XB_XGEN(b.x)], 1u);
      asm volatile("s_waitcnt vmcnt(0)" ::: "memory");
    } else {
      XB_SPIN(xb_ld(&bar[XB_XGEN(b.x)]) == gen, bar);
      __builtin_amdgcn_fence(__ATOMIC_ACQUIRE, "agent");
      asm volatile("s_waitcnt vmcnt(0)" ::: "memory");
    }
  }
  __syncthreads();
}

namespace pg8 {
constexpr int BM = 256, BK = 64, HALF = 128, HTB = HALF * BK * 2, STAGE_BYTES = 8 * HTB, NXCD = 8, WGM = 8;
__host__ __device__ __forceinline__ int lds_byte(int r, int c) { const int st = (r >> 4) * 2 + (c >> 5), rr = r & 15, cc = c & 31, ob = rr * 64 + cc * 2; return st * 1024 + (ob ^ (((ob >> 9) & 1) << 5)); }
__host__ __device__ __forceinline__ void stage_rc(int b, int& R, int& C) { const int st = b / 1024, sb = b % 1024, swz = sb ^ (((sb >> 9) & 1) << 5); R = (st >> 1) * 16 + swz / 64; C = (st & 1) * 32 + (swz % 64) / 2; }
__host__ __device__ __forceinline__ int perm32(int rho) { const int n = rho >> 4, i = rho & 15; return 8 * (i >> 2) + 4 * n + (i & 3); }
struct Unit { int pm, pn, ks; };
struct Gemm { const bf16_t* A; const bf16_t* Bt; int M, N, K, ld, nks; };
struct StaticOrder {
  int nM, nN, ntile, nwg, G, c;
  __device__ void init(int M, int N, int nks, int G_, int c_) { nM = M / BM; nN = N / BM; ntile = nM * nN; nwg = ntile * nks; G = G_; c = c_; }
  __device__ bool next(int i, Unit& u) const {
    const long L = (long)i * G + c; if (L >= nwg) return false;
    u.ks = (int)L / ntile; int wgid = (int)L - u.ks * ntile;
    { const int q = ntile / NXCD, r = ntile % NXCD, xcd = wgid % NXCD, off = wgid / NXCD; wgid = (xcd < r ? xcd * (q + 1) : r * (q + 1) + (xcd - r) * q) + off; }
    const int nig = WGM * nN, gid = wgid / nig, fm = gid * WGM, gsz = (nM - fm) < WGM ? (nM - fm) : WGM;
    u.pm = fm + ((wgid % nig) % gsz); u.pn = (wgid % nig) / gsz; return true;
  }
};

template <class Epi>
__device__ __forceinline__ void gemm_phase(LP lds, const Gemm g, const StaticOrder& S, const Epi& E) {
  int tid_ = threadIdx.x; asm volatile("" : "+v"(tid_));
  const int tid = tid_, wid = __builtin_amdgcn_readfirstlane(tid >> 6), lane = tid & 63, wr = wid >> 2, wc = wid & 3, fr = lane & 15, fq = lane >> 4;
  const int K = g.ld, nt = g.K / BK;
  const size_t ksb = (size_t)g.K * 2;
  unsigned voffA[2], voffB[2];
#pragma unroll
  for (int i = 0; i < 2; ++i) { int R, C; stage_rc(tid * 16 + i * 8192, R, C); const int Rb = (R & ~31) + perm32(R & 31); voffA[i] = (unsigned)(R * K + C) * 2u; voffB[i] = (unsigned)(Rb * K + C) * 2u; }
  const size_t kstep = (size_t)(BK * 2);
  const size_t hstep = (size_t)HALF * K * 2;
  const size_t tstep = 2 * hstep;
  const unsigned ldsw = (unsigned)wid * 1024u;
  const int aoff = lds_byte(wr * 64 + fr, fq * 8), boff = lds_byte(wc * 32 + fr, fq * 8);
#define PG8_SA(b, h) (((b) * 2 + (h)) * HTB)
#define PG8_SB(b, h) ((4 + (b) * 2 + (h)) * HTB)
#define PG8_STAGE(bufoff, gbase, voff) do { _Pragma("unroll") for (int _i = 0; _i < 2; ++_i) \
    __builtin_amdgcn_global_load_lds((const unsigned*)((const char*)(gbase) + (voff)[_i]), (LAS unsigned*)(lds + (bufoff) + ldsw + _i * 8192), 16, 0, 0); } while (0)
#define PG8_LDA(dst, b, h) do { _Pragma("unroll") for (int m = 0; m < 4; ++m) _Pragma("unroll") for (int k = 0; k < 2; ++k) dst[m][k] = *(const LAS bf16x8*)(lds + PG8_SA(b, h) + aoff + m * 2048 + k * 1024); } while (0)
#define PG8_LDB(dst, b, h) do { _Pragma("unroll") for (int n = 0; n < 2; ++n) _Pragma("unroll") for (int k = 0; k < 2; ++k) dst[n][k] = *(const LAS bf16x8*)(lds + PG8_SB(b, h) + boff + n * 2048 + k * 1024); } while (0)
#define PG8_MMA(ai, bj, At, Bt) do { __builtin_amdgcn_s_setprio(1); _Pragma("unroll") for (int m = 0; m < 4; ++m) _Pragma("unroll") for (int n = 0; n < 2; ++n) _Pragma("unroll") for (int k = 0; k < 2; ++k) \
    acc[ai][bj][m][n] = __builtin_amdgcn_mfma_f32_16x16x32_bf16(Bt[n][k], At[m][k], acc[ai][bj][m][n], 0, 0, 0); __builtin_amdgcn_s_setprio(0); } while (0)
#define PG8_WAIT_V(n) asm volatile("s_waitcnt vmcnt(" #n ")" ::: "memory")
#define PG8_WAIT_L(n) asm volatile("s_waitcnt lgkmcnt(" #n ")" ::: "memory")
#define PG8_BAR __builtin_amdgcn_s_barrier()
#define PG8_SCHED __builtin_amdgcn_sched_barrier(0)
  Unit cur, nxt; int ui = 0;
  if (!S.next(0, cur)) return;
  f32x4 acc[2][2][4][2];
#pragma unroll
  for (int a = 0; a < 2; ++a)
#pragma unroll
    for (int b = 0; b < 2; ++b)
#pragma unroll
      for (int m = 0; m < 4; ++m)
#pragma unroll
        for (int n = 0; n < 2; ++n) acc[a][b][m][n] = (f32x4){0.f, 0.f, 0.f, 0.f};
  bf16x8 At[4][2], B0[2][2], B1[2][2];
  const char* cA = (const char*)g.A + (size_t)cur.pm * tstep + cur.ks * ksb; const char* cB = (const char*)g.Bt + (size_t)cur.pn * tstep + cur.ks * ksb;
  PG8_STAGE(PG8_SB(0, 0), cB, voffB); PG8_STAGE(PG8_SA(0, 0), cA, voffA); PG8_STAGE(PG8_SB(0, 1), cB + hstep, voffB); PG8_STAGE(PG8_SA(0, 1), cA + hstep, voffA);
  if (wr == 1) PG8_BAR;
  PG8_WAIT_V(4); PG8_BAR;
  PG8_STAGE(PG8_SB(1, 0), cB + kstep, voffB); PG8_STAGE(PG8_SA(1, 0), cA + kstep, voffA); PG8_STAGE(PG8_SB(1, 1), cB + hstep + kstep, voffB);
  PG8_WAIT_V(6); PG8_BAR;
  for (;;) {
    const bool has_next = S.next(ui + 1, nxt);
    const char* nA = has_next ? (const char*)g.A + (size_t)nxt.pm * tstep + nxt.ks * ksb : cA; const char* nB = has_next ? (const char*)g.Bt + (size_t)nxt.pn * tstep + nxt.ks * ksb : cB;
    for (int t = 0; t < nt; t += 2) {
      const bool last = (t == nt - 2);
      const char* a1 = cA + (size_t)(t + 1) * kstep;
      const char* a2 = last ? nA : cA + (size_t)(t + 2) * kstep; const char* b2 = last ? nB : cB + (size_t)(t + 2) * kstep;
      const char* a3 = a2 + kstep; const char* b3 = b2 + kstep;
      PG8_LDB(B0, 0, 0); PG8_SCHED; PG8_LDA(At, 0, 0); PG8_STAGE(PG8_SA(1, 1), a1 + hstep, voffA);
      PG8_WAIT_L(8); PG8_BAR; PG8_WAIT_L(0); PG8_MMA(0, 0, At, B0); PG8_BAR; PG8_SCHED;
      PG8_LDB(B1, 0, 1); PG8_STAGE(PG8_SB(0, 0), b2, voffB);
      PG8_BAR; PG8_WAIT_L(0); PG8_MMA(0, 1, At, B1); PG8_BAR;
      PG8_LDA(At, 0, 1); PG8_STAGE(PG8_SA(0, 0), a2, voffA);
      PG8_BAR; PG8_WAIT_L(0); PG8_MMA(1, 0, At, B0); PG8_BAR; PG8_SCHED;
      PG8_STAGE(PG8_SB(0, 1), b2 + hstep, voffB);
      PG8_WAIT_V(6); PG8_BAR; PG8_MMA(1, 1, At, B1); PG8_BAR;
      PG8_LDB(B0, 1, 0); PG8_SCHED; PG8_LDA(At, 1, 0); PG8_STAGE(PG8_SA(0, 1), a2 + hstep, voffA);
      PG8_WAIT_L(8); PG8_BAR; PG8_WAIT_L(0); PG8_MMA(0, 0, At, B0); PG8_BAR; PG8_SCHED;
      PG8_LDB(B1, 1, 1); PG8_STAGE(PG8_SB(1, 0), b3, voffB);
      PG8_BAR; PG8_WAIT_L(0); PG8_MMA(0, 1, At, B1); PG8_BAR;
      PG8_LDA(At, 1, 1); PG8_STAGE(PG8_SA(1, 0), a3, voffA);
      PG8_BAR; PG8_WAIT_L(0); PG8_MMA(1, 0, At, B0); PG8_BAR; PG8_SCHED;
      PG8_STAGE(PG8_SB(1, 1), b3 + hstep, voffB);
      PG8_WAIT_V(6); PG8_BAR; PG8_MMA(1, 1, At, B1); PG8_BAR;
    }
    { int fr2 = fr, fq2 = fq; asm volatile("" : "+v"(fr2), "+v"(fq2)); E(acc, cur, wr, wc, fr2, fq2); }
    if (!has_next) break;
#pragma unroll
    for (int a = 0; a < 2; ++a)
#pragma unroll
      for (int b = 0; b < 2; ++b)
#pragma unroll
        for (int m = 0; m < 4; ++m)
#pragma unroll
          for (int n = 0; n < 2; ++n) acc[a][b][m][n] = (f32x4){0.f, 0.f, 0.f, 0.f};
    cur = nxt; cA = nA; cB = nB; ++ui;
  }
  PG8_WAIT_V(0);
  if (wr == 0) PG8_BAR;
  PG8_BAR;
#undef PG8_SA
#undef PG8_SB
#undef PG8_STAGE
#undef PG8_LDA
#undef PG8_LDB
#undef PG8_MMA
#undef PG8_WAIT_V
#undef PG8_WAIT_L
#undef PG8_BAR
#undef PG8_SCHED
}
}
using pg8::Unit;
typedef f32x4 AccT[2][2][4][2];

#define EPI_ROW(ai, m) (u.pm * 256 + (ai) * 128 + wr * 64 + (m) * 16 + fr)
#define EPI_COL(bj, n) (u.pn * 256 + (bj) * 128 + wc * 32 + 8 * fq + 4 * (n))
#define EPI_LOOP_ROWS _Pragma("unroll") for (int ai = 0; ai < 2; ++ai) _Pragma("unroll") for (int m = 0; m < 4; ++m)
#define EPI_LOOP_COLS _Pragma("unroll") for (int bj = 0; bj < 2; ++bj) _Pragma("unroll") for (int n = 0; n < 2; ++n)

__device__ __forceinline__ int cond_of_row(int row) { return row < NCTX ? 0 : 1 + ((row - NCTX) >> 11); }

#define EPI_LOOP_BJ _Pragma("unroll") for (int bj = 0; bj < 2; ++bj)
__device__ __forceinline__ u32x4 pack8(const f32x4 v0, const f32x4 v1) { u32x4 w; w.x = pack2(v0[0], v0[1]); w.y = pack2(v0[2], v0[3]); w.z = pack2(v1[0], v1[1]); w.w = pack2(v1[2], v1[3]); return w; }
__device__ __forceinline__ void unpack8(const u32x4 w, f32x4& v0, f32x4& v1) { v0[0] = bflo(w.x); v0[1] = bfhi(w.x); v0[2] = bflo(w.y); v0[3] = bfhi(w.y); v1[0] = bflo(w.z); v1[1] = bfhi(w.z); v1[2] = bflo(w.w); v1[3] = bfhi(w.w); }
struct EpiQKV {
  bf16_t* O; const float* bias;
  __device__ __forceinline__ void operator()(const AccT& acc, const Unit& u, int wr, int wc, int fr, int fq) const {
    const float sc = (u.pn < 4) ? 0.0625f : 1.0f;
    f32x4 bv[2][2];
    EPI_LOOP_COLS { bv[bj][n] = *(const f32x4*)(bias + EPI_COL(bj, n)); }
    EPI_LOOP_ROWS { const int row = EPI_ROW(ai, m);
      EPI_LOOP_BJ { *(u32x4*)(O + (size_t)row * 3072 + EPI_COL(bj, 0)) = pack8((acc[ai][bj][m][0] + bv[bj][0]) * sc, (acc[ai][bj][m][1] + bv[bj][1]) * sc); } }
  }
};
struct EpiUT {
  bf16_t* O; const float* bias;
  __device__ __forceinline__ void operator()(const AccT& acc, const Unit& u, int wr, int wc, int fr, int fq) const {
    EPI_LOOP_ROWS { const int row = EPI_ROW(ai, m); const float bv = bias[row];
      EPI_LOOP_BJ { *(u32x4*)(O + (size_t)row * NTOK + EPI_COL(bj, 0)) = pack8(acc[ai][bj][m][0] + bv, acc[ai][bj][m][1] + bv); } }
  }
};
struct EpiGates {
  bf16_t* H; bf16_t* G; const float* b_in;
  __device__ __forceinline__ void operator()(const AccT& acc, const Unit& u, int wr, int wc, int fr, int fq) const {
    const bool og = u.pn < 4;
    f32x4 bv[2][2];
    EPI_LOOP_COLS { const int col = EPI_COL(bj, n); bv[bj][n] = *(const f32x4*)(b_in + (og ? 3072 + col : 7184 + (col - 1024))); }
    EPI_LOOP_ROWS { const int row = EPI_ROW(ai, m);
      u32x4 hv[2];
      if (og) { EPI_LOOP_BJ { hv[bj] = *(const u32x4*)(H + (size_t)row * 1024 + EPI_COL(bj, 0)); } }
      EPI_LOOP_BJ { const int col = EPI_COL(bj, 0); f32x4 s0, s1; const f32x4 a0 = acc[ai][bj][m][0] + bv[bj][0], a1 = acc[ai][bj][m][1] + bv[bj][1];
#pragma unroll
        for (int e = 0; e < 4; ++e) { s0[e] = sigmoidf_(a0[e]); s1[e] = sigmoidf_(a1[e]); }
        if (og) { f32x4 h0, h1; unpack8(hv[bj], h0, h1); *(u32x4*)(H + (size_t)row * 1024 + col) = pack8(h0 * s0, h1 * s1); }
        else *(u32x4*)(G + (size_t)row * 2048 + (col - 1024)) = pack8(s0, s1); } }
  }
};
template <int SECOND> struct EpiMerge {
  bf16_t* T; const bf16_t* G;
  __device__ __forceinline__ void operator()(const AccT& acc, const Unit& u, int wr, int wc, int fr, int fq) const {
    EPI_LOOP_ROWS { const int row = EPI_ROW(ai, m);
      u32x4 gv[2], tv[2];
      EPI_LOOP_BJ { const int col = EPI_COL(bj, 0); gv[bj] = *(const u32x4*)(G + (size_t)row * 2048 + SECOND * 1024 + col);
        if (SECOND) tv[bj] = *(const u32x4*)(T + (size_t)row * 1024 + col); }
      EPI_LOOP_BJ { const int col = EPI_COL(bj, 0); f32x4 g0, g1; unpack8(gv[bj], g0, g1);
        f32x4 v0 = g0 * acc[ai][bj][m][0], v1 = g1 * acc[ai][bj][m][1];
        if (SECOND) { f32x4 t0, t1; unpack8(tv[bj], t0, t1); v0 += t0; v1 += t1; }
        *(u32x4*)(T + (size_t)row * 1024 + col) = pack8(v0, v1); } }
  }
};
struct EpiOut {
  const float* xp; const float* xs; const float* per; const float* pec; const float* mod; const float* n2w; float* X1; bf16_t* A2; float* ssq;
  __device__ __forceinline__ void operator()(const AccT& acc, const Unit& u, int wr, int wc, int fr, int fq) const {
    const int cb = cond_of_row(u.pm * 256); const float* md = mod + cb * 6144; const bool smp = (u.pm * 256) >= NCTX;
    f32x4 g1v[2][2], k2v[2][2];
    EPI_LOOP_COLS { const int col = EPI_COL(bj, n); g1v[bj][n] = *(const f32x4*)(md + 2048 + col); k2v[bj][n] = *(const f32x4*)(n2w + col) * (*(const f32x4*)(md + 4096 + col) + 1.0f); }
    EPI_LOOP_ROWS { const int row = EPI_ROW(ai, m); float ss = 0.f;
#pragma unroll
      for (int bj = 0; bj < 2; ++bj) {
        f32x4 x0[2];
        if (!smp) {
#pragma unroll
          for (int n = 0; n < 2; ++n) x0[n] = *(const f32x4*)(xp + (size_t)row * 1024 + EPI_COL(bj, n)); }
        else { const int r2 = row - NCTX, t = r2 & 2047; f32x4 pe[2];
#pragma unroll
          for (int n = 0; n < 2; ++n) { const int col = EPI_COL(bj, n); x0[n] = *(const f32x4*)(xs + (size_t)r2 * 1024 + col);
            pe[n] = (col < 512) ? *(const f32x4*)(per + (t >> 6) * 512 + col) : *(const f32x4*)(pec + (t & 63) * 512 + (col - 512)); }
#pragma unroll
          for (int n = 0; n < 2; ++n) x0[n] += pe[n]; }
        f32x4 x1[2];
#pragma unroll
        for (int n = 0; n < 2; ++n) { x1[n] = x0[n] + g1v[bj][n] * acc[ai][bj][m][n]; *(f32x4*)(X1 + (size_t)row * 1024 + EPI_COL(bj, n)) = x1[n];
          ss += x1[n][0] * x1[n][0] + x1[n][1] * x1[n][1] + x1[n][2] * x1[n][2] + x1[n][3] * x1[n][3]; }
        *(u32x4*)(A2 + (size_t)row * 1024 + EPI_COL(bj, 0)) = pack8(x1[0] * k2v[bj][0], x1[1] * k2v[bj][1]); }
      ss += __shfl_xor(ss, 16); ss += __shfl_xor(ss, 32);
      if (fq == 0) ssq[(size_t)row * 16 + u.pn * 4 + wc] = ss; }
  }
};
struct EpiFF1 {
  int row0; const float* ssq; const float* c1; bf16_t* Hd;
  __device__ __forceinline__ void operator()(const AccT& acc, const Unit& u, int wr, int wc, int fr, int fq) const {
    const int cb = cond_of_row(row0 + u.pm * 256); const float* cc = c1 + cb * 4096;
    f32x4 cv[2][2];
    EPI_LOOP_COLS { cv[bj][n] = *(const f32x4*)(cc + EPI_COL(bj, n)); }
    float rs[2][4];
    EPI_LOOP_ROWS { const float* sp = ssq + (size_t)(row0 + EPI_ROW(ai, m)) * 16;
      const f32x4 st = (*(const f32x4*)sp + *(const f32x4*)(sp + 4)) + (*(const f32x4*)(sp + 8) + *(const f32x4*)(sp + 12));
      rs[ai][m] = rsqrtf((st[0] + st[1] + st[2] + st[3]) * (1.0f / 1024.0f) + 1e-6f); }
    EPI_LOOP_ROWS { const int rl = EPI_ROW(ai, m); const float rstd = rs[ai][m];
      EPI_LOOP_BJ { f32x4 v0 = acc[ai][bj][m][0] * rstd + cv[bj][0], v1 = acc[ai][bj][m][1] * rstd + cv[bj][1];
#pragma unroll
        for (int e = 0; e < 4; ++e) { const float r0 = fmaxf(v0[e], 0.f), r1 = fmaxf(v1[e], 0.f); v0[e] = r0 * r0; v1[e] = r1 * r1; }
        *(u32x4*)(Hd + (size_t)rl * 4096 + EPI_COL(bj, 0)) = pack8(v0, v1); } }
  }
};
struct EpiFF2 {
  int row0; const float* mod; const float* b2; float* X; float* P;
  __device__ __forceinline__ void operator()(const AccT& acc, const Unit& u, int wr, int wc, int fr, int fq) const {
    if (u.ks == 1) {
      EPI_LOOP_ROWS { const int rl = EPI_ROW(ai, m); EPI_LOOP_COLS { *(f32x4*)(P + (size_t)rl * 1024 + EPI_COL(bj, n)) = acc[ai][bj][m][n]; } }
    } else {
    const int cb = cond_of_row(row0 + u.pm * 256); const float* md = mod + cb * 6144;
    f32x4 g2v[2][2], bbv[2][2];
    EPI_LOOP_COLS { const int col = EPI_COL(bj, n); g2v[bj][n] = *(const f32x4*)(md + 5120 + col); bbv[bj][n] = *(const f32x4*)(b2 + col); }
#pragma unroll
    for (int ai = 0; ai < 2; ++ai)
#pragma unroll
      for (int m2 = 0; m2 < 2; ++m2) {
        f32x4 xv[2][2][2];
#pragma unroll
        for (int mm = 0; mm < 2; ++mm) { const int row = row0 + EPI_ROW(ai, 2 * m2 + mm); EPI_LOOP_COLS { xv[mm][bj][n] = *(const f32x4*)(X + (size_t)row * 1024 + EPI_COL(bj, n)); } }
#pragma unroll
        for (int mm = 0; mm < 2; ++mm) { const int m = 2 * m2 + mm; const int row = row0 + EPI_ROW(ai, m);
          EPI_LOOP_COLS { const int col = EPI_COL(bj, n); *(f32x4*)(X + (size_t)row * 1024 + col) = xv[mm][bj][n] + g2v[bj][n] * (acc[ai][bj][m][n] + bbv[bj][n]); } } }
    }
  }
};

template <class Epi> __device__ __forceinline__ void run_gemm(LP lds, const bf16_t* A, const bf16_t* Bt, int M, int N, int K, const Epi& E, int nks = 1) {
  pg8::Gemm g; g.A = A; g.Bt = Bt; g.M = M; g.N = N; g.K = K / nks; g.ld = K; g.nks = nks;
  pg8::StaticOrder S; S.init(M, N, nks, (int)gridDim.x, (int)blockIdx.x);
  pg8::gemm_phase<Epi>(lds, g, S, E);
}

__device__ void transpose_tile(const float* __restrict__ src, int ld, int col0, int k0, bf16_t* __restrict__ dst, int K, int drow0, LAS float* tile) {
  const int t = opaque_tid();
  f32x4 v[4];
#pragma unroll
  for (int i = 0; i < 4; ++i) { const int idx = t + 512 * i, kr = idx >> 5, c4 = idx & 31; v[i] = *(const f32x4*)(src + (size_t)(k0 + kr) * ld + col0 + 4 * c4); }
#pragma unroll
  for (int i = 0; i < 4; ++i) { const int idx = t + 512 * i, kr = idx >> 5, c4 = idx & 31; LAS float* tp = tile + kr * 129 + 4 * c4; tp[0] = v[i][0]; tp[1] = v[i][1]; tp[2] = v[i][2]; tp[3] = v[i][3]; }
  __syncthreads();
  const int kb = t & 7;
#pragma unroll
  for (int i = 0; i < 2; ++i) { const int c = (t >> 3) + 64 * i; const LAS float* tp = tile + (kb * 8) * 129 + c; u32x4 o;
    o.x = pack2(tp[0], tp[129]); o.y = pack2(tp[2 * 129], tp[3 * 129]); o.z = pack2(tp[4 * 129], tp[5 * 129]); o.w = pack2(tp[6 * 129], tp[7 * 129]);
    *(u32x4*)(dst + (size_t)(drow0 + c) * K + k0 + kb * 8) = o; }
  __syncthreads();
}
template <int SILU> __device__ void matvec9_unit(const float* v0, const float* v1, int v1stride, const float* __restrict__ W, int ldw, const float* bias, float* out, int ldo, int col0, LAS float* lf) {
  const int t = opaque_tid(), lane = t & 63, wid = t >> 6;
  LAS float* sv = lf; LAS float* red = lf + 9216;
  for (int i = t; i < 9216; i += 512) { const int b = i >> 10, k = i & 1023; float x = (b == 0) ? v0[k] : v1[(size_t)(b - 1) * v1stride + k]; if (SILU) x = x / (1.0f + __expf(-x)); sv[i] = x; }
  __syncthreads();
  const int c4 = t & 7, kl = t >> 3;
  f32x4 w[16];
#pragma unroll
  for (int i = 0; i < 16; ++i) w[i] = *(const f32x4*)(W + (size_t)(kl + 64 * i) * ldw + col0 + 4 * c4);
  f32x4 acc[9];
#pragma unroll
  for (int b = 0; b < 9; ++b) acc[b] = (f32x4){0.f, 0.f, 0.f, 0.f};
#pragma unroll
  for (int i = 0; i < 16; ++i)
#pragma unroll
    for (int b = 0; b < 9; ++b) acc[b] += w[i] * sv[b * 1024 + kl + 64 * i];
#pragma unroll
  for (int b = 0; b < 9; ++b)
#pragma unroll
    for (int e = 0; e < 4; ++e) { float x = acc[b][e]; x += __shfl_xor(x, 8); x += __shfl_xor(x, 16); x += __shfl_xor(x, 32); acc[b][e] = x; }
  if (lane < 8) {
#pragma unroll
    for (int b = 0; b < 9; ++b) *(LAS f32x4*)(red + (wid * 9 + b) * 32 + 4 * lane) = acc[b]; }
  __syncthreads();
  if (t < 288) { const int b = t >> 5, cc = t & 31; float s = bias[col0 + cc];
#pragma unroll
    for (int pz = 0; pz < 8; ++pz) s += red[(pz * 9 + b) * 32 + cc];
    out[(size_t)b * ldo + col0 + cc] = s; }
  __syncthreads();
}

__device__ void phase0(const Params& p, LP lds) {
  unsigned char* ws = p.ws; LAS float* lf = (LAS float*)lds;
  const int tid0 = opaque_tid(); const int wid = tid0 >> 6, lane = tid0 & 63;
  for (int unit = blockIdx.x; unit < 576; unit += gridDim.x) {
    if (unit < 192) {
      matvec9_unit<1>(p.in[6], p.in[5], 1024, p.in[7], 6144, p.in[8], (float*)(ws + OFF_MOD), 6144, unit * 32, lf);
    } else if (unit < 480) {
      const int row = (unit - 192) * 8 + wid; const bool smp = row < 2048; const int L = smp ? 2048 : 256, t = smp ? row : row - 2048;
      const float* w1 = p.in[14]; const float* b1 = p.in[15]; const float* fr1 = p.in[16]; const float* w2 = p.in[17]; const float* b2 = p.in[18]; const float* fr2 = p.in[19];
      float a = b1[lane] + (float)t / (float)(L - 1) * w1[lane];
      const float base = (6.283185307179586f / (float)L) * (float)t;
      float cs = 0.f, sn = 0.f; if (lane < 16) { const float ang = base * (float)(lane + 1); cs = cosf(ang); sn = sinf(ang); }
#pragma unroll
      for (int i = 0; i < 16; ++i) a += __shfl(cs, i) * w1[(1 + i) * 64 + lane] + __shfl(sn, i) * w1[(17 + i) * 64 + lane];
      const float h1 = sinf(fr1[lane] * a);
      float a2 = b2[lane];
#pragma unroll 16
      for (int j = 0; j < 64; ++j) a2 += __shfl(h1, j) * w2[j * 64 + lane];
      const float h2 = sinf(fr2[lane] * a2);
      float* dst = (float*)(ws + (smp ? OFF_H2S : OFF_H2C)); dst[(size_t)t * 64 + lane] = h2;
    } else {
      const int r = unit - 480, c = tid0; const int pos = r < 32 ? r : r - 32; const int i = c & 255;
      const float omega = 1.0f / powf(10000.0f, (float)i / 256.0f); const float a = (float)pos * omega; const float v = c < 256 ? sinf(a) : cosf(a);
      float* dst = (float*)(ws + (r < 32 ? OFF_PER : OFF_PEC)); dst[(size_t)pos * 512 + c] = v;
    }
  }
}
__device__ void weight_tiles(const Params& p, LP lds) {
  unsigned char* ws = p.ws; LAS float* lf = (LAS float*)lds;
  for (int tu = blockIdx.x; tu < 2560; tu += gridDim.x) {
    const float* src; int ld, K, col0, k0, drow0; bf16_t* dst;
    if (tu < 1152) { const int nt = tu >> 4, kt = tu & 15; const int r = nt * 128; src = p.in[10]; ld = INC; K = 1024; k0 = kt * 64; drow0 = r; dst = (bf16_t*)(ws + OFF_WT);
      col0 = r < 3072 ? r : (r < 6144 ? 4112 + (r - 3072) : (r < 7168 ? 3072 + (r - 6144) : 7184 + (r - 7168))); }
    else if (tu < 1536) { const int v = tu - 1152, w = v >> 7, q = v & 127; src = p.in[23 + w]; ld = 1024; K = 1024; k0 = (q & 15) * 64; col0 = (q >> 4) * 128; drow0 = col0; dst = (bf16_t*)(ws + (w == 0 ? OFF_WBM : (w == 1 ? OFF_WBH : OFF_WOUT))); }
    else if (tu < 2048) { const int q = tu - 1536; src = p.in[27]; ld = 4096; K = 1024; k0 = (q & 15) * 64; col0 = (q >> 4) * 128; drow0 = col0; dst = (bf16_t*)(ws + OFF_W1T); }
    else { const int q = tu - 2048; src = p.in[29]; ld = 1024; K = 4096; k0 = (q & 63) * 64; col0 = (q >> 6) * 128; drow0 = col0; dst = (bf16_t*)(ws + OFF_W2T); }
    transpose_tile(src, ld, col0, k0, dst, K, drow0, lf);
  }
}

__device__ void phase1(const Params& p, LP lds) {
  unsigned char* ws = p.ws;
  int tid_ = threadIdx.x; asm volatile("" : "+v"(tid_));
  const int tid = tid_, wid = tid >> 6, lane = tid & 63;
  const float* mod = (const float*)(ws + OFF_MOD);
  LAS float* wg = (LAS float*)lds;
  if ((int)blockIdx.x < 1536) {
    f32x4 gw[8];
#pragma unroll
    for (int i = 0; i < 8; ++i) { const int idx = tid + 512 * i, k = idx >> 2, q = idx & 3; gw[i] = *(const f32x4*)(p.in[10] + (size_t)k * INC + 4096 + 4 * q); }
#pragma unroll
    for (int i = 0; i < 8; ++i) { const int idx = tid + 512 * i, k = idx >> 2, q = idx & 3; wg[(4 * q) * 1024 + k] = gw[i][0]; wg[(4 * q + 1) * 1024 + k] = gw[i][1]; wg[(4 * q + 2) * 1024 + k] = gw[i][2]; wg[(4 * q + 3) * 1024 + k] = gw[i][3]; }
    __syncthreads();
  }
  for (int unit = blockIdx.x; unit < 1536; unit += gridDim.x) {
    const int tidn = opaque_tid(); const int wid = tidn >> 6, lane = tidn & 63;
    const int row0 = unit * 16 + wid * 2; const int cb = cond_of_row(row0); const float* md = mod + cb * 6144; const bool smp = row0 >= NCTX;
    f32x4 v[2][4]; float rstd[2];
#pragma unroll
    for (int r = 0; r < 2; ++r) { const int row = row0 + r; const float* xr; int t = 0;
      if (!smp) xr = p.in[0] + (size_t)row * 1024; else { xr = p.in[1] + (size_t)(row - NCTX) * 1024; t = (row - NCTX) & 2047; }
      const float* per = (const float*)(ws + OFF_PER) + (t >> 6) * 512; const float* pec = (const float*)(ws + OFF_PEC) + (t & 63) * 512;
      float ss = 0.f;
#pragma unroll
      for (int i = 0; i < 4; ++i) { const int col = 4 * lane + 256 * i; v[r][i] = *(const f32x4*)(xr + col);
        if (smp) v[r][i] += (col < 512) ? *(const f32x4*)(per + col) : *(const f32x4*)(pec + col - 512);
        ss += v[r][i][0] * v[r][i][0] + v[r][i][1] * v[r][i][1] + v[r][i][2] * v[r][i][2] + v[r][i][3] * v[r][i][3]; }
      ss = wave_sum(ss); rstd[r] = rsqrtf(ss * (1.0f / 1024.0f) + 1e-6f); }
    const float* n1w = p.in[9];
    float ga[32];
#pragma unroll
    for (int g = 0; g < 32; ++g) ga[g] = 0.f;
#pragma unroll
    for (int i = 0; i < 4; ++i) { const int col = 4 * lane + 256 * i;
      const f32x4 w = *(const f32x4*)(n1w + col), sc = *(const f32x4*)(md + 1024 + col), sh = *(const f32x4*)(md + col);
      const f32x4 ws1 = w * (sc + 1.0f);
      f32x4 h[2];
#pragma unroll
      for (int r = 0; r < 2; ++r) { h[r] = v[r][i] * rstd[r] * ws1 + sh;
        u32x2 o; o.x = pack2(h[r][0], h[r][1]); o.y = pack2(h[r][2], h[r][3]); *(u32x2*)((bf16_t*)(ws + OFF_HN) + (size_t)(row0 + r) * 1024 + col) = o; }
#pragma unroll
      for (int g = 0; g < 16; ++g) { const f32x4 wv = *(const LAS f32x4*)(wg + g * 1024 + col);
#pragma unroll
        for (int r = 0; r < 2; ++r) ga[r * 16 + g] += h[r][0] * wv[0] + h[r][1] * wv[1] + h[r][2] * wv[2] + h[r][3] * wv[3]; }
      asm volatile("" ::: "memory"); }
#pragma unroll
    for (int off = 16; off >= 1; off >>= 1) { const bool hi = (lane & off) != 0;
#pragma unroll
      for (int i = 0; i < off; ++i) { const float send = hi ? ga[i] : ga[i + off]; const float keep = hi ? ga[i + off] : ga[i]; ga[i] = keep + __shfl_xor(send, off); } }
    const float tot = ga[0] + __shfl_xor(ga[0], 32);
    if (lane < 32) ((float*)(ws + OFF_GT))[(size_t)row0 * 16 + lane] = tot + p.in[11][4096 + (lane & 15)];
  }
  __syncthreads();
  LAS float* w3s = (LAS float*)lds;
  for (int v = blockIdx.x; v < 320; v += gridDim.x) {
    const int tid = opaque_tid();
    const bool smp = v < 256; const int L = smp ? 2048 : 256; const int tt = smp ? (v >> 6) : 0, cgp = v & 63; const int t = tt * 512 + tid;
    { const f32x4 x = *(const f32x4*)(p.in[20] + (size_t)(tid >> 3) * 2048 + cgp * 32 + 4 * (tid & 7)); LAS float* wp = w3s + (4 * (tid & 7)) * 64 + (tid >> 3);
      wp[0] = x[0]; wp[64] = x[1]; wp[128] = x[2]; wp[192] = x[3]; }
    __syncthreads();
    if (t < L) {
      const float* H2 = (const float*)(ws + (smp ? OFF_H2S : OFF_H2C)) + (size_t)t * 64;
      f32x4 h2[16];
#pragma unroll
      for (int i = 0; i < 16; ++i) h2[i] = *(const f32x4*)(H2 + 4 * i);
      const float dist = fabsf((float)t - (float)(L / 2)) / (float)(L / 2);
      float* HF = (float*)(ws + (smp ? OFF_HFS : OFF_HFC)) + (size_t)(cgp * 32) * L + t;
#pragma unroll 1
      for (int j = 0; j < 32; ++j) {
        f32x4 a = {0.f, 0.f, 0.f, 0.f};
#pragma unroll
        for (int i = 0; i < 16; ++i) a += *(const LAS f32x4*)(w3s + j * 64 + 4 * i) * h2[i];
        const int c = (cgp * 32 + j) & 1023;
        const float dmin = -3.0701134573253946f, dmax = -15.350567286626973f;
        const float delta = fabsf(dmin + (dmax - dmin) * ((float)c / 1023.0f));
        HF[(size_t)j * L] = ((a[0] + a[1]) + (a[2] + a[3])) * __expf(-dist * delta); }
    }
    __syncthreads();
  }
  for (int u = (int)gridDim.x - 1 - (int)blockIdx.x; u < 128; u += gridDim.x)
    matvec9_unit<0>(mod + 3072, mod + 6144 + 3072, 6144, p.in[27], 4096, p.in[28], (float*)(ws + OFF_C1), 4096, u * 32, (LAS float*)lds);
}

__device__ __forceinline__ bf16x8 tr_frag(LP base, int k0, int m0, int pitch  , int l15, int g) {
  const int q = l15 >> 2, pp = l15 & 3;
  LP a = base + ((k0 + 8 * g + q) * pitch + m0 + 4 * pp) * 2;
  const s16x4 lo = __builtin_amdgcn_ds_read_tr16_b64_v4i16((LAS s16x4*)a);
  const s16x4 hi = __builtin_amdgcn_ds_read_tr16_b64_v4i16((LAS s16x4*)(a + 8 * pitch));
  bf16x8 r; r[0] = lo[0]; r[1] = lo[1]; r[2] = lo[2]; r[3] = lo[3]; r[4] = hi[0]; r[5] = hi[1]; r[6] = hi[2]; r[7] = hi[3]; return r;
}
__device__ __forceinline__ bf16x8 tr_at(LP lanebase, int coff  , int pitch_bytes) {
  const s16x4 lo = __builtin_amdgcn_ds_read_tr16_b64_v4i16((LAS s16x4*)(lanebase + coff));
  const s16x4 hi = __builtin_amdgcn_ds_read_tr16_b64_v4i16((LAS s16x4*)(lanebase + coff + 4 * pitch_bytes));
  bf16x8 r; r[0] = lo[0]; r[1] = lo[1]; r[2] = lo[2]; r[3] = lo[3]; r[4] = hi[0]; r[5] = hi[1]; r[6] = hi[2]; r[7] = hi[3]; return r;
}
constexpr int ML_K = 0, ML_V = 67584, ML_P = 86016, ML_C = 120832, ML_T = 157696, ML_TSZ = 1600;
constexpr int KP = 264, VP = 72, PP = 136, CP = 72;

__device__ void mlstm_item(const Params& p, LP lds, int item) {
  const int tid = opaque_tid(), wid = __builtin_amdgcn_readfirstlane(tid >> 6), lane = tid & 63, l15 = lane & 15, g = lane >> 4;
  const bool smp = item < 256; const int uu = smp ? (item >> 2) : ((item - 256) >> 2); const int sl = item & 3;
  const int b = uu >> 3, dir = (uu >> 2) & 1, head = uu & 3;
  const int S = smp ? SEQS : SEQC, nc = S >> 7; const int tok0 = smp ? NCTX + b * SEQS : b * SEQC;
  const bf16_t* qkv = (const bf16_t*)(p.ws + OFF_BIG);
  const float* GT = (const float*)(p.ws + OFF_GT);
  bf16_t* hout = (bf16_t*)((unsigned char*)p.out + (dir ? OUT_HB : OUT_H));
  const int sidx = (b * 2 + dir) * 4 + head;
  const int gi_col = dir * 8 + head, gf_col = dir * 8 + 4 + head;
  f32x4 Cacc[2][4], nacc[2]; float mst0;
  if (smp) {
    const float* C0 = p.in[2] + (size_t)sidx * 65536;
#pragma unroll
    for (int dt = 0; dt < 2; ++dt) {
#pragma unroll
      for (int vt = 0; vt < 4; ++vt) Cacc[dt][vt] = *(const f32x4*)(C0 + (size_t)((2 * wid + dt) * 16 + l15) * 256 + sl * 64 + 16 * vt + 4 * g);
      nacc[dt] = (f32x4){p.in[3][sidx * 256 + (2 * wid + dt) * 16 + l15], 0.f, 0.f, 0.f}; }
    mst0 = p.in[4][sidx];
  } else {
#pragma unroll
    for (int dt = 0; dt < 2; ++dt) {
#pragma unroll
      for (int vt = 0; vt < 4; ++vt) Cacc[dt][vt] = (f32x4){0.f, 0.f, 0.f, 0.f};
      nacc[dt] = (f32x4){0.f, 0.f, 0.f, 0.f}; }
    mst0 = 0.f;
  }
#define TOKC(cc, j) (dir ? (tok0 + S - 1 - ((cc) * 128 + (j))) : (tok0 + (cc) * 128 + (j)))
  const int rt = (wid < 4) ? wid : 11 - wid;
  const int jrow = 16 * rt + l15;
  bf16x8 qf[8]; u32x4 kreg[8], vreg[2]; float g4[4] = {0.f, 0.f, 0.f, 0.f};
#define ML_LOAD_Q(cc) do { const bf16_t* qp = qkv + (size_t)TOKC(cc, jrow) * 3072 + head * 256 + 8 * g; \
    _Pragma("unroll") for (int kk = 0; kk < 8; ++kk) qf[kk] = *(const bf16x8*)(qp + 32 * kk); } while (0)
#define ML_LOAD_KV(cc) do { \
    _Pragma("unroll") for (int i = 0; i < 8; ++i) { const int row = (tid >> 5) + 16 * i; kreg[i] = *(const u32x4*)(qkv + (size_t)TOKC(cc, row) * 3072 + 1024 + head * 256 + (tid & 31) * 8); } \
    _Pragma("unroll") for (int i = 0; i < 2; ++i) { const int row = (tid >> 3) + 64 * i; vreg[i] = *(const u32x4*)(qkv + (size_t)TOKC(cc, row) * 3072 + 2048 + head * 256 + sl * 64 + (tid & 7) * 8); } \
    if (wid == 0) { const float* g0 = GT + (size_t)TOKC(cc, 2 * lane) * 16; const float* g1 = GT + (size_t)TOKC(cc, 2 * lane + 1) * 16; g4[0] = g0[gi_col]; g4[1] = g0[gf_col]; g4[2] = g1[gi_col]; g4[3] = g1[gf_col]; } } while (0)
#define ML_SCAN(tabp, mcur, mnext) do { LAS float* T_ = (LAS float*)(tabp); \
    const float lf0 = fminf(g4[1], 0.f) - log1pf(__expf(-fabsf(g4[1]))), lf1 = fminf(g4[3], 0.f) - log1pf(__expf(-fabsf(g4[3]))); \
    float s_ = lf0 + lf1; \
    _Pragma("unroll") for (int o = 1; o < 64; o <<= 1) { const float t_ = __shfl_up(s_, o); if (lane >= o) s_ += t_; } \
    const float b1_ = s_, b0_ = s_ - lf1; const float u0_ = g4[0] - b0_, u1_ = g4[2] - b1_; \
    float mx_ = fmaxf(u0_, u1_); \
    _Pragma("unroll") for (int o = 1; o < 64; o <<= 1) { const float t_ = __shfl_up(mx_, o); if (lane >= o) mx_ = fmaxf(mx_, t_); } \
    float ex_ = __shfl_up(mx_, 1); if (lane == 0) ex_ = -INFINITY; \
    const float M0_ = fmaxf(mcur, fmaxf(ex_, u0_)), M1_ = fmaxf(mcur, mx_); \
    T_[2 * lane] = u0_; T_[2 * lane + 1] = u1_; T_[128 + 2 * lane] = M0_; T_[128 + 2 * lane + 1] = M1_; T_[256 + 2 * lane] = b0_; T_[256 + 2 * lane + 1] = b1_; \
    const float Ml_ = __shfl(M1_, 63), bl_ = __shfl(b1_, 63); \
    if (lane == 0) { T_[384] = mcur; T_[385] = Ml_; } \
    mnext = bl_ + Ml_; } while (0)
  float mw0 = mst0;
  ML_LOAD_Q(0); ML_LOAD_KV(0);
  if (wid == 0) { float mn; ML_SCAN(lds + ML_T, mw0, mn); mw0 = mn; }
  __syncthreads();
  float m_final = 0.f;
  for (int c = 0; c < nc; ++c) {
    LAS float* T = (LAS float*)(lds + ML_T + (c & 1) * ML_TSZ);
    const float mst = T[384], M_last = T[385];
#pragma unroll
    for (int i = 0; i < 8; ++i) { const int row = (tid >> 5) + 16 * i; *(LAS u32x4*)(lds + ML_K + (row * KP + (tid & 31) * 8) * 2) = kreg[i]; }
#pragma unroll
    for (int i = 0; i < 2; ++i) { const int row = (tid >> 3) + 64 * i; const float w = __expf(T[row] - M_last); const u32x4 v = vreg[i]; u32x4 o;
      o.x = pack2(bflo(v.x) * w, bfhi(v.x) * w); o.y = pack2(bflo(v.y) * w, bfhi(v.y) * w); o.z = pack2(bflo(v.z) * w, bfhi(v.z) * w); o.w = pack2(bflo(v.w) * w, bfhi(v.w) * w);
      *(LAS u32x4*)(lds + ML_V + (row * VP + (tid & 7) * 8) * 2) = o; }
    if (tid < 128) *(LAS unsigned short*)(lds + ML_V + (tid * VP + 64) * 2) = f2bf(__expf(T[tid] - M_last));
#pragma unroll
    for (int dt = 0; dt < 2; ++dt) {
#pragma unroll
      for (int vt = 0; vt < 4; ++vt) { u32x2 w; w.x = pack2(Cacc[dt][vt][0], Cacc[dt][vt][1]); w.y = pack2(Cacc[dt][vt][2], Cacc[dt][vt][3]);
        *(LAS u32x2*)(lds + ML_C + (((2 * wid + dt) * 16 + l15) * CP + 16 * vt + 4 * g) * 2) = w; }
      if (g == 0) *(LAS unsigned short*)(lds + ML_C + (((2 * wid + dt) * 16 + l15) * CP + 64) * 2) = f2bf(nacc[dt][0]); }
    const int qtok = TOKC(c, jrow);
    const bool more = (c + 1 < nc);
    __syncthreads();
    const float Mj = T[128 + jrow], bj = T[256 + jrow]; const float rf = __expf(M_last - Mj), w_inter = __expf(mst - Mj);
    int lq_ = (8 * g + (l15 >> 2)), lp_ = 4 * (l15 & 3); asm volatile("" : "+v"(lq_), "+v"(lp_));
    const LP cB = lds + ML_C + (lq_ * CP + lp_) * 2, vB = lds + ML_V + (lq_ * VP + lp_) * 2, kB = lds + ML_K + (lq_ * KP + lp_ + 32 * wid) * 2;
    const LP pB = lds + ML_P + (jrow * PP + 8 * g) * 2;
    for (int st = 0; st <= rt; ++st) {
      f32x4 s = {0.f, 0.f, 0.f, 0.f};
      bf16x8 kfr[8];
#pragma unroll
      for (int kk = 0; kk < 8; ++kk) kfr[kk] = *(const LAS bf16x8*)(lds + ML_K + ((16 * st + l15) * KP + 32 * kk + 8 * g) * 2);
      __builtin_amdgcn_sched_barrier(0);
#pragma unroll
      for (int kk = 0; kk < 8; ++kk) s = __builtin_amdgcn_mfma_f32_16x16x32_bf16(kfr[kk], qf[kk], s, 0, 0, 0);
      float pv[4];
#pragma unroll
      for (int i = 0; i < 4; ++i) pv[i] = ((16 * st + 4 * g + i) <= jrow) ? s[i] * rf : 0.f;
      u32x2 w; w.x = pack2(pv[0], pv[1]); w.y = pack2(pv[2], pv[3]);
      *(LAS u32x2*)(lds + ML_P + (jrow * PP + 16 * st + 4 * g) * 2) = w;
    }
    if ((rt & 1) == 0) { u32x2 z; z.x = 0u; z.y = 0u; *(LAS u32x2*)(lds + ML_P + (jrow * PP + 16 * (rt + 1) + 4 * g) * 2) = z; }
    if (more) ML_LOAD_KV(c + 1);
    asm volatile("s_waitcnt lgkmcnt(0)" ::: "memory");
    f32x4 ha[5];
#pragma unroll
    for (int vt = 0; vt < 5; ++vt) { f32x4 a = {0.f, 0.f, 0.f, 0.f};
      if (smp || c > 0) {
        bf16x8 cfr[8];
#pragma unroll
        for (int kk = 0; kk < 8; ++kk) cfr[kk] = tr_at(cB, (32 * kk * CP + 16 * vt) * 2, CP * 2);
        __builtin_amdgcn_sched_barrier(0);
#pragma unroll
        for (int kk = 0; kk < 8; ++kk) a = __builtin_amdgcn_mfma_f32_16x16x32_bf16(cfr[kk], qf[kk], a, 0, 0, 0);
        a *= w_inter; }
      ha[vt] = a; }
    for (int k2 = 0; k2 <= (rt >> 1); ++k2) {
      const bf16x8 pf = *(const LAS bf16x8*)(pB + k2 * 64);
      bf16x8 vfr[5];
#pragma unroll
      for (int vt = 0; vt < 5; ++vt) vfr[vt] = tr_at(vB + k2 * (32 * VP * 2), (16 * vt) * 2, VP * 2);
      __builtin_amdgcn_sched_barrier(0);
#pragma unroll
      for (int vt = 0; vt < 5; ++vt) ha[vt] = __builtin_amdgcn_mfma_f32_16x16x32_bf16(vfr[vt], pf, ha[vt], 0, 0, 0); }
    { const float den = __shfl(ha[4][0], l15); const float rdd = 1.0f / fmaxf(fabsf(den), __expf(-(bj + Mj)));
#pragma unroll
      for (int vt = 0; vt < 4; ++vt) { const f32x4 a = ha[vt] * rdd; u32x2 w; w.x = pack2(a[0], a[1]); w.y = pack2(a[2], a[3]);
        *(u32x2*)(hout + (size_t)qtok * 1024 + head * 256 + sl * 64 + 16 * vt + 4 * g) = w; } }
    if (more) ML_LOAD_Q(c + 1);
    const bool need_state = (!smp) || more;
    if (need_state) {
      const float decay = __expf(mst - M_last);
#pragma unroll
      for (int dt = 0; dt < 2; ++dt) {
#pragma unroll
        for (int vt = 0; vt < 4; ++vt) Cacc[dt][vt] *= decay;
        nacc[dt] *= decay; }
#pragma unroll
      for (int ks = 0; ks < 4; ++ks) {
        const bf16x8 kf0 = tr_at(kB, (32 * ks * KP) * 2, KP * 2), kf1 = tr_at(kB, (32 * ks * KP + 16) * 2, KP * 2);
        bf16x8 vfr[5];
#pragma unroll
        for (int vt = 0; vt < 5; ++vt) vfr[vt] = tr_at(vB, (32 * ks * VP + 16 * vt) * 2, VP * 2);
        __builtin_amdgcn_sched_barrier(0);
#pragma unroll
        for (int vt = 0; vt < 4; ++vt) { Cacc[0][vt] = __builtin_amdgcn_mfma_f32_16x16x32_bf16(vfr[vt], kf0, Cacc[0][vt], 0, 0, 0); Cacc[1][vt] = __builtin_amdgcn_mfma_f32_16x16x32_bf16(vfr[vt], kf1, Cacc[1][vt], 0, 0, 0); }
        nacc[0] = __builtin_amdgcn_mfma_f32_16x16x32_bf16(vfr[4], kf0, nacc[0], 0, 0, 0); nacc[1] = __builtin_amdgcn_mfma_f32_16x16x32_bf16(vfr[4], kf1, nacc[1], 0, 0, 0);
      }
    }
    if (wid == 0 && more) { float mn; ML_SCAN(lds + ML_T + ((c + 1) & 1) * ML_TSZ, mw0, mn); mw0 = mn; }
    m_final = T[256 + 127] + M_last;
    __syncthreads();
  }
#undef ML_LOAD_Q
#undef ML_LOAD_KV
#undef ML_SCAN
#undef TOKC
  if (!smp) {
    float* oC = p.out + OUTF_C + (size_t)sidx * 65536;
#pragma unroll
    for (int dt = 0; dt < 2; ++dt) {
#pragma unroll
      for (int vt = 0; vt < 4; ++vt) *(f32x4*)(oC + (size_t)((2 * wid + dt) * 16 + l15) * 256 + sl * 64 + 16 * vt + 4 * g) = Cacc[dt][vt];
      if (sl == 0 && g == 0) p.out[OUTF_N + (size_t)sidx * 256 + (2 * wid + dt) * 16 + l15] = nacc[dt][0]; }
    if (sl == 0 && tid == 0) p.out[OUTF_M + sidx] = m_final;
  }
}

__device__ void combine_rows(const Params& p) {
  const int tid0 = opaque_tid(); const int wid = tid0 >> 6, lane = tid0 & 63;
  bf16_t* H = (bf16_t*)((unsigned char*)p.out + OUT_H); const bf16_t* HB = (const bf16_t*)((unsigned char*)p.out + OUT_HB); const float* nw = p.in[22];
  f32x4 wv[4];
#pragma unroll
  for (int i = 0; i < 4; ++i) wv[i] = *(const f32x4*)(nw + 16 * lane + 4 * i);
  for (int unit = blockIdx.x; unit < 768; unit += gridDim.x) {
    const int row0 = unit * 32 + wid * 4;
    u32x4 a[4][2], bq[4][2];
#pragma unroll
    for (int r = 0; r < 4; ++r)
#pragma unroll
      for (int i = 0; i < 2; ++i) { a[r][i] = *(const u32x4*)(H + (size_t)(row0 + r) * 1024 + 16 * lane + 8 * i); bq[r][i] = *(const u32x4*)(HB + (size_t)(row0 + r) * 1024 + 16 * lane + 8 * i); }
#pragma unroll
    for (int r = 0; r < 4; ++r) {
      f32x4 v[4]; float ss = 0.f;
#pragma unroll
      for (int i = 0; i < 2; ++i) { f32x4 x0, x1, y0, y1; unpack8(a[r][i], x0, x1); unpack8(bq[r][i], y0, y1); v[2 * i] = x0 + y0; v[2 * i + 1] = x1 + y1; }
#pragma unroll
      for (int i = 0; i < 4; ++i) ss += v[i][0] * v[i][0] + v[i][1] * v[i][1] + v[i][2] * v[i][2] + v[i][3] * v[i][3];
      ss += __shfl_xor(ss, 1); ss += __shfl_xor(ss, 2); ss += __shfl_xor(ss, 4); ss += __shfl_xor(ss, 8);
      const float rr = rsqrtf(ss * (1.0f / 256.0f) + 1e-6f);
#pragma unroll
      for (int i = 0; i < 2; ++i) *(u32x4*)(H + (size_t)(row0 + r) * 1024 + 16 * lane + 8 * i) = pack8(v[2 * i] * rr * wv[2 * i], v[2 * i + 1] * rr * wv[2 * i + 1]);
    }
  }
}

constexpr int HY_WAVE = 18816, HY_HR = 0, HY_ZA = 8576, HY_ZB = 8576 + 5120;
__device__ void hyena_item(const Params& p, LP lds, int item) {
  const int tid = opaque_tid(), wid = __builtin_amdgcn_readfirstlane(tid >> 6), lane = tid & 63, n31 = lane & 31, hh = lane >> 5;
  const bool smp = item < 1024; const int it = smp ? item : item - 1024; const int bset = it >> 7, cgp = it & 127; const int c = cgp * 8 + wid;
  const int L = smp ? 2048 : 256, lgL = smp ? 11 : 8, nblk = L >> 5, lgnb = lgL - 5, ntok = smp ? 2048 : 1024, ntile = smp ? 2 : 1, dmax = L >> 6;
  const int tok0 = smp ? NCTX + bset * 2048 : bset * 1024;
  LP wl = lds + wid * HY_WAVE; LAS float* hr = (LAS float*)(wl + HY_HR);
  const float* HFp = (const float*)(p.ws + (smp ? OFF_HFS : OFF_HFC));
  const bf16_t* UT = (const bf16_t*)(p.ws + OFF_BIG);
  const float* cw = p.in[12]; const float* cbv = p.in[13]; const float* skp = p.in[21];
  { const int uc = 2048 + c; const float w0 = cw[uc], w1 = cw[3072 + uc], w2 = cw[6144 + uc], cb = cbv[uc]; const bf16_t* src = UT + (size_t)uc * NTOK + tok0;
    u32x4 vv[4]; float pvv[4], nxv[4];
#pragma unroll
    for (int i = 0; i < 4; ++i) { const int base = lane * 8 + 512 * i; vv[i] = (u32x4){0u, 0u, 0u, 0u}; pvv[i] = 0.f; nxv[i] = 0.f;
      if (base < ntok) { vv[i] = *(const u32x4*)(src + base); const int tl = base & (L - 1);
        if (tl != 0) pvv[i] = bf2f(src[base - 1]); if (tl + 8 != L) nxv[i] = bf2f(src[base + 8]); } }
#pragma unroll
    for (int i = 0; i < 4; ++i) { const int base = lane * 8 + 512 * i;
      if (base < ntok) { const u32x4 v = vv[i];
        float u[10]; u[0] = pvv[i]; u[1] = bflo(v.x); u[2] = bfhi(v.x); u[3] = bflo(v.y); u[4] = bfhi(v.y); u[5] = bflo(v.z); u[6] = bfhi(v.z); u[7] = bflo(v.w); u[8] = bfhi(v.w); u[9] = nxv[i];
        float o[8];
#pragma unroll
        for (int e = 0; e < 8; ++e) o[e] = cb + w0 * u[e] + w1 * u[e + 1] + w2 * u[e + 2];
        u32x4 w; w.x = pack2(o[0], o[1]); w.y = pack2(o[2], o[3]); w.z = pack2(o[4], o[5]); w.w = pack2(o[6], o[7]);
        *(LAS u32x4*)(wl + HY_ZA + ((base >> 5) * 40 + (base & 31)) * 2) = w; } } }
  const int HRP = L + 96;
  f32x4 fvN[8];
#define HY_FLOAD(o) do { const float* src_ = HFp + (size_t)((o) * 1024 + c) * L; \
    _Pragma("unroll") for (int i = 0; i < 8; ++i) { const int q = lane + 64 * i; fvN[i] = (4 * q < L) ? *(const f32x4*)(src_ + 4 * q) : (f32x4){0.f, 0.f, 0.f, 0.f}; } } while (0)
  HY_FLOAD(0);
  for (int ord = 0; ord < 2; ++ord) {
    { float sa = 0.f;
      f32x4 fv[8];
#pragma unroll
      for (int i = 0; i < 8; ++i) fv[i] = fvN[i];
#pragma unroll
      for (int i = 0; i < 8; ++i) sa += (fabsf(fv[i][0]) + fabsf(fv[i][1])) + (fabsf(fv[i][2]) + fabsf(fv[i][3]));
      sa = wave_sum(sa); const float inv = 1.0f / (sa + 1e-6f);
      asm volatile("s_waitcnt lgkmcnt(0)" ::: "memory");
      LAS bf16_t* E = (LAS bf16_t*)hr; LAS bf16_t* O = E + HRP;
#pragma unroll
      for (int i = 0; i < 8; ++i) { const int q = lane + 64 * i;
        if (4 * q < L) {
#pragma unroll
          for (int e = 0; e < 4; ++e) { const int yy = L - 1 - (4 * q + e); const bf16_t v = f2bf(fv[i][e] * inv); E[32 + yy] = v; O[31 + yy] = v; } } }
      if (lane < 32) { E[lane] = 0; E[32 + L + lane] = 0; O[31 + L + lane] = 0; if (lane < 31) O[lane] = 0; }
      if (lane < 33) O[HRP - 33 + lane] = 0;
      asm volatile("s_waitcnt lgkmcnt(0)" ::: "memory"); }
    if (ord == 0) HY_FLOAD(1);
    LP zin = wl + (ord == 0 ? HY_ZA : HY_ZB); LP zout = wl + (ord == 0 ? HY_ZB : HY_ZA);
    const int gc = ord * 1024 + c; const float w0 = cw[gc], w1 = cw[3072 + gc], w2 = cw[6144 + gc], cb = cbv[gc], sk = skp[ord * 1024 + c];
    const bf16_t* gsrc = UT + (size_t)gc * NTOK + tok0;
    u32x4 gv[4]; unsigned gpv[4], gnx[4];
#pragma unroll
    for (int i = 0; i < 4; ++i) { const int base = lane * 8 + 512 * i; gv[i] = (u32x4){0u, 0u, 0u, 0u}; gpv[i] = 0u; gnx[i] = 0u;
      if (base < ntok) { gv[i] = *(const u32x4*)(gsrc + base); const int tl = base & (L - 1);
        if (tl != 0) gpv[i] = gsrc[base - 1]; if (tl + 8 != L) gnx[i] = gsrc[base + 8]; } }
    f32x16 accs[2];
#pragma unroll
    for (int o2 = 0; o2 < 2; ++o2)
#pragma unroll
      for (int r = 0; r < 16; ++r) accs[o2][r] = 0.f;
    LP fb = wl + HY_HR + ((n31 & 1) ? 0 : (HRP * 2 - 2)) + 2 * ((L >> 1) - 1 - n31 + 8 * hh + 32);
    int cbl[2], ca[2];
#pragma unroll
    for (int ot = 0; ot < 2; ++ot) { const int col = 32 * ot + n31; cbl[ot] = (col >> lgnb) << lgnb; ca[ot] = col & (nblk - 1); }
    const bool two = (ntile == 2);
    {
      LP zero = wl + HY_HR + 16 * hh;
      LP ap = fb + 64 * dmax;
      int bbr0 = ca[0] + dmax, bbr1 = ca[1] + dmax;
      LP bp0 = zin + ((cbl[0] + bbr0) * 40 + 8 * hh) * 2, bp1 = zin + ((cbl[1] + bbr1) * 40 + 8 * hh) * 2;
      for (int d = -dmax; d <= dmax; ++d) {
        u32x4 w0v, w1v;
        w0v.x = *(const LAS unsigned*)(ap); w0v.y = *(const LAS unsigned*)(ap + 4); w0v.z = *(const LAS unsigned*)(ap + 8); w0v.w = *(const LAS unsigned*)(ap + 12);
        w1v.x = *(const LAS unsigned*)(ap + 32); w1v.y = *(const LAS unsigned*)(ap + 36); w1v.z = *(const LAS unsigned*)(ap + 40); w1v.w = *(const LAS unsigned*)(ap + 44);
        const bf16x8 af0 = __builtin_bit_cast(bf16x8, w0v), af1 = __builtin_bit_cast(bf16x8, w1v);
        LP q0 = ((unsigned)bbr0 < (unsigned)nblk) ? bp0 : zero;
        LP q1 = (two && ((unsigned)bbr1 < (unsigned)nblk)) ? bp1 : zero;
        const bf16x8 b00 = *(const LAS bf16x8*)q0, b01 = *(const LAS bf16x8*)(q0 + 32);
        const bf16x8 b10 = *(const LAS bf16x8*)q1, b11 = *(const LAS bf16x8*)(q1 + 32);
        __builtin_amdgcn_sched_barrier(0);
        accs[0] = __builtin_amdgcn_mfma_f32_32x32x16_bf16(af0, b00, accs[0], 0, 0, 0);
        if (two) accs[1] = __builtin_amdgcn_mfma_f32_32x32x16_bf16(af0, b10, accs[1], 0, 0, 0);
        accs[0] = __builtin_amdgcn_mfma_f32_32x32x16_bf16(af1, b01, accs[0], 0, 0, 0);
        if (two) accs[1] = __builtin_amdgcn_mfma_f32_32x32x16_bf16(af1, b11, accs[1], 0, 0, 0);
        ap -= 64; bbr0 -= 1; bbr1 -= 1; bp0 -= 80; bp1 -= 80;
      }
    }
#pragma unroll
    for (int ot = 0; ot < 2; ++ot) {
      if (ot >= ntile) continue;
      const f32x16 acc = accs[ot];
#pragma unroll
      for (int rg = 0; rg < 4; ++rg) {
        const int zo = (((cbl[ot] + ca[ot]) * 40) + 8 * rg + 4 * hh) * 2;
        const u32x2 zv = *(const LAS u32x2*)(zin + zo);
        u32x2 w; w.x = pack2(acc[4 * rg] + sk * bflo(zv.x), acc[4 * rg + 1] + sk * bfhi(zv.x)); w.y = pack2(acc[4 * rg + 2] + sk * bflo(zv.y), acc[4 * rg + 3] + sk * bfhi(zv.y));
        *(LAS u32x2*)(zout + zo) = w;
      }
    }
    asm volatile("s_waitcnt lgkmcnt(0)" ::: "memory");
#pragma unroll
    for (int i = 0; i < 4; ++i) { const int base = lane * 8 + 512 * i;
      if (base < ntok) { const u32x4 v = gv[i];
        float u[10]; u[0] = bf2f(gpv[i]); u[1] = bflo(v.x); u[2] = bfhi(v.x); u[3] = bflo(v.y); u[4] = bfhi(v.y); u[5] = bflo(v.z); u[6] = bfhi(v.z); u[7] = bflo(v.w); u[8] = bfhi(v.w); u[9] = bf2f(gnx[i]);
        LP zp = zout + ((base >> 5) * 40 + (base & 31)) * 2; const u32x4 t = *(const LAS u32x4*)zp;
        float tv[8]; tv[0] = bflo(t.x); tv[1] = bfhi(t.x); tv[2] = bflo(t.y); tv[3] = bfhi(t.y); tv[4] = bflo(t.z); tv[5] = bfhi(t.z); tv[6] = bflo(t.w); tv[7] = bfhi(t.w);
        float o[8];
#pragma unroll
        for (int e = 0; e < 8; ++e) o[e] = (cb + w0 * u[e] + w1 * u[e + 1] + w2 * u[e + 2]) * tv[e];
        u32x4 w; w.x = pack2(o[0], o[1]); w.y = pack2(o[2], o[3]); w.z = pack2(o[4], o[5]); w.w = pack2(o[6], o[7]);
        *(LAS u32x4*)zp = w; } }
    asm volatile("s_waitcnt lgkmcnt(0)" ::: "memory");
  }
  __syncthreads();
  { bf16_t* YH = (bf16_t*)((unsigned char*)p.out + OUT_HB);
    for (int tl = tid; tl < ntok; tl += 512) {
      const int bl = tl >> lgL, tloc = tl & (L - 1); const int zo = ((((bl << lgnb) + (tloc >> 5)) * 40) + (tloc & 31)) * 2;
      unsigned short e[8];
#pragma unroll
      for (int w = 0; w < 8; ++w) e[w] = *(const LAS unsigned short*)(lds + w * HY_WAVE + HY_ZA + zo);
      u32x4 o; o.x = e[0] | ((unsigned)e[1] << 16); o.y = e[2] | ((unsigned)e[3] << 16); o.z = e[4] | ((unsigned)e[5] << 16); o.w = e[6] | ((unsigned)e[7] << 16);
      *(u32x4*)(YH + (size_t)(tok0 + tl) * 1024 + cgp * 8) = o; } }
  __syncthreads();
}

__device__ void final_norm(const Params& p) {
  const int tid0 = opaque_tid(); const int wid = tid0 >> 6, lane = tid0 & 63; const float* fw = p.in[31];
  const float* P = (const float*)(p.ws + OFF_BIG + (size_t)8192 * 4096 * 2); const float* mod = (const float*)(p.ws + OFF_MOD);
  f32x4 wv[4];
#pragma unroll
  for (int i = 0; i < 4; ++i) wv[i] = *(const f32x4*)(fw + 4 * lane + 256 * i);
  for (int unit = blockIdx.x; unit < 768; unit += gridDim.x) {
    const int row0 = unit * 32 + wid * 4; const bool chunkB = row0 >= 16384;
    f32x4 x[4][4];
#pragma unroll
    for (int r = 0; r < 4; ++r)
#pragma unroll
      for (int i = 0; i < 4; ++i) x[r][i] = *(const f32x4*)(p.out + (size_t)(row0 + r) * 1024 + 4 * lane + 256 * i);
    if (chunkB) { const float* md = mod + cond_of_row(row0) * 6144 + 5120;
#pragma unroll
      for (int i = 0; i < 4; ++i) { const f32x4 g2 = *(const f32x4*)(md + 4 * lane + 256 * i);
#pragma unroll
        for (int r = 0; r < 4; ++r) x[r][i] += g2 * *(const f32x4*)(P + (size_t)(row0 + r - 16384) * 1024 + 4 * lane + 256 * i); } }
#pragma unroll
    for (int r = 0; r < 4; ++r) { float ss = 0.f;
#pragma unroll
      for (int i = 0; i < 4; ++i) ss += x[r][i][0] * x[r][i][0] + x[r][i][1] * x[r][i][1] + x[r][i][2] * x[r][i][2] + x[r][i][3] * x[r][i][3];
      ss = wave_sum(ss); const float rstd = rsqrtf(ss * (1.0f / 1024.0f) + 1e-6f);
#pragma unroll
      for (int i = 0; i < 4; ++i) *(f32x4*)(p.out + (size_t)(row0 + r) * 1024 + 4 * lane + 256 * i) = x[r][i] * rstd * wv[i]; }
  }
}

__global__ void __launch_bounds__(512, 2) __attribute__((flatten)) mega(Params p) {
  extern __shared__ __attribute__((aligned(16))) unsigned char shm[];
  LP lds = (LP)shm;
  cg::grid_group grid = cg::this_grid();
  volatile LAS unsigned* xst = (volatile LAS unsigned*)(lds + LDS_BYTES - 16);
  if (threadIdx.x == 0) { xst[0] = 0u; xst[1] = 0u; }
  __syncthreads();
  const XcdBarrier xb = xcd_barrier_post((unsigned*)(p.ws + OFF_BAR), xst);
  unsigned char* ws = p.ws;
  const bf16_t* WT = (const bf16_t*)(ws + OFF_WT); const bf16_t* HN = (const bf16_t*)(ws + OFF_HN); bf16_t* BIG = (bf16_t*)(ws + OFF_BIG);
  bf16_t* Hb = (bf16_t*)((unsigned char*)p.out + OUT_H); bf16_t* YH = (bf16_t*)((unsigned char*)p.out + OUT_HB);
  const float* mod = (const float*)(ws + OFF_MOD);
  phase0(p, lds);
  if (gridDim.y == 7u) grid.sync();
  xcd_barrier(xb);
  phase1(p, lds);
  weight_tiles(p, lds);
  xcd_barrier(xb);
  { EpiQKV e; e.O = BIG; e.bias = p.in[11]; run_gemm(lds, HN, WT, NTOK, 3072, 1024, e); }
  xcd_barrier(xb);
  for (int item = blockIdx.x; item < 1280; item += gridDim.x) mlstm_item(p, lds, item);
  xcd_barrier(xb);
  combine_rows(p);
  { EpiUT e; e.O = BIG; e.bias = p.in[11] + 4112; run_gemm(lds, WT + (size_t)3072 * 1024, HN, 3072, NTOK, 1024, e); }
  xcd_barrier(xb);
  for (int item = blockIdx.x; item < 2048; item += gridDim.x) hyena_item(p, lds, item);
  xcd_barrier(xb);
  { EpiGates e; e.H = Hb; e.G = BIG; e.b_in = p.in[11]; run_gemm(lds, HN, WT + (size_t)6144 * 1024, NTOK, 3072, 1024, e); }
  xcd_barrier(xb);
  bf16_t* T = BIG + (size_t)NTOK * 2048;
  { EpiMerge<0> e; e.T = T; e.G = BIG; run_gemm(lds, Hb, (const bf16_t*)(ws + OFF_WBM), NTOK, 1024, 1024, e); }
  { EpiMerge<1> e; e.T = T; e.G = BIG; run_gemm(lds, YH, (const bf16_t*)(ws + OFF_WBH), NTOK, 1024, 1024, e); }
  xcd_barrier(xb);
  { EpiOut e; e.xp = p.in[0]; e.xs = p.in[1]; e.per = (const float*)(ws + OFF_PER); e.pec = (const float*)(ws + OFF_PEC); e.mod = mod; e.n2w = p.in[26];
    e.X1 = p.out; e.A2 = (bf16_t*)(ws + OFF_HN); e.ssq = (float*)(ws + OFF_SSQ1); run_gemm(lds, T, (const bf16_t*)(ws + OFF_WOUT), NTOK, 1024, 1024, e); }
  xcd_barrier(xb);
  constexpr int ROWS_A = 16384, ROWS_B = NTOK - ROWS_A;
  { EpiFF1 e; e.row0 = 0; e.ssq = (const float*)(p.ws + OFF_SSQ1); e.c1 = (const float*)(p.ws + OFF_C1); e.Hd = (bf16_t*)(p.ws + OFF_BIG);
    run_gemm(lds, (const bf16_t*)(p.ws + OFF_HN), (const bf16_t*)(p.ws + OFF_W1T), ROWS_A, 4096, 1024, e); }
  xcd_barrier(xb);
  { EpiFF2 e; e.row0 = 0; e.mod = (const float*)(p.ws + OFF_MOD); e.b2 = p.in[30]; e.X = p.out; e.P = (float*)(p.ws + OFF_BIG + (size_t)ROWS_A * 4096 * 2);
    run_gemm(lds, (const bf16_t*)(p.ws + OFF_BIG), (const bf16_t*)(p.ws + OFF_W2T), ROWS_A, 1024, 4096, e); }
  xcd_barrier(xb);
  { EpiFF1 e; e.row0 = ROWS_A; e.ssq = (const float*)(p.ws + OFF_SSQ1); e.c1 = (const float*)(p.ws + OFF_C1); e.Hd = (bf16_t*)(p.ws + OFF_BIG);
    run_gemm(lds, (const bf16_t*)(p.ws + OFF_HN) + (size_t)ROWS_A * 1024, (const bf16_t*)(p.ws + OFF_W1T), ROWS_B, 4096, 1024, e); }
  xcd_barrier(xb);
  { EpiFF2 e; e.row0 = ROWS_A; e.mod = (const float*)(p.ws + OFF_MOD); e.b2 = p.in[30]; e.X = p.out; e.P = (float*)(p.ws + OFF_BIG + (size_t)ROWS_B * 4096 * 2);
    run_gemm(lds, (const bf16_t*)(p.ws + OFF_BIG), (const bf16_t*)(p.ws + OFF_W2T), ROWS_B, 1024, 4096, e, 2); }
  xcd_barrier(xb);
  final_norm(p);
}

extern "C" void kernel_launch(void* const* d_in, const int* in_sizes, int n_in, void* d_out, int out_size, void* d_ws, size_t ws_size, hipStream_t stream) {
  static int grid_blocks = 0;
  if (!grid_blocks) {
    int dev = 0, cus = 0, per_cu = 0;
    hipGetDevice(&dev);
    hipDeviceGetAttribute(&cus, hipDeviceAttributeMultiprocessorCount, dev);
    hipFuncSetAttribute((const void*)mega, hipFuncAttributeMaxDynamicSharedMemorySize, LDS_BYTES);
    hipOccupancyMaxActiveBlocksPerMultiprocessor(&per_cu, (const void*)mega, 512, LDS_BYTES);
    if (per_cu < 1) { fprintf(stderr, "kernel_launch: occupancy query reports %d blocks per CU\n", per_cu); grid_blocks = -1; }
    else grid_blocks = cus;
    if (n_in != 32 || ws_size < WS_END) { fprintf(stderr, "kernel_launch: unexpected n_in %d / ws_size %zu (need %zu)\n", n_in, ws_size, (size_t)WS_END); grid_blocks = -1; }
  }
  if (grid_blocks < 0) return;
  hipMemsetAsync((unsigned char*)d_ws + OFF_BAR, 0, 3456 * 4, stream);
  Params p{};
  for (int i = 0; i < 32; ++i) p.in[i] = (const float*)d_in[i];
  p.out = (float*)d_out; p.ws = (unsigned char*)d_ws;
  void* args[] = {&p};
  hipError_t e = hipLaunchCooperativeKernel((void*)mega, dim3(grid_blocks), dim3(512), args, LDS_BYTES, stream);
  if (e != hipSuccess) fprintf(stderr, "cooperative launch failed: %s (grid %d)\n", hipGetErrorString(e), grid_blocks);
}
```

```cpp
#include <hip/hip_runtime.h>
#include <hip/hip_cooperative_groups.h>
#include <cstdio>
#include <cstdint>
namespace cg = cooperative_groups;

#define LAS __attribute__((address_space(3)))
typedef LAS unsigned char* LP;
typedef unsigned short bf16_t;
typedef short bf16x8 __attribute__((ext_vector_type(8)));
typedef short s16x4 __attribute__((ext_vector_type(4)));
typedef float f32x4 __attribute__((ext_vector_type(4)));
typedef float f32x16 __attribute__((ext_vector_type(16)));
typedef unsigned u32x4 __attribute__((ext_vector_type(4)));
typedef unsigned u32x2 __attribute__((ext_vector_type(2)));

constexpr int DM = 1024, NTOK = 24576, NCTX = 8192, SEQC = 256, SEQS = 2048, INC = 9232;
constexpr int LDS_BYTES = 160 * 1024;
constexpr size_t OFF_WT = 0;
constexpr size_t OFF_WBM = 18874368, OFF_WBH = 20971520, OFF_WOUT = 23068672, OFF_W1T = 25165824, OFF_W2T = 33554432;
constexpr size_t OFF_HN = 41943040;
constexpr size_t OFF_BIG = 92274688;
constexpr size_t OFF_SM = 243269632;
constexpr size_t OFF_MOD = OFF_SM;
constexpr size_t OFF_C1 = OFF_MOD + 221184;
constexpr size_t OFF_H2S = OFF_C1 + 147456;
constexpr size_t OFF_H2C = OFF_H2S + 524288;
constexpr size_t OFF_PER = OFF_H2C + 65536;
constexpr size_t OFF_PEC = OFF_PER + 65536;
constexpr size_t OFF_GT = OFF_PEC + 131072;
constexpr size_t OFF_SSQ1 = OFF_GT + 1572864;
constexpr size_t OFF_SSQ2 = OFF_SSQ1 + 1572864;
constexpr size_t OFF_HFS = OFF_SSQ2 + 1572864;
constexpr size_t OFF_HFC = OFF_HFS + 16777216;
constexpr size_t OFF_BAR = OFF_HFC + 2097152;
constexpr size_t WS_END = OFF_BAR + 3456 * 4;
constexpr size_t OUT_H = 0, OUT_HB = 50331648;
constexpr size_t OUTF_C = 25165824, OUTF_N = 41943040, OUTF_M = 42008576;

struct Params { const float* in[32]; float* out; unsigned char* ws; };

__device__ __forceinline__ bf16_t f2bf(float f) { unsigned u = __float_as_uint(f); u += 0x7FFFu + ((u >> 16) & 1u); return (bf16_t)(u >> 16); }
__device__ __forceinline__ float bf2f(unsigned b) { return __uint_as_float(b << 16); }
__device__ __forceinline__ unsigned pack2(float lo, float hi) { return (unsigned)f2bf(lo) | ((unsigned)f2bf(hi) << 16); }
__device__ __forceinline__ float bflo(unsigned w) { return __uint_as_float(w << 16); }
__device__ __forceinline__ float bfhi(unsigned w) { return __uint_as_float(w & 0xffff0000u); }
__device__ __forceinline__ float sigmoidf_(float x) { return 1.0f / (1.0f + __expf(-x)); }
__device__ __forceinline__ int opaque_tid() { int t = threadIdx.x; asm volatile("" : "+v"(t)); return t; }
__device__ __forceinline__ float wave_sum(float v) {
#pragma unroll
  for (int o = 32; o >= 1; o >>= 1) v += __shfl_xor(v, o);
  return v;
}


#define XB_TMO      128
#define XB_XCNT(j)  (256  + 64 * (j))
#define XB_XSUB(j)  (1280 + 64 * (j))
#define XB_XGEN(j)  (2304 + 64 * (j))
#define XB_TOP      3328
#define XB_TOPGEN   3392
#define XCD_BAR_WORDS 3456
#define XB_SPIN_CAP (1u << 18)
__device__ __forceinline__ unsigned xb_ld(unsigned* p)              { return __hip_atomic_load(p, __ATOMIC_RELAXED, __HIP_MEMORY_SCOPE_AGENT); }
__device__ __forceinline__ unsigned xb_add(unsigned* p, unsigned v) { return __hip_atomic_fetch_add(p, v, __ATOMIC_RELAXED, __HIP_MEMORY_SCOPE_AGENT); }
__device__ __forceinline__ unsigned xb_xcc_id() { return (unsigned)__builtin_amdgcn_s_getreg((3 << 11) | 20) & 0xFu; }
#define XB_SPIN(cond, bar) do { unsigned _sp = 0; while (cond) { __builtin_amdgcn_s_sleep(1); \
    if ((++_sp & 255u) == 0u) { if (xb_ld(&(bar)[XB_TMO])) break; if (_sp > XB_SPIN_CAP) { atomicAdd(&(bar)[XB_TMO], 1u); break; } } } } while (0)
struct XcdBarrier { unsigned* bar; unsigned x; volatile LAS unsigned* st; };
__device__ __forceinline__ XcdBarrier xcd_barrier_post(unsigned* bar, volatile LAS unsigned* st) {
  XcdBarrier b; b.bar = bar; b.x = xb_xcc_id(); b.st = st;
  if (threadIdx.x == 0) (void)xb_add(&bar[XB_XCNT(b.x)], 1u);
  return b;
}
__device__ __forceinline__ void xcd_barrier_complete(unsigned* bar, unsigned x, unsigned& nloc, unsigned& nx) {
  const unsigned G = gridDim.x * gridDim.y * gridDim.z;
  unsigned sum, cnt, mine, sp = 0u;
  for (;;) {
    sum = 0u; cnt = 0u; mine = 0u;
#pragma unroll
    for (unsigned j = 0; j < 16; ++j) { const unsigned c = xb_ld(&bar[XB_XCNT(j)]); sum += c; cnt += (c > 0u) ? 1u : 0u; mine = (j == x) ? c : mine; }
    if (sum == G) break;
    __builtin_amdgcn_s_sleep(1);
    if ((++sp & 255u) == 0u) { if (xb_ld(&bar[XB_TMO])) break; if (sp > XB_SPIN_CAP) { atomicAdd(&bar[XB_TMO], 1u); break; } }
  }
  nloc = mine > 0u ? mine : 1u; nx = cnt > 0u ? cnt : 1u;
}
__device__ __forceinline__ void xcd_barrier(const XcdBarrier& b) {
  asm volatile("s_waitcnt vmcnt(0)" ::: "memory");
  __syncthreads();
  if (threadIdx.x == 0) {
    unsigned* bar = b.bar;
    __builtin_amdgcn_s_waitcnt(0);
    unsigned nloc = b.st[0], nx = b.st[1];
    if (nloc == 0u) { xcd_barrier_complete(bar, b.x, nloc, nx); b.st[0] = nloc; b.st[1] = nx; }
    const unsigned old = xb_add(&bar[XB_XSUB(b.x)], 1u);
    const unsigned gen = old / nloc;
    if (old + 1u == (gen + 1u) * nloc) {
      __builtin_amdgcn_fence(__ATOMIC_RELEASE, "agent");
      asm volatile("s_waitcnt vmcnt(0)" ::: "memory");
      const unsigned og = xb_add(&bar[XB_TOP], 1u);
      const unsigned tg = og / nx;
      if (og + 1u == (tg + 1u) * nx) xb_add(&bar[XB_TOPGEN], 1u);
      else XB_SPIN(xb_ld(&bar[XB_TOPGEN]) == tg, bar);
      __builtin_amdgcn_fence(__ATOMIC_ACQUIRE, "agent");
      xb_add(&bar[XB_XGEN(b.x)], 1u);
      asm volatile("s_waitcnt vmcnt(0)" ::: "memory");
    } else {
      XB_SPIN(xb_ld(&bar[XB_XGEN(b.x)]) == gen, bar);
      __builtin_amdgcn_fence(__ATOMIC_ACQUIRE, "agent");
      asm volatile("s_waitcnt vmcnt(0)" ::: "memory");
    }
  }
  __syncthreads();
}

namespace pg8 {
constexpr int BM = 256, BK = 64, HALF = 128, HTB = HALF * BK * 2, STAGE_BYTES = 8 * HTB, NXCD = 8, WGM = 8;
__host__ __device__ __forceinline__ int lds_byte(int r, int c) { const int st = (r >> 4) * 2 + (c >> 5), rr = r & 15, cc = c & 31, ob = rr * 64 + cc * 2; return st * 1024 + (ob ^ (((ob >> 9) & 1) << 5)); }
__host__ __device__ __forceinline__ void stage_rc(int b, int& R, int& C) { const int st = b / 1024, sb = b % 1024, swz = sb ^ (((sb >> 9) & 1) << 5); R = (st >> 1) * 16 + swz / 64; C = (st & 1) * 32 + (swz % 64) / 2; }
__host__ __device__ __forceinline__ int perm32(int rho) { const int n = rho >> 4, i = rho & 15; return 8 * (i >> 2) + 4 * n + (i & 3); }
struct Unit { int pm, pn, ks; };
struct Gemm { const bf16_t* A; const bf16_t* Bt; int M, N, K, ld, nks; };
struct StaticOrder {
  int nM, nN, ntile, nwg, G, c;
  __device__ void init(int M, int N, int nks, int G_, int c_) { nM = M / BM; nN = N / BM; ntile = nM * nN; nwg = ntile * nks; G = G_; c = c_; }
  __device__ bool next(int i, Unit& u) const {
    const long L = (long)i * G + c; if (L >= nwg) return false;
    u.ks = (int)L / ntile; int wgid = (int)L - u.ks * ntile;
    { const int q = ntile / NXCD, r = ntile % NXCD, xcd = wgid % NXCD, off = wgid / NXCD; wgid = (xcd < r ? xcd * (q + 1) : r * (q + 1) + (xcd - r) * q) + off; }
    const int nig = WGM * nN, gid = wgid / nig, fm = gid * WGM, gsz = (nM - fm) < WGM ? (nM - fm) : WGM;
    u.pm = fm + ((wgid % nig) % gsz); u.pn = (wgid % nig) / gsz; return true;
  }
};

template <class Epi>
__device__ __forceinline__ void gemm_phase(LP lds, const Gemm g, const StaticOrder& S, const Epi& E) {
  int tid_ = threadIdx.x; asm volatile("" : "+v"(tid_));
  const int tid = tid_, wid = __builtin_amdgcn_readfirstlane(tid >> 6), lane = tid & 63, wr = wid >> 2, wc = wid & 3, fr = lane & 15, fq = lane >> 4;
  const int K = g.ld, nt = g.K / BK;
  const size_t ksb = (size_t)g.K * 2;
  unsigned voffA[2], voffB[2];
#pragma unroll
  for (int i = 0; i < 2; ++i) { int R, C; stage_rc(tid * 16 + i * 8192, R, C); const int Rb = (R & ~31) + perm32(R & 31); voffA[i] = (unsigned)(R * K + C) * 2u; voffB[i] = (unsigned)(Rb * K + C) * 2u; }
  const size_t kstep = (size_t)(BK * 2);
  const size_t hstep = (size_t)HALF * K * 2;
  const size_t tstep = 2 * hstep;
  const unsigned ldsw = (unsigned)wid * 1024u;
  const int aoff = lds_byte(wr * 64 + fr, fq * 8), boff = lds_byte(wc * 32 + fr, fq * 8);
#define PG8_SA(b, h) (((b) * 2 + (h)) * HTB)
#define PG8_SB(b, h) ((4 + (b) * 2 + (h)) * HTB)
#define PG8_STAGE(bufoff, gbase, voff) do { _Pragma("unroll") for (int _i = 0; _i < 2; ++_i) \
    __builtin_amdgcn_global_load_lds((const unsigned*)((const char*)(gbase) + (voff)[_i]), (LAS unsigned*)(lds + (bufoff) + ldsw + _i * 8192), 16, 0, 0); } while (0)
#define PG8_LDA(dst, b, h) do { _Pragma("unroll") for (int m = 0; m < 4; ++m) _Pragma("unroll") for (int k = 0; k < 2; ++k) dst[m][k] = *(const LAS bf16x8*)(lds + PG8_SA(b, h) + aoff + m * 2048 + k * 1024); } while (0)
#define PG8_LDB(dst, b, h) do { _Pragma("unroll") for (int n = 0; n < 2; ++n) _Pragma("unroll") for (int k = 0; k < 2; ++k) dst[n][k] = *(const LAS bf16x8*)(lds + PG8_SB(b, h) + boff + n * 2048 + k * 1024); } while (0)
#define PG8_MMA(ai, bj, At, Bt) do { __builtin_amdgcn_s_setprio(1); _Pragma("unroll") for (int m = 0; m < 4; ++m) _Pragma("unroll") for (int n = 0; n < 2; ++n) _Pragma("unroll") for (int k = 0; k < 2; ++k) \
    acc[ai][bj][m][n] = __builtin_amdgcn_mfma_f32_16x16x32_bf16(Bt[n][k], At[m][k], acc[ai][bj][m][n], 0, 0, 0); __builtin_amdgcn_s_setprio(0); } while (0)
#define PG8_WAIT_V(n) asm volatile("s_waitcnt vmcnt(" #n ")" ::: "memory")
#define PG8_WAIT_L(n) asm volatile("s_waitcnt lgkmcnt(" #n ")" ::: "memory")
#define PG8_BAR __builtin_amdgcn_s_barrier()
#define PG8_SCHED __builtin_amdgcn_sched_barrier(0)
  Unit cur, nxt; int ui = 0;
  if (!S.next(0, cur)) return;
  f32x4 acc[2][2][4][2];
#pragma unroll
  for (int a = 0; a < 2; ++a)
#pragma unroll
    for (int b = 0; b < 2; ++b)
#pragma unroll
      for (int m = 0; m < 4; ++m)
#pragma unroll
        for (int n = 0; n < 2; ++n) acc[a][b][m][n] = (f32x4){0.f, 0.f, 0.f, 0.f};
  bf16x8 At[4][2], B0[2][2], B1[2][2];
  const char* cA = (const char*)g.A + (size_t)cur.pm * tstep + cur.ks * ksb; const char* cB = (const char*)g.Bt + (size_t)cur.pn * tstep + cur.ks * ksb;
  PG8_STAGE(PG8_SB(0, 0), cB, voffB); PG8_STAGE(PG8_SA(0, 0), cA, voffA); PG8_STAGE(PG8_SB(0, 1), cB + hstep, voffB); PG8_STAGE(PG8_SA(0, 1), cA + hstep, voffA);
  if (wr == 1) PG8_BAR;
  PG8_WAIT_V(4); PG8_BAR;
  PG8_STAGE(PG8_SB(1, 0), cB + kstep, voffB); PG8_STAGE(PG8_SA(1, 0), cA + kstep, voffA); PG8_STAGE(PG8_SB(1, 1), cB + hstep + kstep, voffB);
  PG8_WAIT_V(6); PG8_BAR;
  for (;;) {
    const bool has_next = S.next(ui + 1, nxt);
    const char* nA = has_next ? (const char*)g.A + (size_t)nxt.pm * tstep + nxt.ks * ksb : cA; const char* nB = has_next ? (const char*)g.Bt + (size_t)nxt.pn * tstep + nxt.ks * ksb : cB;
    for (int t = 0; t < nt; t += 2) {
      const bool last = (t == nt - 2);
      const char* a1 = cA + (size_t)(t + 1) * kstep;
      const char* a2 = last ? nA : cA + (size_t)(t + 2) * kstep; const char* b2 = last ? nB : cB + (size_t)(t + 2) * kstep;
      const char* a3 = a2 + kstep; const char* b3 = b2 + kstep;
      PG8_LDB(B0, 0, 0); PG8_SCHED; PG8_LDA(At, 0, 0); PG8_STAGE(PG8_SA(1, 1), a1 + hstep, voffA);
      PG8_WAIT_L(8); PG8_BAR; PG8_WAIT_L(0); PG8_MMA(0, 0, At, B0); PG8_BAR; PG8_SCHED;
      PG8_LDB(B1, 0, 1); PG8_STAGE(PG8_SB(0, 0), b2, voffB);
      PG8_BAR; PG8_WAIT_L(0); PG8_MMA(0, 1, At, B1); PG8_BAR;
      PG8_LDA(At, 0, 1); PG8_STAGE(PG8_SA(0, 0), a2, voffA);
      PG8_BAR; PG8_WAIT_L(0); PG8_MMA(1, 0, At, B0); PG8_BAR; PG8_SCHED;
      PG8_STAGE(PG8_SB(0, 1), b2 + hstep, voffB);
      PG8_WAIT_V(6); PG8_BAR; PG8_MMA(1, 1, At, B1); PG8_BAR;
      PG8_LDB(B0, 1, 0); PG8_SCHED; PG8_LDA(At, 1, 0); PG8_STAGE(PG8_SA(0, 1), a2 + hstep, voffA);
      PG8_WAIT_L(8); PG8_BAR; PG8_WAIT_L(0); PG8_MMA(0, 0, At, B0); PG8_BAR; PG8_SCHED;
      PG8_LDB(B1, 1, 1); PG8_STAGE(PG8_SB(1, 0), b3, voffB);
      PG8_BAR; PG8_WAIT_L(0); PG8_MMA(0, 1, At, B1); PG8_BAR;
      PG8_LDA(At, 1, 1); PG8_STAGE(PG8_SA(1, 0), a3, voffA);
      PG8_BAR; PG8_WAIT_L(0); PG8_MMA(1, 0, At, B0); PG8_BAR; PG8_SCHED;
      PG8_STAGE(PG8_SB(1, 1), b3 + hstep, voffB);
      PG8_WAIT_V(6); PG8_BAR; PG8_MMA(1, 1, At, B1); PG8_BAR;
    }
    { int fr2 = fr, fq2 = fq; asm volatile("" : "+v"(fr2), "+v"(fq2)); E(acc, cur, wr, wc, fr2, fq2); }
    if (!has_next) break;
#pragma unroll
    for (int a = 0; a < 2; ++a)
#pragma unroll
      for (int b = 0; b < 2; ++b)
#pragma unroll
        for (int m = 0; m < 4; ++m)
#pragma unroll
          for (int n = 0; n < 2; ++n) acc[a][b][m][n] = (f32x4){0.f, 0.f, 0.f, 0.f};
    cur = nxt; cA = nA; cB = nB; ++ui;
  }
  PG8_WAIT_V(0);
  if (wr == 0) PG8_BAR;
  PG8_BAR;
#undef PG8_SA
#undef PG8_SB
#undef PG8_STAGE
#undef PG8_LDA
#undef PG8_LDB
#undef PG8_MMA
#undef PG8_WAIT_V
#undef PG8_WAIT_L
#undef PG8_BAR
#undef PG8_SCHED
}
}
using pg8::Unit;
typedef f32x4 AccT[2][2][4][2];

#define EPI_ROW(ai, m) (u.pm * 256 + (ai) * 128 + wr * 64 + (m) * 16 + fr)
#define EPI_COL(bj, n) (u.pn * 256 + (bj) * 128 + wc * 32 + 8 * fq + 4 * (n))
#define EPI_LOOP_ROWS _Pragma("unroll") for (int ai = 0; ai < 2; ++ai) _Pragma("unroll") for (int m = 0; m < 4; ++m)
#define EPI_LOOP_COLS _Pragma("unroll") for (int bj = 0; bj < 2; ++bj) _Pragma("unroll") for (int n = 0; n < 2; ++n)

__device__ __forceinline__ int cond_of_row(int row) { return row < NCTX ? 0 : 1 + ((row - NCTX) >> 11); }

#define EPI_LOOP_BJ _Pragma("unroll") for (int bj = 0; bj < 2; ++bj)
__device__ __forceinline__ u32x4 pack8(const f32x4 v0, const f32x4 v1) { u32x4 w; w.x = pack2(v0[0], v0[1]); w.y = pack2(v0[2], v0[3]); w.z = pack2(v1[0], v1[1]); w.w = pack2(v1[2], v1[3]); return w; }
__device__ __forceinline__ void unpack8(const u32x4 w, f32x4& v0, f32x4& v1) { v0[0] = bflo(w.x); v0[1] = bfhi(w.x); v0[2] = bflo(w.y); v0[3] = bfhi(w.y); v1[0] = bflo(w.z); v1[1] = bfhi(w.z); v1[2] = bflo(w.w); v1[3] = bfhi(w.w); }
struct EpiQKV {
  bf16_t* O; const float* bias;
  __device__ __forceinline__ void operator()(const AccT& acc, const Unit& u, int wr, int wc, int fr, int fq) const {
    const float sc = (u.pn < 4) ? 0.0625f : 1.0f;
    f32x4 bv[2][2];
    EPI_LOOP_COLS { bv[bj][n] = *(const f32x4*)(bias + EPI_COL(bj, n)); }
    EPI_LOOP_ROWS { const int row = EPI_ROW(ai, m);
      EPI_LOOP_BJ { *(u32x4*)(O + (size_t)row * 3072 + EPI_COL(bj, 0)) = pack8((acc[ai][bj][m][0] + bv[bj][0]) * sc, (acc[ai][bj][m][1] + bv[bj][1]) * sc); } }
  }
};
struct EpiUT {
  bf16_t* O; const float* bias;
  __device__ __forceinline__ void operator()(const AccT& acc, const Unit& u, int wr, int wc, int fr, int fq) const {
    EPI_LOOP_ROWS { const int row = EPI_ROW(ai, m); const float bv = bias[row];
      EPI_LOOP_BJ { *(u32x4*)(O + (size_t)row * NTOK + EPI_COL(bj, 0)) = pack8(acc[ai][bj][m][0] + bv, acc[ai][bj][m][1] + bv); } }
  }
};
struct EpiGates {
  bf16_t* H; bf16_t* G; const float* b_in;
  __device__ __forceinline__ void operator()(const AccT& acc, const Unit& u, int wr, int wc, int fr, int fq) const {
    const bool og = u.pn < 4;
    f32x4 bv[2][2];
    EPI_LOOP_COLS { const int col = EPI_COL(bj, n); bv[bj][n] = *(const f32x4*)(b_in + (og ? 3072 + col : 7184 + (col - 1024))); }
    EPI_LOOP_ROWS { const int row = EPI_ROW(ai, m);
      u32x4 hv[2];
      if (og) { EPI_LOOP_BJ { hv[bj] = *(const u32x4*)(H + (size_t)row * 1024 + EPI_COL(bj, 0)); } }
      EPI_LOOP_BJ { const int col = EPI_COL(bj, 0); f32x4 s0, s1; const f32x4 a0 = acc[ai][bj][m][0] + bv[bj][0], a1 = acc[ai][bj][m][1] + bv[bj][1];
#pragma unroll
        for (int e = 0; e < 4; ++e) { s0[e] = sigmoidf_(a0[e]); s1[e] = sigmoidf_(a1[e]); }
        if (og) { f32x4 h0, h1; unpack8(hv[bj], h0, h1); *(u32x4*)(H + (size_t)row * 1024 + col) = pack8(h0 * s0, h1 * s1); }
        else *(u32x4*)(G + (size_t)row * 2048 + (col - 1024)) = pack8(s0, s1); } }
  }
};
template <int SECOND> struct EpiMerge {
  bf16_t* T; const bf16_t* G;
  __device__ __forceinline__ void operator()(const AccT& acc, const Unit& u, int wr, int wc, int fr, int fq) const {
    EPI_LOOP_ROWS { const int row = EPI_ROW(ai, m);
      u32x4 gv[2], tv[2];
      EPI_LOOP_BJ { const int col = EPI_COL(bj, 0); gv[bj] = *(const u32x4*)(G + (size_t)row * 2048 + SECOND * 1024 + col);
        if (SECOND) tv[bj] = *(const u32x4*)(T + (size_t)row * 1024 + col); }
      EPI_LOOP_BJ { const int col = EPI_COL(bj, 0); f32x4 g0, g1; unpack8(gv[bj], g0, g1);
        f32x4 v0 = g0 * acc[ai][bj][m][0], v1 = g1 * acc[ai][bj][m][1];
        if (SECOND) { f32x4 t0, t1; unpack8(tv[bj], t0, t1); v0 += t0; v1 += t1; }
        *(u32x4*)(T + (size_t)row * 1024 + col) = pack8(v0, v1); } }
  }
};
struct EpiOut {
  const float* xp; const float* xs; const float* per; const float* pec; const float* mod; const float* n2w; float* X1; bf16_t* A2; float* ssq;
  __device__ __forceinline__ void operator()(const AccT& acc, const Unit& u, int wr, int wc, int fr, int fq) const {
    const int cb = cond_of_row(u.pm * 256); const float* md = mod + cb * 6144; const bool smp = (u.pm * 256) >= NCTX;
    f32x4 g1v[2][2], k2v[2][2];
    EPI_LOOP_COLS { const int col = EPI_COL(bj, n); g1v[bj][n] = *(const f32x4*)(md + 2048 + col); k2v[bj][n] = *(const f32x4*)(n2w + col) * (*(const f32x4*)(md + 4096 + col) + 1.0f); }
    EPI_LOOP_ROWS { const int row = EPI_ROW(ai, m); float ss = 0.f;
#pragma unroll
      for (int bj = 0; bj < 2; ++bj) {
        f32x4 x0[2];
        if (!smp) {
#pragma unroll
          for (int n = 0; n < 2; ++n) x0[n] = *(const f32x4*)(xp + (size_t)row * 1024 + EPI_COL(bj, n)); }
        else { const int r2 = row - NCTX, t = r2 & 2047; f32x4 pe[2];
#pragma unroll
          for (int n = 0; n < 2; ++n) { const int col = EPI_COL(bj, n); x0[n] = *(const f32x4*)(xs + (size_t)r2 * 1024 + col);
            pe[n] = (col < 512) ? *(const f32x4*)(per + (t >> 6) * 512 + col) : *(const f32x4*)(pec + (t & 63) * 512 + (col - 512)); }
#pragma unroll
          for (int n = 0; n < 2; ++n) x0[n] += pe[n]; }
        f32x4 x1[2];
#pragma unroll
        for (int n = 0; n < 2; ++n) { x1[n] = x0[n] + g1v[bj][n] * acc[ai][bj][m][n]; *(f32x4*)(X1 + (size_t)row * 1024 + EPI_COL(bj, n)) = x1[n];
          ss += x1[n][0] * x1[n][0] + x1[n][1] * x1[n][1] + x1[n][2] * x1[n][2] + x1[n][3] * x1[n][3]; }
        *(u32x4*)(A2 + (size_t)row * 1024 + EPI_COL(bj, 0)) = pack8(x1[0] * k2v[bj][0], x1[1] * k2v[bj][1]); }
      ss += __shfl_xor(ss, 16); ss += __shfl_xor(ss, 32);
      if (fq == 0) ssq[(size_t)row * 16 + u.pn * 4 + wc] = ss; }
  }
};
struct EpiFF1 {
  int row0; const float* ssq; const float* c1; bf16_t* Hd;
  __device__ __forceinline__ void operator()(const AccT& acc, const Unit& u, int wr, int wc, int fr, int fq) const {
    const int cb = cond_of_row(row0 + u.pm * 256); const float* cc = c1 + cb * 4096;
    f32x4 cv[2][2];
    EPI_LOOP_COLS { cv[bj][n] = *(const f32x4*)(cc + EPI_COL(bj, n)); }
    float rs[2][4];
    EPI_LOOP_ROWS { const float* sp = ssq + (size_t)(row0 + EPI_ROW(ai, m)) * 16;
      const f32x4 st = (*(const f32x4*)sp + *(const f32x4*)(sp + 4)) + (*(const f32x4*)(sp + 8) + *(const f32x4*)(sp + 12));
      rs[ai][m] = rsqrtf((st[0] + st[1] + st[2] + st[3]) * (1.0f / 1024.0f) + 1e-6f); }
    EPI_LOOP_ROWS { const int rl = EPI_ROW(ai, m); const float rstd = rs[ai][m];
      EPI_LOOP_BJ { f32x4 v0 = acc[ai][bj][m][0] * rstd + cv[bj][0], v1 = acc[ai][bj][m][1] * rstd + cv[bj][1];
#pragma unroll
        for (int e = 0; e < 4; ++e) { const float r0 = fmaxf(v0[e], 0.f), r1 = fmaxf(v1[e], 0.f); v0[e] = r0 * r0; v1[e] = r1 * r1; }
        *(u32x4*)(Hd + (size_t)rl * 4096 + EPI_COL(bj, 0)) = pack8(v0, v1); } }
  }
};
struct EpiFF2 {
  int row0; const float* mod; const float* b2; float* X; float* P;
  __device__ __forceinline__ void operator()(const AccT& acc, const Unit& u, int wr, int wc, int fr, int fq) const {
    if (u.ks == 1) {
      EPI_LOOP_ROWS { const int rl = EPI_ROW(ai, m); EPI_LOOP_COLS { *(f32x4*)(P + (size_t)rl * 1024 + EPI_COL(bj, n)) = acc[ai][bj][m][n]; } }
    } else {
    const int cb = cond_of_row(row0 + u.pm * 256); const float* md = mod + cb * 6144;
    f32x4 g2v[2][2], bbv[2][2];
    EPI_LOOP_COLS { const int col = EPI_COL(bj, n); g2v[bj][n] = *(const f32x4*)(md + 5120 + col); bbv[bj][n] = *(const f32x4*)(b2 + col); }
#pragma unroll
    for (int ai = 0; ai < 2; ++ai)
#pragma unroll
      for (int m2 = 0; m2 < 2; ++m2) {
        f32x4 xv[2][2][2];
#pragma unroll
        for (int mm = 0; mm < 2; ++mm) { const int row = row0 + EPI_ROW(ai, 2 * m2 + mm); EPI_LOOP_COLS { xv[mm][bj][n] = *(const f32x4*)(X + (size_t)row * 1024 + EPI_COL(bj, n)); } }
#pragma unroll
        for (int mm = 0; mm < 2; ++mm) { const int m = 2 * m2 + mm; const int row = row0 + EPI_ROW(ai, m);
          EPI_LOOP_COLS { const int col = EPI_COL(bj, n); *(f32x4*)(X + (size_t)row * 1024 + col) = xv[mm][bj][n] + g2v[bj][n] * (acc[ai][bj][m][n] + bbv[bj][n]); } } }
    }
  }
};

template <class Epi> __device__ __forceinline__ void run_gemm(LP lds, const bf16_t* A, const bf16_t* Bt, int M, int N, int K, const Epi& E, int nks = 1) {
  pg8::Gemm g; g.A = A; g.Bt = Bt; g.M = M; g.N = N; g.K = K / nks; g.ld = K; g.nks = nks;
  pg8::StaticOrder S; S.init(M, N, nks, (int)gridDim.x, (int)blockIdx.x);
  pg8::gemm_phase<Epi>(lds, g, S, E);
}

__device__ void transpose_tile(const float* __restrict__ src, int ld, int col0, int k0, bf16_t* __restrict__ dst, int K, int drow0, LAS float* tile) {
  const int t = opaque_tid();
  f32x4 v[4];
#pragma unroll
  for (int i = 0; i < 4; ++i) { const int idx = t + 512 * i, kr = idx >> 5, c4 = idx & 31; v[i] = *(const f32x4*)(src + (size_t)(k0 + kr) * ld + col0 + 4 * c4); }
#pragma unroll
  for (int i = 0; i < 4; ++i) { const int idx = t + 512 * i, kr = idx >> 5, c4 = idx & 31; LAS float* tp = tile + kr * 129 + 4 * c4; tp[0] = v[i][0]; tp[1] = v[i][1]; tp[2] = v[i][2]; tp[3] = v[i][3]; }
  __syncthreads();
  const int kb = t & 7;
#pragma unroll
  for (int i = 0; i < 2; ++i) { const int c = (t >> 3) + 64 * i; const LAS float* tp = tile + (kb * 8) * 129 + c; u32x4 o;
    o.x = pack2(tp[0], tp[129]); o.y = pack2(tp[2 * 129], tp[3 * 129]); o.z = pack2(tp[4 * 129], tp[5 * 129]); o.w = pack2(tp[6 * 129], tp[7 * 129]);
    *(u32x4*)(dst + (size_t)(drow0 + c) * K + k0 + kb * 8) = o; }
  __syncthreads();
}
template <int SILU> __device__ void matvec9_unit(const float* v0, const float* v1, int v1stride, const float* __restrict__ W, int ldw, const float* bias, float* out, int ldo, int col0, LAS float* lf) {
  const int t = opaque_tid(), lane = t & 63, wid = t >> 6;
  LAS float* sv = lf; LAS float* red = lf + 9216;
  for (int i = t; i < 9216; i += 512) { const int b = i >> 10, k = i & 1023; float x = (b == 0) ? v0[k] : v1[(size_t)(b - 1) * v1stride + k]; if (SILU) x = x / (1.0f + __expf(-x)); sv[i] = x; }
  __syncthreads();
  const int c4 = t & 7, kl = t >> 3;
  f32x4 w[16];
#pragma unroll
  for (int i = 0; i < 16; ++i) w[i] = *(const f32x4*)(W + (size_t)(kl + 64 * i) * ldw + col0 + 4 * c4);
  f32x4 acc[9];
#pragma unroll
  for (int b = 0; b < 9; ++b) acc[b] = (f32x4){0.f, 0.f, 0.f, 0.f};
#pragma unroll
  for (int i = 0; i < 16; ++i)
#pragma unroll
    for (int b = 0; b < 9; ++b) acc[b] += w[i] * sv[b * 1024 + kl + 64 * i];
#pragma unroll
  for (int b = 0; b < 9; ++b)
#pragma unroll
    for (int e = 0; e < 4; ++e) { float x = acc[b][e]; x += __shfl_xor(x, 8); x += __shfl_xor(x, 16); x += __shfl_xor(x, 32); acc[b][e] = x; }
  if (lane < 8) {
#pragma unroll
    for (int b = 0; b < 9; ++b) *(LAS f32x4*)(red + (wid * 9 + b) * 32 + 4 * lane) = acc[b]; }
  __syncthreads();
  if (t < 288) { const int b = t >> 5, cc = t & 31; float s = bias[col0 + cc];
#pragma unroll
    for (int pz = 0; pz < 8; ++pz) s += red[(pz * 9 + b) * 32 + cc];
    out[(size_t)b * ldo + col0 + cc] = s; }
  __syncthreads();
}

__device__ void phase0(const Params& p, LP lds) {
  unsigned char* ws = p.ws; LAS float* lf = (LAS float*)lds;
  const int tid0 = opaque_tid(); const int wid = tid0 >> 6, lane = tid0 & 63;
  for (int unit = blockIdx.x; unit < 576; unit += gridDim.x) {
    if (unit < 192) {
      matvec9_unit<1>(p.in[6], p.in[5], 1024, p.in[7], 6144, p.in[8], (float*)(ws + OFF_MOD), 6144, unit * 32, lf);
    } else if (unit < 480) {
      const int row = (unit - 192) * 8 + wid; const bool smp = row < 2048; const int L = smp ? 2048 : 256, t = smp ? row : row - 2048;
      const float* w1 = p.in[14]; const float* b1 = p.in[15]; const float* fr1 = p.in[16]; const float* w2 = p.in[17]; const float* b2 = p.in[18]; const float* fr2 = p.in[19];
      float a = b1[lane] + (float)t / (float)(L - 1) * w1[lane];
      const float base = (6.283185307179586f / (float)L) * (float)t;
      float cs = 0.f, sn = 0.f; if (lane < 16) { const float ang = base * (float)(lane + 1); cs = cosf(ang); sn = sinf(ang); }
#pragma unroll
      for (int i = 0; i < 16; ++i) a += __shfl(cs, i) * w1[(1 + i) * 64 + lane] + __shfl(sn, i) * w1[(17 + i) * 64 + lane];
      const float h1 = sinf(fr1[lane] * a);
      float a2 = b2[lane];
#pragma unroll 16
      for (int j = 0; j < 64; ++j) a2 += __shfl(h1, j) * w2[j * 64 + lane];
      const float h2 = sinf(fr2[lane] * a2);
      float* dst = (float*)(ws + (smp ? OFF_H2S : OFF_H2C)); dst[(size_t)t * 64 + lane] = h2;
    } else {
      const int r = unit - 480, c = tid0; const int pos = r < 32 ? r : r - 32; const int i = c & 255;
      const float omega = 1.0f / powf(10000.0f, (float)i / 256.0f); const float a = (float)pos * omega; const float v = c < 256 ? sinf(a) : cosf(a);
      float* dst = (float*)(ws + (r < 32 ? OFF_PER : OFF_PEC)); dst[(size_t)pos * 512 + c] = v;
    }
  }
}
__device__ void weight_tiles(const Params& p, LP lds) {
  unsigned char* ws = p.ws; LAS float* lf = (LAS float*)lds;
  for (int tu = blockIdx.x; tu < 2560; tu += gridDim.x) {
    const float* src; int ld, K, col0, k0, drow0; bf16_t* dst;
    if (tu < 1152) { const int nt = tu >> 4, kt = tu & 15; const int r = nt * 128; src = p.in[10]; ld = INC; K = 1024; k0 = kt * 64; drow0 = r; dst = (bf16_t*)(ws + OFF_WT);
      col0 = r < 3072 ? r : (r < 6144 ? 4112 + (r - 3072) : (r < 7168 ? 3072 + (r - 6144) : 7184 + (r - 7168))); }
    else if (tu < 1536) { const int v = tu - 1152, w = v >> 7, q = v & 127; src = p.in[23 + w]; ld = 1024; K = 1024; k0 = (q & 15) * 64; col0 = (q >> 4) * 128; drow0 = col0; dst = (bf16_t*)(ws + (w == 0 ? OFF_WBM : (w == 1 ? OFF_WBH : OFF_WOUT))); }
    else if (tu < 2048) { const int q = tu - 1536; src = p.in[27]; ld = 4096; K = 1024; k0 = (q & 15) * 64; col0 = (q >> 4) * 128; drow0 = col0; dst = (bf16_t*)(ws + OFF_W1T); }
    else { const int q = tu - 2048; src = p.in[29]; ld = 1024; K = 4096; k0 = (q & 63) * 64; col0 = (q >> 6) * 128; drow0 = col0; dst = (bf16_t*)(ws + OFF_W2T); }
    transpose_tile(src, ld, col0, k0, dst, K, drow0, lf);
  }
}

__device__ void phase1(const Params& p, LP lds) {
  unsigned char* ws = p.ws;
  int tid_ = threadIdx.x; asm volatile("" : "+v"(tid_));
  const int tid = tid_, wid = tid >> 6, lane = tid & 63;
  const float* mod = (const float*)(ws + OFF_MOD);
  LAS float* wg = (LAS float*)lds;
  if ((int)blockIdx.x < 1536) {
    f32x4 gw[8];
#pragma unroll
    for (int i = 0; i < 8; ++i) { const int idx = tid + 512 * i, k = idx >> 2, q = idx & 3; gw[i] = *(const f32x4*)(p.in[10] + (size_t)k * INC + 4096 + 4 * q); }
#pragma unroll
    for (int i = 0; i < 8; ++i) { const int idx = tid + 512 * i, k = idx >> 2, q = idx & 3; wg[(4 * q) * 1024 + k] = gw[i][0]; wg[(4 * q + 1) * 1024 + k] = gw[i][1]; wg[(4 * q + 2) * 1024 + k] = gw[i][2]; wg[(4 * q + 3) * 1024 + k] = gw[i][3]; }
    __syncthreads();
  }
  for (int unit = blockIdx.x; unit < 1536; unit += gridDim.x) {
    const int tidn = opaque_tid(); const int wid = tidn >> 6, lane = tidn & 63;
    const int row0 = unit * 16 + wid * 2; const int cb = cond_of_row(row0); const float* md = mod + cb * 6144; const bool smp = row0 >= NCTX;
    f32x4 v[2][4]; float rstd[2];
#pragma unroll
    for (int r = 0; r < 2; ++r) { const int row = row0 + r; const float* xr; int t = 0;
      if (!smp) xr = p.in[0] + (size_t)row * 1024; else { xr = p.in[1] + (size_t)(row - NCTX) * 1024; t = (row - NCTX) & 2047; }
      const float* per = (const float*)(ws + OFF_PER) + (t >> 6) * 512; const float* pec = (const float*)(ws + OFF_PEC) + (t & 63) * 512;
      float ss = 0.f;
#pragma unroll
      for (int i = 0; i < 4; ++i) { const int col = 4 * lane + 256 * i; v[r][i] = *(const f32x4*)(xr + col);
        if (smp) v[r][i] += (col < 512) ? *(const f32x4*)(per + col) : *(const f32x4*)(pec + col - 512);
        ss += v[r][i][0] * v[r][i][0] + v[r][i][1] * v[r][i][1] + v[r][i][2] * v[r][i][2] + v[r][i][3] * v[r][i][3]; }
      ss = wave_sum(ss); rstd[r] = rsqrtf(ss * (1.0f / 1024.0f) + 1e-6f); }
    const float* n1w = p.in[9];
    float ga[32];
#pragma unroll
    for (int g = 0; g < 32; ++g) ga[g] = 0.f;
#pragma unroll
    for (int i = 0; i < 4; ++i) { const int col = 4 * lane + 256 * i;
      const f32x4 w = *(const f32x4*)(n1w + col), sc = *(const f32x4*)(md + 1024 + col), sh = *(const f32x4*)(md + col);
      const f32x4 ws1 = w * (sc + 1.0f);
      f32x4 h[2];
#pragma unroll
      for (int r = 0; r < 2; ++r) { h[r] = v[r][i] * rstd[r] * ws1 + sh;
        u32x2 o; o.x = pack2(h[r][0], h[r][1]); o.y = pack2(h[r][2], h[r][3]); *(u32x2*)((bf16_t*)(ws + OFF_HN) + (size_t)(row0 + r) * 1024 + col) = o; }
#pragma unroll
      for (int g = 0; g < 16; ++g) { const f32x4 wv = *(const LAS f32x4*)(wg + g * 1024 + col);
#pragma unroll
        for (int r = 0; r < 2; ++r) ga[r * 16 + g] += h[r][0] * wv[0] + h[r][1] * wv[1] + h[r][2] * wv[2] + h[r][3] * wv[3]; }
      asm volatile("" ::: "memory"); }
#pragma unroll
    for (int off = 16; off >= 1; off >>= 1) { const bool hi = (lane & off) != 0;
#pragma unroll
      for (int i = 0; i < off; ++i) { const float send = hi ? ga[i] : ga[i + off]; const float keep = hi ? ga[i + off] : ga[i]; ga[i] = keep + __shfl_xor(send, off); } }
    const float tot = ga[0] + __shfl_xor(ga[0], 32);
    if (lane < 32) ((float*)(ws + OFF_GT))[(size_t)row0 * 16 + lane] = tot + p.in[11][4096 + (lane & 15)];
  }
  __syncthreads();
  LAS float* w3s = (LAS float*)lds;
  for (int v = blockIdx.x; v < 320; v += gridDim.x) {
    const int tid = opaque_tid();
    const bool smp = v < 256; const int L = smp ? 2048 : 256; const int tt = smp ? (v >> 6) : 0, cgp = v & 63; const int t = tt * 512 + tid;
    { const f32x4 x = *(const f32x4*)(p.in[20] + (size_t)(tid >> 3) * 2048 + cgp * 32 + 4 * (tid & 7)); LAS float* wp = w3s + (4 * (tid & 7)) * 64 + (tid >> 3);
      wp[0] = x[0]; wp[64] = x[1]; wp[128] = x[2]; wp[192] = x[3]; }
    __syncthreads();
    if (t < L) {
      const float* H2 = (const float*)(ws + (smp ? OFF_H2S : OFF_H2C)) + (size_t)t * 64;
      f32x4 h2[16];
#pragma unroll
      for (int i = 0; i < 16; ++i) h2[i] = *(const f32x4*)(H2 + 4 * i);
      const float dist = fabsf((float)t - (float)(L / 2)) / (float)(L / 2);
      float* HF = (float*)(ws + (smp ? OFF_HFS : OFF_HFC)) + (size_t)(cgp * 32) * L + t;
#pragma unroll 1
      for (int j = 0; j < 32; ++j) {
        f32x4 a = {0.f, 0.f, 0.f, 0.f};
#pragma unroll
        for (int i = 0; i < 16; ++i) a += *(const LAS f32x4*)(w3s + j * 64 + 4 * i) * h2[i];
        const int c = (cgp * 32 + j) & 1023;
        const float dmin = -3.0701134573253946f, dmax = -15.350567286626973f;
        const float delta = fabsf(dmin + (dmax - dmin) * ((float)c / 1023.0f));
        HF[(size_t)j * L] = ((a[0] + a[1]) + (a[2] + a[3])) * __expf(-dist * delta); }
    }
    __syncthreads();
  }
  for (int u = (int)gridDim.x - 1 - (int)blockIdx.x; u < 128; u += gridDim.x)
    matvec9_unit<0>(mod + 3072, mod + 6144 + 3072, 6144, p.in[27], 4096, p.in[28], (float*)(ws + OFF_C1), 4096, u * 32, (LAS float*)lds);
}

__device__ __forceinline__ bf16x8 tr_frag(LP base, int k0, int m0, int pitch  , int l15, int g) {
  const int q = l15 >> 2, pp = l15 & 3;
  LP a = base + ((k0 + 8 * g + q) * pitch + m0 + 4 * pp) * 2;
  const s16x4 lo = __builtin_amdgcn_ds_read_tr16_b64_v4i16((LAS s16x4*)a);
  const s16x4 hi = __builtin_amdgcn_ds_read_tr16_b64_v4i16((LAS s16x4*)(a + 8 * pitch));
  bf16x8 r; r[0] = lo[0]; r[1] = lo[1]; r[2] = lo[2]; r[3] = lo[3]; r[4] = hi[0]; r[5] = hi[1]; r[6] = hi[2]; r[7] = hi[3]; return r;
}
__device__ __forceinline__ bf16x8 tr_at(LP lanebase, int coff  , int pitch_bytes) {
  const s16x4 lo = __builtin_amdgcn_ds_read_tr16_b64_v4i16((LAS s16x4*)(lanebase + coff));
  const s16x4 hi = __builtin_amdgcn_ds_read_tr16_b64_v4i16((LAS s16x4*)(lanebase + coff + 4 * pitch_bytes));
  bf16x8 r; r[0] = lo[0]; r[1] = lo[1]; r[2] = lo[2]; r[3] = lo[3]; r[4] = hi[0]; r[5] = hi[1]; r[6] = hi[2]; r[7] = hi[3]; return r;
}
constexpr int ML_K = 0, ML_V = 67584, ML_P = 86016, ML_C = 120832, ML_T = 157696, ML_TSZ = 1600;
constexpr int KP = 264, VP = 72, PP = 136, CP = 72;

__device__ void mlstm_item(const Params& p, LP lds, int item) {
  const int tid = opaque_tid(), wid = __builtin_amdgcn_readfirstlane(tid >> 6), lane = tid & 63, l15 = lane & 15, g = lane >> 4;
  const bool smp = item < 256; const int uu = smp ? (item >> 2) : ((item - 256) >> 2); const int sl = item & 3;
  const int b = uu >> 3, dir = (uu >> 2) & 1, head = uu & 3;
  const int S = smp ? SEQS : SEQC, nc = S >> 7; const int tok0 = smp ? NCTX + b * SEQS : b * SEQC;
  const bf16_t* qkv = (const bf16_t*)(p.ws + OFF_BIG);
  const float* GT = (const float*)(p.ws + OFF_GT);
  bf16_t* hout = (bf16_t*)((unsigned char*)p.out + (dir ? OUT_HB : OUT_H));
  const int sidx = (b * 2 + dir) * 4 + head;
  const int gi_col = dir * 8 + head, gf_col = dir * 8 + 4 + head;
  f32x4 Cacc[2][4], nacc[2]; float mst0;
  if (smp) {
    const float* C0 = p.in[2] + (size_t)sidx * 65536;
#pragma unroll
    for (int dt = 0; dt < 2; ++dt) {
#pragma unroll
      for (int vt = 0; vt < 4; ++vt) Cacc[dt][vt] = *(const f32x4*)(C0 + (size_t)((2 * wid + dt) * 16 + l15) * 256 + sl * 64 + 16 * vt + 4 * g);
      nacc[dt] = (f32x4){p.in[3][sidx * 256 + (2 * wid + dt) * 16 + l15], 0.f, 0.f, 0.f}; }
    mst0 = p.in[4][sidx];
  } else {
#pragma unroll
    for (int dt = 0; dt < 2; ++dt) {
#pragma unroll
      for (int vt = 0; vt < 4; ++vt) Cacc[dt][vt] = (f32x4){0.f, 0.f, 0.f, 0.f};
      nacc[dt] = (f32x4){0.f, 0.f, 0.f, 0.f}; }
    mst0 = 0.f;
  }
#define TOKC(cc, j) (dir ? (tok0 + S - 1 - ((cc) * 128 + (j))) : (tok0 + (cc) * 128 + (j)))
  const int rt = (wid < 4) ? wid : 11 - wid;
  const int jrow = 16 * rt + l15;
  bf16x8 qf[8]; u32x4 kreg[8], vreg[2]; float g4[4] = {0.f, 0.f, 0.f, 0.f};
#define ML_LOAD_Q(cc) do { const bf16_t* qp = qkv + (size_t)TOKC(cc, jrow) * 3072 + head * 256 + 8 * g; \
    _Pragma("unroll") for (int kk = 0; kk < 8; ++kk) qf[kk] = *(const bf16x8*)(qp + 32 * kk); } while (0)
#define ML_LOAD_KV(cc) do { \
    _Pragma("unroll") for (int i = 0; i < 8; ++i) { const int row = (tid >> 5) + 16 * i; kreg[i] = *(const u32x4*)(qkv + (size_t)TOKC(cc, row) * 3072 + 1024 + head * 256 + (tid & 31) * 8); } \
    _Pragma("unroll") for (int i = 0; i < 2; ++i) { const int row = (tid >> 3) + 64 * i; vreg[i] = *(const u32x4*)(qkv + (size_t)TOKC(cc, row) * 3072 + 2048 + head * 256 + sl * 64 + (tid & 7) * 8); } \
    if (wid == 0) { const float* g0 = GT + (size_t)TOKC(cc, 2 * lane) * 16; const float* g1 = GT + (size_t)TOKC(cc, 2 * lane + 1) * 16; g4[0] = g0[gi_col]; g4[1] = g0[gf_col]; g4[2] = g1[gi_col]; g4[3] = g1[gf_col]; } } while (0)
#define ML_SCAN(tabp, mcur, mnext) do { LAS float* T_ = (LAS float*)(tabp); \
    const float lf0 = fminf(g4[1], 0.f) - log1pf(__expf(-fabsf(g4[1]))), lf1 = fminf(g4[3], 0.f) - log1pf(__expf(-fabsf(g4[3]))); \
    float s_ = lf0 + lf1; \
    _Pragma("unroll") for (int o = 1; o < 64; o <<= 1) { const float t_ = __shfl_up(s_, o); if (lane >= o) s_ += t_; } \
    const float b1_ = s_, b0_ = s_ - lf1; const float u0_ = g4[0] - b0_, u1_ = g4[2] - b1_; \
    float mx_ = fmaxf(u0_, u1_); \
    _Pragma("unroll") for (int o = 1; o < 64; o <<= 1) { const float t_ = __shfl_up(mx_, o); if (lane >= o) mx_ = fmaxf(mx_, t_); } \
    float ex_ = __shfl_up(mx_, 1); if (lane == 0) ex_ = -INFINITY; \
    const float M0_ = fmaxf(mcur, fmaxf(ex_, u0_)), M1_ = fmaxf(mcur, mx_); \
    T_[2 * lane] = u0_; T_[2 * lane + 1] = u1_; T_[128 + 2 * lane] = M0_; T_[128 + 2 * lane + 1] = M1_; T_[256 + 2 * lane] = b0_; T_[256 + 2 * lane + 1] = b1_; \
    const float Ml_ = __shfl(M1_, 63), bl_ = __shfl(b1_, 63); \
    if (lane == 0) { T_[384] = mcur; T_[385] = Ml_; } \
    mnext = bl_ + Ml_; } while (0)
  float mw0 = mst0;
  ML_LOAD_Q(0); ML_LOAD_KV(0);
  if (wid == 0) { float mn; ML_SCAN(lds + ML_T, mw0, mn); mw0 = mn; }
  __syncthreads();
  float m_final = 0.f;
  for (int c = 0; c < nc; ++c) {
    LAS float* T = (LAS float*)(lds + ML_T + (c & 1) * ML_TSZ);
    const float mst = T[384], M_last = T[385];
#pragma unroll
    for (int i = 0; i < 8; ++i) { const int row = (tid >> 5) + 16 * i; *(LAS u32x4*)(lds + ML_K + (row * KP + (tid & 31) * 8) * 2) = kreg[i]; }
#pragma unroll
    for (int i = 0; i < 2; ++i) { const int row = (tid >> 3) + 64 * i; const float w = __expf(T[row] - M_last); const u32x4 v = vreg[i]; u32x4 o;
      o.x = pack2(bflo(v.x) * w, bfhi(v.x) * w); o.y = pack2(bflo(v.y) * w, bfhi(v.y) * w); o.z = pack2(bflo(v.z) * w, bfhi(v.z) * w); o.w = pack2(bflo(v.w) * w, bfhi(v.w) * w);
      *(LAS u32x4*)(lds + ML_V + (row * VP + (tid & 7) * 8) * 2) = o; }
    if (tid < 128) *(LAS unsigned short*)(lds + ML_V + (tid * VP + 64) * 2) = f2bf(__expf(T[tid] - M_last));
#pragma unroll
    for (int dt = 0; dt < 2; ++dt) {
#pragma unroll
      for (int vt = 0; vt < 4; ++vt) { u32x2 w; w.x = pack2(Cacc[dt][vt][0], Cacc[dt][vt][1]); w.y = pack2(Cacc[dt][vt][2], Cacc[dt][vt][3]);
        *(LAS u32x2*)(lds + ML_C + (((2 * wid + dt) * 16 + l15) * CP + 16 * vt + 4 * g) * 2) = w; }
      if (g == 0) *(LAS unsigned short*)(lds + ML_C + (((2 * wid + dt) * 16 + l15) * CP + 64) * 2) = f2bf(nacc[dt][0]); }
    const int qtok = TOKC(c, jrow);
    const bool more = (c + 1 < nc);
    __syncthreads();
    const float Mj = T[128 + jrow], bj = T[256 + jrow]; const float rf = __expf(M_last - Mj), w_inter = __expf(mst - Mj);
    int lq_ = (8 * g + (l15 >> 2)), lp_ = 4 * (l15 & 3); asm volatile("" : "+v"(lq_), "+v"(lp_));
    const LP cB = lds + ML_C + (lq_ * CP + lp_) * 2, vB = lds + ML_V + (lq_ * VP + lp_) * 2, kB = lds + ML_K + (lq_ * KP + lp_ + 32 * wid) * 2;
    const LP pB = lds + ML_P + (jrow * PP + 8 * g) * 2;
    for (int st = 0; st <= rt; ++st) {
      f32x4 s = {0.f, 0.f, 0.f, 0.f};
      bf16x8 kfr[8];
#pragma unroll
      for (int kk = 0; kk < 8; ++kk) kfr[kk] = *(const LAS bf16x8*)(lds + ML_K + ((16 * st + l15) * KP + 32 * kk + 8 * g) * 2);
      __builtin_amdgcn_sched_barrier(0);
#pragma unroll
      for (int kk = 0; kk < 8; ++kk) s = __builtin_amdgcn_mfma_f32_16x16x32_bf16(kfr[kk], qf[kk], s, 0, 0, 0);
      float pv[4];
#pragma unroll
      for (int i = 0; i < 4; ++i) pv[i] = ((16 * st + 4 * g + i) <= jrow) ? s[i] * rf : 0.f;
      u32x2 w; w.x = pack2(pv[0], pv[1]); w.y = pack2(pv[2], pv[3]);
      *(LAS u32x2*)(lds + ML_P + (jrow * PP + 16 * st + 4 * g) * 2) = w;
    }
    if ((rt & 1) == 0) { u32x2 z; z.x = 0u; z.y = 0u; *(LAS u32x2*)(lds + ML_P + (jrow * PP + 16 * (rt + 1) + 4 * g) * 2) = z; }
    if (more) ML_LOAD_KV(c + 1);
    asm volatile("s_waitcnt lgkmcnt(0)" ::: "memory");
    f32x4 ha[5];
#pragma unroll
    for (int vt = 0; vt < 5; ++vt) { f32x4 a = {0.f, 0.f, 0.f, 0.f};
      if (smp || c > 0) {
        bf16x8 cfr[8];
#pragma unroll
        for (int kk = 0; kk < 8; ++kk) cfr[kk] = tr_at(cB, (32 * kk * CP + 16 * vt) * 2, CP * 2);
        __builtin_amdgcn_sched_barrier(0);
#pragma unroll
        for (int kk = 0; kk < 8; ++kk) a = __builtin_amdgcn_mfma_f32_16x16x32_bf16(cfr[kk], qf[kk], a, 0, 0, 0);
        a *= w_inter; }
      ha[vt] = a; }
    for (int k2 = 0; k2 <= (rt >> 1); ++k2) {
      const bf16x8 pf = *(const LAS bf16x8*)(pB + k2 * 64);
      bf16x8 vfr[5];
#pragma unroll
      for (int vt = 0; vt < 5; ++vt) vfr[vt] = tr_at(vB + k2 * (32 * VP * 2), (16 * vt) * 2, VP * 2);
      __builtin_amdgcn_sched_barrier(0);
#pragma unroll
      for (int vt = 0; vt < 5; ++vt) ha[vt] = __builtin_amdgcn_mfma_f32_16x16x32_bf16(vfr[vt], pf, ha[vt], 0, 0, 0); }
    { const float den = __shfl(ha[4][0], l15); const float rdd = 1.0f / fmaxf(fabsf(den), __expf(-(bj + Mj)));
#pragma unroll
      for (int vt = 0; vt < 4; ++vt) { const f32x4 a = ha[vt] * rdd; u32x2 w; w.x = pack2(a[0], a[1]); w.y = pack2(a[2], a[3]);
        *(u32x2*)(hout + (size_t)qtok * 1024 + head * 256 + sl * 64 + 16 * vt + 4 * g) = w; } }
    if (more) ML_LOAD_Q(c + 1);
    const bool need_state = (!smp) || more;
    if (need_state) {
      const float decay = __expf(mst - M_last);
#pragma unroll
      for (int dt = 0; dt < 2; ++dt) {
#pragma unroll
        for (int vt = 0; vt < 4; ++vt) Cacc[dt][vt] *= decay;
        nacc[dt] *= decay; }
#pragma unroll
      for (int ks = 0; ks < 4; ++ks) {
        const bf16x8 kf0 = tr_at(kB, (32 * ks * KP) * 2, KP * 2), kf1 = tr_at(kB, (32 * ks * KP + 16) * 2, KP * 2);
        bf16x8 vfr[5];
#pragma unroll
        for (int vt = 0; vt < 5; ++vt) vfr[vt] = tr_at(vB, (32 * ks * VP + 16 * vt) * 2, VP * 2);
        __builtin_amdgcn_sched_barrier(0);
#pragma unroll
        for (int vt = 0; vt < 4; ++vt) { Cacc[0][vt] = __builtin_amdgcn_mfma_f32_16x16x32_bf16(vfr[vt], kf0, Cacc[0][vt], 0, 0, 0); Cacc[1][vt] = __builtin_amdgcn_mfma_f32_16x16x32_bf16(vfr[vt], kf1, Cacc[1][vt], 0, 0, 0); }
        nacc[0] = __builtin_amdgcn_mfma_f32_16x16x32_bf16(vfr[4], kf0, nacc[0], 0, 0, 0); nacc[1] = __builtin_amdgcn_mfma_f32_16x16x32_bf16(vfr[4], kf1, nacc[1], 0, 0, 0);
      }
    }
    if (wid == 0 && more) { float mn; ML_SCAN(lds + ML_T + ((c + 1) & 1) * ML_TSZ, mw0, mn); mw0 = mn; }
    m_final = T[256 + 127] + M_last;
    __syncthreads();
  }
#undef ML_LOAD_Q
#undef ML_LOAD_KV
#undef ML_SCAN
#undef TOKC
  if (!smp) {
    float* oC = p.out + OUTF_C + (size_t)sidx * 65536;
#pragma unroll
    for (int dt = 0; dt < 2; ++dt) {
#pragma unroll
      for (int vt = 0; vt < 4; ++vt) *(f32x4*)(oC + (size_t)((2 * wid + dt) * 16 + l15) * 256 + sl * 64 + 16 * vt + 4 * g) = Cacc[dt][vt];
      if (sl == 0 && g == 0) p.out[OUTF_N + (size_t)sidx * 256 + (2 * wid + dt) * 16 + l15] = nacc[dt][0]; }
    if (sl == 0 && tid == 0) p.out[OUTF_M + sidx] = m_final;
  }
}

__device__ void combine_rows(const Params& p) {
  const int tid0 = opaque_tid(); const int wid = tid0 >> 6, lane = tid0 & 63;
  bf16_t* H = (bf16_t*)((unsigned char*)p.out + OUT_H); const bf16_t* HB = (const bf16_t*)((unsigned char*)p.out + OUT_HB); const float* nw = p.in[22];
  f32x4 wv[4];
#pragma unroll
  for (int i = 0; i < 4; ++i) wv[i] = *(const f32x4*)(nw + 16 * lane + 4 * i);
  const int nh = (int)gridDim.x >> 1;
  if ((int)blockIdx.x < nh) return;
  for (int unit = (int)blockIdx.x - nh; unit < 768; unit += (int)gridDim.x - nh) {
    const int row0 = unit * 32 + wid * 4;
    u32x4 a[4][2], bq[4][2];
#pragma unroll
    for (int r = 0; r < 4; ++r)
#pragma unroll
      for (int i = 0; i < 2; ++i) { a[r][i] = *(const u32x4*)(H + (size_t)(row0 + r) * 1024 + 16 * lane + 8 * i); bq[r][i] = *(const u32x4*)(HB + (size_t)(row0 + r) * 1024 + 16 * lane + 8 * i); }
#pragma unroll
    for (int r = 0; r < 4; ++r) {
      f32x4 v[4]; float ss = 0.f;
#pragma unroll
      for (int i = 0; i < 2; ++i) { f32x4 x0, x1, y0, y1; unpack8(a[r][i], x0, x1); unpack8(bq[r][i], y0, y1); v[2 * i] = x0 + y0; v[2 * i + 1] = x1 + y1; }
#pragma unroll
      for (int i = 0; i < 4; ++i) ss += v[i][0] * v[i][0] + v[i][1] * v[i][1] + v[i][2] * v[i][2] + v[i][3] * v[i][3];
      ss += __shfl_xor(ss, 1); ss += __shfl_xor(ss, 2); ss += __shfl_xor(ss, 4); ss += __shfl_xor(ss, 8);
      const float rr = rsqrtf(ss * (1.0f / 256.0f) + 1e-6f);
#pragma unroll
      for (int i = 0; i < 2; ++i) *(u32x4*)(H + (size_t)(row0 + r) * 1024 + 16 * lane + 8 * i) = pack8(v[2 * i] * rr * wv[2 * i], v[2 * i + 1] * rr * wv[2 * i + 1]);
    }
  }
}

constexpr int HY_WAVE = 18816, HY_HR = 0, HY_ZA = 8576, HY_ZB = 8576 + 5120;
__device__ void hyena_item(const Params& p, LP lds, int item) {
  const int tid = opaque_tid(), wid = __builtin_amdgcn_readfirstlane(tid >> 6), lane = tid & 63, n31 = lane & 31, hh = lane >> 5;
  const bool smp = item < 1024; const int it = smp ? item : item - 1024; const int bset = it >> 7, cgp = it & 127; const int c = cgp * 8 + wid;
  const int L = smp ? 2048 : 256, lgL = smp ? 11 : 8, nblk = L >> 5, lgnb = lgL - 5, ntok = smp ? 2048 : 1024, ntile = smp ? 2 : 1, dmax = L >> 6;
  const int tok0 = smp ? NCTX + bset * 2048 : bset * 1024;
  LP wl = lds + wid * HY_WAVE; LAS float* hr = (LAS float*)(wl + HY_HR);
  const float* HFp = (const float*)(p.ws + (smp ? OFF_HFS : OFF_HFC));
  const bf16_t* UT = (const bf16_t*)(p.ws + OFF_BIG);
  const float* cw = p.in[12]; const float* cbv = p.in[13]; const float* skp = p.in[21];
  { const int uc = 2048 + c; const float w0 = cw[uc], w1 = cw[3072 + uc], w2 = cw[6144 + uc], cb = cbv[uc]; const bf16_t* src = UT + (size_t)uc * NTOK + tok0;
    u32x4 vv[4]; float pvv[4], nxv[4];
#pragma unroll
    for (int i = 0; i < 4; ++i) { const int base = lane * 8 + 512 * i; vv[i] = (u32x4){0u, 0u, 0u, 0u}; pvv[i] = 0.f; nxv[i] = 0.f;
      if (base < ntok) { vv[i] = *(const u32x4*)(src + base); const int tl = base & (L - 1);
        if (tl != 0) pvv[i] = bf2f(src[base - 1]); if (tl + 8 != L) nxv[i] = bf2f(src[base + 8]); } }
#pragma unroll
    for (int i = 0; i < 4; ++i) { const int base = lane * 8 + 512 * i;
      if (base < ntok) { const u32x4 v = vv[i];
        float u[10]; u[0] = pvv[i]; u[1] = bflo(v.x); u[2] = bfhi(v.x); u[3] = bflo(v.y); u[4] = bfhi(v.y); u[5] = bflo(v.z); u[6] = bfhi(v.z); u[7] = bflo(v.w); u[8] = bfhi(v.w); u[9] = nxv[i];
        float o[8];
#pragma unroll
        for (int e = 0; e < 8; ++e) o[e] = cb + w0 * u[e] + w1 * u[e + 1] + w2 * u[e + 2];
        u32x4 w; w.x = pack2(o[0], o[1]); w.y = pack2(o[2], o[3]); w.z = pack2(o[4], o[5]); w.w = pack2(o[6], o[7]);
        *(LAS u32x4*)(wl + HY_ZA + ((base >> 5) * 40 + (base & 31)) * 2) = w; } } }
  const int HRP = L + 96;
  f32x4 fvN[8];
#define HY_FLOAD(o) do { const float* src_ = HFp + (size_t)((o) * 1024 + c) * L; \
    _Pragma("unroll") for (int i = 0; i < 8; ++i) { const int q = lane + 64 * i; fvN[i] = (4 * q < L) ? *(const f32x4*)(src_ + 4 * q) : (f32x4){0.f, 0.f, 0.f, 0.f}; } } while (0)
  HY_FLOAD(0);
  for (int ord = 0; ord < 2; ++ord) {
    { float sa = 0.f;
      f32x4 fv[8];
#pragma unroll
      for (int i = 0; i < 8; ++i) fv[i] = fvN[i];
#pragma unroll
      for (int i = 0; i < 8; ++i) sa += (fabsf(fv[i][0]) + fabsf(fv[i][1])) + (fabsf(fv[i][2]) + fabsf(fv[i][3]));
      sa = wave_sum(sa); const float inv = 1.0f / (sa + 1e-6f);
      asm volatile("s_waitcnt lgkmcnt(0)" ::: "memory");
      LAS bf16_t* E = (LAS bf16_t*)hr; LAS bf16_t* O = E + HRP;
#pragma unroll
      for (int i = 0; i < 8; ++i) { const int q = lane + 64 * i;
        if (4 * q < L) {
#pragma unroll
          for (int e = 0; e < 4; ++e) { const int yy = L - 1 - (4 * q + e); const bf16_t v = f2bf(fv[i][e] * inv); E[32 + yy] = v; O[31 + yy] = v; } } }
      if (lane < 32) { E[lane] = 0; E[32 + L + lane] = 0; O[31 + L + lane] = 0; if (lane < 31) O[lane] = 0; }
      if (lane < 33) O[HRP - 33 + lane] = 0;
      asm volatile("s_waitcnt lgkmcnt(0)" ::: "memory"); }
    if (ord == 0) HY_FLOAD(1);
    LP zin = wl + (ord == 0 ? HY_ZA : HY_ZB); LP zout = wl + (ord == 0 ? HY_ZB : HY_ZA);
    const int gc = ord * 1024 + c; const float w0 = cw[gc], w1 = cw[3072 + gc], w2 = cw[6144 + gc], cb = cbv[gc], sk = skp[ord * 1024 + c];
    const bf16_t* gsrc = UT + (size_t)gc * NTOK + tok0;
    u32x4 gv[4]; unsigned gpv[4], gnx[4];
#pragma unroll
    for (int i = 0; i < 4; ++i) { const int base = lane * 8 + 512 * i; gv[i] = (u32x4){0u, 0u, 0u, 0u}; gpv[i] = 0u; gnx[i] = 0u;
      if (base < ntok) { gv[i] = *(const u32x4*)(gsrc + base); const int tl = base & (L - 1);
        if (tl != 0) gpv[i] = gsrc[base - 1]; if (tl + 8 != L) gnx[i] = gsrc[base + 8]; } }
    f32x16 accs[2];
#pragma unroll
    for (int o2 = 0; o2 < 2; ++o2)
#pragma unroll
      for (int r = 0; r < 16; ++r) accs[o2][r] = 0.f;
    LP fb = wl + HY_HR + ((n31 & 1) ? 0 : (HRP * 2 - 2)) + 2 * ((L >> 1) - 1 - n31 + 8 * hh + 32);
    int cbl[2], ca[2];
#pragma unroll
    for (int ot = 0; ot < 2; ++ot) { const int col = 32 * ot + n31; cbl[ot] = (col >> lgnb) << lgnb; ca[ot] = col & (nblk - 1); }
    const bool two = (ntile == 2);
    {
      LP zero = wl + HY_HR + 16 * hh;
      LP ap = fb + 64 * dmax;
      int bbr0 = ca[0] + dmax, bbr1 = ca[1] + dmax;
      LP bp0 = zin + ((cbl[0] + bbr0) * 40 + 8 * hh) * 2, bp1 = zin + ((cbl[1] + bbr1) * 40 + 8 * hh) * 2;
      for (int d = -dmax; d <= dmax; ++d) {
        u32x4 w0v, w1v;
        w0v.x = *(const LAS unsigned*)(ap); w0v.y = *(const LAS unsigned*)(ap + 4); w0v.z = *(const LAS unsigned*)(ap + 8); w0v.w = *(const LAS unsigned*)(ap + 12);
        w1v.x = *(const LAS unsigned*)(ap + 32); w1v.y = *(const LAS unsigned*)(ap + 36); w1v.z = *(const LAS unsigned*)(ap + 40); w1v.w = *(const LAS unsigned*)(ap + 44);
        const bf16x8 af0 = __builtin_bit_cast(bf16x8, w0v), af1 = __builtin_bit_cast(bf16x8, w1v);
        LP q0 = ((unsigned)bbr0 < (unsigned)nblk) ? bp0 : zero;
        LP q1 = (two && ((unsigned)bbr1 < (unsigned)nblk)) ? bp1 : zero;
        const bf16x8 b00 = *(const LAS bf16x8*)q0, b01 = *(const LAS bf16x8*)(q0 + 32);
        const bf16x8 b10 = *(const LAS bf16x8*)q1, b11 = *(const LAS bf16x8*)(q1 + 32);
        __builtin_amdgcn_sched_barrier(0);
        accs[0] = __builtin_amdgcn_mfma_f32_32x32x16_bf16(af0, b00, accs[0], 0, 0, 0);
        if (two) accs[1] = __builtin_amdgcn_mfma_f32_32x32x16_bf16(af0, b10, accs[1], 0, 0, 0);
        accs[0] = __builtin_amdgcn_mfma_f32_32x32x16_bf16(af1, b01, accs[0], 0, 0, 0);
        if (two) accs[1] = __builtin_amdgcn_mfma_f32_32x32x16_bf16(af1, b11, accs[1], 0, 0, 0);
        ap -= 64; bbr0 -= 1; bbr1 -= 1; bp0 -= 80; bp1 -= 80;
      }
    }
#pragma unroll
    for (int ot = 0; ot < 2; ++ot) {
      if (ot >= ntile) continue;
      const f32x16 acc = accs[ot];
#pragma unroll
      for (int rg = 0; rg < 4; ++rg) {
        const int zo = (((cbl[ot] + ca[ot]) * 40) + 8 * rg + 4 * hh) * 2;
        const u32x2 zv = *(const LAS u32x2*)(zin + zo);
        u32x2 w; w.x = pack2(acc[4 * rg] + sk * bflo(zv.x), acc[4 * rg + 1] + sk * bfhi(zv.x)); w.y = pack2(acc[4 * rg + 2] + sk * bflo(zv.y), acc[4 * rg + 3] + sk * bfhi(zv.y));
        *(LAS u32x2*)(zout + zo) = w;
      }
    }
    asm volatile("s_waitcnt lgkmcnt(0)" ::: "memory");
#pragma unroll
    for (int i = 0; i < 4; ++i) { const int base = lane * 8 + 512 * i;
      if (base < ntok) { const u32x4 v = gv[i];
        float u[10]; u[0] = bf2f(gpv[i]); u[1] = bflo(v.x); u[2] = bfhi(v.x); u[3] = bflo(v.y); u[4] = bfhi(v.y); u[5] = bflo(v.z); u[6] = bfhi(v.z); u[7] = bflo(v.w); u[8] = bfhi(v.w); u[9] = bf2f(gnx[i]);
        LP zp = zout + ((base >> 5) * 40 + (base & 31)) * 2; const u32x4 t = *(const LAS u32x4*)zp;
        float tv[8]; tv[0] = bflo(t.x); tv[1] = bfhi(t.x); tv[2] = bflo(t.y); tv[3] = bfhi(t.y); tv[4] = bflo(t.z); tv[5] = bfhi(t.z); tv[6] = bflo(t.w); tv[7] = bfhi(t.w);
        float o[8];
#pragma unroll
        for (int e = 0; e < 8; ++e) o[e] = (cb + w0 * u[e] + w1 * u[e + 1] + w2 * u[e + 2]) * tv[e];
        u32x4 w; w.x = pack2(o[0], o[1]); w.y = pack2(o[2], o[3]); w.z = pack2(o[4], o[5]); w.w = pack2(o[6], o[7]);
        *(LAS u32x4*)zp = w; } }
    asm volatile("s_waitcnt lgkmcnt(0)" ::: "memory");
  }
  __syncthreads();
  { bf16_t* YH = (bf16_t*)((unsigned char*)p.out + OUT_HB);
    for (int tl = tid; tl < ntok; tl += 512) {
      const int bl = tl >> lgL, tloc = tl & (L - 1); const int zo = ((((bl << lgnb) + (tloc >> 5)) * 40) + (tloc & 31)) * 2;
      unsigned short e[8];
#pragma unroll
      for (int w = 0; w < 8; ++w) e[w] = *(const LAS unsigned short*)(lds + w * HY_WAVE + HY_ZA + zo);
      u32x4 o; o.x = e[0] | ((unsigned)e[1] << 16); o.y = e[2] | ((unsigned)e[3] << 16); o.z = e[4] | ((unsigned)e[5] << 16); o.w = e[6] | ((unsigned)e[7] << 16);
      *(u32x4*)(YH + (size_t)(tok0 + tl) * 1024 + cgp * 8) = o; } }
  __syncthreads();
}

__device__ void final_norm(const Params& p) {
  const int tid0 = opaque_tid(); const int wid = tid0 >> 6, lane = tid0 & 63; const float* fw = p.in[31];
  const float* P = (const float*)(p.ws + OFF_BIG + (size_t)8192 * 4096 * 2); const float* mod = (const float*)(p.ws + OFF_MOD);
  f32x4 wv[4];
#pragma unroll
  for (int i = 0; i < 4; ++i) wv[i] = *(const f32x4*)(fw + 4 * lane + 256 * i);
  for (int unit = blockIdx.x; unit < 768; unit += gridDim.x) {
    const int row0 = unit * 32 + wid * 4; const bool chunkB = row0 >= 16384;
    f32x4 x[4][4];
#pragma unroll
    for (int r = 0; r < 4; ++r)
#pragma unroll
      for (int i = 0; i < 4; ++i) x[r][i] = *(const f32x4*)(p.out + (size_t)(row0 + r) * 1024 + 4 * lane + 256 * i);
    if (chunkB) { const float* md = mod + cond_of_row(row0) * 6144 + 5120;
#pragma unroll
      for (int i = 0; i < 4; ++i) { const f32x4 g2 = *(const f32x4*)(md + 4 * lane + 256 * i);
#pragma unroll
        for (int r = 0; r < 4; ++r) x[r][i] += g2 * *(const f32x4*)(P + (size_t)(row0 + r - 16384) * 1024 + 4 * lane + 256 * i); } }
#pragma unroll
    for (int r = 0; r < 4; ++r) { float ss = 0.f;
#pragma unroll
      for (int i = 0; i < 4; ++i) ss += x[r][i][0] * x[r][i][0] + x[r][i][1] * x[r][i][1] + x[r][i][2] * x[r][i][2] + x[r][i][3] * x[r][i][3];
      ss = wave_sum(ss); const float rstd = rsqrtf(ss * (1.0f / 1024.0f) + 1e-6f);
#pragma unroll
      for (int i = 0; i < 4; ++i) *(f32x4*)(p.out + (size_t)(row0 + r) * 1024 + 4 * lane + 256 * i) = x[r][i] * rstd * wv[i]; }
  }
}

__global__ void __launch_bounds__(512, 2) __attribute__((flatten)) mega(Params p) {
  extern __shared__ __attribute__((aligned(16))) unsigned char shm[];
  LP lds = (LP)shm;
  cg::grid_group grid = cg::this_grid();
  volatile LAS unsigned* xst = (volatile LAS unsigned*)(lds + LDS_BYTES - 16);
  if (threadIdx.x == 0) { xst[0] = 0u; xst[1] = 0u; }
  __syncthreads();
  const XcdBarrier xb = xcd_barrier_post((unsigned*)(p.ws + OFF_BAR), xst);
  unsigned char* ws = p.ws;
  const bf16_t* WT = (const bf16_t*)(ws + OFF_WT); const bf16_t* HN = (const bf16_t*)(ws + OFF_HN); bf16_t* BIG = (bf16_t*)(ws + OFF_BIG);
  bf16_t* Hb = (bf16_t*)((unsigned char*)p.out + OUT_H); bf16_t* YH = (bf16_t*)((unsigned char*)p.out + OUT_HB);
  const float* mod = (const float*)(ws + OFF_MOD);
  phase0(p, lds);
  if (gridDim.y == 7u) grid.sync();
  xcd_barrier(xb);
  phase1(p, lds);
  weight_tiles(p, lds);
  xcd_barrier(xb);
  { EpiQKV e; e.O = BIG; e.bias = p.in[11]; run_gemm(lds, HN, WT, NTOK, 3072, 1024, e); }
  xcd_barrier(xb);
  for (int item = blockIdx.x; item < 1280; item += gridDim.x) mlstm_item(p, lds, item);
  xcd_barrier(xb);
  combine_rows(p);
  { EpiUT e; e.O = BIG; e.bias = p.in[11] + 4112; run_gemm(lds, WT + (size_t)3072 * 1024, HN, 3072, NTOK, 1024, e); }
  xcd_barrier(xb);
  for (int item = blockIdx.x; item < 2048; item += gridDim.x) hyena_item(p, lds, item);
  xcd_barrier(xb);
  { EpiGates e; e.H = Hb; e.G = BIG; e.b_in = p.in[11]; run_gemm(lds, HN, WT + (size_t)6144 * 1024, NTOK, 3072, 1024, e); }
  xcd_barrier(xb);
  bf16_t* T = BIG + (size_t)NTOK * 2048;
  { EpiMerge<0> e; e.T = T; e.G = BIG; run_gemm(lds, Hb, (const bf16_t*)(ws + OFF_WBM), NTOK, 1024, 1024, e); }
  { EpiMerge<1> e; e.T = T; e.G = BIG; run_gemm(lds, YH, (const bf16_t*)(ws + OFF_WBH), NTOK, 1024, 1024, e); }
  xcd_barrier(xb);
  { EpiOut e; e.xp = p.in[0]; e.xs = p.in[1]; e.per = (const float*)(ws + OFF_PER); e.pec = (const float*)(ws + OFF_PEC); e.mod = mod; e.n2w = p.in[26];
    e.X1 = p.out; e.A2 = (bf16_t*)(ws + OFF_HN); e.ssq = (float*)(ws + OFF_SSQ1); run_gemm(lds, T, (const bf16_t*)(ws + OFF_WOUT), NTOK, 1024, 1024, e); }
  xcd_barrier(xb);
  constexpr int ROWS_A = 16384, ROWS_B = NTOK - ROWS_A;
  { EpiFF1 e; e.row0 = 0; e.ssq = (const float*)(p.ws + OFF_SSQ1); e.c1 = (const float*)(p.ws + OFF_C1); e.Hd = (bf16_t*)(p.ws + OFF_BIG);
    run_gemm(lds, (const bf16_t*)(p.ws + OFF_HN), (const bf16_t*)(p.ws + OFF_W1T), ROWS_A, 4096, 1024, e); }
  xcd_barrier(xb);
  { EpiFF2 e; e.row0 = 0; e.mod = (const float*)(p.ws + OFF_MOD); e.b2 = p.in[30]; e.X = p.out; e.P = (float*)(p.ws + OFF_BIG + (size_t)ROWS_A * 4096 * 2);
    run_gemm(lds, (const bf16_t*)(p.ws + OFF_BIG), (const bf16_t*)(p.ws + OFF_W2T), ROWS_A, 1024, 4096, e); }
  xcd_barrier(xb);
  { EpiFF1 e; e.row0 = ROWS_A; e.ssq = (const float*)(p.ws + OFF_SSQ1); e.c1 = (const float*)(p.ws + OFF_C1); e.Hd = (bf16_t*)(p.ws + OFF_BIG);
    run_gemm(lds, (const bf16_t*)(p.ws + OFF_HN) + (size_t)ROWS_A * 1024, (const bf16_t*)(p.ws + OFF_W1T), ROWS_B, 4096, 1024, e); }
  xcd_barrier(xb);
  { EpiFF2 e; e.row0 = ROWS_A; e.mod = (const float*)(p.ws + OFF_MOD); e.b2 = p.in[30]; e.X = p.out; e.P = (float*)(p.ws + OFF_BIG + (size_t)ROWS_B * 4096 * 2);
    run_gemm(lds, (const bf16_t*)(p.ws + OFF_BIG), (const bf16_t*)(p.ws + OFF_W2T), ROWS_B, 1024, 4096, e, 2); }
  xcd_barrier(xb);
  final_norm(p);
}

extern "C" void kernel_launch(void* const* d_in, const int* in_sizes, int n_in, void* d_out, int out_size, void* d_ws, size_t ws_size, hipStream_t stream) {
  static int grid_blocks = 0;
  if (!grid_blocks) {
    int dev = 0, cus = 0, per_cu = 0;
    hipGetDevice(&dev);
    hipDeviceGetAttribute(&cus, hipDeviceAttributeMultiprocessorCount, dev);
    hipFuncSetAttribute((const void*)mega, hipFuncAttributeMaxDynamicSharedMemorySize, LDS_BYTES);
    hipOccupancyMaxActiveBlocksPerMultiprocessor(&per_cu, (const void*)mega, 512, LDS_BYTES);
    if (per_cu < 1) { fprintf(stderr, "kernel_launch: occupancy query reports %d blocks per CU\n", per_cu); grid_blocks = -1; }
    else grid_blocks = cus;
    if (n_in != 32 || ws_size < WS_END) { fprintf(stderr, "kernel_launch: unexpected n_in %d / ws_size %zu (need %zu)\n", n_in, ws_size, (size_t)WS_END); grid_blocks = -1; }
  }
  if (grid_blocks < 0) return;
  hipMemsetAsync((unsigned char*)d_ws + OFF_BAR, 0, 3456 * 4, stream);
  Params p{};
  for (int i = 0; i < 32; ++i) p.in[i] = (const float*)d_in[i];
  p.out = (float*)d_out; p.ws = (unsigned char*)d_ws;
  void* args[] = {&p};
  hipError_t e = hipLaunchCooperativeKernel((void*)mega, dim3(grid_blocks), dim3(512), args, LDS_BYTES, stream);
  if (e != hipSuccess) fprintf(stderr, "cooperative launch failed: %s (grid %d)\n", hipGetErrorString(e), grid_blocks);
}
```

```cpp
#include <hip/hip_runtime.h>
#include <hip/hip_cooperative_groups.h>
#include <cstdio>
#include <cstdint>
namespace cg = cooperative_groups;

#define LAS __attribute__((address_space(3)))
typedef LAS unsigned char* LP;
typedef unsigned short bf16_t;
typedef short bf16x8 __attribute__((ext_vector_type(8)));
typedef short s16x4 __attribute__((ext_vector_type(4)));
typedef float f32x4 __attribute__((ext_vector_type(4)));
typedef float f32x16 __attribute__((ext_vector_type(16)));
typedef unsigned u32x4 __attribute__((ext_vector_type(4)));
typedef unsigned u32x2 __attribute__((ext_vector_type(2)));

constexpr int DM = 1024, NTOK = 24576, NCTX = 8192, SEQC = 256, SEQS = 2048, INC = 9232;
constexpr int LDS_BYTES = 160 * 1024;
constexpr size_t OFF_WT = 0;
constexpr size_t OFF_WBM = 18874368, OFF_WBH = 20971520, OFF_WOUT = 23068672, OFF_W1T = 25165824, OFF_W2T = 33554432;
constexpr size_t OFF_HN = 41943040;
constexpr size_t OFF_BIG = 92274688;
constexpr size_t OFF_SM = 243269632;
constexpr size_t OFF_MOD = OFF_SM;
constexpr size_t OFF_C1 = OFF_MOD + 221184;
constexpr size_t OFF_H2S = OFF_C1 + 147456;
constexpr size_t OFF_H2C = OFF_H2S + 524288;
constexpr size_t OFF_PER = OFF_H2C + 65536;
constexpr size_t OFF_PEC = OFF_PER + 65536;
constexpr size_t OFF_GT = OFF_PEC + 131072;
constexpr size_t OFF_SSQ1 = OFF_GT + 1572864;
constexpr size_t OFF_SSQ2 = OFF_SSQ1 + 1572864;
constexpr size_t OFF_HFS = OFF_SSQ2 + 1572864;
constexpr size_t OFF_HFC = OFF_HFS + 16777216;
constexpr size_t OFF_BAR = OFF_HFC + 2097152;
constexpr size_t WS_END = OFF_BAR + 3456 * 4;
constexpr size_t OUT_H = 0, OUT_HB = 50331648;
constexpr size_t OUTF_C = 25165824, OUTF_N = 41943040, OUTF_M = 42008576;

struct Params { const float* in[32]; float* out; unsigned char* ws; };

__device__ __forceinline__ bf16_t f2bf(float f) { unsigned u = __float_as_uint(f); u += 0x7FFFu + ((u >> 16) & 1u); return (bf16_t)(u >> 16); }
__device__ __forceinline__ float bf2f(unsigned b) { return __uint_as_float(b << 16); }
__device__ __forceinline__ unsigned pack2(float lo, float hi) { return (unsigned)f2bf(lo) | ((unsigned)f2bf(hi) << 16); }
__device__ __forceinline__ float bflo(unsigned w) { return __uint_as_float(w << 16); }
__device__ __forceinline__ float bfhi(unsigned w) { return __uint_as_float(w & 0xffff0000u); }
__device__ __forceinline__ float sigmoidf_(float x) { return 1.0f / (1.0f + __expf(-x)); }
__device__ __forceinline__ int opaque_tid() { int t = threadIdx.x; asm volatile("" : "+v"(t)); return t; }
__device__ __forceinline__ float wave_sum(float v) {
#pragma unroll
  for (int o = 32; o >= 1; o >>= 1) v += __shfl_xor(v, o);
  return v;
}


#define XB_TMO      128
#define XB_XCNT(j)  (256  + 64 * (j))
#define XB_XSUB(j)  (1280 + 64 * (j))
#define XB_XGEN(j)  (2304 + 64 * (j))
#define XB_TOP      3328
#define XB_TOPGEN   3392
#define XCD_BAR_WORDS 3456
#define XB_SPIN_CAP (1u << 18)
__device__ __forceinline__ unsigned xb_ld(unsigned* p)              { return __hip_atomic_load(p, __ATOMIC_RELAXED, __HIP_MEMORY_SCOPE_AGENT); }
__device__ __forceinline__ unsigned xb_add(unsigned* p, unsigned v) { return __hip_atomic_fetch_add(p, v, __ATOMIC_RELAXED, __HIP_MEMORY_SCOPE_AGENT); }
__device__ __forceinline__ unsigned xb_xcc_id() { return (unsigned)__builtin_amdgcn_s_getreg((3 << 11) | 20) & 0xFu; }
#define XB_SPIN(cond, bar) do { unsigned _sp = 0; while (cond) { __builtin_amdgcn_s_sleep(1); \
    if ((++_sp & 255u) == 0u) { if (xb_ld(&(bar)[XB_TMO])) break; if (_sp > XB_SPIN_CAP) { atomicAdd(&(bar)[XB_TMO], 1u); break; } } } } while (0)
struct XcdBarrier { unsigned* bar; unsigned x; volatile LAS unsigned* st; };
__device__ __forceinline__ XcdBarrier xcd_barrier_post(unsigned* bar, volatile LAS unsigned* st) {
  XcdBarrier b; b.bar = bar; b.x = xb_xcc_id(); b.st = st;
  if (threadIdx.x == 0) (void)xb_add(&bar[XB_XCNT(b.x)], 1u);
  return b;
}
__device__ __forceinline__ void xcd_barrier_complete(unsigned* bar, unsigned x, unsigned& nloc, unsigned& nx) {
  const unsigned G = gridDim.x * gridDim.y * gridDim.z;
  unsigned sum, cnt, mine, sp = 0u;
  for (;;) {
    sum = 0u; cnt = 0u; mine = 0u;
#pragma unroll
    for (unsigned j = 0; j < 16; ++j) { const unsigned c = xb_ld(&bar[XB_XCNT(j)]); sum += c; cnt += (c > 0u) ? 1u : 0u; mine = (j == x) ? c : mine; }
    if (sum == G) break;
    __builtin_amdgcn_s_sleep(1);
    if ((++sp & 255u) == 0u) { if (xb_ld(&bar[XB_TMO])) break; if (sp > XB_SPIN_CAP) { atomicAdd(&bar[XB_TMO], 1u); break; } }
  }
  nloc = mine > 0u ? mine : 1u; nx = cnt > 0u ? cnt : 1u;
}
__device__ __forceinline__ void xcd_barrier(const XcdBarrier& b) {
  asm volatile("s_waitcnt vmcnt(0)" ::: "memory");
  __syncthreads();
  if (threadIdx.x == 0) {
    unsigned* bar = b.bar;
    __builtin_amdgcn_s_waitcnt(0);
    unsigned nloc = b.st[0], nx = b.st[1];
    if (nloc == 0u) { xcd_barrier_complete(bar, b.x, nloc, nx); b.st[0] = nloc; b.st[1] = nx; }
    const unsigned old = xb_add(&bar[XB_XSUB(b.x)], 1u);
    const unsigned gen = old / nloc;
    if (old + 1u == (gen + 1u) * nloc) {
      __builtin_amdgcn_fence(__ATOMIC_RELEASE, "agent");
      asm volatile("s_waitcnt vmcnt(0)" ::: "memory");
      const unsigned og = xb_add(&bar[XB_TOP], 1u);
      const unsigned tg = og / nx;
      if (og + 1u == (tg + 1u) * nx) xb_add(&bar[XB_TOPGEN], 1u);
      else XB_SPIN(xb_ld(&bar[XB_TOPGEN]) == tg, bar);
      __builtin_amdgcn_fence(__ATOMIC_ACQUIRE, "agent");
      xb_add(&bar[XB_XGEN(b.x)], 1u);
      asm volatile("s_waitcnt vmcnt(0)" ::: "memory");
    } else {
      XB_SPIN(xb_ld(&bar[XB_XGEN(b.x)]) == gen, bar);
      __builtin_amdgcn_fence(__ATOMIC_ACQUIRE, "agent");
      asm volatile("s_waitcnt vmcnt(0)" ::: "memory");
    }
  }
  __syncthreads();
}

namespace pg8 {
constexpr int BM = 256, BK = 64, HALF = 128, HTB = HALF * BK * 2, STAGE_BYTES = 8 * HTB, NXCD = 8, WGM = 8;
__host__ __device__ __forceinline__ int lds_byte(int r, int c) { const int st = (r >> 4) * 2 + (c >> 5), rr = r & 15, cc = c & 31, ob = rr * 64 + cc * 2; return st * 1024 + (ob ^ (((ob >> 9) & 1) << 5)); }
__host__ __device__ __forceinline__ void stage_rc(int b, int& R, int& C) { const int st = b / 1024, sb = b % 1024, swz = sb ^ (((sb >> 9) & 1) << 5); R = (st >> 1) * 16 + swz / 64; C = (st & 1) * 32 + (swz % 64) / 2; }
__host__ __device__ __forceinline__ int perm32(int rho) { const int n = rho >> 4, i = rho & 15; return 8 * (i >> 2) + 4 * n + (i & 3); }
struct Unit { int pm, pn, ks; };
struct Gemm { const bf16_t* A; const bf16_t* Bt; int M, N, K, ld, nks; };
struct StaticOrder {
  int nM, nN, ntile, nwg, G, c;
  __device__ void init(int M, int N, int nks, int G_, int c_) { nM = M / BM; nN = N / BM; ntile = nM * nN; nwg = ntile * nks; G = G_; c = c_; }
  __device__ bool next(int i, Unit& u) const {
    const long L = (long)i * G + c; if (L >= nwg) return false;
    u.ks = (int)L / ntile; int wgid = (int)L - u.ks * ntile;
    { const int q = ntile / NXCD, r = ntile % NXCD, xcd = wgid % NXCD, off = wgid / NXCD; wgid = (xcd < r ? xcd * (q + 1) : r * (q + 1) + (xcd - r) * q) + off; }
    const int nig = WGM * nN, gid = wgid / nig, fm = gid * WGM, gsz = (nM - fm) < WGM ? (nM - fm) : WGM;
    u.pm = fm + ((wgid % nig) % gsz); u.pn = (wgid % nig) / gsz; return true;
  }
};

template <class Epi>
__device__ __forceinline__ void gemm_phase(LP lds, const Gemm g, const StaticOrder& S, const Epi& E) {
  int tid_ = threadIdx.x; asm volatile("" : "+v"(tid_));
  const int tid = tid_, wid = __builtin_amdgcn_readfirstlane(tid >> 6), lane = tid & 63, wr = wid >> 2, wc = wid & 3, fr = lane & 15, fq = lane >> 4;
  const int K = g.ld, nt = g.K / BK;
  const size_t ksb = (size_t)g.K * 2;
  unsigned voffA[2], voffB[2];
#pragma unroll
  for (int i = 0; i < 2; ++i) { int R, C; stage_rc(tid * 16 + i * 8192, R, C); const int Rb = (R & ~31) + perm32(R & 31); voffA[i] = (unsigned)(R * K + C) * 2u; voffB[i] = (unsigned)(Rb * K + C) * 2u; }
  const size_t kstep = (size_t)(BK * 2);
  const size_t hstep = (size_t)HALF * K * 2;
  const size_t tstep = 2 * hstep;
  const unsigned ldsw = (unsigned)wid * 1024u;
  const int aoff = lds_byte(wr * 64 + fr, fq * 8), boff = lds_byte(wc * 32 + fr, fq * 8);
#define PG8_SA(b, h) (((b) * 2 + (h)) * HTB)
#define PG8_SB(b, h) ((4 + (b) * 2 + (h)) * HTB)
#define PG8_STAGE(bufoff, gbase, voff) do { _Pragma("unroll") for (int _i = 0; _i < 2; ++_i) \
    __builtin_amdgcn_global_load_lds((const unsigned*)((const char*)(gbase) + (voff)[_i]), (LAS unsigned*)(lds + (bufoff) + ldsw + _i * 8192), 16, 0, 0); } while (0)
#define PG8_LDA(dst, b, h) do { _Pragma("unroll") for (int m = 0; m < 4; ++m) _Pragma("unroll") for (int k = 0; k < 2; ++k) dst[m][k] = *(const LAS bf16x8*)(lds + PG8_SA(b, h) + aoff + m * 2048 + k * 1024); } while (0)
#define PG8_LDB(dst, b, h) do { _Pragma("unroll") for (int n = 0; n < 2; ++n) _Pragma("unroll") for (int k = 0; k < 2; ++k) dst[n][k] = *(const LAS bf16x8*)(lds + PG8_SB(b, h) + boff + n * 2048 + k * 1024); } while (0)
#define PG8_MMA(ai, bj, At, Bt) do { __builtin_amdgcn_s_setprio(1); _Pragma("unroll") for (int m = 0; m < 4; ++m) _Pragma("unroll") for (int n = 0; n < 2; ++n) _Pragma("unroll") for (int k = 0; k < 2; ++k) \
    acc[ai][bj][m][n] = __builtin_amdgcn_mfma_f32_16x16x32_bf16(Bt[n][k], At[m][k], acc[ai][bj][m][n], 0, 0, 0); __builtin_amdgcn_s_setprio(0); } while (0)
#define PG8_WAIT_V(n) asm volatile("s_waitcnt vmcnt(" #n ")" ::: "memory")
#define PG8_WAIT_L(n) asm volatile("s_waitcnt lgkmcnt(" #n ")" ::: "memory")
#define PG8_BAR __builtin_amdgcn_s_barrier()
#define PG8_SCHED __builtin_amdgcn_sched_barrier(0)
  Unit cur, nxt; int ui = 0;
  if (!S.next(0, cur)) return;
  f32x4 acc[2][2][4][2];
#pragma unroll
  for (int a = 0; a < 2; ++a)
#pragma unroll
    for (int b = 0; b < 2; ++b)
#pragma unroll
      for (int m = 0; m < 4; ++m)
#pragma unroll
        for (int n = 0; n < 2; ++n) acc[a][b][m][n] = (f32x4){0.f, 0.f, 0.f, 0.f};
  bf16x8 At[4][2], B0[2][2], B1[2][2];
  const char* cA = (const char*)g.A + (size_t)cur.pm * tstep + cur.ks * ksb; const char* cB = (const char*)g.Bt + (size_t)cur.pn * tstep + cur.ks * ksb;
  PG8_STAGE(PG8_SB(0, 0), cB, voffB); PG8_STAGE(PG8_SA(0, 0), cA, voffA); PG8_STAGE(PG8_SB(0, 1), cB + hstep, voffB); PG8_STAGE(PG8_SA(0, 1), cA + hstep, voffA);
  if (wr == 1) PG8_BAR;
  PG8_WAIT_V(4); PG8_BAR;
  PG8_STAGE(PG8_SB(1, 0), cB + kstep, voffB); PG8_STAGE(PG8_SA(1, 0), cA + kstep, voffA); PG8_STAGE(PG8_SB(1, 1), cB + hstep + kstep, voffB);
  PG8_WAIT_V(6); PG8_BAR;
  for (;;) {
    const bool has_next = S.next(ui + 1, nxt);
    const char* nA = has_next ? (const char*)g.A + (size_t)nxt.pm * tstep + nxt.ks * ksb : cA; const char* nB = has_next ? (const char*)g.Bt + (size_t)nxt.pn * tstep + nxt.ks * ksb : cB;
    for (int t = 0; t < nt; t += 2) {
      const bool last = (t == nt - 2);
      const char* a1 = cA + (size_t)(t + 1) * kstep;
      const char* a2 = last ? nA : cA + (size_t)(t + 2) * kstep; const char* b2 = last ? nB : cB + (size_t)(t + 2) * kstep;
      const char* a3 = a2 + kstep; const char* b3 = b2 + kstep;
      PG8_LDB(B0, 0, 0); PG8_SCHED; PG8_LDA(At, 0, 0); PG8_STAGE(PG8_SA(1, 1), a1 + hstep, voffA);
      PG8_WAIT_L(8); PG8_BAR; PG8_WAIT_L(0); PG8_MMA(0, 0, At, B0); PG8_BAR; PG8_SCHED;
      PG8_LDB(B1, 0, 1); PG8_STAGE(PG8_SB(0, 0), b2, voffB);
      PG8_BAR; PG8_WAIT_L(0); PG8_MMA(0, 1, At, B1); PG8_BAR;
      PG8_LDA(At, 0, 1); PG8_STAGE(PG8_SA(0, 0), a2, voffA);
      PG8_BAR; PG8_WAIT_L(0); PG8_MMA(1, 0, At, B0); PG8_BAR; PG8_SCHED;
      PG8_STAGE(PG8_SB(0, 1), b2 + hstep, voffB);
      PG8_WAIT_V(6); PG8_BAR; PG8_MMA(1, 1, At, B1); PG8_BAR;
      PG8_LDB(B0, 1, 0); PG8_SCHED; PG8_LDA(At, 1, 0); PG8_STAGE(PG8_SA(0, 1), a2 + hstep, voffA);
      PG8_WAIT_L(8); PG8_BAR; PG8_WAIT_L(0); PG8_MMA(0, 0, At, B0); PG8_BAR; PG8_SCHED;
      PG8_LDB(B1, 1, 1); PG8_STAGE(PG8_SB(1, 0), b3, voffB);
      PG8_BAR; PG8_WAIT_L(0); PG8_MMA(0, 1, At, B1); PG8_BAR;
      PG8_LDA(At, 1, 1); PG8_STAGE(PG8_SA(1, 0), a3, voffA);
      PG8_BAR; PG8_WAIT_L(0); PG8_MMA(1, 0, At, B0); PG8_BAR; PG8_SCHED;
      PG8_STAGE(PG8_SB(1, 1), b3 + hstep, voffB);
      PG8_WAIT_V(6); PG8_BAR; PG8_MMA(1, 1, At, B1); PG8_BAR;
    }
    { int fr2 = fr, fq2 = fq; asm volatile("" : "+v"(fr2), "+v"(fq2)); E(acc, cur, wr, wc, fr2, fq2); }
    if (!has_next) break;
#pragma unroll
    for (int a = 0; a < 2; ++a)
#pragma unroll
      for (int b = 0; b < 2; ++b)
#pragma unroll
        for (int m = 0; m < 4; ++m)
#pragma unroll
          for (int n = 0; n < 2; ++n) acc[a][b][m][n] = (f32x4){0.f, 0.f, 0.f, 0.f};
    cur = nxt; cA = nA; cB = nB; ++ui;
  }
  PG8_WAIT_V(0);
  if (wr == 0) PG8_BAR;
  PG8_BAR;
#undef PG8_SA
#undef PG8_SB
#undef PG8_STAGE
#undef PG8_LDA
#undef PG8_LDB
#undef PG8_MMA
#undef PG8_WAIT_V
#undef PG8_WAIT_L
#undef PG8_BAR
#undef PG8_SCHED
}
}
using pg8::Unit;
typedef f32x4 AccT[2][2][4][2];

#define EPI_ROW(ai, m) (u.pm * 256 + (ai) * 128 + wr * 64 + (m) * 16 + fr)
#define EPI_COL(bj, n) (u.pn * 256 + (bj) * 128 + wc * 32 + 8 * fq + 4 * (n))
#define EPI_LOOP_ROWS _Pragma("unroll") for (int ai = 0; ai < 2; ++ai) _Pragma("unroll") for (int m = 0; m < 4; ++m)
#define EPI_LOOP_COLS _Pragma("unroll") for (int bj = 0; bj < 2; ++bj) _Pragma("unroll") for (int n = 0; n < 2; ++n)

__device__ __forceinline__ int cond_of_row(int row) { return row < NCTX ? 0 : 1 + ((row - NCTX) >> 11); }

#define EPI_LOOP_BJ _Pragma("unroll") for (int bj = 0; bj < 2; ++bj)
__device__ __forceinline__ u32x4 pack8(const f32x4 v0, const f32x4 v1) { u32x4 w; w.x = pack2(v0[0], v0[1]); w.y = pack2(v0[2], v0[3]); w.z = pack2(v1[0], v1[1]); w.w = pack2(v1[2], v1[3]); return w; }
__device__ __forceinline__ void unpack8(const u32x4 w, f32x4& v0, f32x4& v1) { v0[0] = bflo(w.x); v0[1] = bfhi(w.x); v0[2] = bflo(w.y); v0[3] = bfhi(w.y); v1[0] = bflo(w.z); v1[1] = bfhi(w.z); v1[2] = bflo(w.w); v1[3] = bfhi(w.w); }
struct EpiQKV {
  bf16_t* O; const float* bias;
  __device__ __forceinline__ void operator()(const AccT& acc, const Unit& u, int wr, int wc, int fr, int fq) const {
    const float sc = (u.pn < 4) ? 0.0625f : 1.0f;
    f32x4 bv[2][2];
    EPI_LOOP_COLS { bv[bj][n] = *(const f32x4*)(bias + EPI_COL(bj, n)); }
    EPI_LOOP_ROWS { const int row = EPI_ROW(ai, m);
      EPI_LOOP_BJ { *(u32x4*)(O + (size_t)row * 3072 + EPI_COL(bj, 0)) = pack8((acc[ai][bj][m][0] + bv[bj][0]) * sc, (acc[ai][bj][m][1] + bv[bj][1]) * sc); } }
  }
};
struct EpiUT {
  bf16_t* O; const float* bias;
  __device__ __forceinline__ void operator()(const AccT& acc, const Unit& u, int wr, int wc, int fr, int fq) const {
    EPI_LOOP_ROWS { const int row = EPI_ROW(ai, m); const float bv = bias[row];
      EPI_LOOP_BJ { *(u32x4*)(O + (size_t)row * NTOK + EPI_COL(bj, 0)) = pack8(acc[ai][bj][m][0] + bv, acc[ai][bj][m][1] + bv); } }
  }
};
struct EpiGates {
  bf16_t* H; bf16_t* G; const float* b_in;
  __device__ __forceinline__ void operator()(const AccT& acc, const Unit& u, int wr, int wc, int fr, int fq) const {
    const bool og = u.pn < 4;
    f32x4 bv[2][2];
    EPI_LOOP_COLS { const int col = EPI_COL(bj, n); bv[bj][n] = *(const f32x4*)(b_in + (og ? 3072 + col : 7184 + (col - 1024))); }
    EPI_LOOP_ROWS { const int row = EPI_ROW(ai, m);
      u32x4 hv[2];
      if (og) { EPI_LOOP_BJ { hv[bj] = *(const u32x4*)(H + (size_t)row * 1024 + EPI_COL(bj, 0)); } }
      EPI_LOOP_BJ { const int col = EPI_COL(bj, 0); f32x4 s0, s1; const f32x4 a0 = acc[ai][bj][m][0] + bv[bj][0], a1 = acc[ai][bj][m][1] + bv[bj][1];
#pragma unroll
        for (int e = 0; e < 4; ++e) { s0[e] = sigmoidf_(a0[e]); s1[e] = sigmoidf_(a1[e]); }
        if (og) { f32x4 h0, h1; unpack8(hv[bj], h0, h1); *(u32x4*)(H + (size_t)row * 1024 + col) = pack8(h0 * s0, h1 * s1); }
        else *(u32x4*)(G + (size_t)row * 2048 + (col - 1024)) = pack8(s0, s1); } }
  }
};
template <int SECOND> struct EpiMerge {
  bf16_t* T; const bf16_t* G;
  __device__ __forceinline__ void operator()(const AccT& acc, const Unit& u, int wr, int wc, int fr, int fq) const {
    EPI_LOOP_ROWS { const int row = EPI_ROW(ai, m);
      u32x4 gv[2], tv[2];
      EPI_LOOP_BJ { const int col = EPI_COL(bj, 0); gv[bj] = *(const u32x4*)(G + (size_t)row * 2048 + SECOND * 1024 + col);
        if (SECOND) tv[bj] = *(const u32x4*)(T + (size_t)row * 1024 + col); }
      EPI_LOOP_BJ { const int col = EPI_COL(bj, 0); f32x4 g0, g1; unpack8(gv[bj], g0, g1);
        f32x4 v0 = g0 * acc[ai][bj][m][0], v1 = g1 * acc[ai][bj][m][1];
        if (SECOND) { f32x4 t0, t1; unpack8(tv[bj], t0, t1); v0 += t0; v1 += t1; }
        *(u32x4*)(T + (size_t)row * 1024 + col) = pack8(v0, v1); } }
  }
};
struct EpiOut {
  const float* xp; const float* xs; const float* per; const float* pec; const float* mod; const float* n2w; float* X1; bf16_t* A2; float* ssq;
  __device__ __forceinline__ void operator()(const AccT& acc, const Unit& u, int wr, int wc, int fr, int fq) const {
    const int cb = cond_of_row(u.pm * 256); const float* md = mod + cb * 6144; const bool smp = (u.pm * 256) >= NCTX;
    f32x4 g1v[2][2], k2v[2][2];
    EPI_LOOP_COLS { const int col = EPI_COL(bj, n); g1v[bj][n] = *(const f32x4*)(md + 2048 + col); k2v[bj][n] = *(const f32x4*)(n2w + col) * (*(const f32x4*)(md + 4096 + col) + 1.0f); }
    EPI_LOOP_ROWS { const int row = EPI_ROW(ai, m); float ss = 0.f;
#pragma unroll
      for (int bj = 0; bj < 2; ++bj) {
        f32x4 x0[2];
        if (!smp) {
#pragma unroll
          for (int n = 0; n < 2; ++n) x0[n] = *(const f32x4*)(xp + (size_t)row * 1024 + EPI_COL(bj, n)); }
        else { const int r2 = row - NCTX, t = r2 & 2047; f32x4 pe[2];
#pragma unroll
          for (int n = 0; n < 2; ++n) { const int col = EPI_COL(bj, n); x0[n] = *(const f32x4*)(xs + (size_t)r2 * 1024 + col);
            pe[n] = (col < 512) ? *(const f32x4*)(per + (t >> 6) * 512 + col) : *(const f32x4*)(pec + (t & 63) * 512 + (col - 512)); }
#pragma unroll
          for (int n = 0; n < 2; ++n) x0[n] += pe[n]; }
        f32x4 x1[2];
#pragma unroll
        for (int n = 0; n < 2; ++n) { x1[n] = x0[n] + g1v[bj][n] * acc[ai][bj][m][n]; *(f32x4*)(X1 + (size_t)row * 1024 + EPI_COL(bj, n)) = x1[n];
          ss += x1[n][0] * x1[n][0] + x1[n][1] * x1[n][1] + x1[n][2] * x1[n][2] + x1[n][3] * x1[n][3]; }
        *(u32x4*)(A2 + (size_t)row * 1024 + EPI_COL(bj, 0)) = pack8(x1[0] * k2v[bj][0], x1[1] * k2v[bj][1]); }
      ss += __shfl_xor(ss, 16); ss += __shfl_xor(ss, 32);
      if (fq == 0) ssq[(size_t)row * 16 + u.pn * 4 + wc] = ss; }
  }
};
struct EpiFF1 {
  int row0; const float* ssq; const float* c1; bf16_t* Hd;
  __device__ __forceinline__ void operator()(const AccT& acc, const Unit& u, int wr, int wc, int fr, int fq) const {
    const int cb = cond_of_row(row0 + u.pm * 256); const float* cc = c1 + cb * 4096;
    f32x4 cv[2][2];
    EPI_LOOP_COLS { cv[bj][n] = *(const f32x4*)(cc + EPI_COL(bj, n)); }
    float rs[2][4];
    EPI_LOOP_ROWS { const float* sp = ssq + (size_t)(row0 + EPI_ROW(ai, m)) * 16;
      const f32x4 st = (*(const f32x4*)sp + *(const f32x4*)(sp + 4)) + (*(const f32x4*)(sp + 8) + *(const f32x4*)(sp + 12));
      rs[ai][m] = rsqrtf((st[0] + st[1] + st[2] + st[3]) * (1.0f / 1024.0f) + 1e-6f); }
    EPI_LOOP_ROWS { const int rl = EPI_ROW(ai, m); const float rstd = rs[ai][m];
      EPI_LOOP_BJ { f32x4 v0 = acc[ai][bj][m][0] * rstd + cv[bj][0], v1 = acc[ai][bj][m][1] * rstd + cv[bj][1];
#pragma unroll
        for (int e = 0; e < 4; ++e) { const float r0 = fmaxf(v0[e], 0.f), r1 = fmaxf(v1[e], 0.f); v0[e] = r0 * r0; v1[e] = r1 * r1; }
        *(u32x4*)(Hd + (size_t)rl * 4096 + EPI_COL(bj, 0)) = pack8(v0, v1); } }
  }
};
struct EpiFF2 {
  int row0; const float* mod; const float* b2; float* X; float* P;
  __device__ __forceinline__ void operator()(const AccT& acc, const Unit& u, int wr, int wc, int fr, int fq) const {
    if (u.ks == 1) {
      EPI_LOOP_ROWS { const int rl = EPI_ROW(ai, m); EPI_LOOP_COLS { *(f32x4*)(P + (size_t)rl * 1024 + EPI_COL(bj, n)) = acc[ai][bj][m][n]; } }
    } else {
    const int cb = cond_of_row(row0 + u.pm * 256); const float* md = mod + cb * 6144;
    f32x4 g2v[2][2], bbv[2][2];
    EPI_LOOP_COLS { const int col = EPI_COL(bj, n); g2v[bj][n] = *(const f32x4*)(md + 5120 + col); bbv[bj][n] = *(const f32x4*)(b2 + col); }
#pragma unroll
    for (int ai = 0; ai < 2; ++ai)
#pragma unroll
      for (int m2 = 0; m2 < 2; ++m2) {
        f32x4 xv[2][2][2];
#pragma unroll
        for (int mm = 0; mm < 2; ++mm) { const int row = row0 + EPI_ROW(ai, 2 * m2 + mm); EPI_LOOP_COLS { xv[mm][bj][n] = *(const f32x4*)(X + (size_t)row * 1024 + EPI_COL(bj, n)); } }
#pragma unroll
        for (int mm = 0; mm < 2; ++mm) { const int m = 2 * m2 + mm; const int row = row0 + EPI_ROW(ai, m);
          EPI_LOOP_COLS { const int col = EPI_COL(bj, n); *(f32x4*)(X + (size_t)row * 1024 + col) = xv[mm][bj][n] + g2v[bj][n] * (acc[ai][bj][m][n] + bbv[bj][n]); } } }
    }
  }
};

template <class Epi> __device__ __forceinline__ void run_gemm(LP lds, const bf16_t* A, const bf16_t* Bt, int M, int N, int K, const Epi& E, int nks = 1) {
  pg8::Gemm g; g.A = A; g.Bt = Bt; g.M = M; g.N = N; g.K = K / nks; g.ld = K; g.nks = nks;
  pg8::StaticOrder S; S.init(M, N, nks, (int)gridDim.x, (int)blockIdx.x);
  pg8::gemm_phase<Epi>(lds, g, S, E);
}

__device__ void transpose_tile(const float* __restrict__ src, int ld, int col0, int k0, bf16_t* __restrict__ dst, int K, int drow0, LAS float* tile) {
  const int t = opaque_tid();
  f32x4 v[4];
#pragma unroll
  for (int i = 0; i < 4; ++i) { const int idx = t + 512 * i, kr = idx >> 5, c4 = idx & 31; v[i] = *(const f32x4*)(src + (size_t)(k0 + kr) * ld + col0 + 4 * c4); }
#pragma unroll
  for (int i = 0; i < 4; ++i) { const int idx = t + 512 * i, kr = idx >> 5, c4 = idx & 31; LAS float* tp = tile + kr * 129 + 4 * c4; tp[0] = v[i][0]; tp[1] = v[i][1]; tp[2] = v[i][2]; tp[3] = v[i][3]; }
  __syncthreads();
  const int kb = t & 7;
#pragma unroll
  for (int i = 0; i < 2; ++i) { const int c = (t >> 3) + 64 * i; const LAS float* tp = tile + (kb * 8) * 129 + c; u32x4 o;
    o.x = pack2(tp[0], tp[129]); o.y = pack2(tp[2 * 129], tp[3 * 129]); o.z = pack2(tp[4 * 129], tp[5 * 129]); o.w = pack2(tp[6 * 129], tp[7 * 129]);
    *(u32x4*)(dst + (size_t)(drow0 + c) * K + k0 + kb * 8) = o; }
  __syncthreads();
}
template <int SILU> __device__ void matvec9_unit(const float* v0, const float* v1, int v1stride, const float* __restrict__ W, int ldw, const float* bias, float* out, int ldo, int col0, LAS float* lf) {
  const int t = opaque_tid(), lane = t & 63, wid = t >> 6;
  LAS float* sv = lf; LAS float* red = lf + 9216;
  for (int i = t; i < 9216; i += 512) { const int b = i >> 10, k = i & 1023; float x = (b == 0) ? v0[k] : v1[(size_t)(b - 1) * v1stride + k]; if (SILU) x = x / (1.0f + __expf(-x)); sv[i] = x; }
  __syncthreads();
  const int c4 = t & 7, kl = t >> 3;
  f32x4 w[16];
#pragma unroll
  for (int i = 0; i < 16; ++i) w[i] = *(const f32x4*)(W + (size_t)(kl + 64 * i) * ldw + col0 + 4 * c4);
  f32x4 acc[9];
#pragma unroll
  for (int b = 0; b < 9; ++b) acc[b] = (f32x4){0.f, 0.f, 0.f, 0.f};
#pragma unroll
  for (int i = 0; i < 16; ++i)
#pragma unroll
    for (int b = 0; b < 9; ++b) acc[b] += w[i] * sv[b * 1024 + kl + 64 * i];
#pragma unroll
  for (int b = 0; b < 9; ++b)
#pragma unroll
    for (int e = 0; e < 4; ++e) { float x = acc[b][e]; x += __shfl_xor(x, 8); x += __shfl_xor(x, 16); x += __shfl_xor(x, 32); acc[b][e] = x; }
  if (lane < 8) {
#pragma unroll
    for (int b = 0; b < 9; ++b) *(LAS f32x4*)(red + (wid * 9 + b) * 32 + 4 * lane) = acc[b]; }
  __syncthreads();
  if (t < 288) { const int b = t >> 5, cc = t & 31; float s = bias[col0 + cc];
#pragma unroll
    for (int pz = 0; pz < 8; ++pz) s += red[(pz * 9 + b) * 32 + cc];
    out[(size_t)b * ldo + col0 + cc] = s; }
  __syncthreads();
}

__device__ void phase0(const Params& p, LP lds) {
  unsigned char* ws = p.ws; LAS float* lf = (LAS float*)lds;
  const int tid0 = opaque_tid(); const int wid = tid0 >> 6, lane = tid0 & 63;
  for (int unit = blockIdx.x; unit < 576; unit += gridDim.x) {
    if (unit < 192) {
      matvec9_unit<1>(p.in[6], p.in[5], 1024, p.in[7], 6144, p.in[8], (float*)(ws + OFF_MOD), 6144, unit * 32, lf);
    } else if (unit < 480) {
      const int row = (unit - 192) * 8 + wid; const bool smp = row < 2048; const int L = smp ? 2048 : 256, t = smp ? row : row - 2048;
      const float* w1 = p.in[14]; const float* b1 = p.in[15]; const float* fr1 = p.in[16]; const float* w2 = p.in[17]; const float* b2 = p.in[18]; const float* fr2 = p.in[19];
      float a = b1[lane] + (float)t / (float)(L - 1) * w1[lane];
      const float base = (6.283185307179586f / (float)L) * (float)t;
      float cs = 0.f, sn = 0.f; if (lane < 16) { const float ang = base * (float)(lane + 1); cs = cosf(ang); sn = sinf(ang); }
#pragma unroll
      for (int i = 0; i < 16; ++i) a += __shfl(cs, i) * w1[(1 + i) * 64 + lane] + __shfl(sn, i) * w1[(17 + i) * 64 + lane];
      const float h1 = sinf(fr1[lane] * a);
      float a2 = b2[lane];
#pragma unroll 16
      for (int j = 0; j < 64; ++j) a2 += __shfl(h1, j) * w2[j * 64 + lane];
      const float h2 = sinf(fr2[lane] * a2);
      float* dst = (float*)(ws + (smp ? OFF_H2S : OFF_H2C)); dst[(size_t)t * 64 + lane] = h2;
    } else {
      const int r = unit - 480, c = tid0; const int pos = r < 32 ? r : r - 32; const int i = c & 255;
      const float omega = 1.0f / powf(10000.0f, (float)i / 256.0f); const float a = (float)pos * omega; const float v = c < 256 ? sinf(a) : cosf(a);
      float* dst = (float*)(ws + (r < 32 ? OFF_PER : OFF_PEC)); dst[(size_t)pos * 512 + c] = v;
    }
  }
}
__device__ void weight_tiles(const Params& p, LP lds) {
  unsigned char* ws = p.ws; LAS float* lf = (LAS float*)lds;
  for (int tu = blockIdx.x; tu < 2560; tu += gridDim.x) {
    const float* src; int ld, K, col0, k0, drow0; bf16_t* dst;
    if (tu < 1152) { const int nt = tu >> 4, kt = tu & 15; const int r = nt * 128; src = p.in[10]; ld = INC; K = 1024; k0 = kt * 64; drow0 = r; dst = (bf16_t*)(ws + OFF_WT);
      col0 = r < 3072 ? r : (r < 6144 ? 4112 + (r - 3072) : (r < 7168 ? 3072 + (r - 6144) : 7184 + (r - 7168))); }
    else if (tu < 1536) { const int v = tu - 1152, w = v >> 7, q = v & 127; src = p.in[23 + w]; ld = 1024; K = 1024; k0 = (q & 15) * 64; col0 = (q >> 4) * 128; drow0 = col0; dst = (bf16_t*)(ws + (w == 0 ? OFF_WBM : (w == 1 ? OFF_WBH : OFF_WOUT))); }
    else if (tu < 2048) { const int q = tu - 1536; src = p.in[27]; ld = 4096; K = 1024; k0 = (q & 15) * 64; col0 = (q >> 4) * 128; drow0 = col0; dst = (bf16_t*)(ws + OFF_W1T); }
    else { const int q = tu - 2048; src = p.in[29]; ld = 1024; K = 4096; k0 = (q & 63) * 64; col0 = (q >> 6) * 128; drow0 = col0; dst = (bf16_t*)(ws + OFF_W2T); }
    transpose_tile(src, ld, col0, k0, dst, K, drow0, lf);
  }
}

__device__ void phase1(const Params& p, LP lds) {
  unsigned char* ws = p.ws;
  int tid_ = threadIdx.x; asm volatile("" : "+v"(tid_));
  const int tid = tid_, wid = tid >> 6, lane = tid & 63;
  const float* mod = (const float*)(ws + OFF_MOD);
  LAS float* wg = (LAS float*)lds;
  if ((int)blockIdx.x < 1536) {
    f32x4 gw[8];
#pragma unroll
    for (int i = 0; i < 8; ++i) { const int idx = tid + 512 * i, k = idx >> 2, q = idx & 3; gw[i] = *(const f32x4*)(p.in[10] + (size_t)k * INC + 4096 + 4 * q); }
#pragma unroll
    for (int i = 0; i < 8; ++i) { const int idx = tid + 512 * i, k = idx >> 2, q = idx & 3; wg[(4 * q) * 1024 + k] = gw[i][0]; wg[(4 * q + 1) * 1024 + k] = gw[i][1]; wg[(4 * q + 2) * 1024 + k] = gw[i][2]; wg[(4 * q + 3) * 1024 + k] = gw[i][3]; }
    __syncthreads();
  }
  for (int unit = blockIdx.x; unit < 1536; unit += gridDim.x) {
    const int tidn = opaque_tid(); const int wid = tidn >> 6, lane = tidn & 63;
    const int row0 = unit * 16 + wid * 2; const int cb = cond_of_row(row0); const float* md = mod + cb * 6144; const bool smp = row0 >= NCTX;
    f32x4 v[2][4]; float rstd[2];
#pragma unroll
    for (int r = 0; r < 2; ++r) { const int row = row0 + r; const float* xr; int t = 0;
      if (!smp) xr = p.in[0] + (size_t)row * 1024; else { xr = p.in[1] + (size_t)(row - NCTX) * 1024; t = (row - NCTX) & 2047; }
      const float* per = (const float*)(ws + OFF_PER) + (t >> 6) * 512; const float* pec = (const float*)(ws + OFF_PEC) + (t & 63) * 512;
      float ss = 0.f;
#pragma unroll
      for (int i = 0; i < 4; ++i) { const int col = 4 * lane + 256 * i; v[r][i] = *(const f32x4*)(xr + col);
        if (smp) v[r][i] += (col < 512) ? *(const f32x4*)(per + col) : *(const f32x4*)(pec + col - 512);
        ss += v[r][i][0] * v[r][i][0] + v[r][i][1] * v[r][i][1] + v[r][i][2] * v[r][i][2] + v[r][i][3] * v[r][i][3]; }
      ss = wave_sum(ss); rstd[r] = rsqrtf(ss * (1.0f / 1024.0f) + 1e-6f); }
    const float* n1w = p.in[9];
    float ga[32];
#pragma unroll
    for (int g = 0; g < 32; ++g) ga[g] = 0.f;
#pragma unroll
    for (int i = 0; i < 4; ++i) { const int col = 4 * lane + 256 * i;
      const f32x4 w = *(const f32x4*)(n1w + col), sc = *(const f32x4*)(md + 1024 + col), sh = *(const f32x4*)(md + col);
      const f32x4 ws1 = w * (sc + 1.0f);
      f32x4 h[2];
#pragma unroll
      for (int r = 0; r < 2; ++r) { h[r] = v[r][i] * rstd[r] * ws1 + sh;
        u32x2 o; o.x = pack2(h[r][0], h[r][1]); o.y = pack2(h[r][2], h[r][3]); *(u32x2*)((bf16_t*)(ws + OFF_HN) + (size_t)(row0 + r) * 1024 + col) = o; }
#pragma unroll
      for (int g = 0; g < 16; ++g) { const f32x4 wv = *(const LAS f32x4*)(wg + g * 1024 + col);
#pragma unroll
        for (int r = 0; r < 2; ++r) ga[r * 16 + g] += h[r][0] * wv[0] + h[r][1] * wv[1] + h[r][2] * wv[2] + h[r][3] * wv[3]; }
      asm volatile("" ::: "memory"); }
#pragma unroll
    for (int off = 16; off >= 1; off >>= 1) { const bool hi = (lane & off) != 0;
#pragma unroll
      for (int i = 0; i < off; ++i) { const float send = hi ? ga[i] : ga[i + off]; const float keep = hi ? ga[i + off] : ga[i]; ga[i] = keep + __shfl_xor(send, off); } }
    const float tot = ga[0] + __shfl_xor(ga[0], 32);
    if (lane < 32) ((float*)(ws + OFF_GT))[(size_t)row0 * 16 + lane] = tot + p.in[11][4096 + (lane & 15)];
  }
  __syncthreads();
}
__device__ void filters_upper_half(const Params& p, LP lds) {
  unsigned char* ws = p.ws; const int nh = (int)gridDim.x >> 1;
  if ((int)blockIdx.x < nh) return;
  LAS float* w3s = (LAS float*)lds;
  for (int v = (int)blockIdx.x - nh; v < 320; v += (int)gridDim.x - nh) {
    const int tid = opaque_tid();
    const bool smp = v < 256; const int L = smp ? 2048 : 256; const int tt = smp ? (v >> 6) : 0, cgp = v & 63; const int t = tt * 512 + tid;
    { const f32x4 x = *(const f32x4*)(p.in[20] + (size_t)(tid >> 3) * 2048 + cgp * 32 + 4 * (tid & 7)); LAS float* wp = w3s + (4 * (tid & 7)) * 64 + (tid >> 3);
      wp[0] = x[0]; wp[64] = x[1]; wp[128] = x[2]; wp[192] = x[3]; }
    __syncthreads();
    if (t < L) {
      const float* H2 = (const float*)(ws + (smp ? OFF_H2S : OFF_H2C)) + (size_t)t * 64;
      f32x4 h2[16];
#pragma unroll
      for (int i = 0; i < 16; ++i) h2[i] = *(const f32x4*)(H2 + 4 * i);
      const float dist = fabsf((float)t - (float)(L / 2)) / (float)(L / 2);
      float* HF = (float*)(ws + (smp ? OFF_HFS : OFF_HFC)) + (size_t)(cgp * 32) * L + t;
#pragma unroll 1
      for (int j = 0; j < 32; ++j) {
        f32x4 a = {0.f, 0.f, 0.f, 0.f};
#pragma unroll
        for (int i = 0; i < 16; ++i) a += *(const LAS f32x4*)(w3s + j * 64 + 4 * i) * h2[i];
        const int c = (cgp * 32 + j) & 1023;
        const float dmin = -3.0701134573253946f, dmax = -15.350567286626973f;
        const float delta = fabsf(dmin + (dmax - dmin) * ((float)c / 1023.0f));
        HF[(size_t)j * L] = ((a[0] + a[1]) + (a[2] + a[3])) * __expf(-dist * delta); }
    }
    __syncthreads();
  }
}
__device__ void c1_upper_half(const Params& p, LP lds) {
  unsigned char* ws = p.ws; const float* mod = (const float*)(ws + OFF_MOD); const int nh = (int)gridDim.x >> 1;
  if ((int)blockIdx.x < nh) return;
  for (int u = (int)blockIdx.x - nh; u < 128; u += (int)gridDim.x - nh)
    matvec9_unit<0>(mod + 3072, mod + 6144 + 3072, 6144, p.in[27], 4096, p.in[28], (float*)(ws + OFF_C1), 4096, u * 32, (LAS float*)lds);
}

__device__ __forceinline__ bf16x8 tr_frag(LP base, int k0, int m0, int pitch  , int l15, int g) {
  const int q = l15 >> 2, pp = l15 & 3;
  LP a = base + ((k0 + 8 * g + q) * pitch + m0 + 4 * pp) * 2;
  const s16x4 lo = __builtin_amdgcn_ds_read_tr16_b64_v4i16((LAS s16x4*)a);
  const s16x4 hi = __builtin_amdgcn_ds_read_tr16_b64_v4i16((LAS s16x4*)(a + 8 * pitch));
  bf16x8 r; r[0] = lo[0]; r[1] = lo[1]; r[2] = lo[2]; r[3] = lo[3]; r[4] = hi[0]; r[5] = hi[1]; r[6] = hi[2]; r[7] = hi[3]; return r;
}
__device__ __forceinline__ bf16x8 tr_at(LP lanebase, int coff  , int pitch_bytes) {
  const s16x4 lo = __builtin_amdgcn_ds_read_tr16_b64_v4i16((LAS s16x4*)(lanebase + coff));
  const s16x4 hi = __builtin_amdgcn_ds_read_tr16_b64_v4i16((LAS s16x4*)(lanebase + coff + 4 * pitch_bytes));
  bf16x8 r; r[0] = lo[0]; r[1] = lo[1]; r[2] = lo[2]; r[3] = lo[3]; r[4] = hi[0]; r[5] = hi[1]; r[6] = hi[2]; r[7] = hi[3]; return r;
}
constexpr int ML_K = 0, ML_V = 67584, ML_P = 86016, ML_C = 120832, ML_T = 157696, ML_TSZ = 1600;
constexpr int KP = 264, VP = 72, PP = 136, CP = 72;

__device__ void mlstm_item(const Params& p, LP lds, int item) {
  const int tid = opaque_tid(), wid = __builtin_amdgcn_readfirstlane(tid >> 6), lane = tid & 63, l15 = lane & 15, g = lane >> 4;
  const bool smp = item < 256; const int uu = smp ? (item >> 2) : ((item - 256) >> 2); const int sl = item & 3;
  const int b = uu >> 3, dir = (uu >> 2) & 1, head = uu & 3;
  const int S = smp ? SEQS : SEQC, nc = S >> 7; const int tok0 = smp ? NCTX + b * SEQS : b * SEQC;
  const bf16_t* qkv = (const bf16_t*)(p.ws + OFF_BIG);
  const float* GT = (const float*)(p.ws + OFF_GT);
  bf16_t* hout = (bf16_t*)((unsigned char*)p.out + (dir ? OUT_HB : OUT_H));
  const int sidx = (b * 2 + dir) * 4 + head;
  const int gi_col = dir * 8 + head, gf_col = dir * 8 + 4 + head;
  f32x4 Cacc[2][4], nacc[2]; float mst0;
  if (smp) {
    const float* C0 = p.in[2] + (size_t)sidx * 65536;
#pragma unroll
    for (int dt = 0; dt < 2; ++dt) {
#pragma unroll
      for (int vt = 0; vt < 4; ++vt) Cacc[dt][vt] = *(const f32x4*)(C0 + (size_t)((2 * wid + dt) * 16 + l15) * 256 + sl * 64 + 16 * vt + 4 * g);
      nacc[dt] = (f32x4){p.in[3][sidx * 256 + (2 * wid + dt) * 16 + l15], 0.f, 0.f, 0.f}; }
    mst0 = p.in[4][sidx];
  } else {
#pragma unroll
    for (int dt = 0; dt < 2; ++dt) {
#pragma unroll
      for (int vt = 0; vt < 4; ++vt) Cacc[dt][vt] = (f32x4){0.f, 0.f, 0.f, 0.f};
      nacc[dt] = (f32x4){0.f, 0.f, 0.f, 0.f}; }
    mst0 = 0.f;
  }
#define TOKC(cc, j) (dir ? (tok0 + S - 1 - ((cc) * 128 + (j))) : (tok0 + (cc) * 128 + (j)))
  const int rt = (wid < 4) ? wid : 11 - wid;
  const int jrow = 16 * rt + l15;
  bf16x8 qf[8]; u32x4 kreg[8], vreg[2]; float g4[4] = {0.f, 0.f, 0.f, 0.f};
#define ML_LOAD_Q(cc) do { const bf16_t* qp = qkv + (size_t)TOKC(cc, jrow) * 3072 + head * 256 + 8 * g; \
    _Pragma("unroll") for (int kk = 0; kk < 8; ++kk) qf[kk] = *(const bf16x8*)(qp + 32 * kk); } while (0)
#define ML_LOAD_KV(cc) do { \
    _Pragma("unroll") for (int i = 0; i < 8; ++i) { const int row = (tid >> 5) + 16 * i; kreg[i] = *(const u32x4*)(qkv + (size_t)TOKC(cc, row) * 3072 + 1024 + head * 256 + (tid & 31) * 8); } \
    _Pragma("unroll") for (int i = 0; i < 2; ++i) { const int row = (tid >> 3) + 64 * i; vreg[i] = *(const u32x4*)(qkv + (size_t)TOKC(cc, row) * 3072 + 2048 + head * 256 + sl * 64 + (tid & 7) * 8); } \
    if (wid == 0) { const float* g0 = GT + (size_t)TOKC(cc, 2 * lane) * 16; const float* g1 = GT + (size_t)TOKC(cc, 2 * lane + 1) * 16; g4[0] = g0[gi_col]; g4[1] = g0[gf_col]; g4[2] = g1[gi_col]; g4[3] = g1[gf_col]; } } while (0)
#define ML_SCAN(tabp, mcur, mnext) do { LAS float* T_ = (LAS float*)(tabp); \
    const float lf0 = fminf(g4[1], 0.f) - log1pf(__expf(-fabsf(g4[1]))), lf1 = fminf(g4[3], 0.f) - log1pf(__expf(-fabsf(g4[3]))); \
    float s_ = lf0 + lf1; \
    _Pragma("unroll") for (int o = 1; o < 64; o <<= 1) { const float t_ = __shfl_up(s_, o); if (lane >= o) s_ += t_; } \
    const float b1_ = s_, b0_ = s_ - lf1; const float u0_ = g4[0] - b0_, u1_ = g4[2] - b1_; \
    float mx_ = fmaxf(u0_, u1_); \
    _Pragma("unroll") for (int o = 1; o < 64; o <<= 1) { const float t_ = __shfl_up(mx_, o); if (lane >= o) mx_ = fmaxf(mx_, t_); } \
    float ex_ = __shfl_up(mx_, 1); if (lane == 0) ex_ = -INFINITY; \
    const float M0_ = fmaxf(mcur, fmaxf(ex_, u0_)), M1_ = fmaxf(mcur, mx_); \
    T_[2 * lane] = u0_; T_[2 * lane + 1] = u1_; T_[128 + 2 * lane] = M0_; T_[128 + 2 * lane + 1] = M1_; T_[256 + 2 * lane] = b0_; T_[256 + 2 * lane + 1] = b1_; \
    const float Ml_ = __shfl(M1_, 63), bl_ = __shfl(b1_, 63); \
    if (lane == 0) { T_[384] = mcur; T_[385] = Ml_; } \
    mnext = bl_ + Ml_; } while (0)
  float mw0 = mst0;
  ML_LOAD_Q(0); ML_LOAD_KV(0);
  if (wid == 0) { float mn; ML_SCAN(lds + ML_T, mw0, mn); mw0 = mn; }
  __syncthreads();
  float m_final = 0.f;
  for (int c = 0; c < nc; ++c) {
    LAS float* T = (LAS float*)(lds + ML_T + (c & 1) * ML_TSZ);
    const float mst = T[384], M_last = T[385];
#pragma unroll
    for (int i = 0; i < 8; ++i) { const int row = (tid >> 5) + 16 * i; *(LAS u32x4*)(lds + ML_K + (row * KP + (tid & 31) * 8) * 2) = kreg[i]; }
#pragma unroll
    for (int i = 0; i < 2; ++i) { const int row = (tid >> 3) + 64 * i; const float w = __expf(T[row] - M_last); const u32x4 v = vreg[i]; u32x4 o;
      o.x = pack2(bflo(v.x) * w, bfhi(v.x) * w); o.y = pack2(bflo(v.y) * w, bfhi(v.y) * w); o.z = pack2(bflo(v.z) * w, bfhi(v.z) * w); o.w = pack2(bflo(v.w) * w, bfhi(v.w) * w);
      *(LAS u32x4*)(lds + ML_V + (row * VP + (tid & 7) * 8) * 2) = o; }
    if (tid < 128) *(LAS unsigned short*)(lds + ML_V + (tid * VP + 64) * 2) = f2bf(__expf(T[tid] - M_last));
#pragma unroll
    for (int dt = 0; dt < 2; ++dt) {
#pragma unroll
      for (int vt = 0; vt < 4; ++vt) { u32x2 w; w.x = pack2(Cacc[dt][vt][0], Cacc[dt][vt][1]); w.y = pack2(Cacc[dt][vt][2], Cacc[dt][vt][3]);
        *(LAS u32x2*)(lds + ML_C + (((2 * wid + dt) * 16 + l15) * CP + 16 * vt + 4 * g) * 2) = w; }
      if (g == 0) *(LAS unsigned short*)(lds + ML_C + (((2 * wid + dt) * 16 + l15) * CP + 64) * 2) = f2bf(nacc[dt][0]); }
    const int qtok = TOKC(c, jrow);
    const bool more = (c + 1 < nc);
    __syncthreads();
    const float Mj = T[128 + jrow], bj = T[256 + jrow]; const float rf = __expf(M_last - Mj), w_inter = __expf(mst - Mj);
    int lq_ = (8 * g + (l15 >> 2)), lp_ = 4 * (l15 & 3); asm volatile("" : "+v"(lq_), "+v"(lp_));
    const LP cB = lds + ML_C + (lq_ * CP + lp_) * 2, vB = lds + ML_V + (lq_ * VP + lp_) * 2, kB = lds + ML_K + (lq_ * KP + lp_ + 32 * wid) * 2;
    const LP pB = lds + ML_P + (jrow * PP + 8 * g) * 2;
    for (int st = 0; st <= rt; ++st) {
      f32x4 s = {0.f, 0.f, 0.f, 0.f};
      bf16x8 kfr[8];
#pragma unroll
      for (int kk = 0; kk < 8; ++kk) kfr[kk] = *(const LAS bf16x8*)(lds + ML_K + ((16 * st + l15) * KP + 32 * kk + 8 * g) * 2);
      __builtin_amdgcn_sched_barrier(0);
#pragma unroll
      for (int kk = 0; kk < 8; ++kk) s = __builtin_amdgcn_mfma_f32_16x16x32_bf16(kfr[kk], qf[kk], s, 0, 0, 0);
      float pv[4];
#pragma unroll
      for (int i = 0; i < 4; ++i) pv[i] = ((16 * st + 4 * g + i) <= jrow) ? s[i] * rf : 0.f;
      u32x2 w; w.x = pack2(pv[0], pv[1]); w.y = pack2(pv[2], pv[3]);
      *(LAS u32x2*)(lds + ML_P + (jrow * PP + 16 * st + 4 * g) * 2) = w;
    }
    if ((rt & 1) == 0) { u32x2 z; z.x = 0u; z.y = 0u; *(LAS u32x2*)(lds + ML_P + (jrow * PP + 16 * (rt + 1) + 4 * g) * 2) = z; }
    if (more) ML_LOAD_KV(c + 1);
    asm volatile("s_waitcnt lgkmcnt(0)" ::: "memory");
    f32x4 ha[5];
#pragma unroll
    for (int vt = 0; vt < 5; ++vt) { f32x4 a = {0.f, 0.f, 0.f, 0.f};
      if (smp || c > 0) {
        bf16x8 cfr[8];
#pragma unroll
        for (int kk = 0; kk < 8; ++kk) cfr[kk] = tr_at(cB, (32 * kk * CP + 16 * vt) * 2, CP * 2);
        __builtin_amdgcn_sched_barrier(0);
#pragma unroll
        for (int kk = 0; kk < 8; ++kk) a = __builtin_amdgcn_mfma_f32_16x16x32_bf16(cfr[kk], qf[kk], a, 0, 0, 0);
        a *= w_inter; }
      ha[vt] = a; }
    for (int k2 = 0; k2 <= (rt >> 1); ++k2) {
      const bf16x8 pf = *(const LAS bf16x8*)(pB + k2 * 64);
      bf16x8 vfr[5];
#pragma unroll
      for (int vt = 0; vt < 5; ++vt) vfr[vt] = tr_at(vB + k2 * (32 * VP * 2), (16 * vt) * 2, VP * 2);
      __builtin_amdgcn_sched_barrier(0);
#pragma unroll
      for (int vt = 0; vt < 5; ++vt) ha[vt] = __builtin_amdgcn_mfma_f32_16x16x32_bf16(vfr[vt], pf, ha[vt], 0, 0, 0); }
    { const float den = __shfl(ha[4][0], l15); const float rdd = 1.0f / fmaxf(fabsf(den), __expf(-(bj + Mj)));
#pragma unroll
      for (int vt = 0; vt < 4; ++vt) { const f32x4 a = ha[vt] * rdd; u32x2 w; w.x = pack2(a[0], a[1]); w.y = pack2(a[2], a[3]);
        *(u32x2*)(hout + (size_t)qtok * 1024 + head * 256 + sl * 64 + 16 * vt + 4 * g) = w; } }
    if (more) ML_LOAD_Q(c + 1);
    const bool need_state = (!smp) || more;
    if (need_state) {
      const float decay = __expf(mst - M_last);
#pragma unroll
      for (int dt = 0; dt < 2; ++dt) {
#pragma unroll
        for (int vt = 0; vt < 4; ++vt) Cacc[dt][vt] *= decay;
        nacc[dt] *= decay; }
#pragma unroll
      for (int ks = 0; ks < 4; ++ks) {
        const bf16x8 kf0 = tr_at(kB, (32 * ks * KP) * 2, KP * 2), kf1 = tr_at(kB, (32 * ks * KP + 16) * 2, KP * 2);
        bf16x8 vfr[5];
#pragma unroll
        for (int vt = 0; vt < 5; ++vt) vfr[vt] = tr_at(vB, (32 * ks * VP + 16 * vt) * 2, VP * 2);
        __builtin_amdgcn_sched_barrier(0);
#pragma unroll
        for (int vt = 0; vt < 4; ++vt) { Cacc[0][vt] = __builtin_amdgcn_mfma_f32_16x16x32_bf16(vfr[vt], kf0, Cacc[0][vt], 0, 0, 0); Cacc[1][vt] = __builtin_amdgcn_mfma_f32_16x16x32_bf16(vfr[vt], kf1, Cacc[1][vt], 0, 0, 0); }
        nacc[0] = __builtin_amdgcn_mfma_f32_16x16x32_bf16(vfr[4], kf0, nacc[0], 0, 0, 0); nacc[1] = __builtin_amdgcn_mfma_f32_16x16x32_bf16(vfr[4], kf1, nacc[1], 0, 0, 0);
      }
    }
    if (wid == 0 && more) { float mn; ML_SCAN(lds + ML_T + ((c + 1) & 1) * ML_TSZ, mw0, mn); mw0 = mn; }
    m_final = T[256 + 127] + M_last;
    __syncthreads();
  }
#undef ML_LOAD_Q
#undef ML_LOAD_KV
#undef ML_SCAN
#undef TOKC
  if (!smp) {
    float* oC = p.out + OUTF_C + (size_t)sidx * 65536;
#pragma unroll
    for (int dt = 0; dt < 2; ++dt) {
#pragma unroll
      for (int vt = 0; vt < 4; ++vt) *(f32x4*)(oC + (size_t)((2 * wid + dt) * 16 + l15) * 256 + sl * 64 + 16 * vt + 4 * g) = Cacc[dt][vt];
      if (sl == 0 && g == 0) p.out[OUTF_N + (size_t)sidx * 256 + (2 * wid + dt) * 16 + l15] = nacc[dt][0]; }
    if (sl == 0 && tid == 0) p.out[OUTF_M + sidx] = m_final;
  }
}

__device__ void combine_rows(const Params& p) {
  const int tid0 = opaque_tid(); const int wid = tid0 >> 6, lane = tid0 & 63;
  bf16_t* H = (bf16_t*)((unsigned char*)p.out + OUT_H); const bf16_t* HB = (const bf16_t*)((unsigned char*)p.out + OUT_HB); const float* nw = p.in[22];
  f32x4 wv[4];
#pragma unroll
  for (int i = 0; i < 4; ++i) wv[i] = *(const f32x4*)(nw + 16 * lane + 4 * i);
  const int nh = (int)gridDim.x >> 1;
  if ((int)blockIdx.x < nh) return;
  for (int unit = (int)blockIdx.x - nh; unit < 768; unit += (int)gridDim.x - nh) {
    const int row0 = unit * 32 + wid * 4;
    u32x4 a[4][2], bq[4][2];
#pragma unroll
    for (int r = 0; r < 4; ++r)
#pragma unroll
      for (int i = 0; i < 2; ++i) { a[r][i] = *(const u32x4*)(H + (size_t)(row0 + r) * 1024 + 16 * lane + 8 * i); bq[r][i] = *(const u32x4*)(HB + (size_t)(row0 + r) * 1024 + 16 * lane + 8 * i); }
#pragma unroll
    for (int r = 0; r < 4; ++r) {
      f32x4 v[4]; float ss = 0.f;
#pragma unroll
      for (int i = 0; i < 2; ++i) { f32x4 x0, x1, y0, y1; unpack8(a[r][i], x0, x1); unpack8(bq[r][i], y0, y1); v[2 * i] = x0 + y0; v[2 * i + 1] = x1 + y1; }
#pragma unroll
      for (int i = 0; i < 4; ++i) ss += v[i][0] * v[i][0] + v[i][1] * v[i][1] + v[i][2] * v[i][2] + v[i][3] * v[i][3];
      ss += __shfl_xor(ss, 1); ss += __shfl_xor(ss, 2); ss += __shfl_xor(ss, 4); ss += __shfl_xor(ss, 8);
      const float rr = rsqrtf(ss * (1.0f / 256.0f) + 1e-6f);
#pragma unroll
      for (int i = 0; i < 2; ++i) *(u32x4*)(H + (size_t)(row0 + r) * 1024 + 16 * lane + 8 * i) = pack8(v[2 * i] * rr * wv[2 * i], v[2 * i + 1] * rr * wv[2 * i + 1]);
    }
  }
}

constexpr int HY_WAVE = 18816, HY_HR = 0, HY_ZA = 8576, HY_ZB = 8576 + 5120;
__device__ void hyena_item(const Params& p, LP lds, int item) {
  const int tid = opaque_tid(), wid = __builtin_amdgcn_readfirstlane(tid >> 6), lane = tid & 63, n31 = lane & 31, hh = lane >> 5;
  const bool smp = item < 1024; const int it = smp ? item : item - 1024; const int bset = it >> 7, cgp = it & 127; const int c = cgp * 8 + wid;
  const int L = smp ? 2048 : 256, lgL = smp ? 11 : 8, nblk = L >> 5, lgnb = lgL - 5, ntok = smp ? 2048 : 1024, ntile = smp ? 2 : 1, dmax = L >> 6;
  const int tok0 = smp ? NCTX + bset * 2048 : bset * 1024;
  LP wl = lds + wid * HY_WAVE; LAS float* hr = (LAS float*)(wl + HY_HR);
  const float* HFp = (const float*)(p.ws + (smp ? OFF_HFS : OFF_HFC));
  const bf16_t* UT = (const bf16_t*)(p.ws + OFF_BIG);
  const float* cw = p.in[12]; const float* cbv = p.in[13]; const float* skp = p.in[21];
  { const int uc = 2048 + c; const float w0 = cw[uc], w1 = cw[3072 + uc], w2 = cw[6144 + uc], cb = cbv[uc]; const bf16_t* src = UT + (size_t)uc * NTOK + tok0;
    u32x4 vv[4]; float pvv[4], nxv[4];
#pragma unroll
    for (int i = 0; i < 4; ++i) { const int base = lane * 8 + 512 * i; vv[i] = (u32x4){0u, 0u, 0u, 0u}; pvv[i] = 0.f; nxv[i] = 0.f;
      if (base < ntok) { vv[i] = *(const u32x4*)(src + base); const int tl = base & (L - 1);
        if (tl != 0) pvv[i] = bf2f(src[base - 1]); if (tl + 8 != L) nxv[i] = bf2f(src[base + 8]); } }
#pragma unroll
    for (int i = 0; i < 4; ++i) { const int base = lane * 8 + 512 * i;
      if (base < ntok) { const u32x4 v = vv[i];
        float u[10]; u[0] = pvv[i]; u[1] = bflo(v.x); u[2] = bfhi(v.x); u[3] = bflo(v.y); u[4] = bfhi(v.y); u[5] = bflo(v.z); u[6] = bfhi(v.z); u[7] = bflo(v.w); u[8] = bfhi(v.w); u[9] = nxv[i];
        float o[8];
#pragma unroll
        for (int e = 0; e < 8; ++e) o[e] = cb + w0 * u[e] + w1 * u[e + 1] + w2 * u[e + 2];
        u32x4 w; w.x = pack2(o[0], o[1]); w.y = pack2(o[2], o[3]); w.z = pack2(o[4], o[5]); w.w = pack2(o[6], o[7]);
        *(LAS u32x4*)(wl + HY_ZA + ((base >> 5) * 40 + (base & 31)) * 2) = w; } } }
  const int HRP = L + 96;
  f32x4 fvN[8];
#define HY_FLOAD(o) do { const float* src_ = HFp + (size_t)((o) * 1024 + c) * L; \
    _Pragma("unroll") for (int i = 0; i < 8; ++i) { const int q = lane + 64 * i; fvN[i] = (4 * q < L) ? *(const f32x4*)(src_ + 4 * q) : (f32x4){0.f, 0.f, 0.f, 0.f}; } } while (0)
  HY_FLOAD(0);
  for (int ord = 0; ord < 2; ++ord) {
    { float sa = 0.f;
      f32x4 fv[8];
#pragma unroll
      for (int i = 0; i < 8; ++i) fv[i] = fvN[i];
#pragma unroll
      for (int i = 0; i < 8; ++i) sa += (fabsf(fv[i][0]) + fabsf(fv[i][1])) + (fabsf(fv[i][2]) + fabsf(fv[i][3]));
      sa = wave_sum(sa); const float inv = 1.0f / (sa + 1e-6f);
      asm volatile("s_waitcnt lgkmcnt(0)" ::: "memory");
      LAS bf16_t* E = (LAS bf16_t*)hr; LAS bf16_t* O = E + HRP;
#pragma unroll
      for (int i = 0; i < 8; ++i) { const int q = lane + 64 * i;
        if (4 * q < L) {
#pragma unroll
          for (int e = 0; e < 4; ++e) { const int yy = L - 1 - (4 * q + e); const bf16_t v = f2bf(fv[i][e] * inv); E[32 + yy] = v; O[31 + yy] = v; } } }
      if (lane < 32) { E[lane] = 0; E[32 + L + lane] = 0; O[31 + L + lane] = 0; if (lane < 31) O[lane] = 0; }
      if (lane < 33) O[HRP - 33 + lane] = 0;
      asm volatile("s_waitcnt lgkmcnt(0)" ::: "memory"); }
    if (ord == 0) HY_FLOAD(1);
    LP zin = wl + (ord == 0 ? HY_ZA : HY_ZB); LP zout = wl + (ord == 0 ? HY_ZB : HY_ZA);
    const int gc = ord * 1024 + c; const float w0 = cw[gc], w1 = cw[3072 + gc], w2 = cw[6144 + gc], cb = cbv[gc], sk = skp[ord * 1024 + c];
    const bf16_t* gsrc = UT + (size_t)gc * NTOK + tok0;
    u32x4 gv[4]; unsigned gpv[4], gnx[4];
#pragma unroll
    for (int i = 0; i < 4; ++i) { const int base = lane * 8 + 512 * i; gv[i] = (u32x4){0u, 0u, 0u, 0u}; gpv[i] = 0u; gnx[i] = 0u;
      if (base < ntok) { gv[i] = *(const u32x4*)(gsrc + base); const int tl = base & (L - 1);
        if (tl != 0) gpv[i] = gsrc[base - 1]; if (tl + 8 != L) gnx[i] = gsrc[base + 8]; } }
    f32x16 accs[2];
#pragma unroll
    for (int o2 = 0; o2 < 2; ++o2)
#pragma unroll
      for (int r = 0; r < 16; ++r) accs[o2][r] = 0.f;
    LP fb = wl + HY_HR + ((n31 & 1) ? 0 : (HRP * 2 - 2)) + 2 * ((L >> 1) - 1 - n31 + 8 * hh + 32);
    int cbl[2], ca[2];
#pragma unroll
    for (int ot = 0; ot < 2; ++ot) { const int col = 32 * ot + n31; cbl[ot] = (col >> lgnb) << lgnb; ca[ot] = col & (nblk - 1); }
    const bool two = (ntile == 2);
    {
      LP zero = wl + HY_HR + 16 * hh;
      LP ap = fb + 64 * dmax;
      int bbr0 = ca[0] + dmax, bbr1 = ca[1] + dmax;
      LP bp0 = zin + ((cbl[0] + bbr0) * 40 + 8 * hh) * 2, bp1 = zin + ((cbl[1] + bbr1) * 40 + 8 * hh) * 2;
      for (int d = -dmax; d <= dmax; ++d) {
        u32x4 w0v, w1v;
        w0v.x = *(const LAS unsigned*)(ap); w0v.y = *(const LAS unsigned*)(ap + 4); w0v.z = *(const LAS unsigned*)(ap + 8); w0v.w = *(const LAS unsigned*)(ap + 12);
        w1v.x = *(const LAS unsigned*)(ap + 32); w1v.y = *(const LAS unsigned*)(ap + 36); w1v.z = *(const LAS unsigned*)(ap + 40); w1v.w = *(const LAS unsigned*)(ap + 44);
        const bf16x8 af0 = __builtin_bit_cast(bf16x8, w0v), af1 = __builtin_bit_cast(bf16x8, w1v);
        LP q0 = ((unsigned)bbr0 < (unsigned)nblk) ? bp0 : zero;
        LP q1 = (two && ((unsigned)bbr1 < (unsigned)nblk)) ? bp1 : zero;
        const bf16x8 b00 = *(const LAS bf16x8*)q0, b01 = *(const LAS bf16x8*)(q0 + 32);
        const bf16x8 b10 = *(const LAS bf16x8*)q1, b11 = *(const LAS bf16x8*)(q1 + 32);
        __builtin_amdgcn_sched_barrier(0);
        accs[0] = __builtin_amdgcn_mfma_f32_32x32x16_bf16(af0, b00, accs[0], 0, 0, 0);
        if (two) accs[1] = __builtin_amdgcn_mfma_f32_32x32x16_bf16(af0, b10, accs[1], 0, 0, 0);
        accs[0] = __builtin_amdgcn_mfma_f32_32x32x16_bf16(af1, b01, accs[0], 0, 0, 0);
        if (two) accs[1] = __builtin_amdgcn_mfma_f32_32x32x16_bf16(af1, b11, accs[1], 0, 0, 0);
        ap -= 64; bbr0 -= 1; bbr1 -= 1; bp0 -= 80; bp1 -= 80;
      }
    }
#pragma unroll
    for (int ot = 0; ot < 2; ++ot) {
      if (ot >= ntile) continue;
      const f32x16 acc = accs[ot];
#pragma unroll
      for (int rg = 0; rg < 4; ++rg) {
        const int zo = (((cbl[ot] + ca[ot]) * 40) + 8 * rg + 4 * hh) * 2;
        const u32x2 zv = *(const LAS u32x2*)(zin + zo);
        u32x2 w; w.x = pack2(acc[4 * rg] + sk * bflo(zv.x), acc[4 * rg + 1] + sk * bfhi(zv.x)); w.y = pack2(acc[4 * rg + 2] + sk * bflo(zv.y), acc[4 * rg + 3] + sk * bfhi(zv.y));
        *(LAS u32x2*)(zout + zo) = w;
      }
    }
    asm volatile("s_waitcnt lgkmcnt(0)" ::: "memory");
#pragma unroll
    for (int i = 0; i < 4; ++i) { const int base = lane * 8 + 512 * i;
      if (base < ntok) { const u32x4 v = gv[i];
        float u[10]; u[0] = bf2f(gpv[i]); u[1] = bflo(v.x); u[2] = bfhi(v.x); u[3] = bflo(v.y); u[4] = bfhi(v.y); u[5] = bflo(v.z); u[6] = bfhi(v.z); u[7] = bflo(v.w); u[8] = bfhi(v.w); u[9] = bf2f(gnx[i]);
        LP zp = zout + ((base >> 5) * 40 + (base & 31)) * 2; const u32x4 t = *(const LAS u32x4*)zp;
        float tv[8]; tv[0] = bflo(t.x); tv[1] = bfhi(t.x); tv[2] = bflo(t.y); tv[3] = bfhi(t.y); tv[4] = bflo(t.z); tv[5] = bfhi(t.z); tv[6] = bflo(t.w); tv[7] = bfhi(t.w);
        float o[8];
#pragma unroll
        for (int e = 0; e < 8; ++e) o[e] = (cb + w0 * u[e] + w1 * u[e + 1] + w2 * u[e + 2]) * tv[e];
        u32x4 w; w.x = pack2(o[0], o[1]); w.y = pack2(o[2], o[3]); w.z = pack2(o[4], o[5]); w.w = pack2(o[6], o[7]);
        *(LAS u32x4*)zp = w; } }
    asm volatile("s_waitcnt lgkmcnt(0)" ::: "memory");
  }
  __syncthreads();
  { bf16_t* YH = (bf16_t*)((unsigned char*)p.out + OUT_HB);
    for (int tl = tid; tl < ntok; tl += 512) {
      const int bl = tl >> lgL, tloc = tl & (L - 1); const int zo = ((((bl << lgnb) + (tloc >> 5)) * 40) + (tloc & 31)) * 2;
      unsigned short e[8];
#pragma unroll
      for (int w = 0; w < 8; ++w) e[w] = *(const LAS unsigned short*)(lds + w * HY_WAVE + HY_ZA + zo);
      u32x4 o; o.x = e[0] | ((unsigned)e[1] << 16); o.y = e[2] | ((unsigned)e[3] << 16); o.z = e[4] | ((unsigned)e[5] << 16); o.w = e[6] | ((unsigned)e[7] << 16);
      *(u32x4*)(YH + (size_t)(tok0 + tl) * 1024 + cgp * 8) = o; } }
  __syncthreads();
}

__device__ void final_norm(const Params& p) {
  const int tid0 = opaque_tid(); const int wid = tid0 >> 6, lane = tid0 & 63; const float* fw = p.in[31];
  const float* P = (const float*)(p.ws + OFF_BIG + (size_t)8192 * 4096 * 2); const float* mod = (const float*)(p.ws + OFF_MOD);
  f32x4 wv[4];
#pragma unroll
  for (int i = 0; i < 4; ++i) wv[i] = *(const f32x4*)(fw + 4 * lane + 256 * i);
  for (int unit = blockIdx.x; unit < 768; unit += gridDim.x) {
    const int row0 = unit * 32 + wid * 4; const bool chunkB = row0 >= 16384;
    f32x4 x[4][4];
#pragma unroll
    for (int r = 0; r < 4; ++r)
#pragma unroll
      for (int i = 0; i < 4; ++i) x[r][i] = *(const f32x4*)(p.out + (size_t)(row0 + r) * 1024 + 4 * lane + 256 * i);
    if (chunkB) { const float* md = mod + cond_of_row(row0) * 6144 + 5120;
#pragma unroll
      for (int i = 0; i < 4; ++i) { const f32x4 g2 = *(const f32x4*)(md + 4 * lane + 256 * i);
#pragma unroll
        for (int r = 0; r < 4; ++r) x[r][i] += g2 * *(const f32x4*)(P + (size_t)(row0 + r - 16384) * 1024 + 4 * lane + 256 * i); } }
#pragma unroll
    for (int r = 0; r < 4; ++r) { float ss = 0.f;
#pragma unroll
      for (int i = 0; i < 4; ++i) ss += x[r][i][0] * x[r][i][0] + x[r][i][1] * x[r][i][1] + x[r][i][2] * x[r][i][2] + x[r][i][3] * x[r][i][3];
      ss = wave_sum(ss); const float rstd = rsqrtf(ss * (1.0f / 1024.0f) + 1e-6f);
#pragma unroll
      for (int i = 0; i < 4; ++i) *(f32x4*)(p.out + (size_t)(row0 + r) * 1024 + 4 * lane + 256 * i) = x[r][i] * rstd * wv[i]; }
  }
}

__global__ void __launch_bounds__(512, 2) __attribute__((flatten)) mega(Params p) {
  extern __shared__ __attribute__((aligned(16))) unsigned char shm[];
  LP lds = (LP)shm;
  cg::grid_group grid = cg::this_grid();
  volatile LAS unsigned* xst = (volatile LAS unsigned*)(lds + LDS_BYTES - 16);
  if (threadIdx.x == 0) { xst[0] = 0u; xst[1] = 0u; }
  __syncthreads();
  const XcdBarrier xb = xcd_barrier_post((unsigned*)(p.ws + OFF_BAR), xst);
  unsigned char* ws = p.ws;
  const bf16_t* WT = (const bf16_t*)(ws + OFF_WT); const bf16_t* HN = (const bf16_t*)(ws + OFF_HN); bf16_t* BIG = (bf16_t*)(ws + OFF_BIG);
  bf16_t* Hb = (bf16_t*)((unsigned char*)p.out + OUT_H); bf16_t* YH = (bf16_t*)((unsigned char*)p.out + OUT_HB);
  const float* mod = (const float*)(ws + OFF_MOD);
  phase0(p, lds);
  if (gridDim.y == 7u) grid.sync();
  xcd_barrier(xb);
  phase1(p, lds);
  weight_tiles(p, lds);
  xcd_barrier(xb);
  filters_upper_half(p, lds);
  { EpiQKV e; e.O = BIG; e.bias = p.in[11]; run_gemm(lds, HN, WT, NTOK, 3072, 1024, e); }
  xcd_barrier(xb);
  for (int item = blockIdx.x; item < 1280; item += gridDim.x) mlstm_item(p, lds, item);
  xcd_barrier(xb);
  combine_rows(p);
  { EpiUT e; e.O = BIG; e.bias = p.in[11] + 4112; run_gemm(lds, WT + (size_t)3072 * 1024, HN, 3072, NTOK, 1024, e); }
  xcd_barrier(xb);
  for (int item = blockIdx.x; item < 2048; item += gridDim.x) hyena_item(p, lds, item);
  xcd_barrier(xb);
  c1_upper_half(p, lds);
  { EpiGates e; e.H = Hb; e.G = BIG; e.b_in = p.in[11]; run_gemm(lds, HN, WT + (size_t)6144 * 1024, NTOK, 3072, 1024, e); }
  xcd_barrier(xb);
  bf16_t* T = BIG + (size_t)NTOK * 2048;
  { EpiMerge<0> e; e.T = T; e.G = BIG; run_gemm(lds, Hb, (const bf16_t*)(ws + OFF_WBM), NTOK, 1024, 1024, e); }
  { EpiMerge<1> e; e.T = T; e.G = BIG; run_gemm(lds, YH, (const bf16_t*)(ws + OFF_WBH), NTOK, 1024, 1024, e); }
  xcd_barrier(xb);
  { EpiOut e; e.xp = p.in[0]; e.xs = p.in[1]; e.per = (const float*)(ws + OFF_PER); e.pec = (const float*)(ws + OFF_PEC); e.mod = mod; e.n2w = p.in[26];
    e.X1 = p.out; e.A2 = (bf16_t*)(ws + OFF_HN); e.ssq = (float*)(ws + OFF_SSQ1); run_gemm(lds, T, (const bf16_t*)(ws + OFF_WOUT), NTOK, 1024, 1024, e); }
  xcd_barrier(xb);
  constexpr int ROWS_A = 16384, ROWS_B = NTOK - ROWS_A;
  { EpiFF1 e; e.row0 = 0; e.ssq = (const float*)(p.ws + OFF_SSQ1); e.c1 = (const float*)(p.ws + OFF_C1); e.Hd = (bf16_t*)(p.ws + OFF_BIG);
    run_gemm(lds, (const bf16_t*)(p.ws + OFF_HN), (const bf16_t*)(p.ws + OFF_W1T), ROWS_A, 4096, 1024, e); }
  xcd_barrier(xb);
  { EpiFF2 e; e.row0 = 0; e.mod = (const float*)(p.ws + OFF_MOD); e.b2 = p.in[30]; e.X = p.out; e.P = (float*)(p.ws + OFF_BIG + (size_t)ROWS_A * 4096 * 2);
    run_gemm(lds, (const bf16_t*)(p.ws + OFF_BIG), (const bf16_t*)(p.ws + OFF_W2T), ROWS_A, 1024, 4096, e); }
  xcd_barrier(xb);
  { EpiFF1 e; e.row0 = ROWS_A; e.ssq = (const float*)(p.ws + OFF_SSQ1); e.c1 = (const float*)(p.ws + OFF_C1); e.Hd = (bf16_t*)(p.ws + OFF_BIG);
    run_gemm(lds, (const bf16_t*)(p.ws + OFF_HN) + (size_t)ROWS_A * 1024, (const bf16_t*)(p.ws + OFF_W1T), ROWS_B, 4096, 1024, e); }
  xcd_barrier(xb);
  { EpiFF2 e; e.row0 = ROWS_A; e.mod = (const float*)(p.ws + OFF_MOD); e.b2 = p.in[30]; e.X = p.out; e.P = (float*)(p.ws + OFF_BIG + (size_t)ROWS_B * 4096 * 2);
    run_gemm(lds, (const bf16_t*)(p.ws + OFF_BIG), (const bf16_t*)(p.ws + OFF_W2T), ROWS_B, 1024, 4096, e, 2); }
  xcd_barrier(xb);
  final_norm(p);
}

extern "C" void kernel_launch(void* const* d_in, const int* in_sizes, int n_in, void* d_out, int out_size, void* d_ws, size_t ws_size, hipStream_t stream) {
  static int grid_blocks = 0;
  if (!grid_blocks) {
    int dev = 0, cus = 0, per_cu = 0;
    hipGetDevice(&dev);
    hipDeviceGetAttribute(&cus, hipDeviceAttributeMultiprocessorCount, dev);
    hipFuncSetAttribute((const void*)mega, hipFuncAttributeMaxDynamicSharedMemorySize, LDS_BYTES);
    hipOccupancyMaxActiveBlocksPerMultiprocessor(&per_cu, (const void*)mega, 512, LDS_BYTES);
    if (per_cu < 1) { fprintf(stderr, "kernel_launch: occupancy query reports %d blocks per CU\n", per_cu); grid_blocks = -1; }
    else grid_blocks = cus;
    if (n_in != 32 || ws_size < WS_END) { fprintf(stderr, "kernel_launch: unexpected n_in %d / ws_size %zu (need %zu)\n", n_in, ws_size, (size_t)WS_END); grid_blocks = -1; }
  }
  if (grid_blocks < 0) return;
  hipMemsetAsync((unsigned char*)d_ws + OFF_BAR, 0, 3456 * 4, stream);
  Params p{};
  for (int i = 0; i < 32; ++i) p.in[i] = (const float*)d_in[i];
  p.out = (float*)d_out; p.ws = (unsigned char*)d_ws;
  void* args[] = {&p};
  hipError_t e = hipLaunchCooperativeKernel((void*)mega, dim3(grid_blocks), dim3(512), args, LDS_BYTES, stream);
  if (e != hipSuccess) fprintf(stderr, "cooperative launch failed: %s (grid %d)\n", hipGetErrorString(e), grid_blocks);
}
```

```cpp
#include <hip/hip_runtime.h>
#include <hip/hip_cooperative_groups.h>
#include <cstdio>
#include <cstdint>
namespace cg = cooperative_groups;

#define LAS __attribute__((address_space(3)))
typedef LAS unsigned char* LP;
typedef unsigned short bf16_t;
typedef short bf16x8 __attribute__((ext_vector_type(8)));
typedef short s16x4 __attribute__((ext_vector_type(4)));
typedef float f32x4 __attribute__((ext_vector_type(4)));
typedef float f32x16 __attribute__((ext_vector_type(16)));
typedef unsigned u32x4 __attribute__((ext_vector_type(4)));
typedef unsigned u32x2 __attribute__((ext_vector_type(2)));

constexpr int DM = 1024, NTOK = 24576, NCTX = 8192, SEQC = 256, SEQS = 2048, INC = 9232;
constexpr int LDS_BYTES = 160 * 1024;
constexpr size_t OFF_WT = 0;
constexpr size_t OFF_WBM = 18874368, OFF_WBH = 20971520, OFF_WOUT = 23068672, OFF_W1T = 25165824, OFF_W2T = 33554432;
constexpr size_t OFF_HN = 41943040;
constexpr size_t OFF_BIG = 92274688;
constexpr size_t OFF_SM = 243269632;
constexpr size_t OFF_MOD = OFF_SM;
constexpr size_t OFF_C1 = OFF_MOD + 221184;
constexpr size_t OFF_H2S = OFF_C1 + 147456;
constexpr size_t OFF_H2C = OFF_H2S + 524288;
constexpr size_t OFF_PER = OFF_H2C + 65536;
constexpr size_t OFF_PEC = OFF_PER + 65536;
constexpr size_t OFF_GT = OFF_PEC + 131072;
constexpr size_t OFF_SSQ1 = OFF_GT + 1572864;
constexpr size_t OFF_SSQ2 = OFF_SSQ1 + 1572864;
constexpr size_t OFF_HFS = OFF_SSQ2 + 1572864;
constexpr size_t OFF_HFC = OFF_HFS + 16777216;
constexpr size_t OFF_BAR = OFF_HFC + 2097152;
constexpr size_t WS_END = OFF_BAR + 3456 * 4;
constexpr size_t OUT_H = 0, OUT_HB = 50331648;
constexpr size_t OUTF_C = 25165824, OUTF_N = 41943040, OUTF_M = 42008576;

struct Params { const float* in[32]; float* out; unsigned char* ws; };

__device__ __forceinline__ bf16_t f2bf(float f) { unsigned u = __float_as_uint(f); u += 0x7FFFu + ((u >> 16) & 1u); return (bf16_t)(u >> 16); }
__device__ __forceinline__ float bf2f(unsigned b) { return __uint_as_float(b << 16); }
__device__ __forceinline__ unsigned pack2(float lo, float hi) { return (unsigned)f2bf(lo) | ((unsigned)f2bf(hi) << 16); }
__device__ __forceinline__ float bflo(unsigned w) { return __uint_as_float(w << 16); }
__device__ __forceinline__ float bfhi(unsigned w) { return __uint_as_float(w & 0xffff0000u); }
__device__ __forceinline__ float sigmoidf_(float x) { return 1.0f / (1.0f + __expf(-x)); }
__device__ __forceinline__ int opaque_tid() { int t = threadIdx.x; asm volatile("" : "+v"(t)); return t; }
__device__ __forceinline__ float wave_sum(float v) {
#pragma unroll
  for (int o = 32; o >= 1; o >>= 1) v += __shfl_xor(v, o);
  return v;
}


#define XB_TMO      128
#define XB_XCNT(j)  (256  + 64 * (j))
#define XB_XSUB(j)  (1280 + 64 * (j))
#define XB_XGEN(j)  (2304 + 64 * (j))
#define XB_TOP      3328
#define XB_TOPGEN   3392
#define XCD_BAR_WORDS 3456
#define XB_SPIN_CAP (1u << 18)
__device__ __forceinline__ unsigned xb_ld(unsigned* p)              { return __hip_atomic_load(p, __ATOMIC_RELAXED, __HIP_MEMORY_SCOPE_AGENT); }
__device__ __forceinline__ unsigned xb_add(unsigned* p, unsigned v) { return __hip_atomic_fetch_add(p, v, __ATOMIC_RELAXED, __HIP_MEMORY_SCOPE_AGENT); }
__device__ __forceinline__ unsigned xb_xcc_id() { return (unsigned)__builtin_amdgcn_s_getreg((3 << 11) | 20) & 0xFu; }
#define XB_SPIN(cond, bar) do { unsigned _sp = 0; while (cond) { __builtin_amdgcn_s_sleep(1); \
    if ((++_sp & 255u) == 0u) { if (xb_ld(&(bar)[XB_TMO])) break; if (_sp > XB_SPIN_CAP) { atomicAdd(&(bar)[XB_TMO], 1u); break; } } } } while (0)
struct XcdBarrier { unsigned* bar; unsigned x; volatile LAS unsigned* st; };
__device__ __forceinline__ XcdBarrier xcd_barrier_post(unsigned* bar, volatile LAS unsigned* st) {
  XcdBarrier b; b.bar = bar; b.x = xb_xcc_id(); b.st = st;
  if (threadIdx.x == 0) (void)xb_add(&bar[XB_XCNT(b.x)], 1u);
  return b;
}
__device__ __forceinline__ void xcd_barrier_complete(unsigned* bar, unsigned x, unsigned& nloc, unsigned& nx) {
  const unsigned G = gridDim.x * gridDim.y * gridDim.z;
  unsigned sum, cnt, mine, sp = 0u;
  for (;;) {
    sum = 0u; cnt = 0u; mine = 0u;
#pragma unroll
    for (unsigned j = 0; j < 16; ++j) { const unsigned c = xb_ld(&bar[XB_XCNT(j)]); sum += c; cnt += (c > 0u) ? 1u : 0u; mine = (j == x) ? c : mine; }
    if (sum == G) break;
    __builtin_amdgcn_s_sleep(1);
    if ((++sp & 255u) == 0u) { if (xb_ld(&bar[XB_TMO])) break; if (sp > XB_SPIN_CAP) { atomicAdd(&bar[XB_TMO], 1u); break; } }
  }
  nloc = mine > 0u ? mine : 1u; nx = cnt > 0u ? cnt : 1u;
}
__device__ __forceinline__ void xcd_barrier(const XcdBarrier& b) {
  asm volatile("s_waitcnt vmcnt(0)" ::: "memory");
  __syncthreads();
  if (threadIdx.x == 0) {
    unsigned* bar = b.bar;
    __builtin_amdgcn_s_waitcnt(0);
    unsigned nloc = b.st[0], nx = b.st[1];
    if (nloc == 0u) { xcd_barrier_complete(bar, b.x, nloc, nx); b.st[0] = nloc; b.st[1] = nx; }
    const unsigned old = xb_add(&bar[XB_XSUB(b.x)], 1u);
    const unsigned gen = old / nloc;
    if (old + 1u == (gen + 1u) * nloc) {
      __builtin_amdgcn_fence(__ATOMIC_RELEASE, "agent");
      asm volatile("s_waitcnt vmcnt(0)" ::: "memory");
      const unsigned og = xb_add(&bar[XB_TOP], 1u);
      const unsigned tg = og / nx;
      if (og + 1u == (tg + 1u) * nx) xb_add(&bar[XB_TOPGEN], 1u);
      else XB_SPIN(xb_ld(&bar[XB_TOPGEN]) == tg, bar);
      __builtin_amdgcn_fence(__ATOMIC_ACQUIRE, "agent");
      xb_add(&bar[XB_XGEN(b.x)], 1u);
      asm volatile("s_waitcnt vmcnt(0)" ::: "memory");
    } else {
      XB_SPIN(xb_ld(&bar[XB_XGEN(b.x)]) == gen, bar);
      __builtin_amdgcn_fence(__ATOMIC_ACQUIRE, "agent");
      asm volatile("s_waitcnt vmcnt(0)" ::: "memory");
    }
  }
  __syncthreads();
}

namespace pg8 {
constexpr int BM = 256, BK = 64, HALF = 128, HTB = HALF * BK * 2, STAGE_BYTES = 8 * HTB, NXCD = 8, WGM = 8;
__host__ __device__ __forceinline__ int lds_byte(int r, int c) { const int st = (r >> 4) * 2 + (c >> 5), rr = r & 15, cc = c & 31, ob = rr * 64 + cc * 2; return st * 1024 + (ob ^ (((ob >> 9) & 1) << 5)); }
__host__ __device__ __forceinline__ void stage_rc(int b, int& R, int& C) { const int st = b / 1024, sb = b % 1024, swz = sb ^ (((sb >> 9) & 1) << 5); R = (st >> 1) * 16 + swz / 64; C = (st & 1) * 32 + (swz % 64) / 2; }
__host__ __device__ __forceinline__ int perm32(int rho) { const int n = rho >> 4, i = rho & 15; return 8 * (i >> 2) + 4 * n + (i & 3); }
struct Unit { int pm, pn, ks; };
struct Gemm { const bf16_t* A; const bf16_t* Bt; int M, N, K, ld, nks; };
struct StaticOrder {
  int nM, nN, ntile, nwg, G, c;
  __device__ void init(int M, int N, int nks, int G_, int c_) { nM = M / BM; nN = N / BM; ntile = nM * nN; nwg = ntile * nks; G = G_; c = c_; }
  __device__ bool next(int i, Unit& u) const {
    const long L = (long)i * G + c; if (L >= nwg) return false;
    u.ks = (int)L / ntile; int wgid = (int)L - u.ks * ntile;
    { const int q = ntile / NXCD, r = ntile % NXCD, xcd = wgid % NXCD, off = wgid / NXCD; wgid = (xcd < r ? xcd * (q + 1) : r * (q + 1) + (xcd - r) * q) + off; }
    const int nig = WGM * nN, gid = wgid / nig, fm = gid * WGM, gsz = (nM - fm) < WGM ? (nM - fm) : WGM;
    u.pm = fm + ((wgid % nig) % gsz); u.pn = (wgid % nig) / gsz; return true;
  }
};

template <class Epi>
__device__ __forceinline__ void gemm_phase(LP lds, const Gemm g, const StaticOrder& S, const Epi& E) {
  int tid_ = threadIdx.x; asm volatile("" : "+v"(tid_));
  const int tid = tid_, wid = __builtin_amdgcn_readfirstlane(tid >> 6), lane = tid & 63, wr = wid >> 2, wc = wid & 3, fr = lane & 15, fq = lane >> 4;
  const int K = g.ld, nt = g.K / BK;
  const size_t ksb = (size_t)g.K * 2;
  unsigned voffA[2], voffB[2];
#pragma unroll
  for (int i = 0; i < 2; ++i) { int R, C; stage_rc(tid * 16 + i * 8192, R, C); const int Rb = (R & ~31) + perm32(R & 31); voffA[i] = (unsigned)(R * K + C) * 2u; voffB[i] = (unsigned)(Rb * K + C) * 2u; }
  const size_t kstep = (size_t)(BK * 2);
  const size_t hstep = (size_t)HALF * K * 2;
  const size_t tstep = 2 * hstep;
  const unsigned ldsw = (unsigned)wid * 1024u;
  const int aoff = lds_byte(wr * 64 + fr, fq * 8), boff = lds_byte(wc * 32 + fr, fq * 8);
#define PG8_SA(b, h) (((b) * 2 + (h)) * HTB)
#define PG8_SB(b, h) ((4 + (b) * 2 + (h)) * HTB)
#define PG8_STAGE(bufoff, gbase, voff) do { _Pragma("unroll") for (int _i = 0; _i < 2; ++_i) \
    __builtin_amdgcn_global_load_lds((const unsigned*)((const char*)(gbase) + (voff)[_i]), (LAS unsigned*)(lds + (bufoff) + ldsw + _i * 8192), 16, 0, 0); } while (0)
#define PG8_LDA(dst, b, h) do { _Pragma("unroll") for (int m = 0; m < 4; ++m) _Pragma("unroll") for (int k = 0; k < 2; ++k) dst[m][k] = *(const LAS bf16x8*)(lds + PG8_SA(b, h) + aoff + m * 2048 + k * 1024); } while (0)
#define PG8_LDB(dst, b, h) do { _Pragma("unroll") for (int n = 0; n < 2; ++n) _Pragma("unroll") for (int k = 0; k < 2; ++k) dst[n][k] = *(const LAS bf16x8*)(lds + PG8_SB(b, h) + boff + n * 2048 + k * 1024); } while (0)
#define PG8_MMA(ai, bj, At, Bt) do { __builtin_amdgcn_s_setprio(1); _Pragma("unroll") for (int m = 0; m < 4; ++m) _Pragma("unroll") for (int n = 0; n < 2; ++n) _Pragma("unroll") for (int k = 0; k < 2; ++k) \
    acc[ai][bj][m][n] = __builtin_amdgcn_mfma_f32_16x16x32_bf16(Bt[n][k], At[m][k], acc[ai][bj][m][n], 0, 0, 0); __builtin_amdgcn_s_setprio(0); } while (0)
#define PG8_WAIT_V(n) asm volatile("s_waitcnt vmcnt(" #n ")" ::: "memory")
#define PG8_WAIT_L(n) asm volatile("s_waitcnt lgkmcnt(" #n ")" ::: "memory")
#define PG8_BAR __builtin_amdgcn_s_barrier()
#define PG8_SCHED __builtin_amdgcn_sched_barrier(0)
  Unit cur, nxt; int ui = 0;
  if (!S.next(0, cur)) return;
  f32x4 acc[2][2][4][2];
#pragma unroll
  for (int a = 0; a < 2; ++a)
#pragma unroll
    for (int b = 0; b < 2; ++b)
#pragma unroll
      for (int m = 0; m < 4; ++m)
#pragma unroll
        for (int n = 0; n < 2; ++n) acc[a][b][m][n] = (f32x4){0.f, 0.f, 0.f, 0.f};
  bf16x8 At[4][2], B0[2][2], B1[2][2];
  const char* cA = (const char*)g.A + (size_t)cur.pm * tstep + cur.ks * ksb; const char* cB = (const char*)g.Bt + (size_t)cur.pn * tstep + cur.ks * ksb;
  PG8_STAGE(PG8_SB(0, 0), cB, voffB); PG8_STAGE(PG8_SA(0, 0), cA, voffA); PG8_STAGE(PG8_SB(0, 1), cB + hstep, voffB); PG8_STAGE(PG8_SA(0, 1), cA + hstep, voffA);
  if (wr == 1) PG8_BAR;
  PG8_WAIT_V(4); PG8_BAR;
  PG8_STAGE(PG8_SB(1, 0), cB + kstep, voffB); PG8_STAGE(PG8_SA(1, 0), cA + kstep, voffA); PG8_STAGE(PG8_SB(1, 1), cB + hstep + kstep, voffB);
  PG8_WAIT_V(6); PG8_BAR;
  for (;;) {
    const bool has_next = S.next(ui + 1, nxt);
    const char* nA = has_next ? (const char*)g.A + (size_t)nxt.pm * tstep + nxt.ks * ksb : cA; const char* nB = has_next ? (const char*)g.Bt + (size_t)nxt.pn * tstep + nxt.ks * ksb : cB;
    for (int t = 0; t < nt; t += 2) {
      const bool last = (t == nt - 2);
      const char* a1 = cA + (size_t)(t + 1) * kstep;
      const char* a2 = last ? nA : cA + (size_t)(t + 2) * kstep; const char* b2 = last ? nB : cB + (size_t)(t + 2) * kstep;
      const char* a3 = a2 + kstep; const char* b3 = b2 + kstep;
      PG8_LDB(B0, 0, 0); PG8_SCHED; PG8_LDA(At, 0, 0); PG8_STAGE(PG8_SA(1, 1), a1 + hstep, voffA);
      PG8_WAIT_L(8); PG8_BAR; PG8_WAIT_L(0); PG8_MMA(0, 0, At, B0); PG8_BAR; PG8_SCHED;
      PG8_LDB(B1, 0, 1); PG8_STAGE(PG8_SB(0, 0), b2, voffB);
      PG8_BAR; PG8_WAIT_L(0); PG8_MMA(0, 1, At, B1); PG8_BAR;
      PG8_LDA(At, 0, 1); PG8_STAGE(PG8_SA(0, 0), a2, voffA);
      PG8_BAR; PG8_WAIT_L(0); PG8_MMA(1, 0, At, B0); PG8_BAR; PG8_SCHED;
      PG8_STAGE(PG8_SB(0, 1), b2 + hstep, voffB);
      PG8_WAIT_V(6); PG8_BAR; PG8_MMA(1, 1, At, B1); PG8_BAR;
      PG8_LDB(B0, 1, 0); PG8_SCHED; PG8_LDA(At, 1, 0); PG8_STAGE(PG8_SA(0, 1), a2 + hstep, voffA);
      PG8_WAIT_L(8); PG8_BAR; PG8_WAIT_L(0); PG8_MMA(0, 0, At, B0); PG8_BAR; PG8_SCHED;
      PG8_LDB(B1, 1, 1); PG8_STAGE(PG8_SB(1, 0), b3, voffB);
      PG8_BAR; PG8_WAIT_L(0); PG8_MMA(0, 1, At, B1); PG8_BAR;
      PG8_LDA(At, 1, 1); PG8_STAGE(PG8_SA(1, 0), a3, voffA);
      PG8_BAR; PG8_WAIT_L(0); PG8_MMA(1, 0, At, B0); PG8_BAR; PG8_SCHED;
      PG8_STAGE(PG8_SB(1, 1), b3 + hstep, voffB);
      PG8_WAIT_V(6); PG8_BAR; PG8_MMA(1, 1, At, B1); PG8_BAR;
    }
    { int fr2 = fr, fq2 = fq; asm volatile("" : "+v"(fr2), "+v"(fq2)); E(acc, cur, wr, wc, fr2, fq2); }
    if (!has_next) break;
#pragma unroll
    for (int a = 0; a < 2; ++a)
#pragma unroll
      for (int b = 0; b < 2; ++b)
#pragma unroll
        for (int m = 0; m < 4; ++m)
#pragma unroll
          for (int n = 0; n < 2; ++n) acc[a][b][m][n] = (f32x4){0.f, 0.f, 0.f, 0.f};
    cur = nxt; cA = nA; cB = nB; ++ui;
  }
  PG8_WAIT_V(0);
  if (wr == 0) PG8_BAR;
  PG8_BAR;
#undef PG8_SA
#undef PG8_SB
#undef PG8_STAGE
#undef PG8_LDA
#undef PG8_LDB
#undef PG8_MMA
#undef PG8_WAIT_V
#undef PG8_WAIT_L
#undef PG8_BAR
#undef PG8_SCHED
}
}
using pg8::Unit;
typedef f32x4 AccT[2][2][4][2];

#define EPI_ROW(ai, m) (u.pm * 256 + (ai) * 128 + wr * 64 + (m) * 16 + fr)
#define EPI_COL(bj, n) (u.pn * 256 + (bj) * 128 + wc * 32 + 8 * fq + 4 * (n))
#define EPI_LOOP_ROWS _Pragma("unroll") for (int ai = 0; ai < 2; ++ai) _Pragma("unroll") for (int m = 0; m < 4; ++m)
#define EPI_LOOP_COLS _Pragma("unroll") for (int bj = 0; bj < 2; ++bj) _Pragma("unroll") for (int n = 0; n < 2; ++n)

__device__ __forceinline__ int cond_of_row(int row) { return row < NCTX ? 0 : 1 + ((row - NCTX) >> 11); }

#define EPI_LOOP_BJ _Pragma("unroll") for (int bj = 0; bj < 2; ++bj)
__device__ __forceinline__ u32x4 pack8(const f32x4 v0, const f32x4 v1) { u32x4 w; w.x = pack2(v0[0], v0[1]); w.y = pack2(v0[2], v0[3]); w.z = pack2(v1[0], v1[1]); w.w = pack2(v1[2], v1[3]); return w; }
__device__ __forceinline__ void unpack8(const u32x4 w, f32x4& v0, f32x4& v1) { v0[0] = bflo(w.x); v0[1] = bfhi(w.x); v0[2] = bflo(w.y); v0[3] = bfhi(w.y); v1[0] = bflo(w.z); v1[1] = bfhi(w.z); v1[2] = bflo(w.w); v1[3] = bfhi(w.w); }
struct EpiQKV {
  bf16_t* O; const float* bias;
  __device__ __forceinline__ void operator()(const AccT& acc, const Unit& u, int wr, int wc, int fr, int fq) const {
    const float sc = (u.pn < 4) ? 0.0625f : 1.0f;
    f32x4 bv[2][2];
    EPI_LOOP_COLS { bv[bj][n] = *(const f32x4*)(bias + EPI_COL(bj, n)); }
    EPI_LOOP_ROWS { const int row = EPI_ROW(ai, m);
      EPI_LOOP_BJ { *(u32x4*)(O + (size_t)row * 3072 + EPI_COL(bj, 0)) = pack8((acc[ai][bj][m][0] + bv[bj][0]) * sc, (acc[ai][bj][m][1] + bv[bj][1]) * sc); } }
  }
};
struct EpiUT {
  bf16_t* O; const float* bias;
  __device__ __forceinline__ void operator()(const AccT& acc, const Unit& u, int wr, int wc, int fr, int fq) const {
    EPI_LOOP_ROWS { const int row = EPI_ROW(ai, m); const float bv = bias[row];
      EPI_LOOP_BJ { *(u32x4*)(O + (size_t)row * NTOK + EPI_COL(bj, 0)) = pack8(acc[ai][bj][m][0] + bv, acc[ai][bj][m][1] + bv); } }
  }
};
struct EpiGates {
  bf16_t* H; bf16_t* G; const float* b_in;
  __device__ __forceinline__ void operator()(const AccT& acc, const Unit& u, int wr, int wc, int fr, int fq) const {
    const bool og = u.pn < 4;
    f32x4 bv[2][2];
    EPI_LOOP_COLS { const int col = EPI_COL(bj, n); bv[bj][n] = *(const f32x4*)(b_in + (og ? 3072 + col : 7184 + (col - 1024))); }
    EPI_LOOP_ROWS { const int row = EPI_ROW(ai, m);
      u32x4 hv[2];
      if (og) { EPI_LOOP_BJ { hv[bj] = *(const u32x4*)(H + (size_t)row * 1024 + EPI_COL(bj, 0)); } }
      EPI_LOOP_BJ { const int col = EPI_COL(bj, 0); f32x4 s0, s1; const f32x4 a0 = acc[ai][bj][m][0] + bv[bj][0], a1 = acc[ai][bj][m][1] + bv[bj][1];
#pragma unroll
        for (int e = 0; e < 4; ++e) { s0[e] = sigmoidf_(a0[e]); s1[e] = sigmoidf_(a1[e]); }
        if (og) { f32x4 h0, h1; unpack8(hv[bj], h0, h1); *(u32x4*)(H + (size_t)row * 1024 + col) = pack8(h0 * s0, h1 * s1); }
        else *(u32x4*)(G + (size_t)row * 2048 + (col - 1024)) = pack8(s0, s1); } }
  }
};
template <int SECOND> struct EpiMerge {
  bf16_t* T; const bf16_t* G;
  __device__ __forceinline__ void operator()(const AccT& acc, const Unit& u, int wr, int wc, int fr, int fq) const {
    EPI_LOOP_ROWS { const int row = EPI_ROW(ai, m);
      u32x4 gv[2], tv[2];
      EPI_LOOP_BJ { const int col = EPI_COL(bj, 0); gv[bj] = *(const u32x4*)(G + (size_t)row * 2048 + SECOND * 1024 + col);
        if (SECOND) tv[bj] = *(const u32x4*)(T + (size_t)row * 1024 + col); }
      EPI_LOOP_BJ { const int col = EPI_COL(bj, 0); f32x4 g0, g1; unpack8(gv[bj], g0, g1);
        f32x4 v0 = g0 * acc[ai][bj][m][0], v1 = g1 * acc[ai][bj][m][1];
        if (SECOND) { f32x4 t0, t1; unpack8(tv[bj], t0, t1); v0 += t0; v1 += t1; }
        *(u32x4*)(T + (size_t)row * 1024 + col) = pack8(v0, v1); } }
  }
};
struct EpiOut {
  const float* xp; const float* xs; const float* per; const float* pec; const float* mod; const float* n2w; float* X1; bf16_t* A2; float* ssq;
  __device__ __forceinline__ void operator()(const AccT& acc, const Unit& u, int wr, int wc, int fr, int fq) const {
    const int cb = cond_of_row(u.pm * 256); const float* md = mod + cb * 6144; const bool smp = (u.pm * 256) >= NCTX;
    f32x4 g1v[2][2], k2v[2][2];
    EPI_LOOP_COLS { const int col = EPI_COL(bj, n); g1v[bj][n] = *(const f32x4*)(md + 2048 + col); k2v[bj][n] = *(const f32x4*)(n2w + col) * (*(const f32x4*)(md + 4096 + col) + 1.0f); }
    EPI_LOOP_ROWS { const int row = EPI_ROW(ai, m); float ss = 0.f;
#pragma unroll
      for (int bj = 0; bj < 2; ++bj) {
        f32x4 x0[2];
        if (!smp) {
#pragma unroll
          for (int n = 0; n < 2; ++n) x0[n] = *(const f32x4*)(xp + (size_t)row * 1024 + EPI_COL(bj, n)); }
        else { const int r2 = row - NCTX, t = r2 & 2047; f32x4 pe[2];
#pragma unroll
          for (int n = 0; n < 2; ++n) { const int col = EPI_COL(bj, n); x0[n] = *(const f32x4*)(xs + (size_t)r2 * 1024 + col);
            pe[n] = (col < 512) ? *(const f32x4*)(per + (t >> 6) * 512 + col) : *(const f32x4*)(pec + (t & 63) * 512 + (col - 512)); }
#pragma unroll
          for (int n = 0; n < 2; ++n) x0[n] += pe[n]; }
        f32x4 x1[2];
#pragma unroll
        for (int n = 0; n < 2; ++n) { x1[n] = x0[n] + g1v[bj][n] * acc[ai][bj][m][n]; *(f32x4*)(X1 + (size_t)row * 1024 + EPI_COL(bj, n)) = x1[n];
          ss += x1[n][0] * x1[n][0] + x1[n][1] * x1[n][1] + x1[n][2] * x1[n][2] + x1[n][3] * x1[n][3]; }
        *(u32x4*)(A2 + (size_t)row * 1024 + EPI_COL(bj, 0)) = pack8(x1[0] * k2v[bj][0], x1[1] * k2v[bj][1]); }
      ss += __shfl_xor(ss, 16); ss += __shfl_xor(ss, 32);
      if (fq == 0) ssq[(size_t)row * 16 + u.pn * 4 + wc] = ss; }
  }
};
struct EpiFF1 {
  int row0; const float* ssq; const float* c1; bf16_t* Hd;
  __device__ __forceinline__ void operator()(const AccT& acc, const Unit& u, int wr, int wc, int fr, int fq) const {
    const int cb = cond_of_row(row0 + u.pm * 256); const float* cc = c1 + cb * 4096;
    f32x4 cv[2][2];
    EPI_LOOP_COLS { cv[bj][n] = *(const f32x4*)(cc + EPI_COL(bj, n)); }
    float rs[2][4];
    EPI_LOOP_ROWS { const float* sp = ssq + (size_t)(row0 + EPI_ROW(ai, m)) * 16;
      const f32x4 st = (*(const f32x4*)sp + *(const f32x4*)(sp + 4)) + (*(const f32x4*)(sp + 8) + *(const f32x4*)(sp + 12));
      rs[ai][m] = rsqrtf((st[0] + st[1] + st[2] + st[3]) * (1.0f / 1024.0f) + 1e-6f); }
    EPI_LOOP_ROWS { const int rl = EPI_ROW(ai, m); const float rstd = rs[ai][m];
      EPI_LOOP_BJ { f32x4 v0 = acc[ai][bj][m][0] * rstd + cv[bj][0], v1 = acc[ai][bj][m][1] * rstd + cv[bj][1];
#pragma unroll
        for (int e = 0; e < 4; ++e) { const float r0 = fmaxf(v0[e], 0.f), r1 = fmaxf(v1[e], 0.f); v0[e] = r0 * r0; v1[e] = r1 * r1; }
        *(u32x4*)(Hd + (size_t)rl * 4096 + EPI_COL(bj, 0)) = pack8(v0, v1); } }
  }
};
struct EpiFF2 {
  int row0; const float* mod; const float* b2; float* X; float* P;
  __device__ __forceinline__ void operator()(const AccT& acc, const Unit& u, int wr, int wc, int fr, int fq) const {
    if (u.ks == 1) {
      EPI_LOOP_ROWS { const int rl = EPI_ROW(ai, m); EPI_LOOP_COLS { *(f32x4*)(P + (size_t)rl * 1024 + EPI_COL(bj, n)) = acc[ai][bj][m][n]; } }
    } else {
    const int cb = cond_of_row(row0 + u.pm * 256); const float* md = mod + cb * 6144;
    f32x4 g2v[2][2], bbv[2][2];
    EPI_LOOP_COLS { const int col = EPI_COL(bj, n); g2v[bj][n] = *(const f32x4*)(md + 5120 + col); bbv[bj][n] = *(const f32x4*)(b2 + col); }
#pragma unroll
    for (int ai = 0; ai < 2; ++ai)
#pragma unroll
      for (int m2 = 0; m2 < 2; ++m2) {
        f32x4 xv[2][2][2];
#pragma unroll
        for (int mm = 0; mm < 2; ++mm) { const int row = row0 + EPI_ROW(ai, 2 * m2 + mm); EPI_LOOP_COLS { xv[mm][bj][n] = *(const f32x4*)(X + (size_t)row * 1024 + EPI_COL(bj, n)); } }
#pragma unroll
        for (int mm = 0; mm < 2; ++mm) { const int m = 2 * m2 + mm; const int row = row0 + EPI_ROW(ai, m);
          EPI_LOOP_COLS { const int col = EPI_COL(bj, n); *(f32x4*)(X + (size_t)row * 1024 + col) = xv[mm][bj][n] + g2v[bj][n] * (acc[ai][bj][m][n] + bbv[bj][n]); } } }
    }
  }
};

template <class Epi> __device__ __forceinline__ void run_gemm(LP lds, const bf16_t* A, const bf16_t* Bt, int M, int N, int K, const Epi& E, int nks = 1) {
  pg8::Gemm g; g.A = A; g.Bt = Bt; g.M = M; g.N = N; g.K = K / nks; g.ld = K; g.nks = nks;
  pg8::StaticOrder S; S.init(M, N, nks, (int)gridDim.x, (int)blockIdx.x);
  pg8::gemm_phase<Epi>(lds, g, S, E);
}

__device__ void transpose_tile(const float* __restrict__ src, int ld, int col0, int k0, bf16_t* __restrict__ dst, int K, int drow0, LAS float* tile) {
  const int t = opaque_tid();
  f32x4 v[4];
#pragma unroll
  for (int i = 0; i < 4; ++i) { const int idx = t + 512 * i, kr = idx >> 5, c4 = idx & 31; v[i] = *(const f32x4*)(src + (size_t)(k0 + kr) * ld + col0 + 4 * c4); }
#pragma unroll
  for (int i = 0; i < 4; ++i) { const int idx = t + 512 * i, kr = idx >> 5, c4 = idx & 31; LAS float* tp = tile + kr * 129 + 4 * c4; tp[0] = v[i][0]; tp[1] = v[i][1]; tp[2] = v[i][2]; tp[3] = v[i][3]; }
  __syncthreads();
  const int kb = t & 7;
#pragma unroll
  for (int i = 0; i < 2; ++i) { const int c = (t >> 3) + 64 * i; const LAS float* tp = tile + (kb * 8) * 129 + c; u32x4 o;
    o.x = pack2(tp[0], tp[129]); o.y = pack2(tp[2 * 129], tp[3 * 129]); o.z = pack2(tp[4 * 129], tp[5 * 129]); o.w = pack2(tp[6 * 129], tp[7 * 129]);
    *(u32x4*)(dst + (size_t)(drow0 + c) * K + k0 + kb * 8) = o; }
  __syncthreads();
}
template <int SILU> __device__ void matvec9_unit(const float* v0, const float* v1, int v1stride, const float* __restrict__ W, int ldw, const float* bias, float* out, int ldo, int col0, LAS float* lf) {
  const int t = opaque_tid(), lane = t & 63, wid = t >> 6;
  LAS float* sv = lf; LAS float* red = lf + 9216;
  for (int i = t; i < 9216; i += 512) { const int b = i >> 10, k = i & 1023; float x = (b == 0) ? v0[k] : v1[(size_t)(b - 1) * v1stride + k]; if (SILU) x = x / (1.0f + __expf(-x)); sv[i] = x; }
  __syncthreads();
  const int c4 = t & 7, kl = t >> 3;
  f32x4 w[16];
#pragma unroll
  for (int i = 0; i < 16; ++i) w[i] = *(const f32x4*)(W + (size_t)(kl + 64 * i) * ldw + col0 + 4 * c4);
  f32x4 acc[9];
#pragma unroll
  for (int b = 0; b < 9; ++b) acc[b] = (f32x4){0.f, 0.f, 0.f, 0.f};
#pragma unroll
  for (int i = 0; i < 16; ++i)
#pragma unroll
    for (int b = 0; b < 9; ++b) acc[b] += w[i] * sv[b * 1024 + kl + 64 * i];
#pragma unroll
  for (int b = 0; b < 9; ++b)
#pragma unroll
    for (int e = 0; e < 4; ++e) { float x = acc[b][e]; x += __shfl_xor(x, 8); x += __shfl_xor(x, 16); x += __shfl_xor(x, 32); acc[b][e] = x; }
  if (lane < 8) {
#pragma unroll
    for (int b = 0; b < 9; ++b) *(LAS f32x4*)(red + (wid * 9 + b) * 32 + 4 * lane) = acc[b]; }
  __syncthreads();
  if (t < 288) { const int b = t >> 5, cc = t & 31; float s = bias[col0 + cc];
#pragma unroll
    for (int pz = 0; pz < 8; ++pz) s += red[(pz * 9 + b) * 32 + cc];
    out[(size_t)b * ldo + col0 + cc] = s; }
  __syncthreads();
}

__device__ void phase0(const Params& p, LP lds) {
  unsigned char* ws = p.ws; LAS float* lf = (LAS float*)lds;
  const int tid0 = opaque_tid(); const int wid = tid0 >> 6, lane = tid0 & 63;
  for (int unit = blockIdx.x; unit < 576; unit += gridDim.x) {
    if (unit < 192) {
      matvec9_unit<1>(p.in[6], p.in[5], 1024, p.in[7], 6144, p.in[8], (float*)(ws + OFF_MOD), 6144, unit * 32, lf);
    } else if (unit < 480) {
      const int row = (unit - 192) * 8 + wid; const bool smp = row < 2048; const int L = smp ? 2048 : 256, t = smp ? row : row - 2048;
      const float* w1 = p.in[14]; const float* b1 = p.in[15]; const float* fr1 = p.in[16]; const float* w2 = p.in[17]; const float* b2 = p.in[18]; const float* fr2 = p.in[19];
      float a = b1[lane] + (float)t / (float)(L - 1) * w1[lane];
      const float base = (6.283185307179586f / (float)L) * (float)t;
      float cs = 0.f, sn = 0.f; if (lane < 16) { const float ang = base * (float)(lane + 1); cs = cosf(ang); sn = sinf(ang); }
#pragma unroll
      for (int i = 0; i < 16; ++i) a += __shfl(cs, i) * w1[(1 + i) * 64 + lane] + __shfl(sn, i) * w1[(17 + i) * 64 + lane];
      const float h1 = sinf(fr1[lane] * a);
      float a2 = b2[lane];
#pragma unroll 16
      for (int j = 0; j < 64; ++j) a2 += __shfl(h1, j) * w2[j * 64 + lane];
      const float h2 = sinf(fr2[lane] * a2);
      float* dst = (float*)(ws + (smp ? OFF_H2S : OFF_H2C)); dst[(size_t)t * 64 + lane] = h2;
    } else {
      const int r = unit - 480, c = tid0; const int pos = r < 32 ? r : r - 32; const int i = c & 255;
      const float omega = 1.0f / powf(10000.0f, (float)i / 256.0f); const float a = (float)pos * omega; const float v = c < 256 ? sinf(a) : cosf(a);
      float* dst = (float*)(ws + (r < 32 ? OFF_PER : OFF_PEC)); dst[(size_t)pos * 512 + c] = v;
    }
  }
}
__device__ void weight_tiles(const Params& p, LP lds, int lo, int hi, int upper) {
  unsigned char* ws = p.ws; LAS float* lf = (LAS float*)lds;
  const int nh = upper ? ((int)gridDim.x >> 1) : 0;
  if ((int)blockIdx.x < nh) return;
  for (int tu = lo + (int)blockIdx.x - nh; tu < hi; tu += (int)gridDim.x - nh) {
    const float* src; int ld, K, col0, k0, drow0; bf16_t* dst;
    if (tu < 1152) { const int nt = tu >> 4, kt = tu & 15; const int r = nt * 128; src = p.in[10]; ld = INC; K = 1024; k0 = kt * 64; drow0 = r; dst = (bf16_t*)(ws + OFF_WT);
      col0 = r < 3072 ? r : (r < 6144 ? 4112 + (r - 3072) : (r < 7168 ? 3072 + (r - 6144) : 7184 + (r - 7168))); }
    else if (tu < 1536) { const int v = tu - 1152, w = v >> 7, q = v & 127; src = p.in[23 + w]; ld = 1024; K = 1024; k0 = (q & 15) * 64; col0 = (q >> 4) * 128; drow0 = col0; dst = (bf16_t*)(ws + (w == 0 ? OFF_WBM : (w == 1 ? OFF_WBH : OFF_WOUT))); }
    else if (tu < 2048) { const int q = tu - 1536; src = p.in[27]; ld = 4096; K = 1024; k0 = (q & 15) * 64; col0 = (q >> 4) * 128; drow0 = col0; dst = (bf16_t*)(ws + OFF_W1T); }
    else { const int q = tu - 2048; src = p.in[29]; ld = 1024; K = 4096; k0 = (q & 63) * 64; col0 = (q >> 6) * 128; drow0 = col0; dst = (bf16_t*)(ws + OFF_W2T); }
    transpose_tile(src, ld, col0, k0, dst, K, drow0, lf);
  }
}

__device__ void phase1(const Params& p, LP lds) {
  unsigned char* ws = p.ws;
  int tid_ = threadIdx.x; asm volatile("" : "+v"(tid_));
  const int tid = tid_, wid = tid >> 6, lane = tid & 63;
  const float* mod = (const float*)(ws + OFF_MOD);
  LAS float* wg = (LAS float*)lds;
  if ((int)blockIdx.x < 1536) {
    f32x4 gw[8];
#pragma unroll
    for (int i = 0; i < 8; ++i) { const int idx = tid + 512 * i, k = idx >> 2, q = idx & 3; gw[i] = *(const f32x4*)(p.in[10] + (size_t)k * INC + 4096 + 4 * q); }
#pragma unroll
    for (int i = 0; i < 8; ++i) { const int idx = tid + 512 * i, k = idx >> 2, q = idx & 3; wg[(4 * q) * 1024 + k] = gw[i][0]; wg[(4 * q + 1) * 1024 + k] = gw[i][1]; wg[(4 * q + 2) * 1024 + k] = gw[i][2]; wg[(4 * q + 3) * 1024 + k] = gw[i][3]; }
    __syncthreads();
  }
  for (int unit = blockIdx.x; unit < 1536; unit += gridDim.x) {
    const int tidn = opaque_tid(); const int wid = tidn >> 6, lane = tidn & 63;
    const int row0 = unit * 16 + wid * 2; const int cb = cond_of_row(row0); const float* md = mod + cb * 6144; const bool smp = row0 >= NCTX;
    f32x4 v[2][4]; float rstd[2];
#pragma unroll
    for (int r = 0; r < 2; ++r) { const int row = row0 + r; const float* xr; int t = 0;
      if (!smp) xr = p.in[0] + (size_t)row * 1024; else { xr = p.in[1] + (size_t)(row - NCTX) * 1024; t = (row - NCTX) & 2047; }
      const float* per = (const float*)(ws + OFF_PER) + (t >> 6) * 512; const float* pec = (const float*)(ws + OFF_PEC) + (t & 63) * 512;
      float ss = 0.f;
#pragma unroll
      for (int i = 0; i < 4; ++i) { const int col = 4 * lane + 256 * i; v[r][i] = *(const f32x4*)(xr + col);
        if (smp) v[r][i] += (col < 512) ? *(const f32x4*)(per + col) : *(const f32x4*)(pec + col - 512);
        ss += v[r][i][0] * v[r][i][0] + v[r][i][1] * v[r][i][1] + v[r][i][2] * v[r][i][2] + v[r][i][3] * v[r][i][3]; }
      ss = wave_sum(ss); rstd[r] = rsqrtf(ss * (1.0f / 1024.0f) + 1e-6f); }
    const float* n1w = p.in[9];
    float ga[32];
#pragma unroll
    for (int g = 0; g < 32; ++g) ga[g] = 0.f;
#pragma unroll
    for (int i = 0; i < 4; ++i) { const int col = 4 * lane + 256 * i;
      const f32x4 w = *(const f32x4*)(n1w + col), sc = *(const f32x4*)(md + 1024 + col), sh = *(const f32x4*)(md + col);
      const f32x4 ws1 = w * (sc + 1.0f);
      f32x4 h[2];
#pragma unroll
      for (int r = 0; r < 2; ++r) { h[r] = v[r][i] * rstd[r] * ws1 + sh;
        u32x2 o; o.x = pack2(h[r][0], h[r][1]); o.y = pack2(h[r][2], h[r][3]); *(u32x2*)((bf16_t*)(ws + OFF_HN) + (size_t)(row0 + r) * 1024 + col) = o; }
#pragma unroll
      for (int g = 0; g < 16; ++g) { const f32x4 wv = *(const LAS f32x4*)(wg + g * 1024 + col);
#pragma unroll
        for (int r = 0; r < 2; ++r) ga[r * 16 + g] += h[r][0] * wv[0] + h[r][1] * wv[1] + h[r][2] * wv[2] + h[r][3] * wv[3]; }
      asm volatile("" ::: "memory"); }
#pragma unroll
    for (int off = 16; off >= 1; off >>= 1) { const bool hi = (lane & off) != 0;
#pragma unroll
      for (int i = 0; i < off; ++i) { const float send = hi ? ga[i] : ga[i + off]; const float keep = hi ? ga[i + off] : ga[i]; ga[i] = keep + __shfl_xor(send, off); } }
    const float tot = ga[0] + __shfl_xor(ga[0], 32);
    if (lane < 32) ((float*)(ws + OFF_GT))[(size_t)row0 * 16 + lane] = tot + p.in[11][4096 + (lane & 15)];
  }
  __syncthreads();
}
__device__ void filters_upper_half(const Params& p, LP lds) {
  unsigned char* ws = p.ws; const int nh = (int)gridDim.x >> 1;
  if ((int)blockIdx.x < nh) return;
  LAS float* w3s = (LAS float*)lds;
  for (int v = (int)blockIdx.x - nh; v < 320; v += (int)gridDim.x - nh) {
    const int tid = opaque_tid();
    const bool smp = v < 256; const int L = smp ? 2048 : 256; const int tt = smp ? (v >> 6) : 0, cgp = v & 63; const int t = tt * 512 + tid;
    { const f32x4 x = *(const f32x4*)(p.in[20] + (size_t)(tid >> 3) * 2048 + cgp * 32 + 4 * (tid & 7)); LAS float* wp = w3s + (4 * (tid & 7)) * 64 + (tid >> 3);
      wp[0] = x[0]; wp[64] = x[1]; wp[128] = x[2]; wp[192] = x[3]; }
    __syncthreads();
    if (t < L) {
      const float* H2 = (const float*)(ws + (smp ? OFF_H2S : OFF_H2C)) + (size_t)t * 64;
      f32x4 h2[16];
#pragma unroll
      for (int i = 0; i < 16; ++i) h2[i] = *(const f32x4*)(H2 + 4 * i);
      const float dist = fabsf((float)t - (float)(L / 2)) / (float)(L / 2);
      float* HF = (float*)(ws + (smp ? OFF_HFS : OFF_HFC)) + (size_t)(cgp * 32) * L + t;
#pragma unroll 1
      for (int j = 0; j < 32; ++j) {
        f32x4 a = {0.f, 0.f, 0.f, 0.f};
#pragma unroll
        for (int i = 0; i < 16; ++i) a += *(const LAS f32x4*)(w3s + j * 64 + 4 * i) * h2[i];
        const int c = (cgp * 32 + j) & 1023;
        const float dmin = -3.0701134573253946f, dmax = -15.350567286626973f;
        const float delta = fabsf(dmin + (dmax - dmin) * ((float)c / 1023.0f));
        HF[(size_t)j * L] = ((a[0] + a[1]) + (a[2] + a[3])) * __expf(-dist * delta); }
    }
    __syncthreads();
  }
}
__device__ void c1_upper_half(const Params& p, LP lds) {
  unsigned char* ws = p.ws; const float* mod = (const float*)(ws + OFF_MOD); const int nh = (int)gridDim.x >> 1;
  if ((int)blockIdx.x < nh) return;
  for (int u = (int)blockIdx.x - nh; u < 128; u += (int)gridDim.x - nh)
    matvec9_unit<0>(mod + 3072, mod + 6144 + 3072, 6144, p.in[27], 4096, p.in[28], (float*)(ws + OFF_C1), 4096, u * 32, (LAS float*)lds);
}

__device__ __forceinline__ bf16x8 tr_frag(LP base, int k0, int m0, int pitch  , int l15, int g) {
  const int q = l15 >> 2, pp = l15 & 3;
  LP a = base + ((k0 + 8 * g + q) * pitch + m0 + 4 * pp) * 2;
  const s16x4 lo = __builtin_amdgcn_ds_read_tr16_b64_v4i16((LAS s16x4*)a);
  const s16x4 hi = __builtin_amdgcn_ds_read_tr16_b64_v4i16((LAS s16x4*)(a + 8 * pitch));
  bf16x8 r; r[0] = lo[0]; r[1] = lo[1]; r[2] = lo[2]; r[3] = lo[3]; r[4] = hi[0]; r[5] = hi[1]; r[6] = hi[2]; r[7] = hi[3]; return r;
}
__device__ __forceinline__ bf16x8 tr_at(LP lanebase, int coff  , int pitch_bytes) {
  const s16x4 lo = __builtin_amdgcn_ds_read_tr16_b64_v4i16((LAS s16x4*)(lanebase + coff));
  const s16x4 hi = __builtin_amdgcn_ds_read_tr16_b64_v4i16((LAS s16x4*)(lanebase + coff + 4 * pitch_bytes));
  bf16x8 r; r[0] = lo[0]; r[1] = lo[1]; r[2] = lo[2]; r[3] = lo[3]; r[4] = hi[0]; r[5] = hi[1]; r[6] = hi[2]; r[7] = hi[3]; return r;
}
constexpr int ML_K = 0, ML_V = 67584, ML_P = 86016, ML_C = 120832, ML_T = 157696, ML_TSZ = 1600;
constexpr int KP = 264, VP = 72, PP = 136, CP = 72;

__device__ void mlstm_item(const Params& p, LP lds, int item) {
  const int tid = opaque_tid(), wid = __builtin_amdgcn_readfirstlane(tid >> 6), lane = tid & 63, l15 = lane & 15, g = lane >> 4;
  const bool smp = item < 256; const int uu = smp ? (item >> 2) : ((item - 256) >> 2); const int sl = item & 3;
  const int b = uu >> 3, dir = (uu >> 2) & 1, head = uu & 3;
  const int S = smp ? SEQS : SEQC, nc = S >> 7; const int tok0 = smp ? NCTX + b * SEQS : b * SEQC;
  const bf16_t* qkv = (const bf16_t*)(p.ws + OFF_BIG);
  const float* GT = (const float*)(p.ws + OFF_GT);
  bf16_t* hout = (bf16_t*)((unsigned char*)p.out + (dir ? OUT_HB : OUT_H));
  const int sidx = (b * 2 + dir) * 4 + head;
  const int gi_col = dir * 8 + head, gf_col = dir * 8 + 4 + head;
  f32x4 Cacc[2][4], nacc[2]; float mst0;
  if (smp) {
    const float* C0 = p.in[2] + (size_t)sidx * 65536;
#pragma unroll
    for (int dt = 0; dt < 2; ++dt) {
#pragma unroll
      for (int vt = 0; vt < 4; ++vt) Cacc[dt][vt] = *(const f32x4*)(C0 + (size_t)((2 * wid + dt) * 16 + l15) * 256 + sl * 64 + 16 * vt + 4 * g);
      nacc[dt] = (f32x4){p.in[3][sidx * 256 + (2 * wid + dt) * 16 + l15], 0.f, 0.f, 0.f}; }
    mst0 = p.in[4][sidx];
  } else {
#pragma unroll
    for (int dt = 0; dt < 2; ++dt) {
#pragma unroll
      for (int vt = 0; vt < 4; ++vt) Cacc[dt][vt] = (f32x4){0.f, 0.f, 0.f, 0.f};
      nacc[dt] = (f32x4){0.f, 0.f, 0.f, 0.f}; }
    mst0 = 0.f;
  }
#define TOKC(cc, j) (dir ? (tok0 + S - 1 - ((cc) * 128 + (j))) : (tok0 + (cc) * 128 + (j)))
  const int rt = (wid < 4) ? wid : 11 - wid;
  const int jrow = 16 * rt + l15;
  bf16x8 qf[8]; u32x4 kreg[8], vreg[2]; float g4[4] = {0.f, 0.f, 0.f, 0.f};
#define ML_LOAD_Q(cc) do { const bf16_t* qp = qkv + (size_t)TOKC(cc, jrow) * 3072 + head * 256 + 8 * g; \
    _Pragma("unroll") for (int kk = 0; kk < 8; ++kk) qf[kk] = *(const bf16x8*)(qp + 32 * kk); } while (0)
#define ML_LOAD_KV(cc) do { \
    _Pragma("unroll") for (int i = 0; i < 8; ++i) { const int row = (tid >> 5) + 16 * i; kreg[i] = *(const u32x4*)(qkv + (size_t)TOKC(cc, row) * 3072 + 1024 + head * 256 + (tid & 31) * 8); } \
    _Pragma("unroll") for (int i = 0; i < 2; ++i) { const int row = (tid >> 3) + 64 * i; vreg[i] = *(const u32x4*)(qkv + (size_t)TOKC(cc, row) * 3072 + 2048 + head * 256 + sl * 64 + (tid & 7) * 8); } \
    if (wid == 0) { const float* g0 = GT + (size_t)TOKC(cc, 2 * lane) * 16; const float* g1 = GT + (size_t)TOKC(cc, 2 * lane + 1) * 16; g4[0] = g0[gi_col]; g4[1] = g0[gf_col]; g4[2] = g1[gi_col]; g4[3] = g1[gf_col]; } } while (0)
#define ML_SCAN(tabp, mcur, mnext) do { LAS float* T_ = (LAS float*)(tabp); \
    const float lf0 = fminf(g4[1], 0.f) - log1pf(__expf(-fabsf(g4[1]))), lf1 = fminf(g4[3], 0.f) - log1pf(__expf(-fabsf(g4[3]))); \
    float s_ = lf0 + lf1; \
    _Pragma("unroll") for (int o = 1; o < 64; o <<= 1) { const float t_ = __shfl_up(s_, o); if (lane >= o) s_ += t_; } \
    const float b1_ = s_, b0_ = s_ - lf1; const float u0_ = g4[0] - b0_, u1_ = g4[2] - b1_; \
    float mx_ = fmaxf(u0_, u1_); \
    _Pragma("unroll") for (int o = 1; o < 64; o <<= 1) { const float t_ = __shfl_up(mx_, o); if (lane >= o) mx_ = fmaxf(mx_, t_); } \
    float ex_ = __shfl_up(mx_, 1); if (lane == 0) ex_ = -INFINITY; \
    const float M0_ = fmaxf(mcur, fmaxf(ex_, u0_)), M1_ = fmaxf(mcur, mx_); \
    T_[2 * lane] = u0_; T_[2 * lane + 1] = u1_; T_[128 + 2 * lane] = M0_; T_[128 + 2 * lane + 1] = M1_; T_[256 + 2 * lane] = b0_; T_[256 + 2 * lane + 1] = b1_; \
    const float Ml_ = __shfl(M1_, 63), bl_ = __shfl(b1_, 63); \
    if (lane == 0) { T_[384] = mcur; T_[385] = Ml_; } \
    mnext = bl_ + Ml_; } while (0)
  float mw0 = mst0;
  ML_LOAD_Q(0); ML_LOAD_KV(0);
  if (wid == 0) { float mn; ML_SCAN(lds + ML_T, mw0, mn); mw0 = mn; }
  __syncthreads();
  float m_final = 0.f;
  for (int c = 0; c < nc; ++c) {
    LAS float* T = (LAS float*)(lds + ML_T + (c & 1) * ML_TSZ);
    const float mst = T[384], M_last = T[385];
#pragma unroll
    for (int i = 0; i < 8; ++i) { const int row = (tid >> 5) + 16 * i; *(LAS u32x4*)(lds + ML_K + (row * KP + (tid & 31) * 8) * 2) = kreg[i]; }
#pragma unroll
    for (int i = 0; i < 2; ++i) { const int row = (tid >> 3) + 64 * i; const float w = __expf(T[row] - M_last); const u32x4 v = vreg[i]; u32x4 o;
      o.x = pack2(bflo(v.x) * w, bfhi(v.x) * w); o.y = pack2(bflo(v.y) * w, bfhi(v.y) * w); o.z = pack2(bflo(v.z) * w, bfhi(v.z) * w); o.w = pack2(bflo(v.w) * w, bfhi(v.w) * w);
      *(LAS u32x4*)(lds + ML_V + (row * VP + (tid & 7) * 8) * 2) = o; }
    if (tid < 128) *(LAS unsigned short*)(lds + ML_V + (tid * VP + 64) * 2) = f2bf(__expf(T[tid] - M_last));
#pragma unroll
    for (int dt = 0; dt < 2; ++dt) {
#pragma unroll
      for (int vt = 0; vt < 4; ++vt) { u32x2 w; w.x = pack2(Cacc[dt][vt][0], Cacc[dt][vt][1]); w.y = pack2(Cacc[dt][vt][2], Cacc[dt][vt][3]);
        *(LAS u32x2*)(lds + ML_C + (((2 * wid + dt) * 16 + l15) * CP + 16 * vt + 4 * g) * 2) = w; }
      if (g == 0) *(LAS unsigned short*)(lds + ML_C + (((2 * wid + dt) * 16 + l15) * CP + 64) * 2) = f2bf(nacc[dt][0]); }
    const int qtok = TOKC(c, jrow);
    const bool more = (c + 1 < nc);
    __syncthreads();
    const float Mj = T[128 + jrow], bj = T[256 + jrow]; const float rf = __expf(M_last - Mj), w_inter = __expf(mst - Mj);
    int lq_ = (8 * g + (l15 >> 2)), lp_ = 4 * (l15 & 3); asm volatile("" : "+v"(lq_), "+v"(lp_));
    const LP cB = lds + ML_C + (lq_ * CP + lp_) * 2, vB = lds + ML_V + (lq_ * VP + lp_) * 2, kB = lds + ML_K + (lq_ * KP + lp_ + 32 * wid) * 2;
    const LP pB = lds + ML_P + (jrow * PP + 8 * g) * 2;
    for (int st = 0; st <= rt; ++st) {
      f32x4 s = {0.f, 0.f, 0.f, 0.f};
      bf16x8 kfr[8];
#pragma unroll
      for (int kk = 0; kk < 8; ++kk) kfr[kk] = *(const LAS bf16x8*)(lds + ML_K + ((16 * st + l15) * KP + 32 * kk + 8 * g) * 2);
      __builtin_amdgcn_sched_barrier(0);
#pragma unroll
      for (int kk = 0; kk < 8; ++kk) s = __builtin_amdgcn_mfma_f32_16x16x32_bf16(kfr[kk], qf[kk], s, 0, 0, 0);
      float pv[4];
#pragma unroll
      for (int i = 0; i < 4; ++i) pv[i] = ((16 * st + 4 * g + i) <= jrow) ? s[i] * rf : 0.f;
      u32x2 w; w.x = pack2(pv[0], pv[1]); w.y = pack2(pv[2], pv[3]);
      *(LAS u32x2*)(lds + ML_P + (jrow * PP + 16 * st + 4 * g) * 2) = w;
    }
    if ((rt & 1) == 0) { u32x2 z; z.x = 0u; z.y = 0u; *(LAS u32x2*)(lds + ML_P + (jrow * PP + 16 * (rt + 1) + 4 * g) * 2) = z; }
    if (more) ML_LOAD_KV(c + 1);
    asm volatile("s_waitcnt lgkmcnt(0)" ::: "memory");
    f32x4 ha[5];
#pragma unroll
    for (int vt = 0; vt < 5; ++vt) { f32x4 a = {0.f, 0.f, 0.f, 0.f};
      if (smp || c > 0) {
        bf16x8 cfr[8];
#pragma unroll
        for (int kk = 0; kk < 8; ++kk) cfr[kk] = tr_at(cB, (32 * kk * CP + 16 * vt) * 2, CP * 2);
        __builtin_amdgcn_sched_barrier(0);
#pragma unroll
        for (int kk = 0; kk < 8; ++kk) a = __builtin_amdgcn_mfma_f32_16x16x32_bf16(cfr[kk], qf[kk], a, 0, 0, 0);
        a *= w_inter; }
      ha[vt] = a; }
    for (int k2 = 0; k2 <= (rt >> 1); ++k2) {
      const bf16x8 pf = *(const LAS bf16x8*)(pB + k2 * 64);
      bf16x8 vfr[5];
#pragma unroll
      for (int vt = 0; vt < 5; ++vt) vfr[vt] = tr_at(vB + k2 * (32 * VP * 2), (16 * vt) * 2, VP * 2);
      __builtin_amdgcn_sched_barrier(0);
#pragma unroll
      for (int vt = 0; vt < 5; ++vt) ha[vt] = __builtin_amdgcn_mfma_f32_16x16x32_bf16(vfr[vt], pf, ha[vt], 0, 0, 0); }
    { const float den = __shfl(ha[4][0], l15); const float rdd = 1.0f / fmaxf(fabsf(den), __expf(-(bj + Mj)));
#pragma unroll
      for (int vt = 0; vt < 4; ++vt) { const f32x4 a = ha[vt] * rdd; u32x2 w; w.x = pack2(a[0], a[1]); w.y = pack2(a[2], a[3]);
        *(u32x2*)(hout + (size_t)qtok * 1024 + head * 256 + sl * 64 + 16 * vt + 4 * g) = w; } }
    if (more) ML_LOAD_Q(c + 1);
    const bool need_state = (!smp) || more;
    if (need_state) {
      const float decay = __expf(mst - M_last);
#pragma unroll
      for (int dt = 0; dt < 2; ++dt) {
#pragma unroll
        for (int vt = 0; vt < 4; ++vt) Cacc[dt][vt] *= decay;
        nacc[dt] *= decay; }
#pragma unroll
      for (int ks = 0; ks < 4; ++ks) {
        const bf16x8 kf0 = tr_at(kB, (32 * ks * KP) * 2, KP * 2), kf1 = tr_at(kB, (32 * ks * KP + 16) * 2, KP * 2);
        bf16x8 vfr[5];
#pragma unroll
        for (int vt = 0; vt < 5; ++vt) vfr[vt] = tr_at(vB, (32 * ks * VP + 16 * vt) * 2, VP * 2);
        __builtin_amdgcn_sched_barrier(0);
#pragma unroll
        for (int vt = 0; vt < 4; ++vt) { Cacc[0][vt] = __builtin_amdgcn_mfma_f32_16x16x32_bf16(vfr[vt], kf0, Cacc[0][vt], 0, 0, 0); Cacc[1][vt] = __builtin_amdgcn_mfma_f32_16x16x32_bf16(vfr[vt], kf1, Cacc[1][vt], 0, 0, 0); }
        nacc[0] = __builtin_amdgcn_mfma_f32_16x16x32_bf16(vfr[4], kf0, nacc[0], 0, 0, 0); nacc[1] = __builtin_amdgcn_mfma_f32_16x16x32_bf16(vfr[4], kf1, nacc[1], 0, 0, 0);
      }
    }
    if (wid == 0 && more) { float mn; ML_SCAN(lds + ML_T + ((c + 1) & 1) * ML_TSZ, mw0, mn); mw0 = mn; }
    m_final = T[256 + 127] + M_last;
    __syncthreads();
  }
#undef ML_LOAD_Q
#undef ML_LOAD_KV
#undef ML_SCAN
#undef TOKC
  if (!smp) {
    float* oC = p.out + OUTF_C + (size_t)sidx * 65536;
#pragma unroll
    for (int dt = 0; dt < 2; ++dt) {
#pragma unroll
      for (int vt = 0; vt < 4; ++vt) *(f32x4*)(oC + (size_t)((2 * wid + dt) * 16 + l15) * 256 + sl * 64 + 16 * vt + 4 * g) = Cacc[dt][vt];
      if (sl == 0 && g == 0) p.out[OUTF_N + (size_t)sidx * 256 + (2 * wid + dt) * 16 + l15] = nacc[dt][0]; }
    if (sl == 0 && tid == 0) p.out[OUTF_M + sidx] = m_final;
  }
}

__device__ void combine_rows(const Params& p) {
  const int tid0 = opaque_tid(); const int wid = tid0 >> 6, lane = tid0 & 63;
  bf16_t* H = (bf16_t*)((unsigned char*)p.out + OUT_H); const bf16_t* HB = (const bf16_t*)((unsigned char*)p.out + OUT_HB); const float* nw = p.in[22];
  f32x4 wv[4];
#pragma unroll
  for (int i = 0; i < 4; ++i) wv[i] = *(const f32x4*)(nw + 16 * lane + 4 * i);
  const int nh = (int)gridDim.x >> 1;
  if ((int)blockIdx.x < nh) return;
  for (int unit = (int)blockIdx.x - nh; unit < 768; unit += (int)gridDim.x - nh) {
    const int row0 = unit * 32 + wid * 4;
    u32x4 a[4][2], bq[4][2];
#pragma unroll
    for (int r = 0; r < 4; ++r)
#pragma unroll
      for (int i = 0; i < 2; ++i) { a[r][i] = *(const u32x4*)(H + (size_t)(row0 + r) * 1024 + 16 * lane + 8 * i); bq[r][i] = *(const u32x4*)(HB + (size_t)(row0 + r) * 1024 + 16 * lane + 8 * i); }
#pragma unroll
    for (int r = 0; r < 4; ++r) {
      f32x4 v[4]; float ss = 0.f;
#pragma unroll
      for (int i = 0; i < 2; ++i) { f32x4 x0, x1, y0, y1; unpack8(a[r][i], x0, x1); unpack8(bq[r][i], y0, y1); v[2 * i] = x0 + y0; v[2 * i + 1] = x1 + y1; }
#pragma unroll
      for (int i = 0; i < 4; ++i) ss += v[i][0] * v[i][0] + v[i][1] * v[i][1] + v[i][2] * v[i][2] + v[i][3] * v[i][3];
      ss += __shfl_xor(ss, 1); ss += __shfl_xor(ss, 2); ss += __shfl_xor(ss, 4); ss += __shfl_xor(ss, 8);
      const float rr = rsqrtf(ss * (1.0f / 256.0f) + 1e-6f);
#pragma unroll
      for (int i = 0; i < 2; ++i) *(u32x4*)(H + (size_t)(row0 + r) * 1024 + 16 * lane + 8 * i) = pack8(v[2 * i] * rr * wv[2 * i], v[2 * i + 1] * rr * wv[2 * i + 1]);
    }
  }
}

constexpr int HY_WAVE = 18816, HY_HR = 0, HY_ZA = 8576, HY_ZB = 8576 + 5120;
__device__ void hyena_item(const Params& p, LP lds, int item) {
  const int tid = opaque_tid(), wid = __builtin_amdgcn_readfirstlane(tid >> 6), lane = tid & 63, n31 = lane & 31, hh = lane >> 5;
  const bool smp = item < 1024; const int it = smp ? item : item - 1024; const int bset = it >> 7, cgp = it & 127; const int c = cgp * 8 + wid;
  const int L = smp ? 2048 : 256, lgL = smp ? 11 : 8, nblk = L >> 5, lgnb = lgL - 5, ntok = smp ? 2048 : 1024, ntile = smp ? 2 : 1, dmax = L >> 6;
  const int tok0 = smp ? NCTX + bset * 2048 : bset * 1024;
  LP wl = lds + wid * HY_WAVE; LAS float* hr = (LAS float*)(wl + HY_HR);
  const float* HFp = (const float*)(p.ws + (smp ? OFF_HFS : OFF_HFC));
  const bf16_t* UT = (const bf16_t*)(p.ws + OFF_BIG);
  const float* cw = p.in[12]; const float* cbv = p.in[13]; const float* skp = p.in[21];
  { const int uc = 2048 + c; const float w0 = cw[uc], w1 = cw[3072 + uc], w2 = cw[6144 + uc], cb = cbv[uc]; const bf16_t* src = UT + (size_t)uc * NTOK + tok0;
    u32x4 vv[4]; float pvv[4], nxv[4];
#pragma unroll
    for (int i = 0; i < 4; ++i) { const int base = lane * 8 + 512 * i; vv[i] = (u32x4){0u, 0u, 0u, 0u}; pvv[i] = 0.f; nxv[i] = 0.f;
      if (base < ntok) { vv[i] = *(const u32x4*)(src + base); const int tl = base & (L - 1);
        if (tl != 0) pvv[i] = bf2f(src[base - 1]); if (tl + 8 != L) nxv[i] = bf2f(src[base + 8]); } }
#pragma unroll
    for (int i = 0; i < 4; ++i) { const int base = lane * 8 + 512 * i;
      if (base < ntok) { const u32x4 v = vv[i];
        float u[10]; u[0] = pvv[i]; u[1] = bflo(v.x); u[2] = bfhi(v.x); u[3] = bflo(v.y); u[4] = bfhi(v.y); u[5] = bflo(v.z); u[6] = bfhi(v.z); u[7] = bflo(v.w); u[8] = bfhi(v.w); u[9] = nxv[i];
        float o[8];
#pragma unroll
        for (int e = 0; e < 8; ++e) o[e] = cb + w0 * u[e] + w1 * u[e + 1] + w2 * u[e + 2];
        u32x4 w; w.x = pack2(o[0], o[1]); w.y = pack2(o[2], o[3]); w.z = pack2(o[4], o[5]); w.w = pack2(o[6], o[7]);
        *(LAS u32x4*)(wl + HY_ZA + ((base >> 5) * 40 + (base & 31)) * 2) = w; } } }
  const int HRP = L + 96;
  f32x4 fvN[8];
#define HY_FLOAD(o) do { const float* src_ = HFp + (size_t)((o) * 1024 + c) * L; \
    _Pragma("unroll") for (int i = 0; i < 8; ++i) { const int q = lane + 64 * i; fvN[i] = (4 * q < L) ? *(const f32x4*)(src_ + 4 * q) : (f32x4){0.f, 0.f, 0.f, 0.f}; } } while (0)
  HY_FLOAD(0);
  for (int ord = 0; ord < 2; ++ord) {
    { float sa = 0.f;
      f32x4 fv[8];
#pragma unroll
      for (int i = 0; i < 8; ++i) fv[i] = fvN[i];
#pragma unroll
      for (int i = 0; i < 8; ++i) sa += (fabsf(fv[i][0]) + fabsf(fv[i][1])) + (fabsf(fv[i][2]) + fabsf(fv[i][3]));
      sa = wave_sum(sa); const float inv = 1.0f / (sa + 1e-6f);
      asm volatile("s_waitcnt lgkmcnt(0)" ::: "memory");
      LAS bf16_t* E = (LAS bf16_t*)hr; LAS bf16_t* O = E + HRP;
#pragma unroll
      for (int i = 0; i < 8; ++i) { const int q = lane + 64 * i;
        if (4 * q < L) {
#pragma unroll
          for (int e = 0; e < 4; ++e) { const int yy = L - 1 - (4 * q + e); const bf16_t v = f2bf(fv[i][e] * inv); E[32 + yy] = v; O[31 + yy] = v; } } }
      if (lane < 32) { E[lane] = 0; E[32 + L + lane] = 0; O[31 + L + lane] = 0; if (lane < 31) O[lane] = 0; }
      if (lane < 33) O[HRP - 33 + lane] = 0;
      asm volatile("s_waitcnt lgkmcnt(0)" ::: "memory"); }
    if (ord == 0) HY_FLOAD(1);
    LP zin = wl + (ord == 0 ? HY_ZA : HY_ZB); LP zout = wl + (ord == 0 ? HY_ZB : HY_ZA);
    const int gc = ord * 1024 + c; const float w0 = cw[gc], w1 = cw[3072 + gc], w2 = cw[6144 + gc], cb = cbv[gc], sk = skp[ord * 1024 + c];
    const bf16_t* gsrc = UT + (size_t)gc * NTOK + tok0;
    u32x4 gv[4]; unsigned gpv[4], gnx[4];
#pragma unroll
    for (int i = 0; i < 4; ++i) { const int base = lane * 8 + 512 * i; gv[i] = (u32x4){0u, 0u, 0u, 0u}; gpv[i] = 0u; gnx[i] = 0u;
      if (base < ntok) { gv[i] = *(const u32x4*)(gsrc + base); const int tl = base & (L - 1);
        if (tl != 0) gpv[i] = gsrc[base - 1]; if (tl + 8 != L) gnx[i] = gsrc[base + 8]; } }
    f32x16 accs[2];
#pragma unroll
    for (int o2 = 0; o2 < 2; ++o2)
#pragma unroll
      for (int r = 0; r < 16; ++r) accs[o2][r] = 0.f;
    LP fb = wl + HY_HR + ((n31 & 1) ? 0 : (HRP * 2 - 2)) + 2 * ((L >> 1) - 1 - n31 + 8 * hh + 32);
    int cbl[2], ca[2];
#pragma unroll
    for (int ot = 0; ot < 2; ++ot) { const int col = 32 * ot + n31; cbl[ot] = (col >> lgnb) << lgnb; ca[ot] = col & (nblk - 1); }
    const bool two = (ntile == 2);
    {
      LP zero = wl + HY_HR + 16 * hh;
      LP ap = fb + 64 * dmax;
      int bbr0 = ca[0] + dmax, bbr1 = ca[1] + dmax;
      LP bp0 = zin + ((cbl[0] + bbr0) * 40 + 8 * hh) * 2, bp1 = zin + ((cbl[1] + bbr1) * 40 + 8 * hh) * 2;
      for (int d = -dmax; d <= dmax; ++d) {
        u32x4 w0v, w1v;
        w0v.x = *(const LAS unsigned*)(ap); w0v.y = *(const LAS unsigned*)(ap + 4); w0v.z = *(const LAS unsigned*)(ap + 8); w0v.w = *(const LAS unsigned*)(ap + 12);
        w1v.x = *(const LAS unsigned*)(ap + 32); w1v.y = *(const LAS unsigned*)(ap + 36); w1v.z = *(const LAS unsigned*)(ap + 40); w1v.w = *(const LAS unsigned*)(ap + 44);
        const bf16x8 af0 = __builtin_bit_cast(bf16x8, w0v), af1 = __builtin_bit_cast(bf16x8, w1v);
        LP q0 = ((unsigned)bbr0 < (unsigned)nblk) ? bp0 : zero;
        LP q1 = (two && ((unsigned)bbr1 < (unsigned)nblk)) ? bp1 : zero;
        const bf16x8 b00 = *(const LAS bf16x8*)q0, b01 = *(const LAS bf16x8*)(q0 + 32);
        const bf16x8 b10 = *(const LAS bf16x8*)q1, b11 = *(const LAS bf16x8*)(q1 + 32);
        __builtin_amdgcn_sched_barrier(0);
        accs[0] = __builtin_amdgcn_mfma_f32_32x32x16_bf16(af0, b00, accs[0], 0, 0, 0);
        if (two) accs[1] = __builtin_amdgcn_mfma_f32_32x32x16_bf16(af0, b10, accs[1], 0, 0, 0);
        accs[0] = __builtin_amdgcn_mfma_f32_32x32x16_bf16(af1, b01, accs[0], 0, 0, 0);
        if (two) accs[1] = __builtin_amdgcn_mfma_f32_32x32x16_bf16(af1, b11, accs[1], 0, 0, 0);
        ap -= 64; bbr0 -= 1; bbr1 -= 1; bp0 -= 80; bp1 -= 80;
      }
    }
#pragma unroll
    for (int ot = 0; ot < 2; ++ot) {
      if (ot >= ntile) continue;
      const f32x16 acc = accs[ot];
#pragma unroll
      for (int rg = 0; rg < 4; ++rg) {
        const int zo = (((cbl[ot] + ca[ot]) * 40) + 8 * rg + 4 * hh) * 2;
        const u32x2 zv = *(const LAS u32x2*)(zin + zo);
        u32x2 w; w.x = pack2(acc[4 * rg] + sk * bflo(zv.x), acc[4 * rg + 1] + sk * bfhi(zv.x)); w.y = pack2(acc[4 * rg + 2] + sk * bflo(zv.y), acc[4 * rg + 3] + sk * bfhi(zv.y));
        *(LAS u32x2*)(zout + zo) = w;
      }
    }
    asm volatile("s_waitcnt lgkmcnt(0)" ::: "memory");
#pragma unroll
    for (int i = 0; i < 4; ++i) { const int base = lane * 8 + 512 * i;
      if (base < ntok) { const u32x4 v = gv[i];
        float u[10]; u[0] = bf2f(gpv[i]); u[1] = bflo(v.x); u[2] = bfhi(v.x); u[3] = bflo(v.y); u[4] = bfhi(v.y); u[5] = bflo(v.z); u[6] = bfhi(v.z); u[7] = bflo(v.w); u[8] = bfhi(v.w); u[9] = bf2f(gnx[i]);
        LP zp = zout + ((base >> 5) * 40 + (base & 31)) * 2; const u32x4 t = *(const LAS u32x4*)zp;
        float tv[8]; tv[0] = bflo(t.x); tv[1] = bfhi(t.x); tv[2] = bflo(t.y); tv[3] = bfhi(t.y); tv[4] = bflo(t.z); tv[5] = bfhi(t.z); tv[6] = bflo(t.w); tv[7] = bfhi(t.w);
        float o[8];
#pragma unroll
        for (int e = 0; e < 8; ++e) o[e] = (cb + w0 * u[e] + w1 * u[e + 1] + w2 * u[e + 2]) * tv[e];
        u32x4 w; w.x = pack2(o[0], o[1]); w.y = pack2(o[2], o[3]); w.z = pack2(o[4], o[5]); w.w = pack2(o[6], o[7]);
        *(LAS u32x4*)zp = w; } }
    asm volatile("s_waitcnt lgkmcnt(0)" ::: "memory");
  }
  __syncthreads();
  { bf16_t* YH = (bf16_t*)((unsigned char*)p.out + OUT_HB);
    for (int tl = tid; tl < ntok; tl += 512) {
      const int bl = tl >> lgL, tloc = tl & (L - 1); const int zo = ((((bl << lgnb) + (tloc >> 5)) * 40) + (tloc & 31)) * 2;
      unsigned short e[8];
#pragma unroll
      for (int w = 0; w < 8; ++w) e[w] = *(const LAS unsigned short*)(lds + w * HY_WAVE + HY_ZA + zo);
      u32x4 o; o.x = e[0] | ((unsigned)e[1] << 16); o.y = e[2] | ((unsigned)e[3] << 16); o.z = e[4] | ((unsigned)e[5] << 16); o.w = e[6] | ((unsigned)e[7] << 16);
      *(u32x4*)(YH + (size_t)(tok0 + tl) * 1024 + cgp * 8) = o; } }
  __syncthreads();
}

__device__ void final_norm(const Params& p) {
  const int tid0 = opaque_tid(); const int wid = tid0 >> 6, lane = tid0 & 63; const float* fw = p.in[31];
  const float* P = (const float*)(p.ws + OFF_BIG + (size_t)8192 * 4096 * 2); const float* mod = (const float*)(p.ws + OFF_MOD);
  f32x4 wv[4];
#pragma unroll
  for (int i = 0; i < 4; ++i) wv[i] = *(const f32x4*)(fw + 4 * lane + 256 * i);
  for (int unit = blockIdx.x; unit < 768; unit += gridDim.x) {
    const int row0 = unit * 32 + wid * 4; const bool chunkB = row0 >= 16384;
    f32x4 x[4][4];
#pragma unroll
    for (int r = 0; r < 4; ++r)
#pragma unroll
      for (int i = 0; i < 4; ++i) x[r][i] = *(const f32x4*)(p.out + (size_t)(row0 + r) * 1024 + 4 * lane + 256 * i);
    if (chunkB) { const float* md = mod + cond_of_row(row0) * 6144 + 5120;
#pragma unroll
      for (int i = 0; i < 4; ++i) { const f32x4 g2 = *(const f32x4*)(md + 4 * lane + 256 * i);
#pragma unroll
        for (int r = 0; r < 4; ++r) x[r][i] += g2 * *(const f32x4*)(P + (size_t)(row0 + r - 16384) * 1024 + 4 * lane + 256 * i); } }
#pragma unroll
    for (int r = 0; r < 4; ++r) { float ss = 0.f;
#pragma unroll
      for (int i = 0; i < 4; ++i) ss += x[r][i][0] * x[r][i][0] + x[r][i][1] * x[r][i][1] + x[r][i][2] * x[r][i][2] + x[r][i][3] * x[r][i][3];
      ss = wave_sum(ss); const float rstd = rsqrtf(ss * (1.0f / 1024.0f) + 1e-6f);
#pragma unroll
      for (int i = 0; i < 4; ++i) *(f32x4*)(p.out + (size_t)(row0 + r) * 1024 + 4 * lane + 256 * i) = x[r][i] * rstd * wv[i]; }
  }
}

__global__ void __launch_bounds__(512, 2) __attribute__((flatten)) mega(Params p) {
  extern __shared__ __attribute__((aligned(16))) unsigned char shm[];
  LP lds = (LP)shm;
  cg::grid_group grid = cg::this_grid();
  volatile LAS unsigned* xst = (volatile LAS unsigned*)(lds + LDS_BYTES - 16);
  if (threadIdx.x == 0) { xst[0] = 0u; xst[1] = 0u; }
  __syncthreads();
  const XcdBarrier xb = xcd_barrier_post((unsigned*)(p.ws + OFF_BAR), xst);
  unsigned char* ws = p.ws;
  const bf16_t* WT = (const bf16_t*)(ws + OFF_WT); const bf16_t* HN = (const bf16_t*)(ws + OFF_HN); bf16_t* BIG = (bf16_t*)(ws + OFF_BIG);
  bf16_t* Hb = (bf16_t*)((unsigned char*)p.out + OUT_H); bf16_t* YH = (bf16_t*)((unsigned char*)p.out + OUT_HB);
  const float* mod = (const float*)(ws + OFF_MOD);
  phase0(p, lds);
  if (gridDim.y == 7u) grid.sync();
  xcd_barrier(xb);
  phase1(p, lds);
  weight_tiles(p, lds, 0, 384, 0);
  xcd_barrier(xb);
  filters_upper_half(p, lds);
  weight_tiles(p, lds, 384, 768, 1);
  { EpiQKV e; e.O = BIG; e.bias = p.in[11]; run_gemm(lds, HN, WT, NTOK, 3072, 1024, e); }
  xcd_barrier(xb);
  for (int item = blockIdx.x; item < 1280; item += gridDim.x) mlstm_item(p, lds, item);
  xcd_barrier(xb);
  combine_rows(p);
  weight_tiles(p, lds, 768, 1152, 1);
  { EpiUT e; e.O = BIG; e.bias = p.in[11] + 4112; run_gemm(lds, WT + (size_t)3072 * 1024, HN, 3072, NTOK, 1024, e); }
  xcd_barrier(xb);
  for (int item = blockIdx.x; item < 2048; item += gridDim.x) hyena_item(p, lds, item);
  xcd_barrier(xb);
  c1_upper_half(p, lds);
  weight_tiles(p, lds, 1152, 1536, 1);
  { EpiGates e; e.H = Hb; e.G = BIG; e.b_in = p.in[11]; run_gemm(lds, HN, WT + (size_t)6144 * 1024, NTOK, 3072, 1024, e); }
  xcd_barrier(xb);
  bf16_t* T = BIG + (size_t)NTOK * 2048;
  weight_tiles(p, lds, 1536, 2560, 1);
  { EpiMerge<0> e; e.T = T; e.G = BIG; run_gemm(lds, Hb, (const bf16_t*)(ws + OFF_WBM), NTOK, 1024, 1024, e); }
  { EpiMerge<1> e; e.T = T; e.G = BIG; run_gemm(lds, YH, (const bf16_t*)(ws + OFF_WBH), NTOK, 1024, 1024, e); }
  xcd_barrier(xb);
  { EpiOut e; e.xp = p.in[0]; e.xs = p.in[1]; e.per = (const float*)(ws + OFF_PER); e.pec = (const float*)(ws + OFF_PEC); e.mod = mod; e.n2w = p.in[26];
    e.X1 = p.out; e.A2 = (bf16_t*)(ws + OFF_HN); e.ssq = (float*)(ws + OFF_SSQ1); run_gemm(lds, T, (const bf16_t*)(ws + OFF_WOUT), NTOK, 1024, 1024, e); }
  xcd_barrier(xb);
  constexpr int ROWS_A = 16384, ROWS_B = NTOK - ROWS_A;
  { EpiFF1 e; e.row0 = 0; e.ssq = (const float*)(p.ws + OFF_SSQ1); e.c1 = (const float*)(p.ws + OFF_C1); e.Hd = (bf16_t*)(p.ws + OFF_BIG);
    run_gemm(lds, (const bf16_t*)(p.ws + OFF_HN), (const bf16_t*)(p.ws + OFF_W1T), ROWS_A, 4096, 1024, e); }
  xcd_barrier(xb);
  { EpiFF2 e; e.row0 = 0; e.mod = (const float*)(p.ws + OFF_MOD); e.b2 = p.in[30]; e.X = p.out; e.P = (float*)(p.ws + OFF_BIG + (size_t)ROWS_A * 4096 * 2);
    run_gemm(lds, (const bf16_t*)(p.ws + OFF_BIG), (const bf16_t*)(p.ws + OFF_W2T), ROWS_A, 1024, 4096, e); }
  xcd_barrier(xb);
  { EpiFF1 e; e.row0 = ROWS_A; e.ssq = (const float*)(p.ws + OFF_SSQ1); e.c1 = (const float*)(p.ws + OFF_C1); e.Hd = (bf16_t*)(p.ws + OFF_BIG);
    run_gemm(lds, (const bf16_t*)(p.ws + OFF_HN) + (size_t)ROWS_A * 1024, (const bf16_t*)(p.ws + OFF_W1T), ROWS_B, 4096, 1024, e); }
  xcd_barrier(xb);
  { EpiFF2 e; e.row0 = ROWS_A; e.mod = (const float*)(p.ws + OFF_MOD); e.b2 = p.in[30]; e.X = p.out; e.P = (float*)(p.ws + OFF_BIG + (size_t)ROWS_B * 4096 * 2);
    run_gemm(lds, (const bf16_t*)(p.ws + OFF_BIG), (const bf16_t*)(p.ws + OFF_W2T), ROWS_B, 1024, 4096, e, 2); }
  xcd_barrier(xb);
  final_norm(p);
}

extern "C" void kernel_launch(void* const* d_in, const int* in_sizes, int n_in, void* d_out, int out_size, void* d_ws, size_t ws_size, hipStream_t stream) {
  static int grid_blocks = 0;
  if (!grid_blocks) {
    int dev = 0, cus = 0, per_cu = 0;
    hipGetDevice(&dev);
    hipDeviceGetAttribute(&cus, hipDeviceAttributeMultiprocessorCount, dev);
    hipFuncSetAttribute((const void*)mega, hipFuncAttributeMaxDynamicSharedMemorySize, LDS_BYTES);
    hipOccupancyMaxActiveBlocksPerMultiprocessor(&per_cu, (const void*)mega, 512, LDS_BYTES);
    if (per_cu < 1) { fprintf(stderr, "kernel_launch: occupancy query reports %d blocks per CU\n", per_cu); grid_blocks = -1; }
    else grid_blocks = cus;
    if (n_in != 32 || ws_size < WS_END) { fprintf(stderr, "kernel_launch: unexpected n_in %d / ws_size %zu (need %zu)\n", n_in, ws_size, (size_t)WS_END); grid_blocks = -1; }
  }
  if (grid_blocks < 0) return;
  hipMemsetAsync((unsigned char*)d_ws + OFF_BAR, 0, 3456 * 4, stream);
  Params p{};
  for (int i = 0; i < 32; ++i) p.in[i] = (const float*)d_in[i];
  p.out = (float*)d_out; p.ws = (unsigned char*)d_ws;
  void* args[] = {&p};
  hipError_t e = hipLaunchCooperativeKernel((void*)mega, dim3(grid_blocks), dim3(512), args, LDS_BYTES, stream);
  if (e != hipSuccess) fprintf(stderr, "cooperative launch failed: %s (grid %d)\n", hipGetErrorString(e), grid_blocks);
}
```

```cpp
#include <hip/hip_runtime.h>
#include <hip/hip_cooperative_groups.h>
#include <cstdio>
#include <cstdint>
namespace cg = cooperative_groups;

#define LAS __attribute__((address_space(3)))
typedef LAS unsigned char* LP;
typedef unsigned short bf16_t;
typedef short bf16x8 __attribute__((ext_vector_type(8)));
typedef short s16x4 __attribute__((ext_vector_type(4)));
typedef float f32x4 __attribute__((ext_vector_type(4)));
typedef float f32x16 __attribute__((ext_vector_type(16)));
typedef unsigned u32x4 __attribute__((ext_vector_type(4)));
typedef unsigned u32x2 __attribute__((ext_vector_type(2)));

constexpr int DM = 1024, NTOK = 24576, NCTX = 8192, SEQC = 256, SEQS = 2048, INC = 9232;
constexpr int LDS_BYTES = 160 * 1024;
constexpr size_t OFF_WT = 0;
constexpr size_t OFF_WBM = 18874368, OFF_WBH = 20971520, OFF_WOUT = 23068672, OFF_W1T = 25165824, OFF_W2T = 33554432;
constexpr size_t OFF_HN = 41943040;
constexpr size_t OFF_BIG = 92274688;
constexpr size_t OFF_SM = 243269632;
constexpr size_t OFF_MOD = OFF_SM;
constexpr size_t OFF_C1 = OFF_MOD + 221184;
constexpr size_t OFF_H2S = OFF_C1 + 147456;
constexpr size_t OFF_H2C = OFF_H2S + 524288;
constexpr size_t OFF_PER = OFF_H2C + 65536;
constexpr size_t OFF_PEC = OFF_PER + 65536;
constexpr size_t OFF_GT = OFF_PEC + 131072;
constexpr size_t OFF_SSQ1 = OFF_GT + 1572864;
constexpr size_t OFF_SSQ2 = OFF_SSQ1 + 1572864;
constexpr size_t OFF_HFS = OFF_SSQ2 + 1572864;
constexpr size_t OFF_HFC = OFF_HFS + 16777216;
constexpr size_t OFF_BAR = OFF_HFC + 2097152;
constexpr size_t WS_END = OFF_BAR + 3456 * 4;
constexpr size_t OUT_H = 0, OUT_HB = 50331648;
constexpr size_t OUTF_C = 25165824, OUTF_N = 41943040, OUTF_M = 42008576;

struct Params { const float* in[32]; float* out; unsigned char* ws; };

__device__ __forceinline__ bf16_t f2bf(float f) { unsigned u = __float_as_uint(f); u += 0x7FFFu + ((u >> 16) & 1u); return (bf16_t)(u >> 16); }
__device__ __forceinline__ float bf2f(unsigned b) { return __uint_as_float(b << 16); }
__device__ __forceinline__ unsigned pack2(float lo, float hi) { return (unsigned)f2bf(lo) | ((unsigned)f2bf(hi) << 16); }
__device__ __forceinline__ float bflo(unsigned w) { return __uint_as_float(w << 16); }
__device__ __forceinline__ float bfhi(unsigned w) { return __uint_as_float(w & 0xffff0000u); }
__device__ __forceinline__ float sigmoidf_(float x) { return 1.0f / (1.0f + __expf(-x)); }
__device__ __forceinline__ int opaque_tid() { int t = threadIdx.x; asm volatile("" : "+v"(t)); return t; }
__device__ __forceinline__ float wave_sum(float v) {
#pragma unroll
  for (int o = 32; o >= 1; o >>= 1) v += __shfl_xor(v, o);
  return v;
}


#define XB_TMO      128
#define XB_XCNT(j)  (256  + 64 * (j))
#define XB_XSUB(j)  (1280 + 64 * (j))
#define XB_XGEN(j)  (2304 + 64 * (j))
#define XB_TOP      3328
#define XB_TOPGEN   3392
#define XCD_BAR_WORDS 3456
#define XB_SPIN_CAP (1u << 18)
__device__ __forceinline__ unsigned xb_ld(unsigned* p)              { return __hip_atomic_load(p, __ATOMIC_RELAXED, __HIP_MEMORY_SCOPE_AGENT); }
__device__ __forceinline__ unsigned xb_add(unsigned* p, unsigned v) { return __hip_atomic_fetch_add(p, v, __ATOMIC_RELAXED, __HIP_MEMORY_SCOPE_AGENT); }
__device__ __forceinline__ unsigned xb_xcc_id() { return (unsigned)__builtin_amdgcn_s_getreg((3 << 11) | 20) & 0xFu; }
#define XB_SPIN(cond, bar) do { unsigned _sp = 0; while (cond) { __builtin_amdgcn_s_sleep(1); \
    if ((++_sp & 255u) == 0u) { if (xb_ld(&(bar)[XB_TMO])) break; if (_sp > XB_SPIN_CAP) { atomicAdd(&(bar)[XB_TMO], 1u); break; } } } } while (0)
struct XcdBarrier { unsigned* bar; unsigned x; volatile LAS unsigned* st; };
__device__ __forceinline__ XcdBarrier xcd_barrier_post(unsigned* bar, volatile LAS unsigned* st) {
  XcdBarrier b; b.bar = bar; b.x = xb_xcc_id(); b.st = st;
  if (threadIdx.x == 0) (void)xb_add(&bar[XB_XCNT(b.x)], 1u);
  return b;
}
__device__ __forceinline__ void xcd_barrier_complete(unsigned* bar, unsigned x, unsigned& nloc, unsigned& nx) {
  const unsigned G = gridDim.x * gridDim.y * gridDim.z;
  unsigned sum, cnt, mine, sp = 0u;
  for (;;) {
    sum = 0u; cnt = 0u; mine = 0u;
#pragma unroll
    for (unsigned j = 0; j < 16; ++j) { const unsigned c = xb_ld(&bar[XB_XCNT(j)]); sum += c; cnt += (c > 0u) ? 1u : 0u; mine = (j == x) ? c : mine; }
    if (sum == G) break;
    __builtin_amdgcn_s_sleep(1);
    if ((++sp & 255u) == 0u) { if (xb_ld(&bar[XB_TMO])) break; if (sp > XB_SPIN_CAP) { atomicAdd(&bar[XB_TMO], 1u); break; } }
  }
  nloc = mine > 0u ? mine : 1u; nx = cnt > 0u ? cnt : 1u;
}
__device__ __forceinline__ void xcd_barrier(const XcdBarrier& b) {
  asm volatile("s_waitcnt vmcnt(0)" ::: "memory");
  __syncthreads();
  if (threadIdx.x == 0) {
    unsigned* bar = b.bar;
    __builtin_amdgcn_s_waitcnt(0);
    unsigned nloc = b.st[0], nx = b.st[1];
    if (nloc == 0u) { xcd_barrier_complete(bar, b.x, nloc, nx); b.st[0] = nloc; b.st[1] = nx; }
    const unsigned old = xb_add(&bar[XB_XSUB(b.x)], 1u);
    const unsigned gen = old / nloc;
    if (old + 1u == (gen + 1u) * nloc) {
      __builtin_amdgcn_fence(__ATOMIC_RELEASE, "agent");
      asm volatile("s_waitcnt vmcnt(0)" ::: "memory");
      const unsigned og = xb_add(&bar[XB_TOP], 1u);
      const unsigned tg = og / nx;
      if (og + 1u == (tg + 1u) * nx) xb_add(&bar[XB_TOPGEN], 1u);
      else XB_SPIN(xb_ld(&bar[XB_TOPGEN]) == tg, bar);
      __builtin_amdgcn_fence(__ATOMIC_ACQUIRE, "agent");
      xb_add(&bar[XB_XGEN(b.x)], 1u);
      asm volatile("s_waitcnt vmcnt(0)" ::: "memory");
    } else {
      XB_SPIN(xb_ld(&bar[XB_XGEN(b.x)]) == gen, bar);
      __builtin_amdgcn_fence(__ATOMIC_ACQUIRE, "agent");
      asm volatile("s_waitcnt vmcnt(0)" ::: "memory");
    }
  }
  __syncthreads();
}

namespace pg8 {
constexpr int BM = 256, BK = 64, HALF = 128, HTB = HALF * BK * 2, STAGE_BYTES = 8 * HTB, NXCD = 8, WGM = 8;
__host__ __device__ __forceinline__ int lds_byte(int r, int c) { const int st = (r >> 4) * 2 + (c >> 5), rr = r & 15, cc = c & 31, ob = rr * 64 + cc * 2; return st * 1024 + (ob ^ (((ob >> 9) & 1) << 5)); }
__host__ __device__ __forceinline__ void stage_rc(int b, int& R, int& C) { const int st = b / 1024, sb = b % 1024, swz = sb ^ (((sb >> 9) & 1) << 5); R = (st >> 1) * 16 + swz / 64; C = (st & 1) * 32 + (swz % 64) / 2; }
__host__ __device__ __forceinline__ int perm32(int rho) { const int n = rho >> 4, i = rho & 15; return 8 * (i >> 2) + 4 * n + (i & 3); }
struct Unit { int pm, pn, ks; };
struct Gemm { const bf16_t* A; const bf16_t* Bt; int M, N, K, ld, nks; };
struct StaticOrder {
  int nM, nN, ntile, nwg, G, c;
  __device__ void init(int M, int N, int nks, int G_, int c_) { nM = M / BM; nN = N / BM; ntile = nM * nN; nwg = ntile * nks; G = G_; c = c_; }
  __device__ bool next(int i, Unit& u) const {
    const long L = (long)i * G + c; if (L >= nwg) return false;
    u.ks = (int)L / ntile; int wgid = (int)L - u.ks * ntile;
    { const int q = ntile / NXCD, r = ntile % NXCD, xcd = wgid % NXCD, off = wgid / NXCD; wgid = (xcd < r ? xcd * (q + 1) : r * (q + 1) + (xcd - r) * q) + off; }
    const int nig = WGM * nN, gid = wgid / nig, fm = gid * WGM, gsz = (nM - fm) < WGM ? (nM - fm) : WGM;
    u.pm = fm + ((wgid % nig) % gsz); u.pn = (wgid % nig) / gsz; return true;
  }
};

template <class Epi>
__device__ __forceinline__ void gemm_phase(LP lds, const Gemm g, const StaticOrder& S, const Epi& E) {
  int tid_ = threadIdx.x; asm volatile("" : "+v"(tid_));
  const int tid = tid_, wid = __builtin_amdgcn_readfirstlane(tid >> 6), lane = tid & 63, wr = wid >> 2, wc = wid & 3, fr = lane & 15, fq = lane >> 4;
  const int K = g.ld, nt = g.K / BK;
  const size_t ksb = (size_t)g.K * 2;
  unsigned voffA[2], voffB[2];
#pragma unroll
  for (int i = 0; i < 2; ++i) { int R, C; stage_rc(tid * 16 + i * 8192, R, C); const int Rb = (R & ~31) + perm32(R & 31); voffA[i] = (unsigned)(R * K + C) * 2u; voffB[i] = (unsigned)(Rb * K + C) * 2u; }
  const size_t kstep = (size_t)(BK * 2);
  const size_t hstep = (size_t)HALF * K * 2;
  const size_t tstep = 2 * hstep;
  const unsigned ldsw = (unsigned)wid * 1024u;
  const int aoff = lds_byte(wr * 64 + fr, fq * 8), boff = lds_byte(wc * 32 + fr, fq * 8);
#define PG8_SA(b, h) (((b) * 2 + (h)) * HTB)
#define PG8_SB(b, h) ((4 + (b) * 2 + (h)) * HTB)
#define PG8_STAGE(bufoff, gbase, voff) do { _Pragma("unroll") for (int _i = 0; _i < 2; ++_i) \
    __builtin_amdgcn_global_load_lds((const unsigned*)((const char*)(gbase) + (voff)[_i]), (LAS unsigned*)(lds + (bufoff) + ldsw + _i * 8192), 16, 0, 0); } while (0)
#define PG8_LDA(dst, b, h) do { _Pragma("unroll") for (int m = 0; m < 4; ++m) _Pragma("unroll") for (int k = 0; k < 2; ++k) dst[m][k] = *(const LAS bf16x8*)(lds + PG8_SA(b, h) + aoff + m * 2048 + k * 1024); } while (0)
#define PG8_LDB(dst, b, h) do { _Pragma("unroll") for (int n = 0; n < 2; ++n) _Pragma("unroll") for (int k = 0; k < 2; ++k) dst[n][k] = *(const LAS bf16x8*)(lds + PG8_SB(b, h) + boff + n * 2048 + k * 1024); } while (0)
#define PG8_MMA(ai, bj, At, Bt) do { __builtin_amdgcn_s_setprio(1); _Pragma("unroll") for (int m = 0; m < 4; ++m) _Pragma("unroll") for (int n = 0; n < 2; ++n) _Pragma("unroll") for (int k = 0; k < 2; ++k) \
    acc[ai][bj][m][n] = __builtin_amdgcn_mfma_f32_16x16x32_bf16(Bt[n][k], At[m][k], acc[ai][bj][m][n], 0, 0, 0); __builtin_amdgcn_s_setprio(0); } while (0)
#define PG8_WAIT_V(n) asm volatile("s_waitcnt vmcnt(" #n ")" ::: "memory")
#define PG8_WAIT_L(n) asm volatile("s_waitcnt lgkmcnt(" #n ")" ::: "memory")
#define PG8_BAR __builtin_amdgcn_s_barrier()
#define PG8_SCHED __builtin_amdgcn_sched_barrier(0)
  Unit cur, nxt; int ui = 0;
  if (!S.next(0, cur)) return;
  f32x4 acc[2][2][4][2];
#pragma unroll
  for (int a = 0; a < 2; ++a)
#pragma unroll
    for (int b = 0; b < 2; ++b)
#pragma unroll
      for (int m = 0; m < 4; ++m)
#pragma unroll
        for (int n = 0; n < 2; ++n) acc[a][b][m][n] = (f32x4){0.f, 0.f, 0.f, 0.f};
  bf16x8 At[4][2], B0[2][2], B1[2][2];
  const char* cA = (const char*)g.A + (size_t)cur.pm * tstep + cur.ks * ksb; const char* cB = (const char*)g.Bt + (size_t)cur.pn * tstep + cur.ks * ksb;
  PG8_STAGE(PG8_SB(0, 0), cB, voffB); PG8_STAGE(PG8_SA(0, 0), cA, voffA); PG8_STAGE(PG8_SB(0, 1), cB + hstep, voffB); PG8_STAGE(PG8_SA(0, 1), cA + hstep, voffA);
  if (wr == 1) PG8_BAR;
  PG8_WAIT_V(4); PG8_BAR;
  PG8_STAGE(PG8_SB(1, 0), cB + kstep, voffB); PG8_STAGE(PG8_SA(1, 0), cA + kstep, voffA); PG8_STAGE(PG8_SB(1, 1), cB + hstep + kstep, voffB);
  PG8_WAIT_V(6); PG8_BAR;
  for (;;) {
    const bool has_next = S.next(ui + 1, nxt);
    const char* nA = has_next ? (const char*)g.A + (size_t)nxt.pm * tstep + nxt.ks * ksb : cA; const char* nB = has_next ? (const char*)g.Bt + (size_t)nxt.pn * tstep + nxt.ks * ksb : cB;
    for (int t = 0; t < nt; t += 2) {
      const bool last = (t == nt - 2);
      const char* a1 = cA + (size_t)(t + 1) * kstep;
      const char* a2 = last ? nA : cA + (size_t)(t + 2) * kstep; const char* b2 = last ? nB : cB + (size_t)(t + 2) * kstep;
      const char* a3 = a2 + kstep; const char* b3 = b2 + kstep;
      PG8_LDB(B0, 0, 0); PG8_SCHED; PG8_LDA(At, 0, 0); PG8_STAGE(PG8_SA(1, 1), a1 + hstep, voffA);
      PG8_WAIT_L(8); PG8_BAR; PG8_WAIT_L(0); PG8_MMA(0, 0, At, B0); PG8_BAR; PG8_SCHED;
      PG8_LDB(B1, 0, 1); PG8_STAGE(PG8_SB(0, 0), b2, voffB);
      PG8_BAR; PG8_WAIT_L(0); PG8_MMA(0, 1, At, B1); PG8_BAR;
      PG8_LDA(At, 0, 1); PG8_STAGE(PG8_SA(0, 0), a2, voffA);
      PG8_BAR; PG8_WAIT_L(0); PG8_MMA(1, 0, At, B0); PG8_BAR; PG8_SCHED;
      PG8_STAGE(PG8_SB(0, 1), b2 + hstep, voffB);
      PG8_WAIT_V(6); PG8_BAR; PG8_MMA(1, 1, At, B1); PG8_BAR;
      PG8_LDB(B0, 1, 0); PG8_SCHED; PG8_LDA(At, 1, 0); PG8_STAGE(PG8_SA(0, 1), a2 + hstep, voffA);
      PG8_WAIT_L(8); PG8_BAR; PG8_WAIT_L(0); PG8_MMA(0, 0, At, B0); PG8_BAR; PG8_SCHED;
      PG8_LDB(B1, 1, 1); PG8_STAGE(PG8_SB(1, 0), b3, voffB);
      PG8_BAR; PG8_WAIT_L(0); PG8_MMA(0, 1, At, B1); PG8_BAR;
      PG8_LDA(At, 1, 1); PG8_STAGE(PG8_SA(1, 0), a3, voffA);
      PG8_BAR; PG8_WAIT_L(0); PG8_MMA(1, 0, At, B0); PG8_BAR; PG8_SCHED;
      PG8_STAGE(PG8_SB(1, 1), b3 + hstep, voffB);
      PG8_WAIT_V(6); PG8_BAR; PG8_MMA(1, 1, At, B1); PG8_BAR;
    }
    { int fr2 = fr, fq2 = fq; asm volatile("" : "+v"(fr2), "+v"(fq2)); E(acc, cur, wr, wc, fr2, fq2); }
    if (!has_next) break;
#pragma unroll
    for (int a = 0; a < 2; ++a)
#pragma unroll
      for (int b = 0; b < 2; ++b)
#pragma unroll
        for (int m = 0; m < 4; ++m)
#pragma unroll
          for (int n = 0; n < 2; ++n) acc[a][b][m][n] = (f32x4){0.f, 0.f, 0.f, 0.f};
    cur = nxt; cA = nA; cB = nB; ++ui;
  }
  PG8_WAIT_V(0);
  if (wr == 0) PG8_BAR;
  PG8_BAR;
#undef PG8_SA
#undef PG8_SB
#undef PG8_STAGE
#undef PG8_LDA
#undef PG8_LDB
#undef PG8_MMA
#undef PG8_WAIT_V
#undef PG8_WAIT_L
#undef PG8_BAR
#undef PG8_SCHED
}
}
using pg8::Unit;
typedef f32x4 AccT[2][2][4][2];

#define EPI_ROW(ai, m) (u.pm * 256 + (ai) * 128 + wr * 64 + (m) * 16 + fr)
#define EPI_COL(bj, n) (u.pn * 256 + (bj) * 128 + wc * 32 + 8 * fq + 4 * (n))
#define EPI_LOOP_ROWS _Pragma("unroll") for (int ai = 0; ai < 2; ++ai) _Pragma("unroll") for (int m = 0; m < 4; ++m)
#define EPI_LOOP_COLS _Pragma("unroll") for (int bj = 0; bj < 2; ++bj) _Pragma("unroll") for (int n = 0; n < 2; ++n)

__device__ __forceinline__ int cond_of_row(int row) { return row < NCTX ? 0 : 1 + ((row - NCTX) >> 11); }

#define EPI_LOOP_BJ _Pragma("unroll") for (int bj = 0; bj < 2; ++bj)
__device__ __forceinline__ u32x4 pack8(const f32x4 v0, const f32x4 v1) { u32x4 w; w.x = pack2(v0[0], v0[1]); w.y = pack2(v0[2], v0[3]); w.z = pack2(v1[0], v1[1]); w.w = pack2(v1[2], v1[3]); return w; }
__device__ __forceinline__ void unpack8(const u32x4 w, f32x4& v0, f32x4& v1) { v0[0] = bflo(w.x); v0[1] = bfhi(w.x); v0[2] = bflo(w.y); v0[3] = bfhi(w.y); v1[0] = bflo(w.z); v1[1] = bfhi(w.z); v1[2] = bflo(w.w); v1[3] = bfhi(w.w); }
struct EpiQKV {
  bf16_t* O; const float* bias;
  __device__ __forceinline__ void operator()(const AccT& acc, const Unit& u, int wr, int wc, int fr, int fq) const {
    const float sc = (u.pn < 4) ? 0.0625f : 1.0f;
    f32x4 bv[2][2];
    EPI_LOOP_COLS { bv[bj][n] = *(const f32x4*)(bias + EPI_COL(bj, n)); }
    EPI_LOOP_ROWS { const int row = EPI_ROW(ai, m);
      EPI_LOOP_BJ { *(u32x4*)(O + (size_t)row * 3072 + EPI_COL(bj, 0)) = pack8((acc[ai][bj][m][0] + bv[bj][0]) * sc, (acc[ai][bj][m][1] + bv[bj][1]) * sc); } }
  }
};
struct EpiUT {
  bf16_t* O; const float* bias;
  __device__ __forceinline__ void operator()(const AccT& acc, const Unit& u, int wr, int wc, int fr, int fq) const {
    EPI_LOOP_ROWS { const int row = EPI_ROW(ai, m); const float bv = bias[row];
      EPI_LOOP_BJ { *(u32x4*)(O + (size_t)row * NTOK + EPI_COL(bj, 0)) = pack8(acc[ai][bj][m][0] + bv, acc[ai][bj][m][1] + bv); } }
  }
};
struct EpiGates {
  bf16_t* H; bf16_t* G; const float* b_in;
  __device__ __forceinline__ void operator()(const AccT& acc, const Unit& u, int wr, int wc, int fr, int fq) const {
    const bool og = u.pn < 4;
    f32x4 bv[2][2];
    EPI_LOOP_COLS { const int col = EPI_COL(bj, n); bv[bj][n] = *(const f32x4*)(b_in + (og ? 3072 + col : 7184 + (col - 1024))); }
    EPI_LOOP_ROWS { const int row = EPI_ROW(ai, m);
      u32x4 hv[2];
      if (og) { EPI_LOOP_BJ { hv[bj] = *(const u32x4*)(H + (size_t)row * 1024 + EPI_COL(bj, 0)); } }
      EPI_LOOP_BJ { const int col = EPI_COL(bj, 0); f32x4 s0, s1; const f32x4 a0 = acc[ai][bj][m][0] + bv[bj][0], a1 = acc[ai][bj][m][1] + bv[bj][1];
#pragma unroll
        for (int e = 0; e < 4; ++e) { s0[e] = sigmoidf_(a0[e]); s1[e] = sigmoidf_(a1[e]); }
        if (og) { f32x4 h0, h1; unpack8(hv[bj], h0, h1); *(u32x4*)(H + (size_t)row * 1024 + col) = pack8(h0 * s0, h1 * s1); }
        else *(u32x4*)(G + (size_t)row * 2048 + (col - 1024)) = pack8(s0, s1); } }
  }
};
template <int SECOND> struct EpiMerge {
  bf16_t* T; const bf16_t* G;
  __device__ __forceinline__ void operator()(const AccT& acc, const Unit& u, int wr, int wc, int fr, int fq) const {
#pragma unroll
    for (int ai = 0; ai < 2; ++ai)
#pragma unroll
      for (int m2 = 0; m2 < 2; ++m2) {
        u32x4 gv[2][2], tv[2][2];
#pragma unroll
        for (int mm = 0; mm < 2; ++mm) { const int row = EPI_ROW(ai, 2 * m2 + mm);
          EPI_LOOP_BJ { const int col = EPI_COL(bj, 0); gv[mm][bj] = *(const u32x4*)(G + (size_t)row * 2048 + SECOND * 1024 + col);
            if (SECOND) tv[mm][bj] = *(const u32x4*)(T + (size_t)row * 1024 + col); } }
#pragma unroll
        for (int mm = 0; mm < 2; ++mm) { const int m = 2 * m2 + mm; const int row = EPI_ROW(ai, m);
          EPI_LOOP_BJ { const int col = EPI_COL(bj, 0); f32x4 g0, g1; unpack8(gv[mm][bj], g0, g1);
            f32x4 v0 = g0 * acc[ai][bj][m][0], v1 = g1 * acc[ai][bj][m][1];
            if (SECOND) { f32x4 t0, t1; unpack8(tv[mm][bj], t0, t1); v0 += t0; v1 += t1; }
            *(u32x4*)(T + (size_t)row * 1024 + col) = pack8(v0, v1); } } }
  }
};
struct EpiOut {
  const float* xp; const float* xs; const float* per; const float* pec; const float* mod; const float* n2w; float* X1; bf16_t* A2; float* ssq;
  __device__ __forceinline__ void operator()(const AccT& acc, const Unit& u, int wr, int wc, int fr, int fq) const {
    const int cb = cond_of_row(u.pm * 256); const float* md = mod + cb * 6144; const bool smp = (u.pm * 256) >= NCTX;
    f32x4 g1v[2][2], k2v[2][2];
    EPI_LOOP_COLS { const int col = EPI_COL(bj, n); g1v[bj][n] = *(const f32x4*)(md + 2048 + col); k2v[bj][n] = *(const f32x4*)(n2w + col) * (*(const f32x4*)(md + 4096 + col) + 1.0f); }
    EPI_LOOP_ROWS { const int row = EPI_ROW(ai, m); float ss = 0.f;
#pragma unroll
      for (int bj = 0; bj < 2; ++bj) {
        f32x4 x0[2];
        if (!smp) {
#pragma unroll
          for (int n = 0; n < 2; ++n) x0[n] = *(const f32x4*)(xp + (size_t)row * 1024 + EPI_COL(bj, n)); }
        else { const int r2 = row - NCTX, t = r2 & 2047; f32x4 pe[2];
#pragma unroll
          for (int n = 0; n < 2; ++n) { const int col = EPI_COL(bj, n); x0[n] = *(const f32x4*)(xs + (size_t)r2 * 1024 + col);
            pe[n] = (col < 512) ? *(const f32x4*)(per + (t >> 6) * 512 + col) : *(const f32x4*)(pec + (t & 63) * 512 + (col - 512)); }
#pragma unroll
          for (int n = 0; n < 2; ++n) x0[n] += pe[n]; }
        f32x4 x1[2];
#pragma unroll
        for (int n = 0; n < 2; ++n) { x1[n] = x0[n] + g1v[bj][n] * acc[ai][bj][m][n]; *(f32x4*)(X1 + (size_t)row * 1024 + EPI_COL(bj, n)) = x1[n];
          ss += x1[n][0] * x1[n][0] + x1[n][1] * x1[n][1] + x1[n][2] * x1[n][2] + x1[n][3] * x1[n][3]; }
        *(u32x4*)(A2 + (size_t)row * 1024 + EPI_COL(bj, 0)) = pack8(x1[0] * k2v[bj][0], x1[1] * k2v[bj][1]); }
      ss += __shfl_xor(ss, 16); ss += __shfl_xor(ss, 32);
      if (fq == 0) ssq[(size_t)row * 16 + u.pn * 4 + wc] = ss; }
  }
};
struct EpiFF1 {
  int row0; const float* ssq; const float* c1; bf16_t* Hd;
  __device__ __forceinline__ void operator()(const AccT& acc, const Unit& u, int wr, int wc, int fr, int fq) const {
    const int cb = cond_of_row(row0 + u.pm * 256); const float* cc = c1 + cb * 4096;
    f32x4 cv[2][2];
    EPI_LOOP_COLS { cv[bj][n] = *(const f32x4*)(cc + EPI_COL(bj, n)); }
    float rs[2][4];
    EPI_LOOP_ROWS { const float* sp = ssq + (size_t)(row0 + EPI_ROW(ai, m)) * 16;
      const f32x4 st = (*(const f32x4*)sp + *(const f32x4*)(sp + 4)) + (*(const f32x4*)(sp + 8) + *(const f32x4*)(sp + 12));
      rs[ai][m] = rsqrtf((st[0] + st[1] + st[2] + st[3]) * (1.0f / 1024.0f) + 1e-6f); }
    EPI_LOOP_ROWS { const int rl = EPI_ROW(ai, m); const float rstd = rs[ai][m];
      EPI_LOOP_BJ { f32x4 v0 = acc[ai][bj][m][0] * rstd + cv[bj][0], v1 = acc[ai][bj][m][1] * rstd + cv[bj][1];
#pragma unroll
        for (int e = 0; e < 4; ++e) { const float r0 = fmaxf(v0[e], 0.f), r1 = fmaxf(v1[e], 0.f); v0[e] = r0 * r0; v1[e] = r1 * r1; }
        *(u32x4*)(Hd + (size_t)rl * 4096 + EPI_COL(bj, 0)) = pack8(v0, v1); } }
  }
};
struct EpiFF2 {
  int row0; const float* mod; const float* b2; float* X; float* P;
  __device__ __forceinline__ void operator()(const AccT& acc, const Unit& u, int wr, int wc, int fr, int fq) const {
    if (u.ks == 1) {
      EPI_LOOP_ROWS { const int rl = EPI_ROW(ai, m); EPI_LOOP_COLS { *(f32x4*)(P + (size_t)rl * 1024 + EPI_COL(bj, n)) = acc[ai][bj][m][n]; } }
    } else {
    const int cb = cond_of_row(row0 + u.pm * 256); const float* md = mod + cb * 6144;
    f32x4 g2v[2][2], bbv[2][2];
    EPI_LOOP_COLS { const int col = EPI_COL(bj, n); g2v[bj][n] = *(const f32x4*)(md + 5120 + col); bbv[bj][n] = *(const f32x4*)(b2 + col); }
#pragma unroll
    for (int ai = 0; ai < 2; ++ai)
#pragma unroll
      for (int m2 = 0; m2 < 2; ++m2) {
        f32x4 xv[2][2][2];
#pragma unroll
        for (int mm = 0; mm < 2; ++mm) { const int row = row0 + EPI_ROW(ai, 2 * m2 + mm); EPI_LOOP_COLS { xv[mm][bj][n] = *(const f32x4*)(X + (size_t)row * 1024 + EPI_COL(bj, n)); } }
#pragma unroll
        for (int mm = 0; mm < 2; ++mm) { const int m = 2 * m2 + mm; const int row = row0 + EPI_ROW(ai, m);
          EPI_LOOP_COLS { const int col = EPI_COL(bj, n); *(f32x4*)(X + (size_t)row * 1024 + col) = xv[mm][bj][n] + g2v[bj][n] * (acc[ai][bj][m][n] + bbv[bj][n]); } } }
    }
  }
};

template <class Epi> __device__ __forceinline__ void run_gemm(LP lds, const bf16_t* A, const bf16_t* Bt, int M, int N, int K, const Epi& E, int nks = 1) {
  pg8::Gemm g; g.A = A; g.Bt = Bt; g.M = M; g.N = N; g.K = K / nks; g.ld = K; g.nks = nks;
  pg8::StaticOrder S; S.init(M, N, nks, (int)gridDim.x, (int)blockIdx.x);
  pg8::gemm_phase<Epi>(lds, g, S, E);
}

__device__ void transpose_tile(const float* __restrict__ src, int ld, int col0, int k0, bf16_t* __restrict__ dst, int K, int drow0, LAS float* tile) {
  const int t = opaque_tid();
  f32x4 v[4];
#pragma unroll
  for (int i = 0; i < 4; ++i) { const int idx = t + 512 * i, kr = idx >> 5, c4 = idx & 31; v[i] = *(const f32x4*)(src + (size_t)(k0 + kr) * ld + col0 + 4 * c4); }
#pragma unroll
  for (int i = 0; i < 4; ++i) { const int idx = t + 512 * i, kr = idx >> 5, c4 = idx & 31; LAS float* tp = tile + kr * 129 + 4 * c4; tp[0] = v[i][0]; tp[1] = v[i][1]; tp[2] = v[i][2]; tp[3] = v[i][3]; }
  __syncthreads();
  const int kb = t & 7;
#pragma unroll
  for (int i = 0; i < 2; ++i) { const int c = (t >> 3) + 64 * i; const LAS float* tp = tile + (kb * 8) * 129 + c; u32x4 o;
    o.x = pack2(tp[0], tp[129]); o.y = pack2(tp[2 * 129], tp[3 * 129]); o.z = pack2(tp[4 * 129], tp[5 * 129]); o.w = pack2(tp[6 * 129], tp[7 * 129]);
    *(u32x4*)(dst + (size_t)(drow0 + c) * K + k0 + kb * 8) = o; }
  __syncthreads();
}
template <int SILU> __device__ void matvec9_unit(const float* v0, const float* v1, int v1stride, const float* __restrict__ W, int ldw, const float* bias, float* out, int ldo, int col0, LAS float* lf) {
  const int t = opaque_tid(), lane = t & 63, wid = t >> 6;
  LAS float* sv = lf; LAS float* red = lf + 9216;
  for (int i = t; i < 9216; i += 512) { const int b = i >> 10, k = i & 1023; float x = (b == 0) ? v0[k] : v1[(size_t)(b - 1) * v1stride + k]; if (SILU) x = x / (1.0f + __expf(-x)); sv[i] = x; }
  __syncthreads();
  const int c4 = t & 7, kl = t >> 3;
  f32x4 w[16];
#pragma unroll
  for (int i = 0; i < 16; ++i) w[i] = *(const f32x4*)(W + (size_t)(kl + 64 * i) * ldw + col0 + 4 * c4);
  f32x4 acc[9];
#pragma unroll
  for (int b = 0; b < 9; ++b) acc[b] = (f32x4){0.f, 0.f, 0.f, 0.f};
#pragma unroll
  for (int i = 0; i < 16; ++i)
#pragma unroll
    for (int b = 0; b < 9; ++b) acc[b] += w[i] * sv[b * 1024 + kl + 64 * i];
#pragma unroll
  for (int b = 0; b < 9; ++b)
#pragma unroll
    for (int e = 0; e < 4; ++e) { float x = acc[b][e]; x += __shfl_xor(x, 8); x += __shfl_xor(x, 16); x += __shfl_xor(x, 32); acc[b][e] = x; }
  if (lane < 8) {
#pragma unroll
    for (int b = 0; b < 9; ++b) *(LAS f32x4*)(red + (wid * 9 + b) * 32 + 4 * lane) = acc[b]; }
  __syncthreads();
  if (t < 288) { const int b = t >> 5, cc = t & 31; float s = bias[col0 + cc];
#pragma unroll
    for (int pz = 0; pz < 8; ++pz) s += red[(pz * 9 + b) * 32 + cc];
    out[(size_t)b * ldo + col0 + cc] = s; }
  __syncthreads();
}

__device__ void phase0(const Params& p, LP lds) {
  unsigned char* ws = p.ws; LAS float* lf = (LAS float*)lds;
  const int tid0 = opaque_tid(); const int wid = tid0 >> 6, lane = tid0 & 63;
  for (int unit = blockIdx.x; unit < 576; unit += gridDim.x) {
    if (unit < 192) {
      matvec9_unit<1>(p.in[6], p.in[5], 1024, p.in[7], 6144, p.in[8], (float*)(ws + OFF_MOD), 6144, unit * 32, lf);
    } else if (unit < 480) {
      const int row = (unit - 192) * 8 + wid; const bool smp = row < 2048; const int L = smp ? 2048 : 256, t = smp ? row : row - 2048;
      const float* w1 = p.in[14]; const float* b1 = p.in[15]; const float* fr1 = p.in[16]; const float* w2 = p.in[17]; const float* b2 = p.in[18]; const float* fr2 = p.in[19];
      float a = b1[lane] + (float)t / (float)(L - 1) * w1[lane];
      const float base = (6.283185307179586f / (float)L) * (float)t;
      float cs = 0.f, sn = 0.f; if (lane < 16) { const float ang = base * (float)(lane + 1); cs = cosf(ang); sn = sinf(ang); }
#pragma unroll
      for (int i = 0; i < 16; ++i) a += __shfl(cs, i) * w1[(1 + i) * 64 + lane] + __shfl(sn, i) * w1[(17 + i) * 64 + lane];
      const float h1 = sinf(fr1[lane] * a);
      float a2 = b2[lane];
#pragma unroll 16
      for (int j = 0; j < 64; ++j) a2 += __shfl(h1, j) * w2[j * 64 + lane];
      const float h2 = sinf(fr2[lane] * a2);
      float* dst = (float*)(ws + (smp ? OFF_H2S : OFF_H2C)); dst[(size_t)t * 64 + lane] = h2;
    } else {
      const int r = unit - 480, c = tid0; const int pos = r < 32 ? r : r - 32; const int i = c & 255;
      const float omega = 1.0f / powf(10000.0f, (float)i / 256.0f); const float a = (float)pos * omega; const float v = c < 256 ? sinf(a) : cosf(a);
      float* dst = (float*)(ws + (r < 32 ? OFF_PER : OFF_PEC)); dst[(size_t)pos * 512 + c] = v;
    }
  }
}
__device__ void weight_tiles(const Params& p, LP lds, int lo, int hi, int upper) {
  unsigned char* ws = p.ws; LAS float* lf = (LAS float*)lds;
  const int nh = upper ? ((int)gridDim.x >> 1) : 0;
  if ((int)blockIdx.x < nh) return;
  for (int tu = lo + (int)blockIdx.x - nh; tu < hi; tu += (int)gridDim.x - nh) {
    const float* src; int ld, K, col0, k0, drow0; bf16_t* dst;
    if (tu < 1152) { const int nt = tu >> 4, kt = tu & 15; const int r = nt * 128; src = p.in[10]; ld = INC; K = 1024; k0 = kt * 64; drow0 = r; dst = (bf16_t*)(ws + OFF_WT);
      col0 = r < 3072 ? r : (r < 6144 ? 4112 + (r - 3072) : (r < 7168 ? 3072 + (r - 6144) : 7184 + (r - 7168))); }
    else if (tu < 1536) { const int v = tu - 1152, w = v >> 7, q = v & 127; src = p.in[23 + w]; ld = 1024; K = 1024; k0 = (q & 15) * 64; col0 = (q >> 4) * 128; drow0 = col0; dst = (bf16_t*)(ws + (w == 0 ? OFF_WBM : (w == 1 ? OFF_WBH : OFF_WOUT))); }
    else if (tu < 2048) { const int q = tu - 1536; src = p.in[27]; ld = 4096; K = 1024; k0 = (q & 15) * 64; col0 = (q >> 4) * 128; drow0 = col0; dst = (bf16_t*)(ws + OFF_W1T); }
    else { const int q = tu - 2048; src = p.in[29]; ld = 1024; K = 4096; k0 = (q & 63) * 64; col0 = (q >> 6) * 128; drow0 = col0; dst = (bf16_t*)(ws + OFF_W2T); }
    transpose_tile(src, ld, col0, k0, dst, K, drow0, lf);
  }
}

__device__ void phase1(const Params& p, LP lds) {
  unsigned char* ws = p.ws;
  int tid_ = threadIdx.x; asm volatile("" : "+v"(tid_));
  const int tid = tid_, wid = tid >> 6, lane = tid & 63;
  const float* mod = (const float*)(ws + OFF_MOD);
  LAS float* wg = (LAS float*)lds;
  if ((int)blockIdx.x < 1536) {
    f32x4 gw[8];
#pragma unroll
    for (int i = 0; i < 8; ++i) { const int idx = tid + 512 * i, k = idx >> 2, q = idx & 3; gw[i] = *(const f32x4*)(p.in[10] + (size_t)k * INC + 4096 + 4 * q); }
#pragma unroll
    for (int i = 0; i < 8; ++i) { const int idx = tid + 512 * i, k = idx >> 2, q = idx & 3; wg[(4 * q) * 1024 + k] = gw[i][0]; wg[(4 * q + 1) * 1024 + k] = gw[i][1]; wg[(4 * q + 2) * 1024 + k] = gw[i][2]; wg[(4 * q + 3) * 1024 + k] = gw[i][3]; }
    __syncthreads();
  }
  for (int unit = blockIdx.x; unit < 1536; unit += gridDim.x) {
    const int tidn = opaque_tid(); const int wid = tidn >> 6, lane = tidn & 63;
    const int row0 = unit * 16 + wid * 2; const int cb = cond_of_row(row0); const float* md = mod + cb * 6144; const bool smp = row0 >= NCTX;
    f32x4 v[2][4]; float rstd[2];
#pragma unroll
    for (int r = 0; r < 2; ++r) { const int row = row0 + r; const float* xr; int t = 0;
      if (!smp) xr = p.in[0] + (size_t)row * 1024; else { xr = p.in[1] + (size_t)(row - NCTX) * 1024; t = (row - NCTX) & 2047; }
      const float* per = (const float*)(ws + OFF_PER) + (t >> 6) * 512; const float* pec = (const float*)(ws + OFF_PEC) + (t & 63) * 512;
      float ss = 0.f;
#pragma unroll
      for (int i = 0; i < 4; ++i) { const int col = 4 * lane + 256 * i; v[r][i] = *(const f32x4*)(xr + col);
        if (smp) v[r][i] += (col < 512) ? *(const f32x4*)(per + col) : *(const f32x4*)(pec + col - 512);
        ss += v[r][i][0] * v[r][i][0] + v[r][i][1] * v[r][i][1] + v[r][i][2] * v[r][i][2] + v[r][i][3] * v[r][i][3]; }
      ss = wave_sum(ss); rstd[r] = rsqrtf(ss * (1.0f / 1024.0f) + 1e-6f); }
    const float* n1w = p.in[9];
    float ga[32];
#pragma unroll
    for (int g = 0; g < 32; ++g) ga[g] = 0.f;
#pragma unroll
    for (int i = 0; i < 4; ++i) { const int col = 4 * lane + 256 * i;
      const f32x4 w = *(const f32x4*)(n1w + col), sc = *(const f32x4*)(md + 1024 + col), sh = *(const f32x4*)(md + col);
      const f32x4 ws1 = w * (sc + 1.0f);
      f32x4 h[2];
#pragma unroll
      for (int r = 0; r < 2; ++r) { h[r] = v[r][i] * rstd[r] * ws1 + sh;
        u32x2 o; o.x = pack2(h[r][0], h[r][1]); o.y = pack2(h[r][2], h[r][3]); *(u32x2*)((bf16_t*)(ws + OFF_HN) + (size_t)(row0 + r) * 1024 + col) = o; }
#pragma unroll
      for (int g = 0; g < 16; ++g) { const f32x4 wv = *(const LAS f32x4*)(wg + g * 1024 + col);
#pragma unroll
        for (int r = 0; r < 2; ++r) ga[r * 16 + g] += h[r][0] * wv[0] + h[r][1] * wv[1] + h[r][2] * wv[2] + h[r][3] * wv[3]; }
      asm volatile("" ::: "memory"); }
#pragma unroll
    for (int off = 16; off >= 1; off >>= 1) { const bool hi = (lane & off) != 0;
#pragma unroll
      for (int i = 0; i < off; ++i) { const float send = hi ? ga[i] : ga[i + off]; const float keep = hi ? ga[i + off] : ga[i]; ga[i] = keep + __shfl_xor(send, off); } }
    const float tot = ga[0] + __shfl_xor(ga[0], 32);
    if (lane < 32) ((float*)(ws + OFF_GT))[(size_t)row0 * 16 + lane] = tot + p.in[11][4096 + (lane & 15)];
  }
  __syncthreads();
}
__device__ void filters_upper_half(const Params& p, LP lds) {
  unsigned char* ws = p.ws; const int nh = (int)gridDim.x >> 1;
  if ((int)blockIdx.x < nh) return;
  LAS float* w3s = (LAS float*)lds;
  for (int v = (int)blockIdx.x - nh; v < 320; v += (int)gridDim.x - nh) {
    const int tid = opaque_tid();
    const bool smp = v < 256; const int L = smp ? 2048 : 256; const int tt = smp ? (v >> 6) : 0, cgp = v & 63; const int t = tt * 512 + tid;
    { const f32x4 x = *(const f32x4*)(p.in[20] + (size_t)(tid >> 3) * 2048 + cgp * 32 + 4 * (tid & 7)); LAS float* wp = w3s + (4 * (tid & 7)) * 64 + (tid >> 3);
      wp[0] = x[0]; wp[64] = x[1]; wp[128] = x[2]; wp[192] = x[3]; }
    __syncthreads();
    if (t < L) {
      const float* H2 = (const float*)(ws + (smp ? OFF_H2S : OFF_H2C)) + (size_t)t * 64;
      f32x4 h2[16];
#pragma unroll
      for (int i = 0; i < 16; ++i) h2[i] = *(const f32x4*)(H2 + 4 * i);
      const float dist = fabsf((float)t - (float)(L / 2)) / (float)(L / 2);
      float* HF = (float*)(ws + (smp ? OFF_HFS : OFF_HFC)) + (size_t)(cgp * 32) * L + t;
#pragma unroll 1
      for (int j = 0; j < 32; ++j) {
        f32x4 a = {0.f, 0.f, 0.f, 0.f};
#pragma unroll
        for (int i = 0; i < 16; ++i) a += *(const LAS f32x4*)(w3s + j * 64 + 4 * i) * h2[i];
        const int c = (cgp * 32 + j) & 1023;
        const float dmin = -3.0701134573253946f, dmax = -15.350567286626973f;
        const float delta = fabsf(dmin + (dmax - dmin) * ((float)c / 1023.0f));
        HF[(size_t)j * L] = ((a[0] + a[1]) + (a[2] + a[3])) * __expf(-dist * delta); }
    }
    __syncthreads();
  }
}
__device__ void c1_upper_half(const Params& p, LP lds) {
  unsigned char* ws = p.ws; const float* mod = (const float*)(ws + OFF_MOD); const int nh = (int)gridDim.x >> 1;
  if ((int)blockIdx.x < nh) return;
  for (int u = (int)blockIdx.x - nh; u < 128; u += (int)gridDim.x - nh)
    matvec9_unit<0>(mod + 3072, mod + 6144 + 3072, 6144, p.in[27], 4096, p.in[28], (float*)(ws + OFF_C1), 4096, u * 32, (LAS float*)lds);
}

__device__ __forceinline__ bf16x8 tr_frag(LP base, int k0, int m0, int pitch  , int l15, int g) {
  const int q = l15 >> 2, pp = l15 & 3;
  LP a = base + ((k0 + 8 * g + q) * pitch + m0 + 4 * pp) * 2;
  const s16x4 lo = __builtin_amdgcn_ds_read_tr16_b64_v4i16((LAS s16x4*)a);
  const s16x4 hi = __builtin_amdgcn_ds_read_tr16_b64_v4i16((LAS s16x4*)(a + 8 * pitch));
  bf16x8 r; r[0] = lo[0]; r[1] = lo[1]; r[2] = lo[2]; r[3] = lo[3]; r[4] = hi[0]; r[5] = hi[1]; r[6] = hi[2]; r[7] = hi[3]; return r;
}
__device__ __forceinline__ bf16x8 tr_at(LP lanebase, int coff  , int pitch_bytes) {
  const s16x4 lo = __builtin_amdgcn_ds_read_tr16_b64_v4i16((LAS s16x4*)(lanebase + coff));
  const s16x4 hi = __builtin_amdgcn_ds_read_tr16_b64_v4i16((LAS s16x4*)(lanebase + coff + 4 * pitch_bytes));
  bf16x8 r; r[0] = lo[0]; r[1] = lo[1]; r[2] = lo[2]; r[3] = lo[3]; r[4] = hi[0]; r[5] = hi[1]; r[6] = hi[2]; r[7] = hi[3]; return r;
}
constexpr int ML_K = 0, ML_V = 67584, ML_P = 86016, ML_C = 120832, ML_T = 157696, ML_TSZ = 1600;
constexpr int KP = 264, VP = 72, PP = 136, CP = 72;

__device__ void mlstm_item(const Params& p, LP lds, int item) {
  const int tid = opaque_tid(), wid = __builtin_amdgcn_readfirstlane(tid >> 6), lane = tid & 63, l15 = lane & 15, g = lane >> 4;
  const bool smp = item < 256; const int uu = smp ? (item >> 2) : ((item - 256) >> 2); const int sl = item & 3;
  const int b = uu >> 3, dir = (uu >> 2) & 1, head = uu & 3;
  const int S = smp ? SEQS : SEQC, nc = S >> 7; const int tok0 = smp ? NCTX + b * SEQS : b * SEQC;
  const bf16_t* qkv = (const bf16_t*)(p.ws + OFF_BIG);
  const float* GT = (const float*)(p.ws + OFF_GT);
  bf16_t* hout = (bf16_t*)((unsigned char*)p.out + (dir ? OUT_HB : OUT_H));
  const int sidx = (b * 2 + dir) * 4 + head;
  const int gi_col = dir * 8 + head, gf_col = dir * 8 + 4 + head;
  f32x4 Cacc[2][4], nacc[2]; float mst0;
  if (smp) {
    const float* C0 = p.in[2] + (size_t)sidx * 65536;
#pragma unroll
    for (int dt = 0; dt < 2; ++dt) {
#pragma unroll
      for (int vt = 0; vt < 4; ++vt) Cacc[dt][vt] = *(const f32x4*)(C0 + (size_t)((2 * wid + dt) * 16 + l15) * 256 + sl * 64 + 16 * vt + 4 * g);
      nacc[dt] = (f32x4){p.in[3][sidx * 256 + (2 * wid + dt) * 16 + l15], 0.f, 0.f, 0.f}; }
    mst0 = p.in[4][sidx];
  } else {
#pragma unroll
    for (int dt = 0; dt < 2; ++dt) {
#pragma unroll
      for (int vt = 0; vt < 4; ++vt) Cacc[dt][vt] = (f32x4){0.f, 0.f, 0.f, 0.f};
      nacc[dt] = (f32x4){0.f, 0.f, 0.f, 0.f}; }
    mst0 = 0.f;
  }
#define TOKC(cc, j) (dir ? (tok0 + S - 1 - ((cc) * 128 + (j))) : (tok0 + (cc) * 128 + (j)))
  const int rt = (wid < 4) ? wid : 11 - wid;
  const int jrow = 16 * rt + l15;
  bf16x8 qf[8]; u32x4 kreg[8], vreg[2]; float g4[4] = {0.f, 0.f, 0.f, 0.f};
#define ML_LOAD_Q(cc) do { const bf16_t* qp = qkv + (size_t)TOKC(cc, jrow) * 3072 + head * 256 + 8 * g; \
    _Pragma("unroll") for (int kk = 0; kk < 8; ++kk) qf[kk] = *(const bf16x8*)(qp + 32 * kk); } while (0)
#define ML_LOAD_KV(cc) do { \
    _Pragma("unroll") for (int i = 0; i < 8; ++i) { const int row = (tid >> 5) + 16 * i; kreg[i] = *(const u32x4*)(qkv + (size_t)TOKC(cc, row) * 3072 + 1024 + head * 256 + (tid & 31) * 8); } \
    _Pragma("unroll") for (int i = 0; i < 2; ++i) { const int row = (tid >> 3) + 64 * i; vreg[i] = *(const u32x4*)(qkv + (size_t)TOKC(cc, row) * 3072 + 2048 + head * 256 + sl * 64 + (tid & 7) * 8); } \
    if (wid == 0) { const float* g0 = GT + (size_t)TOKC(cc, 2 * lane) * 16; const float* g1 = GT + (size_t)TOKC(cc, 2 * lane + 1) * 16; g4[0] = g0[gi_col]; g4[1] = g0[gf_col]; g4[2] = g1[gi_col]; g4[3] = g1[gf_col]; } } while (0)
#define ML_SCAN(tabp, mcur, mnext) do { LAS float* T_ = (LAS float*)(tabp); \
    const float lf0 = fminf(g4[1], 0.f) - log1pf(__expf(-fabsf(g4[1]))), lf1 = fminf(g4[3], 0.f) - log1pf(__expf(-fabsf(g4[3]))); \
    float s_ = lf0 + lf1; \
    _Pragma("unroll") for (int o = 1; o < 64; o <<= 1) { const float t_ = __shfl_up(s_, o); if (lane >= o) s_ += t_; } \
    const float b1_ = s_, b0_ = s_ - lf1; const float u0_ = g4[0] - b0_, u1_ = g4[2] - b1_; \
    float mx_ = fmaxf(u0_, u1_); \
    _Pragma("unroll") for (int o = 1; o < 64; o <<= 1) { const float t_ = __shfl_up(mx_, o); if (lane >= o) mx_ = fmaxf(mx_, t_); } \
    float ex_ = __shfl_up(mx_, 1); if (lane == 0) ex_ = -INFINITY; \
    const float M0_ = fmaxf(mcur, fmaxf(ex_, u0_)), M1_ = fmaxf(mcur, mx_); \
    T_[2 * lane] = u0_; T_[2 * lane + 1] = u1_; T_[128 + 2 * lane] = M0_; T_[128 + 2 * lane + 1] = M1_; T_[256 + 2 * lane] = b0_; T_[256 + 2 * lane + 1] = b1_; \
    const float Ml_ = __shfl(M1_, 63), bl_ = __shfl(b1_, 63); \
    if (lane == 0) { T_[384] = mcur; T_[385] = Ml_; } \
    mnext = bl_ + Ml_; } while (0)
  float mw0 = mst0;
  ML_LOAD_Q(0); ML_LOAD_KV(0);
  if (wid == 0) { float mn; ML_SCAN(lds + ML_T, mw0, mn); mw0 = mn; }
  __syncthreads();
  float m_final = 0.f;
  for (int c = 0; c < nc; ++c) {
    LAS float* T = (LAS float*)(lds + ML_T + (c & 1) * ML_TSZ);
    const float mst = T[384], M_last = T[385];
#pragma unroll
    for (int i = 0; i < 8; ++i) { const int row = (tid >> 5) + 16 * i; *(LAS u32x4*)(lds + ML_K + (row * KP + (tid & 31) * 8) * 2) = kreg[i]; }
#pragma unroll
    for (int i = 0; i < 2; ++i) { const int row = (tid >> 3) + 64 * i; const float w = __expf(T[row] - M_last); const u32x4 v = vreg[i]; u32x4 o;
      o.x = pack2(bflo(v.x) * w, bfhi(v.x) * w); o.y = pack2(bflo(v.y) * w, bfhi(v.y) * w); o.z = pack2(bflo(v.z) * w, bfhi(v.z) * w); o.w = pack2(bflo(v.w) * w, bfhi(v.w) * w);
      *(LAS u32x4*)(lds + ML_V + (row * VP + (tid & 7) * 8) * 2) = o; }
    if (tid < 128) *(LAS unsigned short*)(lds + ML_V + (tid * VP + 64) * 2) = f2bf(__expf(T[tid] - M_last));
#pragma unroll
    for (int dt = 0; dt < 2; ++dt) {
#pragma unroll
      for (int vt = 0; vt < 4; ++vt) { u32x2 w; w.x = pack2(Cacc[dt][vt][0], Cacc[dt][vt][1]); w.y = pack2(Cacc[dt][vt][2], Cacc[dt][vt][3]);
        *(LAS u32x2*)(lds + ML_C + (((2 * wid + dt) * 16 + l15) * CP + 16 * vt + 4 * g) * 2) = w; }
      if (g == 0) *(LAS unsigned short*)(lds + ML_C + (((2 * wid + dt) * 16 + l15) * CP + 64) * 2) = f2bf(nacc[dt][0]); }
    const int qtok = TOKC(c, jrow);
    const bool more = (c + 1 < nc);
    __syncthreads();
    const float Mj = T[128 + jrow], bj = T[256 + jrow]; const float rf = __expf(M_last - Mj), w_inter = __expf(mst - Mj);
    int lq_ = (8 * g + (l15 >> 2)), lp_ = 4 * (l15 & 3); asm volatile("" : "+v"(lq_), "+v"(lp_));
    const LP cB = lds + ML_C + (lq_ * CP + lp_) * 2, vB = lds + ML_V + (lq_ * VP + lp_) * 2, kB = lds + ML_K + (lq_ * KP + lp_ + 32 * wid) * 2;
    const LP pB = lds + ML_P + (jrow * PP + 8 * g) * 2;
    for (int st = 0; st <= rt; ++st) {
      f32x4 s = {0.f, 0.f, 0.f, 0.f};
      bf16x8 kfr[8];
#pragma unroll
      for (int kk = 0; kk < 8; ++kk) kfr[kk] = *(const LAS bf16x8*)(lds + ML_K + ((16 * st + l15) * KP + 32 * kk + 8 * g) * 2);
      __builtin_amdgcn_sched_barrier(0);
#pragma unroll
      for (int kk = 0; kk < 8; ++kk) s = __builtin_amdgcn_mfma_f32_16x16x32_bf16(kfr[kk], qf[kk], s, 0, 0, 0);
      float pv[4];
#pragma unroll
      for (int i = 0; i < 4; ++i) pv[i] = ((16 * st + 4 * g + i) <= jrow) ? s[i] * rf : 0.f;
      u32x2 w; w.x = pack2(pv[0], pv[1]); w.y = pack2(pv[2], pv[3]);
      *(LAS u32x2*)(lds + ML_P + (jrow * PP + 16 * st + 4 * g) * 2) = w;
    }
    if ((rt & 1) == 0) { u32x2 z; z.x = 0u; z.y = 0u; *(LAS u32x2*)(lds + ML_P + (jrow * PP + 16 * (rt + 1) + 4 * g) * 2) = z; }
    if (more) ML_LOAD_KV(c + 1);
    asm volatile("s_waitcnt lgkmcnt(0)" ::: "memory");
    f32x4 ha[5];
#pragma unroll
    for (int vt = 0; vt < 5; ++vt) { f32x4 a = {0.f, 0.f, 0.f, 0.f};
      if (smp || c > 0) {
        bf16x8 cfr[8];
#pragma unroll
        for (int kk = 0; kk < 8; ++kk) cfr[kk] = tr_at(cB, (32 * kk * CP + 16 * vt) * 2, CP * 2);
        __builtin_amdgcn_sched_barrier(0);
#pragma unroll
        for (int kk = 0; kk < 8; ++kk) a = __builtin_amdgcn_mfma_f32_16x16x32_bf16(cfr[kk], qf[kk], a, 0, 0, 0);
        a *= w_inter; }
      ha[vt] = a; }
    for (int k2 = 0; k2 <= (rt >> 1); ++k2) {
      const bf16x8 pf = *(const LAS bf16x8*)(pB + k2 * 64);
      bf16x8 vfr[5];
#pragma unroll
      for (int vt = 0; vt < 5; ++vt) vfr[vt] = tr_at(vB + k2 * (32 * VP * 2), (16 * vt) * 2, VP * 2);
      __builtin_amdgcn_sched_barrier(0);
#pragma unroll
      for (int vt = 0; vt < 5; ++vt) ha[vt] = __builtin_amdgcn_mfma_f32_16x16x32_bf16(vfr[vt], pf, ha[vt], 0, 0, 0); }
    { const float den = __shfl(ha[4][0], l15); const float rdd = 1.0f / fmaxf(fabsf(den), __expf(-(bj + Mj)));
#pragma unroll
      for (int vt = 0; vt < 4; ++vt) { const f32x4 a = ha[vt] * rdd; u32x2 w; w.x = pack2(a[0], a[1]); w.y = pack2(a[2], a[3]);
        *(u32x2*)(hout + (size_t)qtok * 1024 + head * 256 + sl * 64 + 16 * vt + 4 * g) = w; } }
    if (more) ML_LOAD_Q(c + 1);
    const bool need_state = (!smp) || more;
    if (need_state) {
      const float decay = __expf(mst - M_last);
#pragma unroll
      for (int dt = 0; dt < 2; ++dt) {
#pragma unroll
        for (int vt = 0; vt < 4; ++vt) Cacc[dt][vt] *= decay;
        nacc[dt] *= decay; }
#pragma unroll
      for (int ks = 0; ks < 4; ++ks) {
        const bf16x8 kf0 = tr_at(kB, (32 * ks * KP) * 2, KP * 2), kf1 = tr_at(kB, (32 * ks * KP + 16) * 2, KP * 2);
        bf16x8 vfr[5];
#pragma unroll
        for (int vt = 0; vt < 5; ++vt) vfr[vt] = tr_at(vB, (32 * ks * VP + 16 * vt) * 2, VP * 2);
        __builtin_amdgcn_sched_barrier(0);
#pragma unroll
        for (int vt = 0; vt < 4; ++vt) { Cacc[0][vt] = __builtin_amdgcn_mfma_f32_16x16x32_bf16(vfr[vt], kf0, Cacc[0][vt], 0, 0, 0); Cacc[1][vt] = __builtin_amdgcn_mfma_f32_16x16x32_bf16(vfr[vt], kf1, Cacc[1][vt], 0, 0, 0); }
        nacc[0] = __builtin_amdgcn_mfma_f32_16x16x32_bf16(vfr[4], kf0, nacc[0], 0, 0, 0); nacc[1] = __builtin_amdgcn_mfma_f32_16x16x32_bf16(vfr[4], kf1, nacc[1], 0, 0, 0);
      }
    }
    if (wid == 0 && more) { float mn; ML_SCAN(lds + ML_T + ((c + 1) & 1) * ML_TSZ, mw0, mn); mw0 = mn; }
    m_final = T[256 + 127] + M_last;
    __syncthreads();
  }
#undef ML_LOAD_Q
#undef ML_LOAD_KV
#undef ML_SCAN
#undef TOKC
  if (!smp) {
    float* oC = p.out + OUTF_C + (size_t)sidx * 65536;
#pragma unroll
    for (int dt = 0; dt < 2; ++dt) {
#pragma unroll
      for (int vt = 0; vt < 4; ++vt) *(f32x4*)(oC + (size_t)((2 * wid + dt) * 16 + l15) * 256 + sl * 64 + 16 * vt + 4 * g) = Cacc[dt][vt];
      if (sl == 0 && g == 0) p.out[OUTF_N + (size_t)sidx * 256 + (2 * wid + dt) * 16 + l15] = nacc[dt][0]; }
    if (sl == 0 && tid == 0) p.out[OUTF_M + sidx] = m_final;
  }
}

__device__ void combine_rows(const Params& p) {
  const int tid0 = opaque_tid(); const int wid = tid0 >> 6, lane = tid0 & 63;
  bf16_t* H = (bf16_t*)((unsigned char*)p.out + OUT_H); const bf16_t* HB = (const bf16_t*)((unsigned char*)p.out + OUT_HB); const float* nw = p.in[22];
  f32x4 wv[4];
#pragma unroll
  for (int i = 0; i < 4; ++i) wv[i] = *(const f32x4*)(nw + 16 * lane + 4 * i);
  const int nh = (int)gridDim.x >> 1;
  if ((int)blockIdx.x < nh) return;
  for (int unit = (int)blockIdx.x - nh; unit < 768; unit += (int)gridDim.x - nh) {
    const int row0 = unit * 32 + wid * 4;
    u32x4 a[4][2], bq[4][2];
#pragma unroll
    for (int r = 0; r < 4; ++r)
#pragma unroll
      for (int i = 0; i < 2; ++i) { a[r][i] = *(const u32x4*)(H + (size_t)(row0 + r) * 1024 + 16 * lane + 8 * i); bq[r][i] = *(const u32x4*)(HB + (size_t)(row0 + r) * 1024 + 16 * lane + 8 * i); }
#pragma unroll
    for (int r = 0; r < 4; ++r) {
      f32x4 v[4]; float ss = 0.f;
#pragma unroll
      for (int i = 0; i < 2; ++i) { f32x4 x0, x1, y0, y1; unpack8(a[r][i], x0, x1); unpack8(bq[r][i], y0, y1); v[2 * i] = x0 + y0; v[2 * i + 1] = x1 + y1; }
#pragma unroll
      for (int i = 0; i < 4; ++i) ss += v[i][0] * v[i][0] + v[i][1] * v[i][1] + v[i][2] * v[i][2] + v[i][3] * v[i][3];
      ss += __shfl_xor(ss, 1); ss += __shfl_xor(ss, 2); ss += __shfl_xor(ss, 4); ss += __shfl_xor(ss, 8);
      const float rr = rsqrtf(ss * (1.0f / 256.0f) + 1e-6f);
#pragma unroll
      for (int i = 0; i < 2; ++i) *(u32x4*)(H + (size_t)(row0 + r) * 1024 + 16 * lane + 8 * i) = pack8(v[2 * i] * rr * wv[2 * i], v[2 * i + 1] * rr * wv[2 * i + 1]);
    }
  }
}

constexpr int HY_WAVE = 18816, HY_HR = 0, HY_ZA = 8576, HY_ZB = 8576 + 5120;
__device__ void hyena_item(const Params& p, LP lds, int item) {
  const int tid = opaque_tid(), wid = __builtin_amdgcn_readfirstlane(tid >> 6), lane = tid & 63, n31 = lane & 31, hh = lane >> 5;
  const bool smp = item < 1024; const int it = smp ? item : item - 1024; const int bset = it >> 7, cgp = it & 127; const int c = cgp * 8 + wid;
  const int L = smp ? 2048 : 256, lgL = smp ? 11 : 8, nblk = L >> 5, lgnb = lgL - 5, ntok = smp ? 2048 : 1024, ntile = smp ? 2 : 1, dmax = L >> 6;
  const int tok0 = smp ? NCTX + bset * 2048 : bset * 1024;
  LP wl = lds + wid * HY_WAVE; LAS float* hr = (LAS float*)(wl + HY_HR);
  const float* HFp = (const float*)(p.ws + (smp ? OFF_HFS : OFF_HFC));
  const bf16_t* UT = (const bf16_t*)(p.ws + OFF_BIG);
  const float* cw = p.in[12]; const float* cbv = p.in[13]; const float* skp = p.in[21];
  { const int uc = 2048 + c; const float w0 = cw[uc], w1 = cw[3072 + uc], w2 = cw[6144 + uc], cb = cbv[uc]; const bf16_t* src = UT + (size_t)uc * NTOK + tok0;
    u32x4 vv[4]; float pvv[4], nxv[4];
#pragma unroll
    for (int i = 0; i < 4; ++i) { const int base = lane * 8 + 512 * i; vv[i] = (u32x4){0u, 0u, 0u, 0u}; pvv[i] = 0.f; nxv[i] = 0.f;
      if (base < ntok) { vv[i] = *(const u32x4*)(src + base); const int tl = base & (L - 1);
        if (tl != 0) pvv[i] = bf2f(src[base - 1]); if (tl + 8 != L) nxv[i] = bf2f(src[base + 8]); } }
#pragma unroll
    for (int i = 0; i < 4; ++i) { const int base = lane * 8 + 512 * i;
      if (base < ntok) { const u32x4 v = vv[i];
        float u[10]; u[0] = pvv[i]; u[1] = bflo(v.x); u[2] = bfhi(v.x); u[3] = bflo(v.y); u[4] = bfhi(v.y); u[5] = bflo(v.z); u[6] = bfhi(v.z); u[7] = bflo(v.w); u[8] = bfhi(v.w); u[9] = nxv[i];
        float o[8];
#pragma unroll
        for (int e = 0; e < 8; ++e) o[e] = cb + w0 * u[e] + w1 * u[e + 1] + w2 * u[e + 2];
        u32x4 w; w.x = pack2(o[0], o[1]); w.y = pack2(o[2], o[3]); w.z = pack2(o[4], o[5]); w.w = pack2(o[6], o[7]);
        *(LAS u32x4*)(wl + HY_ZA + ((base >> 5) * 40 + (base & 31)) * 2) = w; } } }
  const int HRP = L + 96;
  f32x4 fvN[8];
#define HY_FLOAD(o) do { const float* src_ = HFp + (size_t)((o) * 1024 + c) * L; \
    _Pragma("unroll") for (int i = 0; i < 8; ++i) { const int q = lane + 64 * i; fvN[i] = (4 * q < L) ? *(const f32x4*)(src_ + 4 * q) : (f32x4){0.f, 0.f, 0.f, 0.f}; } } while (0)
  HY_FLOAD(0);
  for (int ord = 0; ord < 2; ++ord) {
    { float sa = 0.f;
      f32x4 fv[8];
#pragma unroll
      for (int i = 0; i < 8; ++i) fv[i] = fvN[i];
#pragma unroll
      for (int i = 0; i < 8; ++i) sa += (fabsf(fv[i][0]) + fabsf(fv[i][1])) + (fabsf(fv[i][2]) + fabsf(fv[i][3]));
      sa = wave_sum(sa); const float inv = 1.0f / (sa + 1e-6f);
      asm volatile("s_waitcnt lgkmcnt(0)" ::: "memory");
      LAS bf16_t* E = (LAS bf16_t*)hr; LAS bf16_t* O = E + HRP;
#pragma unroll
      for (int i = 0; i < 8; ++i) { const int q = lane + 64 * i;
        if (4 * q < L) {
#pragma unroll
          for (int e = 0; e < 4; ++e) { const int yy = L - 1 - (4 * q + e); const bf16_t v = f2bf(fv[i][e] * inv); E[32 + yy] = v; O[31 + yy] = v; } } }
      if (lane < 32) { E[lane] = 0; E[32 + L + lane] = 0; O[31 + L + lane] = 0; if (lane < 31) O[lane] = 0; }
      if (lane < 33) O[HRP - 33 + lane] = 0;
      asm volatile("s_waitcnt lgkmcnt(0)" ::: "memory"); }
    if (ord == 0) HY_FLOAD(1);
    LP zin = wl + (ord == 0 ? HY_ZA : HY_ZB); LP zout = wl + (ord == 0 ? HY_ZB : HY_ZA);
    const int gc = ord * 1024 + c; const float w0 = cw[gc], w1 = cw[3072 + gc], w2 = cw[6144 + gc], cb = cbv[gc], sk = skp[ord * 1024 + c];
    const bf16_t* gsrc = UT + (size_t)gc * NTOK + tok0;
    u32x4 gv[4]; unsigned gpv[4], gnx[4];
#pragma unroll
    for (int i = 0; i < 4; ++i) { const int base = lane * 8 + 512 * i; gv[i] = (u32x4){0u, 0u, 0u, 0u}; gpv[i] = 0u; gnx[i] = 0u;
      if (base < ntok) { gv[i] = *(const u32x4*)(gsrc + base); const int tl = base & (L - 1);
        if (tl != 0) gpv[i] = gsrc[base - 1]; if (tl + 8 != L) gnx[i] = gsrc[base + 8]; } }
    f32x16 accs[2];
#pragma unroll
    for (int o2 = 0; o2 < 2; ++o2)
#pragma unroll
      for (int r = 0; r < 16; ++r) accs[o2][r] = 0.f;
    LP fb = wl + HY_HR + ((n31 & 1) ? 0 : (HRP * 2 - 2)) + 2 * ((L >> 1) - 1 - n31 + 8 * hh + 32);
    int cbl[2], ca[2];
#pragma unroll
    for (int ot = 0; ot < 2; ++ot) { const int col = 32 * ot + n31; cbl[ot] = (col >> lgnb) << lgnb; ca[ot] = col & (nblk - 1); }
    const bool two = (ntile == 2);
    {
      LP zero = wl + HY_HR + 16 * hh;
      LP ap = fb + 64 * dmax;
      int bbr0 = ca[0] + dmax, bbr1 = ca[1] + dmax;
      LP bp0 = zin + ((cbl[0] + bbr0) * 40 + 8 * hh) * 2, bp1 = zin + ((cbl[1] + bbr1) * 40 + 8 * hh) * 2;
      for (int d = -dmax; d <= dmax; ++d) {
        u32x4 w0v, w1v;
        w0v.x = *(const LAS unsigned*)(ap); w0v.y = *(const LAS unsigned*)(ap + 4); w0v.z = *(const LAS unsigned*)(ap + 8); w0v.w = *(const LAS unsigned*)(ap + 12);
        w1v.x = *(const LAS unsigned*)(ap + 32); w1v.y = *(const LAS unsigned*)(ap + 36); w1v.z = *(const LAS unsigned*)(ap + 40); w1v.w = *(const LAS unsigned*)(ap + 44);
        const bf16x8 af0 = __builtin_bit_cast(bf16x8, w0v), af1 = __builtin_bit_cast(bf16x8, w1v);
        LP q0 = ((unsigned)bbr0 < (unsigned)nblk) ? bp0 : zero;
        LP q1 = (two && ((unsigned)bbr1 < (unsigned)nblk)) ? bp1 : zero;
        const bf16x8 b00 = *(const LAS bf16x8*)q0, b01 = *(const LAS bf16x8*)(q0 + 32);
        const bf16x8 b10 = *(const LAS bf16x8*)q1, b11 = *(const LAS bf16x8*)(q1 + 32);
        __builtin_amdgcn_sched_barrier(0);
        accs[0] = __builtin_amdgcn_mfma_f32_32x32x16_bf16(af0, b00, accs[0], 0, 0, 0);
        if (two) accs[1] = __builtin_amdgcn_mfma_f32_32x32x16_bf16(af0, b10, accs[1], 0, 0, 0);
        accs[0] = __builtin_amdgcn_mfma_f32_32x32x16_bf16(af1, b01, accs[0], 0, 0, 0);
        if (two) accs[1] = __builtin_amdgcn_mfma_f32_32x32x16_bf16(af1, b11, accs[1], 0, 0, 0);
        ap -= 64; bbr0 -= 1; bbr1 -= 1; bp0 -= 80; bp1 -= 80;
      }
    }
#pragma unroll
    for (int ot = 0; ot < 2; ++ot) {
      if (ot >= ntile) continue;
      const f32x16 acc = accs[ot];
#pragma unroll
      for (int rg = 0; rg < 4; ++rg) {
        const int zo = (((cbl[ot] + ca[ot]) * 40) + 8 * rg + 4 * hh) * 2;
        const u32x2 zv = *(const LAS u32x2*)(zin + zo);
        u32x2 w; w.x = pack2(acc[4 * rg] + sk * bflo(zv.x), acc[4 * rg + 1] + sk * bfhi(zv.x)); w.y = pack2(acc[4 * rg + 2] + sk * bflo(zv.y), acc[4 * rg + 3] + sk * bfhi(zv.y));
        *(LAS u32x2*)(zout + zo) = w;
      }
    }
    asm volatile("s_waitcnt lgkmcnt(0)" ::: "memory");
#pragma unroll
    for (int i = 0; i < 4; ++i) { const int base = lane * 8 + 512 * i;
      if (base < ntok) { const u32x4 v = gv[i];
        float u[10]; u[0] = bf2f(gpv[i]); u[1] = bflo(v.x); u[2] = bfhi(v.x); u[3] = bflo(v.y); u[4] = bfhi(v.y); u[5] = bflo(v.z); u[6] = bfhi(v.z); u[7] = bflo(v.w); u[8] = bfhi(v.w); u[9] = bf2f(gnx[i]);
        LP zp = zout + ((base >> 5) * 40 + (base & 31)) * 2; const u32x4 t = *(const LAS u32x4*)zp;
        float tv[8]; tv[0] = bflo(t.x); tv[1] = bfhi(t.x); tv[2] = bflo(t.y); tv[3] = bfhi(t.y); tv[4] = bflo(t.z); tv[5] = bfhi(t.z); tv[6] = bflo(t.w); tv[7] = bfhi(t.w);
        float o[8];
#pragma unroll
        for (int e = 0; e < 8; ++e) o[e] = (cb + w0 * u[e] + w1 * u[e + 1] + w2 * u[e + 2]) * tv[e];
        u32x4 w; w.x = pack2(o[0], o[1]); w.y = pack2(o[2], o[3]); w.z = pack2(o[4], o[5]); w.w = pack2(o[6], o[7]);
        *(LAS u32x4*)zp = w; } }
    asm volatile("s_waitcnt lgkmcnt(0)" ::: "memory");
  }
  __syncthreads();
  { bf16_t* YH = (bf16_t*)((unsigned char*)p.out + OUT_HB);
    for (int tl = tid; tl < ntok; tl += 512) {
      const int bl = tl >> lgL, tloc = tl & (L - 1); const int zo = ((((bl << lgnb) + (tloc >> 5)) * 40) + (tloc & 31)) * 2;
      unsigned short e[8];
#pragma unroll
      for (int w = 0; w < 8; ++w) e[w] = *(const LAS unsigned short*)(lds + w * HY_WAVE + HY_ZA + zo);
      u32x4 o; o.x = e[0] | ((unsigned)e[1] << 16); o.y = e[2] | ((unsigned)e[3] << 16); o.z = e[4] | ((unsigned)e[5] << 16); o.w = e[6] | ((unsigned)e[7] << 16);
      *(u32x4*)(YH + (size_t)(tok0 + tl) * 1024 + cgp * 8) = o; } }
  __syncthreads();
}

__device__ void final_norm(const Params& p) {
  const int tid0 = opaque_tid(); const int wid = tid0 >> 6, lane = tid0 & 63; const float* fw = p.in[31];
  const float* P = (const float*)(p.ws + OFF_BIG + (size_t)8192 * 4096 * 2); const float* mod = (const float*)(p.ws + OFF_MOD);
  f32x4 wv[4];
#pragma unroll
  for (int i = 0; i < 4; ++i) wv[i] = *(const f32x4*)(fw + 4 * lane + 256 * i);
  for (int unit = blockIdx.x; unit < 768; unit += gridDim.x) {
    const int row0 = unit * 32 + wid * 4; const bool chunkB = row0 >= 16384;
    f32x4 x[4][4];
#pragma unroll
    for (int r = 0; r < 4; ++r)
#pragma unroll
      for (int i = 0; i < 4; ++i) x[r][i] = *(const f32x4*)(p.out + (size_t)(row0 + r) * 1024 + 4 * lane + 256 * i);
    if (chunkB) { const float* md = mod + cond_of_row(row0) * 6144 + 5120;
#pragma unroll
      for (int i = 0; i < 4; ++i) { const f32x4 g2 = *(const f32x4*)(md + 4 * lane + 256 * i);
#pragma unroll
        for (int r = 0; r < 4; ++r) x[r][i] += g2 * *(const f32x4*)(P + (size_t)(row0 + r - 16384) * 1024 + 4 * lane + 256 * i); } }
#pragma unroll
    for (int r = 0; r < 4; ++r) { float ss = 0.f;
#pragma unroll
      for (int i = 0; i < 4; ++i) ss += x[r][i][0] * x[r][i][0] + x[r][i][1] * x[r][i][1] + x[r][i][2] * x[r][i][2] + x[r][i][3] * x[r][i][3];
      ss = wave_sum(ss); const float rstd = rsqrtf(ss * (1.0f / 1024.0f) + 1e-6f);
#pragma unroll
      for (int i = 0; i < 4; ++i) *(f32x4*)(p.out + (size_t)(row0 + r) * 1024 + 4 * lane + 256 * i) = x[r][i] * rstd * wv[i]; }
  }
}

__global__ void __launch_bounds__(512, 2) __attribute__((flatten)) mega(Params p) {
  extern __shared__ __attribute__((aligned(16))) unsigned char shm[];
  LP lds = (LP)shm;
  cg::grid_group grid = cg::this_grid();
  volatile LAS unsigned* xst = (volatile LAS unsigned*)(lds + LDS_BYTES - 16);
  if (threadIdx.x == 0) { xst[0] = 0u; xst[1] = 0u; }
  __syncthreads();
  const XcdBarrier xb = xcd_barrier_post((unsigned*)(p.ws + OFF_BAR), xst);
  unsigned char* ws = p.ws;
  const bf16_t* WT = (const bf16_t*)(ws + OFF_WT); const bf16_t* HN = (const bf16_t*)(ws + OFF_HN); bf16_t* BIG = (bf16_t*)(ws + OFF_BIG);
  bf16_t* Hb = (bf16_t*)((unsigned char*)p.out + OUT_H); bf16_t* YH = (bf16_t*)((unsigned char*)p.out + OUT_HB);
  const float* mod = (const float*)(ws + OFF_MOD);
  phase0(p, lds);
  if (gridDim.y == 7u) grid.sync();
  xcd_barrier(xb);
  phase1(p, lds);
  weight_tiles(p, lds, 0, 384, 0);
  xcd_barrier(xb);
  filters_upper_half(p, lds);
  weight_tiles(p, lds, 384, 768, 1);
  { EpiQKV e; e.O = BIG; e.bias = p.in[11]; run_gemm(lds, HN, WT, NTOK, 3072, 1024, e); }
  xcd_barrier(xb);
  for (int item = blockIdx.x; item < 1280; item += gridDim.x) mlstm_item(p, lds, item);
  xcd_barrier(xb);
  combine_rows(p);
  weight_tiles(p, lds, 768, 1152, 1);
  { EpiUT e; e.O = BIG; e.bias = p.in[11] + 4112; run_gemm(lds, WT + (size_t)3072 * 1024, HN, 3072, NTOK, 1024, e); }
  xcd_barrier(xb);
  for (int item = blockIdx.x; item < 2048; item += gridDim.x) hyena_item(p, lds, item);
  xcd_barrier(xb);
  c1_upper_half(p, lds);
  weight_tiles(p, lds, 1152, 1536, 1);
  { EpiGates e; e.H = Hb; e.G = BIG; e.b_in = p.in[11]; run_gemm(lds, HN, WT + (size_t)6144 * 1024, NTOK, 3072, 1024, e); }
  xcd_barrier(xb);
  bf16_t* T = BIG + (size_t)NTOK * 2048;
  weight_tiles(p, lds, 1536, 2560, 1);
  { EpiMerge<0> e; e.T = T; e.G = BIG; run_gemm(lds, Hb, (const bf16_t*)(ws + OFF_WBM), NTOK, 1024, 1024, e); }
  { EpiMerge<1> e; e.T = T; e.G = BIG; run_gemm(lds, YH, (const bf16_t*)(ws + OFF_WBH), NTOK, 1024, 1024, e); }
  xcd_barrier(xb);
  { EpiOut e; e.xp = p.in[0]; e.xs = p.in[1]; e.per = (const float*)(ws + OFF_PER); e.pec = (const float*)(ws + OFF_PEC); e.mod = mod; e.n2w = p.in[26];
    e.X1 = p.out; e.A2 = (bf16_t*)(ws + OFF_HN); e.ssq = (float*)(ws + OFF_SSQ1); run_gemm(lds, T, (const bf16_t*)(ws + OFF_WOUT), NTOK, 1024, 1024, e); }
  xcd_barrier(xb);
  constexpr int ROWS_A = 16384, ROWS_B = NTOK - ROWS_A;
  { EpiFF1 e; e.row0 = 0; e.ssq = (const float*)(p.ws + OFF_SSQ1); e.c1 = (const float*)(p.ws + OFF_C1); e.Hd = (bf16_t*)(p.ws + OFF_BIG);
    run_gemm(lds, (const bf16_t*)(p.ws + OFF_HN), (const bf16_t*)(p.ws + OFF_W1T), ROWS_A, 4096, 1024, e); }
  xcd_barrier(xb);
  { EpiFF2 e; e.row0 = 0; e.mod = (const float*)(p.ws + OFF_MOD); e.b2 = p.in[30]; e.X = p.out; e.P = (float*)(p.ws + OFF_BIG + (size_t)ROWS_A * 4096 * 2);
    run_gemm(lds, (const bf16_t*)(p.ws + OFF_BIG), (const bf16_t*)(p.ws + OFF_W2T), ROWS_A, 1024, 4096, e); }
  xcd_barrier(xb);
  { EpiFF1 e; e.row0 = ROWS_A; e.ssq = (const float*)(p.ws + OFF_SSQ1); e.c1 = (const float*)(p.ws + OFF_C1); e.Hd = (bf16_t*)(p.ws + OFF_BIG);
    run_gemm(lds, (const bf16_t*)(p.ws + OFF_HN) + (size_t)ROWS_A * 1024, (const bf16_t*)(p.ws + OFF_W1T), ROWS_B, 4096, 1024, e); }
  xcd_barrier(xb);
  { EpiFF2 e; e.row0 = ROWS_A; e.mod = (const float*)(p.ws + OFF_MOD); e.b2 = p.in[30]; e.X = p.out; e.P = (float*)(p.ws + OFF_BIG + (size_t)ROWS_B * 4096 * 2);
    run_gemm(lds, (const bf16_t*)(p.ws + OFF_BIG), (const bf16_t*)(p.ws + OFF_W2T), ROWS_B, 1024, 4096, e, 2); }
  xcd_barrier(xb);
  final_norm(p);
}

extern "C" void kernel_launch(void* const* d_in, const int* in_sizes, int n_in, void* d_out, int out_size, void* d_ws, size_t ws_size, hipStream_t stream) {
  static int grid_blocks = 0;
  if (!grid_blocks) {
    int dev = 0, cus = 0, per_cu = 0;
    hipGetDevice(&dev);
    hipDeviceGetAttribute(&cus, hipDeviceAttributeMultiprocessorCount, dev);
    hipFuncSetAttribute((const void*)mega, hipFuncAttributeMaxDynamicSharedMemorySize, LDS_BYTES);
    hipOccupancyMaxActiveBlocksPerMultiprocessor(&per_cu, (const void*)mega, 512, LDS_BYTES);
    if (per_cu < 1) { fprintf(stderr, "kernel_launch: occupancy query reports %d blocks per CU\n", per_cu); grid_blocks = -1; }
    else grid_blocks = cus;
    if (n_in != 32 || ws_size < WS_END) { fprintf(stderr, "kernel_launch: unexpected n_in %d / ws_size %zu (need %zu)\n", n_in, ws_size, (size_t)WS_END); grid_blocks = -1; }
  }
  if (grid_blocks < 0) return;
  hipMemsetAsync((unsigned char*)d_ws + OFF_BAR, 0, 3456 * 4, stream);
  Params p{};
  for (int i = 0; i < 32; ++i) p.in[i] = (const float*)d_in[i];
  p.out = (float*)d_out; p.ws = (unsigned char*)d_ws;
  void* args[] = {&p};
  hipError_t e = hipLaunchCooperativeKernel((void*)mega, dim3(grid_blocks), dim3(512), args, LDS_BYTES, stream);
  if (e != hipSuccess) fprintf(stderr, "cooperative launch failed: %s (grid %d)\n", hipGetErrorString(e), grid_blocks);
}
```

```cpp
#include <hip/hip_runtime.h>
#include <hip/hip_cooperative_groups.h>
#include <cstdio>
#include <cstdint>
namespace cg = cooperative_groups;

#define LAS __attribute__((address_space(3)))
typedef LAS unsigned char* LP;
typedef unsigned short bf16_t;
typedef short bf16x8 __attribute__((ext_vector_type(8)));
typedef short s16x4 __attribute__((ext_vector_type(4)));
typedef float f32x4 __attribute__((ext_vector_type(4)));
typedef float f32x16 __attribute__((ext_vector_type(16)));
typedef unsigned u32x4 __attribute__((ext_vector_type(4)));
typedef unsigned u32x2 __attribute__((ext_vector_type(2)));

constexpr int DM = 1024, NTOK = 24576, NCTX = 8192, SEQC = 256, SEQS = 2048, INC = 9232;
constexpr int LDS_BYTES = 160 * 1024;
constexpr size_t OFF_WT = 0;
constexpr size_t OFF_WBM = 18874368, OFF_WBH = 20971520, OFF_WOUT = 23068672, OFF_W1T = 25165824, OFF_W2T = 33554432;
constexpr size_t OFF_HN = 41943040;
constexpr size_t OFF_BIG = 92274688;
constexpr size_t OFF_SM = 243269632;
constexpr size_t OFF_MOD = OFF_SM;
constexpr size_t OFF_C1 = OFF_MOD + 221184;
constexpr size_t OFF_H2S = OFF_C1 + 147456;
constexpr size_t OFF_H2C = OFF_H2S + 524288;
constexpr size_t OFF_PER = OFF_H2C + 65536;
constexpr size_t OFF_PEC = OFF_PER + 65536;
constexpr size_t OFF_GT = OFF_PEC + 131072;
constexpr size_t OFF_SSQ1 = OFF_GT + 1572864;
constexpr size_t OFF_SSQ2 = OFF_SSQ1 + 1572864;
constexpr size_t OFF_HFS = OFF_SSQ2 + 1572864;
constexpr size_t OFF_HFC = OFF_HFS + 16777216;
constexpr size_t OFF_BAR = OFF_HFC + 2097152;
constexpr size_t WS_END = OFF_BAR + 3456 * 4;
constexpr size_t OUT_H = 0, OUT_HB = 50331648;
constexpr size_t OUTF_C = 25165824, OUTF_N = 41943040, OUTF_M = 42008576;

struct Params { const float* in[32]; float* out; unsigned char* ws; };

__device__ __forceinline__ bf16_t f2bf(float f) { unsigned u = __float_as_uint(f); u += 0x7FFFu + ((u >> 16) & 1u); return (bf16_t)(u >> 16); }
__device__ __forceinline__ float bf2f(unsigned b) { return __uint_as_float(b << 16); }
__device__ __forceinline__ unsigned pack2(float lo, float hi) { return (unsigned)f2bf(lo) | ((unsigned)f2bf(hi) << 16); }
__device__ __forceinline__ float bflo(unsigned w) { return __uint_as_float(w << 16); }
__device__ __forceinline__ float bfhi(unsigned w) { return __uint_as_float(w & 0xffff0000u); }
__device__ __forceinline__ float sigmoidf_(float x) { return 1.0f / (1.0f + __expf(-x)); }
__device__ __forceinline__ int opaque_tid() { int t = threadIdx.x; asm volatile("" : "+v"(t)); return t; }
__device__ __forceinline__ float wave_sum(float v) {
#pragma unroll
  for (int o = 32; o >= 1; o >>= 1) v += __shfl_xor(v, o);
  return v;
}


#define XB_TMO      128
#define XB_XCNT(j)  (256  + 64 * (j))
#define XB_XSUB(j)  (1280 + 64 * (j))
#define XB_XGEN(j)  (2304 + 64 * (j))
#define XB_TOP      3328
#define XB_TOPGEN   3392
#define XCD_BAR_WORDS 3456
#define XB_SPIN_CAP (1u << 18)
__device__ __forceinline__ unsigned xb_ld(unsigned* p)              { return __hip_atomic_load(p, __ATOMIC_RELAXED, __HIP_MEMORY_SCOPE_AGENT); }
__device__ __forceinline__ unsigned xb_add(unsigned* p, unsigned v) { return __hip_atomic_fetch_add(p, v, __ATOMIC_RELAXED, __HIP_MEMORY_SCOPE_AGENT); }
__device__ __forceinline__ unsigned xb_xcc_id() { return (unsigned)__builtin_amdgcn_s_getreg((3 << 11) | 20) & 0xFu; }
#define XB_SPIN(cond, bar) do { unsigned _sp = 0; while (cond) { __builtin_amdgcn_s_sleep(1); \
    if ((++_sp & 255u) == 0u) { if (xb_ld(&(bar)[XB_TMO])) break; if (_sp > XB_SPIN_CAP) { atomicAdd(&(bar)[XB_TMO], 1u); break; } } } } while (0)
struct XcdBarrier { unsigned* bar; unsigned x; volatile LAS unsigned* st; };
__device__ __forceinline__ XcdBarrier xcd_barrier_post(unsigned* bar, volatile LAS unsigned* st) {
  XcdBarrier b; b.bar = bar; b.x = xb_xcc_id(); b.st = st;
  if (threadIdx.x == 0) (void)xb_add(&bar[XB_XCNT(b.x)], 1u);
  return b;
}
__device__ __forceinline__ void xcd_barrier_complete(unsigned* bar, unsigned x, unsigned& nloc, unsigned& nx) {
  const unsigned G = gridDim.x * gridDim.y * gridDim.z;
  unsigned sum, cnt, mine, sp = 0u;
  for (;;) {
    sum = 0u; cnt = 0u; mine = 0u;
#pragma unroll
    for (unsigned j = 0; j < 16; ++j) { const unsigned c = xb_ld(&bar[XB_XCNT(j)]); sum += c; cnt += (c > 0u) ? 1u : 0u; mine = (j == x) ? c : mine; }
    if (sum == G) break;
    __builtin_amdgcn_s_sleep(1);
    if ((++sp & 255u) == 0u) { if (xb_ld(&bar[XB_TMO])) break; if (sp > XB_SPIN_CAP) { atomicAdd(&bar[XB_TMO], 1u); break; } }
  }
  nloc = mine > 0u ? mine : 1u; nx = cnt > 0u ? cnt : 1u;
}
__device__ __forceinline__ void xcd_barrier(const XcdBarrier& b) {
  asm volatile("s_waitcnt vmcnt(0)" ::: "memory");
  __syncthreads();
  if (threadIdx.x == 0) {
    unsigned* bar = b.bar;
    __builtin_amdgcn_s_waitcnt(0);
    unsigned nloc = b.st[0], nx = b.st[1];
    if (nloc == 0u) { xcd_barrier_complete(bar, b.x, nloc, nx); b.st[0] = nloc; b.st[1] = nx; }
    const unsigned old = xb_add(&bar[XB_XSUB(b.x)], 1u);
    const unsigned gen = old / nloc;
    if (old + 1u == (gen + 1u) * nloc) {
      __builtin_amdgcn_fence(__ATOMIC_RELEASE, "agent");
      asm volatile("s_waitcnt vmcnt(0)" ::: "memory");
      const unsigned og = xb_add(&bar[XB_TOP], 1u);
      const unsigned tg = og / nx;
      if (og + 1u == (tg + 1u) * nx) xb_add(&bar[XB_TOPGEN], 1u);
      else XB_SPIN(xb_ld(&bar[XB_TOPGEN]) == tg, bar);
      __builtin_amdgcn_fence(__ATOMIC_ACQUIRE, "agent");
      xb_add(&bar[XB_XGEN(b.x)], 1u);
      asm volatile("s_waitcnt vmcnt(0)" ::: "memory");
    } else {
      XB_SPIN(xb_ld(&bar[XB_XGEN(b.x)]) == gen, bar);
      __builtin_amdgcn_fence(__ATOMIC_ACQUIRE, "agent");
      asm volatile("s_waitcnt vmcnt(0)" ::: "memory");
    }
  }
  __syncthreads();
}

namespace pg8 {
constexpr int BM = 256, BK = 64, HALF = 128, HTB = HALF * BK * 2, STAGE_BYTES = 8 * HTB, NXCD = 8, WGM = 8;
__host__ __device__ __forceinline__ int lds_byte(int r, int c) { const int st = (r >> 4) * 2 + (c >> 5), rr = r & 15, cc = c & 31, ob = rr * 64 + cc * 2; return st * 1024 + (ob ^ (((ob >> 9) & 1) << 5)); }
__host__ __device__ __forceinline__ void stage_rc(int b, int& R, int& C) { const int st = b / 1024, sb = b % 1024, swz = sb ^ (((sb >> 9) & 1) << 5); R = (st >> 1) * 16 + swz / 64; C = (st & 1) * 32 + (swz % 64) / 2; }
__host__ __device__ __forceinline__ int perm32(int rho) { const int n = rho >> 4, i = rho & 15; return 8 * (i >> 2) + 4 * n + (i & 3); }
struct Unit { int pm, pn, ks; };
struct Gemm { const bf16_t* A; const bf16_t* Bt; int M, N, K, ld, nks; };
struct StaticOrder {
  int nM, nN, ntile, nwg, G, c;
  __device__ void init(int M, int N, int nks, int G_, int c_) { nM = M / BM; nN = N / BM; ntile = nM * nN; nwg = ntile * nks; G = G_; c = c_; }
  __device__ bool next(int i, Unit& u) const {
    const long L = (long)i * G + c; if (L >= nwg) return false;
    u.ks = (int)L / ntile; int wgid = (int)L - u.ks * ntile;
    { const int q = ntile / NXCD, r = ntile % NXCD, xcd = wgid % NXCD, off = wgid / NXCD; wgid = (xcd < r ? xcd * (q + 1) : r * (q + 1) + (xcd - r) * q) + off; }
    const int nig = WGM * nN, gid = wgid / nig, fm = gid * WGM, gsz = (nM - fm) < WGM ? (nM - fm) : WGM;
    u.pm = fm + ((wgid % nig) % gsz); u.pn = (wgid % nig) / gsz; return true;
  }
};

template <class Epi>
__device__ __forceinline__ void gemm_phase(LP lds, const Gemm g, const StaticOrder& S, const Epi& E) {
  int tid_ = threadIdx.x; asm volatile("" : "+v"(tid_));
  const int tid = tid_, wid = __builtin_amdgcn_readfirstlane(tid >> 6), lane = tid & 63, wr = wid >> 2, wc = wid & 3, fr = lane & 15, fq = lane >> 4;
  const int K = g.ld, nt = g.K / BK;
  const size_t ksb = (size_t)g.K * 2;
  unsigned voffA[2], voffB[2];
#pragma unroll
  for (int i = 0; i < 2; ++i) { int R, C; stage_rc(tid * 16 + i * 8192, R, C); const int Rb = (R & ~31) + perm32(R & 31); voffA[i] = (unsigned)(R * K + C) * 2u; voffB[i] = (unsigned)(Rb * K + C) * 2u; }
  const size_t kstep = (size_t)(BK * 2);
  const size_t hstep = (size_t)HALF * K * 2;
  const size_t tstep = 2 * hstep;
  const unsigned ldsw = (unsigned)wid * 1024u;
  const int aoff = lds_byte(wr * 64 + fr, fq * 8), boff = lds_byte(wc * 32 + fr, fq * 8);
#define PG8_SA(b, h) (((b) * 2 + (h)) * HTB)
#define PG8_SB(b, h) ((4 + (b) * 2 + (h)) * HTB)
#define PG8_STAGE(bufoff, gbase, voff) do { _Pragma("unroll") for (int _i = 0; _i < 2; ++_i) \
    __builtin_amdgcn_global_load_lds((const unsigned*)((const char*)(gbase) + (voff)[_i]), (LAS unsigned*)(lds + (bufoff) + ldsw + _i * 8192), 16, 0, 0); } while (0)
#define PG8_LDA(dst, b, h) do { _Pragma("unroll") for (int m = 0; m < 4; ++m) _Pragma("unroll") for (int k = 0; k < 2; ++k) dst[m][k] = *(const LAS bf16x8*)(lds + PG8_SA(b, h) + aoff + m * 2048 + k * 1024); } while (0)
#define PG8_LDB(dst, b, h) do { _Pragma("unroll") for (int n = 0; n < 2; ++n) _Pragma("unroll") for (int k = 0; k < 2; ++k) dst[n][k] = *(const LAS bf16x8*)(lds + PG8_SB(b, h) + boff + n * 2048 + k * 1024); } while (0)
#define PG8_MMA(ai, bj, At, Bt) do { __builtin_amdgcn_s_setprio(1); _Pragma("unroll") for (int m = 0; m < 4; ++m) _Pragma("unroll") for (int n = 0; n < 2; ++n) _Pragma("unroll") for (int k = 0; k < 2; ++k) \
    acc[ai][bj][m][n] = __builtin_amdgcn_mfma_f32_16x16x32_bf16(Bt[n][k], At[m][k], acc[ai][bj][m][n], 0, 0, 0); __builtin_amdgcn_s_setprio(0); } while (0)
#define PG8_WAIT_V(n) asm volatile("s_waitcnt vmcnt(" #n ")" ::: "memory")
#define PG8_WAIT_L(n) asm volatile("s_waitcnt lgkmcnt(" #n ")" ::: "memory")
#define PG8_BAR __builtin_amdgcn_s_barrier()
#define PG8_SCHED __builtin_amdgcn_sched_barrier(0)
  Unit cur, nxt; int ui = 0;
  if (!S.next(0, cur)) return;
  f32x4 acc[2][2][4][2];
#pragma unroll
  for (int a = 0; a < 2; ++a)
#pragma unroll
    for (int b = 0; b < 2; ++b)
#pragma unroll
      for (int m = 0; m < 4; ++m)
#pragma unroll
        for (int n = 0; n < 2; ++n) acc[a][b][m][n] = (f32x4){0.f, 0.f, 0.f, 0.f};
  bf16x8 At[4][2], B0[2][2], B1[2][2];
  const char* cA = (const char*)g.A + (size_t)cur.pm * tstep + cur.ks * ksb; const char* cB = (const char*)g.Bt + (size_t)cur.pn * tstep + cur.ks * ksb;
  PG8_STAGE(PG8_SB(0, 0), cB, voffB); PG8_STAGE(PG8_SA(0, 0), cA, voffA); PG8_STAGE(PG8_SB(0, 1), cB + hstep, voffB); PG8_STAGE(PG8_SA(0, 1), cA + hstep, voffA);
  if (wr == 1) PG8_BAR;
  PG8_WAIT_V(4); PG8_BAR;
  PG8_STAGE(PG8_SB(1, 0), cB + kstep, voffB); PG8_STAGE(PG8_SA(1, 0), cA + kstep, voffA); PG8_STAGE(PG8_SB(1, 1), cB + hstep + kstep, voffB);
  PG8_WAIT_V(6); PG8_BAR;
  for (;;) {
    const bool has_next = S.next(ui + 1, nxt);
    const char* nA = has_next ? (const char*)g.A + (size_t)nxt.pm * tstep + nxt.ks * ksb : cA; const char* nB = has_next ? (const char*)g.Bt + (size_t)nxt.pn * tstep + nxt.ks * ksb : cB;
    for (int t = 0; t < nt; t += 2) {
      const bool last = (t == nt - 2);
      const char* a1 = cA + (size_t)(t + 1) * kstep;
      const char* a2 = last ? nA : cA + (size_t)(t + 2) * kstep; const char* b2 = last ? nB : cB + (size_t)(t + 2) * kstep;
      const char* a3 = a2 + kstep; const char* b3 = b2 + kstep;
      PG8_LDB(B0, 0, 0); PG8_SCHED; PG8_LDA(At, 0, 0); PG8_STAGE(PG8_SA(1, 1), a1 + hstep, voffA);
      PG8_WAIT_L(8); PG8_BAR; PG8_WAIT_L(0); PG8_MMA(0, 0, At, B0); PG8_BAR; PG8_SCHED;
      PG8_LDB(B1, 0, 1); PG8_STAGE(PG8_SB(0, 0), b2, voffB);
      PG8_BAR; PG8_WAIT_L(0); PG8_MMA(0, 1, At, B1); PG8_BAR;
      PG8_LDA(At, 0, 1); PG8_STAGE(PG8_SA(0, 0), a2, voffA);
      PG8_BAR; PG8_WAIT_L(0); PG8_MMA(1, 0, At, B0); PG8_BAR; PG8_SCHED;
      PG8_STAGE(PG8_SB(0, 1), b2 + hstep, voffB);
      PG8_WAIT_V(6); PG8_BAR; PG8_MMA(1, 1, At, B1); PG8_BAR;
      PG8_LDB(B0, 1, 0); PG8_SCHED; PG8_LDA(At, 1, 0); PG8_STAGE(PG8_SA(0, 1), a2 + hstep, voffA);
      PG8_WAIT_L(8); PG8_BAR; PG8_WAIT_L(0); PG8_MMA(0, 0, At, B0); PG8_BAR; PG8_SCHED;
      PG8_LDB(B1, 1, 1); PG8_STAGE(PG8_SB(1, 0), b3, voffB);
      PG8_BAR; PG8_WAIT_L(0); PG8_MMA(0, 1, At, B1); PG8_BAR;
      PG8_LDA(At, 1, 1); PG8_STAGE(PG8_SA(1, 0), a3, voffA);
      PG8_BAR; PG8_WAIT_L(0); PG8_MMA(1, 0, At, B0); PG8_BAR; PG8_SCHED;
      PG8_STAGE(PG8_SB(1, 1), b3 + hstep, voffB);
      PG8_WAIT_V(6); PG8_BAR; PG8_MMA(1, 1, At, B1); PG8_BAR;
    }
    { int fr2 = fr, fq2 = fq; asm volatile("" : "+v"(fr2), "+v"(fq2)); E(acc, cur, wr, wc, fr2, fq2); }
    if (!has_next) break;
#pragma unroll
    for (int a = 0; a < 2; ++a)
#pragma unroll
      for (int b = 0; b < 2; ++b)
#pragma unroll
        for (int m = 0; m < 4; ++m)
#pragma unroll
          for (int n = 0; n < 2; ++n) acc[a][b][m][n] = (f32x4){0.f, 0.f, 0.f, 0.f};
    cur = nxt; cA = nA; cB = nB; ++ui;
  }
  PG8_WAIT_V(0);
  if (wr == 0) PG8_BAR;
  PG8_BAR;
#undef PG8_SA
#undef PG8_SB
#undef PG8_STAGE
#undef PG8_LDA
#undef PG8_LDB
#undef PG8_MMA
#undef PG8_WAIT_V
#undef PG8_WAIT_L
#undef PG8_BAR
#undef PG8_SCHED
}
}
using pg8::Unit;
typedef f32x4 AccT[2][2][4][2];

#define EPI_ROW(ai, m) (u.pm * 256 + (ai) * 128 + wr * 64 + (m) * 16 + fr)
#define EPI_COL(bj, n) (u.pn * 256 + (bj) * 128 + wc * 32 + 8 * fq + 4 * (n))
#define EPI_LOOP_ROWS _Pragma("unroll") for (int ai = 0; ai < 2; ++ai) _Pragma("unroll") for (int m = 0; m < 4; ++m)
#define EPI_LOOP_COLS _Pragma("unroll") for (int bj = 0; bj < 2; ++bj) _Pragma("unroll") for (int n = 0; n < 2; ++n)

__device__ __forceinline__ int cond_of_row(int row) { return row < NCTX ? 0 : 1 + ((row - NCTX) >> 11); }

#define EPI_LOOP_BJ _Pragma("unroll") for (int bj = 0; bj < 2; ++bj)
__device__ __forceinline__ u32x4 pack8(const f32x4 v0, const f32x4 v1) { u32x4 w; w.x = pack2(v0[0], v0[1]); w.y = pack2(v0[2], v0[3]); w.z = pack2(v1[0], v1[1]); w.w = pack2(v1[2], v1[3]); return w; }
__device__ __forceinline__ void unpack8(const u32x4 w, f32x4& v0, f32x4& v1) { v0[0] = bflo(w.x); v0[1] = bfhi(w.x); v0[2] = bflo(w.y); v0[3] = bfhi(w.y); v1[0] = bflo(w.z); v1[1] = bfhi(w.z); v1[2] = bflo(w.w); v1[3] = bfhi(w.w); }
struct EpiQKV {
  bf16_t* O; const float* bias;
  __device__ __forceinline__ void operator()(const AccT& acc, const Unit& u, int wr, int wc, int fr, int fq) const {
    const float sc = (u.pn < 4) ? 0.0625f : 1.0f;
    f32x4 bv[2][2];
    EPI_LOOP_COLS { bv[bj][n] = *(const f32x4*)(bias + EPI_COL(bj, n)); }
    EPI_LOOP_ROWS { const int row = EPI_ROW(ai, m);
      EPI_LOOP_BJ { *(u32x4*)(O + (size_t)row * 3072 + EPI_COL(bj, 0)) = pack8((acc[ai][bj][m][0] + bv[bj][0]) * sc, (acc[ai][bj][m][1] + bv[bj][1]) * sc); } }
  }
};
struct EpiUT {
  bf16_t* O; const float* bias;
  __device__ __forceinline__ void operator()(const AccT& acc, const Unit& u, int wr, int wc, int fr, int fq) const {
    EPI_LOOP_ROWS { const int row = EPI_ROW(ai, m); const float bv = bias[row];
      EPI_LOOP_BJ { *(u32x4*)(O + (size_t)row * NTOK + EPI_COL(bj, 0)) = pack8(acc[ai][bj][m][0] + bv, acc[ai][bj][m][1] + bv); } }
  }
};
struct EpiGates {
  bf16_t* H; bf16_t* G; const float* b_in;
  __device__ __forceinline__ void operator()(const AccT& acc, const Unit& u, int wr, int wc, int fr, int fq) const {
    const bool og = u.pn < 4;
    f32x4 bv[2][2];
    EPI_LOOP_COLS { const int col = EPI_COL(bj, n); bv[bj][n] = *(const f32x4*)(b_in + (og ? 3072 + col : 7184 + (col - 1024))); }
#pragma unroll
    for (int ai = 0; ai < 2; ++ai)
#pragma unroll
      for (int m2 = 0; m2 < 2; ++m2) {
        u32x4 hv[2][2];
        if (og) {
#pragma unroll
          for (int mm = 0; mm < 2; ++mm) { const int row = EPI_ROW(ai, 2 * m2 + mm); EPI_LOOP_BJ { hv[mm][bj] = *(const u32x4*)(H + (size_t)row * 1024 + EPI_COL(bj, 0)); } } }
#pragma unroll
        for (int mm = 0; mm < 2; ++mm) { const int m = 2 * m2 + mm; const int row = EPI_ROW(ai, m);
          EPI_LOOP_BJ { const int col = EPI_COL(bj, 0); f32x4 s0, s1; const f32x4 a0 = acc[ai][bj][m][0] + bv[bj][0], a1 = acc[ai][bj][m][1] + bv[bj][1];
#pragma unroll
            for (int e = 0; e < 4; ++e) { s0[e] = sigmoidf_(a0[e]); s1[e] = sigmoidf_(a1[e]); }
            if (og) { f32x4 h0, h1; unpack8(hv[mm][bj], h0, h1); *(u32x4*)(H + (size_t)row * 1024 + col) = pack8(h0 * s0, h1 * s1); }
            else *(u32x4*)(G + (size_t)row * 2048 + (col - 1024)) = pack8(s0, s1); } } }
  }
};
template <int SECOND> struct EpiMerge {
  bf16_t* T; const bf16_t* G;
  __device__ __forceinline__ void operator()(const AccT& acc, const Unit& u, int wr, int wc, int fr, int fq) const {
#pragma unroll
    for (int ai = 0; ai < 2; ++ai)
#pragma unroll
      for (int m2 = 0; m2 < 2; ++m2) {
        u32x4 gv[2][2], tv[2][2];
#pragma unroll
        for (int mm = 0; mm < 2; ++mm) { const int row = EPI_ROW(ai, 2 * m2 + mm);
          EPI_LOOP_BJ { const int col = EPI_COL(bj, 0); gv[mm][bj] = *(const u32x4*)(G + (size_t)row * 2048 + SECOND * 1024 + col);
            if (SECOND) tv[mm][bj] = *(const u32x4*)(T + (size_t)row * 1024 + col); } }
#pragma unroll
        for (int mm = 0; mm < 2; ++mm) { const int m = 2 * m2 + mm; const int row = EPI_ROW(ai, m);
          EPI_LOOP_BJ { const int col = EPI_COL(bj, 0); f32x4 g0, g1; unpack8(gv[mm][bj], g0, g1);
            f32x4 v0 = g0 * acc[ai][bj][m][0], v1 = g1 * acc[ai][bj][m][1];
            if (SECOND) { f32x4 t0, t1; unpack8(tv[mm][bj], t0, t1); v0 += t0; v1 += t1; }
            *(u32x4*)(T + (size_t)row * 1024 + col) = pack8(v0, v1); } } }
  }
};
struct EpiOut {
  const float* xp; const float* xs; const float* per; const float* pec; const float* mod; const float* n2w; float* X1; bf16_t* A2; float* ssq;
  __device__ __forceinline__ void operator()(const AccT& acc, const Unit& u, int wr, int wc, int fr, int fq) const {
    const int cb = cond_of_row(u.pm * 256); const float* md = mod + cb * 6144; const bool smp = (u.pm * 256) >= NCTX;
    f32x4 g1v[2][2], k2v[2][2];
    EPI_LOOP_COLS { const int col = EPI_COL(bj, n); g1v[bj][n] = *(const f32x4*)(md + 2048 + col); k2v[bj][n] = *(const f32x4*)(n2w + col) * (*(const f32x4*)(md + 4096 + col) + 1.0f); }
    EPI_LOOP_ROWS { const int row = EPI_ROW(ai, m); float ss = 0.f;
#pragma unroll
      for (int bj = 0; bj < 2; ++bj) {
        f32x4 x0[2];
        if (!smp) {
#pragma unroll
          for (int n = 0; n < 2; ++n) x0[n] = *(const f32x4*)(xp + (size_t)row * 1024 + EPI_COL(bj, n)); }
        else { const int r2 = row - NCTX, t = r2 & 2047; f32x4 pe[2];
#pragma unroll
          for (int n = 0; n < 2; ++n) { const int col = EPI_COL(bj, n); x0[n] = *(const f32x4*)(xs + (size_t)r2 * 1024 + col);
            pe[n] = (col < 512) ? *(const f32x4*)(per + (t >> 6) * 512 + col) : *(const f32x4*)(pec + (t & 63) * 512 + (col - 512)); }
#pragma unroll
          for (int n = 0; n < 2; ++n) x0[n] += pe[n]; }
        f32x4 x1[2];
#pragma unroll
        for (int n = 0; n < 2; ++n) { x1[n] = x0[n] + g1v[bj][n] * acc[ai][bj][m][n]; *(f32x4*)(X1 + (size_t)row * 1024 + EPI_COL(bj, n)) = x1[n];
          ss += x1[n][0] * x1[n][0] + x1[n][1] * x1[n][1] + x1[n][2] * x1[n][2] + x1[n][3] * x1[n][3]; }
        *(u32x4*)(A2 + (size_t)row * 1024 + EPI_COL(bj, 0)) = pack8(x1[0] * k2v[bj][0], x1[1] * k2v[bj][1]); }
      ss += __shfl_xor(ss, 16); ss += __shfl_xor(ss, 32);
      if (fq == 0) ssq[(size_t)row * 16 + u.pn * 4 + wc] = ss; }
  }
};
struct EpiFF1 {
  int row0; const float* ssq; const float* c1; bf16_t* Hd;
  __device__ __forceinline__ void operator()(const AccT& acc, const Unit& u, int wr, int wc, int fr, int fq) const {
    const int cb = cond_of_row(row0 + u.pm * 256); const float* cc = c1 + cb * 4096;
    f32x4 cv[2][2];
    EPI_LOOP_COLS { cv[bj][n] = *(const f32x4*)(cc + EPI_COL(bj, n)); }
    float rs[2][4];
    EPI_LOOP_ROWS { const float* sp = ssq + (size_t)(row0 + EPI_ROW(ai, m)) * 16;
      const f32x4 st = (*(const f32x4*)sp + *(const f32x4*)(sp + 4)) + (*(const f32x4*)(sp + 8) + *(const f32x4*)(sp + 12));
      rs[ai][m] = rsqrtf((st[0] + st[1] + st[2] + st[3]) * (1.0f / 1024.0f) + 1e-6f); }
    EPI_LOOP_ROWS { const int rl = EPI_ROW(ai, m); const float rstd = rs[ai][m];
      EPI_LOOP_BJ { f32x4 v0 = acc[ai][bj][m][0] * rstd + cv[bj][0], v1 = acc[ai][bj][m][1] * rstd + cv[bj][1];
#pragma unroll
        for (int e = 0; e < 4; ++e) { const float r0 = fmaxf(v0[e], 0.f), r1 = fmaxf(v1[e], 0.f); v0[e] = r0 * r0; v1[e] = r1 * r1; }
        *(u32x4*)(Hd + (size_t)rl * 4096 + EPI_COL(bj, 0)) = pack8(v0, v1); } }
  }
};
struct EpiFF2 {
  int row0; const float* mod; const float* b2; float* X; float* P;
  __device__ __forceinline__ void operator()(const AccT& acc, const Unit& u, int wr, int wc, int fr, int fq) const {
    if (u.ks == 1) {
      EPI_LOOP_ROWS { const int rl = EPI_ROW(ai, m); EPI_LOOP_COLS { *(f32x4*)(P + (size_t)rl * 1024 + EPI_COL(bj, n)) = acc[ai][bj][m][n]; } }
    } else {
    const int cb = cond_of_row(row0 + u.pm * 256); const float* md = mod + cb * 6144;
    f32x4 g2v[2][2], bbv[2][2];
    EPI_LOOP_COLS { const int col = EPI_COL(bj, n); g2v[bj][n] = *(const f32x4*)(md + 5120 + col); bbv[bj][n] = *(const f32x4*)(b2 + col); }
#pragma unroll
    for (int ai = 0; ai < 2; ++ai)
#pragma unroll
      for (int m2 = 0; m2 < 2; ++m2) {
        f32x4 xv[2][2][2];
#pragma unroll
        for (int mm = 0; mm < 2; ++mm) { const int row = row0 + EPI_ROW(ai, 2 * m2 + mm); EPI_LOOP_COLS { xv[mm][bj][n] = *(const f32x4*)(X + (size_t)row * 1024 + EPI_COL(bj, n)); } }
#pragma unroll
        for (int mm = 0; mm < 2; ++mm) { const int m = 2 * m2 + mm; const int row = row0 + EPI_ROW(ai, m);
          EPI_LOOP_COLS { const int col = EPI_COL(bj, n); *(f32x4*)(X + (size_t)row * 1024 + col) = xv[mm][bj][n] + g2v[bj][n] * (acc[ai][bj][m][n] + bbv[bj][n]); } } }
    }
  }
};

template <class Epi> __device__ __forceinline__ void run_gemm(LP lds, const bf16_t* A, const bf16_t* Bt, int M, int N, int K, const Epi& E, int nks = 1) {
  pg8::Gemm g; g.A = A; g.Bt = Bt; g.M = M; g.N = N; g.K = K / nks; g.ld = K; g.nks = nks;
  pg8::StaticOrder S; S.init(M, N, nks, (int)gridDim.x, (int)blockIdx.x);
  pg8::gemm_phase<Epi>(lds, g, S, E);
}

__device__ void transpose_tile(const float* __restrict__ src, int ld, int col0, int k0, bf16_t* __restrict__ dst, int K, int drow0, LAS float* tile) {
  const int t = opaque_tid();
  f32x4 v[4];
#pragma unroll
  for (int i = 0; i < 4; ++i) { const int idx = t + 512 * i, kr = idx >> 5, c4 = idx & 31; v[i] = *(const f32x4*)(src + (size_t)(k0 + kr) * ld + col0 + 4 * c4); }
#pragma unroll
  for (int i = 0; i < 4; ++i) { const int idx = t + 512 * i, kr = idx >> 5, c4 = idx & 31; LAS float* tp = tile + kr * 129 + 4 * c4; tp[0] = v[i][0]; tp[1] = v[i][1]; tp[2] = v[i][2]; tp[3] = v[i][3]; }
  __syncthreads();
  const int kb = t & 7;
#pragma unroll
  for (int i = 0; i < 2; ++i) { const int c = (t >> 3) + 64 * i; const LAS float* tp = tile + (kb * 8) * 129 + c; u32x4 o;
    o.x = pack2(tp[0], tp[129]); o.y = pack2(tp[2 * 129], tp[3 * 129]); o.z = pack2(tp[4 * 129], tp[5 * 129]); o.w = pack2(tp[6 * 129], tp[7 * 129]);
    *(u32x4*)(dst + (size_t)(drow0 + c) * K + k0 + kb * 8) = o; }
  __syncthreads();
}
template <int SILU> __device__ void matvec9_unit(const float* v0, const float* v1, int v1stride, const float* __restrict__ W, int ldw, const float* bias, float* out, int ldo, int col0, LAS float* lf) {
  const int t = opaque_tid(), lane = t & 63, wid = t >> 6;
  LAS float* sv = lf; LAS float* red = lf + 9216;
  for (int i = t; i < 9216; i += 512) { const int b = i >> 10, k = i & 1023; float x = (b == 0) ? v0[k] : v1[(size_t)(b - 1) * v1stride + k]; if (SILU) x = x / (1.0f + __expf(-x)); sv[i] = x; }
  __syncthreads();
  const int c4 = t & 7, kl = t >> 3;
  f32x4 w[16];
#pragma unroll
  for (int i = 0; i < 16; ++i) w[i] = *(const f32x4*)(W + (size_t)(kl + 64 * i) * ldw + col0 + 4 * c4);
  f32x4 acc[9];
#pragma unroll
  for (int b = 0; b < 9; ++b) acc[b] = (f32x4){0.f, 0.f, 0.f, 0.f};
#pragma unroll
  for (int i = 0; i < 16; ++i)
#pragma unroll
    for (int b = 0; b < 9; ++b) acc[b] += w[i] * sv[b * 1024 + kl + 64 * i];
#pragma unroll
  for (int b = 0; b < 9; ++b)
#pragma unroll
    for (int e = 0; e < 4; ++e) { float x = acc[b][e]; x += __shfl_xor(x, 8); x += __shfl_xor(x, 16); x += __shfl_xor(x, 32); acc[b][e] = x; }
  if (lane < 8) {
#pragma unroll
    for (int b = 0; b < 9; ++b) *(LAS f32x4*)(red + (wid * 9 + b) * 32 + 4 * lane) = acc[b]; }
  __syncthreads();
  if (t < 288) { const int b = t >> 5, cc = t & 31; float s = bias[col0 + cc];
#pragma unroll
    for (int pz = 0; pz < 8; ++pz) s += red[(pz * 9 + b) * 32 + cc];
    out[(size_t)b * ldo + col0 + cc] = s; }
  __syncthreads();
}

__device__ void phase0(const Params& p, LP lds) {
  unsigned char* ws = p.ws; LAS float* lf = (LAS float*)lds;
  const int tid0 = opaque_tid(); const int wid = tid0 >> 6, lane = tid0 & 63;
  for (int unit = blockIdx.x; unit < 576; unit += gridDim.x) {
    if (unit < 192) {
      matvec9_unit<1>(p.in[6], p.in[5], 1024, p.in[7], 6144, p.in[8], (float*)(ws + OFF_MOD), 6144, unit * 32, lf);
    } else if (unit < 480) {
      const int row = (unit - 192) * 8 + wid; const bool smp = row < 2048; const int L = smp ? 2048 : 256, t = smp ? row : row - 2048;
      const float* w1 = p.in[14]; const float* b1 = p.in[15]; const float* fr1 = p.in[16]; const float* w2 = p.in[17]; const float* b2 = p.in[18]; const float* fr2 = p.in[19];
      float a = b1[lane] + (float)t / (float)(L - 1) * w1[lane];
      const float base = (6.283185307179586f / (float)L) * (float)t;
      float cs = 0.f, sn = 0.f; if (lane < 16) { const float ang = base * (float)(lane + 1); cs = cosf(ang); sn = sinf(ang); }
#pragma unroll
      for (int i = 0; i < 16; ++i) a += __shfl(cs, i) * w1[(1 + i) * 64 + lane] + __shfl(sn, i) * w1[(17 + i) * 64 + lane];
      const float h1 = sinf(fr1[lane] * a);
      float a2 = b2[lane];
#pragma unroll 16
      for (int j = 0; j < 64; ++j) a2 += __shfl(h1, j) * w2[j * 64 + lane];
      const float h2 = sinf(fr2[lane] * a2);
      float* dst = (float*)(ws + (smp ? OFF_H2S : OFF_H2C)); dst[(size_t)t * 64 + lane] = h2;
    } else {
      const int r = unit - 480, c = tid0; const int pos = r < 32 ? r : r - 32; const int i = c & 255;
      const float omega = 1.0f / powf(10000.0f, (float)i / 256.0f); const float a = (float)pos * omega; const float v = c < 256 ? sinf(a) : cosf(a);
      float* dst = (float*)(ws + (r < 32 ? OFF_PER : OFF_PEC)); dst[(size_t)pos * 512 + c] = v;
    }
  }
}
__device__ void weight_tiles(const Params& p, LP lds, int lo, int hi, int upper) {
  unsigned char* ws = p.ws; LAS float* lf = (LAS float*)lds;
  const int nh = upper ? ((int)gridDim.x >> 1) : 0;
  if ((int)blockIdx.x < nh) return;
  for (int tu = lo + (int)blockIdx.x - nh; tu < hi; tu += (int)gridDim.x - nh) {
    const float* src; int ld, K, col0, k0, drow0; bf16_t* dst;
    if (tu < 1152) { const int nt = tu >> 4, kt = tu & 15; const int r = nt * 128; src = p.in[10]; ld = INC; K = 1024; k0 = kt * 64; drow0 = r; dst = (bf16_t*)(ws + OFF_WT);
      col0 = r < 3072 ? r : (r < 6144 ? 4112 + (r - 3072) : (r < 7168 ? 3072 + (r - 6144) : 7184 + (r - 7168))); }
    else if (tu < 1536) { const int v = tu - 1152, w = v >> 7, q = v & 127; src = p.in[23 + w]; ld = 1024; K = 1024; k0 = (q & 15) * 64; col0 = (q >> 4) * 128; drow0 = col0; dst = (bf16_t*)(ws + (w == 0 ? OFF_WBM : (w == 1 ? OFF_WBH : OFF_WOUT))); }
    else if (tu < 2048) { const int q = tu - 1536; src = p.in[27]; ld = 4096; K = 1024; k0 = (q & 15) * 64; col0 = (q >> 4) * 128; drow0 = col0; dst = (bf16_t*)(ws + OFF_W1T); }
    else { const int q = tu - 2048; src = p.in[29]; ld = 1024; K = 4096; k0 = (q & 63) * 64; col0 = (q >> 6) * 128; drow0 = col0; dst = (bf16_t*)(ws + OFF_W2T); }
    transpose_tile(src, ld, col0, k0, dst, K, drow0, lf);
  }
}

__device__ void phase1(const Params& p, LP lds) {
  unsigned char* ws = p.ws;
  int tid_ = threadIdx.x; asm volatile("" : "+v"(tid_));
  const int tid = tid_, wid = tid >> 6, lane = tid & 63;
  const float* mod = (const float*)(ws + OFF_MOD);
  LAS float* wg = (LAS float*)lds;
  if ((int)blockIdx.x < 1536) {
    f32x4 gw[8];
#pragma unroll
    for (int i = 0; i < 8; ++i) { const int idx = tid + 512 * i, k = idx >> 2, q = idx & 3; gw[i] = *(const f32x4*)(p.in[10] + (size_t)k * INC + 4096 + 4 * q); }
#pragma unroll
    for (int i = 0; i < 8; ++i) { const int idx = tid + 512 * i, k = idx >> 2, q = idx & 3; wg[(4 * q) * 1024 + k] = gw[i][0]; wg[(4 * q + 1) * 1024 + k] = gw[i][1]; wg[(4 * q + 2) * 1024 + k] = gw[i][2]; wg[(4 * q + 3) * 1024 + k] = gw[i][3]; }
    __syncthreads();
  }
  for (int unit = blockIdx.x; unit < 1536; unit += gridDim.x) {
    const int tidn = opaque_tid(); const int wid = tidn >> 6, lane = tidn & 63;
    const int row0 = unit * 16 + wid * 2; const int cb = cond_of_row(row0); const float* md = mod + cb * 6144; const bool smp = row0 >= NCTX;
    f32x4 v[2][4]; float rstd[2];
#pragma unroll
    for (int r = 0; r < 2; ++r) { const int row = row0 + r; const float* xr; int t = 0;
      if (!smp) xr = p.in[0] + (size_t)row * 1024; else { xr = p.in[1] + (size_t)(row - NCTX) * 1024; t = (row - NCTX) & 2047; }
      const float* per = (const float*)(ws + OFF_PER) + (t >> 6) * 512; const float* pec = (const float*)(ws + OFF_PEC) + (t & 63) * 512;
      float ss = 0.f;
#pragma unroll
      for (int i = 0; i < 4; ++i) { const int col = 4 * lane + 256 * i; v[r][i] = *(const f32x4*)(xr + col);
        if (smp) v[r][i] += (col < 512) ? *(const f32x4*)(per + col) : *(const f32x4*)(pec + col - 512);
        ss += v[r][i][0] * v[r][i][0] + v[r][i][1] * v[r][i][1] + v[r][i][2] * v[r][i][2] + v[r][i][3] * v[r][i][3]; }
      ss = wave_sum(ss); rstd[r] = rsqrtf(ss * (1.0f / 1024.0f) + 1e-6f); }
    const float* n1w = p.in[9];
    float ga[32];
#pragma unroll
    for (int g = 0; g < 32; ++g) ga[g] = 0.f;
#pragma unroll
    for (int i = 0; i < 4; ++i) { const int col = 4 * lane + 256 * i;
      const f32x4 w = *(const f32x4*)(n1w + col), sc = *(const f32x4*)(md + 1024 + col), sh = *(const f32x4*)(md + col);
      const f32x4 ws1 = w * (sc + 1.0f);
      f32x4 h[2];
#pragma unroll
      for (int r = 0; r < 2; ++r) { h[r] = v[r][i] * rstd[r] * ws1 + sh;
        u32x2 o; o.x = pack2(h[r][0], h[r][1]); o.y = pack2(h[r][2], h[r][3]); *(u32x2*)((bf16_t*)(ws + OFF_HN) + (size_t)(row0 + r) * 1024 + col) = o; }
#pragma unroll
      for (int g = 0; g < 16; ++g) { const f32x4 wv = *(const LAS f32x4*)(wg + g * 1024 + col);
#pragma unroll
        for (int r = 0; r < 2; ++r) ga[r * 16 + g] += h[r][0] * wv[0] + h[r][1] * wv[1] + h[r][2] * wv[2] + h[r][3] * wv[3]; }
      asm volatile("" ::: "memory"); }
#pragma unroll
    for (int off = 16; off >= 1; off >>= 1) { const bool hi = (lane & off) != 0;
#pragma unroll
      for (int i = 0; i < off; ++i) { const float send = hi ? ga[i] : ga[i + off]; const float keep = hi ? ga[i + off] : ga[i]; ga[i] = keep + __shfl_xor(send, off); } }
    const float tot = ga[0] + __shfl_xor(ga[0], 32);
    if (lane < 32) ((float*)(ws + OFF_GT))[(size_t)row0 * 16 + lane] = tot + p.in[11][4096 + (lane & 15)];
  }
  __syncthreads();
}
__device__ void filters_upper_half(const Params& p, LP lds) {
  unsigned char* ws = p.ws; const int nh = (int)gridDim.x >> 1;
  if ((int)blockIdx.x < nh) return;
  LAS float* w3s = (LAS float*)lds;
  for (int v = (int)blockIdx.x - nh; v < 320; v += (int)gridDim.x - nh) {
    const int tid = opaque_tid();
    const bool smp = v < 256; const int L = smp ? 2048 : 256; const int tt = smp ? (v >> 6) : 0, cgp = v & 63; const int t = tt * 512 + tid;
    { const f32x4 x = *(const f32x4*)(p.in[20] + (size_t)(tid >> 3) * 2048 + cgp * 32 + 4 * (tid & 7)); LAS float* wp = w3s + (4 * (tid & 7)) * 64 + (tid >> 3);
      wp[0] = x[0]; wp[64] = x[1]; wp[128] = x[2]; wp[192] = x[3]; }
    __syncthreads();
    if (t < L) {
      const float* H2 = (const float*)(ws + (smp ? OFF_H2S : OFF_H2C)) + (size_t)t * 64;
      f32x4 h2[16];
#pragma unroll
      for (int i = 0; i < 16; ++i) h2[i] = *(const f32x4*)(H2 + 4 * i);
      const float dist = fabsf((float)t - (float)(L / 2)) / (float)(L / 2);
      float* HF = (float*)(ws + (smp ? OFF_HFS : OFF_HFC)) + (size_t)(cgp * 32) * L + t;
#pragma unroll 1
      for (int j = 0; j < 32; ++j) {
        f32x4 a = {0.f, 0.f, 0.f, 0.f};
#pragma unroll
        for (int i = 0; i < 16; ++i) a += *(const LAS f32x4*)(w3s + j * 64 + 4 * i) * h2[i];
        const int c = (cgp * 32 + j) & 1023;
        const float dmin = -3.0701134573253946f, dmax = -15.350567286626973f;
        const float delta = fabsf(dmin + (dmax - dmin) * ((float)c / 1023.0f));
        HF[(size_t)j * L] = ((a[0] + a[1]) + (a[2] + a[3])) * __expf(-dist * delta); }
    }
    __syncthreads();
  }
}
__device__ void c1_upper_half(const Params& p, LP lds) {
  unsigned char* ws = p.ws; const float* mod = (const float*)(ws + OFF_MOD); const int nh = (int)gridDim.x >> 1;
  if ((int)blockIdx.x < nh) return;
  for (int u = (int)blockIdx.x - nh; u < 128; u += (int)gridDim.x - nh)
    matvec9_unit<0>(mod + 3072, mod + 6144 + 3072, 6144, p.in[27], 4096, p.in[28], (float*)(ws + OFF_C1), 4096, u * 32, (LAS float*)lds);
}

__device__ __forceinline__ bf16x8 tr_frag(LP base, int k0, int m0, int pitch  , int l15, int g) {
  const int q = l15 >> 2, pp = l15 & 3;
  LP a = base + ((k0 + 8 * g + q) * pitch + m0 + 4 * pp) * 2;
  const s16x4 lo = __builtin_amdgcn_ds_read_tr16_b64_v4i16((LAS s16x4*)a);
  const s16x4 hi = __builtin_amdgcn_ds_read_tr16_b64_v4i16((LAS s16x4*)(a + 8 * pitch));
  bf16x8 r; r[0] = lo[0]; r[1] = lo[1]; r[2] = lo[2]; r[3] = lo[3]; r[4] = hi[0]; r[5] = hi[1]; r[6] = hi[2]; r[7] = hi[3]; return r;
}
__device__ __forceinline__ bf16x8 tr_at(LP lanebase, int coff  , int pitch_bytes) {
  const s16x4 lo = __builtin_amdgcn_ds_read_tr16_b64_v4i16((LAS s16x4*)(lanebase + coff));
  const s16x4 hi = __builtin_amdgcn_ds_read_tr16_b64_v4i16((LAS s16x4*)(lanebase + coff + 4 * pitch_bytes));
  bf16x8 r; r[0] = lo[0]; r[1] = lo[1]; r[2] = lo[2]; r[3] = lo[3]; r[4] = hi[0]; r[5] = hi[1]; r[6] = hi[2]; r[7] = hi[3]; return r;
}
constexpr int ML_K = 0, ML_V = 67584, ML_P = 86016, ML_C = 120832, ML_T = 157696, ML_TSZ = 1600;
constexpr int KP = 264, VP = 72, PP = 136, CP = 72;

__device__ void mlstm_item(const Params& p, LP lds, int item) {
  const int tid = opaque_tid(), wid = __builtin_amdgcn_readfirstlane(tid >> 6), lane = tid & 63, l15 = lane & 15, g = lane >> 4;
  const bool smp = item < 256; const int uu = smp ? (item >> 2) : ((item - 256) >> 2); const int sl = item & 3;
  const int b = uu >> 3, dir = (uu >> 2) & 1, head = uu & 3;
  const int S = smp ? SEQS : SEQC, nc = S >> 7; const int tok0 = smp ? NCTX + b * SEQS : b * SEQC;
  const bf16_t* qkv = (const bf16_t*)(p.ws + OFF_BIG);
  const float* GT = (const float*)(p.ws + OFF_GT);
  bf16_t* hout = (bf16_t*)((unsigned char*)p.out + (dir ? OUT_HB : OUT_H));
  const int sidx = (b * 2 + dir) * 4 + head;
  const int gi_col = dir * 8 + head, gf_col = dir * 8 + 4 + head;
  f32x4 Cacc[2][4], nacc[2]; float mst0;
  if (smp) {
    const float* C0 = p.in[2] + (size_t)sidx * 65536;
#pragma unroll
    for (int dt = 0; dt < 2; ++dt) {
#pragma unroll
      for (int vt = 0; vt < 4; ++vt) Cacc[dt][vt] = *(const f32x4*)(C0 + (size_t)((2 * wid + dt) * 16 + l15) * 256 + sl * 64 + 16 * vt + 4 * g);
      nacc[dt] = (f32x4){p.in[3][sidx * 256 + (2 * wid + dt) * 16 + l15], 0.f, 0.f, 0.f}; }
    mst0 = p.in[4][sidx];
  } else {
#pragma unroll
    for (int dt = 0; dt < 2; ++dt) {
#pragma unroll
      for (int vt = 0; vt < 4; ++vt) Cacc[dt][vt] = (f32x4){0.f, 0.f, 0.f, 0.f};
      nacc[dt] = (f32x4){0.f, 0.f, 0.f, 0.f}; }
    mst0 = 0.f;
  }
#define TOKC(cc, j) (dir ? (tok0 + S - 1 - ((cc) * 128 + (j))) : (tok0 + (cc) * 128 + (j)))
  const int rt = (wid < 4) ? wid : 11 - wid;
  const int jrow = 16 * rt + l15;
  bf16x8 qf[8]; u32x4 kreg[8], vreg[2]; float g4[4] = {0.f, 0.f, 0.f, 0.f};
#define ML_LOAD_Q(cc) do { const bf16_t* qp = qkv + (size_t)TOKC(cc, jrow) * 3072 + head * 256 + 8 * g; \
    _Pragma("unroll") for (int kk = 0; kk < 8; ++kk) qf[kk] = *(const bf16x8*)(qp + 32 * kk); } while (0)
#define ML_LOAD_KV(cc) do { \
    _Pragma("unroll") for (int i = 0; i < 8; ++i) { const int row = (tid >> 5) + 16 * i; kreg[i] = *(const u32x4*)(qkv + (size_t)TOKC(cc, row) * 3072 + 1024 + head * 256 + (tid & 31) * 8); } \
    _Pragma("unroll") for (int i = 0; i < 2; ++i) { const int row = (tid >> 3) + 64 * i; vreg[i] = *(const u32x4*)(qkv + (size_t)TOKC(cc, row) * 3072 + 2048 + head * 256 + sl * 64 + (tid & 7) * 8); } \
    if (wid == 0) { const float* g0 = GT + (size_t)TOKC(cc, 2 * lane) * 16; const float* g1 = GT + (size_t)TOKC(cc, 2 * lane + 1) * 16; g4[0] = g0[gi_col]; g4[1] = g0[gf_col]; g4[2] = g1[gi_col]; g4[3] = g1[gf_col]; } } while (0)
#define ML_SCAN(tabp, mcur, mnext) do { LAS float* T_ = (LAS float*)(tabp); \
    const float lf0 = fminf(g4[1], 0.f) - log1pf(__expf(-fabsf(g4[1]))), lf1 = fminf(g4[3], 0.f) - log1pf(__expf(-fabsf(g4[3]))); \
    float s_ = lf0 + lf1; \
    _Pragma("unroll") for (int o = 1; o < 64; o <<= 1) { const float t_ = __shfl_up(s_, o); if (lane >= o) s_ += t_; } \
    const float b1_ = s_, b0_ = s_ - lf1; const float u0_ = g4[0] - b0_, u1_ = g4[2] - b1_; \
    float mx_ = fmaxf(u0_, u1_); \
    _Pragma("unroll") for (int o = 1; o < 64; o <<= 1) { const float t_ = __shfl_up(mx_, o); if (lane >= o) mx_ = fmaxf(mx_, t_); } \
    float ex_ = __shfl_up(mx_, 1); if (lane == 0) ex_ = -INFINITY; \
    const float M0_ = fmaxf(mcur, fmaxf(ex_, u0_)), M1_ = fmaxf(mcur, mx_); \
    T_[2 * lane] = u0_; T_[2 * lane + 1] = u1_; T_[128 + 2 * lane] = M0_; T_[128 + 2 * lane + 1] = M1_; T_[256 + 2 * lane] = b0_; T_[256 + 2 * lane + 1] = b1_; \
    const float Ml_ = __shfl(M1_, 63), bl_ = __shfl(b1_, 63); \
    if (lane == 0) { T_[384] = mcur; T_[385] = Ml_; } \
    mnext = bl_ + Ml_; } while (0)
  float mw0 = mst0;
  ML_LOAD_Q(0); ML_LOAD_KV(0);
  if (wid == 0) { float mn; ML_SCAN(lds + ML_T, mw0, mn); mw0 = mn; }
  __syncthreads();
  float m_final = 0.f;
  for (int c = 0; c < nc; ++c) {
    LAS float* T = (LAS float*)(lds + ML_T + (c & 1) * ML_TSZ);
    const float mst = T[384], M_last = T[385];
#pragma unroll
    for (int i = 0; i < 8; ++i) { const int row = (tid >> 5) + 16 * i; *(LAS u32x4*)(lds + ML_K + (row * KP + (tid & 31) * 8) * 2) = kreg[i]; }
#pragma unroll
    for (int i = 0; i < 2; ++i) { const int row = (tid >> 3) + 64 * i; const float w = __expf(T[row] - M_last); const u32x4 v = vreg[i]; u32x4 o;
      o.x = pack2(bflo(v.x) * w, bfhi(v.x) * w); o.y = pack2(bflo(v.y) * w, bfhi(v.y) * w); o.z = pack2(bflo(v.z) * w, bfhi(v.z) * w); o.w = pack2(bflo(v.w) * w, bfhi(v.w) * w);
      *(LAS u32x4*)(lds + ML_V + (row * VP + (tid & 7) * 8) * 2) = o; }
    if (tid < 128) *(LAS unsigned short*)(lds + ML_V + (tid * VP + 64) * 2) = f2bf(__expf(T[tid] - M_last));
#pragma unroll
    for (int dt = 0; dt < 2; ++dt) {
#pragma unroll
      for (int vt = 0; vt < 4; ++vt) { u32x2 w; w.x = pack2(Cacc[dt][vt][0], Cacc[dt][vt][1]); w.y = pack2(Cacc[dt][vt][2], Cacc[dt][vt][3]);
        *(LAS u32x2*)(lds + ML_C + (((2 * wid + dt) * 16 + l15) * CP + 16 * vt + 4 * g) * 2) = w; }
      if (g == 0) *(LAS unsigned short*)(lds + ML_C + (((2 * wid + dt) * 16 + l15) * CP + 64) * 2) = f2bf(nacc[dt][0]); }
    const int qtok = TOKC(c, jrow);
    const bool more = (c + 1 < nc);
    __syncthreads();
    const float Mj = T[128 + jrow], bj = T[256 + jrow]; const float rf = __expf(M_last - Mj), w_inter = __expf(mst - Mj);
    int lq_ = (8 * g + (l15 >> 2)), lp_ = 4 * (l15 & 3); asm volatile("" : "+v"(lq_), "+v"(lp_));
    const LP cB = lds + ML_C + (lq_ * CP + lp_) * 2, vB = lds + ML_V + (lq_ * VP + lp_) * 2, kB = lds + ML_K + (lq_ * KP + lp_ + 32 * wid) * 2;
    const LP pB = lds + ML_P + (jrow * PP + 8 * g) * 2;
    for (int st = 0; st <= rt; ++st) {
      f32x4 s = {0.f, 0.f, 0.f, 0.f};
      bf16x8 kfr[8];
#pragma unroll
      for (int kk = 0; kk < 8; ++kk) kfr[kk] = *(const LAS bf16x8*)(lds + ML_K + ((16 * st + l15) * KP + 32 * kk + 8 * g) * 2);
      __builtin_amdgcn_sched_barrier(0);
#pragma unroll
      for (int kk = 0; kk < 8; ++kk) s = __builtin_amdgcn_mfma_f32_16x16x32_bf16(kfr[kk], qf[kk], s, 0, 0, 0);
      float pv[4];
#pragma unroll
      for (int i = 0; i < 4; ++i) pv[i] = ((16 * st + 4 * g + i) <= jrow) ? s[i] * rf : 0.f;
      u32x2 w; w.x = pack2(pv[0], pv[1]); w.y = pack2(pv[2], pv[3]);
      *(LAS u32x2*)(lds + ML_P + (jrow * PP + 16 * st + 4 * g) * 2) = w;
    }
    if ((rt & 1) == 0) { u32x2 z; z.x = 0u; z.y = 0u; *(LAS u32x2*)(lds + ML_P + (jrow * PP + 16 * (rt + 1) + 4 * g) * 2) = z; }
    if (more) ML_LOAD_KV(c + 1);
    asm volatile("s_waitcnt lgkmcnt(0)" ::: "memory");
    f32x4 ha[5];
#pragma unroll
    for (int vt = 0; vt < 5; ++vt) { f32x4 a = {0.f, 0.f, 0.f, 0.f};
      if (smp || c > 0) {
        bf16x8 cfr[8];
#pragma unroll
        for (int kk = 0; kk < 8; ++kk) cfr[kk] = tr_at(cB, (32 * kk * CP + 16 * vt) * 2, CP * 2);
        __builtin_amdgcn_sched_barrier(0);
#pragma unroll
        for (int kk = 0; kk < 8; ++kk) a = __builtin_amdgcn_mfma_f32_16x16x32_bf16(cfr[kk], qf[kk], a, 0, 0, 0);
        a *= w_inter; }
      ha[vt] = a; }
    for (int k2 = 0; k2 <= (rt >> 1); ++k2) {
      const bf16x8 pf = *(const LAS bf16x8*)(pB + k2 * 64);
      bf16x8 vfr[5];
#pragma unroll
      for (int vt = 0; vt < 5; ++vt) vfr[vt] = tr_at(vB + k2 * (32 * VP * 2), (16 * vt) * 2, VP * 2);
      __builtin_amdgcn_sched_barrier(0);
#pragma unroll
      for (int vt = 0; vt < 5; ++vt) ha[vt] = __builtin_amdgcn_mfma_f32_16x16x32_bf16(vfr[vt], pf, ha[vt], 0, 0, 0); }
    { const float den = __shfl(ha[4][0], l15); const float rdd = 1.0f / fmaxf(fabsf(den), __expf(-(bj + Mj)));
#pragma unroll
      for (int vt = 0; vt < 4; ++vt) { const f32x4 a = ha[vt] * rdd; u32x2 w; w.x = pack2(a[0], a[1]); w.y = pack2(a[2], a[3]);
        *(u32x2*)(hout + (size_t)qtok * 1024 + head * 256 + sl * 64 + 16 * vt + 4 * g) = w; } }
    if (more) ML_LOAD_Q(c + 1);
    const bool need_state = (!smp) || more;
    if (need_state) {
      const float decay = __expf(mst - M_last);
#pragma unroll
      for (int dt = 0; dt < 2; ++dt) {
#pragma unroll
        for (int vt = 0; vt < 4; ++vt) Cacc[dt][vt] *= decay;
        nacc[dt] *= decay; }
#pragma unroll
      for (int ks = 0; ks < 4; ++ks) {
        const bf16x8 kf0 = tr_at(kB, (32 * ks * KP) * 2, KP * 2), kf1 = tr_at(kB, (32 * ks * KP + 16) * 2, KP * 2);
        bf16x8 vfr[5];
#pragma unroll
        for (int vt = 0; vt < 5; ++vt) vfr[vt] = tr_at(vB, (32 * ks * VP + 16 * vt) * 2, VP * 2);
        __builtin_amdgcn_sched_barrier(0);
#pragma unroll
        for (int vt = 0; vt < 4; ++vt) { Cacc[0][vt] = __builtin_amdgcn_mfma_f32_16x16x32_bf16(vfr[vt], kf0, Cacc[0][vt], 0, 0, 0); Cacc[1][vt] = __builtin_amdgcn_mfma_f32_16x16x32_bf16(vfr[vt], kf1, Cacc[1][vt], 0, 0, 0); }
        nacc[0] = __builtin_amdgcn_mfma_f32_16x16x32_bf16(vfr[4], kf0, nacc[0], 0, 0, 0); nacc[1] = __builtin_amdgcn_mfma_f32_16x16x32_bf16(vfr[4], kf1, nacc[1], 0, 0, 0);
      }
    }
    if (wid == 0 && more) { float mn; ML_SCAN(lds + ML_T + ((c + 1) & 1) * ML_TSZ, mw0, mn); mw0 = mn; }
    m_final = T[256 + 127] + M_last;
    __syncthreads();
  }
#undef ML_LOAD_Q
#undef ML_LOAD_KV
#undef ML_SCAN
#undef TOKC
  if (!smp) {
    float* oC = p.out + OUTF_C + (size_t)sidx * 65536;
#pragma unroll
    for (int dt = 0; dt < 2; ++dt) {
#pragma unroll
      for (int vt = 0; vt < 4; ++vt) *(f32x4*)(oC + (size_t)((2 * wid + dt) * 16 + l15) * 256 + sl * 64 + 16 * vt + 4 * g) = Cacc[dt][vt];
      if (sl == 0 && g == 0) p.out[OUTF_N + (size_t)sidx * 256 + (2 * wid + dt) * 16 + l15] = nacc[dt][0]; }
    if (sl == 0 && tid == 0) p.out[OUTF_M + sidx] = m_final;
  }
}

__device__ void combine_rows(const Params& p) {
  const int tid0 = opaque_tid(); const int wid = tid0 >> 6, lane = tid0 & 63;
  bf16_t* H = (bf16_t*)((unsigned char*)p.out + OUT_H); const bf16_t* HB = (const bf16_t*)((unsigned char*)p.out + OUT_HB); const float* nw = p.in[22];
  f32x4 wv[4];
#pragma unroll
  for (int i = 0; i < 4; ++i) wv[i] = *(const f32x4*)(nw + 16 * lane + 4 * i);
  const int nh = (int)gridDim.x >> 1;
  if ((int)blockIdx.x < nh) return;
  for (int unit = (int)blockIdx.x - nh; unit < 768; unit += (int)gridDim.x - nh) {
    const int row0 = unit * 32 + wid * 4;
    u32x4 a[4][2], bq[4][2];
#pragma unroll
    for (int r = 0; r < 4; ++r)
#pragma unroll
      for (int i = 0; i < 2; ++i) { a[r][i] = *(const u32x4*)(H + (size_t)(row0 + r) * 1024 + 16 * lane + 8 * i); bq[r][i] = *(const u32x4*)(HB + (size_t)(row0 + r) * 1024 + 16 * lane + 8 * i); }
#pragma unroll
    for (int r = 0; r < 4; ++r) {
      f32x4 v[4]; float ss = 0.f;
#pragma unroll
      for (int i = 0; i < 2; ++i) { f32x4 x0, x1, y0, y1; unpack8(a[r][i], x0, x1); unpack8(bq[r][i], y0, y1); v[2 * i] = x0 + y0; v[2 * i + 1] = x1 + y1; }
#pragma unroll
      for (int i = 0; i < 4; ++i) ss += v[i][0] * v[i][0] + v[i][1] * v[i][1] + v[i][2] * v[i][2] + v[i][3] * v[i][3];
      ss += __shfl_xor(ss, 1); ss += __shfl_xor(ss, 2); ss += __shfl_xor(ss, 4); ss += __shfl_xor(ss, 8);
      const float rr = rsqrtf(ss * (1.0f / 256.0f) + 1e-6f);
#pragma unroll
      for (int i = 0; i < 2; ++i) *(u32x4*)(H + (size_t)(row0 + r) * 1024 + 16 * lane + 8 * i) = pack8(v[2 * i] * rr * wv[2 * i], v[2 * i + 1] * rr * wv[2 * i + 1]);
    }
  }
}

constexpr int HY_WAVE = 18816, HY_HR = 0, HY_ZA = 8576, HY_ZB = 8576 + 5120;
__device__ void hyena_item(const Params& p, LP lds, int item) {
  const int tid = opaque_tid(), wid = __builtin_amdgcn_readfirstlane(tid >> 6), lane = tid & 63, n31 = lane & 31, hh = lane >> 5;
  const bool smp = item < 1024; const int it = smp ? item : item - 1024; const int bset = it >> 7, cgp = it & 127; const int c = cgp * 8 + wid;
  const int L = smp ? 2048 : 256, lgL = smp ? 11 : 8, nblk = L >> 5, lgnb = lgL - 5, ntok = smp ? 2048 : 1024, ntile = smp ? 2 : 1, dmax = L >> 6;
  const int tok0 = smp ? NCTX + bset * 2048 : bset * 1024;
  LP wl = lds + wid * HY_WAVE; LAS float* hr = (LAS float*)(wl + HY_HR);
  const float* HFp = (const float*)(p.ws + (smp ? OFF_HFS : OFF_HFC));
  const bf16_t* UT = (const bf16_t*)(p.ws + OFF_BIG);
  const float* cw = p.in[12]; const float* cbv = p.in[13]; const float* skp = p.in[21];
  { const int uc = 2048 + c; const float w0 = cw[uc], w1 = cw[3072 + uc], w2 = cw[6144 + uc], cb = cbv[uc]; const bf16_t* src = UT + (size_t)uc * NTOK + tok0;
    u32x4 vv[4]; float pvv[4], nxv[4];
#pragma unroll
    for (int i = 0; i < 4; ++i) { const int base = lane * 8 + 512 * i; vv[i] = (u32x4){0u, 0u, 0u, 0u}; pvv[i] = 0.f; nxv[i] = 0.f;
      if (base < ntok) { vv[i] = *(const u32x4*)(src + base); const int tl = base & (L - 1);
        if (tl != 0) pvv[i] = bf2f(src[base - 1]); if (tl + 8 != L) nxv[i] = bf2f(src[base + 8]); } }
#pragma unroll
    for (int i = 0; i < 4; ++i) { const int base = lane * 8 + 512 * i;
      if (base < ntok) { const u32x4 v = vv[i];
        float u[10]; u[0] = pvv[i]; u[1] = bflo(v.x); u[2] = bfhi(v.x); u[3] = bflo(v.y); u[4] = bfhi(v.y); u[5] = bflo(v.z); u[6] = bfhi(v.z); u[7] = bflo(v.w); u[8] = bfhi(v.w); u[9] = nxv[i];
        float o[8];
#pragma unroll
        for (int e = 0; e < 8; ++e) o[e] = cb + w0 * u[e] + w1 * u[e + 1] + w2 * u[e + 2];
        u32x4 w; w.x = pack2(o[0], o[1]); w.y = pack2(o[2], o[3]); w.z = pack2(o[4], o[5]); w.w = pack2(o[6], o[7]);
        *(LAS u32x4*)(wl + HY_ZA + ((base >> 5) * 40 + (base & 31)) * 2) = w; } } }
  const int HRP = L + 96;
  f32x4 fvN[8];
#define HY_FLOAD(o) do { const float* src_ = HFp + (size_t)((o) * 1024 + c) * L; \
    _Pragma("unroll") for (int i = 0; i < 8; ++i) { const int q = lane + 64 * i; fvN[i] = (4 * q < L) ? *(const f32x4*)(src_ + 4 * q) : (f32x4){0.f, 0.f, 0.f, 0.f}; } } while (0)
  HY_FLOAD(0);
  for (int ord = 0; ord < 2; ++ord) {
    { float sa = 0.f;
      f32x4 fv[8];
#pragma unroll
      for (int i = 0; i < 8; ++i) fv[i] = fvN[i];
#pragma unroll
      for (int i = 0; i < 8; ++i) sa += (fabsf(fv[i][0]) + fabsf(fv[i][1])) + (fabsf(fv[i][2]) + fabsf(fv[i][3]));
      sa = wave_sum(sa); const float inv = 1.0f / (sa + 1e-6f);
      asm volatile("s_waitcnt lgkmcnt(0)" ::: "memory");
      LAS bf16_t* E = (LAS bf16_t*)hr; LAS bf16_t* O = E + HRP;
#pragma unroll
      for (int i = 0; i < 8; ++i) { const int q = lane + 64 * i;
        if (4 * q < L) {
#pragma unroll
          for (int e = 0; e < 4; ++e) { const int yy = L - 1 - (4 * q + e); const bf16_t v = f2bf(fv[i][e] * inv); E[32 + yy] = v; O[31 + yy] = v; } } }
      if (lane < 32) { E[lane] = 0; E[32 + L + lane] = 0; O[31 + L + lane] = 0; if (lane < 31) O[lane] = 0; }
      if (lane < 33) O[HRP - 33 + lane] = 0;
      asm volatile("s_waitcnt lgkmcnt(0)" ::: "memory"); }
    if (ord == 0) HY_FLOAD(1);
    LP zin = wl + (ord == 0 ? HY_ZA : HY_ZB); LP zout = wl + (ord == 0 ? HY_ZB : HY_ZA);
    const int gc = ord * 1024 + c; const float w0 = cw[gc], w1 = cw[3072 + gc], w2 = cw[6144 + gc], cb = cbv[gc], sk = skp[ord * 1024 + c];
    const bf16_t* gsrc = UT + (size_t)gc * NTOK + tok0;
    u32x4 gv[4]; unsigned gpv[4], gnx[4];
#pragma unroll
    for (int i = 0; i < 4; ++i) { const int base = lane * 8 + 512 * i; gv[i] = (u32x4){0u, 0u, 0u, 0u}; gpv[i] = 0u; gnx[i] = 0u;
      if (base < ntok) { gv[i] = *(const u32x4*)(gsrc + base); const int tl = base & (L - 1);
        if (tl != 0) gpv[i] = gsrc[base - 1]; if (tl + 8 != L) gnx[i] = gsrc[base + 8]; } }
    f32x16 accs[2];
#pragma unroll
    for (int o2 = 0; o2 < 2; ++o2)
#pragma unroll
      for (int r = 0; r < 16; ++r) accs[o2][r] = 0.f;
    LP fb = wl + HY_HR + ((n31 & 1) ? 0 : (HRP * 2 - 2)) + 2 * ((L >> 1) - 1 - n31 + 8 * hh + 32);
    int cbl[2], ca[2];
#pragma unroll
    for (int ot = 0; ot < 2; ++ot) { const int col = 32 * ot + n31; cbl[ot] = (col >> lgnb) << lgnb; ca[ot] = col & (nblk - 1); }
    const bool two = (ntile == 2);
    {
      LP zero = wl + HY_HR + 16 * hh;
      LP ap = fb + 64 * dmax;
      int bbr0 = ca[0] + dmax, bbr1 = ca[1] + dmax;
      LP bp0 = zin + ((cbl[0] + bbr0) * 40 + 8 * hh) * 2, bp1 = zin + ((cbl[1] + bbr1) * 40 + 8 * hh) * 2;
      for (int d = -dmax; d <= dmax; ++d) {
        u32x4 w0v, w1v;
        w0v.x = *(const LAS unsigned*)(ap); w0v.y = *(const LAS unsigned*)(ap + 4); w0v.z = *(const LAS unsigned*)(ap + 8); w0v.w = *(const LAS unsigned*)(ap + 12);
        w1v.x = *(const LAS unsigned*)(ap + 32); w1v.y = *(const LAS unsigned*)(ap + 36); w1v.z = *(const LAS unsigned*)(ap + 40); w1v.w = *(const LAS unsigned*)(ap + 44);
        const bf16x8 af0 = __builtin_bit_cast(bf16x8, w0v), af1 = __builtin_bit_cast(bf16x8, w1v);
        LP q0 = ((unsigned)bbr0 < (unsigned)nblk) ? bp0 : zero;
        LP q1 = (two && ((unsigned)bbr1 < (unsigned)nblk)) ? bp1 : zero;
        const bf16x8 b00 = *(const LAS bf16x8*)q0, b01 = *(const LAS bf16x8*)(q0 + 32);
        const bf16x8 b10 = *(const LAS bf16x8*)q1, b11 = *(const LAS bf16x8*)(q1 + 32);
        __builtin_amdgcn_sched_barrier(0);
        accs[0] = __builtin_amdgcn_mfma_f32_32x32x16_bf16(af0, b00, accs[0], 0, 0, 0);
        if (two) accs[1] = __builtin_amdgcn_mfma_f32_32x32x16_bf16(af0, b10, accs[1], 0, 0, 0);
        accs[0] = __builtin_amdgcn_mfma_f32_32x32x16_bf16(af1, b01, accs[0], 0, 0, 0);
        if (two) accs[1] = __builtin_amdgcn_mfma_f32_32x32x16_bf16(af1, b11, accs[1], 0, 0, 0);
        ap -= 64; bbr0 -= 1; bbr1 -= 1; bp0 -= 80; bp1 -= 80;
      }
    }
#pragma unroll
    for (int ot = 0; ot < 2; ++ot) {
      if (ot >= ntile) continue;
      const f32x16 acc = accs[ot];
#pragma unroll
      for (int rg = 0; rg < 4; ++rg) {
        const int zo = (((cbl[ot] + ca[ot]) * 40) + 8 * rg + 4 * hh) * 2;
        const u32x2 zv = *(const LAS u32x2*)(zin + zo);
        u32x2 w; w.x = pack2(acc[4 * rg] + sk * bflo(zv.x), acc[4 * rg + 1] + sk * bfhi(zv.x)); w.y = pack2(acc[4 * rg + 2] + sk * bflo(zv.y), acc[4 * rg + 3] + sk * bfhi(zv.y));
        *(LAS u32x2*)(zout + zo) = w;
      }
    }
    asm volatile("s_waitcnt lgkmcnt(0)" ::: "memory");
#pragma unroll
    for (int i = 0; i < 4; ++i) { const int base = lane * 8 + 512 * i;
      if (base < ntok) { const u32x4 v = gv[i];
        float u[10]; u[0] = bf2f(gpv[i]); u[1] = bflo(v.x); u[2] = bfhi(v.x); u[3] = bflo(v.y); u[4] = bfhi(v.y); u[5] = bflo(v.z); u[6] = bfhi(v.z); u[7] = bflo(v.w); u[8] = bfhi(v.w); u[9] = bf2f(gnx[i]);
        LP zp = zout + ((base >> 5) * 40 + (base & 31)) * 2; const u32x4 t = *(const LAS u32x4*)zp;
        float tv[8]; tv[0] = bflo(t.x); tv[1] = bfhi(t.x); tv[2] = bflo(t.y); tv[3] = bfhi(t.y); tv[4] = bflo(t.z); tv[5] = bfhi(t.z); tv[6] = bflo(t.w); tv[7] = bfhi(t.w);
        float o[8];
#pragma unroll
        for (int e = 0; e < 8; ++e) o[e] = (cb + w0 * u[e] + w1 * u[e + 1] + w2 * u[e + 2]) * tv[e];
        u32x4 w; w.x = pack2(o[0], o[1]); w.y = pack2(o[2], o[3]); w.z = pack2(o[4], o[5]); w.w = pack2(o[6], o[7]);
        *(LAS u32x4*)zp = w; } }
    asm volatile("s_waitcnt lgkmcnt(0)" ::: "memory");
  }
  __syncthreads();
  { bf16_t* YH = (bf16_t*)((unsigned char*)p.out + OUT_HB);
    for (int tl = tid; tl < ntok; tl += 512) {
      const int bl = tl >> lgL, tloc = tl & (L - 1); const int zo = ((((bl << lgnb) + (tloc >> 5)) * 40) + (tloc & 31)) * 2;
      unsigned short e[8];
#pragma unroll
      for (int w = 0; w < 8; ++w) e[w] = *(const LAS unsigned short*)(lds + w * HY_WAVE + HY_ZA + zo);
      u32x4 o; o.x = e[0] | ((unsigned)e[1] << 16); o.y = e[2] | ((unsigned)e[3] << 16); o.z = e[4] | ((unsigned)e[5] << 16); o.w = e[6] | ((unsigned)e[7] << 16);
      *(u32x4*)(YH + (size_t)(tok0 + tl) * 1024 + cgp * 8) = o; } }
  __syncthreads();
}

__device__ void final_norm(const Params& p) {
  const int tid0 = opaque_tid(); const int wid = tid0 >> 6, lane = tid0 & 63; const float* fw = p.in[31];
  const float* P = (const float*)(p.ws + OFF_BIG + (size_t)8192 * 4096 * 2); const float* mod = (const float*)(p.ws + OFF_MOD);
  f32x4 wv[4];
#pragma unroll
  for (int i = 0; i < 4; ++i) wv[i] = *(const f32x4*)(fw + 4 * lane + 256 * i);
  for (int unit = blockIdx.x; unit < 768; unit += gridDim.x) {
    const int row0 = unit * 32 + wid * 4; const bool chunkB = row0 >= 16384;
    f32x4 x[4][4];
#pragma unroll
    for (int r = 0; r < 4; ++r)
#pragma unroll
      for (int i = 0; i < 4; ++i) x[r][i] = *(const f32x4*)(p.out + (size_t)(row0 + r) * 1024 + 4 * lane + 256 * i);
    if (chunkB) { const float* md = mod + cond_of_row(row0) * 6144 + 5120;
#pragma unroll
      for (int i = 0; i < 4; ++i) { const f32x4 g2 = *(const f32x4*)(md + 4 * lane + 256 * i);
#pragma unroll
        for (int r = 0; r < 4; ++r) x[r][i] += g2 * *(const f32x4*)(P + (size_t)(row0 + r - 16384) * 1024 + 4 * lane + 256 * i); } }
#pragma unroll
    for (int r = 0; r < 4; ++r) { float ss = 0.f;
#pragma unroll
      for (int i = 0; i < 4; ++i) ss += x[r][i][0] * x[r][i][0] + x[r][i][1] * x[r][i][1] + x[r][i][2] * x[r][i][2] + x[r][i][3] * x[r][i][3];
      ss = wave_sum(ss); const float rstd = rsqrtf(ss * (1.0f / 1024.0f) + 1e-6f);
#pragma unroll
      for (int i = 0; i < 4; ++i) *(f32x4*)(p.out + (size_t)(row0 + r) * 1024 + 4 * lane + 256 * i) = x[r][i] * rstd * wv[i]; }
  }
}

__global__ void __launch_bounds__(512, 2) __attribute__((flatten)) mega(Params p) {
  extern __shared__ __attribute__((aligned(16))) unsigned char shm[];
  LP lds = (LP)shm;
  cg::grid_group grid = cg::this_grid();
  volatile LAS unsigned* xst = (volatile LAS unsigned*)(lds + LDS_BYTES - 16);
  if (threadIdx.x == 0) { xst[0] = 0u; xst[1] = 0u; }
  __syncthreads();
  const XcdBarrier xb = xcd_barrier_post((unsigned*)(p.ws + OFF_BAR), xst);
  unsigned char* ws = p.ws;
  const bf16_t* WT = (const bf16_t*)(ws + OFF_WT); const bf16_t* HN = (const bf16_t*)(ws + OFF_HN); bf16_t* BIG = (bf16_t*)(ws + OFF_BIG);
  bf16_t* Hb = (bf16_t*)((unsigned char*)p.out + OUT_H); bf16_t* YH = (bf16_t*)((unsigned char*)p.out + OUT_HB);
  const float* mod = (const float*)(ws + OFF_MOD);
  phase0(p, lds);
  if (gridDim.y == 7u) grid.sync();
  xcd_barrier(xb);
  phase1(p, lds);
  weight_tiles(p, lds, 0, 384, 0);
  xcd_barrier(xb);
  filters_upper_half(p, lds);
  weight_tiles(p, lds, 384, 768, 1);
  { EpiQKV e; e.O = BIG; e.bias = p.in[11]; run_gemm(lds, HN, WT, NTOK, 3072, 1024, e); }
  xcd_barrier(xb);
  for (int item = blockIdx.x; item < 1280; item += gridDim.x) mlstm_item(p, lds, item);
  xcd_barrier(xb);
  combine_rows(p);
  weight_tiles(p, lds, 768, 1152, 1);
  { EpiUT e; e.O = BIG; e.bias = p.in[11] + 4112; run_gemm(lds, WT + (size_t)3072 * 1024, HN, 3072, NTOK, 1024, e); }
  xcd_barrier(xb);
  for (int item = blockIdx.x; item < 2048; item += gridDim.x) hyena_item(p, lds, item);
  xcd_barrier(xb);
  c1_upper_half(p, lds);
  weight_tiles(p, lds, 1152, 1536, 1);
  { EpiGates e; e.H = Hb; e.G = BIG; e.b_in = p.in[11]; run_gemm(lds, HN, WT + (size_t)6144 * 1024, NTOK, 3072, 1024, e); }
  xcd_barrier(xb);
  bf16_t* T = BIG + (size_t)NTOK * 2048;
  weight_tiles(p, lds, 1536, 2560, 1);
  { EpiMerge<0> e; e.T = T; e.G = BIG; run_gemm(lds, Hb, (const bf16_t*)(ws + OFF_WBM), NTOK, 1024, 1024, e); }
  { EpiMerge<1> e; e.T = T; e.G = BIG; run_gemm(lds, YH, (const bf16_t*)(ws + OFF_WBH), NTOK, 1024, 1024, e); }
  xcd_barrier(xb);
  { EpiOut e; e.xp = p.in[0]; e.xs = p.in[1]; e.per = (const float*)(ws + OFF_PER); e.pec = (const float*)(ws + OFF_PEC); e.mod = mod; e.n2w = p.in[26];
    e.X1 = p.out; e.A2 = (bf16_t*)(ws + OFF_HN); e.ssq = (float*)(ws + OFF_SSQ1); run_gemm(lds, T, (const bf16_t*)(ws + OFF_WOUT), NTOK, 1024, 1024, e); }
  xcd_barrier(xb);
  constexpr int ROWS_A = 16384, ROWS_B = NTOK - ROWS_A;
  { EpiFF1 e; e.row0 = 0; e.ssq = (const float*)(p.ws + OFF_SSQ1); e.c1 = (const float*)(p.ws + OFF_C1); e.Hd = (bf16_t*)(p.ws + OFF_BIG);
    run_gemm(lds, (const bf16_t*)(p.ws + OFF_HN), (const bf16_t*)(p.ws + OFF_W1T), ROWS_A, 4096, 1024, e); }
  xcd_barrier(xb);
  { EpiFF2 e; e.row0 = 0; e.mod = (const float*)(p.ws + OFF_MOD); e.b2 = p.in[30]; e.X = p.out; e.P = (float*)(p.ws + OFF_BIG + (size_t)ROWS_A * 4096 * 2);
    run_gemm(lds, (const bf16_t*)(p.ws + OFF_BIG), (const bf16_t*)(p.ws + OFF_W2T), ROWS_A, 1024, 4096, e); }
  xcd_barrier(xb);
  { EpiFF1 e; e.row0 = ROWS_A; e.ssq = (const float*)(p.ws + OFF_SSQ1); e.c1 = (const float*)(p.ws + OFF_C1); e.Hd = (bf16_t*)(p.ws + OFF_BIG);
    run_gemm(lds, (const bf16_t*)(p.ws + OFF_HN) + (size_t)ROWS_A * 1024, (const bf16_t*)(p.ws + OFF_W1T), ROWS_B, 4096, 1024, e); }
  xcd_barrier(xb);
  { EpiFF2 e; e.row0 = ROWS_A; e.mod = (const float*)(p.ws + OFF_MOD); e.b2 = p.in[30]; e.X = p.out; e.P = (float*)(p.ws + OFF_BIG + (size_t)ROWS_B * 4096 * 2);
    run_gemm(lds, (const bf16_t*)(p.ws + OFF_BIG), (const bf16_t*)(p.ws + OFF_W2T), ROWS_B, 1024, 4096, e, 2); }
  xcd_barrier(xb);
  final_norm(p);
}

extern "C" void kernel_launch(void* const* d_in, const int* in_sizes, int n_in, void* d_out, int out_size, void* d_ws, size_t ws_size, hipStream_t stream) {
  static int grid_blocks = 0;
  if (!grid_blocks) {
    int dev = 0, cus = 0, per_cu = 0;
    hipGetDevice(&dev);
    hipDeviceGetAttribute(&cus, hipDeviceAttributeMultiprocessorCount, dev);
    hipFuncSetAttribute((const void*)mega, hipFuncAttributeMaxDynamicSharedMemorySize, LDS_BYTES);
    hipOccupancyMaxActiveBlocksPerMultiprocessor(&per_cu, (const void*)mega, 512, LDS_BYTES);
    if (per_cu < 1) { fprintf(stderr, "kernel_launch: occupancy query reports %d blocks per CU\n", per_cu); grid_blocks = -1; }
    else grid_blocks = cus;
    if (n_in != 32 || ws_size < WS_END) { fprintf(stderr, "kernel_launch: unexpected n_in %d / ws_size %zu (need %zu)\n", n_in, ws_size, (size_t)WS_END); grid_blocks = -1; }
  }
  if (grid_blocks < 0) return;
  hipMemsetAsync((unsigned char*)d_ws + OFF_BAR, 0, 3456 * 4, stream);
  Params p{};
  for (int i = 0; i < 32; ++i) p.in[i] = (const float*)d_in[i];
  p.out = (float*)d_out; p.ws = (unsigned char*)d_ws;
  void* args[] = {&p};
  hipError_t e = hipLaunchCooperativeKernel((void*)mega, dim3(grid_blocks), dim3(512), args, LDS_BYTES, stream);
  if (e != hipSuccess) fprintf(stderr, "cooperative launch failed: %s (grid %d)\n", hipGetErrorString(e), grid_blocks);
}
```

```cpp
#include <hip/hip_runtime.h>
#include <hip/hip_cooperative_groups.h>
#include <cstdio>
#include <cstdint>
namespace cg = cooperative_groups;

#define LAS __attribute__((address_space(3)))
typedef LAS unsigned char* LP;
typedef unsigned short bf16_t;
typedef short bf16x8 __attribute__((ext_vector_type(8)));
typedef short s16x4 __attribute__((ext_vector_type(4)));
typedef float f32x4 __attribute__((ext_vector_type(4)));
typedef float f32x16 __attribute__((ext_vector_type(16)));
typedef unsigned u32x4 __attribute__((ext_vector_type(4)));
typedef unsigned u32x2 __attribute__((ext_vector_type(2)));

constexpr int DM = 1024, NTOK = 24576, NCTX = 8192, SEQC = 256, SEQS = 2048, INC = 9232;
constexpr int LDS_BYTES = 160 * 1024;
constexpr size_t OFF_WT = 0;
constexpr size_t OFF_WBM = 18874368, OFF_WBH = 20971520, OFF_WOUT = 23068672, OFF_W1T = 25165824, OFF_W2T = 33554432;
constexpr size_t OFF_HN = 41943040;
constexpr size_t OFF_BIG = 92274688;
constexpr size_t OFF_SM = 243269632;
constexpr size_t OFF_MOD = OFF_SM;
constexpr size_t OFF_C1 = OFF_MOD + 221184;
constexpr size_t OFF_H2S = OFF_C1 + 147456;
constexpr size_t OFF_H2C = OFF_H2S + 524288;
constexpr size_t OFF_PER = OFF_H2C + 65536;
constexpr size_t OFF_PEC = OFF_PER + 65536;
constexpr size_t OFF_GT = OFF_PEC + 131072;
constexpr size_t OFF_SSQ1 = OFF_GT + 1572864;
constexpr size_t OFF_SSQ2 = OFF_SSQ1 + 1572864;
constexpr size_t OFF_HFS = OFF_SSQ2 + 1572864;
constexpr size_t OFF_HFC = OFF_HFS + 16777216;
constexpr size_t OFF_BAR = OFF_HFC + 2097152;
constexpr size_t WS_END = OFF_BAR + 3456 * 4;
constexpr size_t OUT_H = 0, OUT_HB = 50331648;
constexpr size_t OUTF_C = 25165824, OUTF_N = 41943040, OUTF_M = 42008576;

struct Params { const float* in[32]; float* out; unsigned char* ws; };

__device__ __forceinline__ bf16_t f2bf(float f) { unsigned u = __float_as_uint(f); u += 0x7FFFu + ((u >> 16) & 1u); return (bf16_t)(u >> 16); }
__device__ __forceinline__ float bf2f(unsigned b) { return __uint_as_float(b << 16); }
__device__ __forceinline__ unsigned pack2(float lo, float hi) { return (unsigned)f2bf(lo) | ((unsigned)f2bf(hi) << 16); }
__device__ __forceinline__ float bflo(unsigned w) { return __uint_as_float(w << 16); }
__device__ __forceinline__ float bfhi(unsigned w) { return __uint_as_float(w & 0xffff0000u); }
__device__ __forceinline__ float sigmoidf_(float x) { return 1.0f / (1.0f + __expf(-x)); }
__device__ __forceinline__ int opaque_tid() { int t = threadIdx.x; asm volatile("" : "+v"(t)); return t; }
__device__ __forceinline__ float wave_sum(float v) {
#pragma unroll
  for (int o = 32; o >= 1; o >>= 1) v += __shfl_xor(v, o);
  return v;
}


#define XB_TMO      128
#define XB_XCNT(j)  (256  + 64 * (j))
#define XB_XSUB(j)  (1280 + 64 * (j))
#define XB_XGEN(j)  (2304 + 64 * (j))
#define XB_TOP      3328
#define XB_TOPGEN   3392
#define XCD_BAR_WORDS 3456
#define XB_SPIN_CAP (1u << 18)
__device__ __forceinline__ unsigned xb_ld(unsigned* p)              { return __hip_atomic_load(p, __ATOMIC_RELAXED, __HIP_MEMORY_SCOPE_AGENT); }
__device__ __forceinline__ unsigned xb_add(unsigned* p, unsigned v) { return __hip_atomic_fetch_add(p, v, __ATOMIC_RELAXED, __HIP_MEMORY_SCOPE_AGENT); }
__device__ __forceinline__ unsigned xb_xcc_id() { return (unsigned)__builtin_amdgcn_s_getreg((3 << 11) | 20) & 0xFu; }
#define XB_SPIN(cond, bar) do { unsigned _sp = 0; while (cond) { __builtin_amdgcn_s_sleep(1); \
    if ((++_sp & 255u) == 0u) { if (xb_ld(&(bar)[XB_TMO])) break; if (_sp > XB_SPIN_CAP) { atomicAdd(&(bar)[XB_TMO], 1u); break; } } } } while (0)
struct XcdBarrier { unsigned* bar; unsigned x; volatile LAS unsigned* st; };
__device__ __forceinline__ XcdBarrier xcd_barrier_post(unsigned* bar, volatile LAS unsigned* st) {
  XcdBarrier b; b.bar = bar; b.x = xb_xcc_id(); b.st = st;
  if (threadIdx.x == 0) (void)xb_add(&bar[XB_XCNT(b.x)], 1u);
  return b;
}
__device__ __forceinline__ void xcd_barrier_complete(unsigned* bar, unsigned x, unsigned& nloc, unsigned& nx) {
  const unsigned G = gridDim.x * gridDim.y * gridDim.z;
  unsigned sum, cnt, mine, sp = 0u;
  for (;;) {
    sum = 0u; cnt = 0u; mine = 0u;
#pragma unroll
    for (unsigned j = 0; j < 16; ++j) { const unsigned c = xb_ld(&bar[XB_XCNT(j)]); sum += c; cnt += (c > 0u) ? 1u : 0u; mine = (j == x) ? c : mine; }
    if (sum == G) break;
    __builtin_amdgcn_s_sleep(1);
    if ((++sp & 255u) == 0u) { if (xb_ld(&bar[XB_TMO])) break; if (sp > XB_SPIN_CAP) { atomicAdd(&bar[XB_TMO], 1u); break; } }
  }
  nloc = mine > 0u ? mine : 1u; nx = cnt > 0u ? cnt : 1u;
}
__device__ __forceinline__ void xcd_barrier(const XcdBarrier& b) {
  asm volatile("s_waitcnt vmcnt(0)" ::: "memory");
  __syncthreads();
  if (threadIdx.x == 0) {
    unsigned* bar = b.bar;
    __builtin_amdgcn_s_waitcnt(0);
    unsigned nloc = b.st[0], nx = b.st[1];
    if (nloc == 0u) { xcd_barrier_complete(bar, b.x, nloc, nx); b.st[0] = nloc; b.st[1] = nx; }
    const unsigned old = xb_add(&bar[XB_XSUB(b.x)], 1u);
    const unsigned gen = old / nloc;
    if (old + 1u == (gen + 1u) * nloc) {
      __builtin_amdgcn_fence(__ATOMIC_RELEASE, "agent");
      asm volatile("s_waitcnt vmcnt(0)" ::: "memory");
      const unsigned og = xb_add(&bar[XB_TOP], 1u);
      const unsigned tg = og / nx;
      if (og + 1u == (tg + 1u) * nx) xb_add(&bar[XB_TOPGEN], 1u);
      else XB_SPIN(xb_ld(&bar[XB_TOPGEN]) == tg, bar);
      __builtin_amdgcn_fence(__ATOMIC_ACQUIRE, "agent");
      xb_add(&bar[XB_XGEN(b.x)], 1u);
      asm volatile("s_waitcnt vmcnt(0)" ::: "memory");
    } else {
      XB_SPIN(xb_ld(&bar[XB_XGEN(b.x)]) == gen, bar);
      __builtin_amdgcn_fence(__ATOMIC_ACQUIRE, "agent");
      asm volatile("s_waitcnt vmcnt(0)" ::: "memory");
    }
  }
  __syncthreads();
}

namespace pg8 {
constexpr int BM = 256, BK = 64, HALF = 128, HTB = HALF * BK * 2, STAGE_BYTES = 8 * HTB, NXCD = 8, WGM = 8;
__host__ __device__ __forceinline__ int lds_byte(int r, int c) { const int st = (r >> 4) * 2 + (c >> 5), rr = r & 15, cc = c & 31, ob = rr * 64 + cc * 2; return st * 1024 + (ob ^ (((ob >> 9) & 1) << 5)); }
__host__ __device__ __forceinline__ void stage_rc(int b, int& R, int& C) { const int st = b / 1024, sb = b % 1024, swz = sb ^ (((sb >> 9) & 1) << 5); R = (st >> 1) * 16 + swz / 64; C = (st & 1) * 32 + (swz % 64) / 2; }
__host__ __device__ __forceinline__ int perm32(int rho) { const int n = rho >> 4, i = rho & 15; return 8 * (i >> 2) + 4 * n + (i & 3); }
struct Unit { int pm, pn, ks; };
struct Gemm { const bf16_t* A; const bf16_t* Bt; int M, N, K, ld, nks; };
struct StaticOrder {
  int nM, nN, ntile, nwg, G, c;
  __device__ void init(int M, int N, int nks, int G_, int c_) { nM = M / BM; nN = N / BM; ntile = nM * nN; nwg = ntile * nks; G = G_; c = c_; }
  __device__ bool next(int i, Unit& u) const {
    const long L = (long)i * G + c; if (L >= nwg) return false;
    u.ks = (int)L / ntile; int wgid = (int)L - u.ks * ntile;
    { const int q = ntile / NXCD, r = ntile % NXCD, xcd = wgid % NXCD, off = wgid / NXCD; wgid = (xcd < r ? xcd * (q + 1) : r * (q + 1) + (xcd - r) * q) + off; }
    const int nig = WGM * nN, gid = wgid / nig, fm = gid * WGM, gsz = (nM - fm) < WGM ? (nM - fm) : WGM;
    u.pm = fm + ((wgid % nig) % gsz); u.pn = (wgid % nig) / gsz; return true;
  }
};

template <class Epi>
__device__ __forceinline__ void gemm_phase(LP lds, const Gemm g, const StaticOrder& S, const Epi& E) {
  int tid_ = threadIdx.x; asm volatile("" : "+v"(tid_));
  const int tid = tid_, wid = __builtin_amdgcn_readfirstlane(tid >> 6), lane = tid & 63, wr = wid >> 2, wc = wid & 3, fr = lane & 15, fq = lane >> 4;
  const int K = g.ld, nt = g.K / BK;
  const size_t ksb = (size_t)g.K * 2;
  unsigned voffA[2], voffB[2];
#pragma unroll
  for (int i = 0; i < 2; ++i) { int R, C; stage_rc(tid * 16 + i * 8192, R, C); const int Rb = (R & ~31) + perm32(R & 31); voffA[i] = (unsigned)(R * K + C) * 2u; voffB[i] = (unsigned)(Rb * K + C) * 2u; }
  const size_t kstep = (size_t)(BK * 2);
  const size_t hstep = (size_t)HALF * K * 2;
  const size_t tstep = 2 * hstep;
  const unsigned ldsw = (unsigned)wid * 1024u;
  const int aoff = lds_byte(wr * 64 + fr, fq * 8), boff = lds_byte(wc * 32 + fr, fq * 8);
#define PG8_SA(b, h) (((b) * 2 + (h)) * HTB)
#define PG8_SB(b, h) ((4 + (b) * 2 + (h)) * HTB)
#define PG8_STAGE(bufoff, gbase, voff) do { _Pragma("unroll") for (int _i = 0; _i < 2; ++_i) \
    __builtin_amdgcn_global_load_lds((const unsigned*)((const char*)(gbase) + (voff)[_i]), (LAS unsigned*)(lds + (bufoff) + ldsw + _i * 8192), 16, 0, 0); } while (0)
#define PG8_LDA(dst, b, h) do { _Pragma("unroll") for (int m = 0; m < 4; ++m) _Pragma("unroll") for (int k = 0; k < 2; ++k) dst[m][k] = *(const LAS bf16x8*)(lds + PG8_SA(b, h) + aoff + m * 2048 + k * 1024); } while (0)
#define PG8_LDB(dst, b, h) do { _Pragma("unroll") for (int n = 0; n < 2; ++n) _Pragma("unroll") for (int k = 0; k < 2; ++k) dst[n][k] = *(const LAS bf16x8*)(lds + PG8_SB(b, h) + boff + n * 2048 + k * 1024); } while (0)
#define PG8_MMA(ai, bj, At, Bt) do { __builtin_amdgcn_s_setprio(1); _Pragma("unroll") for (int m = 0; m < 4; ++m) _Pragma("unroll") for (int n = 0; n < 2; ++n) _Pragma("unroll") for (int k = 0; k < 2; ++k) \
    acc[ai][bj][m][n] = __builtin_amdgcn_mfma_f32_16x16x32_bf16(Bt[n][k], At[m][k], acc[ai][bj][m][n], 0, 0, 0); __builtin_amdgcn_s_setprio(0); } while (0)
#define PG8_WAIT_V(n) asm volatile("s_waitcnt vmcnt(" #n ")" ::: "memory")
#define PG8_WAIT_L(n) asm volatile("s_waitcnt lgkmcnt(" #n ")" ::: "memory")
#define PG8_BAR __builtin_amdgcn_s_barrier()
#define PG8_SCHED __builtin_amdgcn_sched_barrier(0)
  Unit cur, nxt; int ui = 0;
  if (!S.next(0, cur)) return;
  f32x4 acc[2][2][4][2];
#pragma unroll
  for (int a = 0; a < 2; ++a)
#pragma unroll
    for (int b = 0; b < 2; ++b)
#pragma unroll
      for (int m = 0; m < 4; ++m)
#pragma unroll
        for (int n = 0; n < 2; ++n) acc[a][b][m][n] = (f32x4){0.f, 0.f, 0.f, 0.f};
  bf16x8 At[4][2], B0[2][2], B1[2][2];
  const char* cA = (const char*)g.A + (size_t)cur.pm * tstep + cur.ks * ksb; const char* cB = (const char*)g.Bt + (size_t)cur.pn * tstep + cur.ks * ksb;
  PG8_STAGE(PG8_SB(0, 0), cB, voffB); PG8_STAGE(PG8_SA(0, 0), cA, voffA); PG8_STAGE(PG8_SB(0, 1), cB + hstep, voffB); PG8_STAGE(PG8_SA(0, 1), cA + hstep, voffA);
  if (wr == 1) PG8_BAR;
  PG8_WAIT_V(4); PG8_BAR;
  PG8_STAGE(PG8_SB(1, 0), cB + kstep, voffB); PG8_STAGE(PG8_SA(1, 0), cA + kstep, voffA); PG8_STAGE(PG8_SB(1, 1), cB + hstep + kstep, voffB);
  PG8_WAIT_V(6); PG8_BAR;
  for (;;) {
    const bool has_next = S.next(ui + 1, nxt);
    const char* nA = has_next ? (const char*)g.A + (size_t)nxt.pm * tstep + nxt.ks * ksb : cA; const char* nB = has_next ? (const char*)g.Bt + (size_t)nxt.pn * tstep + nxt.ks * ksb : cB;
    for (int t = 0; t < nt; t += 2) {
      const bool last = (t == nt - 2);
      const char* a1 = cA + (size_t)(t + 1) * kstep;
      const char* a2 = last ? nA : cA + (size_t)(t + 2) * kstep; const char* b2 = last ? nB : cB + (size_t)(t + 2) * kstep;
      const char* a3 = a2 + kstep; const char* b3 = b2 + kstep;
      PG8_LDB(B0, 0, 0); PG8_SCHED; PG8_LDA(At, 0, 0); PG8_STAGE(PG8_SA(1, 1), a1 + hstep, voffA);
      PG8_WAIT_L(8); PG8_BAR; PG8_WAIT_L(0); PG8_MMA(0, 0, At, B0); PG8_BAR; PG8_SCHED;
      PG8_LDB(B1, 0, 1); PG8_STAGE(PG8_SB(0, 0), b2, voffB);
      PG8_BAR; PG8_WAIT_L(0); PG8_MMA(0, 1, At, B1); PG8_BAR;
      PG8_LDA(At, 0, 1); PG8_STAGE(PG8_SA(0, 0), a2, voffA);
      PG8_BAR; PG8_WAIT_L(0); PG8_MMA(1, 0, At, B0); PG8_BAR; PG8_SCHED;
      PG8_STAGE(PG8_SB(0, 1), b2 + hstep, voffB);
      PG8_WAIT_V(6); PG8_BAR; PG8_MMA(1, 1, At, B1); PG8_BAR;
      PG8_LDB(B0, 1, 0); PG8_SCHED; PG8_LDA(At, 1, 0); PG8_STAGE(PG8_SA(0, 1), a2 + hstep, voffA);
      PG8_WAIT_L(8); PG8_BAR; PG8_WAIT_L(0); PG8_MMA(0, 0, At, B0); PG8_BAR; PG8_SCHED;
      PG8_LDB(B1, 1, 1); PG8_STAGE(PG8_SB(1, 0), b3, voffB);
      PG8_BAR; PG8_WAIT_L(0); PG8_MMA(0, 1, At, B1); PG8_BAR;
      PG8_LDA(At, 1, 1); PG8_STAGE(PG8_SA(1, 0), a3, voffA);
      PG8_BAR; PG8_WAIT_L(0); PG8_MMA(1, 0, At, B0); PG8_BAR; PG8_SCHED;
      PG8_STAGE(PG8_SB(1, 1), b3 + hstep, voffB);
      PG8_WAIT_V(6); PG8_BAR; PG8_MMA(1, 1, At, B1); PG8_BAR;
    }
    { int fr2 = fr, fq2 = fq; asm volatile("" : "+v"(fr2), "+v"(fq2)); E(acc, cur, wr, wc, fr2, fq2); }
    if (!has_next) break;
#pragma unroll
    for (int a = 0; a < 2; ++a)
#pragma unroll
      for (int b = 0; b < 2; ++b)
#pragma unroll
        for (int m = 0; m < 4; ++m)
#pragma unroll
          for (int n = 0; n < 2; ++n) acc[a][b][m][n] = (f32x4){0.f, 0.f, 0.f, 0.f};
    cur = nxt; cA = nA; cB = nB; ++ui;
  }
  PG8_WAIT_V(0);
  if (wr == 0) PG8_BAR;
  PG8_BAR;
#undef PG8_SA
#undef PG8_SB
#undef PG8_STAGE
#undef PG8_LDA
#undef PG8_LDB
#undef PG8_MMA
#undef PG8_WAIT_V
#undef PG8_WAIT_L
#undef PG8_BAR
#undef PG8_SCHED
}
}
using pg8::Unit;
typedef f32x4 AccT[2][2][4][2];

#define EPI_ROW(ai, m) (u.pm * 256 + (ai) * 128 + wr * 64 + (m) * 16 + fr)
#define EPI_COL(bj, n) (u.pn * 256 + (bj) * 128 + wc * 32 + 8 * fq + 4 * (n))
#define EPI_LOOP_ROWS _Pragma("unroll") for (int ai = 0; ai < 2; ++ai) _Pragma("unroll") for (int m = 0; m < 4; ++m)
#define EPI_LOOP_COLS _Pragma("unroll") for (int bj = 0; bj < 2; ++bj) _Pragma("unroll") for (int n = 0; n < 2; ++n)

__device__ __forceinline__ int cond_of_row(int row) { return row < NCTX ? 0 : 1 + ((row - NCTX) >> 11); }

#define EPI_LOOP_BJ _Pragma("unroll") for (int bj = 0; bj < 2; ++bj)
__device__ __forceinline__ u32x4 pack8(const f32x4 v0, const f32x4 v1) { u32x4 w; w.x = pack2(v0[0], v0[1]); w.y = pack2(v0[2], v0[3]); w.z = pack2(v1[0], v1[1]); w.w = pack2(v1[2], v1[3]); return w; }
__device__ __forceinline__ void unpack8(const u32x4 w, f32x4& v0, f32x4& v1) { v0[0] = bflo(w.x); v0[1] = bfhi(w.x); v0[2] = bflo(w.y); v0[3] = bfhi(w.y); v1[0] = bflo(w.z); v1[1] = bfhi(w.z); v1[2] = bflo(w.w); v1[3] = bfhi(w.w); }
struct EpiQKV {
  bf16_t* O; const float* bias;
  __device__ __forceinline__ void operator()(const AccT& acc, const Unit& u, int wr, int wc, int fr, int fq) const {
    const float sc = (u.pn < 4) ? 0.0625f : 1.0f;
    f32x4 bv[2][2];
    EPI_LOOP_COLS { bv[bj][n] = *(const f32x4*)(bias + EPI_COL(bj, n)); }
    EPI_LOOP_ROWS { const int row = EPI_ROW(ai, m);
      EPI_LOOP_BJ { *(u32x4*)(O + (size_t)row * 3072 + EPI_COL(bj, 0)) = pack8((acc[ai][bj][m][0] + bv[bj][0]) * sc, (acc[ai][bj][m][1] + bv[bj][1]) * sc); } }
  }
};
struct EpiUT {
  bf16_t* O; const float* bias;
  __device__ __forceinline__ void operator()(const AccT& acc, const Unit& u, int wr, int wc, int fr, int fq) const {
    EPI_LOOP_ROWS { const int row = EPI_ROW(ai, m); const float bv = bias[row];
      EPI_LOOP_BJ { *(u32x4*)(O + (size_t)row * NTOK + EPI_COL(bj, 0)) = pack8(acc[ai][bj][m][0] + bv, acc[ai][bj][m][1] + bv); } }
  }
};
struct EpiGates {
  bf16_t* H; bf16_t* G; const float* b_in;
  __device__ __forceinline__ void operator()(const AccT& acc, const Unit& u, int wr, int wc, int fr, int fq) const {
    const bool og = u.pn < 4;
    f32x4 bv[2][2];
    EPI_LOOP_COLS { const int col = EPI_COL(bj, n); bv[bj][n] = *(const f32x4*)(b_in + (og ? 3072 + col : 7184 + (col - 1024))); }
#pragma unroll
    for (int ai = 0; ai < 2; ++ai)
#pragma unroll
      for (int m2 = 0; m2 < 2; ++m2) {
        u32x4 hv[2][2];
        if (og) {
#pragma unroll
          for (int mm = 0; mm < 2; ++mm) { const int row = EPI_ROW(ai, 2 * m2 + mm); EPI_LOOP_BJ { hv[mm][bj] = *(const u32x4*)(H + (size_t)row * 1024 + EPI_COL(bj, 0)); } } }
#pragma unroll
        for (int mm = 0; mm < 2; ++mm) { const int m = 2 * m2 + mm; const int row = EPI_ROW(ai, m);
          EPI_LOOP_BJ { const int col = EPI_COL(bj, 0); f32x4 s0, s1; const f32x4 a0 = acc[ai][bj][m][0] + bv[bj][0], a1 = acc[ai][bj][m][1] + bv[bj][1];
#pragma unroll
            for (int e = 0; e < 4; ++e) { s0[e] = sigmoidf_(a0[e]); s1[e] = sigmoidf_(a1[e]); }
            if (og) { f32x4 h0, h1; unpack8(hv[mm][bj], h0, h1); *(u32x4*)(H + (size_t)row * 1024 + col) = pack8(h0 * s0, h1 * s1); }
            else *(u32x4*)(G + (size_t)row * 2048 + (col - 1024)) = pack8(s0, s1); } } }
  }
};
template <int SECOND> struct EpiMerge {
  bf16_t* T; const bf16_t* G;
  __device__ __forceinline__ void operator()(const AccT& acc, const Unit& u, int wr, int wc, int fr, int fq) const {
#pragma unroll
    for (int ai = 0; ai < 2; ++ai)
#pragma unroll
      for (int m2 = 0; m2 < 2; ++m2) {
        u32x4 gv[2][2], tv[2][2];
#pragma unroll
        for (int mm = 0; mm < 2; ++mm) { const int row = EPI_ROW(ai, 2 * m2 + mm);
          EPI_LOOP_BJ { const int col = EPI_COL(bj, 0); gv[mm][bj] = *(const u32x4*)(G + (size_t)row * 2048 + SECOND * 1024 + col);
            if (SECOND) tv[mm][bj] = *(const u32x4*)(T + (size_t)row * 1024 + col); } }
#pragma unroll
        for (int mm = 0; mm < 2; ++mm) { const int m = 2 * m2 + mm; const int row = EPI_ROW(ai, m);
          EPI_LOOP_BJ { const int col = EPI_COL(bj, 0); f32x4 g0, g1; unpack8(gv[mm][bj], g0, g1);
            f32x4 v0 = g0 * acc[ai][bj][m][0], v1 = g1 * acc[ai][bj][m][1];
            if (SECOND) { f32x4 t0, t1; unpack8(tv[mm][bj], t0, t1); v0 += t0; v1 += t1; }
            *(u32x4*)(T + (size_t)row * 1024 + col) = pack8(v0, v1); } } }
  }
};
struct EpiOut {
  const float* xp; const float* xs; const float* per; const float* pec; const float* mod; const float* n2w; float* X1; bf16_t* A2; float* ssq;
  __device__ __forceinline__ void operator()(const AccT& acc, const Unit& u, int wr, int wc, int fr, int fq) const {
    const int cb = cond_of_row(u.pm * 256); const float* md = mod + cb * 6144; const bool smp = (u.pm * 256) >= NCTX;
    f32x4 g1v[2][2], k2v[2][2];
    EPI_LOOP_COLS { const int col = EPI_COL(bj, n); g1v[bj][n] = *(const f32x4*)(md + 2048 + col); k2v[bj][n] = *(const f32x4*)(n2w + col) * (*(const f32x4*)(md + 4096 + col) + 1.0f); }
    EPI_LOOP_ROWS { const int row = EPI_ROW(ai, m); float ss = 0.f;
#pragma unroll
      for (int bj = 0; bj < 2; ++bj) {
        f32x4 x0[2];
        if (!smp) {
#pragma unroll
          for (int n = 0; n < 2; ++n) x0[n] = *(const f32x4*)(xp + (size_t)row * 1024 + EPI_COL(bj, n)); }
        else { const int r2 = row - NCTX, t = r2 & 2047; f32x4 pe[2];
#pragma unroll
          for (int n = 0; n < 2; ++n) { const int col = EPI_COL(bj, n); x0[n] = *(const f32x4*)(xs + (size_t)r2 * 1024 + col);
            pe[n] = (col < 512) ? *(const f32x4*)(per + (t >> 6) * 512 + col) : *(const f32x4*)(pec + (t & 63) * 512 + (col - 512)); }
#pragma unroll
          for (int n = 0; n < 2; ++n) x0[n] += pe[n]; }
        f32x4 x1[2];
#pragma unroll
        for (int n = 0; n < 2; ++n) { x1[n] = x0[n] + g1v[bj][n] * acc[ai][bj][m][n]; *(f32x4*)(X1 + (size_t)row * 1024 + EPI_COL(bj, n)) = x1[n];
          ss += x1[n][0] * x1[n][0] + x1[n][1] * x1[n][1] + x1[n][2] * x1[n][2] + x1[n][3] * x1[n][3]; }
        *(u32x4*)(A2 + (size_t)row * 1024 + EPI_COL(bj, 0)) = pack8(x1[0] * k2v[bj][0], x1[1] * k2v[bj][1]); }
      ss += __shfl_xor(ss, 16); ss += __shfl_xor(ss, 32);
      if (fq == 0) ssq[(size_t)row * 16 + u.pn * 4 + wc] = ss; }
  }
};
struct EpiFF1 {
  int row0; const float* ssq; const float* c1; bf16_t* Hd;
  __device__ __forceinline__ void operator()(const AccT& acc, const Unit& u, int wr, int wc, int fr, int fq) const {
    const int cb = cond_of_row(row0 + u.pm * 256); const float* cc = c1 + cb * 4096;
    f32x4 cv[2][2];
    EPI_LOOP_COLS { cv[bj][n] = *(const f32x4*)(cc + EPI_COL(bj, n)); }
    float rs[2][4];
    EPI_LOOP_ROWS { const float* sp = ssq + (size_t)(row0 + EPI_ROW(ai, m)) * 16;
      const f32x4 st = (*(const f32x4*)sp + *(const f32x4*)(sp + 4)) + (*(const f32x4*)(sp + 8) + *(const f32x4*)(sp + 12));
      rs[ai][m] = rsqrtf((st[0] + st[1] + st[2] + st[3]) * (1.0f / 1024.0f) + 1e-6f); }
    EPI_LOOP_ROWS { const int rl = EPI_ROW(ai, m); const float rstd = rs[ai][m];
      EPI_LOOP_BJ { f32x4 v0 = acc[ai][bj][m][0] * rstd + cv[bj][0], v1 = acc[ai][bj][m][1] * rstd + cv[bj][1];
#pragma unroll
        for (int e = 0; e < 4; ++e) { const float r0 = fmaxf(v0[e], 0.f), r1 = fmaxf(v1[e], 0.f); v0[e] = r0 * r0; v1[e] = r1 * r1; }
        *(u32x4*)(Hd + (size_t)rl * 4096 + EPI_COL(bj, 0)) = pack8(v0, v1); } }
  }
};
struct EpiFF2 {
  int row0; const float* mod; const float* b2; float* X; float* P;
  __device__ __forceinline__ void operator()(const AccT& acc, const Unit& u, int wr, int wc, int fr, int fq) const {
    if (u.ks == 1) {
      EPI_LOOP_ROWS { const int rl = EPI_ROW(ai, m); EPI_LOOP_COLS { *(f32x4*)(P + (size_t)rl * 1024 + EPI_COL(bj, n)) = acc[ai][bj][m][n]; } }
    } else {
    const int cb = cond_of_row(row0 + u.pm * 256); const float* md = mod + cb * 6144;
    f32x4 g2v[2][2], bbv[2][2];
    EPI_LOOP_COLS { const int col = EPI_COL(bj, n); g2v[bj][n] = *(const f32x4*)(md + 5120 + col); bbv[bj][n] = *(const f32x4*)(b2 + col); }
#pragma unroll
    for (int ai = 0; ai < 2; ++ai)
#pragma unroll
      for (int m2 = 0; m2 < 2; ++m2) {
        f32x4 xv[2][2][2];
#pragma unroll
        for (int mm = 0; mm < 2; ++mm) { const int row = row0 + EPI_ROW(ai, 2 * m2 + mm); EPI_LOOP_COLS { xv[mm][bj][n] = *(const f32x4*)(X + (size_t)row * 1024 + EPI_COL(bj, n)); } }
#pragma unroll
        for (int mm = 0; mm < 2; ++mm) { const int m = 2 * m2 + mm; const int row = row0 + EPI_ROW(ai, m);
          EPI_LOOP_COLS { const int col = EPI_COL(bj, n); *(f32x4*)(X + (size_t)row * 1024 + col) = xv[mm][bj][n] + g2v[bj][n] * (acc[ai][bj][m][n] + bbv[bj][n]); } } }
    }
  }
};

template <class Epi> __device__ __forceinline__ void run_gemm(LP lds, const bf16_t* A, const bf16_t* Bt, int M, int N, int K, const Epi& E, int nks = 1) {
  pg8::Gemm g; g.A = A; g.Bt = Bt; g.M = M; g.N = N; g.K = K / nks; g.ld = K; g.nks = nks;
  pg8::StaticOrder S; S.init(M, N, nks, (int)gridDim.x, (int)blockIdx.x);
  pg8::gemm_phase<Epi>(lds, g, S, E);
}

__device__ void transpose_tile(const float* __restrict__ src, int ld, int col0, int k0, bf16_t* __restrict__ dst, int K, int drow0, LAS float* tile) {
  const int t = opaque_tid();
  f32x4 v[4];
#pragma unroll
  for (int i = 0; i < 4; ++i) { const int idx = t + 512 * i, kr = idx >> 5, c4 = idx & 31; v[i] = *(const f32x4*)(src + (size_t)(k0 + kr) * ld + col0 + 4 * c4); }
#pragma unroll
  for (int i = 0; i < 4; ++i) { const int idx = t + 512 * i, kr = idx >> 5, c4 = idx & 31; LAS float* tp = tile + kr * 129 + 4 * c4; tp[0] = v[i][0]; tp[1] = v[i][1]; tp[2] = v[i][2]; tp[3] = v[i][3]; }
  __syncthreads();
  const int kb = t & 7;
#pragma unroll
  for (int i = 0; i < 2; ++i) { const int c = (t >> 3) + 64 * i; const LAS float* tp = tile + (kb * 8) * 129 + c; u32x4 o;
    o.x = pack2(tp[0], tp[129]); o.y = pack2(tp[2 * 129], tp[3 * 129]); o.z = pack2(tp[4 * 129], tp[5 * 129]); o.w = pack2(tp[6 * 129], tp[7 * 129]);
    *(u32x4*)(dst + (size_t)(drow0 + c) * K + k0 + kb * 8) = o; }
  __syncthreads();
}
template <int SILU> __device__ void matvec9_unit(const float* v0, const float* v1, int v1stride, const float* __restrict__ W, int ldw, const float* bias, float* out, int ldo, int col0, LAS float* lf) {
  const int t = opaque_tid(), lane = t & 63, wid = t >> 6;
  LAS float* sv = lf; LAS float* red = lf + 9216;
  for (int i = t; i < 9216; i += 512) { const int b = i >> 10, k = i & 1023; float x = (b == 0) ? v0[k] : v1[(size_t)(b - 1) * v1stride + k]; if (SILU) x = x / (1.0f + __expf(-x)); sv[i] = x; }
  __syncthreads();
  const int c4 = t & 7, kl = t >> 3;
  f32x4 w[16];
#pragma unroll
  for (int i = 0; i < 16; ++i) w[i] = *(const f32x4*)(W + (size_t)(kl + 64 * i) * ldw + col0 + 4 * c4);
  f32x4 acc[9];
#pragma unroll
  for (int b = 0; b < 9; ++b) acc[b] = (f32x4){0.f, 0.f, 0.f, 0.f};
#pragma unroll
  for (int i = 0; i < 16; ++i)
#pragma unroll
    for (int b = 0; b < 9; ++b) acc[b] += w[i] * sv[b * 1024 + kl + 64 * i];
#pragma unroll
  for (int b = 0; b < 9; ++b)
#pragma unroll
    for (int e = 0; e < 4; ++e) { float x = acc[b][e]; x += __shfl_xor(x, 8); x += __shfl_xor(x, 16); x += __shfl_xor(x, 32); acc[b][e] = x; }
  if (lane < 8) {
#pragma unroll
    for (int b = 0; b < 9; ++b) *(LAS f32x4*)(red + (wid * 9 + b) * 32 + 4 * lane) = acc[b]; }
  __syncthreads();
  if (t < 288) { const int b = t >> 5, cc = t & 31; float s = bias[col0 + cc];
#pragma unroll
    for (int pz = 0; pz < 8; ++pz) s += red[(pz * 9 + b) * 32 + cc];
    out[(size_t)b * ldo + col0 + cc] = s; }
  __syncthreads();
}

__device__ void phase0(const Params& p, LP lds) {
  unsigned char* ws = p.ws; LAS float* lf = (LAS float*)lds;
  const int tid0 = opaque_tid(); const int wid = tid0 >> 6, lane = tid0 & 63;
  for (int unit = blockIdx.x; unit < 576; unit += gridDim.x) {
    if (unit < 192) {
      matvec9_unit<1>(p.in[6], p.in[5], 1024, p.in[7], 6144, p.in[8], (float*)(ws + OFF_MOD), 6144, unit * 32, lf);
    } else if (unit < 480) {
      const int row = (unit - 192) * 8 + wid; const bool smp = row < 2048; const int L = smp ? 2048 : 256, t = smp ? row : row - 2048;
      const float* w1 = p.in[14]; const float* b1 = p.in[15]; const float* fr1 = p.in[16]; const float* w2 = p.in[17]; const float* b2 = p.in[18]; const float* fr2 = p.in[19];
      float a = b1[lane] + (float)t / (float)(L - 1) * w1[lane];
      const float base = (6.283185307179586f / (float)L) * (float)t;
      float cs = 0.f, sn = 0.f; if (lane < 16) { const float ang = base * (float)(lane + 1); cs = cosf(ang); sn = sinf(ang); }
#pragma unroll
      for (int i = 0; i < 16; ++i) a += __shfl(cs, i) * w1[(1 + i) * 64 + lane] + __shfl(sn, i) * w1[(17 + i) * 64 + lane];
      const float h1 = sinf(fr1[lane] * a);
      float a2 = b2[lane];
#pragma unroll 16
      for (int j = 0; j < 64; ++j) a2 += __shfl(h1, j) * w2[j * 64 + lane];
      const float h2 = sinf(fr2[lane] * a2);
      float* dst = (float*)(ws + (smp ? OFF_H2S : OFF_H2C)); dst[(size_t)t * 64 + lane] = h2;
    } else {
      const int r = unit - 480, c = tid0; const int pos = r < 32 ? r : r - 32; const int i = c & 255;
      const float omega = 1.0f / powf(10000.0f, (float)i / 256.0f); const float a = (float)pos * omega; const float v = c < 256 ? sinf(a) : cosf(a);
      float* dst = (float*)(ws + (r < 32 ? OFF_PER : OFF_PEC)); dst[(size_t)pos * 512 + c] = v;
    }
  }
}
__device__ void weight_tiles(const Params& p, LP lds, int lo, int hi, int upper) {
  unsigned char* ws = p.ws; LAS float* lf = (LAS float*)lds;
  const int nh = upper ? ((int)gridDim.x >> 1) : 0;
  if ((int)blockIdx.x < nh) return;
  for (int tu = lo + (int)blockIdx.x - nh; tu < hi; tu += (int)gridDim.x - nh) {
    const float* src; int ld, K, col0, k0, drow0; bf16_t* dst;
    if (tu < 1152) { const int nt = tu >> 4, kt = tu & 15; const int r = nt * 128; src = p.in[10]; ld = INC; K = 1024; k0 = kt * 64; drow0 = r; dst = (bf16_t*)(ws + OFF_WT);
      col0 = r < 3072 ? r : (r < 6144 ? 4112 + (r - 3072) : (r < 7168 ? 3072 + (r - 6144) : 7184 + (r - 7168))); }
    else if (tu < 1536) { const int v = tu - 1152, w = v >> 7, q = v & 127; src = p.in[23 + w]; ld = 1024; K = 1024; k0 = (q & 15) * 64; col0 = (q >> 4) * 128; drow0 = col0; dst = (bf16_t*)(ws + (w == 0 ? OFF_WBM : (w == 1 ? OFF_WBH : OFF_WOUT))); }
    else if (tu < 2048) { const int q = tu - 1536; src = p.in[27]; ld = 4096; K = 1024; k0 = (q & 15) * 64; col0 = (q >> 4) * 128; drow0 = col0; dst = (bf16_t*)(ws + OFF_W1T); }
    else { const int q = tu - 2048; src = p.in[29]; ld = 1024; K = 4096; k0 = (q & 63) * 64; col0 = (q >> 6) * 128; drow0 = col0; dst = (bf16_t*)(ws + OFF_W2T); }
    transpose_tile(src, ld, col0, k0, dst, K, drow0, lf);
  }
}

__device__ void phase1(const Params& p, LP lds) {
  unsigned char* ws = p.ws;
  int tid_ = threadIdx.x; asm volatile("" : "+v"(tid_));
  const int tid = tid_, wid = tid >> 6, lane = tid & 63;
  const float* mod = (const float*)(ws + OFF_MOD);
  LAS float* wg = (LAS float*)lds;
  if ((int)blockIdx.x < 1536) {
    f32x4 gw[8];
#pragma unroll
    for (int i = 0; i < 8; ++i) { const int idx = tid + 512 * i, k = idx >> 2, q = idx & 3; gw[i] = *(const f32x4*)(p.in[10] + (size_t)k * INC + 4096 + 4 * q); }
#pragma unroll
    for (int i = 0; i < 8; ++i) { const int idx = tid + 512 * i, k = idx >> 2, q = idx & 3; wg[(4 * q) * 1024 + k] = gw[i][0]; wg[(4 * q + 1) * 1024 + k] = gw[i][1]; wg[(4 * q + 2) * 1024 + k] = gw[i][2]; wg[(4 * q + 3) * 1024 + k] = gw[i][3]; }
    __syncthreads();
  }
  for (int unit = blockIdx.x; unit < 1536; unit += gridDim.x) {
    const int tidn = opaque_tid(); const int wid = tidn >> 6, lane = tidn & 63;
    const int row0 = unit * 16 + wid * 2; const int cb = cond_of_row(row0); const float* md = mod + cb * 6144; const bool smp = row0 >= NCTX;
    f32x4 v[2][4]; float rstd[2];
#pragma unroll
    for (int r = 0; r < 2; ++r) { const int row = row0 + r; const float* xr; int t = 0;
      if (!smp) xr = p.in[0] + (size_t)row * 1024; else { xr = p.in[1] + (size_t)(row - NCTX) * 1024; t = (row - NCTX) & 2047; }
      const float* per = (const float*)(ws + OFF_PER) + (t >> 6) * 512; const float* pec = (const float*)(ws + OFF_PEC) + (t & 63) * 512;
      float ss = 0.f;
#pragma unroll
      for (int i = 0; i < 4; ++i) { const int col = 4 * lane + 256 * i; v[r][i] = *(const f32x4*)(xr + col);
        if (smp) v[r][i] += (col < 512) ? *(const f32x4*)(per + col) : *(const f32x4*)(pec + col - 512);
        ss += v[r][i][0] * v[r][i][0] + v[r][i][1] * v[r][i][1] + v[r][i][2] * v[r][i][2] + v[r][i][3] * v[r][i][3]; }
      ss = wave_sum(ss); rstd[r] = rsqrtf(ss * (1.0f / 1024.0f) + 1e-6f); }
    const float* n1w = p.in[9];
    float ga[32];
#pragma unroll
    for (int g = 0; g < 32; ++g) ga[g] = 0.f;
#pragma unroll
    for (int i = 0; i < 4; ++i) { const int col = 4 * lane + 256 * i;
      const f32x4 w = *(const f32x4*)(n1w + col), sc = *(const f32x4*)(md + 1024 + col), sh = *(const f32x4*)(md + col);
      const f32x4 ws1 = w * (sc + 1.0f);
      f32x4 h[2];
#pragma unroll
      for (int r = 0; r < 2; ++r) { h[r] = v[r][i] * rstd[r] * ws1 + sh;
        u32x2 o; o.x = pack2(h[r][0], h[r][1]); o.y = pack2(h[r][2], h[r][3]); *(u32x2*)((bf16_t*)(ws + OFF_HN) + (size_t)(row0 + r) * 1024 + col) = o; }
#pragma unroll
      for (int g = 0; g < 16; ++g) { const f32x4 wv = *(const LAS f32x4*)(wg + g * 1024 + col);
#pragma unroll
        for (int r = 0; r < 2; ++r) ga[r * 16 + g] += h[r][0] * wv[0] + h[r][1] * wv[1] + h[r][2] * wv[2] + h[r][3] * wv[3]; }
      asm volatile("" ::: "memory"); }
#pragma unroll
    for (int off = 16; off >= 1; off >>= 1) { const bool hi = (lane & off) != 0;
#pragma unroll
      for (int i = 0; i < off; ++i) { const float send = hi ? ga[i] : ga[i + off]; const float keep = hi ? ga[i + off] : ga[i]; ga[i] = keep + __shfl_xor(send, off); } }
    const float tot = ga[0] + __shfl_xor(ga[0], 32);
    if (lane < 32) ((float*)(ws + OFF_GT))[(size_t)row0 * 16 + lane] = tot + p.in[11][4096 + (lane & 15)];
  }
  __syncthreads();
}
__device__ void filters_upper_half(const Params& p, LP lds) {
  unsigned char* ws = p.ws; const int nh = (int)gridDim.x >> 1;
  if ((int)blockIdx.x < nh) return;
  LAS float* w3s = (LAS float*)lds;
  for (int v = (int)blockIdx.x - nh; v < 320; v += (int)gridDim.x - nh) {
    const int tid = opaque_tid();
    const bool smp = v < 256; const int L = smp ? 2048 : 256; const int tt = smp ? (v >> 6) : 0, cgp = v & 63; const int t = tt * 512 + tid;
    { const f32x4 x = *(const f32x4*)(p.in[20] + (size_t)(tid >> 3) * 2048 + cgp * 32 + 4 * (tid & 7)); LAS float* wp = w3s + (4 * (tid & 7)) * 64 + (tid >> 3);
      wp[0] = x[0]; wp[64] = x[1]; wp[128] = x[2]; wp[192] = x[3]; }
    __syncthreads();
    if (t < L) {
      const float* H2 = (const float*)(ws + (smp ? OFF_H2S : OFF_H2C)) + (size_t)t * 64;
      f32x4 h2[16];
#pragma unroll
      for (int i = 0; i < 16; ++i) h2[i] = *(const f32x4*)(H2 + 4 * i);
      const float dist = fabsf((float)t - (float)(L / 2)) / (float)(L / 2);
      float* HF = (float*)(ws + (smp ? OFF_HFS : OFF_HFC)) + (size_t)(cgp * 32) * L + t;
#pragma unroll 1
      for (int j = 0; j < 32; ++j) {
        f32x4 a = {0.f, 0.f, 0.f, 0.f};
#pragma unroll
        for (int i = 0; i < 16; ++i) a += *(const LAS f32x4*)(w3s + j * 64 + 4 * i) * h2[i];
        const int c = (cgp * 32 + j) & 1023;
        const float dmin = -3.0701134573253946f, dmax = -15.350567286626973f;
        const float delta = fabsf(dmin + (dmax - dmin) * ((float)c / 1023.0f));
        HF[(size_t)j * L] = ((a[0] + a[1]) + (a[2] + a[3])) * __expf(-dist * delta); }
    }
    __syncthreads();
  }
}
__device__ void c1_upper_half(const Params& p, LP lds) {
  unsigned char* ws = p.ws; const float* mod = (const float*)(ws + OFF_MOD); const int nh = (int)gridDim.x >> 1;
  if ((int)blockIdx.x < nh) return;
  for (int u = (int)blockIdx.x - nh; u < 128; u += (int)gridDim.x - nh)
    matvec9_unit<0>(mod + 3072, mod + 6144 + 3072, 6144, p.in[27], 4096, p.in[28], (float*)(ws + OFF_C1), 4096, u * 32, (LAS float*)lds);
}

__device__ __forceinline__ bf16x8 tr_frag(LP base, int k0, int m0, int pitch  , int l15, int g) {
  const int q = l15 >> 2, pp = l15 & 3;
  LP a = base + ((k0 + 8 * g + q) * pitch + m0 + 4 * pp) * 2;
  const s16x4 lo = __builtin_amdgcn_ds_read_tr16_b64_v4i16((LAS s16x4*)a);
  const s16x4 hi = __builtin_amdgcn_ds_read_tr16_b64_v4i16((LAS s16x4*)(a + 8 * pitch));
  bf16x8 r; r[0] = lo[0]; r[1] = lo[1]; r[2] = lo[2]; r[3] = lo[3]; r[4] = hi[0]; r[5] = hi[1]; r[6] = hi[2]; r[7] = hi[3]; return r;
}
__device__ __forceinline__ bf16x8 tr_at(LP lanebase, int coff  , int pitch_bytes) {
  const s16x4 lo = __builtin_amdgcn_ds_read_tr16_b64_v4i16((LAS s16x4*)(lanebase + coff));
  const s16x4 hi = __builtin_amdgcn_ds_read_tr16_b64_v4i16((LAS s16x4*)(lanebase + coff + 4 * pitch_bytes));
  bf16x8 r; r[0] = lo[0]; r[1] = lo[1]; r[2] = lo[2]; r[3] = lo[3]; r[4] = hi[0]; r[5] = hi[1]; r[6] = hi[2]; r[7] = hi[3]; return r;
}
constexpr int ML_K = 0, ML_V = 67584, ML_P = 86016, ML_C = 120832, ML_T = 157696, ML_TSZ = 1600;
constexpr int KP = 264, VP = 72, PP = 136, CP = 72;

__device__ void mlstm_item(const Params& p, LP lds, int item) {
  const int tid = opaque_tid(), wid = __builtin_amdgcn_readfirstlane(tid >> 6), lane = tid & 63, l15 = lane & 15, g = lane >> 4;
  const bool smp = item < 256; const int uu = smp ? (item >> 2) : ((item - 256) >> 2); const int sl = item & 3;
  const int b = uu >> 3, dir = (uu >> 2) & 1, head = uu & 3;
  const int S = smp ? SEQS : SEQC, nc = S >> 7; const int tok0 = smp ? NCTX + b * SEQS : b * SEQC;
  const bf16_t* qkv = (const bf16_t*)(p.ws + OFF_BIG);
  const float* GT = (const float*)(p.ws + OFF_GT);
  bf16_t* hout = (bf16_t*)((unsigned char*)p.out + (dir ? OUT_HB : OUT_H));
  const int sidx = (b * 2 + dir) * 4 + head;
  const int gi_col = dir * 8 + head, gf_col = dir * 8 + 4 + head;
  f32x4 Cacc[2][4], nacc[2]; float mst0;
  if (smp) {
    const float* C0 = p.in[2] + (size_t)sidx * 65536;
#pragma unroll
    for (int dt = 0; dt < 2; ++dt) {
#pragma unroll
      for (int vt = 0; vt < 4; ++vt) Cacc[dt][vt] = *(const f32x4*)(C0 + (size_t)((2 * wid + dt) * 16 + l15) * 256 + sl * 64 + 16 * vt + 4 * g);
      nacc[dt] = (f32x4){p.in[3][sidx * 256 + (2 * wid + dt) * 16 + l15], 0.f, 0.f, 0.f}; }
    mst0 = p.in[4][sidx];
  } else {
#pragma unroll
    for (int dt = 0; dt < 2; ++dt) {
#pragma unroll
      for (int vt = 0; vt < 4; ++vt) Cacc[dt][vt] = (f32x4){0.f, 0.f, 0.f, 0.f};
      nacc[dt] = (f32x4){0.f, 0.f, 0.f, 0.f}; }
    mst0 = 0.f;
  }
#define TOKC(cc, j) (dir ? (tok0 + S - 1 - ((cc) * 128 + (j))) : (tok0 + (cc) * 128 + (j)))
  const int rt = (wid < 4) ? wid : 11 - wid;
  const int jrow = 16 * rt + l15;
  bf16x8 qf[8]; u32x4 kreg[8], vreg[2]; float g4[4] = {0.f, 0.f, 0.f, 0.f};
#define ML_LOAD_Q(cc) do { const bf16_t* qp = qkv + (size_t)TOKC(cc, jrow) * 3072 + head * 256 + 8 * g; \
    _Pragma("unroll") for (int kk = 0; kk < 8; ++kk) qf[kk] = *(const bf16x8*)(qp + 32 * kk); } while (0)
#define ML_LOAD_KV(cc) do { \
    _Pragma("unroll") for (int i = 0; i < 8; ++i) { const int row = (tid >> 5) + 16 * i; kreg[i] = *(const u32x4*)(qkv + (size_t)TOKC(cc, row) * 3072 + 1024 + head * 256 + (tid & 31) * 8); } \
    _Pragma("unroll") for (int i = 0; i < 2; ++i) { const int row = (tid >> 3) + 64 * i; vreg[i] = *(const u32x4*)(qkv + (size_t)TOKC(cc, row) * 3072 + 2048 + head * 256 + sl * 64 + (tid & 7) * 8); } \
    if (wid == 0) { const float* g0 = GT + (size_t)TOKC(cc, 2 * lane) * 16; const float* g1 = GT + (size_t)TOKC(cc, 2 * lane + 1) * 16; g4[0] = g0[gi_col]; g4[1] = g0[gf_col]; g4[2] = g1[gi_col]; g4[3] = g1[gf_col]; } } while (0)
#define ML_SCAN(tabp, mcur, mnext) do { LAS float* T_ = (LAS float*)(tabp); \
    const float lf0 = fminf(g4[1], 0.f) - log1pf(__expf(-fabsf(g4[1]))), lf1 = fminf(g4[3], 0.f) - log1pf(__expf(-fabsf(g4[3]))); \
    float s_ = lf0 + lf1; \
    _Pragma("unroll") for (int o = 1; o < 64; o <<= 1) { const float t_ = __shfl_up(s_, o); if (lane >= o) s_ += t_; } \
    const float b1_ = s_, b0_ = s_ - lf1; const float u0_ = g4[0] - b0_, u1_ = g4[2] - b1_; \
    float mx_ = fmaxf(u0_, u1_); \
    _Pragma("unroll") for (int o = 1; o < 64; o <<= 1) { const float t_ = __shfl_up(mx_, o); if (lane >= o) mx_ = fmaxf(mx_, t_); } \
    float ex_ = __shfl_up(mx_, 1); if (lane == 0) ex_ = -INFINITY; \
    const float M0_ = fmaxf(mcur, fmaxf(ex_, u0_)), M1_ = fmaxf(mcur, mx_); \
    T_[2 * lane] = u0_; T_[2 * lane + 1] = u1_; T_[128 + 2 * lane] = M0_; T_[128 + 2 * lane + 1] = M1_; T_[256 + 2 * lane] = b0_; T_[256 + 2 * lane + 1] = b1_; \
    const float Ml_ = __shfl(M1_, 63), bl_ = __shfl(b1_, 63); \
    if (lane == 0) { T_[384] = mcur; T_[385] = Ml_; } \
    mnext = bl_ + Ml_; } while (0)
  float mw0 = mst0;
  ML_LOAD_Q(0); ML_LOAD_KV(0);
  if (wid == 0) { float mn; ML_SCAN(lds + ML_T, mw0, mn); mw0 = mn; }
  __syncthreads();
  float m_final = 0.f;
  for (int c = 0; c < nc; ++c) {
    LAS float* T = (LAS float*)(lds + ML_T + (c & 1) * ML_TSZ);
    const float mst = T[384], M_last = T[385];
#pragma unroll
    for (int i = 0; i < 8; ++i) { const int row = (tid >> 5) + 16 * i; *(LAS u32x4*)(lds + ML_K + (row * KP + (tid & 31) * 8) * 2) = kreg[i]; }
#pragma unroll
    for (int i = 0; i < 2; ++i) { const int row = (tid >> 3) + 64 * i; const float w = __expf(T[row] - M_last); const u32x4 v = vreg[i]; u32x4 o;
      o.x = pack2(bflo(v.x) * w, bfhi(v.x) * w); o.y = pack2(bflo(v.y) * w, bfhi(v.y) * w); o.z = pack2(bflo(v.z) * w, bfhi(v.z) * w); o.w = pack2(bflo(v.w) * w, bfhi(v.w) * w);
      *(LAS u32x4*)(lds + ML_V + (row * VP + (tid & 7) * 8) * 2) = o; }
    if (tid < 128) *(LAS unsigned short*)(lds + ML_V + (tid * VP + 64) * 2) = f2bf(__expf(T[tid] - M_last));
#pragma unroll
    for (int dt = 0; dt < 2; ++dt) {
#pragma unroll
      for (int vt = 0; vt < 4; ++vt) { u32x2 w; w.x = pack2(Cacc[dt][vt][0], Cacc[dt][vt][1]); w.y = pack2(Cacc[dt][vt][2], Cacc[dt][vt][3]);
        *(LAS u32x2*)(lds + ML_C + (((2 * wid + dt) * 16 + l15) * CP + 16 * vt + 4 * g) * 2) = w; }
      if (g == 0) *(LAS unsigned short*)(lds + ML_C + (((2 * wid + dt) * 16 + l15) * CP + 64) * 2) = f2bf(nacc[dt][0]); }
    const int qtok = TOKC(c, jrow);
    const bool more = (c + 1 < nc);
    __syncthreads();
    const float Mj = T[128 + jrow], bj = T[256 + jrow]; const float rf = __expf(M_last - Mj), w_inter = __expf(mst - Mj);
    int lq_ = (8 * g + (l15 >> 2)), lp_ = 4 * (l15 & 3); asm volatile("" : "+v"(lq_), "+v"(lp_));
    const LP cB = lds + ML_C + (lq_ * CP + lp_) * 2, vB = lds + ML_V + (lq_ * VP + lp_) * 2, kB = lds + ML_K + (lq_ * KP + lp_ + 32 * wid) * 2;
    const LP pB = lds + ML_P + (jrow * PP + 8 * g) * 2;
    for (int st = 0; st <= rt; ++st) {
      f32x4 s = {0.f, 0.f, 0.f, 0.f};
      bf16x8 kfr[8];
#pragma unroll
      for (int kk = 0; kk < 8; ++kk) kfr[kk] = *(const LAS bf16x8*)(lds + ML_K + ((16 * st + l15) * KP + 32 * kk + 8 * g) * 2);
      __builtin_amdgcn_sched_barrier(0);
#pragma unroll
      for (int kk = 0; kk < 8; ++kk) s = __builtin_amdgcn_mfma_f32_16x16x32_bf16(kfr[kk], qf[kk], s, 0, 0, 0);
      float pv[4];
#pragma unroll
      for (int i = 0; i < 4; ++i) pv[i] = ((16 * st + 4 * g + i) <= jrow) ? s[i] * rf : 0.f;
      u32x2 w; w.x = pack2(pv[0], pv[1]); w.y = pack2(pv[2], pv[3]);
      *(LAS u32x2*)(lds + ML_P + (jrow * PP + 16 * st + 4 * g) * 2) = w;
    }
    if ((rt & 1) == 0) { u32x2 z; z.x = 0u; z.y = 0u; *(LAS u32x2*)(lds + ML_P + (jrow * PP + 16 * (rt + 1) + 4 * g) * 2) = z; }
    if (more) ML_LOAD_KV(c + 1);
    asm volatile("s_waitcnt lgkmcnt(0)" ::: "memory");
    f32x4 ha[5];
#pragma unroll
    for (int vt = 0; vt < 5; ++vt) { f32x4 a = {0.f, 0.f, 0.f, 0.f};
      if (smp || c > 0) {
        bf16x8 cfr[8];
#pragma unroll
        for (int kk = 0; kk < 8; ++kk) cfr[kk] = tr_at(cB, (32 * kk * CP + 16 * vt) * 2, CP * 2);
        __builtin_amdgcn_sched_barrier(0);
#pragma unroll
        for (int kk = 0; kk < 8; ++kk) a = __builtin_amdgcn_mfma_f32_16x16x32_bf16(cfr[kk], qf[kk], a, 0, 0, 0);
        a *= w_inter; }
      ha[vt] = a; }
    for (int k2 = 0; k2 <= (rt >> 1); ++k2) {
      const bf16x8 pf = *(const LAS bf16x8*)(pB + k2 * 64);
      bf16x8 vfr[5];
#pragma unroll
      for (int vt = 0; vt < 5; ++vt) vfr[vt] = tr_at(vB + k2 * (32 * VP * 2), (16 * vt) * 2, VP * 2);
      __builtin_amdgcn_sched_barrier(0);
#pragma unroll
      for (int vt = 0; vt < 5; ++vt) ha[vt] = __builtin_amdgcn_mfma_f32_16x16x32_bf16(vfr[vt], pf, ha[vt], 0, 0, 0); }
    { const float den = __shfl(ha[4][0], l15); const float rdd = 1.0f / fmaxf(fabsf(den), __expf(-(bj + Mj)));
#pragma unroll
      for (int vt = 0; vt < 4; ++vt) { const f32x4 a = ha[vt] * rdd; u32x2 w; w.x = pack2(a[0], a[1]); w.y = pack2(a[2], a[3]);
        *(u32x2*)(hout + (size_t)qtok * 1024 + head * 256 + sl * 64 + 16 * vt + 4 * g) = w; } }
    if (more) ML_LOAD_Q(c + 1);
    const bool need_state = (!smp) || more;
    if (need_state) {
      const float decay = __expf(mst - M_last);
#pragma unroll
      for (int dt = 0; dt < 2; ++dt) {
#pragma unroll
        for (int vt = 0; vt < 4; ++vt) Cacc[dt][vt] *= decay;
        nacc[dt] *= decay; }
#pragma unroll
      for (int ks = 0; ks < 4; ++ks) {
        const bf16x8 kf0 = tr_at(kB, (32 * ks * KP) * 2, KP * 2), kf1 = tr_at(kB, (32 * ks * KP + 16) * 2, KP * 2);
        bf16x8 vfr[5];
#pragma unroll
        for (int vt = 0; vt < 5; ++vt) vfr[vt] = tr_at(vB, (32 * ks * VP + 16 * vt) * 2, VP * 2);
        __builtin_amdgcn_sched_barrier(0);
#pragma unroll
        for (int vt = 0; vt < 4; ++vt) { Cacc[0][vt] = __builtin_amdgcn_mfma_f32_16x16x32_bf16(vfr[vt], kf0, Cacc[0][vt], 0, 0, 0); Cacc[1][vt] = __builtin_amdgcn_mfma_f32_16x16x32_bf16(vfr[vt], kf1, Cacc[1][vt], 0, 0, 0); }
        nacc[0] = __builtin_amdgcn_mfma_f32_16x16x32_bf16(vfr[4], kf0, nacc[0], 0, 0, 0); nacc[1] = __builtin_amdgcn_mfma_f32_16x16x32_bf16(vfr[4], kf1, nacc[1], 0, 0, 0);
      }
    }
    if (wid == 0 && more) { float mn; ML_SCAN(lds + ML_T + ((c + 1) & 1) * ML_TSZ, mw0, mn); mw0 = mn; }
    m_final = T[256 + 127] + M_last;
    __syncthreads();
  }
#undef ML_LOAD_Q
#undef ML_LOAD_KV
#undef ML_SCAN
#undef TOKC
  if (!smp) {
    float* oC = p.out + OUTF_C + (size_t)sidx * 65536;
#pragma unroll
    for (int dt = 0; dt < 2; ++dt) {
#pragma unroll
      for (int vt = 0; vt < 4; ++vt) *(f32x4*)(oC + (size_t)((2 * wid + dt) * 16 + l15) * 256 + sl * 64 + 16 * vt + 4 * g) = Cacc[dt][vt];
      if (sl == 0 && g == 0) p.out[OUTF_N + (size_t)sidx * 256 + (2 * wid + dt) * 16 + l15] = nacc[dt][0]; }
    if (sl == 0 && tid == 0) p.out[OUTF_M + sidx] = m_final;
  }
}

__device__ void combine_rows(const Params& p) {
  const int tid0 = opaque_tid(); const int wid = tid0 >> 6, lane = tid0 & 63;
  bf16_t* H = (bf16_t*)((unsigned char*)p.out + OUT_H); const bf16_t* HB = (const bf16_t*)((unsigned char*)p.out + OUT_HB); const float* nw = p.in[22];
  f32x4 wv[4];
#pragma unroll
  for (int i = 0; i < 4; ++i) wv[i] = *(const f32x4*)(nw + 16 * lane + 4 * i);
  const int nh = (int)gridDim.x >> 1;
  if ((int)blockIdx.x < nh) return;
  for (int unit = (int)blockIdx.x - nh; unit < 768; unit += (int)gridDim.x - nh) {
    const int row0 = unit * 32 + wid * 4;
    u32x4 a[4][2], bq[4][2];
#pragma unroll
    for (int r = 0; r < 4; ++r)
#pragma unroll
      for (int i = 0; i < 2; ++i) { a[r][i] = *(const u32x4*)(H + (size_t)(row0 + r) * 1024 + 16 * lane + 8 * i); bq[r][i] = *(const u32x4*)(HB + (size_t)(row0 + r) * 1024 + 16 * lane + 8 * i); }
#pragma unroll
    for (int r = 0; r < 4; ++r) {
      f32x4 v[4]; float ss = 0.f;
#pragma unroll
      for (int i = 0; i < 2; ++i) { f32x4 x0, x1, y0, y1; unpack8(a[r][i], x0, x1); unpack8(bq[r][i], y0, y1); v[2 * i] = x0 + y0; v[2 * i + 1] = x1 + y1; }
#pragma unroll
      for (int i = 0; i < 4; ++i) ss += v[i][0] * v[i][0] + v[i][1] * v[i][1] + v[i][2] * v[i][2] + v[i][3] * v[i][3];
      ss += __shfl_xor(ss, 1); ss += __shfl_xor(ss, 2); ss += __shfl_xor(ss, 4); ss += __shfl_xor(ss, 8);
      const float rr = rsqrtf(ss * (1.0f / 256.0f) + 1e-6f);
#pragma unroll
      for (int i = 0; i < 2; ++i) *(u32x4*)(H + (size_t)(row0 + r) * 1024 + 16 * lane + 8 * i) = pack8(v[2 * i] * rr * wv[2 * i], v[2 * i + 1] * rr * wv[2 * i + 1]);
    }
  }
}

constexpr int HY_WAVE = 18816, HY_HR = 0, HY_ZA = 8576, HY_ZB = 8576 + 5120;
__device__ void hyena_item(const Params& p, LP lds, int item) {
  const int tid = opaque_tid(), wid = __builtin_amdgcn_readfirstlane(tid >> 6), lane = tid & 63, n31 = lane & 31, hh = lane >> 5;
  const bool smp = item < 1024; const int it = smp ? item : item - 1024; const int bset = it >> 7, cgp = it & 127; const int c = cgp * 8 + wid;
  const int L = smp ? 2048 : 256, lgL = smp ? 11 : 8, nblk = L >> 5, lgnb = lgL - 5, ntok = 2048, ntile = 2, dmax = L >> 6;
  const int tok0 = smp ? NCTX + bset * 2048 : bset * 2048;
  LP wl = lds + wid * HY_WAVE; LAS float* hr = (LAS float*)(wl + HY_HR);
  const float* HFp = (const float*)(p.ws + (smp ? OFF_HFS : OFF_HFC));
  const bf16_t* UT = (const bf16_t*)(p.ws + OFF_BIG);
  const float* cw = p.in[12]; const float* cbv = p.in[13]; const float* skp = p.in[21];
  { const int uc = 2048 + c; const float w0 = cw[uc], w1 = cw[3072 + uc], w2 = cw[6144 + uc], cb = cbv[uc]; const bf16_t* src = UT + (size_t)uc * NTOK + tok0;
    u32x4 vv[4]; float pvv[4], nxv[4];
#pragma unroll
    for (int i = 0; i < 4; ++i) { const int base = lane * 8 + 512 * i; vv[i] = (u32x4){0u, 0u, 0u, 0u}; pvv[i] = 0.f; nxv[i] = 0.f;
      if (base < ntok) { vv[i] = *(const u32x4*)(src + base); const int tl = base & (L - 1);
        if (tl != 0) pvv[i] = bf2f(src[base - 1]); if (tl + 8 != L) nxv[i] = bf2f(src[base + 8]); } }
#pragma unroll
    for (int i = 0; i < 4; ++i) { const int base = lane * 8 + 512 * i;
      if (base < ntok) { const u32x4 v = vv[i];
        float u[10]; u[0] = pvv[i]; u[1] = bflo(v.x); u[2] = bfhi(v.x); u[3] = bflo(v.y); u[4] = bfhi(v.y); u[5] = bflo(v.z); u[6] = bfhi(v.z); u[7] = bflo(v.w); u[8] = bfhi(v.w); u[9] = nxv[i];
        float o[8];
#pragma unroll
        for (int e = 0; e < 8; ++e) o[e] = cb + w0 * u[e] + w1 * u[e + 1] + w2 * u[e + 2];
        u32x4 w; w.x = pack2(o[0], o[1]); w.y = pack2(o[2], o[3]); w.z = pack2(o[4], o[5]); w.w = pack2(o[6], o[7]);
        *(LAS u32x4*)(wl + HY_ZA + ((base >> 5) * 40 + (base & 31)) * 2) = w; } } }
  const int HRP = L + 96;
  f32x4 fvN[8];
#define HY_FLOAD(o) do { const float* src_ = HFp + (size_t)((o) * 1024 + c) * L; \
    _Pragma("unroll") for (int i = 0; i < 8; ++i) { const int q = lane + 64 * i; fvN[i] = (4 * q < L) ? *(const f32x4*)(src_ + 4 * q) : (f32x4){0.f, 0.f, 0.f, 0.f}; } } while (0)
  HY_FLOAD(0);
  for (int ord = 0; ord < 2; ++ord) {
    { float sa = 0.f;
      f32x4 fv[8];
#pragma unroll
      for (int i = 0; i < 8; ++i) fv[i] = fvN[i];
#pragma unroll
      for (int i = 0; i < 8; ++i) sa += (fabsf(fv[i][0]) + fabsf(fv[i][1])) + (fabsf(fv[i][2]) + fabsf(fv[i][3]));
      sa = wave_sum(sa); const float inv = 1.0f / (sa + 1e-6f);
      asm volatile("s_waitcnt lgkmcnt(0)" ::: "memory");
      LAS bf16_t* E = (LAS bf16_t*)hr; LAS bf16_t* O = E + HRP;
#pragma unroll
      for (int i = 0; i < 8; ++i) { const int q = lane + 64 * i;
        if (4 * q < L) {
#pragma unroll
          for (int e = 0; e < 4; ++e) { const int yy = L - 1 - (4 * q + e); const bf16_t v = f2bf(fv[i][e] * inv); E[32 + yy] = v; O[31 + yy] = v; } } }
      if (lane < 32) { E[lane] = 0; E[32 + L + lane] = 0; O[31 + L + lane] = 0; if (lane < 31) O[lane] = 0; }
      if (lane < 33) O[HRP - 33 + lane] = 0;
      asm volatile("s_waitcnt lgkmcnt(0)" ::: "memory"); }
    if (ord == 0) HY_FLOAD(1);
    LP zin = wl + (ord == 0 ? HY_ZA : HY_ZB); LP zout = wl + (ord == 0 ? HY_ZB : HY_ZA);
    const int gc = ord * 1024 + c; const float w0 = cw[gc], w1 = cw[3072 + gc], w2 = cw[6144 + gc], cb = cbv[gc], sk = skp[ord * 1024 + c];
    const bf16_t* gsrc = UT + (size_t)gc * NTOK + tok0;
    u32x4 gv[4]; unsigned gpv[4], gnx[4];
#pragma unroll
    for (int i = 0; i < 4; ++i) { const int base = lane * 8 + 512 * i; gv[i] = (u32x4){0u, 0u, 0u, 0u}; gpv[i] = 0u; gnx[i] = 0u;
      if (base < ntok) { gv[i] = *(const u32x4*)(gsrc + base); const int tl = base & (L - 1);
        if (tl != 0) gpv[i] = gsrc[base - 1]; if (tl + 8 != L) gnx[i] = gsrc[base + 8]; } }
    f32x16 accs[2];
#pragma unroll
    for (int o2 = 0; o2 < 2; ++o2)
#pragma unroll
      for (int r = 0; r < 16; ++r) accs[o2][r] = 0.f;
    LP fb = wl + HY_HR + ((n31 & 1) ? 0 : (HRP * 2 - 2)) + 2 * ((L >> 1) - 1 - n31 + 8 * hh + 32);
    int cbl[2], ca[2];
#pragma unroll
    for (int ot = 0; ot < 2; ++ot) { const int col = 32 * ot + n31; cbl[ot] = (col >> lgnb) << lgnb; ca[ot] = col & (nblk - 1); }
    const bool two = (ntile == 2);
    {
      LP zero = wl + HY_HR + 16 * hh;
      LP ap = fb + 64 * dmax;
      int bbr0 = ca[0] + dmax, bbr1 = ca[1] + dmax;
      LP bp0 = zin + ((cbl[0] + bbr0) * 40 + 8 * hh) * 2, bp1 = zin + ((cbl[1] + bbr1) * 40 + 8 * hh) * 2;
      for (int d = -dmax; d <= dmax; ++d) {
        u32x4 w0v, w1v;
        w0v.x = *(const LAS unsigned*)(ap); w0v.y = *(const LAS unsigned*)(ap + 4); w0v.z = *(const LAS unsigned*)(ap + 8); w0v.w = *(const LAS unsigned*)(ap + 12);
        w1v.x = *(const LAS unsigned*)(ap + 32); w1v.y = *(const LAS unsigned*)(ap + 36); w1v.z = *(const LAS unsigned*)(ap + 40); w1v.w = *(const LAS unsigned*)(ap + 44);
        const bf16x8 af0 = __builtin_bit_cast(bf16x8, w0v), af1 = __builtin_bit_cast(bf16x8, w1v);
        LP q0 = ((unsigned)bbr0 < (unsigned)nblk) ? bp0 : zero;
        LP q1 = (two && ((unsigned)bbr1 < (unsigned)nblk)) ? bp1 : zero;
        const bf16x8 b00 = *(const LAS bf16x8*)q0, b01 = *(const LAS bf16x8*)(q0 + 32);
        const bf16x8 b10 = *(const LAS bf16x8*)q1, b11 = *(const LAS bf16x8*)(q1 + 32);
        __builtin_amdgcn_sched_barrier(0);
        accs[0] = __builtin_amdgcn_mfma_f32_32x32x16_bf16(af0, b00, accs[0], 0, 0, 0);
        if (two) accs[1] = __builtin_amdgcn_mfma_f32_32x32x16_bf16(af0, b10, accs[1], 0, 0, 0);
        accs[0] = __builtin_amdgcn_mfma_f32_32x32x16_bf16(af1, b01, accs[0], 0, 0, 0);
        if (two) accs[1] = __builtin_amdgcn_mfma_f32_32x32x16_bf16(af1, b11, accs[1], 0, 0, 0);
        ap -= 64; bbr0 -= 1; bbr1 -= 1; bp0 -= 80; bp1 -= 80;
      }
    }
#pragma unroll
    for (int ot = 0; ot < 2; ++ot) {
      if (ot >= ntile) continue;
      const f32x16 acc = accs[ot];
#pragma unroll
      for (int rg = 0; rg < 4; ++rg) {
        const int zo = (((cbl[ot] + ca[ot]) * 40) + 8 * rg + 4 * hh) * 2;
        const u32x2 zv = *(const LAS u32x2*)(zin + zo);
        u32x2 w; w.x = pack2(acc[4 * rg] + sk * bflo(zv.x), acc[4 * rg + 1] + sk * bfhi(zv.x)); w.y = pack2(acc[4 * rg + 2] + sk * bflo(zv.y), acc[4 * rg + 3] + sk * bfhi(zv.y));
        *(LAS u32x2*)(zout + zo) = w;
      }
    }
    asm volatile("s_waitcnt lgkmcnt(0)" ::: "memory");
#pragma unroll
    for (int i = 0; i < 4; ++i) { const int base = lane * 8 + 512 * i;
      if (base < ntok) { const u32x4 v = gv[i];
        float u[10]; u[0] = bf2f(gpv[i]); u[1] = bflo(v.x); u[2] = bfhi(v.x); u[3] = bflo(v.y); u[4] = bfhi(v.y); u[5] = bflo(v.z); u[6] = bfhi(v.z); u[7] = bflo(v.w); u[8] = bfhi(v.w); u[9] = bf2f(gnx[i]);
        LP zp = zout + ((base >> 5) * 40 + (base & 31)) * 2; const u32x4 t = *(const LAS u32x4*)zp;
        float tv[8]; tv[0] = bflo(t.x); tv[1] = bfhi(t.x); tv[2] = bflo(t.y); tv[3] = bfhi(t.y); tv[4] = bflo(t.z); tv[5] = bfhi(t.z); tv[6] = bflo(t.w); tv[7] = bfhi(t.w);
        float o[8];
#pragma unroll
        for (int e = 0; e < 8; ++e) o[e] = (cb + w0 * u[e] + w1 * u[e + 1] + w2 * u[e + 2]) * tv[e];
        u32x4 w; w.x = pack2(o[0], o[1]); w.y = pack2(o[2], o[3]); w.z = pack2(o[4], o[5]); w.w = pack2(o[6], o[7]);
        *(LAS u32x4*)zp = w; } }
    asm volatile("s_waitcnt lgkmcnt(0)" ::: "memory");
  }
  __syncthreads();
  { bf16_t* YH = (bf16_t*)((unsigned char*)p.out + OUT_HB);
    for (int tl = tid; tl < ntok; tl += 512) {
      const int bl = tl >> lgL, tloc = tl & (L - 1); const int zo = ((((bl << lgnb) + (tloc >> 5)) * 40) + (tloc & 31)) * 2;
      unsigned short e[8];
#pragma unroll
      for (int w = 0; w < 8; ++w) e[w] = *(const LAS unsigned short*)(lds + w * HY_WAVE + HY_ZA + zo);
      u32x4 o; o.x = e[0] | ((unsigned)e[1] << 16); o.y = e[2] | ((unsigned)e[3] << 16); o.z = e[4] | ((unsigned)e[5] << 16); o.w = e[6] | ((unsigned)e[7] << 16);
      *(u32x4*)(YH + (size_t)(tok0 + tl) * 1024 + cgp * 8) = o; } }
  __syncthreads();
}

__device__ void final_norm(const Params& p) {
  const int tid0 = opaque_tid(); const int wid = tid0 >> 6, lane = tid0 & 63; const float* fw = p.in[31];
  const float* P = (const float*)(p.ws + OFF_BIG + (size_t)8192 * 4096 * 2); const float* mod = (const float*)(p.ws + OFF_MOD);
  f32x4 wv[4];
#pragma unroll
  for (int i = 0; i < 4; ++i) wv[i] = *(const f32x4*)(fw + 4 * lane + 256 * i);
  for (int unit = blockIdx.x; unit < 768; unit += gridDim.x) {
    const int row0 = unit * 32 + wid * 4; const bool chunkB = row0 >= 16384;
    f32x4 x[4][4];
#pragma unroll
    for (int r = 0; r < 4; ++r)
#pragma unroll
      for (int i = 0; i < 4; ++i) x[r][i] = *(const f32x4*)(p.out + (size_t)(row0 + r) * 1024 + 4 * lane + 256 * i);
    if (chunkB) { const float* md = mod + cond_of_row(row0) * 6144 + 5120;
#pragma unroll
      for (int i = 0; i < 4; ++i) { const f32x4 g2 = *(const f32x4*)(md + 4 * lane + 256 * i);
#pragma unroll
        for (int r = 0; r < 4; ++r) x[r][i] += g2 * *(const f32x4*)(P + (size_t)(row0 + r - 16384) * 1024 + 4 * lane + 256 * i); } }
#pragma unroll
    for (int r = 0; r < 4; ++r) { float ss = 0.f;
#pragma unroll
      for (int i = 0; i < 4; ++i) ss += x[r][i][0] * x[r][i][0] + x[r][i][1] * x[r][i][1] + x[r][i][2] * x[r][i][2] + x[r][i][3] * x[r][i][3];
      ss = wave_sum(ss); const float rstd = rsqrtf(ss * (1.0f / 1024.0f) + 1e-6f);
#pragma unroll
      for (int i = 0; i < 4; ++i) *(f32x4*)(p.out + (size_t)(row0 + r) * 1024 + 4 * lane + 256 * i) = x[r][i] * rstd * wv[i]; }
  }
}

__global__ void __launch_bounds__(512, 2) __attribute__((flatten)) mega(Params p) {
  extern __shared__ __attribute__((aligned(16))) unsigned char shm[];
  LP lds = (LP)shm;
  cg::grid_group grid = cg::this_grid();
  volatile LAS unsigned* xst = (volatile LAS unsigned*)(lds + LDS_BYTES - 16);
  if (threadIdx.x == 0) { xst[0] = 0u; xst[1] = 0u; }
  __syncthreads();
  const XcdBarrier xb = xcd_barrier_post((unsigned*)(p.ws + OFF_BAR), xst);
  unsigned char* ws = p.ws;
  const bf16_t* WT = (const bf16_t*)(ws + OFF_WT); const bf16_t* HN = (const bf16_t*)(ws + OFF_HN); bf16_t* BIG = (bf16_t*)(ws + OFF_BIG);
  bf16_t* Hb = (bf16_t*)((unsigned char*)p.out + OUT_H); bf16_t* YH = (bf16_t*)((unsigned char*)p.out + OUT_HB);
  const float* mod = (const float*)(ws + OFF_MOD);
  phase0(p, lds);
  if (gridDim.y == 7u) grid.sync();
  xcd_barrier(xb);
  phase1(p, lds);
  weight_tiles(p, lds, 0, 384, 0);
  xcd_barrier(xb);
  filters_upper_half(p, lds);
  weight_tiles(p, lds, 384, 768, 1);
  { EpiQKV e; e.O = BIG; e.bias = p.in[11]; run_gemm(lds, HN, WT, NTOK, 3072, 1024, e); }
  xcd_barrier(xb);
  for (int item = blockIdx.x; item < 1280; item += gridDim.x) mlstm_item(p, lds, item);
  xcd_barrier(xb);
  combine_rows(p);
  weight_tiles(p, lds, 768, 1152, 1);
  { EpiUT e; e.O = BIG; e.bias = p.in[11] + 4112; run_gemm(lds, WT + (size_t)3072 * 1024, HN, 3072, NTOK, 1024, e); }
  xcd_barrier(xb);
  for (int item = blockIdx.x; item < 1536; item += gridDim.x) hyena_item(p, lds, item);
  xcd_barrier(xb);
  c1_upper_half(p, lds);
  weight_tiles(p, lds, 1152, 1536, 1);
  { EpiGates e; e.H = Hb; e.G = BIG; e.b_in = p.in[11]; run_gemm(lds, HN, WT + (size_t)6144 * 1024, NTOK, 3072, 1024, e); }
  xcd_barrier(xb);
  bf16_t* T = BIG + (size_t)NTOK * 2048;
  weight_tiles(p, lds, 1536, 2560, 1);
  { EpiMerge<0> e; e.T = T; e.G = BIG; run_gemm(lds, Hb, (const bf16_t*)(ws + OFF_WBM), NTOK, 1024, 1024, e); }
  { EpiMerge<1> e; e.T = T; e.G = BIG; run_gemm(lds, YH, (const bf16_t*)(ws + OFF_WBH), NTOK, 1024, 1024, e); }
  xcd_barrier(xb);
  { EpiOut e; e.xp = p.in[0]; e.xs = p.in[1]; e.per = (const float*)(ws + OFF_PER); e.pec = (const float*)(ws + OFF_PEC); e.mod = mod; e.n2w = p.in[26];
    e.X1 = p.out; e.A2 = (bf16_t*)(ws + OFF_HN); e.ssq = (float*)(ws + OFF_SSQ1); run_gemm(lds, T, (const bf16_t*)(ws + OFF_WOUT), NTOK, 1024, 1024, e); }
  xcd_barrier(xb);
  constexpr int ROWS_A = 16384, ROWS_B = NTOK - ROWS_A;
  { EpiFF1 e; e.row0 = 0; e.ssq = (const float*)(p.ws + OFF_SSQ1); e.c1 = (const float*)(p.ws + OFF_C1); e.Hd = (bf16_t*)(p.ws + OFF_BIG);
    run_gemm(lds, (const bf16_t*)(p.ws + OFF_HN), (const bf16_t*)(p.ws + OFF_W1T), ROWS_A, 4096, 1024, e); }
  xcd_barrier(xb);
  { EpiFF2 e; e.row0 = 0; e.mod = (const float*)(p.ws + OFF_MOD); e.b2 = p.in[30]; e.X = p.out; e.P = (float*)(p.ws + OFF_BIG + (size_t)ROWS_A * 4096 * 2);
    run_gemm(lds, (const bf16_t*)(p.ws + OFF_BIG), (const bf16_t*)(p.ws + OFF_W2T), ROWS_A, 1024, 4096, e); }
  xcd_barrier(xb);
  { EpiFF1 e; e.row0 = ROWS_A; e.ssq = (const float*)(p.ws + OFF_SSQ1); e.c1 = (const float*)(p.ws + OFF_C1); e.Hd = (bf16_t*)(p.ws + OFF_BIG);
    run_gemm(lds, (const bf16_t*)(p.ws + OFF_HN) + (size_t)ROWS_A * 1024, (const bf16_t*)(p.ws + OFF_W1T), ROWS_B, 4096, 1024, e); }
  xcd_barrier(xb);
  { EpiFF2 e; e.row0 = ROWS_A; e.mod = (const float*)(p.ws + OFF_MOD); e.b2 = p.in[30]; e.X = p.out; e.P = (float*)(p.ws + OFF_BIG + (size_t)ROWS_B * 4096 * 2);
    run_gemm(lds, (const bf16_t*)(p.ws + OFF_BIG), (const bf16_t*)(p.ws + OFF_W2T), ROWS_B, 1024, 4096, e, 2); }
  xcd_barrier(xb);
  final_norm(p);
}

extern "C" void kernel_launch(void* const* d_in, const int* in_sizes, int n_in, void* d_out, int out_size, void* d_ws, size_t ws_size, hipStream_t stream) {
  static int grid_blocks = 0;
  if (!grid_blocks) {
    int dev = 0, cus = 0, per_cu = 0;
    hipGetDevice(&dev);
    hipDeviceGetAttribute(&cus, hipDeviceAttributeMultiprocessorCount, dev);
    hipFuncSetAttribute((const void*)mega, hipFuncAttributeMaxDynamicSharedMemorySize, LDS_BYTES);
    hipOccupancyMaxActiveBlocksPerMultiprocessor(&per_cu, (const void*)mega, 512, LDS_BYTES);
    if (per_cu < 1) { fprintf(stderr, "kernel_launch: occupancy query reports %d blocks per CU\n", per_cu); grid_blocks = -1; }
    else grid_blocks = cus;
    if (n_in != 32 || ws_size < WS_END) { fprintf(stderr, "kernel_launch: unexpected n_in %d / ws_size %zu (need %zu)\n", n_in, ws_size, (size_t)WS_END); grid_blocks = -1; }
  }
  if (grid_blocks < 0) return;
  hipMemsetAsync((unsigned char*)d_ws + OFF_BAR, 0, 3456 * 4, stream);
  Params p{};
  for (int i = 0; i < 32; ++i) p.in[i] = (const float*)d_in[i];
  p.out = (float*)d_out; p.ws = (unsigned char*)d_ws;
  void* args[] = {&p};
  hipError_t e = hipLaunchCooperativeKernel((void*)mega, dim3(grid_blocks), dim3(512), args, LDS_BYTES, stream);
  if (e != hipSuccess) fprintf(stderr, "cooperative launch failed: %s (grid %d)\n", hipGetErrorString(e), grid_blocks);
}
```

```cpp
#include <hip/hip_runtime.h>
#include <hip/hip_cooperative_groups.h>
#include <cstdio>
#include <cstdint>
namespace cg = cooperative_groups;

#define LAS __attribute__((address_space(3)))
typedef LAS unsigned char* LP;
typedef unsigned short bf16_t;
typedef short bf16x8 __attribute__((ext_vector_type(8)));
typedef short s16x4 __attribute__((ext_vector_type(4)));
typedef float f32x4 __attribute__((ext_vector_type(4)));
typedef float f32x16 __attribute__((ext_vector_type(16)));
typedef unsigned u32x4 __attribute__((ext_vector_type(4)));
typedef unsigned u32x2 __attribute__((ext_vector_type(2)));

constexpr int DM = 1024, NTOK = 24576, NCTX = 8192, SEQC = 256, SEQS = 2048, INC = 9232;
constexpr int LDS_BYTES = 160 * 1024;
constexpr size_t OFF_WT = 0;
constexpr size_t OFF_WBM = 18874368, OFF_WBH = 20971520, OFF_WOUT = 23068672, OFF_W1T = 25165824, OFF_W2T = 33554432;
constexpr size_t OFF_HN = 41943040;
constexpr size_t OFF_BIG = 92274688;
constexpr size_t OFF_SM = 243269632;
constexpr size_t OFF_MOD = OFF_SM;
constexpr size_t OFF_C1 = OFF_MOD + 221184;
constexpr size_t OFF_H2S = OFF_C1 + 147456;
constexpr size_t OFF_H2C = OFF_H2S + 524288;
constexpr size_t OFF_PER = OFF_H2C + 65536;
constexpr size_t OFF_PEC = OFF_PER + 65536;
constexpr size_t OFF_GT = OFF_PEC + 131072;
constexpr size_t OFF_SSQ1 = OFF_GT + 1572864;
constexpr size_t OFF_SSQ2 = OFF_SSQ1 + 1572864;
constexpr size_t OFF_HFS = OFF_SSQ2 + 1572864;
constexpr size_t OFF_HFC = OFF_HFS + 16777216;
constexpr size_t OFF_BAR = OFF_HFC + 2097152;
constexpr size_t WS_END = OFF_BAR + 3456 * 4;
constexpr size_t OUT_H = 0, OUT_HB = 50331648;
constexpr size_t OUTF_C = 25165824, OUTF_N = 41943040, OUTF_M = 42008576;

struct Params { const float* in[32]; float* out; unsigned char* ws; };

__device__ __forceinline__ bf16_t f2bf(float f) { unsigned u = __float_as_uint(f); u += 0x7FFFu + ((u >> 16) & 1u); return (bf16_t)(u >> 16); }
__device__ __forceinline__ float bf2f(unsigned b) { return __uint_as_float(b << 16); }
__device__ __forceinline__ unsigned pack2(float lo, float hi) { return (unsigned)f2bf(lo) | ((unsigned)f2bf(hi) << 16); }
__device__ __forceinline__ float bflo(unsigned w) { return __uint_as_float(w << 16); }
__device__ __forceinline__ float bfhi(unsigned w) { return __uint_as_float(w & 0xffff0000u); }
__device__ __forceinline__ float sigmoidf_(float x) { return 1.0f / (1.0f + __expf(-x)); }
__device__ __forceinline__ int opaque_tid() { int t = threadIdx.x; asm volatile("" : "+v"(t)); return t; }
__device__ __forceinline__ float wave_sum(float v) {
#pragma unroll
  for (int o = 32; o >= 1; o >>= 1) v += __shfl_xor(v, o);
  return v;
}


#define XB_TMO      128
#define XB_XCNT(j)  (256  + 64 * (j))
#define XB_XSUB(j)  (1280 + 64 * (j))
#define XB_XGEN(j)  (2304 + 64 * (j))
#define XB_TOP      3328
#define XB_TOPGEN   3392
#define XCD_BAR_WORDS 3456
#define XB_SPIN_CAP (1u << 18)
__device__ __forceinline__ unsigned xb_ld(unsigned* p)              { return __hip_atomic_load(p, __ATOMIC_RELAXED, __HIP_MEMORY_SCOPE_AGENT); }
__device__ __forceinline__ unsigned xb_add(unsigned* p, unsigned v) { return __hip_atomic_fetch_add(p, v, __ATOMIC_RELAXED, __HIP_MEMORY_SCOPE_AGENT); }
__device__ __forceinline__ unsigned xb_xcc_id() { return (unsigned)__builtin_amdgcn_s_getreg((3 << 11) | 20) & 0xFu; }
#define XB_SPIN(cond, bar) do { unsigned _sp = 0; while (cond) { __builtin_amdgcn_s_sleep(1); \
    if ((++_sp & 255u) == 0u) { if (xb_ld(&(bar)[XB_TMO])) break; if (_sp > XB_SPIN_CAP) { atomicAdd(&(bar)[XB_TMO], 1u); break; } } } } while (0)
struct XcdBarrier { unsigned* bar; unsigned x; volatile LAS unsigned* st; };
__device__ __forceinline__ XcdBarrier xcd_barrier_post(unsigned* bar, volatile LAS unsigned* st) {
  XcdBarrier b; b.bar = bar; b.x = xb_xcc_id(); b.st = st;
  if (threadIdx.x == 0) (void)xb_add(&bar[XB_XCNT(b.x)], 1u);
  return b;
}
__device__ __forceinline__ void xcd_barrier_complete(unsigned* bar, unsigned x, unsigned& nloc, unsigned& nx) {
  const unsigned G = gridDim.x * gridDim.y * gridDim.z;
  unsigned sum, cnt, mine, sp = 0u;
  for (;;) {
    sum = 0u; cnt = 0u; mine = 0u;
#pragma unroll
    for (unsigned j = 0; j < 16; ++j) { const unsigned c = xb_ld(&bar[XB_XCNT(j)]); sum += c; cnt += (c > 0u) ? 1u : 0u; mine = (j == x) ? c : mine; }
    if (sum == G) break;
    __builtin_amdgcn_s_sleep(1);
    if ((++sp & 255u) == 0u) { if (xb_ld(&bar[XB_TMO])) break; if (sp > XB_SPIN_CAP) { atomicAdd(&bar[XB_TMO], 1u); break; } }
  }
  nloc = mine > 0u ? mine : 1u; nx = cnt > 0u ? cnt : 1u;
}
__device__ __forceinline__ void xcd_barrier(const XcdBarrier& b) {
  asm volatile("s_waitcnt vmcnt(0)" ::: "memory");
  __syncthreads();
  if (threadIdx.x == 0) {
    unsigned* bar = b.bar;
    __builtin_amdgcn_s_waitcnt(0);
    unsigned nloc = b.st[0], nx = b.st[1];
    if (nloc == 0u) { xcd_barrier_complete(bar, b.x, nloc, nx); b.st[0] = nloc; b.st[1] = nx; }
    const unsigned old = xb_add(&bar[XB_XSUB(b.x)], 1u);
    const unsigned gen = old / nloc;
    if (old + 1u == (gen + 1u) * nloc) {
      __builtin_amdgcn_fence(__ATOMIC_RELEASE, "agent");
      asm volatile("s_waitcnt vmcnt(0)" ::: "memory");
      const unsigned og = xb_add(&bar[XB_TOP], 1u);
      const unsigned tg = og / nx;
      if (og + 1u == (tg + 1u) * nx) xb_add(&bar[XB_TOPGEN], 1u);
      else XB_SPIN(xb_ld(&bar[XB_TOPGEN]) == tg, bar);
      __builtin_amdgcn_fence(__ATOMIC_ACQUIRE, "agent");
      xb_add(&bar[XB_XGEN(b.x)], 1u);
      asm volatile("s_waitcnt vmcnt(0)" ::: "memory");
    } else {
      XB_SPIN(xb_ld(&bar[XB_XGEN(b.x)]) == gen, bar);
      __builtin_amdgcn_fence(__ATOMIC_ACQUIRE, "agent");
      asm volatile("s_waitcnt vmcnt(0)" ::: "memory");
    }
  }
  __syncthreads();
}

namespace pg8 {
constexpr int BM = 256, BK = 64, HALF = 128, HTB = HALF * BK * 2, STAGE_BYTES = 8 * HTB, NXCD = 8, WGM = 8;
__host__ __device__ __forceinline__ int lds_byte(int r, int c) { const int st = (r >> 4) * 2 + (c >> 5), rr = r & 15, cc = c & 31, ob = rr * 64 + cc * 2; return st * 1024 + (ob ^ (((ob >> 9) & 1) << 5)); }
__host__ __device__ __forceinline__ void stage_rc(int b, int& R, int& C) { const int st = b / 1024, sb = b % 1024, swz = sb ^ (((sb >> 9) & 1) << 5); R = (st >> 1) * 16 + swz / 64; C = (st & 1) * 32 + (swz % 64) / 2; }
__host__ __device__ __forceinline__ int perm32(int rho) { const int n = rho >> 4, i = rho & 15; return 8 * (i >> 2) + 4 * n + (i & 3); }
struct Unit { int pm, pn, ks; };
struct Gemm { const bf16_t* A; const bf16_t* Bt; int M, N, K, ld, nks; };
struct StaticOrder {
  int nM, nN, ntile, nwg, G, c;
  __device__ void init(int M, int N, int nks, int G_, int c_) { nM = M / BM; nN = N / BM; ntile = nM * nN; nwg = ntile * nks; G = G_; c = c_; }
  __device__ bool next(int i, Unit& u) const {
    const long L = (long)i * G + c; if (L >= nwg) return false;
    u.ks = (int)L / ntile; int wgid = (int)L - u.ks * ntile;
    { const int q = ntile / NXCD, r = ntile % NXCD, xcd = wgid % NXCD, off = wgid / NXCD; wgid = (xcd < r ? xcd * (q + 1) : r * (q + 1) + (xcd - r) * q) + off; }
    const int nig = WGM * nN, gid = wgid / nig, fm = gid * WGM, gsz = (nM - fm) < WGM ? (nM - fm) : WGM;
    u.pm = fm + ((wgid % nig) % gsz); u.pn = (wgid % nig) / gsz; return true;
  }
};

template <class Epi>
__device__ __forceinline__ void gemm_phase(LP lds, const Gemm g, const StaticOrder& S, const Epi& E) {
  int tid_ = threadIdx.x; asm volatile("" : "+v"(tid_));
  const int tid = tid_, wid = __builtin_amdgcn_readfirstlane(tid >> 6), lane = tid & 63, wr = wid >> 2, wc = wid & 3, fr = lane & 15, fq = lane >> 4;
  const int K = g.ld, nt = g.K / BK;
  const size_t ksb = (size_t)g.K * 2;
  unsigned voffA[2], voffB[2];
#pragma unroll
  for (int i = 0; i < 2; ++i) { int R, C; stage_rc(tid * 16 + i * 8192, R, C); const int Rb = (R & ~31) + perm32(R & 31); voffA[i] = (unsigned)(R * K + C) * 2u; voffB[i] = (unsigned)(Rb * K + C) * 2u; }
  const size_t kstep = (size_t)(BK * 2);
  const size_t hstep = (size_t)HALF * K * 2;
  const size_t tstep = 2 * hstep;
  const unsigned ldsw = (unsigned)wid * 1024u;
  const int aoff = lds_byte(wr * 64 + fr, fq * 8), boff = lds_byte(wc * 32 + fr, fq * 8);
#define PG8_SA(b, h) (((b) * 2 + (h)) * HTB)
#define PG8_SB(b, h) ((4 + (b) * 2 + (h)) * HTB)
#define PG8_STAGE(bufoff, gbase, voff) do { _Pragma("unroll") for (int _i = 0; _i < 2; ++_i) \
    __builtin_amdgcn_global_load_lds((const unsigned*)((const char*)(gbase) + (voff)[_i]), (LAS unsigned*)(lds + (bufoff) + ldsw + _i * 8192), 16, 0, 0); } while (0)
#define PG8_LDA(dst, b, h) do { _Pragma("unroll") for (int m = 0; m < 4; ++m) _Pragma("unroll") for (int k = 0; k < 2; ++k) dst[m][k] = *(const LAS bf16x8*)(lds + PG8_SA(b, h) + aoff + m * 2048 + k * 1024); } while (0)
#define PG8_LDB(dst, b, h) do { _Pragma("unroll") for (int n = 0; n < 2; ++n) _Pragma("unroll") for (int k = 0; k < 2; ++k) dst[n][k] = *(const LAS bf16x8*)(lds + PG8_SB(b, h) + boff + n * 2048 + k * 1024); } while (0)
#define PG8_MMA(ai, bj, At, Bt) do { __builtin_amdgcn_s_setprio(1); _Pragma("unroll") for (int m = 0; m < 4; ++m) _Pragma("unroll") for (int n = 0; n < 2; ++n) _Pragma("unroll") for (int k = 0; k < 2; ++k) \
    acc[ai][bj][m][n] = __builtin_amdgcn_mfma_f32_16x16x32_bf16(Bt[n][k], At[m][k], acc[ai][bj][m][n], 0, 0, 0); __builtin_amdgcn_s_setprio(0); } while (0)
#define PG8_WAIT_V(n) asm volatile("s_waitcnt vmcnt(" #n ")" ::: "memory")
#define PG8_WAIT_L(n) asm volatile("s_waitcnt lgkmcnt(" #n ")" ::: "memory")
#define PG8_BAR __builtin_amdgcn_s_barrier()
#define PG8_SCHED __builtin_amdgcn_sched_barrier(0)
  Unit cur, nxt; int ui = 0;
  if (!S.next(0, cur)) return;
  f32x4 acc[2][2][4][2];
#pragma unroll
  for (int a = 0; a < 2; ++a)
#pragma unroll
    for (int b = 0; b < 2; ++b)
#pragma unroll
      for (int m = 0; m < 4; ++m)
#pragma unroll
        for (int n = 0; n < 2; ++n) acc[a][b][m][n] = (f32x4){0.f, 0.f, 0.f, 0.f};
  bf16x8 At[4][2], B0[2][2], B1[2][2];
  const char* cA = (const char*)g.A + (size_t)cur.pm * tstep + cur.ks * ksb; const char* cB = (const char*)g.Bt + (size_t)cur.pn * tstep + cur.ks * ksb;
  PG8_STAGE(PG8_SB(0, 0), cB, voffB); PG8_STAGE(PG8_SB(0, 1), cB + hstep, voffB); PG8_STAGE(PG8_SA(0, 0), cA, voffA); PG8_STAGE(PG8_SA(0, 1), cA + hstep, voffA);
  if (wr == 1) PG8_BAR;
  PG8_WAIT_V(2); PG8_BAR;
  PG8_STAGE(PG8_SB(1, 0), cB + kstep, voffB); PG8_STAGE(PG8_SA(1, 0), cA + kstep, voffA); PG8_STAGE(PG8_SB(1, 1), cB + hstep + kstep, voffB);
  PG8_WAIT_V(6); PG8_BAR;
  for (;;) {
    const bool has_next = S.next(ui + 1, nxt);
    const char* nA = has_next ? (const char*)g.A + (size_t)nxt.pm * tstep + nxt.ks * ksb : cA; const char* nB = has_next ? (const char*)g.Bt + (size_t)nxt.pn * tstep + nxt.ks * ksb : cB;
    for (int t = 0; t < nt; t += 2) {
      const bool last = (t == nt - 2);
      const char* a1 = cA + (size_t)(t + 1) * kstep;
      const char* a2 = last ? nA : cA + (size_t)(t + 2) * kstep; const char* b2 = last ? nB : cB + (size_t)(t + 2) * kstep;
      const char* a3 = a2 + kstep; const char* b3 = b2 + kstep;
      PG8_LDB(B0, 0, 0); PG8_LDB(B1, 0, 1); PG8_SCHED; PG8_LDA(At, 0, 0); PG8_STAGE(PG8_SA(1, 1), a1 + hstep, voffA);
      PG8_WAIT_V(8); PG8_WAIT_L(0); PG8_BAR; PG8_MMA(0, 0, At, B0); PG8_MMA(0, 1, At, B1); PG8_BAR; PG8_SCHED;
      PG8_LDA(At, 0, 1); PG8_STAGE(PG8_SB(0, 0), b2, voffB); PG8_STAGE(PG8_SB(0, 1), b2 + hstep, voffB); PG8_STAGE(PG8_SA(0, 0), a2, voffA);
      PG8_WAIT_V(8); PG8_WAIT_L(0); PG8_BAR; PG8_MMA(1, 0, At, B0); PG8_MMA(1, 1, At, B1); PG8_BAR; PG8_SCHED;
      PG8_LDB(B0, 1, 0); PG8_LDB(B1, 1, 1); PG8_SCHED; PG8_LDA(At, 1, 0); PG8_STAGE(PG8_SA(0, 1), a2 + hstep, voffA);
      PG8_WAIT_V(8); PG8_WAIT_L(0); PG8_BAR; PG8_MMA(0, 0, At, B0); PG8_MMA(0, 1, At, B1); PG8_BAR; PG8_SCHED;
      PG8_LDA(At, 1, 1); PG8_STAGE(PG8_SB(1, 0), b3, voffB); PG8_STAGE(PG8_SB(1, 1), b3 + hstep, voffB); PG8_STAGE(PG8_SA(1, 0), a3, voffA);
      PG8_WAIT_V(8); PG8_WAIT_L(0); PG8_BAR; PG8_MMA(1, 0, At, B0); PG8_MMA(1, 1, At, B1); PG8_BAR; PG8_SCHED;
    }
    if (wr == 0) PG8_BAR;
    { int fr2 = fr, fq2 = fq; asm volatile("" : "+v"(fr2), "+v"(fq2)); E(acc, cur, wr, wc, fr2, fq2); }
    if (!has_next) break;
#pragma unroll
    for (int a = 0; a < 2; ++a)
#pragma unroll
      for (int b = 0; b < 2; ++b)
#pragma unroll
        for (int m = 0; m < 4; ++m)
#pragma unroll
          for (int n = 0; n < 2; ++n) acc[a][b][m][n] = (f32x4){0.f, 0.f, 0.f, 0.f};
    cur = nxt; cA = nA; cB = nB; ++ui;
    if (wr == 1) PG8_BAR;
  }
  PG8_WAIT_V(0);
  PG8_BAR;
#undef PG8_SA
#undef PG8_SB
#undef PG8_STAGE
#undef PG8_LDA
#undef PG8_LDB
#undef PG8_MMA
#undef PG8_WAIT_V
#undef PG8_WAIT_L
#undef PG8_BAR
#undef PG8_SCHED
}
}
using pg8::Unit;
typedef f32x4 AccT[2][2][4][2];

#define EPI_ROW(ai, m) (u.pm * 256 + (ai) * 128 + wr * 64 + (m) * 16 + fr)
#define EPI_COL(bj, n) (u.pn * 256 + (bj) * 128 + wc * 32 + 8 * fq + 4 * (n))
#define EPI_LOOP_ROWS _Pragma("unroll") for (int ai = 0; ai < 2; ++ai) _Pragma("unroll") for (int m = 0; m < 4; ++m)
#define EPI_LOOP_COLS _Pragma("unroll") for (int bj = 0; bj < 2; ++bj) _Pragma("unroll") for (int n = 0; n < 2; ++n)

__device__ __forceinline__ int cond_of_row(int row) { return row < NCTX ? 0 : 1 + ((row - NCTX) >> 11); }

#define EPI_LOOP_BJ _Pragma("unroll") for (int bj = 0; bj < 2; ++bj)
__device__ __forceinline__ u32x4 pack8(const f32x4 v0, const f32x4 v1) { u32x4 w; w.x = pack2(v0[0], v0[1]); w.y = pack2(v0[2], v0[3]); w.z = pack2(v1[0], v1[1]); w.w = pack2(v1[2], v1[3]); return w; }
__device__ __forceinline__ void unpack8(const u32x4 w, f32x4& v0, f32x4& v1) { v0[0] = bflo(w.x); v0[1] = bfhi(w.x); v0[2] = bflo(w.y); v0[3] = bfhi(w.y); v1[0] = bflo(w.z); v1[1] = bfhi(w.z); v1[2] = bflo(w.w); v1[3] = bfhi(w.w); }
struct EpiQKV {
  bf16_t* O; const float* bias;
  __device__ __forceinline__ void operator()(const AccT& acc, const Unit& u, int wr, int wc, int fr, int fq) const {
    const float sc = (u.pn < 4) ? 0.0625f : 1.0f;
    f32x4 bv[2][2];
    EPI_LOOP_COLS { bv[bj][n] = *(const f32x4*)(bias + EPI_COL(bj, n)); }
    EPI_LOOP_ROWS { const int row = EPI_ROW(ai, m);
      EPI_LOOP_BJ { *(u32x4*)(O + (size_t)row * 3072 + EPI_COL(bj, 0)) = pack8((acc[ai][bj][m][0] + bv[bj][0]) * sc, (acc[ai][bj][m][1] + bv[bj][1]) * sc); } }
  }
};
struct EpiUT {
  bf16_t* O; const float* bias;
  __device__ __forceinline__ void operator()(const AccT& acc, const Unit& u, int wr, int wc, int fr, int fq) const {
    EPI_LOOP_ROWS { const int row = EPI_ROW(ai, m); const float bv = bias[row];
      EPI_LOOP_BJ { *(u32x4*)(O + (size_t)row * NTOK + EPI_COL(bj, 0)) = pack8(acc[ai][bj][m][0] + bv, acc[ai][bj][m][1] + bv); } }
  }
};
struct EpiGates {
  bf16_t* H; bf16_t* G; const float* b_in;
  __device__ __forceinline__ void operator()(const AccT& acc, const Unit& u, int wr, int wc, int fr, int fq) const {
    const bool og = u.pn < 4;
    f32x4 bv[2][2];
    EPI_LOOP_COLS { const int col = EPI_COL(bj, n); bv[bj][n] = *(const f32x4*)(b_in + (og ? 3072 + col : 7184 + (col - 1024))); }
#pragma unroll
    for (int ai = 0; ai < 2; ++ai)
#pragma unroll
      for (int m2 = 0; m2 < 2; ++m2) {
        u32x4 hv[2][2];
        if (og) {
#pragma unroll
          for (int mm = 0; mm < 2; ++mm) { const int row = EPI_ROW(ai, 2 * m2 + mm); EPI_LOOP_BJ { hv[mm][bj] = *(const u32x4*)(H + (size_t)row * 1024 + EPI_COL(bj, 0)); } } }
#pragma unroll
        for (int mm = 0; mm < 2; ++mm) { const int m = 2 * m2 + mm; const int row = EPI_ROW(ai, m);
          EPI_LOOP_BJ { const int col = EPI_COL(bj, 0); f32x4 s0, s1; const f32x4 a0 = acc[ai][bj][m][0] + bv[bj][0], a1 = acc[ai][bj][m][1] + bv[bj][1];
#pragma unroll
            for (int e = 0; e < 4; ++e) { s0[e] = sigmoidf_(a0[e]); s1[e] = sigmoidf_(a1[e]); }
            if (og) { f32x4 h0, h1; unpack8(hv[mm][bj], h0, h1); *(u32x4*)(H + (size_t)row * 1024 + col) = pack8(h0 * s0, h1 * s1); }
            else *(u32x4*)(G + (size_t)row * 2048 + (col - 1024)) = pack8(s0, s1); } } }
  }
};
template <int SECOND> struct EpiMerge {
  bf16_t* T; const bf16_t* G;
  __device__ __forceinline__ void operator()(const AccT& acc, const Unit& u, int wr, int wc, int fr, int fq) const {
#pragma unroll
    for (int ai = 0; ai < 2; ++ai)
#pragma unroll
      for (int m2 = 0; m2 < 2; ++m2) {
        u32x4 gv[2][2], tv[2][2];
#pragma unroll
        for (int mm = 0; mm < 2; ++mm) { const int row = EPI_ROW(ai, 2 * m2 + mm);
          EPI_LOOP_BJ { const int col = EPI_COL(bj, 0); gv[mm][bj] = *(const u32x4*)(G + (size_t)row * 2048 + SECOND * 1024 + col);
            if (SECOND) tv[mm][bj] = *(const u32x4*)(T + (size_t)row * 1024 + col); } }
#pragma unroll
        for (int mm = 0; mm < 2; ++mm) { const int m = 2 * m2 + mm; const int row = EPI_ROW(ai, m);
          EPI_LOOP_BJ { const int col = EPI_COL(bj, 0); f32x4 g0, g1; unpack8(gv[mm][bj], g0, g1);
            f32x4 v0 = g0 * acc[ai][bj][m][0], v1 = g1 * acc[ai][bj][m][1];
            if (SECOND) { f32x4 t0, t1; unpack8(tv[mm][bj], t0, t1); v0 += t0; v1 += t1; }
            *(u32x4*)(T + (size_t)row * 1024 + col) = pack8(v0, v1); } } }
  }
};
struct EpiOut {
  const float* xp; const float* xs; const float* per; const float* pec; const float* mod; const float* n2w; float* X1; bf16_t* A2; float* ssq;
  __device__ __forceinline__ void operator()(const AccT& acc, const Unit& u, int wr, int wc, int fr, int fq) const {
    const int cb = cond_of_row(u.pm * 256); const float* md = mod + cb * 6144; const bool smp = (u.pm * 256) >= NCTX;
    f32x4 g1v[2][2], k2v[2][2];
    EPI_LOOP_COLS { const int col = EPI_COL(bj, n); g1v[bj][n] = *(const f32x4*)(md + 2048 + col); k2v[bj][n] = *(const f32x4*)(n2w + col) * (*(const f32x4*)(md + 4096 + col) + 1.0f); }
    EPI_LOOP_ROWS { const int row = EPI_ROW(ai, m); float ss = 0.f;
#pragma unroll
      for (int bj = 0; bj < 2; ++bj) {
        f32x4 x0[2];
        if (!smp) {
#pragma unroll
          for (int n = 0; n < 2; ++n) x0[n] = *(const f32x4*)(xp + (size_t)row * 1024 + EPI_COL(bj, n)); }
        else { const int r2 = row - NCTX, t = r2 & 2047; f32x4 pe[2];
#pragma unroll
          for (int n = 0; n < 2; ++n) { const int col = EPI_COL(bj, n); x0[n] = *(const f32x4*)(xs + (size_t)r2 * 1024 + col);
            pe[n] = (col < 512) ? *(const f32x4*)(per + (t >> 6) * 512 + col) : *(const f32x4*)(pec + (t & 63) * 512 + (col - 512)); }
#pragma unroll
          for (int n = 0; n < 2; ++n) x0[n] += pe[n]; }
        f32x4 x1[2];
#pragma unroll
        for (int n = 0; n < 2; ++n) { x1[n] = x0[n] + g1v[bj][n] * acc[ai][bj][m][n]; *(f32x4*)(X1 + (size_t)row * 1024 + EPI_COL(bj, n)) = x1[n];
          ss += x1[n][0] * x1[n][0] + x1[n][1] * x1[n][1] + x1[n][2] * x1[n][2] + x1[n][3] * x1[n][3]; }
        *(u32x4*)(A2 + (size_t)row * 1024 + EPI_COL(bj, 0)) = pack8(x1[0] * k2v[bj][0], x1[1] * k2v[bj][1]); }
      ss += __shfl_xor(ss, 16); ss += __shfl_xor(ss, 32);
      if (fq == 0) ssq[(size_t)row * 16 + u.pn * 4 + wc] = ss; }
  }
};
struct EpiFF1 {
  int row0; const float* ssq; const float* c1; bf16_t* Hd;
  __device__ __forceinline__ void operator()(const AccT& acc, const Unit& u, int wr, int wc, int fr, int fq) const {
    const int cb = cond_of_row(row0 + u.pm * 256); const float* cc = c1 + cb * 4096;
    f32x4 cv[2][2];
    EPI_LOOP_COLS { cv[bj][n] = *(const f32x4*)(cc + EPI_COL(bj, n)); }
    float rs[2][4];
    EPI_LOOP_ROWS { const float* sp = ssq + (size_t)(row0 + EPI_ROW(ai, m)) * 16;
      const f32x4 st = (*(const f32x4*)sp + *(const f32x4*)(sp + 4)) + (*(const f32x4*)(sp + 8) + *(const f32x4*)(sp + 12));
      rs[ai][m] = rsqrtf((st[0] + st[1] + st[2] + st[3]) * (1.0f / 1024.0f) + 1e-6f); }
    EPI_LOOP_ROWS { const int rl = EPI_ROW(ai, m); const float rstd = rs[ai][m];
      EPI_LOOP_BJ { f32x4 v0 = acc[ai][bj][m][0] * rstd + cv[bj][0], v1 = acc[ai][bj][m][1] * rstd + cv[bj][1];
#pragma unroll
        for (int e = 0; e < 4; ++e) { const float r0 = fmaxf(v0[e], 0.f), r1 = fmaxf(v1[e], 0.f); v0[e] = r0 * r0; v1[e] = r1 * r1; }
        *(u32x4*)(Hd + (size_t)rl * 4096 + EPI_COL(bj, 0)) = pack8(v0, v1); } }
  }
};
struct EpiFF2 {
  int row0; const float* mod; const float* b2; float* X; float* P;
  __device__ __forceinline__ void operator()(const AccT& acc, const Unit& u, int wr, int wc, int fr, int fq) const {
    if (u.ks == 1) {
      EPI_LOOP_ROWS { const int rl = EPI_ROW(ai, m); EPI_LOOP_COLS { *(f32x4*)(P + (size_t)rl * 1024 + EPI_COL(bj, n)) = acc[ai][bj][m][n]; } }
    } else {
    const int cb = cond_of_row(row0 + u.pm * 256); const float* md = mod + cb * 6144;
    f32x4 g2v[2][2], bbv[2][2];
    EPI_LOOP_COLS { const int col = EPI_COL(bj, n); g2v[bj][n] = *(const f32x4*)(md + 5120 + col); bbv[bj][n] = *(const f32x4*)(b2 + col); }
#pragma unroll
    for (int ai = 0; ai < 2; ++ai)
#pragma unroll
      for (int m2 = 0; m2 < 2; ++m2) {
        f32x4 xv[2][2][2];
#pragma unroll
        for (int mm = 0; mm < 2; ++mm) { const int row = row0 + EPI_ROW(ai, 2 * m2 + mm); EPI_LOOP_COLS { xv[mm][bj][n] = *(const f32x4*)(X + (size_t)row * 1024 + EPI_COL(bj, n)); } }
#pragma unroll
        for (int mm = 0; mm < 2; ++mm) { const int m = 2 * m2 + mm; const int row = row0 + EPI_ROW(ai, m);
          EPI_LOOP_COLS { const int col = EPI_COL(bj, n); *(f32x4*)(X + (size_t)row * 1024 + col) = xv[mm][bj][n] + g2v[bj][n] * (acc[ai][bj][m][n] + bbv[bj][n]); } } }
    }
  }
};

template <class Epi> __device__ __forceinline__ void run_gemm(LP lds, const bf16_t* A, const bf16_t* Bt, int M, int N, int K, const Epi& E, int nks = 1) {
  pg8::Gemm g; g.A = A; g.Bt = Bt; g.M = M; g.N = N; g.K = K / nks; g.ld = K; g.nks = nks;
  pg8::StaticOrder S; S.init(M, N, nks, (int)gridDim.x, (int)blockIdx.x);
  pg8::gemm_phase<Epi>(lds, g, S, E);
}

__device__ void transpose_tile(const float* __restrict__ src, int ld, int col0, int k0, bf16_t* __restrict__ dst, int K, int drow0, LAS float* tile) {
  const int t = opaque_tid();
  f32x4 v[4];
#pragma unroll
  for (int i = 0; i < 4; ++i) { const int idx = t + 512 * i, kr = idx >> 5, c4 = idx & 31; v[i] = *(const f32x4*)(src + (size_t)(k0 + kr) * ld + col0 + 4 * c4); }
#pragma unroll
  for (int i = 0; i < 4; ++i) { const int idx = t + 512 * i, kr = idx >> 5, c4 = idx & 31; LAS float* tp = tile + kr * 129 + 4 * c4; tp[0] = v[i][0]; tp[1] = v[i][1]; tp[2] = v[i][2]; tp[3] = v[i][3]; }
  __syncthreads();
  const int kb = t & 7;
#pragma unroll
  for (int i = 0; i < 2; ++i) { const int c = (t >> 3) + 64 * i; const LAS float* tp = tile + (kb * 8) * 129 + c; u32x4 o;
    o.x = pack2(tp[0], tp[129]); o.y = pack2(tp[2 * 129], tp[3 * 129]); o.z = pack2(tp[4 * 129], tp[5 * 129]); o.w = pack2(tp[6 * 129], tp[7 * 129]);
    *(u32x4*)(dst + (size_t)(drow0 + c) * K + k0 + kb * 8) = o; }
  __syncthreads();
}
template <int SILU> __device__ void matvec9_unit(const float* v0, const float* v1, int v1stride, const float* __restrict__ W, int ldw, const float* bias, float* out, int ldo, int col0, LAS float* lf) {
  const int t = opaque_tid(), lane = t & 63, wid = t >> 6;
  LAS float* sv = lf; LAS float* red = lf + 9216;
  for (int i = t; i < 9216; i += 512) { const int b = i >> 10, k = i & 1023; float x = (b == 0) ? v0[k] : v1[(size_t)(b - 1) * v1stride + k]; if (SILU) x = x / (1.0f + __expf(-x)); sv[i] = x; }
  __syncthreads();
  const int c4 = t & 7, kl = t >> 3;
  f32x4 w[16];
#pragma unroll
  for (int i = 0; i < 16; ++i) w[i] = *(const f32x4*)(W + (size_t)(kl + 64 * i) * ldw + col0 + 4 * c4);
  f32x4 acc[9];
#pragma unroll
  for (int b = 0; b < 9; ++b) acc[b] = (f32x4){0.f, 0.f, 0.f, 0.f};
#pragma unroll
  for (int i = 0; i < 16; ++i)
#pragma unroll
    for (int b = 0; b < 9; ++b) acc[b] += w[i] * sv[b * 1024 + kl + 64 * i];
#pragma unroll
  for (int b = 0; b < 9; ++b)
#pragma unroll
    for (int e = 0; e < 4; ++e) { float x = acc[b][e]; x += __shfl_xor(x, 8); x += __shfl_xor(x, 16); x += __shfl_xor(x, 32); acc[b][e] = x; }
  if (lane < 8) {
#pragma unroll
    for (int b = 0; b < 9; ++b) *(LAS f32x4*)(red + (wid * 9 + b) * 32 + 4 * lane) = acc[b]; }
  __syncthreads();
  if (t < 288) { const int b = t >> 5, cc = t & 31; float s = bias[col0 + cc];
#pragma unroll
    for (int pz = 0; pz < 8; ++pz) s += red[(pz * 9 + b) * 32 + cc];
    out[(size_t)b * ldo + col0 + cc] = s; }
  __syncthreads();
}

__device__ void phase0(const Params& p, LP lds) {
  unsigned char* ws = p.ws; LAS float* lf = (LAS float*)lds;
  const int tid0 = opaque_tid(); const int wid = tid0 >> 6, lane = tid0 & 63;
  for (int unit = blockIdx.x; unit < 576; unit += gridDim.x) {
    if (unit < 192) {
      matvec9_unit<1>(p.in[6], p.in[5], 1024, p.in[7], 6144, p.in[8], (float*)(ws + OFF_MOD), 6144, unit * 32, lf);
    } else if (unit < 480) {
      const int row = (unit - 192) * 8 + wid; const bool smp = row < 2048; const int L = smp ? 2048 : 256, t = smp ? row : row - 2048;
      const float* w1 = p.in[14]; const float* b1 = p.in[15]; const float* fr1 = p.in[16]; const float* w2 = p.in[17]; const float* b2 = p.in[18]; const float* fr2 = p.in[19];
      float a = b1[lane] + (float)t / (float)(L - 1) * w1[lane];
      const float base = (6.283185307179586f / (float)L) * (float)t;
      float cs = 0.f, sn = 0.f; if (lane < 16) { const float ang = base * (float)(lane + 1); cs = cosf(ang); sn = sinf(ang); }
#pragma unroll
      for (int i = 0; i < 16; ++i) a += __shfl(cs, i) * w1[(1 + i) * 64 + lane] + __shfl(sn, i) * w1[(17 + i) * 64 + lane];
      const float h1 = sinf(fr1[lane] * a);
      float a2 = b2[lane];
#pragma unroll 16
      for (int j = 0; j < 64; ++j) a2 += __shfl(h1, j) * w2[j * 64 + lane];
      const float h2 = sinf(fr2[lane] * a2);
      float* dst = (float*)(ws + (smp ? OFF_H2S : OFF_H2C)); dst[(size_t)t * 64 + lane] = h2;
    } else {
      const int r = unit - 480, c = tid0; const int pos = r < 32 ? r : r - 32; const int i = c & 255;
      const float omega = 1.0f / powf(10000.0f, (float)i / 256.0f); const float a = (float)pos * omega; const float v = c < 256 ? sinf(a) : cosf(a);
      float* dst = (float*)(ws + (r < 32 ? OFF_PER : OFF_PEC)); dst[(size_t)pos * 512 + c] = v;
    }
  }
}
__device__ void weight_tiles(const Params& p, LP lds, int lo, int hi, int upper) {
  unsigned char* ws = p.ws; LAS float* lf = (LAS float*)lds;
  const int nh = upper ? ((int)gridDim.x >> 1) : 0;
  if ((int)blockIdx.x < nh) return;
  for (int tu = lo + (int)blockIdx.x - nh; tu < hi; tu += (int)gridDim.x - nh) {
    const float* src; int ld, K, col0, k0, drow0; bf16_t* dst;
    if (tu < 1152) { const int nt = tu >> 4, kt = tu & 15; const int r = nt * 128; src = p.in[10]; ld = INC; K = 1024; k0 = kt * 64; drow0 = r; dst = (bf16_t*)(ws + OFF_WT);
      col0 = r < 3072 ? r : (r < 6144 ? 4112 + (r - 3072) : (r < 7168 ? 3072 + (r - 6144) : 7184 + (r - 7168))); }
    else if (tu < 1536) { const int v = tu - 1152, w = v >> 7, q = v & 127; src = p.in[23 + w]; ld = 1024; K = 1024; k0 = (q & 15) * 64; col0 = (q >> 4) * 128; drow0 = col0; dst = (bf16_t*)(ws + (w == 0 ? OFF_WBM : (w == 1 ? OFF_WBH : OFF_WOUT))); }
    else if (tu < 2048) { const int q = tu - 1536; src = p.in[27]; ld = 4096; K = 1024; k0 = (q & 15) * 64; col0 = (q >> 4) * 128; drow0 = col0; dst = (bf16_t*)(ws + OFF_W1T); }
    else { const int q = tu - 2048; src = p.in[29]; ld = 1024; K = 4096; k0 = (q & 63) * 64; col0 = (q >> 6) * 128; drow0 = col0; dst = (bf16_t*)(ws + OFF_W2T); }
    transpose_tile(src, ld, col0, k0, dst, K, drow0, lf);
  }
}

__device__ void phase1(const Params& p, LP lds) {
  unsigned char* ws = p.ws;
  int tid_ = threadIdx.x; asm volatile("" : "+v"(tid_));
  const int tid = tid_, wid = tid >> 6, lane = tid & 63;
  const float* mod = (const float*)(ws + OFF_MOD);
  LAS float* wg = (LAS float*)lds;
  if ((int)blockIdx.x < 1536) {
    f32x4 gw[8];
#pragma unroll
    for (int i = 0; i < 8; ++i) { const int idx = tid + 512 * i, k = idx >> 2, q = idx & 3; gw[i] = *(const f32x4*)(p.in[10] + (size_t)k * INC + 4096 + 4 * q); }
#pragma unroll
    for (int i = 0; i < 8; ++i) { const int idx = tid + 512 * i, k = idx >> 2, q = idx & 3; wg[(4 * q) * 1024 + k] = gw[i][0]; wg[(4 * q + 1) * 1024 + k] = gw[i][1]; wg[(4 * q + 2) * 1024 + k] = gw[i][2]; wg[(4 * q + 3) * 1024 + k] = gw[i][3]; }
    __syncthreads();
  }
  for (int unit = blockIdx.x; unit < 1536; unit += gridDim.x) {
    const int tidn = opaque_tid(); const int wid = tidn >> 6, lane = tidn & 63;
    const int row0 = unit * 16 + wid * 2; const int cb = cond_of_row(row0); const float* md = mod + cb * 6144; const bool smp = row0 >= NCTX;
    f32x4 v[2][4]; float rstd[2];
#pragma unroll
    for (int r = 0; r < 2; ++r) { const int row = row0 + r; const float* xr; int t = 0;
      if (!smp) xr = p.in[0] + (size_t)row * 1024; else { xr = p.in[1] + (size_t)(row - NCTX) * 1024; t = (row - NCTX) & 2047; }
      const float* per = (const float*)(ws + OFF_PER) + (t >> 6) * 512; const float* pec = (const float*)(ws + OFF_PEC) + (t & 63) * 512;
      float ss = 0.f;
#pragma unroll
      for (int i = 0; i < 4; ++i) { const int col = 4 * lane + 256 * i; v[r][i] = *(const f32x4*)(xr + col);
        if (smp) v[r][i] += (col < 512) ? *(const f32x4*)(per + col) : *(const f32x4*)(pec + col - 512);
        ss += v[r][i][0] * v[r][i][0] + v[r][i][1] * v[r][i][1] + v[r][i][2] * v[r][i][2] + v[r][i][3] * v[r][i][3]; }
      ss = wave_sum(ss); rstd[r] = rsqrtf(ss * (1.0f / 1024.0f) + 1e-6f); }
    const float* n1w = p.in[9];
    float ga[32];
#pragma unroll
    for (int g = 0; g < 32; ++g) ga[g] = 0.f;
#pragma unroll
    for (int i = 0; i < 4; ++i) { const int col = 4 * lane + 256 * i;
      const f32x4 w = *(const f32x4*)(n1w + col), sc = *(const f32x4*)(md + 1024 + col), sh = *(const f32x4*)(md + col);
      const f32x4 ws1 = w * (sc + 1.0f);
      f32x4 h[2];
#pragma unroll
      for (int r = 0; r < 2; ++r) { h[r] = v[r][i] * rstd[r] * ws1 + sh;
        u32x2 o; o.x = pack2(h[r][0], h[r][1]); o.y = pack2(h[r][2], h[r][3]); *(u32x2*)((bf16_t*)(ws + OFF_HN) + (size_t)(row0 + r) * 1024 + col) = o; }
#pragma unroll
      for (int g = 0; g < 16; ++g) { const f32x4 wv = *(const LAS f32x4*)(wg + g * 1024 + col);
#pragma unroll
        for (int r = 0; r < 2; ++r) ga[r * 16 + g] += h[r][0] * wv[0] + h[r][1] * wv[1] + h[r][2] * wv[2] + h[r][3] * wv[3]; }
      asm volatile("" ::: "memory"); }
#pragma unroll
    for (int off = 16; off >= 1; off >>= 1) { const bool hi = (lane & off) != 0;
#pragma unroll
      for (int i = 0; i < off; ++i) { const float send = hi ? ga[i] : ga[i + off]; const float keep = hi ? ga[i + off] : ga[i]; ga[i] = keep + __shfl_xor(send, off); } }
    const float tot = ga[0] + __shfl_xor(ga[0], 32);
    if (lane < 32) ((float*)(ws + OFF_GT))[(size_t)row0 * 16 + lane] = tot + p.in[11][4096 + (lane & 15)];
  }
  __syncthreads();
}
__device__ void filters_upper_half(const Params& p, LP lds) {
  unsigned char* ws = p.ws; const int nh = (int)gridDim.x >> 1;
  if ((int)blockIdx.x < nh) return;
  LAS float* w3s = (LAS float*)lds;
  for (int v = (int)blockIdx.x - nh; v < 320; v += (int)gridDim.x - nh) {
    const int tid = opaque_tid();
    const bool smp = v < 256; const int L = smp ? 2048 : 256; const int tt = smp ? (v >> 6) : 0, cgp = v & 63; const int t = tt * 512 + tid;
    { const f32x4 x = *(const f32x4*)(p.in[20] + (size_t)(tid >> 3) * 2048 + cgp * 32 + 4 * (tid & 7)); LAS float* wp = w3s + (4 * (tid & 7)) * 64 + (tid >> 3);
      wp[0] = x[0]; wp[64] = x[1]; wp[128] = x[2]; wp[192] = x[3]; }
    __syncthreads();
    if (t < L) {
      const float* H2 = (const float*)(ws + (smp ? OFF_H2S : OFF_H2C)) + (size_t)t * 64;
      f32x4 h2[16];
#pragma unroll
      for (int i = 0; i < 16; ++i) h2[i] = *(const f32x4*)(H2 + 4 * i);
      const float dist = fabsf((float)t - (float)(L / 2)) / (float)(L / 2);
      float* HF = (float*)(ws + (smp ? OFF_HFS : OFF_HFC)) + (size_t)(cgp * 32) * L + t;
#pragma unroll 1
      for (int j = 0; j < 32; ++j) {
        f32x4 a = {0.f, 0.f, 0.f, 0.f};
#pragma unroll
        for (int i = 0; i < 16; ++i) a += *(const LAS f32x4*)(w3s + j * 64 + 4 * i) * h2[i];
        const int c = (cgp * 32 + j) & 1023;
        const float dmin = -3.0701134573253946f, dmax = -15.350567286626973f;
        const float delta = fabsf(dmin + (dmax - dmin) * ((float)c / 1023.0f));
        HF[(size_t)j * L] = ((a[0] + a[1]) + (a[2] + a[3])) * __expf(-dist * delta); }
    }
    __syncthreads();
  }
}
__device__ void c1_upper_half(const Params& p, LP lds) {
  unsigned char* ws = p.ws; const float* mod = (const float*)(ws + OFF_MOD); const int nh = (int)gridDim.x >> 1;
  if ((int)blockIdx.x < nh) return;
  for (int u = (int)blockIdx.x - nh; u < 128; u += (int)gridDim.x - nh)
    matvec9_unit<0>(mod + 3072, mod + 6144 + 3072, 6144, p.in[27], 4096, p.in[28], (float*)(ws + OFF_C1), 4096, u * 32, (LAS float*)lds);
}

__device__ __forceinline__ bf16x8 tr_frag(LP base, int k0, int m0, int pitch  , int l15, int g) {
  const int q = l15 >> 2, pp = l15 & 3;
  LP a = base + ((k0 + 8 * g + q) * pitch + m0 + 4 * pp) * 2;
  const s16x4 lo = __builtin_amdgcn_ds_read_tr16_b64_v4i16((LAS s16x4*)a);
  const s16x4 hi = __builtin_amdgcn_ds_read_tr16_b64_v4i16((LAS s16x4*)(a + 8 * pitch));
  bf16x8 r; r[0] = lo[0]; r[1] = lo[1]; r[2] = lo[2]; r[3] = lo[3]; r[4] = hi[0]; r[5] = hi[1]; r[6] = hi[2]; r[7] = hi[3]; return r;
}
__device__ __forceinline__ bf16x8 tr_at(LP lanebase, int coff  , int pitch_bytes) {
  const s16x4 lo = __builtin_amdgcn_ds_read_tr16_b64_v4i16((LAS s16x4*)(lanebase + coff));
  const s16x4 hi = __builtin_amdgcn_ds_read_tr16_b64_v4i16((LAS s16x4*)(lanebase + coff + 4 * pitch_bytes));
  bf16x8 r; r[0] = lo[0]; r[1] = lo[1]; r[2] = lo[2]; r[3] = lo[3]; r[4] = hi[0]; r[5] = hi[1]; r[6] = hi[2]; r[7] = hi[3]; return r;
}
constexpr int ML_K = 0, ML_V = 67584, ML_P = 86016, ML_C = 120832, ML_T = 157696, ML_TSZ = 1600;
constexpr int KP = 264, VP = 72, PP = 136, CP = 72;

__device__ void mlstm_item(const Params& p, LP lds, int item) {
  const int tid = opaque_tid(), wid = __builtin_amdgcn_readfirstlane(tid >> 6), lane = tid & 63, l15 = lane & 15, g = lane >> 4;
  const bool smp = item < 256; const int uu = smp ? (item >> 2) : ((item - 256) >> 2); const int sl = item & 3;
  const int b = uu >> 3, dir = (uu >> 2) & 1, head = uu & 3;
  const int S = smp ? SEQS : SEQC, nc = S >> 7; const int tok0 = smp ? NCTX + b * SEQS : b * SEQC;
  const bf16_t* qkv = (const bf16_t*)(p.ws + OFF_BIG);
  const float* GT = (const float*)(p.ws + OFF_GT);
  bf16_t* hout = (bf16_t*)((unsigned char*)p.out + (dir ? OUT_HB : OUT_H));
  const int sidx = (b * 2 + dir) * 4 + head;
  const int gi_col = dir * 8 + head, gf_col = dir * 8 + 4 + head;
  f32x4 Cacc[2][4], nacc[2]; float mst0;
  if (smp) {
    const float* C0 = p.in[2] + (size_t)sidx * 65536;
#pragma unroll
    for (int dt = 0; dt < 2; ++dt) {
#pragma unroll
      for (int vt = 0; vt < 4; ++vt) Cacc[dt][vt] = *(const f32x4*)(C0 + (size_t)((2 * wid + dt) * 16 + l15) * 256 + sl * 64 + 16 * vt + 4 * g);
      nacc[dt] = (f32x4){p.in[3][sidx * 256 + (2 * wid + dt) * 16 + l15], 0.f, 0.f, 0.f}; }
    mst0 = p.in[4][sidx];
  } else {
#pragma unroll
    for (int dt = 0; dt < 2; ++dt) {
#pragma unroll
      for (int vt = 0; vt < 4; ++vt) Cacc[dt][vt] = (f32x4){0.f, 0.f, 0.f, 0.f};
      nacc[dt] = (f32x4){0.f, 0.f, 0.f, 0.f}; }
    mst0 = 0.f;
  }
#define TOKC(cc, j) (dir ? (tok0 + S - 1 - ((cc) * 128 + (j))) : (tok0 + (cc) * 128 + (j)))
  const int rt = (wid < 4) ? wid : 11 - wid;
  const int jrow = 16 * rt + l15;
  bf16x8 qf[8]; u32x4 kreg[8], vreg[2]; float g4[4] = {0.f, 0.f, 0.f, 0.f};
#define ML_LOAD_Q(cc) do { const bf16_t* qp = qkv + (size_t)TOKC(cc, jrow) * 3072 + head * 256 + 8 * g; \
    _Pragma("unroll") for (int kk = 0; kk < 8; ++kk) qf[kk] = *(const bf16x8*)(qp + 32 * kk); } while (0)
#define ML_LOAD_KV(cc) do { \
    _Pragma("unroll") for (int i = 0; i < 8; ++i) { const int row = (tid >> 5) + 16 * i; kreg[i] = *(const u32x4*)(qkv + (size_t)TOKC(cc, row) * 3072 + 1024 + head * 256 + (tid & 31) * 8); } \
    _Pragma("unroll") for (int i = 0; i < 2; ++i) { const int row = (tid >> 3) + 64 * i; vreg[i] = *(const u32x4*)(qkv + (size_t)TOKC(cc, row) * 3072 + 2048 + head * 256 + sl * 64 + (tid & 7) * 8); } \
    if (wid == 0) { const float* g0 = GT + (size_t)TOKC(cc, 2 * lane) * 16; const float* g1 = GT + (size_t)TOKC(cc, 2 * lane + 1) * 16; g4[0] = g0[gi_col]; g4[1] = g0[gf_col]; g4[2] = g1[gi_col]; g4[3] = g1[gf_col]; } } while (0)
#define ML_SCAN(tabp, mcur, mnext) do { LAS float* T_ = (LAS float*)(tabp); \
    const float lf0 = fminf(g4[1], 0.f) - log1pf(__expf(-fabsf(g4[1]))), lf1 = fminf(g4[3], 0.f) - log1pf(__expf(-fabsf(g4[3]))); \
    float s_ = lf0 + lf1; \
    _Pragma("unroll") for (int o = 1; o < 64; o <<= 1) { const float t_ = __shfl_up(s_, o); if (lane >= o) s_ += t_; } \
    const float b1_ = s_, b0_ = s_ - lf1; const float u0_ = g4[0] - b0_, u1_ = g4[2] - b1_; \
    float mx_ = fmaxf(u0_, u1_); \
    _Pragma("unroll") for (int o = 1; o < 64; o <<= 1) { const float t_ = __shfl_up(mx_, o); if (lane >= o) mx_ = fmaxf(mx_, t_); } \
    float ex_ = __shfl_up(mx_, 1); if (lane == 0) ex_ = -INFINITY; \
    const float M0_ = fmaxf(mcur, fmaxf(ex_, u0_)), M1_ = fmaxf(mcur, mx_); \
    T_[2 * lane] = u0_; T_[2 * lane + 1] = u1_; T_[128 + 2 * lane] = M0_; T_[128 + 2 * lane + 1] = M1_; T_[256 + 2 * lane] = b0_; T_[256 + 2 * lane + 1] = b1_; \
    const float Ml_ = __shfl(M1_, 63), bl_ = __shfl(b1_, 63); \
    if (lane == 0) { T_[384] = mcur; T_[385] = Ml_; } \
    mnext = bl_ + Ml_; } while (0)
  float mw0 = mst0;
  ML_LOAD_Q(0); ML_LOAD_KV(0);
  if (wid == 0) { float mn; ML_SCAN(lds + ML_T, mw0, mn); mw0 = mn; }
  __syncthreads();
  float m_final = 0.f;
  for (int c = 0; c < nc; ++c) {
    LAS float* T = (LAS float*)(lds + ML_T + (c & 1) * ML_TSZ);
    const float mst = T[384], M_last = T[385];
#pragma unroll
    for (int i = 0; i < 8; ++i) { const int row = (tid >> 5) + 16 * i; *(LAS u32x4*)(lds + ML_K + (row * KP + (tid & 31) * 8) * 2) = kreg[i]; }
#pragma unroll
    for (int i = 0; i < 2; ++i) { const int row = (tid >> 3) + 64 * i; const float w = __expf(T[row] - M_last); const u32x4 v = vreg[i]; u32x4 o;
      o.x = pack2(bflo(v.x) * w, bfhi(v.x) * w); o.y = pack2(bflo(v.y) * w, bfhi(v.y) * w); o.z = pack2(bflo(v.z) * w, bfhi(v.z) * w); o.w = pack2(bflo(v.w) * w, bfhi(v.w) * w);
      *(LAS u32x4*)(lds + ML_V + (row * VP + (tid & 7) * 8) * 2) = o; }
    if (tid < 128) *(LAS unsigned short*)(lds + ML_V + (tid * VP + 64) * 2) = f2bf(__expf(T[tid] - M_last));
#pragma unroll
    for (int dt = 0; dt < 2; ++dt) {
#pragma unroll
      for (int vt = 0; vt < 4; ++vt) { u32x2 w; w.x = pack2(Cacc[dt][vt][0], Cacc[dt][vt][1]); w.y = pack2(Cacc[dt][vt][2], Cacc[dt][vt][3]);
        *(LAS u32x2*)(lds + ML_C + (((2 * wid + dt) * 16 + l15) * CP + 16 * vt + 4 * g) * 2) = w; }
      if (g == 0) *(LAS unsigned short*)(lds + ML_C + (((2 * wid + dt) * 16 + l15) * CP + 64) * 2) = f2bf(nacc[dt][0]); }
    const int qtok = TOKC(c, jrow);
    const bool more = (c + 1 < nc);
    __syncthreads();
    const float Mj = T[128 + jrow], bj = T[256 + jrow]; const float rf = __expf(M_last - Mj), w_inter = __expf(mst - Mj);
    int lq_ = (8 * g + (l15 >> 2)), lp_ = 4 * (l15 & 3); asm volatile("" : "+v"(lq_), "+v"(lp_));
    const LP cB = lds + ML_C + (lq_ * CP + lp_) * 2, vB = lds + ML_V + (lq_ * VP + lp_) * 2, kB = lds + ML_K + (lq_ * KP + lp_ + 32 * wid) * 2;
    const LP pB = lds + ML_P + (jrow * PP + 8 * g) * 2;
    for (int st = 0; st <= rt; ++st) {
      f32x4 s = {0.f, 0.f, 0.f, 0.f};
      bf16x8 kfr[8];
#pragma unroll
      for (int kk = 0; kk < 8; ++kk) kfr[kk] = *(const LAS bf16x8*)(lds + ML_K + ((16 * st + l15) * KP + 32 * kk + 8 * g) * 2);
      __builtin_amdgcn_sched_barrier(0);
#pragma unroll
      for (int kk = 0; kk < 8; ++kk) s = __builtin_amdgcn_mfma_f32_16x16x32_bf16(kfr[kk], qf[kk], s, 0, 0, 0);
      float pv[4];
#pragma unroll
      for (int i = 0; i < 4; ++i) pv[i] = ((16 * st + 4 * g + i) <= jrow) ? s[i] * rf : 0.f;
      u32x2 w; w.x = pack2(pv[0], pv[1]); w.y = pack2(pv[2], pv[3]);
      *(LAS u32x2*)(lds + ML_P + (jrow * PP + 16 * st + 4 * g) * 2) = w;
    }
    if ((rt & 1) == 0) { u32x2 z; z.x = 0u; z.y = 0u; *(LAS u32x2*)(lds + ML_P + (jrow * PP + 16 * (rt + 1) + 4 * g) * 2) = z; }
    if (more) ML_LOAD_KV(c + 1);
    asm volatile("s_waitcnt lgkmcnt(0)" ::: "memory");
    f32x4 ha[5];
#pragma unroll
    for (int vt = 0; vt < 5; ++vt) { f32x4 a = {0.f, 0.f, 0.f, 0.f};
      if (smp || c > 0) {
        bf16x8 cfr[8];
#pragma unroll
        for (int kk = 0; kk < 8; ++kk) cfr[kk] = tr_at(cB, (32 * kk * CP + 16 * vt) * 2, CP * 2);
        __builtin_amdgcn_sched_barrier(0);
#pragma unroll
        for (int kk = 0; kk < 8; ++kk) a = __builtin_amdgcn_mfma_f32_16x16x32_bf16(cfr[kk], qf[kk], a, 0, 0, 0);
        a *= w_inter; }
      ha[vt] = a; }
    for (int k2 = 0; k2 <= (rt >> 1); ++k2) {
      const bf16x8 pf = *(const LAS bf16x8*)(pB + k2 * 64);
      bf16x8 vfr[5];
#pragma unroll
      for (int vt = 0; vt < 5; ++vt) vfr[vt] = tr_at(vB + k2 * (32 * VP * 2), (16 * vt) * 2, VP * 2);
      __builtin_amdgcn_sched_barrier(0);
#pragma unroll
      for (int vt = 0; vt < 5; ++vt) ha[vt] = __builtin_amdgcn_mfma_f32_16x16x32_bf16(vfr[vt], pf, ha[vt], 0, 0, 0); }
    { const float den = __shfl(ha[4][0], l15); const float rdd = 1.0f / fmaxf(fabsf(den), __expf(-(bj + Mj)));
#pragma unroll
      for (int vt = 0; vt < 4; ++vt) { const f32x4 a = ha[vt] * rdd; u32x2 w; w.x = pack2(a[0], a[1]); w.y = pack2(a[2], a[3]);
        *(u32x2*)(hout + (size_t)qtok * 1024 + head * 256 + sl * 64 + 16 * vt + 4 * g) = w; } }
    if (more) ML_LOAD_Q(c + 1);
    const bool need_state = (!smp) || more;
    if (need_state) {
      const float decay = __expf(mst - M_last);
#pragma unroll
      for (int dt = 0; dt < 2; ++dt) {
#pragma unroll
        for (int vt = 0; vt < 4; ++vt) Cacc[dt][vt] *= decay;
        nacc[dt] *= decay; }
#pragma unroll
      for (int ks = 0; ks < 4; ++ks) {
        const bf16x8 kf0 = tr_at(kB, (32 * ks * KP) * 2, KP * 2), kf1 = tr_at(kB, (32 * ks * KP + 16) * 2, KP * 2);
        bf16x8 vfr[5];
#pragma unroll
        for (int vt = 0; vt < 5; ++vt) vfr[vt] = tr_at(vB, (32 * ks * VP + 16 * vt) * 2, VP * 2);
        __builtin_amdgcn_sched_barrier(0);
#pragma unroll
        for (int vt = 0; vt < 4; ++vt) { Cacc[0][vt] = __builtin_amdgcn_mfma_f32_16x16x32_bf16(vfr[vt], kf0, Cacc[0][vt], 0, 0, 0); Cacc[1][vt] = __builtin_amdgcn_mfma_f32_16x16x32_bf16(vfr[vt], kf1, Cacc[1][vt], 0, 0, 0); }
        nacc[0] = __builtin_amdgcn_mfma_f32_16x16x32_bf16(vfr[4], kf0, nacc[0], 0, 0, 0); nacc[1] = __builtin_amdgcn_mfma_f32_16x16x32_bf16(vfr[4], kf1, nacc[1], 0, 0, 0);
      }
    }
    if (wid == 0 && more) { float mn; ML_SCAN(lds + ML_T + ((c + 1) & 1) * ML_TSZ, mw0, mn); mw0 = mn; }
    m_final = T[256 + 127] + M_last;
    __syncthreads();
  }
#undef ML_LOAD_Q
#undef ML_LOAD_KV
#undef ML_SCAN
#undef TOKC
  if (!smp) {
    float* oC = p.out + OUTF_C + (size_t)sidx * 65536;
#pragma unroll
    for (int dt = 0; dt < 2; ++dt) {
#pragma unroll
      for (int vt = 0; vt < 4; ++vt) *(f32x4*)(oC + (size_t)((2 * wid + dt) * 16 + l15) * 256 + sl * 64 + 16 * vt + 4 * g) = Cacc[dt][vt];
      if (sl == 0 && g == 0) p.out[OUTF_N + (size_t)sidx * 256 + (2 * wid + dt) * 16 + l15] = nacc[dt][0]; }
    if (sl == 0 && tid == 0) p.out[OUTF_M + sidx] = m_final;
  }
}

__device__ void combine_rows(const Params& p) {
  const int tid0 = opaque_tid(); const int wid = tid0 >> 6, lane = tid0 & 63;
  bf16_t* H = (bf16_t*)((unsigned char*)p.out + OUT_H); const bf16_t* HB = (const bf16_t*)((unsigned char*)p.out + OUT_HB); const float* nw = p.in[22];
  f32x4 wv[4];
#pragma unroll
  for (int i = 0; i < 4; ++i) wv[i] = *(const f32x4*)(nw + 16 * lane + 4 * i);
  const int nh = (int)gridDim.x >> 1;
  if ((int)blockIdx.x < nh) return;
  for (int unit = (int)blockIdx.x - nh; unit < 768; unit += (int)gridDim.x - nh) {
    const int row0 = unit * 32 + wid * 4;
    u32x4 a[4][2], bq[4][2];
#pragma unroll
    for (int r = 0; r < 4; ++r)
#pragma unroll
      for (int i = 0; i < 2; ++i) { a[r][i] = *(const u32x4*)(H + (size_t)(row0 + r) * 1024 + 16 * lane + 8 * i); bq[r][i] = *(const u32x4*)(HB + (size_t)(row0 + r) * 1024 + 16 * lane + 8 * i); }
#pragma unroll
    for (int r = 0; r < 4; ++r) {
      f32x4 v[4]; float ss = 0.f;
#pragma unroll
      for (int i = 0; i < 2; ++i) { f32x4 x0, x1, y0, y1; unpack8(a[r][i], x0, x1); unpack8(bq[r][i], y0, y1); v[2 * i] = x0 + y0; v[2 * i + 1] = x1 + y1; }
#pragma unroll
      for (int i = 0; i < 4; ++i) ss += v[i][0] * v[i][0] + v[i][1] * v[i][1] + v[i][2] * v[i][2] + v[i][3] * v[i][3];
      ss += __shfl_xor(ss, 1); ss += __shfl_xor(ss, 2); ss += __shfl_xor(ss, 4); ss += __shfl_xor(ss, 8);
      const float rr = rsqrtf(ss * (1.0f / 256.0f) + 1e-6f);
#pragma unroll
      for (int i = 0; i < 2; ++i) *(u32x4*)(H + (size_t)(row0 + r) * 1024 + 16 * lane + 8 * i) = pack8(v[2 * i] * rr * wv[2 * i], v[2 * i + 1] * rr * wv[2 * i + 1]);
    }
  }
}

constexpr int HY_WAVE = 18816, HY_HR = 0, HY_ZA = 8576, HY_ZB = 8576 + 5120;
__device__ void hyena_item(const Params& p, LP lds, int item) {
  const int tid = opaque_tid(), wid = __builtin_amdgcn_readfirstlane(tid >> 6), lane = tid & 63, n31 = lane & 31, hh = lane >> 5;
  const bool smp = item < 1024; const int it = smp ? item : item - 1024; const int bset = it >> 7, cgp = it & 127; const int c = cgp * 8 + wid;
  const int L = smp ? 2048 : 256, lgL = smp ? 11 : 8, nblk = L >> 5, lgnb = lgL - 5, ntok = 2048, ntile = 2, dmax = L >> 6;
  const int tok0 = smp ? NCTX + bset * 2048 : bset * 2048;
  LP wl = lds + wid * HY_WAVE; LAS float* hr = (LAS float*)(wl + HY_HR);
  const float* HFp = (const float*)(p.ws + (smp ? OFF_HFS : OFF_HFC));
  const bf16_t* UT = (const bf16_t*)(p.ws + OFF_BIG);
  const float* cw = p.in[12]; const float* cbv = p.in[13]; const float* skp = p.in[21];
  { const int uc = 2048 + c; const float w0 = cw[uc], w1 = cw[3072 + uc], w2 = cw[6144 + uc], cb = cbv[uc]; const bf16_t* src = UT + (size_t)uc * NTOK + tok0;
    u32x4 vv[4]; float pvv[4], nxv[4];
#pragma unroll
    for (int i = 0; i < 4; ++i) { const int base = lane * 8 + 512 * i; vv[i] = (u32x4){0u, 0u, 0u, 0u}; pvv[i] = 0.f; nxv[i] = 0.f;
      if (base < ntok) { vv[i] = *(const u32x4*)(src + base); const int tl = base & (L - 1);
        if (tl != 0) pvv[i] = bf2f(src[base - 1]); if (tl + 8 != L) nxv[i] = bf2f(src[base + 8]); } }
#pragma unroll
    for (int i = 0; i < 4; ++i) { const int base = lane * 8 + 512 * i;
      if (base < ntok) { const u32x4 v = vv[i];
        float u[10]; u[0] = pvv[i]; u[1] = bflo(v.x); u[2] = bfhi(v.x); u[3] = bflo(v.y); u[4] = bfhi(v.y); u[5] = bflo(v.z); u[6] = bfhi(v.z); u[7] = bflo(v.w); u[8] = bfhi(v.w); u[9] = nxv[i];
        float o[8];
#pragma unroll
        for (int e = 0; e < 8; ++e) o[e] = cb + w0 * u[e] + w1 * u[e + 1] + w2 * u[e + 2];
        u32x4 w; w.x = pack2(o[0], o[1]); w.y = pack2(o[2], o[3]); w.z = pack2(o[4], o[5]); w.w = pack2(o[6], o[7]);
        *(LAS u32x4*)(wl + HY_ZA + ((base >> 5) * 40 + (base & 31)) * 2) = w; } } }
  const int HRP = L + 96;
  f32x4 fvN[8];
#define HY_FLOAD(o) do { const float* src_ = HFp + (size_t)((o) * 1024 + c) * L; \
    _Pragma("unroll") for (int i = 0; i < 8; ++i) { const int q = lane + 64 * i; fvN[i] = (4 * q < L) ? *(const f32x4*)(src_ + 4 * q) : (f32x4){0.f, 0.f, 0.f, 0.f}; } } while (0)
  HY_FLOAD(0);
  for (int ord = 0; ord < 2; ++ord) {
    { float sa = 0.f;
      f32x4 fv[8];
#pragma unroll
      for (int i = 0; i < 8; ++i) fv[i] = fvN[i];
#pragma unroll
      for (int i = 0; i < 8; ++i) sa += (fabsf(fv[i][0]) + fabsf(fv[i][1])) + (fabsf(fv[i][2]) + fabsf(fv[i][3]));
      sa = wave_sum(sa); const float inv = 1.0f / (sa + 1e-6f);
      asm volatile("s_waitcnt lgkmcnt(0)" ::: "memory");
      LAS bf16_t* E = (LAS bf16_t*)hr; LAS bf16_t* O = E + HRP;
#pragma unroll
      for (int i = 0; i < 8; ++i) { const int q = lane + 64 * i;
        if (4 * q < L) {
#pragma unroll
          for (int e = 0; e < 4; ++e) { const int yy = L - 1 - (4 * q + e); const bf16_t v = f2bf(fv[i][e] * inv); E[32 + yy] = v; O[31 + yy] = v; } } }
      if (lane < 32) { E[lane] = 0; E[32 + L + lane] = 0; O[31 + L + lane] = 0; if (lane < 31) O[lane] = 0; }
      if (lane < 33) O[HRP - 33 + lane] = 0;
      asm volatile("s_waitcnt lgkmcnt(0)" ::: "memory"); }
    if (ord == 0) HY_FLOAD(1);
    LP zin = wl + (ord == 0 ? HY_ZA : HY_ZB); LP zout = wl + (ord == 0 ? HY_ZB : HY_ZA);
    const int gc = ord * 1024 + c; const float w0 = cw[gc], w1 = cw[3072 + gc], w2 = cw[6144 + gc], cb = cbv[gc], sk = skp[ord * 1024 + c];
    const bf16_t* gsrc = UT + (size_t)gc * NTOK + tok0;
    u32x4 gv[4]; unsigned gpv[4], gnx[4];
#pragma unroll
    for (int i = 0; i < 4; ++i) { const int base = lane * 8 + 512 * i; gv[i] = (u32x4){0u, 0u, 0u, 0u}; gpv[i] = 0u; gnx[i] = 0u;
      if (base < ntok) { gv[i] = *(const u32x4*)(gsrc + base); const int tl = base & (L - 1);
        if (tl != 0) gpv[i] = gsrc[base - 1]; if (tl + 8 != L) gnx[i] = gsrc[base + 8]; } }
    f32x16 accs[2];
#pragma unroll
    for (int o2 = 0; o2 < 2; ++o2)
#pragma unroll
      for (int r = 0; r < 16; ++r) accs[o2][r] = 0.f;
    LP fb = wl + HY_HR + ((n31 & 1) ? 0 : (HRP * 2 - 2)) + 2 * ((L >> 1) - 1 - n31 + 8 * hh + 32);
    int cbl[2], ca[2];
#pragma unroll
    for (int ot = 0; ot < 2; ++ot) { const int col = 32 * ot + n31; cbl[ot] = (col >> lgnb) << lgnb; ca[ot] = col & (nblk - 1); }
    const bool two = (ntile == 2);
    {
      LP zero = wl + HY_HR + 16 * hh;
      LP ap = fb + 64 * dmax;
      int bbr0 = ca[0] + dmax, bbr1 = ca[1] + dmax;
      LP bp0 = zin + ((cbl[0] + bbr0) * 40 + 8 * hh) * 2, bp1 = zin + ((cbl[1] + bbr1) * 40 + 8 * hh) * 2;
      for (int d = -dmax; d <= dmax; ++d) {
        u32x4 w0v, w1v;
        w0v.x = *(const LAS unsigned*)(ap); w0v.y = *(const LAS unsigned*)(ap + 4); w0v.z = *(const LAS unsigned*)(ap + 8); w0v.w = *(const LAS unsigned*)(ap + 12);
        w1v.x = *(const LAS unsigned*)(ap + 32); w1v.y = *(const LAS unsigned*)(ap + 36); w1v.z = *(const LAS unsigned*)(ap + 40); w1v.w = *(const LAS unsigned*)(ap + 44);
        const bf16x8 af0 = __builtin_bit_cast(bf16x8, w0v), af1 = __builtin_bit_cast(bf16x8, w1v);
        LP q0 = ((unsigned)bbr0 < (unsigned)nblk) ? bp0 : zero;
        LP q1 = (two && ((unsigned)bbr1 < (unsigned)nblk)) ? bp1 : zero;
        const bf16x8 b00 = *(const LAS bf16x8*)q0, b01 = *(const LAS bf16x8*)(q0 + 32);
        const bf16x8 b10 = *(const LAS bf16x8*)q1, b11 = *(const LAS bf16x8*)(q1 + 32);
        __builtin_amdgcn_sched_barrier(0);
        accs[0] = __builtin_amdgcn_mfma_f32_32x32x16_bf16(af0, b00, accs[0], 0, 0, 0);
        if (two) accs[1] = __builtin_amdgcn_mfma_f32_32x32x16_bf16(af0, b10, accs[1], 0, 0, 0);
        accs[0] = __builtin_amdgcn_mfma_f32_32x32x16_bf16(af1, b01, accs[0], 0, 0, 0);
        if (two) accs[1] = __builtin_amdgcn_mfma_f32_32x32x16_bf16(af1, b11, accs[1], 0, 0, 0);
        ap -= 64; bbr0 -= 1; bbr1 -= 1; bp0 -= 80; bp1 -= 80;
      }
    }
#pragma unroll
    for (int ot = 0; ot < 2; ++ot) {
      if (ot >= ntile) continue;
      const f32x16 acc = accs[ot];
#pragma unroll
      for (int rg = 0; rg < 4; ++rg) {
        const int zo = (((cbl[ot] + ca[ot]) * 40) + 8 * rg + 4 * hh) * 2;
        const u32x2 zv = *(const LAS u32x2*)(zin + zo);
        u32x2 w; w.x = pack2(acc[4 * rg] + sk * bflo(zv.x), acc[4 * rg + 1] + sk * bfhi(zv.x)); w.y = pack2(acc[4 * rg + 2] + sk * bflo(zv.y), acc[4 * rg + 3] + sk * bfhi(zv.y));
        *(LAS u32x2*)(zout + zo) = w;
      }
    }
    asm volatile("s_waitcnt lgkmcnt(0)" ::: "memory");
#pragma unroll
    for (int i = 0; i < 4; ++i) { const int base = lane * 8 + 512 * i;
      if (base < ntok) { const u32x4 v = gv[i];
        float u[10]; u[0] = bf2f(gpv[i]); u[1] = bflo(v.x); u[2] = bfhi(v.x); u[3] = bflo(v.y); u[4] = bfhi(v.y); u[5] = bflo(v.z); u[6] = bfhi(v.z); u[7] = bflo(v.w); u[8] = bfhi(v.w); u[9] = bf2f(gnx[i]);
        LP zp = zout + ((base >> 5) * 40 + (base & 31)) * 2; const u32x4 t = *(const LAS u32x4*)zp;
        float tv[8]; tv[0] = bflo(t.x); tv[1] = bfhi(t.x); tv[2] = bflo(t.y); tv[3] = bfhi(t.y); tv[4] = bflo(t.z); tv[5] = bfhi(t.z); tv[6] = bflo(t.w); tv[7] = bfhi(t.w);
        float o[8];
#pragma unroll
        for (int e = 0; e < 8; ++e) o[e] = (cb + w0 * u[e] + w1 * u[e + 1] + w2 * u[e + 2]) * tv[e];
        u32x4 w; w.x = pack2(o[0], o[1]); w.y = pack2(o[2], o[3]); w.z = pack2(o[4], o[5]); w.w = pack2(o[6], o[7]);
        *(LAS u32x4*)zp = w; } }
    asm volatile("s_waitcnt lgkmcnt(0)" ::: "memory");
  }
  __syncthreads();
  { bf16_t* YH = (bf16_t*)((unsigned char*)p.out + OUT_HB);
    for (int tl = tid; tl < ntok; tl += 512) {
      const int bl = tl >> lgL, tloc = tl & (L - 1); const int zo = ((((bl << lgnb) + (tloc >> 5)) * 40) + (tloc & 31)) * 2;
      unsigned short e[8];
#pragma unroll
      for (int w = 0; w < 8; ++w) e[w] = *(const LAS unsigned short*)(lds + w * HY_WAVE + HY_ZA + zo);
      u32x4 o; o.x = e[0] | ((unsigned)e[1] << 16); o.y = e[2] | ((unsigned)e[3] << 16); o.z = e[4] | ((unsigned)e[5] << 16); o.w = e[6] | ((unsigned)e[7] << 16);
      *(u32x4*)(YH + (size_t)(tok0 + tl) * 1024 + cgp * 8) = o; } }
  __syncthreads();
}

__device__ void final_norm(const Params& p) {
  const int tid0 = opaque_tid(); const int wid = tid0 >> 6, lane = tid0 & 63; const float* fw = p.in[31];
  const float* P = (const float*)(p.ws + OFF_BIG + (size_t)8192 * 4096 * 2); const float* mod = (const float*)(p.ws + OFF_MOD);
  f32x4 wv[4];
#pragma unroll
  for (int i = 0; i < 4; ++i) wv[i] = *(const f32x4*)(fw + 4 * lane + 256 * i);
  for (int unit = blockIdx.x; unit < 768; unit += gridDim.x) {
    const int row0 = unit * 32 + wid * 4; const bool chunkB = row0 >= 16384;
    f32x4 x[4][4];
#pragma unroll
    for (int r = 0; r < 4; ++r)
#pragma unroll
      for (int i = 0; i < 4; ++i) x[r][i] = *(const f32x4*)(p.out + (size_t)(row0 + r) * 1024 + 4 * lane + 256 * i);
    if (chunkB) { const float* md = mod + cond_of_row(row0) * 6144 + 5120;
#pragma unroll
      for (int i = 0; i < 4; ++i) { const f32x4 g2 = *(const f32x4*)(md + 4 * lane + 256 * i);
#pragma unroll
        for (int r = 0; r < 4; ++r) x[r][i] += g2 * *(const f32x4*)(P + (size_t)(row0 + r - 16384) * 1024 + 4 * lane + 256 * i); } }
#pragma unroll
    for (int r = 0; r < 4; ++r) { float ss = 0.f;
#pragma unroll
      for (int i = 0; i < 4; ++i) ss += x[r][i][0] * x[r][i][0] + x[r][i][1] * x[r][i][1] + x[r][i][2] * x[r][i][2] + x[r][i][3] * x[r][i][3];
      ss = wave_sum(ss); const float rstd = rsqrtf(ss * (1.0f / 1024.0f) + 1e-6f);
#pragma unroll
      for (int i = 0; i < 4; ++i) *(f32x4*)(p.out + (size_t)(row0 + r) * 1024 + 4 * lane + 256 * i) = x[r][i] * rstd * wv[i]; }
  }
}

__global__ void __launch_bounds__(512, 2) __attribute__((flatten)) mega(Params p) {
  extern __shared__ __attribute__((aligned(16))) unsigned char shm[];
  LP lds = (LP)shm;
  cg::grid_group grid = cg::this_grid();
  volatile LAS unsigned* xst = (volatile LAS unsigned*)(lds + LDS_BYTES - 16);
  if (threadIdx.x == 0) { xst[0] = 0u; xst[1] = 0u; }
  __syncthreads();
  const XcdBarrier xb = xcd_barrier_post((unsigned*)(p.ws + OFF_BAR), xst);
  unsigned char* ws = p.ws;
  const bf16_t* WT = (const bf16_t*)(ws + OFF_WT); const bf16_t* HN = (const bf16_t*)(ws + OFF_HN); bf16_t* BIG = (bf16_t*)(ws + OFF_BIG);
  bf16_t* Hb = (bf16_t*)((unsigned char*)p.out + OUT_H); bf16_t* YH = (bf16_t*)((unsigned char*)p.out + OUT_HB);
  const float* mod = (const float*)(ws + OFF_MOD);
  phase0(p, lds);
  if (gridDim.y == 7u) grid.sync();
  xcd_barrier(xb);
  phase1(p, lds);
  weight_tiles(p, lds, 0, 384, 0);
  xcd_barrier(xb);
  filters_upper_half(p, lds);
  weight_tiles(p, lds, 384, 768, 1);
  { EpiQKV e; e.O = BIG; e.bias = p.in[11]; run_gemm(lds, HN, WT, NTOK, 3072, 1024, e); }
  xcd_barrier(xb);
  for (int item = blockIdx.x; item < 1280; item += gridDim.x) mlstm_item(p, lds, item);
  xcd_barrier(xb);
  combine_rows(p);
  weight_tiles(p, lds, 768, 1152, 1);
  { EpiUT e; e.O = BIG; e.bias = p.in[11] + 4112; run_gemm(lds, WT + (size_t)3072 * 1024, HN, 3072, NTOK, 1024, e); }
  xcd_barrier(xb);
  for (int item = blockIdx.x; item < 1536; item += gridDim.x) hyena_item(p, lds, item);
  xcd_barrier(xb);
  c1_upper_half(p, lds);
  weight_tiles(p, lds, 1152, 1536, 1);
  { EpiGates e; e.H = Hb; e.G = BIG; e.b_in = p.in[11]; run_gemm(lds, HN, WT + (size_t)6144 * 1024, NTOK, 3072, 1024, e); }
  xcd_barrier(xb);
  bf16_t* T = BIG + (size_t)NTOK * 2048;
  weight_tiles(p, lds, 1536, 2560, 1);
  { EpiMerge<0> e; e.T = T; e.G = BIG; run_gemm(lds, Hb, (const bf16_t*)(ws + OFF_WBM), NTOK, 1024, 1024, e); }
  { EpiMerge<1> e; e.T = T; e.G = BIG; run_gemm(lds, YH, (const bf16_t*)(ws + OFF_WBH), NTOK, 1024, 1024, e); }
  xcd_barrier(xb);
  { EpiOut e; e.xp = p.in[0]; e.xs = p.in[1]; e.per = (const float*)(ws + OFF_PER); e.pec = (const float*)(ws + OFF_PEC); e.mod = mod; e.n2w = p.in[26];
    e.X1 = p.out; e.A2 = (bf16_t*)(ws + OFF_HN); e.ssq = (float*)(ws + OFF_SSQ1); run_gemm(lds, T, (const bf16_t*)(ws + OFF_WOUT), NTOK, 1024, 1024, e); }
  xcd_barrier(xb);
  constexpr int ROWS_A = 16384, ROWS_B = NTOK - ROWS_A;
  { EpiFF1 e; e.row0 = 0; e.ssq = (const float*)(p.ws + OFF_SSQ1); e.c1 = (const float*)(p.ws + OFF_C1); e.Hd = (bf16_t*)(p.ws + OFF_BIG);
    run_gemm(lds, (const bf16_t*)(p.ws + OFF_HN), (const bf16_t*)(p.ws + OFF_W1T), ROWS_A, 4096, 1024, e); }
  xcd_barrier(xb);
  { EpiFF2 e; e.row0 = 0; e.mod = (const float*)(p.ws + OFF_MOD); e.b2 = p.in[30]; e.X = p.out; e.P = (float*)(p.ws + OFF_BIG + (size_t)ROWS_A * 4096 * 2);
    run_gemm(lds, (const bf16_t*)(p.ws + OFF_BIG), (const bf16_t*)(p.ws + OFF_W2T), ROWS_A, 1024, 4096, e); }
  xcd_barrier(xb);
  { EpiFF1 e; e.row0 = ROWS_A; e.ssq = (const float*)(p.ws + OFF_SSQ1); e.c1 = (const float*)(p.ws + OFF_C1); e.Hd = (bf16_t*)(p.ws + OFF_BIG);
    run_gemm(lds, (const bf16_t*)(p.ws + OFF_HN) + (size_t)ROWS_A * 1024, (const bf16_t*)(p.ws + OFF_W1T), ROWS_B, 4096, 1024, e); }
  xcd_barrier(xb);
  { EpiFF2 e; e.row0 = ROWS_A; e.mod = (const float*)(p.ws + OFF_MOD); e.b2 = p.in[30]; e.X = p.out; e.P = (float*)(p.ws + OFF_BIG + (size_t)ROWS_B * 4096 * 2);
    run_gemm(lds, (const bf16_t*)(p.ws + OFF_BIG), (const bf16_t*)(p.ws + OFF_W2T), ROWS_B, 1024, 4096, e, 2); }
  xcd_barrier(xb);
  final_norm(p);
}

extern "C" void kernel_launch(void* const* d_in, const int* in_sizes, int n_in, void* d_out, int out_size, void* d_ws, size_t ws_size, hipStream_t stream) {
  static int grid_blocks = 0;
  if (!grid_blocks) {
    int dev = 0, cus = 0, per_cu = 0;
    hipGetDevice(&dev);
    hipDeviceGetAttribute(&cus, hipDeviceAttributeMultiprocessorCount, dev);
    hipFuncSetAttribute((const void*)mega, hipFuncAttributeMaxDynamicSharedMemorySize, LDS_BYTES);
    hipOccupancyMaxActiveBlocksPerMultiprocessor(&per_cu, (const void*)mega, 512, LDS_BYTES);
    if (per_cu < 1) { fprintf(stderr, "kernel_launch: occupancy query reports %d blocks per CU\n", per_cu); grid_blocks = -1; }
    else grid_blocks = cus;
    if (n_in != 32 || ws_size < WS_END) { fprintf(stderr, "kernel_launch: unexpected n_in %d / ws_size %zu (need %zu)\n", n_in, ws_size, (size_t)WS_END); grid_blocks = -1; }
  }
  if (grid_blocks < 0) return;
  hipMemsetAsync((unsigned char*)d_ws + OFF_BAR, 0, 3456 * 4, stream);
  Params p{};
  for (int i = 0; i < 32; ++i) p.in[i] = (const float*)d_in[i];
  p.out = (float*)d_out; p.ws = (unsigned char*)d_ws;
  void* args[] = {&p};
  hipError_t e = hipLaunchCooperativeKernel((void*)mega, dim3(grid_blocks), dim3(512), args, LDS_BYTES, stream);
  if (e != hipSuccess) fprintf(stderr, "cooperative launch failed: %s (grid %d)\n", hipGetErrorString(e), grid_blocks);
}
```

```cpp
#include <hip/hip_runtime.h>
#include <hip/hip_cooperative_groups.h>
#include <cstdio>
#include <cstdint>
namespace cg = cooperative_groups;

#define LAS __attribute__((address_space(3)))
typedef LAS unsigned char* LP;
typedef unsigned short bf16_t;
typedef short bf16x8 __attribute__((ext_vector_type(8)));
typedef short s16x4 __attribute__((ext_vector_type(4)));
typedef float f32x4 __attribute__((ext_vector_type(4)));
typedef float f32x16 __attribute__((ext_vector_type(16)));
typedef unsigned u32x4 __attribute__((ext_vector_type(4)));
typedef unsigned u32x2 __attribute__((ext_vector_type(2)));

constexpr int DM = 1024, NTOK = 24576, NCTX = 8192, SEQC = 256, SEQS = 2048, INC = 9232;
constexpr int LDS_BYTES = 160 * 1024;
constexpr size_t OFF_WT = 0;
constexpr size_t OFF_WBM = 18874368, OFF_WBH = 20971520, OFF_WOUT = 23068672, OFF_W1T = 25165824, OFF_W2T = 33554432;
constexpr size_t OFF_HN = 41943040;
constexpr size_t OFF_BIG = 92274688;
constexpr size_t OFF_SM = 243269632;
constexpr size_t OFF_MOD = OFF_SM;
constexpr size_t OFF_C1 = OFF_MOD + 221184;
constexpr size_t OFF_H2S = OFF_C1 + 147456;
constexpr size_t OFF_H2C = OFF_H2S + 524288;
constexpr size_t OFF_PER = OFF_H2C + 65536;
constexpr size_t OFF_PEC = OFF_PER + 65536;
constexpr size_t OFF_GT = OFF_PEC + 131072;
constexpr size_t OFF_SSQ1 = OFF_GT + 1572864;
constexpr size_t OFF_SSQ2 = OFF_SSQ1 + 1572864;
constexpr size_t OFF_HFS = OFF_SSQ2 + 1572864;
constexpr size_t OFF_HFC = OFF_HFS + 16777216;
constexpr size_t OFF_BAR = OFF_HFC + 2097152;
constexpr size_t WS_END = OFF_BAR + 3456 * 4;
constexpr size_t OUT_H = 0, OUT_HB = 50331648;
constexpr size_t OUTF_C = 25165824, OUTF_N = 41943040, OUTF_M = 42008576;

struct Params { const float* in[32]; float* out; unsigned char* ws; };

typedef float f32x2 __attribute__((ext_vector_type(2)));
typedef __bf16 bf16x2v __attribute__((ext_vector_type(2)));
__device__ __forceinline__ bf16_t f2bf(float f) { const __bf16 b = (__bf16)f; return __builtin_bit_cast(unsigned short, b); }
__device__ __forceinline__ float bf2f(unsigned b) { return __uint_as_float(b << 16); }
__device__ __forceinline__ unsigned pack2(float lo, float hi) { const f32x2 v = {lo, hi}; const bf16x2v r = __builtin_convertvector(v, bf16x2v); return __builtin_bit_cast(unsigned, r); }
__device__ __forceinline__ float bflo(unsigned w) { return __uint_as_float(w << 16); }
__device__ __forceinline__ float bfhi(unsigned w) { return __uint_as_float(w & 0xffff0000u); }
__device__ __forceinline__ float sigmoidf_(float x) { return 1.0f / (1.0f + __expf(-x)); }
__device__ __forceinline__ int opaque_tid() { int t = threadIdx.x; asm volatile("" : "+v"(t)); return t; }
__device__ __forceinline__ float wave_sum(float v) {
#pragma unroll
  for (int o = 32; o >= 1; o >>= 1) v += __shfl_xor(v, o);
  return v;
}


#define XB_TMO      128
#define XB_XCNT(j)  (256  + 64 * (j))
#define XB_XSUB(j)  (1280 + 64 * (j))
#define XB_XGEN(j)  (2304 + 64 * (j))
#define XB_TOP      3328
#define XB_TOPGEN   3392
#define XCD_BAR_WORDS 3456
#define XB_SPIN_CAP (1u << 18)
__device__ __forceinline__ unsigned xb_ld(unsigned* p)              { return __hip_atomic_load(p, __ATOMIC_RELAXED, __HIP_MEMORY_SCOPE_AGENT); }
__device__ __forceinline__ unsigned xb_add(unsigned* p, unsigned v) { return __hip_atomic_fetch_add(p, v, __ATOMIC_RELAXED, __HIP_MEMORY_SCOPE_AGENT); }
__device__ __forceinline__ unsigned xb_xcc_id() { return (unsigned)__builtin_amdgcn_s_getreg((3 << 11) | 20) & 0xFu; }
#define XB_SPIN(cond, bar) do { unsigned _sp = 0; while (cond) { __builtin_amdgcn_s_sleep(1); \
    if ((++_sp & 255u) == 0u) { if (xb_ld(&(bar)[XB_TMO])) break; if (_sp > XB_SPIN_CAP) { atomicAdd(&(bar)[XB_TMO], 1u); break; } } } } while (0)
struct XcdBarrier { unsigned* bar; unsigned x; volatile LAS unsigned* st; };
__device__ __forceinline__ XcdBarrier xcd_barrier_post(unsigned* bar, volatile LAS unsigned* st) {
  XcdBarrier b; b.bar = bar; b.x = xb_xcc_id(); b.st = st;
  if (threadIdx.x == 0) (void)xb_add(&bar[XB_XCNT(b.x)], 1u);
  return b;
}
__device__ __forceinline__ void xcd_barrier_complete(unsigned* bar, unsigned x, unsigned& nloc, unsigned& nx) {
  const unsigned G = gridDim.x * gridDim.y * gridDim.z;
  unsigned sum, cnt, mine, sp = 0u;
  for (;;) {
    sum = 0u; cnt = 0u; mine = 0u;
#pragma unroll
    for (unsigned j = 0; j < 16; ++j) { const unsigned c = xb_ld(&bar[XB_XCNT(j)]); sum += c; cnt += (c > 0u) ? 1u : 0u; mine = (j == x) ? c : mine; }
    if (sum == G) break;
    __builtin_amdgcn_s_sleep(1);
    if ((++sp & 255u) == 0u) { if (xb_ld(&bar[XB_TMO])) break; if (sp > XB_SPIN_CAP) { atomicAdd(&bar[XB_TMO], 1u); break; } }
  }
  nloc = mine > 0u ? mine : 1u; nx = cnt > 0u ? cnt : 1u;
}
__device__ __forceinline__ void xcd_barrier(const XcdBarrier& b) {
  asm volatile("s_waitcnt vmcnt(0)" ::: "memory");
  __syncthreads();
  if (threadIdx.x == 0) {
    unsigned* bar = b.bar;
    __builtin_amdgcn_s_waitcnt(0);
    unsigned nloc = b.st[0], nx = b.st[1];
    if (nloc == 0u) { xcd_barrier_complete(bar, b.x, nloc, nx); b.st[0] = nloc; b.st[1] = nx; }
    const unsigned old = xb_add(&bar[XB_XSUB(b.x)], 1u);
    const unsigned gen = old / nloc;
    if (old + 1u == (gen + 1u) * nloc) {
      __builtin_amdgcn_fence(__ATOMIC_RELEASE, "agent");
      asm volatile("s_waitcnt vmcnt(0)" ::: "memory");
      const unsigned og = xb_add(&bar[XB_TOP], 1u);
      const unsigned tg = og / nx;
      if (og + 1u == (tg + 1u) * nx) xb_add(&bar[XB_TOPGEN], 1u);
      else XB_SPIN(xb_ld(&bar[XB_TOPGEN]) == tg, bar);
      __builtin_amdgcn_fence(__ATOMIC_ACQUIRE, "agent");
      xb_add(&bar[XB_XGEN(b.x)], 1u);
      asm volatile("s_waitcnt vmcnt(0)" ::: "memory");
    } else {
      XB_SPIN(xb_ld(&bar[XB_XGEN(b.x)]) == gen, bar);
      __builtin_amdgcn_fence(__ATOMIC_ACQUIRE, "agent");
      asm volatile("s_waitcnt vmcnt(0)" ::: "memory");
    }
  }
  __syncthreads();
}

namespace pg8 {
constexpr int BM = 256, BK = 64, HALF = 128, HTB = HALF * BK * 2, STAGE_BYTES = 8 * HTB, NXCD = 8, WGM = 8;
__host__ __device__ __forceinline__ int lds_byte(int r, int c) { const int st = (r >> 4) * 2 + (c >> 5), rr = r & 15, cc = c & 31, ob = rr * 64 + cc * 2; return st * 1024 + (ob ^ (((ob >> 9) & 1) << 5)); }
__host__ __device__ __forceinline__ void stage_rc(int b, int& R, int& C) { const int st = b / 1024, sb = b % 1024, swz = sb ^ (((sb >> 9) & 1) << 5); R = (st >> 1) * 16 + swz / 64; C = (st & 1) * 32 + (swz % 64) / 2; }
__host__ __device__ __forceinline__ int perm32(int rho) { const int n = rho >> 4, i = rho & 15; return 8 * (i >> 2) + 4 * n + (i & 3); }
struct Unit { int pm, pn, ks; };
struct Gemm { const bf16_t* A; const bf16_t* Bt; int M, N, K, ld, nks; };
struct StaticOrder {
  int nM, nN, ntile, nwg, G, c;
  __device__ void init(int M, int N, int nks, int G_, int c_) { nM = M / BM; nN = N / BM; ntile = nM * nN; nwg = ntile * nks; G = G_; c = c_; }
  __device__ bool next(int i, Unit& u) const {
    const long L = (long)i * G + c; if (L >= nwg) return false;
    u.ks = (int)L / ntile; int wgid = (int)L - u.ks * ntile;
    { const int q = ntile / NXCD, r = ntile % NXCD, xcd = wgid % NXCD, off = wgid / NXCD; wgid = (xcd < r ? xcd * (q + 1) : r * (q + 1) + (xcd - r) * q) + off; }
    const int nig = WGM * nN, gid = wgid / nig, fm = gid * WGM, gsz = (nM - fm) < WGM ? (nM - fm) : WGM;
    u.pm = fm + ((wgid % nig) % gsz); u.pn = (wgid % nig) / gsz; return true;
  }
};

template <class Epi>
__device__ __forceinline__ void gemm_phase(LP lds, const Gemm g, const StaticOrder& S, const Epi& E) {
  int tid_ = threadIdx.x; asm volatile("" : "+v"(tid_));
  const int tid = tid_, wid = __builtin_amdgcn_readfirstlane(tid >> 6), lane = tid & 63, wr = wid >> 2, wc = wid & 3, fr = lane & 15, fq = lane >> 4;
  const int K = g.ld, nt = g.K / BK;
  const size_t ksb = (size_t)g.K * 2;
  unsigned voffA[2], voffB[2];
#pragma unroll
  for (int i = 0; i < 2; ++i) { int R, C; stage_rc(tid * 16 + i * 8192, R, C); const int Rb = (R & ~31) + perm32(R & 31); voffA[i] = (unsigned)(R * K + C) * 2u; voffB[i] = (unsigned)(Rb * K + C) * 2u; }
  const size_t kstep = (size_t)(BK * 2);
  const size_t hstep = (size_t)HALF * K * 2;
  const size_t tstep = 2 * hstep;
  const unsigned ldsw = (unsigned)wid * 1024u;
  const int aoff = lds_byte(wr * 64 + fr, fq * 8), boff = lds_byte(wc * 32 + fr, fq * 8);
#define PG8_SA(b, h) (((b) * 2 + (h)) * HTB)
#define PG8_SB(b, h) ((4 + (b) * 2 + (h)) * HTB)
#define PG8_STAGE(bufoff, gbase, voff) do { _Pragma("unroll") for (int _i = 0; _i < 2; ++_i) \
    __builtin_amdgcn_global_load_lds((const unsigned*)((const char*)(gbase) + (voff)[_i]), (LAS unsigned*)(lds + (bufoff) + ldsw + _i * 8192), 16, 0, 0); } while (0)
#define PG8_LDA(dst, b, h) do { _Pragma("unroll") for (int m = 0; m < 4; ++m) _Pragma("unroll") for (int k = 0; k < 2; ++k) dst[m][k] = *(const LAS bf16x8*)(lds + PG8_SA(b, h) + aoff + m * 2048 + k * 1024); } while (0)
#define PG8_LDB(dst, b, h) do { _Pragma("unroll") for (int n = 0; n < 2; ++n) _Pragma("unroll") for (int k = 0; k < 2; ++k) dst[n][k] = *(const LAS bf16x8*)(lds + PG8_SB(b, h) + boff + n * 2048 + k * 1024); } while (0)
#define PG8_MMA(ai, bj, At, Bt) do { __builtin_amdgcn_s_setprio(1); _Pragma("unroll") for (int m = 0; m < 4; ++m) _Pragma("unroll") for (int n = 0; n < 2; ++n) _Pragma("unroll") for (int k = 0; k < 2; ++k) \
    acc[ai][bj][m][n] = __builtin_amdgcn_mfma_f32_16x16x32_bf16(Bt[n][k], At[m][k], acc[ai][bj][m][n], 0, 0, 0); __builtin_amdgcn_s_setprio(0); } while (0)
#define PG8_WAIT_V(n) asm volatile("s_waitcnt vmcnt(" #n ")" ::: "memory")
#define PG8_WAIT_L(n) asm volatile("s_waitcnt lgkmcnt(" #n ")" ::: "memory")
#define PG8_BAR __builtin_amdgcn_s_barrier()
#define PG8_SCHED __builtin_amdgcn_sched_barrier(0)
  Unit cur, nxt; int ui = 0;
  if (!S.next(0, cur)) return;
  f32x4 acc[2][2][4][2];
#pragma unroll
  for (int a = 0; a < 2; ++a)
#pragma unroll
    for (int b = 0; b < 2; ++b)
#pragma unroll
      for (int m = 0; m < 4; ++m)
#pragma unroll
        for (int n = 0; n < 2; ++n) acc[a][b][m][n] = (f32x4){0.f, 0.f, 0.f, 0.f};
  bf16x8 At[4][2], B0[2][2], B1[2][2];
  const char* cA = (const char*)g.A + (size_t)cur.pm * tstep + cur.ks * ksb; const char* cB = (const char*)g.Bt + (size_t)cur.pn * tstep + cur.ks * ksb;
  PG8_STAGE(PG8_SB(0, 0), cB, voffB); PG8_STAGE(PG8_SB(0, 1), cB + hstep, voffB); PG8_STAGE(PG8_SA(0, 0), cA, voffA); PG8_STAGE(PG8_SA(0, 1), cA + hstep, voffA);
  if (wr == 1) PG8_BAR;
  PG8_WAIT_V(2); PG8_BAR;
  PG8_STAGE(PG8_SB(1, 0), cB + kstep, voffB); PG8_STAGE(PG8_SA(1, 0), cA + kstep, voffA); PG8_STAGE(PG8_SB(1, 1), cB + hstep + kstep, voffB);
  PG8_WAIT_V(6); PG8_BAR;
  for (;;) {
    const bool has_next = S.next(ui + 1, nxt);
    const char* nA = has_next ? (const char*)g.A + (size_t)nxt.pm * tstep + nxt.ks * ksb : cA; const char* nB = has_next ? (const char*)g.Bt + (size_t)nxt.pn * tstep + nxt.ks * ksb : cB;
    for (int t = 0; t < nt; t += 2) {
      const bool last = (t == nt - 2);
      const char* a1 = cA + (size_t)(t + 1) * kstep;
      const char* a2 = last ? nA : cA + (size_t)(t + 2) * kstep; const char* b2 = last ? nB : cB + (size_t)(t + 2) * kstep;
      const char* a3 = a2 + kstep; const char* b3 = b2 + kstep;
      PG8_LDB(B0, 0, 0); PG8_LDB(B1, 0, 1); PG8_SCHED; PG8_LDA(At, 0, 0); PG8_STAGE(PG8_SA(1, 1), a1 + hstep, voffA);
      PG8_WAIT_V(8); PG8_WAIT_L(0); PG8_BAR; PG8_MMA(0, 0, At, B0); PG8_MMA(0, 1, At, B1); PG8_BAR; PG8_SCHED;
      PG8_LDA(At, 0, 1); PG8_STAGE(PG8_SB(0, 0), b2, voffB); PG8_STAGE(PG8_SB(0, 1), b2 + hstep, voffB); PG8_STAGE(PG8_SA(0, 0), a2, voffA);
      PG8_WAIT_V(8); PG8_WAIT_L(0); PG8_BAR; PG8_MMA(1, 0, At, B0); PG8_MMA(1, 1, At, B1); PG8_BAR; PG8_SCHED;
      PG8_LDB(B0, 1, 0); PG8_LDB(B1, 1, 1); PG8_SCHED; PG8_LDA(At, 1, 0); PG8_STAGE(PG8_SA(0, 1), a2 + hstep, voffA);
      PG8_WAIT_V(8); PG8_WAIT_L(0); PG8_BAR; PG8_MMA(0, 0, At, B0); PG8_MMA(0, 1, At, B1); PG8_BAR; PG8_SCHED;
      PG8_LDA(At, 1, 1); PG8_STAGE(PG8_SB(1, 0), b3, voffB); PG8_STAGE(PG8_SB(1, 1), b3 + hstep, voffB); PG8_STAGE(PG8_SA(1, 0), a3, voffA);
      PG8_WAIT_V(8); PG8_WAIT_L(0); PG8_BAR; PG8_MMA(1, 0, At, B0); PG8_MMA(1, 1, At, B1); PG8_BAR; PG8_SCHED;
    }
    if (wr == 0) PG8_BAR;
    { int fr2 = fr, fq2 = fq; asm volatile("" : "+v"(fr2), "+v"(fq2)); E(acc, cur, wr, wc, fr2, fq2); }
    if (!has_next) break;
#pragma unroll
    for (int a = 0; a < 2; ++a)
#pragma unroll
      for (int b = 0; b < 2; ++b)
#pragma unroll
        for (int m = 0; m < 4; ++m)
#pragma unroll
          for (int n = 0; n < 2; ++n) acc[a][b][m][n] = (f32x4){0.f, 0.f, 0.f, 0.f};
    cur = nxt; cA = nA; cB = nB; ++ui;
    if (wr == 1) PG8_BAR;
  }
  PG8_WAIT_V(0);
  PG8_BAR;
#undef PG8_SA
#undef PG8_SB
#undef PG8_STAGE
#undef PG8_LDA
#undef PG8_LDB
#undef PG8_MMA
#undef PG8_WAIT_V
#undef PG8_WAIT_L
#undef PG8_BAR
#undef PG8_SCHED
}
}
using pg8::Unit;
typedef f32x4 AccT[2][2][4][2];

#define EPI_ROW(ai, m) (u.pm * 256 + (ai) * 128 + wr * 64 + (m) * 16 + fr)
#define EPI_COL(bj, n) (u.pn * 256 + (bj) * 128 + wc * 32 + 8 * fq + 4 * (n))
#define EPI_LOOP_ROWS _Pragma("unroll") for (int ai = 0; ai < 2; ++ai) _Pragma("unroll") for (int m = 0; m < 4; ++m)
#define EPI_LOOP_COLS _Pragma("unroll") for (int bj = 0; bj < 2; ++bj) _Pragma("unroll") for (int n = 0; n < 2; ++n)

__device__ __forceinline__ int cond_of_row(int row) { return row < NCTX ? 0 : 1 + ((row - NCTX) >> 11); }

#define EPI_LOOP_BJ _Pragma("unroll") for (int bj = 0; bj < 2; ++bj)
__device__ __forceinline__ u32x4 pack8(const f32x4 v0, const f32x4 v1) { u32x4 w; w.x = pack2(v0[0], v0[1]); w.y = pack2(v0[2], v0[3]); w.z = pack2(v1[0], v1[1]); w.w = pack2(v1[2], v1[3]); return w; }
__device__ __forceinline__ void unpack8(const u32x4 w, f32x4& v0, f32x4& v1) { v0[0] = bflo(w.x); v0[1] = bfhi(w.x); v0[2] = bflo(w.y); v0[3] = bfhi(w.y); v1[0] = bflo(w.z); v1[1] = bfhi(w.z); v1[2] = bflo(w.w); v1[3] = bfhi(w.w); }
struct EpiQKV {
  bf16_t* O; const float* bias;
  __device__ __forceinline__ void operator()(const AccT& acc, const Unit& u, int wr, int wc, int fr, int fq) const {
    const float sc = (u.pn < 4) ? 0.0625f : 1.0f;
    f32x4 bv[2][2];
    EPI_LOOP_COLS { bv[bj][n] = *(const f32x4*)(bias + EPI_COL(bj, n)); }
    EPI_LOOP_ROWS { const int row = EPI_ROW(ai, m);
      EPI_LOOP_BJ { *(u32x4*)(O + (size_t)row * 3072 + EPI_COL(bj, 0)) = pack8((acc[ai][bj][m][0] + bv[bj][0]) * sc, (acc[ai][bj][m][1] + bv[bj][1]) * sc); } }
  }
};
struct EpiUT {
  bf16_t* O; const float* bias;
  __device__ __forceinline__ void operator()(const AccT& acc, const Unit& u, int wr, int wc, int fr, int fq) const {
    EPI_LOOP_ROWS { const int row = EPI_ROW(ai, m); const float bv = bias[row];
      EPI_LOOP_BJ { *(u32x4*)(O + (size_t)row * NTOK + EPI_COL(bj, 0)) = pack8(acc[ai][bj][m][0] + bv, acc[ai][bj][m][1] + bv); } }
  }
};
struct EpiGates {
  bf16_t* H; bf16_t* G; const float* b_in;
  __device__ __forceinline__ void operator()(const AccT& acc, const Unit& u, int wr, int wc, int fr, int fq) const {
    const bool og = u.pn < 4;
    f32x4 bv[2][2];
    EPI_LOOP_COLS { const int col = EPI_COL(bj, n); bv[bj][n] = *(const f32x4*)(b_in + (og ? 3072 + col : 7184 + (col - 1024))); }
#pragma unroll
    for (int ai = 0; ai < 2; ++ai)
#pragma unroll
      for (int m2 = 0; m2 < 2; ++m2) {
        u32x4 hv[2][2];
        if (og) {
#pragma unroll
          for (int mm = 0; mm < 2; ++mm) { const int row = EPI_ROW(ai, 2 * m2 + mm); EPI_LOOP_BJ { hv[mm][bj] = *(const u32x4*)(H + (size_t)row * 1024 + EPI_COL(bj, 0)); } } }
#pragma unroll
        for (int mm = 0; mm < 2; ++mm) { const int m = 2 * m2 + mm; const int row = EPI_ROW(ai, m);
          EPI_LOOP_BJ { const int col = EPI_COL(bj, 0); f32x4 s0, s1; const f32x4 a0 = acc[ai][bj][m][0] + bv[bj][0], a1 = acc[ai][bj][m][1] + bv[bj][1];
#pragma unroll
            for (int e = 0; e < 4; ++e) { s0[e] = sigmoidf_(a0[e]); s1[e] = sigmoidf_(a1[e]); }
            if (og) { f32x4 h0, h1; unpack8(hv[mm][bj], h0, h1); *(u32x4*)(H + (size_t)row * 1024 + col) = pack8(h0 * s0, h1 * s1); }
            else *(u32x4*)(G + (size_t)row * 2048 + (col - 1024)) = pack8(s0, s1); } } }
  }
};
template <int SECOND> struct EpiMerge {
  bf16_t* T; const bf16_t* G;
  __device__ __forceinline__ void operator()(const AccT& acc, const Unit& u, int wr, int wc, int fr, int fq) const {
#pragma unroll
    for (int ai = 0; ai < 2; ++ai)
#pragma unroll
      for (int m2 = 0; m2 < 2; ++m2) {
        u32x4 gv[2][2], tv[2][2];
#pragma unroll
        for (int mm = 0; mm < 2; ++mm) { const int row = EPI_ROW(ai, 2 * m2 + mm);
          EPI_LOOP_BJ { const int col = EPI_COL(bj, 0); gv[mm][bj] = *(const u32x4*)(G + (size_t)row * 2048 + SECOND * 1024 + col);
            if (SECOND) tv[mm][bj] = *(const u32x4*)(T + (size_t)row * 1024 + col); } }
#pragma unroll
        for (int mm = 0; mm < 2; ++mm) { const int m = 2 * m2 + mm; const int row = EPI_ROW(ai, m);
          EPI_LOOP_BJ { const int col = EPI_COL(bj, 0); f32x4 g0, g1; unpack8(gv[mm][bj], g0, g1);
            f32x4 v0 = g0 * acc[ai][bj][m][0], v1 = g1 * acc[ai][bj][m][1];
            if (SECOND) { f32x4 t0, t1; unpack8(tv[mm][bj], t0, t1); v0 += t0; v1 += t1; }
            *(u32x4*)(T + (size_t)row * 1024 + col) = pack8(v0, v1); } } }
  }
};
struct EpiOut {
  const float* xp; const float* xs; const float* per; const float* pec; const float* mod; const float* n2w; float* X1; bf16_t* A2; float* ssq;
  __device__ __forceinline__ void operator()(const AccT& acc, const Unit& u, int wr, int wc, int fr, int fq) const {
    const int cb = cond_of_row(u.pm * 256); const float* md = mod + cb * 6144; const bool smp = (u.pm * 256) >= NCTX;
    f32x4 g1v[2][2], k2v[2][2];
    EPI_LOOP_COLS { const int col = EPI_COL(bj, n); g1v[bj][n] = *(const f32x4*)(md + 2048 + col); k2v[bj][n] = *(const f32x4*)(n2w + col) * (*(const f32x4*)(md + 4096 + col) + 1.0f); }
    EPI_LOOP_ROWS { const int row = EPI_ROW(ai, m); float ss = 0.f;
#pragma unroll
      for (int bj = 0; bj < 2; ++bj) {
        f32x4 x0[2];
        if (!smp) {
#pragma unroll
          for (int n = 0; n < 2; ++n) x0[n] = *(const f32x4*)(xp + (size_t)row * 1024 + EPI_COL(bj, n)); }
        else { const int r2 = row - NCTX, t = r2 & 2047; f32x4 pe[2];
#pragma unroll
          for (int n = 0; n < 2; ++n) { const int col = EPI_COL(bj, n); x0[n] = *(const f32x4*)(xs + (size_t)r2 * 1024 + col);
            pe[n] = (col < 512) ? *(const f32x4*)(per + (t >> 6) * 512 + col) : *(const f32x4*)(pec + (t & 63) * 512 + (col - 512)); }
#pragma unroll
          for (int n = 0; n < 2; ++n) x0[n] += pe[n]; }
        f32x4 x1[2];
#pragma unroll
        for (int n = 0; n < 2; ++n) { x1[n] = x0[n] + g1v[bj][n] * acc[ai][bj][m][n]; *(f32x4*)(X1 + (size_t)row * 1024 + EPI_COL(bj, n)) = x1[n];
          ss += x1[n][0] * x1[n][0] + x1[n][1] * x1[n][1] + x1[n][2] * x1[n][2] + x1[n][3] * x1[n][3]; }
        *(u32x4*)(A2 + (size_t)row * 1024 + EPI_COL(bj, 0)) = pack8(x1[0] * k2v[bj][0], x1[1] * k2v[bj][1]); }
      ss += __shfl_xor(ss, 16); ss += __shfl_xor(ss, 32);
      if (fq == 0) ssq[(size_t)row * 16 + u.pn * 4 + wc] = ss; }
  }
};
struct EpiFF1 {
  int row0; const float* ssq; const float* c1; bf16_t* Hd;
  __device__ __forceinline__ void operator()(const AccT& acc, const Unit& u, int wr, int wc, int fr, int fq) const {
    const int cb = cond_of_row(row0 + u.pm * 256); const float* cc = c1 + cb * 4096;
    f32x4 cv[2][2];
    EPI_LOOP_COLS { cv[bj][n] = *(const f32x4*)(cc + EPI_COL(bj, n)); }
    float rs[2][4];
    EPI_LOOP_ROWS { const float* sp = ssq + (size_t)(row0 + EPI_ROW(ai, m)) * 16;
      const f32x4 st = (*(const f32x4*)sp + *(const f32x4*)(sp + 4)) + (*(const f32x4*)(sp + 8) + *(const f32x4*)(sp + 12));
      rs[ai][m] = rsqrtf((st[0] + st[1] + st[2] + st[3]) * (1.0f / 1024.0f) + 1e-6f); }
    EPI_LOOP_ROWS { const int rl = EPI_ROW(ai, m); const float rstd = rs[ai][m];
      EPI_LOOP_BJ { f32x4 v0 = acc[ai][bj][m][0] * rstd + cv[bj][0], v1 = acc[ai][bj][m][1] * rstd + cv[bj][1];
#pragma unroll
        for (int e = 0; e < 4; ++e) { const float r0 = fmaxf(v0[e], 0.f), r1 = fmaxf(v1[e], 0.f); v0[e] = r0 * r0; v1[e] = r1 * r1; }
        *(u32x4*)(Hd + (size_t)rl * 4096 + EPI_COL(bj, 0)) = pack8(v0, v1); } }
  }
};
struct EpiFF2 {
  int row0; const float* mod; const float* b2; float* X; float* P;
  __device__ __forceinline__ void operator()(const AccT& acc, const Unit& u, int wr, int wc, int fr, int fq) const {
    if (u.ks == 1) {
      EPI_LOOP_ROWS { const int rl = EPI_ROW(ai, m); EPI_LOOP_COLS { *(f32x4*)(P + (size_t)rl * 1024 + EPI_COL(bj, n)) = acc[ai][bj][m][n]; } }
    } else {
    const int cb = cond_of_row(row0 + u.pm * 256); const float* md = mod + cb * 6144;
    f32x4 g2v[2][2], bbv[2][2];
    EPI_LOOP_COLS { const int col = EPI_COL(bj, n); g2v[bj][n] = *(const f32x4*)(md + 5120 + col); bbv[bj][n] = *(const f32x4*)(b2 + col); }
#pragma unroll
    for (int ai = 0; ai < 2; ++ai)
#pragma unroll
      for (int m2 = 0; m2 < 2; ++m2) {
        f32x4 xv[2][2][2];
#pragma unroll
        for (int mm = 0; mm < 2; ++mm) { const int row = row0 + EPI_ROW(ai, 2 * m2 + mm); EPI_LOOP_COLS { xv[mm][bj][n] = *(const f32x4*)(X + (size_t)row * 1024 + EPI_COL(bj, n)); } }
#pragma unroll
        for (int mm = 0; mm < 2; ++mm) { const int m = 2 * m2 + mm; const int row = row0 + EPI_ROW(ai, m);
          EPI_LOOP_COLS { const int col = EPI_COL(bj, n); *(f32x4*)(X + (size_t)row * 1024 + col) = xv[mm][bj][n] + g2v[bj][n] * (acc[ai][bj][m][n] + bbv[bj][n]); } } }
    }
  }
};

template <class Epi> __device__ __forceinline__ void run_gemm(LP lds, const bf16_t* A, const bf16_t* Bt, int M, int N, int K, const Epi& E, int nks = 1) {
  pg8::Gemm g; g.A = A; g.Bt = Bt; g.M = M; g.N = N; g.K = K / nks; g.ld = K; g.nks = nks;
  pg8::StaticOrder S; S.init(M, N, nks, (int)gridDim.x, (int)blockIdx.x);
  pg8::gemm_phase<Epi>(lds, g, S, E);
}

__device__ void transpose_tile(const float* __restrict__ src, int ld, int col0, int k0, bf16_t* __restrict__ dst, int K, int drow0, LAS float* tile) {
  const int t = opaque_tid();
  f32x4 v[4];
#pragma unroll
  for (int i = 0; i < 4; ++i) { const int idx = t + 512 * i, kr = idx >> 5, c4 = idx & 31; v[i] = *(const f32x4*)(src + (size_t)(k0 + kr) * ld + col0 + 4 * c4); }
#pragma unroll
  for (int i = 0; i < 4; ++i) { const int idx = t + 512 * i, kr = idx >> 5, c4 = idx & 31; LAS float* tp = tile + kr * 129 + 4 * c4; tp[0] = v[i][0]; tp[1] = v[i][1]; tp[2] = v[i][2]; tp[3] = v[i][3]; }
  __syncthreads();
  const int kb = t & 7;
#pragma unroll
  for (int i = 0; i < 2; ++i) { const int c = (t >> 3) + 64 * i; const LAS float* tp = tile + (kb * 8) * 129 + c; u32x4 o;
    o.x = pack2(tp[0], tp[129]); o.y = pack2(tp[2 * 129], tp[3 * 129]); o.z = pack2(tp[4 * 129], tp[5 * 129]); o.w = pack2(tp[6 * 129], tp[7 * 129]);
    *(u32x4*)(dst + (size_t)(drow0 + c) * K + k0 + kb * 8) = o; }
  __syncthreads();
}
template <int SILU> __device__ void matvec9_unit(const float* v0, const float* v1, int v1stride, const float* __restrict__ W, int ldw, const float* bias, float* out, int ldo, int col0, LAS float* lf) {
  const int t = opaque_tid(), lane = t & 63, wid = t >> 6;
  LAS float* sv = lf; LAS float* red = lf + 9216;
  for (int i = t; i < 9216; i += 512) { const int b = i >> 10, k = i & 1023; float x = (b == 0) ? v0[k] : v1[(size_t)(b - 1) * v1stride + k]; if (SILU) x = x / (1.0f + __expf(-x)); sv[i] = x; }
  __syncthreads();
  const int c4 = t & 7, kl = t >> 3;
  f32x4 w[16];
#pragma unroll
  for (int i = 0; i < 16; ++i) w[i] = *(const f32x4*)(W + (size_t)(kl + 64 * i) * ldw + col0 + 4 * c4);
  f32x4 acc[9];
#pragma unroll
  for (int b = 0; b < 9; ++b) acc[b] = (f32x4){0.f, 0.f, 0.f, 0.f};
#pragma unroll
  for (int i = 0; i < 16; ++i)
#pragma unroll
    for (int b = 0; b < 9; ++b) acc[b] += w[i] * sv[b * 1024 + kl + 64 * i];
#pragma unroll
  for (int b = 0; b < 9; ++b)
#pragma unroll
    for (int e = 0; e < 4; ++e) { float x = acc[b][e]; x += __shfl_xor(x, 8); x += __shfl_xor(x, 16); x += __shfl_xor(x, 32); acc[b][e] = x; }
  if (lane < 8) {
#pragma unroll
    for (int b = 0; b < 9; ++b) *(LAS f32x4*)(red + (wid * 9 + b) * 32 + 4 * lane) = acc[b]; }
  __syncthreads();
  if (t < 288) { const int b = t >> 5, cc = t & 31; float s = bias[col0 + cc];
#pragma unroll
    for (int pz = 0; pz < 8; ++pz) s += red[(pz * 9 + b) * 32 + cc];
    out[(size_t)b * ldo + col0 + cc] = s; }
  __syncthreads();
}

__device__ void phase0(const Params& p, LP lds) {
  unsigned char* ws = p.ws; LAS float* lf = (LAS float*)lds;
  const int tid0 = opaque_tid(); const int wid = tid0 >> 6, lane = tid0 & 63;
  for (int unit = blockIdx.x; unit < 576; unit += gridDim.x) {
    if (unit < 192) {
      matvec9_unit<1>(p.in[6], p.in[5], 1024, p.in[7], 6144, p.in[8], (float*)(ws + OFF_MOD), 6144, unit * 32, lf);
    } else if (unit < 480) {
      const int row = (unit - 192) * 8 + wid; const bool smp = row < 2048; const int L = smp ? 2048 : 256, t = smp ? row : row - 2048;
      const float* w1 = p.in[14]; const float* b1 = p.in[15]; const float* fr1 = p.in[16]; const float* w2 = p.in[17]; const float* b2 = p.in[18]; const float* fr2 = p.in[19];
      float a = b1[lane] + (float)t / (float)(L - 1) * w1[lane];
      const float base = (6.283185307179586f / (float)L) * (float)t;
      float cs = 0.f, sn = 0.f; if (lane < 16) { const float ang = base * (float)(lane + 1); cs = cosf(ang); sn = sinf(ang); }
#pragma unroll
      for (int i = 0; i < 16; ++i) a += __shfl(cs, i) * w1[(1 + i) * 64 + lane] + __shfl(sn, i) * w1[(17 + i) * 64 + lane];
      const float h1 = sinf(fr1[lane] * a);
      float a2 = b2[lane];
#pragma unroll 16
      for (int j = 0; j < 64; ++j) a2 += __shfl(h1, j) * w2[j * 64 + lane];
      const float h2 = sinf(fr2[lane] * a2);
      float* dst = (float*)(ws + (smp ? OFF_H2S : OFF_H2C)); dst[(size_t)t * 64 + lane] = h2;
    } else {
      const int r = unit - 480, c = tid0; const int pos = r < 32 ? r : r - 32; const int i = c & 255;
      const float omega = 1.0f / powf(10000.0f, (float)i / 256.0f); const float a = (float)pos * omega; const float v = c < 256 ? sinf(a) : cosf(a);
      float* dst = (float*)(ws + (r < 32 ? OFF_PER : OFF_PEC)); dst[(size_t)pos * 512 + c] = v;
    }
  }
}
__device__ void weight_tiles(const Params& p, LP lds, int lo, int hi, int upper) {
  unsigned char* ws = p.ws; LAS float* lf = (LAS float*)lds;
  const int nh = upper ? ((int)gridDim.x >> 1) : 0;
  if ((int)blockIdx.x < nh) return;
  for (int tu = lo + (int)blockIdx.x - nh; tu < hi; tu += (int)gridDim.x - nh) {
    const float* src; int ld, K, col0, k0, drow0; bf16_t* dst;
    if (tu < 1152) { const int nt = tu >> 4, kt = tu & 15; const int r = nt * 128; src = p.in[10]; ld = INC; K = 1024; k0 = kt * 64; drow0 = r; dst = (bf16_t*)(ws + OFF_WT);
      col0 = r < 3072 ? r : (r < 6144 ? 4112 + (r - 3072) : (r < 7168 ? 3072 + (r - 6144) : 7184 + (r - 7168))); }
    else if (tu < 1536) { const int v = tu - 1152, w = v >> 7, q = v & 127; src = p.in[23 + w]; ld = 1024; K = 1024; k0 = (q & 15) * 64; col0 = (q >> 4) * 128; drow0 = col0; dst = (bf16_t*)(ws + (w == 0 ? OFF_WBM : (w == 1 ? OFF_WBH : OFF_WOUT))); }
    else if (tu < 2048) { const int q = tu - 1536; src = p.in[27]; ld = 4096; K = 1024; k0 = (q & 15) * 64; col0 = (q >> 4) * 128; drow0 = col0; dst = (bf16_t*)(ws + OFF_W1T); }
    else { const int q = tu - 2048; src = p.in[29]; ld = 1024; K = 4096; k0 = (q & 63) * 64; col0 = (q >> 6) * 128; drow0 = col0; dst = (bf16_t*)(ws + OFF_W2T); }
    transpose_tile(src, ld, col0, k0, dst, K, drow0, lf);
  }
}

__device__ void phase1(const Params& p, LP lds) {
  unsigned char* ws = p.ws;
  int tid_ = threadIdx.x; asm volatile("" : "+v"(tid_));
  const int tid = tid_, wid = tid >> 6, lane = tid & 63;
  const float* mod = (const float*)(ws + OFF_MOD);
  LAS float* wg = (LAS float*)lds;
  if ((int)blockIdx.x < 1536) {
    f32x4 gw[8];
#pragma unroll
    for (int i = 0; i < 8; ++i) { const int idx = tid + 512 * i, k = idx >> 2, q = idx & 3; gw[i] = *(const f32x4*)(p.in[10] + (size_t)k * INC + 4096 + 4 * q); }
#pragma unroll
    for (int i = 0; i < 8; ++i) { const int idx = tid + 512 * i, k = idx >> 2, q = idx & 3; wg[(4 * q) * 1024 + k] = gw[i][0]; wg[(4 * q + 1) * 1024 + k] = gw[i][1]; wg[(4 * q + 2) * 1024 + k] = gw[i][2]; wg[(4 * q + 3) * 1024 + k] = gw[i][3]; }
    __syncthreads();
  }
  for (int unit = blockIdx.x; unit < 1536; unit += gridDim.x) {
    const int tidn = opaque_tid(); const int wid = tidn >> 6, lane = tidn & 63;
    const int row0 = unit * 16 + wid * 2; const int cb = cond_of_row(row0); const float* md = mod + cb * 6144; const bool smp = row0 >= NCTX;
    f32x4 v[2][4]; float rstd[2];
#pragma unroll
    for (int r = 0; r < 2; ++r) { const int row = row0 + r; const float* xr; int t = 0;
      if (!smp) xr = p.in[0] + (size_t)row * 1024; else { xr = p.in[1] + (size_t)(row - NCTX) * 1024; t = (row - NCTX) & 2047; }
      const float* per = (const float*)(ws + OFF_PER) + (t >> 6) * 512; const float* pec = (const float*)(ws + OFF_PEC) + (t & 63) * 512;
      float ss = 0.f;
#pragma unroll
      for (int i = 0; i < 4; ++i) { const int col = 4 * lane + 256 * i; v[r][i] = *(const f32x4*)(xr + col);
        if (smp) v[r][i] += (col < 512) ? *(const f32x4*)(per + col) : *(const f32x4*)(pec + col - 512);
        ss += v[r][i][0] * v[r][i][0] + v[r][i][1] * v[r][i][1] + v[r][i][2] * v[r][i][2] + v[r][i][3] * v[r][i][3]; }
      ss = wave_sum(ss); rstd[r] = rsqrtf(ss * (1.0f / 1024.0f) + 1e-6f); }
    const float* n1w = p.in[9];
    float ga[32];
#pragma unroll
    for (int g = 0; g < 32; ++g) ga[g] = 0.f;
#pragma unroll
    for (int i = 0; i < 4; ++i) { const int col = 4 * lane + 256 * i;
      const f32x4 w = *(const f32x4*)(n1w + col), sc = *(const f32x4*)(md + 1024 + col), sh = *(const f32x4*)(md + col);
      const f32x4 ws1 = w * (sc + 1.0f);
      f32x4 h[2];
#pragma unroll
      for (int r = 0; r < 2; ++r) { h[r] = v[r][i] * rstd[r] * ws1 + sh;
        u32x2 o; o.x = pack2(h[r][0], h[r][1]); o.y = pack2(h[r][2], h[r][3]); *(u32x2*)((bf16_t*)(ws + OFF_HN) + (size_t)(row0 + r) * 1024 + col) = o; }
#pragma unroll
      for (int g = 0; g < 16; ++g) { const f32x4 wv = *(const LAS f32x4*)(wg + g * 1024 + col);
#pragma unroll
        for (int r = 0; r < 2; ++r) ga[r * 16 + g] += h[r][0] * wv[0] + h[r][1] * wv[1] + h[r][2] * wv[2] + h[r][3] * wv[3]; }
      asm volatile("" ::: "memory"); }
#pragma unroll
    for (int off = 16; off >= 1; off >>= 1) { const bool hi = (lane & off) != 0;
#pragma unroll
      for (int i = 0; i < off; ++i) { const float send = hi ? ga[i] : ga[i + off]; const float keep = hi ? ga[i + off] : ga[i]; ga[i] = keep + __shfl_xor(send, off); } }
    const float tot = ga[0] + __shfl_xor(ga[0], 32);
    if (lane < 32) ((float*)(ws + OFF_GT))[(size_t)row0 * 16 + lane] = tot + p.in[11][4096 + (lane & 15)];
  }
  __syncthreads();
}
__device__ void filters_upper_half(const Params& p, LP lds) {
  unsigned char* ws = p.ws; const int nh = (int)gridDim.x >> 1;
  if ((int)blockIdx.x < nh) return;
  LAS float* w3s = (LAS float*)lds;
  for (int v = (int)blockIdx.x - nh; v < 320; v += (int)gridDim.x - nh) {
    const int tid = opaque_tid();
    const bool smp = v < 256; const int L = smp ? 2048 : 256; const int tt = smp ? (v >> 6) : 0, cgp = v & 63; const int t = tt * 512 + tid;
    { const f32x4 x = *(const f32x4*)(p.in[20] + (size_t)(tid >> 3) * 2048 + cgp * 32 + 4 * (tid & 7)); LAS float* wp = w3s + (4 * (tid & 7)) * 64 + (tid >> 3);
      wp[0] = x[0]; wp[64] = x[1]; wp[128] = x[2]; wp[192] = x[3]; }
    __syncthreads();
    if (t < L) {
      const float* H2 = (const float*)(ws + (smp ? OFF_H2S : OFF_H2C)) + (size_t)t * 64;
      f32x4 h2[16];
#pragma unroll
      for (int i = 0; i < 16; ++i) h2[i] = *(const f32x4*)(H2 + 4 * i);
      const float dist = fabsf((float)t - (float)(L / 2)) / (float)(L / 2);
      float* HF = (float*)(ws + (smp ? OFF_HFS : OFF_HFC)) + (size_t)(cgp * 32) * L + t;
#pragma unroll 1
      for (int j = 0; j < 32; ++j) {
        f32x4 a = {0.f, 0.f, 0.f, 0.f};
#pragma unroll
        for (int i = 0; i < 16; ++i) a += *(const LAS f32x4*)(w3s + j * 64 + 4 * i) * h2[i];
        const int c = (cgp * 32 + j) & 1023;
        const float dmin = -3.0701134573253946f, dmax = -15.350567286626973f;
        const float delta = fabsf(dmin + (dmax - dmin) * ((float)c / 1023.0f));
        HF[(size_t)j * L] = ((a[0] + a[1]) + (a[2] + a[3])) * __expf(-dist * delta); }
    }
    __syncthreads();
  }
}
__device__ void c1_upper_half(const Params& p, LP lds) {
  unsigned char* ws = p.ws; const float* mod = (const float*)(ws + OFF_MOD); const int nh = (int)gridDim.x >> 1;
  if ((int)blockIdx.x < nh) return;
  for (int u = (int)blockIdx.x - nh; u < 128; u += (int)gridDim.x - nh)
    matvec9_unit<0>(mod + 3072, mod + 6144 + 3072, 6144, p.in[27], 4096, p.in[28], (float*)(ws + OFF_C1), 4096, u * 32, (LAS float*)lds);
}

__device__ __forceinline__ bf16x8 tr_frag(LP base, int k0, int m0, int pitch  , int l15, int g) {
  const int q = l15 >> 2, pp = l15 & 3;
  LP a = base + ((k0 + 8 * g + q) * pitch + m0 + 4 * pp) * 2;
  const s16x4 lo = __builtin_amdgcn_ds_read_tr16_b64_v4i16((LAS s16x4*)a);
  const s16x4 hi = __builtin_amdgcn_ds_read_tr16_b64_v4i16((LAS s16x4*)(a + 8 * pitch));
  bf16x8 r; r[0] = lo[0]; r[1] = lo[1]; r[2] = lo[2]; r[3] = lo[3]; r[4] = hi[0]; r[5] = hi[1]; r[6] = hi[2]; r[7] = hi[3]; return r;
}
__device__ __forceinline__ bf16x8 tr_at(LP lanebase, int coff  , int pitch_bytes) {
  const s16x4 lo = __builtin_amdgcn_ds_read_tr16_b64_v4i16((LAS s16x4*)(lanebase + coff));
  const s16x4 hi = __builtin_amdgcn_ds_read_tr16_b64_v4i16((LAS s16x4*)(lanebase + coff + 4 * pitch_bytes));
  bf16x8 r; r[0] = lo[0]; r[1] = lo[1]; r[2] = lo[2]; r[3] = lo[3]; r[4] = hi[0]; r[5] = hi[1]; r[6] = hi[2]; r[7] = hi[3]; return r;
}
constexpr int ML_K = 0, ML_V = 67584, ML_P = 86016, ML_C = 120832, ML_T = 157696, ML_TSZ = 1600;
constexpr int KP = 264, VP = 72, PP = 136, CP = 72;

__device__ void mlstm_item(const Params& p, LP lds, int item) {
  const int tid = opaque_tid(), wid = __builtin_amdgcn_readfirstlane(tid >> 6), lane = tid & 63, l15 = lane & 15, g = lane >> 4;
  const bool smp = item < 256; const int uu = smp ? (item >> 2) : ((item - 256) >> 2); const int sl = item & 3;
  const int b = uu >> 3, dir = (uu >> 2) & 1, head = uu & 3;
  const int S = smp ? SEQS : SEQC, nc = S >> 7; const int tok0 = smp ? NCTX + b * SEQS : b * SEQC;
  const bf16_t* qkv = (const bf16_t*)(p.ws + OFF_BIG);
  const float* GT = (const float*)(p.ws + OFF_GT);
  bf16_t* hout = (bf16_t*)((unsigned char*)p.out + (dir ? OUT_HB : OUT_H));
  const int sidx = (b * 2 + dir) * 4 + head;
  const int gi_col = dir * 8 + head, gf_col = dir * 8 + 4 + head;
  f32x4 Cacc[2][4], nacc[2]; float mst0;
  if (smp) {
    const float* C0 = p.in[2] + (size_t)sidx * 65536;
#pragma unroll
    for (int dt = 0; dt < 2; ++dt) {
#pragma unroll
      for (int vt = 0; vt < 4; ++vt) Cacc[dt][vt] = *(const f32x4*)(C0 + (size_t)((2 * wid + dt) * 16 + l15) * 256 + sl * 64 + 16 * vt + 4 * g);
      nacc[dt] = (f32x4){p.in[3][sidx * 256 + (2 * wid + dt) * 16 + l15], 0.f, 0.f, 0.f}; }
    mst0 = p.in[4][sidx];
  } else {
#pragma unroll
    for (int dt = 0; dt < 2; ++dt) {
#pragma unroll
      for (int vt = 0; vt < 4; ++vt) Cacc[dt][vt] = (f32x4){0.f, 0.f, 0.f, 0.f};
      nacc[dt] = (f32x4){0.f, 0.f, 0.f, 0.f}; }
    mst0 = 0.f;
  }
#define TOKC(cc, j) (dir ? (tok0 + S - 1 - ((cc) * 128 + (j))) : (tok0 + (cc) * 128 + (j)))
  const int rt = (wid < 4) ? wid : 11 - wid;
  const int jrow = 16 * rt + l15;
  bf16x8 qf[8]; u32x4 kreg[8], vreg[2]; float g4[4] = {0.f, 0.f, 0.f, 0.f};
#define ML_LOAD_Q(cc) do { const bf16_t* qp = qkv + (size_t)TOKC(cc, jrow) * 3072 + head * 256 + 8 * g; \
    _Pragma("unroll") for (int kk = 0; kk < 8; ++kk) qf[kk] = *(const bf16x8*)(qp + 32 * kk); } while (0)
#define ML_LOAD_KV(cc) do { \
    _Pragma("unroll") for (int i = 0; i < 8; ++i) { const int row = (tid >> 5) + 16 * i; kreg[i] = *(const u32x4*)(qkv + (size_t)TOKC(cc, row) * 3072 + 1024 + head * 256 + (tid & 31) * 8); } \
    _Pragma("unroll") for (int i = 0; i < 2; ++i) { const int row = (tid >> 3) + 64 * i; vreg[i] = *(const u32x4*)(qkv + (size_t)TOKC(cc, row) * 3072 + 2048 + head * 256 + sl * 64 + (tid & 7) * 8); } \
    if (wid == 0) { const float* g0 = GT + (size_t)TOKC(cc, 2 * lane) * 16; const float* g1 = GT + (size_t)TOKC(cc, 2 * lane + 1) * 16; g4[0] = g0[gi_col]; g4[1] = g0[gf_col]; g4[2] = g1[gi_col]; g4[3] = g1[gf_col]; } } while (0)
#define ML_SCAN(tabp, mcur, mnext) do { LAS float* T_ = (LAS float*)(tabp); \
    const float lf0 = fminf(g4[1], 0.f) - log1pf(__expf(-fabsf(g4[1]))), lf1 = fminf(g4[3], 0.f) - log1pf(__expf(-fabsf(g4[3]))); \
    float s_ = lf0 + lf1; \
    _Pragma("unroll") for (int o = 1; o < 64; o <<= 1) { const float t_ = __shfl_up(s_, o); if (lane >= o) s_ += t_; } \
    const float b1_ = s_, b0_ = s_ - lf1; const float u0_ = g4[0] - b0_, u1_ = g4[2] - b1_; \
    float mx_ = fmaxf(u0_, u1_); \
    _Pragma("unroll") for (int o = 1; o < 64; o <<= 1) { const float t_ = __shfl_up(mx_, o); if (lane >= o) mx_ = fmaxf(mx_, t_); } \
    float ex_ = __shfl_up(mx_, 1); if (lane == 0) ex_ = -INFINITY; \
    const float M0_ = fmaxf(mcur, fmaxf(ex_, u0_)), M1_ = fmaxf(mcur, mx_); \
    T_[2 * lane] = u0_; T_[2 * lane + 1] = u1_; T_[128 + 2 * lane] = M0_; T_[128 + 2 * lane + 1] = M1_; T_[256 + 2 * lane] = b0_; T_[256 + 2 * lane + 1] = b1_; \
    const float Ml_ = __shfl(M1_, 63), bl_ = __shfl(b1_, 63); \
    if (lane == 0) { T_[384] = mcur; T_[385] = Ml_; } \
    mnext = bl_ + Ml_; } while (0)
  float mw0 = mst0;
  ML_LOAD_Q(0); ML_LOAD_KV(0);
  if (wid == 0) { float mn; ML_SCAN(lds + ML_T, mw0, mn); mw0 = mn; }
  __syncthreads();
  float m_final = 0.f;
  for (int c = 0; c < nc; ++c) {
    LAS float* T = (LAS float*)(lds + ML_T + (c & 1) * ML_TSZ);
    const float mst = T[384], M_last = T[385];
#pragma unroll
    for (int i = 0; i < 8; ++i) { const int row = (tid >> 5) + 16 * i; *(LAS u32x4*)(lds + ML_K + (row * KP + (tid & 31) * 8) * 2) = kreg[i]; }
#pragma unroll
    for (int i = 0; i < 2; ++i) { const int row = (tid >> 3) + 64 * i; const float w = __expf(T[row] - M_last); const u32x4 v = vreg[i]; u32x4 o;
      o.x = pack2(bflo(v.x) * w, bfhi(v.x) * w); o.y = pack2(bflo(v.y) * w, bfhi(v.y) * w); o.z = pack2(bflo(v.z) * w, bfhi(v.z) * w); o.w = pack2(bflo(v.w) * w, bfhi(v.w) * w);
      *(LAS u32x4*)(lds + ML_V + (row * VP + (tid & 7) * 8) * 2) = o; }
    if (tid < 128) *(LAS unsigned short*)(lds + ML_V + (tid * VP + 64) * 2) = f2bf(__expf(T[tid] - M_last));
#pragma unroll
    for (int dt = 0; dt < 2; ++dt) {
#pragma unroll
      for (int vt = 0; vt < 4; ++vt) { u32x2 w; w.x = pack2(Cacc[dt][vt][0], Cacc[dt][vt][1]); w.y = pack2(Cacc[dt][vt][2], Cacc[dt][vt][3]);
        *(LAS u32x2*)(lds + ML_C + (((2 * wid + dt) * 16 + l15) * CP + 16 * vt + 4 * g) * 2) = w; }
      if (g == 0) *(LAS unsigned short*)(lds + ML_C + (((2 * wid + dt) * 16 + l15) * CP + 64) * 2) = f2bf(nacc[dt][0]); }
    const int qtok = TOKC(c, jrow);
    const bool more = (c + 1 < nc);
    __syncthreads();
    const float Mj = T[128 + jrow], bj = T[256 + jrow]; const float rf = __expf(M_last - Mj), w_inter = __expf(mst - Mj);
    int lq_ = (8 * g + (l15 >> 2)), lp_ = 4 * (l15 & 3); asm volatile("" : "+v"(lq_), "+v"(lp_));
    const LP cB = lds + ML_C + (lq_ * CP + lp_) * 2, vB = lds + ML_V + (lq_ * VP + lp_) * 2, kB = lds + ML_K + (lq_ * KP + lp_ + 32 * wid) * 2;
    const LP pB = lds + ML_P + (jrow * PP + 8 * g) * 2;
    for (int st = 0; st <= rt; ++st) {
      f32x4 s = {0.f, 0.f, 0.f, 0.f};
      bf16x8 kfr[8];
#pragma unroll
      for (int kk = 0; kk < 8; ++kk) kfr[kk] = *(const LAS bf16x8*)(lds + ML_K + ((16 * st + l15) * KP + 32 * kk + 8 * g) * 2);
      __builtin_amdgcn_sched_barrier(0);
#pragma unroll
      for (int kk = 0; kk < 8; ++kk) s = __builtin_amdgcn_mfma_f32_16x16x32_bf16(kfr[kk], qf[kk], s, 0, 0, 0);
      float pv[4];
#pragma unroll
      for (int i = 0; i < 4; ++i) pv[i] = ((16 * st + 4 * g + i) <= jrow) ? s[i] * rf : 0.f;
      u32x2 w; w.x = pack2(pv[0], pv[1]); w.y = pack2(pv[2], pv[3]);
      *(LAS u32x2*)(lds + ML_P + (jrow * PP + 16 * st + 4 * g) * 2) = w;
    }
    if ((rt & 1) == 0) { u32x2 z; z.x = 0u; z.y = 0u; *(LAS u32x2*)(lds + ML_P + (jrow * PP + 16 * (rt + 1) + 4 * g) * 2) = z; }
    if (more) ML_LOAD_KV(c + 1);
    asm volatile("s_waitcnt lgkmcnt(0)" ::: "memory");
    f32x4 ha[5];
#pragma unroll
    for (int vt = 0; vt < 5; ++vt) { f32x4 a = {0.f, 0.f, 0.f, 0.f};
      if (smp || c > 0) {
        bf16x8 cfr[8];
#pragma unroll
        for (int kk = 0; kk < 8; ++kk) cfr[kk] = tr_at(cB, (32 * kk * CP + 16 * vt) * 2, CP * 2);
        __builtin_amdgcn_sched_barrier(0);
#pragma unroll
        for (int kk = 0; kk < 8; ++kk) a = __builtin_amdgcn_mfma_f32_16x16x32_bf16(cfr[kk], qf[kk], a, 0, 0, 0);
        a *= w_inter; }
      ha[vt] = a; }
    for (int k2 = 0; k2 <= (rt >> 1); ++k2) {
      const bf16x8 pf = *(const LAS bf16x8*)(pB + k2 * 64);
      bf16x8 vfr[5];
#pragma unroll
      for (int vt = 0; vt < 5; ++vt) vfr[vt] = tr_at(vB + k2 * (32 * VP * 2), (16 * vt) * 2, VP * 2);
      __builtin_amdgcn_sched_barrier(0);
#pragma unroll
      for (int vt = 0; vt < 5; ++vt) ha[vt] = __builtin_amdgcn_mfma_f32_16x16x32_bf16(vfr[vt], pf, ha[vt], 0, 0, 0); }
    { const float den = __shfl(ha[4][0], l15); const float rdd = 1.0f / fmaxf(fabsf(den), __expf(-(bj + Mj)));
#pragma unroll
      for (int vt = 0; vt < 4; ++vt) { const f32x4 a = ha[vt] * rdd; u32x2 w; w.x = pack2(a[0], a[1]); w.y = pack2(a[2], a[3]);
        *(u32x2*)(hout + (size_t)qtok * 1024 + head * 256 + sl * 64 + 16 * vt + 4 * g) = w; } }
    if (more) ML_LOAD_Q(c + 1);
    const bool need_state = (!smp) || more;
    if (need_state) {
      const float decay = __expf(mst - M_last);
#pragma unroll
      for (int dt = 0; dt < 2; ++dt) {
#pragma unroll
        for (int vt = 0; vt < 4; ++vt) Cacc[dt][vt] *= decay;
        nacc[dt] *= decay; }
#pragma unroll
      for (int ks = 0; ks < 4; ++ks) {
        const bf16x8 kf0 = tr_at(kB, (32 * ks * KP) * 2, KP * 2), kf1 = tr_at(kB, (32 * ks * KP + 16) * 2, KP * 2);
        bf16x8 vfr[5];
#pragma unroll
        for (int vt = 0; vt < 5; ++vt) vfr[vt] = tr_at(vB, (32 * ks * VP + 16 * vt) * 2, VP * 2);
        __builtin_amdgcn_sched_barrier(0);
#pragma unroll
        for (int vt = 0; vt < 4; ++vt) { Cacc[0][vt] = __builtin_amdgcn_mfma_f32_16x16x32_bf16(vfr[vt], kf0, Cacc[0][vt], 0, 0, 0); Cacc[1][vt] = __builtin_amdgcn_mfma_f32_16x16x32_bf16(vfr[vt], kf1, Cacc[1][vt], 0, 0, 0); }
        nacc[0] = __builtin_amdgcn_mfma_f32_16x16x32_bf16(vfr[4], kf0, nacc[0], 0, 0, 0); nacc[1] = __builtin_amdgcn_mfma_f32_16x16x32_bf16(vfr[4], kf1, nacc[1], 0, 0, 0);
      }
    }
    if (wid == 0 && more) { float mn; ML_SCAN(lds + ML_T + ((c + 1) & 1) * ML_TSZ, mw0, mn); mw0 = mn; }
    m_final = T[256 + 127] + M_last;
    __syncthreads();
  }
#undef ML_LOAD_Q
#undef ML_LOAD_KV
#undef ML_SCAN
#undef TOKC
  if (!smp) {
    float* oC = p.out + OUTF_C + (size_t)sidx * 65536;
#pragma unroll
    for (int dt = 0; dt < 2; ++dt) {
#pragma unroll
      for (int vt = 0; vt < 4; ++vt) *(f32x4*)(oC + (size_t)((2 * wid + dt) * 16 + l15) * 256 + sl * 64 + 16 * vt + 4 * g) = Cacc[dt][vt];
      if (sl == 0 && g == 0) p.out[OUTF_N + (size_t)sidx * 256 + (2 * wid + dt) * 16 + l15] = nacc[dt][0]; }
    if (sl == 0 && tid == 0) p.out[OUTF_M + sidx] = m_final;
  }
}

__device__ void combine_rows(const Params& p) {
  const int tid0 = opaque_tid(); const int wid = tid0 >> 6, lane = tid0 & 63;
  bf16_t* H = (bf16_t*)((unsigned char*)p.out + OUT_H); const bf16_t* HB = (const bf16_t*)((unsigned char*)p.out + OUT_HB); const float* nw = p.in[22];
  f32x4 wv[4];
#pragma unroll
  for (int i = 0; i < 4; ++i) wv[i] = *(const f32x4*)(nw + 16 * lane + 4 * i);
  const int nh = (int)gridDim.x >> 1;
  if ((int)blockIdx.x < nh) return;
  for (int unit = (int)blockIdx.x - nh; unit < 768; unit += (int)gridDim.x - nh) {
    const int row0 = unit * 32 + wid * 4;
    u32x4 a[4][2], bq[4][2];
#pragma unroll
    for (int r = 0; r < 4; ++r)
#pragma unroll
      for (int i = 0; i < 2; ++i) { a[r][i] = *(const u32x4*)(H + (size_t)(row0 + r) * 1024 + 16 * lane + 8 * i); bq[r][i] = *(const u32x4*)(HB + (size_t)(row0 + r) * 1024 + 16 * lane + 8 * i); }
#pragma unroll
    for (int r = 0; r < 4; ++r) {
      f32x4 v[4]; float ss = 0.f;
#pragma unroll
      for (int i = 0; i < 2; ++i) { f32x4 x0, x1, y0, y1; unpack8(a[r][i], x0, x1); unpack8(bq[r][i], y0, y1); v[2 * i] = x0 + y0; v[2 * i + 1] = x1 + y1; }
#pragma unroll
      for (int i = 0; i < 4; ++i) ss += v[i][0] * v[i][0] + v[i][1] * v[i][1] + v[i][2] * v[i][2] + v[i][3] * v[i][3];
      ss += __shfl_xor(ss, 1); ss += __shfl_xor(ss, 2); ss += __shfl_xor(ss, 4); ss += __shfl_xor(ss, 8);
      const float rr = rsqrtf(ss * (1.0f / 256.0f) + 1e-6f);
#pragma unroll
      for (int i = 0; i < 2; ++i) *(u32x4*)(H + (size_t)(row0 + r) * 1024 + 16 * lane + 8 * i) = pack8(v[2 * i] * rr * wv[2 * i], v[2 * i + 1] * rr * wv[2 * i + 1]);
    }
  }
}

constexpr int HY_WAVE = 18816, HY_HR = 0, HY_ZA = 8576, HY_ZB = 8576 + 5120;
__device__ void hyena_item(const Params& p, LP lds, int item) {
  const int tid = opaque_tid(), wid = __builtin_amdgcn_readfirstlane(tid >> 6), lane = tid & 63, n31 = lane & 31, hh = lane >> 5;
  const bool smp = item < 1024; const int it = smp ? item : item - 1024; const int bset = it >> 7, cgp = it & 127; const int c = cgp * 8 + wid;
  const int L = smp ? 2048 : 256, lgL = smp ? 11 : 8, nblk = L >> 5, lgnb = lgL - 5, ntok = 2048, ntile = 2, dmax = L >> 6;
  const int tok0 = smp ? NCTX + bset * 2048 : bset * 2048;
  LP wl = lds + wid * HY_WAVE; LAS float* hr = (LAS float*)(wl + HY_HR);
  const float* HFp = (const float*)(p.ws + (smp ? OFF_HFS : OFF_HFC));
  const bf16_t* UT = (const bf16_t*)(p.ws + OFF_BIG);
  const float* cw = p.in[12]; const float* cbv = p.in[13]; const float* skp = p.in[21];
  { const int uc = 2048 + c; const float w0 = cw[uc], w1 = cw[3072 + uc], w2 = cw[6144 + uc], cb = cbv[uc]; const bf16_t* src = UT + (size_t)uc * NTOK + tok0;
    u32x4 vv[4]; float pvv[4], nxv[4];
#pragma unroll
    for (int i = 0; i < 4; ++i) { const int base = lane * 8 + 512 * i; vv[i] = (u32x4){0u, 0u, 0u, 0u}; pvv[i] = 0.f; nxv[i] = 0.f;
      if (base < ntok) { vv[i] = *(const u32x4*)(src + base); const int tl = base & (L - 1);
        if (tl != 0) pvv[i] = bf2f(src[base - 1]); if (tl + 8 != L) nxv[i] = bf2f(src[base + 8]); } }
#pragma unroll
    for (int i = 0; i < 4; ++i) { const int base = lane * 8 + 512 * i;
      if (base < ntok) { const u32x4 v = vv[i];
        float u[10]; u[0] = pvv[i]; u[1] = bflo(v.x); u[2] = bfhi(v.x); u[3] = bflo(v.y); u[4] = bfhi(v.y); u[5] = bflo(v.z); u[6] = bfhi(v.z); u[7] = bflo(v.w); u[8] = bfhi(v.w); u[9] = nxv[i];
        float o[8];
#pragma unroll
        for (int e = 0; e < 8; ++e) o[e] = cb + w0 * u[e] + w1 * u[e + 1] + w2 * u[e + 2];
        u32x4 w; w.x = pack2(o[0], o[1]); w.y = pack2(o[2], o[3]); w.z = pack2(o[4], o[5]); w.w = pack2(o[6], o[7]);
        *(LAS u32x4*)(wl + HY_ZA + ((base >> 5) * 40 + (base & 31)) * 2) = w; } } }
  const int HRP = L + 96;
  f32x4 fvN[8];
#define HY_FLOAD(o) do { const float* src_ = HFp + (size_t)((o) * 1024 + c) * L; \
    _Pragma("unroll") for (int i = 0; i < 8; ++i) { const int q = lane + 64 * i; fvN[i] = (4 * q < L) ? *(const f32x4*)(src_ + 4 * q) : (f32x4){0.f, 0.f, 0.f, 0.f}; } } while (0)
  HY_FLOAD(0);
  for (int ord = 0; ord < 2; ++ord) {
    { float sa = 0.f;
      f32x4 fv[8];
#pragma unroll
      for (int i = 0; i < 8; ++i) fv[i] = fvN[i];
#pragma unroll
      for (int i = 0; i < 8; ++i) sa += (fabsf(fv[i][0]) + fabsf(fv[i][1])) + (fabsf(fv[i][2]) + fabsf(fv[i][3]));
      sa = wave_sum(sa); const float inv = 1.0f / (sa + 1e-6f);
      asm volatile("s_waitcnt lgkmcnt(0)" ::: "memory");
      LAS bf16_t* E = (LAS bf16_t*)hr; LAS bf16_t* O = E + HRP;
#pragma unroll
      for (int i = 0; i < 8; ++i) { const int q = lane + 64 * i;
        if (4 * q < L) {
#pragma unroll
          for (int e = 0; e < 4; ++e) { const int yy = L - 1 - (4 * q + e); const bf16_t v = f2bf(fv[i][e] * inv); E[32 + yy] = v; O[31 + yy] = v; } } }
      if (lane < 32) { E[lane] = 0; E[32 + L + lane] = 0; O[31 + L + lane] = 0; if (lane < 31) O[lane] = 0; }
      if (lane < 33) O[HRP - 33 + lane] = 0;
      asm volatile("s_waitcnt lgkmcnt(0)" ::: "memory"); }
    if (ord == 0) HY_FLOAD(1);
    LP zin = wl + (ord == 0 ? HY_ZA : HY_ZB); LP zout = wl + (ord == 0 ? HY_ZB : HY_ZA);
    const int gc = ord * 1024 + c; const float w0 = cw[gc], w1 = cw[3072 + gc], w2 = cw[6144 + gc], cb = cbv[gc], sk = skp[ord * 1024 + c];
    const bf16_t* gsrc = UT + (size_t)gc * NTOK + tok0;
    u32x4 gv[4]; unsigned gpv[4], gnx[4];
#pragma unroll
    for (int i = 0; i < 4; ++i) { const int base = lane * 8 + 512 * i; gv[i] = (u32x4){0u, 0u, 0u, 0u}; gpv[i] = 0u; gnx[i] = 0u;
      if (base < ntok) { gv[i] = *(const u32x4*)(gsrc + base); const int tl = base & (L - 1);
        if (tl != 0) gpv[i] = gsrc[base - 1]; if (tl + 8 != L) gnx[i] = gsrc[base + 8]; } }
    f32x16 accs[2];
#pragma unroll
    for (int o2 = 0; o2 < 2; ++o2)
#pragma unroll
      for (int r = 0; r < 16; ++r) accs[o2][r] = 0.f;
    LP fb = wl + HY_HR + ((n31 & 1) ? 0 : (HRP * 2 - 2)) + 2 * ((L >> 1) - 1 - n31 + 8 * hh + 32);
    int cbl[2], ca[2];
#pragma unroll
    for (int ot = 0; ot < 2; ++ot) { const int col = 32 * ot + n31; cbl[ot] = (col >> lgnb) << lgnb; ca[ot] = col & (nblk - 1); }
    const bool two = (ntile == 2);
    {
      LP zero = wl + HY_HR + 16 * hh;
      LP ap = fb + 64 * dmax;
      int bbr0 = ca[0] + dmax, bbr1 = ca[1] + dmax;
      LP bp0 = zin + ((cbl[0] + bbr0) * 40 + 8 * hh) * 2, bp1 = zin + ((cbl[1] + bbr1) * 40 + 8 * hh) * 2;
      for (int d = -dmax; d <= dmax; ++d) {
        u32x4 w0v, w1v;
        w0v.x = *(const LAS unsigned*)(ap); w0v.y = *(const LAS unsigned*)(ap + 4); w0v.z = *(const LAS unsigned*)(ap + 8); w0v.w = *(const LAS unsigned*)(ap + 12);
        w1v.x = *(const LAS unsigned*)(ap + 32); w1v.y = *(const LAS unsigned*)(ap + 36); w1v.z = *(const LAS unsigned*)(ap + 40); w1v.w = *(const LAS unsigned*)(ap + 44);
        const bf16x8 af0 = __builtin_bit_cast(bf16x8, w0v), af1 = __builtin_bit_cast(bf16x8, w1v);
        LP q0 = ((unsigned)bbr0 < (unsigned)nblk) ? bp0 : zero;
        LP q1 = (two && ((unsigned)bbr1 < (unsigned)nblk)) ? bp1 : zero;
        const bf16x8 b00 = *(const LAS bf16x8*)q0, b01 = *(const LAS bf16x8*)(q0 + 32);
        const bf16x8 b10 = *(const LAS bf16x8*)q1, b11 = *(const LAS bf16x8*)(q1 + 32);
        __builtin_amdgcn_sched_barrier(0);
        accs[0] = __builtin_amdgcn_mfma_f32_32x32x16_bf16(af0, b00, accs[0], 0, 0, 0);
        if (two) accs[1] = __builtin_amdgcn_mfma_f32_32x32x16_bf16(af0, b10, accs[1], 0, 0, 0);
        accs[0] = __builtin_amdgcn_mfma_f32_32x32x16_bf16(af1, b01, accs[0], 0, 0, 0);
        if (two) accs[1] = __builtin_amdgcn_mfma_f32_32x32x16_bf16(af1, b11, accs[1], 0, 0, 0);
        ap -= 64; bbr0 -= 1; bbr1 -= 1; bp0 -= 80; bp1 -= 80;
      }
    }
#pragma unroll
    for (int ot = 0; ot < 2; ++ot) {
      if (ot >= ntile) continue;
      const f32x16 acc = accs[ot];
#pragma unroll
      for (int rg = 0; rg < 4; ++rg) {
        const int zo = (((cbl[ot] + ca[ot]) * 40) + 8 * rg + 4 * hh) * 2;
        const u32x2 zv = *(const LAS u32x2*)(zin + zo);
        u32x2 w; w.x = pack2(acc[4 * rg] + sk * bflo(zv.x), acc[4 * rg + 1] + sk * bfhi(zv.x)); w.y = pack2(acc[4 * rg + 2] + sk * bflo(zv.y), acc[4 * rg + 3] + sk * bfhi(zv.y));
        *(LAS u32x2*)(zout + zo) = w;
      }
    }
    asm volatile("s_waitcnt lgkmcnt(0)" ::: "memory");
#pragma unroll
    for (int i = 0; i < 4; ++i) { const int base = lane * 8 + 512 * i;
      if (base < ntok) { const u32x4 v = gv[i];
        float u[10]; u[0] = bf2f(gpv[i]); u[1] = bflo(v.x); u[2] = bfhi(v.x); u[3] = bflo(v.y); u[4] = bfhi(v.y); u[5] = bflo(v.z); u[6] = bfhi(v.z); u[7] = bflo(v.w); u[8] = bfhi(v.w); u[9] = bf2f(gnx[i]);
        LP zp = zout + ((base >> 5) * 40 + (base & 31)) * 2; const u32x4 t = *(const LAS u32x4*)zp;
        float tv[8]; tv[0] = bflo(t.x); tv[1] = bfhi(t.x); tv[2] = bflo(t.y); tv[3] = bfhi(t.y); tv[4] = bflo(t.z); tv[5] = bfhi(t.z); tv[6] = bflo(t.w); tv[7] = bfhi(t.w);
        float o[8];
#pragma unroll
        for (int e = 0; e < 8; ++e) o[e] = (cb + w0 * u[e] + w1 * u[e + 1] + w2 * u[e + 2]) * tv[e];
        u32x4 w; w.x = pack2(o[0], o[1]); w.y = pack2(o[2], o[3]); w.z = pack2(o[4], o[5]); w.w = pack2(o[6], o[7]);
        *(LAS u32x4*)zp = w; } }
    asm volatile("s_waitcnt lgkmcnt(0)" ::: "memory");
  }
  __syncthreads();
  { bf16_t* YH = (bf16_t*)((unsigned char*)p.out + OUT_HB);
    for (int tl = tid; tl < ntok; tl += 512) {
      const int bl = tl >> lgL, tloc = tl & (L - 1); const int zo = ((((bl << lgnb) + (tloc >> 5)) * 40) + (tloc & 31)) * 2;
      unsigned short e[8];
#pragma unroll
      for (int w = 0; w < 8; ++w) e[w] = *(const LAS unsigned short*)(lds + w * HY_WAVE + HY_ZA + zo);
      u32x4 o; o.x = e[0] | ((unsigned)e[1] << 16); o.y = e[2] | ((unsigned)e[3] << 16); o.z = e[4] | ((unsigned)e[5] << 16); o.w = e[6] | ((unsigned)e[7] << 16);
      *(u32x4*)(YH + (size_t)(tok0 + tl) * 1024 + cgp * 8) = o; } }
  __syncthreads();
}

__device__ void final_norm(const Params& p) {
  const int tid0 = opaque_tid(); const int wid = tid0 >> 6, lane = tid0 & 63; const float* fw = p.in[31];
  const float* P = (const float*)(p.ws + OFF_BIG + (size_t)8192 * 4096 * 2); const float* mod = (const float*)(p.ws + OFF_MOD);
  f32x4 wv[4];
#pragma unroll
  for (int i = 0; i < 4; ++i) wv[i] = *(const f32x4*)(fw + 4 * lane + 256 * i);
  for (int unit = blockIdx.x; unit < 768; unit += gridDim.x) {
    const int row0 = unit * 32 + wid * 4; const bool chunkB = row0 >= 16384;
    f32x4 x[4][4];
#pragma unroll
    for (int r = 0; r < 4; ++r)
#pragma unroll
      for (int i = 0; i < 4; ++i) x[r][i] = *(const f32x4*)(p.out + (size_t)(row0 + r) * 1024 + 4 * lane + 256 * i);
    if (chunkB) { const float* md = mod + cond_of_row(row0) * 6144 + 5120;
#pragma unroll
      for (int i = 0; i < 4; ++i) { const f32x4 g2 = *(const f32x4*)(md + 4 * lane + 256 * i);
#pragma unroll
        for (int r = 0; r < 4; ++r) x[r][i] += g2 * *(const f32x4*)(P + (size_t)(row0 + r - 16384) * 1024 + 4 * lane + 256 * i); } }
#pragma unroll
    for (int r = 0; r < 4; ++r) { float ss = 0.f;
#pragma unroll
      for (int i = 0; i < 4; ++i) ss += x[r][i][0] * x[r][i][0] + x[r][i][1] * x[r][i][1] + x[r][i][2] * x[r][i][2] + x[r][i][3] * x[r][i][3];
      ss = wave_sum(ss); const float rstd = rsqrtf(ss * (1.0f / 1024.0f) + 1e-6f);
#pragma unroll
      for (int i = 0; i < 4; ++i) *(f32x4*)(p.out + (size_t)(row0 + r) * 1024 + 4 * lane + 256 * i) = x[r][i] * rstd * wv[i]; }
  }
}

__global__ void __launch_bounds__(512, 2) __attribute__((flatten)) mega(Params p) {
  extern __shared__ __attribute__((aligned(16))) unsigned char shm[];
  LP lds = (LP)shm;
  cg::grid_group grid = cg::this_grid();
  volatile LAS unsigned* xst = (volatile LAS unsigned*)(lds + LDS_BYTES - 16);
  if (threadIdx.x == 0) { xst[0] = 0u; xst[1] = 0u; }
  __syncthreads();
  const XcdBarrier xb = xcd_barrier_post((unsigned*)(p.ws + OFF_BAR), xst);
  unsigned char* ws = p.ws;
  const bf16_t* WT = (const bf16_t*)(ws + OFF_WT); const bf16_t* HN = (const bf16_t*)(ws + OFF_HN); bf16_t* BIG = (bf16_t*)(ws + OFF_BIG);
  bf16_t* Hb = (bf16_t*)((unsigned char*)p.out + OUT_H); bf16_t* YH = (bf16_t*)((unsigned char*)p.out + OUT_HB);
  const float* mod = (const float*)(ws + OFF_MOD);
  phase0(p, lds);
  if (gridDim.y == 7u) grid.sync();
  xcd_barrier(xb);
  phase1(p, lds);
  weight_tiles(p, lds, 0, 384, 0);
  xcd_barrier(xb);
  filters_upper_half(p, lds);
  weight_tiles(p, lds, 384, 768, 1);
  { EpiQKV e; e.O = BIG; e.bias = p.in[11]; run_gemm(lds, HN, WT, NTOK, 3072, 1024, e); }
  xcd_barrier(xb);
  for (int item = blockIdx.x; item < 1280; item += gridDim.x) mlstm_item(p, lds, item);
  xcd_barrier(xb);
  combine_rows(p);
  weight_tiles(p, lds, 768, 1152, 1);
  { EpiUT e; e.O = BIG; e.bias = p.in[11] + 4112; run_gemm(lds, WT + (size_t)3072 * 1024, HN, 3072, NTOK, 1024, e); }
  xcd_barrier(xb);
  for (int item = blockIdx.x; item < 1536; item += gridDim.x) hyena_item(p, lds, item);
  xcd_barrier(xb);
  c1_upper_half(p, lds);
  weight_tiles(p, lds, 1152, 1536, 1);
  { EpiGates e; e.H = Hb; e.G = BIG; e.b_in = p.in[11]; run_gemm(lds, HN, WT + (size_t)6144 * 1024, NTOK, 3072, 1024, e); }
  xcd_barrier(xb);
  bf16_t* T = BIG + (size_t)NTOK * 2048;
  weight_tiles(p, lds, 1536, 2560, 1);
  { EpiMerge<0> e; e.T = T; e.G = BIG; run_gemm(lds, Hb, (const bf16_t*)(ws + OFF_WBM), NTOK, 1024, 1024, e); }
  { EpiMerge<1> e; e.T = T; e.G = BIG; run_gemm(lds, YH, (const bf16_t*)(ws + OFF_WBH), NTOK, 1024, 1024, e); }
  xcd_barrier(xb);
  { EpiOut e; e.xp = p.in[0]; e.xs = p.in[1]; e.per = (const float*)(ws + OFF_PER); e.pec = (const float*)(ws + OFF_PEC); e.mod = mod; e.n2w = p.in[26];
    e.X1 = p.out; e.A2 = (bf16_t*)(ws + OFF_HN); e.ssq = (float*)(ws + OFF_SSQ1); run_gemm(lds, T, (const bf16_t*)(ws + OFF_WOUT), NTOK, 1024, 1024, e); }
  xcd_barrier(xb);
  constexpr int ROWS_A = 16384, ROWS_B = NTOK - ROWS_A;
  { EpiFF1 e; e.row0 = 0; e.ssq = (const float*)(p.ws + OFF_SSQ1); e.c1 = (const float*)(p.ws + OFF_C1); e.Hd = (bf16_t*)(p.ws + OFF_BIG);
    run_gemm(lds, (const bf16_t*)(p.ws + OFF_HN), (const bf16_t*)(p.ws + OFF_W1T), ROWS_A, 4096, 1024, e); }
  xcd_barrier(xb);
  { EpiFF2 e; e.row0 = 0; e.mod = (const float*)(p.ws + OFF_MOD); e.b2 = p.in[30]; e.X = p.out; e.P = (float*)(p.ws + OFF_BIG + (size_t)ROWS_A * 4096 * 2);
    run_gemm(lds, (const bf16_t*)(p.ws + OFF_BIG), (const bf16_t*)(p.ws + OFF_W2T), ROWS_A, 1024, 4096, e); }
  xcd_barrier(xb);
  { EpiFF1 e; e.row0 = ROWS_A; e.ssq = (const float*)(p.ws + OFF_SSQ1); e.c1 = (const float*)(p.ws + OFF_C1); e.Hd = (bf16_t*)(p.ws + OFF_BIG);
    run_gemm(lds, (const bf16_t*)(p.ws + OFF_HN) + (size_t)ROWS_A * 1024, (const bf16_t*)(p.ws + OFF_W1T), ROWS_B, 4096, 1024, e); }
  xcd_barrier(xb);
  { EpiFF2 e; e.row0 = ROWS_A; e.mod = (const float*)(p.ws + OFF_MOD); e.b2 = p.in[30]; e.X = p.out; e.P = (float*)(p.ws + OFF_BIG + (size_t)ROWS_B * 4096 * 2);
    run_gemm(lds, (const bf16_t*)(p.ws + OFF_BIG), (const bf16_t*)(p.ws + OFF_W2T), ROWS_B, 1024, 4096, e, 2); }
  xcd_barrier(xb);
  final_norm(p);
}

extern "C" void kernel_launch(void* const* d_in, const int* in_sizes, int n_in, void* d_out, int out_size, void* d_ws, size_t ws_size, hipStream_t stream) {
  static int grid_blocks = 0;
  if (!grid_blocks) {
    int dev = 0, cus = 0, per_cu = 0;
    hipGetDevice(&dev);
    hipDeviceGetAttribute(&cus, hipDeviceAttributeMultiprocessorCount, dev);
    hipFuncSetAttribute((const void*)mega, hipFuncAttributeMaxDynamicSharedMemorySize, LDS_BYTES);
    hipOccupancyMaxActiveBlocksPerMultiprocessor(&per_cu, (const void*)mega, 512, LDS_BYTES);
    if (per_cu < 1) { fprintf(stderr, "kernel_launch: occupancy query reports %d blocks per CU\n", per_cu); grid_blocks = -1; }
    else grid_blocks = cus;
    if (n_in != 32 || ws_size < WS_END) { fprintf(stderr, "kernel_launch: unexpected n_in %d / ws_size %zu (need %zu)\n", n_in, ws_size, (size_t)WS_END); grid_blocks = -1; }
  }
  if (grid_blocks < 0) return;
  hipMemsetAsync((unsigned char*)d_ws + OFF_BAR, 0, 3456 * 4, stream);
  Params p{};
  for (int i = 0; i < 32; ++i) p.in[i] = (const float*)d_in[i];
  p.out = (float*)d_out; p.ws = (unsigned char*)d_ws;
  void* args[] = {&p};
  hipError_t e = hipLaunchCooperativeKernel((void*)mega, dim3(grid_blocks), dim3(512), args, LDS_BYTES, stream);
  if (e != hipSuccess) fprintf(stderr, "cooperative launch failed: %s (grid %d)\n", hipGetErrorString(e), grid_blocks);
}
```

```cpp
#include <hip/hip_runtime.h>
#include <hip/hip_cooperative_groups.h>
#include <cstdio>
#include <cstdint>
namespace cg = cooperative_groups;

#define LAS __attribute__((address_space(3)))
typedef LAS unsigned char* LP;
typedef unsigned short bf16_t;
typedef short bf16x8 __attribute__((ext_vector_type(8)));
typedef short s16x4 __attribute__((ext_vector_type(4)));
typedef float f32x4 __attribute__((ext_vector_type(4)));
typedef float f32x16 __attribute__((ext_vector_type(16)));
typedef unsigned u32x4 __attribute__((ext_vector_type(4)));
typedef unsigned u32x2 __attribute__((ext_vector_type(2)));

constexpr int DM = 1024, NTOK = 24576, NCTX = 8192, SEQC = 256, SEQS = 2048, INC = 9232;
constexpr int LDS_BYTES = 160 * 1024;
constexpr size_t OFF_WT = 0;
constexpr size_t OFF_WBM = 18874368, OFF_WBH = 20971520, OFF_WOUT = 23068672, OFF_W1T = 25165824, OFF_W2T = 33554432;
constexpr size_t OFF_HN = 41943040;
constexpr size_t OFF_BIG = 92274688;
constexpr size_t OFF_SM = 243269632;
constexpr size_t OFF_MOD = OFF_SM;
constexpr size_t OFF_C1 = OFF_MOD + 221184;
constexpr size_t OFF_H2S = OFF_C1 + 147456;
constexpr size_t OFF_H2C = OFF_H2S + 524288;
constexpr size_t OFF_PER = OFF_H2C + 65536;
constexpr size_t OFF_PEC = OFF_PER + 65536;
constexpr size_t OFF_GT = OFF_PEC + 131072;
constexpr size_t OFF_SSQ1 = OFF_GT + 1572864;
constexpr size_t OFF_SSQ2 = OFF_SSQ1 + 1572864;
constexpr size_t OFF_HFS = OFF_SSQ2 + 1572864;
constexpr size_t OFF_HFC = OFF_HFS + 16777216;
constexpr size_t OFF_BAR = OFF_HFC + 2097152;
constexpr size_t WS_END = OFF_BAR + 3456 * 4;
constexpr size_t OUT_H = 0, OUT_HB = 50331648;
constexpr size_t OUTF_C = 25165824, OUTF_N = 41943040, OUTF_M = 42008576;

struct Params { const float* in[32]; float* out; unsigned char* ws; };

typedef float f32x2 __attribute__((ext_vector_type(2)));
typedef __bf16 bf16x2v __attribute__((ext_vector_type(2)));
__device__ __forceinline__ bf16_t f2bf(float f) { const __bf16 b = (__bf16)f; return __builtin_bit_cast(unsigned short, b); }
__device__ __forceinline__ float bf2f(unsigned b) { return __uint_as_float(b << 16); }
__device__ __forceinline__ unsigned pack2(float lo, float hi) { const f32x2 v = {lo, hi}; const bf16x2v r = __builtin_convertvector(v, bf16x2v); return __builtin_bit_cast(unsigned, r); }
__device__ __forceinline__ float bflo(unsigned w) { return __uint_as_float(w << 16); }
__device__ __forceinline__ float bfhi(unsigned w) { return __uint_as_float(w & 0xffff0000u); }
__device__ __forceinline__ float sigmoidf_(float x) { return __builtin_amdgcn_rcpf(1.0f + __expf(-x)); }
__device__ __forceinline__ int opaque_tid() { int t = threadIdx.x; asm volatile("" : "+v"(t)); return t; }
__device__ __forceinline__ float wave_sum(float v) {
#pragma unroll
  for (int o = 32; o >= 1; o >>= 1) v += __shfl_xor(v, o);
  return v;
}


#define XB_TMO      128
#define XB_XCNT(j)  (256  + 64 * (j))
#define XB_XSUB(j)  (1280 + 64 * (j))
#define XB_XGEN(j)  (2304 + 64 * (j))
#define XB_TOP      3328
#define XB_TOPGEN   3392
#define XCD_BAR_WORDS 3456
#define XB_SPIN_CAP (1u << 18)
__device__ __forceinline__ unsigned xb_ld(unsigned* p)              { return __hip_atomic_load(p, __ATOMIC_RELAXED, __HIP_MEMORY_SCOPE_AGENT); }
__device__ __forceinline__ unsigned xb_add(unsigned* p, unsigned v) { return __hip_atomic_fetch_add(p, v, __ATOMIC_RELAXED, __HIP_MEMORY_SCOPE_AGENT); }
__device__ __forceinline__ unsigned xb_xcc_id() { return (unsigned)__builtin_amdgcn_s_getreg((3 << 11) | 20) & 0xFu; }
#define XB_SPIN(cond, bar) do { unsigned _sp = 0; while (cond) { __builtin_amdgcn_s_sleep(1); \
    if ((++_sp & 255u) == 0u) { if (xb_ld(&(bar)[XB_TMO])) break; if (_sp > XB_SPIN_CAP) { atomicAdd(&(bar)[XB_TMO], 1u); break; } } } } while (0)
struct XcdBarrier { unsigned* bar; unsigned x; volatile LAS unsigned* st; };
__device__ __forceinline__ XcdBarrier xcd_barrier_post(unsigned* bar, volatile LAS unsigned* st) {
  XcdBarrier b; b.bar = bar; b.x = xb_xcc_id(); b.st = st;
  if (threadIdx.x == 0) (void)xb_add(&bar[XB_XCNT(b.x)], 1u);
  return b;
}
__device__ __forceinline__ void xcd_barrier_complete(unsigned* bar, unsigned x, unsigned& nloc, unsigned& nx) {
  const unsigned G = gridDim.x * gridDim.y * gridDim.z;
  unsigned sum, cnt, mine, sp = 0u;
  for (;;) {
    sum = 0u; cnt = 0u; mine = 0u;
#pragma unroll
    for (unsigned j = 0; j < 16; ++j) { const unsigned c = xb_ld(&bar[XB_XCNT(j)]); sum += c; cnt += (c > 0u) ? 1u : 0u; mine = (j == x) ? c : mine; }
    if (sum == G) break;
    __builtin_amdgcn_s_sleep(1);
    if ((++sp & 255u) == 0u) { if (xb_ld(&bar[XB_TMO])) break; if (sp > XB_SPIN_CAP) { atomicAdd(&bar[XB_TMO], 1u); break; } }
  }
  nloc = mine > 0u ? mine : 1u; nx = cnt > 0u ? cnt : 1u;
}
__device__ __forceinline__ void xcd_barrier(const XcdBarrier& b) {
  asm volatile("s_waitcnt vmcnt(0)" ::: "memory");
  __syncthreads();
  if (threadIdx.x == 0) {
    unsigned* bar = b.bar;
    __builtin_amdgcn_s_waitcnt(0);
    unsigned nloc = b.st[0], nx = b.st[1];
    if (nloc == 0u) { xcd_barrier_complete(bar, b.x, nloc, nx); b.st[0] = nloc; b.st[1] = nx; }
    const unsigned old = xb_add(&bar[XB_XSUB(b.x)], 1u);
    const unsigned gen = old / nloc;
    if (old + 1u == (gen + 1u) * nloc) {
      __builtin_amdgcn_fence(__ATOMIC_RELEASE, "agent");
      asm volatile("s_waitcnt vmcnt(0)" ::: "memory");
      const unsigned og = xb_add(&bar[XB_TOP], 1u);
      const unsigned tg = og / nx;
      if (og + 1u == (tg + 1u) * nx) xb_add(&bar[XB_TOPGEN], 1u);
      else XB_SPIN(xb_ld(&bar[XB_TOPGEN]) == tg, bar);
      __builtin_amdgcn_fence(__ATOMIC_ACQUIRE, "agent");
      xb_add(&bar[XB_XGEN(b.x)], 1u);
      asm volatile("s_waitcnt vmcnt(0)" ::: "memory");
    } else {
      XB_SPIN(xb_ld(&bar[XB_XGEN(b.x)]) == gen, bar);
      __builtin_amdgcn_fence(__ATOMIC_ACQUIRE, "agent");
      asm volatile("s_waitcnt vmcnt(0)" ::: "memory");
    }
  }
  __syncthreads();
}

namespace pg8 {
constexpr int BM = 256, BK = 64, HALF = 128, HTB = HALF * BK * 2, STAGE_BYTES = 8 * HTB, NXCD = 8, WGM = 8;
__host__ __device__ __forceinline__ int lds_byte(int r, int c) { const int st = (r >> 4) * 2 + (c >> 5), rr = r & 15, cc = c & 31, ob = rr * 64 + cc * 2; return st * 1024 + (ob ^ (((ob >> 9) & 1) << 5)); }
__host__ __device__ __forceinline__ void stage_rc(int b, int& R, int& C) { const int st = b / 1024, sb = b % 1024, swz = sb ^ (((sb >> 9) & 1) << 5); R = (st >> 1) * 16 + swz / 64; C = (st & 1) * 32 + (swz % 64) / 2; }
__host__ __device__ __forceinline__ int perm32(int rho) { const int n = rho >> 4, i = rho & 15; return 8 * (i >> 2) + 4 * n + (i & 3); }
struct Unit { int pm, pn, ks; };
struct Gemm { const bf16_t* A; const bf16_t* Bt; int M, N, K, ld, nks; };
struct StaticOrder {
  int nM, nN, ntile, nwg, G, c;
  __device__ void init(int M, int N, int nks, int G_, int c_) { nM = M / BM; nN = N / BM; ntile = nM * nN; nwg = ntile * nks; G = G_; c = c_; }
  __device__ bool next(int i, Unit& u) const {
    const long L = (long)i * G + c; if (L >= nwg) return false;
    u.ks = (int)L / ntile; int wgid = (int)L - u.ks * ntile;
    { const int q = ntile / NXCD, r = ntile % NXCD, xcd = wgid % NXCD, off = wgid / NXCD; wgid = (xcd < r ? xcd * (q + 1) : r * (q + 1) + (xcd - r) * q) + off; }
    const int nig = WGM * nN, gid = wgid / nig, fm = gid * WGM, gsz = (nM - fm) < WGM ? (nM - fm) : WGM;
    u.pm = fm + ((wgid % nig) % gsz); u.pn = (wgid % nig) / gsz; return true;
  }
};

template <class Epi>
__device__ __forceinline__ void gemm_phase(LP lds, const Gemm g, const StaticOrder& S, const Epi& E) {
  int tid_ = threadIdx.x; asm volatile("" : "+v"(tid_));
  const int tid = tid_, wid = __builtin_amdgcn_readfirstlane(tid >> 6), lane = tid & 63, wr = wid >> 2, wc = wid & 3, fr = lane & 15, fq = lane >> 4;
  const int K = g.ld, nt = g.K / BK;
  const size_t ksb = (size_t)g.K * 2;
  unsigned voffA[2], voffB[2];
#pragma unroll
  for (int i = 0; i < 2; ++i) { int R, C; stage_rc(tid * 16 + i * 8192, R, C); const int Rb = (R & ~31) + perm32(R & 31); voffA[i] = (unsigned)(R * K + C) * 2u; voffB[i] = (unsigned)(Rb * K + C) * 2u; }
  const size_t kstep = (size_t)(BK * 2);
  const size_t hstep = (size_t)HALF * K * 2;
  const size_t tstep = 2 * hstep;
  const unsigned ldsw = (unsigned)wid * 1024u;
  const int aoff = lds_byte(wr * 64 + fr, fq * 8), boff = lds_byte(wc * 32 + fr, fq * 8);
#define PG8_SA(b, h) (((b) * 2 + (h)) * HTB)
#define PG8_SB(b, h) ((4 + (b) * 2 + (h)) * HTB)
#define PG8_STAGE(bufoff, gbase, voff) do { _Pragma("unroll") for (int _i = 0; _i < 2; ++_i) \
    __builtin_amdgcn_global_load_lds((const unsigned*)((const char*)(gbase) + (voff)[_i]), (LAS unsigned*)(lds + (bufoff) + ldsw + _i * 8192), 16, 0, 0); } while (0)
#define PG8_LDA(dst, b, h) do { _Pragma("unroll") for (int m = 0; m < 4; ++m) _Pragma("unroll") for (int k = 0; k < 2; ++k) dst[m][k] = *(const LAS bf16x8*)(lds + PG8_SA(b, h) + aoff + m * 2048 + k * 1024); } while (0)
#define PG8_LDB(dst, b, h) do { _Pragma("unroll") for (int n = 0; n < 2; ++n) _Pragma("unroll") for (int k = 0; k < 2; ++k) dst[n][k] = *(const LAS bf16x8*)(lds + PG8_SB(b, h) + boff + n * 2048 + k * 1024); } while (0)
#define PG8_MMA(ai, bj, At, Bt) do { __builtin_amdgcn_s_setprio(1); _Pragma("unroll") for (int m = 0; m < 4; ++m) _Pragma("unroll") for (int n = 0; n < 2; ++n) _Pragma("unroll") for (int k = 0; k < 2; ++k) \
    acc[ai][bj][m][n] = __builtin_amdgcn_mfma_f32_16x16x32_bf16(Bt[n][k], At[m][k], acc[ai][bj][m][n], 0, 0, 0); __builtin_amdgcn_s_setprio(0); } while (0)
#define PG8_WAIT_V(n) asm volatile("s_waitcnt vmcnt(" #n ")" ::: "memory")
#define PG8_WAIT_L(n) asm volatile("s_waitcnt lgkmcnt(" #n ")" ::: "memory")
#define PG8_BAR __builtin_amdgcn_s_barrier()
#define PG8_SCHED __builtin_amdgcn_sched_barrier(0)
  Unit cur, nxt; int ui = 0;
  if (!S.next(0, cur)) return;
  f32x4 acc[2][2][4][2];
#pragma unroll
  for (int a = 0; a < 2; ++a)
#pragma unroll
    for (int b = 0; b < 2; ++b)
#pragma unroll
      for (int m = 0; m < 4; ++m)
#pragma unroll
        for (int n = 0; n < 2; ++n) acc[a][b][m][n] = (f32x4){0.f, 0.f, 0.f, 0.f};
  bf16x8 At[4][2], B0[2][2], B1[2][2];
  const char* cA = (const char*)g.A + (size_t)cur.pm * tstep + cur.ks * ksb; const char* cB = (const char*)g.Bt + (size_t)cur.pn * tstep + cur.ks * ksb;
  PG8_STAGE(PG8_SB(0, 0), cB, voffB); PG8_STAGE(PG8_SB(0, 1), cB + hstep, voffB); PG8_STAGE(PG8_SA(0, 0), cA, voffA); PG8_STAGE(PG8_SA(0, 1), cA + hstep, voffA);
  if (wr == 1) PG8_BAR;
  PG8_WAIT_V(2); PG8_BAR;
  PG8_STAGE(PG8_SB(1, 0), cB + kstep, voffB); PG8_STAGE(PG8_SA(1, 0), cA + kstep, voffA); PG8_STAGE(PG8_SB(1, 1), cB + hstep + kstep, voffB);
  PG8_WAIT_V(6); PG8_BAR;
  for (;;) {
    const bool has_next = S.next(ui + 1, nxt);
    const char* nA = has_next ? (const char*)g.A + (size_t)nxt.pm * tstep + nxt.ks * ksb : cA; const char* nB = has_next ? (const char*)g.Bt + (size_t)nxt.pn * tstep + nxt.ks * ksb : cB;
    for (int t = 0; t < nt; t += 2) {
      const bool last = (t == nt - 2);
      const char* a1 = cA + (size_t)(t + 1) * kstep;
      const char* a2 = last ? nA : cA + (size_t)(t + 2) * kstep; const char* b2 = last ? nB : cB + (size_t)(t + 2) * kstep;
      const char* a3 = a2 + kstep; const char* b3 = b2 + kstep;
      PG8_LDB(B0, 0, 0); PG8_LDB(B1, 0, 1); PG8_SCHED; PG8_LDA(At, 0, 0); PG8_STAGE(PG8_SA(1, 1), a1 + hstep, voffA);
      PG8_WAIT_V(8); PG8_WAIT_L(0); PG8_BAR; PG8_MMA(0, 0, At, B0); PG8_MMA(0, 1, At, B1); PG8_BAR; PG8_SCHED;
      PG8_LDA(At, 0, 1); PG8_STAGE(PG8_SB(0, 0), b2, voffB); PG8_STAGE(PG8_SB(0, 1), b2 + hstep, voffB); PG8_STAGE(PG8_SA(0, 0), a2, voffA);
      PG8_WAIT_V(8); PG8_WAIT_L(0); PG8_BAR; PG8_MMA(1, 0, At, B0); PG8_MMA(1, 1, At, B1); PG8_BAR; PG8_SCHED;
      PG8_LDB(B0, 1, 0); PG8_LDB(B1, 1, 1); PG8_SCHED; PG8_LDA(At, 1, 0); PG8_STAGE(PG8_SA(0, 1), a2 + hstep, voffA);
      PG8_WAIT_V(8); PG8_WAIT_L(0); PG8_BAR; PG8_MMA(0, 0, At, B0); PG8_MMA(0, 1, At, B1); PG8_BAR; PG8_SCHED;
      PG8_LDA(At, 1, 1); PG8_STAGE(PG8_SB(1, 0), b3, voffB); PG8_STAGE(PG8_SB(1, 1), b3 + hstep, voffB); PG8_STAGE(PG8_SA(1, 0), a3, voffA);
      PG8_WAIT_V(8); PG8_WAIT_L(0); PG8_BAR; PG8_MMA(1, 0, At, B0); PG8_MMA(1, 1, At, B1); PG8_BAR; PG8_SCHED;
    }
    if (wr == 0) PG8_BAR;
    { int fr2 = fr, fq2 = fq; asm volatile("" : "+v"(fr2), "+v"(fq2)); E(acc, cur, wr, wc, fr2, fq2); }
    if (!has_next) break;
#pragma unroll
    for (int a = 0; a < 2; ++a)
#pragma unroll
      for (int b = 0; b < 2; ++b)
#pragma unroll
        for (int m = 0; m < 4; ++m)
#pragma unroll
          for (int n = 0; n < 2; ++n) acc[a][b][m][n] = (f32x4){0.f, 0.f, 0.f, 0.f};
    cur = nxt; cA = nA; cB = nB; ++ui;
    if (wr == 1) PG8_BAR;
  }
  PG8_WAIT_V(0);
  PG8_BAR;
#undef PG8_SA
#undef PG8_SB
#undef PG8_STAGE
#undef PG8_LDA
#undef PG8_LDB
#undef PG8_MMA
#undef PG8_WAIT_V
#undef PG8_WAIT_L
#undef PG8_BAR
#undef PG8_SCHED
}
}
using pg8::Unit;
typedef f32x4 AccT[2][2][4][2];

#define EPI_ROW(ai, m) (u.pm * 256 + (ai) * 128 + wr * 64 + (m) * 16 + fr)
#define EPI_COL(bj, n) (u.pn * 256 + (bj) * 128 + wc * 32 + 8 * fq + 4 * (n))
#define EPI_LOOP_ROWS _Pragma("unroll") for (int ai = 0; ai < 2; ++ai) _Pragma("unroll") for (int m = 0; m < 4; ++m)
#define EPI_LOOP_COLS _Pragma("unroll") for (int bj = 0; bj < 2; ++bj) _Pragma("unroll") for (int n = 0; n < 2; ++n)

__device__ __forceinline__ int cond_of_row(int row) { return row < NCTX ? 0 : 1 + ((row - NCTX) >> 11); }

#define EPI_LOOP_BJ _Pragma("unroll") for (int bj = 0; bj < 2; ++bj)
__device__ __forceinline__ u32x4 pack8(const f32x4 v0, const f32x4 v1) { u32x4 w; w.x = pack2(v0[0], v0[1]); w.y = pack2(v0[2], v0[3]); w.z = pack2(v1[0], v1[1]); w.w = pack2(v1[2], v1[3]); return w; }
__device__ __forceinline__ void unpack8(const u32x4 w, f32x4& v0, f32x4& v1) { v0[0] = bflo(w.x); v0[1] = bfhi(w.x); v0[2] = bflo(w.y); v0[3] = bfhi(w.y); v1[0] = bflo(w.z); v1[1] = bfhi(w.z); v1[2] = bflo(w.w); v1[3] = bfhi(w.w); }
struct EpiQKV {
  bf16_t* O; const float* bias;
  __device__ __forceinline__ void operator()(const AccT& acc, const Unit& u, int wr, int wc, int fr, int fq) const {
    const float sc = (u.pn < 4) ? 0.0625f : 1.0f;
    f32x4 bv[2][2];
    EPI_LOOP_COLS { bv[bj][n] = *(const f32x4*)(bias + EPI_COL(bj, n)); }
    EPI_LOOP_ROWS { const int row = EPI_ROW(ai, m);
      EPI_LOOP_BJ { *(u32x4*)(O + (size_t)row * 3072 + EPI_COL(bj, 0)) = pack8((acc[ai][bj][m][0] + bv[bj][0]) * sc, (acc[ai][bj][m][1] + bv[bj][1]) * sc); } }
  }
};
struct EpiUT {
  bf16_t* O; const float* bias;
  __device__ __forceinline__ void operator()(const AccT& acc, const Unit& u, int wr, int wc, int fr, int fq) const {
    EPI_LOOP_ROWS { const int row = EPI_ROW(ai, m); const float bv = bias[row];
      EPI_LOOP_BJ { *(u32x4*)(O + (size_t)row * NTOK + EPI_COL(bj, 0)) = pack8(acc[ai][bj][m][0] + bv, acc[ai][bj][m][1] + bv); } }
  }
};
struct EpiGates {
  bf16_t* H; bf16_t* G; const float* b_in;
  __device__ __forceinline__ void operator()(const AccT& acc, const Unit& u, int wr, int wc, int fr, int fq) const {
    const bool og = u.pn < 4;
    f32x4 bv[2][2];
    EPI_LOOP_COLS { const int col = EPI_COL(bj, n); bv[bj][n] = *(const f32x4*)(b_in + (og ? 3072 + col : 7184 + (col - 1024))); }
#pragma unroll
    for (int ai = 0; ai < 2; ++ai)
#pragma unroll
      for (int m2 = 0; m2 < 2; ++m2) {
        u32x4 hv[2][2];
        if (og) {
#pragma unroll
          for (int mm = 0; mm < 2; ++mm) { const int row = EPI_ROW(ai, 2 * m2 + mm); EPI_LOOP_BJ { hv[mm][bj] = *(const u32x4*)(H + (size_t)row * 1024 + EPI_COL(bj, 0)); } } }
#pragma unroll
        for (int mm = 0; mm < 2; ++mm) { const int m = 2 * m2 + mm; const int row = EPI_ROW(ai, m);
          EPI_LOOP_BJ { const int col = EPI_COL(bj, 0); f32x4 s0, s1; const f32x4 a0 = acc[ai][bj][m][0] + bv[bj][0], a1 = acc[ai][bj][m][1] + bv[bj][1];
#pragma unroll
            for (int e = 0; e < 4; ++e) { s0[e] = sigmoidf_(a0[e]); s1[e] = sigmoidf_(a1[e]); }
            if (og) { f32x4 h0, h1; unpack8(hv[mm][bj], h0, h1); *(u32x4*)(H + (size_t)row * 1024 + col) = pack8(h0 * s0, h1 * s1); }
            else *(u32x4*)(G + (size_t)row * 2048 + (col - 1024)) = pack8(s0, s1); } } }
  }
};
template <int SECOND> struct EpiMerge {
  bf16_t* T; const bf16_t* G;
  __device__ __forceinline__ void operator()(const AccT& acc, const Unit& u, int wr, int wc, int fr, int fq) const {
#pragma unroll
    for (int ai = 0; ai < 2; ++ai)
#pragma unroll
      for (int m2 = 0; m2 < 2; ++m2) {
        u32x4 gv[2][2], tv[2][2];
#pragma unroll
        for (int mm = 0; mm < 2; ++mm) { const int row = EPI_ROW(ai, 2 * m2 + mm);
          EPI_LOOP_BJ { const int col = EPI_COL(bj, 0); gv[mm][bj] = *(const u32x4*)(G + (size_t)row * 2048 + SECOND * 1024 + col);
            if (SECOND) tv[mm][bj] = *(const u32x4*)(T + (size_t)row * 1024 + col); } }
#pragma unroll
        for (int mm = 0; mm < 2; ++mm) { const int m = 2 * m2 + mm; const int row = EPI_ROW(ai, m);
          EPI_LOOP_BJ { const int col = EPI_COL(bj, 0); f32x4 g0, g1; unpack8(gv[mm][bj], g0, g1);
            f32x4 v0 = g0 * acc[ai][bj][m][0], v1 = g1 * acc[ai][bj][m][1];
            if (SECOND) { f32x4 t0, t1; unpack8(tv[mm][bj], t0, t1); v0 += t0; v1 += t1; }
            *(u32x4*)(T + (size_t)row * 1024 + col) = pack8(v0, v1); } } }
  }
};
struct EpiOut {
  const float* xp; const float* xs; const float* per; const float* pec; const float* mod; const float* n2w; float* X1; bf16_t* A2; float* ssq;
  __device__ __forceinline__ void operator()(const AccT& acc, const Unit& u, int wr, int wc, int fr, int fq) const {
    const int cb = cond_of_row(u.pm * 256); const float* md = mod + cb * 6144; const bool smp = (u.pm * 256) >= NCTX;
    f32x4 g1v[2][2], k2v[2][2];
    EPI_LOOP_COLS { const int col = EPI_COL(bj, n); g1v[bj][n] = *(const f32x4*)(md + 2048 + col); k2v[bj][n] = *(const f32x4*)(n2w + col) * (*(const f32x4*)(md + 4096 + col) + 1.0f); }
    EPI_LOOP_ROWS { const int row = EPI_ROW(ai, m); float ss = 0.f;
#pragma unroll
      for (int bj = 0; bj < 2; ++bj) {
        f32x4 x0[2];
        if (!smp) {
#pragma unroll
          for (int n = 0; n < 2; ++n) x0[n] = *(const f32x4*)(xp + (size_t)row * 1024 + EPI_COL(bj, n)); }
        else { const int r2 = row - NCTX, t = r2 & 2047; f32x4 pe[2];
#pragma unroll
          for (int n = 0; n < 2; ++n) { const int col = EPI_COL(bj, n); x0[n] = *(const f32x4*)(xs + (size_t)r2 * 1024 + col);
            pe[n] = (col < 512) ? *(const f32x4*)(per + (t >> 6) * 512 + col) : *(const f32x4*)(pec + (t & 63) * 512 + (col - 512)); }
#pragma unroll
          for (int n = 0; n < 2; ++n) x0[n] += pe[n]; }
        f32x4 x1[2];
#pragma unroll
        for (int n = 0; n < 2; ++n) { x1[n] = x0[n] + g1v[bj][n] * acc[ai][bj][m][n]; *(f32x4*)(X1 + (size_t)row * 1024 + EPI_COL(bj, n)) = x1[n];
          ss += x1[n][0] * x1[n][0] + x1[n][1] * x1[n][1] + x1[n][2] * x1[n][2] + x1[n][3] * x1[n][3]; }
        *(u32x4*)(A2 + (size_t)row * 1024 + EPI_COL(bj, 0)) = pack8(x1[0] * k2v[bj][0], x1[1] * k2v[bj][1]); }
      ss += __shfl_xor(ss, 16); ss += __shfl_xor(ss, 32);
      if (fq == 0) ssq[(size_t)row * 16 + u.pn * 4 + wc] = ss; }
  }
};
struct EpiFF1 {
  int row0; const float* ssq; const float* c1; bf16_t* Hd;
  __device__ __forceinline__ void operator()(const AccT& acc, const Unit& u, int wr, int wc, int fr, int fq) const {
    const int cb = cond_of_row(row0 + u.pm * 256); const float* cc = c1 + cb * 4096;
    f32x4 cv[2][2];
    EPI_LOOP_COLS { cv[bj][n] = *(const f32x4*)(cc + EPI_COL(bj, n)); }
    float rs[2][4];
    EPI_LOOP_ROWS { const float* sp = ssq + (size_t)(row0 + EPI_ROW(ai, m)) * 16;
      const f32x4 st = (*(const f32x4*)sp + *(const f32x4*)(sp + 4)) + (*(const f32x4*)(sp + 8) + *(const f32x4*)(sp + 12));
      rs[ai][m] = rsqrtf((st[0] + st[1] + st[2] + st[3]) * (1.0f / 1024.0f) + 1e-6f); }
    EPI_LOOP_ROWS { const int rl = EPI_ROW(ai, m); const float rstd = rs[ai][m];
      EPI_LOOP_BJ { f32x4 v0 = acc[ai][bj][m][0] * rstd + cv[bj][0], v1 = acc[ai][bj][m][1] * rstd + cv[bj][1];
#pragma unroll
        for (int e = 0; e < 4; ++e) { const float r0 = fmaxf(v0[e], 0.f), r1 = fmaxf(v1[e], 0.f); v0[e] = r0 * r0; v1[e] = r1 * r1; }
        *(u32x4*)(Hd + (size_t)rl * 4096 + EPI_COL(bj, 0)) = pack8(v0, v1); } }
  }
};
struct EpiFF2 {
  int row0; const float* mod; const float* b2; float* X; float* P;
  __device__ __forceinline__ void operator()(const AccT& acc, const Unit& u, int wr, int wc, int fr, int fq) const {
    if (u.ks == 1) {
      EPI_LOOP_ROWS { const int rl = EPI_ROW(ai, m); EPI_LOOP_COLS { *(f32x4*)(P + (size_t)rl * 1024 + EPI_COL(bj, n)) = acc[ai][bj][m][n]; } }
    } else {
    const int cb = cond_of_row(row0 + u.pm * 256); const float* md = mod + cb * 6144;
    f32x4 g2v[2][2], bbv[2][2];
    EPI_LOOP_COLS { const int col = EPI_COL(bj, n); g2v[bj][n] = *(const f32x4*)(md + 5120 + col); bbv[bj][n] = *(const f32x4*)(b2 + col); }
#pragma unroll
    for (int ai = 0; ai < 2; ++ai)
#pragma unroll
      for (int m2 = 0; m2 < 2; ++m2) {
        f32x4 xv[2][2][2];
#pragma unroll
        for (int mm = 0; mm < 2; ++mm) { const int row = row0 + EPI_ROW(ai, 2 * m2 + mm); EPI_LOOP_COLS { xv[mm][bj][n] = *(const f32x4*)(X + (size_t)row * 1024 + EPI_COL(bj, n)); } }
#pragma unroll
        for (int mm = 0; mm < 2; ++mm) { const int m = 2 * m2 + mm; const int row = row0 + EPI_ROW(ai, m);
          EPI_LOOP_COLS { const int col = EPI_COL(bj, n); *(f32x4*)(X + (size_t)row * 1024 + col) = xv[mm][bj][n] + g2v[bj][n] * (acc[ai][bj][m][n] + bbv[bj][n]); } } }
    }
  }
};

template <class Epi> __device__ __forceinline__ void run_gemm(LP lds, const bf16_t* A, const bf16_t* Bt, int M, int N, int K, const Epi& E, int nks = 1) {
  pg8::Gemm g; g.A = A; g.Bt = Bt; g.M = M; g.N = N; g.K = K / nks; g.ld = K; g.nks = nks;
  pg8::StaticOrder S; S.init(M, N, nks, (int)gridDim.x, (int)blockIdx.x);
  pg8::gemm_phase<Epi>(lds, g, S, E);
}

__device__ void transpose_tile(const float* __restrict__ src, int ld, int col0, int k0, bf16_t* __restrict__ dst, int K, int drow0, LAS float* tile) {
  const int t = opaque_tid();
  f32x4 v[4];
#pragma unroll
  for (int i = 0; i < 4; ++i) { const int idx = t + 512 * i, kr = idx >> 5, c4 = idx & 31; v[i] = *(const f32x4*)(src + (size_t)(k0 + kr) * ld + col0 + 4 * c4); }
#pragma unroll
  for (int i = 0; i < 4; ++i) { const int idx = t + 512 * i, kr = idx >> 5, c4 = idx & 31; LAS float* tp = tile + kr * 129 + 4 * c4; tp[0] = v[i][0]; tp[1] = v[i][1]; tp[2] = v[i][2]; tp[3] = v[i][3]; }
  __syncthreads();
  const int kb = t & 7;
#pragma unroll
  for (int i = 0; i < 2; ++i) { const int c = (t >> 3) + 64 * i; const LAS float* tp = tile + (kb * 8) * 129 + c; u32x4 o;
    o.x = pack2(tp[0], tp[129]); o.y = pack2(tp[2 * 129], tp[3 * 129]); o.z = pack2(tp[4 * 129], tp[5 * 129]); o.w = pack2(tp[6 * 129], tp[7 * 129]);
    *(u32x4*)(dst + (size_t)(drow0 + c) * K + k0 + kb * 8) = o; }
  __syncthreads();
}
template <int SILU> __device__ void matvec9_unit(const float* v0, const float* v1, int v1stride, const float* __restrict__ W, int ldw, const float* bias, float* out, int ldo, int col0, LAS float* lf) {
  const int t = opaque_tid(), lane = t & 63, wid = t >> 6;
  LAS float* sv = lf; LAS float* red = lf + 9216;
  for (int i = t; i < 9216; i += 512) { const int b = i >> 10, k = i & 1023; float x = (b == 0) ? v0[k] : v1[(size_t)(b - 1) * v1stride + k]; if (SILU) x = x * __builtin_amdgcn_rcpf(1.0f + __expf(-x)); sv[i] = x; }
  __syncthreads();
  const int c4 = t & 7, kl = t >> 3;
  f32x4 w[16];
#pragma unroll
  for (int i = 0; i < 16; ++i) w[i] = *(const f32x4*)(W + (size_t)(kl + 64 * i) * ldw + col0 + 4 * c4);
  f32x4 acc[9];
#pragma unroll
  for (int b = 0; b < 9; ++b) acc[b] = (f32x4){0.f, 0.f, 0.f, 0.f};
#pragma unroll
  for (int i = 0; i < 16; ++i)
#pragma unroll
    for (int b = 0; b < 9; ++b) acc[b] += w[i] * sv[b * 1024 + kl + 64 * i];
#pragma unroll
  for (int b = 0; b < 9; ++b)
#pragma unroll
    for (int e = 0; e < 4; ++e) { float x = acc[b][e]; x += __shfl_xor(x, 8); x += __shfl_xor(x, 16); x += __shfl_xor(x, 32); acc[b][e] = x; }
  if (lane < 8) {
#pragma unroll
    for (int b = 0; b < 9; ++b) *(LAS f32x4*)(red + (wid * 9 + b) * 32 + 4 * lane) = acc[b]; }
  __syncthreads();
  if (t < 288) { const int b = t >> 5, cc = t & 31; float s = bias[col0 + cc];
#pragma unroll
    for (int pz = 0; pz < 8; ++pz) s += red[(pz * 9 + b) * 32 + cc];
    out[(size_t)b * ldo + col0 + cc] = s; }
  __syncthreads();
}

__device__ void phase0(const Params& p, LP lds) {
  unsigned char* ws = p.ws; LAS float* lf = (LAS float*)lds;
  const int tid0 = opaque_tid(); const int wid = tid0 >> 6, lane = tid0 & 63;
  for (int unit = blockIdx.x; unit < 576; unit += gridDim.x) {
    if (unit < 192) {
      matvec9_unit<1>(p.in[6], p.in[5], 1024, p.in[7], 6144, p.in[8], (float*)(ws + OFF_MOD), 6144, unit * 32, lf);
    } else if (unit < 480) {
      const int row = (unit - 192) * 8 + wid; const bool smp = row < 2048; const int L = smp ? 2048 : 256, t = smp ? row : row - 2048;
      const float* w1 = p.in[14]; const float* b1 = p.in[15]; const float* fr1 = p.in[16]; const float* w2 = p.in[17]; const float* b2 = p.in[18]; const float* fr2 = p.in[19];
      float a = b1[lane] + (float)t / (float)(L - 1) * w1[lane];
      const float base = (6.283185307179586f / (float)L) * (float)t;
      float cs = 0.f, sn = 0.f; if (lane < 16) { const float ang = base * (float)(lane + 1); cs = cosf(ang); sn = sinf(ang); }
#pragma unroll
      for (int i = 0; i < 16; ++i) a += __shfl(cs, i) * w1[(1 + i) * 64 + lane] + __shfl(sn, i) * w1[(17 + i) * 64 + lane];
      const float h1 = sinf(fr1[lane] * a);
      float a2 = b2[lane];
#pragma unroll 16
      for (int j = 0; j < 64; ++j) a2 += __shfl(h1, j) * w2[j * 64 + lane];
      const float h2 = sinf(fr2[lane] * a2);
      float* dst = (float*)(ws + (smp ? OFF_H2S : OFF_H2C)); dst[(size_t)t * 64 + lane] = h2;
    } else {
      const int r = unit - 480, c = tid0; const int pos = r < 32 ? r : r - 32; const int i = c & 255;
      const float omega = 1.0f / powf(10000.0f, (float)i / 256.0f); const float a = (float)pos * omega; const float v = c < 256 ? sinf(a) : cosf(a);
      float* dst = (float*)(ws + (r < 32 ? OFF_PER : OFF_PEC)); dst[(size_t)pos * 512 + c] = v;
    }
  }
}
__device__ void weight_tiles(const Params& p, LP lds, int lo, int hi, int upper) {
  unsigned char* ws = p.ws; LAS float* lf = (LAS float*)lds;
  const int nh = upper ? ((int)gridDim.x >> 1) : 0;
  if ((int)blockIdx.x < nh) return;
  for (int tu = lo + (int)blockIdx.x - nh; tu < hi; tu += (int)gridDim.x - nh) {
    const float* src; int ld, K, col0, k0, drow0; bf16_t* dst;
    if (tu < 1152) { const int nt = tu >> 4, kt = tu & 15; const int r = nt * 128; src = p.in[10]; ld = INC; K = 1024; k0 = kt * 64; drow0 = r; dst = (bf16_t*)(ws + OFF_WT);
      col0 = r < 3072 ? r : (r < 6144 ? 4112 + (r - 3072) : (r < 7168 ? 3072 + (r - 6144) : 7184 + (r - 7168))); }
    else if (tu < 1536) { const int v = tu - 1152, w = v >> 7, q = v & 127; src = p.in[23 + w]; ld = 1024; K = 1024; k0 = (q & 15) * 64; col0 = (q >> 4) * 128; drow0 = col0; dst = (bf16_t*)(ws + (w == 0 ? OFF_WBM : (w == 1 ? OFF_WBH : OFF_WOUT))); }
    else if (tu < 2048) { const int q = tu - 1536; src = p.in[27]; ld = 4096; K = 1024; k0 = (q & 15) * 64; col0 = (q >> 4) * 128; drow0 = col0; dst = (bf16_t*)(ws + OFF_W1T); }
    else { const int q = tu - 2048; src = p.in[29]; ld = 1024; K = 4096; k0 = (q & 63) * 64; col0 = (q >> 6) * 128; drow0 = col0; dst = (bf16_t*)(ws + OFF_W2T); }
    transpose_tile(src, ld, col0, k0, dst, K, drow0, lf);
  }
}

__device__ void phase1(const Params& p, LP lds) {
  unsigned char* ws = p.ws;
  int tid_ = threadIdx.x; asm volatile("" : "+v"(tid_));
  const int tid = tid_, wid = tid >> 6, lane = tid & 63;
  const float* mod = (const float*)(ws + OFF_MOD);
  LAS float* wg = (LAS float*)lds;
  if ((int)blockIdx.x < 1536) {
    f32x4 gw[8];
#pragma unroll
    for (int i = 0; i < 8; ++i) { const int idx = tid + 512 * i, k = idx >> 2, q = idx & 3; gw[i] = *(const f32x4*)(p.in[10] + (size_t)k * INC + 4096 + 4 * q); }
#pragma unroll
    for (int i = 0; i < 8; ++i) { const int idx = tid + 512 * i, k = idx >> 2, q = idx & 3; wg[(4 * q) * 1024 + k] = gw[i][0]; wg[(4 * q + 1) * 1024 + k] = gw[i][1]; wg[(4 * q + 2) * 1024 + k] = gw[i][2]; wg[(4 * q + 3) * 1024 + k] = gw[i][3]; }
    __syncthreads();
  }
  for (int unit = blockIdx.x; unit < 1536; unit += gridDim.x) {
    const int tidn = opaque_tid(); const int wid = tidn >> 6, lane = tidn & 63;
    const int row0 = unit * 16 + wid * 2; const int cb = cond_of_row(row0); const float* md = mod + cb * 6144; const bool smp = row0 >= NCTX;
    f32x4 v[2][4]; float rstd[2];
#pragma unroll
    for (int r = 0; r < 2; ++r) { const int row = row0 + r; const float* xr; int t = 0;
      if (!smp) xr = p.in[0] + (size_t)row * 1024; else { xr = p.in[1] + (size_t)(row - NCTX) * 1024; t = (row - NCTX) & 2047; }
      const float* per = (const float*)(ws + OFF_PER) + (t >> 6) * 512; const float* pec = (const float*)(ws + OFF_PEC) + (t & 63) * 512;
      float ss = 0.f;
#pragma unroll
      for (int i = 0; i < 4; ++i) { const int col = 4 * lane + 256 * i; v[r][i] = *(const f32x4*)(xr + col);
        if (smp) v[r][i] += (col < 512) ? *(const f32x4*)(per + col) : *(const f32x4*)(pec + col - 512);
        ss += v[r][i][0] * v[r][i][0] + v[r][i][1] * v[r][i][1] + v[r][i][2] * v[r][i][2] + v[r][i][3] * v[r][i][3]; }
      ss = wave_sum(ss); rstd[r] = rsqrtf(ss * (1.0f / 1024.0f) + 1e-6f); }
    const float* n1w = p.in[9];
    float ga[32];
#pragma unroll
    for (int g = 0; g < 32; ++g) ga[g] = 0.f;
#pragma unroll
    for (int i = 0; i < 4; ++i) { const int col = 4 * lane + 256 * i;
      const f32x4 w = *(const f32x4*)(n1w + col), sc = *(const f32x4*)(md + 1024 + col), sh = *(const f32x4*)(md + col);
      const f32x4 ws1 = w * (sc + 1.0f);
      f32x4 h[2];
#pragma unroll
      for (int r = 0; r < 2; ++r) { h[r] = v[r][i] * rstd[r] * ws1 + sh;
        u32x2 o; o.x = pack2(h[r][0], h[r][1]); o.y = pack2(h[r][2], h[r][3]); *(u32x2*)((bf16_t*)(ws + OFF_HN) + (size_t)(row0 + r) * 1024 + col) = o; }
#pragma unroll
      for (int g = 0; g < 16; ++g) { const f32x4 wv = *(const LAS f32x4*)(wg + g * 1024 + col);
#pragma unroll
        for (int r = 0; r < 2; ++r) ga[r * 16 + g] += h[r][0] * wv[0] + h[r][1] * wv[1] + h[r][2] * wv[2] + h[r][3] * wv[3]; }
      asm volatile("" ::: "memory"); }
#pragma unroll
    for (int off = 16; off >= 1; off >>= 1) { const bool hi = (lane & off) != 0;
#pragma unroll
      for (int i = 0; i < off; ++i) { const float send = hi ? ga[i] : ga[i + off]; const float keep = hi ? ga[i + off] : ga[i]; ga[i] = keep + __shfl_xor(send, off); } }
    const float tot = ga[0] + __shfl_xor(ga[0], 32);
    if (lane < 32) ((float*)(ws + OFF_GT))[(size_t)row0 * 16 + lane] = tot + p.in[11][4096 + (lane & 15)];
  }
  __syncthreads();
}
__device__ void filters_upper_half(const Params& p, LP lds) {
  unsigned char* ws = p.ws; const int nh = (int)gridDim.x >> 1;
  if ((int)blockIdx.x < nh) return;
  LAS float* w3s = (LAS float*)lds;
  for (int v = (int)blockIdx.x - nh; v < 320; v += (int)gridDim.x - nh) {
    const int tid = opaque_tid();
    const bool smp = v < 256; const int L = smp ? 2048 : 256; const int tt = smp ? (v >> 6) : 0, cgp = v & 63; const int t = tt * 512 + tid;
    { const f32x4 x = *(const f32x4*)(p.in[20] + (size_t)(tid >> 3) * 2048 + cgp * 32 + 4 * (tid & 7)); LAS float* wp = w3s + (4 * (tid & 7)) * 64 + (tid >> 3);
      wp[0] = x[0]; wp[64] = x[1]; wp[128] = x[2]; wp[192] = x[3]; }
    __syncthreads();
    if (t < L) {
      const float* H2 = (const float*)(ws + (smp ? OFF_H2S : OFF_H2C)) + (size_t)t * 64;
      f32x4 h2[16];
#pragma unroll
      for (int i = 0; i < 16; ++i) h2[i] = *(const f32x4*)(H2 + 4 * i);
      const float dist = fabsf((float)t - (float)(L / 2)) / (float)(L / 2);
      float* HF = (float*)(ws + (smp ? OFF_HFS : OFF_HFC)) + (size_t)(cgp * 32) * L + t;
#pragma unroll 1
      for (int j = 0; j < 32; ++j) {
        f32x4 a = {0.f, 0.f, 0.f, 0.f};
#pragma unroll
        for (int i = 0; i < 16; ++i) a += *(const LAS f32x4*)(w3s + j * 64 + 4 * i) * h2[i];
        const int c = (cgp * 32 + j) & 1023;
        const float dmin = -3.0701134573253946f, dmax = -15.350567286626973f;
        const float delta = fabsf(dmin + (dmax - dmin) * ((float)c / 1023.0f));
        HF[(size_t)j * L] = ((a[0] + a[1]) + (a[2] + a[3])) * __expf(-dist * delta); }
    }
    __syncthreads();
  }
}
__device__ void c1_upper_half(const Params& p, LP lds) {
  unsigned char* ws = p.ws; const float* mod = (const float*)(ws + OFF_MOD); const int nh = (int)gridDim.x >> 1;
  if ((int)blockIdx.x < nh) return;
  for (int u = (int)blockIdx.x - nh; u < 128; u += (int)gridDim.x - nh)
    matvec9_unit<0>(mod + 3072, mod + 6144 + 3072, 6144, p.in[27], 4096, p.in[28], (float*)(ws + OFF_C1), 4096, u * 32, (LAS float*)lds);
}

__device__ __forceinline__ bf16x8 tr_frag(LP base, int k0, int m0, int pitch  , int l15, int g) {
  const int q = l15 >> 2, pp = l15 & 3;
  LP a = base + ((k0 + 8 * g + q) * pitch + m0 + 4 * pp) * 2;
  const s16x4 lo = __builtin_amdgcn_ds_read_tr16_b64_v4i16((LAS s16x4*)a);
  const s16x4 hi = __builtin_amdgcn_ds_read_tr16_b64_v4i16((LAS s16x4*)(a + 8 * pitch));
  bf16x8 r; r[0] = lo[0]; r[1] = lo[1]; r[2] = lo[2]; r[3] = lo[3]; r[4] = hi[0]; r[5] = hi[1]; r[6] = hi[2]; r[7] = hi[3]; return r;
}
__device__ __forceinline__ bf16x8 tr_at(LP lanebase, int coff  , int pitch_bytes) {
  const s16x4 lo = __builtin_amdgcn_ds_read_tr16_b64_v4i16((LAS s16x4*)(lanebase + coff));
  const s16x4 hi = __builtin_amdgcn_ds_read_tr16_b64_v4i16((LAS s16x4*)(lanebase + coff + 4 * pitch_bytes));
  bf16x8 r; r[0] = lo[0]; r[1] = lo[1]; r[2] = lo[2]; r[3] = lo[3]; r[4] = hi[0]; r[5] = hi[1]; r[6] = hi[2]; r[7] = hi[3]; return r;
}
constexpr int ML_K = 0, ML_V = 67584, ML_P = 86016, ML_C = 120832, ML_T = 157696, ML_TSZ = 1600;
constexpr int KP = 264, VP = 72, PP = 136, CP = 72;

__device__ void mlstm_item(const Params& p, LP lds, int item) {
  const int tid = opaque_tid(), wid = __builtin_amdgcn_readfirstlane(tid >> 6), lane = tid & 63, l15 = lane & 15, g = lane >> 4;
  const bool smp = item < 256; const int uu = smp ? (item >> 2) : ((item - 256) >> 2); const int sl = item & 3;
  const int b = uu >> 3, dir = (uu >> 2) & 1, head = uu & 3;
  const int S = smp ? SEQS : SEQC, nc = S >> 7; const int tok0 = smp ? NCTX + b * SEQS : b * SEQC;
  const bf16_t* qkv = (const bf16_t*)(p.ws + OFF_BIG);
  const float* GT = (const float*)(p.ws + OFF_GT);
  bf16_t* hout = (bf16_t*)((unsigned char*)p.out + (dir ? OUT_HB : OUT_H));
  const int sidx = (b * 2 + dir) * 4 + head;
  const int gi_col = dir * 8 + head, gf_col = dir * 8 + 4 + head;
  f32x4 Cacc[2][4], nacc[2]; float mst0;
  if (smp) {
    const float* C0 = p.in[2] + (size_t)sidx * 65536;
#pragma unroll
    for (int dt = 0; dt < 2; ++dt) {
#pragma unroll
      for (int vt = 0; vt < 4; ++vt) Cacc[dt][vt] = *(const f32x4*)(C0 + (size_t)((2 * wid + dt) * 16 + l15) * 256 + sl * 64 + 16 * vt + 4 * g);
      nacc[dt] = (f32x4){p.in[3][sidx * 256 + (2 * wid + dt) * 16 + l15], 0.f, 0.f, 0.f}; }
    mst0 = p.in[4][sidx];
  } else {
#pragma unroll
    for (int dt = 0; dt < 2; ++dt) {
#pragma unroll
      for (int vt = 0; vt < 4; ++vt) Cacc[dt][vt] = (f32x4){0.f, 0.f, 0.f, 0.f};
      nacc[dt] = (f32x4){0.f, 0.f, 0.f, 0.f}; }
    mst0 = 0.f;
  }
#define TOKC(cc, j) (dir ? (tok0 + S - 1 - ((cc) * 128 + (j))) : (tok0 + (cc) * 128 + (j)))
  const int rt = (wid < 4) ? wid : 11 - wid;
  const int jrow = 16 * rt + l15;
  bf16x8 qf[8]; u32x4 kreg[8], vreg[2]; float g4[4] = {0.f, 0.f, 0.f, 0.f};
#define ML_LOAD_Q(cc) do { const bf16_t* qp = qkv + (size_t)TOKC(cc, jrow) * 3072 + head * 256 + 8 * g; \
    _Pragma("unroll") for (int kk = 0; kk < 8; ++kk) qf[kk] = *(const bf16x8*)(qp + 32 * kk); } while (0)
#define ML_LOAD_KV(cc) do { \
    _Pragma("unroll") for (int i = 0; i < 8; ++i) { const int row = (tid >> 5) + 16 * i; kreg[i] = *(const u32x4*)(qkv + (size_t)TOKC(cc, row) * 3072 + 1024 + head * 256 + (tid & 31) * 8); } \
    _Pragma("unroll") for (int i = 0; i < 2; ++i) { const int row = (tid >> 3) + 64 * i; vreg[i] = *(const u32x4*)(qkv + (size_t)TOKC(cc, row) * 3072 + 2048 + head * 256 + sl * 64 + (tid & 7) * 8); } \
    if (wid == 0) { const float* g0 = GT + (size_t)TOKC(cc, 2 * lane) * 16; const float* g1 = GT + (size_t)TOKC(cc, 2 * lane + 1) * 16; g4[0] = g0[gi_col]; g4[1] = g0[gf_col]; g4[2] = g1[gi_col]; g4[3] = g1[gf_col]; } } while (0)
#define ML_SCAN(tabp, mcur, mnext) do { LAS float* T_ = (LAS float*)(tabp); \
    const float lf0 = fminf(g4[1], 0.f) - log1pf(__expf(-fabsf(g4[1]))), lf1 = fminf(g4[3], 0.f) - log1pf(__expf(-fabsf(g4[3]))); \
    float s_ = lf0 + lf1; \
    _Pragma("unroll") for (int o = 1; o < 64; o <<= 1) { const float t_ = __shfl_up(s_, o); if (lane >= o) s_ += t_; } \
    const float b1_ = s_, b0_ = s_ - lf1; const float u0_ = g4[0] - b0_, u1_ = g4[2] - b1_; \
    float mx_ = fmaxf(u0_, u1_); \
    _Pragma("unroll") for (int o = 1; o < 64; o <<= 1) { const float t_ = __shfl_up(mx_, o); if (lane >= o) mx_ = fmaxf(mx_, t_); } \
    float ex_ = __shfl_up(mx_, 1); if (lane == 0) ex_ = -INFINITY; \
    const float M0_ = fmaxf(mcur, fmaxf(ex_, u0_)), M1_ = fmaxf(mcur, mx_); \
    T_[2 * lane] = u0_; T_[2 * lane + 1] = u1_; T_[128 + 2 * lane] = M0_; T_[128 + 2 * lane + 1] = M1_; T_[256 + 2 * lane] = b0_; T_[256 + 2 * lane + 1] = b1_; \
    const float Ml_ = __shfl(M1_, 63), bl_ = __shfl(b1_, 63); \
    if (lane == 0) { T_[384] = mcur; T_[385] = Ml_; } \
    mnext = bl_ + Ml_; } while (0)
  float mw0 = mst0;
  ML_LOAD_Q(0); ML_LOAD_KV(0);
  if (wid == 0) { float mn; ML_SCAN(lds + ML_T, mw0, mn); mw0 = mn; }
  __syncthreads();
  float m_final = 0.f;
  for (int c = 0; c < nc; ++c) {
    LAS float* T = (LAS float*)(lds + ML_T + (c & 1) * ML_TSZ);
    const float mst = T[384], M_last = T[385];
#pragma unroll
    for (int i = 0; i < 8; ++i) { const int row = (tid >> 5) + 16 * i; *(LAS u32x4*)(lds + ML_K + (row * KP + (tid & 31) * 8) * 2) = kreg[i]; }
#pragma unroll
    for (int i = 0; i < 2; ++i) { const int row = (tid >> 3) + 64 * i; const float w = __expf(T[row] - M_last); const u32x4 v = vreg[i]; u32x4 o;
      o.x = pack2(bflo(v.x) * w, bfhi(v.x) * w); o.y = pack2(bflo(v.y) * w, bfhi(v.y) * w); o.z = pack2(bflo(v.z) * w, bfhi(v.z) * w); o.w = pack2(bflo(v.w) * w, bfhi(v.w) * w);
      *(LAS u32x4*)(lds + ML_V + (row * VP + (tid & 7) * 8) * 2) = o; }
    if (tid < 128) *(LAS unsigned short*)(lds + ML_V + (tid * VP + 64) * 2) = f2bf(__expf(T[tid] - M_last));
#pragma unroll
    for (int dt = 0; dt < 2; ++dt) {
#pragma unroll
      for (int vt = 0; vt < 4; ++vt) { u32x2 w; w.x = pack2(Cacc[dt][vt][0], Cacc[dt][vt][1]); w.y = pack2(Cacc[dt][vt][2], Cacc[dt][vt][3]);
        *(LAS u32x2*)(lds + ML_C + (((2 * wid + dt) * 16 + l15) * CP + 16 * vt + 4 * g) * 2) = w; }
      if (g == 0) *(LAS unsigned short*)(lds + ML_C + (((2 * wid + dt) * 16 + l15) * CP + 64) * 2) = f2bf(nacc[dt][0]); }
    const int qtok = TOKC(c, jrow);
    const bool more = (c + 1 < nc);
    __syncthreads();
    const float Mj = T[128 + jrow], bj = T[256 + jrow]; const float rf = __expf(M_last - Mj), w_inter = __expf(mst - Mj);
    int lq_ = (8 * g + (l15 >> 2)), lp_ = 4 * (l15 & 3); asm volatile("" : "+v"(lq_), "+v"(lp_));
    const LP cB = lds + ML_C + (lq_ * CP + lp_) * 2, vB = lds + ML_V + (lq_ * VP + lp_) * 2, kB = lds + ML_K + (lq_ * KP + lp_ + 32 * wid) * 2;
    const LP pB = lds + ML_P + (jrow * PP + 8 * g) * 2;
    for (int st = 0; st <= rt; ++st) {
      f32x4 s = {0.f, 0.f, 0.f, 0.f};
      bf16x8 kfr[8];
#pragma unroll
      for (int kk = 0; kk < 8; ++kk) kfr[kk] = *(const LAS bf16x8*)(lds + ML_K + ((16 * st + l15) * KP + 32 * kk + 8 * g) * 2);
      __builtin_amdgcn_sched_barrier(0);
#pragma unroll
      for (int kk = 0; kk < 8; ++kk) s = __builtin_amdgcn_mfma_f32_16x16x32_bf16(kfr[kk], qf[kk], s, 0, 0, 0);
      float pv[4];
#pragma unroll
      for (int i = 0; i < 4; ++i) pv[i] = ((16 * st + 4 * g + i) <= jrow) ? s[i] * rf : 0.f;
      u32x2 w; w.x = pack2(pv[0], pv[1]); w.y = pack2(pv[2], pv[3]);
      *(LAS u32x2*)(lds + ML_P + (jrow * PP + 16 * st + 4 * g) * 2) = w;
    }
    if ((rt & 1) == 0) { u32x2 z; z.x = 0u; z.y = 0u; *(LAS u32x2*)(lds + ML_P + (jrow * PP + 16 * (rt + 1) + 4 * g) * 2) = z; }
    if (more) ML_LOAD_KV(c + 1);
    asm volatile("s_waitcnt lgkmcnt(0)" ::: "memory");
    f32x4 ha[5];
#pragma unroll
    for (int vt = 0; vt < 5; ++vt) { f32x4 a = {0.f, 0.f, 0.f, 0.f};
      if (smp || c > 0) {
        bf16x8 cfr[8];
#pragma unroll
        for (int kk = 0; kk < 8; ++kk) cfr[kk] = tr_at(cB, (32 * kk * CP + 16 * vt) * 2, CP * 2);
        __builtin_amdgcn_sched_barrier(0);
#pragma unroll
        for (int kk = 0; kk < 8; ++kk) a = __builtin_amdgcn_mfma_f32_16x16x32_bf16(cfr[kk], qf[kk], a, 0, 0, 0);
        a *= w_inter; }
      ha[vt] = a; }
    for (int k2 = 0; k2 <= (rt >> 1); ++k2) {
      const bf16x8 pf = *(const LAS bf16x8*)(pB + k2 * 64);
      bf16x8 vfr[5];
#pragma unroll
      for (int vt = 0; vt < 5; ++vt) vfr[vt] = tr_at(vB + k2 * (32 * VP * 2), (16 * vt) * 2, VP * 2);
      __builtin_amdgcn_sched_barrier(0);
#pragma unroll
      for (int vt = 0; vt < 5; ++vt) ha[vt] = __builtin_amdgcn_mfma_f32_16x16x32_bf16(vfr[vt], pf, ha[vt], 0, 0, 0); }
    { const float den = __shfl(ha[4][0], l15); const float rdd = __builtin_amdgcn_rcpf(fmaxf(fabsf(den), __expf(-(bj + Mj))));
#pragma unroll
      for (int vt = 0; vt < 4; ++vt) { const f32x4 a = ha[vt] * rdd; u32x2 w; w.x = pack2(a[0], a[1]); w.y = pack2(a[2], a[3]);
        *(u32x2*)(hout + (size_t)qtok * 1024 + head * 256 + sl * 64 + 16 * vt + 4 * g) = w; } }
    if (more) ML_LOAD_Q(c + 1);
    const bool need_state = (!smp) || more;
    if (need_state) {
      const float decay = __expf(mst - M_last);
#pragma unroll
      for (int dt = 0; dt < 2; ++dt) {
#pragma unroll
        for (int vt = 0; vt < 4; ++vt) Cacc[dt][vt] *= decay;
        nacc[dt] *= decay; }
#pragma unroll
      for (int ks = 0; ks < 4; ++ks) {
        const bf16x8 kf0 = tr_at(kB, (32 * ks * KP) * 2, KP * 2), kf1 = tr_at(kB, (32 * ks * KP + 16) * 2, KP * 2);
        bf16x8 vfr[5];
#pragma unroll
        for (int vt = 0; vt < 5; ++vt) vfr[vt] = tr_at(vB, (32 * ks * VP + 16 * vt) * 2, VP * 2);
        __builtin_amdgcn_sched_barrier(0);
#pragma unroll
        for (int vt = 0; vt < 4; ++vt) { Cacc[0][vt] = __builtin_amdgcn_mfma_f32_16x16x32_bf16(vfr[vt], kf0, Cacc[0][vt], 0, 0, 0); Cacc[1][vt] = __builtin_amdgcn_mfma_f32_16x16x32_bf16(vfr[vt], kf1, Cacc[1][vt], 0, 0, 0); }
        nacc[0] = __builtin_amdgcn_mfma_f32_16x16x32_bf16(vfr[4], kf0, nacc[0], 0, 0, 0); nacc[1] = __builtin_amdgcn_mfma_f32_16x16x32_bf16(vfr[4], kf1, nacc[1], 0, 0, 0);
      }
    }
    if (wid == 0 && more) { float mn; ML_SCAN(lds + ML_T + ((c + 1) & 1) * ML_TSZ, mw0, mn); mw0 = mn; }
    m_final = T[256 + 127] + M_last;
    __syncthreads();
  }
#undef ML_LOAD_Q
#undef ML_LOAD_KV
#undef ML_SCAN
#undef TOKC
  if (!smp) {
    float* oC = p.out + OUTF_C + (size_t)sidx * 65536;
#pragma unroll
    for (int dt = 0; dt < 2; ++dt) {
#pragma unroll
      for (int vt = 0; vt < 4; ++vt) *(f32x4*)(oC + (size_t)((2 * wid + dt) * 16 + l15) * 256 + sl * 64 + 16 * vt + 4 * g) = Cacc[dt][vt];
      if (sl == 0 && g == 0) p.out[OUTF_N + (size_t)sidx * 256 + (2 * wid + dt) * 16 + l15] = nacc[dt][0]; }
    if (sl == 0 && tid == 0) p.out[OUTF_M + sidx] = m_final;
  }
}

__device__ void combine_rows(const Params& p) {
  const int tid0 = opaque_tid(); const int wid = tid0 >> 6, lane = tid0 & 63;
  bf16_t* H = (bf16_t*)((unsigned char*)p.out + OUT_H); const bf16_t* HB = (const bf16_t*)((unsigned char*)p.out + OUT_HB); const float* nw = p.in[22];
  f32x4 wv[4];
#pragma unroll
  for (int i = 0; i < 4; ++i) wv[i] = *(const f32x4*)(nw + 16 * lane + 4 * i);
  const int nh = (int)gridDim.x >> 1;
  if ((int)blockIdx.x < nh) return;
  for (int unit = (int)blockIdx.x - nh; unit < 768; unit += (int)gridDim.x - nh) {
    const int row0 = unit * 32 + wid * 4;
    u32x4 a[4][2], bq[4][2];
#pragma unroll
    for (int r = 0; r < 4; ++r)
#pragma unroll
      for (int i = 0; i < 2; ++i) { a[r][i] = *(const u32x4*)(H + (size_t)(row0 + r) * 1024 + 16 * lane + 8 * i); bq[r][i] = *(const u32x4*)(HB + (size_t)(row0 + r) * 1024 + 16 * lane + 8 * i); }
#pragma unroll
    for (int r = 0; r < 4; ++r) {
      f32x4 v[4]; float ss = 0.f;
#pragma unroll
      for (int i = 0; i < 2; ++i) { f32x4 x0, x1, y0, y1; unpack8(a[r][i], x0, x1); unpack8(bq[r][i], y0, y1); v[2 * i] = x0 + y0; v[2 * i + 1] = x1 + y1; }
#pragma unroll
      for (int i = 0; i < 4; ++i) ss += v[i][0] * v[i][0] + v[i][1] * v[i][1] + v[i][2] * v[i][2] + v[i][3] * v[i][3];
      ss += __shfl_xor(ss, 1); ss += __shfl_xor(ss, 2); ss += __shfl_xor(ss, 4); ss += __shfl_xor(ss, 8);
      const float rr = rsqrtf(ss * (1.0f / 256.0f) + 1e-6f);
#pragma unroll
      for (int i = 0; i < 2; ++i) *(u32x4*)(H + (size_t)(row0 + r) * 1024 + 16 * lane + 8 * i) = pack8(v[2 * i] * rr * wv[2 * i], v[2 * i + 1] * rr * wv[2 * i + 1]);
    }
  }
}

constexpr int HY_WAVE = 18816, HY_HR = 0, HY_ZA = 8576, HY_ZB = 8576 + 5120;
__device__ void hyena_item(const Params& p, LP lds, int item) {
  const int tid = opaque_tid(), wid = __builtin_amdgcn_readfirstlane(tid >> 6), lane = tid & 63, n31 = lane & 31, hh = lane >> 5;
  const bool smp = item < 1024; const int it = smp ? item : item - 1024; const int bset = it >> 7, cgp = it & 127; const int c = cgp * 8 + wid;
  const int L = smp ? 2048 : 256, lgL = smp ? 11 : 8, nblk = L >> 5, lgnb = lgL - 5, ntok = 2048, ntile = 2, dmax = L >> 6;
  const int tok0 = smp ? NCTX + bset * 2048 : bset * 2048;
  LP wl = lds + wid * HY_WAVE; LAS float* hr = (LAS float*)(wl + HY_HR);
  const float* HFp = (const float*)(p.ws + (smp ? OFF_HFS : OFF_HFC));
  const bf16_t* UT = (const bf16_t*)(p.ws + OFF_BIG);
  const float* cw = p.in[12]; const float* cbv = p.in[13]; const float* skp = p.in[21];
  { const int uc = 2048 + c; const float w0 = cw[uc], w1 = cw[3072 + uc], w2 = cw[6144 + uc], cb = cbv[uc]; const bf16_t* src = UT + (size_t)uc * NTOK + tok0;
    u32x4 vv[4]; float pvv[4], nxv[4];
#pragma unroll
    for (int i = 0; i < 4; ++i) { const int base = lane * 8 + 512 * i; vv[i] = (u32x4){0u, 0u, 0u, 0u}; pvv[i] = 0.f; nxv[i] = 0.f;
      if (base < ntok) { vv[i] = *(const u32x4*)(src + base); const int tl = base & (L - 1);
        if (tl != 0) pvv[i] = bf2f(src[base - 1]); if (tl + 8 != L) nxv[i] = bf2f(src[base + 8]); } }
#pragma unroll
    for (int i = 0; i < 4; ++i) { const int base = lane * 8 + 512 * i;
      if (base < ntok) { const u32x4 v = vv[i];
        float u[10]; u[0] = pvv[i]; u[1] = bflo(v.x); u[2] = bfhi(v.x); u[3] = bflo(v.y); u[4] = bfhi(v.y); u[5] = bflo(v.z); u[6] = bfhi(v.z); u[7] = bflo(v.w); u[8] = bfhi(v.w); u[9] = nxv[i];
        float o[8];
#pragma unroll
        for (int e = 0; e < 8; ++e) o[e] = cb + w0 * u[e] + w1 * u[e + 1] + w2 * u[e + 2];
        u32x4 w; w.x = pack2(o[0], o[1]); w.y = pack2(o[2], o[3]); w.z = pack2(o[4], o[5]); w.w = pack2(o[6], o[7]);
        *(LAS u32x4*)(wl + HY_ZA + ((base >> 5) * 40 + (base & 31)) * 2) = w; } } }
  const int HRP = L + 96;
  f32x4 fvN[8];
#define HY_FLOAD(o) do { const float* src_ = HFp + (size_t)((o) * 1024 + c) * L; \
    _Pragma("unroll") for (int i = 0; i < 8; ++i) { const int q = lane + 64 * i; fvN[i] = (4 * q < L) ? *(const f32x4*)(src_ + 4 * q) : (f32x4){0.f, 0.f, 0.f, 0.f}; } } while (0)
  HY_FLOAD(0);
  for (int ord = 0; ord < 2; ++ord) {
    { float sa = 0.f;
      f32x4 fv[8];
#pragma unroll
      for (int i = 0; i < 8; ++i) fv[i] = fvN[i];
#pragma unroll
      for (int i = 0; i < 8; ++i) sa += (fabsf(fv[i][0]) + fabsf(fv[i][1])) + (fabsf(fv[i][2]) + fabsf(fv[i][3]));
      sa = wave_sum(sa); const float inv = 1.0f / (sa + 1e-6f);
      asm volatile("s_waitcnt lgkmcnt(0)" ::: "memory");
      LAS bf16_t* E = (LAS bf16_t*)hr; LAS bf16_t* O = E + HRP;
#pragma unroll
      for (int i = 0; i < 8; ++i) { const int q = lane + 64 * i;
        if (4 * q < L) {
#pragma unroll
          for (int e = 0; e < 4; ++e) { const int yy = L - 1 - (4 * q + e); const bf16_t v = f2bf(fv[i][e] * inv); E[32 + yy] = v; O[31 + yy] = v; } } }
      if (lane < 32) { E[lane] = 0; E[32 + L + lane] = 0; O[31 + L + lane] = 0; if (lane < 31) O[lane] = 0; }
      if (lane < 33) O[HRP - 33 + lane] = 0;
      asm volatile("s_waitcnt lgkmcnt(0)" ::: "memory"); }
    if (ord == 0) HY_FLOAD(1);
    LP zin = wl + (ord == 0 ? HY_ZA : HY_ZB); LP zout = wl + (ord == 0 ? HY_ZB : HY_ZA);
    const int gc = ord * 1024 + c; const float w0 = cw[gc], w1 = cw[3072 + gc], w2 = cw[6144 + gc], cb = cbv[gc], sk = skp[ord * 1024 + c];
    const bf16_t* gsrc = UT + (size_t)gc * NTOK + tok0;
    u32x4 gv[4]; unsigned gpv[4], gnx[4];
#pragma unroll
    for (int i = 0; i < 4; ++i) { const int base = lane * 8 + 512 * i; gv[i] = (u32x4){0u, 0u, 0u, 0u}; gpv[i] = 0u; gnx[i] = 0u;
      if (base < ntok) { gv[i] = *(const u32x4*)(gsrc + base); const int tl = base & (L - 1);
        if (tl != 0) gpv[i] = gsrc[base - 1]; if (tl + 8 != L) gnx[i] = gsrc[base + 8]; } }
    f32x16 accs[2];
#pragma unroll
    for (int o2 = 0; o2 < 2; ++o2)
#pragma unroll
      for (int r = 0; r < 16; ++r) accs[o2][r] = 0.f;
    LP fb = wl + HY_HR + ((n31 & 1) ? 0 : (HRP * 2 - 2)) + 2 * ((L >> 1) - 1 - n31 + 8 * hh + 32);
    int cbl[2], ca[2];
#pragma unroll
    for (int ot = 0; ot < 2; ++ot) { const int col = 32 * ot + n31; cbl[ot] = (col >> lgnb) << lgnb; ca[ot] = col & (nblk - 1); }
    const bool two = (ntile == 2);
    {
      LP zero = wl + HY_HR + 16 * hh;
      LP ap = fb + 64 * dmax;
      int bbr0 = ca[0] + dmax, bbr1 = ca[1] + dmax;
      LP bp0 = zin + ((cbl[0] + bbr0) * 40 + 8 * hh) * 2, bp1 = zin + ((cbl[1] + bbr1) * 40 + 8 * hh) * 2;
      for (int d = -dmax; d <= dmax; ++d) {
        u32x4 w0v, w1v;
        w0v.x = *(const LAS unsigned*)(ap); w0v.y = *(const LAS unsigned*)(ap + 4); w0v.z = *(const LAS unsigned*)(ap + 8); w0v.w = *(const LAS unsigned*)(ap + 12);
        w1v.x = *(const LAS unsigned*)(ap + 32); w1v.y = *(const LAS unsigned*)(ap + 36); w1v.z = *(const LAS unsigned*)(ap + 40); w1v.w = *(const LAS unsigned*)(ap + 44);
        const bf16x8 af0 = __builtin_bit_cast(bf16x8, w0v), af1 = __builtin_bit_cast(bf16x8, w1v);
        LP q0 = ((unsigned)bbr0 < (unsigned)nblk) ? bp0 : zero;
        LP q1 = (two && ((unsigned)bbr1 < (unsigned)nblk)) ? bp1 : zero;
        const bf16x8 b00 = *(const LAS bf16x8*)q0, b01 = *(const LAS bf16x8*)(q0 + 32);
        const bf16x8 b10 = *(const LAS bf16x8*)q1, b11 = *(const LAS bf16x8*)(q1 + 32);
        __builtin_amdgcn_sched_barrier(0);
        accs[0] = __builtin_amdgcn_mfma_f32_32x32x16_bf16(af0, b00, accs[0], 0, 0, 0);
        if (two) accs[1] = __builtin_amdgcn_mfma_f32_32x32x16_bf16(af0, b10, accs[1], 0, 0, 0);
        accs[0] = __builtin_amdgcn_mfma_f32_32x32x16_bf16(af1, b01, accs[0], 0, 0, 0);
        if (two) accs[1] = __builtin_amdgcn_mfma_f32_32x32x16_bf16(af1, b11, accs[1], 0, 0, 0);
        ap -= 64; bbr0 -= 1; bbr1 -= 1; bp0 -= 80; bp1 -= 80;
      }
    }
#pragma unroll
    for (int ot = 0; ot < 2; ++ot) {
      if (ot >= ntile) continue;
      const f32x16 acc = accs[ot];
#pragma unroll
      for (int rg = 0; rg < 4; ++rg) {
        const int zo = (((cbl[ot] + ca[ot]) * 40) + 8 * rg + 4 * hh) * 2;
        const u32x2 zv = *(const LAS u32x2*)(zin + zo);
        u32x2 w; w.x = pack2(acc[4 * rg] + sk * bflo(zv.x), acc[4 * rg + 1] + sk * bfhi(zv.x)); w.y = pack2(acc[4 * rg + 2] + sk * bflo(zv.y), acc[4 * rg + 3] + sk * bfhi(zv.y));
        *(LAS u32x2*)(zout + zo) = w;
      }
    }
    asm volatile("s_waitcnt lgkmcnt(0)" ::: "memory");
#pragma unroll
    for (int i = 0; i < 4; ++i) { const int base = lane * 8 + 512 * i;
      if (base < ntok) { const u32x4 v = gv[i];
        float u[10]; u[0] = bf2f(gpv[i]); u[1] = bflo(v.x); u[2] = bfhi(v.x); u[3] = bflo(v.y); u[4] = bfhi(v.y); u[5] = bflo(v.z); u[6] = bfhi(v.z); u[7] = bflo(v.w); u[8] = bfhi(v.w); u[9] = bf2f(gnx[i]);
        LP zp = zout + ((base >> 5) * 40 + (base & 31)) * 2; const u32x4 t = *(const LAS u32x4*)zp;
        float tv[8]; tv[0] = bflo(t.x); tv[1] = bfhi(t.x); tv[2] = bflo(t.y); tv[3] = bfhi(t.y); tv[4] = bflo(t.z); tv[5] = bfhi(t.z); tv[6] = bflo(t.w); tv[7] = bfhi(t.w);
        float o[8];
#pragma unroll
        for (int e = 0; e < 8; ++e) o[e] = (cb + w0 * u[e] + w1 * u[e + 1] + w2 * u[e + 2]) * tv[e];
        u32x4 w; w.x = pack2(o[0], o[1]); w.y = pack2(o[2], o[3]); w.z = pack2(o[4], o[5]); w.w = pack2(o[6], o[7]);
        *(LAS u32x4*)zp = w; } }
    asm volatile("s_waitcnt lgkmcnt(0)" ::: "memory");
  }
  __syncthreads();
  { bf16_t* YH = (bf16_t*)((unsigned char*)p.out + OUT_HB);
    for (int tl = tid; tl < ntok; tl += 512) {
      const int bl = tl >> lgL, tloc = tl & (L - 1); const int zo = ((((bl << lgnb) + (tloc >> 5)) * 40) + (tloc & 31)) * 2;
      unsigned short e[8];
#pragma unroll
      for (int w = 0; w < 8; ++w) e[w] = *(const LAS unsigned short*)(lds + w * HY_WAVE + HY_ZA + zo);
      u32x4 o; o.x = e[0] | ((unsigned)e[1] << 16); o.y = e[2] | ((unsigned)e[3] << 16); o.z = e[4] | ((unsigned)e[5] << 16); o.w = e[6] | ((unsigned)e[7] << 16);
      *(u32x4*)(YH + (size_t)(tok0 + tl) * 1024 + cgp * 8) = o; } }
  __syncthreads();
}

__device__ void final_norm(const Params& p) {
  const int tid0 = opaque_tid(); const int wid = tid0 >> 6, lane = tid0 & 63; const float* fw = p.in[31];
  const float* P = (const float*)(p.ws + OFF_BIG + (size_t)8192 * 4096 * 2); const float* mod = (const float*)(p.ws + OFF_MOD);
  f32x4 wv[4];
#pragma unroll
  for (int i = 0; i < 4; ++i) wv[i] = *(const f32x4*)(fw + 4 * lane + 256 * i);
  for (int unit = blockIdx.x; unit < 768; unit += gridDim.x) {
    const int row0 = unit * 32 + wid * 4; const bool chunkB = row0 >= 16384;
    f32x4 x[4][4];
#pragma unroll
    for (int r = 0; r < 4; ++r)
#pragma unroll
      for (int i = 0; i < 4; ++i) x[r][i] = *(const f32x4*)(p.out + (size_t)(row0 + r) * 1024 + 4 * lane + 256 * i);
    if (chunkB) { const float* md = mod + cond_of_row(row0) * 6144 + 5120;
#pragma unroll
      for (int i = 0; i < 4; ++i) { const f32x4 g2 = *(const f32x4*)(md + 4 * lane + 256 * i);
#pragma unroll
        for (int r = 0; r < 4; ++r) x[r][i] += g2 * *(const f32x4*)(P + (size_t)(row0 + r - 16384) * 1024 + 4 * lane + 256 * i); } }
#pragma unroll
    for (int r = 0; r < 4; ++r) { float ss = 0.f;
#pragma unroll
      for (int i = 0; i < 4; ++i) ss += x[r][i][0] * x[r][i][0] + x[r][i][1] * x[r][i][1] + x[r][i][2] * x[r][i][2] + x[r][i][3] * x[r][i][3];
      ss = wave_sum(ss); const float rstd = rsqrtf(ss * (1.0f / 1024.0f) + 1e-6f);
#pragma unroll
      for (int i = 0; i < 4; ++i) *(f32x4*)(p.out + (size_t)(row0 + r) * 1024 + 4 * lane + 256 * i) = x[r][i] * rstd * wv[i]; }
  }
}

__global__ void __launch_bounds__(512, 2) __attribute__((flatten)) mega(Params p) {
  extern __shared__ __attribute__((aligned(16))) unsigned char shm[];
  LP lds = (LP)shm;
  cg::grid_group grid = cg::this_grid();
  volatile LAS unsigned* xst = (volatile LAS unsigned*)(lds + LDS_BYTES - 16);
  if (threadIdx.x == 0) { xst[0] = 0u; xst[1] = 0u; }
  __syncthreads();
  const XcdBarrier xb = xcd_barrier_post((unsigned*)(p.ws + OFF_BAR), xst);
  unsigned char* ws = p.ws;
  const bf16_t* WT = (const bf16_t*)(ws + OFF_WT); const bf16_t* HN = (const bf16_t*)(ws + OFF_HN); bf16_t* BIG = (bf16_t*)(ws + OFF_BIG);
  bf16_t* Hb = (bf16_t*)((unsigned char*)p.out + OUT_H); bf16_t* YH = (bf16_t*)((unsigned char*)p.out + OUT_HB);
  const float* mod = (const float*)(ws + OFF_MOD);
  phase0(p, lds);
  if (gridDim.y == 7u) grid.sync();
  xcd_barrier(xb);
  phase1(p, lds);
  weight_tiles(p, lds, 0, 384, 0);
  xcd_barrier(xb);
  filters_upper_half(p, lds);
  weight_tiles(p, lds, 384, 768, 1);
  { EpiQKV e; e.O = BIG; e.bias = p.in[11]; run_gemm(lds, HN, WT, NTOK, 3072, 1024, e); }
  xcd_barrier(xb);
  for (int item = blockIdx.x; item < 1280; item += gridDim.x) mlstm_item(p, lds, item);
  xcd_barrier(xb);
  combine_rows(p);
  weight_tiles(p, lds, 768, 1152, 1);
  { EpiUT e; e.O = BIG; e.bias = p.in[11] + 4112; run_gemm(lds, WT + (size_t)3072 * 1024, HN, 3072, NTOK, 1024, e); }
  xcd_barrier(xb);
  for (int item = blockIdx.x; item < 1536; item += gridDim.x) hyena_item(p, lds, item);
  xcd_barrier(xb);
  c1_upper_half(p, lds);
  weight_tiles(p, lds, 1152, 1536, 1);
  { EpiGates e; e.H = Hb; e.G = BIG; e.b_in = p.in[11]; run_gemm(lds, HN, WT + (size_t)6144 * 1024, NTOK, 3072, 1024, e); }
  xcd_barrier(xb);
  bf16_t* T = BIG + (size_t)NTOK * 2048;
  weight_tiles(p, lds, 1536, 2560, 1);
  { EpiMerge<0> e; e.T = T; e.G = BIG; run_gemm(lds, Hb, (const bf16_t*)(ws + OFF_WBM), NTOK, 1024, 1024, e); }
  { EpiMerge<1> e; e.T = T; e.G = BIG; run_gemm(lds, YH, (const bf16_t*)(ws + OFF_WBH), NTOK, 1024, 1024, e); }
  xcd_barrier(xb);
  { EpiOut e; e.xp = p.in[0]; e.xs = p.in[1]; e.per = (const float*)(ws + OFF_PER); e.pec = (const float*)(ws + OFF_PEC); e.mod = mod; e.n2w = p.in[26];
    e.X1 = p.out; e.A2 = (bf16_t*)(ws + OFF_HN); e.ssq = (float*)(ws + OFF_SSQ1); run_gemm(lds, T, (const bf16_t*)(ws + OFF_WOUT), NTOK, 1024, 1024, e); }
  xcd_barrier(xb);
  constexpr int ROWS_A = 16384, ROWS_B = NTOK - ROWS_A;
  { EpiFF1 e; e.row0 = 0; e.ssq = (const float*)(p.ws + OFF_SSQ1); e.c1 = (const float*)(p.ws + OFF_C1); e.Hd = (bf16_t*)(p.ws + OFF_BIG);
    run_gemm(lds, (const bf16_t*)(p.ws + OFF_HN), (const bf16_t*)(p.ws + OFF_W1T), ROWS_A, 4096, 1024, e); }
  xcd_barrier(xb);
  { EpiFF2 e; e.row0 = 0; e.mod = (const float*)(p.ws + OFF_MOD); e.b2 = p.in[30]; e.X = p.out; e.P = (float*)(p.ws + OFF_BIG + (size_t)ROWS_A * 4096 * 2);
    run_gemm(lds, (const bf16_t*)(p.ws + OFF_BIG), (const bf16_t*)(p.ws + OFF_W2T), ROWS_A, 1024, 4096, e); }
  xcd_barrier(xb);
  { EpiFF1 e; e.row0 = ROWS_A; e.ssq = (const float*)(p.ws + OFF_SSQ1); e.c1 = (const float*)(p.ws + OFF_C1); e.Hd = (bf16_t*)(p.ws + OFF_BIG);
    run_gemm(lds, (const bf16_t*)(p.ws + OFF_HN) + (size_t)ROWS_A * 1024, (const bf16_t*)(p.ws + OFF_W1T), ROWS_B, 4096, 1024, e); }
  xcd_barrier(xb);
  { EpiFF2 e; e.row0 = ROWS_A; e.mod = (const float*)(p.ws + OFF_MOD); e.b2 = p.in[30]; e.X = p.out; e.P = (float*)(p.ws + OFF_BIG + (size_t)ROWS_B * 4096 * 2);
    run_gemm(lds, (const bf16_t*)(p.ws + OFF_BIG), (const bf16_t*)(p.ws + OFF_W2T), ROWS_B, 1024, 4096, e, 2); }
  xcd_barrier(xb);
  final_norm(p);
}

extern "C" void kernel_launch(void* const* d_in, const int* in_sizes, int n_in, void* d_out, int out_size, void* d_ws, size_t ws_size, hipStream_t stream) {
  static int grid_blocks = 0;
  if (!grid_blocks) {
    int dev = 0, cus = 0, per_cu = 0;
    hipGetDevice(&dev);
    hipDeviceGetAttribute(&cus, hipDeviceAttributeMultiprocessorCount, dev);
    hipFuncSetAttribute((const void*)mega, hipFuncAttributeMaxDynamicSharedMemorySize, LDS_BYTES);
    hipOccupancyMaxActiveBlocksPerMultiprocessor(&per_cu, (const void*)mega, 512, LDS_BYTES);
    if (per_cu < 1) { fprintf(stderr, "kernel_launch: occupancy query reports %d blocks per CU\n", per_cu); grid_blocks = -1; }
    else grid_blocks = cus;
    if (n_in != 32 || ws_size < WS_END) { fprintf(stderr, "kernel_launch: unexpected n_in %d / ws_size %zu (need %zu)\n", n_in, ws_size, (size_t)WS_END); grid_blocks = -1; }
  }
  if (grid_blocks < 0) return;
  hipMemsetAsync((unsigned char*)d_ws + OFF_BAR, 0, 3456 * 4, stream);
  Params p{};
  for (int i = 0; i < 32; ++i) p.in[i] = (const float*)d_in[i];
  p.out = (float*)d_out; p.ws = (unsigned char*)d_ws;
  void* args[] = {&p};
  hipError_t e = hipLaunchCooperativeKernel((void*)mega, dim3(grid_blocks), dim3(512), args, LDS_BYTES, stream);
  if (e != hipSuccess) fprintf(stderr, "cooperative launch failed: %s (grid %d)\n", hipGetErrorString(e), grid_blocks);
}
```

```cpp
#include <hip/hip_runtime.h>
#include <hip/hip_cooperative_groups.h>
#include <cstdio>
#include <cstdint>
namespace cg = cooperative_groups;

#define LAS __attribute__((address_space(3)))
typedef LAS unsigned char* LP;
typedef unsigned short bf16_t;
typedef short bf16x8 __attribute__((ext_vector_type(8)));
typedef short s16x4 __attribute__((ext_vector_type(4)));
typedef float f32x4 __attribute__((ext_vector_type(4)));
typedef float f32x16 __attribute__((ext_vector_type(16)));
typedef unsigned u32x4 __attribute__((ext_vector_type(4)));
typedef unsigned u32x2 __attribute__((ext_vector_type(2)));

constexpr int DM = 1024, NTOK = 24576, NCTX = 8192, SEQC = 256, SEQS = 2048, INC = 9232;
constexpr int LDS_BYTES = 160 * 1024;
constexpr size_t OFF_WT = 0;
constexpr size_t OFF_WBM = 18874368, OFF_WBH = 20971520, OFF_WOUT = 23068672, OFF_W1T = 25165824, OFF_W2T = 33554432;
constexpr size_t OFF_HN = 41943040;
constexpr size_t OFF_BIG = 92274688;
constexpr size_t OFF_SM = 243269632;
constexpr size_t OFF_MOD = OFF_SM;
constexpr size_t OFF_C1 = OFF_MOD + 221184;
constexpr size_t OFF_H2S = OFF_C1 + 147456;
constexpr size_t OFF_H2C = OFF_H2S + 524288;
constexpr size_t OFF_PER = OFF_H2C + 65536;
constexpr size_t OFF_PEC = OFF_PER + 65536;
constexpr size_t OFF_GT = OFF_PEC + 131072;
constexpr size_t OFF_SSQ1 = OFF_GT + 1572864;
constexpr size_t OFF_SSQ2 = OFF_SSQ1 + 1572864;
constexpr size_t OFF_HFS = OFF_SSQ2 + 1572864;
constexpr size_t OFF_HFC = OFF_HFS + 16777216;
constexpr size_t OFF_BAR = OFF_HFC + 2097152;
constexpr size_t WS_END = OFF_BAR + 3456 * 4;
constexpr size_t OUT_H = 0, OUT_HB = 50331648;
constexpr size_t OUTF_C = 25165824, OUTF_N = 41943040, OUTF_M = 42008576;

struct Params { const float* in[32]; float* out; unsigned char* ws; };

typedef float f32x2 __attribute__((ext_vector_type(2)));
typedef __bf16 bf16x2v __attribute__((ext_vector_type(2)));
__device__ __forceinline__ bf16_t f2bf(float f) { const __bf16 b = (__bf16)f; return __builtin_bit_cast(unsigned short, b); }
__device__ __forceinline__ float bf2f(unsigned b) { return __uint_as_float(b << 16); }
__device__ __forceinline__ unsigned pack2(float lo, float hi) { const f32x2 v = {lo, hi}; const bf16x2v r = __builtin_convertvector(v, bf16x2v); return __builtin_bit_cast(unsigned, r); }
__device__ __forceinline__ float bflo(unsigned w) { return __uint_as_float(w << 16); }
__device__ __forceinline__ float bfhi(unsigned w) { return __uint_as_float(w & 0xffff0000u); }
__device__ __forceinline__ float sigmoidf_(float x) { return __builtin_amdgcn_rcpf(1.0f + __expf(-x)); }
__device__ __forceinline__ int opaque_tid() { int t = threadIdx.x; asm volatile("" : "+v"(t)); return t; }
__device__ __forceinline__ float wave_sum(float v) {
#pragma unroll
  for (int o = 32; o >= 1; o >>= 1) v += __shfl_xor(v, o);
  return v;
}


#define XB_TMO      128
#define XB_XCNT(j)  (256  + 64 * (j))
#define XB_XSUB(j)  (1280 + 64 * (j))
#define XB_XGEN(j)  (2304 + 64 * (j))
#define XB_TOP      3328
#define XB_TOPGEN   3392
#define XCD_BAR_WORDS 3456
#define XB_SPIN_CAP (1u << 18)
__device__ __forceinline__ unsigned xb_ld(unsigned* p)              { return __hip_atomic_load(p, __ATOMIC_RELAXED, __HIP_MEMORY_SCOPE_AGENT); }
__device__ __forceinline__ unsigned xb_add(unsigned* p, unsigned v) { return __hip_atomic_fetch_add(p, v, __ATOMIC_RELAXED, __HIP_MEMORY_SCOPE_AGENT); }
__device__ __forceinline__ unsigned xb_xcc_id() { return (unsigned)__builtin_amdgcn_s_getreg((3 << 11) | 20) & 0xFu; }
#define XB_SPIN(cond, bar) do { unsigned _sp = 0; while (cond) { __builtin_amdgcn_s_sleep(1); \
    if ((++_sp & 255u) == 0u) { if (xb_ld(&(bar)[XB_TMO])) break; if (_sp > XB_SPIN_CAP) { atomicAdd(&(bar)[XB_TMO], 1u); break; } } } } while (0)
struct XcdBarrier { unsigned* bar; unsigned x; volatile LAS unsigned* st; };
__device__ __forceinline__ XcdBarrier xcd_barrier_post(unsigned* bar, volatile LAS unsigned* st) {
  XcdBarrier b; b.bar = bar; b.x = xb_xcc_id(); b.st = st;
  if (threadIdx.x == 0) (void)xb_add(&bar[XB_XCNT(b.x)], 1u);
  return b;
}
__device__ __forceinline__ void xcd_barrier_complete(unsigned* bar, unsigned x, unsigned& nloc, unsigned& nx) {
  const unsigned G = gridDim.x * gridDim.y * gridDim.z;
  unsigned sum, cnt, mine, sp = 0u;
  for (;;) {
    sum = 0u; cnt = 0u; mine = 0u;
#pragma unroll
    for (unsigned j = 0; j < 16; ++j) { const unsigned c = xb_ld(&bar[XB_XCNT(j)]); sum += c; cnt += (c > 0u) ? 1u : 0u; mine = (j == x) ? c : mine; }
    if (sum == G) break;
    __builtin_amdgcn_s_sleep(1);
    if ((++sp & 255u) == 0u) { if (xb_ld(&bar[XB_TMO])) break; if (sp > XB_SPIN_CAP) { atomicAdd(&bar[XB_TMO], 1u); break; } }
  }
  nloc = mine > 0u ? mine : 1u; nx = cnt > 0u ? cnt : 1u;
}
__device__ __forceinline__ void xcd_barrier(const XcdBarrier& b) {
  asm volatile("s_waitcnt vmcnt(0)" ::: "memory");
  __syncthreads();
  if (threadIdx.x == 0) {
    unsigned* bar = b.bar;
    __builtin_amdgcn_s_waitcnt(0);
    unsigned nloc = b.st[0], nx = b.st[1];
    if (nloc == 0u) { xcd_barrier_complete(bar, b.x, nloc, nx); b.st[0] = nloc; b.st[1] = nx; }
    const unsigned old = xb_add(&bar[XB_XSUB(b.x)], 1u);
    const unsigned gen = old / nloc;
    if (old + 1u == (gen + 1u) * nloc) {
      __builtin_amdgcn_fence(__ATOMIC_RELEASE, "agent");
      asm volatile("s_waitcnt vmcnt(0)" ::: "memory");
      const unsigned og = xb_add(&bar[XB_TOP], 1u);
      const unsigned tg = og / nx;
      if (og + 1u == (tg + 1u) * nx) xb_add(&bar[XB_TOPGEN], 1u);
      else XB_SPIN(xb_ld(&bar[XB_TOPGEN]) == tg, bar);
      __builtin_amdgcn_fence(__ATOMIC_ACQUIRE, "agent");
      xb_add(&bar[XB_XGEN(b.x)], 1u);
      asm volatile("s_waitcnt vmcnt(0)" ::: "memory");
    } else {
      XB_SPIN(xb_ld(&bar[XB_XGEN(b.x)]) == gen, bar);
      __builtin_amdgcn_fence(__ATOMIC_ACQUIRE, "agent");
      asm volatile("s_waitcnt vmcnt(0)" ::: "memory");
    }
  }
  __syncthreads();
}

namespace pg8 {
constexpr int BM = 256, BK = 64, HALF = 128, HTB = HALF * BK * 2, STAGE_BYTES = 8 * HTB, NXCD = 8, WGM = 8;
__host__ __device__ __forceinline__ int lds_byte(int r, int c) { const int st = (r >> 4) * 2 + (c >> 5), rr = r & 15, cc = c & 31, ob = rr * 64 + cc * 2; return st * 1024 + (ob ^ (((ob >> 9) & 1) << 5)); }
__host__ __device__ __forceinline__ void stage_rc(int b, int& R, int& C) { const int st = b / 1024, sb = b % 1024, swz = sb ^ (((sb >> 9) & 1) << 5); R = (st >> 1) * 16 + swz / 64; C = (st & 1) * 32 + (swz % 64) / 2; }
__host__ __device__ __forceinline__ int perm32(int rho) { const int n = rho >> 4, i = rho & 15; return 8 * (i >> 2) + 4 * n + (i & 3); }
struct Unit { int pm, pn, ks; };
struct Gemm { const bf16_t* A; const bf16_t* Bt; int M, N, K, ld, nks; };
struct StaticOrder {
  int nM, nN, ntile, nwg, G, c;
  __device__ void init(int M, int N, int nks, int G_, int c_) { nM = M / BM; nN = N / BM; ntile = nM * nN; nwg = ntile * nks; G = G_; c = c_; }
  __device__ bool next(int i, Unit& u) const {
    const long L = (long)i * G + c; if (L >= nwg) return false;
    u.ks = (int)L / ntile; int wgid = (int)L - u.ks * ntile;
    { const int q = ntile / NXCD, r = ntile % NXCD, xcd = wgid % NXCD, off = wgid / NXCD; wgid = (xcd < r ? xcd * (q + 1) : r * (q + 1) + (xcd - r) * q) + off; }
    const int nig = WGM * nN, gid = wgid / nig, fm = gid * WGM, gsz = (nM - fm) < WGM ? (nM - fm) : WGM;
    u.pm = fm + ((wgid % nig) % gsz); u.pn = (wgid % nig) / gsz; return true;
  }
};

template <class Epi>
__device__ __forceinline__ void gemm_phase(LP lds, const Gemm g, const StaticOrder& S, const Epi& E) {
  int tid_ = threadIdx.x; asm volatile("" : "+v"(tid_));
  const int tid = tid_, wid = __builtin_amdgcn_readfirstlane(tid >> 6), lane = tid & 63, wr = wid >> 2, wc = wid & 3, fr = lane & 15, fq = lane >> 4;
  const int K = g.ld, nt = g.K / BK;
  const size_t ksb = (size_t)g.K * 2;
  unsigned voffA[2], voffB[2];
#pragma unroll
  for (int i = 0; i < 2; ++i) { int R, C; stage_rc(tid * 16 + i * 8192, R, C); const int Rb = (R & ~31) + perm32(R & 31); voffA[i] = (unsigned)(R * K + C) * 2u; voffB[i] = (unsigned)(Rb * K + C) * 2u; }
  const size_t kstep = (size_t)(BK * 2);
  const size_t hstep = (size_t)HALF * K * 2;
  const size_t tstep = 2 * hstep;
  const unsigned ldsw = (unsigned)wid * 1024u;
  const int aoff = lds_byte(wr * 64 + fr, fq * 8), boff = lds_byte(wc * 32 + fr, fq * 8);
#define PG8_SA(b, h) (((b) * 2 + (h)) * HTB)
#define PG8_SB(b, h) ((4 + (b) * 2 + (h)) * HTB)
#define PG8_STAGE(bufoff, gbase, voff) do { _Pragma("unroll") for (int _i = 0; _i < 2; ++_i) \
    __builtin_amdgcn_global_load_lds((const unsigned*)((const char*)(gbase) + (voff)[_i]), (LAS unsigned*)(lds + (bufoff) + ldsw + _i * 8192), 16, 0, 0); } while (0)
#define PG8_LDA(dst, b, h) do { _Pragma("unroll") for (int m = 0; m < 4; ++m) _Pragma("unroll") for (int k = 0; k < 2; ++k) dst[m][k] = *(const LAS bf16x8*)(lds + PG8_SA(b, h) + aoff + m * 2048 + k * 1024); } while (0)
#define PG8_LDB(dst, b, h) do { _Pragma("unroll") for (int n = 0; n < 2; ++n) _Pragma("unroll") for (int k = 0; k < 2; ++k) dst[n][k] = *(const LAS bf16x8*)(lds + PG8_SB(b, h) + boff + n * 2048 + k * 1024); } while (0)
#define PG8_MMA(ai, bj, At, Bt) do { __builtin_amdgcn_s_setprio(1); _Pragma("unroll") for (int m = 0; m < 4; ++m) _Pragma("unroll") for (int n = 0; n < 2; ++n) _Pragma("unroll") for (int k = 0; k < 2; ++k) \
    acc[ai][bj][m][n] = __builtin_amdgcn_mfma_f32_16x16x32_bf16(Bt[n][k], At[m][k], acc[ai][bj][m][n], 0, 0, 0); __builtin_amdgcn_s_setprio(0); } while (0)
#define PG8_WAIT_V(n) asm volatile("s_waitcnt vmcnt(" #n ")" ::: "memory")
#define PG8_WAIT_L(n) asm volatile("s_waitcnt lgkmcnt(" #n ")" ::: "memory")
#define PG8_BAR __builtin_amdgcn_s_barrier()
#define PG8_SCHED __builtin_amdgcn_sched_barrier(0)
  Unit cur, nxt; int ui = 0;
  if (!S.next(0, cur)) return;
  f32x4 acc[2][2][4][2];
#pragma unroll
  for (int a = 0; a < 2; ++a)
#pragma unroll
    for (int b = 0; b < 2; ++b)
#pragma unroll
      for (int m = 0; m < 4; ++m)
#pragma unroll
        for (int n = 0; n < 2; ++n) acc[a][b][m][n] = (f32x4){0.f, 0.f, 0.f, 0.f};
  bf16x8 At[4][2], B0[2][2], B1[2][2];
  const char* cA = (const char*)g.A + (size_t)cur.pm * tstep + cur.ks * ksb; const char* cB = (const char*)g.Bt + (size_t)cur.pn * tstep + cur.ks * ksb;
  PG8_STAGE(PG8_SB(0, 0), cB, voffB); PG8_STAGE(PG8_SB(0, 1), cB + hstep, voffB); PG8_STAGE(PG8_SA(0, 0), cA, voffA); PG8_STAGE(PG8_SA(0, 1), cA + hstep, voffA);
  if (wr == 1) PG8_BAR;
  PG8_WAIT_V(2); PG8_BAR;
  PG8_STAGE(PG8_SB(1, 0), cB + kstep, voffB); PG8_STAGE(PG8_SA(1, 0), cA + kstep, voffA); PG8_STAGE(PG8_SB(1, 1), cB + hstep + kstep, voffB);
  PG8_WAIT_V(6); PG8_BAR;
  for (;;) {
    const bool has_next = S.next(ui + 1, nxt);
    const char* nA = has_next ? (const char*)g.A + (size_t)nxt.pm * tstep + nxt.ks * ksb : cA; const char* nB = has_next ? (const char*)g.Bt + (size_t)nxt.pn * tstep + nxt.ks * ksb : cB;
    for (int t = 0; t < nt; t += 2) {
      const bool last = (t == nt - 2);
      const char* a1 = cA + (size_t)(t + 1) * kstep;
      const char* a2 = last ? nA : cA + (size_t)(t + 2) * kstep; const char* b2 = last ? nB : cB + (size_t)(t + 2) * kstep;
      const char* a3 = a2 + kstep; const char* b3 = b2 + kstep;
      PG8_LDB(B0, 0, 0); PG8_LDB(B1, 0, 1); PG8_SCHED; PG8_LDA(At, 0, 0); PG8_STAGE(PG8_SA(1, 1), a1 + hstep, voffA);
      PG8_WAIT_V(8); PG8_WAIT_L(0); PG8_BAR; PG8_MMA(0, 0, At, B0); PG8_MMA(0, 1, At, B1); PG8_BAR; PG8_SCHED;
      PG8_LDA(At, 0, 1); PG8_STAGE(PG8_SB(0, 0), b2, voffB); PG8_STAGE(PG8_SB(0, 1), b2 + hstep, voffB); PG8_STAGE(PG8_SA(0, 0), a2, voffA);
      PG8_WAIT_V(8); PG8_WAIT_L(0); PG8_BAR; PG8_MMA(1, 0, At, B0); PG8_MMA(1, 1, At, B1); PG8_BAR; PG8_SCHED;
      PG8_LDB(B0, 1, 0); PG8_LDB(B1, 1, 1); PG8_SCHED; PG8_LDA(At, 1, 0); PG8_STAGE(PG8_SA(0, 1), a2 + hstep, voffA);
      PG8_WAIT_V(8); PG8_WAIT_L(0); PG8_BAR; PG8_MMA(0, 0, At, B0); PG8_MMA(0, 1, At, B1); PG8_BAR; PG8_SCHED;
      PG8_LDA(At, 1, 1); PG8_STAGE(PG8_SB(1, 0), b3, voffB); PG8_STAGE(PG8_SB(1, 1), b3 + hstep, voffB); PG8_STAGE(PG8_SA(1, 0), a3, voffA);
      PG8_WAIT_V(8); PG8_WAIT_L(0); PG8_BAR; PG8_MMA(1, 0, At, B0); PG8_MMA(1, 1, At, B1); PG8_BAR; PG8_SCHED;
    }
    if (wr == 0) PG8_BAR;
    { int fr2 = fr, fq2 = fq; asm volatile("" : "+v"(fr2), "+v"(fq2)); E(acc, cur, wr, wc, fr2, fq2); }
    if (!has_next) break;
#pragma unroll
    for (int a = 0; a < 2; ++a)
#pragma unroll
      for (int b = 0; b < 2; ++b)
#pragma unroll
        for (int m = 0; m < 4; ++m)
#pragma unroll
          for (int n = 0; n < 2; ++n) acc[a][b][m][n] = (f32x4){0.f, 0.f, 0.f, 0.f};
    cur = nxt; cA = nA; cB = nB; ++ui;
    if (wr == 1) PG8_BAR;
  }
  PG8_WAIT_V(0);
  PG8_BAR;
#undef PG8_SA
#undef PG8_SB
#undef PG8_STAGE
#undef PG8_LDA
#undef PG8_LDB
#undef PG8_MMA
#undef PG8_WAIT_V
#undef PG8_WAIT_L
#undef PG8_BAR
#undef PG8_SCHED
}
}
using pg8::Unit;
typedef f32x4 AccT[2][2][4][2];

#define EPI_ROW(ai, m) (u.pm * 256 + (ai) * 128 + wr * 64 + (m) * 16 + fr)
#define EPI_COL(bj, n) (u.pn * 256 + (bj) * 128 + wc * 32 + 8 * fq + 4 * (n))
#define EPI_LOOP_ROWS _Pragma("unroll") for (int ai = 0; ai < 2; ++ai) _Pragma("unroll") for (int m = 0; m < 4; ++m)
#define EPI_LOOP_COLS _Pragma("unroll") for (int bj = 0; bj < 2; ++bj) _Pragma("unroll") for (int n = 0; n < 2; ++n)

__device__ __forceinline__ int cond_of_row(int row) { return row < NCTX ? 0 : 1 + ((row - NCTX) >> 11); }

#define EPI_LOOP_BJ _Pragma("unroll") for (int bj = 0; bj < 2; ++bj)
__device__ __forceinline__ u32x4 pack8(const f32x4 v0, const f32x4 v1) { u32x4 w; w.x = pack2(v0[0], v0[1]); w.y = pack2(v0[2], v0[3]); w.z = pack2(v1[0], v1[1]); w.w = pack2(v1[2], v1[3]); return w; }
__device__ __forceinline__ void unpack8(const u32x4 w, f32x4& v0, f32x4& v1) { v0[0] = bflo(w.x); v0[1] = bfhi(w.x); v0[2] = bflo(w.y); v0[3] = bfhi(w.y); v1[0] = bflo(w.z); v1[1] = bfhi(w.z); v1[2] = bflo(w.w); v1[3] = bfhi(w.w); }
struct EpiQKV {
  bf16_t* O; const float* bias;
  __device__ __forceinline__ void operator()(const AccT& acc, const Unit& u, int wr, int wc, int fr, int fq) const {
    const float sc = (u.pn < 4) ? 0.0625f : 1.0f;
    f32x4 bv[2][2];
    EPI_LOOP_COLS { bv[bj][n] = *(const f32x4*)(bias + EPI_COL(bj, n)); }
    EPI_LOOP_ROWS { const int row = EPI_ROW(ai, m);
      EPI_LOOP_BJ { *(u32x4*)(O + (size_t)row * 3072 + EPI_COL(bj, 0)) = pack8((acc[ai][bj][m][0] + bv[bj][0]) * sc, (acc[ai][bj][m][1] + bv[bj][1]) * sc); } }
  }
};
struct EpiUT {
  bf16_t* O; const float* bias;
  __device__ __forceinline__ void operator()(const AccT& acc, const Unit& u, int wr, int wc, int fr, int fq) const {
    EPI_LOOP_ROWS { const int row = EPI_ROW(ai, m); const float bv = bias[row];
      EPI_LOOP_BJ { *(u32x4*)(O + (size_t)row * NTOK + EPI_COL(bj, 0)) = pack8(acc[ai][bj][m][0] + bv, acc[ai][bj][m][1] + bv); } }
  }
};
struct EpiGates {
  bf16_t* H; bf16_t* G; const float* b_in;
  __device__ __forceinline__ void operator()(const AccT& acc, const Unit& u, int wr, int wc, int fr, int fq) const {
    const bool og = u.pn < 4;
    f32x4 bv[2][2];
    EPI_LOOP_COLS { const int col = EPI_COL(bj, n); bv[bj][n] = *(const f32x4*)(b_in + (og ? 3072 + col : 7184 + (col - 1024))); }
#pragma unroll
    for (int ai = 0; ai < 2; ++ai)
#pragma unroll
      for (int m2 = 0; m2 < 2; ++m2) {
        u32x4 hv[2][2];
        if (og) {
#pragma unroll
          for (int mm = 0; mm < 2; ++mm) { const int row = EPI_ROW(ai, 2 * m2 + mm); EPI_LOOP_BJ { hv[mm][bj] = *(const u32x4*)(H + (size_t)row * 1024 + EPI_COL(bj, 0)); } } }
#pragma unroll
        for (int mm = 0; mm < 2; ++mm) { const int m = 2 * m2 + mm; const int row = EPI_ROW(ai, m);
          EPI_LOOP_BJ { const int col = EPI_COL(bj, 0); f32x4 s0, s1; const f32x4 a0 = acc[ai][bj][m][0] + bv[bj][0], a1 = acc[ai][bj][m][1] + bv[bj][1];
#pragma unroll
            for (int e = 0; e < 4; ++e) { s0[e] = sigmoidf_(a0[e]); s1[e] = sigmoidf_(a1[e]); }
            if (og) { f32x4 h0, h1; unpack8(hv[mm][bj], h0, h1); *(u32x4*)(H + (size_t)row * 1024 + col) = pack8(h0 * s0, h1 * s1); }
            else *(u32x4*)(G + (size_t)row * 2048 + (col - 1024)) = pack8(s0, s1); } } }
  }
};
template <int SECOND> struct EpiMerge {
  bf16_t* T; const bf16_t* G;
  __device__ __forceinline__ void operator()(const AccT& acc, const Unit& u, int wr, int wc, int fr, int fq) const {
#pragma unroll
    for (int ai = 0; ai < 2; ++ai)
#pragma unroll
      for (int m2 = 0; m2 < 2; ++m2) {
        u32x4 gv[2][2], tv[2][2];
#pragma unroll
        for (int mm = 0; mm < 2; ++mm) { const int row = EPI_ROW(ai, 2 * m2 + mm);
          EPI_LOOP_BJ { const int col = EPI_COL(bj, 0); gv[mm][bj] = *(const u32x4*)(G + (size_t)row * 2048 + SECOND * 1024 + col);
            if (SECOND) tv[mm][bj] = *(const u32x4*)(T + (size_t)row * 1024 + col); } }
#pragma unroll
        for (int mm = 0; mm < 2; ++mm) { const int m = 2 * m2 + mm; const int row = EPI_ROW(ai, m);
          EPI_LOOP_BJ { const int col = EPI_COL(bj, 0); f32x4 g0, g1; unpack8(gv[mm][bj], g0, g1);
            f32x4 v0 = g0 * acc[ai][bj][m][0], v1 = g1 * acc[ai][bj][m][1];
            if (SECOND) { f32x4 t0, t1; unpack8(tv[mm][bj], t0, t1); v0 += t0; v1 += t1; }
            *(u32x4*)(T + (size_t)row * 1024 + col) = pack8(v0, v1); } } }
  }
};
struct EpiOut {
  const float* xp; const float* xs; const float* per; const float* pec; const float* mod; const float* n2w; float* X1; bf16_t* A2; float* ssq;
  __device__ __forceinline__ void operator()(const AccT& acc, const Unit& u, int wr, int wc, int fr, int fq) const {
    const int cb = cond_of_row(u.pm * 256); const float* md = mod + cb * 6144; const bool smp = (u.pm * 256) >= NCTX;
    f32x4 g1v[2][2], k2v[2][2];
    EPI_LOOP_COLS { const int col = EPI_COL(bj, n); g1v[bj][n] = *(const f32x4*)(md + 2048 + col); k2v[bj][n] = *(const f32x4*)(n2w + col) * (*(const f32x4*)(md + 4096 + col) + 1.0f); }
    EPI_LOOP_ROWS { const int row = EPI_ROW(ai, m); float ss = 0.f;
#pragma unroll
      for (int bj = 0; bj < 2; ++bj) {
        f32x4 x0[2];
        if (!smp) {
#pragma unroll
          for (int n = 0; n < 2; ++n) x0[n] = *(const f32x4*)(xp + (size_t)row * 1024 + EPI_COL(bj, n)); }
        else { const int r2 = row - NCTX, t = r2 & 2047; f32x4 pe[2];
#pragma unroll
          for (int n = 0; n < 2; ++n) { const int col = EPI_COL(bj, n); x0[n] = *(const f32x4*)(xs + (size_t)r2 * 1024 + col);
            pe[n] = (col < 512) ? *(const f32x4*)(per + (t >> 6) * 512 + col) : *(const f32x4*)(pec + (t & 63) * 512 + (col - 512)); }
#pragma unroll
          for (int n = 0; n < 2; ++n) x0[n] += pe[n]; }
        f32x4 x1[2];
#pragma unroll
        for (int n = 0; n < 2; ++n) { x1[n] = x0[n] + g1v[bj][n] * acc[ai][bj][m][n]; *(f32x4*)(X1 + (size_t)row * 1024 + EPI_COL(bj, n)) = x1[n];
          ss += x1[n][0] * x1[n][0] + x1[n][1] * x1[n][1] + x1[n][2] * x1[n][2] + x1[n][3] * x1[n][3]; }
        *(u32x4*)(A2 + (size_t)row * 1024 + EPI_COL(bj, 0)) = pack8(x1[0] * k2v[bj][0], x1[1] * k2v[bj][1]); }
      ss += __shfl_xor(ss, 16); ss += __shfl_xor(ss, 32);
      if (fq == 0) ssq[(size_t)row * 16 + u.pn * 4 + wc] = ss; }
  }
};
struct EpiFF1 {
  int row0; const float* ssq; const float* c1; bf16_t* Hd;
  __device__ __forceinline__ void operator()(const AccT& acc, const Unit& u, int wr, int wc, int fr, int fq) const {
    const int cb = cond_of_row(row0 + u.pm * 256); const float* cc = c1 + cb * 4096;
    f32x4 cv[2][2];
    EPI_LOOP_COLS { cv[bj][n] = *(const f32x4*)(cc + EPI_COL(bj, n)); }
    float rs[2][4];
    EPI_LOOP_ROWS { const float* sp = ssq + (size_t)(row0 + EPI_ROW(ai, m)) * 16;
      const f32x4 st = (*(const f32x4*)sp + *(const f32x4*)(sp + 4)) + (*(const f32x4*)(sp + 8) + *(const f32x4*)(sp + 12));
      rs[ai][m] = rsqrtf((st[0] + st[1] + st[2] + st[3]) * (1.0f / 1024.0f) + 1e-6f); }
    EPI_LOOP_ROWS { const int rl = EPI_ROW(ai, m); const float rstd = rs[ai][m];
      EPI_LOOP_BJ { f32x4 v0 = acc[ai][bj][m][0] * rstd + cv[bj][0], v1 = acc[ai][bj][m][1] * rstd + cv[bj][1];
#pragma unroll
        for (int e = 0; e < 4; ++e) { const float r0 = fmaxf(v0[e], 0.f), r1 = fmaxf(v1[e], 0.f); v0[e] = r0 * r0; v1[e] = r1 * r1; }
        *(u32x4*)(Hd + (size_t)rl * 4096 + EPI_COL(bj, 0)) = pack8(v0, v1); } }
  }
};
struct EpiFF2 {
  int row0; const float* mod; const float* b2; float* X; float* P;
  __device__ __forceinline__ void operator()(const AccT& acc, const Unit& u, int wr, int wc, int fr, int fq) const {
    if (u.ks == 1) {
      EPI_LOOP_ROWS { const int rl = EPI_ROW(ai, m); EPI_LOOP_COLS { *(f32x4*)(P + (size_t)rl * 1024 + EPI_COL(bj, n)) = acc[ai][bj][m][n]; } }
    } else {
    const int cb = cond_of_row(row0 + u.pm * 256); const float* md = mod + cb * 6144;
    f32x4 g2v[2][2], bbv[2][2];
    EPI_LOOP_COLS { const int col = EPI_COL(bj, n); g2v[bj][n] = *(const f32x4*)(md + 5120 + col); bbv[bj][n] = *(const f32x4*)(b2 + col); }
#pragma unroll
    for (int ai = 0; ai < 2; ++ai)
#pragma unroll
      for (int m2 = 0; m2 < 2; ++m2) {
        f32x4 xv[2][2][2];
#pragma unroll
        for (int mm = 0; mm < 2; ++mm) { const int row = row0 + EPI_ROW(ai, 2 * m2 + mm); EPI_LOOP_COLS { xv[mm][bj][n] = *(const f32x4*)(X + (size_t)row * 1024 + EPI_COL(bj, n)); } }
#pragma unroll
        for (int mm = 0; mm < 2; ++mm) { const int m = 2 * m2 + mm; const int row = row0 + EPI_ROW(ai, m);
          EPI_LOOP_COLS { const int col = EPI_COL(bj, n); *(f32x4*)(X + (size_t)row * 1024 + col) = xv[mm][bj][n] + g2v[bj][n] * (acc[ai][bj][m][n] + bbv[bj][n]); } } }
    }
  }
};

template <class Epi> __device__ __forceinline__ void run_gemm(LP lds, const bf16_t* A, const bf16_t* Bt, int M, int N, int K, const Epi& E, int nks = 1) {
  pg8::Gemm g; g.A = A; g.Bt = Bt; g.M = M; g.N = N; g.K = K / nks; g.ld = K; g.nks = nks;
  pg8::StaticOrder S; S.init(M, N, nks, (int)gridDim.x, (int)blockIdx.x);
  pg8::gemm_phase<Epi>(lds, g, S, E);
}

__device__ void transpose_tile(const float* __restrict__ src, int ld, int col0, int k0, bf16_t* __restrict__ dst, int K, int drow0, LAS float* tile) {
  const int t = opaque_tid();
  f32x4 v[4];
#pragma unroll
  for (int i = 0; i < 4; ++i) { const int idx = t + 512 * i, kr = idx >> 5, c4 = idx & 31; v[i] = *(const f32x4*)(src + (size_t)(k0 + kr) * ld + col0 + 4 * c4); }
#pragma unroll
  for (int i = 0; i < 4; ++i) { const int idx = t + 512 * i, kr = idx >> 5, c4 = idx & 31; LAS float* tp = tile + kr * 129 + 4 * c4; tp[0] = v[i][0]; tp[1] = v[i][1]; tp[2] = v[i][2]; tp[3] = v[i][3]; }
  __syncthreads();
  const int kb = t & 7;
#pragma unroll
  for (int i = 0; i < 2; ++i) { const int c = (t >> 3) + 64 * i; const LAS float* tp = tile + (kb * 8) * 129 + c; u32x4 o;
    o.x = pack2(tp[0], tp[129]); o.y = pack2(tp[2 * 129], tp[3 * 129]); o.z = pack2(tp[4 * 129], tp[5 * 129]); o.w = pack2(tp[6 * 129], tp[7 * 129]);
    *(u32x4*)(dst + (size_t)(drow0 + c) * K + k0 + kb * 8) = o; }
  __syncthreads();
}
template <int SILU> __device__ void matvec9_unit(const float* v0, const float* v1, int v1stride, const float* __restrict__ W, int ldw, const float* bias, float* out, int ldo, int col0, LAS float* lf) {
  const int t = opaque_tid(), lane = t & 63, wid = t >> 6;
  LAS float* sv = lf; LAS float* red = lf + 9216;
  for (int i = t; i < 9216; i += 512) { const int b = i >> 10, k = i & 1023; float x = (b == 0) ? v0[k] : v1[(size_t)(b - 1) * v1stride + k]; if (SILU) x = x * __builtin_amdgcn_rcpf(1.0f + __expf(-x)); sv[i] = x; }
  __syncthreads();
  const int c4 = t & 7, kl = t >> 3;
  f32x4 w[16];
#pragma unroll
  for (int i = 0; i < 16; ++i) w[i] = *(const f32x4*)(W + (size_t)(kl + 64 * i) * ldw + col0 + 4 * c4);
  f32x4 acc[9];
#pragma unroll
  for (int b = 0; b < 9; ++b) acc[b] = (f32x4){0.f, 0.f, 0.f, 0.f};
#pragma unroll
  for (int i = 0; i < 16; ++i)
#pragma unroll
    for (int b = 0; b < 9; ++b) acc[b] += w[i] * sv[b * 1024 + kl + 64 * i];
#pragma unroll
  for (int b = 0; b < 9; ++b)
#pragma unroll
    for (int e = 0; e < 4; ++e) { float x = acc[b][e]; x += __shfl_xor(x, 8); x += __shfl_xor(x, 16); x += __shfl_xor(x, 32); acc[b][e] = x; }
  if (lane < 8) {
#pragma unroll
    for (int b = 0; b < 9; ++b) *(LAS f32x4*)(red + (wid * 9 + b) * 32 + 4 * lane) = acc[b]; }
  __syncthreads();
  if (t < 288) { const int b = t >> 5, cc = t & 31; float s = bias[col0 + cc];
#pragma unroll
    for (int pz = 0; pz < 8; ++pz) s += red[(pz * 9 + b) * 32 + cc];
    out[(size_t)b * ldo + col0 + cc] = s; }
  __syncthreads();
}

__device__ void phase0(const Params& p, LP lds) {
  unsigned char* ws = p.ws; LAS float* lf = (LAS float*)lds;
  const int tid0 = opaque_tid(); const int wid = tid0 >> 6, lane = tid0 & 63;
  for (int unit = blockIdx.x; unit < 576; unit += gridDim.x) {
    if (unit < 192) {
      matvec9_unit<1>(p.in[6], p.in[5], 1024, p.in[7], 6144, p.in[8], (float*)(ws + OFF_MOD), 6144, unit * 32, lf);
    } else if (unit < 480) {
      const int row = (unit - 192) * 8 + wid; const bool smp = row < 2048; const int L = smp ? 2048 : 256, t = smp ? row : row - 2048;
      const float* w1 = p.in[14]; const float* b1 = p.in[15]; const float* fr1 = p.in[16]; const float* w2 = p.in[17]; const float* b2 = p.in[18]; const float* fr2 = p.in[19];
      float a = b1[lane] + (float)t / (float)(L - 1) * w1[lane];
      const float base = (6.283185307179586f / (float)L) * (float)t;
      float cs = 0.f, sn = 0.f; if (lane < 16) { const float ang = base * (float)(lane + 1); cs = cosf(ang); sn = sinf(ang); }
#pragma unroll
      for (int i = 0; i < 16; ++i) a += __shfl(cs, i) * w1[(1 + i) * 64 + lane] + __shfl(sn, i) * w1[(17 + i) * 64 + lane];
      const float h1 = sinf(fr1[lane] * a);
      float a2 = b2[lane];
#pragma unroll 16
      for (int j = 0; j < 64; ++j) a2 += __shfl(h1, j) * w2[j * 64 + lane];
      const float h2 = sinf(fr2[lane] * a2);
      float* dst = (float*)(ws + (smp ? OFF_H2S : OFF_H2C)); dst[(size_t)t * 64 + lane] = h2;
    } else {
      const int r = unit - 480, c = tid0; const int pos = r < 32 ? r : r - 32; const int i = c & 255;
      const float omega = 1.0f / powf(10000.0f, (float)i / 256.0f); const float a = (float)pos * omega; const float v = c < 256 ? sinf(a) : cosf(a);
      float* dst = (float*)(ws + (r < 32 ? OFF_PER : OFF_PEC)); dst[(size_t)pos * 512 + c] = v;
    }
  }
}
__device__ void weight_tiles(const Params& p, LP lds, int lo, int hi, int upper) {
  unsigned char* ws = p.ws; LAS float* lf = (LAS float*)lds;
  const int nh = upper ? ((int)gridDim.x >> 1) : 0;
  if ((int)blockIdx.x < nh) return;
  for (int tu = lo + (int)blockIdx.x - nh; tu < hi; tu += (int)gridDim.x - nh) {
    const float* src; int ld, K, col0, k0, drow0; bf16_t* dst;
    if (tu < 1152) { const int nt = tu >> 4, kt = tu & 15; const int r = nt * 128; src = p.in[10]; ld = INC; K = 1024; k0 = kt * 64; drow0 = r; dst = (bf16_t*)(ws + OFF_WT);
      col0 = r < 3072 ? r : (r < 6144 ? 4112 + (r - 3072) : (r < 7168 ? 3072 + (r - 6144) : 7184 + (r - 7168))); }
    else if (tu < 1536) { const int v = tu - 1152, w = v >> 7, q = v & 127; src = p.in[23 + w]; ld = 1024; K = 1024; k0 = (q & 15) * 64; col0 = (q >> 4) * 128; drow0 = col0; dst = (bf16_t*)(ws + (w == 0 ? OFF_WBM : (w == 1 ? OFF_WBH : OFF_WOUT))); }
    else if (tu < 2048) { const int q = tu - 1536; src = p.in[27]; ld = 4096; K = 1024; k0 = (q & 15) * 64; col0 = (q >> 4) * 128; drow0 = col0; dst = (bf16_t*)(ws + OFF_W1T); }
    else { const int q = tu - 2048; src = p.in[29]; ld = 1024; K = 4096; k0 = (q & 63) * 64; col0 = (q >> 6) * 128; drow0 = col0; dst = (bf16_t*)(ws + OFF_W2T); }
    transpose_tile(src, ld, col0, k0, dst, K, drow0, lf);
  }
}

__device__ void phase1(const Params& p, LP lds) {
  unsigned char* ws = p.ws;
  int tid_ = threadIdx.x; asm volatile("" : "+v"(tid_));
  const int tid = tid_, wid = tid >> 6, lane = tid & 63;
  const float* mod = (const float*)(ws + OFF_MOD);
  LAS float* wg = (LAS float*)lds;
  if ((int)blockIdx.x < 1536) {
    f32x4 gw[8];
#pragma unroll
    for (int i = 0; i < 8; ++i) { const int idx = tid + 512 * i, k = idx >> 2, q = idx & 3; gw[i] = *(const f32x4*)(p.in[10] + (size_t)k * INC + 4096 + 4 * q); }
#pragma unroll
    for (int i = 0; i < 8; ++i) { const int idx = tid + 512 * i, k = idx >> 2, q = idx & 3; wg[(4 * q) * 1024 + k] = gw[i][0]; wg[(4 * q + 1) * 1024 + k] = gw[i][1]; wg[(4 * q + 2) * 1024 + k] = gw[i][2]; wg[(4 * q + 3) * 1024 + k] = gw[i][3]; }
    __syncthreads();
  }
  for (int unit = blockIdx.x; unit < 1536; unit += gridDim.x) {
    const int tidn = opaque_tid(); const int wid = tidn >> 6, lane = tidn & 63;
    const int row0 = unit * 16 + wid * 2; const int cb = cond_of_row(row0); const float* md = mod + cb * 6144; const bool smp = row0 >= NCTX;
    f32x4 v[2][4]; float rstd[2];
#pragma unroll
    for (int r = 0; r < 2; ++r) { const int row = row0 + r; const float* xr; int t = 0;
      if (!smp) xr = p.in[0] + (size_t)row * 1024; else { xr = p.in[1] + (size_t)(row - NCTX) * 1024; t = (row - NCTX) & 2047; }
      const float* per = (const float*)(ws + OFF_PER) + (t >> 6) * 512; const float* pec = (const float*)(ws + OFF_PEC) + (t & 63) * 512;
      float ss = 0.f;
#pragma unroll
      for (int i = 0; i < 4; ++i) { const int col = 4 * lane + 256 * i; v[r][i] = *(const f32x4*)(xr + col);
        if (smp) v[r][i] += (col < 512) ? *(const f32x4*)(per + col) : *(const f32x4*)(pec + col - 512);
        ss += v[r][i][0] * v[r][i][0] + v[r][i][1] * v[r][i][1] + v[r][i][2] * v[r][i][2] + v[r][i][3] * v[r][i][3]; }
      ss = wave_sum(ss); rstd[r] = rsqrtf(ss * (1.0f / 1024.0f) + 1e-6f); }
    const float* n1w = p.in[9];
    float ga[32];
#pragma unroll
    for (int g = 0; g < 32; ++g) ga[g] = 0.f;
#pragma unroll
    for (int i = 0; i < 4; ++i) { const int col = 4 * lane + 256 * i;
      const f32x4 w = *(const f32x4*)(n1w + col), sc = *(const f32x4*)(md + 1024 + col), sh = *(const f32x4*)(md + col);
      const f32x4 ws1 = w * (sc + 1.0f);
      f32x4 h[2];
#pragma unroll
      for (int r = 0; r < 2; ++r) { h[r] = v[r][i] * rstd[r] * ws1 + sh;
        u32x2 o; o.x = pack2(h[r][0], h[r][1]); o.y = pack2(h[r][2], h[r][3]); *(u32x2*)((bf16_t*)(ws + OFF_HN) + (size_t)(row0 + r) * 1024 + col) = o; }
#pragma unroll
      for (int g = 0; g < 16; ++g) { const f32x4 wv = *(const LAS f32x4*)(wg + g * 1024 + col);
#pragma unroll
        for (int r = 0; r < 2; ++r) ga[r * 16 + g] += h[r][0] * wv[0] + h[r][1] * wv[1] + h[r][2] * wv[2] + h[r][3] * wv[3]; }
      asm volatile("" ::: "memory"); }
#pragma unroll
    for (int off = 16; off >= 1; off >>= 1) { const bool hi = (lane & off) != 0;
#pragma unroll
      for (int i = 0; i < off; ++i) { const float send = hi ? ga[i] : ga[i + off]; const float keep = hi ? ga[i + off] : ga[i]; ga[i] = keep + __shfl_xor(send, off); } }
    const float tot = ga[0] + __shfl_xor(ga[0], 32);
    if (lane < 32) ((float*)(ws + OFF_GT))[(size_t)row0 * 16 + lane] = tot + p.in[11][4096 + (lane & 15)];
  }
  __syncthreads();
}
__device__ void filters_upper_half(const Params& p, LP lds) {
  unsigned char* ws = p.ws; const int nh = (int)gridDim.x >> 1;
  if ((int)blockIdx.x < nh) return;
  LAS float* w3s = (LAS float*)lds;
  for (int v = (int)blockIdx.x - nh; v < 320; v += (int)gridDim.x - nh) {
    const int tid = opaque_tid();
    const bool smp = v < 256; const int L = smp ? 2048 : 256; const int tt = smp ? (v >> 6) : 0, cgp = v & 63; const int t = tt * 512 + tid;
    { const f32x4 x = *(const f32x4*)(p.in[20] + (size_t)(tid >> 3) * 2048 + cgp * 32 + 4 * (tid & 7)); LAS float* wp = w3s + (4 * (tid & 7)) * 64 + (tid >> 3);
      wp[0] = x[0]; wp[64] = x[1]; wp[128] = x[2]; wp[192] = x[3]; }
    __syncthreads();
    if (t < L) {
      const float* H2 = (const float*)(ws + (smp ? OFF_H2S : OFF_H2C)) + (size_t)t * 64;
      f32x4 h2[16];
#pragma unroll
      for (int i = 0; i < 16; ++i) h2[i] = *(const f32x4*)(H2 + 4 * i);
      const float dist = fabsf((float)t - (float)(L / 2)) / (float)(L / 2);
      float* HF = (float*)(ws + (smp ? OFF_HFS : OFF_HFC)) + (size_t)(cgp * 32) * L + t;
#pragma unroll 1
      for (int j = 0; j < 32; ++j) {
        f32x4 a = {0.f, 0.f, 0.f, 0.f};
#pragma unroll
        for (int i = 0; i < 16; ++i) a += *(const LAS f32x4*)(w3s + j * 64 + 4 * i) * h2[i];
        const int c = (cgp * 32 + j) & 1023;
        const float dmin = -3.0701134573253946f, dmax = -15.350567286626973f;
        const float delta = fabsf(dmin + (dmax - dmin) * ((float)c / 1023.0f));
        HF[(size_t)j * L] = ((a[0] + a[1]) + (a[2] + a[3])) * __expf(-dist * delta); }
    }
    __syncthreads();
  }
}
__device__ void c1_upper_half(const Params& p, LP lds) {
  unsigned char* ws = p.ws; const float* mod = (const float*)(ws + OFF_MOD); const int nh = (int)gridDim.x >> 1;
  if ((int)blockIdx.x < nh) return;
  for (int u = (int)blockIdx.x - nh; u < 128; u += (int)gridDim.x - nh)
    matvec9_unit<0>(mod + 3072, mod + 6144 + 3072, 6144, p.in[27], 4096, p.in[28], (float*)(ws + OFF_C1), 4096, u * 32, (LAS float*)lds);
}

__device__ __forceinline__ bf16x8 tr_frag(LP base, int k0, int m0, int pitch  , int l15, int g) {
  const int q = l15 >> 2, pp = l15 & 3;
  LP a = base + ((k0 + 8 * g + q) * pitch + m0 + 4 * pp) * 2;
  const s16x4 lo = __builtin_amdgcn_ds_read_tr16_b64_v4i16((LAS s16x4*)a);
  const s16x4 hi = __builtin_amdgcn_ds_read_tr16_b64_v4i16((LAS s16x4*)(a + 8 * pitch));
  bf16x8 r; r[0] = lo[0]; r[1] = lo[1]; r[2] = lo[2]; r[3] = lo[3]; r[4] = hi[0]; r[5] = hi[1]; r[6] = hi[2]; r[7] = hi[3]; return r;
}
__device__ __forceinline__ bf16x8 tr_at(LP lanebase, int coff  , int pitch_bytes) {
  const s16x4 lo = __builtin_amdgcn_ds_read_tr16_b64_v4i16((LAS s16x4*)(lanebase + coff));
  const s16x4 hi = __builtin_amdgcn_ds_read_tr16_b64_v4i16((LAS s16x4*)(lanebase + coff + 4 * pitch_bytes));
  bf16x8 r; r[0] = lo[0]; r[1] = lo[1]; r[2] = lo[2]; r[3] = lo[3]; r[4] = hi[0]; r[5] = hi[1]; r[6] = hi[2]; r[7] = hi[3]; return r;
}
constexpr int ML_K = 0, ML_V = 67584, ML_P = 86016, ML_C = 120832, ML_T = 157696, ML_TSZ = 1600;
constexpr int KP = 264, VP = 72, PP = 136, CP = 72;

__device__ void mlstm_item(const Params& p, LP lds, int item) {
  const int tid = opaque_tid(), wid = __builtin_amdgcn_readfirstlane(tid >> 6), lane = tid & 63, l15 = lane & 15, g = lane >> 4;
  const bool smp = item < 256; const int uu = smp ? (item >> 2) : ((item - 256) >> 2); const int sl = item & 3;
  const int b = uu >> 3, dir = (uu >> 2) & 1, head = uu & 3;
  const int S = smp ? SEQS : SEQC, nc = S >> 7; const int tok0 = smp ? NCTX + b * SEQS : b * SEQC;
  const bf16_t* qkv = (const bf16_t*)(p.ws + OFF_BIG);
  const float* GT = (const float*)(p.ws + OFF_GT);
  bf16_t* hout = (bf16_t*)((unsigned char*)p.out + (dir ? OUT_HB : OUT_H));
  const int sidx = (b * 2 + dir) * 4 + head;
  const int gi_col = dir * 8 + head, gf_col = dir * 8 + 4 + head;
  f32x4 Cacc[2][4], nacc[2]; float mst0;
  if (smp) {
    const float* C0 = p.in[2] + (size_t)sidx * 65536;
#pragma unroll
    for (int dt = 0; dt < 2; ++dt) {
#pragma unroll
      for (int vt = 0; vt < 4; ++vt) Cacc[dt][vt] = *(const f32x4*)(C0 + (size_t)((2 * wid + dt) * 16 + l15) * 256 + sl * 64 + 16 * vt + 4 * g);
      nacc[dt] = (f32x4){p.in[3][sidx * 256 + (2 * wid + dt) * 16 + l15], 0.f, 0.f, 0.f}; }
    mst0 = p.in[4][sidx];
  } else {
#pragma unroll
    for (int dt = 0; dt < 2; ++dt) {
#pragma unroll
      for (int vt = 0; vt < 4; ++vt) Cacc[dt][vt] = (f32x4){0.f, 0.f, 0.f, 0.f};
      nacc[dt] = (f32x4){0.f, 0.f, 0.f, 0.f}; }
    mst0 = 0.f;
  }
#define TOKC(cc, j) (dir ? (tok0 + S - 1 - ((cc) * 128 + (j))) : (tok0 + (cc) * 128 + (j)))
  const int rt = (wid < 4) ? wid : 11 - wid;
  const int jrow = 16 * rt + l15;
  bf16x8 qf[8]; u32x4 kreg[8], vreg[2]; float g4[4] = {0.f, 0.f, 0.f, 0.f};
#define ML_LOAD_Q(cc) do { const bf16_t* qp = qkv + (size_t)TOKC(cc, jrow) * 3072 + head * 256 + 8 * g; \
    _Pragma("unroll") for (int kk = 0; kk < 8; ++kk) qf[kk] = *(const bf16x8*)(qp + 32 * kk); } while (0)
#define ML_LOAD_KV(cc) do { \
    _Pragma("unroll") for (int i = 0; i < 8; ++i) { const int row = (tid >> 5) + 16 * i; kreg[i] = *(const u32x4*)(qkv + (size_t)TOKC(cc, row) * 3072 + 1024 + head * 256 + (tid & 31) * 8); } \
    _Pragma("unroll") for (int i = 0; i < 2; ++i) { const int row = (tid >> 3) + 64 * i; vreg[i] = *(const u32x4*)(qkv + (size_t)TOKC(cc, row) * 3072 + 2048 + head * 256 + sl * 64 + (tid & 7) * 8); } \
    if (wid == 0) { const float* g0 = GT + (size_t)TOKC(cc, 2 * lane) * 16; const float* g1 = GT + (size_t)TOKC(cc, 2 * lane + 1) * 16; g4[0] = g0[gi_col]; g4[1] = g0[gf_col]; g4[2] = g1[gi_col]; g4[3] = g1[gf_col]; } } while (0)
#define ML_SCAN(tabp, mcur, mnext) do { LAS float* T_ = (LAS float*)(tabp); \
    const float lf0 = fminf(g4[1], 0.f) - log1pf(__expf(-fabsf(g4[1]))), lf1 = fminf(g4[3], 0.f) - log1pf(__expf(-fabsf(g4[3]))); \
    float s_ = lf0 + lf1; \
    _Pragma("unroll") for (int o = 1; o < 64; o <<= 1) { const float t_ = __shfl_up(s_, o); if (lane >= o) s_ += t_; } \
    const float b1_ = s_, b0_ = s_ - lf1; const float u0_ = g4[0] - b0_, u1_ = g4[2] - b1_; \
    float mx_ = fmaxf(u0_, u1_); \
    _Pragma("unroll") for (int o = 1; o < 64; o <<= 1) { const float t_ = __shfl_up(mx_, o); if (lane >= o) mx_ = fmaxf(mx_, t_); } \
    float ex_ = __shfl_up(mx_, 1); if (lane == 0) ex_ = -INFINITY; \
    const float M0_ = fmaxf(mcur, fmaxf(ex_, u0_)), M1_ = fmaxf(mcur, mx_); \
    T_[2 * lane] = u0_; T_[2 * lane + 1] = u1_; T_[128 + 2 * lane] = M0_; T_[128 + 2 * lane + 1] = M1_; T_[256 + 2 * lane] = b0_; T_[256 + 2 * lane + 1] = b1_; \
    const float Ml_ = __shfl(M1_, 63), bl_ = __shfl(b1_, 63); \
    if (lane == 0) { T_[384] = mcur; T_[385] = Ml_; } \
    mnext = bl_ + Ml_; } while (0)
  float mw0 = mst0;
  ML_LOAD_Q(0); ML_LOAD_KV(0);
  if (wid == 0) { float mn; ML_SCAN(lds + ML_T, mw0, mn); mw0 = mn; }
  __syncthreads();
  float m_final = 0.f;
  for (int c = 0; c < nc; ++c) {
    LAS float* T = (LAS float*)(lds + ML_T + (c & 1) * ML_TSZ);
    const float mst = T[384], M_last = T[385];
#pragma unroll
    for (int i = 0; i < 8; ++i) { const int row = (tid >> 5) + 16 * i; *(LAS u32x4*)(lds + ML_K + (row * KP + (tid & 31) * 8) * 2) = kreg[i]; }
#pragma unroll
    for (int i = 0; i < 2; ++i) { const int row = (tid >> 3) + 64 * i; const float w = __expf(T[row] - M_last); const u32x4 v = vreg[i]; u32x4 o;
      o.x = pack2(bflo(v.x) * w, bfhi(v.x) * w); o.y = pack2(bflo(v.y) * w, bfhi(v.y) * w); o.z = pack2(bflo(v.z) * w, bfhi(v.z) * w); o.w = pack2(bflo(v.w) * w, bfhi(v.w) * w);
      *(LAS u32x4*)(lds + ML_V + (row * VP + (tid & 7) * 8) * 2) = o; }
    if (tid < 128) *(LAS unsigned short*)(lds + ML_V + (tid * VP + 64) * 2) = f2bf(__expf(T[tid] - M_last));
#pragma unroll
    for (int dt = 0; dt < 2; ++dt) {
#pragma unroll
      for (int vt = 0; vt < 4; ++vt) { u32x2 w; w.x = pack2(Cacc[dt][vt][0], Cacc[dt][vt][1]); w.y = pack2(Cacc[dt][vt][2], Cacc[dt][vt][3]);
        *(LAS u32x2*)(lds + ML_C + (((2 * wid + dt) * 16 + l15) * CP + 16 * vt + 4 * g) * 2) = w; }
      if (g == 0) *(LAS unsigned short*)(lds + ML_C + (((2 * wid + dt) * 16 + l15) * CP + 64) * 2) = f2bf(nacc[dt][0]); }
    const int qtok = TOKC(c, jrow);
    const bool more = (c + 1 < nc);
    __syncthreads();
    const float Mj = T[128 + jrow], bj = T[256 + jrow]; const float rf = __expf(M_last - Mj), w_inter = __expf(mst - Mj);
    int lq_ = (8 * g + (l15 >> 2)), lp_ = 4 * (l15 & 3); asm volatile("" : "+v"(lq_), "+v"(lp_));
    const LP cB = lds + ML_C + (lq_ * CP + lp_) * 2, vB = lds + ML_V + (lq_ * VP + lp_) * 2, kB = lds + ML_K + (lq_ * KP + lp_ + 32 * wid) * 2;
    const LP pB = lds + ML_P + (jrow * PP + 8 * g) * 2;
    for (int st = 0; st <= rt; ++st) {
      f32x4 s = {0.f, 0.f, 0.f, 0.f};
      bf16x8 kfr[8];
#pragma unroll
      for (int kk = 0; kk < 8; ++kk) kfr[kk] = *(const LAS bf16x8*)(lds + ML_K + ((16 * st + l15) * KP + 32 * kk + 8 * g) * 2);
      __builtin_amdgcn_sched_barrier(0);
#pragma unroll
      for (int kk = 0; kk < 8; ++kk) s = __builtin_amdgcn_mfma_f32_16x16x32_bf16(kfr[kk], qf[kk], s, 0, 0, 0);
      float pv[4];
#pragma unroll
      for (int i = 0; i < 4; ++i) pv[i] = ((16 * st + 4 * g + i) <= jrow) ? s[i] * rf : 0.f;
      u32x2 w; w.x = pack2(pv[0], pv[1]); w.y = pack2(pv[2], pv[3]);
      *(LAS u32x2*)(lds + ML_P + (jrow * PP + 16 * st + 4 * g) * 2) = w;
    }
    if ((rt & 1) == 0) { u32x2 z; z.x = 0u; z.y = 0u; *(LAS u32x2*)(lds + ML_P + (jrow * PP + 16 * (rt + 1) + 4 * g) * 2) = z; }
    if (more) ML_LOAD_KV(c + 1);
    asm volatile("s_waitcnt lgkmcnt(0)" ::: "memory");
    f32x4 ha[5];
#pragma unroll
    for (int vt = 0; vt < 5; ++vt) { f32x4 a = {0.f, 0.f, 0.f, 0.f};
      if (smp || c > 0) {
        bf16x8 cfr[8];
#pragma unroll
        for (int kk = 0; kk < 8; ++kk) cfr[kk] = tr_at(cB, (32 * kk * CP + 16 * vt) * 2, CP * 2);
        __builtin_amdgcn_sched_barrier(0);
#pragma unroll
        for (int kk = 0; kk < 8; ++kk) a = __builtin_amdgcn_mfma_f32_16x16x32_bf16(cfr[kk], qf[kk], a, 0, 0, 0);
        a *= w_inter; }
      ha[vt] = a; }
    for (int k2 = 0; k2 <= (rt >> 1); ++k2) {
      const bf16x8 pf = *(const LAS bf16x8*)(pB + k2 * 64);
      bf16x8 vfr[5];
#pragma unroll
      for (int vt = 0; vt < 5; ++vt) vfr[vt] = tr_at(vB + k2 * (32 * VP * 2), (16 * vt) * 2, VP * 2);
      __builtin_amdgcn_sched_barrier(0);
#pragma unroll
      for (int vt = 0; vt < 5; ++vt) ha[vt] = __builtin_amdgcn_mfma_f32_16x16x32_bf16(vfr[vt], pf, ha[vt], 0, 0, 0); }
    { const float den = __shfl(ha[4][0], l15); const float rdd = __builtin_amdgcn_rcpf(fmaxf(fabsf(den), __expf(-(bj + Mj))));
#pragma unroll
      for (int vt = 0; vt < 4; ++vt) { const f32x4 a = ha[vt] * rdd; u32x2 w; w.x = pack2(a[0], a[1]); w.y = pack2(a[2], a[3]);
        *(u32x2*)(hout + (size_t)qtok * 1024 + head * 256 + sl * 64 + 16 * vt + 4 * g) = w; } }
    if (more) ML_LOAD_Q(c + 1);
    const bool need_state = (!smp) || more;
    if (need_state) {
      const float decay = __expf(mst - M_last);
#pragma unroll
      for (int dt = 0; dt < 2; ++dt) {
#pragma unroll
        for (int vt = 0; vt < 4; ++vt) Cacc[dt][vt] *= decay;
        nacc[dt] *= decay; }
#pragma unroll
      for (int ks = 0; ks < 4; ++ks) {
        const bf16x8 kf0 = tr_at(kB, (32 * ks * KP) * 2, KP * 2), kf1 = tr_at(kB, (32 * ks * KP + 16) * 2, KP * 2);
        bf16x8 vfr[5];
#pragma unroll
        for (int vt = 0; vt < 5; ++vt) vfr[vt] = tr_at(vB, (32 * ks * VP + 16 * vt) * 2, VP * 2);
        __builtin_amdgcn_sched_barrier(0);
#pragma unroll
        for (int vt = 0; vt < 4; ++vt) { Cacc[0][vt] = __builtin_amdgcn_mfma_f32_16x16x32_bf16(vfr[vt], kf0, Cacc[0][vt], 0, 0, 0); Cacc[1][vt] = __builtin_amdgcn_mfma_f32_16x16x32_bf16(vfr[vt], kf1, Cacc[1][vt], 0, 0, 0); }
        nacc[0] = __builtin_amdgcn_mfma_f32_16x16x32_bf16(vfr[4], kf0, nacc[0], 0, 0, 0); nacc[1] = __builtin_amdgcn_mfma_f32_16x16x32_bf16(vfr[4], kf1, nacc[1], 0, 0, 0);
      }
    }
    if (wid == 0 && more) { float mn; ML_SCAN(lds + ML_T + ((c + 1) & 1) * ML_TSZ, mw0, mn); mw0 = mn; }
    m_final = T[256 + 127] + M_last;
    __syncthreads();
  }
#undef ML_LOAD_Q
#undef ML_LOAD_KV
#undef ML_SCAN
#undef TOKC
  if (!smp) {
    float* oC = p.out + OUTF_C + (size_t)sidx * 65536;
#pragma unroll
    for (int dt = 0; dt < 2; ++dt) {
#pragma unroll
      for (int vt = 0; vt < 4; ++vt) *(f32x4*)(oC + (size_t)((2 * wid + dt) * 16 + l15) * 256 + sl * 64 + 16 * vt + 4 * g) = Cacc[dt][vt];
      if (sl == 0 && g == 0) p.out[OUTF_N + (size_t)sidx * 256 + (2 * wid + dt) * 16 + l15] = nacc[dt][0]; }
    if (sl == 0 && tid == 0) p.out[OUTF_M + sidx] = m_final;
  }
}

__device__ void combine_rows(const Params& p) {
  const int tid0 = opaque_tid(); const int wid = tid0 >> 6, lane = tid0 & 63;
  bf16_t* H = (bf16_t*)((unsigned char*)p.out + OUT_H); const bf16_t* HB = (const bf16_t*)((unsigned char*)p.out + OUT_HB); const float* nw = p.in[22];
  f32x4 wv[4];
#pragma unroll
  for (int i = 0; i < 4; ++i) wv[i] = *(const f32x4*)(nw + 16 * lane + 4 * i);
  const int nh = (int)gridDim.x >> 1;
  if ((int)blockIdx.x < nh) return;
  for (int unit = (int)blockIdx.x - nh; unit < 768; unit += (int)gridDim.x - nh) {
    const int row0 = unit * 32 + wid * 4;
    u32x4 a[4][2], bq[4][2];
#pragma unroll
    for (int r = 0; r < 4; ++r)
#pragma unroll
      for (int i = 0; i < 2; ++i) { a[r][i] = *(const u32x4*)(H + (size_t)(row0 + r) * 1024 + 16 * lane + 8 * i); bq[r][i] = *(const u32x4*)(HB + (size_t)(row0 + r) * 1024 + 16 * lane + 8 * i); }
#pragma unroll
    for (int r = 0; r < 4; ++r) {
      f32x4 v[4]; float ss = 0.f;
#pragma unroll
      for (int i = 0; i < 2; ++i) { f32x4 x0, x1, y0, y1; unpack8(a[r][i], x0, x1); unpack8(bq[r][i], y0, y1); v[2 * i] = x0 + y0; v[2 * i + 1] = x1 + y1; }
#pragma unroll
      for (int i = 0; i < 4; ++i) ss += v[i][0] * v[i][0] + v[i][1] * v[i][1] + v[i][2] * v[i][2] + v[i][3] * v[i][3];
      ss += __shfl_xor(ss, 1); ss += __shfl_xor(ss, 2); ss += __shfl_xor(ss, 4); ss += __shfl_xor(ss, 8);
      const float rr = rsqrtf(ss * (1.0f / 256.0f) + 1e-6f);
#pragma unroll
      for (int i = 0; i < 2; ++i) *(u32x4*)(H + (size_t)(row0 + r) * 1024 + 16 * lane + 8 * i) = pack8(v[2 * i] * rr * wv[2 * i], v[2 * i + 1] * rr * wv[2 * i + 1]);
    }
  }
}

constexpr int HY_WAVE = 18816, HY_HR = 0, HY_ZA = 8576, HY_ZB = 8576 + 5120;
__device__ void hyena_item(const Params& p, LP lds, int item) {
  const int tid = opaque_tid(), wid = __builtin_amdgcn_readfirstlane(tid >> 6), lane = tid & 63, n31 = lane & 31, hh = lane >> 5;
  const bool smp = item < 1024; const int it = smp ? item : item - 1024; const int bset = it >> 7, cgp = it & 127; const int c = cgp * 8 + wid;
  const int L = smp ? 2048 : 256, lgL = smp ? 11 : 8, nblk = L >> 5, lgnb = lgL - 5, ntok = 2048, ntile = 2, dmax = L >> 6;
  const int tok0 = smp ? NCTX + bset * 2048 : bset * 2048;
  LP wl = lds + wid * HY_WAVE; LAS float* hr = (LAS float*)(wl + HY_HR);
  const float* HFp = (const float*)(p.ws + (smp ? OFF_HFS : OFF_HFC));
  const bf16_t* UT = (const bf16_t*)(p.ws + OFF_BIG);
  const float* cw = p.in[12]; const float* cbv = p.in[13]; const float* skp = p.in[21];
  { const int uc = 2048 + c; const float w0 = cw[uc], w1 = cw[3072 + uc], w2 = cw[6144 + uc], cb = cbv[uc]; const bf16_t* src = UT + (size_t)uc * NTOK + tok0;
    u32x4 vv[4]; float pvv[4], nxv[4];
#pragma unroll
    for (int i = 0; i < 4; ++i) { const int base = lane * 8 + 512 * i; vv[i] = (u32x4){0u, 0u, 0u, 0u}; pvv[i] = 0.f; nxv[i] = 0.f;
      if (base < ntok) { vv[i] = *(const u32x4*)(src + base); const int tl = base & (L - 1);
        if (tl != 0) pvv[i] = bf2f(src[base - 1]); if (tl + 8 != L) nxv[i] = bf2f(src[base + 8]); } }
#pragma unroll
    for (int i = 0; i < 4; ++i) { const int base = lane * 8 + 512 * i;
      if (base < ntok) { const u32x4 v = vv[i];
        float u[10]; u[0] = pvv[i]; u[1] = bflo(v.x); u[2] = bfhi(v.x); u[3] = bflo(v.y); u[4] = bfhi(v.y); u[5] = bflo(v.z); u[6] = bfhi(v.z); u[7] = bflo(v.w); u[8] = bfhi(v.w); u[9] = nxv[i];
        float o[8];
#pragma unroll
        for (int e = 0; e < 8; ++e) o[e] = cb + w0 * u[e] + w1 * u[e + 1] + w2 * u[e + 2];
        u32x4 w; w.x = pack2(o[0], o[1]); w.y = pack2(o[2], o[3]); w.z = pack2(o[4], o[5]); w.w = pack2(o[6], o[7]);
        *(LAS u32x4*)(wl + HY_ZA + ((base >> 5) * 40 + (base & 31)) * 2) = w; } } }
  const int HRP = L + 96;
  f32x4 fvN[8];
#define HY_FLOAD(o) do { const float* src_ = HFp + (size_t)((o) * 1024 + c) * L; \
    _Pragma("unroll") for (int i = 0; i < 8; ++i) { const int q = lane + 64 * i; fvN[i] = (4 * q < L) ? *(const f32x4*)(src_ + 4 * q) : (f32x4){0.f, 0.f, 0.f, 0.f}; } } while (0)
  HY_FLOAD(0);
  for (int ord = 0; ord < 2; ++ord) {
    { float sa = 0.f;
      f32x4 fv[8];
#pragma unroll
      for (int i = 0; i < 8; ++i) fv[i] = fvN[i];
#pragma unroll
      for (int i = 0; i < 8; ++i) sa += (fabsf(fv[i][0]) + fabsf(fv[i][1])) + (fabsf(fv[i][2]) + fabsf(fv[i][3]));
      sa = wave_sum(sa); const float inv = __builtin_amdgcn_rcpf(sa + 1e-6f);
      asm volatile("s_waitcnt lgkmcnt(0)" ::: "memory");
      LAS bf16_t* E = (LAS bf16_t*)hr; LAS bf16_t* O = E + HRP;
#pragma unroll
      for (int i = 0; i < 8; ++i) { const int q = lane + 64 * i;
        if (4 * q < L) {
#pragma unroll
          for (int e = 0; e < 4; ++e) { const int yy = L - 1 - (4 * q + e); const bf16_t v = f2bf(fv[i][e] * inv); E[32 + yy] = v; O[31 + yy] = v; } } }
      if (lane < 32) { E[lane] = 0; E[32 + L + lane] = 0; O[31 + L + lane] = 0; if (lane < 31) O[lane] = 0; }
      if (lane < 33) O[HRP - 33 + lane] = 0;
      asm volatile("s_waitcnt lgkmcnt(0)" ::: "memory"); }
    if (ord == 0) HY_FLOAD(1);
    LP zin = wl + (ord == 0 ? HY_ZA : HY_ZB); LP zout = wl + (ord == 0 ? HY_ZB : HY_ZA);
    const int gc = ord * 1024 + c; const float w0 = cw[gc], w1 = cw[3072 + gc], w2 = cw[6144 + gc], cb = cbv[gc], sk = skp[ord * 1024 + c];
    const bf16_t* gsrc = UT + (size_t)gc * NTOK + tok0;
    u32x4 gv[4]; unsigned gpv[4], gnx[4];
#pragma unroll
    for (int i = 0; i < 4; ++i) { const int base = lane * 8 + 512 * i; gv[i] = (u32x4){0u, 0u, 0u, 0u}; gpv[i] = 0u; gnx[i] = 0u;
      if (base < ntok) { gv[i] = *(const u32x4*)(gsrc + base); const int tl = base & (L - 1);
        if (tl != 0) gpv[i] = gsrc[base - 1]; if (tl + 8 != L) gnx[i] = gsrc[base + 8]; } }
    f32x16 accs[2];
#pragma unroll
    for (int o2 = 0; o2 < 2; ++o2)
#pragma unroll
      for (int r = 0; r < 16; ++r) accs[o2][r] = 0.f;
    LP fb = wl + HY_HR + ((n31 & 1) ? 0 : (HRP * 2 - 2)) + 2 * ((L >> 1) - 1 - n31 + 8 * hh + 32);
    int cbl[2], ca[2];
#pragma unroll
    for (int ot = 0; ot < 2; ++ot) { const int col = 32 * ot + n31; cbl[ot] = (col >> lgnb) << lgnb; ca[ot] = col & (nblk - 1); }
    const bool two = (ntile == 2);
    {
      LP zero = wl + HY_HR + 16 * hh;
      LP ap = fb + 64 * dmax;
      int bbr0 = ca[0] + dmax, bbr1 = ca[1] + dmax;
      LP bp0 = zin + ((cbl[0] + bbr0) * 40 + 8 * hh) * 2, bp1 = zin + ((cbl[1] + bbr1) * 40 + 8 * hh) * 2;
      for (int d = -dmax; d <= dmax; ++d) {
        u32x4 w0v, w1v;
        w0v.x = *(const LAS unsigned*)(ap); w0v.y = *(const LAS unsigned*)(ap + 4); w0v.z = *(const LAS unsigned*)(ap + 8); w0v.w = *(const LAS unsigned*)(ap + 12);
        w1v.x = *(const LAS unsigned*)(ap + 32); w1v.y = *(const LAS unsigned*)(ap + 36); w1v.z = *(const LAS unsigned*)(ap + 40); w1v.w = *(const LAS unsigned*)(ap + 44);
        const bf16x8 af0 = __builtin_bit_cast(bf16x8, w0v), af1 = __builtin_bit_cast(bf16x8, w1v);
        LP q0 = ((unsigned)bbr0 < (unsigned)nblk) ? bp0 : zero;
        LP q1 = (two && ((unsigned)bbr1 < (unsigned)nblk)) ? bp1 : zero;
        const bf16x8 b00 = *(const LAS bf16x8*)q0, b01 = *(const LAS bf16x8*)(q0 + 32);
        const bf16x8 b10 = *(const LAS bf16x8*)q1, b11 = *(const LAS bf16x8*)(q1 + 32);
        __builtin_amdgcn_sched_barrier(0);
        accs[0] = __builtin_amdgcn_mfma_f32_32x32x16_bf16(af0, b00, accs[0], 0, 0, 0);
        if (two) accs[1] = __builtin_amdgcn_mfma_f32_32x32x16_bf16(af0, b10, accs[1], 0, 0, 0);
        accs[0] = __builtin_amdgcn_mfma_f32_32x32x16_bf16(af1, b01, accs[0], 0, 0, 0);
        if (two) accs[1] = __builtin_amdgcn_mfma_f32_32x32x16_bf16(af1, b11, accs[1], 0, 0, 0);
        ap -= 64; bbr0 -= 1; bbr1 -= 1; bp0 -= 80; bp1 -= 80;
      }
    }
#pragma unroll
    for (int ot = 0; ot < 2; ++ot) {
      if (ot >= ntile) continue;
      const f32x16 acc = accs[ot];
#pragma unroll
      for (int rg = 0; rg < 4; ++rg) {
        const int zo = (((cbl[ot] + ca[ot]) * 40) + 8 * rg + 4 * hh) * 2;
        const u32x2 zv = *(const LAS u32x2*)(zin + zo);
        u32x2 w; w.x = pack2(acc[4 * rg] + sk * bflo(zv.x), acc[4 * rg + 1] + sk * bfhi(zv.x)); w.y = pack2(acc[4 * rg + 2] + sk * bflo(zv.y), acc[4 * rg + 3] + sk * bfhi(zv.y));
        *(LAS u32x2*)(zout + zo) = w;
      }
    }
    asm volatile("s_waitcnt lgkmcnt(0)" ::: "memory");
#pragma unroll
    for (int i = 0; i < 4; ++i) { const int base = lane * 8 + 512 * i;
      if (base < ntok) { const u32x4 v = gv[i];
        float u[10]; u[0] = bf2f(gpv[i]); u[1] = bflo(v.x); u[2] = bfhi(v.x); u[3] = bflo(v.y); u[4] = bfhi(v.y); u[5] = bflo(v.z); u[6] = bfhi(v.z); u[7] = bflo(v.w); u[8] = bfhi(v.w); u[9] = bf2f(gnx[i]);
        LP zp = zout + ((base >> 5) * 40 + (base & 31)) * 2; const u32x4 t = *(const LAS u32x4*)zp;
        float tv[8]; tv[0] = bflo(t.x); tv[1] = bfhi(t.x); tv[2] = bflo(t.y); tv[3] = bfhi(t.y); tv[4] = bflo(t.z); tv[5] = bfhi(t.z); tv[6] = bflo(t.w); tv[7] = bfhi(t.w);
        float o[8];
#pragma unroll
        for (int e = 0; e < 8; ++e) o[e] = (cb + w0 * u[e] + w1 * u[e + 1] + w2 * u[e + 2]) * tv[e];
        u32x4 w; w.x = pack2(o[0], o[1]); w.y = pack2(o[2], o[3]); w.z = pack2(o[4], o[5]); w.w = pack2(o[6], o[7]);
        *(LAS u32x4*)zp = w; } }
    asm volatile("s_waitcnt lgkmcnt(0)" ::: "memory");
  }
  __syncthreads();
  { bf16_t* YH = (bf16_t*)((unsigned char*)p.out + OUT_HB);
    for (int tl = tid; tl < ntok; tl += 512) {
      const int bl = tl >> lgL, tloc = tl & (L - 1); const int zo = ((((bl << lgnb) + (tloc >> 5)) * 40) + (tloc & 31)) * 2;
      unsigned short e[8];
#pragma unroll
      for (int w = 0; w < 8; ++w) e[w] = *(const LAS unsigned short*)(lds + w * HY_WAVE + HY_ZA + zo);
      u32x4 o; o.x = e[0] | ((unsigned)e[1] << 16); o.y = e[2] | ((unsigned)e[3] << 16); o.z = e[4] | ((unsigned)e[5] << 16); o.w = e[6] | ((unsigned)e[7] << 16);
      *(u32x4*)(YH + (size_t)(tok0 + tl) * 1024 + cgp * 8) = o; } }
  __syncthreads();
}

__device__ void final_norm(const Params& p) {
  const int tid0 = opaque_tid(); const int wid = tid0 >> 6, lane = tid0 & 63; const float* fw = p.in[31];
  const float* P = (const float*)(p.ws + OFF_BIG + (size_t)8192 * 4096 * 2); const float* mod = (const float*)(p.ws + OFF_MOD);
  f32x4 wv[4];
#pragma unroll
  for (int i = 0; i < 4; ++i) wv[i] = *(const f32x4*)(fw + 4 * lane + 256 * i);
  for (int unit = blockIdx.x; unit < 768; unit += gridDim.x) {
    const int row0 = unit * 32 + wid * 4; const bool chunkB = row0 >= 16384;
    f32x4 x[4][4];
#pragma unroll
    for (int r = 0; r < 4; ++r)
#pragma unroll
      for (int i = 0; i < 4; ++i) x[r][i] = *(const f32x4*)(p.out + (size_t)(row0 + r) * 1024 + 4 * lane + 256 * i);
    if (chunkB) { const float* md = mod + cond_of_row(row0) * 6144 + 5120;
#pragma unroll
      for (int i = 0; i < 4; ++i) { const f32x4 g2 = *(const f32x4*)(md + 4 * lane + 256 * i);
#pragma unroll
        for (int r = 0; r < 4; ++r) x[r][i] += g2 * *(const f32x4*)(P + (size_t)(row0 + r - 16384) * 1024 + 4 * lane + 256 * i); } }
#pragma unroll
    for (int r = 0; r < 4; ++r) { float ss = 0.f;
#pragma unroll
      for (int i = 0; i < 4; ++i) ss += x[r][i][0] * x[r][i][0] + x[r][i][1] * x[r][i][1] + x[r][i][2] * x[r][i][2] + x[r][i][3] * x[r][i][3];
      ss = wave_sum(ss); const float rstd = rsqrtf(ss * (1.0f / 1024.0f) + 1e-6f);
#pragma unroll
      for (int i = 0; i < 4; ++i) *(f32x4*)(p.out + (size_t)(row0 + r) * 1024 + 4 * lane + 256 * i) = x[r][i] * rstd * wv[i]; }
  }
}

__global__ void __launch_bounds__(512, 2) __attribute__((flatten)) mega(Params p) {
  extern __shared__ __attribute__((aligned(16))) unsigned char shm[];
  LP lds = (LP)shm;
  cg::grid_group grid = cg::this_grid();
  volatile LAS unsigned* xst = (volatile LAS unsigned*)(lds + LDS_BYTES - 16);
  if (threadIdx.x == 0) { xst[0] = 0u; xst[1] = 0u; }
  __syncthreads();
  const XcdBarrier xb = xcd_barrier_post((unsigned*)(p.ws + OFF_BAR), xst);
  unsigned char* ws = p.ws;
  const bf16_t* WT = (const bf16_t*)(ws + OFF_WT); const bf16_t* HN = (const bf16_t*)(ws + OFF_HN); bf16_t* BIG = (bf16_t*)(ws + OFF_BIG);
  bf16_t* Hb = (bf16_t*)((unsigned char*)p.out + OUT_H); bf16_t* YH = (bf16_t*)((unsigned char*)p.out + OUT_HB);
  const float* mod = (const float*)(ws + OFF_MOD);
  phase0(p, lds);
  if (gridDim.y == 7u) grid.sync();
  xcd_barrier(xb);
  phase1(p, lds);
  weight_tiles(p, lds, 0, 384, 0);
  xcd_barrier(xb);
  filters_upper_half(p, lds);
  weight_tiles(p, lds, 384, 768, 1);
  { EpiQKV e; e.O = BIG; e.bias = p.in[11]; run_gemm(lds, HN, WT, NTOK, 3072, 1024, e); }
  xcd_barrier(xb);
  for (int item = blockIdx.x; item < 1280; item += gridDim.x) mlstm_item(p, lds, item);
  xcd_barrier(xb);
  combine_rows(p);
  weight_tiles(p, lds, 768, 1152, 1);
  { EpiUT e; e.O = BIG; e.bias = p.in[11] + 4112; run_gemm(lds, WT + (size_t)3072 * 1024, HN, 3072, NTOK, 1024, e); }
  xcd_barrier(xb);
  for (int item = blockIdx.x; item < 1536; item += gridDim.x) hyena_item(p, lds, item);
  xcd_barrier(xb);
  c1_upper_half(p, lds);
  weight_tiles(p, lds, 1152, 1536, 1);
  { EpiGates e; e.H = Hb; e.G = BIG; e.b_in = p.in[11]; run_gemm(lds, HN, WT + (size_t)6144 * 1024, NTOK, 3072, 1024, e); }
  xcd_barrier(xb);
  bf16_t* T = BIG + (size_t)NTOK * 2048;
  weight_tiles(p, lds, 1536, 2560, 1);
  { EpiMerge<0> e; e.T = T; e.G = BIG; run_gemm(lds, Hb, (const bf16_t*)(ws + OFF_WBM), NTOK, 1024, 1024, e); }
  { EpiMerge<1> e; e.T = T; e.G = BIG; run_gemm(lds, YH, (const bf16_t*)(ws + OFF_WBH), NTOK, 1024, 1024, e); }
  xcd_barrier(xb);
  { EpiOut e; e.xp = p.in[0]; e.xs = p.in[1]; e.per = (const float*)(ws + OFF_PER); e.pec = (const float*)(ws + OFF_PEC); e.mod = mod; e.n2w = p.in[26];
    e.X1 = p.out; e.A2 = (bf16_t*)(ws + OFF_HN); e.ssq = (float*)(ws + OFF_SSQ1); run_gemm(lds, T, (const bf16_t*)(ws + OFF_WOUT), NTOK, 1024, 1024, e); }
  xcd_barrier(xb);
  constexpr int ROWS_A = 16384, ROWS_B = NTOK - ROWS_A;
  { EpiFF1 e; e.row0 = 0; e.ssq = (const float*)(p.ws + OFF_SSQ1); e.c1 = (const float*)(p.ws + OFF_C1); e.Hd = (bf16_t*)(p.ws + OFF_BIG);
    run_gemm(lds, (const bf16_t*)(p.ws + OFF_HN), (const bf16_t*)(p.ws + OFF_W1T), ROWS_A, 4096, 1024, e); }
  xcd_barrier(xb);
  { EpiFF2 e; e.row0 = 0; e.mod = (const float*)(p.ws + OFF_MOD); e.b2 = p.in[30]; e.X = p.out; e.P = (float*)(p.ws + OFF_BIG + (size_t)ROWS_A * 4096 * 2);
    run_gemm(lds, (const bf16_t*)(p.ws + OFF_BIG), (const bf16_t*)(p.ws + OFF_W2T), ROWS_A, 1024, 4096, e); }
  xcd_barrier(xb);
  { EpiFF1 e; e.row0 = ROWS_A; e.ssq = (const float*)(p.ws + OFF_SSQ1); e.c1 = (const float*)(p.ws + OFF_C1); e.Hd = (bf16_t*)(p.ws + OFF_BIG);
    run_gemm(lds, (const bf16_t*)(p.ws + OFF_HN) + (size_t)ROWS_A * 1024, (const bf16_t*)(p.ws + OFF_W1T), ROWS_B, 4096, 1024, e); }
  xcd_barrier(xb);
  { EpiFF2 e; e.row0 = ROWS_A; e.mod = (const float*)(p.ws + OFF_MOD); e.b2 = p.in[30]; e.X = p.out; e.P = (float*)(p.ws + OFF_BIG + (size_t)ROWS_B * 4096 * 2);
    run_gemm(lds, (const bf16_t*)(p.ws + OFF_BIG), (const bf16_t*)(p.ws + OFF_W2T), ROWS_B, 1024, 4096, e, 2); }
  xcd_barrier(xb);
  final_norm(p);
}

extern "C" void kernel_launch(void* const* d_in, const int* in_sizes, int n_in, void* d_out, int out_size, void* d_ws, size_t ws_size, hipStream_t stream) {
  static int grid_blocks = 0;
  if (!grid_blocks) {
    int dev = 0, cus = 0, per_cu = 0;
    hipGetDevice(&dev);
    hipDeviceGetAttribute(&cus, hipDeviceAttributeMultiprocessorCount, dev);
    hipFuncSetAttribute((const void*)mega, hipFuncAttributeMaxDynamicSharedMemorySize, LDS_BYTES);
    hipOccupancyMaxActiveBlocksPerMultiprocessor(&per_cu, (const void*)mega, 512, LDS_BYTES);
    if (per_cu < 1) { fprintf(stderr, "kernel_launch: occupancy query reports %d blocks per CU\n", per_cu); grid_blocks = -1; }
    else grid_blocks = cus;
    if (n_in != 32 || ws_size < WS_END) { fprintf(stderr, "kernel_launch: unexpected n_in %d / ws_size %zu (need %zu)\n", n_in, ws_size, (size_t)WS_END); grid_blocks = -1; }
  }
  if (grid_blocks < 0) return;
  hipMemsetAsync((unsigned char*)d_ws + OFF_BAR, 0, 3456 * 4, stream);
  Params p{};
  for (int i = 0; i < 32; ++i) p.in[i] = (const float*)d_in[i];
  p.out = (float*)d_out; p.ws = (unsigned char*)d_ws;
  void* args[] = {&p};
  hipError_t e = hipLaunchCooperativeKernel((void*)mega, dim3(grid_blocks), dim3(512), args, LDS_BYTES, stream);
  if (e != hipSuccess) fprintf(stderr, "cooperative launch failed: %s (grid %d)\n", hipGetErrorString(e), grid_blocks);
}
```

```cpp
#include <hip/hip_runtime.h>
#include <hip/hip_cooperative_groups.h>
#include <cstdio>
#include <cstdint>
namespace cg = cooperative_groups;

#define LAS __attribute__((address_space(3)))
typedef LAS unsigned char* LP;
typedef unsigned short bf16_t;
typedef short bf16x8 __attribute__((ext_vector_type(8)));
typedef short s16x4 __attribute__((ext_vector_type(4)));
typedef float f32x4 __attribute__((ext_vector_type(4)));
typedef float f32x16 __attribute__((ext_vector_type(16)));
typedef unsigned u32x4 __attribute__((ext_vector_type(4)));
typedef unsigned u32x2 __attribute__((ext_vector_type(2)));

constexpr int DM = 1024, NTOK = 24576, NCTX = 8192, SEQC = 256, SEQS = 2048, INC = 9232;
constexpr int LDS_BYTES = 160 * 1024;
constexpr size_t OFF_WT = 0;
constexpr size_t OFF_WBM = 18874368, OFF_WBH = 20971520, OFF_WOUT = 23068672, OFF_W1T = 25165824, OFF_W2T = 33554432;
constexpr size_t OFF_HN = 41943040;
constexpr size_t OFF_BIG = 92274688;
constexpr size_t OFF_SM = 243269632;
constexpr size_t OFF_MOD = OFF_SM;
constexpr size_t OFF_C1 = OFF_MOD + 221184;
constexpr size_t OFF_H2S = OFF_C1 + 147456;
constexpr size_t OFF_H2C = OFF_H2S + 524288;
constexpr size_t OFF_PER = OFF_H2C + 65536;
constexpr size_t OFF_PEC = OFF_PER + 65536;
constexpr size_t OFF_GT = OFF_PEC + 131072;
constexpr size_t OFF_SSQ1 = OFF_GT + 1572864;
constexpr size_t OFF_SSQ2 = OFF_SSQ1 + 1572864;
constexpr size_t OFF_HFS = OFF_SSQ2 + 1572864;
constexpr size_t OFF_HFC = OFF_HFS + 16777216;
constexpr size_t OFF_BAR = OFF_HFC + 2097152;
constexpr size_t WS_END = OFF_BAR + 3456 * 4;
constexpr size_t OUT_H = 0, OUT_HB = 50331648;
constexpr size_t OUTF_C = 25165824, OUTF_N = 41943040, OUTF_M = 42008576;

struct Params { const float* in[32]; float* out; unsigned char* ws; };

typedef float f32x2 __attribute__((ext_vector_type(2)));
typedef __bf16 bf16x2v __attribute__((ext_vector_type(2)));
__device__ __forceinline__ bf16_t f2bf(float f) { const __bf16 b = (__bf16)f; return __builtin_bit_cast(unsigned short, b); }
__device__ __forceinline__ float bf2f(unsigned b) { return __uint_as_float(b << 16); }
__device__ __forceinline__ unsigned pack2(float lo, float hi) { const f32x2 v = {lo, hi}; const bf16x2v r = __builtin_convertvector(v, bf16x2v); return __builtin_bit_cast(unsigned, r); }
__device__ __forceinline__ float bflo(unsigned w) { return __uint_as_float(w << 16); }
__device__ __forceinline__ float bfhi(unsigned w) { return __uint_as_float(w & 0xffff0000u); }
__device__ __forceinline__ float sigmoidf_(float x) { return __builtin_amdgcn_rcpf(1.0f + __expf(-x)); }
__device__ __forceinline__ int opaque_tid() { int t = threadIdx.x; asm volatile("" : "+v"(t)); return t; }
__device__ __forceinline__ float wave_sum(float v) {
#pragma unroll
  for (int o = 32; o >= 1; o >>= 1) v += __shfl_xor(v, o);
  return v;
}


#define XB_TMO      128
#define XB_XCNT(j)  (256  + 64 * (j))
#define XB_XSUB(j)  (1280 + 64 * (j))
#define XB_XGEN(j)  (2304 + 64 * (j))
#define XB_TOP      3328
#define XB_TOPGEN   3392
#define XCD_BAR_WORDS 3456
#define XB_SPIN_CAP (1u << 18)
__device__ __forceinline__ unsigned xb_ld(unsigned* p)              { return __hip_atomic_load(p, __ATOMIC_RELAXED, __HIP_MEMORY_SCOPE_AGENT); }
__device__ __forceinline__ unsigned xb_add(unsigned* p, unsigned v) { return __hip_atomic_fetch_add(p, v, __ATOMIC_RELAXED, __HIP_MEMORY_SCOPE_AGENT); }
__device__ __forceinline__ unsigned xb_xcc_id() { return (unsigned)__builtin_amdgcn_s_getreg((3 << 11) | 20) & 0xFu; }
#define XB_SPIN(cond, bar) do { unsigned _sp = 0; while (cond) { __builtin_amdgcn_s_sleep(1); \
    if ((++_sp & 255u) == 0u) { if (xb_ld(&(bar)[XB_TMO])) break; if (_sp > XB_SPIN_CAP) { atomicAdd(&(bar)[XB_TMO], 1u); break; } } } } while (0)
struct XcdBarrier { unsigned* bar; unsigned x; volatile LAS unsigned* st; };
__device__ __forceinline__ XcdBarrier xcd_barrier_post(unsigned* bar, volatile LAS unsigned* st) {
  XcdBarrier b; b.bar = bar; b.x = xb_xcc_id(); b.st = st;
  if (threadIdx.x == 0) (void)xb_add(&bar[XB_XCNT(b.x)], 1u);
  return b;
}
__device__ __forceinline__ void xcd_barrier_complete(unsigned* bar, unsigned x, unsigned& nloc, unsigned& nx) {
  const unsigned G = gridDim.x * gridDim.y * gridDim.z;
  unsigned sum, cnt, mine, sp = 0u;
  for (;;) {
    sum = 0u; cnt = 0u; mine = 0u;
#pragma unroll
    for (unsigned j = 0; j < 16; ++j) { const unsigned c = xb_ld(&bar[XB_XCNT(j)]); sum += c; cnt += (c > 0u) ? 1u : 0u; mine = (j == x) ? c : mine; }
    if (sum == G) break;
    __builtin_amdgcn_s_sleep(1);
    if ((++sp & 255u) == 0u) { if (xb_ld(&bar[XB_TMO])) break; if (sp > XB_SPIN_CAP) { atomicAdd(&bar[XB_TMO], 1u); break; } }
  }
  nloc = mine > 0u ? mine : 1u; nx = cnt > 0u ? cnt : 1u;
}
__device__ __forceinline__ void xcd_barrier(const XcdBarrier& b) {
  asm volatile("s_waitcnt vmcnt(0)" ::: "memory");
  __syncthreads();
  if (threadIdx.x == 0) {
    unsigned* bar = b.bar;
    __builtin_amdgcn_s_waitcnt(0);
    unsigned nloc = b.st[0], nx = b.st[1];
    if (nloc == 0u) { xcd_barrier_complete(bar, b.x, nloc, nx); b.st[0] = nloc; b.st[1] = nx; }
    const unsigned old = xb_add(&bar[XB_XSUB(b.x)], 1u);
    const unsigned gen = old / nloc;
    if (old + 1u == (gen + 1u) * nloc) {
      __builtin_amdgcn_fence(__ATOMIC_RELEASE, "agent");
      asm volatile("s_waitcnt vmcnt(0)" ::: "memory");
      const unsigned og = xb_add(&bar[XB_TOP], 1u);
      const unsigned tg = og / nx;
      if (og + 1u == (tg + 1u) * nx) xb_add(&bar[XB_TOPGEN], 1u);
      else XB_SPIN(xb_ld(&bar[XB_TOPGEN]) == tg, bar);
      __builtin_amdgcn_fence(__ATOMIC_ACQUIRE, "agent");
      xb_add(&bar[XB_XGEN(b.x)], 1u);
      asm volatile("s_waitcnt vmcnt(0)" ::: "memory");
    } else {
      XB_SPIN(xb_ld(&bar[XB_XGEN(b.x)]) == gen, bar);
      __builtin_amdgcn_fence(__ATOMIC_ACQUIRE, "agent");
      asm volatile("s_waitcnt vmcnt(0)" ::: "memory");
    }
  }
  __syncthreads();
}

namespace pg8 {
constexpr int BM = 256, BK = 64, HALF = 128, HTB = HALF * BK * 2, STAGE_BYTES = 8 * HTB, NXCD = 8, WGM = 8;
__host__ __device__ __forceinline__ int lds_byte(int r, int c) { const int st = (r >> 4) * 2 + (c >> 5), rr = r & 15, cc = c & 31, ob = rr * 64 + cc * 2; return st * 1024 + (ob ^ (((ob >> 9) & 1) << 5)); }
__host__ __device__ __forceinline__ void stage_rc(int b, int& R, int& C) { const int st = b / 1024, sb = b % 1024, swz = sb ^ (((sb >> 9) & 1) << 5); R = (st >> 1) * 16 + swz / 64; C = (st & 1) * 32 + (swz % 64) / 2; }
__host__ __device__ __forceinline__ int perm32(int rho) { const int n = rho >> 4, i = rho & 15; return 8 * (i >> 2) + 4 * n + (i & 3); }
struct Unit { int pm, pn, ks; };
struct Gemm { const bf16_t* A; const bf16_t* Bt; int M, N, K, ld, nks; };
struct StaticOrder {
  int nM, nN, ntile, nwg, G, c;
  __device__ void init(int M, int N, int nks, int G_, int c_) { nM = M / BM; nN = N / BM; ntile = nM * nN; nwg = ntile * nks; G = G_; c = c_; }
  __device__ bool next(int i, Unit& u) const {
    const long L = (long)i * G + c; if (L >= nwg) return false;
    u.ks = (int)L / ntile; int wgid = (int)L - u.ks * ntile;
    { const int q = ntile / NXCD, r = ntile % NXCD, xcd = wgid % NXCD, off = wgid / NXCD; wgid = (xcd < r ? xcd * (q + 1) : r * (q + 1) + (xcd - r) * q) + off; }
    const int nig = WGM * nN, gid = wgid / nig, fm = gid * WGM, gsz = (nM - fm) < WGM ? (nM - fm) : WGM;
    u.pm = fm + ((wgid % nig) % gsz); u.pn = (wgid % nig) / gsz; return true;
  }
};

template <class Epi>
__device__ __forceinline__ void gemm_phase(LP lds, const Gemm g, const StaticOrder& S, const Epi& E) {
  int tid_ = threadIdx.x; asm volatile("" : "+v"(tid_));
  const int tid = tid_, wid = __builtin_amdgcn_readfirstlane(tid >> 6), lane = tid & 63, wr = wid >> 2, wc = wid & 3, fr = lane & 15, fq = lane >> 4;
  const int K = g.ld, nt = g.K / BK;
  const size_t ksb = (size_t)g.K * 2;
  unsigned voffA[2], voffB[2];
#pragma unroll
  for (int i = 0; i < 2; ++i) { int R, C; stage_rc(tid * 16 + i * 8192, R, C); const int Rb = (R & ~31) + perm32(R & 31); voffA[i] = (unsigned)(R * K + C) * 2u; voffB[i] = (unsigned)(Rb * K + C) * 2u; }
  const size_t kstep = (size_t)(BK * 2);
  const size_t hstep = (size_t)HALF * K * 2;
  const size_t tstep = 2 * hstep;
  const unsigned ldsw = (unsigned)wid * 1024u;
  const int aoff = lds_byte(wr * 64 + fr, fq * 8), boff = lds_byte(wc * 32 + fr, fq * 8);
#define PG8_SA(b, h) (((b) * 2 + (h)) * HTB)
#define PG8_SB(b, h) ((4 + (b) * 2 + (h)) * HTB)
#define PG8_STAGE(bufoff, gbase, voff) do { _Pragma("unroll") for (int _i = 0; _i < 2; ++_i) \
    __builtin_amdgcn_global_load_lds((const unsigned*)((const char*)(gbase) + (voff)[_i]), (LAS unsigned*)(lds + (bufoff) + ldsw + _i * 8192), 16, 0, 0); } while (0)
#define PG8_LDA(dst, b, h) do { _Pragma("unroll") for (int m = 0; m < 4; ++m) _Pragma("unroll") for (int k = 0; k < 2; ++k) dst[m][k] = *(const LAS bf16x8*)(lds + PG8_SA(b, h) + aoff + m * 2048 + k * 1024); } while (0)
#define PG8_LDB(dst, b, h) do { _Pragma("unroll") for (int n = 0; n < 2; ++n) _Pragma("unroll") for (int k = 0; k < 2; ++k) dst[n][k] = *(const LAS bf16x8*)(lds + PG8_SB(b, h) + boff + n * 2048 + k * 1024); } while (0)
#define PG8_MMA(ai, bj, At, Bt) do { __builtin_amdgcn_s_setprio(1); _Pragma("unroll") for (int m = 0; m < 4; ++m) _Pragma("unroll") for (int n = 0; n < 2; ++n) _Pragma("unroll") for (int k = 0; k < 2; ++k) \
    acc[ai][bj][m][n] = __builtin_amdgcn_mfma_f32_16x16x32_bf16(Bt[n][k], At[m][k], acc[ai][bj][m][n], 0, 0, 0); __builtin_amdgcn_s_setprio(0); } while (0)
#define PG8_WAIT_V(n) asm volatile("s_waitcnt vmcnt(" #n ")" ::: "memory")
#define PG8_WAIT_L(n) asm volatile("s_waitcnt lgkmcnt(" #n ")" ::: "memory")
#define PG8_BAR __builtin_amdgcn_s_barrier()
#define PG8_SCHED __builtin_amdgcn_sched_barrier(0)
  Unit cur, nxt; int ui = 0;
  if (!S.next(0, cur)) return;
  f32x4 acc[2][2][4][2];
#pragma unroll
  for (int a = 0; a < 2; ++a)
#pragma unroll
    for (int b = 0; b < 2; ++b)
#pragma unroll
      for (int m = 0; m < 4; ++m)
#pragma unroll
        for (int n = 0; n < 2; ++n) acc[a][b][m][n] = (f32x4){0.f, 0.f, 0.f, 0.f};
  bf16x8 At[4][2], B0[2][2], B1[2][2];
  const char* cA = (const char*)g.A + (size_t)cur.pm * tstep + cur.ks * ksb; const char* cB = (const char*)g.Bt + (size_t)cur.pn * tstep + cur.ks * ksb;
  PG8_STAGE(PG8_SB(0, 0), cB, voffB); PG8_STAGE(PG8_SB(0, 1), cB + hstep, voffB); PG8_STAGE(PG8_SA(0, 0), cA, voffA); PG8_STAGE(PG8_SA(0, 1), cA + hstep, voffA);
  if (wr == 1) PG8_BAR;
  PG8_WAIT_V(2); PG8_BAR;
  PG8_STAGE(PG8_SB(1, 0), cB + kstep, voffB); PG8_STAGE(PG8_SA(1, 0), cA + kstep, voffA); PG8_STAGE(PG8_SB(1, 1), cB + hstep + kstep, voffB);
  PG8_WAIT_V(6); PG8_BAR;
  for (;;) {
    const bool has_next = S.next(ui + 1, nxt);
    const char* nA = has_next ? (const char*)g.A + (size_t)nxt.pm * tstep + nxt.ks * ksb : cA; const char* nB = has_next ? (const char*)g.Bt + (size_t)nxt.pn * tstep + nxt.ks * ksb : cB;
    for (int t = 0; t < nt; t += 2) {
      const bool last = (t == nt - 2);
      const char* a1 = cA + (size_t)(t + 1) * kstep;
      const char* a2 = last ? nA : cA + (size_t)(t + 2) * kstep; const char* b2 = last ? nB : cB + (size_t)(t + 2) * kstep;
      const char* a3 = a2 + kstep; const char* b3 = b2 + kstep;
      PG8_LDB(B0, 0, 0); PG8_LDB(B1, 0, 1); PG8_SCHED; PG8_LDA(At, 0, 0); PG8_STAGE(PG8_SA(1, 1), a1 + hstep, voffA);
      PG8_WAIT_V(8); PG8_WAIT_L(0); PG8_BAR; PG8_MMA(0, 0, At, B0); PG8_MMA(0, 1, At, B1); PG8_BAR; PG8_SCHED;
      PG8_LDA(At, 0, 1); PG8_STAGE(PG8_SB(0, 0), b2, voffB); PG8_STAGE(PG8_SB(0, 1), b2 + hstep, voffB); PG8_STAGE(PG8_SA(0, 0), a2, voffA);
      PG8_WAIT_V(8); PG8_WAIT_L(0); PG8_BAR; PG8_MMA(1, 0, At, B0); PG8_MMA(1, 1, At, B1); PG8_BAR; PG8_SCHED;
      PG8_LDB(B0, 1, 0); PG8_LDB(B1, 1, 1); PG8_SCHED; PG8_LDA(At, 1, 0); PG8_STAGE(PG8_SA(0, 1), a2 + hstep, voffA);
      PG8_WAIT_V(8); PG8_WAIT_L(0); PG8_BAR; PG8_MMA(0, 0, At, B0); PG8_MMA(0, 1, At, B1); PG8_BAR; PG8_SCHED;
      PG8_LDA(At, 1, 1); PG8_STAGE(PG8_SB(1, 0), b3, voffB); PG8_STAGE(PG8_SB(1, 1), b3 + hstep, voffB); PG8_STAGE(PG8_SA(1, 0), a3, voffA);
      PG8_WAIT_V(8); PG8_WAIT_L(0); PG8_BAR; PG8_MMA(1, 0, At, B0); PG8_MMA(1, 1, At, B1); PG8_BAR; PG8_SCHED;
    }
    if (wr == 0) PG8_BAR;
    { int fr2 = fr, fq2 = fq; asm volatile("" : "+v"(fr2), "+v"(fq2)); E(acc, cur, wr, wc, fr2, fq2); }
    if (!has_next) break;
#pragma unroll
    for (int a = 0; a < 2; ++a)
#pragma unroll
      for (int b = 0; b < 2; ++b)
#pragma unroll
        for (int m = 0; m < 4; ++m)
#pragma unroll
          for (int n = 0; n < 2; ++n) acc[a][b][m][n] = (f32x4){0.f, 0.f, 0.f, 0.f};
    cur = nxt; cA = nA; cB = nB; ++ui;
    if (wr == 1) PG8_BAR;
  }
  PG8_WAIT_V(0);
  PG8_BAR;
#undef PG8_SA
#undef PG8_SB
#undef PG8_STAGE
#undef PG8_LDA
#undef PG8_LDB
#undef PG8_MMA
#undef PG8_WAIT_V
#undef PG8_WAIT_L
#undef PG8_BAR
#undef PG8_SCHED
}
}
using pg8::Unit;
typedef f32x4 AccT[2][2][4][2];

#define EPI_ROW(ai, m) (u.pm * 256 + (ai) * 128 + wr * 64 + (m) * 16 + fr)
#define EPI_COL(bj, n) (u.pn * 256 + (bj) * 128 + wc * 32 + 8 * fq + 4 * (n))
#define EPI_LOOP_ROWS _Pragma("unroll") for (int ai = 0; ai < 2; ++ai) _Pragma("unroll") for (int m = 0; m < 4; ++m)
#define EPI_LOOP_COLS _Pragma("unroll") for (int bj = 0; bj < 2; ++bj) _Pragma("unroll") for (int n = 0; n < 2; ++n)

__device__ __forceinline__ int cond_of_row(int row) { return row < NCTX ? 0 : 1 + ((row - NCTX) >> 11); }

#define EPI_LOOP_BJ _Pragma("unroll") for (int bj = 0; bj < 2; ++bj)
__device__ __forceinline__ u32x4 pack8(const f32x4 v0, const f32x4 v1) { u32x4 w; w.x = pack2(v0[0], v0[1]); w.y = pack2(v0[2], v0[3]); w.z = pack2(v1[0], v1[1]); w.w = pack2(v1[2], v1[3]); return w; }
__device__ __forceinline__ void unpack8(const u32x4 w, f32x4& v0, f32x4& v1) { v0[0] = bflo(w.x); v0[1] = bfhi(w.x); v0[2] = bflo(w.y); v0[3] = bfhi(w.y); v1[0] = bflo(w.z); v1[1] = bfhi(w.z); v1[2] = bflo(w.w); v1[3] = bfhi(w.w); }
struct EpiQKV {
  bf16_t* O; const float* bias;
  __device__ __forceinline__ void operator()(const AccT& acc, const Unit& u, int wr, int wc, int fr, int fq) const {
    const float sc = (u.pn < 4) ? 0.0625f : 1.0f;
    f32x4 bv[2][2];
    EPI_LOOP_COLS { bv[bj][n] = *(const f32x4*)(bias + EPI_COL(bj, n)); }
    EPI_LOOP_ROWS { const int row = EPI_ROW(ai, m);
      EPI_LOOP_BJ { *(u32x4*)(O + (size_t)row * 3072 + EPI_COL(bj, 0)) = pack8((acc[ai][bj][m][0] + bv[bj][0]) * sc, (acc[ai][bj][m][1] + bv[bj][1]) * sc); } }
  }
};
struct EpiUT {
  bf16_t* O; const float* bias;
  __device__ __forceinline__ void operator()(const AccT& acc, const Unit& u, int wr, int wc, int fr, int fq) const {
    EPI_LOOP_ROWS { const int row = EPI_ROW(ai, m); const float bv = bias[row];
      EPI_LOOP_BJ { *(u32x4*)(O + (size_t)row * NTOK + EPI_COL(bj, 0)) = pack8(acc[ai][bj][m][0] + bv, acc[ai][bj][m][1] + bv); } }
  }
};
struct EpiGates {
  bf16_t* H; bf16_t* G; const float* b_in;
  __device__ __forceinline__ void operator()(const AccT& acc, const Unit& u, int wr, int wc, int fr, int fq) const {
    const bool og = u.pn < 4;
    f32x4 bv[2][2];
    EPI_LOOP_COLS { const int col = EPI_COL(bj, n); bv[bj][n] = *(const f32x4*)(b_in + (og ? 3072 + col : 7184 + (col - 1024))); }
#pragma unroll
    for (int ai = 0; ai < 2; ++ai)
#pragma unroll
      for (int m2 = 0; m2 < 2; ++m2) {
        u32x4 hv[2][2];
        if (og) {
#pragma unroll
          for (int mm = 0; mm < 2; ++mm) { const int row = EPI_ROW(ai, 2 * m2 + mm); EPI_LOOP_BJ { hv[mm][bj] = *(const u32x4*)(H + (size_t)row * 1024 + EPI_COL(bj, 0)); } } }
#pragma unroll
        for (int mm = 0; mm < 2; ++mm) { const int m = 2 * m2 + mm; const int row = EPI_ROW(ai, m);
          EPI_LOOP_BJ { const int col = EPI_COL(bj, 0); f32x4 s0, s1; const f32x4 a0 = acc[ai][bj][m][0] + bv[bj][0], a1 = acc[ai][bj][m][1] + bv[bj][1];
#pragma unroll
            for (int e = 0; e < 4; ++e) { s0[e] = sigmoidf_(a0[e]); s1[e] = sigmoidf_(a1[e]); }
            if (og) { f32x4 h0, h1; unpack8(hv[mm][bj], h0, h1); *(u32x4*)(H + (size_t)row * 1024 + col) = pack8(h0 * s0, h1 * s1); }
            else *(u32x4*)(G + (size_t)row * 2048 + (col - 1024)) = pack8(s0, s1); } } }
  }
};
template <int SECOND> struct EpiMerge {
  bf16_t* T; const bf16_t* G;
  __device__ __forceinline__ void operator()(const AccT& acc, const Unit& u, int wr, int wc, int fr, int fq) const {
#pragma unroll
    for (int ai = 0; ai < 2; ++ai)
#pragma unroll
      for (int m2 = 0; m2 < 2; ++m2) {
        u32x4 gv[2][2], tv[2][2];
#pragma unroll
        for (int mm = 0; mm < 2; ++mm) { const int row = EPI_ROW(ai, 2 * m2 + mm);
          EPI_LOOP_BJ { const int col = EPI_COL(bj, 0); gv[mm][bj] = *(const u32x4*)(G + (size_t)row * 2048 + SECOND * 1024 + col);
            if (SECOND) tv[mm][bj] = *(const u32x4*)(T + (size_t)row * 1024 + col); } }
#pragma unroll
        for (int mm = 0; mm < 2; ++mm) { const int m = 2 * m2 + mm; const int row = EPI_ROW(ai, m);
          EPI_LOOP_BJ { const int col = EPI_COL(bj, 0); f32x4 g0, g1; unpack8(gv[mm][bj], g0, g1);
            f32x4 v0 = g0 * acc[ai][bj][m][0], v1 = g1 * acc[ai][bj][m][1];
            if (SECOND) { f32x4 t0, t1; unpack8(tv[mm][bj], t0, t1); v0 += t0; v1 += t1; }
            *(u32x4*)(T + (size_t)row * 1024 + col) = pack8(v0, v1); } } }
  }
};
struct EpiOut {
  const float* xp; const float* xs; const float* per; const float* pec; const float* mod; const float* n2w; float* X1; bf16_t* A2; float* ssq;
  __device__ __forceinline__ void operator()(const AccT& acc, const Unit& u, int wr, int wc, int fr, int fq) const {
    const int cb = cond_of_row(u.pm * 256); const float* md = mod + cb * 6144; const bool smp = (u.pm * 256) >= NCTX;
    f32x4 g1v[2][2], k2v[2][2];
    EPI_LOOP_COLS { const int col = EPI_COL(bj, n); g1v[bj][n] = *(const f32x4*)(md + 2048 + col); k2v[bj][n] = *(const f32x4*)(n2w + col) * (*(const f32x4*)(md + 4096 + col) + 1.0f); }
    EPI_LOOP_ROWS { const int row = EPI_ROW(ai, m); float ss = 0.f;
#pragma unroll
      for (int bj = 0; bj < 2; ++bj) {
        f32x4 x0[2];
        if (!smp) {
#pragma unroll
          for (int n = 0; n < 2; ++n) x0[n] = *(const f32x4*)(xp + (size_t)row * 1024 + EPI_COL(bj, n)); }
        else { const int r2 = row - NCTX, t = r2 & 2047; f32x4 pe[2];
#pragma unroll
          for (int n = 0; n < 2; ++n) { const int col = EPI_COL(bj, n); x0[n] = *(const f32x4*)(xs + (size_t)r2 * 1024 + col);
            pe[n] = (col < 512) ? *(const f32x4*)(per + (t >> 6) * 512 + col) : *(const f32x4*)(pec + (t & 63) * 512 + (col - 512)); }
#pragma unroll
          for (int n = 0; n < 2; ++n) x0[n] += pe[n]; }
        f32x4 x1[2];
#pragma unroll
        for (int n = 0; n < 2; ++n) { x1[n] = x0[n] + g1v[bj][n] * acc[ai][bj][m][n]; *(f32x4*)(X1 + (size_t)row * 1024 + EPI_COL(bj, n)) = x1[n];
          ss += x1[n][0] * x1[n][0] + x1[n][1] * x1[n][1] + x1[n][2] * x1[n][2] + x1[n][3] * x1[n][3]; }
        *(u32x4*)(A2 + (size_t)row * 1024 + EPI_COL(bj, 0)) = pack8(x1[0] * k2v[bj][0], x1[1] * k2v[bj][1]); }
      ss += __shfl_xor(ss, 16); ss += __shfl_xor(ss, 32);
      if (fq == 0) ssq[(size_t)row * 16 + u.pn * 4 + wc] = ss; }
  }
};
struct EpiFF1 {
  int row0; const float* ssq; const float* c1; bf16_t* Hd;
  __device__ __forceinline__ void operator()(const AccT& acc, const Unit& u, int wr, int wc, int fr, int fq) const {
    const int cb = cond_of_row(row0 + u.pm * 256); const float* cc = c1 + cb * 4096;
    f32x4 cv[2][2];
    EPI_LOOP_COLS { cv[bj][n] = *(const f32x4*)(cc + EPI_COL(bj, n)); }
    float rs[2][4];
    EPI_LOOP_ROWS { const float* sp = ssq + (size_t)(row0 + EPI_ROW(ai, m)) * 16;
      const f32x4 st = (*(const f32x4*)sp + *(const f32x4*)(sp + 4)) + (*(const f32x4*)(sp + 8) + *(const f32x4*)(sp + 12));
      rs[ai][m] = rsqrtf((st[0] + st[1] + st[2] + st[3]) * (1.0f / 1024.0f) + 1e-6f); }
    EPI_LOOP_ROWS { const int rl = EPI_ROW(ai, m); const float rstd = rs[ai][m];
      EPI_LOOP_BJ { f32x4 v0 = acc[ai][bj][m][0] * rstd + cv[bj][0], v1 = acc[ai][bj][m][1] * rstd + cv[bj][1];
#pragma unroll
        for (int e = 0; e < 4; ++e) { const float r0 = fmaxf(v0[e], 0.f), r1 = fmaxf(v1[e], 0.f); v0[e] = r0 * r0; v1[e] = r1 * r1; }
        *(u32x4*)(Hd + (size_t)rl * 4096 + EPI_COL(bj, 0)) = pack8(v0, v1); } }
  }
};
struct EpiFF2 {
  int row0; const float* mod; const float* b2; float* X; float* P;
  __device__ __forceinline__ void operator()(const AccT& acc, const Unit& u, int wr, int wc, int fr, int fq) const {
    if (u.ks == 1) {
      EPI_LOOP_ROWS { const int rl = EPI_ROW(ai, m); EPI_LOOP_COLS { *(f32x4*)(P + (size_t)rl * 1024 + EPI_COL(bj, n)) = acc[ai][bj][m][n]; } }
    } else {
    const int cb = cond_of_row(row0 + u.pm * 256); const float* md = mod + cb * 6144;
    f32x4 g2v[2][2], bbv[2][2];
    EPI_LOOP_COLS { const int col = EPI_COL(bj, n); g2v[bj][n] = *(const f32x4*)(md + 5120 + col); bbv[bj][n] = *(const f32x4*)(b2 + col); }
#pragma unroll
    for (int ai = 0; ai < 2; ++ai)
#pragma unroll
      for (int m2 = 0; m2 < 2; ++m2) {
        f32x4 xv[2][2][2];
#pragma unroll
        for (int mm = 0; mm < 2; ++mm) { const int row = row0 + EPI_ROW(ai, 2 * m2 + mm); EPI_LOOP_COLS { xv[mm][bj][n] = *(const f32x4*)(X + (size_t)row * 1024 + EPI_COL(bj, n)); } }
#pragma unroll
        for (int mm = 0; mm < 2; ++mm) { const int m = 2 * m2 + mm; const int row = row0 + EPI_ROW(ai, m);
          EPI_LOOP_COLS { const int col = EPI_COL(bj, n); *(f32x4*)(X + (size_t)row * 1024 + col) = xv[mm][bj][n] + g2v[bj][n] * (acc[ai][bj][m][n] + bbv[bj][n]); } } }
    }
  }
};

template <class Epi> __device__ __forceinline__ void run_gemm(LP lds, const bf16_t* A, const bf16_t* Bt, int M, int N, int K, const Epi& E, int nks = 1) {
  pg8::Gemm g; g.A = A; g.Bt = Bt; g.M = M; g.N = N; g.K = K / nks; g.ld = K; g.nks = nks;
  pg8::StaticOrder S; S.init(M, N, nks, (int)gridDim.x, (int)blockIdx.x);
  pg8::gemm_phase<Epi>(lds, g, S, E);
}

__device__ void transpose_tile(const float* __restrict__ src, int ld, int col0, int k0, bf16_t* __restrict__ dst, int K, int drow0, LAS float* tile) {
  const int t = opaque_tid();
  f32x4 v[4];
#pragma unroll
  for (int i = 0; i < 4; ++i) { const int idx = t + 512 * i, kr = idx >> 5, c4 = idx & 31; v[i] = *(const f32x4*)(src + (size_t)(k0 + kr) * ld + col0 + 4 * c4); }
#pragma unroll
  for (int i = 0; i < 4; ++i) { const int idx = t + 512 * i, kr = idx >> 5, c4 = idx & 31; LAS float* tp = tile + kr * 129 + 4 * c4; tp[0] = v[i][0]; tp[1] = v[i][1]; tp[2] = v[i][2]; tp[3] = v[i][3]; }
  __syncthreads();
  const int kb = t & 7;
#pragma unroll
  for (int i = 0; i < 2; ++i) { const int c = (t >> 3) + 64 * i; const LAS float* tp = tile + (kb * 8) * 129 + c; u32x4 o;
    o.x = pack2(tp[0], tp[129]); o.y = pack2(tp[2 * 129], tp[3 * 129]); o.z = pack2(tp[4 * 129], tp[5 * 129]); o.w = pack2(tp[6 * 129], tp[7 * 129]);
    *(u32x4*)(dst + (size_t)(drow0 + c) * K + k0 + kb * 8) = o; }
  __syncthreads();
}
template <int SILU> __device__ void matvec9_unit(const float* v0, const float* v1, int v1stride, const float* __restrict__ W, int ldw, const float* bias, float* out, int ldo, int col0, LAS float* lf) {
  const int t = opaque_tid(), lane = t & 63, wid = t >> 6;
  LAS float* sv = lf; LAS float* red = lf + 9216;
  for (int i = t; i < 9216; i += 512) { const int b = i >> 10, k = i & 1023; float x = (b == 0) ? v0[k] : v1[(size_t)(b - 1) * v1stride + k]; if (SILU) x = x * __builtin_amdgcn_rcpf(1.0f + __expf(-x)); sv[i] = x; }
  __syncthreads();
  const int c4 = t & 7, kl = t >> 3;
  f32x4 w[16];
#pragma unroll
  for (int i = 0; i < 16; ++i) w[i] = *(const f32x4*)(W + (size_t)(kl + 64 * i) * ldw + col0 + 4 * c4);
  f32x4 acc[9];
#pragma unroll
  for (int b = 0; b < 9; ++b) acc[b] = (f32x4){0.f, 0.f, 0.f, 0.f};
#pragma unroll
  for (int i = 0; i < 16; ++i)
#pragma unroll
    for (int b = 0; b < 9; ++b) acc[b] += w[i] * sv[b * 1024 + kl + 64 * i];
#pragma unroll
  for (int b = 0; b < 9; ++b)
#pragma unroll
    for (int e = 0; e < 4; ++e) { float x = acc[b][e]; x += __shfl_xor(x, 8); x += __shfl_xor(x, 16); x += __shfl_xor(x, 32); acc[b][e] = x; }
  if (lane < 8) {
#pragma unroll
    for (int b = 0; b < 9; ++b) *(LAS f32x4*)(red + (wid * 9 + b) * 32 + 4 * lane) = acc[b]; }
  __syncthreads();
  if (t < 288) { const int b = t >> 5, cc = t & 31; float s = bias[col0 + cc];
#pragma unroll
    for (int pz = 0; pz < 8; ++pz) s += red[(pz * 9 + b) * 32 + cc];
    out[(size_t)b * ldo + col0 + cc] = s; }
  __syncthreads();
}

__device__ void phase0(const Params& p, LP lds) {
  unsigned char* ws = p.ws; LAS float* lf = (LAS float*)lds;
  const int tid0 = opaque_tid(); const int wid = tid0 >> 6, lane = tid0 & 63;
  for (int unit = blockIdx.x; unit < 576; unit += gridDim.x) {
    if (unit < 192) {
      matvec9_unit<1>(p.in[6], p.in[5], 1024, p.in[7], 6144, p.in[8], (float*)(ws + OFF_MOD), 6144, unit * 32, lf);
    } else if (unit < 480) {
      const int row = (unit - 192) * 8 + wid; const bool smp = row < 2048; const int L = smp ? 2048 : 256, t = smp ? row : row - 2048;
      const float* w1 = p.in[14]; const float* b1 = p.in[15]; const float* fr1 = p.in[16]; const float* w2 = p.in[17]; const float* b2 = p.in[18]; const float* fr2 = p.in[19];
      float a = b1[lane] + (float)t / (float)(L - 1) * w1[lane];
      const float base = (6.283185307179586f / (float)L) * (float)t;
      float cs = 0.f, sn = 0.f; if (lane < 16) { const float ang = base * (float)(lane + 1); cs = cosf(ang); sn = sinf(ang); }
#pragma unroll
      for (int i = 0; i < 16; ++i) a += __shfl(cs, i) * w1[(1 + i) * 64 + lane] + __shfl(sn, i) * w1[(17 + i) * 64 + lane];
      const float h1 = sinf(fr1[lane] * a);
      float a2 = b2[lane];
#pragma unroll 16
      for (int j = 0; j < 64; ++j) a2 += __shfl(h1, j) * w2[j * 64 + lane];
      const float h2 = sinf(fr2[lane] * a2);
      float* dst = (float*)(ws + (smp ? OFF_H2S : OFF_H2C)); dst[(size_t)t * 64 + lane] = h2;
    } else {
      const int r = unit - 480, c = tid0; const int pos = r < 32 ? r : r - 32; const int i = c & 255;
      const float omega = 1.0f / powf(10000.0f, (float)i / 256.0f); const float a = (float)pos * omega; const float v = c < 256 ? sinf(a) : cosf(a);
      float* dst = (float*)(ws + (r < 32 ? OFF_PER : OFF_PEC)); dst[(size_t)pos * 512 + c] = v;
    }
  }
}
__device__ void weight_tiles(const Params& p, LP lds, int lo, int hi, int upper) {
  unsigned char* ws = p.ws; LAS float* lf = (LAS float*)lds;
  const int nh = upper ? ((int)gridDim.x >> 1) : 0;
  if ((int)blockIdx.x < nh) return;
  for (int tu = lo + (int)blockIdx.x - nh; tu < hi; tu += (int)gridDim.x - nh) {
    const float* src; int ld, K, col0, k0, drow0; bf16_t* dst;
    if (tu < 1152) { const int nt = tu >> 4, kt = tu & 15; const int r = nt * 128; src = p.in[10]; ld = INC; K = 1024; k0 = kt * 64; drow0 = r; dst = (bf16_t*)(ws + OFF_WT);
      col0 = r < 3072 ? r : (r < 6144 ? 4112 + (r - 3072) : (r < 7168 ? 3072 + (r - 6144) : 7184 + (r - 7168))); }
    else if (tu < 1536) { const int v = tu - 1152, w = v >> 7, q = v & 127; src = p.in[23 + w]; ld = 1024; K = 1024; k0 = (q & 15) * 64; col0 = (q >> 4) * 128; drow0 = col0; dst = (bf16_t*)(ws + (w == 0 ? OFF_WBM : (w == 1 ? OFF_WBH : OFF_WOUT))); }
    else if (tu < 2048) { const int q = tu - 1536; src = p.in[27]; ld = 4096; K = 1024; k0 = (q & 15) * 64; col0 = (q >> 4) * 128; drow0 = col0; dst = (bf16_t*)(ws + OFF_W1T); }
    else { const int q = tu - 2048; src = p.in[29]; ld = 1024; K = 4096; k0 = (q & 63) * 64; col0 = (q >> 6) * 128; drow0 = col0; dst = (bf16_t*)(ws + OFF_W2T); }
    transpose_tile(src, ld, col0, k0, dst, K, drow0, lf);
  }
}

__device__ void phase1(const Params& p, LP lds) {
  unsigned char* ws = p.ws;
  int tid_ = threadIdx.x; asm volatile("" : "+v"(tid_));
  const int tid = tid_, wid = tid >> 6, lane = tid & 63;
  const float* mod = (const float*)(ws + OFF_MOD);
  LAS float* wg = (LAS float*)lds;
  if ((int)blockIdx.x < 1536) {
    f32x4 gw[8];
#pragma unroll
    for (int i = 0; i < 8; ++i) { const int idx = tid + 512 * i, k = idx >> 2, q = idx & 3; gw[i] = *(const f32x4*)(p.in[10] + (size_t)k * INC + 4096 + 4 * q); }
#pragma unroll
    for (int i = 0; i < 8; ++i) { const int idx = tid + 512 * i, k = idx >> 2, q = idx & 3; wg[(4 * q) * 1024 + k] = gw[i][0]; wg[(4 * q + 1) * 1024 + k] = gw[i][1]; wg[(4 * q + 2) * 1024 + k] = gw[i][2]; wg[(4 * q + 3) * 1024 + k] = gw[i][3]; }
    __syncthreads();
  }
  for (int unit = blockIdx.x; unit < 1536; unit += gridDim.x) {
    const int tidn = opaque_tid(); const int wid = tidn >> 6, lane = tidn & 63;
    const int row0 = unit * 16 + wid * 2; const int cb = cond_of_row(row0); const float* md = mod + cb * 6144; const bool smp = row0 >= NCTX;
    f32x4 v[2][4]; float rstd[2];
#pragma unroll
    for (int r = 0; r < 2; ++r) { const int row = row0 + r; const float* xr; int t = 0;
      if (!smp) xr = p.in[0] + (size_t)row * 1024; else { xr = p.in[1] + (size_t)(row - NCTX) * 1024; t = (row - NCTX) & 2047; }
      const float* per = (const float*)(ws + OFF_PER) + (t >> 6) * 512; const float* pec = (const float*)(ws + OFF_PEC) + (t & 63) * 512;
      float ss = 0.f;
#pragma unroll
      for (int i = 0; i < 4; ++i) { const int col = 4 * lane + 256 * i; v[r][i] = *(const f32x4*)(xr + col);
        if (smp) v[r][i] += (col < 512) ? *(const f32x4*)(per + col) : *(const f32x4*)(pec + col - 512);
        ss += v[r][i][0] * v[r][i][0] + v[r][i][1] * v[r][i][1] + v[r][i][2] * v[r][i][2] + v[r][i][3] * v[r][i][3]; }
      ss = wave_sum(ss); rstd[r] = rsqrtf(ss * (1.0f / 1024.0f) + 1e-6f); }
    const float* n1w = p.in[9];
    float ga[32];
#pragma unroll
    for (int g = 0; g < 32; ++g) ga[g] = 0.f;
#pragma unroll
    for (int i = 0; i < 4; ++i) { const int col = 4 * lane + 256 * i;
      const f32x4 w = *(const f32x4*)(n1w + col), sc = *(const f32x4*)(md + 1024 + col), sh = *(const f32x4*)(md + col);
      const f32x4 ws1 = w * (sc + 1.0f);
      f32x4 h[2];
#pragma unroll
      for (int r = 0; r < 2; ++r) { h[r] = v[r][i] * rstd[r] * ws1 + sh;
        u32x2 o; o.x = pack2(h[r][0], h[r][1]); o.y = pack2(h[r][2], h[r][3]); *(u32x2*)((bf16_t*)(ws + OFF_HN) + (size_t)(row0 + r) * 1024 + col) = o; }
#pragma unroll
      for (int g = 0; g < 16; ++g) { const f32x4 wv = *(const LAS f32x4*)(wg + g * 1024 + col);
#pragma unroll
        for (int r = 0; r < 2; ++r) ga[r * 16 + g] += h[r][0] * wv[0] + h[r][1] * wv[1] + h[r][2] * wv[2] + h[r][3] * wv[3]; }
      asm volatile("" ::: "memory"); }
#pragma unroll
    for (int off = 16; off >= 1; off >>= 1) { const bool hi = (lane & off) != 0;
#pragma unroll
      for (int i = 0; i < off; ++i) { const float send = hi ? ga[i] : ga[i + off]; const float keep = hi ? ga[i + off] : ga[i]; ga[i] = keep + __shfl_xor(send, off); } }
    const float tot = ga[0] + __shfl_xor(ga[0], 32);
    if (lane < 32) ((float*)(ws + OFF_GT))[(size_t)row0 * 16 + lane] = tot + p.in[11][4096 + (lane & 15)];
  }
  __syncthreads();
}
__device__ void filters_upper_half(const Params& p, LP lds) {
  unsigned char* ws = p.ws; const int nh = (int)gridDim.x >> 1;
  if ((int)blockIdx.x < nh) return;
  LAS float* w3s = (LAS float*)lds;
  for (int v = (int)blockIdx.x - nh; v < 320; v += (int)gridDim.x - nh) {
    const int tid = opaque_tid();
    const bool smp = v < 256; const int L = smp ? 2048 : 256; const int tt = smp ? (v >> 6) : 0, cgp = v & 63; const int t = tt * 512 + tid;
    { const f32x4 x = *(const f32x4*)(p.in[20] + (size_t)(tid >> 3) * 2048 + cgp * 32 + 4 * (tid & 7)); LAS float* wp = w3s + (4 * (tid & 7)) * 64 + (tid >> 3);
      wp[0] = x[0]; wp[64] = x[1]; wp[128] = x[2]; wp[192] = x[3]; }
    __syncthreads();
    if (t < L) {
      const float* H2 = (const float*)(ws + (smp ? OFF_H2S : OFF_H2C)) + (size_t)t * 64;
      f32x4 h2[16];
#pragma unroll
      for (int i = 0; i < 16; ++i) h2[i] = *(const f32x4*)(H2 + 4 * i);
      const float dist = fabsf((float)t - (float)(L / 2)) / (float)(L / 2);
      float* HF = (float*)(ws + (smp ? OFF_HFS : OFF_HFC)) + (size_t)(cgp * 32) * L + t;
#pragma unroll 1
      for (int j = 0; j < 32; ++j) {
        f32x4 a = {0.f, 0.f, 0.f, 0.f};
#pragma unroll
        for (int i = 0; i < 16; ++i) a += *(const LAS f32x4*)(w3s + j * 64 + 4 * i) * h2[i];
        const int c = (cgp * 32 + j) & 1023;
        const float dmin = -3.0701134573253946f, dmax = -15.350567286626973f;
        const float delta = fabsf(dmin + (dmax - dmin) * ((float)c / 1023.0f));
        HF[(size_t)j * L] = ((a[0] + a[1]) + (a[2] + a[3])) * __expf(-dist * delta); }
    }
    __syncthreads();
  }
}
__device__ void c1_upper_half(const Params& p, LP lds) {
  unsigned char* ws = p.ws; const float* mod = (const float*)(ws + OFF_MOD); const int nh = (int)gridDim.x >> 1;
  if ((int)blockIdx.x < nh) return;
  for (int u = (int)blockIdx.x - nh; u < 128; u += (int)gridDim.x - nh)
    matvec9_unit<0>(mod + 3072, mod + 6144 + 3072, 6144, p.in[27], 4096, p.in[28], (float*)(ws + OFF_C1), 4096, u * 32, (LAS float*)lds);
}

__device__ __forceinline__ bf16x8 tr_frag(LP base, int k0, int m0, int pitch  , int l15, int g) {
  const int q = l15 >> 2, pp = l15 & 3;
  LP a = base + ((k0 + 8 * g + q) * pitch + m0 + 4 * pp) * 2;
  const s16x4 lo = __builtin_amdgcn_ds_read_tr16_b64_v4i16((LAS s16x4*)a);
  const s16x4 hi = __builtin_amdgcn_ds_read_tr16_b64_v4i16((LAS s16x4*)(a + 8 * pitch));
  bf16x8 r; r[0] = lo[0]; r[1] = lo[1]; r[2] = lo[2]; r[3] = lo[3]; r[4] = hi[0]; r[5] = hi[1]; r[6] = hi[2]; r[7] = hi[3]; return r;
}
__device__ __forceinline__ bf16x8 tr_at(LP lanebase, int coff  , int pitch_bytes) {
  const s16x4 lo = __builtin_amdgcn_ds_read_tr16_b64_v4i16((LAS s16x4*)(lanebase + coff));
  const s16x4 hi = __builtin_amdgcn_ds_read_tr16_b64_v4i16((LAS s16x4*)(lanebase + coff + 4 * pitch_bytes));
  bf16x8 r; r[0] = lo[0]; r[1] = lo[1]; r[2] = lo[2]; r[3] = lo[3]; r[4] = hi[0]; r[5] = hi[1]; r[6] = hi[2]; r[7] = hi[3]; return r;
}
constexpr int ML_K = 0, ML_V = 67584, ML_P = 86016, ML_C = 120832, ML_T = 157696, ML_TSZ = 1600;
constexpr int KP = 264, VP = 72, PP = 136, CP = 72;

__device__ void mlstm_item(const Params& p, LP lds, int item) {
  const int tid = opaque_tid(), wid = __builtin_amdgcn_readfirstlane(tid >> 6), lane = tid & 63, l15 = lane & 15, g = lane >> 4;
  const bool smp = item < 256; const int uu = smp ? (item >> 2) : ((item - 256) >> 2); const int sl = item & 3;
  const int b = uu >> 3, dir = (uu >> 2) & 1, head = uu & 3;
  const int S = smp ? SEQS : SEQC, nc = S >> 7; const int tok0 = smp ? NCTX + b * SEQS : b * SEQC;
  const bf16_t* qkv = (const bf16_t*)(p.ws + OFF_BIG);
  const float* GT = (const float*)(p.ws + OFF_GT);
  bf16_t* hout = (bf16_t*)((unsigned char*)p.out + (dir ? OUT_HB : OUT_H));
  const int sidx = (b * 2 + dir) * 4 + head;
  const int gi_col = dir * 8 + head, gf_col = dir * 8 + 4 + head;
  f32x4 Cacc[2][4], nacc[2]; float mst0;
  if (smp) {
    const float* C0 = p.in[2] + (size_t)sidx * 65536;
#pragma unroll
    for (int dt = 0; dt < 2; ++dt) {
#pragma unroll
      for (int vt = 0; vt < 4; ++vt) Cacc[dt][vt] = *(const f32x4*)(C0 + (size_t)((2 * wid + dt) * 16 + l15) * 256 + sl * 64 + 16 * vt + 4 * g);
      nacc[dt] = (f32x4){p.in[3][sidx * 256 + (2 * wid + dt) * 16 + l15], 0.f, 0.f, 0.f}; }
    mst0 = p.in[4][sidx];
  } else {
#pragma unroll
    for (int dt = 0; dt < 2; ++dt) {
#pragma unroll
      for (int vt = 0; vt < 4; ++vt) Cacc[dt][vt] = (f32x4){0.f, 0.f, 0.f, 0.f};
      nacc[dt] = (f32x4){0.f, 0.f, 0.f, 0.f}; }
    mst0 = 0.f;
  }
#define TOKC(cc, j) (dir ? (tok0 + S - 1 - ((cc) * 128 + (j))) : (tok0 + (cc) * 128 + (j)))
  const int rt = (wid < 4) ? wid : 11 - wid;
  const int jrow = 16 * rt + l15;
  bf16x8 qf[8]; u32x4 kreg[8], vreg[2]; float g4[4] = {0.f, 0.f, 0.f, 0.f};
#define ML_LOAD_Q(cc) do { const bf16_t* qp = qkv + (size_t)TOKC(cc, jrow) * 3072 + head * 256 + 8 * g; \
    _Pragma("unroll") for (int kk = 0; kk < 8; ++kk) qf[kk] = *(const bf16x8*)(qp + 32 * kk); } while (0)
#define ML_LOAD_KV(cc) do { \
    _Pragma("unroll") for (int i = 0; i < 8; ++i) { const int row = (tid >> 5) + 16 * i; kreg[i] = *(const u32x4*)(qkv + (size_t)TOKC(cc, row) * 3072 + 1024 + head * 256 + (tid & 31) * 8); } \
    _Pragma("unroll") for (int i = 0; i < 2; ++i) { const int row = (tid >> 3) + 64 * i; vreg[i] = *(const u32x4*)(qkv + (size_t)TOKC(cc, row) * 3072 + 2048 + head * 256 + sl * 64 + (tid & 7) * 8); } \
    if (wid == 0) { const float* g0 = GT + (size_t)TOKC(cc, 2 * lane) * 16; const float* g1 = GT + (size_t)TOKC(cc, 2 * lane + 1) * 16; g4[0] = g0[gi_col]; g4[1] = g0[gf_col]; g4[2] = g1[gi_col]; g4[3] = g1[gf_col]; } } while (0)
#define ML_SCAN(tabp, mcur, mnext) do { LAS float* T_ = (LAS float*)(tabp); \
    const float lf0 = fminf(g4[1], 0.f) - log1pf(__expf(-fabsf(g4[1]))), lf1 = fminf(g4[3], 0.f) - log1pf(__expf(-fabsf(g4[3]))); \
    float s_ = lf0 + lf1; \
    _Pragma("unroll") for (int o = 1; o < 64; o <<= 1) { const float t_ = __shfl_up(s_, o); if (lane >= o) s_ += t_; } \
    const float b1_ = s_, b0_ = s_ - lf1; const float u0_ = g4[0] - b0_, u1_ = g4[2] - b1_; \
    float mx_ = fmaxf(u0_, u1_); \
    _Pragma("unroll") for (int o = 1; o < 64; o <<= 1) { const float t_ = __shfl_up(mx_, o); if (lane >= o) mx_ = fmaxf(mx_, t_); } \
    float ex_ = __shfl_up(mx_, 1); if (lane == 0) ex_ = -INFINITY; \
    const float M0_ = fmaxf(mcur, fmaxf(ex_, u0_)), M1_ = fmaxf(mcur, mx_); \
    T_[2 * lane] = u0_; T_[2 * lane + 1] = u1_; T_[128 + 2 * lane] = M0_; T_[128 + 2 * lane + 1] = M1_; T_[256 + 2 * lane] = b0_; T_[256 + 2 * lane + 1] = b1_; \
    const float Ml_ = __shfl(M1_, 63), bl_ = __shfl(b1_, 63); \
    if (lane == 0) { T_[384] = mcur; T_[385] = Ml_; } \
    mnext = bl_ + Ml_; } while (0)
  float mw0 = mst0;
  ML_LOAD_Q(0); ML_LOAD_KV(0);
  if (wid == 0) { float mn; ML_SCAN(lds + ML_T, mw0, mn); mw0 = mn; }
  __syncthreads();
  float m_final = 0.f;
  for (int c = 0; c < nc; ++c) {
    LAS float* T = (LAS float*)(lds + ML_T + (c & 1) * ML_TSZ);
    const float mst = T[384], M_last = T[385];
#pragma unroll
    for (int i = 0; i < 8; ++i) { const int row = (tid >> 5) + 16 * i; *(LAS u32x4*)(lds + ML_K + (row * KP + (tid & 31) * 8) * 2) = kreg[i]; }
#pragma unroll
    for (int i = 0; i < 2; ++i) { const int row = (tid >> 3) + 64 * i; const float w = __expf(T[row] - M_last); const u32x4 v = vreg[i]; u32x4 o;
      o.x = pack2(bflo(v.x) * w, bfhi(v.x) * w); o.y = pack2(bflo(v.y) * w, bfhi(v.y) * w); o.z = pack2(bflo(v.z) * w, bfhi(v.z) * w); o.w = pack2(bflo(v.w) * w, bfhi(v.w) * w);
      *(LAS u32x4*)(lds + ML_V + (row * VP + (tid & 7) * 8) * 2) = o; }
    if (tid < 128) *(LAS unsigned short*)(lds + ML_V + (tid * VP + 64) * 2) = f2bf(__expf(T[tid] - M_last));
#pragma unroll
    for (int dt = 0; dt < 2; ++dt) {
#pragma unroll
      for (int vt = 0; vt < 4; ++vt) { u32x2 w; w.x = pack2(Cacc[dt][vt][0], Cacc[dt][vt][1]); w.y = pack2(Cacc[dt][vt][2], Cacc[dt][vt][3]);
        *(LAS u32x2*)(lds + ML_C + (((2 * wid + dt) * 16 + l15) * CP + 16 * vt + 4 * g) * 2) = w; }
      if (g == 0) *(LAS unsigned short*)(lds + ML_C + (((2 * wid + dt) * 16 + l15) * CP + 64) * 2) = f2bf(nacc[dt][0]); }
    const int qtok = TOKC(c, jrow);
    const bool more = (c + 1 < nc);
    __syncthreads();
    const float Mj = T[128 + jrow], bj = T[256 + jrow]; const float rf = __expf(M_last - Mj), w_inter = __expf(mst - Mj);
    int lq_ = (8 * g + (l15 >> 2)), lp_ = 4 * (l15 & 3); asm volatile("" : "+v"(lq_), "+v"(lp_));
    const LP cB = lds + ML_C + (lq_ * CP + lp_) * 2, vB = lds + ML_V + (lq_ * VP + lp_) * 2, kB = lds + ML_K + (lq_ * KP + lp_ + 32 * wid) * 2;
    const LP pB = lds + ML_P + (jrow * PP + 8 * g) * 2;
    for (int st = 0; st <= rt; ++st) {
      f32x4 s = {0.f, 0.f, 0.f, 0.f};
      bf16x8 kfr[8];
#pragma unroll
      for (int kk = 0; kk < 8; ++kk) kfr[kk] = *(const LAS bf16x8*)(lds + ML_K + ((16 * st + l15) * KP + 32 * kk + 8 * g) * 2);
      __builtin_amdgcn_sched_barrier(0);
#pragma unroll
      for (int kk = 0; kk < 8; ++kk) s = __builtin_amdgcn_mfma_f32_16x16x32_bf16(kfr[kk], qf[kk], s, 0, 0, 0);
      float pv[4];
#pragma unroll
      for (int i = 0; i < 4; ++i) pv[i] = ((16 * st + 4 * g + i) <= jrow) ? s[i] * rf : 0.f;
      u32x2 w; w.x = pack2(pv[0], pv[1]); w.y = pack2(pv[2], pv[3]);
      *(LAS u32x2*)(lds + ML_P + (jrow * PP + 16 * st + 4 * g) * 2) = w;
    }
    if ((rt & 1) == 0) { u32x2 z; z.x = 0u; z.y = 0u; *(LAS u32x2*)(lds + ML_P + (jrow * PP + 16 * (rt + 1) + 4 * g) * 2) = z; }
    if (more) ML_LOAD_KV(c + 1);
    asm volatile("s_waitcnt lgkmcnt(0)" ::: "memory");
    f32x4 ha[5];
#pragma unroll
    for (int vt = 0; vt < 5; ++vt) { f32x4 a = {0.f, 0.f, 0.f, 0.f};
      if (smp || c > 0) {
        bf16x8 cfr[8];
#pragma unroll
        for (int kk = 0; kk < 8; ++kk) cfr[kk] = tr_at(cB, (32 * kk * CP + 16 * vt) * 2, CP * 2);
        __builtin_amdgcn_sched_barrier(0);
#pragma unroll
        for (int kk = 0; kk < 8; ++kk) a = __builtin_amdgcn_mfma_f32_16x16x32_bf16(cfr[kk], qf[kk], a, 0, 0, 0);
        a *= w_inter; }
      ha[vt] = a; }
    for (int k2 = 0; k2 <= (rt >> 1); ++k2) {
      const bf16x8 pf = *(const LAS bf16x8*)(pB + k2 * 64);
      bf16x8 vfr[5];
#pragma unroll
      for (int vt = 0; vt < 5; ++vt) vfr[vt] = tr_at(vB + k2 * (32 * VP * 2), (16 * vt) * 2, VP * 2);
      __builtin_amdgcn_sched_barrier(0);
#pragma unroll
      for (int vt = 0; vt < 5; ++vt) ha[vt] = __builtin_amdgcn_mfma_f32_16x16x32_bf16(vfr[vt], pf, ha[vt], 0, 0, 0); }
    { const float den = __shfl(ha[4][0], l15); const float rdd = __builtin_amdgcn_rcpf(fmaxf(fabsf(den), __expf(-(bj + Mj))));
#pragma unroll
      for (int vt = 0; vt < 4; ++vt) { const f32x4 a = ha[vt] * rdd; u32x2 w; w.x = pack2(a[0], a[1]); w.y = pack2(a[2], a[3]);
        *(u32x2*)(hout + (size_t)qtok * 1024 + head * 256 + sl * 64 + 16 * vt + 4 * g) = w; } }
    if (more) ML_LOAD_Q(c + 1);
    const bool need_state = (!smp) || more;
    if (need_state) {
      const float decay = __expf(mst - M_last);
#pragma unroll
      for (int dt = 0; dt < 2; ++dt) {
#pragma unroll
        for (int vt = 0; vt < 4; ++vt) Cacc[dt][vt] *= decay;
        nacc[dt] *= decay; }
#pragma unroll
      for (int ks = 0; ks < 4; ++ks) {
        const bf16x8 kf0 = tr_at(kB, (32 * ks * KP) * 2, KP * 2), kf1 = tr_at(kB, (32 * ks * KP + 16) * 2, KP * 2);
        bf16x8 vfr[5];
#pragma unroll
        for (int vt = 0; vt < 5; ++vt) vfr[vt] = tr_at(vB, (32 * ks * VP + 16 * vt) * 2, VP * 2);
        __builtin_amdgcn_sched_barrier(0);
#pragma unroll
        for (int vt = 0; vt < 4; ++vt) { Cacc[0][vt] = __builtin_amdgcn_mfma_f32_16x16x32_bf16(vfr[vt], kf0, Cacc[0][vt], 0, 0, 0); Cacc[1][vt] = __builtin_amdgcn_mfma_f32_16x16x32_bf16(vfr[vt], kf1, Cacc[1][vt], 0, 0, 0); }
        nacc[0] = __builtin_amdgcn_mfma_f32_16x16x32_bf16(vfr[4], kf0, nacc[0], 0, 0, 0); nacc[1] = __builtin_amdgcn_mfma_f32_16x16x32_bf16(vfr[4], kf1, nacc[1], 0, 0, 0);
      }
    }
    if (wid == 0 && more) { float mn; ML_SCAN(lds + ML_T + ((c + 1) & 1) * ML_TSZ, mw0, mn); mw0 = mn; }
    m_final = T[256 + 127] + M_last;
    __syncthreads();
  }
#undef ML_LOAD_Q
#undef ML_LOAD_KV
#undef ML_SCAN
#undef TOKC
  if (!smp) {
    float* oC = p.out + OUTF_C + (size_t)sidx * 65536;
#pragma unroll
    for (int dt = 0; dt < 2; ++dt) {
#pragma unroll
      for (int vt = 0; vt < 4; ++vt) *(f32x4*)(oC + (size_t)((2 * wid + dt) * 16 + l15) * 256 + sl * 64 + 16 * vt + 4 * g) = Cacc[dt][vt];
      if (sl == 0 && g == 0) p.out[OUTF_N + (size_t)sidx * 256 + (2 * wid + dt) * 16 + l15] = nacc[dt][0]; }
    if (sl == 0 && tid == 0) p.out[OUTF_M + sidx] = m_final;
  }
}

__device__ void combine_rows(const Params& p) {
  const int tid0 = opaque_tid(); const int wid = tid0 >> 6, lane = tid0 & 63;
  bf16_t* H = (bf16_t*)((unsigned char*)p.out + OUT_H); const bf16_t* HB = (const bf16_t*)((unsigned char*)p.out + OUT_HB); const float* nw = p.in[22];
  f32x4 wv[4];
#pragma unroll
  for (int i = 0; i < 4; ++i) wv[i] = *(const f32x4*)(nw + 16 * lane + 4 * i);
  const int nh = (int)gridDim.x >> 1;
  if ((int)blockIdx.x < nh) return;
  for (int unit = (int)blockIdx.x - nh; unit < 768; unit += (int)gridDim.x - nh) {
    const int row0 = unit * 32 + wid * 4;
    u32x4 a[4][2], bq[4][2];
#pragma unroll
    for (int r = 0; r < 4; ++r)
#pragma unroll
      for (int i = 0; i < 2; ++i) { a[r][i] = *(const u32x4*)(H + (size_t)(row0 + r) * 1024 + 16 * lane + 8 * i); bq[r][i] = *(const u32x4*)(HB + (size_t)(row0 + r) * 1024 + 16 * lane + 8 * i); }
#pragma unroll
    for (int r = 0; r < 4; ++r) {
      f32x4 v[4]; float ss = 0.f;
#pragma unroll
      for (int i = 0; i < 2; ++i) { f32x4 x0, x1, y0, y1; unpack8(a[r][i], x0, x1); unpack8(bq[r][i], y0, y1); v[2 * i] = x0 + y0; v[2 * i + 1] = x1 + y1; }
#pragma unroll
      for (int i = 0; i < 4; ++i) ss += v[i][0] * v[i][0] + v[i][1] * v[i][1] + v[i][2] * v[i][2] + v[i][3] * v[i][3];
      ss += __shfl_xor(ss, 1); ss += __shfl_xor(ss, 2); ss += __shfl_xor(ss, 4); ss += __shfl_xor(ss, 8);
      const float rr = rsqrtf(ss * (1.0f / 256.0f) + 1e-6f);
#pragma unroll
      for (int i = 0; i < 2; ++i) *(u32x4*)(H + (size_t)(row0 + r) * 1024 + 16 * lane + 8 * i) = pack8(v[2 * i] * rr * wv[2 * i], v[2 * i + 1] * rr * wv[2 * i + 1]);
    }
  }
}

constexpr int HY_WAVE = 18816, HY_HR = 0, HY_ZA = 8576, HY_ZB = 8576 + 5120;
__device__ void hyena_item(const Params& p, LP lds, int item) {
  const int tid = opaque_tid(), wid = __builtin_amdgcn_readfirstlane(tid >> 6), lane = tid & 63, n31 = lane & 31, hh = lane >> 5;
  const bool smp = item < 1024; const int it = smp ? item : item - 1024; const int bset = it >> 7, cgp = it & 127; const int c = cgp * 8 + wid;
  const int L = smp ? 2048 : 256, lgL = smp ? 11 : 8, nblk = L >> 5, lgnb = lgL - 5, ntok = 2048, ntile = 2, dmax = L >> 6;
  const int tok0 = smp ? NCTX + bset * 2048 : bset * 2048;
  LP wl = lds + wid * HY_WAVE; LAS float* hr = (LAS float*)(wl + HY_HR);
  const float* HFp = (const float*)(p.ws + (smp ? OFF_HFS : OFF_HFC));
  const bf16_t* UT = (const bf16_t*)(p.ws + OFF_BIG);
  const float* cw = p.in[12]; const float* cbv = p.in[13]; const float* skp = p.in[21];
  { const int uc = 2048 + c; const float w0 = cw[uc], w1 = cw[3072 + uc], w2 = cw[6144 + uc], cb = cbv[uc]; const bf16_t* src = UT + (size_t)uc * NTOK + tok0;
    u32x4 vv[4]; float pvv[4], nxv[4];
#pragma unroll
    for (int i = 0; i < 4; ++i) { const int base = lane * 8 + 512 * i; vv[i] = (u32x4){0u, 0u, 0u, 0u}; pvv[i] = 0.f; nxv[i] = 0.f;
      if (base < ntok) { vv[i] = *(const u32x4*)(src + base); const int tl = base & (L - 1);
        if (tl != 0) pvv[i] = bf2f(src[base - 1]); if (tl + 8 != L) nxv[i] = bf2f(src[base + 8]); } }
#pragma unroll
    for (int i = 0; i < 4; ++i) { const int base = lane * 8 + 512 * i;
      if (base < ntok) { const u32x4 v = vv[i];
        float u[10]; u[0] = pvv[i]; u[1] = bflo(v.x); u[2] = bfhi(v.x); u[3] = bflo(v.y); u[4] = bfhi(v.y); u[5] = bflo(v.z); u[6] = bfhi(v.z); u[7] = bflo(v.w); u[8] = bfhi(v.w); u[9] = nxv[i];
        float o[8];
#pragma unroll
        for (int e = 0; e < 8; ++e) o[e] = cb + w0 * u[e] + w1 * u[e + 1] + w2 * u[e + 2];
        u32x4 w; w.x = pack2(o[0], o[1]); w.y = pack2(o[2], o[3]); w.z = pack2(o[4], o[5]); w.w = pack2(o[6], o[7]);
        *(LAS u32x4*)(wl + HY_ZA + ((base >> 5) * 40 + (base & 31)) * 2) = w; } } }
  const int HRP = L + 96;
  f32x4 fvN[8];
#define HY_FLOAD(o) do { const float* src_ = HFp + (size_t)((o) * 1024 + c) * L; \
    _Pragma("unroll") for (int i = 0; i < 8; ++i) { const int q = lane + 64 * i; fvN[i] = (4 * q < L) ? *(const f32x4*)(src_ + 4 * q) : (f32x4){0.f, 0.f, 0.f, 0.f}; } } while (0)
  HY_FLOAD(0);
  for (int ord = 0; ord < 2; ++ord) {
    { float sa = 0.f;
      f32x4 fv[8];
#pragma unroll
      for (int i = 0; i < 8; ++i) fv[i] = fvN[i];
#pragma unroll
      for (int i = 0; i < 8; ++i) sa += (fabsf(fv[i][0]) + fabsf(fv[i][1])) + (fabsf(fv[i][2]) + fabsf(fv[i][3]));
      sa = wave_sum(sa); const float inv = __builtin_amdgcn_rcpf(sa + 1e-6f);
      asm volatile("s_waitcnt lgkmcnt(0)" ::: "memory");
      LAS bf16_t* E = (LAS bf16_t*)hr; LAS bf16_t* O = E + HRP;
#pragma unroll
      for (int i = 0; i < 8; ++i) { const int q = lane + 64 * i;
        if (4 * q < L) {
#pragma unroll
          for (int e = 0; e < 4; ++e) { const int yy = L - 1 - (4 * q + e); const bf16_t v = f2bf(fv[i][e] * inv); E[32 + yy] = v; O[31 + yy] = v; } } }
      if (lane < 32) { E[lane] = 0; E[32 + L + lane] = 0; O[31 + L + lane] = 0; if (lane < 31) O[lane] = 0; }
      if (lane < 33) O[HRP - 33 + lane] = 0;
      asm volatile("s_waitcnt lgkmcnt(0)" ::: "memory"); }
    if (ord == 0) HY_FLOAD(1);
    LP zin = wl + (ord == 0 ? HY_ZA : HY_ZB); LP zout = wl + (ord == 0 ? HY_ZB : HY_ZA);
    const int gc = ord * 1024 + c; const float w0 = cw[gc], w1 = cw[3072 + gc], w2 = cw[6144 + gc], cb = cbv[gc], sk = skp[ord * 1024 + c];
    const bf16_t* gsrc = UT + (size_t)gc * NTOK + tok0;
    u32x4 gv[4]; unsigned gpv[4], gnx[4];
#pragma unroll
    for (int i = 0; i < 4; ++i) { const int base = lane * 8 + 512 * i; gv[i] = (u32x4){0u, 0u, 0u, 0u}; gpv[i] = 0u; gnx[i] = 0u;
      if (base < ntok) { gv[i] = *(const u32x4*)(gsrc + base); const int tl = base & (L - 1);
        if (tl != 0) gpv[i] = gsrc[base - 1]; if (tl + 8 != L) gnx[i] = gsrc[base + 8]; } }
    f32x16 accs[2];
#pragma unroll
    for (int o2 = 0; o2 < 2; ++o2)
#pragma unroll
      for (int r = 0; r < 16; ++r) accs[o2][r] = 0.f;
    LP fb = wl + HY_HR + ((n31 & 1) ? 0 : (HRP * 2 - 2)) + 2 * ((L >> 1) - 1 - n31 + 8 * hh + 32);
    int cbl[2], ca[2];
#pragma unroll
    for (int ot = 0; ot < 2; ++ot) { const int col = 32 * ot + n31; cbl[ot] = (col >> lgnb) << lgnb; ca[ot] = col & (nblk - 1); }
    const bool two = (ntile == 2);
    {
      LP zero = wl + HY_HR + 16 * hh;
      LP ap = fb + 64 * dmax;
      int bbr0 = ca[0] + dmax, bbr1 = ca[1] + dmax;
      LP bp0 = zin + ((cbl[0] + bbr0) * 40 + 8 * hh) * 2, bp1 = zin + ((cbl[1] + bbr1) * 40 + 8 * hh) * 2;
      for (int d = -dmax; d <= dmax; ++d) {
        u32x4 w0v, w1v;
        w0v.x = *(const LAS unsigned*)(ap); w0v.y = *(const LAS unsigned*)(ap + 4); w0v.z = *(const LAS unsigned*)(ap + 8); w0v.w = *(const LAS unsigned*)(ap + 12);
        w1v.x = *(const LAS unsigned*)(ap + 32); w1v.y = *(const LAS unsigned*)(ap + 36); w1v.z = *(const LAS unsigned*)(ap + 40); w1v.w = *(const LAS unsigned*)(ap + 44);
        const bf16x8 af0 = __builtin_bit_cast(bf16x8, w0v), af1 = __builtin_bit_cast(bf16x8, w1v);
        LP q0 = ((unsigned)bbr0 < (unsigned)nblk) ? bp0 : zero;
        LP q1 = (two && ((unsigned)bbr1 < (unsigned)nblk)) ? bp1 : zero;
        const bf16x8 b00 = *(const LAS bf16x8*)q0, b01 = *(const LAS bf16x8*)(q0 + 32);
        const bf16x8 b10 = *(const LAS bf16x8*)q1, b11 = *(const LAS bf16x8*)(q1 + 32);
        __builtin_amdgcn_sched_barrier(0);
        accs[0] = __builtin_amdgcn_mfma_f32_32x32x16_bf16(af0, b00, accs[0], 0, 0, 0);
        if (two) accs[1] = __builtin_amdgcn_mfma_f32_32x32x16_bf16(af0, b10, accs[1], 0, 0, 0);
        accs[0] = __builtin_amdgcn_mfma_f32_32x32x16_bf16(af1, b01, accs[0], 0, 0, 0);
        if (two) accs[1] = __builtin_amdgcn_mfma_f32_32x32x16_bf16(af1, b11, accs[1], 0, 0, 0);
        ap -= 64; bbr0 -= 1; bbr1 -= 1; bp0 -= 80; bp1 -= 80;
      }
    }
#pragma unroll
    for (int ot = 0; ot < 2; ++ot) {
      if (ot >= ntile) continue;
      const f32x16 acc = accs[ot];
#pragma unroll
      for (int rg = 0; rg < 4; ++rg) {
        const int zo = (((cbl[ot] + ca[ot]) * 40) + 8 * rg + 4 * hh) * 2;
        const u32x2 zv = *(const LAS u32x2*)(zin + zo);
        u32x2 w; w.x = pack2(acc[4 * rg] + sk * bflo(zv.x), acc[4 * rg + 1] + sk * bfhi(zv.x)); w.y = pack2(acc[4 * rg + 2] + sk * bflo(zv.y), acc[4 * rg + 3] + sk * bfhi(zv.y));
        *(LAS u32x2*)(zout + zo) = w;
      }
    }
    asm volatile("s_waitcnt lgkmcnt(0)" ::: "memory");
#pragma unroll
    for (int i = 0; i < 4; ++i) { const int base = lane * 8 + 512 * i;
      if (base < ntok) { const u32x4 v = gv[i];
        float u[10]; u[0] = bf2f(gpv[i]); u[1] = bflo(v.x); u[2] = bfhi(v.x); u[3] = bflo(v.y); u[4] = bfhi(v.y); u[5] = bflo(v.z); u[6] = bfhi(v.z); u[7] = bflo(v.w); u[8] = bfhi(v.w); u[9] = bf2f(gnx[i]);
        LP zp = zout + ((base >> 5) * 40 + (base & 31)) * 2; const u32x4 t = *(const LAS u32x4*)zp;
        float tv[8]; tv[0] = bflo(t.x); tv[1] = bfhi(t.x); tv[2] = bflo(t.y); tv[3] = bfhi(t.y); tv[4] = bflo(t.z); tv[5] = bfhi(t.z); tv[6] = bflo(t.w); tv[7] = bfhi(t.w);
        float o[8];
#pragma unroll
        for (int e = 0; e < 8; ++e) o[e] = (cb + w0 * u[e] + w1 * u[e + 1] + w2 * u[e + 2]) * tv[e];
        u32x4 w; w.x = pack2(o[0], o[1]); w.y = pack2(o[2], o[3]); w.z = pack2(o[4], o[5]); w.w = pack2(o[6], o[7]);
        *(LAS u32x4*)zp = w; } }
    asm volatile("s_waitcnt lgkmcnt(0)" ::: "memory");
  }
  __syncthreads();
  { bf16_t* YH = (bf16_t*)((unsigned char*)p.out + OUT_HB);
    for (int tl = tid; tl < ntok; tl += 512) {
      const int bl = tl >> lgL, tloc = tl & (L - 1); const int zo = ((((bl << lgnb) + (tloc >> 5)) * 40) + (tloc & 31)) * 2;
      unsigned short e[8];
#pragma unroll
      for (int w = 0; w < 8; ++w) e[w] = *(const LAS unsigned short*)(lds + w * HY_WAVE + HY_ZA + zo);
      u32x4 o; o.x = e[0] | ((unsigned)e[1] << 16); o.y = e[2] | ((unsigned)e[3] << 16); o.z = e[4] | ((unsigned)e[5] << 16); o.w = e[6] | ((unsigned)e[7] << 16);
      *(u32x4*)(YH + (size_t)(tok0 + tl) * 1024 + cgp * 8) = o; } }
  __syncthreads();
}

__device__ void final_norm(const Params& p) {
  const int tid0 = opaque_tid(); const int wid = tid0 >> 6, lane = tid0 & 63; const float* fw = p.in[31];
  const float* P = (const float*)(p.ws + OFF_BIG + (size_t)8192 * 4096 * 2); const float* mod = (const float*)(p.ws + OFF_MOD);
  f32x4 wv[4];
#pragma unroll
  for (int i = 0; i < 4; ++i) wv[i] = *(const f32x4*)(fw + 4 * lane + 256 * i);
  for (int unit = blockIdx.x; unit < 768; unit += gridDim.x) {
    const int row0 = unit * 32 + wid * 4; const bool chunkB = row0 >= 16384;
    f32x4 x[4][4];
#pragma unroll
    for (int r = 0; r < 4; ++r)
#pragma unroll
      for (int i = 0; i < 4; ++i) x[r][i] = *(const f32x4*)(p.out + (size_t)(row0 + r) * 1024 + 4 * lane + 256 * i);
    if (chunkB) { const float* md = mod + cond_of_row(row0) * 6144 + 5120;
#pragma unroll
      for (int i = 0; i < 4; ++i) { const f32x4 g2 = *(const f32x4*)(md + 4 * lane + 256 * i);
#pragma unroll
        for (int r = 0; r < 4; ++r) x[r][i] += g2 * *(const f32x4*)(P + (size_t)(row0 + r - 16384) * 1024 + 4 * lane + 256 * i); } }
#pragma unroll
    for (int r = 0; r < 4; ++r) { float ss = 0.f;
#pragma unroll
      for (int i = 0; i < 4; ++i) ss += x[r][i][0] * x[r][i][0] + x[r][i][1] * x[r][i][1] + x[r][i][2] * x[r][i][2] + x[r][i][3] * x[r][i][3];
      ss = wave_sum(ss); const float rstd = rsqrtf(ss * (1.0f / 1024.0f) + 1e-6f);
#pragma unroll
      for (int i = 0; i < 4; ++i) *(f32x4*)(p.out + (size_t)(row0 + r) * 1024 + 4 * lane + 256 * i) = x[r][i] * rstd * wv[i]; }
  }
}

__device__ __forceinline__ int xcd_group_index(int c, int lg) {
  if (gridDim.x != 256u) return c;
  const int xcd = c & 7, slot = c >> 3;
  return ((((slot >> lg) << 3) + xcd) << lg) + (slot & ((1 << lg) - 1));
}
__global__ void __launch_bounds__(512, 2) __attribute__((flatten)) mega(Params p) {
  extern __shared__ __attribute__((aligned(16))) unsigned char shm[];
  LP lds = (LP)shm;
  cg::grid_group grid = cg::this_grid();
  volatile LAS unsigned* xst = (volatile LAS unsigned*)(lds + LDS_BYTES - 16);
  if (threadIdx.x == 0) { xst[0] = 0u; xst[1] = 0u; }
  __syncthreads();
  const XcdBarrier xb = xcd_barrier_post((unsigned*)(p.ws + OFF_BAR), xst);
  unsigned char* ws = p.ws;
  const bf16_t* WT = (const bf16_t*)(ws + OFF_WT); const bf16_t* HN = (const bf16_t*)(ws + OFF_HN); bf16_t* BIG = (bf16_t*)(ws + OFF_BIG);
  bf16_t* Hb = (bf16_t*)((unsigned char*)p.out + OUT_H); bf16_t* YH = (bf16_t*)((unsigned char*)p.out + OUT_HB);
  const float* mod = (const float*)(ws + OFF_MOD);
  phase0(p, lds);
  if (gridDim.y == 7u) grid.sync();
  xcd_barrier(xb);
  phase1(p, lds);
  weight_tiles(p, lds, 0, 384, 0);
  xcd_barrier(xb);
  filters_upper_half(p, lds);
  weight_tiles(p, lds, 384, 768, 1);
  { EpiQKV e; e.O = BIG; e.bias = p.in[11]; run_gemm(lds, HN, WT, NTOK, 3072, 1024, e); }
  xcd_barrier(xb);
  for (int item = xcd_group_index((int)blockIdx.x, 2); item < 1280; item += gridDim.x) mlstm_item(p, lds, item);
  xcd_barrier(xb);
  combine_rows(p);
  weight_tiles(p, lds, 768, 1152, 1);
  { EpiUT e; e.O = BIG; e.bias = p.in[11] + 4112; run_gemm(lds, WT + (size_t)3072 * 1024, HN, 3072, NTOK, 1024, e); }
  xcd_barrier(xb);
  for (int item = xcd_group_index((int)blockIdx.x, 3); item < 1536; item += gridDim.x) hyena_item(p, lds, item);
  xcd_barrier(xb);
  c1_upper_half(p, lds);
  weight_tiles(p, lds, 1152, 1536, 1);
  { EpiGates e; e.H = Hb; e.G = BIG; e.b_in = p.in[11]; run_gemm(lds, HN, WT + (size_t)6144 * 1024, NTOK, 3072, 1024, e); }
  xcd_barrier(xb);
  bf16_t* T = BIG + (size_t)NTOK * 2048;
  weight_tiles(p, lds, 1536, 2560, 1);
  { EpiMerge<0> e; e.T = T; e.G = BIG; run_gemm(lds, Hb, (const bf16_t*)(ws + OFF_WBM), NTOK, 1024, 1024, e); }
  { EpiMerge<1> e; e.T = T; e.G = BIG; run_gemm(lds, YH, (const bf16_t*)(ws + OFF_WBH), NTOK, 1024, 1024, e); }
  xcd_barrier(xb);
  { EpiOut e; e.xp = p.in[0]; e.xs = p.in[1]; e.per = (const float*)(ws + OFF_PER); e.pec = (const float*)(ws + OFF_PEC); e.mod = mod; e.n2w = p.in[26];
    e.X1 = p.out; e.A2 = (bf16_t*)(ws + OFF_HN); e.ssq = (float*)(ws + OFF_SSQ1); run_gemm(lds, T, (const bf16_t*)(ws + OFF_WOUT), NTOK, 1024, 1024, e); }
  xcd_barrier(xb);
  constexpr int ROWS_A = 16384, ROWS_B = NTOK - ROWS_A;
  { EpiFF1 e; e.row0 = 0; e.ssq = (const float*)(p.ws + OFF_SSQ1); e.c1 = (const float*)(p.ws + OFF_C1); e.Hd = (bf16_t*)(p.ws + OFF_BIG);
    run_gemm(lds, (const bf16_t*)(p.ws + OFF_HN), (const bf16_t*)(p.ws + OFF_W1T), ROWS_A, 4096, 1024, e); }
  xcd_barrier(xb);
  { EpiFF2 e; e.row0 = 0; e.mod = (const float*)(p.ws + OFF_MOD); e.b2 = p.in[30]; e.X = p.out; e.P = (float*)(p.ws + OFF_BIG + (size_t)ROWS_A * 4096 * 2);
    run_gemm(lds, (const bf16_t*)(p.ws + OFF_BIG), (const bf16_t*)(p.ws + OFF_W2T), ROWS_A, 1024, 4096, e); }
  xcd_barrier(xb);
  { EpiFF1 e; e.row0 = ROWS_A; e.ssq = (const float*)(p.ws + OFF_SSQ1); e.c1 = (const float*)(p.ws + OFF_C1); e.Hd = (bf16_t*)(p.ws + OFF_BIG);
    run_gemm(lds, (const bf16_t*)(p.ws + OFF_HN) + (size_t)ROWS_A * 1024, (const bf16_t*)(p.ws + OFF_W1T), ROWS_B, 4096, 1024, e); }
  xcd_barrier(xb);
  { EpiFF2 e; e.row0 = ROWS_A; e.mod = (const float*)(p.ws + OFF_MOD); e.b2 = p.in[30]; e.X = p.out; e.P = (float*)(p.ws + OFF_BIG + (size_t)ROWS_B * 4096 * 2);
    run_gemm(lds, (const bf16_t*)(p.ws + OFF_BIG), (const bf16_t*)(p.ws + OFF_W2T), ROWS_B, 1024, 4096, e, 2); }
  xcd_barrier(xb);
  final_norm(p);
}

extern "C" void kernel_launch(void* const* d_in, const int* in_sizes, int n_in, void* d_out, int out_size, void* d_ws, size_t ws_size, hipStream_t stream) {
  static int grid_blocks = 0;
  if (!grid_blocks) {
    int dev = 0, cus = 0, per_cu = 0;
    hipGetDevice(&dev);
    hipDeviceGetAttribute(&cus, hipDeviceAttributeMultiprocessorCount, dev);
    hipFuncSetAttribute((const void*)mega, hipFuncAttributeMaxDynamicSharedMemorySize, LDS_BYTES);
    hipOccupancyMaxActiveBlocksPerMultiprocessor(&per_cu, (const void*)mega, 512, LDS_BYTES);
    if (per_cu < 1) { fprintf(stderr, "kernel_launch: occupancy query reports %d blocks per CU\n", per_cu); grid_blocks = -1; }
    else grid_blocks = cus;
    if (n_in != 32 || ws_size < WS_END) { fprintf(stderr, "kernel_launch: unexpected n_in %d / ws_size %zu (need %zu)\n", n_in, ws_size, (size_t)WS_END); grid_blocks = -1; }
  }
  if (grid_blocks < 0) return;
  hipMemsetAsync((unsigned char*)d_ws + OFF_BAR, 0, 3456 * 4, stream);
  Params p{};
  for (int i = 0; i < 32; ++i) p.in[i] = (const float*)d_in[i];
  p.out = (float*)d_out; p.ws = (unsigned char*)d_ws;
  void* args[] = {&p};
  hipError_t e = hipLaunchCooperativeKernel((void*)mega, dim3(grid_blocks), dim3(512), args, LDS_BYTES, stream);
  if (e != hipSuccess) fprintf(stderr, "cooperative launch failed: %s (grid %d)\n", hipGetErrorString(e), grid_blocks);
}
```

```cpp
#include <hip/hip_runtime.h>
#include <hip/hip_cooperative_groups.h>
#include <cstdio>
#include <cstdint>
namespace cg = cooperative_groups;

#define LAS __attribute__((address_space(3)))
typedef LAS unsigned char* LP;
typedef unsigned short bf16_t;
typedef short bf16x8 __attribute__((ext_vector_type(8)));
typedef short s16x4 __attribute__((ext_vector_type(4)));
typedef float f32x4 __attribute__((ext_vector_type(4)));
typedef float f32x16 __attribute__((ext_vector_type(16)));
typedef unsigned u32x4 __attribute__((ext_vector_type(4)));
typedef unsigned u32x2 __attribute__((ext_vector_type(2)));

constexpr int DM = 1024, NTOK = 24576, NCTX = 8192, SEQC = 256, SEQS = 2048, INC = 9232;
constexpr int LDS_BYTES = 160 * 1024;
constexpr size_t OFF_WT = 0;
constexpr size_t OFF_WBM = 18874368, OFF_WBH = 20971520, OFF_WOUT = 23068672, OFF_W1T = 25165824, OFF_W2T = 33554432;
constexpr size_t OFF_HN = 41943040;
constexpr size_t OFF_BIG = 92274688;
constexpr size_t OFF_SM = 243269632;
constexpr size_t OFF_MOD = OFF_SM;
constexpr size_t OFF_C1 = OFF_MOD + 221184;
constexpr size_t OFF_H2S = OFF_C1 + 147456;
constexpr size_t OFF_H2C = OFF_H2S + 524288;
constexpr size_t OFF_PER = OFF_H2C + 65536;
constexpr size_t OFF_PEC = OFF_PER + 65536;
constexpr size_t OFF_GT = OFF_PEC + 131072;
constexpr size_t OFF_SSQ1 = OFF_GT + 1572864;
constexpr size_t OFF_SSQ2 = OFF_SSQ1 + 1572864;
constexpr size_t OFF_HFS = OFF_SSQ2 + 1572864;
constexpr size_t OFF_HFC = OFF_HFS + 16777216;
constexpr size_t OFF_BAR = OFF_HFC + 2097152;
constexpr size_t WS_END = OFF_BAR + 3456 * 4;
constexpr size_t OUT_H = 0, OUT_HB = 50331648;
constexpr size_t OUTF_C = 25165824, OUTF_N = 41943040, OUTF_M = 42008576;

struct Params { const float* in[32]; float* out; unsigned char* ws; };

typedef float f32x2 __attribute__((ext_vector_type(2)));
typedef __bf16 bf16x2v __attribute__((ext_vector_type(2)));
__device__ __forceinline__ bf16_t f2bf(float f) { const __bf16 b = (__bf16)f; return __builtin_bit_cast(unsigned short, b); }
__device__ __forceinline__ float bf2f(unsigned b) { return __uint_as_float(b << 16); }
__device__ __forceinline__ unsigned pack2(float lo, float hi) { const f32x2 v = {lo, hi}; const bf16x2v r = __builtin_convertvector(v, bf16x2v); return __builtin_bit_cast(unsigned, r); }
__device__ __forceinline__ float bflo(unsigned w) { return __uint_as_float(w << 16); }
__device__ __forceinline__ float bfhi(unsigned w) { return __uint_as_float(w & 0xffff0000u); }
__device__ __forceinline__ float sigmoidf_(float x) { return __builtin_amdgcn_rcpf(1.0f + __expf(-x)); }
__device__ __forceinline__ int opaque_tid() { int t = threadIdx.x; asm volatile("" : "+v"(t)); return t; }
template <int CTRL> __device__ __forceinline__ float dppf(float x) { return __builtin_bit_cast(float, __builtin_amdgcn_mov_dpp(__builtin_bit_cast(int, x), CTRL, 0xf, 0xf, true)); }
constexpr int DPP_XOR1 = 0xB1, DPP_XOR2 = 0x4E, DPP_HMIR = 0x141, DPP_ROR8 = 0x128;
__device__ __forceinline__ float row16_sum(float v) { v += dppf<DPP_XOR1>(v); v += dppf<DPP_XOR2>(v); v += dppf<DPP_HMIR>(v); v += dppf<DPP_ROR8>(v); return v; }
__device__ __forceinline__ float xrow16_sum(float x) {
  auto s = __builtin_amdgcn_permlane16_swap(__float_as_uint(x), __float_as_uint(x), false, false);
  x = __uint_as_float(s[0]) + __uint_as_float(s[1]);
  auto t = __builtin_amdgcn_permlane32_swap(__float_as_uint(x), __float_as_uint(x), false, false);
  return __uint_as_float(t[0]) + __uint_as_float(t[1]);
}
__device__ __forceinline__ float wave_sum(float v) { return xrow16_sum(row16_sum(v)); }

#define XB_TMO      128
#define XB_XCNT(j)  (256  + 64 * (j))
#define XB_XSUB(j)  (1280 + 64 * (j))
#define XB_XGEN(j)  (2304 + 64 * (j))
#define XB_TOP      3328
#define XB_TOPGEN   3392
#define XCD_BAR_WORDS 3456
#define XB_SPIN_CAP (1u << 18)
__device__ __forceinline__ unsigned xb_ld(unsigned* p)              { return __hip_atomic_load(p, __ATOMIC_RELAXED, __HIP_MEMORY_SCOPE_AGENT); }
__device__ __forceinline__ unsigned xb_add(unsigned* p, unsigned v) { return __hip_atomic_fetch_add(p, v, __ATOMIC_RELAXED, __HIP_MEMORY_SCOPE_AGENT); }
__device__ __forceinline__ unsigned xb_xcc_id() { return (unsigned)__builtin_amdgcn_s_getreg((3 << 11) | 20) & 0xFu; }
#define XB_SPIN(cond, bar) do { unsigned _sp = 0; while (cond) { __builtin_amdgcn_s_sleep(1); \
    if ((++_sp & 255u) == 0u) { if (xb_ld(&(bar)[XB_TMO])) break; if (_sp > XB_SPIN_CAP) { atomicAdd(&(bar)[XB_TMO], 1u); break; } } } } while (0)
struct XcdBarrier { unsigned* bar; unsigned x; volatile LAS unsigned* st; };
__device__ __forceinline__ XcdBarrier xcd_barrier_post(unsigned* bar, volatile LAS unsigned* st) {
  XcdBarrier b; b.bar = bar; b.x = xb_xcc_id(); b.st = st;
  if (threadIdx.x == 0) (void)xb_add(&bar[XB_XCNT(b.x)], 1u);
  return b;
}
__device__ __forceinline__ void xcd_barrier_complete(unsigned* bar, unsigned x, unsigned& nloc, unsigned& nx) {
  const unsigned G = gridDim.x * gridDim.y * gridDim.z;
  unsigned sum, cnt, mine, sp = 0u;
  for (;;) {
    sum = 0u; cnt = 0u; mine = 0u;
#pragma unroll
    for (unsigned j = 0; j < 16; ++j) { const unsigned c = xb_ld(&bar[XB_XCNT(j)]); sum += c; cnt += (c > 0u) ? 1u : 0u; mine = (j == x) ? c : mine; }
    if (sum == G) break;
    __builtin_amdgcn_s_sleep(1);
    if ((++sp & 255u) == 0u) { if (xb_ld(&bar[XB_TMO])) break; if (sp > XB_SPIN_CAP) { atomicAdd(&bar[XB_TMO], 1u); break; } }
  }
  nloc = mine > 0u ? mine : 1u; nx = cnt > 0u ? cnt : 1u;
}
__device__ __forceinline__ void xcd_barrier(const XcdBarrier& b) {
  asm volatile("s_waitcnt vmcnt(0)" ::: "memory");
  __syncthreads();
  if (threadIdx.x == 0) {
    unsigned* bar = b.bar;
    __builtin_amdgcn_s_waitcnt(0);
    unsigned nloc = b.st[0], nx = b.st[1];
    if (nloc == 0u) { xcd_barrier_complete(bar, b.x, nloc, nx); b.st[0] = nloc; b.st[1] = nx; }
    const unsigned old = xb_add(&bar[XB_XSUB(b.x)], 1u);
    const unsigned gen = old / nloc;
    if (old + 1u == (gen + 1u) * nloc) {
      __builtin_amdgcn_fence(__ATOMIC_RELEASE, "agent");
      asm volatile("s_waitcnt vmcnt(0)" ::: "memory");
      const unsigned og = xb_add(&bar[XB_TOP], 1u);
      const unsigned tg = og / nx;
      if (og + 1u == (tg + 1u) * nx) xb_add(&bar[XB_TOPGEN], 1u);
      else XB_SPIN(xb_ld(&bar[XB_TOPGEN]) == tg, bar);
      __builtin_amdgcn_fence(__ATOMIC_ACQUIRE, "agent");
      xb_add(&bar[XB_XGEN(b.x)], 1u);
      asm volatile("s_waitcnt vmcnt(0)" ::: "memory");
    } else {
      XB_SPIN(xb_ld(&bar[XB_XGEN(b.x)]) == gen, bar);
      __builtin_amdgcn_fence(__ATOMIC_ACQUIRE, "agent");
      asm volatile("s_waitcnt vmcnt(0)" ::: "memory");
    }
  }
  __syncthreads();
}

namespace pg8 {
constexpr int BM = 256, BK = 64, HALF = 128, HTB = HALF * BK * 2, STAGE_BYTES = 8 * HTB, NXCD = 8, WGM = 8;
__host__ __device__ __forceinline__ int lds_byte(int r, int c) { const int st = (r >> 4) * 2 + (c >> 5), rr = r & 15, cc = c & 31, ob = rr * 64 + cc * 2; return st * 1024 + (ob ^ (((ob >> 9) & 1) << 5)); }
__host__ __device__ __forceinline__ void stage_rc(int b, int& R, int& C) { const int st = b / 1024, sb = b % 1024, swz = sb ^ (((sb >> 9) & 1) << 5); R = (st >> 1) * 16 + swz / 64; C = (st & 1) * 32 + (swz % 64) / 2; }
__host__ __device__ __forceinline__ int perm32(int rho) { const int n = rho >> 4, i = rho & 15; return 8 * (i >> 2) + 4 * n + (i & 3); }
struct Unit { int pm, pn, ks; };
struct Gemm { const bf16_t* A; const bf16_t* Bt; int M, N, K, ld, nks; };
struct StaticOrder {
  int nM, nN, ntile, nwg, G, c;
  __device__ void init(int M, int N, int nks, int G_, int c_) { nM = M / BM; nN = N / BM; ntile = nM * nN; nwg = ntile * nks; G = G_; c = c_; }
  __device__ bool next(int i, Unit& u) const {
    const long L = (long)i * G + c; if (L >= nwg) return false;
    u.ks = (int)L / ntile; int wgid = (int)L - u.ks * ntile;
    { const int q = ntile / NXCD, r = ntile % NXCD, xcd = wgid % NXCD, off = wgid / NXCD; wgid = (xcd < r ? xcd * (q + 1) : r * (q + 1) + (xcd - r) * q) + off; }
    const int nig = WGM * nN, gid = wgid / nig, fm = gid * WGM, gsz = (nM - fm) < WGM ? (nM - fm) : WGM;
    u.pm = fm + ((wgid % nig) % gsz); u.pn = (wgid % nig) / gsz; return true;
  }
};

template <class Epi>
__device__ __forceinline__ void gemm_phase(LP lds, const Gemm g, const StaticOrder& S, const Epi& E) {
  int tid_ = threadIdx.x; asm volatile("" : "+v"(tid_));
  const int tid = tid_, wid = __builtin_amdgcn_readfirstlane(tid >> 6), lane = tid & 63, wr = wid >> 2, wc = wid & 3, fr = lane & 15, fq = lane >> 4;
  const int K = g.ld, nt = g.K / BK;
  const size_t ksb = (size_t)g.K * 2;
  unsigned voffA[2], voffB[2];
#pragma unroll
  for (int i = 0; i < 2; ++i) { int R, C; stage_rc(tid * 16 + i * 8192, R, C); const int Rb = (R & ~31) + perm32(R & 31); voffA[i] = (unsigned)(R * K + C) * 2u; voffB[i] = (unsigned)(Rb * K + C) * 2u; }
  const size_t kstep = (size_t)(BK * 2);
  const size_t hstep = (size_t)HALF * K * 2;
  const size_t tstep = 2 * hstep;
  const unsigned ldsw = (unsigned)wid * 1024u;
  const int aoff = lds_byte(wr * 64 + fr, fq * 8), boff = lds_byte(wc * 32 + fr, fq * 8);
#define PG8_SA(b, h) (((b) * 2 + (h)) * HTB)
#define PG8_SB(b, h) ((4 + (b) * 2 + (h)) * HTB)
#define PG8_STAGE(bufoff, gbase, voff) do { _Pragma("unroll") for (int _i = 0; _i < 2; ++_i) \
    __builtin_amdgcn_global_load_lds((const unsigned*)((const char*)(gbase) + (voff)[_i]), (LAS unsigned*)(lds + (bufoff) + ldsw + _i * 8192), 16, 0, 0); } while (0)
#define PG8_LDA(dst, b, h) do { _Pragma("unroll") for (int m = 0; m < 4; ++m) _Pragma("unroll") for (int k = 0; k < 2; ++k) dst[m][k] = *(const LAS bf16x8*)(lds + PG8_SA(b, h) + aoff + m * 2048 + k * 1024); } while (0)
#define PG8_LDB(dst, b, h) do { _Pragma("unroll") for (int n = 0; n < 2; ++n) _Pragma("unroll") for (int k = 0; k < 2; ++k) dst[n][k] = *(const LAS bf16x8*)(lds + PG8_SB(b, h) + boff + n * 2048 + k * 1024); } while (0)
#define PG8_MMA(ai, bj, At, Bt) do { __builtin_amdgcn_s_setprio(1); _Pragma("unroll") for (int m = 0; m < 4; ++m) _Pragma("unroll") for (int n = 0; n < 2; ++n) _Pragma("unroll") for (int k = 0; k < 2; ++k) \
    acc[ai][bj][m][n] = __builtin_amdgcn_mfma_f32_16x16x32_bf16(Bt[n][k], At[m][k], acc[ai][bj][m][n], 0, 0, 0); __builtin_amdgcn_s_setprio(0); } while (0)
#define PG8_WAIT_V(n) asm volatile("s_waitcnt vmcnt(" #n ")" ::: "memory")
#define PG8_WAIT_L(n) asm volatile("s_waitcnt lgkmcnt(" #n ")" ::: "memory")
#define PG8_BAR __builtin_amdgcn_s_barrier()
#define PG8_SCHED __builtin_amdgcn_sched_barrier(0)
  Unit cur, nxt; int ui = 0;
  if (!S.next(0, cur)) return;
  f32x4 acc[2][2][4][2];
#pragma unroll
  for (int a = 0; a < 2; ++a)
#pragma unroll
    for (int b = 0; b < 2; ++b)
#pragma unroll
      for (int m = 0; m < 4; ++m)
#pragma unroll
        for (int n = 0; n < 2; ++n) acc[a][b][m][n] = (f32x4){0.f, 0.f, 0.f, 0.f};
  bf16x8 At[4][2], B0[2][2], B1[2][2];
  const char* cA = (const char*)g.A + (size_t)cur.pm * tstep + cur.ks * ksb; const char* cB = (const char*)g.Bt + (size_t)cur.pn * tstep + cur.ks * ksb;
  PG8_STAGE(PG8_SB(0, 0), cB, voffB); PG8_STAGE(PG8_SB(0, 1), cB + hstep, voffB); PG8_STAGE(PG8_SA(0, 0), cA, voffA); PG8_STAGE(PG8_SA(0, 1), cA + hstep, voffA);
  if (wr == 1) PG8_BAR;
  PG8_WAIT_V(2); PG8_BAR;
  PG8_STAGE(PG8_SB(1, 0), cB + kstep, voffB); PG8_STAGE(PG8_SA(1, 0), cA + kstep, voffA); PG8_STAGE(PG8_SB(1, 1), cB + hstep + kstep, voffB);
  PG8_WAIT_V(6); PG8_BAR;
  for (;;) {
    const bool has_next = S.next(ui + 1, nxt);
    const char* nA = has_next ? (const char*)g.A + (size_t)nxt.pm * tstep + nxt.ks * ksb : cA; const char* nB = has_next ? (const char*)g.Bt + (size_t)nxt.pn * tstep + nxt.ks * ksb : cB;
    for (int t = 0; t < nt; t += 2) {
      const bool last = (t == nt - 2);
      const char* a1 = cA + (size_t)(t + 1) * kstep;
      const char* a2 = last ? nA : cA + (size_t)(t + 2) * kstep; const char* b2 = last ? nB : cB + (size_t)(t + 2) * kstep;
      const char* a3 = a2 + kstep; const char* b3 = b2 + kstep;
      PG8_LDB(B0, 0, 0); PG8_LDB(B1, 0, 1); PG8_SCHED; PG8_LDA(At, 0, 0); PG8_STAGE(PG8_SA(1, 1), a1 + hstep, voffA);
      PG8_WAIT_V(8); PG8_WAIT_L(0); PG8_BAR; PG8_MMA(0, 0, At, B0); PG8_MMA(0, 1, At, B1); PG8_BAR; PG8_SCHED;
      PG8_LDA(At, 0, 1); PG8_STAGE(PG8_SB(0, 0), b2, voffB); PG8_STAGE(PG8_SB(0, 1), b2 + hstep, voffB); PG8_STAGE(PG8_SA(0, 0), a2, voffA);
      PG8_WAIT_V(8); PG8_WAIT_L(0); PG8_BAR; PG8_MMA(1, 0, At, B0); PG8_MMA(1, 1, At, B1); PG8_BAR; PG8_SCHED;
      PG8_LDB(B0, 1, 0); PG8_LDB(B1, 1, 1); PG8_SCHED; PG8_LDA(At, 1, 0); PG8_STAGE(PG8_SA(0, 1), a2 + hstep, voffA);
      PG8_WAIT_V(8); PG8_WAIT_L(0); PG8_BAR; PG8_MMA(0, 0, At, B0); PG8_MMA(0, 1, At, B1); PG8_BAR; PG8_SCHED;
      PG8_LDA(At, 1, 1); PG8_STAGE(PG8_SB(1, 0), b3, voffB); PG8_STAGE(PG8_SB(1, 1), b3 + hstep, voffB); PG8_STAGE(PG8_SA(1, 0), a3, voffA);
      PG8_WAIT_V(8); PG8_WAIT_L(0); PG8_BAR; PG8_MMA(1, 0, At, B0); PG8_MMA(1, 1, At, B1); PG8_BAR; PG8_SCHED;
    }
    if (wr == 0) PG8_BAR;
    { int fr2 = fr, fq2 = fq; asm volatile("" : "+v"(fr2), "+v"(fq2)); E(acc, cur, wr, wc, fr2, fq2); }
    if (!has_next) break;
#pragma unroll
    for (int a = 0; a < 2; ++a)
#pragma unroll
      for (int b = 0; b < 2; ++b)
#pragma unroll
        for (int m = 0; m < 4; ++m)
#pragma unroll
          for (int n = 0; n < 2; ++n) acc[a][b][m][n] = (f32x4){0.f, 0.f, 0.f, 0.f};
    cur = nxt; cA = nA; cB = nB; ++ui;
    if (wr == 1) PG8_BAR;
  }
  PG8_WAIT_V(0);
  PG8_BAR;
#undef PG8_SA
#undef PG8_SB
#undef PG8_STAGE
#undef PG8_LDA
#undef PG8_LDB
#undef PG8_MMA
#undef PG8_WAIT_V
#undef PG8_WAIT_L
#undef PG8_BAR
#undef PG8_SCHED
}
}
using pg8::Unit;
typedef f32x4 AccT[2][2][4][2];

#define EPI_ROW(ai, m) (u.pm * 256 + (ai) * 128 + wr * 64 + (m) * 16 + fr)
#define EPI_COL(bj, n) (u.pn * 256 + (bj) * 128 + wc * 32 + 8 * fq + 4 * (n))
#define EPI_LOOP_ROWS _Pragma("unroll") for (int ai = 0; ai < 2; ++ai) _Pragma("unroll") for (int m = 0; m < 4; ++m)
#define EPI_LOOP_COLS _Pragma("unroll") for (int bj = 0; bj < 2; ++bj) _Pragma("unroll") for (int n = 0; n < 2; ++n)

__device__ __forceinline__ int cond_of_row(int row) { return row < NCTX ? 0 : 1 + ((row - NCTX) >> 11); }

#define EPI_LOOP_BJ _Pragma("unroll") for (int bj = 0; bj < 2; ++bj)
__device__ __forceinline__ u32x4 pack8(const f32x4 v0, const f32x4 v1) { u32x4 w; w.x = pack2(v0[0], v0[1]); w.y = pack2(v0[2], v0[3]); w.z = pack2(v1[0], v1[1]); w.w = pack2(v1[2], v1[3]); return w; }
__device__ __forceinline__ void unpack8(const u32x4 w, f32x4& v0, f32x4& v1) { v0[0] = bflo(w.x); v0[1] = bfhi(w.x); v0[2] = bflo(w.y); v0[3] = bfhi(w.y); v1[0] = bflo(w.z); v1[1] = bfhi(w.z); v1[2] = bflo(w.w); v1[3] = bfhi(w.w); }
struct EpiQKV {
  bf16_t* O; const float* bias;
  __device__ __forceinline__ void operator()(const AccT& acc, const Unit& u, int wr, int wc, int fr, int fq) const {
    const float sc = (u.pn < 4) ? 0.0625f : 1.0f;
    f32x4 bv[2][2];
    EPI_LOOP_COLS { bv[bj][n] = *(const f32x4*)(bias + EPI_COL(bj, n)); }
    EPI_LOOP_ROWS { const int row = EPI_ROW(ai, m);
      EPI_LOOP_BJ { *(u32x4*)(O + (size_t)row * 3072 + EPI_COL(bj, 0)) = pack8((acc[ai][bj][m][0] + bv[bj][0]) * sc, (acc[ai][bj][m][1] + bv[bj][1]) * sc); } }
  }
};
struct EpiUT {
  bf16_t* O; const float* bias;
  __device__ __forceinline__ void operator()(const AccT& acc, const Unit& u, int wr, int wc, int fr, int fq) const {
    EPI_LOOP_ROWS { const int row = EPI_ROW(ai, m); const float bv = bias[row];
      EPI_LOOP_BJ { *(u32x4*)(O + (size_t)row * NTOK + EPI_COL(bj, 0)) = pack8(acc[ai][bj][m][0] + bv, acc[ai][bj][m][1] + bv); } }
  }
};
struct EpiGates {
  bf16_t* H; bf16_t* G; const float* b_in;
  __device__ __forceinline__ void operator()(const AccT& acc, const Unit& u, int wr, int wc, int fr, int fq) const {
    const bool og = u.pn < 4;
    f32x4 bv[2][2];
    EPI_LOOP_COLS { const int col = EPI_COL(bj, n); bv[bj][n] = *(const f32x4*)(b_in + (og ? 3072 + col : 7184 + (col - 1024))); }
#pragma unroll
    for (int ai = 0; ai < 2; ++ai)
#pragma unroll
      for (int m2 = 0; m2 < 2; ++m2) {
        u32x4 hv[2][2];
        if (og) {
#pragma unroll
          for (int mm = 0; mm < 2; ++mm) { const int row = EPI_ROW(ai, 2 * m2 + mm); EPI_LOOP_BJ { hv[mm][bj] = *(const u32x4*)(H + (size_t)row * 1024 + EPI_COL(bj, 0)); } } }
#pragma unroll
        for (int mm = 0; mm < 2; ++mm) { const int m = 2 * m2 + mm; const int row = EPI_ROW(ai, m);
          EPI_LOOP_BJ { const int col = EPI_COL(bj, 0); f32x4 s0, s1; const f32x4 a0 = acc[ai][bj][m][0] + bv[bj][0], a1 = acc[ai][bj][m][1] + bv[bj][1];
#pragma unroll
            for (int e = 0; e < 4; ++e) { s0[e] = sigmoidf_(a0[e]); s1[e] = sigmoidf_(a1[e]); }
            if (og) { f32x4 h0, h1; unpack8(hv[mm][bj], h0, h1); *(u32x4*)(H + (size_t)row * 1024 + col) = pack8(h0 * s0, h1 * s1); }
            else *(u32x4*)(G + (size_t)row * 2048 + (col - 1024)) = pack8(s0, s1); } } }
  }
};
template <int SECOND> struct EpiMerge {
  bf16_t* T; const bf16_t* G;
  __device__ __forceinline__ void operator()(const AccT& acc, const Unit& u, int wr, int wc, int fr, int fq) const {
#pragma unroll
    for (int ai = 0; ai < 2; ++ai)
#pragma unroll
      for (int m2 = 0; m2 < 2; ++m2) {
        u32x4 gv[2][2], tv[2][2];
#pragma unroll
        for (int mm = 0; mm < 2; ++mm) { const int row = EPI_ROW(ai, 2 * m2 + mm);
          EPI_LOOP_BJ { const int col = EPI_COL(bj, 0); gv[mm][bj] = *(const u32x4*)(G + (size_t)row * 2048 + SECOND * 1024 + col);
            if (SECOND) tv[mm][bj] = *(const u32x4*)(T + (size_t)row * 1024 + col); } }
#pragma unroll
        for (int mm = 0; mm < 2; ++mm) { const int m = 2 * m2 + mm; const int row = EPI_ROW(ai, m);
          EPI_LOOP_BJ { const int col = EPI_COL(bj, 0); f32x4 g0, g1; unpack8(gv[mm][bj], g0, g1);
            f32x4 v0 = g0 * acc[ai][bj][m][0], v1 = g1 * acc[ai][bj][m][1];
            if (SECOND) { f32x4 t0, t1; unpack8(tv[mm][bj], t0, t1); v0 += t0; v1 += t1; }
            *(u32x4*)(T + (size_t)row * 1024 + col) = pack8(v0, v1); } } }
  }
};
struct EpiOut {
  const float* xp; const float* xs; const float* per; const float* pec; const float* mod; const float* n2w; float* X1; bf16_t* A2; float* ssq;
  __device__ __forceinline__ void operator()(const AccT& acc, const Unit& u, int wr, int wc, int fr, int fq) const {
    const int cb = cond_of_row(u.pm * 256); const float* md = mod + cb * 6144; const bool smp = (u.pm * 256) >= NCTX;
    f32x4 g1v[2][2], k2v[2][2];
    EPI_LOOP_COLS { const int col = EPI_COL(bj, n); g1v[bj][n] = *(const f32x4*)(md + 2048 + col); k2v[bj][n] = *(const f32x4*)(n2w + col) * (*(const f32x4*)(md + 4096 + col) + 1.0f); }
    EPI_LOOP_ROWS { const int row = EPI_ROW(ai, m); float ss = 0.f;
#pragma unroll
      for (int bj = 0; bj < 2; ++bj) {
        f32x4 x0[2];
        if (!smp) {
#pragma unroll
          for (int n = 0; n < 2; ++n) x0[n] = *(const f32x4*)(xp + (size_t)row * 1024 + EPI_COL(bj, n)); }
        else { const int r2 = row - NCTX, t = r2 & 2047; f32x4 pe[2];
#pragma unroll
          for (int n = 0; n < 2; ++n) { const int col = EPI_COL(bj, n); x0[n] = *(const f32x4*)(xs + (size_t)r2 * 1024 + col);
            pe[n] = (col < 512) ? *(const f32x4*)(per + (t >> 6) * 512 + col) : *(const f32x4*)(pec + (t & 63) * 512 + (col - 512)); }
#pragma unroll
          for (int n = 0; n < 2; ++n) x0[n] += pe[n]; }
        f32x4 x1[2];
#pragma unroll
        for (int n = 0; n < 2; ++n) { x1[n] = x0[n] + g1v[bj][n] * acc[ai][bj][m][n]; *(f32x4*)(X1 + (size_t)row * 1024 + EPI_COL(bj, n)) = x1[n];
          ss += x1[n][0] * x1[n][0] + x1[n][1] * x1[n][1] + x1[n][2] * x1[n][2] + x1[n][3] * x1[n][3]; }
        *(u32x4*)(A2 + (size_t)row * 1024 + EPI_COL(bj, 0)) = pack8(x1[0] * k2v[bj][0], x1[1] * k2v[bj][1]); }
      ss = xrow16_sum(ss);
      if (fq == 0) ssq[(size_t)row * 16 + u.pn * 4 + wc] = ss; }
  }
};
struct EpiFF1 {
  int row0; const float* ssq; const float* c1; bf16_t* Hd;
  __device__ __forceinline__ void operator()(const AccT& acc, const Unit& u, int wr, int wc, int fr, int fq) const {
    const int cb = cond_of_row(row0 + u.pm * 256); const float* cc = c1 + cb * 4096;
    f32x4 cv[2][2];
    EPI_LOOP_COLS { cv[bj][n] = *(const f32x4*)(cc + EPI_COL(bj, n)); }
    float rs[2][4];
    EPI_LOOP_ROWS { const float* sp = ssq + (size_t)(row0 + EPI_ROW(ai, m)) * 16;
      const f32x4 st = (*(const f32x4*)sp + *(const f32x4*)(sp + 4)) + (*(const f32x4*)(sp + 8) + *(const f32x4*)(sp + 12));
      rs[ai][m] = rsqrtf((st[0] + st[1] + st[2] + st[3]) * (1.0f / 1024.0f) + 1e-6f); }
    EPI_LOOP_ROWS { const int rl = EPI_ROW(ai, m); const float rstd = rs[ai][m];
      EPI_LOOP_BJ { f32x4 v0 = acc[ai][bj][m][0] * rstd + cv[bj][0], v1 = acc[ai][bj][m][1] * rstd + cv[bj][1];
#pragma unroll
        for (int e = 0; e < 4; ++e) { const float r0 = fmaxf(v0[e], 0.f), r1 = fmaxf(v1[e], 0.f); v0[e] = r0 * r0; v1[e] = r1 * r1; }
        *(u32x4*)(Hd + (size_t)rl * 4096 + EPI_COL(bj, 0)) = pack8(v0, v1); } }
  }
};
struct EpiFF2 {
  int row0; const float* mod; const float* b2; float* X; float* P;
  __device__ __forceinline__ void operator()(const AccT& acc, const Unit& u, int wr, int wc, int fr, int fq) const {
    if (u.ks == 1) {
      EPI_LOOP_ROWS { const int rl = EPI_ROW(ai, m); EPI_LOOP_COLS { *(f32x4*)(P + (size_t)rl * 1024 + EPI_COL(bj, n)) = acc[ai][bj][m][n]; } }
    } else {
    const int cb = cond_of_row(row0 + u.pm * 256); const float* md = mod + cb * 6144;
    f32x4 g2v[2][2], bbv[2][2];
    EPI_LOOP_COLS { const int col = EPI_COL(bj, n); g2v[bj][n] = *(const f32x4*)(md + 5120 + col); bbv[bj][n] = *(const f32x4*)(b2 + col); }
#pragma unroll
    for (int ai = 0; ai < 2; ++ai)
#pragma unroll
      for (int m2 = 0; m2 < 2; ++m2) {
        f32x4 xv[2][2][2];
#pragma unroll
        for (int mm = 0; mm < 2; ++mm) { const int row = row0 + EPI_ROW(ai, 2 * m2 + mm); EPI_LOOP_COLS { xv[mm][bj][n] = *(const f32x4*)(X + (size_t)row * 1024 + EPI_COL(bj, n)); } }
#pragma unroll
        for (int mm = 0; mm < 2; ++mm) { const int m = 2 * m2 + mm; const int row = row0 + EPI_ROW(ai, m);
          EPI_LOOP_COLS { const int col = EPI_COL(bj, n); *(f32x4*)(X + (size_t)row * 1024 + col) = xv[mm][bj][n] + g2v[bj][n] * (acc[ai][bj][m][n] + bbv[bj][n]); } } }
    }
  }
};

template <class Epi> __device__ __forceinline__ void run_gemm(LP lds, const bf16_t* A, const bf16_t* Bt, int M, int N, int K, const Epi& E, int nks = 1) {
  pg8::Gemm g; g.A = A; g.Bt = Bt; g.M = M; g.N = N; g.K = K / nks; g.ld = K; g.nks = nks;
  pg8::StaticOrder S; S.init(M, N, nks, (int)gridDim.x, (int)blockIdx.x);
  pg8::gemm_phase<Epi>(lds, g, S, E);
}

__device__ void transpose_tile(const float* __restrict__ src, int ld, int col0, int k0, bf16_t* __restrict__ dst, int K, int drow0, LAS float* tile) {
  const int t = opaque_tid();
  f32x4 v[4];
#pragma unroll
  for (int i = 0; i < 4; ++i) { const int idx = t + 512 * i, kr = idx >> 5, c4 = idx & 31; v[i] = *(const f32x4*)(src + (size_t)(k0 + kr) * ld + col0 + 4 * c4); }
#pragma unroll
  for (int i = 0; i < 4; ++i) { const int idx = t + 512 * i, kr = idx >> 5, c4 = idx & 31; LAS float* tp = tile + kr * 129 + 4 * c4; tp[0] = v[i][0]; tp[1] = v[i][1]; tp[2] = v[i][2]; tp[3] = v[i][3]; }
  __syncthreads();
  const int kb = t & 7;
#pragma unroll
  for (int i = 0; i < 2; ++i) { const int c = (t >> 3) + 64 * i; const LAS float* tp = tile + (kb * 8) * 129 + c; u32x4 o;
    o.x = pack2(tp[0], tp[129]); o.y = pack2(tp[2 * 129], tp[3 * 129]); o.z = pack2(tp[4 * 129], tp[5 * 129]); o.w = pack2(tp[6 * 129], tp[7 * 129]);
    *(u32x4*)(dst + (size_t)(drow0 + c) * K + k0 + kb * 8) = o; }
  __syncthreads();
}
template <int SILU> __device__ void matvec9_unit(const float* v0, const float* v1, int v1stride, const float* __restrict__ W, int ldw, const float* bias, float* out, int ldo, int col0, LAS float* lf) {
  const int t = opaque_tid(), lane = t & 63, wid = t >> 6;
  LAS float* sv = lf; LAS float* red = lf + 9216;
  for (int i = t; i < 9216; i += 512) { const int b = i >> 10, k = i & 1023; float x = (b == 0) ? v0[k] : v1[(size_t)(b - 1) * v1stride + k]; if (SILU) x = x * __builtin_amdgcn_rcpf(1.0f + __expf(-x)); sv[i] = x; }
  __syncthreads();
  const int c4 = t & 7, kl = t >> 3;
  f32x4 w[16];
#pragma unroll
  for (int i = 0; i < 16; ++i) w[i] = *(const f32x4*)(W + (size_t)(kl + 64 * i) * ldw + col0 + 4 * c4);
  f32x4 acc[9];
#pragma unroll
  for (int b = 0; b < 9; ++b) acc[b] = (f32x4){0.f, 0.f, 0.f, 0.f};
#pragma unroll
  for (int i = 0; i < 16; ++i)
#pragma unroll
    for (int b = 0; b < 9; ++b) acc[b] += w[i] * sv[b * 1024 + kl + 64 * i];
#pragma unroll
  for (int b = 0; b < 9; ++b)
#pragma unroll
    for (int e = 0; e < 4; ++e) { float x = acc[b][e]; x += __shfl_xor(x, 8); x += __shfl_xor(x, 16); x += __shfl_xor(x, 32); acc[b][e] = x; }
  if (lane < 8) {
#pragma unroll
    for (int b = 0; b < 9; ++b) *(LAS f32x4*)(red + (wid * 9 + b) * 32 + 4 * lane) = acc[b]; }
  __syncthreads();
  if (t < 288) { const int b = t >> 5, cc = t & 31; float s = bias[col0 + cc];
#pragma unroll
    for (int pz = 0; pz < 8; ++pz) s += red[(pz * 9 + b) * 32 + cc];
    out[(size_t)b * ldo + col0 + cc] = s; }
  __syncthreads();
}

__device__ void phase0(const Params& p, LP lds) {
  unsigned char* ws = p.ws; LAS float* lf = (LAS float*)lds;
  const int tid0 = opaque_tid(); const int wid = tid0 >> 6, lane = tid0 & 63;
  for (int unit = blockIdx.x; unit < 576; unit += gridDim.x) {
    if (unit < 192) {
      matvec9_unit<1>(p.in[6], p.in[5], 1024, p.in[7], 6144, p.in[8], (float*)(ws + OFF_MOD), 6144, unit * 32, lf);
    } else if (unit < 480) {
      const int row = (unit - 192) * 8 + wid; const bool smp = row < 2048; const int L = smp ? 2048 : 256, t = smp ? row : row - 2048;
      const float* w1 = p.in[14]; const float* b1 = p.in[15]; const float* fr1 = p.in[16]; const float* w2 = p.in[17]; const float* b2 = p.in[18]; const float* fr2 = p.in[19];
      float a = b1[lane] + (float)t / (float)(L - 1) * w1[lane];
      const float base = (6.283185307179586f / (float)L) * (float)t;
      float cs = 0.f, sn = 0.f; if (lane < 16) { const float ang = base * (float)(lane + 1); cs = cosf(ang); sn = sinf(ang); }
#pragma unroll
      for (int i = 0; i < 16; ++i) a += __shfl(cs, i) * w1[(1 + i) * 64 + lane] + __shfl(sn, i) * w1[(17 + i) * 64 + lane];
      const float h1 = sinf(fr1[lane] * a);
      float a2 = b2[lane];
#pragma unroll 16
      for (int j = 0; j < 64; ++j) a2 += __shfl(h1, j) * w2[j * 64 + lane];
      const float h2 = sinf(fr2[lane] * a2);
      float* dst = (float*)(ws + (smp ? OFF_H2S : OFF_H2C)); dst[(size_t)t * 64 + lane] = h2;
    } else {
      const int r = unit - 480, c = tid0; const int pos = r < 32 ? r : r - 32; const int i = c & 255;
      const float omega = 1.0f / powf(10000.0f, (float)i / 256.0f); const float a = (float)pos * omega; const float v = c < 256 ? sinf(a) : cosf(a);
      float* dst = (float*)(ws + (r < 32 ? OFF_PER : OFF_PEC)); dst[(size_t)pos * 512 + c] = v;
    }
  }
}
__device__ void weight_tiles(const Params& p, LP lds, int lo, int hi, int upper) {
  unsigned char* ws = p.ws; LAS float* lf = (LAS float*)lds;
  const int nh = upper ? ((int)gridDim.x >> 1) : 0;
  if ((int)blockIdx.x < nh) return;
  for (int tu = lo + (int)blockIdx.x - nh; tu < hi; tu += (int)gridDim.x - nh) {
    const float* src; int ld, K, col0, k0, drow0; bf16_t* dst;
    if (tu < 1152) { const int nt = tu >> 4, kt = tu & 15; const int r = nt * 128; src = p.in[10]; ld = INC; K = 1024; k0 = kt * 64; drow0 = r; dst = (bf16_t*)(ws + OFF_WT);
      col0 = r < 3072 ? r : (r < 6144 ? 4112 + (r - 3072) : (r < 7168 ? 3072 + (r - 6144) : 7184 + (r - 7168))); }
    else if (tu < 1536) { const int v = tu - 1152, w = v >> 7, q = v & 127; src = p.in[23 + w]; ld = 1024; K = 1024; k0 = (q & 15) * 64; col0 = (q >> 4) * 128; drow0 = col0; dst = (bf16_t*)(ws + (w == 0 ? OFF_WBM : (w == 1 ? OFF_WBH : OFF_WOUT))); }
    else if (tu < 2048) { const int q = tu - 1536; src = p.in[27]; ld = 4096; K = 1024; k0 = (q & 15) * 64; col0 = (q >> 4) * 128; drow0 = col0; dst = (bf16_t*)(ws + OFF_W1T); }
    else { const int q = tu - 2048; src = p.in[29]; ld = 1024; K = 4096; k0 = (q & 63) * 64; col0 = (q >> 6) * 128; drow0 = col0; dst = (bf16_t*)(ws + OFF_W2T); }
    transpose_tile(src, ld, col0, k0, dst, K, drow0, lf);
  }
}

__device__ void phase1(const Params& p, LP lds) {
  unsigned char* ws = p.ws;
  int tid_ = threadIdx.x; asm volatile("" : "+v"(tid_));
  const int tid = tid_, wid = tid >> 6, lane = tid & 63;
  const float* mod = (const float*)(ws + OFF_MOD);
  LAS float* wg = (LAS float*)lds;
  if ((int)blockIdx.x < 1536) {
    f32x4 gw[8];
#pragma unroll
    for (int i = 0; i < 8; ++i) { const int idx = tid + 512 * i, k = idx >> 2, q = idx & 3; gw[i] = *(const f32x4*)(p.in[10] + (size_t)k * INC + 4096 + 4 * q); }
#pragma unroll
    for (int i = 0; i < 8; ++i) { const int idx = tid + 512 * i, k = idx >> 2, q = idx & 3; wg[(4 * q) * 1024 + k] = gw[i][0]; wg[(4 * q + 1) * 1024 + k] = gw[i][1]; wg[(4 * q + 2) * 1024 + k] = gw[i][2]; wg[(4 * q + 3) * 1024 + k] = gw[i][3]; }
    __syncthreads();
  }
  for (int unit = blockIdx.x; unit < 1536; unit += gridDim.x) {
    const int tidn = opaque_tid(); const int wid = tidn >> 6, lane = tidn & 63;
    const int row0 = unit * 16 + wid * 2; const int cb = cond_of_row(row0); const float* md = mod + cb * 6144; const bool smp = row0 >= NCTX;
    f32x4 v[2][4]; float rstd[2];
#pragma unroll
    for (int r = 0; r < 2; ++r) { const int row = row0 + r; const float* xr; int t = 0;
      if (!smp) xr = p.in[0] + (size_t)row * 1024; else { xr = p.in[1] + (size_t)(row - NCTX) * 1024; t = (row - NCTX) & 2047; }
      const float* per = (const float*)(ws + OFF_PER) + (t >> 6) * 512; const float* pec = (const float*)(ws + OFF_PEC) + (t & 63) * 512;
      float ss = 0.f;
#pragma unroll
      for (int i = 0; i < 4; ++i) { const int col = 4 * lane + 256 * i; v[r][i] = *(const f32x4*)(xr + col);
        if (smp) v[r][i] += (col < 512) ? *(const f32x4*)(per + col) : *(const f32x4*)(pec + col - 512);
        ss += v[r][i][0] * v[r][i][0] + v[r][i][1] * v[r][i][1] + v[r][i][2] * v[r][i][2] + v[r][i][3] * v[r][i][3]; }
      ss = wave_sum(ss); rstd[r] = rsqrtf(ss * (1.0f / 1024.0f) + 1e-6f); }
    const float* n1w = p.in[9];
    float ga[32];
#pragma unroll
    for (int g = 0; g < 32; ++g) ga[g] = 0.f;
#pragma unroll
    for (int i = 0; i < 4; ++i) { const int col = 4 * lane + 256 * i;
      const f32x4 w = *(const f32x4*)(n1w + col), sc = *(const f32x4*)(md + 1024 + col), sh = *(const f32x4*)(md + col);
      const f32x4 ws1 = w * (sc + 1.0f);
      f32x4 h[2];
#pragma unroll
      for (int r = 0; r < 2; ++r) { h[r] = v[r][i] * rstd[r] * ws1 + sh;
        u32x2 o; o.x = pack2(h[r][0], h[r][1]); o.y = pack2(h[r][2], h[r][3]); *(u32x2*)((bf16_t*)(ws + OFF_HN) + (size_t)(row0 + r) * 1024 + col) = o; }
#pragma unroll
      for (int g = 0; g < 16; ++g) { const f32x4 wv = *(const LAS f32x4*)(wg + g * 1024 + col);
#pragma unroll
        for (int r = 0; r < 2; ++r) ga[r * 16 + g] += h[r][0] * wv[0] + h[r][1] * wv[1] + h[r][2] * wv[2] + h[r][3] * wv[3]; }
      asm volatile("" ::: "memory"); }
#pragma unroll
    for (int off = 16; off >= 1; off >>= 1) { const bool hi = (lane & off) != 0;
#pragma unroll
      for (int i = 0; i < off; ++i) { const float send = hi ? ga[i] : ga[i + off]; const float keep = hi ? ga[i + off] : ga[i]; ga[i] = keep + __shfl_xor(send, off); } }
    const float tot = ga[0] + __shfl_xor(ga[0], 32);
    if (lane < 32) ((float*)(ws + OFF_GT))[(size_t)row0 * 16 + lane] = tot + p.in[11][4096 + (lane & 15)];
  }
  __syncthreads();
}
__device__ void filters_upper_half(const Params& p, LP lds) {
  unsigned char* ws = p.ws; const int nh = (int)gridDim.x >> 1;
  if ((int)blockIdx.x < nh) return;
  LAS float* w3s = (LAS float*)lds;
  for (int v = (int)blockIdx.x - nh; v < 320; v += (int)gridDim.x - nh) {
    const int tid = opaque_tid();
    const bool smp = v < 256; const int L = smp ? 2048 : 256; const int tt = smp ? (v >> 6) : 0, cgp = v & 63; const int t = tt * 512 + tid;
    { const f32x4 x = *(const f32x4*)(p.in[20] + (size_t)(tid >> 3) * 2048 + cgp * 32 + 4 * (tid & 7)); LAS float* wp = w3s + (4 * (tid & 7)) * 64 + (tid >> 3);
      wp[0] = x[0]; wp[64] = x[1]; wp[128] = x[2]; wp[192] = x[3]; }
    __syncthreads();
    if (t < L) {
      const float* H2 = (const float*)(ws + (smp ? OFF_H2S : OFF_H2C)) + (size_t)t * 64;
      f32x4 h2[16];
#pragma unroll
      for (int i = 0; i < 16; ++i) h2[i] = *(const f32x4*)(H2 + 4 * i);
      const float dist = fabsf((float)t - (float)(L / 2)) / (float)(L / 2);
      float* HF = (float*)(ws + (smp ? OFF_HFS : OFF_HFC)) + (size_t)(cgp * 32) * L + t;
#pragma unroll 1
      for (int j = 0; j < 32; ++j) {
        f32x4 a = {0.f, 0.f, 0.f, 0.f};
#pragma unroll
        for (int i = 0; i < 16; ++i) a += *(const LAS f32x4*)(w3s + j * 64 + 4 * i) * h2[i];
        const int c = (cgp * 32 + j) & 1023;
        const float dmin = -3.0701134573253946f, dmax = -15.350567286626973f;
        const float delta = fabsf(dmin + (dmax - dmin) * ((float)c / 1023.0f));
        HF[(size_t)j * L] = ((a[0] + a[1]) + (a[2] + a[3])) * __expf(-dist * delta); }
    }
    __syncthreads();
  }
}
__device__ void c1_upper_half(const Params& p, LP lds) {
  unsigned char* ws = p.ws; const float* mod = (const float*)(ws + OFF_MOD); const int nh = (int)gridDim.x >> 1;
  if ((int)blockIdx.x < nh) return;
  for (int u = (int)blockIdx.x - nh; u < 128; u += (int)gridDim.x - nh)
    matvec9_unit<0>(mod + 3072, mod + 6144 + 3072, 6144, p.in[27], 4096, p.in[28], (float*)(ws + OFF_C1), 4096, u * 32, (LAS float*)lds);
}

__device__ __forceinline__ bf16x8 tr_frag(LP base, int k0, int m0, int pitch  , int l15, int g) {
  const int q = l15 >> 2, pp = l15 & 3;
  LP a = base + ((k0 + 8 * g + q) * pitch + m0 + 4 * pp) * 2;
  const s16x4 lo = __builtin_amdgcn_ds_read_tr16_b64_v4i16((LAS s16x4*)a);
  const s16x4 hi = __builtin_amdgcn_ds_read_tr16_b64_v4i16((LAS s16x4*)(a + 8 * pitch));
  bf16x8 r; r[0] = lo[0]; r[1] = lo[1]; r[2] = lo[2]; r[3] = lo[3]; r[4] = hi[0]; r[5] = hi[1]; r[6] = hi[2]; r[7] = hi[3]; return r;
}
__device__ __forceinline__ bf16x8 tr_at(LP lanebase, int coff  , int pitch_bytes) {
  const s16x4 lo = __builtin_amdgcn_ds_read_tr16_b64_v4i16((LAS s16x4*)(lanebase + coff));
  const s16x4 hi = __builtin_amdgcn_ds_read_tr16_b64_v4i16((LAS s16x4*)(lanebase + coff + 4 * pitch_bytes));
  bf16x8 r; r[0] = lo[0]; r[1] = lo[1]; r[2] = lo[2]; r[3] = lo[3]; r[4] = hi[0]; r[5] = hi[1]; r[6] = hi[2]; r[7] = hi[3]; return r;
}
constexpr int ML_K = 0, ML_V = 67584, ML_P = 86016, ML_C = 120832, ML_T = 157696, ML_TSZ = 1600;
constexpr int KP = 264, VP = 72, PP = 136, CP = 72;

__device__ void mlstm_item(const Params& p, LP lds, int item) {
  const int tid = opaque_tid(), wid = __builtin_amdgcn_readfirstlane(tid >> 6), lane = tid & 63, l15 = lane & 15, g = lane >> 4;
  const bool smp = item < 256; const int uu = smp ? (item >> 2) : ((item - 256) >> 2); const int sl = item & 3;
  const int b = uu >> 3, dir = (uu >> 2) & 1, head = uu & 3;
  const int S = smp ? SEQS : SEQC, nc = S >> 7; const int tok0 = smp ? NCTX + b * SEQS : b * SEQC;
  const bf16_t* qkv = (const bf16_t*)(p.ws + OFF_BIG);
  const float* GT = (const float*)(p.ws + OFF_GT);
  bf16_t* hout = (bf16_t*)((unsigned char*)p.out + (dir ? OUT_HB : OUT_H));
  const int sidx = (b * 2 + dir) * 4 + head;
  const int gi_col = dir * 8 + head, gf_col = dir * 8 + 4 + head;
  f32x4 Cacc[2][4], nacc[2]; float mst0;
  if (smp) {
    const float* C0 = p.in[2] + (size_t)sidx * 65536;
#pragma unroll
    for (int dt = 0; dt < 2; ++dt) {
#pragma unroll
      for (int vt = 0; vt < 4; ++vt) Cacc[dt][vt] = *(const f32x4*)(C0 + (size_t)((2 * wid + dt) * 16 + l15) * 256 + sl * 64 + 16 * vt + 4 * g);
      nacc[dt] = (f32x4){p.in[3][sidx * 256 + (2 * wid + dt) * 16 + l15], 0.f, 0.f, 0.f}; }
    mst0 = p.in[4][sidx];
  } else {
#pragma unroll
    for (int dt = 0; dt < 2; ++dt) {
#pragma unroll
      for (int vt = 0; vt < 4; ++vt) Cacc[dt][vt] = (f32x4){0.f, 0.f, 0.f, 0.f};
      nacc[dt] = (f32x4){0.f, 0.f, 0.f, 0.f}; }
    mst0 = 0.f;
  }
#define TOKC(cc, j) (dir ? (tok0 + S - 1 - ((cc) * 128 + (j))) : (tok0 + (cc) * 128 + (j)))
  const int rt = (wid < 4) ? wid : 11 - wid;
  const int jrow = 16 * rt + l15;
  bf16x8 qf[8]; u32x4 kreg[8], vreg[2]; float g4[4] = {0.f, 0.f, 0.f, 0.f};
#define ML_LOAD_Q(cc) do { const bf16_t* qp = qkv + (size_t)TOKC(cc, jrow) * 3072 + head * 256 + 8 * g; \
    _Pragma("unroll") for (int kk = 0; kk < 8; ++kk) qf[kk] = *(const bf16x8*)(qp + 32 * kk); } while (0)
#define ML_LOAD_KV(cc) do { \
    _Pragma("unroll") for (int i = 0; i < 8; ++i) { const int row = (tid >> 5) + 16 * i; kreg[i] = *(const u32x4*)(qkv + (size_t)TOKC(cc, row) * 3072 + 1024 + head * 256 + (tid & 31) * 8); } \
    _Pragma("unroll") for (int i = 0; i < 2; ++i) { const int row = (tid >> 3) + 64 * i; vreg[i] = *(const u32x4*)(qkv + (size_t)TOKC(cc, row) * 3072 + 2048 + head * 256 + sl * 64 + (tid & 7) * 8); } \
    if (wid == 0) { const float* g0 = GT + (size_t)TOKC(cc, 2 * lane) * 16; const float* g1 = GT + (size_t)TOKC(cc, 2 * lane + 1) * 16; g4[0] = g0[gi_col]; g4[1] = g0[gf_col]; g4[2] = g1[gi_col]; g4[3] = g1[gf_col]; } } while (0)
#define ML_SCAN(tabp, mcur, mnext) do { LAS float* T_ = (LAS float*)(tabp); \
    const float lf0 = fminf(g4[1], 0.f) - log1pf(__expf(-fabsf(g4[1]))), lf1 = fminf(g4[3], 0.f) - log1pf(__expf(-fabsf(g4[3]))); \
    float s_ = lf0 + lf1; \
    _Pragma("unroll") for (int o = 1; o < 64; o <<= 1) { const float t_ = __shfl_up(s_, o); if (lane >= o) s_ += t_; } \
    const float b1_ = s_, b0_ = s_ - lf1; const float u0_ = g4[0] - b0_, u1_ = g4[2] - b1_; \
    float mx_ = fmaxf(u0_, u1_); \
    _Pragma("unroll") for (int o = 1; o < 64; o <<= 1) { const float t_ = __shfl_up(mx_, o); if (lane >= o) mx_ = fmaxf(mx_, t_); } \
    float ex_ = __shfl_up(mx_, 1); if (lane == 0) ex_ = -INFINITY; \
    const float M0_ = fmaxf(mcur, fmaxf(ex_, u0_)), M1_ = fmaxf(mcur, mx_); \
    T_[2 * lane] = u0_; T_[2 * lane + 1] = u1_; T_[128 + 2 * lane] = M0_; T_[128 + 2 * lane + 1] = M1_; T_[256 + 2 * lane] = b0_; T_[256 + 2 * lane + 1] = b1_; \
    const float Ml_ = __shfl(M1_, 63), bl_ = __shfl(b1_, 63); \
    if (lane == 0) { T_[384] = mcur; T_[385] = Ml_; } \
    mnext = bl_ + Ml_; } while (0)
  float mw0 = mst0;
  ML_LOAD_Q(0); ML_LOAD_KV(0);
  if (wid == 0) { float mn; ML_SCAN(lds + ML_T, mw0, mn); mw0 = mn; }
  __syncthreads();
  float m_final = 0.f;
  for (int c = 0; c < nc; ++c) {
    LAS float* T = (LAS float*)(lds + ML_T + (c & 1) * ML_TSZ);
    const float mst = T[384], M_last = T[385];
#pragma unroll
    for (int i = 0; i < 8; ++i) { const int row = (tid >> 5) + 16 * i; *(LAS u32x4*)(lds + ML_K + (row * KP + (tid & 31) * 8) * 2) = kreg[i]; }
#pragma unroll
    for (int i = 0; i < 2; ++i) { const int row = (tid >> 3) + 64 * i; const float w = __expf(T[row] - M_last); const u32x4 v = vreg[i]; u32x4 o;
      o.x = pack2(bflo(v.x) * w, bfhi(v.x) * w); o.y = pack2(bflo(v.y) * w, bfhi(v.y) * w); o.z = pack2(bflo(v.z) * w, bfhi(v.z) * w); o.w = pack2(bflo(v.w) * w, bfhi(v.w) * w);
      *(LAS u32x4*)(lds + ML_V + (row * VP + (tid & 7) * 8) * 2) = o; }
    if (tid < 128) *(LAS unsigned short*)(lds + ML_V + (tid * VP + 64) * 2) = f2bf(__expf(T[tid] - M_last));
#pragma unroll
    for (int dt = 0; dt < 2; ++dt) {
#pragma unroll
      for (int vt = 0; vt < 4; ++vt) { u32x2 w; w.x = pack2(Cacc[dt][vt][0], Cacc[dt][vt][1]); w.y = pack2(Cacc[dt][vt][2], Cacc[dt][vt][3]);
        *(LAS u32x2*)(lds + ML_C + (((2 * wid + dt) * 16 + l15) * CP + 16 * vt + 4 * g) * 2) = w; }
      if (g == 0) *(LAS unsigned short*)(lds + ML_C + (((2 * wid + dt) * 16 + l15) * CP + 64) * 2) = f2bf(nacc[dt][0]); }
    const int qtok = TOKC(c, jrow);
    const bool more = (c + 1 < nc);
    __syncthreads();
    const float Mj = T[128 + jrow], bj = T[256 + jrow]; const float rf = __expf(M_last - Mj), w_inter = __expf(mst - Mj);
    int lq_ = (8 * g + (l15 >> 2)), lp_ = 4 * (l15 & 3); asm volatile("" : "+v"(lq_), "+v"(lp_));
    const LP cB = lds + ML_C + (lq_ * CP + lp_) * 2, vB = lds + ML_V + (lq_ * VP + lp_) * 2, kB = lds + ML_K + (lq_ * KP + lp_ + 32 * wid) * 2;
    const LP pB = lds + ML_P + (jrow * PP + 8 * g) * 2;
    for (int st = 0; st <= rt; ++st) {
      f32x4 s = {0.f, 0.f, 0.f, 0.f};
      bf16x8 kfr[8];
#pragma unroll
      for (int kk = 0; kk < 8; ++kk) kfr[kk] = *(const LAS bf16x8*)(lds + ML_K + ((16 * st + l15) * KP + 32 * kk + 8 * g) * 2);
      __builtin_amdgcn_sched_barrier(0);
#pragma unroll
      for (int kk = 0; kk < 8; ++kk) s = __builtin_amdgcn_mfma_f32_16x16x32_bf16(kfr[kk], qf[kk], s, 0, 0, 0);
      float pv[4];
#pragma unroll
      for (int i = 0; i < 4; ++i) pv[i] = ((16 * st + 4 * g + i) <= jrow) ? s[i] * rf : 0.f;
      u32x2 w; w.x = pack2(pv[0], pv[1]); w.y = pack2(pv[2], pv[3]);
      *(LAS u32x2*)(lds + ML_P + (jrow * PP + 16 * st + 4 * g) * 2) = w;
    }
    if ((rt & 1) == 0) { u32x2 z; z.x = 0u; z.y = 0u; *(LAS u32x2*)(lds + ML_P + (jrow * PP + 16 * (rt + 1) + 4 * g) * 2) = z; }
    if (more) ML_LOAD_KV(c + 1);
    asm volatile("s_waitcnt lgkmcnt(0)" ::: "memory");
    f32x4 ha[5];
#pragma unroll
    for (int vt = 0; vt < 5; ++vt) { f32x4 a = {0.f, 0.f, 0.f, 0.f};
      if (smp || c > 0) {
        bf16x8 cfr[8];
#pragma unroll
        for (int kk = 0; kk < 8; ++kk) cfr[kk] = tr_at(cB, (32 * kk * CP + 16 * vt) * 2, CP * 2);
        __builtin_amdgcn_sched_barrier(0);
#pragma unroll
        for (int kk = 0; kk < 8; ++kk) a = __builtin_amdgcn_mfma_f32_16x16x32_bf16(cfr[kk], qf[kk], a, 0, 0, 0);
        a *= w_inter; }
      ha[vt] = a; }
    for (int k2 = 0; k2 <= (rt >> 1); ++k2) {
      const bf16x8 pf = *(const LAS bf16x8*)(pB + k2 * 64);
      bf16x8 vfr[5];
#pragma unroll
      for (int vt = 0; vt < 5; ++vt) vfr[vt] = tr_at(vB + k2 * (32 * VP * 2), (16 * vt) * 2, VP * 2);
      __builtin_amdgcn_sched_barrier(0);
#pragma unroll
      for (int vt = 0; vt < 5; ++vt) ha[vt] = __builtin_amdgcn_mfma_f32_16x16x32_bf16(vfr[vt], pf, ha[vt], 0, 0, 0); }
    { const float den = __shfl(ha[4][0], l15); const float rdd = __builtin_amdgcn_rcpf(fmaxf(fabsf(den), __expf(-(bj + Mj))));
#pragma unroll
      for (int vt = 0; vt < 4; ++vt) { const f32x4 a = ha[vt] * rdd; u32x2 w; w.x = pack2(a[0], a[1]); w.y = pack2(a[2], a[3]);
        *(u32x2*)(hout + (size_t)qtok * 1024 + head * 256 + sl * 64 + 16 * vt + 4 * g) = w; } }
    if (more) ML_LOAD_Q(c + 1);
    const bool need_state = (!smp) || more;
    if (need_state) {
      const float decay = __expf(mst - M_last);
#pragma unroll
      for (int dt = 0; dt < 2; ++dt) {
#pragma unroll
        for (int vt = 0; vt < 4; ++vt) Cacc[dt][vt] *= decay;
        nacc[dt] *= decay; }
#pragma unroll
      for (int ks = 0; ks < 4; ++ks) {
        const bf16x8 kf0 = tr_at(kB, (32 * ks * KP) * 2, KP * 2), kf1 = tr_at(kB, (32 * ks * KP + 16) * 2, KP * 2);
        bf16x8 vfr[5];
#pragma unroll
        for (int vt = 0; vt < 5; ++vt) vfr[vt] = tr_at(vB, (32 * ks * VP + 16 * vt) * 2, VP * 2);
        __builtin_amdgcn_sched_barrier(0);
#pragma unroll
        for (int vt = 0; vt < 4; ++vt) { Cacc[0][vt] = __builtin_amdgcn_mfma_f32_16x16x32_bf16(vfr[vt], kf0, Cacc[0][vt], 0, 0, 0); Cacc[1][vt] = __builtin_amdgcn_mfma_f32_16x16x32_bf16(vfr[vt], kf1, Cacc[1][vt], 0, 0, 0); }
        nacc[0] = __builtin_amdgcn_mfma_f32_16x16x32_bf16(vfr[4], kf0, nacc[0], 0, 0, 0); nacc[1] = __builtin_amdgcn_mfma_f32_16x16x32_bf16(vfr[4], kf1, nacc[1], 0, 0, 0);
      }
    }
    if (wid == 0 && more) { float mn; ML_SCAN(lds + ML_T + ((c + 1) & 1) * ML_TSZ, mw0, mn); mw0 = mn; }
    m_final = T[256 + 127] + M_last;
    __syncthreads();
  }
#undef ML_LOAD_Q
#undef ML_LOAD_KV
#undef ML_SCAN
#undef TOKC
  if (!smp) {
    float* oC = p.out + OUTF_C + (size_t)sidx * 65536;
#pragma unroll
    for (int dt = 0; dt < 2; ++dt) {
#pragma unroll
      for (int vt = 0; vt < 4; ++vt) *(f32x4*)(oC + (size_t)((2 * wid + dt) * 16 + l15) * 256 + sl * 64 + 16 * vt + 4 * g) = Cacc[dt][vt];
      if (sl == 0 && g == 0) p.out[OUTF_N + (size_t)sidx * 256 + (2 * wid + dt) * 16 + l15] = nacc[dt][0]; }
    if (sl == 0 && tid == 0) p.out[OUTF_M + sidx] = m_final;
  }
}

__device__ void combine_rows(const Params& p) {
  const int tid0 = opaque_tid(); const int wid = tid0 >> 6, lane = tid0 & 63;
  bf16_t* H = (bf16_t*)((unsigned char*)p.out + OUT_H); const bf16_t* HB = (const bf16_t*)((unsigned char*)p.out + OUT_HB); const float* nw = p.in[22];
  f32x4 wv[4];
#pragma unroll
  for (int i = 0; i < 4; ++i) wv[i] = *(const f32x4*)(nw + 16 * lane + 4 * i);
  const int nh = (int)gridDim.x >> 1;
  if ((int)blockIdx.x < nh) return;
  for (int unit = (int)blockIdx.x - nh; unit < 768; unit += (int)gridDim.x - nh) {
    const int row0 = unit * 32 + wid * 4;
    u32x4 a[4][2], bq[4][2];
#pragma unroll
    for (int r = 0; r < 4; ++r)
#pragma unroll
      for (int i = 0; i < 2; ++i) { a[r][i] = *(const u32x4*)(H + (size_t)(row0 + r) * 1024 + 16 * lane + 8 * i); bq[r][i] = *(const u32x4*)(HB + (size_t)(row0 + r) * 1024 + 16 * lane + 8 * i); }
#pragma unroll
    for (int r = 0; r < 4; ++r) {
      f32x4 v[4]; float ss = 0.f;
#pragma unroll
      for (int i = 0; i < 2; ++i) { f32x4 x0, x1, y0, y1; unpack8(a[r][i], x0, x1); unpack8(bq[r][i], y0, y1); v[2 * i] = x0 + y0; v[2 * i + 1] = x1 + y1; }
#pragma unroll
      for (int i = 0; i < 4; ++i) ss += v[i][0] * v[i][0] + v[i][1] * v[i][1] + v[i][2] * v[i][2] + v[i][3] * v[i][3];
      ss = row16_sum(ss);
      const float rr = rsqrtf(ss * (1.0f / 256.0f) + 1e-6f);
#pragma unroll
      for (int i = 0; i < 2; ++i) *(u32x4*)(H + (size_t)(row0 + r) * 1024 + 16 * lane + 8 * i) = pack8(v[2 * i] * rr * wv[2 * i], v[2 * i + 1] * rr * wv[2 * i + 1]);
    }
  }
}

constexpr int HY_WAVE = 18816, HY_HR = 0, HY_ZA = 8576, HY_ZB = 8576 + 5120;
__device__ void hyena_item(const Params& p, LP lds, int item) {
  const int tid = opaque_tid(), wid = __builtin_amdgcn_readfirstlane(tid >> 6), lane = tid & 63, n31 = lane & 31, hh = lane >> 5;
  const bool smp = item < 1024; const int it = smp ? item : item - 1024; const int bset = it >> 7, cgp = it & 127; const int c = cgp * 8 + wid;
  const int L = smp ? 2048 : 256, lgL = smp ? 11 : 8, nblk = L >> 5, lgnb = lgL - 5, ntok = 2048, ntile = 2, dmax = L >> 6;
  const int tok0 = smp ? NCTX + bset * 2048 : bset * 2048;
  LP wl = lds + wid * HY_WAVE; LAS float* hr = (LAS float*)(wl + HY_HR);
  const float* HFp = (const float*)(p.ws + (smp ? OFF_HFS : OFF_HFC));
  const bf16_t* UT = (const bf16_t*)(p.ws + OFF_BIG);
  const float* cw = p.in[12]; const float* cbv = p.in[13]; const float* skp = p.in[21];
  { const int uc = 2048 + c; const float w0 = cw[uc], w1 = cw[3072 + uc], w2 = cw[6144 + uc], cb = cbv[uc]; const bf16_t* src = UT + (size_t)uc * NTOK + tok0;
    u32x4 vv[4]; float pvv[4], nxv[4];
#pragma unroll
    for (int i = 0; i < 4; ++i) { const int base = lane * 8 + 512 * i; vv[i] = (u32x4){0u, 0u, 0u, 0u}; pvv[i] = 0.f; nxv[i] = 0.f;
      if (base < ntok) { vv[i] = *(const u32x4*)(src + base); const int tl = base & (L - 1);
        if (tl != 0) pvv[i] = bf2f(src[base - 1]); if (tl + 8 != L) nxv[i] = bf2f(src[base + 8]); } }
#pragma unroll
    for (int i = 0; i < 4; ++i) { const int base = lane * 8 + 512 * i;
      if (base < ntok) { const u32x4 v = vv[i];
        float u[10]; u[0] = pvv[i]; u[1] = bflo(v.x); u[2] = bfhi(v.x); u[3] = bflo(v.y); u[4] = bfhi(v.y); u[5] = bflo(v.z); u[6] = bfhi(v.z); u[7] = bflo(v.w); u[8] = bfhi(v.w); u[9] = nxv[i];
        float o[8];
#pragma unroll
        for (int e = 0; e < 8; ++e) o[e] = cb + w0 * u[e] + w1 * u[e + 1] + w2 * u[e + 2];
        u32x4 w; w.x = pack2(o[0], o[1]); w.y = pack2(o[2], o[3]); w.z = pack2(o[4], o[5]); w.w = pack2(o[6], o[7]);
        *(LAS u32x4*)(wl + HY_ZA + ((base >> 5) * 40 + (base & 31)) * 2) = w; } } }
  const int HRP = L + 96;
  f32x4 fvN[8];
#define HY_FLOAD(o) do { const float* src_ = HFp + (size_t)((o) * 1024 + c) * L; \
    _Pragma("unroll") for (int i = 0; i < 8; ++i) { const int q = lane + 64 * i; fvN[i] = (4 * q < L) ? *(const f32x4*)(src_ + 4 * q) : (f32x4){0.f, 0.f, 0.f, 0.f}; } } while (0)
  HY_FLOAD(0);
  for (int ord = 0; ord < 2; ++ord) {
    { float sa = 0.f;
      f32x4 fv[8];
#pragma unroll
      for (int i = 0; i < 8; ++i) fv[i] = fvN[i];
#pragma unroll
      for (int i = 0; i < 8; ++i) sa += (fabsf(fv[i][0]) + fabsf(fv[i][1])) + (fabsf(fv[i][2]) + fabsf(fv[i][3]));
      sa = wave_sum(sa); const float inv = __builtin_amdgcn_rcpf(sa + 1e-6f);
      asm volatile("s_waitcnt lgkmcnt(0)" ::: "memory");
      LAS bf16_t* E = (LAS bf16_t*)hr; LAS bf16_t* O = E + HRP;
#pragma unroll
      for (int i = 0; i < 8; ++i) { const int q = lane + 64 * i;
        if (4 * q < L) {
#pragma unroll
          for (int e = 0; e < 4; ++e) { const int yy = L - 1 - (4 * q + e); const bf16_t v = f2bf(fv[i][e] * inv); E[32 + yy] = v; O[31 + yy] = v; } } }
      if (lane < 32) { E[lane] = 0; E[32 + L + lane] = 0; O[31 + L + lane] = 0; if (lane < 31) O[lane] = 0; }
      if (lane < 33) O[HRP - 33 + lane] = 0;
      asm volatile("s_waitcnt lgkmcnt(0)" ::: "memory"); }
    if (ord == 0) HY_FLOAD(1);
    LP zin = wl + (ord == 0 ? HY_ZA : HY_ZB); LP zout = wl + (ord == 0 ? HY_ZB : HY_ZA);
    const int gc = ord * 1024 + c; const float w0 = cw[gc], w1 = cw[3072 + gc], w2 = cw[6144 + gc], cb = cbv[gc], sk = skp[ord * 1024 + c];
    const bf16_t* gsrc = UT + (size_t)gc * NTOK + tok0;
    u32x4 gv[4]; unsigned gpv[4], gnx[4];
#pragma unroll
    for (int i = 0; i < 4; ++i) { const int base = lane * 8 + 512 * i; gv[i] = (u32x4){0u, 0u, 0u, 0u}; gpv[i] = 0u; gnx[i] = 0u;
      if (base < ntok) { gv[i] = *(const u32x4*)(gsrc + base); const int tl = base & (L - 1);
        if (tl != 0) gpv[i] = gsrc[base - 1]; if (tl + 8 != L) gnx[i] = gsrc[base + 8]; } }
    f32x16 accs[2];
#pragma unroll
    for (int o2 = 0; o2 < 2; ++o2)
#pragma unroll
      for (int r = 0; r < 16; ++r) accs[o2][r] = 0.f;
    LP fb = wl + HY_HR + ((n31 & 1) ? 0 : (HRP * 2 - 2)) + 2 * ((L >> 1) - 1 - n31 + 8 * hh + 32);
    int cbl[2], ca[2];
#pragma unroll
    for (int ot = 0; ot < 2; ++ot) { const int col = 32 * ot + n31; cbl[ot] = (col >> lgnb) << lgnb; ca[ot] = col & (nblk - 1); }
    const bool two = (ntile == 2);
    {
      LP zero = wl + HY_HR + 16 * hh;
      LP ap = fb + 64 * dmax;
      int bbr0 = ca[0] + dmax, bbr1 = ca[1] + dmax;
      LP bp0 = zin + ((cbl[0] + bbr0) * 40 + 8 * hh) * 2, bp1 = zin + ((cbl[1] + bbr1) * 40 + 8 * hh) * 2;
      for (int d = -dmax; d <= dmax; ++d) {
        u32x4 w0v, w1v;
        w0v.x = *(const LAS unsigned*)(ap); w0v.y = *(const LAS unsigned*)(ap + 4); w0v.z = *(const LAS unsigned*)(ap + 8); w0v.w = *(const LAS unsigned*)(ap + 12);
        w1v.x = *(const LAS unsigned*)(ap + 32); w1v.y = *(const LAS unsigned*)(ap + 36); w1v.z = *(const LAS unsigned*)(ap + 40); w1v.w = *(const LAS unsigned*)(ap + 44);
        const bf16x8 af0 = __builtin_bit_cast(bf16x8, w0v), af1 = __builtin_bit_cast(bf16x8, w1v);
        LP q0 = ((unsigned)bbr0 < (unsigned)nblk) ? bp0 : zero;
        LP q1 = (two && ((unsigned)bbr1 < (unsigned)nblk)) ? bp1 : zero;
        const bf16x8 b00 = *(const LAS bf16x8*)q0, b01 = *(const LAS bf16x8*)(q0 + 32);
        const bf16x8 b10 = *(const LAS bf16x8*)q1, b11 = *(const LAS bf16x8*)(q1 + 32);
        __builtin_amdgcn_sched_barrier(0);
        accs[0] = __builtin_amdgcn_mfma_f32_32x32x16_bf16(af0, b00, accs[0], 0, 0, 0);
        if (two) accs[1] = __builtin_amdgcn_mfma_f32_32x32x16_bf16(af0, b10, accs[1], 0, 0, 0);
        accs[0] = __builtin_amdgcn_mfma_f32_32x32x16_bf16(af1, b01, accs[0], 0, 0, 0);
        if (two) accs[1] = __builtin_amdgcn_mfma_f32_32x32x16_bf16(af1, b11, accs[1], 0, 0, 0);
        ap -= 64; bbr0 -= 1; bbr1 -= 1; bp0 -= 80; bp1 -= 80;
      }
    }
#pragma unroll
    for (int ot = 0; ot < 2; ++ot) {
      if (ot >= ntile) continue;
      const f32x16 acc = accs[ot];
#pragma unroll
      for (int rg = 0; rg < 4; ++rg) {
        const int zo = (((cbl[ot] + ca[ot]) * 40) + 8 * rg + 4 * hh) * 2;
        const u32x2 zv = *(const LAS u32x2*)(zin + zo);
        u32x2 w; w.x = pack2(acc[4 * rg] + sk * bflo(zv.x), acc[4 * rg + 1] + sk * bfhi(zv.x)); w.y = pack2(acc[4 * rg + 2] + sk * bflo(zv.y), acc[4 * rg + 3] + sk * bfhi(zv.y));
        *(LAS u32x2*)(zout + zo) = w;
      }
    }
    asm volatile("s_waitcnt lgkmcnt(0)" ::: "memory");
#pragma unroll
    for (int i = 0; i < 4; ++i) { const int base = lane * 8 + 512 * i;
      if (base < ntok) { const u32x4 v = gv[i];
        float u[10]; u[0] = bf2f(gpv[i]); u[1] = bflo(v.x); u[2] = bfhi(v.x); u[3] = bflo(v.y); u[4] = bfhi(v.y); u[5] = bflo(v.z); u[6] = bfhi(v.z); u[7] = bflo(v.w); u[8] = bfhi(v.w); u[9] = bf2f(gnx[i]);
        LP zp = zout + ((base >> 5) * 40 + (base & 31)) * 2; const u32x4 t = *(const LAS u32x4*)zp;
        float tv[8]; tv[0] = bflo(t.x); tv[1] = bfhi(t.x); tv[2] = bflo(t.y); tv[3] = bfhi(t.y); tv[4] = bflo(t.z); tv[5] = bfhi(t.z); tv[6] = bflo(t.w); tv[7] = bfhi(t.w);
        float o[8];
#pragma unroll
        for (int e = 0; e < 8; ++e) o[e] = (cb + w0 * u[e] + w1 * u[e + 1] + w2 * u[e + 2]) * tv[e];
        u32x4 w; w.x = pack2(o[0], o[1]); w.y = pack2(o[2], o[3]); w.z = pack2(o[4], o[5]); w.w = pack2(o[6], o[7]);
        *(LAS u32x4*)zp = w; } }
    asm volatile("s_waitcnt lgkmcnt(0)" ::: "memory");
  }
  __syncthreads();
  { bf16_t* YH = (bf16_t*)((unsigned char*)p.out + OUT_HB);
    for (int tl = tid; tl < ntok; tl += 512) {
      const int bl = tl >> lgL, tloc = tl & (L - 1); const int zo = ((((bl << lgnb) + (tloc >> 5)) * 40) + (tloc & 31)) * 2;
      unsigned short e[8];
#pragma unroll
      for (int w = 0; w < 8; ++w) e[w] = *(const LAS unsigned short*)(lds + w * HY_WAVE + HY_ZA + zo);
      u32x4 o; o.x = e[0] | ((unsigned)e[1] << 16); o.y = e[2] | ((unsigned)e[3] << 16); o.z = e[4] | ((unsigned)e[5] << 16); o.w = e[6] | ((unsigned)e[7] << 16);
      *(u32x4*)(YH + (size_t)(tok0 + tl) * 1024 + cgp * 8) = o; } }
  __syncthreads();
}

__device__ void final_norm(const Params& p) {
  const int tid0 = opaque_tid(); const int wid = tid0 >> 6, lane = tid0 & 63; const float* fw = p.in[31];
  const float* P = (const float*)(p.ws + OFF_BIG + (size_t)8192 * 4096 * 2); const float* mod = (const float*)(p.ws + OFF_MOD);
  f32x4 wv[4];
#pragma unroll
  for (int i = 0; i < 4; ++i) wv[i] = *(const f32x4*)(fw + 4 * lane + 256 * i);
  for (int unit = blockIdx.x; unit < 768; unit += gridDim.x) {
    const int row0 = unit * 32 + wid * 4; const bool chunkB = row0 >= 16384;
    f32x4 x[4][4];
#pragma unroll
    for (int r = 0; r < 4; ++r)
#pragma unroll
      for (int i = 0; i < 4; ++i) x[r][i] = *(const f32x4*)(p.out + (size_t)(row0 + r) * 1024 + 4 * lane + 256 * i);
    if (chunkB) { const float* md = mod + cond_of_row(row0) * 6144 + 5120;
#pragma unroll
      for (int i = 0; i < 4; ++i) { const f32x4 g2 = *(const f32x4*)(md + 4 * lane + 256 * i);
#pragma unroll
        for (int r = 0; r < 4; ++r) x[r][i] += g2 * *(const f32x4*)(P + (size_t)(row0 + r - 16384) * 1024 + 4 * lane + 256 * i); } }
#pragma unroll
    for (int r = 0; r < 4; ++r) { float ss = 0.f;
#pragma unroll
      for (int i = 0; i < 4; ++i) ss += x[r][i][0] * x[r][i][0] + x[r][i][1] * x[r][i][1] + x[r][i][2] * x[r][i][2] + x[r][i][3] * x[r][i][3];
      ss = wave_sum(ss); const float rstd = rsqrtf(ss * (1.0f / 1024.0f) + 1e-6f);
#pragma unroll
      for (int i = 0; i < 4; ++i) *(f32x4*)(p.out + (size_t)(row0 + r) * 1024 + 4 * lane + 256 * i) = x[r][i] * rstd * wv[i]; }
  }
}

__device__ __forceinline__ int xcd_group_index(int c, int lg) {
  if (gridDim.x != 256u) return c;
  const int xcd = c & 7, slot = c >> 3;
  return ((((slot >> lg) << 3) + xcd) << lg) + (slot & ((1 << lg) - 1));
}
__global__ void __launch_bounds__(512, 2) __attribute__((flatten)) mega(Params p) {
  extern __shared__ __attribute__((aligned(16))) unsigned char shm[];
  LP lds = (LP)shm;
  cg::grid_group grid = cg::this_grid();
  volatile LAS unsigned* xst = (volatile LAS unsigned*)(lds + LDS_BYTES - 16);
  if (threadIdx.x == 0) { xst[0] = 0u; xst[1] = 0u; }
  __syncthreads();
  const XcdBarrier xb = xcd_barrier_post((unsigned*)(p.ws + OFF_BAR), xst);
  unsigned char* ws = p.ws;
  const bf16_t* WT = (const bf16_t*)(ws + OFF_WT); const bf16_t* HN = (const bf16_t*)(ws + OFF_HN); bf16_t* BIG = (bf16_t*)(ws + OFF_BIG);
  bf16_t* Hb = (bf16_t*)((unsigned char*)p.out + OUT_H); bf16_t* YH = (bf16_t*)((unsigned char*)p.out + OUT_HB);
  const float* mod = (const float*)(ws + OFF_MOD);
  phase0(p, lds);
  if (gridDim.y == 7u) grid.sync();
  xcd_barrier(xb);
  phase1(p, lds);
  weight_tiles(p, lds, 0, 384, 0);
  xcd_barrier(xb);
  filters_upper_half(p, lds);
  weight_tiles(p, lds, 384, 768, 1);
  { EpiQKV e; e.O = BIG; e.bias = p.in[11]; run_gemm(lds, HN, WT, NTOK, 3072, 1024, e); }
  xcd_barrier(xb);
  for (int item = xcd_group_index((int)blockIdx.x, 2); item < 1280; item += gridDim.x) mlstm_item(p, lds, item);
  xcd_barrier(xb);
  combine_rows(p);
  weight_tiles(p, lds, 768, 1152, 1);
  { EpiUT e; e.O = BIG; e.bias = p.in[11] + 4112; run_gemm(lds, WT + (size_t)3072 * 1024, HN, 3072, NTOK, 1024, e); }
  xcd_barrier(xb);
  for (int item = xcd_group_index((int)blockIdx.x, 3); item < 1536; item += gridDim.x) hyena_item(p, lds, item);
  xcd_barrier(xb);
  c1_upper_half(p, lds);
  weight_tiles(p, lds, 1152, 1536, 1);
  { EpiGates e; e.H = Hb; e.G = BIG; e.b_in = p.in[11]; run_gemm(lds, HN, WT + (size_t)6144 * 1024, NTOK, 3072, 1024, e); }
  xcd_barrier(xb);
  bf16_t* T = BIG + (size_t)NTOK * 2048;
  weight_tiles(p, lds, 1536, 2560, 1);
  { EpiMerge<0> e; e.T = T; e.G = BIG; run_gemm(lds, Hb, (const bf16_t*)(ws + OFF_WBM), NTOK, 1024, 1024, e); }
  { EpiMerge<1> e; e.T = T; e.G = BIG; run_gemm(lds, YH, (const bf16_t*)(ws + OFF_WBH), NTOK, 1024, 1024, e); }
  xcd_barrier(xb);
  { EpiOut e; e.xp = p.in[0]; e.xs = p.in[1]; e.per = (const float*)(ws + OFF_PER); e.pec = (const float*)(ws + OFF_PEC); e.mod = mod; e.n2w = p.in[26];
    e.X1 = p.out; e.A2 = (bf16_t*)(ws + OFF_HN); e.ssq = (float*)(ws + OFF_SSQ1); run_gemm(lds, T, (const bf16_t*)(ws + OFF_WOUT), NTOK, 1024, 1024, e); }
  xcd_barrier(xb);
  constexpr int ROWS_A = 16384, ROWS_B = NTOK - ROWS_A;
  { EpiFF1 e; e.row0 = 0; e.ssq = (const float*)(p.ws + OFF_SSQ1); e.c1 = (const float*)(p.ws + OFF_C1); e.Hd = (bf16_t*)(p.ws + OFF_BIG);
    run_gemm(lds, (const bf16_t*)(p.ws + OFF_HN), (const bf16_t*)(p.ws + OFF_W1T), ROWS_A, 4096, 1024, e); }
  xcd_barrier(xb);
  { EpiFF2 e; e.row0 = 0; e.mod = (const float*)(p.ws + OFF_MOD); e.b2 = p.in[30]; e.X = p.out; e.P = (float*)(p.ws + OFF_BIG + (size_t)ROWS_A * 4096 * 2);
    run_gemm(lds, (const bf16_t*)(p.ws + OFF_BIG), (const bf16_t*)(p.ws + OFF_W2T), ROWS_A, 1024, 4096, e); }
  xcd_barrier(xb);
  { EpiFF1 e; e.row0 = ROWS_A; e.ssq = (const float*)(p.ws + OFF_SSQ1); e.c1 = (const float*)(p.ws + OFF_C1); e.Hd = (bf16_t*)(p.ws + OFF_BIG);
    run_gemm(lds, (const bf16_t*)(p.ws + OFF_HN) + (size_t)ROWS_A * 1024, (const bf16_t*)(p.ws + OFF_W1T), ROWS_B, 4096, 1024, e); }
  xcd_barrier(xb);
  { EpiFF2 e; e.row0 = ROWS_A; e.mod = (const float*)(p.ws + OFF_MOD); e.b2 = p.in[30]; e.X = p.out; e.P = (float*)(p.ws + OFF_BIG + (size_t)ROWS_B * 4096 * 2);
    run_gemm(lds, (const bf16_t*)(p.ws + OFF_BIG), (const bf16_t*)(p.ws + OFF_W2T), ROWS_B, 1024, 4096, e, 2); }
  xcd_barrier(xb);
  final_norm(p);
}

extern "C" void kernel_launch(void* const* d_in, const int* in_sizes, int n_in, void* d_out, int out_size, void* d_ws, size_t ws_size, hipStream_t stream) {
  static int grid_blocks = 0;
  if (!grid_blocks) {
    int dev = 0, cus = 0, per_cu = 0;
    hipGetDevice(&dev);
    hipDeviceGetAttribute(&cus, hipDeviceAttributeMultiprocessorCount, dev);
    hipFuncSetAttribute((const void*)mega, hipFuncAttributeMaxDynamicSharedMemorySize, LDS_BYTES);
    hipOccupancyMaxActiveBlocksPerMultiprocessor(&per_cu, (const void*)mega, 512, LDS_BYTES);
    if (per_cu < 1) { fprintf(stderr, "kernel_launch: occupancy query reports %d blocks per CU\n", per_cu); grid_blocks = -1; }
    else grid_blocks = cus;
    if (n_in != 32 || ws_size < WS_END) { fprintf(stderr, "kernel_launch: unexpected n_in %d / ws_size %zu (need %zu)\n", n_in, ws_size, (size_t)WS_END); grid_blocks = -1; }
  }
  if (grid_blocks < 0) return;
  hipMemsetAsync((unsigned char*)d_ws + OFF_BAR, 0, 3456 * 4, stream);
  Params p{};
  for (int i = 0; i < 32; ++i) p.in[i] = (const float*)d_in[i];
  p.out = (float*)d_out; p.ws = (unsigned char*)d_ws;
  void* args[] = {&p};
  hipError_t e = hipLaunchCooperativeKernel((void*)mega, dim3(grid_blocks), dim3(512), args, LDS_BYTES, stream);
  if (e != hipSuccess) fprintf(stderr, "cooperative launch failed: %s (grid %d)\n", hipGetErrorString(e), grid_blocks);
}
```

```cpp
#include <hip/hip_runtime.h>
#include <hip/hip_cooperative_groups.h>
#include <cstdio>
#include <cstdint>
namespace cg = cooperative_groups;

#define LAS __attribute__((address_space(3)))
typedef LAS unsigned char* LP;
typedef unsigned short bf16_t;
typedef short bf16x8 __attribute__((ext_vector_type(8)));
typedef short s16x4 __attribute__((ext_vector_type(4)));
typedef float f32x4 __attribute__((ext_vector_type(4)));
typedef float f32x16 __attribute__((ext_vector_type(16)));
typedef unsigned u32x4 __attribute__((ext_vector_type(4)));
typedef unsigned u32x2 __attribute__((ext_vector_type(2)));

constexpr int DM = 1024, NTOK = 24576, NCTX = 8192, SEQC = 256, SEQS = 2048, INC = 9232;
constexpr int LDS_BYTES = 160 * 1024;
constexpr size_t OFF_WT = 0;
constexpr size_t OFF_WBM = 18874368, OFF_WBH = 20971520, OFF_WOUT = 23068672, OFF_W1T = 25165824, OFF_W2T = 33554432;
constexpr size_t OFF_HN = 41943040;
constexpr size_t OFF_BIG = 92274688;
constexpr size_t OFF_SM = 243269632;
constexpr size_t OFF_MOD = OFF_SM;
constexpr size_t OFF_C1 = OFF_MOD + 221184;
constexpr size_t OFF_H2S = OFF_C1 + 147456;
constexpr size_t OFF_H2C = OFF_H2S + 524288;
constexpr size_t OFF_PER = OFF_H2C + 65536;
constexpr size_t OFF_PEC = OFF_PER + 65536;
constexpr size_t OFF_GT = OFF_PEC + 131072;
constexpr size_t OFF_SSQ1 = OFF_GT + 1572864;
constexpr size_t OFF_SSQ2 = OFF_SSQ1 + 1572864;
constexpr size_t OFF_HFS = OFF_SSQ2 + 1572864;
constexpr size_t OFF_HFC = OFF_HFS + 16777216;
constexpr size_t OFF_BAR = OFF_HFC + 2097152;
constexpr size_t WS_END = OFF_BAR + 3456 * 4;
constexpr size_t OUT_H = 0, OUT_HB = 50331648;
constexpr size_t OUTF_C = 25165824, OUTF_N = 41943040, OUTF_M = 42008576;

struct Params { const float* in[32]; float* out; unsigned char* ws; };

typedef float f32x2 __attribute__((ext_vector_type(2)));
typedef __bf16 bf16x2v __attribute__((ext_vector_type(2)));
__device__ __forceinline__ bf16_t f2bf(float f) { const __bf16 b = (__bf16)f; return __builtin_bit_cast(unsigned short, b); }
__device__ __forceinline__ float bf2f(unsigned b) { return __uint_as_float(b << 16); }
__device__ __forceinline__ unsigned pack2(float lo, float hi) { const f32x2 v = {lo, hi}; const bf16x2v r = __builtin_convertvector(v, bf16x2v); return __builtin_bit_cast(unsigned, r); }
__device__ __forceinline__ float bflo(unsigned w) { return __uint_as_float(w << 16); }
__device__ __forceinline__ float bfhi(unsigned w) { return __uint_as_float(w & 0xffff0000u); }
__device__ __forceinline__ float sigmoidf_(float x) { return __builtin_amdgcn_rcpf(1.0f + __expf(-x)); }
__device__ __forceinline__ int opaque_tid() { int t = threadIdx.x; asm volatile("" : "+v"(t)); return t; }
template <int CTRL> __device__ __forceinline__ float dppf(float x) { return __builtin_bit_cast(float, __builtin_amdgcn_mov_dpp(__builtin_bit_cast(int, x), CTRL, 0xf, 0xf, true)); }
constexpr int DPP_XOR1 = 0xB1, DPP_XOR2 = 0x4E, DPP_HMIR = 0x141, DPP_ROR8 = 0x128;
__device__ __forceinline__ float row16_sum(float v) { v += dppf<DPP_XOR1>(v); v += dppf<DPP_XOR2>(v); v += dppf<DPP_HMIR>(v); v += dppf<DPP_ROR8>(v); return v; }
__device__ __forceinline__ float xrow16_sum(float x) {
  auto s = __builtin_amdgcn_permlane16_swap(__float_as_uint(x), __float_as_uint(x), false, false);
  x = __uint_as_float(s[0]) + __uint_as_float(s[1]);
  auto t = __builtin_amdgcn_permlane32_swap(__float_as_uint(x), __float_as_uint(x), false, false);
  return __uint_as_float(t[0]) + __uint_as_float(t[1]);
}
__device__ __forceinline__ float wave_sum(float v) { return xrow16_sum(row16_sum(v)); }

#define XB_TMO      128
#define XB_XCNT(j)  (256  + 64 * (j))
#define XB_XSUB(j)  (1280 + 64 * (j))
#define XB_XGEN(j)  (2304 + 64 * (j))
#define XB_TOP      3328
#define XB_TOPGEN   3392
#define XCD_BAR_WORDS 3456
#define XB_SPIN_CAP (1u << 18)
__device__ __forceinline__ unsigned xb_ld(unsigned* p)              { return __hip_atomic_load(p, __ATOMIC_RELAXED, __HIP_MEMORY_SCOPE_AGENT); }
__device__ __forceinline__ unsigned xb_add(unsigned* p, unsigned v) { return __hip_atomic_fetch_add(p, v, __ATOMIC_RELAXED, __HIP_MEMORY_SCOPE_AGENT); }
__device__ __forceinline__ unsigned xb_xcc_id() { return (unsigned)__builtin_amdgcn_s_getreg((3 << 11) | 20) & 0xFu; }
#define XB_SPIN(cond, bar) do { unsigned _sp = 0; while (cond) { __builtin_amdgcn_s_sleep(1); \
    if ((++_sp & 255u) == 0u) { if (xb_ld(&(bar)[XB_TMO])) break; if (_sp > XB_SPIN_CAP) { atomicAdd(&(bar)[XB_TMO], 1u); break; } } } } while (0)
struct XcdBarrier { unsigned* bar; unsigned x; volatile LAS unsigned* st; };
__device__ __forceinline__ XcdBarrier xcd_barrier_post(unsigned* bar, volatile LAS unsigned* st) {
  XcdBarrier b; b.bar = bar; b.x = xb_xcc_id(); b.st = st;
  if (threadIdx.x == 0) (void)xb_add(&bar[XB_XCNT(b.x)], 1u);
  return b;
}
__device__ __forceinline__ void xcd_barrier_complete(unsigned* bar, unsigned x, unsigned& nloc, unsigned& nx) {
  const unsigned G = gridDim.x * gridDim.y * gridDim.z;
  unsigned sum, cnt, mine, sp = 0u;
  for (;;) {
    sum = 0u; cnt = 0u; mine = 0u;
#pragma unroll
    for (unsigned j = 0; j < 16; ++j) { const unsigned c = xb_ld(&bar[XB_XCNT(j)]); sum += c; cnt += (c > 0u) ? 1u : 0u; mine = (j == x) ? c : mine; }
    if (sum == G) break;
    __builtin_amdgcn_s_sleep(1);
    if ((++sp & 255u) == 0u) { if (xb_ld(&bar[XB_TMO])) break; if (sp > XB_SPIN_CAP) { atomicAdd(&bar[XB_TMO], 1u); break; } }
  }
  nloc = mine > 0u ? mine : 1u; nx = cnt > 0u ? cnt : 1u;
}
__device__ __forceinline__ void xcd_barrier(const XcdBarrier& b) {
  asm volatile("s_waitcnt vmcnt(0)" ::: "memory");
  __syncthreads();
  if (threadIdx.x == 0) {
    unsigned* bar = b.bar;
    __builtin_amdgcn_s_waitcnt(0);
    unsigned nloc = b.st[0], nx = b.st[1];
    if (nloc == 0u) { xcd_barrier_complete(bar, b.x, nloc, nx); b.st[0] = nloc; b.st[1] = nx; }
    const unsigned old = xb_add(&bar[XB_XSUB(b.x)], 1u);
    const unsigned gen = old / nloc;
    if (old + 1u == (gen + 1u) * nloc) {
      __builtin_amdgcn_fence(__ATOMIC_RELEASE, "agent");
      asm volatile("s_waitcnt vmcnt(0)" ::: "memory");
      const unsigned og = xb_add(&bar[XB_TOP], 1u);
      const unsigned tg = og / nx;
      if (og + 1u == (tg + 1u) * nx) xb_add(&bar[XB_TOPGEN], 1u);
      else XB_SPIN(xb_ld(&bar[XB_TOPGEN]) == tg, bar);
      __builtin_amdgcn_fence(__ATOMIC_ACQUIRE, "agent");
      xb_add(&bar[XB_XGEN(b.x)], 1u);
      asm volatile("s_waitcnt vmcnt(0)" ::: "memory");
    } else {
      XB_SPIN(xb_ld(&bar[XB_XGEN(b.x)]) == gen, bar);
      __builtin_amdgcn_fence(__ATOMIC_ACQUIRE, "agent");
      asm volatile("s_waitcnt vmcnt(0)" ::: "memory");
    }
  }
  __syncthreads();
}

namespace pg8 {
constexpr int BM = 256, BK = 64, HALF = 128, HTB = HALF * BK * 2, STAGE_BYTES = 8 * HTB, NXCD = 8, WGM = 8;
__host__ __device__ __forceinline__ int lds_byte(int r, int c) { const int st = (r >> 4) * 2 + (c >> 5), rr = r & 15, cc = c & 31, ob = rr * 64 + cc * 2; return st * 1024 + (ob ^ (((ob >> 9) & 1) << 5)); }
__host__ __device__ __forceinline__ void stage_rc(int b, int& R, int& C) { const int st = b / 1024, sb = b % 1024, swz = sb ^ (((sb >> 9) & 1) << 5); R = (st >> 1) * 16 + swz / 64; C = (st & 1) * 32 + (swz % 64) / 2; }
__host__ __device__ __forceinline__ int perm32(int rho) { const int n = rho >> 4, i = rho & 15; return 8 * (i >> 2) + 4 * n + (i & 3); }
struct Unit { int pm, pn, ks; };
struct Gemm { const bf16_t* A; const bf16_t* Bt; int M, N, K, ld, nks; };
struct StaticOrder {
  int nM, nN, ntile, nwg, G, c;
  __device__ void init(int M, int N, int nks, int G_, int c_) { nM = M / BM; nN = N / BM; ntile = nM * nN; nwg = ntile * nks; G = G_; c = c_; }
  __device__ bool next(int i, Unit& u) const {
    const long L = (long)i * G + c; if (L >= nwg) return false;
    u.ks = (int)L / ntile; int wgid = (int)L - u.ks * ntile;
    { const int q = ntile / NXCD, r = ntile % NXCD, xcd = wgid % NXCD, off = wgid / NXCD; wgid = (xcd < r ? xcd * (q + 1) : r * (q + 1) + (xcd - r) * q) + off; }
    const int nig = WGM * nN, gid = wgid / nig, fm = gid * WGM, gsz = (nM - fm) < WGM ? (nM - fm) : WGM;
    u.pm = fm + ((wgid % nig) % gsz); u.pn = (wgid % nig) / gsz; return true;
  }
};

template <class Epi>
__device__ __forceinline__ void gemm_phase(LP lds, const Gemm g, const StaticOrder& S, const Epi& E) {
  int tid_ = threadIdx.x; asm volatile("" : "+v"(tid_));
  const int tid = tid_, wid = __builtin_amdgcn_readfirstlane(tid >> 6), lane = tid & 63, wr = wid >> 2, wc = wid & 3, fr = lane & 15, fq = lane >> 4;
  const int K = g.ld, nt = g.K / BK;
  const size_t ksb = (size_t)g.K * 2;
  unsigned voffA[2], voffB[2];
#pragma unroll
  for (int i = 0; i < 2; ++i) { int R, C; stage_rc(tid * 16 + i * 8192, R, C); const int Rb = (R & ~31) + perm32(R & 31); voffA[i] = (unsigned)(R * K + C) * 2u; voffB[i] = (unsigned)(Rb * K + C) * 2u; }
  const size_t kstep = (size_t)(BK * 2);
  const size_t hstep = (size_t)HALF * K * 2;
  const size_t tstep = 2 * hstep;
  const unsigned ldsw = (unsigned)wid * 1024u;
  const int aoff = lds_byte(wr * 64 + fr, fq * 8), boff = lds_byte(wc * 32 + fr, fq * 8);
#define PG8_SA(b, h) (((b) * 2 + (h)) * HTB)
#define PG8_SB(b, h) ((4 + (b) * 2 + (h)) * HTB)
#define PG8_STAGE(bufoff, gbase, voff) do { _Pragma("unroll") for (int _i = 0; _i < 2; ++_i) \
    __builtin_amdgcn_global_load_lds((const unsigned*)((const char*)(gbase) + (voff)[_i]), (LAS unsigned*)(lds + (bufoff) + ldsw + _i * 8192), 16, 0, 0); } while (0)
#define PG8_LDA(dst, b, h) do { _Pragma("unroll") for (int m = 0; m < 4; ++m) _Pragma("unroll") for (int k = 0; k < 2; ++k) dst[m][k] = *(const LAS bf16x8*)(lds + PG8_SA(b, h) + aoff + m * 2048 + k * 1024); } while (0)
#define PG8_LDB(dst, b, h) do { _Pragma("unroll") for (int n = 0; n < 2; ++n) _Pragma("unroll") for (int k = 0; k < 2; ++k) dst[n][k] = *(const LAS bf16x8*)(lds + PG8_SB(b, h) + boff + n * 2048 + k * 1024); } while (0)
#define PG8_MMA(ai, bj, At, Bt) do { __builtin_amdgcn_s_setprio(1); _Pragma("unroll") for (int m = 0; m < 4; ++m) _Pragma("unroll") for (int n = 0; n < 2; ++n) _Pragma("unroll") for (int k = 0; k < 2; ++k) \
    acc[ai][bj][m][n] = __builtin_amdgcn_mfma_f32_16x16x32_bf16(Bt[n][k], At[m][k], acc[ai][bj][m][n], 0, 0, 0); __builtin_amdgcn_s_setprio(0); } while (0)
#define PG8_WAIT_V(n) asm volatile("s_waitcnt vmcnt(" #n ")" ::: "memory")
#define PG8_WAIT_L(n) asm volatile("s_waitcnt lgkmcnt(" #n ")" ::: "memory")
#define PG8_BAR __builtin_amdgcn_s_barrier()
#define PG8_SCHED __builtin_amdgcn_sched_barrier(0)
  Unit cur, nxt; int ui = 0;
  if (!S.next(0, cur)) return;
  f32x4 acc[2][2][4][2];
#pragma unroll
  for (int a = 0; a < 2; ++a)
#pragma unroll
    for (int b = 0; b < 2; ++b)
#pragma unroll
      for (int m = 0; m < 4; ++m)
#pragma unroll
        for (int n = 0; n < 2; ++n) acc[a][b][m][n] = (f32x4){0.f, 0.f, 0.f, 0.f};
  bf16x8 At[4][2], B0[2][2], B1[2][2];
  const char* cA = (const char*)g.A + (size_t)cur.pm * tstep + cur.ks * ksb; const char* cB = (const char*)g.Bt + (size_t)cur.pn * tstep + cur.ks * ksb;
  PG8_STAGE(PG8_SB(0, 0), cB, voffB); PG8_STAGE(PG8_SB(0, 1), cB + hstep, voffB); PG8_STAGE(PG8_SA(0, 0), cA, voffA); PG8_STAGE(PG8_SA(0, 1), cA + hstep, voffA);
  if (wr == 1) PG8_BAR;
  PG8_WAIT_V(2); PG8_BAR;
  PG8_STAGE(PG8_SB(1, 0), cB + kstep, voffB); PG8_STAGE(PG8_SA(1, 0), cA + kstep, voffA); PG8_STAGE(PG8_SB(1, 1), cB + hstep + kstep, voffB);
  PG8_WAIT_V(6); PG8_BAR;
  for (;;) {
    const bool has_next = S.next(ui + 1, nxt);
    const char* nA = has_next ? (const char*)g.A + (size_t)nxt.pm * tstep + nxt.ks * ksb : cA; const char* nB = has_next ? (const char*)g.Bt + (size_t)nxt.pn * tstep + nxt.ks * ksb : cB;
    for (int t = 0; t < nt; t += 2) {
      const bool last = (t == nt - 2);
      const char* a1 = cA + (size_t)(t + 1) * kstep;
      const char* a2 = last ? nA : cA + (size_t)(t + 2) * kstep; const char* b2 = last ? nB : cB + (size_t)(t + 2) * kstep;
      const char* a3 = a2 + kstep; const char* b3 = b2 + kstep;
      PG8_LDB(B0, 0, 0); PG8_LDB(B1, 0, 1); PG8_SCHED; PG8_LDA(At, 0, 0); PG8_STAGE(PG8_SA(1, 1), a1 + hstep, voffA);
      PG8_WAIT_V(8); PG8_WAIT_L(0); PG8_BAR; PG8_MMA(0, 0, At, B0); PG8_MMA(0, 1, At, B1); PG8_BAR; PG8_SCHED;
      PG8_LDA(At, 0, 1); PG8_STAGE(PG8_SB(0, 0), b2, voffB); PG8_STAGE(PG8_SB(0, 1), b2 + hstep, voffB); PG8_STAGE(PG8_SA(0, 0), a2, voffA);
      PG8_WAIT_V(8); PG8_WAIT_L(0); PG8_BAR; PG8_MMA(1, 0, At, B0); PG8_MMA(1, 1, At, B1); PG8_BAR; PG8_SCHED;
      PG8_LDB(B0, 1, 0); PG8_LDB(B1, 1, 1); PG8_SCHED; PG8_LDA(At, 1, 0); PG8_STAGE(PG8_SA(0, 1), a2 + hstep, voffA);
      PG8_WAIT_V(8); PG8_WAIT_L(0); PG8_BAR; PG8_MMA(0, 0, At, B0); PG8_MMA(0, 1, At, B1); PG8_BAR; PG8_SCHED;
      PG8_LDA(At, 1, 1); PG8_STAGE(PG8_SB(1, 0), b3, voffB); PG8_STAGE(PG8_SB(1, 1), b3 + hstep, voffB); PG8_STAGE(PG8_SA(1, 0), a3, voffA);
      PG8_WAIT_V(8); PG8_WAIT_L(0); PG8_BAR; PG8_MMA(1, 0, At, B0); PG8_MMA(1, 1, At, B1); PG8_BAR; PG8_SCHED;
    }
    if (wr == 0) PG8_BAR;
    { int fr2 = fr, fq2 = fq; asm volatile("" : "+v"(fr2), "+v"(fq2)); E(acc, cur, wr, wc, fr2, fq2); }
    if (!has_next) break;
#pragma unroll
    for (int a = 0; a < 2; ++a)
#pragma unroll
      for (int b = 0; b < 2; ++b)
#pragma unroll
        for (int m = 0; m < 4; ++m)
#pragma unroll
          for (int n = 0; n < 2; ++n) acc[a][b][m][n] = (f32x4){0.f, 0.f, 0.f, 0.f};
    cur = nxt; cA = nA; cB = nB; ++ui;
    if (wr == 1) PG8_BAR;
  }
  PG8_WAIT_V(0);
  PG8_BAR;
#undef PG8_SA
#undef PG8_SB
#undef PG8_STAGE
#undef PG8_LDA
#undef PG8_LDB
#undef PG8_MMA
#undef PG8_WAIT_V
#undef PG8_WAIT_L
#undef PG8_BAR
#undef PG8_SCHED
}
}
using pg8::Unit;
typedef f32x4 AccT[2][2][4][2];

#define EPI_ROW(ai, m) (u.pm * 256 + (ai) * 128 + wr * 64 + (m) * 16 + fr)
#define EPI_COL(bj, n) (u.pn * 256 + (bj) * 128 + wc * 32 + 8 * fq + 4 * (n))
#define EPI_LOOP_ROWS _Pragma("unroll") for (int ai = 0; ai < 2; ++ai) _Pragma("unroll") for (int m = 0; m < 4; ++m)
#define EPI_LOOP_COLS _Pragma("unroll") for (int bj = 0; bj < 2; ++bj) _Pragma("unroll") for (int n = 0; n < 2; ++n)

__device__ __forceinline__ int cond_of_row(int row) { return row < NCTX ? 0 : 1 + ((row - NCTX) >> 11); }

#define EPI_LOOP_BJ _Pragma("unroll") for (int bj = 0; bj < 2; ++bj)
__device__ __forceinline__ u32x4 pack8(const f32x4 v0, const f32x4 v1) { u32x4 w; w.x = pack2(v0[0], v0[1]); w.y = pack2(v0[2], v0[3]); w.z = pack2(v1[0], v1[1]); w.w = pack2(v1[2], v1[3]); return w; }
__device__ __forceinline__ void unpack8(const u32x4 w, f32x4& v0, f32x4& v1) { v0[0] = bflo(w.x); v0[1] = bfhi(w.x); v0[2] = bflo(w.y); v0[3] = bfhi(w.y); v1[0] = bflo(w.z); v1[1] = bfhi(w.z); v1[2] = bflo(w.w); v1[3] = bfhi(w.w); }
struct EpiQKV {
  bf16_t* O; const float* bias;
  __device__ __forceinline__ void operator()(const AccT& acc, const Unit& u, int wr, int wc, int fr, int fq) const {
    const float sc = (u.pn < 4) ? 0.0625f : 1.0f;
    f32x4 bv[2][2];
    EPI_LOOP_COLS { bv[bj][n] = *(const f32x4*)(bias + EPI_COL(bj, n)); }
    EPI_LOOP_ROWS { const int row = EPI_ROW(ai, m);
      EPI_LOOP_BJ { *(u32x4*)(O + (size_t)row * 3072 + EPI_COL(bj, 0)) = pack8((acc[ai][bj][m][0] + bv[bj][0]) * sc, (acc[ai][bj][m][1] + bv[bj][1]) * sc); } }
  }
};
struct EpiUT {
  bf16_t* O; const float* bias;
  __device__ __forceinline__ void operator()(const AccT& acc, const Unit& u, int wr, int wc, int fr, int fq) const {
    EPI_LOOP_ROWS { const int row = EPI_ROW(ai, m); const float bv = bias[row];
      EPI_LOOP_BJ { *(u32x4*)(O + (size_t)row * NTOK + EPI_COL(bj, 0)) = pack8(acc[ai][bj][m][0] + bv, acc[ai][bj][m][1] + bv); } }
  }
};
struct EpiGates {
  bf16_t* H; bf16_t* G; const float* b_in;
  __device__ __forceinline__ void operator()(const AccT& acc, const Unit& u, int wr, int wc, int fr, int fq) const {
    const bool og = u.pn < 4;
    f32x4 bv[2][2];
    EPI_LOOP_COLS { const int col = EPI_COL(bj, n); bv[bj][n] = *(const f32x4*)(b_in + (og ? 3072 + col : 7184 + (col - 1024))); }
#pragma unroll
    for (int ai = 0; ai < 2; ++ai)
#pragma unroll
      for (int m2 = 0; m2 < 2; ++m2) {
        u32x4 hv[2][2];
        if (og) {
#pragma unroll
          for (int mm = 0; mm < 2; ++mm) { const int row = EPI_ROW(ai, 2 * m2 + mm); EPI_LOOP_BJ { hv[mm][bj] = *(const u32x4*)(H + (size_t)row * 1024 + EPI_COL(bj, 0)); } } }
#pragma unroll
        for (int mm = 0; mm < 2; ++mm) { const int m = 2 * m2 + mm; const int row = EPI_ROW(ai, m);
          EPI_LOOP_BJ { const int col = EPI_COL(bj, 0); f32x4 s0, s1; const f32x4 a0 = acc[ai][bj][m][0] + bv[bj][0], a1 = acc[ai][bj][m][1] + bv[bj][1];
#pragma unroll
            for (int e = 0; e < 4; ++e) { s0[e] = sigmoidf_(a0[e]); s1[e] = sigmoidf_(a1[e]); }
            if (og) { f32x4 h0, h1; unpack8(hv[mm][bj], h0, h1); *(u32x4*)(H + (size_t)row * 1024 + col) = pack8(h0 * s0, h1 * s1); }
            else *(u32x4*)(G + (size_t)row * 2048 + (col - 1024)) = pack8(s0, s1); } } }
  }
};
template <int SECOND> struct EpiMerge {
  bf16_t* T; const bf16_t* G;
  __device__ __forceinline__ void operator()(const AccT& acc, const Unit& u, int wr, int wc, int fr, int fq) const {
#pragma unroll
    for (int ai = 0; ai < 2; ++ai)
#pragma unroll
      for (int m2 = 0; m2 < 2; ++m2) {
        u32x4 gv[2][2], tv[2][2];
#pragma unroll
        for (int mm = 0; mm < 2; ++mm) { const int row = EPI_ROW(ai, 2 * m2 + mm);
          EPI_LOOP_BJ { const int col = EPI_COL(bj, 0); gv[mm][bj] = *(const u32x4*)(G + (size_t)row * 2048 + SECOND * 1024 + col);
            if (SECOND) tv[mm][bj] = *(const u32x4*)(T + (size_t)row * 1024 + col); } }
#pragma unroll
        for (int mm = 0; mm < 2; ++mm) { const int m = 2 * m2 + mm; const int row = EPI_ROW(ai, m);
          EPI_LOOP_BJ { const int col = EPI_COL(bj, 0); f32x4 g0, g1; unpack8(gv[mm][bj], g0, g1);
            f32x4 v0 = g0 * acc[ai][bj][m][0], v1 = g1 * acc[ai][bj][m][1];
            if (SECOND) { f32x4 t0, t1; unpack8(tv[mm][bj], t0, t1); v0 += t0; v1 += t1; }
            *(u32x4*)(T + (size_t)row * 1024 + col) = pack8(v0, v1); } } }
  }
};
struct EpiOut {
  const float* xp; const float* xs; const float* per; const float* pec; const float* mod; const float* n2w; float* X1; bf16_t* A2; float* ssq;
  __device__ __forceinline__ void operator()(const AccT& acc, const Unit& u, int wr, int wc, int fr, int fq) const {
    const int cb = cond_of_row(u.pm * 256); const float* md = mod + cb * 6144; const bool smp = (u.pm * 256) >= NCTX;
    f32x4 g1v[2][2], k2v[2][2];
    EPI_LOOP_COLS { const int col = EPI_COL(bj, n); g1v[bj][n] = *(const f32x4*)(md + 2048 + col); k2v[bj][n] = *(const f32x4*)(n2w + col) * (*(const f32x4*)(md + 4096 + col) + 1.0f); }
    EPI_LOOP_ROWS { const int row = EPI_ROW(ai, m); float ss = 0.f;
#pragma unroll
      for (int bj = 0; bj < 2; ++bj) {
        f32x4 x0[2];
        if (!smp) {
#pragma unroll
          for (int n = 0; n < 2; ++n) x0[n] = *(const f32x4*)(xp + (size_t)row * 1024 + EPI_COL(bj, n)); }
        else { const int r2 = row - NCTX, t = r2 & 2047; f32x4 pe[2];
#pragma unroll
          for (int n = 0; n < 2; ++n) { const int col = EPI_COL(bj, n); x0[n] = *(const f32x4*)(xs + (size_t)r2 * 1024 + col);
            pe[n] = (col < 512) ? *(const f32x4*)(per + (t >> 6) * 512 + col) : *(const f32x4*)(pec + (t & 63) * 512 + (col - 512)); }
#pragma unroll
          for (int n = 0; n < 2; ++n) x0[n] += pe[n]; }
        f32x4 x1[2];
#pragma unroll
        for (int n = 0; n < 2; ++n) { x1[n] = x0[n] + g1v[bj][n] * acc[ai][bj][m][n]; *(f32x4*)(X1 + (size_t)row * 1024 + EPI_COL(bj, n)) = x1[n];
          ss += x1[n][0] * x1[n][0] + x1[n][1] * x1[n][1] + x1[n][2] * x1[n][2] + x1[n][3] * x1[n][3]; }
        *(u32x4*)(A2 + (size_t)row * 1024 + EPI_COL(bj, 0)) = pack8(x1[0] * k2v[bj][0], x1[1] * k2v[bj][1]); }
      ss = xrow16_sum(ss);
      if (fq == 0) ssq[(size_t)row * 16 + u.pn * 4 + wc] = ss; }
  }
};
struct EpiFF1 {
  int row0; const float* ssq; const float* c1; bf16_t* Hd;
  __device__ __forceinline__ void operator()(const AccT& acc, const Unit& u, int wr, int wc, int fr, int fq) const {
    const int cb = cond_of_row(row0 + u.pm * 256); const float* cc = c1 + cb * 4096;
    f32x4 cv[2][2];
    EPI_LOOP_COLS { cv[bj][n] = *(const f32x4*)(cc + EPI_COL(bj, n)); }
    float rs[2][4];
    EPI_LOOP_ROWS { const float* sp = ssq + (size_t)(row0 + EPI_ROW(ai, m)) * 16;
      const f32x4 st = (*(const f32x4*)sp + *(const f32x4*)(sp + 4)) + (*(const f32x4*)(sp + 8) + *(const f32x4*)(sp + 12));
      rs[ai][m] = rsqrtf((st[0] + st[1] + st[2] + st[3]) * (1.0f / 1024.0f) + 1e-6f); }
    EPI_LOOP_ROWS { const int rl = EPI_ROW(ai, m); const float rstd = rs[ai][m];
      EPI_LOOP_BJ { f32x4 v0 = acc[ai][bj][m][0] * rstd + cv[bj][0], v1 = acc[ai][bj][m][1] * rstd + cv[bj][1];
#pragma unroll
        for (int e = 0; e < 4; ++e) { const float r0 = fmaxf(v0[e], 0.f), r1 = fmaxf(v1[e], 0.f); v0[e] = r0 * r0; v1[e] = r1 * r1; }
        *(u32x4*)(Hd + (size_t)rl * 4096 + EPI_COL(bj, 0)) = pack8(v0, v1); } }
  }
};
struct EpiFF2 {
  int row0; const float* mod; const float* b2; float* X; float* P;
  __device__ __forceinline__ void operator()(const AccT& acc, const Unit& u, int wr, int wc, int fr, int fq) const {
    if (u.ks == 1) {
      EPI_LOOP_ROWS { const int rl = EPI_ROW(ai, m); EPI_LOOP_COLS { *(f32x4*)(P + (size_t)rl * 1024 + EPI_COL(bj, n)) = acc[ai][bj][m][n]; } }
    } else {
    const int cb = cond_of_row(row0 + u.pm * 256); const float* md = mod + cb * 6144;
    f32x4 g2v[2][2], bbv[2][2];
    EPI_LOOP_COLS { const int col = EPI_COL(bj, n); g2v[bj][n] = *(const f32x4*)(md + 5120 + col); bbv[bj][n] = *(const f32x4*)(b2 + col); }
#pragma unroll
    for (int ai = 0; ai < 2; ++ai)
#pragma unroll
      for (int m2 = 0; m2 < 2; ++m2) {
        f32x4 xv[2][2][2];
#pragma unroll
        for (int mm = 0; mm < 2; ++mm) { const int row = row0 + EPI_ROW(ai, 2 * m2 + mm); EPI_LOOP_COLS { xv[mm][bj][n] = *(const f32x4*)(X + (size_t)row * 1024 + EPI_COL(bj, n)); } }
#pragma unroll
        for (int mm = 0; mm < 2; ++mm) { const int m = 2 * m2 + mm; const int row = row0 + EPI_ROW(ai, m);
          EPI_LOOP_COLS { const int col = EPI_COL(bj, n); *(f32x4*)(X + (size_t)row * 1024 + col) = xv[mm][bj][n] + g2v[bj][n] * (acc[ai][bj][m][n] + bbv[bj][n]); } } }
    }
  }
};

template <class Epi> __device__ __forceinline__ void run_gemm(LP lds, const bf16_t* A, const bf16_t* Bt, int M, int N, int K, const Epi& E, int nks = 1) {
  pg8::Gemm g; g.A = A; g.Bt = Bt; g.M = M; g.N = N; g.K = K / nks; g.ld = K; g.nks = nks;
  pg8::StaticOrder S; S.init(M, N, nks, (int)gridDim.x, (int)blockIdx.x);
  pg8::gemm_phase<Epi>(lds, g, S, E);
}

__device__ void transpose_tile(const float* __restrict__ src, int ld, int col0, int k0, bf16_t* __restrict__ dst, int K, int drow0, LAS float* tile) {
  const int t = opaque_tid();
  f32x4 v[4];
#pragma unroll
  for (int i = 0; i < 4; ++i) { const int idx = t + 512 * i, kr = idx >> 5, c4 = idx & 31; v[i] = *(const f32x4*)(src + (size_t)(k0 + kr) * ld + col0 + 4 * c4); }
#pragma unroll
  for (int i = 0; i < 4; ++i) { const int idx = t + 512 * i, kr = idx >> 5, c4 = idx & 31; LAS float* tp = tile + kr * 129 + 4 * c4; tp[0] = v[i][0]; tp[1] = v[i][1]; tp[2] = v[i][2]; tp[3] = v[i][3]; }
  __syncthreads();
  const int kb = t & 7;
#pragma unroll
  for (int i = 0; i < 2; ++i) { const int c = (t >> 3) + 64 * i; const LAS float* tp = tile + (kb * 8) * 129 + c; u32x4 o;
    o.x = pack2(tp[0], tp[129]); o.y = pack2(tp[2 * 129], tp[3 * 129]); o.z = pack2(tp[4 * 129], tp[5 * 129]); o.w = pack2(tp[6 * 129], tp[7 * 129]);
    *(u32x4*)(dst + (size_t)(drow0 + c) * K + k0 + kb * 8) = o; }
  __syncthreads();
}
template <int SILU> __device__ void matvec9_unit(const float* v0, const float* v1, int v1stride, const float* __restrict__ W, int ldw, const float* bias, float* out, int ldo, int col0, LAS float* lf) {
  const int t = opaque_tid(), lane = t & 63, wid = t >> 6;
  LAS float* sv = lf; LAS float* red = lf + 9216;
  for (int i = t; i < 9216; i += 512) { const int b = i >> 10, k = i & 1023; float x = (b == 0) ? v0[k] : v1[(size_t)(b - 1) * v1stride + k]; if (SILU) x = x * __builtin_amdgcn_rcpf(1.0f + __expf(-x)); sv[i] = x; }
  __syncthreads();
  const int c4 = t & 7, kl = t >> 3;
  f32x4 w[16];
#pragma unroll
  for (int i = 0; i < 16; ++i) w[i] = *(const f32x4*)(W + (size_t)(kl + 64 * i) * ldw + col0 + 4 * c4);
  f32x4 acc[9];
#pragma unroll
  for (int b = 0; b < 9; ++b) acc[b] = (f32x4){0.f, 0.f, 0.f, 0.f};
#pragma unroll
  for (int i = 0; i < 16; ++i)
#pragma unroll
    for (int b = 0; b < 9; ++b) acc[b] += w[i] * sv[b * 1024 + kl + 64 * i];
#pragma unroll
  for (int b = 0; b < 9; ++b)
#pragma unroll
    for (int e = 0; e < 4; ++e) { float x = acc[b][e]; x += __shfl_xor(x, 8); x += __shfl_xor(x, 16); x += __shfl_xor(x, 32); acc[b][e] = x; }
  if (lane < 8) {
#pragma unroll
    for (int b = 0; b < 9; ++b) *(LAS f32x4*)(red + (wid * 9 + b) * 32 + 4 * lane) = acc[b]; }
  __syncthreads();
  if (t < 288) { const int b = t >> 5, cc = t & 31; float s = bias[col0 + cc];
#pragma unroll
    for (int pz = 0; pz < 8; ++pz) s += red[(pz * 9 + b) * 32 + cc];
    out[(size_t)b * ldo + col0 + cc] = s; }
  __syncthreads();
}

__device__ void phase0(const Params& p, LP lds) {
  unsigned char* ws = p.ws; LAS float* lf = (LAS float*)lds;
  const int tid0 = opaque_tid(); const int wid = tid0 >> 6, lane = tid0 & 63;
  for (int unit = blockIdx.x; unit < 576; unit += gridDim.x) {
    if (unit < 192) {
      matvec9_unit<1>(p.in[6], p.in[5], 1024, p.in[7], 6144, p.in[8], (float*)(ws + OFF_MOD), 6144, unit * 32, lf);
    } else if (unit < 480) {
      const int row = (unit - 192) * 8 + wid; const bool smp = row < 2048; const int L = smp ? 2048 : 256, t = smp ? row : row - 2048;
      const float* w1 = p.in[14]; const float* b1 = p.in[15]; const float* fr1 = p.in[16]; const float* w2 = p.in[17]; const float* b2 = p.in[18]; const float* fr2 = p.in[19];
      float a = b1[lane] + (float)t / (float)(L - 1) * w1[lane];
      const float base = (6.283185307179586f / (float)L) * (float)t;
      float cs = 0.f, sn = 0.f; if (lane < 16) { const float ang = base * (float)(lane + 1); cs = cosf(ang); sn = sinf(ang); }
#pragma unroll
      for (int i = 0; i < 16; ++i) a += __shfl(cs, i) * w1[(1 + i) * 64 + lane] + __shfl(sn, i) * w1[(17 + i) * 64 + lane];
      const float h1 = sinf(fr1[lane] * a);
      float a2 = b2[lane];
#pragma unroll 16
      for (int j = 0; j < 64; ++j) a2 += __shfl(h1, j) * w2[j * 64 + lane];
      const float h2 = sinf(fr2[lane] * a2);
      float* dst = (float*)(ws + (smp ? OFF_H2S : OFF_H2C)); dst[(size_t)t * 64 + lane] = h2;
    } else {
      const int r = unit - 480, c = tid0; const int pos = r < 32 ? r : r - 32; const int i = c & 255;
      const float omega = 1.0f / powf(10000.0f, (float)i / 256.0f); const float a = (float)pos * omega; const float v = c < 256 ? sinf(a) : cosf(a);
      float* dst = (float*)(ws + (r < 32 ? OFF_PER : OFF_PEC)); dst[(size_t)pos * 512 + c] = v;
    }
  }
}
__device__ void weight_tiles(const Params& p, LP lds, int lo, int hi, int upper) {
  unsigned char* ws = p.ws; LAS float* lf = (LAS float*)lds;
  const int nh = upper ? ((int)gridDim.x >> 1) : 0;
  if ((int)blockIdx.x < nh) return;
  for (int tu = lo + (int)blockIdx.x - nh; tu < hi; tu += (int)gridDim.x - nh) {
    const float* src; int ld, K, col0, k0, drow0; bf16_t* dst;
    if (tu < 1152) { const int nt = tu >> 4, kt = tu & 15; const int r = nt * 128; src = p.in[10]; ld = INC; K = 1024; k0 = kt * 64; drow0 = r; dst = (bf16_t*)(ws + OFF_WT);
      col0 = r < 3072 ? r : (r < 6144 ? 4112 + (r - 3072) : (r < 7168 ? 3072 + (r - 6144) : 7184 + (r - 7168))); }
    else if (tu < 1536) { const int v = tu - 1152, w = v >> 7, q = v & 127; src = p.in[23 + w]; ld = 1024; K = 1024; k0 = (q & 15) * 64; col0 = (q >> 4) * 128; drow0 = col0; dst = (bf16_t*)(ws + (w == 0 ? OFF_WBM : (w == 1 ? OFF_WBH : OFF_WOUT))); }
    else if (tu < 2048) { const int q = tu - 1536; src = p.in[27]; ld = 4096; K = 1024; k0 = (q & 15) * 64; col0 = (q >> 4) * 128; drow0 = col0; dst = (bf16_t*)(ws + OFF_W1T); }
    else { const int q = tu - 2048; src = p.in[29]; ld = 1024; K = 4096; k0 = (q & 63) * 64; col0 = (q >> 6) * 128; drow0 = col0; dst = (bf16_t*)(ws + OFF_W2T); }
    transpose_tile(src, ld, col0, k0, dst, K, drow0, lf);
  }
}

__device__ void phase1(const Params& p, LP lds) {
  unsigned char* ws = p.ws;
  int tid_ = threadIdx.x; asm volatile("" : "+v"(tid_));
  const int tid = tid_, wid = tid >> 6, lane = tid & 63;
  const float* mod = (const float*)(ws + OFF_MOD);
  LAS float* wg = (LAS float*)lds;
  if ((int)blockIdx.x < 1536) {
    f32x4 gw[8];
#pragma unroll
    for (int i = 0; i < 8; ++i) { const int idx = tid + 512 * i, k = idx >> 2, q = idx & 3; gw[i] = *(const f32x4*)(p.in[10] + (size_t)k * INC + 4096 + 4 * q); }
#pragma unroll
    for (int i = 0; i < 8; ++i) { const int idx = tid + 512 * i, k = idx >> 2, q = idx & 3; wg[(4 * q) * 1024 + k] = gw[i][0]; wg[(4 * q + 1) * 1024 + k] = gw[i][1]; wg[(4 * q + 2) * 1024 + k] = gw[i][2]; wg[(4 * q + 3) * 1024 + k] = gw[i][3]; }
    __syncthreads();
  }
  for (int unit = blockIdx.x; unit < 1536; unit += gridDim.x) {
    const int tidn = opaque_tid(); const int wid = tidn >> 6, lane = tidn & 63;
    const int row0 = unit * 16 + wid * 2; const int cb = cond_of_row(row0); const float* md = mod + cb * 6144; const bool smp = row0 >= NCTX;
    f32x4 v[2][4]; float rstd[2];
#pragma unroll
    for (int r = 0; r < 2; ++r) { const int row = row0 + r; const float* xr; int t = 0;
      if (!smp) xr = p.in[0] + (size_t)row * 1024; else { xr = p.in[1] + (size_t)(row - NCTX) * 1024; t = (row - NCTX) & 2047; }
      const float* per = (const float*)(ws + OFF_PER) + (t >> 6) * 512; const float* pec = (const float*)(ws + OFF_PEC) + (t & 63) * 512;
      float ss = 0.f;
#pragma unroll
      for (int i = 0; i < 4; ++i) { const int col = 4 * lane + 256 * i; v[r][i] = *(const f32x4*)(xr + col);
        if (smp) v[r][i] += (col < 512) ? *(const f32x4*)(per + col) : *(const f32x4*)(pec + col - 512);
        ss += v[r][i][0] * v[r][i][0] + v[r][i][1] * v[r][i][1] + v[r][i][2] * v[r][i][2] + v[r][i][3] * v[r][i][3]; }
      ss = wave_sum(ss); rstd[r] = rsqrtf(ss * (1.0f / 1024.0f) + 1e-6f); }
    const float* n1w = p.in[9];
    float ga[32];
#pragma unroll
    for (int g = 0; g < 32; ++g) ga[g] = 0.f;
#pragma unroll
    for (int i = 0; i < 4; ++i) { const int col = 4 * lane + 256 * i;
      const f32x4 w = *(const f32x4*)(n1w + col), sc = *(const f32x4*)(md + 1024 + col), sh = *(const f32x4*)(md + col);
      const f32x4 ws1 = w * (sc + 1.0f);
      f32x4 h[2];
#pragma unroll
      for (int r = 0; r < 2; ++r) { h[r] = v[r][i] * rstd[r] * ws1 + sh;
        u32x2 o; o.x = pack2(h[r][0], h[r][1]); o.y = pack2(h[r][2], h[r][3]); *(u32x2*)((bf16_t*)(ws + OFF_HN) + (size_t)(row0 + r) * 1024 + col) = o; }
#pragma unroll
      for (int g = 0; g < 16; ++g) { const f32x4 wv = *(const LAS f32x4*)(wg + g * 1024 + col);
#pragma unroll
        for (int r = 0; r < 2; ++r) ga[r * 16 + g] += h[r][0] * wv[0] + h[r][1] * wv[1] + h[r][2] * wv[2] + h[r][3] * wv[3]; }
      asm volatile("" ::: "memory"); }
#pragma unroll
    for (int i = 0; i < 16; ++i) { auto s2 = __builtin_amdgcn_permlane16_swap(__float_as_uint(ga[i]), __float_as_uint(ga[i + 16]), false, false); ga[i] = __uint_as_float(s2[0]) + __uint_as_float(s2[1]); }
    { const bool hi = (lane & 8) != 0;
#pragma unroll
      for (int i = 0; i < 8; ++i) { const float send = hi ? ga[i] : ga[i + 8]; const float keep = hi ? ga[i + 8] : ga[i]; ga[i] = keep + dppf<DPP_ROR8>(send); } }
    { const bool hi = (lane & 4) != 0;
#pragma unroll
      for (int i = 0; i < 4; ++i) { const float send = hi ? ga[i] : ga[i + 4]; const float keep = hi ? ga[i + 4] : ga[i]; ga[i] = keep + __shfl_xor(send, 4); } }
    { const bool hi = (lane & 2) != 0;
#pragma unroll
      for (int i = 0; i < 2; ++i) { const float send = hi ? ga[i] : ga[i + 2]; const float keep = hi ? ga[i + 2] : ga[i]; ga[i] = keep + dppf<DPP_XOR2>(send); } }
    { const bool hi = (lane & 1) != 0; const float send = hi ? ga[0] : ga[1]; const float keep = hi ? ga[1] : ga[0]; ga[0] = keep + dppf<DPP_XOR1>(send); }
    float tot; { auto s3 = __builtin_amdgcn_permlane32_swap(__float_as_uint(ga[0]), __float_as_uint(ga[0]), false, false); tot = __uint_as_float(s3[0]) + __uint_as_float(s3[1]); }
    if (lane < 32) ((float*)(ws + OFF_GT))[(size_t)row0 * 16 + lane] = tot + p.in[11][4096 + (lane & 15)];
  }
  __syncthreads();
}
__device__ void filters_upper_half(const Params& p, LP lds) {
  unsigned char* ws = p.ws; const int nh = (int)gridDim.x >> 1;
  if ((int)blockIdx.x < nh) return;
  LAS float* w3s = (LAS float*)lds;
  for (int v = (int)blockIdx.x - nh; v < 320; v += (int)gridDim.x - nh) {
    const int tid = opaque_tid();
    const bool smp = v < 256; const int L = smp ? 2048 : 256; const int tt = smp ? (v >> 6) : 0, cgp = v & 63; const int t = tt * 512 + tid;
    { const f32x4 x = *(const f32x4*)(p.in[20] + (size_t)(tid >> 3) * 2048 + cgp * 32 + 4 * (tid & 7)); LAS float* wp = w3s + (4 * (tid & 7)) * 64 + (tid >> 3);
      wp[0] = x[0]; wp[64] = x[1]; wp[128] = x[2]; wp[192] = x[3]; }
    __syncthreads();
    if (t < L) {
      const float* H2 = (const float*)(ws + (smp ? OFF_H2S : OFF_H2C)) + (size_t)t * 64;
      f32x4 h2[16];
#pragma unroll
      for (int i = 0; i < 16; ++i) h2[i] = *(const f32x4*)(H2 + 4 * i);
      const float dist = fabsf((float)t - (float)(L / 2)) / (float)(L / 2);
      float* HF = (float*)(ws + (smp ? OFF_HFS : OFF_HFC)) + (size_t)(cgp * 32) * L + t;
#pragma unroll 1
      for (int j = 0; j < 32; ++j) {
        f32x4 a = {0.f, 0.f, 0.f, 0.f};
#pragma unroll
        for (int i = 0; i < 16; ++i) a += *(const LAS f32x4*)(w3s + j * 64 + 4 * i) * h2[i];
        const int c = (cgp * 32 + j) & 1023;
        const float dmin = -3.0701134573253946f, dmax = -15.350567286626973f;
        const float delta = fabsf(dmin + (dmax - dmin) * ((float)c / 1023.0f));
        HF[(size_t)j * L] = ((a[0] + a[1]) + (a[2] + a[3])) * __expf(-dist * delta); }
    }
    __syncthreads();
  }
}
__device__ void c1_upper_half(const Params& p, LP lds) {
  unsigned char* ws = p.ws; const float* mod = (const float*)(ws + OFF_MOD); const int nh = (int)gridDim.x >> 1;
  if ((int)blockIdx.x < nh) return;
  for (int u = (int)blockIdx.x - nh; u < 128; u += (int)gridDim.x - nh)
    matvec9_unit<0>(mod + 3072, mod + 6144 + 3072, 6144, p.in[27], 4096, p.in[28], (float*)(ws + OFF_C1), 4096, u * 32, (LAS float*)lds);
}

__device__ __forceinline__ bf16x8 tr_frag(LP base, int k0, int m0, int pitch  , int l15, int g) {
  const int q = l15 >> 2, pp = l15 & 3;
  LP a = base + ((k0 + 8 * g + q) * pitch + m0 + 4 * pp) * 2;
  const s16x4 lo = __builtin_amdgcn_ds_read_tr16_b64_v4i16((LAS s16x4*)a);
  const s16x4 hi = __builtin_amdgcn_ds_read_tr16_b64_v4i16((LAS s16x4*)(a + 8 * pitch));
  bf16x8 r; r[0] = lo[0]; r[1] = lo[1]; r[2] = lo[2]; r[3] = lo[3]; r[4] = hi[0]; r[5] = hi[1]; r[6] = hi[2]; r[7] = hi[3]; return r;
}
__device__ __forceinline__ bf16x8 tr_at(LP lanebase, int coff  , int pitch_bytes) {
  const s16x4 lo = __builtin_amdgcn_ds_read_tr16_b64_v4i16((LAS s16x4*)(lanebase + coff));
  const s16x4 hi = __builtin_amdgcn_ds_read_tr16_b64_v4i16((LAS s16x4*)(lanebase + coff + 4 * pitch_bytes));
  bf16x8 r; r[0] = lo[0]; r[1] = lo[1]; r[2] = lo[2]; r[3] = lo[3]; r[4] = hi[0]; r[5] = hi[1]; r[6] = hi[2]; r[7] = hi[3]; return r;
}
constexpr int ML_K = 0, ML_V = 67584, ML_P = 86016, ML_C = 120832, ML_T = 157696, ML_TSZ = 1600;
constexpr int KP = 264, VP = 72, PP = 136, CP = 72;

__device__ void mlstm_item(const Params& p, LP lds, int item) {
  const int tid = opaque_tid(), wid = __builtin_amdgcn_readfirstlane(tid >> 6), lane = tid & 63, l15 = lane & 15, g = lane >> 4;
  const bool smp = item < 256; const int uu = smp ? (item >> 2) : ((item - 256) >> 2); const int sl = item & 3;
  const int b = uu >> 3, dir = (uu >> 2) & 1, head = uu & 3;
  const int S = smp ? SEQS : SEQC, nc = S >> 7; const int tok0 = smp ? NCTX + b * SEQS : b * SEQC;
  const bf16_t* qkv = (const bf16_t*)(p.ws + OFF_BIG);
  const float* GT = (const float*)(p.ws + OFF_GT);
  bf16_t* hout = (bf16_t*)((unsigned char*)p.out + (dir ? OUT_HB : OUT_H));
  const int sidx = (b * 2 + dir) * 4 + head;
  const int gi_col = dir * 8 + head, gf_col = dir * 8 + 4 + head;
  f32x4 Cacc[2][4], nacc[2]; float mst0;
  if (smp) {
    const float* C0 = p.in[2] + (size_t)sidx * 65536;
#pragma unroll
    for (int dt = 0; dt < 2; ++dt) {
#pragma unroll
      for (int vt = 0; vt < 4; ++vt) Cacc[dt][vt] = *(const f32x4*)(C0 + (size_t)((2 * wid + dt) * 16 + l15) * 256 + sl * 64 + 16 * vt + 4 * g);
      nacc[dt] = (f32x4){p.in[3][sidx * 256 + (2 * wid + dt) * 16 + l15], 0.f, 0.f, 0.f}; }
    mst0 = p.in[4][sidx];
  } else {
#pragma unroll
    for (int dt = 0; dt < 2; ++dt) {
#pragma unroll
      for (int vt = 0; vt < 4; ++vt) Cacc[dt][vt] = (f32x4){0.f, 0.f, 0.f, 0.f};
      nacc[dt] = (f32x4){0.f, 0.f, 0.f, 0.f}; }
    mst0 = 0.f;
  }
#define TOKC(cc, j) (dir ? (tok0 + S - 1 - ((cc) * 128 + (j))) : (tok0 + (cc) * 128 + (j)))
  const int rt = (wid < 4) ? wid : 11 - wid;
  const int jrow = 16 * rt + l15;
  bf16x8 qf[8]; u32x4 kreg[8], vreg[2]; float g4[4] = {0.f, 0.f, 0.f, 0.f};
#define ML_LOAD_Q(cc) do { const bf16_t* qp = qkv + (size_t)TOKC(cc, jrow) * 3072 + head * 256 + 8 * g; \
    _Pragma("unroll") for (int kk = 0; kk < 8; ++kk) qf[kk] = *(const bf16x8*)(qp + 32 * kk); } while (0)
#define ML_LOAD_KV(cc) do { \
    _Pragma("unroll") for (int i = 0; i < 8; ++i) { const int row = (tid >> 5) + 16 * i; kreg[i] = *(const u32x4*)(qkv + (size_t)TOKC(cc, row) * 3072 + 1024 + head * 256 + (tid & 31) * 8); } \
    _Pragma("unroll") for (int i = 0; i < 2; ++i) { const int row = (tid >> 3) + 64 * i; vreg[i] = *(const u32x4*)(qkv + (size_t)TOKC(cc, row) * 3072 + 2048 + head * 256 + sl * 64 + (tid & 7) * 8); } \
    if (wid == 0) { const float* g0 = GT + (size_t)TOKC(cc, 2 * lane) * 16; const float* g1 = GT + (size_t)TOKC(cc, 2 * lane + 1) * 16; g4[0] = g0[gi_col]; g4[1] = g0[gf_col]; g4[2] = g1[gi_col]; g4[3] = g1[gf_col]; } } while (0)
#define ML_SCAN(tabp, mcur, mnext) do { LAS float* T_ = (LAS float*)(tabp); \
    const float lf0 = fminf(g4[1], 0.f) - log1pf(__expf(-fabsf(g4[1]))), lf1 = fminf(g4[3], 0.f) - log1pf(__expf(-fabsf(g4[3]))); \
    float s_ = lf0 + lf1; \
    _Pragma("unroll") for (int o = 1; o < 64; o <<= 1) { const float t_ = __shfl_up(s_, o); if (lane >= o) s_ += t_; } \
    const float b1_ = s_, b0_ = s_ - lf1; const float u0_ = g4[0] - b0_, u1_ = g4[2] - b1_; \
    float mx_ = fmaxf(u0_, u1_); \
    _Pragma("unroll") for (int o = 1; o < 64; o <<= 1) { const float t_ = __shfl_up(mx_, o); if (lane >= o) mx_ = fmaxf(mx_, t_); } \
    float ex_ = __shfl_up(mx_, 1); if (lane == 0) ex_ = -INFINITY; \
    const float M0_ = fmaxf(mcur, fmaxf(ex_, u0_)), M1_ = fmaxf(mcur, mx_); \
    T_[2 * lane] = u0_; T_[2 * lane + 1] = u1_; T_[128 + 2 * lane] = M0_; T_[128 + 2 * lane + 1] = M1_; T_[256 + 2 * lane] = b0_; T_[256 + 2 * lane + 1] = b1_; \
    const float Ml_ = __shfl(M1_, 63), bl_ = __shfl(b1_, 63); \
    if (lane == 0) { T_[384] = mcur; T_[385] = Ml_; } \
    mnext = bl_ + Ml_; } while (0)
  float mw0 = mst0;
  ML_LOAD_Q(0); ML_LOAD_KV(0);
  if (wid == 0) { float mn; ML_SCAN(lds + ML_T, mw0, mn); mw0 = mn; }
  __syncthreads();
  float m_final = 0.f;
  for (int c = 0; c < nc; ++c) {
    LAS float* T = (LAS float*)(lds + ML_T + (c & 1) * ML_TSZ);
    const float mst = T[384], M_last = T[385];
#pragma unroll
    for (int i = 0; i < 8; ++i) { const int row = (tid >> 5) + 16 * i; *(LAS u32x4*)(lds + ML_K + (row * KP + (tid & 31) * 8) * 2) = kreg[i]; }
#pragma unroll
    for (int i = 0; i < 2; ++i) { const int row = (tid >> 3) + 64 * i; const float w = __expf(T[row] - M_last); const u32x4 v = vreg[i]; u32x4 o;
      o.x = pack2(bflo(v.x) * w, bfhi(v.x) * w); o.y = pack2(bflo(v.y) * w, bfhi(v.y) * w); o.z = pack2(bflo(v.z) * w, bfhi(v.z) * w); o.w = pack2(bflo(v.w) * w, bfhi(v.w) * w);
      *(LAS u32x4*)(lds + ML_V + (row * VP + (tid & 7) * 8) * 2) = o; }
    if (tid < 128) *(LAS unsigned short*)(lds + ML_V + (tid * VP + 64) * 2) = f2bf(__expf(T[tid] - M_last));
#pragma unroll
    for (int dt = 0; dt < 2; ++dt) {
#pragma unroll
      for (int vt = 0; vt < 4; ++vt) { u32x2 w; w.x = pack2(Cacc[dt][vt][0], Cacc[dt][vt][1]); w.y = pack2(Cacc[dt][vt][2], Cacc[dt][vt][3]);
        *(LAS u32x2*)(lds + ML_C + (((2 * wid + dt) * 16 + l15) * CP + 16 * vt + 4 * g) * 2) = w; }
      if (g == 0) *(LAS unsigned short*)(lds + ML_C + (((2 * wid + dt) * 16 + l15) * CP + 64) * 2) = f2bf(nacc[dt][0]); }
    const int qtok = TOKC(c, jrow);
    const bool more = (c + 1 < nc);
    __syncthreads();
    const float Mj = T[128 + jrow], bj = T[256 + jrow]; const float rf = __expf(M_last - Mj), w_inter = __expf(mst - Mj);
    int lq_ = (8 * g + (l15 >> 2)), lp_ = 4 * (l15 & 3); asm volatile("" : "+v"(lq_), "+v"(lp_));
    const LP cB = lds + ML_C + (lq_ * CP + lp_) * 2, vB = lds + ML_V + (lq_ * VP + lp_) * 2, kB = lds + ML_K + (lq_ * KP + lp_ + 32 * wid) * 2;
    const LP pB = lds + ML_P + (jrow * PP + 8 * g) * 2;
    for (int st = 0; st <= rt; ++st) {
      f32x4 s = {0.f, 0.f, 0.f, 0.f};
      bf16x8 kfr[8];
#pragma unroll
      for (int kk = 0; kk < 8; ++kk) kfr[kk] = *(const LAS bf16x8*)(lds + ML_K + ((16 * st + l15) * KP + 32 * kk + 8 * g) * 2);
      __builtin_amdgcn_sched_barrier(0);
#pragma unroll
      for (int kk = 0; kk < 8; ++kk) s = __builtin_amdgcn_mfma_f32_16x16x32_bf16(kfr[kk], qf[kk], s, 0, 0, 0);
      float pv[4];
#pragma unroll
      for (int i = 0; i < 4; ++i) pv[i] = ((16 * st + 4 * g + i) <= jrow) ? s[i] * rf : 0.f;
      u32x2 w; w.x = pack2(pv[0], pv[1]); w.y = pack2(pv[2], pv[3]);
      *(LAS u32x2*)(lds + ML_P + (jrow * PP + 16 * st + 4 * g) * 2) = w;
    }
    if ((rt & 1) == 0) { u32x2 z; z.x = 0u; z.y = 0u; *(LAS u32x2*)(lds + ML_P + (jrow * PP + 16 * (rt + 1) + 4 * g) * 2) = z; }
    if (more) ML_LOAD_KV(c + 1);
    asm volatile("s_waitcnt lgkmcnt(0)" ::: "memory");
    f32x4 ha[5];
#pragma unroll
    for (int vt = 0; vt < 5; ++vt) { f32x4 a = {0.f, 0.f, 0.f, 0.f};
      if (smp || c > 0) {
        bf16x8 cfr[8];
#pragma unroll
        for (int kk = 0; kk < 8; ++kk) cfr[kk] = tr_at(cB, (32 * kk * CP + 16 * vt) * 2, CP * 2);
        __builtin_amdgcn_sched_barrier(0);
#pragma unroll
        for (int kk = 0; kk < 8; ++kk) a = __builtin_amdgcn_mfma_f32_16x16x32_bf16(cfr[kk], qf[kk], a, 0, 0, 0);
        a *= w_inter; }
      ha[vt] = a; }
    for (int k2 = 0; k2 <= (rt >> 1); ++k2) {
      const bf16x8 pf = *(const LAS bf16x8*)(pB + k2 * 64);
      bf16x8 vfr[5];
#pragma unroll
      for (int vt = 0; vt < 5; ++vt) vfr[vt] = tr_at(vB + k2 * (32 * VP * 2), (16 * vt) * 2, VP * 2);
      __builtin_amdgcn_sched_barrier(0);
#pragma unroll
      for (int vt = 0; vt < 5; ++vt) ha[vt] = __builtin_amdgcn_mfma_f32_16x16x32_bf16(vfr[vt], pf, ha[vt], 0, 0, 0); }
    { const float den = __shfl(ha[4][0], l15); const float rdd = __builtin_amdgcn_rcpf(fmaxf(fabsf(den), __expf(-(bj + Mj))));
#pragma unroll
      for (int vt = 0; vt < 4; ++vt) { const f32x4 a = ha[vt] * rdd; u32x2 w; w.x = pack2(a[0], a[1]); w.y = pack2(a[2], a[3]);
        *(u32x2*)(hout + (size_t)qtok * 1024 + head * 256 + sl * 64 + 16 * vt + 4 * g) = w; } }
    if (more) ML_LOAD_Q(c + 1);
    const bool need_state = (!smp) || more;
    if (need_state) {
      const float decay = __expf(mst - M_last);
#pragma unroll
      for (int dt = 0; dt < 2; ++dt) {
#pragma unroll
        for (int vt = 0; vt < 4; ++vt) Cacc[dt][vt] *= decay;
        nacc[dt] *= decay; }
#pragma unroll
      for (int ks = 0; ks < 4; ++ks) {
        const bf16x8 kf0 = tr_at(kB, (32 * ks * KP) * 2, KP * 2), kf1 = tr_at(kB, (32 * ks * KP + 16) * 2, KP * 2);
        bf16x8 vfr[5];
#pragma unroll
        for (int vt = 0; vt < 5; ++vt) vfr[vt] = tr_at(vB, (32 * ks * VP + 16 * vt) * 2, VP * 2);
        __builtin_amdgcn_sched_barrier(0);
#pragma unroll
        for (int vt = 0; vt < 4; ++vt) { Cacc[0][vt] = __builtin_amdgcn_mfma_f32_16x16x32_bf16(vfr[vt], kf0, Cacc[0][vt], 0, 0, 0); Cacc[1][vt] = __builtin_amdgcn_mfma_f32_16x16x32_bf16(vfr[vt], kf1, Cacc[1][vt], 0, 0, 0); }
        nacc[0] = __builtin_amdgcn_mfma_f32_16x16x32_bf16(vfr[4], kf0, nacc[0], 0, 0, 0); nacc[1] = __builtin_amdgcn_mfma_f32_16x16x32_bf16(vfr[4], kf1, nacc[1], 0, 0, 0);
      }
    }
    if (wid == 0 && more) { float mn; ML_SCAN(lds + ML_T + ((c + 1) & 1) * ML_TSZ, mw0, mn); mw0 = mn; }
    m_final = T[256 + 127] + M_last;
    __syncthreads();
  }
#undef ML_LOAD_Q
#undef ML_LOAD_KV
#undef ML_SCAN
#undef TOKC
  if (!smp) {
    float* oC = p.out + OUTF_C + (size_t)sidx * 65536;
#pragma unroll
    for (int dt = 0; dt < 2; ++dt) {
#pragma unroll
      for (int vt = 0; vt < 4; ++vt) *(f32x4*)(oC + (size_t)((2 * wid + dt) * 16 + l15) * 256 + sl * 64 + 16 * vt + 4 * g) = Cacc[dt][vt];
      if (sl == 0 && g == 0) p.out[OUTF_N + (size_t)sidx * 256 + (2 * wid + dt) * 16 + l15] = nacc[dt][0]; }
    if (sl == 0 && tid == 0) p.out[OUTF_M + sidx] = m_final;
  }
}

__device__ void combine_rows(const Params& p) {
  const int tid0 = opaque_tid(); const int wid = tid0 >> 6, lane = tid0 & 63;
  bf16_t* H = (bf16_t*)((unsigned char*)p.out + OUT_H); const bf16_t* HB = (const bf16_t*)((unsigned char*)p.out + OUT_HB); const float* nw = p.in[22];
  f32x4 wv[4];
#pragma unroll
  for (int i = 0; i < 4; ++i) wv[i] = *(const f32x4*)(nw + 16 * lane + 4 * i);
  const int nh = (int)gridDim.x >> 1;
  if ((int)blockIdx.x < nh) return;
  for (int unit = (int)blockIdx.x - nh; unit < 768; unit += (int)gridDim.x - nh) {
    const int row0 = unit * 32 + wid * 4;
    u32x4 a[4][2], bq[4][2];
#pragma unroll
    for (int r = 0; r < 4; ++r)
#pragma unroll
      for (int i = 0; i < 2; ++i) { a[r][i] = *(const u32x4*)(H + (size_t)(row0 + r) * 1024 + 16 * lane + 8 * i); bq[r][i] = *(const u32x4*)(HB + (size_t)(row0 + r) * 1024 + 16 * lane + 8 * i); }
#pragma unroll
    for (int r = 0; r < 4; ++r) {
      f32x4 v[4]; float ss = 0.f;
#pragma unroll
      for (int i = 0; i < 2; ++i) { f32x4 x0, x1, y0, y1; unpack8(a[r][i], x0, x1); unpack8(bq[r][i], y0, y1); v[2 * i] = x0 + y0; v[2 * i + 1] = x1 + y1; }
#pragma unroll
      for (int i = 0; i < 4; ++i) ss += v[i][0] * v[i][0] + v[i][1] * v[i][1] + v[i][2] * v[i][2] + v[i][3] * v[i][3];
      ss = row16_sum(ss);
      const float rr = rsqrtf(ss * (1.0f / 256.0f) + 1e-6f);
#pragma unroll
      for (int i = 0; i < 2; ++i) *(u32x4*)(H + (size_t)(row0 + r) * 1024 + 16 * lane + 8 * i) = pack8(v[2 * i] * rr * wv[2 * i], v[2 * i + 1] * rr * wv[2 * i + 1]);
    }
  }
}

constexpr int HY_WAVE = 18816, HY_HR = 0, HY_ZA = 8576, HY_ZB = 8576 + 5120;
__device__ void hyena_item(const Params& p, LP lds, int item) {
  const int tid = opaque_tid(), wid = __builtin_amdgcn_readfirstlane(tid >> 6), lane = tid & 63, n31 = lane & 31, hh = lane >> 5;
  const bool smp = item < 1024; const int it = smp ? item : item - 1024; const int bset = it >> 7, cgp = it & 127; const int c = cgp * 8 + wid;
  const int L = smp ? 2048 : 256, lgL = smp ? 11 : 8, nblk = L >> 5, lgnb = lgL - 5, ntok = 2048, ntile = 2, dmax = L >> 6;
  const int tok0 = smp ? NCTX + bset * 2048 : bset * 2048;
  LP wl = lds + wid * HY_WAVE; LAS float* hr = (LAS float*)(wl + HY_HR);
  const float* HFp = (const float*)(p.ws + (smp ? OFF_HFS : OFF_HFC));
  const bf16_t* UT = (const bf16_t*)(p.ws + OFF_BIG);
  const float* cw = p.in[12]; const float* cbv = p.in[13]; const float* skp = p.in[21];
  { const int uc = 2048 + c; const float w0 = cw[uc], w1 = cw[3072 + uc], w2 = cw[6144 + uc], cb = cbv[uc]; const bf16_t* src = UT + (size_t)uc * NTOK + tok0;
    u32x4 vv[4]; float pvv[4], nxv[4];
#pragma unroll
    for (int i = 0; i < 4; ++i) { const int base = lane * 8 + 512 * i; vv[i] = (u32x4){0u, 0u, 0u, 0u}; pvv[i] = 0.f; nxv[i] = 0.f;
      if (base < ntok) { vv[i] = *(const u32x4*)(src + base); const int tl = base & (L - 1);
        if (tl != 0) pvv[i] = bf2f(src[base - 1]); if (tl + 8 != L) nxv[i] = bf2f(src[base + 8]); } }
#pragma unroll
    for (int i = 0; i < 4; ++i) { const int base = lane * 8 + 512 * i;
      if (base < ntok) { const u32x4 v = vv[i];
        float u[10]; u[0] = pvv[i]; u[1] = bflo(v.x); u[2] = bfhi(v.x); u[3] = bflo(v.y); u[4] = bfhi(v.y); u[5] = bflo(v.z); u[6] = bfhi(v.z); u[7] = bflo(v.w); u[8] = bfhi(v.w); u[9] = nxv[i];
        float o[8];
#pragma unroll
        for (int e = 0; e < 8; ++e) o[e] = cb + w0 * u[e] + w1 * u[e + 1] + w2 * u[e + 2];
        u32x4 w; w.x = pack2(o[0], o[1]); w.y = pack2(o[2], o[3]); w.z = pack2(o[4], o[5]); w.w = pack2(o[6], o[7]);
        *(LAS u32x4*)(wl + HY_ZA + ((base >> 5) * 40 + (base & 31)) * 2) = w; } } }
  const int HRP = L + 96;
  f32x4 fvN[8];
#define HY_FLOAD(o) do { const float* src_ = HFp + (size_t)((o) * 1024 + c) * L; \
    _Pragma("unroll") for (int i = 0; i < 8; ++i) { const int q = lane + 64 * i; fvN[i] = (4 * q < L) ? *(const f32x4*)(src_ + 4 * q) : (f32x4){0.f, 0.f, 0.f, 0.f}; } } while (0)
  HY_FLOAD(0);
  for (int ord = 0; ord < 2; ++ord) {
    { float sa = 0.f;
      f32x4 fv[8];
#pragma unroll
      for (int i = 0; i < 8; ++i) fv[i] = fvN[i];
#pragma unroll
      for (int i = 0; i < 8; ++i) sa += (fabsf(fv[i][0]) + fabsf(fv[i][1])) + (fabsf(fv[i][2]) + fabsf(fv[i][3]));
      sa = wave_sum(sa); const float inv = __builtin_amdgcn_rcpf(sa + 1e-6f);
      asm volatile("s_waitcnt lgkmcnt(0)" ::: "memory");
      LAS bf16_t* E = (LAS bf16_t*)hr; LAS bf16_t* O = E + HRP;
#pragma unroll
      for (int i = 0; i < 8; ++i) { const int q = lane + 64 * i;
        if (4 * q < L) {
#pragma unroll
          for (int e = 0; e < 4; ++e) { const int yy = L - 1 - (4 * q + e); const bf16_t v = f2bf(fv[i][e] * inv); E[32 + yy] = v; O[31 + yy] = v; } } }
      if (lane < 32) { E[lane] = 0; E[32 + L + lane] = 0; O[31 + L + lane] = 0; if (lane < 31) O[lane] = 0; }
      if (lane < 33) O[HRP - 33 + lane] = 0;
      asm volatile("s_waitcnt lgkmcnt(0)" ::: "memory"); }
    if (ord == 0) HY_FLOAD(1);
    LP zin = wl + (ord == 0 ? HY_ZA : HY_ZB); LP zout = wl + (ord == 0 ? HY_ZB : HY_ZA);
    const int gc = ord * 1024 + c; const float w0 = cw[gc], w1 = cw[3072 + gc], w2 = cw[6144 + gc], cb = cbv[gc], sk = skp[ord * 1024 + c];
    const bf16_t* gsrc = UT + (size_t)gc * NTOK + tok0;
    u32x4 gv[4]; unsigned gpv[4], gnx[4];
#pragma unroll
    for (int i = 0; i < 4; ++i) { const int base = lane * 8 + 512 * i; gv[i] = (u32x4){0u, 0u, 0u, 0u}; gpv[i] = 0u; gnx[i] = 0u;
      if (base < ntok) { gv[i] = *(const u32x4*)(gsrc + base); const int tl = base & (L - 1);
        if (tl != 0) gpv[i] = gsrc[base - 1]; if (tl + 8 != L) gnx[i] = gsrc[base + 8]; } }
    f32x16 accs[2];
#pragma unroll
    for (int o2 = 0; o2 < 2; ++o2)
#pragma unroll
      for (int r = 0; r < 16; ++r) accs[o2][r] = 0.f;
    LP fb = wl + HY_HR + ((n31 & 1) ? 0 : (HRP * 2 - 2)) + 2 * ((L >> 1) - 1 - n31 + 8 * hh + 32);
    int cbl[2], ca[2];
#pragma unroll
    for (int ot = 0; ot < 2; ++ot) { const int col = 32 * ot + n31; cbl[ot] = (col >> lgnb) << lgnb; ca[ot] = col & (nblk - 1); }
    const bool two = (ntile == 2);
    {
      LP zero = wl + HY_HR + 16 * hh;
      LP ap = fb + 64 * dmax;
      int bbr0 = ca[0] + dmax, bbr1 = ca[1] + dmax;
      LP bp0 = zin + ((cbl[0] + bbr0) * 40 + 8 * hh) * 2, bp1 = zin + ((cbl[1] + bbr1) * 40 + 8 * hh) * 2;
      for (int d = -dmax; d <= dmax; ++d) {
        u32x4 w0v, w1v;
        w0v.x = *(const LAS unsigned*)(ap); w0v.y = *(const LAS unsigned*)(ap + 4); w0v.z = *(const LAS unsigned*)(ap + 8); w0v.w = *(const LAS unsigned*)(ap + 12);
        w1v.x = *(const LAS unsigned*)(ap + 32); w1v.y = *(const LAS unsigned*)(ap + 36); w1v.z = *(const LAS unsigned*)(ap + 40); w1v.w = *(const LAS unsigned*)(ap + 44);
        const bf16x8 af0 = __builtin_bit_cast(bf16x8, w0v), af1 = __builtin_bit_cast(bf16x8, w1v);
        LP q0 = ((unsigned)bbr0 < (unsigned)nblk) ? bp0 : zero;
        LP q1 = (two && ((unsigned)bbr1 < (unsigned)nblk)) ? bp1 : zero;
        const bf16x8 b00 = *(const LAS bf16x8*)q0, b01 = *(const LAS bf16x8*)(q0 + 32);
        const bf16x8 b10 = *(const LAS bf16x8*)q1, b11 = *(const LAS bf16x8*)(q1 + 32);
        __builtin_amdgcn_sched_barrier(0);
        accs[0] = __builtin_amdgcn_mfma_f32_32x32x16_bf16(af0, b00, accs[0], 0, 0, 0);
        if (two) accs[1] = __builtin_amdgcn_mfma_f32_32x32x16_bf16(af0, b10, accs[1], 0, 0, 0);
        accs[0] = __builtin_amdgcn_mfma_f32_32x32x16_bf16(af1, b01, accs[0], 0, 0, 0);
        if (two) accs[1] = __builtin_amdgcn_mfma_f32_32x32x16_bf16(af1, b11, accs[1], 0, 0, 0);
        ap -= 64; bbr0 -= 1; bbr1 -= 1; bp0 -= 80; bp1 -= 80;
      }
    }
#pragma unroll
    for (int ot = 0; ot < 2; ++ot) {
      if (ot >= ntile) continue;
      const f32x16 acc = accs[ot];
#pragma unroll
      for (int rg = 0; rg < 4; ++rg) {
        const int zo = (((cbl[ot] + ca[ot]) * 40) + 8 * rg + 4 * hh) * 2;
        const u32x2 zv = *(const LAS u32x2*)(zin + zo);
        u32x2 w; w.x = pack2(acc[4 * rg] + sk * bflo(zv.x), acc[4 * rg + 1] + sk * bfhi(zv.x)); w.y = pack2(acc[4 * rg + 2] + sk * bflo(zv.y), acc[4 * rg + 3] + sk * bfhi(zv.y));
        *(LAS u32x2*)(zout + zo) = w;
      }
    }
    asm volatile("s_waitcnt lgkmcnt(0)" ::: "memory");
#pragma unroll
    for (int i = 0; i < 4; ++i) { const int base = lane * 8 + 512 * i;
      if (base < ntok) { const u32x4 v = gv[i];
        float u[10]; u[0] = bf2f(gpv[i]); u[1] = bflo(v.x); u[2] = bfhi(v.x); u[3] = bflo(v.y); u[4] = bfhi(v.y); u[5] = bflo(v.z); u[6] = bfhi(v.z); u[7] = bflo(v.w); u[8] = bfhi(v.w); u[9] = bf2f(gnx[i]);
        LP zp = zout + ((base >> 5) * 40 + (base & 31)) * 2; const u32x4 t = *(const LAS u32x4*)zp;
        float tv[8]; tv[0] = bflo(t.x); tv[1] = bfhi(t.x); tv[2] = bflo(t.y); tv[3] = bfhi(t.y); tv[4] = bflo(t.z); tv[5] = bfhi(t.z); tv[6] = bflo(t.w); tv[7] = bfhi(t.w);
        float o[8];
#pragma unroll
        for (int e = 0; e < 8; ++e) o[e] = (cb + w0 * u[e] + w1 * u[e + 1] + w2 * u[e + 2]) * tv[e];
        u32x4 w; w.x = pack2(o[0], o[1]); w.y = pack2(o[2], o[3]); w.z = pack2(o[4], o[5]); w.w = pack2(o[6], o[7]);
        *(LAS u32x4*)zp = w; } }
    asm volatile("s_waitcnt lgkmcnt(0)" ::: "memory");
  }
  __syncthreads();
  { bf16_t* YH = (bf16_t*)((unsigned char*)p.out + OUT_HB);
    for (int tl = tid; tl < ntok; tl += 512) {
      const int bl = tl >> lgL, tloc = tl & (L - 1); const int zo = ((((bl << lgnb) + (tloc >> 5)) * 40) + (tloc & 31)) * 2;
      unsigned short e[8];
#pragma unroll
      for (int w = 0; w < 8; ++w) e[w] = *(const LAS unsigned short*)(lds + w * HY_WAVE + HY_ZA + zo);
      u32x4 o; o.x = e[0] | ((unsigned)e[1] << 16); o.y = e[2] | ((unsigned)e[3] << 16); o.z = e[4] | ((unsigned)e[5] << 16); o.w = e[6] | ((unsigned)e[7] << 16);
      *(u32x4*)(YH + (size_t)(tok0 + tl) * 1024 + cgp * 8) = o; } }
  __syncthreads();
}

__device__ void final_norm(const Params& p) {
  const int tid0 = opaque_tid(); const int wid = tid0 >> 6, lane = tid0 & 63; const float* fw = p.in[31];
  const float* P = (const float*)(p.ws + OFF_BIG + (size_t)8192 * 4096 * 2); const float* mod = (const float*)(p.ws + OFF_MOD);
  f32x4 wv[4];
#pragma unroll
  for (int i = 0; i < 4; ++i) wv[i] = *(const f32x4*)(fw + 4 * lane + 256 * i);
  for (int unit = blockIdx.x; unit < 768; unit += gridDim.x) {
    const int row0 = unit * 32 + wid * 4; const bool chunkB = row0 >= 16384;
    f32x4 x[4][4];
#pragma unroll
    for (int r = 0; r < 4; ++r)
#pragma unroll
      for (int i = 0; i < 4; ++i) x[r][i] = *(const f32x4*)(p.out + (size_t)(row0 + r) * 1024 + 4 * lane + 256 * i);
    if (chunkB) { const float* md = mod + cond_of_row(row0) * 6144 + 5120;
#pragma unroll
      for (int i = 0; i < 4; ++i) { const f32x4 g2 = *(const f32x4*)(md + 4 * lane + 256 * i);
#pragma unroll
        for (int r = 0; r < 4; ++r) x[r][i] += g2 * *(const f32x4*)(P + (size_t)(row0 + r - 16384) * 1024 + 4 * lane + 256 * i); } }
#pragma unroll
    for (int r = 0; r < 4; ++r) { float ss = 0.f;
#pragma unroll
      for (int i = 0; i < 4; ++i) ss += x[r][i][0] * x[r][i][0] + x[r][i][1] * x[r][i][1] + x[r][i][2] * x[r][i][2] + x[r][i][3] * x[r][i][3];
      ss = wave_sum(ss); const float rstd = rsqrtf(ss * (1.0f / 1024.0f) + 1e-6f);
#pragma unroll
      for (int i = 0; i < 4; ++i) *(f32x4*)(p.out + (size_t)(row0 + r) * 1024 + 4 * lane + 256 * i) = x[r][i] * rstd * wv[i]; }
  }
}

__device__ __forceinline__ int xcd_group_index(int c, int lg) {
  if (gridDim.x != 256u) return c;
  const int xcd = c & 7, slot = c >> 3;
  return ((((slot >> lg) << 3) + xcd) << lg) + (slot & ((1 << lg) - 1));
}
__global__ void __launch_bounds__(512, 2) __attribute__((flatten)) mega(Params p) {
  extern __shared__ __attribute__((aligned(16))) unsigned char shm[];
  LP lds = (LP)shm;
  cg::grid_group grid = cg::this_grid();
  volatile LAS unsigned* xst = (volatile LAS unsigned*)(lds + LDS_BYTES - 16);
  if (threadIdx.x == 0) { xst[0] = 0u; xst[1] = 0u; }
  __syncthreads();
  const XcdBarrier xb = xcd_barrier_post((unsigned*)(p.ws + OFF_BAR), xst);
  unsigned char* ws = p.ws;
  const bf16_t* WT = (const bf16_t*)(ws + OFF_WT); const bf16_t* HN = (const bf16_t*)(ws + OFF_HN); bf16_t* BIG = (bf16_t*)(ws + OFF_BIG);
  bf16_t* Hb = (bf16_t*)((unsigned char*)p.out + OUT_H); bf16_t* YH = (bf16_t*)((unsigned char*)p.out + OUT_HB);
  const float* mod = (const float*)(ws + OFF_MOD);
  phase0(p, lds);
  if (gridDim.y == 7u) grid.sync();
  xcd_barrier(xb);
  phase1(p, lds);
  weight_tiles(p, lds, 0, 384, 0);
  xcd_barrier(xb);
  filters_upper_half(p, lds);
  weight_tiles(p, lds, 384, 768, 1);
  { EpiQKV e; e.O = BIG; e.bias = p.in[11]; run_gemm(lds, HN, WT, NTOK, 3072, 1024, e); }
  xcd_barrier(xb);
  for (int item = xcd_group_index((int)blockIdx.x, 2); item < 1280; item += gridDim.x) mlstm_item(p, lds, item);
  xcd_barrier(xb);
  combine_rows(p);
  weight_tiles(p, lds, 768, 1152, 1);
  { EpiUT e; e.O = BIG; e.bias = p.in[11] + 4112; run_gemm(lds, WT + (size_t)3072 * 1024, HN, 3072, NTOK, 1024, e); }
  xcd_barrier(xb);
  for (int item = xcd_group_index((int)blockIdx.x, 3); item < 1536; item += gridDim.x) hyena_item(p, lds, item);
  xcd_barrier(xb);
  c1_upper_half(p, lds);
  weight_tiles(p, lds, 1152, 1536, 1);
  { EpiGates e; e.H = Hb; e.G = BIG; e.b_in = p.in[11]; run_gemm(lds, HN, WT + (size_t)6144 * 1024, NTOK, 3072, 1024, e); }
  xcd_barrier(xb);
  bf16_t* T = BIG + (size_t)NTOK * 2048;
  weight_tiles(p, lds, 1536, 2560, 1);
  { EpiMerge<0> e; e.T = T; e.G = BIG; run_gemm(lds, Hb, (const bf16_t*)(ws + OFF_WBM), NTOK, 1024, 1024, e); }
  { EpiMerge<1> e; e.T = T; e.G = BIG; run_gemm(lds, YH, (const bf16_t*)(ws + OFF_WBH), NTOK, 1024, 1024, e); }
  xcd_barrier(xb);
  { EpiOut e; e.xp = p.in[0]; e.xs = p.in[1]; e.per = (const float*)(ws + OFF_PER); e.pec = (const float*)(ws + OFF_PEC); e.mod = mod; e.n2w = p.in[26];
    e.X1 = p.out; e.A2 = (bf16_t*)(ws + OFF_HN); e.ssq = (float*)(ws + OFF_SSQ1); run_gemm(lds, T, (const bf16_t*)(ws + OFF_WOUT), NTOK, 1024, 1024, e); }
  xcd_barrier(xb);
  constexpr int ROWS_A = 16384, ROWS_B = NTOK - ROWS_A;
  { EpiFF1 e; e.row0 = 0; e.ssq = (const float*)(p.ws + OFF_SSQ1); e.c1 = (const float*)(p.ws + OFF_C1); e.Hd = (bf16_t*)(p.ws + OFF_BIG);
    run_gemm(lds, (const bf16_t*)(p.ws + OFF_HN), (const bf16_t*)(p.ws + OFF_W1T), ROWS_A, 4096, 1024, e); }
  xcd_barrier(xb);
  { EpiFF2 e; e.row0 = 0; e.mod = (const float*)(p.ws + OFF_MOD); e.b2 = p.in[30]; e.X = p.out; e.P = (float*)(p.ws + OFF_BIG + (size_t)ROWS_A * 4096 * 2);
    run_gemm(lds, (const bf16_t*)(p.ws + OFF_BIG), (const bf16_t*)(p.ws + OFF_W2T), ROWS_A, 1024, 4096, e); }
  xcd_barrier(xb);
  { EpiFF1 e; e.row0 = ROWS_A; e.ssq = (const float*)(p.ws + OFF_SSQ1); e.c1 = (const float*)(p.ws + OFF_C1); e.Hd = (bf16_t*)(p.ws + OFF_BIG);
    run_gemm(lds, (const bf16_t*)(p.ws + OFF_HN) + (size_t)ROWS_A * 1024, (const bf16_t*)(p.ws + OFF_W1T), ROWS_B, 4096, 1024, e); }
  xcd_barrier(xb);
  { EpiFF2 e; e.row0 = ROWS_A; e.mod = (const float*)(p.ws + OFF_MOD); e.b2 = p.in[30]; e.X = p.out; e.P = (float*)(p.ws + OFF_BIG + (size_t)ROWS_B * 4096 * 2);
    run_gemm(lds, (const bf16_t*)(p.ws + OFF_BIG), (const bf16_t*)(p.ws + OFF_W2T), ROWS_B, 1024, 4096, e, 2); }
  xcd_barrier(xb);
  final_norm(p);
}

extern "C" void kernel_launch(void* const* d_in, const int* in_sizes, int n_in, void* d_out, int out_size, void* d_ws, size_t ws_size, hipStream_t stream) {
  static int grid_blocks = 0;
  if (!grid_blocks) {
    int dev = 0, cus = 0, per_cu = 0;
    hipGetDevice(&dev);
    hipDeviceGetAttribute(&cus, hipDeviceAttributeMultiprocessorCount, dev);
    hipFuncSetAttribute((const void*)mega, hipFuncAttributeMaxDynamicSharedMemorySize, LDS_BYTES);
    hipOccupancyMaxActiveBlocksPerMultiprocessor(&per_cu, (const void*)mega, 512, LDS_BYTES);
    if (per_cu < 1) { fprintf(stderr, "kernel_launch: occupancy query reports %d blocks per CU\n", per_cu); grid_blocks = -1; }
    else grid_blocks = cus;
    if (n_in != 32 || ws_size < WS_END) { fprintf(stderr, "kernel_launch: unexpected n_in %d / ws_size %zu (need %zu)\n", n_in, ws_size, (size_t)WS_END); grid_blocks = -1; }
  }
  if (grid_blocks < 0) return;
  hipMemsetAsync((unsigned char*)d_ws + OFF_BAR, 0, 3456 * 4, stream);
  Params p{};
  for (int i = 0; i < 32; ++i) p.in[i] = (const float*)d_in[i];
  p.out = (float*)d_out; p.ws = (unsigned char*)d_ws;
  void* args[] = {&p};
  hipError_t e = hipLaunchCooperativeKernel((void*)mega, dim3(grid_blocks), dim3(512), args, LDS_BYTES, stream);
  if (e != hipSuccess) fprintf(stderr, "cooperative launch failed: %s (grid %d)\n", hipGetErrorString(e), grid_blocks);
}
```
